# Optimizing an MI355X kernel written in HIP

```python
import jax, jax.numpy as jnp
from jax import lax
import numpy as np

D_MODEL = 2048
BATCH = 4
SEQ = 4096
DEPTH = 1

CHUNK = 64
Q_BLOCK = 128
EPS = 1e-6

MLA_HEADS = 8
MLA_Q_RANK = 512
MLA_KV_RANK = 256
MLA_NOPE = 128
MLA_ROPE = 64
MLA_V = 128
ROPE_THETA = 10000.0

SB_HEADS = 8
SB_DIM = 128
SB_WIDTH = SB_HEADS * SB_DIM

PEER_HEADS = 8
PEER_NKEYS = 128
PEER_N = PEER_NKEYS * PEER_NKEYS
PEER_DKEY = 256
PEER_TOPK = 16
PEER_TOK_BLOCK = 128

IN_SIZES = (MLA_Q_RANK, MLA_KV_RANK, MLA_ROPE, SB_WIDTH, SB_WIDTH, SB_WIDTH, D_MODEL, D_MODEL)
IN_COLS = MLA_Q_RANK + MLA_KV_RANK + MLA_ROPE + 3 * SB_WIDTH + 2 * D_MODEL
N_ADA = 6

kernel_name = "hybrid_mla_stickbreak_peer_block"


def rmsnorm(x, g):
    xf = x.astype(jnp.float32)
    y = xf * lax.rsqrt(jnp.mean(xf * xf, axis=-1, keepdims=True) + EPS)
    return (y * g.astype(jnp.float32)).astype(x.dtype)


def rope(x, cos, sin):
    half = x.shape[-1] // 2
    x1, x2 = x[..., :half], x[..., half:]
    return jnp.concatenate([x1 * cos - x2 * sin, x2 * cos + x1 * sin], axis=-1)


def mla_attention(q_nope, q_rope, k_nope, k_rope, v):
    B, S, H, _ = q_nope.shape
    nb = S // Q_BLOCK
    qn = q_nope.reshape(B, nb, Q_BLOCK, H, MLA_NOPE).transpose(1, 0, 2, 3, 4)
    qr = q_rope.reshape(B, nb, Q_BLOCK, H, MLA_ROPE).transpose(1, 0, 2, 3, 4)
    q0s = jnp.arange(nb, dtype=jnp.int32) * Q_BLOCK
    key_chunk = jnp.arange(S, dtype=jnp.int32) // CHUNK
    scale = (MLA_NOPE + MLA_ROPE) ** -0.5

    def block(args):
        qn_b, qr_b, q0 = args
        s = (jnp.einsum('bqhd,bkhd->bhqk', qn_b, k_nope)
             + jnp.einsum('bqhd,bkd->bhqk', qr_b, k_rope)).astype(jnp.float32) * scale
        q_chunk = (q0 + jnp.arange(Q_BLOCK, dtype=jnp.int32)) // CHUNK
        allowed = key_chunk[None, :] <= q_chunk[:, None]
        s = jnp.where(allowed, s, -jnp.inf)
        p = jax.nn.softmax(s, axis=-1).astype(v.dtype)
        return jnp.einsum('bhqk,bkhd->bqhd', p, v)

    out = lax.map(block, (qn, qr, q0s))
    return out.transpose(1, 0, 2, 3, 4).reshape(B, S, H * MLA_V)


def stick_breaking_attention(q, k, v):
    B, S, H, Dh = q.shape
    nb = S // Q_BLOCK
    qb = q.reshape(B, nb, Q_BLOCK, H, Dh).transpose(1, 0, 2, 3, 4)
    q0s = jnp.arange(nb, dtype=jnp.int32) * Q_BLOCK
    key_pos = jnp.arange(S, dtype=jnp.int32)
    scale = Dh ** -0.5

    def block(args):
        q_b, q0 = args
        z = jnp.einsum('bqhd,bkhd->bhqk', q_b, k).astype(jnp.float32) * scale
        q_pos = q0 + jnp.arange(Q_BLOCK, dtype=jnp.int32)
        strict = key_pos[None, :] < q_pos[:, None]
        log_not = jnp.where(strict, jax.nn.log_sigmoid(-z), 0.0)
        later = lax.cumsum(log_not, axis=3, reverse=True) - log_not
        w = jnp.where(strict, jnp.exp(jax.nn.log_sigmoid(z) + later), 0.0)
        return jnp.einsum('bhqk,bkhd->bqhd', w.astype(v.dtype), v)

    out = lax.map(block, (qb, q0s))
    return out.transpose(1, 0, 2, 3, 4).reshape(B, S, H * Dh)


def token_mixer(h, cos, sin, w_in, q_norm_g, kv_norm_g, w_uq, w_ukv, w_branch_mla, w_branch_sb, w_out):
    B, S, _ = h.shape
    proj = h @ w_in
    cq, ckv, kr, sbq, sbk, sbv, gate_a, gate_b = jnp.split(proj, np.cumsum(IN_SIZES)[:-1].tolist(), axis=-1)
    q = (rmsnorm(cq, q_norm_g) @ w_uq).reshape(B, S, MLA_HEADS, MLA_NOPE + MLA_ROPE)
    q_nope, q_rope = q[..., :MLA_NOPE], q[..., MLA_NOPE:]
    q_rope = rope(q_rope, cos[:, :, None, :], sin[:, :, None, :])
    kv = (rmsnorm(ckv, kv_norm_g) @ w_ukv).reshape(B, S, MLA_HEADS, MLA_NOPE + MLA_V)
    k_nope, v_mla = kv[..., :MLA_NOPE], kv[..., MLA_NOPE:]
    k_rope = rope(kr, cos, sin)
    y_a = mla_attention(q_nope, q_rope, k_nope, k_rope, v_mla) @ w_branch_mla
    shp = (B, S, SB_HEADS, SB_DIM)
    y_b = stick_breaking_attention(sbq.reshape(shp), sbk.reshape(shp), sbv.reshape(shp)) @ w_branch_sb
    merged = jax.nn.sigmoid(gate_a) * y_a + jax.nn.sigmoid(gate_b) * y_b
    return merged @ w_out


def peer_ffn(h, w_q, sub_keys, u_tab, v_tab):
    B, S, D = h.shape
    q = (h @ w_q).reshape(B, S, PEER_HEADS, PEER_DKEY).astype(jnp.float32)
    half = PEER_DKEY // 2
    s1 = jnp.einsum('bshd,hnd->bshn', q[..., :half], sub_keys[:, 0].astype(jnp.float32))
    s2 = jnp.einsum('bshd,hnd->bshn', q[..., half:], sub_keys[:, 1].astype(jnp.float32))
    v1, i1 = lax.top_k(s1, PEER_TOPK)
    v2, i2 = lax.top_k(s2, PEER_TOPK)
    cand = (v1[..., :, None] + v2[..., None, :]).reshape(B, S, PEER_HEADS, PEER_TOPK * PEER_TOPK)
    sc, ci = lax.top_k(cand, PEER_TOPK)
    e1 = jnp.take_along_axis(i1, ci // PEER_TOPK, axis=-1)
    e2 = jnp.take_along_axis(i2, ci % PEER_TOPK, axis=-1)
    idx = e1 * PEER_NKEYS + e2
    g = jax.nn.softmax(sc, axis=-1).astype(h.dtype)
    nblk = (B * S) // PEER_TOK_BLOCK
    hb = h.reshape(nblk, PEER_TOK_BLOCK, D)
    ib = idx.reshape(nblk, PEER_TOK_BLOCK, PEER_HEADS * PEER_TOPK)
    gb = g.reshape(nblk, PEER_TOK_BLOCK, PEER_HEADS * PEER_TOPK)

    def block(args):
        h_b, i_b, g_b = args
        act = jax.nn.gelu(jnp.einsum('td,tkd->tk', h_b, u_tab[i_b]))
        return jnp.einsum('tk,tkd->td', g_b * act, v_tab[i_b])

    out = lax.map(block, (hb, ib, gb))
    return out.reshape(B, S, D)


def setup_inputs(seed: int = 0) -> dict:
    key = jax.random.key(seed)
    ks = jax.random.split(key, 20)

    def nrm(k, shape, scale):
        return jax.random.normal(k, shape, jnp.float32) * scale

    d_mla_out = MLA_HEADS * MLA_V
    return {
        "x": nrm(ks[0], (BATCH, SEQ, D_MODEL), 1.0),
        "c": nrm(ks[1], (BATCH, D_MODEL), 1.0),
        "positions": jax.random.randint(ks[2], (BATCH, 1), 0, 65536, dtype=jnp.int32)
                     + jnp.arange(SEQ, dtype=jnp.int32)[None, :],
        "ada_w": nrm(ks[3], (DEPTH, D_MODEL, N_ADA * D_MODEL), 0.5 * D_MODEL ** -0.5),
        "ada_b": nrm(ks[4], (DEPTH, N_ADA * D_MODEL), 0.02),
        "norm1_g": 1.0 + nrm(ks[5], (DEPTH, D_MODEL), 0.02),
        "norm2_g": 1.0 + nrm(ks[6], (DEPTH, D_MODEL), 0.02),
        "w_in": nrm(ks[7], (DEPTH, D_MODEL, IN_COLS), D_MODEL ** -0.5),
        "mla_q_norm_g": 1.0 + nrm(ks[8], (DEPTH, MLA_Q_RANK), 0.02),
        "mla_kv_norm_g": 1.0 + nrm(ks[9], (DEPTH, MLA_KV_RANK), 0.02),
        "mla_w_uq": nrm(ks[10], (DEPTH, MLA_Q_RANK, MLA_HEADS * (MLA_NOPE + MLA_ROPE)), MLA_Q_RANK ** -0.5),
        "mla_w_ukv": nrm(ks[11], (DEPTH, MLA_KV_RANK, MLA_HEADS * (MLA_NOPE + MLA_V)), MLA_KV_RANK ** -0.5),
        "w_branch_mla": nrm(ks[12], (DEPTH, d_mla_out, D_MODEL), d_mla_out ** -0.5),
        "w_branch_sb": nrm(ks[13], (DEPTH, SB_WIDTH, D_MODEL), SB_WIDTH ** -0.5),
        "w_out": nrm(ks[14], (DEPTH, D_MODEL, D_MODEL), D_MODEL ** -0.5),
        "peer_w_q": nrm(ks[15], (DEPTH, D_MODEL, PEER_HEADS * PEER_DKEY), D_MODEL ** -0.5),
        "peer_sub_keys": nrm(ks[16], (DEPTH, PEER_HEADS, 2, PEER_NKEYS, PEER_DKEY // 2), (PEER_DKEY // 2) ** -0.5),
        "peer_u": nrm(ks[17], (DEPTH, PEER_N, D_MODEL), D_MODEL ** -0.5),
        "peer_v": nrm(ks[18], (DEPTH, PEER_N, D_MODEL), 1.0),
        "final_norm_g": 1.0 + nrm(ks[19], (D_MODEL,), 0.02),
    }


def reference(x, c, positions, ada_w, ada_b, norm1_g, norm2_g, w_in, mla_q_norm_g, mla_kv_norm_g,
              mla_w_uq, mla_w_ukv, w_branch_mla, w_branch_sb, w_out, peer_w_q, peer_sub_keys,
              peer_u, peer_v, final_norm_g):
    inv_freq = ROPE_THETA ** (-jnp.arange(0, MLA_ROPE, 2, dtype=jnp.float32) / MLA_ROPE)
    ang = positions.astype(jnp.float32)[..., None] * inv_freq
    cos = jnp.cos(ang).astype(x.dtype)
    sin = jnp.sin(ang).astype(x.dtype)
    for l in range(DEPTH):
        mod = jax.nn.silu(c) @ ada_w[l] + ada_b[l]
        sh1, sc1, gt1, sh2, sc2, gt2 = [m[:, None, :] for m in jnp.split(mod, N_ADA, axis=-1)]
        h = rmsnorm(x, norm1_g[l]) * (1.0 + sc1) + sh1
        x = x + gt1 * token_mixer(h, cos, sin, w_in[l], mla_q_norm_g[l], mla_kv_norm_g[l],
                                  mla_w_uq[l], mla_w_ukv[l], w_branch_mla[l], w_branch_sb[l], w_out[l])
        h = rmsnorm(x, norm2_g[l]) * (1.0 + sc2) + sh2
        x = x + gt2 * peer_ffn(h, peer_w_q[l], peer_sub_keys[l], peer_u[l], peer_v[l])
    return rmsnorm(x, final_norm_g)
```

```cpp
#include <hip/hip_runtime.h>
#include <hip/hip_cooperative_groups.h>
#include <cstdio>
#include <cstdint>
#include <cmath>
namespace cg = cooperative_groups;

#ifndef N_LAUNCH_MODE
#define N_LAUNCH_MODE 1
#endif

#ifndef DBG_ALPHA
#define DBG_ALPHA 1.0f
#endif
#ifndef DBG_BETA
#define DBG_BETA 1.0f
#endif
#define LAS __attribute__((address_space(3)))
#define DI __device__ __forceinline__
typedef unsigned short bf16_t;
typedef short bf16x8 __attribute__((ext_vector_type(8)));
typedef float f32x4 __attribute__((ext_vector_type(4)));
typedef float f32x2 __attribute__((ext_vector_type(2)));
typedef unsigned u32x4 __attribute__((ext_vector_type(4)));
typedef unsigned u32x2 __attribute__((ext_vector_type(2)));
typedef __bf16 bf16v2 __attribute__((ext_vector_type(2)));

constexpr int M = 16384, D = 2048, SEQ = 4096, NB = 4;
constexpr int NTHREADS = 512, NWAVES = 8;
constexpr int LDS_BYTES = 160 * 1024;
constexpr float EPS = 1e-6f;
constexpr float LOG2E = 1.4426950408889634f;
constexpr int NPHASE = 12;

constexpr size_t al256(size_t x) { return (x + 255) & ~(size_t)255; }
constexpr size_t OFF_CTL = 0;
constexpr size_t OFF_MODI = 4096;
constexpr size_t ZERO_BYTES = OFF_MODI + (size_t)NB * 6 * D * 8;
constexpr size_t OFF_MOD = al256(ZERO_BYTES);
constexpr size_t OFF_RSTQ = OFF_MOD + (size_t)NB * 6 * D * 4;
constexpr size_t OFF_RSTKV = OFF_RSTQ + (size_t)M * 4;
constexpr size_t OFF_CS = OFF_RSTKV + (size_t)M * 4;
constexpr size_t OFF_KEYS = OFF_CS + (size_t)M * 32 * 8;
constexpr size_t OFF_WIN = OFF_KEYS + (size_t)8 * 2 * 128 * 128 * 2;
constexpr size_t OFF_WSBV = OFF_WIN + (size_t)7168 * 2048 * 2;
constexpr size_t OFF_WUQ = OFF_WSBV + (size_t)1024 * 2048 * 2;
constexpr size_t OFF_WUK = OFF_WUQ + (size_t)1536 * 512 * 2;
constexpr size_t OFF_WUV = OFF_WUK + (size_t)1024 * 256 * 2;
constexpr size_t OFF_WA = OFF_WUV + (size_t)1024 * 256 * 2;
constexpr size_t OFF_WB = OFF_WA + (size_t)2048 * 1024 * 2;
constexpr size_t OFF_WOUT = OFF_WB + (size_t)2048 * 1024 * 2;
constexpr size_t OFF_WPQ = OFF_WOUT + (size_t)2048 * 2048 * 2;
constexpr size_t OFF_H = OFF_WPQ + (size_t)2048 * 2048 * 2;
constexpr size_t OFF_CQ = OFF_H + (size_t)M * 2048 * 2;
constexpr size_t OFF_CKV = OFF_CQ + (size_t)M * 512 * 2;
constexpr size_t OFF_KR = OFF_CKV + (size_t)M * 256 * 2;
constexpr size_t OFF_SBQ = OFF_KR + (size_t)M * 64 * 2;
constexpr size_t OFF_SBK = OFF_SBQ + (size_t)M * 1024 * 2;
constexpr size_t OFF_SBVT = OFF_SBK + (size_t)M * 1024 * 2;
constexpr size_t OFF_GA = OFF_SBVT + (size_t)M * 1024 * 2;
constexpr size_t OFF_GB = OFF_GA + (size_t)M * 2048 * 2;
constexpr size_t OFF_Q = OFF_GB + (size_t)M * 2048 * 2;
constexpr size_t OFF_KN = OFF_Q + (size_t)M * 1536 * 2;
constexpr size_t OFF_VT = OFF_KN + (size_t)M * 1024 * 2;
constexpr size_t OFF_ATTA = OFF_VT + (size_t)M * 1024 * 2;
constexpr size_t OFF_ATTB = OFF_ATTA + (size_t)M * 1024 * 2;
constexpr size_t WS_END = OFF_ATTB + (size_t)M * 1024 * 2;
constexpr size_t OFF_MERGED = OFF_SBQ;
constexpr size_t OFF_PQ = OFF_GA;
constexpr size_t OFF_IDX = OFF_GB;
constexpr size_t OFF_GW = OFF_GB + (size_t)M * 128 * 4;
constexpr size_t OFF_U16 = OFF_Q;
constexpr size_t OFF_V16 = OFF_U16 + (size_t)16384 * 2048 * 2;
static_assert(OFF_V16 + (size_t)16384 * 2048 * 2 <= WS_END, "u/v overlay");
static_assert(WS_END < (size_t)620 * 1000 * 1000, "workspace budget");

struct Params {
    const float *x, *c; const int* pos;
    const float *ada_w, *ada_b, *n1g, *n2g, *w_in, *qng, *kvng, *w_uq, *w_ukv, *w_bm, *w_bs, *w_out, *w_pq, *skeys, *pu, *pv, *fng;
    float* out; unsigned char* ws;
    float invf[32];
    int ph_lo, ph_hi;
};

DI unsigned pk2(float lo, float hi) { bf16v2 p; p[0] = (__bf16)lo; p[1] = (__bf16)hi; return __builtin_bit_cast(unsigned, p); }
DI float bflo(unsigned u) { return __uint_as_float(u << 16); }
DI float bfhi(unsigned u) { return __uint_as_float(u & 0xffff0000u); }
DI float dot2bf(unsigned a, unsigned b, float c) { return __builtin_amdgcn_fdot2_f32_bf16(__builtin_bit_cast(bf16v2, a), __builtin_bit_cast(bf16v2, b), c, false); }
DI float bf2f(bf16_t b) { return __uint_as_float(((unsigned)b) << 16); }
DI float wave_sum(float v) {
#pragma unroll
    for (int o = 1; o < 64; o <<= 1) v += __shfl_xor(v, o);
    return v;
}
DI float wave_max(float v) {
#pragma unroll
    for (int o = 1; o < 64; o <<= 1) v = fmaxf(v, __shfl_xor(v, o));
    return v;
}
DI float sigmoidf_(float v) { return 1.f / (1.f + __expf(-v)); }
DI float gelu_tanh(float v) { const float u = 0.7978845608028654f * (v + 0.044715f * v * v * v); const float e = __expf(2.f * u); const float t = 1.f - 2.f / (e + 1.f); return 0.5f * v * (1.f + t); }
DI void store_bf16x4(bf16_t* p, f32x4 v) { u32x2 w; w.x = pk2(v[0], v[1]); w.y = pk2(v[2], v[3]); *(u32x2*)p = w; }
DI f32x4 load_bf16x4(const bf16_t* p) { const u32x2 w = *(const u32x2*)p; return (f32x4){bflo(w.x), bfhi(w.x), bflo(w.y), bfhi(w.y)}; }

struct Ctx {
    LAS unsigned char* lds;
    int tid, lane, wave, gw, ngw;
};

struct MapWin { DI int operator()(int n) const {
    if (n < 768) return n;
    if (n < 1024) { const int j = n - 768; if (j >= 64) return -1; return 768 + (j >> 1) + 32 * (j & 1); }
    if (n < 2048) return 832 + (n - 1024);
    if (n < 3072) return 1856 + (n - 2048);
    if (n < 5120) return 3904 + (n - 3072);
    return 5952 + (n - 5120); } };
struct MapOff { int off; DI int operator()(int n) const { return n + off; } };
struct MapUq { DI int operator()(int n) const { const int hd = n / 192, j = n % 192; if (j < 128) return hd * 192 + j; const int jj = j - 128; return hd * 192 + 128 + (jj >> 1) + 32 * (jj & 1); } };
struct MapUk { DI int operator()(int n) const { return (n >> 7) * 256 + (n & 127); } };
struct MapUv { DI int operator()(int n) const { return (n >> 7) * 256 + 128 + (n & 127); } };

template <class Map>
DI void transpose_item(const float* W, int K, int N, const Map& mp, const float* rowscale, bf16_t* dst, int kb, int nb, LAS float* scr, int lane) {
    const int k0 = kb * 64, sc = mp(nb * 64 + lane);
#pragma unroll 8
    for (int kk = 0; kk < 64; ++kk) {
        float v = 0.f;
        if (sc >= 0) v = W[(size_t)(k0 + kk) * N + sc];
        if (rowscale) v *= rowscale[k0 + kk];
        scr[kk * 65 + lane] = v;
    }
    asm volatile("s_waitcnt lgkmcnt(0)" ::: "memory");
    const int kc = lane & 7;
#pragma unroll
    for (int j = 0; j < 8; ++j) {
        const int nrow = (lane >> 3) + 8 * j; const LAS float* s = scr + (8 * kc) * 65 + nrow;
        u32x4 o; o.x = pk2(s[0], s[65]); o.y = pk2(s[2 * 65], s[3 * 65]); o.z = pk2(s[4 * 65], s[5 * 65]); o.w = pk2(s[6 * 65], s[7 * 65]);
        *(u32x4*)(dst + (size_t)(nb * 64 + nrow) * K + k0 + 8 * kc) = o;
    }
    asm volatile("s_waitcnt lgkmcnt(0)" ::: "memory");
}

DI void phase_prologue(const Params& p, const Ctx& c) {
    unsigned char* ws = p.ws;
    LAS float* scr = (LAS float*)(c.lds + c.wave * 16640);
    unsigned long long* modi = (unsigned long long*)(ws + OFF_MODI);
    for (int u = c.gw; u < 32 * 48; u += c.ngw) {
        const int kp = u / 48, ch = u % 48, k0 = kp * 64, c0 = ch * 256 + c.lane * 4;
        float sl[4];
#pragma unroll
        for (int b = 0; b < 4; ++b) { const float cv = p.c[b * D + k0 + c.lane]; sl[b] = cv / (1.f + __expf(-cv)); }
        f32x4 acc[4];
#pragma unroll
        for (int b = 0; b < 4; ++b) acc[b] = (f32x4){0.f, 0.f, 0.f, 0.f};
#pragma unroll 4
        for (int kk = 0; kk < 64; ++kk) {
            const f32x4 w = *(const f32x4*)(p.ada_w + (size_t)(k0 + kk) * (6 * D) + c0);
#pragma unroll
            for (int b = 0; b < 4; ++b) { const float s = __shfl(sl[b], kk); acc[b] += w * s; }
        }
        if (kp == 0) { const f32x4 bv = *(const f32x4*)(p.ada_b + c0);
#pragma unroll
            for (int b = 0; b < 4; ++b) acc[b] += bv; }
#pragma unroll
        for (int b = 0; b < 4; ++b)
#pragma unroll
            for (int e = 0; e < 4; ++e) atomicAdd(modi + b * 6 * D + c0 + e, (unsigned long long)(long long)__builtin_rint((double)acc[b][e] * 4294967296.0));
    }
    constexpr int I_WIN = 112 * 32, I_SBV = 16 * 32, I_UQ = 24 * 8, I_UK = 16 * 4, I_UV = 16 * 4, I_A = 32 * 16, I_B = 32 * 16, I_OUT = 32 * 32, I_PQ = 32 * 32;
    constexpr int NIT = I_WIN + I_SBV + I_UQ + I_UK + I_UV + I_A + I_B + I_OUT + I_PQ;
    for (int it = c.gw; it < NIT; it += c.ngw) {
        int r = it;
        if (r < I_WIN) { transpose_item(p.w_in, 2048, 8000, MapWin{}, nullptr, (bf16_t*)(ws + OFF_WIN), r % 32, r / 32, scr, c.lane); continue; } r -= I_WIN;
        if (r < I_SBV) { transpose_item(p.w_in, 2048, 8000, MapOff{2880}, nullptr, (bf16_t*)(ws + OFF_WSBV), r % 32, r / 32, scr, c.lane); continue; } r -= I_SBV;
        if (r < I_UQ) { transpose_item(p.w_uq, 512, 1536, MapUq{}, p.qng, (bf16_t*)(ws + OFF_WUQ), r % 8, r / 8, scr, c.lane); continue; } r -= I_UQ;
        if (r < I_UK) { transpose_item(p.w_ukv, 256, 2048, MapUk{}, p.kvng, (bf16_t*)(ws + OFF_WUK), r % 4, r / 4, scr, c.lane); continue; } r -= I_UK;
        if (r < I_UV) { transpose_item(p.w_ukv, 256, 2048, MapUv{}, p.kvng, (bf16_t*)(ws + OFF_WUV), r % 4, r / 4, scr, c.lane); continue; } r -= I_UV;
        if (r < I_A) { transpose_item(p.w_bm, 1024, 2048, MapOff{0}, nullptr, (bf16_t*)(ws + OFF_WA), r % 16, r / 16, scr, c.lane); continue; } r -= I_A;
        if (r < I_B) { transpose_item(p.w_bs, 1024, 2048, MapOff{0}, nullptr, (bf16_t*)(ws + OFF_WB), r % 16, r / 16, scr, c.lane); continue; } r -= I_B;
        if (r < I_OUT) { transpose_item(p.w_out, 2048, 2048, MapOff{0}, nullptr, (bf16_t*)(ws + OFF_WOUT), r % 32, r / 32, scr, c.lane); continue; } r -= I_OUT;
        transpose_item(p.w_pq, 2048, 2048, MapOff{0}, nullptr, (bf16_t*)(ws + OFF_WPQ), r % 32, r / 32, scr, c.lane);
    }
    { bf16_t* kd = (bf16_t*)(ws + OFF_KEYS);
      for (int i = (c.gw * 64 + c.lane) * 4; i < 8 * 2 * 128 * 128; i += c.ngw * 64 * 4) store_bf16x4(kd + i, *(const f32x4*)(p.skeys + i)); }
    { f32x2* cs = (f32x2*)(ws + OFF_CS);
      for (int i = c.gw * 64 + c.lane; i < M * 32; i += c.ngw * 64) {
          const int m = i >> 5, f = i & 31;
          const float ang = (float)p.pos[m] * p.invf[f];
          const double rev = (double)ang * 0.15915494309189533576888;
          const float fr = (float)(rev - __builtin_rint(rev));
          cs[i] = (f32x2){__builtin_amdgcn_cosf(fr), __builtin_amdgcn_sinf(fr)};
      } }
}

DI f32x4 ld_mod4(const float* p) { return *(const f32x4*)p; }
DI f32x4 ld_mod4(const long long* p) { f32x4 r;
#pragma unroll
    for (int e = 0; e < 4; ++e) r[e] = (float)((double)p[e] * (1.0 / 4294967296.0));
    return r; }
template <class MT>
DI void modulate_rows(const float* src, const float* g, const MT* sc, const MT* sh, bf16_t* dst, const Ctx& c) {
    for (int m = c.gw; m < M; m += c.ngw) {
        const int b = m / SEQ;
        const float* xr = src + (size_t)m * D;
        f32x4 v[8]; float ss = 0.f;
#pragma unroll
        for (int j = 0; j < 8; ++j) { v[j] = *(const f32x4*)(xr + (j * 64 + c.lane) * 4); ss += v[j][0] * v[j][0] + v[j][1] * v[j][1] + v[j][2] * v[j][2] + v[j][3] * v[j][3]; }
        const float rstd = rsqrtf(wave_sum(ss) * (1.f / D) + EPS);
#pragma unroll
        for (int j = 0; j < 8; ++j) {
            const int col = (j * 64 + c.lane) * 4;
            const f32x4 gg = *(const f32x4*)(g + col), s1 = ld_mod4(sc + b * 6 * D + col), h1 = ld_mod4(sh + b * 6 * D + col);
            const f32x4 o = v[j] * rstd * gg * (s1 + 1.f) + h1;
            store_bf16x4(dst + (size_t)m * D + col, o);
        }
    }
}
DI void phase_rowstats(const Params& p, const Ctx& c) {
    const bf16_t* cq = (const bf16_t*)(p.ws + OFF_CQ); const bf16_t* ckv = (const bf16_t*)(p.ws + OFF_CKV);
    float* rq = (float*)(p.ws + OFF_RSTQ); float* rkv = (float*)(p.ws + OFF_RSTKV);
    for (int m = c.gw; m < M; m += c.ngw) {
        const u32x4 a = *(const u32x4*)(cq + (size_t)m * 512 + c.lane * 8);
        const u32x2 b = *(const u32x2*)(ckv + (size_t)m * 256 + c.lane * 4);
        float s1 = 0.f, s2 = 0.f;
#pragma unroll
        for (int e = 0; e < 4; ++e) { const float lo = bflo(a[e]), hi = bfhi(a[e]); s1 += lo * lo + hi * hi; }
#pragma unroll
        for (int e = 0; e < 2; ++e) { const float lo = bflo(b[e]), hi = bfhi(b[e]); s2 += lo * lo + hi * hi; }
        s1 = wave_sum(s1); s2 = wave_sum(s2);
        if (c.lane == 0) { rq[m] = rsqrtf(s1 * (1.f / 512.f) + EPS); rkv[m] = rsqrtf(s2 * (1.f / 256.f) + EPS); }
    }
}
DI void convert_table(const float* src, bf16_t* dst, const Ctx& c) {
    const size_t n = (size_t)16384 * 2048;
    for (size_t i = ((size_t)c.gw * 64 + c.lane) * 8; i < n; i += (size_t)c.ngw * 64 * 8) {
        const f32x4 a = *(const f32x4*)(src + i), b = *(const f32x4*)(src + i + 4);
        u32x4 o; o.x = pk2(a[0], a[1]); o.y = pk2(a[2], a[3]); o.z = pk2(b[0], b[1]); o.w = pk2(b[2], b[3]);
        *(u32x4*)(dst + i) = o;
    }
}

struct EpiProj {
    bf16_t *cq, *ckv, *kr, *sbq, *sbk, *ga, *gb; const f32x2* cs;
    DI void operator()(int row, int col, f32x4 v) const {
        const int tile = col >> 8;
        if (tile < 2) { store_bf16x4(cq + (size_t)row * 512 + col, v); }
        else if (tile == 2) { store_bf16x4(ckv + (size_t)row * 256 + (col - 512), v); }
        else if (tile == 3) { const int j = col - 768; if (j < 64) { const f32x2 c0 = cs[row * 32 + (j >> 1)], c1 = cs[row * 32 + (j >> 1) + 1];
            const f32x4 o = {v[0] * c0.x - v[1] * c0.y, v[1] * c0.x + v[0] * c0.y, v[2] * c1.x - v[3] * c1.y, v[3] * c1.x + v[2] * c1.y};
            store_bf16x4(kr + (size_t)row * 64 + j, o); } }
        else if (tile < 8) { store_bf16x4(sbq + (size_t)row * 1024 + (col - 1024), v * (0.08838834764831845f * LOG2E)); }
        else if (tile < 12) { store_bf16x4(sbk + (size_t)row * 1024 + (col - 2048), v); }
        else if (tile < 20) { store_bf16x4(ga + (size_t)row * 2048 + (col - 3072), (f32x4){sigmoidf_(v[0]), sigmoidf_(v[1]), sigmoidf_(v[2]), sigmoidf_(v[3])}); }
        else { store_bf16x4(gb + (size_t)row * 2048 + (col - 5120), (f32x4){sigmoidf_(v[0]), sigmoidf_(v[1]), sigmoidf_(v[2]), sigmoidf_(v[3])}); }
    }
};
struct EpiT { bf16_t* o; const float* cscale;
    DI void operator()(int row, int col, f32x4 v) const { if (cscale) v = v * *(const f32x4*)(cscale + col); store_bf16x4(o + (size_t)row * M + col, v); } };
struct EpiUq { bf16_t* q; const float* rst; const f32x2* cs;
    DI void operator()(int row, int col, f32x4 v) const {
        v = v * (rst[row] * (0.07216878364870322f * LOG2E));
        const int j = col % 192;
        if (j >= 128) { const int i0 = (j - 128) >> 1; const f32x2 c0 = cs[row * 32 + i0], c1 = cs[row * 32 + i0 + 1];
            v = (f32x4){v[0] * c0.x - v[1] * c0.y, v[1] * c0.x + v[0] * c0.y, v[2] * c1.x - v[3] * c1.y, v[3] * c1.x + v[2] * c1.y}; }
        store_bf16x4(q + (size_t)row * 1536 + col, v);
    } };
struct EpiRowScale { bf16_t* o; int ld; const float* rst;
    DI void operator()(int row, int col, f32x4 v) const { store_bf16x4(o + (size_t)row * ld + col, v * rst[row]); } };
struct EpiGate1 { bf16_t* mg; const bf16_t* g;
    DI void operator()(int row, int col, f32x4 v) const { const size_t i = (size_t)row * 2048 + col; store_bf16x4(mg + i, v * load_bf16x4(g + i)); } };
struct EpiGate2 { bf16_t* mg; const bf16_t* g;
    DI void operator()(int row, int col, f32x4 v) const { const size_t i = (size_t)row * 2048 + col; store_bf16x4(mg + i, load_bf16x4(mg + i) + v * load_bf16x4(g + i)); } };
struct EpiRes { const float* x; const float* gt; float* x1;
    DI void operator()(int row, int col, f32x4 v) const { const size_t i = (size_t)row * 2048 + col; const int b = row / SEQ;
        *(f32x4*)(x1 + i) = *(const f32x4*)(x + i) + *(const f32x4*)(gt + b * 6 * D + col) * v * DBG_ALPHA; } };
struct EpiPq { bf16_t* pq;
    DI void operator()(int row, int col, f32x4 v) const { store_bf16x4(pq + (size_t)(col >> 8) * M * 256 + (size_t)row * 256 + (col & 255), v); } };

template <class Epi>
DI void gemm_naive(const Ctx& c, const bf16_t* A, const bf16_t* Bt, int Mg, int Ng, int Kg, const Epi& E) {
    LAS float* As = (LAS float*)c.lds; LAS float* Bs = As + 16 * 132;
    const int tid = c.tid, ty = tid >> 5, tx = tid & 31;
    const int tilesN = Ng / 128, ntiles = (Mg / 128) * tilesN;
    for (int t = blockIdx.x; t < ntiles; t += gridDim.x) {
        const int tm = t / tilesN, tn = t % tilesN;
        float acc[8][4];
#pragma unroll
        for (int i = 0; i < 8; ++i)
#pragma unroll
            for (int j = 0; j < 4; ++j) acc[i][j] = 0.f;
        for (int k0 = 0; k0 < Kg; k0 += 16) {
            { const int lt = tid & 255, r = lt >> 1, kc = lt & 1;
              const bf16_t* src = (tid < 256 ? A + (size_t)(tm * 128 + r) * Kg : Bt + (size_t)(tn * 128 + r) * Kg) + k0 + kc * 8;
              const u32x4 v = *(const u32x4*)src;
              LAS float* dst = (tid < 256 ? As : Bs) + (kc * 8) * 132 + r;
              dst[0] = bflo(v.x); dst[132] = bfhi(v.x); dst[2 * 132] = bflo(v.y); dst[3 * 132] = bfhi(v.y);
              dst[4 * 132] = bflo(v.z); dst[5 * 132] = bfhi(v.z); dst[6 * 132] = bflo(v.w); dst[7 * 132] = bfhi(v.w); }
            __syncthreads();
#pragma unroll
            for (int kk = 0; kk < 16; ++kk) {
                const f32x4 a0 = *(const LAS f32x4*)(As + kk * 132 + ty * 8), a1 = *(const LAS f32x4*)(As + kk * 132 + ty * 8 + 4);
                const f32x4 b = *(const LAS f32x4*)(Bs + kk * 132 + tx * 4);
#pragma unroll
                for (int j = 0; j < 4; ++j) {
                    acc[0][j] += a0[0] * b[j]; acc[1][j] += a0[1] * b[j]; acc[2][j] += a0[2] * b[j]; acc[3][j] += a0[3] * b[j];
                    acc[4][j] += a1[0] * b[j]; acc[5][j] += a1[1] * b[j]; acc[6][j] += a1[2] * b[j]; acc[7][j] += a1[3] * b[j];
                }
            }
            __syncthreads();
        }
#pragma unroll
        for (int i = 0; i < 8; ++i) E(tm * 128 + ty * 8 + i, tn * 128 + tx * 4, (f32x4){acc[i][0], acc[i][1], acc[i][2], acc[i][3]});
    }
}

namespace pg8 {
#define PG8_LAS __attribute__((address_space(3)))
typedef unsigned short bf16_t;
typedef short bf16x8 __attribute__((ext_vector_type(8)));
typedef float f32x4 __attribute__((ext_vector_type(4)));
typedef unsigned u32x4 __attribute__((ext_vector_type(4)));
constexpr int BM = 256, BK = 64, HALF = 128, HTB = HALF * BK * 2  , STAGE_BYTES = 8 * HTB, NXCD = 8, WGM = 8;

__host__ __device__ __forceinline__ int lds_byte(int r, int c) { const int st = (r >> 4) * 2 + (c >> 5), rr = r & 15, cc = c & 31, ob = rr * 64 + cc * 2; return st * 1024 + (ob ^ (((ob >> 9) & 1) << 5)); }
__host__ __device__ __forceinline__ void stage_rc(int b, int& R, int& C) { const int st = b / 1024, sb = b % 1024, swz = sb ^ (((sb >> 9) & 1) << 5); R = (st >> 1) * 16 + swz / 64; C = (st & 1) * 32 + (swz % 64) / 2; }
__host__ __device__ __forceinline__ int perm32(int rho) { const int n = rho >> 4, i = rho & 15; return 8 * (i >> 2) + 4 * n + (i & 3); }

struct Unit { int pm, pn; };
struct Gemm { const bf16_t* A; const bf16_t* Bt; int M, N, K; };
struct StaticOrder {
    int nM, nN, nwg, G, c;
    __host__ __device__ void init(int M, int N, int G_, int c_) { nM = M / BM; nN = N / BM; nwg = nM * nN; G = G_; c = c_; }
    __host__ __device__ bool next(int i, Unit& u) const {
        const long L = (long)i * G + c; if (L >= nwg) return false;
        int wgid = (int)L; { const int q = nwg / NXCD, r = nwg % NXCD, xcd = wgid % NXCD, off = wgid / NXCD; wgid = (xcd < r ? xcd * (q + 1) : r * (q + 1) + (xcd - r) * q) + off; }
        const int nig = WGM * nN, gid = wgid / nig, fm = gid * WGM, gsz = (nM - fm) < WGM ? (nM - fm) : WGM;
        u.pm = fm + ((wgid % nig) % gsz); u.pn = (wgid % nig) / gsz; return true;
    }
    __device__ __forceinline__ void a_ready(const Unit&) const {}
    __device__ __forceinline__ void done(const Unit&) const {}
};
template <class Epi, class Sched, bool STAMP = false>
__device__ __forceinline__ void gemm_phase(PG8_LAS unsigned char* lds, const Gemm g, const Sched& S, const Epi& E, unsigned long long* stamps) {
    const int tid = threadIdx.x, wid = __builtin_amdgcn_readfirstlane(tid >> 6), lane = tid & 63, wr = wid >> 2, wc = wid & 3, fr = lane & 15, fq = lane >> 4;
    const int K = g.K, nt = K / BK;
    int ts_lo = 0, ts_hi = 0, nts = 0; const unsigned long long rt_entry = STAMP ? (unsigned long long)wall_clock64() : 0ull;
#define PG8_STAMP() do { if (STAMP && wid == 0 && nts < 64) { const unsigned long long _c = (unsigned long long)clock64(); \
        ts_lo = (lane == nts) ? (int)(unsigned)_c : ts_lo; ts_hi = (lane == nts) ? (int)(unsigned)(_c >> 32) : ts_hi; ++nts; } } while (0)
    PG8_STAMP();
    unsigned voffA[2], voffB[2];
#pragma unroll
    for (int i = 0; i < 2; ++i) { int R, C; stage_rc(tid * 16 + i * 8192, R, C); const int Rb = Epi::PERM ? ((R & ~31) + perm32(R & 31)) : R;
        voffA[i] = (unsigned)(R * K + C) * 2u; voffB[i] = (unsigned)(Rb * K + C) * 2u; }
    const size_t kstep = (size_t)(BK * 2);
    const size_t hstep = (size_t)HALF * K * 2;
    const size_t tstep = 2 * hstep;
    const unsigned ldsw = (unsigned)wid * 1024u;
    const int aoff = lds_byte(wr * 64 + fr, fq * 8), boff = lds_byte(wc * 32 + fr, fq * 8);
#define PG8_SA(b, h) (((b) * 2 + (h)) * HTB)
#define PG8_SB(b, h) ((4 + (b) * 2 + (h)) * HTB)
#define PG8_STAGE(bufoff, gbase, voff) do { _Pragma("unroll") for (int _i = 0; _i < 2; ++_i) \
        __builtin_amdgcn_global_load_lds((const unsigned*)((const char*)(gbase) + (voff)[_i]), (PG8_LAS unsigned*)(lds + (bufoff) + ldsw + _i * 8192), 16, 0, 0); } while (0)
#define PG8_LDA(dst, b, h) do { _Pragma("unroll") for (int m = 0; m < 4; ++m) _Pragma("unroll") for (int k = 0; k < 2; ++k) dst[m][k] = *(const PG8_LAS bf16x8*)(lds + PG8_SA(b, h) + aoff + m * 2048 + k * 1024); } while (0)
#define PG8_LDB(dst, b, h) do { _Pragma("unroll") for (int n = 0; n < 2; ++n) _Pragma("unroll") for (int k = 0; k < 2; ++k) dst[n][k] = *(const PG8_LAS bf16x8*)(lds + PG8_SB(b, h) + boff + n * 2048 + k * 1024); } while (0)
#define PG8_MMA(ai, bj, At, Bt) do { __builtin_amdgcn_s_setprio(1); _Pragma("unroll") for (int m = 0; m < 4; ++m) _Pragma("unroll") for (int n = 0; n < 2; ++n) _Pragma("unroll") for (int k = 0; k < 2; ++k) \
        acc[ai][bj][m][n] = __builtin_amdgcn_mfma_f32_16x16x32_bf16(Bt[n][k], At[m][k], acc[ai][bj][m][n], 0, 0, 0); __builtin_amdgcn_s_setprio(0); } while (0)
#define PG8_WAIT_V(n) asm volatile("s_waitcnt vmcnt(" #n ")" ::: "memory")
#define PG8_WAIT_L(n) asm volatile("s_waitcnt lgkmcnt(" #n ")" ::: "memory")
#define PG8_BAR __builtin_amdgcn_s_barrier()
#define PG8_SCHED __builtin_amdgcn_sched_barrier(0)
    Unit cur, nxt; int ui = 0;
    if (!S.next(0, cur)) return;
    f32x4 acc[2][2][4][2];
#pragma unroll
    for (int a = 0; a < 2; ++a)
#pragma unroll
        for (int b = 0; b < 2; ++b)
#pragma unroll
            for (int m = 0; m < 4; ++m)
#pragma unroll
                for (int n = 0; n < 2; ++n) acc[a][b][m][n] = (f32x4){0.f, 0.f, 0.f, 0.f};
    bf16x8 At[4][2], B0[2][2], B1[2][2];
    const char* cA = (const char*)g.A + (size_t)cur.pm * tstep; const char* cB = (const char*)g.Bt + (size_t)cur.pn * tstep;
    S.a_ready(cur);
    PG8_STAGE(PG8_SB(0, 0), cB, voffB); PG8_STAGE(PG8_SA(0, 0), cA, voffA); PG8_STAGE(PG8_SB(0, 1), cB + hstep, voffB); PG8_STAGE(PG8_SA(0, 1), cA + hstep, voffA);
    if (wr == 1) PG8_BAR;
    PG8_WAIT_V(4); PG8_BAR;
    PG8_STAGE(PG8_SB(1, 0), cB + kstep, voffB); PG8_STAGE(PG8_SA(1, 0), cA + kstep, voffA); PG8_STAGE(PG8_SB(1, 1), cB + hstep + kstep, voffB);
    PG8_WAIT_V(6); PG8_BAR;
    PG8_STAMP();
    for (;;) {
        const bool has_next = S.next(ui + 1, nxt);
        const char* nA = has_next ? (const char*)g.A + (size_t)nxt.pm * tstep : cA; const char* nB = has_next ? (const char*)g.Bt + (size_t)nxt.pn * tstep : cB;
        for (int t = 0; t < nt; t += 2) {
            const bool last = (t == nt - 2);
            const char* a1 = cA + (size_t)(t + 1) * kstep;
            const char* a2 = last ? nA : cA + (size_t)(t + 2) * kstep; const char* b2 = last ? nB : cB + (size_t)(t + 2) * kstep;
            const char* a3 = a2 + kstep; const char* b3 = b2 + kstep;
            if (last && has_next) S.a_ready(nxt);
            PG8_LDB(B0, 0, 0); PG8_SCHED; PG8_LDA(At, 0, 0); PG8_STAGE(PG8_SA(1, 1), a1 + hstep, voffA);
            PG8_WAIT_L(8); PG8_BAR; PG8_WAIT_L(0); PG8_MMA(0, 0, At, B0); PG8_BAR; PG8_SCHED;
            PG8_LDB(B1, 0, 1); PG8_STAGE(PG8_SB(0, 0), b2, voffB);
            PG8_BAR; PG8_WAIT_L(0); PG8_MMA(0, 1, At, B1); PG8_BAR;
            PG8_LDA(At, 0, 1); PG8_STAGE(PG8_SA(0, 0), a2, voffA);
            PG8_BAR; PG8_WAIT_L(0); PG8_MMA(1, 0, At, B0); PG8_BAR; PG8_SCHED;
            PG8_STAGE(PG8_SB(0, 1), b2 + hstep, voffB);
            PG8_WAIT_V(6); PG8_BAR; PG8_MMA(1, 1, At, B1); PG8_BAR;
            PG8_LDB(B0, 1, 0); PG8_SCHED; PG8_LDA(At, 1, 0); PG8_STAGE(PG8_SA(0, 1), a2 + hstep, voffA);
            PG8_WAIT_L(8); PG8_BAR; PG8_WAIT_L(0); PG8_MMA(0, 0, At, B0); PG8_BAR; PG8_SCHED;
            PG8_LDB(B1, 1, 1); PG8_STAGE(PG8_SB(1, 0), b3, voffB);
            PG8_BAR; PG8_WAIT_L(0); PG8_MMA(0, 1, At, B1); PG8_BAR;
            PG8_LDA(At, 1, 1); PG8_STAGE(PG8_SA(1, 0), a3, voffA);
            PG8_BAR; PG8_WAIT_L(0); PG8_MMA(1, 0, At, B0); PG8_BAR; PG8_SCHED;
            PG8_STAGE(PG8_SB(1, 1), b3 + hstep, voffB);
            PG8_WAIT_V(6); PG8_BAR; PG8_MMA(1, 1, At, B1); PG8_BAR;
        }
        PG8_STAMP();
        if constexpr (!Epi::AFTER_DRAIN) { E(acc, cur, wr, wc, fr, fq); S.done(cur); }
        PG8_STAMP();
        if (!has_next) break;
#pragma unroll
        for (int a = 0; a < 2; ++a)
#pragma unroll
            for (int b = 0; b < 2; ++b)
#pragma unroll
                for (int m = 0; m < 4; ++m)
#pragma unroll
                    for (int n = 0; n < 2; ++n) acc[a][b][m][n] = (f32x4){0.f, 0.f, 0.f, 0.f};
        cur = nxt; cA = nA; cB = nB; ++ui;
    }
    PG8_WAIT_V(0);
    if (wr == 0) PG8_BAR;
    PG8_BAR;
    if constexpr (Epi::AFTER_DRAIN) { E.fused(acc, cur, wr, wc, fr, fq, lds, wid, lane); S.done(cur); }
    PG8_STAMP();
    if (STAMP && wid == 0) { stamps[lane] = lane < nts ? (((unsigned long long)(unsigned)ts_hi << 32) | (unsigned)ts_lo) : 0ull;
        if (lane == 62) stamps[62] = rt_entry; if (lane == 63) stamps[63] = (unsigned long long)wall_clock64(); }
#undef PG8_STAMP
#undef PG8_SA
#undef PG8_SB
#undef PG8_STAGE
#undef PG8_LDA
#undef PG8_LDB
#undef PG8_MMA
#undef PG8_WAIT_V
#undef PG8_WAIT_L
#undef PG8_BAR
#undef PG8_SCHED
}
}

template <class E4> struct EpiAdapt {
    static constexpr bool PERM = false, AFTER_DRAIN = false;
    E4 e;
    __device__ __forceinline__ void operator()(const pg8::f32x4 (&acc)[2][2][4][2], const pg8::Unit& u, int wr, int wc, int fr, int fq) const {
#pragma unroll
        for (int ai = 0; ai < 2; ++ai)
#pragma unroll
            for (int m = 0; m < 4; ++m) {
                const int row = u.pm * 256 + ai * 128 + wr * 64 + m * 16 + fr;
#pragma unroll
                for (int bj = 0; bj < 2; ++bj)
#pragma unroll
                    for (int n = 0; n < 2; ++n) e(row, u.pn * 256 + bj * 128 + wc * 32 + n * 16 + fq * 4, acc[ai][bj][m][n]);
            }
    }
};
template <class E4>
DI void gemm_fast(const Ctx& c, const bf16_t* A, const bf16_t* Bt, int Mg, int Ng, int Kg, const E4& e4) {
    pg8::Gemm g{A, Bt, Mg, Ng, Kg}; pg8::StaticOrder S; S.init(Mg, Ng, (int)gridDim.x, (int)blockIdx.x);
    EpiAdapt<E4> E{e4};
    pg8::gemm_phase<EpiAdapt<E4>, pg8::StaticOrder, false>((PG8_LAS unsigned char*)c.lds, g, S, E, nullptr);
}
#ifndef FAST_GEMM
#define FAST_GEMM 1
#endif
#if FAST_GEMM
#define GEMM gemm_fast
#else
#define GEMM gemm_naive
#endif

DI void attn_mla_naive(const Params& p, const Ctx& c) {
    const bf16_t* Q = (const bf16_t*)(p.ws + OFF_Q); const bf16_t* KN = (const bf16_t*)(p.ws + OFF_KN); const bf16_t* KR = (const bf16_t*)(p.ws + OFF_KR);
    const bf16_t* VT = (const bf16_t*)(p.ws + OFF_VT); bf16_t* O = (bf16_t*)(p.ws + OFF_ATTA);
    for (int u = c.gw; u < M * 8; u += c.ngw) {
        const int m = u >> 3, hd = u & 7, b = m / SEQ, s = m % SEQ, base = b * SEQ, nkeys = ((s >> 6) + 1) << 6;
        const float q0 = bf2f(Q[(size_t)m * 1536 + hd * 192 + c.lane]), q1 = bf2f(Q[(size_t)m * 1536 + hd * 192 + 64 + c.lane]), q2 = bf2f(Q[(size_t)m * 1536 + hd * 192 + 128 + c.lane]);
        float mx = -1e30f, l = 0.f, o0 = 0.f, o1 = 0.f;
        const bf16_t* v0p = VT + (size_t)(hd * 128 + c.lane) * M + base; const bf16_t* v1p = v0p + (size_t)64 * M;
        for (int kk = 0; kk < nkeys; ++kk) {
            const size_t tk = base + kk;
            const float part = q0 * bf2f(KN[tk * 1024 + hd * 128 + c.lane]) + q1 * bf2f(KN[tk * 1024 + hd * 128 + 64 + c.lane]) + q2 * bf2f(KR[tk * 64 + c.lane]);
            const float sc = wave_sum(part);
            const float mn = fmaxf(mx, sc), al = exp2f(mx - mn), pp = exp2f(sc - mn);
            l = l * al + pp; o0 = o0 * al + pp * bf2f(v0p[kk]); o1 = o1 * al + pp * bf2f(v1p[kk]); mx = mn;
        }
        const float inv = 1.f / l;
        O[(size_t)m * 1024 + hd * 128 + c.lane] = (bf16_t)(pk2(o0 * inv, 0.f) & 0xffff);
        O[(size_t)m * 1024 + hd * 128 + 64 + c.lane] = (bf16_t)(pk2(o1 * inv, 0.f) & 0xffff);
    }
}
DI void attn_sb_naive(const Params& p, const Ctx& c) {
    const bf16_t* Q = (const bf16_t*)(p.ws + OFF_SBQ); const bf16_t* K = (const bf16_t*)(p.ws + OFF_SBK);
    const bf16_t* VT = (const bf16_t*)(p.ws + OFF_SBVT); bf16_t* O = (bf16_t*)(p.ws + OFF_ATTB);
    for (int u = c.gw; u < M * 8; u += c.ngw) {
        const int m = u >> 3, hd = u & 7, b = m / SEQ, s = m % SEQ, base = b * SEQ;
        const float q0 = bf2f(Q[(size_t)m * 1024 + hd * 128 + c.lane]), q1 = bf2f(Q[(size_t)m * 1024 + hd * 128 + 64 + c.lane]);
        float later = 0.f, o0 = 0.f, o1 = 0.f;
        const bf16_t* v0p = VT + (size_t)(hd * 128 + c.lane) * M + base; const bf16_t* v1p = v0p + (size_t)64 * M;
        for (int kk = s - 1; kk >= 0; --kk) {
            const size_t tk = base + kk;
            const float z2 = wave_sum(q0 * bf2f(K[tk * 1024 + hd * 128 + c.lane]) + q1 * bf2f(K[tk * 1024 + hd * 128 + 64 + c.lane]));
            const float ln2 = -(fmaxf(z2, 0.f) + __log2f(1.f + exp2f(-fabsf(z2))));
            const float w = exp2f(z2 + ln2 + later);
            later += ln2; o0 += w * bf2f(v0p[kk]); o1 += w * bf2f(v1p[kk]);
        }
        O[(size_t)m * 1024 + hd * 128 + c.lane] = (bf16_t)(pk2(o0, 0.f) & 0xffff);
        O[(size_t)m * 1024 + hd * 128 + 64 + c.lane] = (bf16_t)(pk2(o1, 0.f) & 0xffff);
    }
}


typedef float f32x16 __attribute__((ext_vector_type(16)));
#define MFMA32(a, b, c) __builtin_amdgcn_mfma_f32_32x32x16_bf16((a), (b), (c), 0, 0, 0)
constexpr int ST_KR = 16384, ST_VT = 24576, ST_BYTES = 40960;
constexpr int ATT_FLAGS = 2 * ST_BYTES;
DI float ex2(float x) { return __builtin_amdgcn_exp2f(x); }
DI float lg2(float x) { return __builtin_amdgcn_logf(x); }
DI bf16x8 pack8(float a0, float a1, float a2, float a3, float a4, float a5, float a6, float a7) {
    u32x4 t; t.x = pk2(a0, a1); t.y = pk2(a2, a3); t.z = pk2(a4, a5); t.w = pk2(a6, a7); return __builtin_bit_cast(bf16x8, t); }
#define GLDS16(gp, lp) __builtin_amdgcn_global_load_lds((const unsigned*)(gp), (LAS unsigned*)(lp), 16, 0, 0)

template <bool ROPE>
DI void att_dma(LAS unsigned char* buf, const bf16_t* Kp, const bf16_t* KRp, const bf16_t* VTp, size_t tok0, int hd, int w, int lane) {
    const char* kb = (const char*)(Kp + tok0 * 1024 + hd * 128); const char* vb = (const char*)(VTp + (size_t)(hd * 128) * M + tok0);
    const unsigned lr = lane >> 4, pp = lane & 15;
#pragma unroll
    for (int i = 0; i < 2; ++i) { const unsigned q = w * 2 + i, R = 4 * q + lr, cc = pp ^ (R & 15);
        GLDS16(kb + (R * 2048u + cc * 16u), buf + q * 1024); }
    if (ROPE) { const char* rb = (const char*)(KRp + tok0 * 64); const unsigned q = w, R2 = 4 * q + lr, cc = pp ^ (R2 & 15);
        GLDS16(rb + ((2 * R2 + (cc >> 3)) * 128u + (cc & 7) * 16u), buf + ST_KR + q * 1024); }
#pragma unroll
    for (int i = 0; i < 2; ++i) { const unsigned q = w * 2 + i, R2 = 4 * q + lr, cc = pp ^ (R2 & 15);
        GLDS16(vb + ((2 * R2 + (cc >> 3)) * (unsigned)(M * 2) + (cc & 7) * 16u), buf + ST_VT + q * 1024); }
}
DI void att_store(const f32x16 (&o)[4], float scale, bf16_t* O, size_t row, int hd, int h) {
#pragma unroll
    for (int db = 0; db < 4; ++db)
#pragma unroll
        for (int g = 0; g < 4; ++g)
            store_bf16x4(O + row * 1024 + hd * 128 + db * 32 + g * 8 + h * 4, (f32x4){o[db][4 * g] * scale, o[db][4 * g + 1] * scale, o[db][4 * g + 2] * scale, o[db][4 * g + 3] * scale});
}
DI void att_pv(f32x16 (&o)[4], const bf16x8 (&pf)[2][2], const LAS unsigned char* buf, unsigned va) {
#pragma unroll
    for (int db = 0; db < 4; ++db) {
#pragma unroll
        for (int blk = 0; blk < 2; ++blk)
#pragma unroll
            for (int ks = 0; ks < 2; ++ks) o[db] = MFMA32(*(const LAS bf16x8*)(buf + ((va ^ ((blk * 2 + ks) << 5)) + db * 4096)), pf[blk][ks], o[db]);
        asm volatile("" ::: "memory");
    }
}

DI void attn_mla_fast(const Params& p, const Ctx& c) {
    const bf16_t* Q = (const bf16_t*)(p.ws + OFF_Q); const bf16_t* KN = (const bf16_t*)(p.ws + OFF_KN); const bf16_t* KR = (const bf16_t*)(p.ws + OFF_KR);
    const bf16_t* VT = (const bf16_t*)(p.ws + OFF_VT); bf16_t* O = (bf16_t*)(p.ws + OFF_ATTA);
    const int lane = c.lane, r = lane & 31, h = lane >> 5, w = c.wave;
    const int pr = (r & 0x13) | ((r & 4) << 1) | ((r & 8) >> 1);
    const unsigned ka = (pr << 8) | ((((pr & 15) ^ h) & 15) << 4);
    const unsigned ra = ST_KR + (((pr >> 1) << 8) | (((((pr & 1) << 3) | h) ^ ((pr >> 1) & 15)) << 4));
    const unsigned va = ST_VT + (((r >> 1) << 8) | (((((r & 1) << 3) | h) ^ ((r >> 1) & 15)) << 4));
    for (int it = blockIdx.x; it < 256; it += gridDim.x) {
        const int bh = it & 31, b = bh >> 3, hd = bh & 7, pairi = it >> 5;
#pragma unroll 1
        for (int half = 0; half < 2; ++half) {
            const int qb = half ? 15 - pairi : pairi, q0 = qb * 256;
            const size_t base = (size_t)b * SEQ, qrow = base + q0 + w * 32 + r;
            bf16x8 qf[12];
#pragma unroll
            for (int st = 0; st < 12; ++st) qf[st] = *(const bf16x8*)(Q + qrow * 1536 + hd * 192 + st * 16 + h * 8);
            const int ntile = q0 / 64 + 4, myn = (q0 + w * 32) / 64 + 1;
            f32x16 o[4];
#pragma unroll
            for (int db = 0; db < 4; ++db)
#pragma unroll
                for (int i = 0; i < 16; ++i) o[db][i] = 0.f;
            float mrun = -1e30f, lrun = 0.f;
            __syncthreads();
            att_dma<true>(c.lds, KN, KR, VT, base, hd, w, lane);
            asm volatile("s_waitcnt vmcnt(0)" ::: "memory");
            __syncthreads();
            for (int j = 0; j < ntile; ++j) {
                LAS unsigned char* buf = c.lds + (j & 1) * ST_BYTES;
                if (j + 1 < ntile) att_dma<true>(c.lds + ((j + 1) & 1) * ST_BYTES, KN, KR, VT, base + (size_t)(j + 1) * 64, hd, w, lane);
                if (j < myn) {
                    f32x16 s0, s1;
#pragma unroll
                    for (int i = 0; i < 16; ++i) { s0[i] = 0.f; s1[i] = 0.f; }
#pragma unroll
                    for (int st = 0; st < 8; ++st) {
                        s0 = MFMA32(*(const LAS bf16x8*)(buf + (ka ^ (st << 5))), qf[st], s0);
                        s1 = MFMA32(*(const LAS bf16x8*)(buf + ((ka ^ (st << 5)) + 8192)), qf[st], s1);
                        if (st & 1) asm volatile("" ::: "memory");
                    }
#pragma unroll
                    for (int st = 0; st < 4; ++st) {
                        s0 = MFMA32(*(const LAS bf16x8*)(buf + (ra ^ (st << 5))), qf[8 + st], s0);
                        s1 = MFMA32(*(const LAS bf16x8*)(buf + ((ra ^ (st << 5)) + 4096)), qf[8 + st], s1);
                        if (st & 1) asm volatile("" ::: "memory");
                    }
                    float mx = fmaxf(s0[0], s1[0]);
#pragma unroll
                    for (int i = 1; i < 16; ++i) mx = fmaxf(mx, fmaxf(s0[i], s1[i]));
                    mx = fmaxf(mx, __shfl_xor(mx, 32));
                    const float mnew = fmaxf(mrun, mx), alpha = ex2(mrun - mnew);
                    mrun = mnew;
                    float ps = 0.f;
#pragma unroll
                    for (int i = 0; i < 16; ++i) { s0[i] = ex2(s0[i] - mnew); s1[i] = ex2(s1[i] - mnew); ps += s0[i] + s1[i]; }
                    lrun = lrun * alpha + ps;
#pragma unroll
                    for (int db = 0; db < 4; ++db)
#pragma unroll
                        for (int i = 0; i < 16; ++i) o[db][i] *= alpha;
                    bf16x8 pf[2][2];
                    pf[0][0] = pack8(s0[0], s0[1], s0[2], s0[3], s0[4], s0[5], s0[6], s0[7]); pf[0][1] = pack8(s0[8], s0[9], s0[10], s0[11], s0[12], s0[13], s0[14], s0[15]);
                    pf[1][0] = pack8(s1[0], s1[1], s1[2], s1[3], s1[4], s1[5], s1[6], s1[7]); pf[1][1] = pack8(s1[8], s1[9], s1[10], s1[11], s1[12], s1[13], s1[14], s1[15]);
                    att_pv(o, pf, buf, va);
                }
                asm volatile("s_waitcnt vmcnt(0)" ::: "memory");
                __syncthreads();
            }
            const float ltot = lrun + __shfl_xor(lrun, 32);
            att_store(o, 1.f / ltot, O, qrow, hd, h);
        }
    }
}

DI void attn_sb_fast(const Params& p, const Ctx& c) {
    const bf16_t* Q = (const bf16_t*)(p.ws + OFF_SBQ); const bf16_t* K = (const bf16_t*)(p.ws + OFF_SBK);
    const bf16_t* VT = (const bf16_t*)(p.ws + OFF_SBVT); bf16_t* O = (bf16_t*)(p.ws + OFF_ATTB);
    const int lane = c.lane, r = lane & 31, h = lane >> 5, w = c.wave, tid = c.tid;
    const int pr = (r & 0x13) | ((r & 4) << 1) | ((r & 8) >> 1);
    const unsigned ka = (pr << 8) | ((((pr & 15) ^ h) & 15) << 4);
    const unsigned va = ST_VT + (((r >> 1) << 8) | (((((r & 1) << 3) | h) ^ ((r >> 1) & 15)) << 4));
    LAS int* flags = (LAS int*)(c.lds + ATT_FLAGS);
    for (int it = blockIdx.x; it < 256; it += gridDim.x) {
        const int bh = it & 31, b = bh >> 3, hd = bh & 7, pairi = it >> 5;
#pragma unroll 1
        for (int half = 0; half < 2; ++half) {
            const int qb = half ? 15 - pairi : pairi, q0 = qb * 256;
            const size_t base = (size_t)b * SEQ, qrow = base + q0 + w * 32 + r;
            const int tq = q0 + w * 32 + r;
            bf16x8 qf[8];
#pragma unroll
            for (int st = 0; st < 8; ++st) qf[st] = *(const bf16x8*)(Q + qrow * 1024 + hd * 128 + st * 16 + h * 8);
            const int jmax = q0 / 64 + 3, jd = (q0 + w * 32) / 64;
            f32x16 o[4];
#pragma unroll
            for (int db = 0; db < 4; ++db)
#pragma unroll
                for (int i = 0; i < 16; ++i) o[db][i] = 0.f;
            float carry = 0.f; bool wdone = false;
            __syncthreads();
            att_dma<false>(c.lds, K, nullptr, VT, base + (size_t)jmax * 64, hd, w, lane);
            if (tid < 16) flags[tid] = 0;
            asm volatile("s_waitcnt vmcnt(0)" ::: "memory");
            __syncthreads();
            int itn = 0;
            for (int j = jmax; j >= 0; --j, ++itn) {
                LAS unsigned char* buf = c.lds + (itn & 1) * ST_BYTES;
                if (j > 0) att_dma<false>(c.lds + ((itn + 1) & 1) * ST_BYTES, K, nullptr, VT, base + (size_t)(j - 1) * 64, hd, w, lane);
                if (j <= jd && !wdone) {
                    f32x16 s0, s1;
#pragma unroll
                    for (int i = 0; i < 16; ++i) { s0[i] = 0.f; s1[i] = 0.f; }
#pragma unroll
                    for (int st = 0; st < 8; ++st) {
                        s0 = MFMA32(*(const LAS bf16x8*)(buf + (ka ^ (st << 5))), qf[st], s0);
                        s1 = MFMA32(*(const LAS bf16x8*)(buf + ((ka ^ (st << 5)) + 8192)), qf[st], s1);
                        if (st & 1) asm volatile("" ::: "memory");
                    }
                    const int kb0 = 64 * j + 8 * h - tq;
                    bf16x8 pf[2][2];
                    {
                        f32x16 l1;
#pragma unroll
                        for (int i = 0; i < 16; ++i) { const float z = s1[i]; const float a = -(fmaxf(z, 0.f) + lg2(1.f + ex2(-fabsf(z)))); l1[i] = (kb0 + 32 + 16 * (i >> 3) + (i & 7) < 0) ? a : 0.f; }
                        float g0 = 0.f, g1 = 0.f;
#pragma unroll
                        for (int e = 0; e < 8; ++e) { g0 += l1[e]; g1 += l1[8 + e]; }
                        const float p0 = __shfl_xor(g0, 32), p1 = __shfl_xor(g1, 32);
                        float run = carry + (h == 0 ? p1 : 0.f);
#pragma unroll
                        for (int e = 7; e >= 0; --e) { run += l1[8 + e]; l1[8 + e] = run; }
                        run = carry + (g1 + p1) + (h == 0 ? p0 : 0.f);
#pragma unroll
                        for (int e = 7; e >= 0; --e) { run += l1[e]; l1[e] = run; }
                        carry += (g1 + p1) + (g0 + p0);
#pragma unroll
                        for (int i = 0; i < 16; ++i) { const float wv = ex2(s1[i] + l1[i]); s1[i] = (kb0 + 32 + 16 * (i >> 3) + (i & 7) < 0) ? wv : 0.f; }
                        pf[1][0] = pack8(s1[0], s1[1], s1[2], s1[3], s1[4], s1[5], s1[6], s1[7]); pf[1][1] = pack8(s1[8], s1[9], s1[10], s1[11], s1[12], s1[13], s1[14], s1[15]);
                    }
                    {
                        f32x16 l0;
#pragma unroll
                        for (int i = 0; i < 16; ++i) { const float z = s0[i]; const float a = -(fmaxf(z, 0.f) + lg2(1.f + ex2(-fabsf(z)))); l0[i] = (kb0 + 16 * (i >> 3) + (i & 7) < 0) ? a : 0.f; }
                        float g0 = 0.f, g1 = 0.f;
#pragma unroll
                        for (int e = 0; e < 8; ++e) { g0 += l0[e]; g1 += l0[8 + e]; }
                        const float p0 = __shfl_xor(g0, 32), p1 = __shfl_xor(g1, 32);
                        float run = carry + (h == 0 ? p1 : 0.f);
#pragma unroll
                        for (int e = 7; e >= 0; --e) { run += l0[8 + e]; l0[8 + e] = run; }
                        run = carry + (g1 + p1) + (h == 0 ? p0 : 0.f);
#pragma unroll
                        for (int e = 7; e >= 0; --e) { run += l0[e]; l0[e] = run; }
                        carry += (g1 + p1) + (g0 + p0);
#pragma unroll
                        for (int i = 0; i < 16; ++i) { const float wv = ex2(s0[i] + l0[i]); s0[i] = (kb0 + 16 * (i >> 3) + (i & 7) < 0) ? wv : 0.f; }
                        pf[0][0] = pack8(s0[0], s0[1], s0[2], s0[3], s0[4], s0[5], s0[6], s0[7]); pf[0][1] = pack8(s0[8], s0[9], s0[10], s0[11], s0[12], s0[13], s0[14], s0[15]);
                    }
                    att_pv(o, pf, buf, va);
                    wdone = __all(carry < -150.f);
                }
                if (lane == 0) flags[(itn & 1) * 8 + w] = wdone ? 1 : 0;
                asm volatile("s_waitcnt vmcnt(0)" ::: "memory");
                __syncthreads();
                int alld = 1;
#pragma unroll
                for (int q = 0; q < 8; ++q) alld &= flags[(itn & 1) * 8 + q];
                if (alld) break;
            }
            att_store(o, 1.f, O, qrow, hd, h);
        }
    }
}
#ifndef FAST_ATTN
#define FAST_ATTN 1
#endif

constexpr int SEL_LD = 260;
DI void topk_insert(float (&a)[16], float x) {
#pragma unroll
    for (int i = 0; i < 16; ++i) { const float hi = fmaxf(a[i], x); x = fminf(a[i], x); a[i] = hi; }
}
DI void select_tail(const Params& p, const Ctx& c, int t0, int hd) {
    LAS float* sc = (LAS float*)c.lds; LAS float* lst = sc + 128 * SEL_LD;
    if (c.tid < 256) {
        const int tok = c.tid >> 1, hf = c.tid & 1;
        float a[16];
#pragma unroll
        for (int i = 0; i < 16; ++i) a[i] = -__builtin_inff();
        const LAS float* row = sc + tok * SEL_LD + hf * 128;
#pragma unroll 4
        for (int n4 = 0; n4 < 32; ++n4) {
            const f32x4 v = *(const LAS f32x4*)(row + n4 * 4);
#pragma unroll
            for (int e = 0; e < 4; ++e) topk_insert(a, __uint_as_float((__float_as_uint(v[e]) & ~127u) | (unsigned)(n4 * 4 + e)));
        }
#pragma unroll
        for (int i = 0; i < 16; ++i) lst[(tok * 2 + hf) * 16 + i] = a[i];
    }
    __syncthreads();
    if (c.tid < 128) {
        const int tok = c.tid;
        float v1[16], v2[16];
#pragma unroll
        for (int i = 0; i < 16; ++i) { v1[i] = __uint_as_float(__float_as_uint(lst[(tok * 2) * 16 + i]) & ~127u); v2[i] = __uint_as_float(__float_as_uint(lst[(tok * 2 + 1) * 16 + i]) & ~127u); }
        float bb[16];
#pragma unroll
        for (int i = 0; i < 16; ++i) bb[i] = -__builtin_inff();
#pragma unroll
        for (int i = 0; i < 16; ++i)
#pragma unroll
            for (int j = 0; j < 16; ++j)
                if ((i + 1) * (j + 1) <= 16) topk_insert(bb, __uint_as_float((__float_as_uint(v1[i] + v2[j]) & ~255u) | (unsigned)(i * 16 + j)));
        float sv[16], mxv = -__builtin_inff(), sum = 0.f;
#pragma unroll
        for (int i = 0; i < 16; ++i) { sv[i] = __uint_as_float(__float_as_uint(bb[i]) & ~255u); mxv = fmaxf(mxv, sv[i]); }
#pragma unroll
        for (int i = 0; i < 16; ++i) { sv[i] = __expf(sv[i] - mxv); sum += sv[i]; }
        const float inv = 1.f / sum;
        int* idx = (int*)(p.ws + OFF_IDX) + (size_t)(t0 + tok) * 128 + hd * 16; float* gw = (float*)(p.ws + OFF_GW) + (size_t)(t0 + tok) * 128 + hd * 16;
#pragma unroll
        for (int i = 0; i < 16; ++i) {
            const unsigned code = __float_as_uint(bb[i]) & 255u;
            const unsigned e1 = __float_as_uint(lst[(tok * 2) * 16 + (code >> 4)]) & 127u, e2 = __float_as_uint(lst[(tok * 2 + 1) * 16 + (code & 15u)]) & 127u;
            idx[i] = (int)(e1 * 128u + e2); gw[i] = sv[i] * inv;
        }
    }
    __syncthreads();
}
DI void select_naive(const Params& p, const Ctx& c) {
    const bf16_t* PQ = (const bf16_t*)(p.ws + OFF_PQ); const bf16_t* KEYS = (const bf16_t*)(p.ws + OFF_KEYS);
    LAS float* sc = (LAS float*)c.lds;
    for (int u = blockIdx.x; u < 128 * 8; u += gridDim.x) {
        const int hd = u & 7, t0 = (u >> 3) * 128;
        const int tok = c.tid >> 2, part = c.tid & 3, hf = part >> 1, n0 = (part & 1) * 64;
        const bf16_t* qrow = PQ + (size_t)hd * M * 256 + (size_t)(t0 + tok) * 256 + hf * 128;
        const bf16_t* kb = KEYS + (size_t)((hd * 2 + hf) * 128 + n0) * 128;
        for (int n = 0; n < 64; ++n) {
            float acc = 0.f;
#pragma unroll
            for (int d8 = 0; d8 < 16; ++d8) {
                const u32x4 a = *(const u32x4*)(qrow + d8 * 8), b = *(const u32x4*)(kb + (size_t)n * 128 + d8 * 8);
#pragma unroll
                for (int e = 0; e < 4; ++e) acc += bflo(a[e]) * bflo(b[e]) + bfhi(a[e]) * bfhi(b[e]);
            }
            sc[tok * SEL_LD + hf * 128 + n0 + n] = acc;
        }
        __syncthreads();
        select_tail(p, c, t0, hd);
    }
}

DI void phase_gather(const Params& p, const Ctx& c) {
    const bf16_t* H2 = (const bf16_t*)(p.ws + OFF_H); const bf16_t* U = (const bf16_t*)(p.ws + OFF_U16); const bf16_t* V = (const bf16_t*)(p.ws + OFF_V16);
    const int* IDX = (const int*)(p.ws + OFF_IDX); const float* GW = (const float*)(p.ws + OFF_GW); const float* mod = (const float*)(p.ws + OFF_MOD);
    for (int m = c.gw; m < M; m += c.ngw) {
        const int b = m / SEQ;
        u32x4 hq[4];
#pragma unroll
        for (int j = 0; j < 4; ++j) hq[j] = *(const u32x4*)(H2 + (size_t)m * D + j * 512 + c.lane * 8);
        const int ia = IDX[(size_t)m * 128 + c.lane], ib = IDX[(size_t)m * 128 + 64 + c.lane];
        const float ga = GW[(size_t)m * 128 + c.lane], gb = GW[(size_t)m * 128 + 64 + c.lane];
        float wa = 0.f, wb = 0.f;
        for (int k = 0; k < 128; ++k) {
            const int e = __shfl(k < 64 ? ia : ib, k & 63);
            const bf16_t* ur = U + (size_t)e * D + c.lane * 8;
            float d0 = 0.f, d1 = 0.f, d2 = 0.f, d3 = 0.f;
#pragma unroll
            for (int j = 0; j < 4; ++j) { const u32x4 uu = *(const u32x4*)(ur + j * 512);
                d0 = dot2bf(hq[j].x, uu.x, d0); d1 = dot2bf(hq[j].y, uu.y, d1); d2 = dot2bf(hq[j].z, uu.z, d2); d3 = dot2bf(hq[j].w, uu.w, d3); }
            const float d = wave_sum((d0 + d1) + (d2 + d3));
            const float a = gelu_tanh(d);
            if (k < 64) { if (c.lane == k) wa = a * ga; } else { if (c.lane == k - 64) wb = a * gb; }
        }
        float acc[4][8];
#pragma unroll
        for (int j = 0; j < 4; ++j)
#pragma unroll
            for (int q = 0; q < 8; ++q) acc[j][q] = 0.f;
        for (int k = 0; k < 128; ++k) {
            const int e = __shfl(k < 64 ? ia : ib, k & 63);
            const float w = __shfl(k < 64 ? wa : wb, k & 63);
            const bf16_t* vr = V + (size_t)e * D + c.lane * 8;
#pragma unroll
            for (int j = 0; j < 4; ++j) { const u32x4 vv = *(const u32x4*)(vr + j * 512);
#pragma unroll
                for (int q = 0; q < 4; ++q) { acc[j][2 * q] += w * bflo(vv[q]); acc[j][2 * q + 1] += w * bfhi(vv[q]); } }
        }
        float* orow = p.out + (size_t)m * D; const float* gt2 = mod + b * 6 * D + 5 * D;
        float ss = 0.f;
#pragma unroll
        for (int j = 0; j < 4; ++j) {
            const int col = j * 512 + c.lane * 8;
            const f32x4 xa = *(const f32x4*)(orow + col), xb = *(const f32x4*)(orow + col + 4), ta = *(const f32x4*)(gt2 + col), tb = *(const f32x4*)(gt2 + col + 4);
#pragma unroll
            for (int q = 0; q < 4; ++q) { acc[j][q] = xa[q] + DBG_BETA * ta[q] * acc[j][q]; acc[j][4 + q] = xb[q] + DBG_BETA * tb[q] * acc[j][4 + q]; ss += acc[j][q] * acc[j][q] + acc[j][4 + q] * acc[j][4 + q]; }
        }
        const float rstd = rsqrtf(wave_sum(ss) * (1.f / D) + EPS);
#pragma unroll
        for (int j = 0; j < 4; ++j) {
            const int col = j * 512 + c.lane * 8;
            const f32x4 fa = *(const f32x4*)(p.fng + col), fb = *(const f32x4*)(p.fng + col + 4);
            *(f32x4*)(orow + col) = (f32x4){acc[j][0], acc[j][1], acc[j][2], acc[j][3]} * rstd * fa;
            *(f32x4*)(orow + col + 4) = (f32x4){acc[j][4], acc[j][5], acc[j][6], acc[j][7]} * rstd * fb;
        }
    }
}


DI void phase_gather_v2(const Params& p, const Ctx& c) {
    const bf16_t* H2 = (const bf16_t*)(p.ws + OFF_H);
    const int* IDX = (const int*)(p.ws + OFF_IDX); const float* GW = (const float*)(p.ws + OFF_GW); const float* mod = (const float*)(p.ws + OFF_MOD);
    LAS float* hs = (LAS float*)c.lds; LAS float* wk = hs + 2048; LAS int* ek = (LAS int*)(wk + 128); LAS float* red = (LAS float*)(ek + 128);
    for (int m = blockIdx.x; m < M; m += gridDim.x) {
        const int b = m / SEQ;
        __syncthreads();
        for (int i = c.tid; i < 2048; i += NTHREADS) hs[i] = bf2f(H2[(size_t)m * D + i]);
        if (c.tid < 128) ek[c.tid] = IDX[(size_t)m * 128 + c.tid];
        __syncthreads();
        for (int k = c.wave; k < 128; k += NWAVES) {
            const float* ur = p.pu + (size_t)ek[k] * D;
            float d = 0.f;
            for (int i = 0; i < 8; ++i) { const int col = i * 256 + c.lane * 4; const f32x4 u = *(const f32x4*)(ur + col);
                d += u[0] * hs[col] + u[1] * hs[col + 1] + u[2] * hs[col + 2] + u[3] * hs[col + 3]; }
            d = wave_sum(d);
            if (c.lane == 0) wk[k] = gelu_tanh(d) * GW[(size_t)m * 128 + k];
        }
        __syncthreads();
        const int col = c.tid * 4;
        f32x4 acc = {0.f, 0.f, 0.f, 0.f};
        for (int k = 0; k < 128; ++k) { const f32x4 v = *(const f32x4*)(p.pv + (size_t)ek[k] * D + col); acc += v * wk[k]; }
        float* orow = p.out + (size_t)m * D;
        const f32x4 x2 = *(const f32x4*)(orow + col) + DBG_BETA * *(const f32x4*)(mod + b * 6 * D + 5 * D + col) * acc;
        float ss = wave_sum(x2[0] * x2[0] + x2[1] * x2[1] + x2[2] * x2[2] + x2[3] * x2[3]);
        if (c.lane == 0) red[c.wave] = ss;
        __syncthreads();
        float tot = 0.f;
        for (int w = 0; w < NWAVES; ++w) tot += red[w];
        const float rstd = rsqrtf(tot * (1.f / D) + EPS);
        *(f32x4*)(orow + col) = x2 * rstd * *(const f32x4*)(p.fng + col);
    }
}


DI void grid_barrier(unsigned* ctr, unsigned target, int wave_s) {
    asm volatile("s_waitcnt vmcnt(0)" ::: "memory");
    __syncthreads();
    if (wave_s == 0) {
        const int l = __builtin_amdgcn_mbcnt_hi(~0u, __builtin_amdgcn_mbcnt_lo(~0u, 0u));
        if (l == 0) {
            __builtin_amdgcn_fence(__ATOMIC_RELEASE, "agent");
            asm volatile("s_waitcnt vmcnt(0)" ::: "memory");
            __hip_atomic_fetch_add(ctr, 1u, __ATOMIC_RELAXED, __HIP_MEMORY_SCOPE_AGENT);
            unsigned spins = 0;
            while (__hip_atomic_load(ctr, __ATOMIC_RELAXED, __HIP_MEMORY_SCOPE_AGENT) < target) { __builtin_amdgcn_s_sleep(2); if (++spins > (1u << 23)) break; }
            __builtin_amdgcn_fence(__ATOMIC_ACQUIRE, "agent");
            asm volatile("s_waitcnt vmcnt(0)" ::: "memory");
        }
    }
    __syncthreads();
}

__global__ void __launch_bounds__(NTHREADS, 2) mega(Params p) {
    extern __shared__ __attribute__((aligned(16))) unsigned char lds_raw[];
    const int wave_s = __builtin_amdgcn_readfirstlane(threadIdx.x >> 6);
#define MKCTX() Ctx c; { int l_; asm volatile("v_mbcnt_lo_u32_b32 %0, -1, 0\n\tv_mbcnt_hi_u32_b32 %0, -1, %0" : "=v"(l_)); c.lds = (LAS unsigned char*)lds_raw; c.lane = l_; c.wave = wave_s; c.tid = wave_s * 64 + l_; \
    c.gw = blockIdx.x * NWAVES + wave_s; c.ngw = gridDim.x * NWAVES; }
    unsigned char* ws = p.ws;
    const float* mod = (const float*)(ws + OFF_MOD);
    const int lo = p.ph_lo, hi = p.ph_hi;
#define IN(k) (lo <= (k) && (k) < hi)
#define SEAM(k) do { if (IN(k) && IN((k) + 1)) grid_barrier((unsigned*)(ws + OFF_CTL), (unsigned)((k) + 1) * gridDim.x, wave_s); } while (0)

    if (IN(0)) { MKCTX(); phase_prologue(p, c); }
    SEAM(0);
    if (IN(1)) { MKCTX();
        const long long* modi = (const long long*)(ws + OFF_MODI); float* modw = (float*)(ws + OFF_MOD);
        for (int i = blockIdx.x * NTHREADS + c.tid; i < NB * 6 * D; i += gridDim.x * NTHREADS) modw[i] = (float)((double)modi[i] * (1.0 / 4294967296.0));
        modulate_rows(p.x, p.n1g, modi + 1 * D, modi + 0 * D, (bf16_t*)(ws + OFF_H), c);
    }
    SEAM(1);
    if (IN(2)) { MKCTX();
        EpiProj e1{(bf16_t*)(ws + OFF_CQ), (bf16_t*)(ws + OFF_CKV), (bf16_t*)(ws + OFF_KR), (bf16_t*)(ws + OFF_SBQ), (bf16_t*)(ws + OFF_SBK), (bf16_t*)(ws + OFF_GA), (bf16_t*)(ws + OFF_GB), (const f32x2*)(ws + OFF_CS)};
        GEMM(c, (const bf16_t*)(ws + OFF_H), (const bf16_t*)(ws + OFF_WIN), M, 7168, 2048, e1);
        EpiT e2{(bf16_t*)(ws + OFF_SBVT), nullptr};
        GEMM(c, (const bf16_t*)(ws + OFF_WSBV), (const bf16_t*)(ws + OFF_H), 1024, M, 2048, e2);
    }
    SEAM(2);
    if (IN(3)) { MKCTX(); phase_rowstats(p, c); }
    SEAM(3);
    if (IN(4)) { MKCTX();
        EpiUq e1{(bf16_t*)(ws + OFF_Q), (const float*)(ws + OFF_RSTQ), (const f32x2*)(ws + OFF_CS)};
        GEMM(c, (const bf16_t*)(ws + OFF_CQ), (const bf16_t*)(ws + OFF_WUQ), M, 1536, 512, e1);
        EpiRowScale e2{(bf16_t*)(ws + OFF_KN), 1024, (const float*)(ws + OFF_RSTKV)};
        GEMM(c, (const bf16_t*)(ws + OFF_CKV), (const bf16_t*)(ws + OFF_WUK), M, 1024, 256, e2);
        EpiT e3{(bf16_t*)(ws + OFF_VT), (const float*)(ws + OFF_RSTKV)};
        GEMM(c, (const bf16_t*)(ws + OFF_WUV), (const bf16_t*)(ws + OFF_CKV), 1024, M, 256, e3);
    }
    SEAM(4);
    if (IN(5)) {
#if FAST_ATTN
        { MKCTX(); attn_mla_fast(p, c); }
        { MKCTX(); attn_sb_fast(p, c); }
#else
        MKCTX();
        attn_mla_naive(p, c); attn_sb_naive(p, c);
#endif
    }
    SEAM(5);
    if (IN(6)) { MKCTX();
        EpiGate1 e1{(bf16_t*)(ws + OFF_MERGED), (const bf16_t*)(ws + OFF_GA)};
        GEMM(c, (const bf16_t*)(ws + OFF_ATTA), (const bf16_t*)(ws + OFF_WA), M, 2048, 1024, e1);
        EpiGate2 e2{(bf16_t*)(ws + OFF_MERGED), (const bf16_t*)(ws + OFF_GB)};
        GEMM(c, (const bf16_t*)(ws + OFF_ATTB), (const bf16_t*)(ws + OFF_WB), M, 2048, 1024, e2);
    }
    SEAM(6);
    if (IN(7)) { MKCTX();
        EpiRes e{p.x, mod + 2 * D, p.out};
        GEMM(c, (const bf16_t*)(ws + OFF_MERGED), (const bf16_t*)(ws + OFF_WOUT), M, 2048, 2048, e);
    }
    SEAM(7);
    if (IN(8)) { MKCTX();
        modulate_rows(p.out, p.n2g, mod + 4 * D, mod + 3 * D, (bf16_t*)(ws + OFF_H), c);
        convert_table(p.pu, (bf16_t*)(ws + OFF_U16), c);
        convert_table(p.pv, (bf16_t*)(ws + OFF_V16), c);
    }
    SEAM(8);
    if (IN(9)) { MKCTX();
        EpiPq e{(bf16_t*)(ws + OFF_PQ)};
        GEMM(c, (const bf16_t*)(ws + OFF_H), (const bf16_t*)(ws + OFF_WPQ), M, 2048, 2048, e);
    }
    SEAM(9);
    if (IN(10)) { MKCTX(); select_naive(p, c); }
    SEAM(10);
    if (IN(11)) { MKCTX(); phase_gather(p, c); }
#undef IN
#undef SEAM
}

extern "C" void kernel_launch(void* const* d_in, const int* in_sizes, int n_in, void* d_out, int out_size, void* d_ws, size_t ws_size, hipStream_t stream) {
    static int grid = 0;
    if (grid == 0) {
        if (n_in != 20 || out_size != M * D || ws_size < WS_END) { fprintf(stderr, "kernel_launch: unexpected shapes (n_in %d out %d ws %zu need %zu)\n", n_in, out_size, ws_size, (size_t)WS_END); grid = -1; return; }
        int dev = 0, cus = 0, per_cu = 0;
        (void)hipGetDevice(&dev); (void)hipDeviceGetAttribute(&cus, hipDeviceAttributeMultiprocessorCount, dev);
        if (hipFuncSetAttribute((const void*)mega, hipFuncAttributeMaxDynamicSharedMemorySize, LDS_BYTES) != hipSuccess) { fprintf(stderr, "kernel_launch: hipFuncSetAttribute failed\n"); grid = -1; return; }
        if (hipOccupancyMaxActiveBlocksPerMultiprocessor(&per_cu, (const void*)mega, NTHREADS, LDS_BYTES) != hipSuccess || per_cu < 1) { fprintf(stderr, "kernel_launch: occupancy query failed (%d)\n", per_cu); per_cu = 1; }
        (void)hipGetLastError();
        grid = cus;
    }
    if (grid < 0) return;
    (void)hipMemsetAsync((char*)d_ws + OFF_CTL, 0, ZERO_BYTES, stream);
    Params p{};
    p.x = (const float*)d_in[0]; p.c = (const float*)d_in[1]; p.pos = (const int*)d_in[2]; p.ada_w = (const float*)d_in[3]; p.ada_b = (const float*)d_in[4];
    p.n1g = (const float*)d_in[5]; p.n2g = (const float*)d_in[6]; p.w_in = (const float*)d_in[7]; p.qng = (const float*)d_in[8]; p.kvng = (const float*)d_in[9];
    p.w_uq = (const float*)d_in[10]; p.w_ukv = (const float*)d_in[11]; p.w_bm = (const float*)d_in[12]; p.w_bs = (const float*)d_in[13]; p.w_out = (const float*)d_in[14];
    p.w_pq = (const float*)d_in[15]; p.skeys = (const float*)d_in[16]; p.pu = (const float*)d_in[17]; p.pv = (const float*)d_in[18]; p.fng = (const float*)d_in[19];
    p.out = (float*)d_out; p.ws = (unsigned char*)d_ws;
    for (int i = 0; i < 32; ++i) p.invf[i] = (float)pow(10000.0, -(double)i / 32.0);
#if N_LAUNCH_MODE == 1
    p.ph_lo = 0; p.ph_hi = NPHASE;
    void* args[] = {&p};
    hipError_t e = hipLaunchCooperativeKernel((const void*)mega, dim3(grid), dim3(NTHREADS), args, LDS_BYTES, stream);
    if (e != hipSuccess) fprintf(stderr, "cooperative launch failed: %s (grid %d)\n", hipGetErrorString(e), grid);
#else
    for (int k = 0; k < NPHASE; ++k) {
        p.ph_lo = k; p.ph_hi = k + 1;
        hipLaunchKernelGGL(mega, dim3(grid), dim3(NTHREADS), LDS_BYTES, stream, p);
    }
#endif
}
```

```cpp
#include <hip/hip_runtime.h>
#include <hip/hip_cooperative_groups.h>
#include <cstdio>
#include <cstdint>
#include <cmath>
namespace cg = cooperative_groups;

#ifndef N_LAUNCH_MODE
#define N_LAUNCH_MODE 1
#endif

#ifndef TIME_PHASE
#define TIME_PHASE -1
#endif
#ifndef TIME_SCALE
#define TIME_SCALE 5000.f
#endif
#ifndef DUP_GEMM
#define DUP_GEMM -1
#endif
#ifndef PRO_SPLIT
#define PRO_SPLIT 1
#endif
#ifndef USE_XBAR
#define USE_XBAR 1
#endif
#ifndef DBG_XTRA_BAR
#define DBG_XTRA_BAR 0
#endif
#ifndef DBG_ROUND_BAR
#define DBG_ROUND_BAR 0
#endif
#ifndef GATHER_DYN
#define GATHER_DYN 1
#endif
#ifndef SEL_FUSED
#define SEL_FUSED 1
#endif
#ifndef DUP_PHASE
#define DUP_PHASE -1
#endif
#ifndef DBG_ALPHA
#define DBG_ALPHA 1.0f
#endif
#ifndef DBG_BETA
#define DBG_BETA 1.0f
#endif
#define LAS __attribute__((address_space(3)))
#define DI __device__ __forceinline__
typedef unsigned short bf16_t;
typedef short bf16x8 __attribute__((ext_vector_type(8)));
typedef float f32x4 __attribute__((ext_vector_type(4)));
typedef float f32x2 __attribute__((ext_vector_type(2)));
typedef unsigned u32x4 __attribute__((ext_vector_type(4)));
typedef unsigned u32x2 __attribute__((ext_vector_type(2)));
typedef __bf16 bf16v2 __attribute__((ext_vector_type(2)));

constexpr int M = 16384, D = 2048, SEQ = 4096, NB = 4;
constexpr int NTHREADS = 512, NWAVES = 8;
constexpr int LDS_BYTES = 160 * 1024;
constexpr float EPS = 1e-6f;
constexpr float LOG2E = 1.4426950408889634f;
constexpr int NPHASE = 14;

constexpr size_t al256(size_t x) { return (x + 255) & ~(size_t)255; }
constexpr size_t OFF_CTL = 0;
constexpr size_t OFF_XBAR = 4096;
constexpr size_t OFF_MODI = 32768;
constexpr size_t ZERO_BYTES = OFF_MODI + (size_t)NB * 6 * D * 8;
constexpr size_t OFF_MOD = al256(ZERO_BYTES);
constexpr size_t OFF_RSTQ = OFF_MOD + (size_t)NB * 6 * D * 4;
constexpr size_t OFF_RSTKV = OFF_RSTQ + (size_t)M * 4;
constexpr size_t OFF_CS = OFF_RSTKV + (size_t)M * 4;
constexpr size_t OFF_KEYS = OFF_CS + (size_t)M * 32 * 8;
constexpr size_t OFF_WIN = OFF_KEYS + (size_t)8 * 2 * 128 * 128 * 2;
constexpr size_t OFF_WSBV = OFF_WIN + (size_t)7168 * 2048 * 2;
constexpr size_t OFF_WUQ = OFF_WSBV + (size_t)1024 * 2048 * 2;
constexpr size_t OFF_WUK = OFF_WUQ + (size_t)1536 * 512 * 2;
constexpr size_t OFF_WUV = OFF_WUK + (size_t)1024 * 256 * 2;
constexpr size_t OFF_WA = OFF_WUV + (size_t)1024 * 256 * 2;
constexpr size_t OFF_WB = OFF_WA + (size_t)2048 * 1024 * 2;
constexpr size_t OFF_WOUT = OFF_WB + (size_t)2048 * 1024 * 2;
constexpr size_t OFF_WPQ = OFF_WOUT + (size_t)2048 * 2048 * 2;
constexpr size_t OFF_H = OFF_WPQ + (size_t)2048 * 2048 * 2;
constexpr size_t OFF_CQ = OFF_H + (size_t)M * 2048 * 2;
constexpr size_t OFF_CKV = OFF_CQ + (size_t)M * 512 * 2;
constexpr size_t OFF_KR = OFF_CKV + (size_t)M * 256 * 2;
constexpr size_t OFF_SBQ = OFF_KR + (size_t)M * 64 * 2;
constexpr size_t OFF_SBK = OFF_SBQ + (size_t)M * 1024 * 2;
constexpr size_t OFF_SBVT = OFF_SBK + (size_t)M * 1024 * 2;
constexpr size_t OFF_GA = OFF_SBVT + (size_t)M * 1024 * 2;
constexpr size_t OFF_GB = OFF_GA + (size_t)M * 2048 * 2;
constexpr size_t OFF_Q = OFF_GB + (size_t)M * 2048 * 2;
constexpr size_t OFF_KN = OFF_Q + (size_t)M * 1536 * 2;
constexpr size_t OFF_VT = OFF_KN + (size_t)M * 1024 * 2;
constexpr size_t OFF_ATTA = OFF_VT + (size_t)M * 1024 * 2;
constexpr size_t OFF_ATTB = OFF_ATTA + (size_t)M * 1024 * 2;
constexpr size_t WS_END = OFF_ATTB + (size_t)M * 1024 * 2;
constexpr size_t OFF_MERGED = OFF_SBQ;
constexpr size_t OFF_PQ = OFF_GA;
constexpr size_t OFF_IDX = OFF_GB;
constexpr size_t OFF_GW = OFF_GB + (size_t)M * 128 * 4;
constexpr size_t OFF_U16 = OFF_Q;
constexpr size_t OFF_V16 = OFF_U16 + (size_t)16384 * 2048;
static_assert(OFF_V16 + (size_t)16384 * 2048 <= WS_END, "u/v overlay");
constexpr float U8_SCALE = 68.f, V8_SCALE = 1.5f;
static_assert(WS_END < (size_t)620 * 1000 * 1000, "workspace budget");

struct Params {
    const float *x, *c; const int* pos;
    const float *ada_w, *ada_b, *n1g, *n2g, *w_in, *qng, *kvng, *w_uq, *w_ukv, *w_bm, *w_bs, *w_out, *w_pq, *skeys, *pu, *pv, *fng;
    float* out; unsigned char* ws;
    float invf[32];
    int ph_lo, ph_hi;
};

DI unsigned pk2(float lo, float hi) { bf16v2 p; p[0] = (__bf16)lo; p[1] = (__bf16)hi; return __builtin_bit_cast(unsigned, p); }
DI float bflo(unsigned u) { return __uint_as_float(u << 16); }
DI float bfhi(unsigned u) { return __uint_as_float(u & 0xffff0000u); }
DI float dot2bf(unsigned a, unsigned b, float c) { return __builtin_amdgcn_fdot2_f32_bf16(__builtin_bit_cast(bf16v2, a), __builtin_bit_cast(bf16v2, b), c, false); }
DI float bf2f(bf16_t b) { return __uint_as_float(((unsigned)b) << 16); }
DI float wave_sum(float v) {
#pragma unroll
    for (int o = 1; o < 64; o <<= 1) v += __shfl_xor(v, o);
    return v;
}
DI float wave_max(float v) {
#pragma unroll
    for (int o = 1; o < 64; o <<= 1) v = fmaxf(v, __shfl_xor(v, o));
    return v;
}
DI float sigmoidf_(float v) { return 1.f / (1.f + __expf(-v)); }
DI float gelu_tanh(float v) { const float u = 0.7978845608028654f * (v + 0.044715f * v * v * v); const float e = __expf(2.f * u); const float t = 1.f - 2.f / (e + 1.f); return 0.5f * v * (1.f + t); }
DI void store_bf16x4(bf16_t* p, f32x4 v) { u32x2 w; w.x = pk2(v[0], v[1]); w.y = pk2(v[2], v[3]); *(u32x2*)p = w; }
DI void store_bf16x8(bf16_t* p, f32x4 a, f32x4 b) { u32x4 w; w.x = pk2(a[0], a[1]); w.y = pk2(a[2], a[3]); w.z = pk2(b[0], b[1]); w.w = pk2(b[2], b[3]); *(u32x4*)p = w; }
DI void load_bf16x8(const bf16_t* p, f32x4& a, f32x4& b) { const u32x4 w = *(const u32x4*)p; a = (f32x4){bflo(w.x), bfhi(w.x), bflo(w.y), bfhi(w.y)}; b = (f32x4){bflo(w.z), bfhi(w.z), bflo(w.w), bfhi(w.w)}; }
DI f32x4 sig4(f32x4 v) { return (f32x4){sigmoidf_(v[0]), sigmoidf_(v[1]), sigmoidf_(v[2]), sigmoidf_(v[3])}; }
DI f32x4 rope4(f32x4 v, f32x2 c0, f32x2 c1) { return (f32x4){v[0] * c0.x - v[1] * c0.y, v[1] * c0.x + v[0] * c0.y, v[2] * c1.x - v[3] * c1.y, v[3] * c1.x + v[2] * c1.y}; }
DI f32x4 load_bf16x4(const bf16_t* p) { const u32x2 w = *(const u32x2*)p; return (f32x4){bflo(w.x), bfhi(w.x), bflo(w.y), bfhi(w.y)}; }

struct Ctx {
    LAS unsigned char* lds;
    int tid, lane, wave, gw, ngw;
};

struct MapWin { DI int operator()(int n) const {
    if (n < 768) return n;
    if (n < 1024) { const int j = n - 768; if (j >= 64) return -1; return 768 + (j >> 1) + 32 * (j & 1); }
    if (n < 2048) return 832 + (n - 1024);
    if (n < 3072) return 1856 + (n - 2048);
    if (n < 5120) return 3904 + (n - 3072);
    return 5952 + (n - 5120); } };
struct MapOff { int off; DI int operator()(int n) const { return n + off; } };
struct MapUq { DI int operator()(int n) const { const int hd = n / 192, j = n % 192; if (j < 128) return hd * 192 + j; const int jj = j - 128; return hd * 192 + 128 + (jj >> 1) + 32 * (jj & 1); } };
struct MapUk { DI int operator()(int n) const { return (n >> 7) * 256 + (n & 127); } };
struct MapUv { DI int operator()(int n) const { return (n >> 7) * 256 + 128 + (n & 127); } };

template <class Map>
DI void transpose_item(const float* W, int K, int N, const Map& mp, const float* rowscale, bf16_t* dst, int kb, int nb, LAS float* scr, int lane) {
    const int k0 = kb * 64, sc = mp(nb * 64 + lane);
#pragma unroll 8
    for (int kk = 0; kk < 64; ++kk) {
        float v = 0.f;
        if (sc >= 0) v = W[(size_t)(k0 + kk) * N + sc];
        if (rowscale) v *= rowscale[k0 + kk];
        scr[kk * 65 + lane] = v;
    }
    asm volatile("s_waitcnt lgkmcnt(0)" ::: "memory");
    const int kc = lane & 7;
#pragma unroll
    for (int j = 0; j < 8; ++j) {
        const int nrow = (lane >> 3) + 8 * j; const LAS float* s = scr + (8 * kc) * 65 + nrow;
        u32x4 o; o.x = pk2(s[0], s[65]); o.y = pk2(s[2 * 65], s[3 * 65]); o.z = pk2(s[4 * 65], s[5 * 65]); o.w = pk2(s[6 * 65], s[7 * 65]);
        *(u32x4*)(dst + (size_t)(nb * 64 + nrow) * K + k0 + 8 * kc) = o;
    }
    asm volatile("s_waitcnt lgkmcnt(0)" ::: "memory");
}

DI void phase_prologue(const Params& p, const Ctx& c, bool do_ada = true, bool do_rest = true) {
    unsigned char* ws = p.ws;
    LAS float* scr = (LAS float*)(c.lds + c.wave * 16640);
    unsigned long long* modi = (unsigned long long*)(ws + OFF_MODI);
    if (do_ada) for (int u = c.gw; u < 32 * 48; u += c.ngw) {
        const int kp = u / 48, ch = u % 48, k0 = kp * 64, c0 = ch * 256 + c.lane * 4;
        float sl[4];
#pragma unroll
        for (int b = 0; b < 4; ++b) { const float cv = p.c[b * D + k0 + c.lane]; sl[b] = cv / (1.f + __expf(-cv)); }
        f32x4 acc[4];
#pragma unroll
        for (int b = 0; b < 4; ++b) acc[b] = (f32x4){0.f, 0.f, 0.f, 0.f};
#pragma unroll 16
        for (int kk = 0; kk < 64; ++kk) {
            const f32x4 w = *(const f32x4*)(p.ada_w + (size_t)(k0 + kk) * (6 * D) + c0);
#pragma unroll
            for (int b = 0; b < 4; ++b) { const float s = __shfl(sl[b], kk); acc[b] += w * s; }
        }
        if (kp == 0) { const f32x4 bv = *(const f32x4*)(p.ada_b + c0);
#pragma unroll
            for (int b = 0; b < 4; ++b) acc[b] += bv; }
#pragma unroll
        for (int b = 0; b < 4; ++b)
#pragma unroll
            for (int e = 0; e < 4; ++e) atomicAdd(modi + b * 6 * D + c0 + e, (unsigned long long)(long long)__builtin_rint((double)acc[b][e] * 4294967296.0));
    }
    if (!do_rest) return;
    constexpr int I_WIN = 112 * 32, I_SBV = 16 * 32, I_UQ = 24 * 8, I_UK = 16 * 4, I_UV = 16 * 4, I_A = 32 * 16, I_B = 32 * 16, I_OUT = 32 * 32, I_PQ = 32 * 32;
    constexpr int NIT = I_WIN + I_SBV + I_UQ + I_UK + I_UV + I_A + I_B + I_OUT + I_PQ;
    for (int it = c.gw; it < NIT; it += c.ngw) {
        int r = it;
        if (r < I_WIN) { transpose_item(p.w_in, 2048, 8000, MapWin{}, nullptr, (bf16_t*)(ws + OFF_WIN), r % 32, r / 32, scr, c.lane); continue; } r -= I_WIN;
        if (r < I_SBV) { transpose_item(p.w_in, 2048, 8000, MapOff{2880}, nullptr, (bf16_t*)(ws + OFF_WSBV), r % 32, r / 32, scr, c.lane); continue; } r -= I_SBV;
        if (r < I_UQ) { transpose_item(p.w_uq, 512, 1536, MapUq{}, p.qng, (bf16_t*)(ws + OFF_WUQ), r % 8, r / 8, scr, c.lane); continue; } r -= I_UQ;
        if (r < I_UK) { transpose_item(p.w_ukv, 256, 2048, MapUk{}, p.kvng, (bf16_t*)(ws + OFF_WUK), r % 4, r / 4, scr, c.lane); continue; } r -= I_UK;
        if (r < I_UV) { transpose_item(p.w_ukv, 256, 2048, MapUv{}, p.kvng, (bf16_t*)(ws + OFF_WUV), r % 4, r / 4, scr, c.lane); continue; } r -= I_UV;
        if (r < I_A) { transpose_item(p.w_bm, 1024, 2048, MapOff{0}, nullptr, (bf16_t*)(ws + OFF_WA), r % 16, r / 16, scr, c.lane); continue; } r -= I_A;
        if (r < I_B) { transpose_item(p.w_bs, 1024, 2048, MapOff{0}, nullptr, (bf16_t*)(ws + OFF_WB), r % 16, r / 16, scr, c.lane); continue; } r -= I_B;
        if (r < I_OUT) { transpose_item(p.w_out, 2048, 2048, MapOff{0}, nullptr, (bf16_t*)(ws + OFF_WOUT), r % 32, r / 32, scr, c.lane); continue; } r -= I_OUT;
        transpose_item(p.w_pq, 2048, 2048, MapOff{0}, nullptr, (bf16_t*)(ws + OFF_WPQ), r % 32, r / 32, scr, c.lane);
    }
    { bf16_t* kd = (bf16_t*)(ws + OFF_KEYS);
      for (int i = (c.gw * 64 + c.lane) * 4; i < 8 * 2 * 128 * 128; i += c.ngw * 64 * 4) store_bf16x4(kd + i, *(const f32x4*)(p.skeys + i)); }
    { f32x2* cs = (f32x2*)(ws + OFF_CS);
      for (int i = c.gw * 64 + c.lane; i < M * 32; i += c.ngw * 64) {
          const int m = i >> 5, f = i & 31;
          const float ang = (float)p.pos[m] * p.invf[f];
          const double rev = (double)ang * 0.15915494309189533576888;
          const float fr = (float)(rev - __builtin_rint(rev));
          cs[i] = (f32x2){__builtin_amdgcn_cosf(fr), __builtin_amdgcn_sinf(fr)};
      } }
}

DI f32x4 ld_mod4(const float* p) { return *(const f32x4*)p; }
DI f32x4 ld_mod4(const long long* p) { f32x4 r;
#pragma unroll
    for (int e = 0; e < 4; ++e) r[e] = (float)((double)p[e] * (1.0 / 4294967296.0));
    return r; }
template <class MT>
DI void modulate_rows(const float* src, const float* g, const MT* sc, const MT* sh, bf16_t* dst, const Ctx& c) {
    for (int m = c.gw; m < M; m += c.ngw) {
        const int b = m / SEQ;
        const float* xr = src + (size_t)m * D;
        f32x4 v[8]; float ss = 0.f;
#pragma unroll
        for (int j = 0; j < 8; ++j) { v[j] = *(const f32x4*)(xr + (j * 64 + c.lane) * 4); ss += v[j][0] * v[j][0] + v[j][1] * v[j][1] + v[j][2] * v[j][2] + v[j][3] * v[j][3]; }
        const float rstd = rsqrtf(wave_sum(ss) * (1.f / D) + EPS);
#pragma unroll
        for (int j = 0; j < 8; ++j) {
            const int col = (j * 64 + c.lane) * 4;
            const f32x4 gg = *(const f32x4*)(g + col), s1 = ld_mod4(sc + b * 6 * D + col), h1 = ld_mod4(sh + b * 6 * D + col);
            const f32x4 o = v[j] * rstd * gg * (s1 + 1.f) + h1;
            store_bf16x4(dst + (size_t)m * D + col, o);
        }
    }
}
DI void phase_rowstats(const Params& p, const Ctx& c) {
    const bf16_t* cq = (const bf16_t*)(p.ws + OFF_CQ); const bf16_t* ckv = (const bf16_t*)(p.ws + OFF_CKV);
    float* rq = (float*)(p.ws + OFF_RSTQ); float* rkv = (float*)(p.ws + OFF_RSTKV);
    for (int m = c.gw; m < M; m += c.ngw) {
        const u32x4 a = *(const u32x4*)(cq + (size_t)m * 512 + c.lane * 8);
        const u32x2 b = *(const u32x2*)(ckv + (size_t)m * 256 + c.lane * 4);
        float s1 = 0.f, s2 = 0.f;
#pragma unroll
        for (int e = 0; e < 4; ++e) { const float lo = bflo(a[e]), hi = bfhi(a[e]); s1 += lo * lo + hi * hi; }
#pragma unroll
        for (int e = 0; e < 2; ++e) { const float lo = bflo(b[e]), hi = bfhi(b[e]); s2 += lo * lo + hi * hi; }
        s1 = wave_sum(s1); s2 = wave_sum(s2);
        if (c.lane == 0) { rq[m] = rsqrtf(s1 * (1.f / 512.f) + EPS); rkv[m] = rsqrtf(s2 * (1.f / 256.f) + EPS); }
    }
}
typedef float f32x16v __attribute__((ext_vector_type(16)));
typedef float f32x32v __attribute__((ext_vector_type(32)));
typedef unsigned u32x6 __attribute__((ext_vector_type(6)));
#ifndef FP6_ORDER
#define FP6_ORDER 1
#endif
DI void convert_table(const float* src, unsigned char* dst, float scale, const Ctx& c) {
    const size_t ngroups = (size_t)16384 * 64;
    for (size_t gi = (size_t)c.gw * 64 + c.lane; gi < ngroups; gi += (size_t)c.ngw * 64) {
        const size_t row = gi >> 6; const int l = (int)(gi & 63);
        const float* sp = src + row * 2048 + l * 32;
        f32x4 v[8];
#pragma unroll
        for (int i = 0; i < 8; ++i) v[i] = *(const f32x4*)(sp + 4 * i) * scale;
        f32x16v a, b;
#pragma unroll
        for (int e = 0; e < 16; ++e) {
#if FP6_ORDER == 0
            a[e] = v[e >> 2][e & 3]; b[e] = v[4 + (e >> 2)][e & 3];
#else
            a[e] = v[(2 * e) >> 2][(2 * e) & 3]; b[e] = v[(2 * e + 1) >> 2][(2 * e + 1) & 3];
#endif
        }
        const u32x6 pk = __builtin_amdgcn_cvt_scalef32_2xpk16_fp6_f32(a, b, 1.0f);
        unsigned char* dp = dst + row * 1536;
        *(u32x4*)(dp + 16 * l) = (u32x4){pk[0], pk[1], pk[2], pk[3]};
        *(u32x2*)(dp + 1024 + 8 * l) = (u32x2){pk[4], pk[5]};
    }
}

struct EpiProj {
    bf16_t *cq, *ckv, *kr, *sbq, *sbk, *ga, *gb; const f32x2* cs;
    DI void operator()(int row, int col, f32x4 v) const {
        const int tile = col >> 8;
        if (tile < 2) { store_bf16x4(cq + (size_t)row * 512 + col, v); }
        else if (tile == 2) { store_bf16x4(ckv + (size_t)row * 256 + (col - 512), v); }
        else if (tile == 3) { const int j = col - 768; if (j < 64) { const f32x2 c0 = cs[row * 32 + (j >> 1)], c1 = cs[row * 32 + (j >> 1) + 1];
            const f32x4 o = {v[0] * c0.x - v[1] * c0.y, v[1] * c0.x + v[0] * c0.y, v[2] * c1.x - v[3] * c1.y, v[3] * c1.x + v[2] * c1.y};
            store_bf16x4(kr + (size_t)row * 64 + j, o); } }
        else if (tile < 8) { store_bf16x4(sbq + (size_t)row * 1024 + (col - 1024), v * (0.08838834764831845f * LOG2E)); }
        else if (tile < 12) { store_bf16x4(sbk + (size_t)row * 1024 + (col - 2048), v); }
        else if (tile < 20) { store_bf16x4(ga + (size_t)row * 2048 + (col - 3072), (f32x4){sigmoidf_(v[0]), sigmoidf_(v[1]), sigmoidf_(v[2]), sigmoidf_(v[3])}); }
        else { store_bf16x4(gb + (size_t)row * 2048 + (col - 5120), (f32x4){sigmoidf_(v[0]), sigmoidf_(v[1]), sigmoidf_(v[2]), sigmoidf_(v[3])}); }
    }    DI void operator()(int row, int col, f32x4 v0, f32x4 v1) const {
        const int tile = col >> 8;
        if (tile < 2) { store_bf16x8(cq + (size_t)row * 512 + col, v0, v1); }
        else if (tile == 2) { store_bf16x8(ckv + (size_t)row * 256 + (col - 512), v0, v1); }
        else if (tile == 3) { const int j = col - 768; if (j < 64) { const f32x2* cp = cs + row * 32 + (j >> 1);
            store_bf16x8(kr + (size_t)row * 64 + j, rope4(v0, cp[0], cp[1]), rope4(v1, cp[2], cp[3])); } }
        else if (tile < 8) { const float sc = 0.08838834764831845f * LOG2E; store_bf16x8(sbq + (size_t)row * 1024 + (col - 1024), v0 * sc, v1 * sc); }
        else if (tile < 12) { store_bf16x8(sbk + (size_t)row * 1024 + (col - 2048), v0, v1); }
        else if (tile < 20) { store_bf16x8(ga + (size_t)row * 2048 + (col - 3072), sig4(v0), sig4(v1)); }
        else { store_bf16x8(gb + (size_t)row * 2048 + (col - 5120), sig4(v0), sig4(v1)); }
    }
};
struct EpiT { bf16_t* o; const float* cscale;
    DI void operator()(int row, int col, f32x4 v) const { if (cscale) v = v * *(const f32x4*)(cscale + col); store_bf16x4(o + (size_t)row * M + col, v); }
    DI void operator()(int row, int col, f32x4 v0, f32x4 v1) const { if (cscale) { v0 = v0 * *(const f32x4*)(cscale + col); v1 = v1 * *(const f32x4*)(cscale + col + 4); } store_bf16x8(o + (size_t)row * M + col, v0, v1); } };
struct EpiUq { bf16_t* q; const float* rst; const f32x2* cs;
    DI void operator()(int row, int col, f32x4 v) const {
        v = v * (rst[row] * (0.07216878364870322f * LOG2E));
        const int j = col % 192;
        if (j >= 128) { const int i0 = (j - 128) >> 1; const f32x2 c0 = cs[row * 32 + i0], c1 = cs[row * 32 + i0 + 1];
            v = (f32x4){v[0] * c0.x - v[1] * c0.y, v[1] * c0.x + v[0] * c0.y, v[2] * c1.x - v[3] * c1.y, v[3] * c1.x + v[2] * c1.y}; }
        store_bf16x4(q + (size_t)row * 1536 + col, v);
    }
    DI void operator()(int row, int col, f32x4 v0, f32x4 v1) const {
        const float sc = rst[row] * (0.07216878364870322f * LOG2E); v0 = v0 * sc; v1 = v1 * sc;
        const int j = col % 192;
        if (j >= 128) { const f32x2* cp = cs + row * 32 + ((j - 128) >> 1); v0 = rope4(v0, cp[0], cp[1]); v1 = rope4(v1, cp[2], cp[3]); }
        store_bf16x8(q + (size_t)row * 1536 + col, v0, v1);
    } };
struct EpiRowScale { bf16_t* o; int ld; const float* rst;
    DI void operator()(int row, int col, f32x4 v) const { store_bf16x4(o + (size_t)row * ld + col, v * rst[row]); }
    DI void operator()(int row, int col, f32x4 v0, f32x4 v1) const { const float sc = rst[row]; store_bf16x8(o + (size_t)row * ld + col, v0 * sc, v1 * sc); } };
struct EpiGate1 { bf16_t* mg; const bf16_t* g;
    DI void operator()(int row, int col, f32x4 v) const { const size_t i = (size_t)row * 2048 + col; store_bf16x4(mg + i, v * load_bf16x4(g + i)); }
    DI void operator()(int row, int col, f32x4 v0, f32x4 v1) const { const size_t i = (size_t)row * 2048 + col; f32x4 g0, g1; load_bf16x8(g + i, g0, g1); store_bf16x8(mg + i, v0 * g0, v1 * g1); } };
struct EpiGate2 { bf16_t* mg; const bf16_t* g;
    DI void operator()(int row, int col, f32x4 v) const { const size_t i = (size_t)row * 2048 + col; store_bf16x4(mg + i, load_bf16x4(mg + i) + v * load_bf16x4(g + i)); }
    DI void operator()(int row, int col, f32x4 v0, f32x4 v1) const { const size_t i = (size_t)row * 2048 + col; f32x4 g0, g1, m0, m1; load_bf16x8(g + i, g0, g1); load_bf16x8(mg + i, m0, m1); store_bf16x8(mg + i, m0 + v0 * g0, m1 + v1 * g1); } };
struct EpiRes { const float* x; const float* gt; float* x1;
    DI void operator()(int row, int col, f32x4 v) const { const size_t i = (size_t)row * 2048 + col; const int b = row / SEQ;
        *(f32x4*)(x1 + i) = *(const f32x4*)(x + i) + *(const f32x4*)(gt + b * 6 * D + col) * v * DBG_ALPHA; }
    DI void operator()(int row, int col, f32x4 v0, f32x4 v1) const { (*this)(row, col, v0); (*this)(row, col + 4, v1); } };
struct EpiPq { bf16_t* pq;
    DI void operator()(int row, int col, f32x4 v) const { store_bf16x4(pq + (size_t)(col >> 8) * M * 256 + (size_t)row * 256 + (col & 255), v); }
    DI void operator()(int row, int col, f32x4 v0, f32x4 v1) const { store_bf16x8(pq + (size_t)(col >> 8) * M * 256 + (size_t)row * 256 + (col & 255), v0, v1); } };

template <class Epi>
DI void gemm_naive(const Ctx& c, const bf16_t* A, const bf16_t* Bt, int Mg, int Ng, int Kg, const Epi& E) {
    LAS float* As = (LAS float*)c.lds; LAS float* Bs = As + 16 * 132;
    const int tid = c.tid, ty = tid >> 5, tx = tid & 31;
    const int tilesN = Ng / 128, ntiles = (Mg / 128) * tilesN;
    for (int t = blockIdx.x; t < ntiles; t += gridDim.x) {
        const int tm = t / tilesN, tn = t % tilesN;
        float acc[8][4];
#pragma unroll
        for (int i = 0; i < 8; ++i)
#pragma unroll
            for (int j = 0; j < 4; ++j) acc[i][j] = 0.f;
        for (int k0 = 0; k0 < Kg; k0 += 16) {
            { const int lt = tid & 255, r = lt >> 1, kc = lt & 1;
              const bf16_t* src = (tid < 256 ? A + (size_t)(tm * 128 + r) * Kg : Bt + (size_t)(tn * 128 + r) * Kg) + k0 + kc * 8;
              const u32x4 v = *(const u32x4*)src;
              LAS float* dst = (tid < 256 ? As : Bs) + (kc * 8) * 132 + r;
              dst[0] = bflo(v.x); dst[132] = bfhi(v.x); dst[2 * 132] = bflo(v.y); dst[3 * 132] = bfhi(v.y);
              dst[4 * 132] = bflo(v.z); dst[5 * 132] = bfhi(v.z); dst[6 * 132] = bflo(v.w); dst[7 * 132] = bfhi(v.w); }
            __syncthreads();
#pragma unroll
            for (int kk = 0; kk < 16; ++kk) {
                const f32x4 a0 = *(const LAS f32x4*)(As + kk * 132 + ty * 8), a1 = *(const LAS f32x4*)(As + kk * 132 + ty * 8 + 4);
                const f32x4 b = *(const LAS f32x4*)(Bs + kk * 132 + tx * 4);
#pragma unroll
                for (int j = 0; j < 4; ++j) {
                    acc[0][j] += a0[0] * b[j]; acc[1][j] += a0[1] * b[j]; acc[2][j] += a0[2] * b[j]; acc[3][j] += a0[3] * b[j];
                    acc[4][j] += a1[0] * b[j]; acc[5][j] += a1[1] * b[j]; acc[6][j] += a1[2] * b[j]; acc[7][j] += a1[3] * b[j];
                }
            }
            __syncthreads();
        }
#pragma unroll
        for (int i = 0; i < 8; ++i) E(tm * 128 + ty * 8 + i, tn * 128 + tx * 4, (f32x4){acc[i][0], acc[i][1], acc[i][2], acc[i][3]});
    }
}

namespace pg8 {
#define PG8_LAS __attribute__((address_space(3)))
typedef unsigned short bf16_t;
typedef short bf16x8 __attribute__((ext_vector_type(8)));
typedef float f32x4 __attribute__((ext_vector_type(4)));
typedef unsigned u32x4 __attribute__((ext_vector_type(4)));
constexpr int BM = 256, BK = 64, HALF = 128, HTB = HALF * BK * 2  , STAGE_BYTES = 8 * HTB, NXCD = 8, WGM = 4;

__host__ __device__ __forceinline__ int lds_byte(int r, int c) { const int st = (r >> 4) * 2 + (c >> 5), rr = r & 15, cc = c & 31, ob = rr * 64 + cc * 2; return st * 1024 + (ob ^ (((ob >> 9) & 1) << 5)); }
__host__ __device__ __forceinline__ void stage_rc(int b, int& R, int& C) { const int st = b / 1024, sb = b % 1024, swz = sb ^ (((sb >> 9) & 1) << 5); R = (st >> 1) * 16 + swz / 64; C = (st & 1) * 32 + (swz % 64) / 2; }
__host__ __device__ __forceinline__ int perm32(int rho) { const int n = rho >> 4, i = rho & 15; return 8 * (i >> 2) + 4 * n + (i & 3); }

struct Unit { int pm, pn; };
struct Gemm { const bf16_t* A; const bf16_t* Bt; int M, N, K; int tid; };
struct StaticOrder {
    int nM, nN, nwg, G, c;
    __host__ __device__ void init(int M, int N, int G_, int c_) { nM = M / BM; nN = N / BM; nwg = nM * nN; G = G_; c = c_; }
    __host__ __device__ bool next(int i, Unit& u) const {
        const long L = (long)i * G + c; if (L >= nwg) return false;
        int wgid = (int)L; { const int q = nwg / NXCD, r = nwg % NXCD, xcd = wgid % NXCD, off = wgid / NXCD; wgid = (xcd < r ? xcd * (q + 1) : r * (q + 1) + (xcd - r) * q) + off; }
        const int nig = WGM * nN, gid = wgid / nig, fm = gid * WGM, gsz = (nM - fm) < WGM ? (nM - fm) : WGM;
        u.pm = fm + ((wgid % nig) % gsz); u.pn = (wgid % nig) / gsz; return true;
    }
    __device__ __forceinline__ void a_ready(const Unit&) const {}
    __device__ __forceinline__ void done(const Unit&) const {}
};
template <class Epi, class Sched, bool STAMP = false>
__device__ __forceinline__ void gemm_phase(PG8_LAS unsigned char* lds, const Gemm g, const Sched& S, const Epi& E, unsigned long long* stamps) {
    const int tid = g.tid, wid = __builtin_amdgcn_readfirstlane(tid >> 6), lane = tid & 63, wr = wid >> 2, wc = wid & 3, fr = lane & 15, fq = lane >> 4;
    const int K = g.K, nt = K / BK;
    int ts_lo = 0, ts_hi = 0, nts = 0; const unsigned long long rt_entry = STAMP ? (unsigned long long)wall_clock64() : 0ull;
#define PG8_STAMP() do { if (STAMP && wid == 0 && nts < 64) { const unsigned long long _c = (unsigned long long)clock64(); \
        ts_lo = (lane == nts) ? (int)(unsigned)_c : ts_lo; ts_hi = (lane == nts) ? (int)(unsigned)(_c >> 32) : ts_hi; ++nts; } } while (0)
    PG8_STAMP();
    unsigned voffA[2], voffB[2];
#pragma unroll
    for (int i = 0; i < 2; ++i) { int R, C; stage_rc(tid * 16 + i * 8192, R, C); const int Rb = Epi::PERM ? ((R & ~31) + perm32(R & 31)) : R;
        voffA[i] = (unsigned)(R * K + C) * 2u; voffB[i] = (unsigned)(Rb * K + C) * 2u; }
    const size_t kstep = (size_t)(BK * 2);
    const size_t hstep = (size_t)HALF * K * 2;
    const size_t tstep = 2 * hstep;
    const unsigned ldsw = (unsigned)wid * 1024u;
    const int aoff = lds_byte(wr * 64 + fr, fq * 8), boff = lds_byte(wc * 32 + fr, fq * 8);
#define PG8_SA(b, h) (((b) * 2 + (h)) * HTB)
#define PG8_SB(b, h) ((4 + (b) * 2 + (h)) * HTB)
#define PG8_STAGE(bufoff, gbase, voff) do { _Pragma("unroll") for (int _i = 0; _i < 2; ++_i) \
        __builtin_amdgcn_global_load_lds((const unsigned*)((const char*)(gbase) + (voff)[_i]), (PG8_LAS unsigned*)(lds + (bufoff) + ldsw + _i * 8192), 16, 0, 0); } while (0)
#define PG8_LDA(dst, b, h) do { _Pragma("unroll") for (int m = 0; m < 4; ++m) _Pragma("unroll") for (int k = 0; k < 2; ++k) dst[m][k] = *(const PG8_LAS bf16x8*)(lds + PG8_SA(b, h) + aoff + m * 2048 + k * 1024); } while (0)
#define PG8_LDB(dst, b, h) do { _Pragma("unroll") for (int n = 0; n < 2; ++n) _Pragma("unroll") for (int k = 0; k < 2; ++k) dst[n][k] = *(const PG8_LAS bf16x8*)(lds + PG8_SB(b, h) + boff + n * 2048 + k * 1024); } while (0)
#define PG8_MMA(ai, bj, At, Bt) do { __builtin_amdgcn_s_setprio(1); _Pragma("unroll") for (int m = 0; m < 4; ++m) _Pragma("unroll") for (int n = 0; n < 2; ++n) _Pragma("unroll") for (int k = 0; k < 2; ++k) \
        acc[ai][bj][m][n] = __builtin_amdgcn_mfma_f32_16x16x32_bf16(Bt[n][k], At[m][k], acc[ai][bj][m][n], 0, 0, 0); __builtin_amdgcn_s_setprio(0); } while (0)
#define PG8_WAIT_V(n) asm volatile("s_waitcnt vmcnt(" #n ")" ::: "memory")
#define PG8_WAIT_L(n) asm volatile("s_waitcnt lgkmcnt(" #n ")" ::: "memory")
#define PG8_BAR __builtin_amdgcn_s_barrier()
#define PG8_SCHED __builtin_amdgcn_sched_barrier(0)
    Unit cur, nxt; int ui = 0;
    if (!S.next(0, cur)) return;
    f32x4 acc[2][2][4][2];
#pragma unroll
    for (int a = 0; a < 2; ++a)
#pragma unroll
        for (int b = 0; b < 2; ++b)
#pragma unroll
            for (int m = 0; m < 4; ++m)
#pragma unroll
                for (int n = 0; n < 2; ++n) acc[a][b][m][n] = (f32x4){0.f, 0.f, 0.f, 0.f};
    bf16x8 At[4][2], B0[2][2], B1[2][2];
    const char* cA = (const char*)g.A + (size_t)cur.pm * tstep; const char* cB = (const char*)g.Bt + (size_t)cur.pn * tstep;
    S.a_ready(cur);
    PG8_STAGE(PG8_SB(0, 0), cB, voffB); PG8_STAGE(PG8_SA(0, 0), cA, voffA); PG8_STAGE(PG8_SB(0, 1), cB + hstep, voffB); PG8_STAGE(PG8_SA(0, 1), cA + hstep, voffA);
    if (wr == 1) PG8_BAR;
    PG8_WAIT_V(4); PG8_BAR;
    PG8_STAGE(PG8_SB(1, 0), cB + kstep, voffB); PG8_STAGE(PG8_SA(1, 0), cA + kstep, voffA); PG8_STAGE(PG8_SB(1, 1), cB + hstep + kstep, voffB);
    PG8_WAIT_V(6); PG8_BAR;
    PG8_STAMP();
    for (;;) {
        const bool has_next = S.next(ui + 1, nxt);
        const char* nA = has_next ? (const char*)g.A + (size_t)nxt.pm * tstep : cA; const char* nB = has_next ? (const char*)g.Bt + (size_t)nxt.pn * tstep : cB;
        for (int t = 0; t < nt; t += 2) {
            const bool last = (t == nt - 2);
            const char* a1 = cA + (size_t)(t + 1) * kstep;
            const char* a2 = last ? nA : cA + (size_t)(t + 2) * kstep; const char* b2 = last ? nB : cB + (size_t)(t + 2) * kstep;
            const char* a3 = a2 + kstep; const char* b3 = b2 + kstep;
            if (last && has_next) S.a_ready(nxt);
            PG8_LDB(B0, 0, 0); PG8_SCHED; PG8_LDA(At, 0, 0); PG8_STAGE(PG8_SA(1, 1), a1 + hstep, voffA);
            PG8_WAIT_L(8); PG8_BAR; PG8_WAIT_L(0); PG8_MMA(0, 0, At, B0); PG8_BAR; PG8_SCHED;
            PG8_LDB(B1, 0, 1); PG8_STAGE(PG8_SB(0, 0), b2, voffB);
            PG8_BAR; PG8_WAIT_L(0); PG8_MMA(0, 1, At, B1); PG8_BAR;
            PG8_LDA(At, 0, 1); PG8_STAGE(PG8_SA(0, 0), a2, voffA);
            PG8_BAR; PG8_WAIT_L(0); PG8_MMA(1, 0, At, B0); PG8_BAR; PG8_SCHED;
            PG8_STAGE(PG8_SB(0, 1), b2 + hstep, voffB);
            PG8_WAIT_V(6); PG8_BAR; PG8_MMA(1, 1, At, B1); PG8_BAR;
            PG8_LDB(B0, 1, 0); PG8_SCHED; PG8_LDA(At, 1, 0); PG8_STAGE(PG8_SA(0, 1), a2 + hstep, voffA);
            PG8_WAIT_L(8); PG8_BAR; PG8_WAIT_L(0); PG8_MMA(0, 0, At, B0); PG8_BAR; PG8_SCHED;
            PG8_LDB(B1, 1, 1); PG8_STAGE(PG8_SB(1, 0), b3, voffB);
            PG8_BAR; PG8_WAIT_L(0); PG8_MMA(0, 1, At, B1); PG8_BAR;
            PG8_LDA(At, 1, 1); PG8_STAGE(PG8_SA(1, 0), a3, voffA);
            PG8_BAR; PG8_WAIT_L(0); PG8_MMA(1, 0, At, B0); PG8_BAR; PG8_SCHED;
            PG8_STAGE(PG8_SB(1, 1), b3 + hstep, voffB);
            PG8_WAIT_V(6); PG8_BAR; PG8_MMA(1, 1, At, B1); PG8_BAR;
        }
        PG8_STAMP();
        if constexpr (!Epi::AFTER_DRAIN) { E(acc, cur, wr, wc, fr, fq); S.done(cur); }
        PG8_STAMP();
        if (!has_next) break;
#pragma unroll
        for (int a = 0; a < 2; ++a)
#pragma unroll
            for (int b = 0; b < 2; ++b)
#pragma unroll
                for (int m = 0; m < 4; ++m)
#pragma unroll
                    for (int n = 0; n < 2; ++n) acc[a][b][m][n] = (f32x4){0.f, 0.f, 0.f, 0.f};
        cur = nxt; cA = nA; cB = nB; ++ui;
    }
    PG8_WAIT_V(0);
    if (wr == 0) PG8_BAR;
    PG8_BAR;
    if constexpr (Epi::AFTER_DRAIN) { E.fused(acc, cur, wr, wc, fr, fq, lds, wid, lane); S.done(cur); }
    PG8_STAMP();
    if (STAMP && wid == 0) { stamps[lane] = lane < nts ? (((unsigned long long)(unsigned)ts_hi << 32) | (unsigned)ts_lo) : 0ull;
        if (lane == 62) stamps[62] = rt_entry; if (lane == 63) stamps[63] = (unsigned long long)wall_clock64(); }
#undef PG8_STAMP
#undef PG8_SA
#undef PG8_SB
#undef PG8_STAGE
#undef PG8_LDA
#undef PG8_LDB
#undef PG8_MMA
#undef PG8_WAIT_V
#undef PG8_WAIT_L
#undef PG8_BAR
#undef PG8_SCHED
}
}

template <class E4> struct EpiAdapt {
    static constexpr bool PERM = true, AFTER_DRAIN = false;
    E4 e;
    __device__ __forceinline__ void operator()(const pg8::f32x4 (&acc)[2][2][4][2], const pg8::Unit& u, int wr, int wc, int fr, int fq) const {
#pragma unroll
        for (int ai = 0; ai < 2; ++ai)
#pragma unroll
            for (int m = 0; m < 4; ++m) {
                const int row = u.pm * 256 + ai * 128 + wr * 64 + m * 16 + fr;
#pragma unroll
                for (int bj = 0; bj < 2; ++bj) e(row, u.pn * 256 + bj * 128 + wc * 32 + fq * 8, acc[ai][bj][m][0], acc[ai][bj][m][1]);
                asm volatile("" ::: "memory");
            }
    }
};
template <class E4>
DI void gemm_fast(const Ctx& c, const bf16_t* A, const bf16_t* Bt, int Mg, int Ng, int Kg, const E4& e4) {
    pg8::Gemm g{A, Bt, Mg, Ng, Kg, c.tid}; pg8::StaticOrder S; S.init(Mg, Ng, (int)gridDim.x, (int)blockIdx.x);
    EpiAdapt<E4> E{e4};
    pg8::gemm_phase<EpiAdapt<E4>, pg8::StaticOrder, false>((PG8_LAS unsigned char*)c.lds, g, S, E, nullptr);
}
#ifndef FAST_GEMM
#define FAST_GEMM 1
#endif
#if FAST_GEMM
#define GEMM(c_, ...) do { MKCTX(); gemm_fast(c, __VA_ARGS__); } while (0)
#else
#define GEMM(c_, ...) do { MKCTX(); gemm_naive(c, __VA_ARGS__); } while (0)
#endif

DI void attn_mla_naive(const Params& p, const Ctx& c) {
    const bf16_t* Q = (const bf16_t*)(p.ws + OFF_Q); const bf16_t* KN = (const bf16_t*)(p.ws + OFF_KN); const bf16_t* KR = (const bf16_t*)(p.ws + OFF_KR);
    const bf16_t* VT = (const bf16_t*)(p.ws + OFF_VT); bf16_t* O = (bf16_t*)(p.ws + OFF_ATTA);
    for (int u = c.gw; u < M * 8; u += c.ngw) {
        const int m = u >> 3, hd = u & 7, b = m / SEQ, s = m % SEQ, base = b * SEQ, nkeys = ((s >> 6) + 1) << 6;
        const float q0 = bf2f(Q[(size_t)m * 1536 + hd * 192 + c.lane]), q1 = bf2f(Q[(size_t)m * 1536 + hd * 192 + 64 + c.lane]), q2 = bf2f(Q[(size_t)m * 1536 + hd * 192 + 128 + c.lane]);
        float mx = -1e30f, l = 0.f, o0 = 0.f, o1 = 0.f;
        const bf16_t* v0p = VT + (size_t)(hd * 128 + c.lane) * M + base; const bf16_t* v1p = v0p + (size_t)64 * M;
        for (int kk = 0; kk < nkeys; ++kk) {
            const size_t tk = base + kk;
            const float part = q0 * bf2f(KN[tk * 1024 + hd * 128 + c.lane]) + q1 * bf2f(KN[tk * 1024 + hd * 128 + 64 + c.lane]) + q2 * bf2f(KR[tk * 64 + c.lane]);
            const float sc = wave_sum(part);
            const float mn = fmaxf(mx, sc), al = exp2f(mx - mn), pp = exp2f(sc - mn);
            l = l * al + pp; o0 = o0 * al + pp * bf2f(v0p[kk]); o1 = o1 * al + pp * bf2f(v1p[kk]); mx = mn;
        }
        const float inv = 1.f / l;
        O[(size_t)m * 1024 + hd * 128 + c.lane] = (bf16_t)(pk2(o0 * inv, 0.f) & 0xffff);
        O[(size_t)m * 1024 + hd * 128 + 64 + c.lane] = (bf16_t)(pk2(o1 * inv, 0.f) & 0xffff);
    }
}
DI void attn_sb_naive(const Params& p, const Ctx& c) {
    const bf16_t* Q = (const bf16_t*)(p.ws + OFF_SBQ); const bf16_t* K = (const bf16_t*)(p.ws + OFF_SBK);
    const bf16_t* VT = (const bf16_t*)(p.ws + OFF_SBVT); bf16_t* O = (bf16_t*)(p.ws + OFF_ATTB);
    for (int u = c.gw; u < M * 8; u += c.ngw) {
        const int m = u >> 3, hd = u & 7, b = m / SEQ, s = m % SEQ, base = b * SEQ;
        const float q0 = bf2f(Q[(size_t)m * 1024 + hd * 128 + c.lane]), q1 = bf2f(Q[(size_t)m * 1024 + hd * 128 + 64 + c.lane]);
        float later = 0.f, o0 = 0.f, o1 = 0.f;
        const bf16_t* v0p = VT + (size_t)(hd * 128 + c.lane) * M + base; const bf16_t* v1p = v0p + (size_t)64 * M;
        for (int kk = s - 1; kk >= 0; --kk) {
            const size_t tk = base + kk;
            const float z2 = wave_sum(q0 * bf2f(K[tk * 1024 + hd * 128 + c.lane]) + q1 * bf2f(K[tk * 1024 + hd * 128 + 64 + c.lane]));
            const float ln2 = -(fmaxf(z2, 0.f) + __log2f(1.f + exp2f(-fabsf(z2))));
            const float w = exp2f(z2 + ln2 + later);
            later += ln2; o0 += w * bf2f(v0p[kk]); o1 += w * bf2f(v1p[kk]);
        }
        O[(size_t)m * 1024 + hd * 128 + c.lane] = (bf16_t)(pk2(o0, 0.f) & 0xffff);
        O[(size_t)m * 1024 + hd * 128 + 64 + c.lane] = (bf16_t)(pk2(o1, 0.f) & 0xffff);
    }
}


typedef float f32x16 __attribute__((ext_vector_type(16)));
#define MFMA32(a, b, c) __builtin_amdgcn_mfma_f32_32x32x16_bf16((a), (b), (c), 0, 0, 0)
constexpr int ST_KR = 16384, ST_VT = 24576, ST_BYTES = 40960;
constexpr int ATT_FLAGS = 2 * ST_BYTES;
DI float ex2(float x) { return __builtin_amdgcn_exp2f(x); }
DI float lg2(float x) { return __builtin_amdgcn_logf(x); }
DI bf16x8 pack8(float a0, float a1, float a2, float a3, float a4, float a5, float a6, float a7) {
    u32x4 t; t.x = pk2(a0, a1); t.y = pk2(a2, a3); t.z = pk2(a4, a5); t.w = pk2(a6, a7); return __builtin_bit_cast(bf16x8, t); }
#define GLDS16(gp, lp) __builtin_amdgcn_global_load_lds((const unsigned*)(gp), (LAS unsigned*)(lp), 16, 0, 0)

struct AttDmaOff { unsigned kn[2], kr, vt[2]; };
DI AttDmaOff att_dma_offsets(int w, int lane) {
    AttDmaOff o; const unsigned lr = lane >> 4, pp = lane & 15;
#pragma unroll
    for (int i = 0; i < 2; ++i) { const unsigned q = w * 2 + i, R = 4 * q + lr, cc = pp ^ (R & 15); o.kn[i] = R * 2048u + cc * 16u; }
    { const unsigned q = w, R2 = 4 * q + lr, cc = pp ^ (R2 & 15); o.kr = (2 * R2 + (cc >> 3)) * 128u + (cc & 7) * 16u; }
#pragma unroll
    for (int i = 0; i < 2; ++i) { const unsigned q = w * 2 + i, R2 = 4 * q + lr, cc = pp ^ (R2 & 15); o.vt[i] = (2 * R2 + (cc >> 3)) * (unsigned)(M * 2) + (cc & 7) * 16u; }
    return o;
}
template <bool ROPE>
DI void att_dma(LAS unsigned char* buf, __amdgpu_buffer_rsrc_t rs, const AttDmaOff& o, unsigned k_so, unsigned kr_so, unsigned vt_so, int w) {
#pragma unroll
    for (int i = 0; i < 2; ++i) __builtin_amdgcn_raw_ptr_buffer_load_lds(rs, (LAS void*)(buf + (w * 2 + i) * 1024), 16, o.kn[i], k_so, 0, 0);
    if (ROPE) __builtin_amdgcn_raw_ptr_buffer_load_lds(rs, (LAS void*)(buf + ST_KR + w * 1024), 16, o.kr, kr_so, 0, 0);
#pragma unroll
    for (int i = 0; i < 2; ++i) __builtin_amdgcn_raw_ptr_buffer_load_lds(rs, (LAS void*)(buf + ST_VT + (w * 2 + i) * 1024), 16, o.vt[i], vt_so, 0, 0);
}
DI void att_store(const f32x16 (&o)[4], float scale, bf16_t* O, size_t row, int hd, int h) {
#pragma unroll
    for (int db = 0; db < 4; ++db)
#pragma unroll
        for (int g = 0; g < 4; ++g)
            store_bf16x4(O + row * 1024 + hd * 128 + db * 32 + g * 8 + h * 4, (f32x4){o[db][4 * g] * scale, o[db][4 * g + 1] * scale, o[db][4 * g + 2] * scale, o[db][4 * g + 3] * scale});
}
DI void att_pv(f32x16 (&o)[4], const bf16x8 (&pf)[2][2], const LAS unsigned char* buf, unsigned va) {
#pragma unroll
    for (int db = 0; db < 4; ++db) {
#pragma unroll
        for (int blk = 0; blk < 2; ++blk)
#pragma unroll
            for (int ks = 0; ks < 2; ++ks) o[db] = MFMA32(*(const LAS bf16x8*)(buf + ((va ^ ((blk * 2 + ks) << 5)) + db * 4096)), pf[blk][ks], o[db]);
        asm volatile("" ::: "memory");
    }
}

DI void attn_mla_fast(const Params& p, const Ctx& c) {
    const bf16_t* Q = (const bf16_t*)(p.ws + OFF_Q); const bf16_t* KN = (const bf16_t*)(p.ws + OFF_KN); const bf16_t* KR = (const bf16_t*)(p.ws + OFF_KR);
    const bf16_t* VT = (const bf16_t*)(p.ws + OFF_VT); bf16_t* O = (bf16_t*)(p.ws + OFF_ATTA);
    const int lane = c.lane, r = lane & 31, h = lane >> 5, w = c.wave;
    const int pr = (r & 0x13) | ((r & 4) << 1) | ((r & 8) >> 1);
    const unsigned ka = (pr << 8) | ((((pr & 15) ^ h) & 15) << 4);
    const unsigned ra = ST_KR + (((pr >> 1) << 8) | (((((pr & 1) << 3) | h) ^ ((pr >> 1) & 15)) << 4));
    const unsigned va = ST_VT + (((r >> 1) << 8) | (((((r & 1) << 3) | h) ^ ((r >> 1) & 15)) << 4));
    const __amdgpu_buffer_rsrc_t rs = __builtin_amdgcn_make_buffer_rsrc((void*)p.ws, (short)0, (int)WS_END, 0x00020000);
    const AttDmaOff dof = att_dma_offsets(w, lane);
    for (int it = blockIdx.x; it < 256; it += gridDim.x) {
        const int bh = it & 31, b = bh >> 3, hd = bh & 7, pairi = it >> 5;
#pragma unroll 1
        for (int half = 0; half < 2; ++half) {
            const int qb = half ? 15 - pairi : pairi, q0 = qb * 256;
            const size_t base = (size_t)b * SEQ, qrow = base + q0 + w * 32 + r;
            bf16x8 qf[12];
#pragma unroll
            for (int st = 0; st < 12; ++st) qf[st] = *(const bf16x8*)(Q + qrow * 1536 + hd * 192 + st * 16 + h * 8);
            const int ntile = q0 / 64 + 4, myn = (q0 + w * 32) / 64 + 1;
            f32x16 o[4];
#pragma unroll
            for (int db = 0; db < 4; ++db)
#pragma unroll
                for (int i = 0; i < 16; ++i) o[db][i] = 0.f;
            float mrun = -1e30f, lrun = 0.f;
            __syncthreads();
            const unsigned k_so0 = (unsigned)(OFF_KN + (base * 1024 + hd * 128) * 2), kr_so0 = (unsigned)(OFF_KR + base * 64 * 2), vt_so0 = (unsigned)(OFF_VT + ((size_t)(hd * 128) * M + base) * 2);
            att_dma<true>(c.lds, rs, dof, k_so0, kr_so0, vt_so0, w);
            asm volatile("s_waitcnt vmcnt(0)" ::: "memory");
            __syncthreads();
            for (int j = 0; j < ntile; ++j) {
                LAS unsigned char* buf = c.lds + (j & 1) * ST_BYTES;
                if (j + 1 < ntile) att_dma<true>(c.lds + ((j + 1) & 1) * ST_BYTES, rs, dof, k_so0 + (unsigned)(j + 1) * (64 * 2048), kr_so0 + (unsigned)(j + 1) * (64 * 128), vt_so0 + (unsigned)(j + 1) * 128, w);
                if (j < myn) {
                    f32x16 s0, s1;
#pragma unroll
                    for (int i = 0; i < 16; ++i) { s0[i] = 0.f; s1[i] = 0.f; }
                    __builtin_amdgcn_s_setprio(1);
#pragma unroll
                    for (int st = 0; st < 8; ++st) {
                        s0 = MFMA32(*(const LAS bf16x8*)(buf + (ka ^ (st << 5))), qf[st], s0);
                        s1 = MFMA32(*(const LAS bf16x8*)(buf + ((ka ^ (st << 5)) + 8192)), qf[st], s1);
                    }
#pragma unroll
                    for (int st = 0; st < 4; ++st) {
                        s0 = MFMA32(*(const LAS bf16x8*)(buf + (ra ^ (st << 5))), qf[8 + st], s0);
                        s1 = MFMA32(*(const LAS bf16x8*)(buf + ((ra ^ (st << 5)) + 4096)), qf[8 + st], s1);
                    }
                    __builtin_amdgcn_s_setprio(0);
                    float mx = fmaxf(s0[0], s1[0]);
#pragma unroll
                    for (int i = 1; i < 16; ++i) mx = fmaxf(mx, fmaxf(s0[i], s1[i]));
                    mx = fmaxf(mx, __shfl_xor(mx, 32));
                    const float mnew = fmaxf(mrun, mx), alpha = ex2(mrun - mnew);
                    mrun = mnew;
                    float ps = 0.f;
#pragma unroll
                    for (int i = 0; i < 16; ++i) { s0[i] = ex2(s0[i] - mnew); s1[i] = ex2(s1[i] - mnew); ps += s0[i] + s1[i]; }
                    lrun = lrun * alpha + ps;
#pragma unroll
                    for (int db = 0; db < 4; ++db)
#pragma unroll
                        for (int i = 0; i < 16; ++i) o[db][i] *= alpha;
                    bf16x8 pf[2][2];
                    pf[0][0] = pack8(s0[0], s0[1], s0[2], s0[3], s0[4], s0[5], s0[6], s0[7]); pf[0][1] = pack8(s0[8], s0[9], s0[10], s0[11], s0[12], s0[13], s0[14], s0[15]);
                    pf[1][0] = pack8(s1[0], s1[1], s1[2], s1[3], s1[4], s1[5], s1[6], s1[7]); pf[1][1] = pack8(s1[8], s1[9], s1[10], s1[11], s1[12], s1[13], s1[14], s1[15]);
                    __builtin_amdgcn_s_setprio(1);
                    att_pv(o, pf, buf, va);
                    __builtin_amdgcn_s_setprio(0);
                }
                asm volatile("s_waitcnt vmcnt(0)" ::: "memory");
                __syncthreads();
            }
            const float ltot = lrun + __shfl_xor(lrun, 32);
            att_store(o, 1.f / ltot, O, qrow, hd, h);
        }
    }
}

DI void attn_sb_fast(const Params& p, const Ctx& c) {
    const bf16_t* Q = (const bf16_t*)(p.ws + OFF_SBQ); const bf16_t* K = (const bf16_t*)(p.ws + OFF_SBK);
    const bf16_t* VT = (const bf16_t*)(p.ws + OFF_SBVT); bf16_t* O = (bf16_t*)(p.ws + OFF_ATTB);
    const int lane = c.lane, r = lane & 31, h = lane >> 5, w = c.wave, tid = c.tid;
    const int pr = (r & 0x13) | ((r & 4) << 1) | ((r & 8) >> 1);
    const unsigned ka = (pr << 8) | ((((pr & 15) ^ h) & 15) << 4);
    const unsigned va = ST_VT + (((r >> 1) << 8) | (((((r & 1) << 3) | h) ^ ((r >> 1) & 15)) << 4));
    const __amdgpu_buffer_rsrc_t rs = __builtin_amdgcn_make_buffer_rsrc((void*)p.ws, (short)0, (int)WS_END, 0x00020000);
    const AttDmaOff dof = att_dma_offsets(w, lane);
    LAS int* flags = (LAS int*)(c.lds + ATT_FLAGS);
    for (int it = blockIdx.x; it < 256; it += gridDim.x) {
        const int bh = it & 31, b = bh >> 3, hd = bh & 7, pairi = it >> 5;
#pragma unroll 1
        for (int half = 0; half < 2; ++half) {
            const int qb = half ? 15 - pairi : pairi, q0 = qb * 256;
            const size_t base = (size_t)b * SEQ, qrow = base + q0 + w * 32 + r;
            const int tq = q0 + w * 32 + r;
            bf16x8 qf[8];
#pragma unroll
            for (int st = 0; st < 8; ++st) qf[st] = *(const bf16x8*)(Q + qrow * 1024 + hd * 128 + st * 16 + h * 8);
            const int jmax = q0 / 64 + 3, jd = (q0 + w * 32) / 64;
            f32x16 o[4];
#pragma unroll
            for (int db = 0; db < 4; ++db)
#pragma unroll
                for (int i = 0; i < 16; ++i) o[db][i] = 0.f;
            float carry = 0.f; bool wdone = false;
            __syncthreads();
            const unsigned k_so0 = (unsigned)(OFF_SBK + (base * 1024 + hd * 128) * 2), vt_so0 = (unsigned)(OFF_SBVT + ((size_t)(hd * 128) * M + base) * 2);
            att_dma<false>(c.lds, rs, dof, k_so0 + (unsigned)jmax * (64 * 2048), 0u, vt_so0 + (unsigned)jmax * 128, w);
            if (tid < 16) flags[tid] = 0;
            asm volatile("s_waitcnt vmcnt(0)" ::: "memory");
            __syncthreads();
            int itn = 0;
            for (int j = jmax; j >= 0; --j, ++itn) {
                LAS unsigned char* buf = c.lds + (itn & 1) * ST_BYTES;
                if (j > 0) att_dma<false>(c.lds + ((itn + 1) & 1) * ST_BYTES, rs, dof, k_so0 + (unsigned)(j - 1) * (64 * 2048), 0u, vt_so0 + (unsigned)(j - 1) * 128, w);
                if (j <= jd && !wdone) {
                    f32x16 s0, s1;
#pragma unroll
                    for (int i = 0; i < 16; ++i) { s0[i] = 0.f; s1[i] = 0.f; }
#pragma unroll
                    for (int st = 0; st < 8; ++st) {
                        s0 = MFMA32(*(const LAS bf16x8*)(buf + (ka ^ (st << 5))), qf[st], s0);
                        s1 = MFMA32(*(const LAS bf16x8*)(buf + ((ka ^ (st << 5)) + 8192)), qf[st], s1);
                    }
                    const int kb0 = 64 * j + 8 * h - tq;
                    bf16x8 pf[2][2];
                    {
                        f32x16 l1;
#pragma unroll
                        for (int i = 0; i < 16; ++i) { const float z = s1[i]; const float a = -(fmaxf(z, 0.f) + lg2(1.f + ex2(-fabsf(z)))); l1[i] = (kb0 + 32 + 16 * (i >> 3) + (i & 7) < 0) ? a : 0.f; }
                        float g0 = 0.f, g1 = 0.f;
#pragma unroll
                        for (int e = 0; e < 8; ++e) { g0 += l1[e]; g1 += l1[8 + e]; }
                        const float p0 = __shfl_xor(g0, 32), p1 = __shfl_xor(g1, 32);
                        float run = carry + (h == 0 ? p1 : 0.f);
#pragma unroll
                        for (int e = 7; e >= 0; --e) { run += l1[8 + e]; l1[8 + e] = run; }
                        run = carry + (g1 + p1) + (h == 0 ? p0 : 0.f);
#pragma unroll
                        for (int e = 7; e >= 0; --e) { run += l1[e]; l1[e] = run; }
                        carry += (g1 + p1) + (g0 + p0);
#pragma unroll
                        for (int i = 0; i < 16; ++i) { const float wv = ex2(s1[i] + l1[i]); s1[i] = (kb0 + 32 + 16 * (i >> 3) + (i & 7) < 0) ? wv : 0.f; }
                        pf[1][0] = pack8(s1[0], s1[1], s1[2], s1[3], s1[4], s1[5], s1[6], s1[7]); pf[1][1] = pack8(s1[8], s1[9], s1[10], s1[11], s1[12], s1[13], s1[14], s1[15]);
                    }
                    {
                        f32x16 l0;
#pragma unroll
                        for (int i = 0; i < 16; ++i) { const float z = s0[i]; const float a = -(fmaxf(z, 0.f) + lg2(1.f + ex2(-fabsf(z)))); l0[i] = (kb0 + 16 * (i >> 3) + (i & 7) < 0) ? a : 0.f; }
                        float g0 = 0.f, g1 = 0.f;
#pragma unroll
                        for (int e = 0; e < 8; ++e) { g0 += l0[e]; g1 += l0[8 + e]; }
                        const float p0 = __shfl_xor(g0, 32), p1 = __shfl_xor(g1, 32);
                        float run = carry + (h == 0 ? p1 : 0.f);
#pragma unroll
                        for (int e = 7; e >= 0; --e) { run += l0[8 + e]; l0[8 + e] = run; }
                        run = carry + (g1 + p1) + (h == 0 ? p0 : 0.f);
#pragma unroll
                        for (int e = 7; e >= 0; --e) { run += l0[e]; l0[e] = run; }
                        carry += (g1 + p1) + (g0 + p0);
#pragma unroll
                        for (int i = 0; i < 16; ++i) { const float wv = ex2(s0[i] + l0[i]); s0[i] = (kb0 + 16 * (i >> 3) + (i & 7) < 0) ? wv : 0.f; }
                        pf[0][0] = pack8(s0[0], s0[1], s0[2], s0[3], s0[4], s0[5], s0[6], s0[7]); pf[0][1] = pack8(s0[8], s0[9], s0[10], s0[11], s0[12], s0[13], s0[14], s0[15]);
                    }
                    att_pv(o, pf, buf, va);
                    wdone = __all(carry < -150.f);
                }
                if (lane == 0) flags[(itn & 1) * 8 + w] = wdone ? 1 : 0;
                asm volatile("s_waitcnt vmcnt(0)" ::: "memory");
                __syncthreads();
                int alld = 1;
#pragma unroll
                for (int q = 0; q < 8; ++q) alld &= flags[(itn & 1) * 8 + q];
                if (alld) break;
            }
            att_store(o, 1.f, O, qrow, hd, h);
        }
    }
}
#ifndef FAST_ATTN
#define FAST_ATTN 1
#endif

constexpr int SEL_LD = 260;
DI void topk_insert(float (&a)[16], float x) {
#pragma unroll
    for (int i = 15; i >= 1; --i) a[i] = __builtin_amdgcn_fmed3f(a[i - 1], a[i], x);
    a[0] = fmaxf(a[0], x);
}
struct SelMap { int mode, a0, a1, a2, a3; };
DI void sel_decode(const SelMap& mp, int q, int& t0, int& hd) {
    if (mp.mode == 0) { int u = mp.a0 + q * mp.a1; if (u >= 128 * 8) u = mp.a0; hd = u & 7; t0 = (u >> 3) * 128; }
    else { const int pm = (q >> 1) ? mp.a2 : mp.a0, pn = (q >> 1) ? mp.a3 : mp.a1; hd = pn; t0 = pm * 256 + (q & 1) * 128; }
}
template <int NU> DI void select_stage2(const Params& p, const Ctx& c, const SelMap mp, const LAS float* lst_all) {
    if (c.tid < 128 * NU) {
        const int tok = c.tid & 127, un = c.tid >> 7;
        int t0, hd; sel_decode(mp, un, t0, hd);
        const LAS float* lst = lst_all + un * 4096;
        float v1[16], v2[16];
#pragma unroll
        for (int i = 0; i < 16; ++i) { v1[i] = __uint_as_float(__float_as_uint(lst[(tok * 2) * 16 + i]) & ~127u); v2[i] = __uint_as_float(__float_as_uint(lst[(tok * 2 + 1) * 16 + i]) & ~127u); }
        float bb[16];
#pragma unroll
        for (int i = 0; i < 16; ++i) bb[i] = -__builtin_inff();
#pragma unroll
        for (int i = 0; i < 16; ++i)
#pragma unroll
            for (int j = 0; j < 16; ++j)
                if ((i + 1) * (j + 1) <= 16) topk_insert(bb, __uint_as_float((__float_as_uint(v1[i] + v2[j]) & ~255u) | (unsigned)(i * 16 + j)));
        float sv[16], mxv = -__builtin_inff(), sum = 0.f;
#pragma unroll
        for (int i = 0; i < 16; ++i) { sv[i] = __uint_as_float(__float_as_uint(bb[i]) & ~255u); mxv = fmaxf(mxv, sv[i]); }
#pragma unroll
        for (int i = 0; i < 16; ++i) { sv[i] = __expf(sv[i] - mxv); sum += sv[i]; }
        const float inv = 1.f / sum;
        int* idx = (int*)(p.ws + OFF_IDX) + (size_t)(t0 + tok) * 128 + hd * 16; float* gw = (float*)(p.ws + OFF_GW) + (size_t)(t0 + tok) * 128 + hd * 16;
#pragma unroll
        for (int i = 0; i < 16; ++i) {
            const unsigned code = __float_as_uint(bb[i]) & 255u;
            const unsigned e1 = __float_as_uint(lst[(tok * 2) * 16 + (code >> 4)]) & 127u, e2 = __float_as_uint(lst[(tok * 2 + 1) * 16 + (code & 15u)]) & 127u;
            idx[i] = (int)(e1 * 128u + e2); gw[i] = sv[i] * inv;
        }
    }
    __syncthreads();
}
DI void select_tail(const Params& p, const Ctx& c, int t0, int hd) {
    LAS float* sc = (LAS float*)c.lds; LAS float* lst = sc + 128 * SEL_LD;
    if (c.tid < 256) {
        const int tok = c.tid >> 1, hf = c.tid & 1;
        float a[16];
#pragma unroll
        for (int i = 0; i < 16; ++i) a[i] = -__builtin_inff();
        const LAS float* row = sc + tok * SEL_LD + hf * 128;
#pragma unroll 4
        for (int n4 = 0; n4 < 32; ++n4) {
            const f32x4 v = *(const LAS f32x4*)(row + n4 * 4);
#pragma unroll
            for (int e = 0; e < 4; ++e) topk_insert(a, __uint_as_float((__float_as_uint(v[e]) & ~127u) | (unsigned)(n4 * 4 + e)));
        }
#pragma unroll
        for (int i = 0; i < 16; ++i) lst[(tok * 2 + hf) * 16 + i] = a[i];
    }
    __syncthreads();
    select_stage2<1>(p, c, SelMap{0, ((t0 >> 7) << 3) | hd, 0, 0, 0}, lst);
}
DI void select_naive(const Params& p, const Ctx& c) {
    const bf16_t* PQ = (const bf16_t*)(p.ws + OFF_PQ); const bf16_t* KEYS = (const bf16_t*)(p.ws + OFF_KEYS);
    LAS float* sc = (LAS float*)c.lds;
    for (int u = blockIdx.x; u < 128 * 8; u += gridDim.x) {
        const int hd = u & 7, t0 = (u >> 3) * 128;
        const int tok = c.tid >> 2, part = c.tid & 3, hf = part >> 1, n0 = (part & 1) * 64;
        const bf16_t* qrow = PQ + (size_t)hd * M * 256 + (size_t)(t0 + tok) * 256 + hf * 128;
        const bf16_t* kb = KEYS + (size_t)((hd * 2 + hf) * 128 + n0) * 128;
        for (int n = 0; n < 64; ++n) {
            float acc = 0.f;
#pragma unroll
            for (int d8 = 0; d8 < 16; ++d8) {
                const u32x4 a = *(const u32x4*)(qrow + d8 * 8), b = *(const u32x4*)(kb + (size_t)n * 128 + d8 * 8);
#pragma unroll
                for (int e = 0; e < 4; ++e) acc += bflo(a[e]) * bflo(b[e]) + bfhi(a[e]) * bfhi(b[e]);
            }
            sc[tok * SEL_LD + hf * 128 + n0 + n] = acc;
        }
        __syncthreads();
        select_tail(p, c, t0, hd);
    }
}


DI void select_batch(const Params& p, const Ctx& c, const SelMap mp) {
    const bf16_t* PQ = (const bf16_t*)(p.ws + OFF_PQ); const bf16_t* KEYS = (const bf16_t*)(p.ws + OFF_KEYS);
    LAS float* lst_all = (LAS float*)c.lds;
    const int lane = c.lane, r = lane & 31, h = lane >> 5, w = c.wave, tb = w & 3, hf = w >> 2;
#pragma unroll
    for (int q = 0; q < 4; ++q) {
        int t0, hd; sel_decode(mp, q, t0, hd);
        LAS float* lst = lst_all + q * 4096;
        const bf16_t* qrow = PQ + (size_t)hd * M * 256 + (size_t)(t0 + tb * 32 + r) * 256 + hf * 128 + h * 8;
        const bf16_t* kbase = KEYS + (size_t)((hd * 2 + hf) * 128 + r) * 128 + h * 8;
        bf16x8 qf[8];
#pragma unroll
        for (int st = 0; st < 8; ++st) qf[st] = *(const bf16x8*)(qrow + st * 16);
        float a[16];
#pragma unroll
        for (int i = 0; i < 16; ++i) a[i] = -__builtin_inff();
#pragma unroll
        for (int kb = 0; kb < 4; ++kb) {
            f32x16 sc;
#pragma unroll
            for (int i = 0; i < 16; ++i) sc[i] = 0.f;
#pragma unroll
            for (int st = 0; st < 8; ++st) sc = MFMA32(*(const bf16x8*)(kbase + (size_t)kb * 32 * 128 + st * 16), qf[st], sc);
#pragma unroll
            for (int i = 0; i < 16; ++i) topk_insert(a, __uint_as_float((__float_as_uint(sc[i]) & ~127u) | (unsigned)(kb * 32 + (i & 3) + 8 * (i >> 2) + 4 * h)));
        }
        float bq[16];
#pragma unroll
        for (int i = 0; i < 16; ++i) bq[i] = __shfl_xor(a[i], 32);
#pragma unroll
        for (int i = 0; i < 16; ++i) topk_insert(a, bq[i]);
        if (h == 0) {
#pragma unroll
            for (int i = 0; i < 16; ++i) lst[((tb * 32 + r) * 2 + hf) * 16 + i] = a[i];
        }
    }
    __syncthreads();
    select_stage2<4>(p, c, mp, lst_all);
}
DI void select_fast(const Params& p, const Ctx& c) {
    for (int u0 = blockIdx.x; u0 < 128 * 8; u0 += 4 * gridDim.x) select_batch(p, c, SelMap{0, u0, (int)gridDim.x, 0, 0});
}
DI void select_own_tiles(const Params& p, const Ctx& c) {
    pg8::StaticOrder S; S.init(M, 2048, (int)gridDim.x, (int)blockIdx.x);
    asm volatile("s_waitcnt vmcnt(0)" ::: "memory");
    __syncthreads();
    for (int i = 0;; i += 2) {
        pg8::Unit u0, u1;
        if (!S.next(i, u0)) break;
        if (!S.next(i + 1, u1)) u1 = u0;
        select_batch(p, c, SelMap{1, u0.pm, u0.pn, u1.pm, u1.pn});
    }
}
#ifndef FAST_SEL
#define FAST_SEL 1
#endif

DI void phase_gather(const Params& p, const Ctx& c, float* dst, int rowmask = -1) {
    const bf16_t* H2 = (const bf16_t*)(p.ws + OFF_H); const unsigned char* U = p.ws + OFF_U16; const unsigned char* V = p.ws + OFF_V16;
    const int* IDX = (const int*)(p.ws + OFF_IDX); const float* GW = (const float*)(p.ws + OFF_GW); const float* mod = (const float*)(p.ws + OFF_MOD);
    constexpr int G = 8, GV = 16;
    const int lane = c.lane;
    unsigned* tokctr = (unsigned*)(p.ws + OFF_CTL) + 700;
    constexpr int NSTATIC = 6;
    for (int it = 0;; ++it) {
        int m;
        if (GATHER_DYN == 0) { m = c.gw + it * c.ngw; if (m >= M) break; }
        else if (it < NSTATIC) { m = c.gw + it * c.ngw; if (m >= M) break; }
        else { unsigned t = 0; if (lane == 0) t = __hip_atomic_fetch_add(tokctr, 1u, __ATOMIC_RELAXED, __HIP_MEMORY_SCOPE_AGENT); m = NSTATIC * c.ngw + (int)__builtin_amdgcn_readfirstlane(t); if (m >= M) break; }
        const int b = m / SEQ;
        f32x2 hf[16];
#pragma unroll
        for (int i = 0; i < 4; ++i) { const u32x4 a = *(const u32x4*)(H2 + (size_t)m * D + lane * 32 + i * 8);
#pragma unroll
            for (int q = 0; q < 4; ++q) hf[4 * i + q] = (f32x2){bflo(a[q]), bfhi(a[q])}; }
        const int ia = IDX[(size_t)m * 128 + lane], ib = IDX[(size_t)m * 128 + 64 + lane];
        const float ga = GW[(size_t)m * 128 + lane], gb = GW[(size_t)m * 128 + 64 + lane];
        float wa = 0.f, wb = 0.f;
#pragma unroll 1
        for (int k0 = 0; k0 < 128; k0 += G) {
            u32x4 ua[G]; u32x2 ub[G];
#pragma unroll
            for (int g = 0; g < G; ++g) {
                const int e = __builtin_amdgcn_readlane(k0 < 64 ? ia : ib, (k0 + g) & 63) & rowmask;
                const unsigned char* ur = U + (size_t)e * 1536;
                ua[g] = *(const u32x4*)(ur + (unsigned)lane * 16u); ub[g] = *(const u32x2*)(ur + 1024u + (unsigned)lane * 8u);
            }
            float d[G];
#pragma unroll
            for (int g = 0; g < G; ++g) {
                const f32x32v f = __builtin_amdgcn_cvt_scalef32_pk32_f32_fp6((u32x6){ua[g][0], ua[g][1], ua[g][2], ua[g][3], ub[g][0], ub[g][1]}, 1.0f);
                f32x2 d2 = {0.f, 0.f};
#pragma unroll
                for (int i = 0; i < 16; ++i) d2 = (f32x2){f[2 * i], f[2 * i + 1]} * hf[i] + d2;
                d[g] = d2.x + d2.y;
            }
            { const bool u5 = lane & 32, u4 = lane & 16, u3 = lane & 8;
              float r4[4];
#pragma unroll
              for (int i = 0; i < 4; ++i) { const float send = u5 ? d[i] : d[4 + i], keep = u5 ? d[4 + i] : d[i]; r4[i] = keep + __shfl_xor(send, 32); }
              float r2[2];
#pragma unroll
              for (int i = 0; i < 2; ++i) { const float send = u4 ? r4[i] : r4[2 + i], keep = u4 ? r4[2 + i] : r4[i]; r2[i] = keep + __shfl_xor(send, 16); }
              const float send = u3 ? r2[0] : r2[1], keep = u3 ? r2[1] : r2[0];
              float r1 = keep + __shfl_xor(send, 8);
              r1 += __shfl_xor(r1, 4); r1 += __shfl_xor(r1, 2); r1 += __shfl_xor(r1, 1);
              const float act = gelu_tanh(r1 * (1.f / U8_SCALE)) * (1.f / V8_SCALE);
              const int gsel = lane - (k0 & 63);
              const int src = ((gsel & 4) << 3) | ((gsel & 2) << 3) | ((gsel & 1) << 3);
              const float got = __shfl(act, src & 63);
              if (gsel >= 0 && gsel < G) { if (k0 < 64) wa = got * ga; else wb = got * gb; }
            }
        }
        f32x2 acc[16];
#pragma unroll
        for (int i = 0; i < 16; ++i) acc[i] = (f32x2){0.f, 0.f};
#define VB_ISSUE(P, K0) do { _Pragma("unroll") for (int g = 0; g < 8; ++g) { \
            const int e = __builtin_amdgcn_readlane((K0) < 64 ? ia : ib, ((K0) + g) & 63) & rowmask; \
            P##w[g] = __builtin_bit_cast(float, __builtin_amdgcn_readlane(__builtin_bit_cast(int, (K0) < 64 ? wa : wb), ((K0) + g) & 63)); \
            const unsigned char* vr = V + (size_t)e * 1536; \
            P##a[g] = *(const u32x4*)(vr + (unsigned)lane * 16u); P##b[g] = *(const u32x2*)(vr + 1024u + (unsigned)lane * 8u); } } while (0)
#define VB_COMPUTE(P) do { _Pragma("unroll") for (int g = 0; g < 8; ++g) { const f32x2 w2 = {P##w[g], P##w[g]}; \
            const f32x32v f = __builtin_amdgcn_cvt_scalef32_pk32_f32_fp6((u32x6){P##a[g][0], P##a[g][1], P##a[g][2], P##a[g][3], P##b[g][0], P##b[g][1]}, 1.0f); \
            _Pragma("unroll") for (int i = 0; i < 16; ++i) acc[i] = (f32x2){f[2 * i], f[2 * i + 1]} * w2 + acc[i]; } } while (0)
        {
            u32x4 A_a[8], B_a[8]; u32x2 A_b[8], B_b[8]; float A_w[8], B_w[8];
            VB_ISSUE(A_, 0);
#pragma unroll 1
            for (int k0 = 0; k0 < 128; k0 += 16) {
                VB_ISSUE(B_, k0 + 8);
                VB_COMPUTE(A_);
                if (k0 + 16 < 128) VB_ISSUE(A_, k0 + 16);
                VB_COMPUTE(B_);
            }
        }
#undef VB_ISSUE
#undef VB_COMPUTE
        const float* orow = p.out + (size_t)m * D + lane * 32; float* drow = dst + (size_t)m * D + lane * 32; const float* gt2 = mod + b * 6 * D + 5 * D + lane * 32; const float* fg = p.fng + lane * 32;
        float ss = 0.f; f32x4 xv[8];
#pragma unroll
        for (int i = 0; i < 8; ++i) {
            const f32x4 xa = *(const f32x4*)(orow + 4 * i), ta = *(const f32x4*)(gt2 + 4 * i);
            const f32x4 pe = {acc[2 * i].x, acc[2 * i].y, acc[2 * i + 1].x, acc[2 * i + 1].y};
            const f32x4 v = xa + DBG_BETA * ta * pe; xv[i] = v; ss += (v[0] * v[0] + v[1] * v[1]) + (v[2] * v[2] + v[3] * v[3]);
        }
        const float rstd = rsqrtf(wave_sum(ss) * (1.f / D) + EPS);
#pragma unroll
        for (int i = 0; i < 8; ++i) *(f32x4*)(drow + 4 * i) = xv[i] * rstd * *(const f32x4*)(fg + 4 * i);
    }
}


struct XcdBarrier; DI void xcd_barrier(const XcdBarrier& b, int wave_s);
DI int rl2r(int a, int b, int k) { const int va = __builtin_amdgcn_readlane(a, k & 63), vb = __builtin_amdgcn_readlane(b, k & 63); return k < 64 ? va : vb; }
DI void phase_gather_rounds(const Params& p, const Ctx& c, const XcdBarrier& xbar) {
    const bf16_t* H2 = (const bf16_t*)(p.ws + OFF_H); const unsigned char* U = p.ws + OFF_U16; const unsigned char* V = p.ws + OFF_V16;
    const int* IDX = (const int*)(p.ws + OFF_IDX); const float* GW = (const float*)(p.ws + OFF_GW); const float* mod = (const float*)(p.ws + OFF_MOD);
    const int lane = c.lane;
    LAS unsigned char* wl = c.lds + c.wave * 20480;
    const bool u5 = lane & 32, u4 = lane & 16, u3 = lane & 8;
    constexpr int G = 8;
#pragma unroll 1
    for (int pass = 0; pass < 2; ++pass) {
#pragma unroll
        for (int t = 0; t < 4; ++t) {
            const int m = c.gw + (pass * 4 + t) * c.ngw;
            LAS unsigned char* ts = wl + t * 5120;
            if (m < M) {
#pragma unroll
                for (int i = 0; i < 4; ++i) *(LAS u32x4*)(ts + lane * 64 + i * 16) = *(const u32x4*)(H2 + (size_t)m * D + lane * 32 + i * 8);
                *(LAS int*)(ts + 4096 + lane * 4) = IDX[(size_t)m * 128 + lane]; *(LAS int*)(ts + 4096 + 256 + lane * 4) = IDX[(size_t)m * 128 + 64 + lane];
                *(LAS float*)(ts + 4608 + lane * 4) = GW[(size_t)m * 128 + lane]; *(LAS float*)(ts + 4608 + 256 + lane * 4) = GW[(size_t)m * 128 + 64 + lane];
            }
        }
        asm volatile("s_waitcnt vmcnt(0) lgkmcnt(0)" ::: "memory");
#pragma unroll 1
        for (int r = 0; r < 8; ++r) {
#pragma unroll 1
            for (int t = 0; t < 4; ++t) {
                if (c.gw + (pass * 4 + t) * c.ngw >= M) continue;
                LAS unsigned char* ts = wl + t * 5120;
                const int ia = *(LAS int*)(ts + 4096 + lane * 4), ib = *(LAS int*)(ts + 4096 + 256 + lane * 4);
                unsigned long long ma = __ballot((ia >> 11) == r), mb = __ballot((ib >> 11) == r);
                if (!(ma | mb)) continue;
                f32x2 hf[16];
#pragma unroll
                for (int i = 0; i < 4; ++i) { const u32x4 a = *(LAS u32x4*)(ts + lane * 64 + i * 16);
#pragma unroll
                    for (int q = 0; q < 4; ++q) hf[4 * i + q] = (f32x2){bflo(a[q]), bfhi(a[q])}; }
                float wa = 0.f, wb = 0.f; const unsigned long long ma0 = ma, mb0 = mb;
                while (ma | mb) {
                    u32x4 ua[G]; u32x2 ub[G]; int kk[G]; int n = 0;
#pragma unroll
                    for (int g = 0; g < G; ++g) {
                        int k = (g == 0) ? 0 : kk[g - 1];
                        if (ma) { k = __builtin_ctzll(ma); ma &= ma - 1; ++n; } else if (mb) { k = 64 + __builtin_ctzll(mb); mb &= mb - 1; ++n; }
                        kk[g] = k;
                        const int e = rl2r(ia, ib, k);
                        const unsigned char* ur = U + (size_t)e * 1536;
                        ua[g] = *(const u32x4*)(ur + (unsigned)lane * 16u); ub[g] = *(const u32x2*)(ur + 1024u + (unsigned)lane * 8u);
                    }
                    float d[G];
#pragma unroll
                    for (int g = 0; g < G; ++g) {
                        d[g] = 0.f;
                        if (g < n) {
                            const f32x32v f = __builtin_amdgcn_cvt_scalef32_pk32_f32_fp6((u32x6){ua[g][0], ua[g][1], ua[g][2], ua[g][3], ub[g][0], ub[g][1]}, 1.0f);
                            f32x2 d0 = {0.f, 0.f}, d1 = {0.f, 0.f};
#pragma unroll
                            for (int i = 0; i < 8; ++i) { d0 = (f32x2){f[4 * i], f[4 * i + 1]} * hf[2 * i] + d0; d1 = (f32x2){f[4 * i + 2], f[4 * i + 3]} * hf[2 * i + 1] + d1; }
                            d[g] = (d0.x + d0.y) + (d1.x + d1.y);
                        }
                    }
                    float r4[4];
#pragma unroll
                    for (int i = 0; i < 4; ++i) { const float send = u5 ? d[i] : d[4 + i], keep = u5 ? d[4 + i] : d[i]; r4[i] = keep + __shfl_xor(send, 32); }
                    float r2[2];
#pragma unroll
                    for (int i = 0; i < 2; ++i) { const float send = u4 ? r4[i] : r4[2 + i], keep = u4 ? r4[2 + i] : r4[i]; r2[i] = keep + __shfl_xor(send, 16); }
                    const float send = u3 ? r2[0] : r2[1], keep = u3 ? r2[1] : r2[0];
                    float r1 = keep + __shfl_xor(send, 8);
                    r1 += __shfl_xor(r1, 4); r1 += __shfl_xor(r1, 2); r1 += __shfl_xor(r1, 1);
                    const float act = gelu_tanh(r1 * (1.f / U8_SCALE)) * (1.f / V8_SCALE);
#pragma unroll
                    for (int g = 0; g < G; ++g) if (g < n) {
                        const float av = __builtin_bit_cast(float, __builtin_amdgcn_readlane(__builtin_bit_cast(int, act), ((g & 4) << 3) | ((g & 2) << 3) | ((g & 1) << 3)));
                        const int k = kk[g];
                        if (k < 64) { if (lane == k) wa = av; } else { if (lane == k - 64) wb = av; }
                    }
                }
                if ((ma0 >> lane) & 1ull) { LAS float* gp = (LAS float*)(ts + 4608 + lane * 4); *gp = *gp * wa; }
                if ((mb0 >> lane) & 1ull) { LAS float* gp = (LAS float*)(ts + 4608 + 256 + lane * 4); *gp = *gp * wb; }
            }
            if (DBG_ROUND_BAR) xcd_barrier(xbar, c.wave);
        }
        asm volatile("s_waitcnt lgkmcnt(0)" ::: "memory");
#pragma unroll 1
        for (int t = 0; t < 4; ++t) {
            const int m = c.gw + (pass * 4 + t) * c.ngw;
            if (m >= M) continue;
            const int b = m / SEQ;
            LAS unsigned char* ts = wl + t * 5120;
            const int ia = *(LAS int*)(ts + 4096 + lane * 4), ib = *(LAS int*)(ts + 4096 + 256 + lane * 4);
            const float wa = *(LAS float*)(ts + 4608 + lane * 4), wb = *(LAS float*)(ts + 4608 + 256 + lane * 4);
            f32x2 acc[16];
#pragma unroll
            for (int i = 0; i < 16; ++i) acc[i] = (f32x2){0.f, 0.f};
#pragma unroll 1
            for (int k0 = 0; k0 < 128; k0 += G) {
                u32x4 va[G]; u32x2 vb[G]; float wk[G];
#pragma unroll
                for (int g = 0; g < G; ++g) {
                    const int e = __builtin_amdgcn_readlane(k0 < 64 ? ia : ib, (k0 + g) & 63);
                    wk[g] = __builtin_bit_cast(float, __builtin_amdgcn_readlane(__builtin_bit_cast(int, k0 < 64 ? wa : wb), (k0 + g) & 63));
                    const unsigned char* vr = V + (size_t)e * 1536;
                    va[g] = *(const u32x4*)(vr + (unsigned)lane * 16u); vb[g] = *(const u32x2*)(vr + 1024u + (unsigned)lane * 8u);
                }
#pragma unroll
                for (int g = 0; g < G; ++g) { const f32x2 w2 = {wk[g], wk[g]};
                    const f32x32v f = __builtin_amdgcn_cvt_scalef32_pk32_f32_fp6((u32x6){va[g][0], va[g][1], va[g][2], va[g][3], vb[g][0], vb[g][1]}, 1.0f);
#pragma unroll
                    for (int i = 0; i < 16; ++i) acc[i] = (f32x2){f[2 * i], f[2 * i + 1]} * w2 + acc[i]; }
            }
            float* orow = p.out + (size_t)m * D + lane * 32; const float* gt2 = mod + b * 6 * D + 5 * D + lane * 32; const float* fg = p.fng + lane * 32;
            float ss = 0.f; f32x4 xv[8];
#pragma unroll
            for (int i = 0; i < 8; ++i) {
                const f32x4 xa = *(const f32x4*)(orow + 4 * i), ta = *(const f32x4*)(gt2 + 4 * i);
                const f32x4 pe = {acc[2 * i].x, acc[2 * i].y, acc[2 * i + 1].x, acc[2 * i + 1].y};
                const f32x4 v = xa + DBG_BETA * ta * pe; xv[i] = v; ss += (v[0] * v[0] + v[1] * v[1]) + (v[2] * v[2] + v[3] * v[3]);
            }
            const float rstd = rsqrtf(wave_sum(ss) * (1.f / D) + EPS);
#pragma unroll
            for (int i = 0; i < 8; ++i) *(f32x4*)(orow + 4 * i) = xv[i] * rstd * *(const f32x4*)(fg + 4 * i);
        }
    }
}
#ifndef GATHER_ROUNDS
#define GATHER_ROUNDS 0
#endif

constexpr size_t OFF_WK = OFF_GB + (size_t)32 * 1024 * 1024;
constexpr size_t OFF_SSQ = OFF_GB + (size_t)48 * 1024 * 1024;
constexpr int NPU = 2, NPV = 2;
struct PairPick { int k; bool valid; };
DI PairPick pick_next(unsigned long long& ma, unsigned long long& mb, int prev) {
    PairPick r;
    if (ma) { r.k = __builtin_ctzll(ma); ma &= ma - 1; r.valid = true; }
    else if (mb) { r.k = 64 + __builtin_ctzll(mb); mb &= mb - 1; r.valid = true; }
    else { r.k = prev; r.valid = false; }
    return r;
}
DI int rl2(int a, int b, int k) { const int va = __builtin_amdgcn_readlane(a, k & 63), vb = __builtin_amdgcn_readlane(b, k & 63); return k < 64 ? va : vb; }
DI float rl2f(float a, float b, int k) { return __builtin_bit_cast(float, rl2(__builtin_bit_cast(int, a), __builtin_bit_cast(int, b), k)); }

DI void gather_u(const Params& p, const Ctx& c) {
    const bf16_t* H2 = (const bf16_t*)(p.ws + OFF_H); const unsigned char* U = p.ws + OFF_U16;
    const int* IDX = (const int*)(p.ws + OFF_IDX); const float* GW = (const float*)(p.ws + OFF_GW); float* WK = (float*)(p.ws + OFF_WK);
    const int x = blockIdx.x & 7, jb = blockIdx.x >> 3, nj = ((int)gridDim.x - x + 7) >> 3;
    const int wl = jb * NWAVES + c.wave, nwl = nj * NWAVES;
    constexpr int G = 4, SH = (NPU == 2) ? 10 : 11;
#pragma unroll 1
    for (int ps = 0; ps < NPU; ++ps) {
        const int part = x * NPU + ps;
#pragma unroll 1
        for (int m = wl; m < M; m += nwl) {
            const int ia = IDX[(size_t)m * 128 + c.lane], ib = IDX[(size_t)m * 128 + 64 + c.lane];
            unsigned long long ma = __ballot((ia >> SH) == part), mb = __ballot((ib >> SH) == part);
            if (!(ma | mb)) continue;
            const unsigned long long ma0 = ma, mb0 = mb;
            float hf[2][16];
#pragma unroll
            for (int j = 0; j < 2; ++j) { const u32x4 a = *(const u32x4*)(H2 + (size_t)m * D + j * 1024 + c.lane * 16), bq = *(const u32x4*)(H2 + (size_t)m * D + j * 1024 + c.lane * 16 + 8);
#pragma unroll
                for (int q = 0; q < 4; ++q) { hf[j][2 * q] = bflo(a[q]); hf[j][2 * q + 1] = bfhi(a[q]); hf[j][8 + 2 * q] = bflo(bq[q]); hf[j][8 + 2 * q + 1] = bfhi(bq[q]); } }
            const float ga = GW[(size_t)m * 128 + c.lane], gb = GW[(size_t)m * 128 + 64 + c.lane];
            float wa = 0.f, wb = 0.f;
            int prev = 0;
            while (ma | mb) {
                PairPick pk[G]; u32x4 uu[G][2];
#pragma unroll
                for (int g = 0; g < G; ++g) { pk[g] = pick_next(ma, mb, prev); prev = pk[g].k;
                    const int e = rl2(ia, ib, pk[g].k);
                    const unsigned char* ur = U + (size_t)e * D;
#pragma unroll
                    for (int j = 0; j < 2; ++j) uu[g][j] = *(const u32x4*)(ur + ((unsigned)c.lane * 16u + j * 1024u)); }
                float d[G];
#pragma unroll
                for (int g = 0; g < G; ++g) {
                    float d0 = 0.f, d1 = 0.f;
#pragma unroll
                    for (int j = 0; j < 2; ++j)
#pragma unroll
                        for (int q = 0; q < 4; ++q) { const f32x2 lo = __builtin_amdgcn_cvt_pk_f32_fp8((int)uu[g][j][q], false), hi = __builtin_amdgcn_cvt_pk_f32_fp8((int)uu[g][j][q], true);
                            d0 += lo.x * hf[j][4 * q] + hi.x * hf[j][4 * q + 2]; d1 += lo.y * hf[j][4 * q + 1] + hi.y * hf[j][4 * q + 3]; }
                    d[g] = d0 + d1;
                }
#pragma unroll
                for (int o = 1; o < 64; o <<= 1)
#pragma unroll
                    for (int g = 0; g < G; ++g) d[g] += __shfl_xor(d[g], o);
#pragma unroll
                for (int g = 0; g < G; ++g) if (pk[g].valid) {
                    const float a = gelu_tanh(d[g] * (1.f / U8_SCALE)) * (1.f / V8_SCALE); const int k = pk[g].k;
                    if (k < 64) { if (c.lane == k) wa = a * ga; } else { if (c.lane == k - 64) wb = a * gb; }
                }
            }
            if ((ma0 >> c.lane) & 1ull) WK[(size_t)m * 128 + c.lane] = wa;
            if ((mb0 >> c.lane) & 1ull) WK[(size_t)m * 128 + 64 + c.lane] = wb;
        }
    }
}

DI void gather_v(const Params& p, const Ctx& c) {
    const unsigned char* V = p.ws + OFF_V16;
    const int* IDX = (const int*)(p.ws + OFF_IDX); const float* WK = (const float*)(p.ws + OFF_WK); const float* mod = (const float*)(p.ws + OFF_MOD);
    float* SSQ = (float*)(p.ws + OFF_SSQ);
    const int x = blockIdx.x & 7, jb = blockIdx.x >> 3, nj = ((int)gridDim.x - x + 7) >> 3;
    const int wl = jb * NWAVES + c.wave, nwl = nj * NWAVES;
    const int q4 = c.lane >> 4, l16 = c.lane & 15;
    const unsigned voff = 256u * x + l16 * 16u;
    constexpr int SHV = (NPV == 2) ? 13 : 14;
#pragma unroll 1
    for (int ps = 0; ps < NPV; ++ps) {
#pragma unroll 1
        for (int m = wl; m < M; m += nwl) {
            const int b = m / SEQ;
            const int ia = IDX[(size_t)m * 128 + c.lane], ib = IDX[(size_t)m * 128 + 64 + c.lane];
            const float wa = WK[(size_t)m * 128 + c.lane], wb = WK[(size_t)m * 128 + 64 + c.lane];
            unsigned long long ma = __ballot((ia >> SHV) == ps), mb = __ballot((ib >> SHV) == ps);
            float acc[16];
#pragma unroll
            for (int i = 0; i < 16; ++i) acc[i] = 0.f;
            int prev = 0;
            while (ma | mb) {
                u32x4 vv[4]; float wv[4];
#pragma unroll
                for (int s4 = 0; s4 < 4; ++s4) {
                    int e = 0; float w = 0.f;
#pragma unroll
                    for (int g = 0; g < 4; ++g) { const PairPick pk = pick_next(ma, mb, prev); prev = pk.k;
                        const int eg = rl2(ia, ib, pk.k); const float wg = pk.valid ? rl2f(wa, wb, pk.k) : 0.f;
                        e = (q4 == g) ? eg : e; w = (q4 == g) ? wg : w; }
                    vv[s4] = *(const u32x4*)(V + (size_t)e * D + voff); wv[s4] = w;
                }
#pragma unroll
                for (int s4 = 0; s4 < 4; ++s4)
#pragma unroll
                    for (int q = 0; q < 4; ++q) { const f32x2 lo = __builtin_amdgcn_cvt_pk_f32_fp8((int)vv[s4][q], false), hi = __builtin_amdgcn_cvt_pk_f32_fp8((int)vv[s4][q], true);
                        acc[4 * q] += wv[s4] * lo.x; acc[4 * q + 1] += wv[s4] * lo.y; acc[4 * q + 2] += wv[s4] * hi.x; acc[4 * q + 3] += wv[s4] * hi.y; }
            }
#pragma unroll
            for (int i = 0; i < 16; ++i) { acc[i] += __shfl_xor(acc[i], 16); acc[i] += __shfl_xor(acc[i], 32); }
            f32x4 sel;
#pragma unroll
            for (int e = 0; e < 4; ++e) sel[e] = q4 == 0 ? acc[e] : (q4 == 1 ? acc[4 + e] : (q4 == 2 ? acc[8 + e] : acc[12 + e]));
            const int col = 256 * x + 16 * l16 + 4 * q4;
            float* op = p.out + (size_t)m * D + col;
            const f32x4 val = *(const f32x4*)op + DBG_BETA * *(const f32x4*)(mod + b * 6 * D + 5 * D + col) * sel;
            *(f32x4*)op = val;
            if (ps == NPV - 1) { const float ss = wave_sum(val[0] * val[0] + val[1] * val[1] + val[2] * val[2] + val[3] * val[3]); if (c.lane == 0) SSQ[(size_t)m * 8 + x] = ss; }
        }
    }
}
DI void gather_final(const Params& p, const Ctx& c) {
    const float* SSQ = (const float*)(p.ws + OFF_SSQ);
    for (int m = c.gw; m < M; m += c.ngw) {
        float s = (c.lane < 8) ? SSQ[(size_t)m * 8 + c.lane] : 0.f;
        s += __shfl_xor(s, 1); s += __shfl_xor(s, 2); s += __shfl_xor(s, 4);
        const float rstd = rsqrtf(__shfl(s, 0) * (1.f / D) + EPS);
        float* orow = p.out + (size_t)m * D;
#pragma unroll
        for (int j = 0; j < 8; ++j) { const int col = (j * 64 + c.lane) * 4; *(f32x4*)(orow + col) = *(const f32x4*)(orow + col) * rstd * *(const f32x4*)(p.fng + col); }
    }
}
#ifndef GATHER_L2
#define GATHER_L2 0
#endif

DI void phase_gather_v2(const Params& p, const Ctx& c) {
    const bf16_t* H2 = (const bf16_t*)(p.ws + OFF_H);
    const int* IDX = (const int*)(p.ws + OFF_IDX); const float* GW = (const float*)(p.ws + OFF_GW); const float* mod = (const float*)(p.ws + OFF_MOD);
    LAS float* hs = (LAS float*)c.lds; LAS float* wk = hs + 2048; LAS int* ek = (LAS int*)(wk + 128); LAS float* red = (LAS float*)(ek + 128);
    for (int m = blockIdx.x; m < M; m += gridDim.x) {
        const int b = m / SEQ;
        __syncthreads();
        for (int i = c.tid; i < 2048; i += NTHREADS) hs[i] = bf2f(H2[(size_t)m * D + i]);
        if (c.tid < 128) ek[c.tid] = IDX[(size_t)m * 128 + c.tid];
        __syncthreads();
        for (int k = c.wave; k < 128; k += NWAVES) {
            const float* ur = p.pu + (size_t)ek[k] * D;
            float d = 0.f;
            for (int i = 0; i < 8; ++i) { const int col = i * 256 + c.lane * 4; const f32x4 u = *(const f32x4*)(ur + col);
                d += u[0] * hs[col] + u[1] * hs[col + 1] + u[2] * hs[col + 2] + u[3] * hs[col + 3]; }
            d = wave_sum(d);
            if (c.lane == 0) wk[k] = gelu_tanh(d) * GW[(size_t)m * 128 + k];
        }
        __syncthreads();
        const int col = c.tid * 4;
        f32x4 acc = {0.f, 0.f, 0.f, 0.f};
        for (int k = 0; k < 128; ++k) { const f32x4 v = *(const f32x4*)(p.pv + (size_t)ek[k] * D + col); acc += v * wk[k]; }
        float* orow = p.out + (size_t)m * D;
        const f32x4 x2 = *(const f32x4*)(orow + col) + DBG_BETA * *(const f32x4*)(mod + b * 6 * D + 5 * D + col) * acc;
        float ss = wave_sum(x2[0] * x2[0] + x2[1] * x2[1] + x2[2] * x2[2] + x2[3] * x2[3]);
        if (c.lane == 0) red[c.wave] = ss;
        __syncthreads();
        float tot = 0.f;
        for (int w = 0; w < NWAVES; ++w) tot += red[w];
        const float rstd = rsqrtf(tot * (1.f / D) + EPS);
        *(f32x4*)(orow + col) = x2 * rstd * *(const f32x4*)(p.fng + col);
    }
}


#define XB_TMO      128
#define XB_XCNT(j)  (256  + 64 * (j))
#define XB_XSUB(j)  (1280 + 64 * (j))
#define XB_XGEN(j)  (2304 + 64 * (j))
#define XB_TOP      3328
#define XB_TOPGEN   3392
#define XCD_BAR_WORDS 3456
#define XB_SPIN_CAP (1u << 18)

__device__ __forceinline__ unsigned xb_ld(unsigned* p)              { return __hip_atomic_load(p, __ATOMIC_RELAXED, __HIP_MEMORY_SCOPE_AGENT); }
__device__ __forceinline__ unsigned xb_add(unsigned* p, unsigned v) { return __hip_atomic_fetch_add(p, v, __ATOMIC_RELAXED, __HIP_MEMORY_SCOPE_AGENT); }
__device__ __forceinline__ unsigned xb_xcc_id() { return (unsigned)__builtin_amdgcn_s_getreg((3 << 11) | 20) & 0xFu; }
#define XB_SPIN(cond, bar) do { unsigned _sp = 0; while (cond) { __builtin_amdgcn_s_sleep(1); \
    if ((++_sp & 255u) == 0u) { if (xb_ld(&(bar)[XB_TMO])) break; if (_sp > XB_SPIN_CAP) { atomicAdd(&(bar)[XB_TMO], 1u); break; } } } } while (0)

struct XcdBarrier {
    unsigned* bar; unsigned x;
    volatile LAS unsigned* st;
};

__device__ __forceinline__ XcdBarrier xcd_barrier_post(unsigned* bar, volatile LAS unsigned* st) {
    XcdBarrier b; b.bar = bar; b.x = xb_xcc_id(); b.st = st;
    if (threadIdx.x == 0) (void)xb_add(&bar[XB_XCNT(b.x)], 1u);
    return b;
}
__device__ __forceinline__ void xcd_barrier_complete(unsigned* bar, unsigned x, unsigned& nloc, unsigned& nx) {
    const unsigned G = gridDim.x * gridDim.y * gridDim.z;
    unsigned sum, cnt, mine, sp = 0u;
    for (;;) {
        sum = 0u; cnt = 0u; mine = 0u;
#pragma unroll
        for (unsigned j = 0; j < 16; ++j) { const unsigned c = xb_ld(&bar[XB_XCNT(j)]); sum += c; cnt += (c > 0u) ? 1u : 0u; mine = (j == x) ? c : mine; }
        if (sum == G) break;
        __builtin_amdgcn_s_sleep(1);
        if ((++sp & 255u) == 0u) { if (xb_ld(&bar[XB_TMO])) break; if (sp > XB_SPIN_CAP) { atomicAdd(&bar[XB_TMO], 1u); break; } }
    }
    nloc = mine > 0u ? mine : 1u; nx = cnt > 0u ? cnt : 1u;
}

__device__ __forceinline__ bool xb_lead(int wave_s) { return wave_s == 0 && __builtin_amdgcn_mbcnt_hi(~0u, __builtin_amdgcn_mbcnt_lo(~0u, 0u)) == 0; }
__device__ __forceinline__ void xcd_barrier(const XcdBarrier& b, int wave_s) {
    asm volatile("s_waitcnt vmcnt(0)" ::: "memory");
    __syncthreads();
    if (xb_lead(wave_s)) {
        unsigned* bar = b.bar;
        __builtin_amdgcn_s_waitcnt(0);
        unsigned nloc = b.st[0], nx = b.st[1];
        if (nloc == 0u) { xcd_barrier_complete(bar, b.x, nloc, nx); b.st[0] = nloc; b.st[1] = nx; }
        const unsigned old = xb_add(&bar[XB_XSUB(b.x)], 1u);
        const unsigned gen = old / nloc;
        if (old + 1u == (gen + 1u) * nloc) {
            __builtin_amdgcn_fence(__ATOMIC_RELEASE, "agent");
            asm volatile("s_waitcnt vmcnt(0)" ::: "memory");
            const unsigned og = xb_add(&bar[XB_TOP], 1u);
            const unsigned tg = og / nx;
            if (og + 1u == (tg + 1u) * nx) xb_add(&bar[XB_TOPGEN], 1u);
            else XB_SPIN(xb_ld(&bar[XB_TOPGEN]) == tg, bar);
            __builtin_amdgcn_fence(__ATOMIC_ACQUIRE, "agent");
            xb_add(&bar[XB_XGEN(b.x)], 1u);
            asm volatile("s_waitcnt vmcnt(0)" ::: "memory");
        } else {
            XB_SPIN(xb_ld(&bar[XB_XGEN(b.x)]) == gen, bar);
            __builtin_amdgcn_fence(__ATOMIC_ACQUIRE, "agent");
            asm volatile("s_waitcnt vmcnt(0)" ::: "memory");
        }
    }
    __syncthreads();
}


DI void grid_barrier(unsigned* ctr, unsigned target, int wave_s) {
    asm volatile("s_waitcnt vmcnt(0)" ::: "memory");
    __syncthreads();
    if (wave_s == 0) {
        const int l = __builtin_amdgcn_mbcnt_hi(~0u, __builtin_amdgcn_mbcnt_lo(~0u, 0u));
        if (l == 0) {
            __builtin_amdgcn_fence(__ATOMIC_RELEASE, "agent");
            asm volatile("s_waitcnt vmcnt(0)" ::: "memory");
            __hip_atomic_fetch_add(ctr, 1u, __ATOMIC_RELAXED, __HIP_MEMORY_SCOPE_AGENT);
            unsigned spins = 0;
            while (__hip_atomic_load(ctr, __ATOMIC_RELAXED, __HIP_MEMORY_SCOPE_AGENT) < target) { __builtin_amdgcn_s_sleep(2); if (++spins > (1u << 23)) break; }
            __builtin_amdgcn_fence(__ATOMIC_ACQUIRE, "agent");
            asm volatile("s_waitcnt vmcnt(0)" ::: "memory");
        }
    }
    __syncthreads();
}

__global__ void __launch_bounds__(NTHREADS, 2) mega(Params p) {
    extern __shared__ __attribute__((aligned(16))) unsigned char lds_raw[];
    const int wave_s = __builtin_amdgcn_readfirstlane(threadIdx.x >> 6);
#define MKCTX() Ctx c; { int l_; asm volatile("v_mbcnt_lo_u32_b32 %0, -1, 0\n\tv_mbcnt_hi_u32_b32 %0, -1, %0" : "=v"(l_)); c.lds = (LAS unsigned char*)lds_raw; c.lane = l_; c.wave = wave_s; c.tid = wave_s * 64 + l_; \
    c.gw = blockIdx.x * NWAVES + wave_s; c.ngw = gridDim.x * NWAVES; }
    unsigned char* ws = p.ws;
    const float* mod = (const float*)(ws + OFF_MOD);
    const int lo = p.ph_lo, hi = p.ph_hi;
    XcdBarrier xbar; xbar.bar = (unsigned*)(ws + OFF_XBAR); xbar.x = 0; xbar.st = nullptr;
    if (USE_XBAR && lo == 0 && hi == NPHASE) {
        volatile LAS unsigned* stw = (volatile LAS unsigned*)(lds_raw + LDS_BYTES - 32);
        if (threadIdx.x < 2) stw[threadIdx.x] = 0u;
        __syncthreads();
        xbar = xcd_barrier_post((unsigned*)(ws + OFF_XBAR), stw);
    }
#define IN(k) (lo <= (k) && (k) < hi)
#define SEAM(k) do { if (IN(k) && IN((k) + 1)) { if (USE_XBAR) xcd_barrier(xbar, wave_s); else grid_barrier((unsigned*)(ws + OFF_CTL), (unsigned)((k) + 1) * gridDim.x, wave_s); \
    if (TIME_PHASE >= 0 && blockIdx.x == 0 && threadIdx.x == 0) ((unsigned long long*)(ws + OFF_CTL + 512))[(k) + 1] = __builtin_amdgcn_s_memrealtime(); } } while (0)

    if (TIME_PHASE >= 0 && blockIdx.x == 0 && threadIdx.x == 0) ((unsigned long long*)(ws + OFF_CTL + 512))[0] = __builtin_amdgcn_s_memrealtime();
    if (IN(0)) { MKCTX(); phase_prologue(p, c, true, PRO_SPLIT == 0); }
    SEAM(0);
    if (IN(1)) for (int rep_ = 0; rep_ < (DUP_PHASE == 1 ? 2 : 1); ++rep_) { MKCTX();
        const long long* modi = (const long long*)(ws + OFF_MODI); float* modw = (float*)(ws + OFF_MOD);
        for (int i = blockIdx.x * NTHREADS + c.tid; i < NB * 6 * D; i += gridDim.x * NTHREADS) modw[i] = (float)((double)modi[i] * (1.0 / 4294967296.0));
        modulate_rows(p.x, p.n1g, modi + 1 * D, modi + 0 * D, (bf16_t*)(ws + OFF_H), c);
        if (PRO_SPLIT) phase_prologue(p, c, false, true);
    }
    SEAM(1);
    if (IN(2)) for (int rep_ = 0; rep_ < (DUP_PHASE == 2 ? 2 : 1); ++rep_) { MKCTX();
        EpiProj e1{(bf16_t*)(ws + OFF_CQ), (bf16_t*)(ws + OFF_CKV), (bf16_t*)(ws + OFF_KR), (bf16_t*)(ws + OFF_SBQ), (bf16_t*)(ws + OFF_SBK), (bf16_t*)(ws + OFF_GA), (bf16_t*)(ws + OFF_GB), (const f32x2*)(ws + OFF_CS)};
        GEMM(c, (const bf16_t*)(ws + OFF_H), (const bf16_t*)(ws + OFF_WIN), M, 7168, 2048, e1);
        if (DUP_GEMM == 20) GEMM(c, (const bf16_t*)(ws + OFF_H), (const bf16_t*)(ws + OFF_WIN), M, 7168, 2048, e1);
        EpiT e2{(bf16_t*)(ws + OFF_SBVT), nullptr};
        GEMM(c, (const bf16_t*)(ws + OFF_WSBV), (const bf16_t*)(ws + OFF_H), 1024, M, 2048, e2);
        if (DUP_GEMM == 21) GEMM(c, (const bf16_t*)(ws + OFF_WSBV), (const bf16_t*)(ws + OFF_H), 1024, M, 2048, e2);
    }
    SEAM(2);
    if (IN(3)) for (int rep_ = 0; rep_ < (DUP_PHASE == 3 ? 2 : 1); ++rep_) { MKCTX(); phase_rowstats(p, c); }
    SEAM(3);
    if (DBG_XTRA_BAR) { for (int q_ = 0; q_ < DBG_XTRA_BAR; ++q_) { if (IN(3) && IN(4)) xcd_barrier(xbar, wave_s); } }
    if (IN(4)) for (int rep_ = 0; rep_ < (DUP_PHASE == 4 ? 2 : 1); ++rep_) { MKCTX();
        EpiUq e1{(bf16_t*)(ws + OFF_Q), (const float*)(ws + OFF_RSTQ), (const f32x2*)(ws + OFF_CS)};
        GEMM(c, (const bf16_t*)(ws + OFF_CQ), (const bf16_t*)(ws + OFF_WUQ), M, 1536, 512, e1);
        if (DUP_GEMM == 40) GEMM(c, (const bf16_t*)(ws + OFF_CQ), (const bf16_t*)(ws + OFF_WUQ), M, 1536, 512, e1);
        EpiRowScale e2{(bf16_t*)(ws + OFF_KN), 1024, (const float*)(ws + OFF_RSTKV)};
        GEMM(c, (const bf16_t*)(ws + OFF_CKV), (const bf16_t*)(ws + OFF_WUK), M, 1024, 256, e2);
        if (DUP_GEMM == 41) GEMM(c, (const bf16_t*)(ws + OFF_CKV), (const bf16_t*)(ws + OFF_WUK), M, 1024, 256, e2);
        EpiT e3{(bf16_t*)(ws + OFF_VT), (const float*)(ws + OFF_RSTKV)};
        GEMM(c, (const bf16_t*)(ws + OFF_WUV), (const bf16_t*)(ws + OFF_CKV), 1024, M, 256, e3);
        if (DUP_GEMM == 42) GEMM(c, (const bf16_t*)(ws + OFF_WUV), (const bf16_t*)(ws + OFF_CKV), 1024, M, 256, e3);
    }
    SEAM(4);
    if (IN(5)) for (int rep_ = 0; rep_ < (DUP_PHASE == 5 ? 2 : 1); ++rep_) {
#if FAST_ATTN
        { MKCTX(); attn_mla_fast(p, c); }
        if (DUP_GEMM == 51) { MKCTX(); attn_mla_fast(p, c); }
        { MKCTX(); attn_sb_fast(p, c); }
        if (DUP_GEMM == 52) { MKCTX(); attn_sb_fast(p, c); }
#else
        MKCTX();
        attn_mla_naive(p, c); attn_sb_naive(p, c);
#endif
    }
    SEAM(5);
    if (IN(6)) for (int rep_ = 0; rep_ < (DUP_PHASE == 6 ? 2 : 1); ++rep_) { MKCTX();
        EpiGate1 e1{(bf16_t*)(ws + OFF_MERGED), (const bf16_t*)(ws + OFF_GA)};
        GEMM(c, (const bf16_t*)(ws + OFF_ATTA), (const bf16_t*)(ws + OFF_WA), M, 2048, 1024, e1);
        if (DUP_GEMM == 60) GEMM(c, (const bf16_t*)(ws + OFF_ATTA), (const bf16_t*)(ws + OFF_WA), M, 2048, 1024, e1);
        EpiGate2 e2{(bf16_t*)(ws + OFF_MERGED), (const bf16_t*)(ws + OFF_GB)};
        GEMM(c, (const bf16_t*)(ws + OFF_ATTB), (const bf16_t*)(ws + OFF_WB), M, 2048, 1024, e2);
    }
    SEAM(6);
    if (IN(7)) for (int rep_ = 0; rep_ < (DUP_PHASE == 7 ? 2 : 1); ++rep_) { MKCTX();
        EpiRes e{p.x, mod + 2 * D, p.out};
        GEMM(c, (const bf16_t*)(ws + OFF_MERGED), (const bf16_t*)(ws + OFF_WOUT), M, 2048, 2048, e);
    }
    SEAM(7);
    if (IN(8)) for (int rep_ = 0; rep_ < (DUP_PHASE == 8 ? 2 : 1); ++rep_) { MKCTX();
        modulate_rows(p.out, p.n2g, mod + 4 * D, mod + 3 * D, (bf16_t*)(ws + OFF_H), c);
        convert_table(p.pu, ws + OFF_U16, U8_SCALE, c);
        convert_table(p.pv, ws + OFF_V16, V8_SCALE, c);
    }
    SEAM(8);
    if (IN(9)) for (int rep_ = 0; rep_ < (DUP_PHASE == 9 ? 2 : 1); ++rep_) { MKCTX();
        EpiPq e{(bf16_t*)(ws + OFF_PQ)};
        GEMM(c, (const bf16_t*)(ws + OFF_H), (const bf16_t*)(ws + OFF_WPQ), M, 2048, 2048, e);
#if FAST_SEL && FAST_GEMM && SEL_FUSED
        { MKCTX(); select_own_tiles(p, c); }
#endif
    }
#if !(FAST_SEL && FAST_GEMM && SEL_FUSED)
    SEAM(9);
    if (IN(10)) for (int rep_ = 0; rep_ < (DUP_PHASE == 10 ? 2 : 1); ++rep_) { MKCTX();
#if FAST_SEL
        select_fast(p, c);
#else
        select_naive(p, c);
#endif
    }
#else
    if (IN(9) && IN(10)) {   }
#endif
    SEAM(10);
#if GATHER_L2
    if (IN(11)) { MKCTX(); gather_u(p, c); }
    SEAM(11);
    if (IN(12)) { MKCTX(); gather_v(p, c); }
    SEAM(12);
    if (IN(13)) { MKCTX(); gather_final(p, c); }
#else
#if GATHER_ROUNDS
    if (IN(11)) { MKCTX(); phase_gather_rounds(p, c, xbar); }
#else
    if (IN(11)) { if (DUP_GEMM == 110) { MKCTX(); phase_gather(p, c, (float*)(ws + OFF_SBQ)); }
        if (DUP_GEMM == 111) { MKCTX(); phase_gather(p, c, (float*)(ws + OFF_SBQ), 0x3ff); } MKCTX(); phase_gather(p, c, p.out); }
#endif
#endif
#undef IN
#undef SEAM
}

extern "C" void kernel_launch(void* const* d_in, const int* in_sizes, int n_in, void* d_out, int out_size, void* d_ws, size_t ws_size, hipStream_t stream) {
    static int grid = 0;
    if (grid == 0) {
        if (n_in != 20 || out_size != M * D || ws_size < WS_END) { fprintf(stderr, "kernel_launch: unexpected shapes (n_in %d out %d ws %zu need %zu)\n", n_in, out_size, ws_size, (size_t)WS_END); grid = -1; return; }
        int dev = 0, cus = 0, per_cu = 0;
        (void)hipGetDevice(&dev); (void)hipDeviceGetAttribute(&cus, hipDeviceAttributeMultiprocessorCount, dev);
        if (hipFuncSetAttribute((const void*)mega, hipFuncAttributeMaxDynamicSharedMemorySize, LDS_BYTES) != hipSuccess) { fprintf(stderr, "kernel_launch: hipFuncSetAttribute failed\n"); grid = -1; return; }
        if (hipOccupancyMaxActiveBlocksPerMultiprocessor(&per_cu, (const void*)mega, NTHREADS, LDS_BYTES) != hipSuccess || per_cu < 1) { fprintf(stderr, "kernel_launch: occupancy query failed (%d)\n", per_cu); per_cu = 1; }
        (void)hipGetLastError();
        grid = cus;
    }
    if (grid < 0) return;
    (void)hipMemsetAsync((char*)d_ws + OFF_CTL, 0, ZERO_BYTES, stream);
    Params p{};
    p.x = (const float*)d_in[0]; p.c = (const float*)d_in[1]; p.pos = (const int*)d_in[2]; p.ada_w = (const float*)d_in[3]; p.ada_b = (const float*)d_in[4];
    p.n1g = (const float*)d_in[5]; p.n2g = (const float*)d_in[6]; p.w_in = (const float*)d_in[7]; p.qng = (const float*)d_in[8]; p.kvng = (const float*)d_in[9];
    p.w_uq = (const float*)d_in[10]; p.w_ukv = (const float*)d_in[11]; p.w_bm = (const float*)d_in[12]; p.w_bs = (const float*)d_in[13]; p.w_out = (const float*)d_in[14];
    p.w_pq = (const float*)d_in[15]; p.skeys = (const float*)d_in[16]; p.pu = (const float*)d_in[17]; p.pv = (const float*)d_in[18]; p.fng = (const float*)d_in[19];
    p.out = (float*)d_out; p.ws = (unsigned char*)d_ws;
    for (int i = 0; i < 32; ++i) p.invf[i] = (float)pow(10000.0, -(double)i / 32.0);
#if N_LAUNCH_MODE == 1
    p.ph_lo = 0; p.ph_hi = NPHASE;
    void* args[] = {&p};
    hipError_t e = hipLaunchCooperativeKernel((const void*)mega, dim3(grid), dim3(NTHREADS), args, LDS_BYTES, stream);
    if (e != hipSuccess) fprintf(stderr, "cooperative launch failed: %s (grid %d)\n", hipGetErrorString(e), grid);
#else
    for (int k = 0; k < NPHASE; ++k) {
        p.ph_lo = k; p.ph_hi = k + 1;
        hipLaunchKernelGGL(mega, dim3(grid), dim3(NTHREADS), LDS_BYTES, stream, p);
    }
#endif
}
```

```cpp
#include <hip/hip_runtime.h>
#include <hip/hip_cooperative_groups.h>
#include <cstdio>
#include <cstdint>
#include <cmath>
namespace cg = cooperative_groups;

#ifndef N_LAUNCH_MODE
#define N_LAUNCH_MODE 1
#endif

#ifndef TIME_PHASE
#define TIME_PHASE -1
#endif
#ifndef TIME_SCALE
#define TIME_SCALE 5000.f
#endif
#ifndef DUP_GEMM
#define DUP_GEMM -1
#endif
#ifndef PRO_SPLIT
#define PRO_SPLIT 1
#endif
#ifndef USE_XBAR
#define USE_XBAR 1
#endif
#ifndef DBG_XTRA_BAR
#define DBG_XTRA_BAR 0
#endif
#ifndef DBG_ROUND_BAR
#define DBG_ROUND_BAR 0
#endif
#ifndef GATHER_DYN
#define GATHER_DYN 1
#endif
#ifndef SEL_FUSED
#define SEL_FUSED 1
#endif
#ifndef DUP_PHASE
#define DUP_PHASE -1
#endif
#ifndef DBG_ALPHA
#define DBG_ALPHA 1.0f
#endif
#ifndef DBG_BETA
#define DBG_BETA 1.0f
#endif
#define LAS __attribute__((address_space(3)))
#define DI __device__ __forceinline__
typedef unsigned short bf16_t;
typedef short bf16x8 __attribute__((ext_vector_type(8)));
typedef float f32x4 __attribute__((ext_vector_type(4)));
typedef float f32x2 __attribute__((ext_vector_type(2)));
typedef unsigned u32x4 __attribute__((ext_vector_type(4)));
typedef unsigned u32x2 __attribute__((ext_vector_type(2)));
typedef __bf16 bf16v2 __attribute__((ext_vector_type(2)));

constexpr int M = 16384, D = 2048, SEQ = 4096, NB = 4;
constexpr int NTHREADS = 512, NWAVES = 8;
constexpr int LDS_BYTES = 160 * 1024;
constexpr float EPS = 1e-6f;
constexpr float LOG2E = 1.4426950408889634f;
constexpr int NPHASE = 14;

constexpr size_t al256(size_t x) { return (x + 255) & ~(size_t)255; }
constexpr size_t OFF_CTL = 0;
constexpr size_t OFF_XBAR = 4096;
constexpr size_t OFF_MODI = 32768;
constexpr size_t ZERO_BYTES = OFF_MODI + (size_t)NB * 6 * D * 8;
constexpr size_t OFF_MOD = al256(ZERO_BYTES);
constexpr size_t OFF_RSTQ = OFF_MOD + (size_t)NB * 6 * D * 4;
constexpr size_t OFF_RSTKV = OFF_RSTQ + (size_t)M * 4;
constexpr size_t OFF_CS = OFF_RSTKV + (size_t)M * 4;
constexpr size_t OFF_KEYS = OFF_CS + (size_t)M * 32 * 8;
constexpr size_t OFF_WIN = OFF_KEYS + (size_t)8 * 2 * 128 * 128 * 2;
constexpr size_t OFF_WSBV = OFF_WIN + (size_t)7168 * 2048 * 2;
constexpr size_t OFF_WUQ = OFF_WSBV + (size_t)1024 * 2048 * 2;
constexpr size_t OFF_WUK = OFF_WUQ + (size_t)1536 * 512 * 2;
constexpr size_t OFF_WUV = OFF_WUK + (size_t)1024 * 256 * 2;
constexpr size_t OFF_WA = OFF_WUV + (size_t)1024 * 256 * 2;
constexpr size_t OFF_WB = OFF_WA + (size_t)2048 * 1024 * 2;
constexpr size_t OFF_WOUT = OFF_WB + (size_t)2048 * 1024 * 2;
constexpr size_t OFF_WPQ = OFF_WOUT + (size_t)2048 * 2048 * 2;
constexpr size_t OFF_H = OFF_WPQ + (size_t)2048 * 2048 * 2;
constexpr size_t OFF_CQ = OFF_H + (size_t)M * 2048 * 2;
constexpr size_t OFF_CKV = OFF_CQ + (size_t)M * 512 * 2;
constexpr size_t OFF_KR = OFF_CKV + (size_t)M * 256 * 2;
constexpr size_t OFF_SBQ = OFF_KR + (size_t)M * 64 * 2;
constexpr size_t OFF_SBK = OFF_SBQ + (size_t)M * 1024 * 2;
constexpr size_t OFF_SBVT = OFF_SBK + (size_t)M * 1024 * 2;
constexpr size_t OFF_GA = OFF_SBVT + (size_t)M * 1024 * 2;
constexpr size_t OFF_GB = OFF_GA + (size_t)M * 2048 * 2;
constexpr size_t OFF_Q = OFF_GB + (size_t)M * 2048 * 2;
constexpr size_t OFF_KN = OFF_Q + (size_t)M * 1536 * 2;
constexpr size_t OFF_VT = OFF_KN + (size_t)M * 1024 * 2;
constexpr size_t OFF_ATTA = OFF_VT + (size_t)M * 1024 * 2;
constexpr size_t OFF_ATTB = OFF_ATTA + (size_t)M * 1024 * 2;
constexpr size_t WS_END = OFF_ATTB + (size_t)M * 1024 * 2;
constexpr size_t OFF_MERGED = OFF_SBQ;
constexpr size_t OFF_PQ = OFF_GA;
constexpr size_t OFF_IDX = OFF_GB;
constexpr size_t OFF_GW = OFF_GB + (size_t)M * 128 * 4;
constexpr size_t OFF_U16 = OFF_Q;
constexpr size_t OFF_V16 = OFF_U16 + (size_t)16384 * 2048;
static_assert(OFF_V16 + (size_t)16384 * 2048 <= WS_END, "u/v overlay");
constexpr float U8_SCALE = 68.f, V8_SCALE = 1.5f;
static_assert(WS_END < (size_t)620 * 1000 * 1000, "workspace budget");

struct Params {
    const float *x, *c; const int* pos;
    const float *ada_w, *ada_b, *n1g, *n2g, *w_in, *qng, *kvng, *w_uq, *w_ukv, *w_bm, *w_bs, *w_out, *w_pq, *skeys, *pu, *pv, *fng;
    float* out; unsigned char* ws;
    float invf[32];
    int ph_lo, ph_hi;
};

DI unsigned pk2(float lo, float hi) { bf16v2 p; p[0] = (__bf16)lo; p[1] = (__bf16)hi; return __builtin_bit_cast(unsigned, p); }
DI float bflo(unsigned u) { return __uint_as_float(u << 16); }
DI float bfhi(unsigned u) { return __uint_as_float(u & 0xffff0000u); }
DI float dot2bf(unsigned a, unsigned b, float c) { return __builtin_amdgcn_fdot2_f32_bf16(__builtin_bit_cast(bf16v2, a), __builtin_bit_cast(bf16v2, b), c, false); }
DI float bf2f(bf16_t b) { return __uint_as_float(((unsigned)b) << 16); }
DI float wave_sum(float v) {
#pragma unroll
    for (int o = 1; o < 64; o <<= 1) v += __shfl_xor(v, o);
    return v;
}
DI float wave_max(float v) {
#pragma unroll
    for (int o = 1; o < 64; o <<= 1) v = fmaxf(v, __shfl_xor(v, o));
    return v;
}
DI float sigmoidf_(float v) { return 1.f / (1.f + __expf(-v)); }
DI float gelu_tanh(float v) { const float u = 0.7978845608028654f * (v + 0.044715f * v * v * v); const float e = __expf(2.f * u); const float t = 1.f - 2.f / (e + 1.f); return 0.5f * v * (1.f + t); }
DI void store_bf16x4(bf16_t* p, f32x4 v) { u32x2 w; w.x = pk2(v[0], v[1]); w.y = pk2(v[2], v[3]); *(u32x2*)p = w; }
DI void store_bf16x8(bf16_t* p, f32x4 a, f32x4 b) { u32x4 w; w.x = pk2(a[0], a[1]); w.y = pk2(a[2], a[3]); w.z = pk2(b[0], b[1]); w.w = pk2(b[2], b[3]); *(u32x4*)p = w; }
DI void load_bf16x8(const bf16_t* p, f32x4& a, f32x4& b) { const u32x4 w = *(const u32x4*)p; a = (f32x4){bflo(w.x), bfhi(w.x), bflo(w.y), bfhi(w.y)}; b = (f32x4){bflo(w.z), bfhi(w.z), bflo(w.w), bfhi(w.w)}; }
DI f32x4 sig4(f32x4 v) { return (f32x4){sigmoidf_(v[0]), sigmoidf_(v[1]), sigmoidf_(v[2]), sigmoidf_(v[3])}; }
DI f32x4 rope4(f32x4 v, f32x2 c0, f32x2 c1) { return (f32x4){v[0] * c0.x - v[1] * c0.y, v[1] * c0.x + v[0] * c0.y, v[2] * c1.x - v[3] * c1.y, v[3] * c1.x + v[2] * c1.y}; }
DI f32x4 load_bf16x4(const bf16_t* p) { const u32x2 w = *(const u32x2*)p; return (f32x4){bflo(w.x), bfhi(w.x), bflo(w.y), bfhi(w.y)}; }

struct Ctx {
    LAS unsigned char* lds;
    int tid, lane, wave, gw, ngw;
};

struct MapWin { DI int operator()(int n) const {
    if (n < 768) return n;
    if (n < 1024) { const int j = n - 768; if (j >= 64) return -1; return 768 + (j >> 1) + 32 * (j & 1); }
    if (n < 2048) return 832 + (n - 1024);
    if (n < 3072) return 1856 + (n - 2048);
    if (n < 5120) return 3904 + (n - 3072);
    return 5952 + (n - 5120); } };
struct MapOff { int off; DI int operator()(int n) const { return n + off; } };
struct MapUq { DI int operator()(int n) const { const int hd = n / 192, j = n % 192; if (j < 128) return hd * 192 + j; const int jj = j - 128; return hd * 192 + 128 + (jj >> 1) + 32 * (jj & 1); } };
struct MapUk { DI int operator()(int n) const { return (n >> 7) * 256 + (n & 127); } };
struct MapUv { DI int operator()(int n) const { return (n >> 7) * 256 + 128 + (n & 127); } };

template <class Map>
DI void transpose_item(const float* W, int K, int N, const Map& mp, const float* rowscale, bf16_t* dst, int kb, int nb, LAS float* scr, int lane) {
    const int k0 = kb * 64, sc = mp(nb * 64 + lane);
#pragma unroll 8
    for (int kk = 0; kk < 64; ++kk) {
        float v = 0.f;
        if (sc >= 0) v = W[(size_t)(k0 + kk) * N + sc];
        if (rowscale) v *= rowscale[k0 + kk];
        scr[kk * 65 + lane] = v;
    }
    asm volatile("s_waitcnt lgkmcnt(0)" ::: "memory");
    const int kc = lane & 7;
#pragma unroll
    for (int j = 0; j < 8; ++j) {
        const int nrow = (lane >> 3) + 8 * j; const LAS float* s = scr + (8 * kc) * 65 + nrow;
        u32x4 o; o.x = pk2(s[0], s[65]); o.y = pk2(s[2 * 65], s[3 * 65]); o.z = pk2(s[4 * 65], s[5 * 65]); o.w = pk2(s[6 * 65], s[7 * 65]);
        *(u32x4*)(dst + (size_t)(nb * 64 + nrow) * K + k0 + 8 * kc) = o;
    }
    asm volatile("s_waitcnt lgkmcnt(0)" ::: "memory");
}

DI void phase_prologue(const Params& p, const Ctx& c, bool do_ada = true, bool do_rest = true) {
    unsigned char* ws = p.ws;
    LAS float* scr = (LAS float*)(c.lds + c.wave * 16640);
    unsigned long long* modi = (unsigned long long*)(ws + OFF_MODI);
    if (do_ada) for (int u = c.gw; u < 32 * 48; u += c.ngw) {
        const int kp = u / 48, ch = u % 48, k0 = kp * 64, c0 = ch * 256 + c.lane * 4;
        float sl[4];
#pragma unroll
        for (int b = 0; b < 4; ++b) { const float cv = p.c[b * D + k0 + c.lane]; sl[b] = cv / (1.f + __expf(-cv)); }
        f32x4 acc[4];
#pragma unroll
        for (int b = 0; b < 4; ++b) acc[b] = (f32x4){0.f, 0.f, 0.f, 0.f};
#pragma unroll 16
        for (int kk = 0; kk < 64; ++kk) {
            const f32x4 w = *(const f32x4*)(p.ada_w + (size_t)(k0 + kk) * (6 * D) + c0);
#pragma unroll
            for (int b = 0; b < 4; ++b) { const float s = __shfl(sl[b], kk); acc[b] += w * s; }
        }
        if (kp == 0) { const f32x4 bv = *(const f32x4*)(p.ada_b + c0);
#pragma unroll
            for (int b = 0; b < 4; ++b) acc[b] += bv; }
#pragma unroll
        for (int b = 0; b < 4; ++b)
#pragma unroll
            for (int e = 0; e < 4; ++e) atomicAdd(modi + b * 6 * D + c0 + e, (unsigned long long)(long long)__builtin_rint((double)acc[b][e] * 4294967296.0));
    }
    if (!do_rest) return;
    constexpr int I_WIN = 112 * 32, I_SBV = 16 * 32, I_UQ = 24 * 8, I_UK = 16 * 4, I_UV = 16 * 4, I_A = 32 * 16, I_B = 32 * 16, I_OUT = 32 * 32, I_PQ = 32 * 32;
    constexpr int NIT = I_WIN + I_SBV + I_UQ + I_UK + I_UV + I_A + I_B + I_OUT + I_PQ;
    for (int it = c.gw; it < NIT; it += c.ngw) {
        int r = it;
        if (r < I_WIN) { transpose_item(p.w_in, 2048, 8000, MapWin{}, nullptr, (bf16_t*)(ws + OFF_WIN), r % 32, r / 32, scr, c.lane); continue; } r -= I_WIN;
        if (r < I_SBV) { transpose_item(p.w_in, 2048, 8000, MapOff{2880}, nullptr, (bf16_t*)(ws + OFF_WSBV), r % 32, r / 32, scr, c.lane); continue; } r -= I_SBV;
        if (r < I_UQ) { transpose_item(p.w_uq, 512, 1536, MapUq{}, p.qng, (bf16_t*)(ws + OFF_WUQ), r % 8, r / 8, scr, c.lane); continue; } r -= I_UQ;
        if (r < I_UK) { transpose_item(p.w_ukv, 256, 2048, MapUk{}, p.kvng, (bf16_t*)(ws + OFF_WUK), r % 4, r / 4, scr, c.lane); continue; } r -= I_UK;
        if (r < I_UV) { transpose_item(p.w_ukv, 256, 2048, MapUv{}, p.kvng, (bf16_t*)(ws + OFF_WUV), r % 4, r / 4, scr, c.lane); continue; } r -= I_UV;
        if (r < I_A) { transpose_item(p.w_bm, 1024, 2048, MapOff{0}, nullptr, (bf16_t*)(ws + OFF_WA), r % 16, r / 16, scr, c.lane); continue; } r -= I_A;
        if (r < I_B) { transpose_item(p.w_bs, 1024, 2048, MapOff{0}, nullptr, (bf16_t*)(ws + OFF_WB), r % 16, r / 16, scr, c.lane); continue; } r -= I_B;
        if (r < I_OUT) { transpose_item(p.w_out, 2048, 2048, MapOff{0}, nullptr, (bf16_t*)(ws + OFF_WOUT), r % 32, r / 32, scr, c.lane); continue; } r -= I_OUT;
        transpose_item(p.w_pq, 2048, 2048, MapOff{0}, nullptr, (bf16_t*)(ws + OFF_WPQ), r % 32, r / 32, scr, c.lane);
    }
    { bf16_t* kd = (bf16_t*)(ws + OFF_KEYS);
      for (int i = (c.gw * 64 + c.lane) * 4; i < 8 * 2 * 128 * 128; i += c.ngw * 64 * 4) store_bf16x4(kd + i, *(const f32x4*)(p.skeys + i)); }
    { f32x2* cs = (f32x2*)(ws + OFF_CS);
      for (int i = c.gw * 64 + c.lane; i < M * 32; i += c.ngw * 64) {
          const int m = i >> 5, f = i & 31;
          const float ang = (float)p.pos[m] * p.invf[f];
          const double rev = (double)ang * 0.15915494309189533576888;
          const float fr = (float)(rev - __builtin_rint(rev));
          cs[i] = (f32x2){__builtin_amdgcn_cosf(fr), __builtin_amdgcn_sinf(fr)};
      } }
}

DI f32x4 ld_mod4(const float* p) { return *(const f32x4*)p; }
DI f32x4 ld_mod4(const long long* p) { f32x4 r;
#pragma unroll
    for (int e = 0; e < 4; ++e) r[e] = (float)((double)p[e] * (1.0 / 4294967296.0));
    return r; }
template <class MT>
DI void modulate_rows(const float* src, const float* g, const MT* sc, const MT* sh, bf16_t* dst, const Ctx& c) {
    for (int m = c.gw; m < M; m += c.ngw) {
        const int b = m / SEQ;
        const float* xr = src + (size_t)m * D;
        f32x4 v[8]; float ss = 0.f;
#pragma unroll
        for (int j = 0; j < 8; ++j) { v[j] = *(const f32x4*)(xr + (j * 64 + c.lane) * 4); ss += v[j][0] * v[j][0] + v[j][1] * v[j][1] + v[j][2] * v[j][2] + v[j][3] * v[j][3]; }
        const float rstd = rsqrtf(wave_sum(ss) * (1.f / D) + EPS);
#pragma unroll
        for (int j = 0; j < 8; ++j) {
            const int col = (j * 64 + c.lane) * 4;
            const f32x4 gg = *(const f32x4*)(g + col), s1 = ld_mod4(sc + b * 6 * D + col), h1 = ld_mod4(sh + b * 6 * D + col);
            const f32x4 o = v[j] * rstd * gg * (s1 + 1.f) + h1;
            store_bf16x4(dst + (size_t)m * D + col, o);
        }
    }
}
DI void phase_rowstats(const Params& p, const Ctx& c) {
    const bf16_t* cq = (const bf16_t*)(p.ws + OFF_CQ); const bf16_t* ckv = (const bf16_t*)(p.ws + OFF_CKV);
    float* rq = (float*)(p.ws + OFF_RSTQ); float* rkv = (float*)(p.ws + OFF_RSTKV);
    for (int m = c.gw; m < M; m += c.ngw) {
        const u32x4 a = *(const u32x4*)(cq + (size_t)m * 512 + c.lane * 8);
        const u32x2 b = *(const u32x2*)(ckv + (size_t)m * 256 + c.lane * 4);
        float s1 = 0.f, s2 = 0.f;
#pragma unroll
        for (int e = 0; e < 4; ++e) { const float lo = bflo(a[e]), hi = bfhi(a[e]); s1 += lo * lo + hi * hi; }
#pragma unroll
        for (int e = 0; e < 2; ++e) { const float lo = bflo(b[e]), hi = bfhi(b[e]); s2 += lo * lo + hi * hi; }
        s1 = wave_sum(s1); s2 = wave_sum(s2);
        if (c.lane == 0) { rq[m] = rsqrtf(s1 * (1.f / 512.f) + EPS); rkv[m] = rsqrtf(s2 * (1.f / 256.f) + EPS); }
    }
}
typedef float f32x16v __attribute__((ext_vector_type(16)));
typedef float f32x32v __attribute__((ext_vector_type(32)));
typedef unsigned u32x6 __attribute__((ext_vector_type(6)));
#ifndef FP6_ORDER
#define FP6_ORDER 1
#endif
DI void convert_table(const float* src, unsigned char* dst, float scale, const Ctx& c) {
    const size_t ngroups = (size_t)16384 * 64;
    for (size_t gi = (size_t)c.gw * 64 + c.lane; gi < ngroups; gi += (size_t)c.ngw * 64) {
        const size_t row = gi >> 6; const int l = (int)(gi & 63);
        const float* sp = src + row * 2048 + l * 32;
        f32x4 v[8];
#pragma unroll
        for (int i = 0; i < 8; ++i) v[i] = *(const f32x4*)(sp + 4 * i) * scale;
        f32x16v a, b;
#pragma unroll
        for (int e = 0; e < 16; ++e) {
#if FP6_ORDER == 0
            a[e] = v[e >> 2][e & 3]; b[e] = v[4 + (e >> 2)][e & 3];
#else
            a[e] = v[(2 * e) >> 2][(2 * e) & 3]; b[e] = v[(2 * e + 1) >> 2][(2 * e + 1) & 3];
#endif
        }
        const u32x6 pk = __builtin_amdgcn_cvt_scalef32_2xpk16_fp6_f32(a, b, 1.0f);
        unsigned char* dp = dst + row * 1536;
        *(u32x4*)(dp + 16 * l) = (u32x4){pk[0], pk[1], pk[2], pk[3]};
        *(u32x2*)(dp + 1024 + 8 * l) = (u32x2){pk[4], pk[5]};
    }
}

struct EpiProj {
    bf16_t *cq, *ckv, *kr, *sbq, *sbk, *ga, *gb; const f32x2* cs;
    DI void operator()(int row, int col, f32x4 v) const {
        const int tile = col >> 8;
        if (tile < 2) { store_bf16x4(cq + (size_t)row * 512 + col, v); }
        else if (tile == 2) { store_bf16x4(ckv + (size_t)row * 256 + (col - 512), v); }
        else if (tile == 3) { const int j = col - 768; if (j < 64) { const f32x2 c0 = cs[row * 32 + (j >> 1)], c1 = cs[row * 32 + (j >> 1) + 1];
            const f32x4 o = {v[0] * c0.x - v[1] * c0.y, v[1] * c0.x + v[0] * c0.y, v[2] * c1.x - v[3] * c1.y, v[3] * c1.x + v[2] * c1.y};
            store_bf16x4(kr + (size_t)row * 64 + j, o); } }
        else if (tile < 8) { store_bf16x4(sbq + (size_t)row * 1024 + (col - 1024), v * (0.08838834764831845f * LOG2E)); }
        else if (tile < 12) { store_bf16x4(sbk + (size_t)row * 1024 + (col - 2048), v); }
        else if (tile < 20) { store_bf16x4(ga + (size_t)row * 2048 + (col - 3072), (f32x4){sigmoidf_(v[0]), sigmoidf_(v[1]), sigmoidf_(v[2]), sigmoidf_(v[3])}); }
        else { store_bf16x4(gb + (size_t)row * 2048 + (col - 5120), (f32x4){sigmoidf_(v[0]), sigmoidf_(v[1]), sigmoidf_(v[2]), sigmoidf_(v[3])}); }
    }    DI void operator()(int row, int col, f32x4 v0, f32x4 v1) const {
        const int tile = col >> 8;
        if (tile < 2) { store_bf16x8(cq + (size_t)row * 512 + col, v0, v1); }
        else if (tile == 2) { store_bf16x8(ckv + (size_t)row * 256 + (col - 512), v0, v1); }
        else if (tile == 3) { const int j = col - 768; if (j < 64) { const f32x2* cp = cs + row * 32 + (j >> 1);
            store_bf16x8(kr + (size_t)row * 64 + j, rope4(v0, cp[0], cp[1]), rope4(v1, cp[2], cp[3])); } }
        else if (tile < 8) { const float sc = 0.08838834764831845f * LOG2E; store_bf16x8(sbq + (size_t)row * 1024 + (col - 1024), v0 * sc, v1 * sc); }
        else if (tile < 12) { store_bf16x8(sbk + (size_t)row * 1024 + (col - 2048), v0, v1); }
        else if (tile < 20) { store_bf16x8(ga + (size_t)row * 2048 + (col - 3072), sig4(v0), sig4(v1)); }
        else { store_bf16x8(gb + (size_t)row * 2048 + (col - 5120), sig4(v0), sig4(v1)); }
    }
};
struct EpiT { bf16_t* o; const float* cscale;
    DI void operator()(int row, int col, f32x4 v) const { if (cscale) v = v * *(const f32x4*)(cscale + col); store_bf16x4(o + (size_t)row * M + col, v); }
    DI void operator()(int row, int col, f32x4 v0, f32x4 v1) const { if (cscale) { v0 = v0 * *(const f32x4*)(cscale + col); v1 = v1 * *(const f32x4*)(cscale + col + 4); } store_bf16x8(o + (size_t)row * M + col, v0, v1); } };
struct EpiUq { bf16_t* q; const float* rst; const f32x2* cs;
    DI void operator()(int row, int col, f32x4 v) const {
        v = v * (rst[row] * (0.07216878364870322f * LOG2E));
        const int j = col % 192;
        if (j >= 128) { const int i0 = (j - 128) >> 1; const f32x2 c0 = cs[row * 32 + i0], c1 = cs[row * 32 + i0 + 1];
            v = (f32x4){v[0] * c0.x - v[1] * c0.y, v[1] * c0.x + v[0] * c0.y, v[2] * c1.x - v[3] * c1.y, v[3] * c1.x + v[2] * c1.y}; }
        store_bf16x4(q + (size_t)row * 1536 + col, v);
    }
    DI void operator()(int row, int col, f32x4 v0, f32x4 v1) const {
        const float sc = rst[row] * (0.07216878364870322f * LOG2E); v0 = v0 * sc; v1 = v1 * sc;
        const int j = col % 192;
        if (j >= 128) { const f32x2* cp = cs + row * 32 + ((j - 128) >> 1); v0 = rope4(v0, cp[0], cp[1]); v1 = rope4(v1, cp[2], cp[3]); }
        store_bf16x8(q + (size_t)row * 1536 + col, v0, v1);
    } };
struct EpiRowScale { bf16_t* o; int ld; const float* rst;
    DI void operator()(int row, int col, f32x4 v) const { store_bf16x4(o + (size_t)row * ld + col, v * rst[row]); }
    DI void operator()(int row, int col, f32x4 v0, f32x4 v1) const { const float sc = rst[row]; store_bf16x8(o + (size_t)row * ld + col, v0 * sc, v1 * sc); } };
struct EpiGate1 { bf16_t* mg; const bf16_t* g;
    DI void operator()(int row, int col, f32x4 v) const { const size_t i = (size_t)row * 2048 + col; store_bf16x4(mg + i, v * load_bf16x4(g + i)); }
    DI void operator()(int row, int col, f32x4 v0, f32x4 v1) const { const size_t i = (size_t)row * 2048 + col; f32x4 g0, g1; load_bf16x8(g + i, g0, g1); store_bf16x8(mg + i, v0 * g0, v1 * g1); } };
struct EpiGate2 { bf16_t* mg; const bf16_t* g;
    DI void operator()(int row, int col, f32x4 v) const { const size_t i = (size_t)row * 2048 + col; store_bf16x4(mg + i, load_bf16x4(mg + i) + v * load_bf16x4(g + i)); }
    DI void operator()(int row, int col, f32x4 v0, f32x4 v1) const { const size_t i = (size_t)row * 2048 + col; f32x4 g0, g1, m0, m1; load_bf16x8(g + i, g0, g1); load_bf16x8(mg + i, m0, m1); store_bf16x8(mg + i, m0 + v0 * g0, m1 + v1 * g1); } };
struct EpiRes { const float* x; const float* gt; float* x1;
    DI void operator()(int row, int col, f32x4 v) const { const size_t i = (size_t)row * 2048 + col; const int b = row / SEQ;
        *(f32x4*)(x1 + i) = *(const f32x4*)(x + i) + *(const f32x4*)(gt + b * 6 * D + col) * v * DBG_ALPHA; }
    DI void operator()(int row, int col, f32x4 v0, f32x4 v1) const { (*this)(row, col, v0); (*this)(row, col + 4, v1); } };
struct EpiPq { bf16_t* pq;
    DI void operator()(int row, int col, f32x4 v) const { store_bf16x4(pq + (size_t)(col >> 8) * M * 256 + (size_t)row * 256 + (col & 255), v); }
    DI void operator()(int row, int col, f32x4 v0, f32x4 v1) const { store_bf16x8(pq + (size_t)(col >> 8) * M * 256 + (size_t)row * 256 + (col & 255), v0, v1); } };

template <class Epi>
DI void gemm_naive(const Ctx& c, const bf16_t* A, const bf16_t* Bt, int Mg, int Ng, int Kg, const Epi& E) {
    LAS float* As = (LAS float*)c.lds; LAS float* Bs = As + 16 * 132;
    const int tid = c.tid, ty = tid >> 5, tx = tid & 31;
    const int tilesN = Ng / 128, ntiles = (Mg / 128) * tilesN;
    for (int t = blockIdx.x; t < ntiles; t += gridDim.x) {
        const int tm = t / tilesN, tn = t % tilesN;
        float acc[8][4];
#pragma unroll
        for (int i = 0; i < 8; ++i)
#pragma unroll
            for (int j = 0; j < 4; ++j) acc[i][j] = 0.f;
        for (int k0 = 0; k0 < Kg; k0 += 16) {
            { const int lt = tid & 255, r = lt >> 1, kc = lt & 1;
              const bf16_t* src = (tid < 256 ? A + (size_t)(tm * 128 + r) * Kg : Bt + (size_t)(tn * 128 + r) * Kg) + k0 + kc * 8;
              const u32x4 v = *(const u32x4*)src;
              LAS float* dst = (tid < 256 ? As : Bs) + (kc * 8) * 132 + r;
              dst[0] = bflo(v.x); dst[132] = bfhi(v.x); dst[2 * 132] = bflo(v.y); dst[3 * 132] = bfhi(v.y);
              dst[4 * 132] = bflo(v.z); dst[5 * 132] = bfhi(v.z); dst[6 * 132] = bflo(v.w); dst[7 * 132] = bfhi(v.w); }
            __syncthreads();
#pragma unroll
            for (int kk = 0; kk < 16; ++kk) {
                const f32x4 a0 = *(const LAS f32x4*)(As + kk * 132 + ty * 8), a1 = *(const LAS f32x4*)(As + kk * 132 + ty * 8 + 4);
                const f32x4 b = *(const LAS f32x4*)(Bs + kk * 132 + tx * 4);
#pragma unroll
                for (int j = 0; j < 4; ++j) {
                    acc[0][j] += a0[0] * b[j]; acc[1][j] += a0[1] * b[j]; acc[2][j] += a0[2] * b[j]; acc[3][j] += a0[3] * b[j];
                    acc[4][j] += a1[0] * b[j]; acc[5][j] += a1[1] * b[j]; acc[6][j] += a1[2] * b[j]; acc[7][j] += a1[3] * b[j];
                }
            }
            __syncthreads();
        }
#pragma unroll
        for (int i = 0; i < 8; ++i) E(tm * 128 + ty * 8 + i, tn * 128 + tx * 4, (f32x4){acc[i][0], acc[i][1], acc[i][2], acc[i][3]});
    }
}

namespace pg8 {
#define PG8_LAS __attribute__((address_space(3)))
typedef unsigned short bf16_t;
typedef short bf16x8 __attribute__((ext_vector_type(8)));
typedef float f32x4 __attribute__((ext_vector_type(4)));
typedef unsigned u32x4 __attribute__((ext_vector_type(4)));
constexpr int BM = 256, BK = 64, HALF = 128, HTB = HALF * BK * 2  , STAGE_BYTES = 8 * HTB, NXCD = 8, WGM = 4;

__host__ __device__ __forceinline__ int lds_byte(int r, int c) { const int st = (r >> 4) * 2 + (c >> 5), rr = r & 15, cc = c & 31, ob = rr * 64 + cc * 2; return st * 1024 + (ob ^ (((ob >> 9) & 1) << 5)); }
__host__ __device__ __forceinline__ void stage_rc(int b, int& R, int& C) { const int st = b / 1024, sb = b % 1024, swz = sb ^ (((sb >> 9) & 1) << 5); R = (st >> 1) * 16 + swz / 64; C = (st & 1) * 32 + (swz % 64) / 2; }
__host__ __device__ __forceinline__ int perm32(int rho) { const int n = rho >> 4, i = rho & 15; return 8 * (i >> 2) + 4 * n + (i & 3); }

struct Unit { int pm, pn; };
struct Gemm { const bf16_t* A; const bf16_t* Bt; int M, N, K; int tid; };
struct StaticOrder {
    int nM, nN, nwg, G, c;
    __host__ __device__ void init(int M, int N, int G_, int c_) { nM = M / BM; nN = N / BM; nwg = nM * nN; G = G_; c = c_; }
    __host__ __device__ bool next(int i, Unit& u) const {
        const long L = (long)i * G + c; if (L >= nwg) return false;
        int wgid = (int)L; { const int q = nwg / NXCD, r = nwg % NXCD, xcd = wgid % NXCD, off = wgid / NXCD; wgid = (xcd < r ? xcd * (q + 1) : r * (q + 1) + (xcd - r) * q) + off; }
        const int nig = WGM * nN, gid = wgid / nig, fm = gid * WGM, gsz = (nM - fm) < WGM ? (nM - fm) : WGM;
        u.pm = fm + ((wgid % nig) % gsz); u.pn = (wgid % nig) / gsz; return true;
    }
    __device__ __forceinline__ void a_ready(const Unit&) const {}
    __device__ __forceinline__ void done(const Unit&) const {}
};
template <class Epi, class Sched, bool STAMP = false>
__device__ __forceinline__ void gemm_phase(PG8_LAS unsigned char* lds, const Gemm g, const Sched& S, const Epi& E, unsigned long long* stamps) {
    const int tid = g.tid, wid = __builtin_amdgcn_readfirstlane(tid >> 6), lane = tid & 63, wr = wid >> 2, wc = wid & 3, fr = lane & 15, fq = lane >> 4;
    const int K = g.K, nt = K / BK;
    int ts_lo = 0, ts_hi = 0, nts = 0; const unsigned long long rt_entry = STAMP ? (unsigned long long)wall_clock64() : 0ull;
#define PG8_STAMP() do { if (STAMP && wid == 0 && nts < 64) { const unsigned long long _c = (unsigned long long)clock64(); \
        ts_lo = (lane == nts) ? (int)(unsigned)_c : ts_lo; ts_hi = (lane == nts) ? (int)(unsigned)(_c >> 32) : ts_hi; ++nts; } } while (0)
    PG8_STAMP();
    unsigned voffA[2], voffB[2];
#pragma unroll
    for (int i = 0; i < 2; ++i) { int R, C; stage_rc(tid * 16 + i * 8192, R, C); const int Rb = Epi::PERM ? ((R & ~31) + perm32(R & 31)) : R;
        voffA[i] = (unsigned)(R * K + C) * 2u; voffB[i] = (unsigned)(Rb * K + C) * 2u; }
    const size_t kstep = (size_t)(BK * 2);
    const size_t hstep = (size_t)HALF * K * 2;
    const size_t tstep = 2 * hstep;
    const unsigned ldsw = (unsigned)wid * 1024u;
    const int aoff = lds_byte(wr * 64 + fr, fq * 8), boff = lds_byte(wc * 32 + fr, fq * 8);
#define PG8_SA(b, h) (((b) * 2 + (h)) * HTB)
#define PG8_SB(b, h) ((4 + (b) * 2 + (h)) * HTB)
#define PG8_STAGE(bufoff, gbase, voff) do { _Pragma("unroll") for (int _i = 0; _i < 2; ++_i) \
        __builtin_amdgcn_global_load_lds((const unsigned*)((const char*)(gbase) + (voff)[_i]), (PG8_LAS unsigned*)(lds + (bufoff) + ldsw + _i * 8192), 16, 0, 0); } while (0)
#define PG8_LDA(dst, b, h) do { _Pragma("unroll") for (int m = 0; m < 4; ++m) _Pragma("unroll") for (int k = 0; k < 2; ++k) dst[m][k] = *(const PG8_LAS bf16x8*)(lds + PG8_SA(b, h) + aoff + m * 2048 + k * 1024); } while (0)
#define PG8_LDB(dst, b, h) do { _Pragma("unroll") for (int n = 0; n < 2; ++n) _Pragma("unroll") for (int k = 0; k < 2; ++k) dst[n][k] = *(const PG8_LAS bf16x8*)(lds + PG8_SB(b, h) + boff + n * 2048 + k * 1024); } while (0)
#define PG8_MMA(ai, bj, At, Bt) do { __builtin_amdgcn_s_setprio(1); _Pragma("unroll") for (int m = 0; m < 4; ++m) _Pragma("unroll") for (int n = 0; n < 2; ++n) _Pragma("unroll") for (int k = 0; k < 2; ++k) \
        acc[ai][bj][m][n] = __builtin_amdgcn_mfma_f32_16x16x32_bf16(Bt[n][k], At[m][k], acc[ai][bj][m][n], 0, 0, 0); __builtin_amdgcn_s_setprio(0); } while (0)
#define PG8_WAIT_V(n) asm volatile("s_waitcnt vmcnt(" #n ")" ::: "memory")
#define PG8_WAIT_L(n) asm volatile("s_waitcnt lgkmcnt(" #n ")" ::: "memory")
#define PG8_BAR __builtin_amdgcn_s_barrier()
#define PG8_SCHED __builtin_amdgcn_sched_barrier(0)
    Unit cur, nxt; int ui = 0;
    if (!S.next(0, cur)) return;
    f32x4 acc[2][2][4][2];
#pragma unroll
    for (int a = 0; a < 2; ++a)
#pragma unroll
        for (int b = 0; b < 2; ++b)
#pragma unroll
            for (int m = 0; m < 4; ++m)
#pragma unroll
                for (int n = 0; n < 2; ++n) acc[a][b][m][n] = (f32x4){0.f, 0.f, 0.f, 0.f};
    bf16x8 At[4][2], B0[2][2], B1[2][2];
    const char* cA = (const char*)g.A + (size_t)cur.pm * tstep; const char* cB = (const char*)g.Bt + (size_t)cur.pn * tstep;
    S.a_ready(cur);
    PG8_STAGE(PG8_SB(0, 0), cB, voffB); PG8_STAGE(PG8_SA(0, 0), cA, voffA); PG8_STAGE(PG8_SB(0, 1), cB + hstep, voffB); PG8_STAGE(PG8_SA(0, 1), cA + hstep, voffA);
    if (wr == 1) PG8_BAR;
    PG8_WAIT_V(4); PG8_BAR;
    PG8_STAGE(PG8_SB(1, 0), cB + kstep, voffB); PG8_STAGE(PG8_SA(1, 0), cA + kstep, voffA); PG8_STAGE(PG8_SB(1, 1), cB + hstep + kstep, voffB);
    PG8_WAIT_V(6); PG8_BAR;
    PG8_STAMP();
    for (;;) {
        const bool has_next = S.next(ui + 1, nxt);
        const char* nA = has_next ? (const char*)g.A + (size_t)nxt.pm * tstep : cA; const char* nB = has_next ? (const char*)g.Bt + (size_t)nxt.pn * tstep : cB;
        for (int t = 0; t < nt; t += 2) {
            const bool last = (t == nt - 2);
            const char* a1 = cA + (size_t)(t + 1) * kstep;
            const char* a2 = last ? nA : cA + (size_t)(t + 2) * kstep; const char* b2 = last ? nB : cB + (size_t)(t + 2) * kstep;
            const char* a3 = a2 + kstep; const char* b3 = b2 + kstep;
            if (last && has_next) S.a_ready(nxt);
            PG8_LDB(B0, 0, 0); PG8_SCHED; PG8_LDA(At, 0, 0); PG8_STAGE(PG8_SA(1, 1), a1 + hstep, voffA);
            PG8_WAIT_L(8); PG8_BAR; PG8_WAIT_L(0); PG8_MMA(0, 0, At, B0); PG8_BAR; PG8_SCHED;
            PG8_LDB(B1, 0, 1); PG8_STAGE(PG8_SB(0, 0), b2, voffB);
            PG8_BAR; PG8_WAIT_L(0); PG8_MMA(0, 1, At, B1); PG8_BAR;
            PG8_LDA(At, 0, 1); PG8_STAGE(PG8_SA(0, 0), a2, voffA);
            PG8_BAR; PG8_WAIT_L(0); PG8_MMA(1, 0, At, B0); PG8_BAR; PG8_SCHED;
            PG8_STAGE(PG8_SB(0, 1), b2 + hstep, voffB);
            PG8_WAIT_V(6); PG8_BAR; PG8_MMA(1, 1, At, B1); PG8_BAR;
            PG8_LDB(B0, 1, 0); PG8_SCHED; PG8_LDA(At, 1, 0); PG8_STAGE(PG8_SA(0, 1), a2 + hstep, voffA);
            PG8_WAIT_L(8); PG8_BAR; PG8_WAIT_L(0); PG8_MMA(0, 0, At, B0); PG8_BAR; PG8_SCHED;
            PG8_LDB(B1, 1, 1); PG8_STAGE(PG8_SB(1, 0), b3, voffB);
            PG8_BAR; PG8_WAIT_L(0); PG8_MMA(0, 1, At, B1); PG8_BAR;
            PG8_LDA(At, 1, 1); PG8_STAGE(PG8_SA(1, 0), a3, voffA);
            PG8_BAR; PG8_WAIT_L(0); PG8_MMA(1, 0, At, B0); PG8_BAR; PG8_SCHED;
            PG8_STAGE(PG8_SB(1, 1), b3 + hstep, voffB);
            PG8_WAIT_V(6); PG8_BAR; PG8_MMA(1, 1, At, B1); PG8_BAR;
        }
        PG8_STAMP();
        if constexpr (!Epi::AFTER_DRAIN) { E(acc, cur, wr, wc, fr, fq); S.done(cur); }
        PG8_STAMP();
        if (!has_next) break;
#pragma unroll
        for (int a = 0; a < 2; ++a)
#pragma unroll
            for (int b = 0; b < 2; ++b)
#pragma unroll
                for (int m = 0; m < 4; ++m)
#pragma unroll
                    for (int n = 0; n < 2; ++n) acc[a][b][m][n] = (f32x4){0.f, 0.f, 0.f, 0.f};
        cur = nxt; cA = nA; cB = nB; ++ui;
    }
    PG8_WAIT_V(0);
    if (wr == 0) PG8_BAR;
    PG8_BAR;
    if constexpr (Epi::AFTER_DRAIN) { E.fused(acc, cur, wr, wc, fr, fq, lds, wid, lane); S.done(cur); }
    PG8_STAMP();
    if (STAMP && wid == 0) { stamps[lane] = lane < nts ? (((unsigned long long)(unsigned)ts_hi << 32) | (unsigned)ts_lo) : 0ull;
        if (lane == 62) stamps[62] = rt_entry; if (lane == 63) stamps[63] = (unsigned long long)wall_clock64(); }
#undef PG8_STAMP
#undef PG8_SA
#undef PG8_SB
#undef PG8_STAGE
#undef PG8_LDA
#undef PG8_LDB
#undef PG8_MMA
#undef PG8_WAIT_V
#undef PG8_WAIT_L
#undef PG8_BAR
#undef PG8_SCHED
}
}

template <class E4> struct EpiAdapt {
    static constexpr bool PERM = true, AFTER_DRAIN = false;
    E4 e;
    __device__ __forceinline__ void operator()(const pg8::f32x4 (&acc)[2][2][4][2], const pg8::Unit& u, int wr, int wc, int fr, int fq) const {
#pragma unroll
        for (int ai = 0; ai < 2; ++ai)
#pragma unroll
            for (int m = 0; m < 4; ++m) {
                const int row = u.pm * 256 + ai * 128 + wr * 64 + m * 16 + fr;
#pragma unroll
                for (int bj = 0; bj < 2; ++bj) e(row, u.pn * 256 + bj * 128 + wc * 32 + fq * 8, acc[ai][bj][m][0], acc[ai][bj][m][1]);
                asm volatile("" ::: "memory");
            }
    }
};
template <class E4>
DI void gemm_fast(const Ctx& c, const bf16_t* A, const bf16_t* Bt, int Mg, int Ng, int Kg, const E4& e4) {
    pg8::Gemm g{A, Bt, Mg, Ng, Kg, c.tid}; pg8::StaticOrder S; S.init(Mg, Ng, (int)gridDim.x, (int)blockIdx.x);
    EpiAdapt<E4> E{e4};
    pg8::gemm_phase<EpiAdapt<E4>, pg8::StaticOrder, false>((PG8_LAS unsigned char*)c.lds, g, S, E, nullptr);
}
#ifndef FAST_GEMM
#define FAST_GEMM 1
#endif
#if FAST_GEMM
#define GEMM(c_, ...) do { MKCTX(); gemm_fast(c, __VA_ARGS__); } while (0)
#else
#define GEMM(c_, ...) do { MKCTX(); gemm_naive(c, __VA_ARGS__); } while (0)
#endif

DI void attn_mla_naive(const Params& p, const Ctx& c) {
    const bf16_t* Q = (const bf16_t*)(p.ws + OFF_Q); const bf16_t* KN = (const bf16_t*)(p.ws + OFF_KN); const bf16_t* KR = (const bf16_t*)(p.ws + OFF_KR);
    const bf16_t* VT = (const bf16_t*)(p.ws + OFF_VT); bf16_t* O = (bf16_t*)(p.ws + OFF_ATTA);
    for (int u = c.gw; u < M * 8; u += c.ngw) {
        const int m = u >> 3, hd = u & 7, b = m / SEQ, s = m % SEQ, base = b * SEQ, nkeys = ((s >> 6) + 1) << 6;
        const float q0 = bf2f(Q[(size_t)m * 1536 + hd * 192 + c.lane]), q1 = bf2f(Q[(size_t)m * 1536 + hd * 192 + 64 + c.lane]), q2 = bf2f(Q[(size_t)m * 1536 + hd * 192 + 128 + c.lane]);
        float mx = -1e30f, l = 0.f, o0 = 0.f, o1 = 0.f;
        const bf16_t* v0p = VT + (size_t)(hd * 128 + c.lane) * M + base; const bf16_t* v1p = v0p + (size_t)64 * M;
        for (int kk = 0; kk < nkeys; ++kk) {
            const size_t tk = base + kk;
            const float part = q0 * bf2f(KN[tk * 1024 + hd * 128 + c.lane]) + q1 * bf2f(KN[tk * 1024 + hd * 128 + 64 + c.lane]) + q2 * bf2f(KR[tk * 64 + c.lane]);
            const float sc = wave_sum(part);
            const float mn = fmaxf(mx, sc), al = exp2f(mx - mn), pp = exp2f(sc - mn);
            l = l * al + pp; o0 = o0 * al + pp * bf2f(v0p[kk]); o1 = o1 * al + pp * bf2f(v1p[kk]); mx = mn;
        }
        const float inv = 1.f / l;
        O[(size_t)m * 1024 + hd * 128 + c.lane] = (bf16_t)(pk2(o0 * inv, 0.f) & 0xffff);
        O[(size_t)m * 1024 + hd * 128 + 64 + c.lane] = (bf16_t)(pk2(o1 * inv, 0.f) & 0xffff);
    }
}
DI void attn_sb_naive(const Params& p, const Ctx& c) {
    const bf16_t* Q = (const bf16_t*)(p.ws + OFF_SBQ); const bf16_t* K = (const bf16_t*)(p.ws + OFF_SBK);
    const bf16_t* VT = (const bf16_t*)(p.ws + OFF_SBVT); bf16_t* O = (bf16_t*)(p.ws + OFF_ATTB);
    for (int u = c.gw; u < M * 8; u += c.ngw) {
        const int m = u >> 3, hd = u & 7, b = m / SEQ, s = m % SEQ, base = b * SEQ;
        const float q0 = bf2f(Q[(size_t)m * 1024 + hd * 128 + c.lane]), q1 = bf2f(Q[(size_t)m * 1024 + hd * 128 + 64 + c.lane]);
        float later = 0.f, o0 = 0.f, o1 = 0.f;
        const bf16_t* v0p = VT + (size_t)(hd * 128 + c.lane) * M + base; const bf16_t* v1p = v0p + (size_t)64 * M;
        for (int kk = s - 1; kk >= 0; --kk) {
            const size_t tk = base + kk;
            const float z2 = wave_sum(q0 * bf2f(K[tk * 1024 + hd * 128 + c.lane]) + q1 * bf2f(K[tk * 1024 + hd * 128 + 64 + c.lane]));
            const float ln2 = -(fmaxf(z2, 0.f) + __log2f(1.f + exp2f(-fabsf(z2))));
            const float w = exp2f(z2 + ln2 + later);
            later += ln2; o0 += w * bf2f(v0p[kk]); o1 += w * bf2f(v1p[kk]);
        }
        O[(size_t)m * 1024 + hd * 128 + c.lane] = (bf16_t)(pk2(o0, 0.f) & 0xffff);
        O[(size_t)m * 1024 + hd * 128 + 64 + c.lane] = (bf16_t)(pk2(o1, 0.f) & 0xffff);
    }
}


typedef float f32x16 __attribute__((ext_vector_type(16)));
#define MFMA32(a, b, c) __builtin_amdgcn_mfma_f32_32x32x16_bf16((a), (b), (c), 0, 0, 0)
constexpr int ST_KR = 16384, ST_VT = 24576, ST_BYTES = 40960;
constexpr int ATT_FLAGS = 2 * ST_BYTES;
DI float ex2(float x) { return __builtin_amdgcn_exp2f(x); }
DI float lg2(float x) { return __builtin_amdgcn_logf(x); }
DI bf16x8 pack8(float a0, float a1, float a2, float a3, float a4, float a5, float a6, float a7) {
    u32x4 t; t.x = pk2(a0, a1); t.y = pk2(a2, a3); t.z = pk2(a4, a5); t.w = pk2(a6, a7); return __builtin_bit_cast(bf16x8, t); }
#define GLDS16(gp, lp) __builtin_amdgcn_global_load_lds((const unsigned*)(gp), (LAS unsigned*)(lp), 16, 0, 0)

struct AttDmaOff { unsigned kn[2], kr, vt[2]; };
DI AttDmaOff att_dma_offsets(int w, int lane) {
    AttDmaOff o; const unsigned lr = lane >> 4, pp = lane & 15;
#pragma unroll
    for (int i = 0; i < 2; ++i) { const unsigned q = w * 2 + i, R = 4 * q + lr, cc = pp ^ (R & 15); o.kn[i] = R * 2048u + cc * 16u; }
    { const unsigned q = w, R2 = 4 * q + lr, cc = pp ^ (R2 & 15); o.kr = (2 * R2 + (cc >> 3)) * 128u + (cc & 7) * 16u; }
#pragma unroll
    for (int i = 0; i < 2; ++i) { const unsigned q = w * 2 + i, R2 = 4 * q + lr, cc = pp ^ (R2 & 15); o.vt[i] = (2 * R2 + (cc >> 3)) * (unsigned)(M * 2) + (cc & 7) * 16u; }
    return o;
}
template <bool ROPE>
DI void att_dma(LAS unsigned char* buf, __amdgpu_buffer_rsrc_t rs, const AttDmaOff& o, unsigned k_so, unsigned kr_so, unsigned vt_so, int w) {
#pragma unroll
    for (int i = 0; i < 2; ++i) __builtin_amdgcn_raw_ptr_buffer_load_lds(rs, (LAS void*)(buf + (w * 2 + i) * 1024), 16, o.kn[i], k_so, 0, 0);
    if (ROPE) __builtin_amdgcn_raw_ptr_buffer_load_lds(rs, (LAS void*)(buf + ST_KR + w * 1024), 16, o.kr, kr_so, 0, 0);
#pragma unroll
    for (int i = 0; i < 2; ++i) __builtin_amdgcn_raw_ptr_buffer_load_lds(rs, (LAS void*)(buf + ST_VT + (w * 2 + i) * 1024), 16, o.vt[i], vt_so, 0, 0);
}
DI void att_store(const f32x16 (&o)[4], float scale, bf16_t* O, size_t row, int hd, int h) {
#pragma unroll
    for (int db = 0; db < 4; ++db)
#pragma unroll
        for (int g = 0; g < 4; ++g)
            store_bf16x4(O + row * 1024 + hd * 128 + db * 32 + g * 8 + h * 4, (f32x4){o[db][4 * g] * scale, o[db][4 * g + 1] * scale, o[db][4 * g + 2] * scale, o[db][4 * g + 3] * scale});
}
DI void att_pv(f32x16 (&o)[4], const bf16x8 (&pf)[2][2], const LAS unsigned char* buf, unsigned va) {
#pragma unroll
    for (int db = 0; db < 4; ++db) {
#pragma unroll
        for (int blk = 0; blk < 2; ++blk)
#pragma unroll
            for (int ks = 0; ks < 2; ++ks) o[db] = MFMA32(*(const LAS bf16x8*)(buf + ((va ^ ((blk * 2 + ks) << 5)) + db * 4096)), pf[blk][ks], o[db]);
        asm volatile("" ::: "memory");
    }
}

DI void attn_mla_fast(const Params& p, const Ctx& c) {
    const bf16_t* Q = (const bf16_t*)(p.ws + OFF_Q); const bf16_t* KN = (const bf16_t*)(p.ws + OFF_KN); const bf16_t* KR = (const bf16_t*)(p.ws + OFF_KR);
    const bf16_t* VT = (const bf16_t*)(p.ws + OFF_VT); bf16_t* O = (bf16_t*)(p.ws + OFF_ATTA);
    const int lane = c.lane, r = lane & 31, h = lane >> 5, w = c.wave;
    const int pr = (r & 0x13) | ((r & 4) << 1) | ((r & 8) >> 1);
    const unsigned ka = (pr << 8) | ((((pr & 15) ^ h) & 15) << 4);
    const unsigned ra = ST_KR + (((pr >> 1) << 8) | (((((pr & 1) << 3) | h) ^ ((pr >> 1) & 15)) << 4));
    const unsigned va = ST_VT + (((r >> 1) << 8) | (((((r & 1) << 3) | h) ^ ((r >> 1) & 15)) << 4));
    const __amdgpu_buffer_rsrc_t rs = __builtin_amdgcn_make_buffer_rsrc((void*)p.ws, (short)0, (int)WS_END, 0x00020000);
    const AttDmaOff dof = att_dma_offsets(w, lane);
    for (int it = blockIdx.x; it < 256; it += gridDim.x) {
        const int bh = it & 31, b = bh >> 3, hd = bh & 7, pairi = it >> 5;
#pragma unroll 1
        for (int half = 0; half < 2; ++half) {
            const int qb = half ? 15 - pairi : pairi, q0 = qb * 256;
            const size_t base = (size_t)b * SEQ, qrow = base + q0 + w * 32 + r;
            bf16x8 qf[12];
#pragma unroll
            for (int st = 0; st < 12; ++st) qf[st] = *(const bf16x8*)(Q + qrow * 1536 + hd * 192 + st * 16 + h * 8);
            const int ntile = q0 / 64 + 4, myn = (q0 + w * 32) / 64 + 1;
            f32x16 o[4];
#pragma unroll
            for (int db = 0; db < 4; ++db)
#pragma unroll
                for (int i = 0; i < 16; ++i) o[db][i] = 0.f;
            float mrun = -1e30f, lrun = 0.f;
            __syncthreads();
            const unsigned k_so0 = (unsigned)(OFF_KN + (base * 1024 + hd * 128) * 2), kr_so0 = (unsigned)(OFF_KR + base * 64 * 2), vt_so0 = (unsigned)(OFF_VT + ((size_t)(hd * 128) * M + base) * 2);
            att_dma<true>(c.lds, rs, dof, k_so0, kr_so0, vt_so0, w);
            asm volatile("s_waitcnt vmcnt(0)" ::: "memory");
            __syncthreads();
            for (int j = 0; j < ntile; ++j) {
                LAS unsigned char* buf = c.lds + (j & 1) * ST_BYTES;
                if (j + 1 < ntile) att_dma<true>(c.lds + ((j + 1) & 1) * ST_BYTES, rs, dof, k_so0 + (unsigned)(j + 1) * (64 * 2048), kr_so0 + (unsigned)(j + 1) * (64 * 128), vt_so0 + (unsigned)(j + 1) * 128, w);
                if (j < myn) {
                    f32x16 s0, s1;
#pragma unroll
                    for (int i = 0; i < 16; ++i) { s0[i] = 0.f; s1[i] = 0.f; }
                    __builtin_amdgcn_s_setprio(1);
#pragma unroll
                    for (int st = 0; st < 8; ++st) {
                        s0 = MFMA32(*(const LAS bf16x8*)(buf + (ka ^ (st << 5))), qf[st], s0);
                        s1 = MFMA32(*(const LAS bf16x8*)(buf + ((ka ^ (st << 5)) + 8192)), qf[st], s1);
                    }
#pragma unroll
                    for (int st = 0; st < 4; ++st) {
                        s0 = MFMA32(*(const LAS bf16x8*)(buf + (ra ^ (st << 5))), qf[8 + st], s0);
                        s1 = MFMA32(*(const LAS bf16x8*)(buf + ((ra ^ (st << 5)) + 4096)), qf[8 + st], s1);
                    }
                    __builtin_amdgcn_s_setprio(0);
                    float mx = fmaxf(s0[0], s1[0]);
#pragma unroll
                    for (int i = 1; i < 16; ++i) mx = fmaxf(mx, fmaxf(s0[i], s1[i]));
                    mx = fmaxf(mx, __shfl_xor(mx, 32));
                    const float mnew = fmaxf(mrun, mx), alpha = ex2(mrun - mnew);
                    mrun = mnew;
                    float ps = 0.f;
#pragma unroll
                    for (int i = 0; i < 16; ++i) { s0[i] = ex2(s0[i] - mnew); s1[i] = ex2(s1[i] - mnew); ps += s0[i] + s1[i]; }
                    lrun = lrun * alpha + ps;
#pragma unroll
                    for (int db = 0; db < 4; ++db)
#pragma unroll
                        for (int i = 0; i < 16; ++i) o[db][i] *= alpha;
                    bf16x8 pf[2][2];
                    pf[0][0] = pack8(s0[0], s0[1], s0[2], s0[3], s0[4], s0[5], s0[6], s0[7]); pf[0][1] = pack8(s0[8], s0[9], s0[10], s0[11], s0[12], s0[13], s0[14], s0[15]);
                    pf[1][0] = pack8(s1[0], s1[1], s1[2], s1[3], s1[4], s1[5], s1[6], s1[7]); pf[1][1] = pack8(s1[8], s1[9], s1[10], s1[11], s1[12], s1[13], s1[14], s1[15]);
                    __builtin_amdgcn_s_setprio(1);
                    att_pv(o, pf, buf, va);
                    __builtin_amdgcn_s_setprio(0);
                }
                asm volatile("s_waitcnt vmcnt(0)" ::: "memory");
                __syncthreads();
            }
            const float ltot = lrun + __shfl_xor(lrun, 32);
            att_store(o, 1.f / ltot, O, qrow, hd, h);
        }
    }
}

DI void attn_sb_fast(const Params& p, const Ctx& c) {
    const bf16_t* Q = (const bf16_t*)(p.ws + OFF_SBQ); const bf16_t* K = (const bf16_t*)(p.ws + OFF_SBK);
    const bf16_t* VT = (const bf16_t*)(p.ws + OFF_SBVT); bf16_t* O = (bf16_t*)(p.ws + OFF_ATTB);
    const int lane = c.lane, r = lane & 31, h = lane >> 5, w = c.wave, tid = c.tid;
    const int pr = (r & 0x13) | ((r & 4) << 1) | ((r & 8) >> 1);
    const unsigned ka = (pr << 8) | ((((pr & 15) ^ h) & 15) << 4);
    const unsigned va = ST_VT + (((r >> 1) << 8) | (((((r & 1) << 3) | h) ^ ((r >> 1) & 15)) << 4));
    const __amdgpu_buffer_rsrc_t rs = __builtin_amdgcn_make_buffer_rsrc((void*)p.ws, (short)0, (int)WS_END, 0x00020000);
    const AttDmaOff dof = att_dma_offsets(w, lane);
    LAS int* flags = (LAS int*)(c.lds + ATT_FLAGS);
    for (int it = blockIdx.x; it < 256; it += gridDim.x) {
        const int bh = it & 31, b = bh >> 3, hd = bh & 7, pairi = it >> 5;
#pragma unroll 1
        for (int half = 0; half < 2; ++half) {
            const int qb = half ? 15 - pairi : pairi, q0 = qb * 256;
            const size_t base = (size_t)b * SEQ, qrow = base + q0 + w * 32 + r;
            const int tq = q0 + w * 32 + r;
            bf16x8 qf[8];
#pragma unroll
            for (int st = 0; st < 8; ++st) qf[st] = *(const bf16x8*)(Q + qrow * 1024 + hd * 128 + st * 16 + h * 8);
            const int jmax = q0 / 64 + 3, jd = (q0 + w * 32) / 64;
            f32x16 o[4];
#pragma unroll
            for (int db = 0; db < 4; ++db)
#pragma unroll
                for (int i = 0; i < 16; ++i) o[db][i] = 0.f;
            float carry = 0.f; bool wdone = false;
            __syncthreads();
            const unsigned k_so0 = (unsigned)(OFF_SBK + (base * 1024 + hd * 128) * 2), vt_so0 = (unsigned)(OFF_SBVT + ((size_t)(hd * 128) * M + base) * 2);
            att_dma<false>(c.lds, rs, dof, k_so0 + (unsigned)jmax * (64 * 2048), 0u, vt_so0 + (unsigned)jmax * 128, w);
            if (tid < 16) flags[tid] = 0;
            asm volatile("s_waitcnt vmcnt(0)" ::: "memory");
            __syncthreads();
            int itn = 0;
            for (int j = jmax; j >= 0; --j, ++itn) {
                LAS unsigned char* buf = c.lds + (itn & 1) * ST_BYTES;
                if (j > 0) att_dma<false>(c.lds + ((itn + 1) & 1) * ST_BYTES, rs, dof, k_so0 + (unsigned)(j - 1) * (64 * 2048), 0u, vt_so0 + (unsigned)(j - 1) * 128, w);
                if (j <= jd && !wdone) {
                    f32x16 s0, s1;
#pragma unroll
                    for (int i = 0; i < 16; ++i) { s0[i] = 0.f; s1[i] = 0.f; }
#pragma unroll
                    for (int st = 0; st < 8; ++st) {
                        s0 = MFMA32(*(const LAS bf16x8*)(buf + (ka ^ (st << 5))), qf[st], s0);
                        s1 = MFMA32(*(const LAS bf16x8*)(buf + ((ka ^ (st << 5)) + 8192)), qf[st], s1);
                    }
                    const int kb0 = 64 * j + 8 * h - tq;
                    bf16x8 pf[2][2];
                    {
                        f32x16 l1;
#pragma unroll
                        for (int i = 0; i < 16; ++i) { const float z = s1[i]; const float a = -(fmaxf(z, 0.f) + lg2(1.f + ex2(-fabsf(z)))); l1[i] = (kb0 + 32 + 16 * (i >> 3) + (i & 7) < 0) ? a : 0.f; }
                        float g0 = 0.f, g1 = 0.f;
#pragma unroll
                        for (int e = 0; e < 8; ++e) { g0 += l1[e]; g1 += l1[8 + e]; }
                        const float p0 = __shfl_xor(g0, 32), p1 = __shfl_xor(g1, 32);
                        float run = carry + (h == 0 ? p1 : 0.f);
#pragma unroll
                        for (int e = 7; e >= 0; --e) { run += l1[8 + e]; l1[8 + e] = run; }
                        run = carry + (g1 + p1) + (h == 0 ? p0 : 0.f);
#pragma unroll
                        for (int e = 7; e >= 0; --e) { run += l1[e]; l1[e] = run; }
                        carry += (g1 + p1) + (g0 + p0);
#pragma unroll
                        for (int i = 0; i < 16; ++i) { const float wv = ex2(s1[i] + l1[i]); s1[i] = (kb0 + 32 + 16 * (i >> 3) + (i & 7) < 0) ? wv : 0.f; }
                        pf[1][0] = pack8(s1[0], s1[1], s1[2], s1[3], s1[4], s1[5], s1[6], s1[7]); pf[1][1] = pack8(s1[8], s1[9], s1[10], s1[11], s1[12], s1[13], s1[14], s1[15]);
                    }
                    {
                        f32x16 l0;
#pragma unroll
                        for (int i = 0; i < 16; ++i) { const float z = s0[i]; const float a = -(fmaxf(z, 0.f) + lg2(1.f + ex2(-fabsf(z)))); l0[i] = (kb0 + 16 * (i >> 3) + (i & 7) < 0) ? a : 0.f; }
                        float g0 = 0.f, g1 = 0.f;
#pragma unroll
                        for (int e = 0; e < 8; ++e) { g0 += l0[e]; g1 += l0[8 + e]; }
                        const float p0 = __shfl_xor(g0, 32), p1 = __shfl_xor(g1, 32);
                        float run = carry + (h == 0 ? p1 : 0.f);
#pragma unroll
                        for (int e = 7; e >= 0; --e) { run += l0[8 + e]; l0[8 + e] = run; }
                        run = carry + (g1 + p1) + (h == 0 ? p0 : 0.f);
#pragma unroll
                        for (int e = 7; e >= 0; --e) { run += l0[e]; l0[e] = run; }
                        carry += (g1 + p1) + (g0 + p0);
#pragma unroll
                        for (int i = 0; i < 16; ++i) { const float wv = ex2(s0[i] + l0[i]); s0[i] = (kb0 + 16 * (i >> 3) + (i & 7) < 0) ? wv : 0.f; }
                        pf[0][0] = pack8(s0[0], s0[1], s0[2], s0[3], s0[4], s0[5], s0[6], s0[7]); pf[0][1] = pack8(s0[8], s0[9], s0[10], s0[11], s0[12], s0[13], s0[14], s0[15]);
                    }
                    att_pv(o, pf, buf, va);
                    wdone = __all(carry < -150.f);
                }
                if (lane == 0) flags[(itn & 1) * 8 + w] = wdone ? 1 : 0;
                asm volatile("s_waitcnt vmcnt(0)" ::: "memory");
                __syncthreads();
                int alld = 1;
#pragma unroll
                for (int q = 0; q < 8; ++q) alld &= flags[(itn & 1) * 8 + q];
                if (alld) break;
            }
            att_store(o, 1.f, O, qrow, hd, h);
        }
    }
}
#ifndef FAST_ATTN
#define FAST_ATTN 1
#endif

constexpr int SEL_LD = 260;
DI void topk_insert(float (&a)[16], float x) {
#pragma unroll
    for (int i = 15; i >= 1; --i) a[i] = __builtin_amdgcn_fmed3f(a[i - 1], a[i], x);
    a[0] = fmaxf(a[0], x);
}
struct SelMap { int mode, a0, a1, a2, a3; };
DI void sel_decode(const SelMap& mp, int q, int& t0, int& hd) {
    if (mp.mode == 0) { int u = mp.a0 + q * mp.a1; if (u >= 128 * 8) u = mp.a0; hd = u & 7; t0 = (u >> 3) * 128; }
    else { const int pm = (q >> 1) ? mp.a2 : mp.a0, pn = (q >> 1) ? mp.a3 : mp.a1; hd = pn; t0 = pm * 256 + (q & 1) * 128; }
}
template <int NU> DI void select_stage2(const Params& p, const Ctx& c, const SelMap mp, const LAS float* lst_all) {
    if (c.tid < 128 * NU) {
        const int tok = c.tid & 127, un = c.tid >> 7;
        int t0, hd; sel_decode(mp, un, t0, hd);
        const LAS float* lst = lst_all + un * 4096;
        float v1[16], v2[16];
#pragma unroll
        for (int i = 0; i < 16; ++i) { v1[i] = __uint_as_float(__float_as_uint(lst[(tok * 2) * 16 + i]) & ~127u); v2[i] = __uint_as_float(__float_as_uint(lst[(tok * 2 + 1) * 16 + i]) & ~127u); }
        float bb[16];
#pragma unroll
        for (int i = 0; i < 16; ++i) bb[i] = -__builtin_inff();
#pragma unroll
        for (int i = 0; i < 16; ++i)
#pragma unroll
            for (int j = 0; j < 16; ++j)
                if ((i + 1) * (j + 1) <= 16) topk_insert(bb, __uint_as_float((__float_as_uint(v1[i] + v2[j]) & ~255u) | (unsigned)(i * 16 + j)));
        float sv[16], mxv = -__builtin_inff(), sum = 0.f;
#pragma unroll
        for (int i = 0; i < 16; ++i) { sv[i] = __uint_as_float(__float_as_uint(bb[i]) & ~255u); mxv = fmaxf(mxv, sv[i]); }
#pragma unroll
        for (int i = 0; i < 16; ++i) { sv[i] = __expf(sv[i] - mxv); sum += sv[i]; }
        const float inv = 1.f / sum;
        int* idx = (int*)(p.ws + OFF_IDX) + (size_t)(t0 + tok) * 128 + hd * 16; float* gw = (float*)(p.ws + OFF_GW) + (size_t)(t0 + tok) * 128 + hd * 16;
#pragma unroll
        for (int i = 0; i < 16; ++i) {
            const unsigned code = __float_as_uint(bb[i]) & 255u;
            const unsigned e1 = __float_as_uint(lst[(tok * 2) * 16 + (code >> 4)]) & 127u, e2 = __float_as_uint(lst[(tok * 2 + 1) * 16 + (code & 15u)]) & 127u;
            idx[i] = (int)(e1 * 128u + e2); gw[i] = sv[i] * inv;
        }
    }
    __syncthreads();
}
DI void select_tail(const Params& p, const Ctx& c, int t0, int hd) {
    LAS float* sc = (LAS float*)c.lds; LAS float* lst = sc + 128 * SEL_LD;
    if (c.tid < 256) {
        const int tok = c.tid >> 1, hf = c.tid & 1;
        float a[16];
#pragma unroll
        for (int i = 0; i < 16; ++i) a[i] = -__builtin_inff();
        const LAS float* row = sc + tok * SEL_LD + hf * 128;
#pragma unroll 4
        for (int n4 = 0; n4 < 32; ++n4) {
            const f32x4 v = *(const LAS f32x4*)(row + n4 * 4);
#pragma unroll
            for (int e = 0; e < 4; ++e) topk_insert(a, __uint_as_float((__float_as_uint(v[e]) & ~127u) | (unsigned)(n4 * 4 + e)));
        }
#pragma unroll
        for (int i = 0; i < 16; ++i) lst[(tok * 2 + hf) * 16 + i] = a[i];
    }
    __syncthreads();
    select_stage2<1>(p, c, SelMap{0, ((t0 >> 7) << 3) | hd, 0, 0, 0}, lst);
}
DI void select_naive(const Params& p, const Ctx& c) {
    const bf16_t* PQ = (const bf16_t*)(p.ws + OFF_PQ); const bf16_t* KEYS = (const bf16_t*)(p.ws + OFF_KEYS);
    LAS float* sc = (LAS float*)c.lds;
    for (int u = blockIdx.x; u < 128 * 8; u += gridDim.x) {
        const int hd = u & 7, t0 = (u >> 3) * 128;
        const int tok = c.tid >> 2, part = c.tid & 3, hf = part >> 1, n0 = (part & 1) * 64;
        const bf16_t* qrow = PQ + (size_t)hd * M * 256 + (size_t)(t0 + tok) * 256 + hf * 128;
        const bf16_t* kb = KEYS + (size_t)((hd * 2 + hf) * 128 + n0) * 128;
        for (int n = 0; n < 64; ++n) {
            float acc = 0.f;
#pragma unroll
            for (int d8 = 0; d8 < 16; ++d8) {
                const u32x4 a = *(const u32x4*)(qrow + d8 * 8), b = *(const u32x4*)(kb + (size_t)n * 128 + d8 * 8);
#pragma unroll
                for (int e = 0; e < 4; ++e) acc += bflo(a[e]) * bflo(b[e]) + bfhi(a[e]) * bfhi(b[e]);
            }
            sc[tok * SEL_LD + hf * 128 + n0 + n] = acc;
        }
        __syncthreads();
        select_tail(p, c, t0, hd);
    }
}


DI void select_batch(const Params& p, const Ctx& c, const SelMap mp) {
    const bf16_t* PQ = (const bf16_t*)(p.ws + OFF_PQ); const bf16_t* KEYS = (const bf16_t*)(p.ws + OFF_KEYS);
    LAS float* lst_all = (LAS float*)c.lds;
    const int lane = c.lane, r = lane & 31, h = lane >> 5, w = c.wave, tb = w & 3, hf = w >> 2;
#pragma unroll
    for (int q = 0; q < 4; ++q) {
        int t0, hd; sel_decode(mp, q, t0, hd);
        LAS float* lst = lst_all + q * 4096;
        const bf16_t* qrow = PQ + (size_t)hd * M * 256 + (size_t)(t0 + tb * 32 + r) * 256 + hf * 128 + h * 8;
        const bf16_t* kbase = KEYS + (size_t)((hd * 2 + hf) * 128 + r) * 128 + h * 8;
        bf16x8 qf[8];
#pragma unroll
        for (int st = 0; st < 8; ++st) qf[st] = *(const bf16x8*)(qrow + st * 16);
        float a[16];
#pragma unroll
        for (int i = 0; i < 16; ++i) a[i] = -__builtin_inff();
#pragma unroll
        for (int kb = 0; kb < 4; ++kb) {
            f32x16 sc;
#pragma unroll
            for (int i = 0; i < 16; ++i) sc[i] = 0.f;
#pragma unroll
            for (int st = 0; st < 8; ++st) sc = MFMA32(*(const bf16x8*)(kbase + (size_t)kb * 32 * 128 + st * 16), qf[st], sc);
#pragma unroll
            for (int i = 0; i < 16; ++i) topk_insert(a, __uint_as_float((__float_as_uint(sc[i]) & ~127u) | (unsigned)(kb * 32 + (i & 3) + 8 * (i >> 2) + 4 * h)));
        }
        float bq[16];
#pragma unroll
        for (int i = 0; i < 16; ++i) bq[i] = __shfl_xor(a[i], 32);
#pragma unroll
        for (int i = 0; i < 16; ++i) topk_insert(a, bq[i]);
        if (h == 0) {
#pragma unroll
            for (int i = 0; i < 16; ++i) lst[((tb * 32 + r) * 2 + hf) * 16 + i] = a[i];
        }
    }
    __syncthreads();
    select_stage2<4>(p, c, mp, lst_all);
}
DI void select_fast(const Params& p, const Ctx& c) {
    for (int u0 = blockIdx.x; u0 < 128 * 8; u0 += 4 * gridDim.x) select_batch(p, c, SelMap{0, u0, (int)gridDim.x, 0, 0});
}
DI void select_own_tiles(const Params& p, const Ctx& c) {
    pg8::StaticOrder S; S.init(M, 2048, (int)gridDim.x, (int)blockIdx.x);
    asm volatile("s_waitcnt vmcnt(0)" ::: "memory");
    __syncthreads();
    if (c.tid == 0) { __builtin_amdgcn_fence(__ATOMIC_ACQUIRE, "agent"); asm volatile("s_waitcnt vmcnt(0)" ::: "memory"); }
    __syncthreads();
    for (int i = 0;; i += 2) {
        pg8::Unit u0, u1;
        if (!S.next(i, u0)) break;
        if (!S.next(i + 1, u1)) u1 = u0;
        select_batch(p, c, SelMap{1, u0.pm, u0.pn, u1.pm, u1.pn});
    }
}
#ifndef FAST_SEL
#define FAST_SEL 1
#endif

DI void phase_gather(const Params& p, const Ctx& c, float* dst, int rowmask = -1) {
    const bf16_t* H2 = (const bf16_t*)(p.ws + OFF_H); const unsigned char* U = p.ws + OFF_U16; const unsigned char* V = p.ws + OFF_V16;
    const int* IDX = (const int*)(p.ws + OFF_IDX); const float* GW = (const float*)(p.ws + OFF_GW); const float* mod = (const float*)(p.ws + OFF_MOD);
    constexpr int G = 8, GV = 16;
    const int lane = c.lane;
    unsigned* tokctr = (unsigned*)(p.ws + OFF_CTL) + 700;
    constexpr int NSTATIC = 6;
    for (int it = 0;; ++it) {
        int m;
        if (GATHER_DYN == 0) { m = c.gw + it * c.ngw; if (m >= M) break; }
        else if (it < NSTATIC) { m = c.gw + it * c.ngw; if (m >= M) break; }
        else { unsigned t = 0; if (lane == 0) t = __hip_atomic_fetch_add(tokctr, 1u, __ATOMIC_RELAXED, __HIP_MEMORY_SCOPE_AGENT); m = NSTATIC * c.ngw + (int)__builtin_amdgcn_readfirstlane(t); if (m >= M) break; }
        const int b = m / SEQ;
        f32x2 hf[16];
#pragma unroll
        for (int i = 0; i < 4; ++i) { const u32x4 a = *(const u32x4*)(H2 + (size_t)m * D + lane * 32 + i * 8);
#pragma unroll
            for (int q = 0; q < 4; ++q) hf[4 * i + q] = (f32x2){bflo(a[q]), bfhi(a[q])}; }
        const int ia = IDX[(size_t)m * 128 + lane], ib = IDX[(size_t)m * 128 + 64 + lane];
        const float ga = GW[(size_t)m * 128 + lane], gb = GW[(size_t)m * 128 + 64 + lane];
        float wa = 0.f, wb = 0.f;
#pragma unroll 1
        for (int k0 = 0; k0 < 128; k0 += G) {
            u32x4 ua[G]; u32x2 ub[G];
#pragma unroll
            for (int g = 0; g < G; ++g) {
                const int e = __builtin_amdgcn_readlane(k0 < 64 ? ia : ib, (k0 + g) & 63) & rowmask;
                const unsigned char* ur = U + (size_t)e * 1536;
                ua[g] = *(const u32x4*)(ur + (unsigned)lane * 16u); ub[g] = *(const u32x2*)(ur + 1024u + (unsigned)lane * 8u);
            }
            float d[G];
#pragma unroll
            for (int g = 0; g < G; ++g) {
                const f32x32v f = __builtin_amdgcn_cvt_scalef32_pk32_f32_fp6((u32x6){ua[g][0], ua[g][1], ua[g][2], ua[g][3], ub[g][0], ub[g][1]}, 1.0f);
                f32x2 d2 = {0.f, 0.f};
#pragma unroll
                for (int i = 0; i < 16; ++i) d2 = (f32x2){f[2 * i], f[2 * i + 1]} * hf[i] + d2;
                d[g] = d2.x + d2.y;
            }
            { const bool u5 = lane & 32, u4 = lane & 16, u3 = lane & 8;
              float r4[4];
#pragma unroll
              for (int i = 0; i < 4; ++i) { const float send = u5 ? d[i] : d[4 + i], keep = u5 ? d[4 + i] : d[i]; r4[i] = keep + __shfl_xor(send, 32); }
              float r2[2];
#pragma unroll
              for (int i = 0; i < 2; ++i) { const float send = u4 ? r4[i] : r4[2 + i], keep = u4 ? r4[2 + i] : r4[i]; r2[i] = keep + __shfl_xor(send, 16); }
              const float send = u3 ? r2[0] : r2[1], keep = u3 ? r2[1] : r2[0];
              float r1 = keep + __shfl_xor(send, 8);
              r1 += __shfl_xor(r1, 4); r1 += __shfl_xor(r1, 2); r1 += __shfl_xor(r1, 1);
              const float act = gelu_tanh(r1 * (1.f / U8_SCALE)) * (1.f / V8_SCALE);
              const int gsel = lane - (k0 & 63);
              const int src = ((gsel & 4) << 3) | ((gsel & 2) << 3) | ((gsel & 1) << 3);
              const float got = __shfl(act, src & 63);
              if (gsel >= 0 && gsel < G) { if (k0 < 64) wa = got * ga; else wb = got * gb; }
            }
        }
        f32x2 acc[16];
#pragma unroll
        for (int i = 0; i < 16; ++i) acc[i] = (f32x2){0.f, 0.f};
#define VB_ISSUE(P, K0) do { _Pragma("unroll") for (int g = 0; g < 8; ++g) { \
            const int e = __builtin_amdgcn_readlane((K0) < 64 ? ia : ib, ((K0) + g) & 63) & rowmask; \
            P##w[g] = __builtin_bit_cast(float, __builtin_amdgcn_readlane(__builtin_bit_cast(int, (K0) < 64 ? wa : wb), ((K0) + g) & 63)); \
            const unsigned char* vr = V + (size_t)e * 1536; \
            P##a[g] = *(const u32x4*)(vr + (unsigned)lane * 16u); P##b[g] = *(const u32x2*)(vr + 1024u + (unsigned)lane * 8u); } } while (0)
#define VB_COMPUTE(P) do { _Pragma("unroll") for (int g = 0; g < 8; ++g) { const f32x2 w2 = {P##w[g], P##w[g]}; \
            const f32x32v f = __builtin_amdgcn_cvt_scalef32_pk32_f32_fp6((u32x6){P##a[g][0], P##a[g][1], P##a[g][2], P##a[g][3], P##b[g][0], P##b[g][1]}, 1.0f); \
            _Pragma("unroll") for (int i = 0; i < 16; ++i) acc[i] = (f32x2){f[2 * i], f[2 * i + 1]} * w2 + acc[i]; } } while (0)
        {
            u32x4 A_a[8], B_a[8]; u32x2 A_b[8], B_b[8]; float A_w[8], B_w[8];
            VB_ISSUE(A_, 0);
#pragma unroll 1
            for (int k0 = 0; k0 < 128; k0 += 16) {
                VB_ISSUE(B_, k0 + 8);
                VB_COMPUTE(A_);
                if (k0 + 16 < 128) VB_ISSUE(A_, k0 + 16);
                VB_COMPUTE(B_);
            }
        }
#undef VB_ISSUE
#undef VB_COMPUTE
        const float* orow = p.out + (size_t)m * D + lane * 32; float* drow = dst + (size_t)m * D + lane * 32; const float* gt2 = mod + b * 6 * D + 5 * D + lane * 32; const float* fg = p.fng + lane * 32;
        float ss = 0.f; f32x4 xv[8];
#pragma unroll
        for (int i = 0; i < 8; ++i) {
            const f32x4 xa = *(const f32x4*)(orow + 4 * i), ta = *(const f32x4*)(gt2 + 4 * i);
            const f32x4 pe = {acc[2 * i].x, acc[2 * i].y, acc[2 * i + 1].x, acc[2 * i + 1].y};
            const f32x4 v = xa + DBG_BETA * ta * pe; xv[i] = v; ss += (v[0] * v[0] + v[1] * v[1]) + (v[2] * v[2] + v[3] * v[3]);
        }
        const float rstd = rsqrtf(wave_sum(ss) * (1.f / D) + EPS);
#pragma unroll
        for (int i = 0; i < 8; ++i) *(f32x4*)(drow + 4 * i) = xv[i] * rstd * *(const f32x4*)(fg + 4 * i);
    }
}


struct XcdBarrier; DI void xcd_barrier(const XcdBarrier& b, int wave_s);
DI int rl2r(int a, int b, int k) { const int va = __builtin_amdgcn_readlane(a, k & 63), vb = __builtin_amdgcn_readlane(b, k & 63); return k < 64 ? va : vb; }
DI void phase_gather_rounds(const Params& p, const Ctx& c, const XcdBarrier& xbar) {
    const bf16_t* H2 = (const bf16_t*)(p.ws + OFF_H); const unsigned char* U = p.ws + OFF_U16; const unsigned char* V = p.ws + OFF_V16;
    const int* IDX = (const int*)(p.ws + OFF_IDX); const float* GW = (const float*)(p.ws + OFF_GW); const float* mod = (const float*)(p.ws + OFF_MOD);
    const int lane = c.lane;
    LAS unsigned char* wl = c.lds + c.wave * 20480;
    const bool u5 = lane & 32, u4 = lane & 16, u3 = lane & 8;
    constexpr int G = 8;
#pragma unroll 1
    for (int pass = 0; pass < 2; ++pass) {
#pragma unroll
        for (int t = 0; t < 4; ++t) {
            const int m = c.gw + (pass * 4 + t) * c.ngw;
            LAS unsigned char* ts = wl + t * 5120;
            if (m < M) {
#pragma unroll
                for (int i = 0; i < 4; ++i) *(LAS u32x4*)(ts + lane * 64 + i * 16) = *(const u32x4*)(H2 + (size_t)m * D + lane * 32 + i * 8);
                *(LAS int*)(ts + 4096 + lane * 4) = IDX[(size_t)m * 128 + lane]; *(LAS int*)(ts + 4096 + 256 + lane * 4) = IDX[(size_t)m * 128 + 64 + lane];
                *(LAS float*)(ts + 4608 + lane * 4) = GW[(size_t)m * 128 + lane]; *(LAS float*)(ts + 4608 + 256 + lane * 4) = GW[(size_t)m * 128 + 64 + lane];
            }
        }
        asm volatile("s_waitcnt vmcnt(0) lgkmcnt(0)" ::: "memory");
#pragma unroll 1
        for (int r = 0; r < 8; ++r) {
#pragma unroll 1
            for (int t = 0; t < 4; ++t) {
                if (c.gw + (pass * 4 + t) * c.ngw >= M) continue;
                LAS unsigned char* ts = wl + t * 5120;
                const int ia = *(LAS int*)(ts + 4096 + lane * 4), ib = *(LAS int*)(ts + 4096 + 256 + lane * 4);
                unsigned long long ma = __ballot((ia >> 11) == r), mb = __ballot((ib >> 11) == r);
                if (!(ma | mb)) continue;
                f32x2 hf[16];
#pragma unroll
                for (int i = 0; i < 4; ++i) { const u32x4 a = *(LAS u32x4*)(ts + lane * 64 + i * 16);
#pragma unroll
                    for (int q = 0; q < 4; ++q) hf[4 * i + q] = (f32x2){bflo(a[q]), bfhi(a[q])}; }
                float wa = 0.f, wb = 0.f; const unsigned long long ma0 = ma, mb0 = mb;
                while (ma | mb) {
                    u32x4 ua[G]; u32x2 ub[G]; int kk[G]; int n = 0;
#pragma unroll
                    for (int g = 0; g < G; ++g) {
                        int k = (g == 0) ? 0 : kk[g - 1];
                        if (ma) { k = __builtin_ctzll(ma); ma &= ma - 1; ++n; } else if (mb) { k = 64 + __builtin_ctzll(mb); mb &= mb - 1; ++n; }
                        kk[g] = k;
                        const int e = rl2r(ia, ib, k);
                        const unsigned char* ur = U + (size_t)e * 1536;
                        ua[g] = *(const u32x4*)(ur + (unsigned)lane * 16u); ub[g] = *(const u32x2*)(ur + 1024u + (unsigned)lane * 8u);
                    }
                    float d[G];
#pragma unroll
                    for (int g = 0; g < G; ++g) {
                        d[g] = 0.f;
                        if (g < n) {
                            const f32x32v f = __builtin_amdgcn_cvt_scalef32_pk32_f32_fp6((u32x6){ua[g][0], ua[g][1], ua[g][2], ua[g][3], ub[g][0], ub[g][1]}, 1.0f);
                            f32x2 d0 = {0.f, 0.f}, d1 = {0.f, 0.f};
#pragma unroll
                            for (int i = 0; i < 8; ++i) { d0 = (f32x2){f[4 * i], f[4 * i + 1]} * hf[2 * i] + d0; d1 = (f32x2){f[4 * i + 2], f[4 * i + 3]} * hf[2 * i + 1] + d1; }
                            d[g] = (d0.x + d0.y) + (d1.x + d1.y);
                        }
                    }
                    float r4[4];
#pragma unroll
                    for (int i = 0; i < 4; ++i) { const float send = u5 ? d[i] : d[4 + i], keep = u5 ? d[4 + i] : d[i]; r4[i] = keep + __shfl_xor(send, 32); }
                    float r2[2];
#pragma unroll
                    for (int i = 0; i < 2; ++i) { const float send = u4 ? r4[i] : r4[2 + i], keep = u4 ? r4[2 + i] : r4[i]; r2[i] = keep + __shfl_xor(send, 16); }
                    const float send = u3 ? r2[0] : r2[1], keep = u3 ? r2[1] : r2[0];
                    float r1 = keep + __shfl_xor(send, 8);
                    r1 += __shfl_xor(r1, 4); r1 += __shfl_xor(r1, 2); r1 += __shfl_xor(r1, 1);
                    const float act = gelu_tanh(r1 * (1.f / U8_SCALE)) * (1.f / V8_SCALE);
#pragma unroll
                    for (int g = 0; g < G; ++g) if (g < n) {
                        const float av = __builtin_bit_cast(float, __builtin_amdgcn_readlane(__builtin_bit_cast(int, act), ((g & 4) << 3) | ((g & 2) << 3) | ((g & 1) << 3)));
                        const int k = kk[g];
                        if (k < 64) { if (lane == k) wa = av; } else { if (lane == k - 64) wb = av; }
                    }
                }
                if ((ma0 >> lane) & 1ull) { LAS float* gp = (LAS float*)(ts + 4608 + lane * 4); *gp = *gp * wa; }
                if ((mb0 >> lane) & 1ull) { LAS float* gp = (LAS float*)(ts + 4608 + 256 + lane * 4); *gp = *gp * wb; }
            }
            if (DBG_ROUND_BAR) xcd_barrier(xbar, c.wave);
        }
        asm volatile("s_waitcnt lgkmcnt(0)" ::: "memory");
#pragma unroll 1
        for (int t = 0; t < 4; ++t) {
            const int m = c.gw + (pass * 4 + t) * c.ngw;
            if (m >= M) continue;
            const int b = m / SEQ;
            LAS unsigned char* ts = wl + t * 5120;
            const int ia = *(LAS int*)(ts + 4096 + lane * 4), ib = *(LAS int*)(ts + 4096 + 256 + lane * 4);
            const float wa = *(LAS float*)(ts + 4608 + lane * 4), wb = *(LAS float*)(ts + 4608 + 256 + lane * 4);
            f32x2 acc[16];
#pragma unroll
            for (int i = 0; i < 16; ++i) acc[i] = (f32x2){0.f, 0.f};
#pragma unroll 1
            for (int k0 = 0; k0 < 128; k0 += G) {
                u32x4 va[G]; u32x2 vb[G]; float wk[G];
#pragma unroll
                for (int g = 0; g < G; ++g) {
                    const int e = __builtin_amdgcn_readlane(k0 < 64 ? ia : ib, (k0 + g) & 63);
                    wk[g] = __builtin_bit_cast(float, __builtin_amdgcn_readlane(__builtin_bit_cast(int, k0 < 64 ? wa : wb), (k0 + g) & 63));
                    const unsigned char* vr = V + (size_t)e * 1536;
                    va[g] = *(const u32x4*)(vr + (unsigned)lane * 16u); vb[g] = *(const u32x2*)(vr + 1024u + (unsigned)lane * 8u);
                }
#pragma unroll
                for (int g = 0; g < G; ++g) { const f32x2 w2 = {wk[g], wk[g]};
                    const f32x32v f = __builtin_amdgcn_cvt_scalef32_pk32_f32_fp6((u32x6){va[g][0], va[g][1], va[g][2], va[g][3], vb[g][0], vb[g][1]}, 1.0f);
#pragma unroll
                    for (int i = 0; i < 16; ++i) acc[i] = (f32x2){f[2 * i], f[2 * i + 1]} * w2 + acc[i]; }
            }
            float* orow = p.out + (size_t)m * D + lane * 32; const float* gt2 = mod + b * 6 * D + 5 * D + lane * 32; const float* fg = p.fng + lane * 32;
            float ss = 0.f; f32x4 xv[8];
#pragma unroll
            for (int i = 0; i < 8; ++i) {
                const f32x4 xa = *(const f32x4*)(orow + 4 * i), ta = *(const f32x4*)(gt2 + 4 * i);
                const f32x4 pe = {acc[2 * i].x, acc[2 * i].y, acc[2 * i + 1].x, acc[2 * i + 1].y};
                const f32x4 v = xa + DBG_BETA * ta * pe; xv[i] = v; ss += (v[0] * v[0] + v[1] * v[1]) + (v[2] * v[2] + v[3] * v[3]);
            }
            const float rstd = rsqrtf(wave_sum(ss) * (1.f / D) + EPS);
#pragma unroll
            for (int i = 0; i < 8; ++i) *(f32x4*)(orow + 4 * i) = xv[i] * rstd * *(const f32x4*)(fg + 4 * i);
        }
    }
}
#ifndef GATHER_ROUNDS
#define GATHER_ROUNDS 0
#endif

constexpr size_t OFF_WK = OFF_GB + (size_t)32 * 1024 * 1024;
constexpr size_t OFF_SSQ = OFF_GB + (size_t)48 * 1024 * 1024;
constexpr int NPU = 2, NPV = 2;
struct PairPick { int k; bool valid; };
DI PairPick pick_next(unsigned long long& ma, unsigned long long& mb, int prev) {
    PairPick r;
    if (ma) { r.k = __builtin_ctzll(ma); ma &= ma - 1; r.valid = true; }
    else if (mb) { r.k = 64 + __builtin_ctzll(mb); mb &= mb - 1; r.valid = true; }
    else { r.k = prev; r.valid = false; }
    return r;
}
DI int rl2(int a, int b, int k) { const int va = __builtin_amdgcn_readlane(a, k & 63), vb = __builtin_amdgcn_readlane(b, k & 63); return k < 64 ? va : vb; }
DI float rl2f(float a, float b, int k) { return __builtin_bit_cast(float, rl2(__builtin_bit_cast(int, a), __builtin_bit_cast(int, b), k)); }

DI void gather_u(const Params& p, const Ctx& c) {
    const bf16_t* H2 = (const bf16_t*)(p.ws + OFF_H); const unsigned char* U = p.ws + OFF_U16;
    const int* IDX = (const int*)(p.ws + OFF_IDX); const float* GW = (const float*)(p.ws + OFF_GW); float* WK = (float*)(p.ws + OFF_WK);
    const int x = blockIdx.x & 7, jb = blockIdx.x >> 3, nj = ((int)gridDim.x - x + 7) >> 3;
    const int wl = jb * NWAVES + c.wave, nwl = nj * NWAVES;
    constexpr int G = 4, SH = (NPU == 2) ? 10 : 11;
#pragma unroll 1
    for (int ps = 0; ps < NPU; ++ps) {
        const int part = x * NPU + ps;
#pragma unroll 1
        for (int m = wl; m < M; m += nwl) {
            const int ia = IDX[(size_t)m * 128 + c.lane], ib = IDX[(size_t)m * 128 + 64 + c.lane];
            unsigned long long ma = __ballot((ia >> SH) == part), mb = __ballot((ib >> SH) == part);
            if (!(ma | mb)) continue;
            const unsigned long long ma0 = ma, mb0 = mb;
            float hf[2][16];
#pragma unroll
            for (int j = 0; j < 2; ++j) { const u32x4 a = *(const u32x4*)(H2 + (size_t)m * D + j * 1024 + c.lane * 16), bq = *(const u32x4*)(H2 + (size_t)m * D + j * 1024 + c.lane * 16 + 8);
#pragma unroll
                for (int q = 0; q < 4; ++q) { hf[j][2 * q] = bflo(a[q]); hf[j][2 * q + 1] = bfhi(a[q]); hf[j][8 + 2 * q] = bflo(bq[q]); hf[j][8 + 2 * q + 1] = bfhi(bq[q]); } }
            const float ga = GW[(size_t)m * 128 + c.lane], gb = GW[(size_t)m * 128 + 64 + c.lane];
            float wa = 0.f, wb = 0.f;
            int prev = 0;
            while (ma | mb) {
                PairPick pk[G]; u32x4 uu[G][2];
#pragma unroll
                for (int g = 0; g < G; ++g) { pk[g] = pick_next(ma, mb, prev); prev = pk[g].k;
                    const int e = rl2(ia, ib, pk[g].k);
                    const unsigned char* ur = U + (size_t)e * D;
#pragma unroll
                    for (int j = 0; j < 2; ++j) uu[g][j] = *(const u32x4*)(ur + ((unsigned)c.lane * 16u + j * 1024u)); }
                float d[G];
#pragma unroll
                for (int g = 0; g < G; ++g) {
                    float d0 = 0.f, d1 = 0.f;
#pragma unroll
                    for (int j = 0; j < 2; ++j)
#pragma unroll
                        for (int q = 0; q < 4; ++q) { const f32x2 lo = __builtin_amdgcn_cvt_pk_f32_fp8((int)uu[g][j][q], false), hi = __builtin_amdgcn_cvt_pk_f32_fp8((int)uu[g][j][q], true);
                            d0 += lo.x * hf[j][4 * q] + hi.x * hf[j][4 * q + 2]; d1 += lo.y * hf[j][4 * q + 1] + hi.y * hf[j][4 * q + 3]; }
                    d[g] = d0 + d1;
                }
#pragma unroll
                for (int o = 1; o < 64; o <<= 1)
#pragma unroll
                    for (int g = 0; g < G; ++g) d[g] += __shfl_xor(d[g], o);
#pragma unroll
                for (int g = 0; g < G; ++g) if (pk[g].valid) {
                    const float a = gelu_tanh(d[g] * (1.f / U8_SCALE)) * (1.f / V8_SCALE); const int k = pk[g].k;
                    if (k < 64) { if (c.lane == k) wa = a * ga; } else { if (c.lane == k - 64) wb = a * gb; }
                }
            }
            if ((ma0 >> c.lane) & 1ull) WK[(size_t)m * 128 + c.lane] = wa;
            if ((mb0 >> c.lane) & 1ull) WK[(size_t)m * 128 + 64 + c.lane] = wb;
        }
    }
}

DI void gather_v(const Params& p, const Ctx& c) {
    const unsigned char* V = p.ws + OFF_V16;
    const int* IDX = (const int*)(p.ws + OFF_IDX); const float* WK = (const float*)(p.ws + OFF_WK); const float* mod = (const float*)(p.ws + OFF_MOD);
    float* SSQ = (float*)(p.ws + OFF_SSQ);
    const int x = blockIdx.x & 7, jb = blockIdx.x >> 3, nj = ((int)gridDim.x - x + 7) >> 3;
    const int wl = jb * NWAVES + c.wave, nwl = nj * NWAVES;
    const int q4 = c.lane >> 4, l16 = c.lane & 15;
    const unsigned voff = 256u * x + l16 * 16u;
    constexpr int SHV = (NPV == 2) ? 13 : 14;
#pragma unroll 1
    for (int ps = 0; ps < NPV; ++ps) {
#pragma unroll 1
        for (int m = wl; m < M; m += nwl) {
            const int b = m / SEQ;
            const int ia = IDX[(size_t)m * 128 + c.lane], ib = IDX[(size_t)m * 128 + 64 + c.lane];
            const float wa = WK[(size_t)m * 128 + c.lane], wb = WK[(size_t)m * 128 + 64 + c.lane];
            unsigned long long ma = __ballot((ia >> SHV) == ps), mb = __ballot((ib >> SHV) == ps);
            float acc[16];
#pragma unroll
            for (int i = 0; i < 16; ++i) acc[i] = 0.f;
            int prev = 0;
            while (ma | mb) {
                u32x4 vv[4]; float wv[4];
#pragma unroll
                for (int s4 = 0; s4 < 4; ++s4) {
                    int e = 0; float w = 0.f;
#pragma unroll
                    for (int g = 0; g < 4; ++g) { const PairPick pk = pick_next(ma, mb, prev); prev = pk.k;
                        const int eg = rl2(ia, ib, pk.k); const float wg = pk.valid ? rl2f(wa, wb, pk.k) : 0.f;
                        e = (q4 == g) ? eg : e; w = (q4 == g) ? wg : w; }
                    vv[s4] = *(const u32x4*)(V + (size_t)e * D + voff); wv[s4] = w;
                }
#pragma unroll
                for (int s4 = 0; s4 < 4; ++s4)
#pragma unroll
                    for (int q = 0; q < 4; ++q) { const f32x2 lo = __builtin_amdgcn_cvt_pk_f32_fp8((int)vv[s4][q], false), hi = __builtin_amdgcn_cvt_pk_f32_fp8((int)vv[s4][q], true);
                        acc[4 * q] += wv[s4] * lo.x; acc[4 * q + 1] += wv[s4] * lo.y; acc[4 * q + 2] += wv[s4] * hi.x; acc[4 * q + 3] += wv[s4] * hi.y; }
            }
#pragma unroll
            for (int i = 0; i < 16; ++i) { acc[i] += __shfl_xor(acc[i], 16); acc[i] += __shfl_xor(acc[i], 32); }
            f32x4 sel;
#pragma unroll
            for (int e = 0; e < 4; ++e) sel[e] = q4 == 0 ? acc[e] : (q4 == 1 ? acc[4 + e] : (q4 == 2 ? acc[8 + e] : acc[12 + e]));
            const int col = 256 * x + 16 * l16 + 4 * q4;
            float* op = p.out + (size_t)m * D + col;
            const f32x4 val = *(const f32x4*)op + DBG_BETA * *(const f32x4*)(mod + b * 6 * D + 5 * D + col) * sel;
            *(f32x4*)op = val;
            if (ps == NPV - 1) { const float ss = wave_sum(val[0] * val[0] + val[1] * val[1] + val[2] * val[2] + val[3] * val[3]); if (c.lane == 0) SSQ[(size_t)m * 8 + x] = ss; }
        }
    }
}
DI void gather_final(const Params& p, const Ctx& c) {
    const float* SSQ = (const float*)(p.ws + OFF_SSQ);
    for (int m = c.gw; m < M; m += c.ngw) {
        float s = (c.lane < 8) ? SSQ[(size_t)m * 8 + c.lane] : 0.f;
        s += __shfl_xor(s, 1); s += __shfl_xor(s, 2); s += __shfl_xor(s, 4);
        const float rstd = rsqrtf(__shfl(s, 0) * (1.f / D) + EPS);
        float* orow = p.out + (size_t)m * D;
#pragma unroll
        for (int j = 0; j < 8; ++j) { const int col = (j * 64 + c.lane) * 4; *(f32x4*)(orow + col) = *(const f32x4*)(orow + col) * rstd * *(const f32x4*)(p.fng + col); }
    }
}
#ifndef GATHER_L2
#define GATHER_L2 0
#endif

DI void phase_gather_v2(const Params& p, const Ctx& c) {
    const bf16_t* H2 = (const bf16_t*)(p.ws + OFF_H);
    const int* IDX = (const int*)(p.ws + OFF_IDX); const float* GW = (const float*)(p.ws + OFF_GW); const float* mod = (const float*)(p.ws + OFF_MOD);
    LAS float* hs = (LAS float*)c.lds; LAS float* wk = hs + 2048; LAS int* ek = (LAS int*)(wk + 128); LAS float* red = (LAS float*)(ek + 128);
    for (int m = blockIdx.x; m < M; m += gridDim.x) {
        const int b = m / SEQ;
        __syncthreads();
        for (int i = c.tid; i < 2048; i += NTHREADS) hs[i] = bf2f(H2[(size_t)m * D + i]);
        if (c.tid < 128) ek[c.tid] = IDX[(size_t)m * 128 + c.tid];
        __syncthreads();
        for (int k = c.wave; k < 128; k += NWAVES) {
            const float* ur = p.pu + (size_t)ek[k] * D;
            float d = 0.f;
            for (int i = 0; i < 8; ++i) { const int col = i * 256 + c.lane * 4; const f32x4 u = *(const f32x4*)(ur + col);
                d += u[0] * hs[col] + u[1] * hs[col + 1] + u[2] * hs[col + 2] + u[3] * hs[col + 3]; }
            d = wave_sum(d);
            if (c.lane == 0) wk[k] = gelu_tanh(d) * GW[(size_t)m * 128 + k];
        }
        __syncthreads();
        const int col = c.tid * 4;
        f32x4 acc = {0.f, 0.f, 0.f, 0.f};
        for (int k = 0; k < 128; ++k) { const f32x4 v = *(const f32x4*)(p.pv + (size_t)ek[k] * D + col); acc += v * wk[k]; }
        float* orow = p.out + (size_t)m * D;
        const f32x4 x2 = *(const f32x4*)(orow + col) + DBG_BETA * *(const f32x4*)(mod + b * 6 * D + 5 * D + col) * acc;
        float ss = wave_sum(x2[0] * x2[0] + x2[1] * x2[1] + x2[2] * x2[2] + x2[3] * x2[3]);
        if (c.lane == 0) red[c.wave] = ss;
        __syncthreads();
        float tot = 0.f;
        for (int w = 0; w < NWAVES; ++w) tot += red[w];
        const float rstd = rsqrtf(tot * (1.f / D) + EPS);
        *(f32x4*)(orow + col) = x2 * rstd * *(const f32x4*)(p.fng + col);
    }
}


#define XB_TMO      128
#define XB_XCNT(j)  (256  + 64 * (j))
#define XB_XSUB(j)  (1280 + 64 * (j))
#define XB_XGEN(j)  (2304 + 64 * (j))
#define XB_TOP      3328
#define XB_TOPGEN   3392
#define XCD_BAR_WORDS 3456
#define XB_SPIN_CAP (1u << 18)

__device__ __forceinline__ unsigned xb_ld(unsigned* p)              { return __hip_atomic_load(p, __ATOMIC_RELAXED, __HIP_MEMORY_SCOPE_AGENT); }
__device__ __forceinline__ unsigned xb_add(unsigned* p, unsigned v) { return __hip_atomic_fetch_add(p, v, __ATOMIC_RELAXED, __HIP_MEMORY_SCOPE_AGENT); }
__device__ __forceinline__ unsigned xb_xcc_id() { return (unsigned)__builtin_amdgcn_s_getreg((3 << 11) | 20) & 0xFu; }
#define XB_SPIN(cond, bar) do { unsigned _sp = 0; while (cond) { __builtin_amdgcn_s_sleep(1); \
    if ((++_sp & 255u) == 0u) { if (xb_ld(&(bar)[XB_TMO])) break; if (_sp > XB_SPIN_CAP) { atomicAdd(&(bar)[XB_TMO], 1u); break; } } } } while (0)

struct XcdBarrier {
    unsigned* bar; unsigned x;
    volatile LAS unsigned* st;
};

__device__ __forceinline__ XcdBarrier xcd_barrier_post(unsigned* bar, volatile LAS unsigned* st) {
    XcdBarrier b; b.bar = bar; b.x = xb_xcc_id(); b.st = st;
    if (threadIdx.x == 0) (void)xb_add(&bar[XB_XCNT(b.x)], 1u);
    return b;
}
__device__ __forceinline__ void xcd_barrier_complete(unsigned* bar, unsigned x, unsigned& nloc, unsigned& nx) {
    const unsigned G = gridDim.x * gridDim.y * gridDim.z;
    unsigned sum, cnt, mine, sp = 0u;
    for (;;) {
        sum = 0u; cnt = 0u; mine = 0u;
#pragma unroll
        for (unsigned j = 0; j < 16; ++j) { const unsigned c = xb_ld(&bar[XB_XCNT(j)]); sum += c; cnt += (c > 0u) ? 1u : 0u; mine = (j == x) ? c : mine; }
        if (sum == G) break;
        __builtin_amdgcn_s_sleep(1);
        if ((++sp & 255u) == 0u) { if (xb_ld(&bar[XB_TMO])) break; if (sp > XB_SPIN_CAP) { atomicAdd(&bar[XB_TMO], 1u); break; } }
    }
    nloc = mine > 0u ? mine : 1u; nx = cnt > 0u ? cnt : 1u;
}

__device__ __forceinline__ bool xb_lead(int wave_s) { return wave_s == 0 && __builtin_amdgcn_mbcnt_hi(~0u, __builtin_amdgcn_mbcnt_lo(~0u, 0u)) == 0; }
__device__ __forceinline__ void xcd_barrier(const XcdBarrier& b, int wave_s) {
    asm volatile("s_waitcnt vmcnt(0)" ::: "memory");
    __syncthreads();
    if (xb_lead(wave_s)) {
        unsigned* bar = b.bar;
        __builtin_amdgcn_s_waitcnt(0);
        unsigned nloc = b.st[0], nx = b.st[1];
        if (nloc == 0u) { xcd_barrier_complete(bar, b.x, nloc, nx); b.st[0] = nloc; b.st[1] = nx; }
        const unsigned old = xb_add(&bar[XB_XSUB(b.x)], 1u);
        const unsigned gen = old / nloc;
        if (old + 1u == (gen + 1u) * nloc) {
            __builtin_amdgcn_fence(__ATOMIC_RELEASE, "agent");
            asm volatile("s_waitcnt vmcnt(0)" ::: "memory");
            const unsigned og = xb_add(&bar[XB_TOP], 1u);
            const unsigned tg = og / nx;
            if (og + 1u == (tg + 1u) * nx) xb_add(&bar[XB_TOPGEN], 1u);
            else XB_SPIN(xb_ld(&bar[XB_TOPGEN]) == tg, bar);
            __builtin_amdgcn_fence(__ATOMIC_ACQUIRE, "agent");
            xb_add(&bar[XB_XGEN(b.x)], 1u);
            asm volatile("s_waitcnt vmcnt(0)" ::: "memory");
        } else {
            XB_SPIN(xb_ld(&bar[XB_XGEN(b.x)]) == gen, bar);
            __builtin_amdgcn_fence(__ATOMIC_ACQUIRE, "agent");
            asm volatile("s_waitcnt vmcnt(0)" ::: "memory");
        }
    }
    __syncthreads();
}


DI void grid_barrier(unsigned* ctr, unsigned target, int wave_s) {
    asm volatile("s_waitcnt vmcnt(0)" ::: "memory");
    __syncthreads();
    if (wave_s == 0) {
        const int l = __builtin_amdgcn_mbcnt_hi(~0u, __builtin_amdgcn_mbcnt_lo(~0u, 0u));
        if (l == 0) {
            __builtin_amdgcn_fence(__ATOMIC_RELEASE, "agent");
            asm volatile("s_waitcnt vmcnt(0)" ::: "memory");
            __hip_atomic_fetch_add(ctr, 1u, __ATOMIC_RELAXED, __HIP_MEMORY_SCOPE_AGENT);
            unsigned spins = 0;
            while (__hip_atomic_load(ctr, __ATOMIC_RELAXED, __HIP_MEMORY_SCOPE_AGENT) < target) { __builtin_amdgcn_s_sleep(2); if (++spins > (1u << 23)) break; }
            __builtin_amdgcn_fence(__ATOMIC_ACQUIRE, "agent");
            asm volatile("s_waitcnt vmcnt(0)" ::: "memory");
        }
    }
    __syncthreads();
}

__global__ void __launch_bounds__(NTHREADS, 2) mega(Params p) {
    extern __shared__ __attribute__((aligned(16))) unsigned char lds_raw[];
    const int wave_s = __builtin_amdgcn_readfirstlane(threadIdx.x >> 6);
#define MKCTX() Ctx c; { int l_; asm volatile("v_mbcnt_lo_u32_b32 %0, -1, 0\n\tv_mbcnt_hi_u32_b32 %0, -1, %0" : "=v"(l_)); c.lds = (LAS unsigned char*)lds_raw; c.lane = l_; c.wave = wave_s; c.tid = wave_s * 64 + l_; \
    c.gw = blockIdx.x * NWAVES + wave_s; c.ngw = gridDim.x * NWAVES; }
    unsigned char* ws = p.ws;
    const float* mod = (const float*)(ws + OFF_MOD);
    const int lo = p.ph_lo, hi = p.ph_hi;
    XcdBarrier xbar; xbar.bar = (unsigned*)(ws + OFF_XBAR); xbar.x = 0; xbar.st = nullptr;
    if (USE_XBAR && lo == 0 && hi == NPHASE) {
        volatile LAS unsigned* stw = (volatile LAS unsigned*)(lds_raw + LDS_BYTES - 32);
        if (threadIdx.x < 2) stw[threadIdx.x] = 0u;
        __syncthreads();
        xbar = xcd_barrier_post((unsigned*)(ws + OFF_XBAR), stw);
    }
#define IN(k) (lo <= (k) && (k) < hi)
#define SEAM(k) do { if (IN(k) && IN((k) + 1)) { if (USE_XBAR) xcd_barrier(xbar, wave_s); else grid_barrier((unsigned*)(ws + OFF_CTL), (unsigned)((k) + 1) * gridDim.x, wave_s); \
    if (TIME_PHASE >= 0 && blockIdx.x == 0 && threadIdx.x == 0) ((unsigned long long*)(ws + OFF_CTL + 512))[(k) + 1] = __builtin_amdgcn_s_memrealtime(); } } while (0)

    if (TIME_PHASE >= 0 && blockIdx.x == 0 && threadIdx.x == 0) ((unsigned long long*)(ws + OFF_CTL + 512))[0] = __builtin_amdgcn_s_memrealtime();
    if (IN(0)) { MKCTX(); phase_prologue(p, c, true, PRO_SPLIT == 0); }
    SEAM(0);
    if (IN(1)) for (int rep_ = 0; rep_ < (DUP_PHASE == 1 ? 2 : 1); ++rep_) { MKCTX();
        const long long* modi = (const long long*)(ws + OFF_MODI); float* modw = (float*)(ws + OFF_MOD);
        for (int i = blockIdx.x * NTHREADS + c.tid; i < NB * 6 * D; i += gridDim.x * NTHREADS) modw[i] = (float)((double)modi[i] * (1.0 / 4294967296.0));
        modulate_rows(p.x, p.n1g, modi + 1 * D, modi + 0 * D, (bf16_t*)(ws + OFF_H), c);
        if (PRO_SPLIT) phase_prologue(p, c, false, true);
    }
    SEAM(1);
    if (IN(2)) for (int rep_ = 0; rep_ < (DUP_PHASE == 2 ? 2 : 1); ++rep_) { MKCTX();
        EpiProj e1{(bf16_t*)(ws + OFF_CQ), (bf16_t*)(ws + OFF_CKV), (bf16_t*)(ws + OFF_KR), (bf16_t*)(ws + OFF_SBQ), (bf16_t*)(ws + OFF_SBK), (bf16_t*)(ws + OFF_GA), (bf16_t*)(ws + OFF_GB), (const f32x2*)(ws + OFF_CS)};
        GEMM(c, (const bf16_t*)(ws + OFF_H), (const bf16_t*)(ws + OFF_WIN), M, 7168, 2048, e1);
        if (DUP_GEMM == 20) GEMM(c, (const bf16_t*)(ws + OFF_H), (const bf16_t*)(ws + OFF_WIN), M, 7168, 2048, e1);
        EpiT e2{(bf16_t*)(ws + OFF_SBVT), nullptr};
        GEMM(c, (const bf16_t*)(ws + OFF_WSBV), (const bf16_t*)(ws + OFF_H), 1024, M, 2048, e2);
        if (DUP_GEMM == 21) GEMM(c, (const bf16_t*)(ws + OFF_WSBV), (const bf16_t*)(ws + OFF_H), 1024, M, 2048, e2);
    }
    SEAM(2);
    if (IN(3)) for (int rep_ = 0; rep_ < (DUP_PHASE == 3 ? 2 : 1); ++rep_) { MKCTX(); phase_rowstats(p, c); }
    SEAM(3);
    if (DBG_XTRA_BAR) { for (int q_ = 0; q_ < DBG_XTRA_BAR; ++q_) { if (IN(3) && IN(4)) xcd_barrier(xbar, wave_s); } }
    if (IN(4)) for (int rep_ = 0; rep_ < (DUP_PHASE == 4 ? 2 : 1); ++rep_) { MKCTX();
        EpiUq e1{(bf16_t*)(ws + OFF_Q), (const float*)(ws + OFF_RSTQ), (const f32x2*)(ws + OFF_CS)};
        GEMM(c, (const bf16_t*)(ws + OFF_CQ), (const bf16_t*)(ws + OFF_WUQ), M, 1536, 512, e1);
        if (DUP_GEMM == 40) GEMM(c, (const bf16_t*)(ws + OFF_CQ), (const bf16_t*)(ws + OFF_WUQ), M, 1536, 512, e1);
        EpiRowScale e2{(bf16_t*)(ws + OFF_KN), 1024, (const float*)(ws + OFF_RSTKV)};
        GEMM(c, (const bf16_t*)(ws + OFF_CKV), (const bf16_t*)(ws + OFF_WUK), M, 1024, 256, e2);
        if (DUP_GEMM == 41) GEMM(c, (const bf16_t*)(ws + OFF_CKV), (const bf16_t*)(ws + OFF_WUK), M, 1024, 256, e2);
        EpiT e3{(bf16_t*)(ws + OFF_VT), (const float*)(ws + OFF_RSTKV)};
        GEMM(c, (const bf16_t*)(ws + OFF_WUV), (const bf16_t*)(ws + OFF_CKV), 1024, M, 256, e3);
        if (DUP_GEMM == 42) GEMM(c, (const bf16_t*)(ws + OFF_WUV), (const bf16_t*)(ws + OFF_CKV), 1024, M, 256, e3);
    }
    SEAM(4);
    if (IN(5)) for (int rep_ = 0; rep_ < (DUP_PHASE == 5 ? 2 : 1); ++rep_) {
#if FAST_ATTN
        { MKCTX(); attn_mla_fast(p, c); }
        if (DUP_GEMM == 51) { MKCTX(); attn_mla_fast(p, c); }
        { MKCTX(); attn_sb_fast(p, c); }
        if (DUP_GEMM == 52) { MKCTX(); attn_sb_fast(p, c); }
#else
        MKCTX();
        attn_mla_naive(p, c); attn_sb_naive(p, c);
#endif
    }
    SEAM(5);
    if (IN(6)) for (int rep_ = 0; rep_ < (DUP_PHASE == 6 ? 2 : 1); ++rep_) { MKCTX();
        EpiGate1 e1{(bf16_t*)(ws + OFF_MERGED), (const bf16_t*)(ws + OFF_GA)};
        GEMM(c, (const bf16_t*)(ws + OFF_ATTA), (const bf16_t*)(ws + OFF_WA), M, 2048, 1024, e1);
        if (DUP_GEMM == 60) GEMM(c, (const bf16_t*)(ws + OFF_ATTA), (const bf16_t*)(ws + OFF_WA), M, 2048, 1024, e1);
        EpiGate2 e2{(bf16_t*)(ws + OFF_MERGED), (const bf16_t*)(ws + OFF_GB)};
        GEMM(c, (const bf16_t*)(ws + OFF_ATTB), (const bf16_t*)(ws + OFF_WB), M, 2048, 1024, e2);
    }
    SEAM(6);
    if (IN(7)) for (int rep_ = 0; rep_ < (DUP_PHASE == 7 ? 2 : 1); ++rep_) { MKCTX();
        EpiRes e{p.x, mod + 2 * D, p.out};
        GEMM(c, (const bf16_t*)(ws + OFF_MERGED), (const bf16_t*)(ws + OFF_WOUT), M, 2048, 2048, e);
    }
    SEAM(7);
    if (IN(8)) for (int rep_ = 0; rep_ < (DUP_PHASE == 8 ? 2 : 1); ++rep_) { MKCTX();
        modulate_rows(p.out, p.n2g, mod + 4 * D, mod + 3 * D, (bf16_t*)(ws + OFF_H), c);
        convert_table(p.pu, ws + OFF_U16, U8_SCALE, c);
        convert_table(p.pv, ws + OFF_V16, V8_SCALE, c);
    }
    SEAM(8);
    if (IN(9)) for (int rep_ = 0; rep_ < (DUP_PHASE == 9 ? 2 : 1); ++rep_) { MKCTX();
        EpiPq e{(bf16_t*)(ws + OFF_PQ)};
        GEMM(c, (const bf16_t*)(ws + OFF_H), (const bf16_t*)(ws + OFF_WPQ), M, 2048, 2048, e);
#if FAST_SEL && FAST_GEMM && SEL_FUSED
        { MKCTX(); select_own_tiles(p, c); }
#endif
    }
#if !(FAST_SEL && FAST_GEMM && SEL_FUSED)
    SEAM(9);
    if (IN(10)) for (int rep_ = 0; rep_ < (DUP_PHASE == 10 ? 2 : 1); ++rep_) { MKCTX();
#if FAST_SEL
        select_fast(p, c);
#else
        select_naive(p, c);
#endif
    }
#else
    if (IN(9) && IN(10)) {   }
#endif
    SEAM(10);
#if GATHER_L2
    if (IN(11)) { MKCTX(); gather_u(p, c); }
    SEAM(11);
    if (IN(12)) { MKCTX(); gather_v(p, c); }
    SEAM(12);
    if (IN(13)) { MKCTX(); gather_final(p, c); }
#else
#if GATHER_ROUNDS
    if (IN(11)) { MKCTX(); phase_gather_rounds(p, c, xbar); }
#else
    if (IN(11)) { if (DUP_GEMM == 110) { MKCTX(); phase_gather(p, c, (float*)(ws + OFF_SBQ)); }
        if (DUP_GEMM == 111) { MKCTX(); phase_gather(p, c, (float*)(ws + OFF_SBQ), 0x3ff); } MKCTX(); phase_gather(p, c, p.out); }
#endif
#endif
#undef IN
#undef SEAM
}

extern "C" void kernel_launch(void* const* d_in, const int* in_sizes, int n_in, void* d_out, int out_size, void* d_ws, size_t ws_size, hipStream_t stream) {
    static int grid = 0;
    if (grid == 0) {
        if (n_in != 20 || out_size != M * D || ws_size < WS_END) { fprintf(stderr, "kernel_launch: unexpected shapes (n_in %d out %d ws %zu need %zu)\n", n_in, out_size, ws_size, (size_t)WS_END); grid = -1; return; }
        int dev = 0, cus = 0, per_cu = 0;
        (void)hipGetDevice(&dev); (void)hipDeviceGetAttribute(&cus, hipDeviceAttributeMultiprocessorCount, dev);
        if (hipFuncSetAttribute((const void*)mega, hipFuncAttributeMaxDynamicSharedMemorySize, LDS_BYTES) != hipSuccess) { fprintf(stderr, "kernel_launch: hipFuncSetAttribute failed\n"); grid = -1; return; }
        if (hipOccupancyMaxActiveBlocksPerMultiprocessor(&per_cu, (const void*)mega, NTHREADS, LDS_BYTES) != hipSuccess || per_cu < 1) { fprintf(stderr, "kernel_launch: occupancy query failed (%d)\n", per_cu); per_cu = 1; }
        (void)hipGetLastError();
        grid = cus;
    }
    if (grid < 0) return;
    (void)hipMemsetAsync((char*)d_ws + OFF_CTL, 0, ZERO_BYTES, stream);
    Params p{};
    p.x = (const float*)d_in[0]; p.c = (const float*)d_in[1]; p.pos = (const int*)d_in[2]; p.ada_w = (const float*)d_in[3]; p.ada_b = (const float*)d_in[4];
    p.n1g = (const float*)d_in[5]; p.n2g = (const float*)d_in[6]; p.w_in = (const float*)d_in[7]; p.qng = (const float*)d_in[8]; p.kvng = (const float*)d_in[9];
    p.w_uq = (const float*)d_in[10]; p.w_ukv = (const float*)d_in[11]; p.w_bm = (const float*)d_in[12]; p.w_bs = (const float*)d_in[13]; p.w_out = (const float*)d_in[14];
    p.w_pq = (const float*)d_in[15]; p.skeys = (const float*)d_in[16]; p.pu = (const float*)d_in[17]; p.pv = (const float*)d_in[18]; p.fng = (const float*)d_in[19];
    p.out = (float*)d_out; p.ws = (unsigned char*)d_ws;
    for (int i = 0; i < 32; ++i) p.invf[i] = (float)pow(10000.0, -(double)i / 32.0);
#if N_LAUNCH_MODE == 1
    p.ph_lo = 0; p.ph_hi = NPHASE;
    void* args[] = {&p};
    hipError_t e = hipLaunchCooperativeKernel((const void*)mega, dim3(grid), dim3(NTHREADS), args, LDS_BYTES, stream);
    if (e != hipSuccess) fprintf(stderr, "cooperative launch failed: %s (grid %d)\n", hipGetErrorString(e), grid);
#else
    for (int k = 0; k < NPHASE; ++k) {
        p.ph_lo = k; p.ph_hi = k + 1;
        hipLaunchKernelGGL(mega, dim3(grid), dim3(NTHREADS), LDS_BYTES, stream, p);
    }
#endif
}
```

```cpp
#include <hip/hip_runtime.h>
#include <hip/hip_cooperative_groups.h>
#include <cstdio>
#include <cstdint>
#include <cmath>
namespace cg = cooperative_groups;

#ifndef N_LAUNCH_MODE
#define N_LAUNCH_MODE 1
#endif

#ifndef TIME_PHASE
#define TIME_PHASE -1
#endif
#ifndef TIME_SCALE
#define TIME_SCALE 5000.f
#endif
#ifndef DUP_GEMM
#define DUP_GEMM -1
#endif
#ifndef PRO_SPLIT
#define PRO_SPLIT 1
#endif
#ifndef USE_XBAR
#define USE_XBAR 1
#endif
#ifndef DBG_XTRA_BAR
#define DBG_XTRA_BAR 0
#endif
#ifndef DBG_ROUND_BAR
#define DBG_ROUND_BAR 0
#endif
#ifndef GATHER_DYN
#define GATHER_DYN 1
#endif
#ifndef SEL_FUSED
#define SEL_FUSED 1
#endif
#ifndef DUP_PHASE
#define DUP_PHASE -1
#endif
#ifndef DBG_ALPHA
#define DBG_ALPHA 1.0f
#endif
#ifndef DBG_BETA
#define DBG_BETA 1.0f
#endif
#define LAS __attribute__((address_space(3)))
#define DI __device__ __forceinline__
typedef unsigned short bf16_t;
typedef short bf16x8 __attribute__((ext_vector_type(8)));
typedef float f32x4 __attribute__((ext_vector_type(4)));
typedef float f32x2 __attribute__((ext_vector_type(2)));
typedef unsigned u32x4 __attribute__((ext_vector_type(4)));
typedef unsigned u32x2 __attribute__((ext_vector_type(2)));
typedef __bf16 bf16v2 __attribute__((ext_vector_type(2)));

constexpr int M = 16384, D = 2048, SEQ = 4096, NB = 4;
constexpr int NTHREADS = 512, NWAVES = 8;
constexpr int LDS_BYTES = 160 * 1024;
constexpr float EPS = 1e-6f;
constexpr float LOG2E = 1.4426950408889634f;
constexpr int NPHASE = 14;

constexpr size_t al256(size_t x) { return (x + 255) & ~(size_t)255; }
constexpr size_t OFF_CTL = 0;
constexpr size_t OFF_XBAR = 4096;
constexpr size_t OFF_MODI = 32768;
constexpr size_t ZERO_BYTES = OFF_MODI + (size_t)NB * 6 * D * 8;
constexpr size_t OFF_MOD = al256(ZERO_BYTES);
constexpr size_t OFF_RSTQ = OFF_MOD + (size_t)NB * 6 * D * 4;
constexpr size_t OFF_RSTKV = OFF_RSTQ + (size_t)M * 4;
constexpr size_t OFF_CS = OFF_RSTKV + (size_t)M * 4;
constexpr size_t OFF_KEYS = OFF_CS + (size_t)M * 32 * 8;
constexpr size_t OFF_WIN = OFF_KEYS + (size_t)8 * 2 * 128 * 128 * 2;
constexpr size_t OFF_WSBV = OFF_WIN + (size_t)7168 * 2048 * 2;
constexpr size_t OFF_WUQ = OFF_WSBV + (size_t)1024 * 2048 * 2;
constexpr size_t OFF_WUK = OFF_WUQ + (size_t)1536 * 512 * 2;
constexpr size_t OFF_WUV = OFF_WUK + (size_t)1024 * 256 * 2;
constexpr size_t OFF_WA = OFF_WUV + (size_t)1024 * 256 * 2;
constexpr size_t OFF_WB = OFF_WA + (size_t)2048 * 1024 * 2;
constexpr size_t OFF_WOUT = OFF_WB + (size_t)2048 * 1024 * 2;
constexpr size_t OFF_WPQ = OFF_WOUT + (size_t)2048 * 2048 * 2;
constexpr size_t OFF_H = OFF_WPQ + (size_t)2048 * 2048 * 2;
constexpr size_t OFF_CQ = OFF_H + (size_t)M * 2048 * 2;
constexpr size_t OFF_CKV = OFF_CQ + (size_t)M * 512 * 2;
constexpr size_t OFF_KR = OFF_CKV + (size_t)M * 256 * 2;
constexpr size_t OFF_SBQ = OFF_KR + (size_t)M * 64 * 2;
constexpr size_t OFF_SBK = OFF_SBQ + (size_t)M * 1024 * 2;
constexpr size_t OFF_SBVT = OFF_SBK + (size_t)M * 1024 * 2;
constexpr size_t OFF_GA = OFF_SBVT + (size_t)M * 1024 * 2;
constexpr size_t OFF_GB = OFF_GA + (size_t)M * 2048 * 2;
constexpr size_t OFF_Q = OFF_GB + (size_t)M * 2048 * 2;
constexpr size_t OFF_KN = OFF_Q + (size_t)M * 1536 * 2;
constexpr size_t OFF_VT = OFF_KN + (size_t)M * 1024 * 2;
constexpr size_t OFF_ATTA = OFF_VT + (size_t)M * 1024 * 2;
constexpr size_t OFF_ATTB = OFF_ATTA + (size_t)M * 1024 * 2;
constexpr size_t WS_END = OFF_ATTB + (size_t)M * 1024 * 2;
constexpr size_t OFF_MERGED = OFF_SBQ;
constexpr size_t OFF_PQ = OFF_GA;
constexpr size_t OFF_IDX = OFF_GB;
constexpr size_t OFF_GW = OFF_GB + (size_t)M * 128 * 4;
constexpr size_t OFF_U16 = OFF_Q;
constexpr size_t OFF_V16 = OFF_U16 + (size_t)16384 * 2048;
static_assert(OFF_V16 + (size_t)16384 * 2048 <= WS_END, "u/v overlay");
constexpr float U8_SCALE = 68.f, V8_SCALE = 1.5f;
static_assert(WS_END < (size_t)620 * 1000 * 1000, "workspace budget");

struct Params {
    const float *x, *c; const int* pos;
    const float *ada_w, *ada_b, *n1g, *n2g, *w_in, *qng, *kvng, *w_uq, *w_ukv, *w_bm, *w_bs, *w_out, *w_pq, *skeys, *pu, *pv, *fng;
    float* out; unsigned char* ws;
    float invf[32];
    int ph_lo, ph_hi;
};

DI unsigned pk2(float lo, float hi) { bf16v2 p; p[0] = (__bf16)lo; p[1] = (__bf16)hi; return __builtin_bit_cast(unsigned, p); }
DI float bflo(unsigned u) { return __uint_as_float(u << 16); }
DI float bfhi(unsigned u) { return __uint_as_float(u & 0xffff0000u); }
DI float dot2bf(unsigned a, unsigned b, float c) { return __builtin_amdgcn_fdot2_f32_bf16(__builtin_bit_cast(bf16v2, a), __builtin_bit_cast(bf16v2, b), c, false); }
DI float bf2f(bf16_t b) { return __uint_as_float(((unsigned)b) << 16); }
DI float wave_sum(float v) {
#pragma unroll
    for (int o = 1; o < 64; o <<= 1) v += __shfl_xor(v, o);
    return v;
}
DI float wave_max(float v) {
#pragma unroll
    for (int o = 1; o < 64; o <<= 1) v = fmaxf(v, __shfl_xor(v, o));
    return v;
}
DI float sigmoidf_(float v) { return 1.f / (1.f + __expf(-v)); }
DI float gelu_tanh(float v) { const float u = 0.7978845608028654f * (v + 0.044715f * v * v * v); const float e = __expf(2.f * u); const float t = 1.f - 2.f / (e + 1.f); return 0.5f * v * (1.f + t); }
DI void store_bf16x4(bf16_t* p, f32x4 v) { u32x2 w; w.x = pk2(v[0], v[1]); w.y = pk2(v[2], v[3]); *(u32x2*)p = w; }
DI void store_bf16x8(bf16_t* p, f32x4 a, f32x4 b) { u32x4 w; w.x = pk2(a[0], a[1]); w.y = pk2(a[2], a[3]); w.z = pk2(b[0], b[1]); w.w = pk2(b[2], b[3]); *(u32x4*)p = w; }
DI void load_bf16x8(const bf16_t* p, f32x4& a, f32x4& b) { const u32x4 w = *(const u32x4*)p; a = (f32x4){bflo(w.x), bfhi(w.x), bflo(w.y), bfhi(w.y)}; b = (f32x4){bflo(w.z), bfhi(w.z), bflo(w.w), bfhi(w.w)}; }
DI f32x4 sig4(f32x4 v) { return (f32x4){sigmoidf_(v[0]), sigmoidf_(v[1]), sigmoidf_(v[2]), sigmoidf_(v[3])}; }
DI f32x4 rope4(f32x4 v, f32x2 c0, f32x2 c1) { return (f32x4){v[0] * c0.x - v[1] * c0.y, v[1] * c0.x + v[0] * c0.y, v[2] * c1.x - v[3] * c1.y, v[3] * c1.x + v[2] * c1.y}; }
DI f32x4 load_bf16x4(const bf16_t* p) { const u32x2 w = *(const u32x2*)p; return (f32x4){bflo(w.x), bfhi(w.x), bflo(w.y), bfhi(w.y)}; }

struct Ctx {
    LAS unsigned char* lds;
    int tid, lane, wave, gw, ngw;
};

struct MapWin { DI int operator()(int n) const {
    if (n < 768) return n;
    if (n < 1024) { const int j = n - 768; if (j >= 64) return -1; return 768 + (j >> 1) + 32 * (j & 1); }
    if (n < 2048) return 832 + (n - 1024);
    if (n < 3072) return 1856 + (n - 2048);
    if (n < 5120) return 3904 + (n - 3072);
    return 5952 + (n - 5120); } };
struct MapOff { int off; DI int operator()(int n) const { return n + off; } };
struct MapUq { DI int operator()(int n) const { const int hd = n / 192, j = n % 192; if (j < 128) return hd * 192 + j; const int jj = j - 128; return hd * 192 + 128 + (jj >> 1) + 32 * (jj & 1); } };
struct MapUk { DI int operator()(int n) const { return (n >> 7) * 256 + (n & 127); } };
struct MapUv { DI int operator()(int n) const { return (n >> 7) * 256 + 128 + (n & 127); } };

template <class Map>
DI void transpose_item(const float* W, int K, int N, const Map& mp, const float* rowscale, bf16_t* dst, int kb, int nb, LAS float* scr, int lane) {
    const int k0 = kb * 64, sc = mp(nb * 64 + lane);
#pragma unroll 8
    for (int kk = 0; kk < 64; ++kk) {
        float v = 0.f;
        if (sc >= 0) v = W[(size_t)(k0 + kk) * N + sc];
        if (rowscale) v *= rowscale[k0 + kk];
        scr[kk * 65 + lane] = v;
    }
    asm volatile("s_waitcnt lgkmcnt(0)" ::: "memory");
    const int kc = lane & 7;
#pragma unroll
    for (int j = 0; j < 8; ++j) {
        const int nrow = (lane >> 3) + 8 * j; const LAS float* s = scr + (8 * kc) * 65 + nrow;
        u32x4 o; o.x = pk2(s[0], s[65]); o.y = pk2(s[2 * 65], s[3 * 65]); o.z = pk2(s[4 * 65], s[5 * 65]); o.w = pk2(s[6 * 65], s[7 * 65]);
        *(u32x4*)(dst + (size_t)(nb * 64 + nrow) * K + k0 + 8 * kc) = o;
    }
    asm volatile("s_waitcnt lgkmcnt(0)" ::: "memory");
}

DI void phase_prologue(const Params& p, const Ctx& c, bool do_ada = true, bool do_rest = true) {
    unsigned char* ws = p.ws;
    LAS float* scr = (LAS float*)(c.lds + c.wave * 16640);
    unsigned long long* modi = (unsigned long long*)(ws + OFF_MODI);
    if (do_ada) for (int u = c.gw; u < 32 * 48; u += c.ngw) {
        const int kp = u / 48, ch = u % 48, k0 = kp * 64, c0 = ch * 256 + c.lane * 4;
        float sl[4];
#pragma unroll
        for (int b = 0; b < 4; ++b) { const float cv = p.c[b * D + k0 + c.lane]; sl[b] = cv / (1.f + __expf(-cv)); }
        f32x4 acc[4];
#pragma unroll
        for (int b = 0; b < 4; ++b) acc[b] = (f32x4){0.f, 0.f, 0.f, 0.f};
#pragma unroll 16
        for (int kk = 0; kk < 64; ++kk) {
            const f32x4 w = *(const f32x4*)(p.ada_w + (size_t)(k0 + kk) * (6 * D) + c0);
#pragma unroll
            for (int b = 0; b < 4; ++b) { const float s = __shfl(sl[b], kk); acc[b] += w * s; }
        }
        if (kp == 0) { const f32x4 bv = *(const f32x4*)(p.ada_b + c0);
#pragma unroll
            for (int b = 0; b < 4; ++b) acc[b] += bv; }
#pragma unroll
        for (int b = 0; b < 4; ++b)
#pragma unroll
            for (int e = 0; e < 4; ++e) atomicAdd(modi + b * 6 * D + c0 + e, (unsigned long long)(long long)__builtin_rint((double)acc[b][e] * 4294967296.0));
    }
    if (!do_rest) return;
    constexpr int I_WIN = 112 * 32, I_SBV = 16 * 32, I_UQ = 24 * 8, I_UK = 16 * 4, I_UV = 16 * 4, I_A = 32 * 16, I_B = 32 * 16, I_OUT = 32 * 32, I_PQ = 32 * 32;
    constexpr int NIT = I_WIN + I_SBV + I_UQ + I_UK + I_UV + I_A + I_B + I_OUT + I_PQ;
    for (int it = c.gw; it < NIT; it += c.ngw) {
        int r = it;
        if (r < I_WIN) { transpose_item(p.w_in, 2048, 8000, MapWin{}, nullptr, (bf16_t*)(ws + OFF_WIN), r % 32, r / 32, scr, c.lane); continue; } r -= I_WIN;
        if (r < I_SBV) { transpose_item(p.w_in, 2048, 8000, MapOff{2880}, nullptr, (bf16_t*)(ws + OFF_WSBV), r % 32, r / 32, scr, c.lane); continue; } r -= I_SBV;
        if (r < I_UQ) { transpose_item(p.w_uq, 512, 1536, MapUq{}, p.qng, (bf16_t*)(ws + OFF_WUQ), r % 8, r / 8, scr, c.lane); continue; } r -= I_UQ;
        if (r < I_UK) { transpose_item(p.w_ukv, 256, 2048, MapUk{}, p.kvng, (bf16_t*)(ws + OFF_WUK), r % 4, r / 4, scr, c.lane); continue; } r -= I_UK;
        if (r < I_UV) { transpose_item(p.w_ukv, 256, 2048, MapUv{}, p.kvng, (bf16_t*)(ws + OFF_WUV), r % 4, r / 4, scr, c.lane); continue; } r -= I_UV;
        if (r < I_A) { transpose_item(p.w_bm, 1024, 2048, MapOff{0}, nullptr, (bf16_t*)(ws + OFF_WA), r % 16, r / 16, scr, c.lane); continue; } r -= I_A;
        if (r < I_B) { transpose_item(p.w_bs, 1024, 2048, MapOff{0}, nullptr, (bf16_t*)(ws + OFF_WB), r % 16, r / 16, scr, c.lane); continue; } r -= I_B;
        if (r < I_OUT) { transpose_item(p.w_out, 2048, 2048, MapOff{0}, nullptr, (bf16_t*)(ws + OFF_WOUT), r % 32, r / 32, scr, c.lane); continue; } r -= I_OUT;
        transpose_item(p.w_pq, 2048, 2048, MapOff{0}, nullptr, (bf16_t*)(ws + OFF_WPQ), r % 32, r / 32, scr, c.lane);
    }
    { bf16_t* kd = (bf16_t*)(ws + OFF_KEYS);
      for (int i = (c.gw * 64 + c.lane) * 4; i < 8 * 2 * 128 * 128; i += c.ngw * 64 * 4) store_bf16x4(kd + i, *(const f32x4*)(p.skeys + i)); }
    { f32x2* cs = (f32x2*)(ws + OFF_CS);
      for (int i = c.gw * 64 + c.lane; i < M * 32; i += c.ngw * 64) {
          const int m = i >> 5, f = i & 31;
          const float ang = (float)p.pos[m] * p.invf[f];
          const double rev = (double)ang * 0.15915494309189533576888;
          const float fr = (float)(rev - __builtin_rint(rev));
          cs[i] = (f32x2){__builtin_amdgcn_cosf(fr), __builtin_amdgcn_sinf(fr)};
      } }
}

DI f32x4 ld_mod4(const float* p) { return *(const f32x4*)p; }
DI f32x4 ld_mod4(const long long* p) { f32x4 r;
#pragma unroll
    for (int e = 0; e < 4; ++e) r[e] = (float)((double)p[e] * (1.0 / 4294967296.0));
    return r; }
template <class MT>
DI void modulate_rows(const float* src, const float* g, const MT* sc, const MT* sh, bf16_t* dst, const Ctx& c) {
    for (int m = c.gw; m < M; m += c.ngw) {
        const int b = m / SEQ;
        const float* xr = src + (size_t)m * D;
        f32x4 v[8]; float ss = 0.f;
#pragma unroll
        for (int j = 0; j < 8; ++j) { v[j] = *(const f32x4*)(xr + (j * 64 + c.lane) * 4); ss += v[j][0] * v[j][0] + v[j][1] * v[j][1] + v[j][2] * v[j][2] + v[j][3] * v[j][3]; }
        const float rstd = rsqrtf(wave_sum(ss) * (1.f / D) + EPS);
#pragma unroll
        for (int j = 0; j < 8; ++j) {
            const int col = (j * 64 + c.lane) * 4;
            const f32x4 gg = *(const f32x4*)(g + col), s1 = ld_mod4(sc + b * 6 * D + col), h1 = ld_mod4(sh + b * 6 * D + col);
            const f32x4 o = v[j] * rstd * gg * (s1 + 1.f) + h1;
            store_bf16x4(dst + (size_t)m * D + col, o);
        }
    }
}
DI void phase_rowstats(const Params& p, const Ctx& c) {
    const bf16_t* cq = (const bf16_t*)(p.ws + OFF_CQ); const bf16_t* ckv = (const bf16_t*)(p.ws + OFF_CKV);
    float* rq = (float*)(p.ws + OFF_RSTQ); float* rkv = (float*)(p.ws + OFF_RSTKV);
    for (int m = c.gw; m < M; m += c.ngw) {
        const u32x4 a = *(const u32x4*)(cq + (size_t)m * 512 + c.lane * 8);
        const u32x2 b = *(const u32x2*)(ckv + (size_t)m * 256 + c.lane * 4);
        float s1 = 0.f, s2 = 0.f;
#pragma unroll
        for (int e = 0; e < 4; ++e) { const float lo = bflo(a[e]), hi = bfhi(a[e]); s1 += lo * lo + hi * hi; }
#pragma unroll
        for (int e = 0; e < 2; ++e) { const float lo = bflo(b[e]), hi = bfhi(b[e]); s2 += lo * lo + hi * hi; }
        s1 = wave_sum(s1); s2 = wave_sum(s2);
        if (c.lane == 0) { rq[m] = rsqrtf(s1 * (1.f / 512.f) + EPS); rkv[m] = rsqrtf(s2 * (1.f / 256.f) + EPS); }
    }
}
typedef float f32x16v __attribute__((ext_vector_type(16)));
typedef float f32x32v __attribute__((ext_vector_type(32)));
typedef unsigned u32x6 __attribute__((ext_vector_type(6)));
#ifndef FP6_ORDER
#define FP6_ORDER 1
#endif
DI void convert_table(const float* src, unsigned char* dst, float scale, const Ctx& c) {
    const size_t ngroups = (size_t)16384 * 64;
    for (size_t gi = (size_t)c.gw * 64 + c.lane; gi < ngroups; gi += (size_t)c.ngw * 64) {
        const size_t row = gi >> 6; const int l = (int)(gi & 63);
        const float* sp = src + row * 2048 + l * 32;
        f32x4 v[8];
#pragma unroll
        for (int i = 0; i < 8; ++i) v[i] = *(const f32x4*)(sp + 4 * i) * scale;
        f32x16v a, b;
#pragma unroll
        for (int e = 0; e < 16; ++e) {
#if FP6_ORDER == 0
            a[e] = v[e >> 2][e & 3]; b[e] = v[4 + (e >> 2)][e & 3];
#else
            a[e] = v[(2 * e) >> 2][(2 * e) & 3]; b[e] = v[(2 * e + 1) >> 2][(2 * e + 1) & 3];
#endif
        }
        const u32x6 pk = __builtin_amdgcn_cvt_scalef32_2xpk16_fp6_f32(a, b, 1.0f);
        unsigned char* dp = dst + row * 1536;
        *(u32x4*)(dp + 16 * l) = (u32x4){pk[0], pk[1], pk[2], pk[3]};
        *(u32x2*)(dp + 1024 + 8 * l) = (u32x2){pk[4], pk[5]};
    }
}

struct EpiProj {
    bf16_t *cq, *ckv, *kr, *sbq, *sbk, *ga, *gb; const f32x2* cs;
    DI void operator()(int row, int col, f32x4 v) const {
        const int tile = col >> 8;
        if (tile < 2) { store_bf16x4(cq + (size_t)row * 512 + col, v); }
        else if (tile == 2) { store_bf16x4(ckv + (size_t)row * 256 + (col - 512), v); }
        else if (tile == 3) { const int j = col - 768; if (j < 64) { const f32x2 c0 = cs[row * 32 + (j >> 1)], c1 = cs[row * 32 + (j >> 1) + 1];
            const f32x4 o = {v[0] * c0.x - v[1] * c0.y, v[1] * c0.x + v[0] * c0.y, v[2] * c1.x - v[3] * c1.y, v[3] * c1.x + v[2] * c1.y};
            store_bf16x4(kr + (size_t)row * 64 + j, o); } }
        else if (tile < 8) { store_bf16x4(sbq + (size_t)row * 1024 + (col - 1024), v * (0.08838834764831845f * LOG2E)); }
        else if (tile < 12) { store_bf16x4(sbk + (size_t)row * 1024 + (col - 2048), v); }
        else if (tile < 20) { store_bf16x4(ga + (size_t)row * 2048 + (col - 3072), (f32x4){sigmoidf_(v[0]), sigmoidf_(v[1]), sigmoidf_(v[2]), sigmoidf_(v[3])}); }
        else { store_bf16x4(gb + (size_t)row * 2048 + (col - 5120), (f32x4){sigmoidf_(v[0]), sigmoidf_(v[1]), sigmoidf_(v[2]), sigmoidf_(v[3])}); }
    }    DI void operator()(int row, int col, f32x4 v0, f32x4 v1) const {
        const int tile = col >> 8;
        if (tile < 2) { store_bf16x8(cq + (size_t)row * 512 + col, v0, v1); }
        else if (tile == 2) { store_bf16x8(ckv + (size_t)row * 256 + (col - 512), v0, v1); }
        else if (tile == 3) { const int j = col - 768; if (j < 64) { const f32x2* cp = cs + row * 32 + (j >> 1);
            store_bf16x8(kr + (size_t)row * 64 + j, rope4(v0, cp[0], cp[1]), rope4(v1, cp[2], cp[3])); } }
        else if (tile < 8) { const float sc = 0.08838834764831845f * LOG2E; store_bf16x8(sbq + (size_t)row * 1024 + (col - 1024), v0 * sc, v1 * sc); }
        else if (tile < 12) { store_bf16x8(sbk + (size_t)row * 1024 + (col - 2048), v0, v1); }
        else if (tile < 20) { store_bf16x8(ga + (size_t)row * 2048 + (col - 3072), sig4(v0), sig4(v1)); }
        else { store_bf16x8(gb + (size_t)row * 2048 + (col - 5120), sig4(v0), sig4(v1)); }
    }
};
struct EpiT { bf16_t* o; const float* cscale;
    DI void operator()(int row, int col, f32x4 v) const { if (cscale) v = v * *(const f32x4*)(cscale + col); store_bf16x4(o + (size_t)row * M + col, v); }
    DI void operator()(int row, int col, f32x4 v0, f32x4 v1) const { if (cscale) { v0 = v0 * *(const f32x4*)(cscale + col); v1 = v1 * *(const f32x4*)(cscale + col + 4); } store_bf16x8(o + (size_t)row * M + col, v0, v1); } };
struct EpiUq { bf16_t* q; const float* rst; const f32x2* cs;
    DI void operator()(int row, int col, f32x4 v) const {
        v = v * (rst[row] * (0.07216878364870322f * LOG2E));
        const int j = col % 192;
        if (j >= 128) { const int i0 = (j - 128) >> 1; const f32x2 c0 = cs[row * 32 + i0], c1 = cs[row * 32 + i0 + 1];
            v = (f32x4){v[0] * c0.x - v[1] * c0.y, v[1] * c0.x + v[0] * c0.y, v[2] * c1.x - v[3] * c1.y, v[3] * c1.x + v[2] * c1.y}; }
        store_bf16x4(q + (size_t)row * 1536 + col, v);
    }
    DI void operator()(int row, int col, f32x4 v0, f32x4 v1) const {
        const float sc = rst[row] * (0.07216878364870322f * LOG2E); v0 = v0 * sc; v1 = v1 * sc;
        const int j = col % 192;
        if (j >= 128) { const f32x2* cp = cs + row * 32 + ((j - 128) >> 1); v0 = rope4(v0, cp[0], cp[1]); v1 = rope4(v1, cp[2], cp[3]); }
        store_bf16x8(q + (size_t)row * 1536 + col, v0, v1);
    } };
struct EpiRowScale { bf16_t* o; int ld; const float* rst;
    DI void operator()(int row, int col, f32x4 v) const { store_bf16x4(o + (size_t)row * ld + col, v * rst[row]); }
    DI void operator()(int row, int col, f32x4 v0, f32x4 v1) const { const float sc = rst[row]; store_bf16x8(o + (size_t)row * ld + col, v0 * sc, v1 * sc); } };
struct EpiGate1 { bf16_t* mg; const bf16_t* g;
    DI void operator()(int row, int col, f32x4 v) const { const size_t i = (size_t)row * 2048 + col; store_bf16x4(mg + i, v * load_bf16x4(g + i)); }
    DI void operator()(int row, int col, f32x4 v0, f32x4 v1) const { const size_t i = (size_t)row * 2048 + col; f32x4 g0, g1; load_bf16x8(g + i, g0, g1); store_bf16x8(mg + i, v0 * g0, v1 * g1); } };
struct EpiGate2 { bf16_t* mg; const bf16_t* g;
    DI void operator()(int row, int col, f32x4 v) const { const size_t i = (size_t)row * 2048 + col; store_bf16x4(mg + i, load_bf16x4(mg + i) + v * load_bf16x4(g + i)); }
    DI void operator()(int row, int col, f32x4 v0, f32x4 v1) const { const size_t i = (size_t)row * 2048 + col; f32x4 g0, g1, m0, m1; load_bf16x8(g + i, g0, g1); load_bf16x8(mg + i, m0, m1); store_bf16x8(mg + i, m0 + v0 * g0, m1 + v1 * g1); } };
struct EpiRes { const float* x; const float* gt; float* x1;
    DI void operator()(int row, int col, f32x4 v) const { const size_t i = (size_t)row * 2048 + col; const int b = row / SEQ;
        *(f32x4*)(x1 + i) = *(const f32x4*)(x + i) + *(const f32x4*)(gt + b * 6 * D + col) * v * DBG_ALPHA; }
    DI void operator()(int row, int col, f32x4 v0, f32x4 v1) const { (*this)(row, col, v0); (*this)(row, col + 4, v1); } };
struct EpiPq { bf16_t* pq;
    DI void operator()(int row, int col, f32x4 v) const { store_bf16x4(pq + (size_t)(col >> 8) * M * 256 + (size_t)row * 256 + (col & 255), v); }
    DI void operator()(int row, int col, f32x4 v0, f32x4 v1) const { store_bf16x8(pq + (size_t)(col >> 8) * M * 256 + (size_t)row * 256 + (col & 255), v0, v1); } };

template <class Epi>
DI void gemm_naive(const Ctx& c, const bf16_t* A, const bf16_t* Bt, int Mg, int Ng, int Kg, const Epi& E) {
    LAS float* As = (LAS float*)c.lds; LAS float* Bs = As + 16 * 132;
    const int tid = c.tid, ty = tid >> 5, tx = tid & 31;
    const int tilesN = Ng / 128, ntiles = (Mg / 128) * tilesN;
    for (int t = blockIdx.x; t < ntiles; t += gridDim.x) {
        const int tm = t / tilesN, tn = t % tilesN;
        float acc[8][4];
#pragma unroll
        for (int i = 0; i < 8; ++i)
#pragma unroll
            for (int j = 0; j < 4; ++j) acc[i][j] = 0.f;
        for (int k0 = 0; k0 < Kg; k0 += 16) {
            { const int lt = tid & 255, r = lt >> 1, kc = lt & 1;
              const bf16_t* src = (tid < 256 ? A + (size_t)(tm * 128 + r) * Kg : Bt + (size_t)(tn * 128 + r) * Kg) + k0 + kc * 8;
              const u32x4 v = *(const u32x4*)src;
              LAS float* dst = (tid < 256 ? As : Bs) + (kc * 8) * 132 + r;
              dst[0] = bflo(v.x); dst[132] = bfhi(v.x); dst[2 * 132] = bflo(v.y); dst[3 * 132] = bfhi(v.y);
              dst[4 * 132] = bflo(v.z); dst[5 * 132] = bfhi(v.z); dst[6 * 132] = bflo(v.w); dst[7 * 132] = bfhi(v.w); }
            __syncthreads();
#pragma unroll
            for (int kk = 0; kk < 16; ++kk) {
                const f32x4 a0 = *(const LAS f32x4*)(As + kk * 132 + ty * 8), a1 = *(const LAS f32x4*)(As + kk * 132 + ty * 8 + 4);
                const f32x4 b = *(const LAS f32x4*)(Bs + kk * 132 + tx * 4);
#pragma unroll
                for (int j = 0; j < 4; ++j) {
                    acc[0][j] += a0[0] * b[j]; acc[1][j] += a0[1] * b[j]; acc[2][j] += a0[2] * b[j]; acc[3][j] += a0[3] * b[j];
                    acc[4][j] += a1[0] * b[j]; acc[5][j] += a1[1] * b[j]; acc[6][j] += a1[2] * b[j]; acc[7][j] += a1[3] * b[j];
                }
            }
            __syncthreads();
        }
#pragma unroll
        for (int i = 0; i < 8; ++i) E(tm * 128 + ty * 8 + i, tn * 128 + tx * 4, (f32x4){acc[i][0], acc[i][1], acc[i][2], acc[i][3]});
    }
}

namespace pg8 {
#define PG8_LAS __attribute__((address_space(3)))
typedef unsigned short bf16_t;
typedef short bf16x8 __attribute__((ext_vector_type(8)));
typedef float f32x4 __attribute__((ext_vector_type(4)));
typedef unsigned u32x4 __attribute__((ext_vector_type(4)));
constexpr int BM = 256, BK = 64, HALF = 128, HTB = HALF * BK * 2  , STAGE_BYTES = 8 * HTB, NXCD = 8, WGM = 4;

__host__ __device__ __forceinline__ int lds_byte(int r, int c) { const int st = (r >> 4) * 2 + (c >> 5), rr = r & 15, cc = c & 31, ob = rr * 64 + cc * 2; return st * 1024 + (ob ^ (((ob >> 9) & 1) << 5)); }
__host__ __device__ __forceinline__ void stage_rc(int b, int& R, int& C) { const int st = b / 1024, sb = b % 1024, swz = sb ^ (((sb >> 9) & 1) << 5); R = (st >> 1) * 16 + swz / 64; C = (st & 1) * 32 + (swz % 64) / 2; }
__host__ __device__ __forceinline__ int perm32(int rho) { const int n = rho >> 4, i = rho & 15; return 8 * (i >> 2) + 4 * n + (i & 3); }

struct Unit { int pm, pn; };
struct Gemm { const bf16_t* A; const bf16_t* Bt; int M, N, K; int tid; };
struct StaticOrder {
    int nM, nN, nwg, G, c;
    __host__ __device__ void init(int M, int N, int G_, int c_) { nM = M / BM; nN = N / BM; nwg = nM * nN; G = G_; c = c_; }
    __host__ __device__ bool next(int i, Unit& u) const {
        const long L = (long)i * G + c; if (L >= nwg) return false;
        int wgid = (int)L; { const int q = nwg / NXCD, r = nwg % NXCD, xcd = wgid % NXCD, off = wgid / NXCD; wgid = (xcd < r ? xcd * (q + 1) : r * (q + 1) + (xcd - r) * q) + off; }
        const int nig = WGM * nN, gid = wgid / nig, fm = gid * WGM, gsz = (nM - fm) < WGM ? (nM - fm) : WGM;
        u.pm = fm + ((wgid % nig) % gsz); u.pn = (wgid % nig) / gsz; return true;
    }
    __device__ __forceinline__ void a_ready(const Unit&) const {}
    __device__ __forceinline__ void done(const Unit&) const {}
};
template <class Epi, class Sched, bool STAMP = false>
__device__ __forceinline__ void gemm_phase(PG8_LAS unsigned char* lds, const Gemm g, const Sched& S, const Epi& E, unsigned long long* stamps) {
    const int tid = g.tid, wid = __builtin_amdgcn_readfirstlane(tid >> 6), lane = tid & 63, wr = wid >> 2, wc = wid & 3, fr = lane & 15, fq = lane >> 4;
    const int K = g.K, nt = K / BK;
    int ts_lo = 0, ts_hi = 0, nts = 0; const unsigned long long rt_entry = STAMP ? (unsigned long long)wall_clock64() : 0ull;
#define PG8_STAMP() do { if (STAMP && wid == 0 && nts < 64) { const unsigned long long _c = (unsigned long long)clock64(); \
        ts_lo = (lane == nts) ? (int)(unsigned)_c : ts_lo; ts_hi = (lane == nts) ? (int)(unsigned)(_c >> 32) : ts_hi; ++nts; } } while (0)
    PG8_STAMP();
    unsigned voffA[2], voffB[2];
#pragma unroll
    for (int i = 0; i < 2; ++i) { int R, C; stage_rc(tid * 16 + i * 8192, R, C); const int Rb = Epi::PERM ? ((R & ~31) + perm32(R & 31)) : R;
        voffA[i] = (unsigned)(R * K + C) * 2u; voffB[i] = (unsigned)(Rb * K + C) * 2u; }
    const size_t kstep = (size_t)(BK * 2);
    const size_t hstep = (size_t)HALF * K * 2;
    const size_t tstep = 2 * hstep;
    const unsigned ldsw = (unsigned)wid * 1024u;
    const int aoff = lds_byte(wr * 64 + fr, fq * 8), boff = lds_byte(wc * 32 + fr, fq * 8);
#define PG8_SA(b, h) (((b) * 2 + (h)) * HTB)
#define PG8_SB(b, h) ((4 + (b) * 2 + (h)) * HTB)
#define PG8_STAGE(bufoff, gbase, voff) do { _Pragma("unroll") for (int _i = 0; _i < 2; ++_i) \
        __builtin_amdgcn_global_load_lds((const unsigned*)((const char*)(gbase) + (voff)[_i]), (PG8_LAS unsigned*)(lds + (bufoff) + ldsw + _i * 8192), 16, 0, 0); } while (0)
#define PG8_LDA(dst, b, h) do { _Pragma("unroll") for (int m = 0; m < 4; ++m) _Pragma("unroll") for (int k = 0; k < 2; ++k) dst[m][k] = *(const PG8_LAS bf16x8*)(lds + PG8_SA(b, h) + aoff + m * 2048 + k * 1024); } while (0)
#define PG8_LDB(dst, b, h) do { _Pragma("unroll") for (int n = 0; n < 2; ++n) _Pragma("unroll") for (int k = 0; k < 2; ++k) dst[n][k] = *(const PG8_LAS bf16x8*)(lds + PG8_SB(b, h) + boff + n * 2048 + k * 1024); } while (0)
#define PG8_MMA(ai, bj, At, Bt) do { __builtin_amdgcn_s_setprio(1); _Pragma("unroll") for (int m = 0; m < 4; ++m) _Pragma("unroll") for (int n = 0; n < 2; ++n) _Pragma("unroll") for (int k = 0; k < 2; ++k) \
        acc[ai][bj][m][n] = __builtin_amdgcn_mfma_f32_16x16x32_bf16(Bt[n][k], At[m][k], acc[ai][bj][m][n], 0, 0, 0); __builtin_amdgcn_s_setprio(0); } while (0)
#define PG8_WAIT_V(n) asm volatile("s_waitcnt vmcnt(" #n ")" ::: "memory")
#define PG8_WAIT_L(n) asm volatile("s_waitcnt lgkmcnt(" #n ")" ::: "memory")
#define PG8_BAR __builtin_amdgcn_s_barrier()
#define PG8_SCHED __builtin_amdgcn_sched_barrier(0)
    Unit cur, nxt; int ui = 0;
    if (!S.next(0, cur)) return;
    f32x4 acc[2][2][4][2];
#pragma unroll
    for (int a = 0; a < 2; ++a)
#pragma unroll
        for (int b = 0; b < 2; ++b)
#pragma unroll
            for (int m = 0; m < 4; ++m)
#pragma unroll
                for (int n = 0; n < 2; ++n) acc[a][b][m][n] = (f32x4){0.f, 0.f, 0.f, 0.f};
    bf16x8 At[4][2], B0[2][2], B1[2][2];
    const char* cA = (const char*)g.A + (size_t)cur.pm * tstep; const char* cB = (const char*)g.Bt + (size_t)cur.pn * tstep;
    S.a_ready(cur);
    PG8_STAGE(PG8_SB(0, 0), cB, voffB); PG8_STAGE(PG8_SA(0, 0), cA, voffA); PG8_STAGE(PG8_SB(0, 1), cB + hstep, voffB); PG8_STAGE(PG8_SA(0, 1), cA + hstep, voffA);
    if (wr == 1) PG8_BAR;
    PG8_WAIT_V(4); PG8_BAR;
    PG8_STAGE(PG8_SB(1, 0), cB + kstep, voffB); PG8_STAGE(PG8_SA(1, 0), cA + kstep, voffA); PG8_STAGE(PG8_SB(1, 1), cB + hstep + kstep, voffB);
    PG8_WAIT_V(6); PG8_BAR;
    PG8_STAMP();
    for (;;) {
        const bool has_next = S.next(ui + 1, nxt);
        const char* nA = has_next ? (const char*)g.A + (size_t)nxt.pm * tstep : cA; const char* nB = has_next ? (const char*)g.Bt + (size_t)nxt.pn * tstep : cB;
        for (int t = 0; t < nt; t += 2) {
            const bool last = (t == nt - 2);
            const char* a1 = cA + (size_t)(t + 1) * kstep;
            const char* a2 = last ? nA : cA + (size_t)(t + 2) * kstep; const char* b2 = last ? nB : cB + (size_t)(t + 2) * kstep;
            const char* a3 = a2 + kstep; const char* b3 = b2 + kstep;
            if (last && has_next) S.a_ready(nxt);
            PG8_LDB(B0, 0, 0); PG8_SCHED; PG8_LDA(At, 0, 0); PG8_STAGE(PG8_SA(1, 1), a1 + hstep, voffA);
            PG8_WAIT_L(8); PG8_BAR; PG8_WAIT_L(0); PG8_MMA(0, 0, At, B0); PG8_BAR; PG8_SCHED;
            PG8_LDB(B1, 0, 1); PG8_STAGE(PG8_SB(0, 0), b2, voffB);
            PG8_BAR; PG8_WAIT_L(0); PG8_MMA(0, 1, At, B1); PG8_BAR;
            PG8_LDA(At, 0, 1); PG8_STAGE(PG8_SA(0, 0), a2, voffA);
            PG8_BAR; PG8_WAIT_L(0); PG8_MMA(1, 0, At, B0); PG8_BAR; PG8_SCHED;
            PG8_STAGE(PG8_SB(0, 1), b2 + hstep, voffB);
            PG8_WAIT_V(6); PG8_BAR; PG8_MMA(1, 1, At, B1); PG8_BAR;
            PG8_LDB(B0, 1, 0); PG8_SCHED; PG8_LDA(At, 1, 0); PG8_STAGE(PG8_SA(0, 1), a2 + hstep, voffA);
            PG8_WAIT_L(8); PG8_BAR; PG8_WAIT_L(0); PG8_MMA(0, 0, At, B0); PG8_BAR; PG8_SCHED;
            PG8_LDB(B1, 1, 1); PG8_STAGE(PG8_SB(1, 0), b3, voffB);
            PG8_BAR; PG8_WAIT_L(0); PG8_MMA(0, 1, At, B1); PG8_BAR;
            PG8_LDA(At, 1, 1); PG8_STAGE(PG8_SA(1, 0), a3, voffA);
            PG8_BAR; PG8_WAIT_L(0); PG8_MMA(1, 0, At, B0); PG8_BAR; PG8_SCHED;
            PG8_STAGE(PG8_SB(1, 1), b3 + hstep, voffB);
            PG8_WAIT_V(6); PG8_BAR; PG8_MMA(1, 1, At, B1); PG8_BAR;
        }
        PG8_STAMP();
        if constexpr (!Epi::AFTER_DRAIN) { E(acc, cur, wr, wc, fr, fq); S.done(cur); }
        PG8_STAMP();
        if (!has_next) break;
#pragma unroll
        for (int a = 0; a < 2; ++a)
#pragma unroll
            for (int b = 0; b < 2; ++b)
#pragma unroll
                for (int m = 0; m < 4; ++m)
#pragma unroll
                    for (int n = 0; n < 2; ++n) acc[a][b][m][n] = (f32x4){0.f, 0.f, 0.f, 0.f};
        cur = nxt; cA = nA; cB = nB; ++ui;
    }
    PG8_WAIT_V(0);
    if (wr == 0) PG8_BAR;
    PG8_BAR;
    if constexpr (Epi::AFTER_DRAIN) { E.fused(acc, cur, wr, wc, fr, fq, lds, wid, lane); S.done(cur); }
    PG8_STAMP();
    if (STAMP && wid == 0) { stamps[lane] = lane < nts ? (((unsigned long long)(unsigned)ts_hi << 32) | (unsigned)ts_lo) : 0ull;
        if (lane == 62) stamps[62] = rt_entry; if (lane == 63) stamps[63] = (unsigned long long)wall_clock64(); }
#undef PG8_STAMP
#undef PG8_SA
#undef PG8_SB
#undef PG8_STAGE
#undef PG8_LDA
#undef PG8_LDB
#undef PG8_MMA
#undef PG8_WAIT_V
#undef PG8_WAIT_L
#undef PG8_BAR
#undef PG8_SCHED
}
}

template <class E4> struct EpiAdapt {
    static constexpr bool PERM = true, AFTER_DRAIN = false;
    E4 e;
    __device__ __forceinline__ void operator()(const pg8::f32x4 (&acc)[2][2][4][2], const pg8::Unit& u, int wr, int wc, int fr, int fq) const {
#pragma unroll
        for (int ai = 0; ai < 2; ++ai)
#pragma unroll
            for (int m = 0; m < 4; ++m) {
                const int row = u.pm * 256 + ai * 128 + wr * 64 + m * 16 + fr;
#pragma unroll
                for (int bj = 0; bj < 2; ++bj) e(row, u.pn * 256 + bj * 128 + wc * 32 + fq * 8, acc[ai][bj][m][0], acc[ai][bj][m][1]);
                asm volatile("" ::: "memory");
            }
    }
};
template <class E4>
DI void gemm_fast(const Ctx& c, const bf16_t* A, const bf16_t* Bt, int Mg, int Ng, int Kg, const E4& e4) {
    pg8::Gemm g{A, Bt, Mg, Ng, Kg, c.tid}; pg8::StaticOrder S; S.init(Mg, Ng, (int)gridDim.x, (int)blockIdx.x);
    EpiAdapt<E4> E{e4};
    pg8::gemm_phase<EpiAdapt<E4>, pg8::StaticOrder, false>((PG8_LAS unsigned char*)c.lds, g, S, E, nullptr);
}
#ifndef FAST_GEMM
#define FAST_GEMM 1
#endif
#if FAST_GEMM
#define GEMM(c_, ...) do { MKCTX(); gemm_fast(c, __VA_ARGS__); } while (0)
#else
#define GEMM(c_, ...) do { MKCTX(); gemm_naive(c, __VA_ARGS__); } while (0)
#endif

DI void attn_mla_naive(const Params& p, const Ctx& c) {
    const bf16_t* Q = (const bf16_t*)(p.ws + OFF_Q); const bf16_t* KN = (const bf16_t*)(p.ws + OFF_KN); const bf16_t* KR = (const bf16_t*)(p.ws + OFF_KR);
    const bf16_t* VT = (const bf16_t*)(p.ws + OFF_VT); bf16_t* O = (bf16_t*)(p.ws + OFF_ATTA);
    for (int u = c.gw; u < M * 8; u += c.ngw) {
        const int m = u >> 3, hd = u & 7, b = m / SEQ, s = m % SEQ, base = b * SEQ, nkeys = ((s >> 6) + 1) << 6;
        const float q0 = bf2f(Q[(size_t)m * 1536 + hd * 192 + c.lane]), q1 = bf2f(Q[(size_t)m * 1536 + hd * 192 + 64 + c.lane]), q2 = bf2f(Q[(size_t)m * 1536 + hd * 192 + 128 + c.lane]);
        float mx = -1e30f, l = 0.f, o0 = 0.f, o1 = 0.f;
        const bf16_t* v0p = VT + (size_t)(hd * 128 + c.lane) * M + base; const bf16_t* v1p = v0p + (size_t)64 * M;
        for (int kk = 0; kk < nkeys; ++kk) {
            const size_t tk = base + kk;
            const float part = q0 * bf2f(KN[tk * 1024 + hd * 128 + c.lane]) + q1 * bf2f(KN[tk * 1024 + hd * 128 + 64 + c.lane]) + q2 * bf2f(KR[tk * 64 + c.lane]);
            const float sc = wave_sum(part);
            const float mn = fmaxf(mx, sc), al = exp2f(mx - mn), pp = exp2f(sc - mn);
            l = l * al + pp; o0 = o0 * al + pp * bf2f(v0p[kk]); o1 = o1 * al + pp * bf2f(v1p[kk]); mx = mn;
        }
        const float inv = 1.f / l;
        O[(size_t)m * 1024 + hd * 128 + c.lane] = (bf16_t)(pk2(o0 * inv, 0.f) & 0xffff);
        O[(size_t)m * 1024 + hd * 128 + 64 + c.lane] = (bf16_t)(pk2(o1 * inv, 0.f) & 0xffff);
    }
}
DI void attn_sb_naive(const Params& p, const Ctx& c) {
    const bf16_t* Q = (const bf16_t*)(p.ws + OFF_SBQ); const bf16_t* K = (const bf16_t*)(p.ws + OFF_SBK);
    const bf16_t* VT = (const bf16_t*)(p.ws + OFF_SBVT); bf16_t* O = (bf16_t*)(p.ws + OFF_ATTB);
    for (int u = c.gw; u < M * 8; u += c.ngw) {
        const int m = u >> 3, hd = u & 7, b = m / SEQ, s = m % SEQ, base = b * SEQ;
        const float q0 = bf2f(Q[(size_t)m * 1024 + hd * 128 + c.lane]), q1 = bf2f(Q[(size_t)m * 1024 + hd * 128 + 64 + c.lane]);
        float later = 0.f, o0 = 0.f, o1 = 0.f;
        const bf16_t* v0p = VT + (size_t)(hd * 128 + c.lane) * M + base; const bf16_t* v1p = v0p + (size_t)64 * M;
        for (int kk = s - 1; kk >= 0; --kk) {
            const size_t tk = base + kk;
            const float z2 = wave_sum(q0 * bf2f(K[tk * 1024 + hd * 128 + c.lane]) + q1 * bf2f(K[tk * 1024 + hd * 128 + 64 + c.lane]));
            const float ln2 = -(fmaxf(z2, 0.f) + __log2f(1.f + exp2f(-fabsf(z2))));
            const float w = exp2f(z2 + ln2 + later);
            later += ln2; o0 += w * bf2f(v0p[kk]); o1 += w * bf2f(v1p[kk]);
        }
        O[(size_t)m * 1024 + hd * 128 + c.lane] = (bf16_t)(pk2(o0, 0.f) & 0xffff);
        O[(size_t)m * 1024 + hd * 128 + 64 + c.lane] = (bf16_t)(pk2(o1, 0.f) & 0xffff);
    }
}


typedef float f32x16 __attribute__((ext_vector_type(16)));
#define MFMA32(a, b, c) __builtin_amdgcn_mfma_f32_32x32x16_bf16((a), (b), (c), 0, 0, 0)
constexpr int ST_KR = 16384, ST_VT = 24576, ST_BYTES = 40960;
constexpr int ATT_FLAGS = 2 * ST_BYTES;
DI float ex2(float x) { return __builtin_amdgcn_exp2f(x); }
DI float lg2(float x) { return __builtin_amdgcn_logf(x); }
DI bf16x8 pack8(float a0, float a1, float a2, float a3, float a4, float a5, float a6, float a7) {
    u32x4 t; t.x = pk2(a0, a1); t.y = pk2(a2, a3); t.z = pk2(a4, a5); t.w = pk2(a6, a7); return __builtin_bit_cast(bf16x8, t); }
#define GLDS16(gp, lp) __builtin_amdgcn_global_load_lds((const unsigned*)(gp), (LAS unsigned*)(lp), 16, 0, 0)

struct AttDmaOff { unsigned kn[2], kr, vt[2]; };
DI AttDmaOff att_dma_offsets(int w, int lane) {
    AttDmaOff o; const unsigned lr = lane >> 4, pp = lane & 15;
#pragma unroll
    for (int i = 0; i < 2; ++i) { const unsigned q = w * 2 + i, R = 4 * q + lr, cc = pp ^ (R & 15); o.kn[i] = R * 2048u + cc * 16u; }
    { const unsigned q = w, R2 = 4 * q + lr, cc = pp ^ (R2 & 15); o.kr = (2 * R2 + (cc >> 3)) * 128u + (cc & 7) * 16u; }
#pragma unroll
    for (int i = 0; i < 2; ++i) { const unsigned q = w * 2 + i, R2 = 4 * q + lr, cc = pp ^ (R2 & 15); o.vt[i] = (2 * R2 + (cc >> 3)) * (unsigned)(M * 2) + (cc & 7) * 16u; }
    return o;
}
template <bool ROPE>
DI void att_dma(LAS unsigned char* buf, __amdgpu_buffer_rsrc_t rs, const AttDmaOff& o, unsigned k_so, unsigned kr_so, unsigned vt_so, int w) {
#pragma unroll
    for (int i = 0; i < 2; ++i) __builtin_amdgcn_raw_ptr_buffer_load_lds(rs, (LAS void*)(buf + (w * 2 + i) * 1024), 16, o.kn[i], k_so, 0, 0);
    if (ROPE) __builtin_amdgcn_raw_ptr_buffer_load_lds(rs, (LAS void*)(buf + ST_KR + w * 1024), 16, o.kr, kr_so, 0, 0);
#pragma unroll
    for (int i = 0; i < 2; ++i) __builtin_amdgcn_raw_ptr_buffer_load_lds(rs, (LAS void*)(buf + ST_VT + (w * 2 + i) * 1024), 16, o.vt[i], vt_so, 0, 0);
}
DI void att_store(const f32x16 (&o)[4], float scale, bf16_t* O, size_t row, int hd, int h) {
#pragma unroll
    for (int db = 0; db < 4; ++db)
#pragma unroll
        for (int g = 0; g < 4; ++g)
            store_bf16x4(O + row * 1024 + hd * 128 + db * 32 + g * 8 + h * 4, (f32x4){o[db][4 * g] * scale, o[db][4 * g + 1] * scale, o[db][4 * g + 2] * scale, o[db][4 * g + 3] * scale});
}
DI void att_pv(f32x16 (&o)[4], const bf16x8 (&pf)[2][2], const LAS unsigned char* buf, unsigned va) {
#pragma unroll
    for (int db = 0; db < 4; ++db) {
#pragma unroll
        for (int blk = 0; blk < 2; ++blk)
#pragma unroll
            for (int ks = 0; ks < 2; ++ks) o[db] = MFMA32(*(const LAS bf16x8*)(buf + ((va ^ ((blk * 2 + ks) << 5)) + db * 4096)), pf[blk][ks], o[db]);
        asm volatile("" ::: "memory");
    }
}

DI void attn_mla_fast(const Params& p, const Ctx& c) {
    const bf16_t* Q = (const bf16_t*)(p.ws + OFF_Q); const bf16_t* KN = (const bf16_t*)(p.ws + OFF_KN); const bf16_t* KR = (const bf16_t*)(p.ws + OFF_KR);
    const bf16_t* VT = (const bf16_t*)(p.ws + OFF_VT); bf16_t* O = (bf16_t*)(p.ws + OFF_ATTA);
    const int lane = c.lane, r = lane & 31, h = lane >> 5, w = c.wave;
    const int pr = (r & 0x13) | ((r & 4) << 1) | ((r & 8) >> 1);
    const unsigned ka = (pr << 8) | ((((pr & 15) ^ h) & 15) << 4);
    const unsigned ra = ST_KR + (((pr >> 1) << 8) | (((((pr & 1) << 3) | h) ^ ((pr >> 1) & 15)) << 4));
    const unsigned va = ST_VT + (((r >> 1) << 8) | (((((r & 1) << 3) | h) ^ ((r >> 1) & 15)) << 4));
    const __amdgpu_buffer_rsrc_t rs = __builtin_amdgcn_make_buffer_rsrc((void*)p.ws, (short)0, (int)WS_END, 0x00020000);
    const AttDmaOff dof = att_dma_offsets(w, lane);
    for (int it = blockIdx.x; it < 256; it += gridDim.x) {
        const int bh = it & 31, b = bh >> 3, hd = bh & 7, pairi = it >> 5;
#pragma unroll 1
        for (int half = 0; half < 2; ++half) {
            const int qb = half ? 15 - pairi : pairi, q0 = qb * 256;
            const size_t base = (size_t)b * SEQ, qrow = base + q0 + w * 32 + r;
            bf16x8 qf[12];
#pragma unroll
            for (int st = 0; st < 12; ++st) qf[st] = *(const bf16x8*)(Q + qrow * 1536 + hd * 192 + st * 16 + h * 8);
            const int ntile = q0 / 64 + 4, myn = (q0 + w * 32) / 64 + 1;
            f32x16 o[4];
#pragma unroll
            for (int db = 0; db < 4; ++db)
#pragma unroll
                for (int i = 0; i < 16; ++i) o[db][i] = 0.f;
            float mrun = -1e30f, lrun = 0.f;
            __syncthreads();
            const unsigned k_so0 = (unsigned)(OFF_KN + (base * 1024 + hd * 128) * 2), kr_so0 = (unsigned)(OFF_KR + base * 64 * 2), vt_so0 = (unsigned)(OFF_VT + ((size_t)(hd * 128) * M + base) * 2);
            att_dma<true>(c.lds, rs, dof, k_so0, kr_so0, vt_so0, w);
            asm volatile("s_waitcnt vmcnt(0)" ::: "memory");
            __syncthreads();
            for (int j = 0; j < ntile; ++j) {
                LAS unsigned char* buf = c.lds + (j & 1) * ST_BYTES;
                if (j + 1 < ntile) att_dma<true>(c.lds + ((j + 1) & 1) * ST_BYTES, rs, dof, k_so0 + (unsigned)(j + 1) * (64 * 2048), kr_so0 + (unsigned)(j + 1) * (64 * 128), vt_so0 + (unsigned)(j + 1) * 128, w);
                if (j < myn) {
                    f32x16 s0, s1;
#pragma unroll
                    for (int i = 0; i < 16; ++i) { s0[i] = 0.f; s1[i] = 0.f; }
                    __builtin_amdgcn_s_setprio(1);
#pragma unroll
                    for (int st = 0; st < 8; ++st) {
                        s0 = MFMA32(*(const LAS bf16x8*)(buf + (ka ^ (st << 5))), qf[st], s0);
                        s1 = MFMA32(*(const LAS bf16x8*)(buf + ((ka ^ (st << 5)) + 8192)), qf[st], s1);
                    }
#pragma unroll
                    for (int st = 0; st < 4; ++st) {
                        s0 = MFMA32(*(const LAS bf16x8*)(buf + (ra ^ (st << 5))), qf[8 + st], s0);
                        s1 = MFMA32(*(const LAS bf16x8*)(buf + ((ra ^ (st << 5)) + 4096)), qf[8 + st], s1);
                    }
                    __builtin_amdgcn_s_setprio(0);
                    float mx = fmaxf(s0[0], s1[0]);
#pragma unroll
                    for (int i = 1; i < 16; ++i) mx = fmaxf(mx, fmaxf(s0[i], s1[i]));
                    mx = fmaxf(mx, __shfl_xor(mx, 32));
                    const float mnew = fmaxf(mrun, mx), alpha = ex2(mrun - mnew);
                    mrun = mnew;
                    float ps = 0.f;
#pragma unroll
                    for (int i = 0; i < 16; ++i) { s0[i] = ex2(s0[i] - mnew); s1[i] = ex2(s1[i] - mnew); ps += s0[i] + s1[i]; }
                    lrun = lrun * alpha + ps;
#pragma unroll
                    for (int db = 0; db < 4; ++db)
#pragma unroll
                        for (int i = 0; i < 16; ++i) o[db][i] *= alpha;
                    bf16x8 pf[2][2];
                    pf[0][0] = pack8(s0[0], s0[1], s0[2], s0[3], s0[4], s0[5], s0[6], s0[7]); pf[0][1] = pack8(s0[8], s0[9], s0[10], s0[11], s0[12], s0[13], s0[14], s0[15]);
                    pf[1][0] = pack8(s1[0], s1[1], s1[2], s1[3], s1[4], s1[5], s1[6], s1[7]); pf[1][1] = pack8(s1[8], s1[9], s1[10], s1[11], s1[12], s1[13], s1[14], s1[15]);
                    __builtin_amdgcn_s_setprio(1);
                    att_pv(o, pf, buf, va);
                    __builtin_amdgcn_s_setprio(0);
                }
                asm volatile("s_waitcnt vmcnt(0)" ::: "memory");
                __syncthreads();
            }
            const float ltot = lrun + __shfl_xor(lrun, 32);
            att_store(o, 1.f / ltot, O, qrow, hd, h);
        }
    }
}

DI void attn_sb_fast(const Params& p, const Ctx& c) {
    const bf16_t* Q = (const bf16_t*)(p.ws + OFF_SBQ); const bf16_t* K = (const bf16_t*)(p.ws + OFF_SBK);
    const bf16_t* VT = (const bf16_t*)(p.ws + OFF_SBVT); bf16_t* O = (bf16_t*)(p.ws + OFF_ATTB);
    const int lane = c.lane, r = lane & 31, h = lane >> 5, w = c.wave, tid = c.tid;
    const int pr = (r & 0x13) | ((r & 4) << 1) | ((r & 8) >> 1);
    const unsigned ka = (pr << 8) | ((((pr & 15) ^ h) & 15) << 4);
    const unsigned va = ST_VT + (((r >> 1) << 8) | (((((r & 1) << 3) | h) ^ ((r >> 1) & 15)) << 4));
    const __amdgpu_buffer_rsrc_t rs = __builtin_amdgcn_make_buffer_rsrc((void*)p.ws, (short)0, (int)WS_END, 0x00020000);
    const AttDmaOff dof = att_dma_offsets(w, lane);
    LAS int* flags = (LAS int*)(c.lds + ATT_FLAGS);
    for (int it = blockIdx.x; it < 256; it += gridDim.x) {
        const int bh = it & 31, b = bh >> 3, hd = bh & 7, pairi = it >> 5;
#pragma unroll 1
        for (int half = 0; half < 2; ++half) {
            const int qb = half ? 15 - pairi : pairi, q0 = qb * 256;
            const size_t base = (size_t)b * SEQ, qrow = base + q0 + w * 32 + r;
            const int tq = q0 + w * 32 + r;
            bf16x8 qf[8];
#pragma unroll
            for (int st = 0; st < 8; ++st) qf[st] = *(const bf16x8*)(Q + qrow * 1024 + hd * 128 + st * 16 + h * 8);
            const int jmax = q0 / 64 + 3, jd = (q0 + w * 32) / 64;
            f32x16 o[4];
#pragma unroll
            for (int db = 0; db < 4; ++db)
#pragma unroll
                for (int i = 0; i < 16; ++i) o[db][i] = 0.f;
            float carry = 0.f; bool wdone = false;
            __syncthreads();
            const unsigned k_so0 = (unsigned)(OFF_SBK + (base * 1024 + hd * 128) * 2), vt_so0 = (unsigned)(OFF_SBVT + ((size_t)(hd * 128) * M + base) * 2);
            att_dma<false>(c.lds, rs, dof, k_so0 + (unsigned)jmax * (64 * 2048), 0u, vt_so0 + (unsigned)jmax * 128, w);
            if (tid < 16) flags[tid] = 0;
            asm volatile("s_waitcnt vmcnt(0)" ::: "memory");
            __syncthreads();
            int itn = 0;
            for (int j = jmax; j >= 0; --j, ++itn) {
                LAS unsigned char* buf = c.lds + (itn & 1) * ST_BYTES;
                if (j > 0) att_dma<false>(c.lds + ((itn + 1) & 1) * ST_BYTES, rs, dof, k_so0 + (unsigned)(j - 1) * (64 * 2048), 0u, vt_so0 + (unsigned)(j - 1) * 128, w);
                if (j <= jd && !wdone) {
                    f32x16 s0, s1;
#pragma unroll
                    for (int i = 0; i < 16; ++i) { s0[i] = 0.f; s1[i] = 0.f; }
#pragma unroll
                    for (int st = 0; st < 8; ++st) {
                        s0 = MFMA32(*(const LAS bf16x8*)(buf + (ka ^ (st << 5))), qf[st], s0);
                        s1 = MFMA32(*(const LAS bf16x8*)(buf + ((ka ^ (st << 5)) + 8192)), qf[st], s1);
                    }
                    const int kb0 = 64 * j + 8 * h - tq;
                    bf16x8 pf[2][2];
                    {
                        f32x16 l1;
#pragma unroll
                        for (int i = 0; i < 16; ++i) { const float z = s1[i]; const float a = -(fmaxf(z, 0.f) + lg2(1.f + ex2(-fabsf(z)))); l1[i] = (kb0 + 32 + 16 * (i >> 3) + (i & 7) < 0) ? a : 0.f; }
                        float g0 = 0.f, g1 = 0.f;
#pragma unroll
                        for (int e = 0; e < 8; ++e) { g0 += l1[e]; g1 += l1[8 + e]; }
                        const float p0 = __shfl_xor(g0, 32), p1 = __shfl_xor(g1, 32);
                        float run = carry + (h == 0 ? p1 : 0.f);
#pragma unroll
                        for (int e = 7; e >= 0; --e) { run += l1[8 + e]; l1[8 + e] = run; }
                        run = carry + (g1 + p1) + (h == 0 ? p0 : 0.f);
#pragma unroll
                        for (int e = 7; e >= 0; --e) { run += l1[e]; l1[e] = run; }
                        carry += (g1 + p1) + (g0 + p0);
#pragma unroll
                        for (int i = 0; i < 16; ++i) { const float wv = ex2(s1[i] + l1[i]); s1[i] = (kb0 + 32 + 16 * (i >> 3) + (i & 7) < 0) ? wv : 0.f; }
                        pf[1][0] = pack8(s1[0], s1[1], s1[2], s1[3], s1[4], s1[5], s1[6], s1[7]); pf[1][1] = pack8(s1[8], s1[9], s1[10], s1[11], s1[12], s1[13], s1[14], s1[15]);
                    }
                    {
                        f32x16 l0;
#pragma unroll
                        for (int i = 0; i < 16; ++i) { const float z = s0[i]; const float a = -(fmaxf(z, 0.f) + lg2(1.f + ex2(-fabsf(z)))); l0[i] = (kb0 + 16 * (i >> 3) + (i & 7) < 0) ? a : 0.f; }
                        float g0 = 0.f, g1 = 0.f;
#pragma unroll
                        for (int e = 0; e < 8; ++e) { g0 += l0[e]; g1 += l0[8 + e]; }
                        const float p0 = __shfl_xor(g0, 32), p1 = __shfl_xor(g1, 32);
                        float run = carry + (h == 0 ? p1 : 0.f);
#pragma unroll
                        for (int e = 7; e >= 0; --e) { run += l0[8 + e]; l0[8 + e] = run; }
                        run = carry + (g1 + p1) + (h == 0 ? p0 : 0.f);
#pragma unroll
                        for (int e = 7; e >= 0; --e) { run += l0[e]; l0[e] = run; }
                        carry += (g1 + p1) + (g0 + p0);
#pragma unroll
                        for (int i = 0; i < 16; ++i) { const float wv = ex2(s0[i] + l0[i]); s0[i] = (kb0 + 16 * (i >> 3) + (i & 7) < 0) ? wv : 0.f; }
                        pf[0][0] = pack8(s0[0], s0[1], s0[2], s0[3], s0[4], s0[5], s0[6], s0[7]); pf[0][1] = pack8(s0[8], s0[9], s0[10], s0[11], s0[12], s0[13], s0[14], s0[15]);
                    }
                    att_pv(o, pf, buf, va);
                    wdone = __all(carry < -150.f);
                }
                if (lane == 0) flags[(itn & 1) * 8 + w] = wdone ? 1 : 0;
                asm volatile("s_waitcnt vmcnt(0)" ::: "memory");
                __syncthreads();
                int alld = 1;
#pragma unroll
                for (int q = 0; q < 8; ++q) alld &= flags[(itn & 1) * 8 + q];
                if (alld) break;
            }
            att_store(o, 1.f, O, qrow, hd, h);
        }
    }
}
#ifndef FAST_ATTN
#define FAST_ATTN 1
#endif

constexpr int SEL_LD = 260;
DI void topk_insert(float (&a)[16], float x) {
#pragma unroll
    for (int i = 15; i >= 1; --i) a[i] = __builtin_amdgcn_fmed3f(a[i - 1], a[i], x);
    a[0] = fmaxf(a[0], x);
}
struct SelMap { int mode, a0, a1, a2, a3; };
DI void sel_decode(const SelMap& mp, int q, int& t0, int& hd) {
    if (mp.mode == 0) { int u = mp.a0 + q * mp.a1; if (u >= 128 * 8) u = mp.a0; hd = u & 7; t0 = (u >> 3) * 128; }
    else { const int pm = (q >> 1) ? mp.a2 : mp.a0, pn = (q >> 1) ? mp.a3 : mp.a1; hd = pn; t0 = pm * 256 + (q & 1) * 128; }
}
template <int NU> DI void select_stage2(const Params& p, const Ctx& c, const SelMap mp, const LAS float* lst_all) {
    if (c.tid < 128 * NU) {
        const int tok = c.tid & 127, un = c.tid >> 7;
        int t0, hd; sel_decode(mp, un, t0, hd);
        const LAS float* lst = lst_all + un * 4096;
        float v1[16], v2[16];
#pragma unroll
        for (int i = 0; i < 16; ++i) { v1[i] = __uint_as_float(__float_as_uint(lst[(tok * 2) * 16 + i]) & ~127u); v2[i] = __uint_as_float(__float_as_uint(lst[(tok * 2 + 1) * 16 + i]) & ~127u); }
        float bb[16];
#pragma unroll
        for (int i = 0; i < 16; ++i) bb[i] = -__builtin_inff();
#pragma unroll
        for (int i = 0; i < 16; ++i)
#pragma unroll
            for (int j = 0; j < 16; ++j)
                if ((i + 1) * (j + 1) <= 16) topk_insert(bb, __uint_as_float((__float_as_uint(v1[i] + v2[j]) & ~255u) | (unsigned)(i * 16 + j)));
        float sv[16], mxv = -__builtin_inff(), sum = 0.f;
#pragma unroll
        for (int i = 0; i < 16; ++i) { sv[i] = __uint_as_float(__float_as_uint(bb[i]) & ~255u); mxv = fmaxf(mxv, sv[i]); }
#pragma unroll
        for (int i = 0; i < 16; ++i) { sv[i] = __expf(sv[i] - mxv); sum += sv[i]; }
        const float inv = 1.f / sum;
        int* idx = (int*)(p.ws + OFF_IDX) + (size_t)(t0 + tok) * 128 + hd * 16; float* gw = (float*)(p.ws + OFF_GW) + (size_t)(t0 + tok) * 128 + hd * 16;
#pragma unroll
        for (int i = 0; i < 16; ++i) {
            const unsigned code = __float_as_uint(bb[i]) & 255u;
            const unsigned e1 = __float_as_uint(lst[(tok * 2) * 16 + (code >> 4)]) & 127u, e2 = __float_as_uint(lst[(tok * 2 + 1) * 16 + (code & 15u)]) & 127u;
            idx[i] = (int)(e1 * 128u + e2); gw[i] = sv[i] * inv;
        }
    }
    __syncthreads();
}
DI void select_tail(const Params& p, const Ctx& c, int t0, int hd) {
    LAS float* sc = (LAS float*)c.lds; LAS float* lst = sc + 128 * SEL_LD;
    if (c.tid < 256) {
        const int tok = c.tid >> 1, hf = c.tid & 1;
        float a[16];
#pragma unroll
        for (int i = 0; i < 16; ++i) a[i] = -__builtin_inff();
        const LAS float* row = sc + tok * SEL_LD + hf * 128;
#pragma unroll 4
        for (int n4 = 0; n4 < 32; ++n4) {
            const f32x4 v = *(const LAS f32x4*)(row + n4 * 4);
#pragma unroll
            for (int e = 0; e < 4; ++e) topk_insert(a, __uint_as_float((__float_as_uint(v[e]) & ~127u) | (unsigned)(n4 * 4 + e)));
        }
#pragma unroll
        for (int i = 0; i < 16; ++i) lst[(tok * 2 + hf) * 16 + i] = a[i];
    }
    __syncthreads();
    select_stage2<1>(p, c, SelMap{0, ((t0 >> 7) << 3) | hd, 0, 0, 0}, lst);
}
DI void select_naive(const Params& p, const Ctx& c) {
    const bf16_t* PQ = (const bf16_t*)(p.ws + OFF_PQ); const bf16_t* KEYS = (const bf16_t*)(p.ws + OFF_KEYS);
    LAS float* sc = (LAS float*)c.lds;
    for (int u = blockIdx.x; u < 128 * 8; u += gridDim.x) {
        const int hd = u & 7, t0 = (u >> 3) * 128;
        const int tok = c.tid >> 2, part = c.tid & 3, hf = part >> 1, n0 = (part & 1) * 64;
        const bf16_t* qrow = PQ + (size_t)hd * M * 256 + (size_t)(t0 + tok) * 256 + hf * 128;
        const bf16_t* kb = KEYS + (size_t)((hd * 2 + hf) * 128 + n0) * 128;
        for (int n = 0; n < 64; ++n) {
            float acc = 0.f;
#pragma unroll
            for (int d8 = 0; d8 < 16; ++d8) {
                const u32x4 a = *(const u32x4*)(qrow + d8 * 8), b = *(const u32x4*)(kb + (size_t)n * 128 + d8 * 8);
#pragma unroll
                for (int e = 0; e < 4; ++e) acc += bflo(a[e]) * bflo(b[e]) + bfhi(a[e]) * bfhi(b[e]);
            }
            sc[tok * SEL_LD + hf * 128 + n0 + n] = acc;
        }
        __syncthreads();
        select_tail(p, c, t0, hd);
    }
}


DI void select_batch(const Params& p, const Ctx& c, const SelMap mp) {
    const bf16_t* PQ = (const bf16_t*)(p.ws + OFF_PQ); const bf16_t* KEYS = (const bf16_t*)(p.ws + OFF_KEYS);
    LAS float* lst_all = (LAS float*)c.lds;
    const int lane = c.lane, r = lane & 31, h = lane >> 5, w = c.wave, tb = w & 3, hf = w >> 2;
#pragma unroll
    for (int q = 0; q < 4; ++q) {
        int t0, hd; sel_decode(mp, q, t0, hd);
        LAS float* lst = lst_all + q * 4096;
        const bf16_t* qrow = PQ + (size_t)hd * M * 256 + (size_t)(t0 + tb * 32 + r) * 256 + hf * 128 + h * 8;
        const bf16_t* kbase = KEYS + (size_t)((hd * 2 + hf) * 128 + r) * 128 + h * 8;
        bf16x8 qf[8];
#pragma unroll
        for (int st = 0; st < 8; ++st) qf[st] = *(const bf16x8*)(qrow + st * 16);
        float a[16];
#pragma unroll
        for (int i = 0; i < 16; ++i) a[i] = -__builtin_inff();
#pragma unroll
        for (int kb = 0; kb < 4; ++kb) {
            f32x16 sc;
#pragma unroll
            for (int i = 0; i < 16; ++i) sc[i] = 0.f;
#pragma unroll
            for (int st = 0; st < 8; ++st) sc = MFMA32(*(const bf16x8*)(kbase + (size_t)kb * 32 * 128 + st * 16), qf[st], sc);
#pragma unroll
            for (int i = 0; i < 16; ++i) topk_insert(a, __uint_as_float((__float_as_uint(sc[i]) & ~127u) | (unsigned)(kb * 32 + (i & 3) + 8 * (i >> 2) + 4 * h)));
        }
        float bq[16];
#pragma unroll
        for (int i = 0; i < 16; ++i) bq[i] = __shfl_xor(a[i], 32);
#pragma unroll
        for (int i = 0; i < 16; ++i) topk_insert(a, bq[i]);
        if (h == 0) {
#pragma unroll
            for (int i = 0; i < 16; ++i) lst[((tb * 32 + r) * 2 + hf) * 16 + i] = a[i];
        }
    }
    __syncthreads();
    select_stage2<4>(p, c, mp, lst_all);
}
DI void select_fast(const Params& p, const Ctx& c) {
    for (int u0 = blockIdx.x; u0 < 128 * 8; u0 += 4 * gridDim.x) select_batch(p, c, SelMap{0, u0, (int)gridDim.x, 0, 0});
}
DI void select_own_tiles(const Params& p, const Ctx& c) {
    pg8::StaticOrder S; S.init(M, 2048, (int)gridDim.x, (int)blockIdx.x);
    asm volatile("s_waitcnt vmcnt(0)" ::: "memory");
    __syncthreads();
    if (c.tid == 0) { __builtin_amdgcn_fence(__ATOMIC_ACQUIRE, "agent"); asm volatile("s_waitcnt vmcnt(0)" ::: "memory"); }
    __syncthreads();
    for (int i = 0;; i += 2) {
        pg8::Unit u0, u1;
        if (!S.next(i, u0)) break;
        if (!S.next(i + 1, u1)) u1 = u0;
        select_batch(p, c, SelMap{1, u0.pm, u0.pn, u1.pm, u1.pn});
    }
}
#ifndef FAST_SEL
#define FAST_SEL 1
#endif

DI void phase_gather(const Params& p, const Ctx& c, float* dst, int rowmask = -1) {
    const bf16_t* H2 = (const bf16_t*)(p.ws + OFF_H); const unsigned char* U = p.ws + OFF_U16; const unsigned char* V = p.ws + OFF_V16;
    const int* IDX = (const int*)(p.ws + OFF_IDX); const float* GW = (const float*)(p.ws + OFF_GW); const float* mod = (const float*)(p.ws + OFF_MOD);
    constexpr int G = 8, GV = 16;
    const int lane = c.lane;
    unsigned* tokctr = (unsigned*)(p.ws + OFF_CTL) + 700;
    constexpr int NSTATIC = 6;
    LAS int* park = (LAS int*)(c.lds + c.wave * 20480);
    for (int it = 0;; ++it) {
        int m, slot; bool doU, doV;
        if (it < NSTATIC) { slot = it; m = c.gw + it * c.ngw; doU = true; doV = false; }
        else if (it < 2 * NSTATIC) { slot = it - NSTATIC; m = c.gw + slot * c.ngw; doU = false; doV = true; }
        else { unsigned t = 0; if (lane == 0) t = __hip_atomic_fetch_add(tokctr, 1u, __ATOMIC_RELAXED, __HIP_MEMORY_SCOPE_AGENT); m = NSTATIC * c.ngw + (int)__builtin_amdgcn_readfirstlane(t); if (m >= M) break; slot = 0; doU = true; doV = true; }
        if (m >= M) continue;
        const int b = m / SEQ;
        LAS int* ps = park + slot * 256;
        int ia = 0, ib = 0; float wa = 0.f, wb = 0.f;
        if (doU) {
        f32x2 hf[16];
#pragma unroll
        for (int i = 0; i < 4; ++i) { const u32x4 a = *(const u32x4*)(H2 + (size_t)m * D + lane * 32 + i * 8);
#pragma unroll
            for (int q = 0; q < 4; ++q) hf[4 * i + q] = (f32x2){bflo(a[q]), bfhi(a[q])}; }
        ia = IDX[(size_t)m * 128 + lane]; ib = IDX[(size_t)m * 128 + 64 + lane];
        const float ga = GW[(size_t)m * 128 + lane], gb = GW[(size_t)m * 128 + 64 + lane];
#pragma unroll 1
        for (int k0 = 0; k0 < 128; k0 += G) {
            u32x4 ua[G]; u32x2 ub[G];
#pragma unroll
            for (int g = 0; g < G; ++g) {
                const int e = __builtin_amdgcn_readlane(k0 < 64 ? ia : ib, (k0 + g) & 63) & rowmask;
                const unsigned char* ur = U + (size_t)e * 1536;
                ua[g] = *(const u32x4*)(ur + (unsigned)lane * 16u); ub[g] = *(const u32x2*)(ur + 1024u + (unsigned)lane * 8u);
            }
            float d[G];
#pragma unroll
            for (int g = 0; g < G; ++g) {
                const f32x32v f = __builtin_amdgcn_cvt_scalef32_pk32_f32_fp6((u32x6){ua[g][0], ua[g][1], ua[g][2], ua[g][3], ub[g][0], ub[g][1]}, 1.0f);
                f32x2 d2 = {0.f, 0.f};
#pragma unroll
                for (int i = 0; i < 16; ++i) d2 = (f32x2){f[2 * i], f[2 * i + 1]} * hf[i] + d2;
                d[g] = d2.x + d2.y;
            }
            { const bool u5 = lane & 32, u4 = lane & 16, u3 = lane & 8;
              float r4[4];
#pragma unroll
              for (int i = 0; i < 4; ++i) { const float send = u5 ? d[i] : d[4 + i], keep = u5 ? d[4 + i] : d[i]; r4[i] = keep + __shfl_xor(send, 32); }
              float r2[2];
#pragma unroll
              for (int i = 0; i < 2; ++i) { const float send = u4 ? r4[i] : r4[2 + i], keep = u4 ? r4[2 + i] : r4[i]; r2[i] = keep + __shfl_xor(send, 16); }
              const float send = u3 ? r2[0] : r2[1], keep = u3 ? r2[1] : r2[0];
              float r1 = keep + __shfl_xor(send, 8);
              r1 += __shfl_xor(r1, 4); r1 += __shfl_xor(r1, 2); r1 += __shfl_xor(r1, 1);
              const float act = gelu_tanh(r1 * (1.f / U8_SCALE)) * (1.f / V8_SCALE);
              const int gsel = lane - (k0 & 63);
              const int src = ((gsel & 4) << 3) | ((gsel & 2) << 3) | ((gsel & 1) << 3);
              const float got = __shfl(act, src & 63);
              if (gsel >= 0 && gsel < G) { if (k0 < 64) wa = got * ga; else wb = got * gb; }
            }
        }
        ps[lane] = ia; ps[64 + lane] = ib; ps[128 + lane] = __builtin_bit_cast(int, wa); ps[192 + lane] = __builtin_bit_cast(int, wb);
        }
        if (!doV) continue;
        if (!doU) { ia = ps[lane]; ib = ps[64 + lane]; wa = __builtin_bit_cast(float, ps[128 + lane]); wb = __builtin_bit_cast(float, ps[192 + lane]); }
        f32x2 acc[16];
#pragma unroll
        for (int i = 0; i < 16; ++i) acc[i] = (f32x2){0.f, 0.f};
#define VB_ISSUE(P, K0) do { _Pragma("unroll") for (int g = 0; g < 8; ++g) { \
            const int e = __builtin_amdgcn_readlane((K0) < 64 ? ia : ib, ((K0) + g) & 63) & rowmask; \
            P##w[g] = __builtin_bit_cast(float, __builtin_amdgcn_readlane(__builtin_bit_cast(int, (K0) < 64 ? wa : wb), ((K0) + g) & 63)); \
            const unsigned char* vr = V + (size_t)e * 1536; \
            P##a[g] = *(const u32x4*)(vr + (unsigned)lane * 16u); P##b[g] = *(const u32x2*)(vr + 1024u + (unsigned)lane * 8u); } } while (0)
#define VB_COMPUTE(P) do { _Pragma("unroll") for (int g = 0; g < 8; ++g) { const f32x2 w2 = {P##w[g], P##w[g]}; \
            const f32x32v f = __builtin_amdgcn_cvt_scalef32_pk32_f32_fp6((u32x6){P##a[g][0], P##a[g][1], P##a[g][2], P##a[g][3], P##b[g][0], P##b[g][1]}, 1.0f); \
            _Pragma("unroll") for (int i = 0; i < 16; ++i) acc[i] = (f32x2){f[2 * i], f[2 * i + 1]} * w2 + acc[i]; } } while (0)
        {
            u32x4 A_a[8], B_a[8]; u32x2 A_b[8], B_b[8]; float A_w[8], B_w[8];
            VB_ISSUE(A_, 0);
#pragma unroll 1
            for (int k0 = 0; k0 < 128; k0 += 16) {
                VB_ISSUE(B_, k0 + 8);
                VB_COMPUTE(A_);
                if (k0 + 16 < 128) VB_ISSUE(A_, k0 + 16);
                VB_COMPUTE(B_);
            }
        }
#undef VB_ISSUE
#undef VB_COMPUTE
        const float* orow = p.out + (size_t)m * D + lane * 32; float* drow = dst + (size_t)m * D + lane * 32; const float* gt2 = mod + b * 6 * D + 5 * D + lane * 32; const float* fg = p.fng + lane * 32;
        float ss = 0.f; f32x4 xv[8];
#pragma unroll
        for (int i = 0; i < 8; ++i) {
            const f32x4 xa = *(const f32x4*)(orow + 4 * i), ta = *(const f32x4*)(gt2 + 4 * i);
            const f32x4 pe = {acc[2 * i].x, acc[2 * i].y, acc[2 * i + 1].x, acc[2 * i + 1].y};
            const f32x4 v = xa + DBG_BETA * ta * pe; xv[i] = v; ss += (v[0] * v[0] + v[1] * v[1]) + (v[2] * v[2] + v[3] * v[3]);
        }
        const float rstd = rsqrtf(wave_sum(ss) * (1.f / D) + EPS);
#pragma unroll
        for (int i = 0; i < 8; ++i) *(f32x4*)(drow + 4 * i) = xv[i] * rstd * *(const f32x4*)(fg + 4 * i);
    }
}


struct XcdBarrier; DI void xcd_barrier(const XcdBarrier& b, int wave_s);
DI int rl2r(int a, int b, int k) { const int va = __builtin_amdgcn_readlane(a, k & 63), vb = __builtin_amdgcn_readlane(b, k & 63); return k < 64 ? va : vb; }
DI void phase_gather_rounds(const Params& p, const Ctx& c, const XcdBarrier& xbar) {
    const bf16_t* H2 = (const bf16_t*)(p.ws + OFF_H); const unsigned char* U = p.ws + OFF_U16; const unsigned char* V = p.ws + OFF_V16;
    const int* IDX = (const int*)(p.ws + OFF_IDX); const float* GW = (const float*)(p.ws + OFF_GW); const float* mod = (const float*)(p.ws + OFF_MOD);
    const int lane = c.lane;
    LAS unsigned char* wl = c.lds + c.wave * 20480;
    const bool u5 = lane & 32, u4 = lane & 16, u3 = lane & 8;
    constexpr int G = 8;
#pragma unroll 1
    for (int pass = 0; pass < 2; ++pass) {
#pragma unroll
        for (int t = 0; t < 4; ++t) {
            const int m = c.gw + (pass * 4 + t) * c.ngw;
            LAS unsigned char* ts = wl + t * 5120;
            if (m < M) {
#pragma unroll
                for (int i = 0; i < 4; ++i) *(LAS u32x4*)(ts + lane * 64 + i * 16) = *(const u32x4*)(H2 + (size_t)m * D + lane * 32 + i * 8);
                *(LAS int*)(ts + 4096 + lane * 4) = IDX[(size_t)m * 128 + lane]; *(LAS int*)(ts + 4096 + 256 + lane * 4) = IDX[(size_t)m * 128 + 64 + lane];
                *(LAS float*)(ts + 4608 + lane * 4) = GW[(size_t)m * 128 + lane]; *(LAS float*)(ts + 4608 + 256 + lane * 4) = GW[(size_t)m * 128 + 64 + lane];
            }
        }
        asm volatile("s_waitcnt vmcnt(0) lgkmcnt(0)" ::: "memory");
#pragma unroll 1
        for (int r = 0; r < 8; ++r) {
#pragma unroll 1
            for (int t = 0; t < 4; ++t) {
                if (c.gw + (pass * 4 + t) * c.ngw >= M) continue;
                LAS unsigned char* ts = wl + t * 5120;
                const int ia = *(LAS int*)(ts + 4096 + lane * 4), ib = *(LAS int*)(ts + 4096 + 256 + lane * 4);
                unsigned long long ma = __ballot((ia >> 11) == r), mb = __ballot((ib >> 11) == r);
                if (!(ma | mb)) continue;
                f32x2 hf[16];
#pragma unroll
                for (int i = 0; i < 4; ++i) { const u32x4 a = *(LAS u32x4*)(ts + lane * 64 + i * 16);
#pragma unroll
                    for (int q = 0; q < 4; ++q) hf[4 * i + q] = (f32x2){bflo(a[q]), bfhi(a[q])}; }
                float wa = 0.f, wb = 0.f; const unsigned long long ma0 = ma, mb0 = mb;
                while (ma | mb) {
                    u32x4 ua[G]; u32x2 ub[G]; int kk[G]; int n = 0;
#pragma unroll
                    for (int g = 0; g < G; ++g) {
                        int k = (g == 0) ? 0 : kk[g - 1];
                        if (ma) { k = __builtin_ctzll(ma); ma &= ma - 1; ++n; } else if (mb) { k = 64 + __builtin_ctzll(mb); mb &= mb - 1; ++n; }
                        kk[g] = k;
                        const int e = rl2r(ia, ib, k);
                        const unsigned char* ur = U + (size_t)e * 1536;
                        ua[g] = *(const u32x4*)(ur + (unsigned)lane * 16u); ub[g] = *(const u32x2*)(ur + 1024u + (unsigned)lane * 8u);
                    }
                    float d[G];
#pragma unroll
                    for (int g = 0; g < G; ++g) {
                        d[g] = 0.f;
                        if (g < n) {
                            const f32x32v f = __builtin_amdgcn_cvt_scalef32_pk32_f32_fp6((u32x6){ua[g][0], ua[g][1], ua[g][2], ua[g][3], ub[g][0], ub[g][1]}, 1.0f);
                            f32x2 d0 = {0.f, 0.f}, d1 = {0.f, 0.f};
#pragma unroll
                            for (int i = 0; i < 8; ++i) { d0 = (f32x2){f[4 * i], f[4 * i + 1]} * hf[2 * i] + d0; d1 = (f32x2){f[4 * i + 2], f[4 * i + 3]} * hf[2 * i + 1] + d1; }
                            d[g] = (d0.x + d0.y) + (d1.x + d1.y);
                        }
                    }
                    float r4[4];
#pragma unroll
                    for (int i = 0; i < 4; ++i) { const float send = u5 ? d[i] : d[4 + i], keep = u5 ? d[4 + i] : d[i]; r4[i] = keep + __shfl_xor(send, 32); }
                    float r2[2];
#pragma unroll
                    for (int i = 0; i < 2; ++i) { const float send = u4 ? r4[i] : r4[2 + i], keep = u4 ? r4[2 + i] : r4[i]; r2[i] = keep + __shfl_xor(send, 16); }
                    const float send = u3 ? r2[0] : r2[1], keep = u3 ? r2[1] : r2[0];
                    float r1 = keep + __shfl_xor(send, 8);
                    r1 += __shfl_xor(r1, 4); r1 += __shfl_xor(r1, 2); r1 += __shfl_xor(r1, 1);
                    const float act = gelu_tanh(r1 * (1.f / U8_SCALE)) * (1.f / V8_SCALE);
#pragma unroll
                    for (int g = 0; g < G; ++g) if (g < n) {
                        const float av = __builtin_bit_cast(float, __builtin_amdgcn_readlane(__builtin_bit_cast(int, act), ((g & 4) << 3) | ((g & 2) << 3) | ((g & 1) << 3)));
                        const int k = kk[g];
                        if (k < 64) { if (lane == k) wa = av; } else { if (lane == k - 64) wb = av; }
                    }
                }
                if ((ma0 >> lane) & 1ull) { LAS float* gp = (LAS float*)(ts + 4608 + lane * 4); *gp = *gp * wa; }
                if ((mb0 >> lane) & 1ull) { LAS float* gp = (LAS float*)(ts + 4608 + 256 + lane * 4); *gp = *gp * wb; }
            }
            if (DBG_ROUND_BAR) xcd_barrier(xbar, c.wave);
        }
        asm volatile("s_waitcnt lgkmcnt(0)" ::: "memory");
#pragma unroll 1
        for (int t = 0; t < 4; ++t) {
            const int m = c.gw + (pass * 4 + t) * c.ngw;
            if (m >= M) continue;
            const int b = m / SEQ;
            LAS unsigned char* ts = wl + t * 5120;
            const int ia = *(LAS int*)(ts + 4096 + lane * 4), ib = *(LAS int*)(ts + 4096 + 256 + lane * 4);
            const float wa = *(LAS float*)(ts + 4608 + lane * 4), wb = *(LAS float*)(ts + 4608 + 256 + lane * 4);
            f32x2 acc[16];
#pragma unroll
            for (int i = 0; i < 16; ++i) acc[i] = (f32x2){0.f, 0.f};
#pragma unroll 1
            for (int k0 = 0; k0 < 128; k0 += G) {
                u32x4 va[G]; u32x2 vb[G]; float wk[G];
#pragma unroll
                for (int g = 0; g < G; ++g) {
                    const int e = __builtin_amdgcn_readlane(k0 < 64 ? ia : ib, (k0 + g) & 63);
                    wk[g] = __builtin_bit_cast(float, __builtin_amdgcn_readlane(__builtin_bit_cast(int, k0 < 64 ? wa : wb), (k0 + g) & 63));
                    const unsigned char* vr = V + (size_t)e * 1536;
                    va[g] = *(const u32x4*)(vr + (unsigned)lane * 16u); vb[g] = *(const u32x2*)(vr + 1024u + (unsigned)lane * 8u);
                }
#pragma unroll
                for (int g = 0; g < G; ++g) { const f32x2 w2 = {wk[g], wk[g]};
                    const f32x32v f = __builtin_amdgcn_cvt_scalef32_pk32_f32_fp6((u32x6){va[g][0], va[g][1], va[g][2], va[g][3], vb[g][0], vb[g][1]}, 1.0f);
#pragma unroll
                    for (int i = 0; i < 16; ++i) acc[i] = (f32x2){f[2 * i], f[2 * i + 1]} * w2 + acc[i]; }
            }
            float* orow = p.out + (size_t)m * D + lane * 32; const float* gt2 = mod + b * 6 * D + 5 * D + lane * 32; const float* fg = p.fng + lane * 32;
            float ss = 0.f; f32x4 xv[8];
#pragma unroll
            for (int i = 0; i < 8; ++i) {
                const f32x4 xa = *(const f32x4*)(orow + 4 * i), ta = *(const f32x4*)(gt2 + 4 * i);
                const f32x4 pe = {acc[2 * i].x, acc[2 * i].y, acc[2 * i + 1].x, acc[2 * i + 1].y};
                const f32x4 v = xa + DBG_BETA * ta * pe; xv[i] = v; ss += (v[0] * v[0] + v[1] * v[1]) + (v[2] * v[2] + v[3] * v[3]);
            }
            const float rstd = rsqrtf(wave_sum(ss) * (1.f / D) + EPS);
#pragma unroll
            for (int i = 0; i < 8; ++i) *(f32x4*)(orow + 4 * i) = xv[i] * rstd * *(const f32x4*)(fg + 4 * i);
        }
    }
}
#ifndef GATHER_ROUNDS
#define GATHER_ROUNDS 0
#endif

constexpr size_t OFF_WK = OFF_GB + (size_t)32 * 1024 * 1024;
constexpr size_t OFF_SSQ = OFF_GB + (size_t)48 * 1024 * 1024;
constexpr int NPU = 2, NPV = 2;
struct PairPick { int k; bool valid; };
DI PairPick pick_next(unsigned long long& ma, unsigned long long& mb, int prev) {
    PairPick r;
    if (ma) { r.k = __builtin_ctzll(ma); ma &= ma - 1; r.valid = true; }
    else if (mb) { r.k = 64 + __builtin_ctzll(mb); mb &= mb - 1; r.valid = true; }
    else { r.k = prev; r.valid = false; }
    return r;
}
DI int rl2(int a, int b, int k) { const int va = __builtin_amdgcn_readlane(a, k & 63), vb = __builtin_amdgcn_readlane(b, k & 63); return k < 64 ? va : vb; }
DI float rl2f(float a, float b, int k) { return __builtin_bit_cast(float, rl2(__builtin_bit_cast(int, a), __builtin_bit_cast(int, b), k)); }

DI void gather_u(const Params& p, const Ctx& c) {
    const bf16_t* H2 = (const bf16_t*)(p.ws + OFF_H); const unsigned char* U = p.ws + OFF_U16;
    const int* IDX = (const int*)(p.ws + OFF_IDX); const float* GW = (const float*)(p.ws + OFF_GW); float* WK = (float*)(p.ws + OFF_WK);
    const int x = blockIdx.x & 7, jb = blockIdx.x >> 3, nj = ((int)gridDim.x - x + 7) >> 3;
    const int wl = jb * NWAVES + c.wave, nwl = nj * NWAVES;
    constexpr int G = 4, SH = (NPU == 2) ? 10 : 11;
#pragma unroll 1
    for (int ps = 0; ps < NPU; ++ps) {
        const int part = x * NPU + ps;
#pragma unroll 1
        for (int m = wl; m < M; m += nwl) {
            const int ia = IDX[(size_t)m * 128 + c.lane], ib = IDX[(size_t)m * 128 + 64 + c.lane];
            unsigned long long ma = __ballot((ia >> SH) == part), mb = __ballot((ib >> SH) == part);
            if (!(ma | mb)) continue;
            const unsigned long long ma0 = ma, mb0 = mb;
            float hf[2][16];
#pragma unroll
            for (int j = 0; j < 2; ++j) { const u32x4 a = *(const u32x4*)(H2 + (size_t)m * D + j * 1024 + c.lane * 16), bq = *(const u32x4*)(H2 + (size_t)m * D + j * 1024 + c.lane * 16 + 8);
#pragma unroll
                for (int q = 0; q < 4; ++q) { hf[j][2 * q] = bflo(a[q]); hf[j][2 * q + 1] = bfhi(a[q]); hf[j][8 + 2 * q] = bflo(bq[q]); hf[j][8 + 2 * q + 1] = bfhi(bq[q]); } }
            const float ga = GW[(size_t)m * 128 + c.lane], gb = GW[(size_t)m * 128 + 64 + c.lane];
            float wa = 0.f, wb = 0.f;
            int prev = 0;
            while (ma | mb) {
                PairPick pk[G]; u32x4 uu[G][2];
#pragma unroll
                for (int g = 0; g < G; ++g) { pk[g] = pick_next(ma, mb, prev); prev = pk[g].k;
                    const int e = rl2(ia, ib, pk[g].k);
                    const unsigned char* ur = U + (size_t)e * D;
#pragma unroll
                    for (int j = 0; j < 2; ++j) uu[g][j] = *(const u32x4*)(ur + ((unsigned)c.lane * 16u + j * 1024u)); }
                float d[G];
#pragma unroll
                for (int g = 0; g < G; ++g) {
                    float d0 = 0.f, d1 = 0.f;
#pragma unroll
                    for (int j = 0; j < 2; ++j)
#pragma unroll
                        for (int q = 0; q < 4; ++q) { const f32x2 lo = __builtin_amdgcn_cvt_pk_f32_fp8((int)uu[g][j][q], false), hi = __builtin_amdgcn_cvt_pk_f32_fp8((int)uu[g][j][q], true);
                            d0 += lo.x * hf[j][4 * q] + hi.x * hf[j][4 * q + 2]; d1 += lo.y * hf[j][4 * q + 1] + hi.y * hf[j][4 * q + 3]; }
                    d[g] = d0 + d1;
                }
#pragma unroll
                for (int o = 1; o < 64; o <<= 1)
#pragma unroll
                    for (int g = 0; g < G; ++g) d[g] += __shfl_xor(d[g], o);
#pragma unroll
                for (int g = 0; g < G; ++g) if (pk[g].valid) {
                    const float a = gelu_tanh(d[g] * (1.f / U8_SCALE)) * (1.f / V8_SCALE); const int k = pk[g].k;
                    if (k < 64) { if (c.lane == k) wa = a * ga; } else { if (c.lane == k - 64) wb = a * gb; }
                }
            }
            if ((ma0 >> c.lane) & 1ull) WK[(size_t)m * 128 + c.lane] = wa;
            if ((mb0 >> c.lane) & 1ull) WK[(size_t)m * 128 + 64 + c.lane] = wb;
        }
    }
}

DI void gather_v(const Params& p, const Ctx& c) {
    const unsigned char* V = p.ws + OFF_V16;
    const int* IDX = (const int*)(p.ws + OFF_IDX); const float* WK = (const float*)(p.ws + OFF_WK); const float* mod = (const float*)(p.ws + OFF_MOD);
    float* SSQ = (float*)(p.ws + OFF_SSQ);
    const int x = blockIdx.x & 7, jb = blockIdx.x >> 3, nj = ((int)gridDim.x - x + 7) >> 3;
    const int wl = jb * NWAVES + c.wave, nwl = nj * NWAVES;
    const int q4 = c.lane >> 4, l16 = c.lane & 15;
    const unsigned voff = 256u * x + l16 * 16u;
    constexpr int SHV = (NPV == 2) ? 13 : 14;
#pragma unroll 1
    for (int ps = 0; ps < NPV; ++ps) {
#pragma unroll 1
        for (int m = wl; m < M; m += nwl) {
            const int b = m / SEQ;
            const int ia = IDX[(size_t)m * 128 + c.lane], ib = IDX[(size_t)m * 128 + 64 + c.lane];
            const float wa = WK[(size_t)m * 128 + c.lane], wb = WK[(size_t)m * 128 + 64 + c.lane];
            unsigned long long ma = __ballot((ia >> SHV) == ps), mb = __ballot((ib >> SHV) == ps);
            float acc[16];
#pragma unroll
            for (int i = 0; i < 16; ++i) acc[i] = 0.f;
            int prev = 0;
            while (ma | mb) {
                u32x4 vv[4]; float wv[4];
#pragma unroll
                for (int s4 = 0; s4 < 4; ++s4) {
                    int e = 0; float w = 0.f;
#pragma unroll
                    for (int g = 0; g < 4; ++g) { const PairPick pk = pick_next(ma, mb, prev); prev = pk.k;
                        const int eg = rl2(ia, ib, pk.k); const float wg = pk.valid ? rl2f(wa, wb, pk.k) : 0.f;
                        e = (q4 == g) ? eg : e; w = (q4 == g) ? wg : w; }
                    vv[s4] = *(const u32x4*)(V + (size_t)e * D + voff); wv[s4] = w;
                }
#pragma unroll
                for (int s4 = 0; s4 < 4; ++s4)
#pragma unroll
                    for (int q = 0; q < 4; ++q) { const f32x2 lo = __builtin_amdgcn_cvt_pk_f32_fp8((int)vv[s4][q], false), hi = __builtin_amdgcn_cvt_pk_f32_fp8((int)vv[s4][q], true);
                        acc[4 * q] += wv[s4] * lo.x; acc[4 * q + 1] += wv[s4] * lo.y; acc[4 * q + 2] += wv[s4] * hi.x; acc[4 * q + 3] += wv[s4] * hi.y; }
            }
#pragma unroll
            for (int i = 0; i < 16; ++i) { acc[i] += __shfl_xor(acc[i], 16); acc[i] += __shfl_xor(acc[i], 32); }
            f32x4 sel;
#pragma unroll
            for (int e = 0; e < 4; ++e) sel[e] = q4 == 0 ? acc[e] : (q4 == 1 ? acc[4 + e] : (q4 == 2 ? acc[8 + e] : acc[12 + e]));
            const int col = 256 * x + 16 * l16 + 4 * q4;
            float* op = p.out + (size_t)m * D + col;
            const f32x4 val = *(const f32x4*)op + DBG_BETA * *(const f32x4*)(mod + b * 6 * D + 5 * D + col) * sel;
            *(f32x4*)op = val;
            if (ps == NPV - 1) { const float ss = wave_sum(val[0] * val[0] + val[1] * val[1] + val[2] * val[2] + val[3] * val[3]); if (c.lane == 0) SSQ[(size_t)m * 8 + x] = ss; }
        }
    }
}
DI void gather_final(const Params& p, const Ctx& c) {
    const float* SSQ = (const float*)(p.ws + OFF_SSQ);
    for (int m = c.gw; m < M; m += c.ngw) {
        float s = (c.lane < 8) ? SSQ[(size_t)m * 8 + c.lane] : 0.f;
        s += __shfl_xor(s, 1); s += __shfl_xor(s, 2); s += __shfl_xor(s, 4);
        const float rstd = rsqrtf(__shfl(s, 0) * (1.f / D) + EPS);
        float* orow = p.out + (size_t)m * D;
#pragma unroll
        for (int j = 0; j < 8; ++j) { const int col = (j * 64 + c.lane) * 4; *(f32x4*)(orow + col) = *(const f32x4*)(orow + col) * rstd * *(const f32x4*)(p.fng + col); }
    }
}
#ifndef GATHER_L2
#define GATHER_L2 0
#endif

DI void phase_gather_v2(const Params& p, const Ctx& c) {
    const bf16_t* H2 = (const bf16_t*)(p.ws + OFF_H);
    const int* IDX = (const int*)(p.ws + OFF_IDX); const float* GW = (const float*)(p.ws + OFF_GW); const float* mod = (const float*)(p.ws + OFF_MOD);
    LAS float* hs = (LAS float*)c.lds; LAS float* wk = hs + 2048; LAS int* ek = (LAS int*)(wk + 128); LAS float* red = (LAS float*)(ek + 128);
    for (int m = blockIdx.x; m < M; m += gridDim.x) {
        const int b = m / SEQ;
        __syncthreads();
        for (int i = c.tid; i < 2048; i += NTHREADS) hs[i] = bf2f(H2[(size_t)m * D + i]);
        if (c.tid < 128) ek[c.tid] = IDX[(size_t)m * 128 + c.tid];
        __syncthreads();
        for (int k = c.wave; k < 128; k += NWAVES) {
            const float* ur = p.pu + (size_t)ek[k] * D;
            float d = 0.f;
            for (int i = 0; i < 8; ++i) { const int col = i * 256 + c.lane * 4; const f32x4 u = *(const f32x4*)(ur + col);
                d += u[0] * hs[col] + u[1] * hs[col + 1] + u[2] * hs[col + 2] + u[3] * hs[col + 3]; }
            d = wave_sum(d);
            if (c.lane == 0) wk[k] = gelu_tanh(d) * GW[(size_t)m * 128 + k];
        }
        __syncthreads();
        const int col = c.tid * 4;
        f32x4 acc = {0.f, 0.f, 0.f, 0.f};
        for (int k = 0; k < 128; ++k) { const f32x4 v = *(const f32x4*)(p.pv + (size_t)ek[k] * D + col); acc += v * wk[k]; }
        float* orow = p.out + (size_t)m * D;
        const f32x4 x2 = *(const f32x4*)(orow + col) + DBG_BETA * *(const f32x4*)(mod + b * 6 * D + 5 * D + col) * acc;
        float ss = wave_sum(x2[0] * x2[0] + x2[1] * x2[1] + x2[2] * x2[2] + x2[3] * x2[3]);
        if (c.lane == 0) red[c.wave] = ss;
        __syncthreads();
        float tot = 0.f;
        for (int w = 0; w < NWAVES; ++w) tot += red[w];
        const float rstd = rsqrtf(tot * (1.f / D) + EPS);
        *(f32x4*)(orow + col) = x2 * rstd * *(const f32x4*)(p.fng + col);
    }
}


#define XB_TMO      128
#define XB_XCNT(j)  (256  + 64 * (j))
#define XB_XSUB(j)  (1280 + 64 * (j))
#define XB_XGEN(j)  (2304 + 64 * (j))
#define XB_TOP      3328
#define XB_TOPGEN   3392
#define XCD_BAR_WORDS 3456
#define XB_SPIN_CAP (1u << 18)

__device__ __forceinline__ unsigned xb_ld(unsigned* p)              { return __hip_atomic_load(p, __ATOMIC_RELAXED, __HIP_MEMORY_SCOPE_AGENT); }
__device__ __forceinline__ unsigned xb_add(unsigned* p, unsigned v) { return __hip_atomic_fetch_add(p, v, __ATOMIC_RELAXED, __HIP_MEMORY_SCOPE_AGENT); }
__device__ __forceinline__ unsigned xb_xcc_id() { return (unsigned)__builtin_amdgcn_s_getreg((3 << 11) | 20) & 0xFu; }
#define XB_SPIN(cond, bar) do { unsigned _sp = 0; while (cond) { __builtin_amdgcn_s_sleep(1); \
    if ((++_sp & 255u) == 0u) { if (xb_ld(&(bar)[XB_TMO])) break; if (_sp > XB_SPIN_CAP) { atomicAdd(&(bar)[XB_TMO], 1u); break; } } } } while (0)

struct XcdBarrier {
    unsigned* bar; unsigned x;
    volatile LAS unsigned* st;
};

__device__ __forceinline__ XcdBarrier xcd_barrier_post(unsigned* bar, volatile LAS unsigned* st) {
    XcdBarrier b; b.bar = bar; b.x = xb_xcc_id(); b.st = st;
    if (threadIdx.x == 0) (void)xb_add(&bar[XB_XCNT(b.x)], 1u);
    return b;
}
__device__ __forceinline__ void xcd_barrier_complete(unsigned* bar, unsigned x, unsigned& nloc, unsigned& nx) {
    const unsigned G = gridDim.x * gridDim.y * gridDim.z;
    unsigned sum, cnt, mine, sp = 0u;
    for (;;) {
        sum = 0u; cnt = 0u; mine = 0u;
#pragma unroll
        for (unsigned j = 0; j < 16; ++j) { const unsigned c = xb_ld(&bar[XB_XCNT(j)]); sum += c; cnt += (c > 0u) ? 1u : 0u; mine = (j == x) ? c : mine; }
        if (sum == G) break;
        __builtin_amdgcn_s_sleep(1);
        if ((++sp & 255u) == 0u) { if (xb_ld(&bar[XB_TMO])) break; if (sp > XB_SPIN_CAP) { atomicAdd(&bar[XB_TMO], 1u); break; } }
    }
    nloc = mine > 0u ? mine : 1u; nx = cnt > 0u ? cnt : 1u;
}

__device__ __forceinline__ bool xb_lead(int wave_s) { return wave_s == 0 && __builtin_amdgcn_mbcnt_hi(~0u, __builtin_amdgcn_mbcnt_lo(~0u, 0u)) == 0; }
__device__ __forceinline__ void xcd_barrier(const XcdBarrier& b, int wave_s) {
    asm volatile("s_waitcnt vmcnt(0)" ::: "memory");
    __syncthreads();
    if (xb_lead(wave_s)) {
        unsigned* bar = b.bar;
        __builtin_amdgcn_s_waitcnt(0);
        unsigned nloc = b.st[0], nx = b.st[1];
        if (nloc == 0u) { xcd_barrier_complete(bar, b.x, nloc, nx); b.st[0] = nloc; b.st[1] = nx; }
        const unsigned old = xb_add(&bar[XB_XSUB(b.x)], 1u);
        const unsigned gen = old / nloc;
        if (old + 1u == (gen + 1u) * nloc) {
            __builtin_amdgcn_fence(__ATOMIC_RELEASE, "agent");
            asm volatile("s_waitcnt vmcnt(0)" ::: "memory");
            const unsigned og = xb_add(&bar[XB_TOP], 1u);
            const unsigned tg = og / nx;
            if (og + 1u == (tg + 1u) * nx) xb_add(&bar[XB_TOPGEN], 1u);
            else XB_SPIN(xb_ld(&bar[XB_TOPGEN]) == tg, bar);
            __builtin_amdgcn_fence(__ATOMIC_ACQUIRE, "agent");
            xb_add(&bar[XB_XGEN(b.x)], 1u);
            asm volatile("s_waitcnt vmcnt(0)" ::: "memory");
        } else {
            XB_SPIN(xb_ld(&bar[XB_XGEN(b.x)]) == gen, bar);
            __builtin_amdgcn_fence(__ATOMIC_ACQUIRE, "agent");
            asm volatile("s_waitcnt vmcnt(0)" ::: "memory");
        }
    }
    __syncthreads();
}


DI void grid_barrier(unsigned* ctr, unsigned target, int wave_s) {
    asm volatile("s_waitcnt vmcnt(0)" ::: "memory");
    __syncthreads();
    if (wave_s == 0) {
        const int l = __builtin_amdgcn_mbcnt_hi(~0u, __builtin_amdgcn_mbcnt_lo(~0u, 0u));
        if (l == 0) {
            __builtin_amdgcn_fence(__ATOMIC_RELEASE, "agent");
            asm volatile("s_waitcnt vmcnt(0)" ::: "memory");
            __hip_atomic_fetch_add(ctr, 1u, __ATOMIC_RELAXED, __HIP_MEMORY_SCOPE_AGENT);
            unsigned spins = 0;
            while (__hip_atomic_load(ctr, __ATOMIC_RELAXED, __HIP_MEMORY_SCOPE_AGENT) < target) { __builtin_amdgcn_s_sleep(2); if (++spins > (1u << 23)) break; }
            __builtin_amdgcn_fence(__ATOMIC_ACQUIRE, "agent");
            asm volatile("s_waitcnt vmcnt(0)" ::: "memory");
        }
    }
    __syncthreads();
}

__global__ void __launch_bounds__(NTHREADS, 2) mega(Params p) {
    extern __shared__ __attribute__((aligned(16))) unsigned char lds_raw[];
    const int wave_s = __builtin_amdgcn_readfirstlane(threadIdx.x >> 6);
#define MKCTX() Ctx c; { int l_; asm volatile("v_mbcnt_lo_u32_b32 %0, -1, 0\n\tv_mbcnt_hi_u32_b32 %0, -1, %0" : "=v"(l_)); c.lds = (LAS unsigned char*)lds_raw; c.lane = l_; c.wave = wave_s; c.tid = wave_s * 64 + l_; \
    c.gw = blockIdx.x * NWAVES + wave_s; c.ngw = gridDim.x * NWAVES; }
    unsigned char* ws = p.ws;
    const float* mod = (const float*)(ws + OFF_MOD);
    const int lo = p.ph_lo, hi = p.ph_hi;
    XcdBarrier xbar; xbar.bar = (unsigned*)(ws + OFF_XBAR); xbar.x = 0; xbar.st = nullptr;
    if (USE_XBAR && lo == 0 && hi == NPHASE) {
        volatile LAS unsigned* stw = (volatile LAS unsigned*)(lds_raw + LDS_BYTES - 32);
        if (threadIdx.x < 2) stw[threadIdx.x] = 0u;
        __syncthreads();
        xbar = xcd_barrier_post((unsigned*)(ws + OFF_XBAR), stw);
    }
#define IN(k) (lo <= (k) && (k) < hi)
#define SEAM(k) do { if (IN(k) && IN((k) + 1)) { if (USE_XBAR) xcd_barrier(xbar, wave_s); else grid_barrier((unsigned*)(ws + OFF_CTL), (unsigned)((k) + 1) * gridDim.x, wave_s); \
    if (TIME_PHASE >= 0 && blockIdx.x == 0 && threadIdx.x == 0) ((unsigned long long*)(ws + OFF_CTL + 512))[(k) + 1] = __builtin_amdgcn_s_memrealtime(); } } while (0)

    if (TIME_PHASE >= 0 && blockIdx.x == 0 && threadIdx.x == 0) ((unsigned long long*)(ws + OFF_CTL + 512))[0] = __builtin_amdgcn_s_memrealtime();
    if (IN(0)) { MKCTX(); phase_prologue(p, c, true, PRO_SPLIT == 0); }
    SEAM(0);
    if (IN(1)) for (int rep_ = 0; rep_ < (DUP_PHASE == 1 ? 2 : 1); ++rep_) { MKCTX();
        const long long* modi = (const long long*)(ws + OFF_MODI); float* modw = (float*)(ws + OFF_MOD);
        for (int i = blockIdx.x * NTHREADS + c.tid; i < NB * 6 * D; i += gridDim.x * NTHREADS) modw[i] = (float)((double)modi[i] * (1.0 / 4294967296.0));
        modulate_rows(p.x, p.n1g, modi + 1 * D, modi + 0 * D, (bf16_t*)(ws + OFF_H), c);
        if (PRO_SPLIT) phase_prologue(p, c, false, true);
    }
    SEAM(1);
    if (IN(2)) for (int rep_ = 0; rep_ < (DUP_PHASE == 2 ? 2 : 1); ++rep_) { MKCTX();
        EpiProj e1{(bf16_t*)(ws + OFF_CQ), (bf16_t*)(ws + OFF_CKV), (bf16_t*)(ws + OFF_KR), (bf16_t*)(ws + OFF_SBQ), (bf16_t*)(ws + OFF_SBK), (bf16_t*)(ws + OFF_GA), (bf16_t*)(ws + OFF_GB), (const f32x2*)(ws + OFF_CS)};
        GEMM(c, (const bf16_t*)(ws + OFF_H), (const bf16_t*)(ws + OFF_WIN), M, 7168, 2048, e1);
        if (DUP_GEMM == 20) GEMM(c, (const bf16_t*)(ws + OFF_H), (const bf16_t*)(ws + OFF_WIN), M, 7168, 2048, e1);
        EpiT e2{(bf16_t*)(ws + OFF_SBVT), nullptr};
        GEMM(c, (const bf16_t*)(ws + OFF_WSBV), (const bf16_t*)(ws + OFF_H), 1024, M, 2048, e2);
        if (DUP_GEMM == 21) GEMM(c, (const bf16_t*)(ws + OFF_WSBV), (const bf16_t*)(ws + OFF_H), 1024, M, 2048, e2);
    }
    SEAM(2);
    if (IN(3)) for (int rep_ = 0; rep_ < (DUP_PHASE == 3 ? 2 : 1); ++rep_) { MKCTX(); phase_rowstats(p, c); }
    SEAM(3);
    if (DBG_XTRA_BAR) { for (int q_ = 0; q_ < DBG_XTRA_BAR; ++q_) { if (IN(3) && IN(4)) xcd_barrier(xbar, wave_s); } }
    if (IN(4)) for (int rep_ = 0; rep_ < (DUP_PHASE == 4 ? 2 : 1); ++rep_) { MKCTX();
        EpiUq e1{(bf16_t*)(ws + OFF_Q), (const float*)(ws + OFF_RSTQ), (const f32x2*)(ws + OFF_CS)};
        GEMM(c, (const bf16_t*)(ws + OFF_CQ), (const bf16_t*)(ws + OFF_WUQ), M, 1536, 512, e1);
        if (DUP_GEMM == 40) GEMM(c, (const bf16_t*)(ws + OFF_CQ), (const bf16_t*)(ws + OFF_WUQ), M, 1536, 512, e1);
        EpiRowScale e2{(bf16_t*)(ws + OFF_KN), 1024, (const float*)(ws + OFF_RSTKV)};
        GEMM(c, (const bf16_t*)(ws + OFF_CKV), (const bf16_t*)(ws + OFF_WUK), M, 1024, 256, e2);
        if (DUP_GEMM == 41) GEMM(c, (const bf16_t*)(ws + OFF_CKV), (const bf16_t*)(ws + OFF_WUK), M, 1024, 256, e2);
        EpiT e3{(bf16_t*)(ws + OFF_VT), (const float*)(ws + OFF_RSTKV)};
        GEMM(c, (const bf16_t*)(ws + OFF_WUV), (const bf16_t*)(ws + OFF_CKV), 1024, M, 256, e3);
        if (DUP_GEMM == 42) GEMM(c, (const bf16_t*)(ws + OFF_WUV), (const bf16_t*)(ws + OFF_CKV), 1024, M, 256, e3);
    }
    SEAM(4);
    if (IN(5)) for (int rep_ = 0; rep_ < (DUP_PHASE == 5 ? 2 : 1); ++rep_) {
#if FAST_ATTN
        { MKCTX(); attn_mla_fast(p, c); }
        if (DUP_GEMM == 51) { MKCTX(); attn_mla_fast(p, c); }
        { MKCTX(); attn_sb_fast(p, c); }
        if (DUP_GEMM == 52) { MKCTX(); attn_sb_fast(p, c); }
#else
        MKCTX();
        attn_mla_naive(p, c); attn_sb_naive(p, c);
#endif
    }
    SEAM(5);
    if (IN(6)) for (int rep_ = 0; rep_ < (DUP_PHASE == 6 ? 2 : 1); ++rep_) { MKCTX();
        EpiGate1 e1{(bf16_t*)(ws + OFF_MERGED), (const bf16_t*)(ws + OFF_GA)};
        GEMM(c, (const bf16_t*)(ws + OFF_ATTA), (const bf16_t*)(ws + OFF_WA), M, 2048, 1024, e1);
        if (DUP_GEMM == 60) GEMM(c, (const bf16_t*)(ws + OFF_ATTA), (const bf16_t*)(ws + OFF_WA), M, 2048, 1024, e1);
        EpiGate2 e2{(bf16_t*)(ws + OFF_MERGED), (const bf16_t*)(ws + OFF_GB)};
        GEMM(c, (const bf16_t*)(ws + OFF_ATTB), (const bf16_t*)(ws + OFF_WB), M, 2048, 1024, e2);
    }
    SEAM(6);
    if (IN(7)) for (int rep_ = 0; rep_ < (DUP_PHASE == 7 ? 2 : 1); ++rep_) { MKCTX();
        EpiRes e{p.x, mod + 2 * D, p.out};
        GEMM(c, (const bf16_t*)(ws + OFF_MERGED), (const bf16_t*)(ws + OFF_WOUT), M, 2048, 2048, e);
    }
    SEAM(7);
    if (IN(8)) for (int rep_ = 0; rep_ < (DUP_PHASE == 8 ? 2 : 1); ++rep_) { MKCTX();
        modulate_rows(p.out, p.n2g, mod + 4 * D, mod + 3 * D, (bf16_t*)(ws + OFF_H), c);
        convert_table(p.pu, ws + OFF_U16, U8_SCALE, c);
        convert_table(p.pv, ws + OFF_V16, V8_SCALE, c);
    }
    SEAM(8);
    if (IN(9)) for (int rep_ = 0; rep_ < (DUP_PHASE == 9 ? 2 : 1); ++rep_) { MKCTX();
        EpiPq e{(bf16_t*)(ws + OFF_PQ)};
        GEMM(c, (const bf16_t*)(ws + OFF_H), (const bf16_t*)(ws + OFF_WPQ), M, 2048, 2048, e);
#if FAST_SEL && FAST_GEMM && SEL_FUSED
        { MKCTX(); select_own_tiles(p, c); }
#endif
    }
#if !(FAST_SEL && FAST_GEMM && SEL_FUSED)
    SEAM(9);
    if (IN(10)) for (int rep_ = 0; rep_ < (DUP_PHASE == 10 ? 2 : 1); ++rep_) { MKCTX();
#if FAST_SEL
        select_fast(p, c);
#else
        select_naive(p, c);
#endif
    }
#else
    if (IN(9) && IN(10)) {   }
#endif
    SEAM(10);
#if GATHER_L2
    if (IN(11)) { MKCTX(); gather_u(p, c); }
    SEAM(11);
    if (IN(12)) { MKCTX(); gather_v(p, c); }
    SEAM(12);
    if (IN(13)) { MKCTX(); gather_final(p, c); }
#else
#if GATHER_ROUNDS
    if (IN(11)) { MKCTX(); phase_gather_rounds(p, c, xbar); }
#else
    if (IN(11)) { if (DUP_GEMM == 110) { MKCTX(); phase_gather(p, c, (float*)(ws + OFF_SBQ)); }
        if (DUP_GEMM == 111) { MKCTX(); phase_gather(p, c, (float*)(ws + OFF_SBQ), 0x3ff); } MKCTX(); phase_gather(p, c, p.out); }
#endif
#endif
#undef IN
#undef SEAM
}

extern "C" void kernel_launch(void* const* d_in, const int* in_sizes, int n_in, void* d_out, int out_size, void* d_ws, size_t ws_size, hipStream_t stream) {
    static int grid = 0;
    if (grid == 0) {
        if (n_in != 20 || out_size != M * D || ws_size < WS_END) { fprintf(stderr, "kernel_launch: unexpected shapes (n_in %d out %d ws %zu need %zu)\n", n_in, out_size, ws_size, (size_t)WS_END); grid = -1; return; }
        int dev = 0, cus = 0, per_cu = 0;
        (void)hipGetDevice(&dev); (void)hipDeviceGetAttribute(&cus, hipDeviceAttributeMultiprocessorCount, dev);
        if (hipFuncSetAttribute((const void*)mega, hipFuncAttributeMaxDynamicSharedMemorySize, LDS_BYTES) != hipSuccess) { fprintf(stderr, "kernel_launch: hipFuncSetAttribute failed\n"); grid = -1; return; }
        if (hipOccupancyMaxActiveBlocksPerMultiprocessor(&per_cu, (const void*)mega, NTHREADS, LDS_BYTES) != hipSuccess || per_cu < 1) { fprintf(stderr, "kernel_launch: occupancy query failed (%d)\n", per_cu); per_cu = 1; }
        (void)hipGetLastError();
        grid = cus;
    }
    if (grid < 0) return;
    (void)hipMemsetAsync((char*)d_ws + OFF_CTL, 0, ZERO_BYTES, stream);
    Params p{};
    p.x = (const float*)d_in[0]; p.c = (const float*)d_in[1]; p.pos = (const int*)d_in[2]; p.ada_w = (const float*)d_in[3]; p.ada_b = (const float*)d_in[4];
    p.n1g = (const float*)d_in[5]; p.n2g = (const float*)d_in[6]; p.w_in = (const float*)d_in[7]; p.qng = (const float*)d_in[8]; p.kvng = (const float*)d_in[9];
    p.w_uq = (const float*)d_in[10]; p.w_ukv = (const float*)d_in[11]; p.w_bm = (const float*)d_in[12]; p.w_bs = (const float*)d_in[13]; p.w_out = (const float*)d_in[14];
    p.w_pq = (const float*)d_in[15]; p.skeys = (const float*)d_in[16]; p.pu = (const float*)d_in[17]; p.pv = (const float*)d_in[18]; p.fng = (const float*)d_in[19];
    p.out = (float*)d_out; p.ws = (unsigned char*)d_ws;
    for (int i = 0; i < 32; ++i) p.invf[i] = (float)pow(10000.0, -(double)i / 32.0);
#if N_LAUNCH_MODE == 1
    p.ph_lo = 0; p.ph_hi = NPHASE;
    void* args[] = {&p};
    hipError_t e = hipLaunchCooperativeKernel((const void*)mega, dim3(grid), dim3(NTHREADS), args, LDS_BYTES, stream);
    if (e != hipSuccess) fprintf(stderr, "cooperative launch failed: %s (grid %d)\n", hipGetErrorString(e), grid);
#else
    for (int k = 0; k < NPHASE; ++k) {
        p.ph_lo = k; p.ph_hi = k + 1;
        hipLaunchKernelGGL(mega, dim3(grid), dim3(NTHREADS), LDS_BYTES, stream, p);
    }
#endif
}
```

```cpp
#include <hip/hip_runtime.h>
#include <hip/hip_cooperative_groups.h>
#include <cstdio>
#include <cstdint>
#include <cmath>
namespace cg = cooperative_groups;

#ifndef N_LAUNCH_MODE
#define N_LAUNCH_MODE 1
#endif

#ifndef TIME_PHASE
#define TIME_PHASE -1
#endif
#ifndef TIME_SCALE
#define TIME_SCALE 5000.f
#endif
#ifndef DUP_GEMM
#define DUP_GEMM -1
#endif
#ifndef PRO_SPLIT
#define PRO_SPLIT 1
#endif
#ifndef USE_XBAR
#define USE_XBAR 1
#endif
#ifndef DBG_XTRA_BAR
#define DBG_XTRA_BAR 0
#endif
#ifndef DBG_ROUND_BAR
#define DBG_ROUND_BAR 0
#endif
#ifndef GATHER_DYN
#define GATHER_DYN 1
#endif
#ifndef SEL_FUSED
#define SEL_FUSED 1
#endif
#ifndef DUP_PHASE
#define DUP_PHASE -1
#endif
#ifndef DBG_ALPHA
#define DBG_ALPHA 1.0f
#endif
#ifndef DBG_BETA
#define DBG_BETA 1.0f
#endif
#define LAS __attribute__((address_space(3)))
#define DI __device__ __forceinline__
typedef unsigned short bf16_t;
typedef short bf16x8 __attribute__((ext_vector_type(8)));
typedef float f32x4 __attribute__((ext_vector_type(4)));
typedef float f32x2 __attribute__((ext_vector_type(2)));
typedef unsigned u32x4 __attribute__((ext_vector_type(4)));
typedef unsigned u32x2 __attribute__((ext_vector_type(2)));
typedef __bf16 bf16v2 __attribute__((ext_vector_type(2)));

constexpr int M = 16384, D = 2048, SEQ = 4096, NB = 4;
constexpr int NTHREADS = 512, NWAVES = 8;
constexpr int LDS_BYTES = 160 * 1024;
constexpr float EPS = 1e-6f;
constexpr float LOG2E = 1.4426950408889634f;
constexpr int NPHASE = 14;

constexpr size_t al256(size_t x) { return (x + 255) & ~(size_t)255; }
constexpr size_t OFF_CTL = 0;
constexpr size_t OFF_XBAR = 4096;
constexpr size_t OFF_MODI = 32768;
constexpr size_t ZERO_BYTES = OFF_MODI + (size_t)NB * 6 * D * 8;
constexpr size_t OFF_MOD = al256(ZERO_BYTES);
constexpr size_t OFF_RSTQ = OFF_MOD + (size_t)NB * 6 * D * 4;
constexpr size_t OFF_RSTKV = OFF_RSTQ + (size_t)M * 4;
constexpr size_t OFF_CS = OFF_RSTKV + (size_t)M * 4;
constexpr size_t OFF_KEYS = OFF_CS + (size_t)M * 32 * 8;
constexpr size_t OFF_WIN = OFF_KEYS + (size_t)8 * 2 * 128 * 128 * 2;
constexpr size_t OFF_WSBV = OFF_WIN + (size_t)7168 * 2048 * 2;
constexpr size_t OFF_WUQ = OFF_WSBV + (size_t)1024 * 2048 * 2;
constexpr size_t OFF_WUK = OFF_WUQ + (size_t)1536 * 512 * 2;
constexpr size_t OFF_WUV = OFF_WUK + (size_t)1024 * 256 * 2;
constexpr size_t OFF_WA = OFF_WUV + (size_t)1024 * 256 * 2;
constexpr size_t OFF_WB = OFF_WA + (size_t)2048 * 1024 * 2;
constexpr size_t OFF_WOUT = OFF_WB + (size_t)2048 * 1024 * 2;
constexpr size_t OFF_WPQ = OFF_WOUT + (size_t)2048 * 2048 * 2;
constexpr size_t OFF_H = OFF_WPQ + (size_t)2048 * 2048 * 2;
constexpr size_t OFF_CQ = OFF_H + (size_t)M * 2048 * 2;
constexpr size_t OFF_CKV = OFF_CQ + (size_t)M * 512 * 2;
constexpr size_t OFF_KR = OFF_CKV + (size_t)M * 256 * 2;
constexpr size_t OFF_SBQ = OFF_KR + (size_t)M * 64 * 2;
constexpr size_t OFF_SBK = OFF_SBQ + (size_t)M * 1024 * 2;
constexpr size_t OFF_SBVT = OFF_SBK + (size_t)M * 1024 * 2;
constexpr size_t OFF_GA = OFF_SBVT + (size_t)M * 1024 * 2;
constexpr size_t OFF_GB = OFF_GA + (size_t)M * 2048 * 2;
constexpr size_t OFF_Q = OFF_GB + (size_t)M * 2048 * 2;
constexpr size_t OFF_KN = OFF_Q + (size_t)M * 1536 * 2;
constexpr size_t OFF_VT = OFF_KN + (size_t)M * 1024 * 2;
constexpr size_t OFF_ATTA = OFF_VT + (size_t)M * 1024 * 2;
constexpr size_t OFF_ATTB = OFF_ATTA + (size_t)M * 1024 * 2;
constexpr size_t WS_END = OFF_ATTB + (size_t)M * 1024 * 2;
constexpr size_t OFF_MERGED = OFF_SBQ;
constexpr size_t OFF_PQ = OFF_GA;
constexpr size_t OFF_IDX = OFF_GB;
constexpr size_t OFF_GW = OFF_GB + (size_t)M * 128 * 4;
constexpr size_t OFF_U16 = OFF_Q;
constexpr size_t OFF_V16 = OFF_U16 + (size_t)16384 * 2048;
static_assert(OFF_V16 + (size_t)16384 * 2048 <= WS_END, "u/v overlay");
constexpr float U8_SCALE = 68.f, V8_SCALE = 1.5f;
static_assert(WS_END < (size_t)620 * 1000 * 1000, "workspace budget");

struct Params {
    const float *x, *c; const int* pos;
    const float *ada_w, *ada_b, *n1g, *n2g, *w_in, *qng, *kvng, *w_uq, *w_ukv, *w_bm, *w_bs, *w_out, *w_pq, *skeys, *pu, *pv, *fng;
    float* out; unsigned char* ws;
    float invf[32];
    int ph_lo, ph_hi;
};

DI unsigned pk2(float lo, float hi) { bf16v2 p; p[0] = (__bf16)lo; p[1] = (__bf16)hi; return __builtin_bit_cast(unsigned, p); }
DI float bflo(unsigned u) { return __uint_as_float(u << 16); }
DI float bfhi(unsigned u) { return __uint_as_float(u & 0xffff0000u); }
DI float dot2bf(unsigned a, unsigned b, float c) { return __builtin_amdgcn_fdot2_f32_bf16(__builtin_bit_cast(bf16v2, a), __builtin_bit_cast(bf16v2, b), c, false); }
DI float bf2f(bf16_t b) { return __uint_as_float(((unsigned)b) << 16); }
DI float wave_sum(float v) {
#pragma unroll
    for (int o = 1; o < 64; o <<= 1) v += __shfl_xor(v, o);
    return v;
}
DI float wave_max(float v) {
#pragma unroll
    for (int o = 1; o < 64; o <<= 1) v = fmaxf(v, __shfl_xor(v, o));
    return v;
}
DI float sigmoidf_(float v) { return 1.f / (1.f + __expf(-v)); }
DI float gelu_tanh(float v) { const float u = 0.7978845608028654f * (v + 0.044715f * v * v * v); const float e = __expf(2.f * u); const float t = 1.f - 2.f / (e + 1.f); return 0.5f * v * (1.f + t); }
DI void store_bf16x4(bf16_t* p, f32x4 v) { u32x2 w; w.x = pk2(v[0], v[1]); w.y = pk2(v[2], v[3]); *(u32x2*)p = w; }
DI void store_bf16x8(bf16_t* p, f32x4 a, f32x4 b) { u32x4 w; w.x = pk2(a[0], a[1]); w.y = pk2(a[2], a[3]); w.z = pk2(b[0], b[1]); w.w = pk2(b[2], b[3]); *(u32x4*)p = w; }
DI void load_bf16x8(const bf16_t* p, f32x4& a, f32x4& b) { const u32x4 w = *(const u32x4*)p; a = (f32x4){bflo(w.x), bfhi(w.x), bflo(w.y), bfhi(w.y)}; b = (f32x4){bflo(w.z), bfhi(w.z), bflo(w.w), bfhi(w.w)}; }
DI f32x4 sig4(f32x4 v) { return (f32x4){sigmoidf_(v[0]), sigmoidf_(v[1]), sigmoidf_(v[2]), sigmoidf_(v[3])}; }
DI f32x4 rope4(f32x4 v, f32x2 c0, f32x2 c1) { return (f32x4){v[0] * c0.x - v[1] * c0.y, v[1] * c0.x + v[0] * c0.y, v[2] * c1.x - v[3] * c1.y, v[3] * c1.x + v[2] * c1.y}; }
DI f32x4 load_bf16x4(const bf16_t* p) { const u32x2 w = *(const u32x2*)p; return (f32x4){bflo(w.x), bfhi(w.x), bflo(w.y), bfhi(w.y)}; }

struct Ctx {
    LAS unsigned char* lds;
    int tid, lane, wave, gw, ngw;
};

struct MapWin { DI int operator()(int n) const {
    if (n < 768) return n;
    if (n < 1024) { const int j = n - 768; if (j >= 64) return -1; return 768 + (j >> 1) + 32 * (j & 1); }
    if (n < 2048) return 832 + (n - 1024);
    if (n < 3072) return 1856 + (n - 2048);
    if (n < 5120) return 3904 + (n - 3072);
    return 5952 + (n - 5120); } };
struct MapOff { int off; DI int operator()(int n) const { return n + off; } };
struct MapUq { DI int operator()(int n) const { const int hd = n / 192, j = n % 192; if (j < 128) return hd * 192 + j; const int jj = j - 128; return hd * 192 + 128 + (jj >> 1) + 32 * (jj & 1); } };
struct MapUk { DI int operator()(int n) const { return (n >> 7) * 256 + (n & 127); } };
struct MapUv { DI int operator()(int n) const { return (n >> 7) * 256 + 128 + (n & 127); } };

template <class Map>
DI void transpose_item(const float* W, int K, int N, const Map& mp, const float* rowscale, bf16_t* dst, int kb, int nb, LAS float* scr, int lane) {
    const int k0 = kb * 64, sc = mp(nb * 64 + lane);
#pragma unroll 8
    for (int kk = 0; kk < 64; ++kk) {
        float v = 0.f;
        if (sc >= 0) v = W[(size_t)(k0 + kk) * N + sc];
        if (rowscale) v *= rowscale[k0 + kk];
        scr[kk * 65 + lane] = v;
    }
    asm volatile("s_waitcnt lgkmcnt(0)" ::: "memory");
    const int kc = lane & 7;
#pragma unroll
    for (int j = 0; j < 8; ++j) {
        const int nrow = (lane >> 3) + 8 * j; const LAS float* s = scr + (8 * kc) * 65 + nrow;
        u32x4 o; o.x = pk2(s[0], s[65]); o.y = pk2(s[2 * 65], s[3 * 65]); o.z = pk2(s[4 * 65], s[5 * 65]); o.w = pk2(s[6 * 65], s[7 * 65]);
        *(u32x4*)(dst + (size_t)(nb * 64 + nrow) * K + k0 + 8 * kc) = o;
    }
    asm volatile("s_waitcnt lgkmcnt(0)" ::: "memory");
}

DI void phase_prologue(const Params& p, const Ctx& c, bool do_ada = true, bool do_rest = true) {
    unsigned char* ws = p.ws;
    LAS float* scr = (LAS float*)(c.lds + c.wave * 16640);
    unsigned long long* modi = (unsigned long long*)(ws + OFF_MODI);
    if (do_ada) for (int u = c.gw; u < 32 * 48; u += c.ngw) {
        const int kp = u / 48, ch = u % 48, k0 = kp * 64, c0 = ch * 256 + c.lane * 4;
        float sl[4];
#pragma unroll
        for (int b = 0; b < 4; ++b) { const float cv = p.c[b * D + k0 + c.lane]; sl[b] = cv / (1.f + __expf(-cv)); }
        f32x4 acc[4];
#pragma unroll
        for (int b = 0; b < 4; ++b) acc[b] = (f32x4){0.f, 0.f, 0.f, 0.f};
#pragma unroll 16
        for (int kk = 0; kk < 64; ++kk) {
            const f32x4 w = *(const f32x4*)(p.ada_w + (size_t)(k0 + kk) * (6 * D) + c0);
#pragma unroll
            for (int b = 0; b < 4; ++b) { const float s = __shfl(sl[b], kk); acc[b] += w * s; }
        }
        if (kp == 0) { const f32x4 bv = *(const f32x4*)(p.ada_b + c0);
#pragma unroll
            for (int b = 0; b < 4; ++b) acc[b] += bv; }
#pragma unroll
        for (int b = 0; b < 4; ++b)
#pragma unroll
            for (int e = 0; e < 4; ++e) atomicAdd(modi + b * 6 * D + c0 + e, (unsigned long long)(long long)__builtin_rint((double)acc[b][e] * 4294967296.0));
    }
    if (!do_rest) return;
    constexpr int I_WIN = 112 * 32, I_SBV = 16 * 32, I_UQ = 24 * 8, I_UK = 16 * 4, I_UV = 16 * 4, I_A = 32 * 16, I_B = 32 * 16, I_OUT = 32 * 32, I_PQ = 32 * 32;
    constexpr int NIT = I_WIN + I_SBV + I_UQ + I_UK + I_UV + I_A + I_B + I_OUT + I_PQ;
    for (int it = c.gw; it < NIT; it += c.ngw) {
        int r = it;
        if (r < I_WIN) { transpose_item(p.w_in, 2048, 8000, MapWin{}, nullptr, (bf16_t*)(ws + OFF_WIN), r % 32, r / 32, scr, c.lane); continue; } r -= I_WIN;
        if (r < I_SBV) { transpose_item(p.w_in, 2048, 8000, MapOff{2880}, nullptr, (bf16_t*)(ws + OFF_WSBV), r % 32, r / 32, scr, c.lane); continue; } r -= I_SBV;
        if (r < I_UQ) { transpose_item(p.w_uq, 512, 1536, MapUq{}, p.qng, (bf16_t*)(ws + OFF_WUQ), r % 8, r / 8, scr, c.lane); continue; } r -= I_UQ;
        if (r < I_UK) { transpose_item(p.w_ukv, 256, 2048, MapUk{}, p.kvng, (bf16_t*)(ws + OFF_WUK), r % 4, r / 4, scr, c.lane); continue; } r -= I_UK;
        if (r < I_UV) { transpose_item(p.w_ukv, 256, 2048, MapUv{}, p.kvng, (bf16_t*)(ws + OFF_WUV), r % 4, r / 4, scr, c.lane); continue; } r -= I_UV;
        if (r < I_A) { transpose_item(p.w_bm, 1024, 2048, MapOff{0}, nullptr, (bf16_t*)(ws + OFF_WA), r % 16, r / 16, scr, c.lane); continue; } r -= I_A;
        if (r < I_B) { transpose_item(p.w_bs, 1024, 2048, MapOff{0}, nullptr, (bf16_t*)(ws + OFF_WB), r % 16, r / 16, scr, c.lane); continue; } r -= I_B;
        if (r < I_OUT) { transpose_item(p.w_out, 2048, 2048, MapOff{0}, nullptr, (bf16_t*)(ws + OFF_WOUT), r % 32, r / 32, scr, c.lane); continue; } r -= I_OUT;
        transpose_item(p.w_pq, 2048, 2048, MapOff{0}, nullptr, (bf16_t*)(ws + OFF_WPQ), r % 32, r / 32, scr, c.lane);
    }
    { bf16_t* kd = (bf16_t*)(ws + OFF_KEYS);
      for (int i = (c.gw * 64 + c.lane) * 4; i < 8 * 2 * 128 * 128; i += c.ngw * 64 * 4) store_bf16x4(kd + i, *(const f32x4*)(p.skeys + i)); }
    { f32x2* cs = (f32x2*)(ws + OFF_CS);
      for (int i = c.gw * 64 + c.lane; i < M * 32; i += c.ngw * 64) {
          const int m = i >> 5, f = i & 31;
          const float ang = (float)p.pos[m] * p.invf[f];
          const double rev = (double)ang * 0.15915494309189533576888;
          const float fr = (float)(rev - __builtin_rint(rev));
          cs[i] = (f32x2){__builtin_amdgcn_cosf(fr), __builtin_amdgcn_sinf(fr)};
      } }
}

DI f32x4 ld_mod4(const float* p) { return *(const f32x4*)p; }
DI f32x4 ld_mod4(const long long* p) { f32x4 r;
#pragma unroll
    for (int e = 0; e < 4; ++e) r[e] = (float)((double)p[e] * (1.0 / 4294967296.0));
    return r; }
template <class MT>
DI void modulate_rows(const float* src, const float* g, const MT* sc, const MT* sh, bf16_t* dst, const Ctx& c) {
    for (int m = c.gw; m < M; m += c.ngw) {
        const int b = m / SEQ;
        const float* xr = src + (size_t)m * D;
        f32x4 v[8]; float ss = 0.f;
#pragma unroll
        for (int j = 0; j < 8; ++j) { v[j] = *(const f32x4*)(xr + (j * 64 + c.lane) * 4); ss += v[j][0] * v[j][0] + v[j][1] * v[j][1] + v[j][2] * v[j][2] + v[j][3] * v[j][3]; }
        const float rstd = rsqrtf(wave_sum(ss) * (1.f / D) + EPS);
#pragma unroll
        for (int j = 0; j < 8; ++j) {
            const int col = (j * 64 + c.lane) * 4;
            const f32x4 gg = *(const f32x4*)(g + col), s1 = ld_mod4(sc + b * 6 * D + col), h1 = ld_mod4(sh + b * 6 * D + col);
            const f32x4 o = v[j] * rstd * gg * (s1 + 1.f) + h1;
            store_bf16x4(dst + (size_t)m * D + col, o);
        }
    }
}
DI void phase_rowstats(const Params& p, const Ctx& c) {
    const bf16_t* cq = (const bf16_t*)(p.ws + OFF_CQ); const bf16_t* ckv = (const bf16_t*)(p.ws + OFF_CKV);
    float* rq = (float*)(p.ws + OFF_RSTQ); float* rkv = (float*)(p.ws + OFF_RSTKV);
    for (int m = c.gw; m < M; m += c.ngw) {
        const u32x4 a = *(const u32x4*)(cq + (size_t)m * 512 + c.lane * 8);
        const u32x2 b = *(const u32x2*)(ckv + (size_t)m * 256 + c.lane * 4);
        float s1 = 0.f, s2 = 0.f;
#pragma unroll
        for (int e = 0; e < 4; ++e) { const float lo = bflo(a[e]), hi = bfhi(a[e]); s1 += lo * lo + hi * hi; }
#pragma unroll
        for (int e = 0; e < 2; ++e) { const float lo = bflo(b[e]), hi = bfhi(b[e]); s2 += lo * lo + hi * hi; }
        s1 = wave_sum(s1); s2 = wave_sum(s2);
        if (c.lane == 0) { rq[m] = rsqrtf(s1 * (1.f / 512.f) + EPS); rkv[m] = rsqrtf(s2 * (1.f / 256.f) + EPS); }
    }
}
typedef float f32x16v __attribute__((ext_vector_type(16)));
typedef float f32x32v __attribute__((ext_vector_type(32)));
typedef unsigned u32x6 __attribute__((ext_vector_type(6)));
#ifndef FP6_ORDER
#define FP6_ORDER 1
#endif
DI void convert_table(const float* src, unsigned char* dst, float scale, const Ctx& c) {
    const size_t ngroups = (size_t)16384 * 64;
    for (size_t gi = (size_t)c.gw * 64 + c.lane; gi < ngroups; gi += (size_t)c.ngw * 64) {
        const size_t row = gi >> 6; const int l = (int)(gi & 63);
        const float* sp = src + row * 2048 + l * 32;
        f32x4 v[8];
#pragma unroll
        for (int i = 0; i < 8; ++i) v[i] = *(const f32x4*)(sp + 4 * i) * scale;
        f32x16v a, b;
#pragma unroll
        for (int e = 0; e < 16; ++e) {
#if FP6_ORDER == 0
            a[e] = v[e >> 2][e & 3]; b[e] = v[4 + (e >> 2)][e & 3];
#else
            a[e] = v[(2 * e) >> 2][(2 * e) & 3]; b[e] = v[(2 * e + 1) >> 2][(2 * e + 1) & 3];
#endif
        }
        const u32x6 pk = __builtin_amdgcn_cvt_scalef32_2xpk16_fp6_f32(a, b, 1.0f);
        unsigned char* dp = dst + row * 1536;
        *(u32x4*)(dp + 16 * l) = (u32x4){pk[0], pk[1], pk[2], pk[3]};
        *(u32x2*)(dp + 1024 + 8 * l) = (u32x2){pk[4], pk[5]};
    }
}

struct EpiProj {
    bf16_t *cq, *ckv, *kr, *sbq, *sbk, *ga, *gb; const f32x2* cs;
    DI void operator()(int row, int col, f32x4 v) const {
        const int tile = col >> 8;
        if (tile < 2) { store_bf16x4(cq + (size_t)row * 512 + col, v); }
        else if (tile == 2) { store_bf16x4(ckv + (size_t)row * 256 + (col - 512), v); }
        else if (tile == 3) { const int j = col - 768; if (j < 64) { const f32x2 c0 = cs[row * 32 + (j >> 1)], c1 = cs[row * 32 + (j >> 1) + 1];
            const f32x4 o = {v[0] * c0.x - v[1] * c0.y, v[1] * c0.x + v[0] * c0.y, v[2] * c1.x - v[3] * c1.y, v[3] * c1.x + v[2] * c1.y};
            store_bf16x4(kr + (size_t)row * 64 + j, o); } }
        else if (tile < 8) { store_bf16x4(sbq + (size_t)row * 1024 + (col - 1024), v * (0.08838834764831845f * LOG2E)); }
        else if (tile < 12) { store_bf16x4(sbk + (size_t)row * 1024 + (col - 2048), v); }
        else if (tile < 20) { store_bf16x4(ga + (size_t)row * 2048 + (col - 3072), (f32x4){sigmoidf_(v[0]), sigmoidf_(v[1]), sigmoidf_(v[2]), sigmoidf_(v[3])}); }
        else { store_bf16x4(gb + (size_t)row * 2048 + (col - 5120), (f32x4){sigmoidf_(v[0]), sigmoidf_(v[1]), sigmoidf_(v[2]), sigmoidf_(v[3])}); }
    }    DI void operator()(int row, int col, f32x4 v0, f32x4 v1) const {
        const int tile = col >> 8;
        if (tile < 2) { store_bf16x8(cq + (size_t)row * 512 + col, v0, v1); }
        else if (tile == 2) { store_bf16x8(ckv + (size_t)row * 256 + (col - 512), v0, v1); }
        else if (tile == 3) { const int j = col - 768; if (j < 64) { const f32x2* cp = cs + row * 32 + (j >> 1);
            store_bf16x8(kr + (size_t)row * 64 + j, rope4(v0, cp[0], cp[1]), rope4(v1, cp[2], cp[3])); } }
        else if (tile < 8) { const float sc = 0.08838834764831845f * LOG2E; store_bf16x8(sbq + (size_t)row * 1024 + (col - 1024), v0 * sc, v1 * sc); }
        else if (tile < 12) { store_bf16x8(sbk + (size_t)row * 1024 + (col - 2048), v0, v1); }
        else if (tile < 20) { store_bf16x8(ga + (size_t)row * 2048 + (col - 3072), sig4(v0), sig4(v1)); }
        else { store_bf16x8(gb + (size_t)row * 2048 + (col - 5120), sig4(v0), sig4(v1)); }
    }
};
struct EpiT { bf16_t* o; const float* cscale;
    DI void operator()(int row, int col, f32x4 v) const { if (cscale) v = v * *(const f32x4*)(cscale + col); store_bf16x4(o + (size_t)row * M + col, v); }
    DI void operator()(int row, int col, f32x4 v0, f32x4 v1) const { if (cscale) { v0 = v0 * *(const f32x4*)(cscale + col); v1 = v1 * *(const f32x4*)(cscale + col + 4); } store_bf16x8(o + (size_t)row * M + col, v0, v1); } };
struct EpiUq { bf16_t* q; const float* rst; const f32x2* cs;
    DI void operator()(int row, int col, f32x4 v) const {
        v = v * (rst[row] * (0.07216878364870322f * LOG2E));
        const int j = col % 192;
        if (j >= 128) { const int i0 = (j - 128) >> 1; const f32x2 c0 = cs[row * 32 + i0], c1 = cs[row * 32 + i0 + 1];
            v = (f32x4){v[0] * c0.x - v[1] * c0.y, v[1] * c0.x + v[0] * c0.y, v[2] * c1.x - v[3] * c1.y, v[3] * c1.x + v[2] * c1.y}; }
        store_bf16x4(q + (size_t)row * 1536 + col, v);
    }
    DI void operator()(int row, int col, f32x4 v0, f32x4 v1) const {
        const float sc = rst[row] * (0.07216878364870322f * LOG2E); v0 = v0 * sc; v1 = v1 * sc;
        const int j = col % 192;
        if (j >= 128) { const f32x2* cp = cs + row * 32 + ((j - 128) >> 1); v0 = rope4(v0, cp[0], cp[1]); v1 = rope4(v1, cp[2], cp[3]); }
        store_bf16x8(q + (size_t)row * 1536 + col, v0, v1);
    } };
struct EpiRowScale { bf16_t* o; int ld; const float* rst;
    DI void operator()(int row, int col, f32x4 v) const { store_bf16x4(o + (size_t)row * ld + col, v * rst[row]); }
    DI void operator()(int row, int col, f32x4 v0, f32x4 v1) const { const float sc = rst[row]; store_bf16x8(o + (size_t)row * ld + col, v0 * sc, v1 * sc); } };
struct EpiGate1 { bf16_t* mg; const bf16_t* g;
    DI void operator()(int row, int col, f32x4 v) const { const size_t i = (size_t)row * 2048 + col; store_bf16x4(mg + i, v * load_bf16x4(g + i)); }
    DI void operator()(int row, int col, f32x4 v0, f32x4 v1) const { const size_t i = (size_t)row * 2048 + col; f32x4 g0, g1; load_bf16x8(g + i, g0, g1); store_bf16x8(mg + i, v0 * g0, v1 * g1); } };
struct EpiGate2 { bf16_t* mg; const bf16_t* g;
    DI void operator()(int row, int col, f32x4 v) const { const size_t i = (size_t)row * 2048 + col; store_bf16x4(mg + i, load_bf16x4(mg + i) + v * load_bf16x4(g + i)); }
    DI void operator()(int row, int col, f32x4 v0, f32x4 v1) const { const size_t i = (size_t)row * 2048 + col; f32x4 g0, g1, m0, m1; load_bf16x8(g + i, g0, g1); load_bf16x8(mg + i, m0, m1); store_bf16x8(mg + i, m0 + v0 * g0, m1 + v1 * g1); } };
struct EpiRes { const float* x; const float* gt; float* x1;
    DI void operator()(int row, int col, f32x4 v) const { const size_t i = (size_t)row * 2048 + col; const int b = row / SEQ;
        *(f32x4*)(x1 + i) = *(const f32x4*)(x + i) + *(const f32x4*)(gt + b * 6 * D + col) * v * DBG_ALPHA; }
    DI void operator()(int row, int col, f32x4 v0, f32x4 v1) const { (*this)(row, col, v0); (*this)(row, col + 4, v1); } };
struct EpiPq { bf16_t* pq;
    DI void operator()(int row, int col, f32x4 v) const { store_bf16x4(pq + (size_t)(col >> 8) * M * 256 + (size_t)row * 256 + (col & 255), v); }
    DI void operator()(int row, int col, f32x4 v0, f32x4 v1) const { store_bf16x8(pq + (size_t)(col >> 8) * M * 256 + (size_t)row * 256 + (col & 255), v0, v1); } };

template <class Epi>
DI void gemm_naive(const Ctx& c, const bf16_t* A, const bf16_t* Bt, int Mg, int Ng, int Kg, const Epi& E) {
    LAS float* As = (LAS float*)c.lds; LAS float* Bs = As + 16 * 132;
    const int tid = c.tid, ty = tid >> 5, tx = tid & 31;
    const int tilesN = Ng / 128, ntiles = (Mg / 128) * tilesN;
    for (int t = blockIdx.x; t < ntiles; t += gridDim.x) {
        const int tm = t / tilesN, tn = t % tilesN;
        float acc[8][4];
#pragma unroll
        for (int i = 0; i < 8; ++i)
#pragma unroll
            for (int j = 0; j < 4; ++j) acc[i][j] = 0.f;
        for (int k0 = 0; k0 < Kg; k0 += 16) {
            { const int lt = tid & 255, r = lt >> 1, kc = lt & 1;
              const bf16_t* src = (tid < 256 ? A + (size_t)(tm * 128 + r) * Kg : Bt + (size_t)(tn * 128 + r) * Kg) + k0 + kc * 8;
              const u32x4 v = *(const u32x4*)src;
              LAS float* dst = (tid < 256 ? As : Bs) + (kc * 8) * 132 + r;
              dst[0] = bflo(v.x); dst[132] = bfhi(v.x); dst[2 * 132] = bflo(v.y); dst[3 * 132] = bfhi(v.y);
              dst[4 * 132] = bflo(v.z); dst[5 * 132] = bfhi(v.z); dst[6 * 132] = bflo(v.w); dst[7 * 132] = bfhi(v.w); }
            __syncthreads();
#pragma unroll
            for (int kk = 0; kk < 16; ++kk) {
                const f32x4 a0 = *(const LAS f32x4*)(As + kk * 132 + ty * 8), a1 = *(const LAS f32x4*)(As + kk * 132 + ty * 8 + 4);
                const f32x4 b = *(const LAS f32x4*)(Bs + kk * 132 + tx * 4);
#pragma unroll
                for (int j = 0; j < 4; ++j) {
                    acc[0][j] += a0[0] * b[j]; acc[1][j] += a0[1] * b[j]; acc[2][j] += a0[2] * b[j]; acc[3][j] += a0[3] * b[j];
                    acc[4][j] += a1[0] * b[j]; acc[5][j] += a1[1] * b[j]; acc[6][j] += a1[2] * b[j]; acc[7][j] += a1[3] * b[j];
                }
            }
            __syncthreads();
        }
#pragma unroll
        for (int i = 0; i < 8; ++i) E(tm * 128 + ty * 8 + i, tn * 128 + tx * 4, (f32x4){acc[i][0], acc[i][1], acc[i][2], acc[i][3]});
    }
}

namespace pg8 {
#define PG8_LAS __attribute__((address_space(3)))
typedef unsigned short bf16_t;
typedef short bf16x8 __attribute__((ext_vector_type(8)));
typedef float f32x4 __attribute__((ext_vector_type(4)));
typedef unsigned u32x4 __attribute__((ext_vector_type(4)));
constexpr int BM = 256, BK = 64, HALF = 128, HTB = HALF * BK * 2  , STAGE_BYTES = 8 * HTB, NXCD = 8, WGM = 4;

__host__ __device__ __forceinline__ int lds_byte(int r, int c) { const int st = (r >> 4) * 2 + (c >> 5), rr = r & 15, cc = c & 31, ob = rr * 64 + cc * 2; return st * 1024 + (ob ^ (((ob >> 9) & 1) << 5)); }
__host__ __device__ __forceinline__ void stage_rc(int b, int& R, int& C) { const int st = b / 1024, sb = b % 1024, swz = sb ^ (((sb >> 9) & 1) << 5); R = (st >> 1) * 16 + swz / 64; C = (st & 1) * 32 + (swz % 64) / 2; }
__host__ __device__ __forceinline__ int perm32(int rho) { const int n = rho >> 4, i = rho & 15; return 8 * (i >> 2) + 4 * n + (i & 3); }

struct Unit { int pm, pn; };
struct Gemm { const bf16_t* A; const bf16_t* Bt; int M, N, K; int tid; };
struct StaticOrder {
    int nM, nN, nwg, G, c;
    __host__ __device__ void init(int M, int N, int G_, int c_) { nM = M / BM; nN = N / BM; nwg = nM * nN; G = G_; c = c_; }
    __host__ __device__ bool next(int i, Unit& u) const {
        const long L = (long)i * G + c; if (L >= nwg) return false;
        int wgid = (int)L; { const int q = nwg / NXCD, r = nwg % NXCD, xcd = wgid % NXCD, off = wgid / NXCD; wgid = (xcd < r ? xcd * (q + 1) : r * (q + 1) + (xcd - r) * q) + off; }
        const int nig = WGM * nN, gid = wgid / nig, fm = gid * WGM, gsz = (nM - fm) < WGM ? (nM - fm) : WGM;
        u.pm = fm + ((wgid % nig) % gsz); u.pn = (wgid % nig) / gsz; return true;
    }
    __device__ __forceinline__ void a_ready(const Unit&) const {}
    __device__ __forceinline__ void done(const Unit&) const {}
};
template <class Epi, class Sched, bool STAMP = false>
__device__ __forceinline__ void gemm_phase(PG8_LAS unsigned char* lds, const Gemm g, const Sched& S, const Epi& E, unsigned long long* stamps) {
    const int tid = g.tid, wid = __builtin_amdgcn_readfirstlane(tid >> 6), lane = tid & 63, wr = wid >> 2, wc = wid & 3, fr = lane & 15, fq = lane >> 4;
    const int K = g.K, nt = K / BK;
    int ts_lo = 0, ts_hi = 0, nts = 0; const unsigned long long rt_entry = STAMP ? (unsigned long long)wall_clock64() : 0ull;
#define PG8_STAMP() do { if (STAMP && wid == 0 && nts < 64) { const unsigned long long _c = (unsigned long long)clock64(); \
        ts_lo = (lane == nts) ? (int)(unsigned)_c : ts_lo; ts_hi = (lane == nts) ? (int)(unsigned)(_c >> 32) : ts_hi; ++nts; } } while (0)
    PG8_STAMP();
    unsigned voffA[2], voffB[2];
#pragma unroll
    for (int i = 0; i < 2; ++i) { int R, C; stage_rc(tid * 16 + i * 8192, R, C); const int Rb = Epi::PERM ? ((R & ~31) + perm32(R & 31)) : R;
        voffA[i] = (unsigned)(R * K + C) * 2u; voffB[i] = (unsigned)(Rb * K + C) * 2u; }
    const size_t kstep = (size_t)(BK * 2);
    const size_t hstep = (size_t)HALF * K * 2;
    const size_t tstep = 2 * hstep;
    const unsigned ldsw = (unsigned)wid * 1024u;
    const int aoff = lds_byte(wr * 64 + fr, fq * 8), boff = lds_byte(wc * 32 + fr, fq * 8);
#define PG8_SA(b, h) (((b) * 2 + (h)) * HTB)
#define PG8_SB(b, h) ((4 + (b) * 2 + (h)) * HTB)
#define PG8_STAGE(bufoff, gbase, voff) do { _Pragma("unroll") for (int _i = 0; _i < 2; ++_i) \
        __builtin_amdgcn_global_load_lds((const unsigned*)((const char*)(gbase) + (voff)[_i]), (PG8_LAS unsigned*)(lds + (bufoff) + ldsw + _i * 8192), 16, 0, 0); } while (0)
#define PG8_LDA(dst, b, h) do { _Pragma("unroll") for (int m = 0; m < 4; ++m) _Pragma("unroll") for (int k = 0; k < 2; ++k) dst[m][k] = *(const PG8_LAS bf16x8*)(lds + PG8_SA(b, h) + aoff + m * 2048 + k * 1024); } while (0)
#define PG8_LDB(dst, b, h) do { _Pragma("unroll") for (int n = 0; n < 2; ++n) _Pragma("unroll") for (int k = 0; k < 2; ++k) dst[n][k] = *(const PG8_LAS bf16x8*)(lds + PG8_SB(b, h) + boff + n * 2048 + k * 1024); } while (0)
#define PG8_MMA(ai, bj, At, Bt) do { __builtin_amdgcn_s_setprio(1); _Pragma("unroll") for (int m = 0; m < 4; ++m) _Pragma("unroll") for (int n = 0; n < 2; ++n) _Pragma("unroll") for (int k = 0; k < 2; ++k) \
        acc[ai][bj][m][n] = __builtin_amdgcn_mfma_f32_16x16x32_bf16(Bt[n][k], At[m][k], acc[ai][bj][m][n], 0, 0, 0); __builtin_amdgcn_s_setprio(0); } while (0)
#define PG8_WAIT_V(n) asm volatile("s_waitcnt vmcnt(" #n ")" ::: "memory")
#define PG8_WAIT_L(n) asm volatile("s_waitcnt lgkmcnt(" #n ")" ::: "memory")
#define PG8_BAR __builtin_amdgcn_s_barrier()
#define PG8_SCHED __builtin_amdgcn_sched_barrier(0)
    Unit cur, nxt; int ui = 0;
    if (!S.next(0, cur)) return;
    f32x4 acc[2][2][4][2];
#pragma unroll
    for (int a = 0; a < 2; ++a)
#pragma unroll
        for (int b = 0; b < 2; ++b)
#pragma unroll
            for (int m = 0; m < 4; ++m)
#pragma unroll
                for (int n = 0; n < 2; ++n) acc[a][b][m][n] = (f32x4){0.f, 0.f, 0.f, 0.f};
    bf16x8 At[4][2], B0[2][2], B1[2][2];
    const char* cA = (const char*)g.A + (size_t)cur.pm * tstep; const char* cB = (const char*)g.Bt + (size_t)cur.pn * tstep;
    S.a_ready(cur);
    PG8_STAGE(PG8_SB(0, 0), cB, voffB); PG8_STAGE(PG8_SA(0, 0), cA, voffA); PG8_STAGE(PG8_SB(0, 1), cB + hstep, voffB); PG8_STAGE(PG8_SA(0, 1), cA + hstep, voffA);
    if (wr == 1) PG8_BAR;
    PG8_WAIT_V(4); PG8_BAR;
    PG8_STAGE(PG8_SB(1, 0), cB + kstep, voffB); PG8_STAGE(PG8_SA(1, 0), cA + kstep, voffA); PG8_STAGE(PG8_SB(1, 1), cB + hstep + kstep, voffB);
    PG8_WAIT_V(6); PG8_BAR;
    PG8_STAMP();
    for (;;) {
        const bool has_next = S.next(ui + 1, nxt);
        const char* nA = has_next ? (const char*)g.A + (size_t)nxt.pm * tstep : cA; const char* nB = has_next ? (const char*)g.Bt + (size_t)nxt.pn * tstep : cB;
        for (int t = 0; t < nt; t += 2) {
            const bool last = (t == nt - 2);
            const char* a1 = cA + (size_t)(t + 1) * kstep;
            const char* a2 = last ? nA : cA + (size_t)(t + 2) * kstep; const char* b2 = last ? nB : cB + (size_t)(t + 2) * kstep;
            const char* a3 = a2 + kstep; const char* b3 = b2 + kstep;
            if (last && has_next) S.a_ready(nxt);
            PG8_LDB(B0, 0, 0); PG8_SCHED; PG8_LDA(At, 0, 0); PG8_STAGE(PG8_SA(1, 1), a1 + hstep, voffA);
            PG8_WAIT_L(8); PG8_BAR; PG8_WAIT_L(0); PG8_MMA(0, 0, At, B0); PG8_BAR; PG8_SCHED;
            PG8_LDB(B1, 0, 1); PG8_STAGE(PG8_SB(0, 0), b2, voffB);
            PG8_BAR; PG8_WAIT_L(0); PG8_MMA(0, 1, At, B1); PG8_BAR;
            PG8_LDA(At, 0, 1); PG8_STAGE(PG8_SA(0, 0), a2, voffA);
            PG8_BAR; PG8_WAIT_L(0); PG8_MMA(1, 0, At, B0); PG8_BAR; PG8_SCHED;
            PG8_STAGE(PG8_SB(0, 1), b2 + hstep, voffB);
            PG8_WAIT_V(6); PG8_BAR; PG8_MMA(1, 1, At, B1); PG8_BAR;
            PG8_LDB(B0, 1, 0); PG8_SCHED; PG8_LDA(At, 1, 0); PG8_STAGE(PG8_SA(0, 1), a2 + hstep, voffA);
            PG8_WAIT_L(8); PG8_BAR; PG8_WAIT_L(0); PG8_MMA(0, 0, At, B0); PG8_BAR; PG8_SCHED;
            PG8_LDB(B1, 1, 1); PG8_STAGE(PG8_SB(1, 0), b3, voffB);
            PG8_BAR; PG8_WAIT_L(0); PG8_MMA(0, 1, At, B1); PG8_BAR;
            PG8_LDA(At, 1, 1); PG8_STAGE(PG8_SA(1, 0), a3, voffA);
            PG8_BAR; PG8_WAIT_L(0); PG8_MMA(1, 0, At, B0); PG8_BAR; PG8_SCHED;
            PG8_STAGE(PG8_SB(1, 1), b3 + hstep, voffB);
            PG8_WAIT_V(6); PG8_BAR; PG8_MMA(1, 1, At, B1); PG8_BAR;
        }
        PG8_STAMP();
        if constexpr (!Epi::AFTER_DRAIN) { E(acc, cur, wr, wc, fr, fq); S.done(cur); }
        PG8_STAMP();
        if (!has_next) break;
#pragma unroll
        for (int a = 0; a < 2; ++a)
#pragma unroll
            for (int b = 0; b < 2; ++b)
#pragma unroll
                for (int m = 0; m < 4; ++m)
#pragma unroll
                    for (int n = 0; n < 2; ++n) acc[a][b][m][n] = (f32x4){0.f, 0.f, 0.f, 0.f};
        cur = nxt; cA = nA; cB = nB; ++ui;
    }
    PG8_WAIT_V(0);
    if (wr == 0) PG8_BAR;
    PG8_BAR;
    if constexpr (Epi::AFTER_DRAIN) { E.fused(acc, cur, wr, wc, fr, fq, lds, wid, lane); S.done(cur); }
    PG8_STAMP();
    if (STAMP && wid == 0) { stamps[lane] = lane < nts ? (((unsigned long long)(unsigned)ts_hi << 32) | (unsigned)ts_lo) : 0ull;
        if (lane == 62) stamps[62] = rt_entry; if (lane == 63) stamps[63] = (unsigned long long)wall_clock64(); }
#undef PG8_STAMP
#undef PG8_SA
#undef PG8_SB
#undef PG8_STAGE
#undef PG8_LDA
#undef PG8_LDB
#undef PG8_MMA
#undef PG8_WAIT_V
#undef PG8_WAIT_L
#undef PG8_BAR
#undef PG8_SCHED
}
}

template <class E4> struct EpiAdapt {
    static constexpr bool PERM = true, AFTER_DRAIN = false;
    E4 e;
    __device__ __forceinline__ void operator()(const pg8::f32x4 (&acc)[2][2][4][2], const pg8::Unit& u, int wr, int wc, int fr, int fq) const {
#pragma unroll
        for (int ai = 0; ai < 2; ++ai)
#pragma unroll
            for (int m = 0; m < 4; ++m) {
                const int row = u.pm * 256 + ai * 128 + wr * 64 + m * 16 + fr;
#pragma unroll
                for (int bj = 0; bj < 2; ++bj) e(row, u.pn * 256 + bj * 128 + wc * 32 + fq * 8, acc[ai][bj][m][0], acc[ai][bj][m][1]);
                asm volatile("" ::: "memory");
            }
    }
};
template <class E4>
DI void gemm_fast(const Ctx& c, const bf16_t* A, const bf16_t* Bt, int Mg, int Ng, int Kg, const E4& e4) {
    pg8::Gemm g{A, Bt, Mg, Ng, Kg, c.tid}; pg8::StaticOrder S; S.init(Mg, Ng, (int)gridDim.x, (int)blockIdx.x);
    EpiAdapt<E4> E{e4};
    pg8::gemm_phase<EpiAdapt<E4>, pg8::StaticOrder, false>((PG8_LAS unsigned char*)c.lds, g, S, E, nullptr);
}
#ifndef FAST_GEMM
#define FAST_GEMM 1
#endif
#if FAST_GEMM
#define GEMM(c_, ...) do { MKCTX(); gemm_fast(c, __VA_ARGS__); } while (0)
#else
#define GEMM(c_, ...) do { MKCTX(); gemm_naive(c, __VA_ARGS__); } while (0)
#endif

DI void attn_mla_naive(const Params& p, const Ctx& c) {
    const bf16_t* Q = (const bf16_t*)(p.ws + OFF_Q); const bf16_t* KN = (const bf16_t*)(p.ws + OFF_KN); const bf16_t* KR = (const bf16_t*)(p.ws + OFF_KR);
    const bf16_t* VT = (const bf16_t*)(p.ws + OFF_VT); bf16_t* O = (bf16_t*)(p.ws + OFF_ATTA);
    for (int u = c.gw; u < M * 8; u += c.ngw) {
        const int m = u >> 3, hd = u & 7, b = m / SEQ, s = m % SEQ, base = b * SEQ, nkeys = ((s >> 6) + 1) << 6;
        const float q0 = bf2f(Q[(size_t)m * 1536 + hd * 192 + c.lane]), q1 = bf2f(Q[(size_t)m * 1536 + hd * 192 + 64 + c.lane]), q2 = bf2f(Q[(size_t)m * 1536 + hd * 192 + 128 + c.lane]);
        float mx = -1e30f, l = 0.f, o0 = 0.f, o1 = 0.f;
        const bf16_t* v0p = VT + (size_t)(hd * 128 + c.lane) * M + base; const bf16_t* v1p = v0p + (size_t)64 * M;
        for (int kk = 0; kk < nkeys; ++kk) {
            const size_t tk = base + kk;
            const float part = q0 * bf2f(KN[tk * 1024 + hd * 128 + c.lane]) + q1 * bf2f(KN[tk * 1024 + hd * 128 + 64 + c.lane]) + q2 * bf2f(KR[tk * 64 + c.lane]);
            const float sc = wave_sum(part);
            const float mn = fmaxf(mx, sc), al = exp2f(mx - mn), pp = exp2f(sc - mn);
            l = l * al + pp; o0 = o0 * al + pp * bf2f(v0p[kk]); o1 = o1 * al + pp * bf2f(v1p[kk]); mx = mn;
        }
        const float inv = 1.f / l;
        O[(size_t)m * 1024 + hd * 128 + c.lane] = (bf16_t)(pk2(o0 * inv, 0.f) & 0xffff);
        O[(size_t)m * 1024 + hd * 128 + 64 + c.lane] = (bf16_t)(pk2(o1 * inv, 0.f) & 0xffff);
    }
}
DI void attn_sb_naive(const Params& p, const Ctx& c) {
    const bf16_t* Q = (const bf16_t*)(p.ws + OFF_SBQ); const bf16_t* K = (const bf16_t*)(p.ws + OFF_SBK);
    const bf16_t* VT = (const bf16_t*)(p.ws + OFF_SBVT); bf16_t* O = (bf16_t*)(p.ws + OFF_ATTB);
    for (int u = c.gw; u < M * 8; u += c.ngw) {
        const int m = u >> 3, hd = u & 7, b = m / SEQ, s = m % SEQ, base = b * SEQ;
        const float q0 = bf2f(Q[(size_t)m * 1024 + hd * 128 + c.lane]), q1 = bf2f(Q[(size_t)m * 1024 + hd * 128 + 64 + c.lane]);
        float later = 0.f, o0 = 0.f, o1 = 0.f;
        const bf16_t* v0p = VT + (size_t)(hd * 128 + c.lane) * M + base; const bf16_t* v1p = v0p + (size_t)64 * M;
        for (int kk = s - 1; kk >= 0; --kk) {
            const size_t tk = base + kk;
            const float z2 = wave_sum(q0 * bf2f(K[tk * 1024 + hd * 128 + c.lane]) + q1 * bf2f(K[tk * 1024 + hd * 128 + 64 + c.lane]));
            const float ln2 = -(fmaxf(z2, 0.f) + __log2f(1.f + exp2f(-fabsf(z2))));
            const float w = exp2f(z2 + ln2 + later);
            later += ln2; o0 += w * bf2f(v0p[kk]); o1 += w * bf2f(v1p[kk]);
        }
        O[(size_t)m * 1024 + hd * 128 + c.lane] = (bf16_t)(pk2(o0, 0.f) & 0xffff);
        O[(size_t)m * 1024 + hd * 128 + 64 + c.lane] = (bf16_t)(pk2(o1, 0.f) & 0xffff);
    }
}


typedef float f32x16 __attribute__((ext_vector_type(16)));
#define MFMA32(a, b, c) __builtin_amdgcn_mfma_f32_32x32x16_bf16((a), (b), (c), 0, 0, 0)
constexpr int ST_KR = 16384, ST_VT = 24576, ST_BYTES = 40960;
constexpr int ATT_FLAGS = 2 * ST_BYTES;
DI float ex2(float x) { return __builtin_amdgcn_exp2f(x); }
DI float lg2(float x) { return __builtin_amdgcn_logf(x); }
DI bf16x8 pack8(float a0, float a1, float a2, float a3, float a4, float a5, float a6, float a7) {
    u32x4 t; t.x = pk2(a0, a1); t.y = pk2(a2, a3); t.z = pk2(a4, a5); t.w = pk2(a6, a7); return __builtin_bit_cast(bf16x8, t); }
#define GLDS16(gp, lp) __builtin_amdgcn_global_load_lds((const unsigned*)(gp), (LAS unsigned*)(lp), 16, 0, 0)

struct AttDmaOff { unsigned kn[2], kr, vt[2]; };
DI AttDmaOff att_dma_offsets(int w, int lane) {
    AttDmaOff o; const unsigned lr = lane >> 4, pp = lane & 15;
#pragma unroll
    for (int i = 0; i < 2; ++i) { const unsigned q = w * 2 + i, R = 4 * q + lr, cc = pp ^ (R & 15); o.kn[i] = R * 2048u + cc * 16u; }
    { const unsigned q = w, R2 = 4 * q + lr, cc = pp ^ (R2 & 15); o.kr = (2 * R2 + (cc >> 3)) * 128u + (cc & 7) * 16u; }
#pragma unroll
    for (int i = 0; i < 2; ++i) { const unsigned q = w * 2 + i, R2 = 4 * q + lr, cc = pp ^ (R2 & 15); o.vt[i] = (2 * R2 + (cc >> 3)) * (unsigned)(M * 2) + (cc & 7) * 16u; }
    return o;
}
template <bool ROPE>
DI void att_dma(LAS unsigned char* buf, __amdgpu_buffer_rsrc_t rs, const AttDmaOff& o, unsigned k_so, unsigned kr_so, unsigned vt_so, int w) {
#pragma unroll
    for (int i = 0; i < 2; ++i) __builtin_amdgcn_raw_ptr_buffer_load_lds(rs, (LAS void*)(buf + (w * 2 + i) * 1024), 16, o.kn[i], k_so, 0, 0);
    if (ROPE) __builtin_amdgcn_raw_ptr_buffer_load_lds(rs, (LAS void*)(buf + ST_KR + w * 1024), 16, o.kr, kr_so, 0, 0);
#pragma unroll
    for (int i = 0; i < 2; ++i) __builtin_amdgcn_raw_ptr_buffer_load_lds(rs, (LAS void*)(buf + ST_VT + (w * 2 + i) * 1024), 16, o.vt[i], vt_so, 0, 0);
}
DI void att_store(const f32x16 (&o)[4], float scale, bf16_t* O, size_t row, int hd, int h) {
#pragma unroll
    for (int db = 0; db < 4; ++db)
#pragma unroll
        for (int g = 0; g < 4; ++g)
            store_bf16x4(O + row * 1024 + hd * 128 + db * 32 + g * 8 + h * 4, (f32x4){o[db][4 * g] * scale, o[db][4 * g + 1] * scale, o[db][4 * g + 2] * scale, o[db][4 * g + 3] * scale});
}
DI void att_pv(f32x16 (&o)[4], const bf16x8 (&pf)[2][2], const LAS unsigned char* buf, unsigned va) {
#pragma unroll
    for (int db = 0; db < 4; ++db) {
#pragma unroll
        for (int blk = 0; blk < 2; ++blk)
#pragma unroll
            for (int ks = 0; ks < 2; ++ks) o[db] = MFMA32(*(const LAS bf16x8*)(buf + ((va ^ ((blk * 2 + ks) << 5)) + db * 4096)), pf[blk][ks], o[db]);
        asm volatile("" ::: "memory");
    }
}

DI void attn_mla_fast(const Params& p, const Ctx& c) {
    const bf16_t* Q = (const bf16_t*)(p.ws + OFF_Q); const bf16_t* KN = (const bf16_t*)(p.ws + OFF_KN); const bf16_t* KR = (const bf16_t*)(p.ws + OFF_KR);
    const bf16_t* VT = (const bf16_t*)(p.ws + OFF_VT); bf16_t* O = (bf16_t*)(p.ws + OFF_ATTA);
    const int lane = c.lane, r = lane & 31, h = lane >> 5, w = c.wave;
    const int pr = (r & 0x13) | ((r & 4) << 1) | ((r & 8) >> 1);
    const unsigned ka = (pr << 8) | ((((pr & 15) ^ h) & 15) << 4);
    const unsigned ra = ST_KR + (((pr >> 1) << 8) | (((((pr & 1) << 3) | h) ^ ((pr >> 1) & 15)) << 4));
    const unsigned va = ST_VT + (((r >> 1) << 8) | (((((r & 1) << 3) | h) ^ ((r >> 1) & 15)) << 4));
    const __amdgpu_buffer_rsrc_t rs = __builtin_amdgcn_make_buffer_rsrc((void*)p.ws, (short)0, (int)WS_END, 0x00020000);
    const AttDmaOff dof = att_dma_offsets(w, lane);
    for (int it = blockIdx.x; it < 256; it += gridDim.x) {
        const int bh = it & 31, b = bh >> 3, hd = bh & 7, pairi = it >> 5;
#pragma unroll 1
        for (int half = 0; half < 2; ++half) {
            const int qb = half ? 15 - pairi : pairi, q0 = qb * 256;
            const size_t base = (size_t)b * SEQ, qrow = base + q0 + w * 32 + r;
            bf16x8 qf[12];
#pragma unroll
            for (int st = 0; st < 12; ++st) qf[st] = *(const bf16x8*)(Q + qrow * 1536 + hd * 192 + st * 16 + h * 8);
            const int ntile = q0 / 64 + 4, myn = (q0 + w * 32) / 64 + 1;
            f32x16 o[4];
#pragma unroll
            for (int db = 0; db < 4; ++db)
#pragma unroll
                for (int i = 0; i < 16; ++i) o[db][i] = 0.f;
            float mrun = -1e30f, lrun = 0.f;
            __syncthreads();
            const unsigned k_so0 = (unsigned)(OFF_KN + (base * 1024 + hd * 128) * 2), kr_so0 = (unsigned)(OFF_KR + base * 64 * 2), vt_so0 = (unsigned)(OFF_VT + ((size_t)(hd * 128) * M + base) * 2);
            att_dma<true>(c.lds, rs, dof, k_so0, kr_so0, vt_so0, w);
            asm volatile("s_waitcnt vmcnt(0)" ::: "memory");
            __syncthreads();
            for (int j = 0; j < ntile; ++j) {
                LAS unsigned char* buf = c.lds + (j & 1) * ST_BYTES;
                if (j + 1 < ntile) att_dma<true>(c.lds + ((j + 1) & 1) * ST_BYTES, rs, dof, k_so0 + (unsigned)(j + 1) * (64 * 2048), kr_so0 + (unsigned)(j + 1) * (64 * 128), vt_so0 + (unsigned)(j + 1) * 128, w);
                if (j < myn) {
                    f32x16 s0, s1;
#pragma unroll
                    for (int i = 0; i < 16; ++i) { s0[i] = 0.f; s1[i] = 0.f; }
                    __builtin_amdgcn_s_setprio(1);
#pragma unroll
                    for (int st = 0; st < 8; ++st) {
                        s0 = MFMA32(*(const LAS bf16x8*)(buf + (ka ^ (st << 5))), qf[st], s0);
                        s1 = MFMA32(*(const LAS bf16x8*)(buf + ((ka ^ (st << 5)) + 8192)), qf[st], s1);
                    }
#pragma unroll
                    for (int st = 0; st < 4; ++st) {
                        s0 = MFMA32(*(const LAS bf16x8*)(buf + (ra ^ (st << 5))), qf[8 + st], s0);
                        s1 = MFMA32(*(const LAS bf16x8*)(buf + ((ra ^ (st << 5)) + 4096)), qf[8 + st], s1);
                    }
                    __builtin_amdgcn_s_setprio(0);
                    float mx = fmaxf(s0[0], s1[0]);
#pragma unroll
                    for (int i = 1; i < 16; ++i) mx = fmaxf(mx, fmaxf(s0[i], s1[i]));
                    mx = fmaxf(mx, __shfl_xor(mx, 32));
                    const float mnew = fmaxf(mrun, mx), alpha = ex2(mrun - mnew);
                    mrun = mnew;
                    float ps = 0.f;
#pragma unroll
                    for (int i = 0; i < 16; ++i) { s0[i] = ex2(s0[i] - mnew); s1[i] = ex2(s1[i] - mnew); ps += s0[i] + s1[i]; }
                    lrun = lrun * alpha + ps;
#pragma unroll
                    for (int db = 0; db < 4; ++db)
#pragma unroll
                        for (int i = 0; i < 16; ++i) o[db][i] *= alpha;
                    bf16x8 pf[2][2];
                    pf[0][0] = pack8(s0[0], s0[1], s0[2], s0[3], s0[4], s0[5], s0[6], s0[7]); pf[0][1] = pack8(s0[8], s0[9], s0[10], s0[11], s0[12], s0[13], s0[14], s0[15]);
                    pf[1][0] = pack8(s1[0], s1[1], s1[2], s1[3], s1[4], s1[5], s1[6], s1[7]); pf[1][1] = pack8(s1[8], s1[9], s1[10], s1[11], s1[12], s1[13], s1[14], s1[15]);
                    __builtin_amdgcn_s_setprio(1);
                    att_pv(o, pf, buf, va);
                    __builtin_amdgcn_s_setprio(0);
                }
                asm volatile("s_waitcnt vmcnt(0)" ::: "memory");
                __syncthreads();
            }
            const float ltot = lrun + __shfl_xor(lrun, 32);
            att_store(o, 1.f / ltot, O, qrow, hd, h);
        }
    }
}

DI void attn_sb_fast(const Params& p, const Ctx& c) {
    const bf16_t* Q = (const bf16_t*)(p.ws + OFF_SBQ); const bf16_t* K = (const bf16_t*)(p.ws + OFF_SBK);
    const bf16_t* VT = (const bf16_t*)(p.ws + OFF_SBVT); bf16_t* O = (bf16_t*)(p.ws + OFF_ATTB);
    const int lane = c.lane, r = lane & 31, h = lane >> 5, w = c.wave, tid = c.tid;
    const int pr = (r & 0x13) | ((r & 4) << 1) | ((r & 8) >> 1);
    const unsigned ka = (pr << 8) | ((((pr & 15) ^ h) & 15) << 4);
    const unsigned va = ST_VT + (((r >> 1) << 8) | (((((r & 1) << 3) | h) ^ ((r >> 1) & 15)) << 4));
    const __amdgpu_buffer_rsrc_t rs = __builtin_amdgcn_make_buffer_rsrc((void*)p.ws, (short)0, (int)WS_END, 0x00020000);
    const AttDmaOff dof = att_dma_offsets(w, lane);
    LAS int* flags = (LAS int*)(c.lds + ATT_FLAGS);
    for (int it = blockIdx.x; it < 256; it += gridDim.x) {
        const int bh = it & 31, b = bh >> 3, hd = bh & 7, pairi = it >> 5;
#pragma unroll 1
        for (int half = 0; half < 2; ++half) {
            const int qb = half ? 15 - pairi : pairi, q0 = qb * 256;
            const size_t base = (size_t)b * SEQ, qrow = base + q0 + w * 32 + r;
            const int tq = q0 + w * 32 + r;
            bf16x8 qf[8];
#pragma unroll
            for (int st = 0; st < 8; ++st) qf[st] = *(const bf16x8*)(Q + qrow * 1024 + hd * 128 + st * 16 + h * 8);
            const int jmax = q0 / 64 + 3, jd = (q0 + w * 32) / 64;
            f32x16 o[4];
#pragma unroll
            for (int db = 0; db < 4; ++db)
#pragma unroll
                for (int i = 0; i < 16; ++i) o[db][i] = 0.f;
            float carry = 0.f; bool wdone = false;
            __syncthreads();
            const unsigned k_so0 = (unsigned)(OFF_SBK + (base * 1024 + hd * 128) * 2), vt_so0 = (unsigned)(OFF_SBVT + ((size_t)(hd * 128) * M + base) * 2);
            att_dma<false>(c.lds, rs, dof, k_so0 + (unsigned)jmax * (64 * 2048), 0u, vt_so0 + (unsigned)jmax * 128, w);
            if (tid < 16) flags[tid] = 0;
            asm volatile("s_waitcnt vmcnt(0)" ::: "memory");
            __syncthreads();
            int itn = 0;
            for (int j = jmax; j >= 0; --j, ++itn) {
                LAS unsigned char* buf = c.lds + (itn & 1) * ST_BYTES;
                if (j > 0) att_dma<false>(c.lds + ((itn + 1) & 1) * ST_BYTES, rs, dof, k_so0 + (unsigned)(j - 1) * (64 * 2048), 0u, vt_so0 + (unsigned)(j - 1) * 128, w);
                if (j <= jd && !wdone) {
                    f32x16 s0, s1;
#pragma unroll
                    for (int i = 0; i < 16; ++i) { s0[i] = 0.f; s1[i] = 0.f; }
#pragma unroll
                    for (int st = 0; st < 8; ++st) {
                        s0 = MFMA32(*(const LAS bf16x8*)(buf + (ka ^ (st << 5))), qf[st], s0);
                        s1 = MFMA32(*(const LAS bf16x8*)(buf + ((ka ^ (st << 5)) + 8192)), qf[st], s1);
                    }
                    const int kb0 = 64 * j + 8 * h - tq;
                    bf16x8 pf[2][2];
                    {
                        f32x16 l1;
#pragma unroll
                        for (int i = 0; i < 16; ++i) { const float z = s1[i]; const float a = -(fmaxf(z, 0.f) + lg2(1.f + ex2(-fabsf(z)))); l1[i] = (kb0 + 32 + 16 * (i >> 3) + (i & 7) < 0) ? a : 0.f; }
                        float g0 = 0.f, g1 = 0.f;
#pragma unroll
                        for (int e = 0; e < 8; ++e) { g0 += l1[e]; g1 += l1[8 + e]; }
                        const float p0 = __shfl_xor(g0, 32), p1 = __shfl_xor(g1, 32);
                        float run = carry + (h == 0 ? p1 : 0.f);
#pragma unroll
                        for (int e = 7; e >= 0; --e) { run += l1[8 + e]; l1[8 + e] = run; }
                        run = carry + (g1 + p1) + (h == 0 ? p0 : 0.f);
#pragma unroll
                        for (int e = 7; e >= 0; --e) { run += l1[e]; l1[e] = run; }
                        carry += (g1 + p1) + (g0 + p0);
#pragma unroll
                        for (int i = 0; i < 16; ++i) { const float wv = ex2(s1[i] + l1[i]); s1[i] = (kb0 + 32 + 16 * (i >> 3) + (i & 7) < 0) ? wv : 0.f; }
                        pf[1][0] = pack8(s1[0], s1[1], s1[2], s1[3], s1[4], s1[5], s1[6], s1[7]); pf[1][1] = pack8(s1[8], s1[9], s1[10], s1[11], s1[12], s1[13], s1[14], s1[15]);
                    }
                    {
                        f32x16 l0;
#pragma unroll
                        for (int i = 0; i < 16; ++i) { const float z = s0[i]; const float a = -(fmaxf(z, 0.f) + lg2(1.f + ex2(-fabsf(z)))); l0[i] = (kb0 + 16 * (i >> 3) + (i & 7) < 0) ? a : 0.f; }
                        float g0 = 0.f, g1 = 0.f;
#pragma unroll
                        for (int e = 0; e < 8; ++e) { g0 += l0[e]; g1 += l0[8 + e]; }
                        const float p0 = __shfl_xor(g0, 32), p1 = __shfl_xor(g1, 32);
                        float run = carry + (h == 0 ? p1 : 0.f);
#pragma unroll
                        for (int e = 7; e >= 0; --e) { run += l0[8 + e]; l0[8 + e] = run; }
                        run = carry + (g1 + p1) + (h == 0 ? p0 : 0.f);
#pragma unroll
                        for (int e = 7; e >= 0; --e) { run += l0[e]; l0[e] = run; }
                        carry += (g1 + p1) + (g0 + p0);
#pragma unroll
                        for (int i = 0; i < 16; ++i) { const float wv = ex2(s0[i] + l0[i]); s0[i] = (kb0 + 16 * (i >> 3) + (i & 7) < 0) ? wv : 0.f; }
                        pf[0][0] = pack8(s0[0], s0[1], s0[2], s0[3], s0[4], s0[5], s0[6], s0[7]); pf[0][1] = pack8(s0[8], s0[9], s0[10], s0[11], s0[12], s0[13], s0[14], s0[15]);
                    }
                    att_pv(o, pf, buf, va);
                    wdone = __all(carry < -150.f);
                }
                if (lane == 0) flags[(itn & 1) * 8 + w] = wdone ? 1 : 0;
                asm volatile("s_waitcnt vmcnt(0)" ::: "memory");
                __syncthreads();
                int alld = 1;
#pragma unroll
                for (int q = 0; q < 8; ++q) alld &= flags[(itn & 1) * 8 + q];
                if (alld) break;
            }
            att_store(o, 1.f, O, qrow, hd, h);
        }
    }
}
#ifndef FAST_ATTN
#define FAST_ATTN 1
#endif

constexpr int SEL_LD = 260;
DI void topk_insert(float (&a)[16], float x) {
#pragma unroll
    for (int i = 15; i >= 1; --i) a[i] = __builtin_amdgcn_fmed3f(a[i - 1], a[i], x);
    a[0] = fmaxf(a[0], x);
}
struct SelMap { int mode, a0, a1, a2, a3; };
DI void sel_decode(const SelMap& mp, int q, int& t0, int& hd) {
    if (mp.mode == 0) { int u = mp.a0 + q * mp.a1; if (u >= 128 * 8) u = mp.a0; hd = u & 7; t0 = (u >> 3) * 128; }
    else { const int pm = (q >> 1) ? mp.a2 : mp.a0, pn = (q >> 1) ? mp.a3 : mp.a1; hd = pn; t0 = pm * 256 + (q & 1) * 128; }
}
template <int NU> DI void select_stage2(const Params& p, const Ctx& c, const SelMap mp, const LAS float* lst_all) {
    if (c.tid < 128 * NU) {
        const int tok = c.tid & 127, un = c.tid >> 7;
        int t0, hd; sel_decode(mp, un, t0, hd);
        const LAS float* lst = lst_all + un * 4096;
        float v1[16], v2[16];
#pragma unroll
        for (int i = 0; i < 16; ++i) { v1[i] = __uint_as_float(__float_as_uint(lst[(tok * 2) * 16 + i]) & ~127u); v2[i] = __uint_as_float(__float_as_uint(lst[(tok * 2 + 1) * 16 + i]) & ~127u); }
        float bb[16];
#pragma unroll
        for (int i = 0; i < 16; ++i) bb[i] = -__builtin_inff();
#pragma unroll
        for (int i = 0; i < 16; ++i)
#pragma unroll
            for (int j = 0; j < 16; ++j)
                if ((i + 1) * (j + 1) <= 16) topk_insert(bb, __uint_as_float((__float_as_uint(v1[i] + v2[j]) & ~255u) | (unsigned)(i * 16 + j)));
        float sv[16], mxv = -__builtin_inff(), sum = 0.f;
#pragma unroll
        for (int i = 0; i < 16; ++i) { sv[i] = __uint_as_float(__float_as_uint(bb[i]) & ~255u); mxv = fmaxf(mxv, sv[i]); }
#pragma unroll
        for (int i = 0; i < 16; ++i) { sv[i] = __expf(sv[i] - mxv); sum += sv[i]; }
        const float inv = 1.f / sum;
        int* idx = (int*)(p.ws + OFF_IDX) + (size_t)(t0 + tok) * 128 + hd * 16; float* gw = (float*)(p.ws + OFF_GW) + (size_t)(t0 + tok) * 128 + hd * 16;
#pragma unroll
        for (int i = 0; i < 16; ++i) {
            const unsigned code = __float_as_uint(bb[i]) & 255u;
            const unsigned e1 = __float_as_uint(lst[(tok * 2) * 16 + (code >> 4)]) & 127u, e2 = __float_as_uint(lst[(tok * 2 + 1) * 16 + (code & 15u)]) & 127u;
            idx[i] = (int)(e1 * 128u + e2); gw[i] = sv[i] * inv;
        }
    }
    __syncthreads();
}
DI void select_tail(const Params& p, const Ctx& c, int t0, int hd) {
    LAS float* sc = (LAS float*)c.lds; LAS float* lst = sc + 128 * SEL_LD;
    if (c.tid < 256) {
        const int tok = c.tid >> 1, hf = c.tid & 1;
        float a[16];
#pragma unroll
        for (int i = 0; i < 16; ++i) a[i] = -__builtin_inff();
        const LAS float* row = sc + tok * SEL_LD + hf * 128;
#pragma unroll 4
        for (int n4 = 0; n4 < 32; ++n4) {
            const f32x4 v = *(const LAS f32x4*)(row + n4 * 4);
#pragma unroll
            for (int e = 0; e < 4; ++e) topk_insert(a, __uint_as_float((__float_as_uint(v[e]) & ~127u) | (unsigned)(n4 * 4 + e)));
        }
#pragma unroll
        for (int i = 0; i < 16; ++i) lst[(tok * 2 + hf) * 16 + i] = a[i];
    }
    __syncthreads();
    select_stage2<1>(p, c, SelMap{0, ((t0 >> 7) << 3) | hd, 0, 0, 0}, lst);
}
DI void select_naive(const Params& p, const Ctx& c) {
    const bf16_t* PQ = (const bf16_t*)(p.ws + OFF_PQ); const bf16_t* KEYS = (const bf16_t*)(p.ws + OFF_KEYS);
    LAS float* sc = (LAS float*)c.lds;
    for (int u = blockIdx.x; u < 128 * 8; u += gridDim.x) {
        const int hd = u & 7, t0 = (u >> 3) * 128;
        const int tok = c.tid >> 2, part = c.tid & 3, hf = part >> 1, n0 = (part & 1) * 64;
        const bf16_t* qrow = PQ + (size_t)hd * M * 256 + (size_t)(t0 + tok) * 256 + hf * 128;
        const bf16_t* kb = KEYS + (size_t)((hd * 2 + hf) * 128 + n0) * 128;
        for (int n = 0; n < 64; ++n) {
            float acc = 0.f;
#pragma unroll
            for (int d8 = 0; d8 < 16; ++d8) {
                const u32x4 a = *(const u32x4*)(qrow + d8 * 8), b = *(const u32x4*)(kb + (size_t)n * 128 + d8 * 8);
#pragma unroll
                for (int e = 0; e < 4; ++e) acc += bflo(a[e]) * bflo(b[e]) + bfhi(a[e]) * bfhi(b[e]);
            }
            sc[tok * SEL_LD + hf * 128 + n0 + n] = acc;
        }
        __syncthreads();
        select_tail(p, c, t0, hd);
    }
}


DI void select_batch(const Params& p, const Ctx& c, const SelMap mp) {
    const bf16_t* PQ = (const bf16_t*)(p.ws + OFF_PQ); const bf16_t* KEYS = (const bf16_t*)(p.ws + OFF_KEYS);
    LAS float* lst_all = (LAS float*)c.lds;
    const int lane = c.lane, r = lane & 31, h = lane >> 5, w = c.wave, tb = w & 3, hf = w >> 2;
#pragma unroll
    for (int q = 0; q < 4; ++q) {
        int t0, hd; sel_decode(mp, q, t0, hd);
        LAS float* lst = lst_all + q * 4096;
        const bf16_t* qrow = PQ + (size_t)hd * M * 256 + (size_t)(t0 + tb * 32 + r) * 256 + hf * 128 + h * 8;
        const bf16_t* kbase = KEYS + (size_t)((hd * 2 + hf) * 128 + r) * 128 + h * 8;
        bf16x8 qf[8];
#pragma unroll
        for (int st = 0; st < 8; ++st) qf[st] = *(const bf16x8*)(qrow + st * 16);
        float a[16];
#pragma unroll
        for (int i = 0; i < 16; ++i) a[i] = -__builtin_inff();
#pragma unroll
        for (int kb = 0; kb < 4; ++kb) {
            f32x16 sc;
#pragma unroll
            for (int i = 0; i < 16; ++i) sc[i] = 0.f;
#pragma unroll
            for (int st = 0; st < 8; ++st) sc = MFMA32(*(const bf16x8*)(kbase + (size_t)kb * 32 * 128 + st * 16), qf[st], sc);
#pragma unroll
            for (int i = 0; i < 16; ++i) topk_insert(a, __uint_as_float((__float_as_uint(sc[i]) & ~127u) | (unsigned)(kb * 32 + (i & 3) + 8 * (i >> 2) + 4 * h)));
        }
        float bq[16];
#pragma unroll
        for (int i = 0; i < 16; ++i) bq[i] = __shfl_xor(a[i], 32);
#pragma unroll
        for (int i = 0; i < 16; ++i) topk_insert(a, bq[i]);
        if (h == 0) {
#pragma unroll
            for (int i = 0; i < 16; ++i) lst[((tb * 32 + r) * 2 + hf) * 16 + i] = a[i];
        }
    }
    __syncthreads();
    select_stage2<4>(p, c, mp, lst_all);
}
DI void select_fast(const Params& p, const Ctx& c) {
    for (int u0 = blockIdx.x; u0 < 128 * 8; u0 += 4 * gridDim.x) select_batch(p, c, SelMap{0, u0, (int)gridDim.x, 0, 0});
}
DI void select_own_tiles(const Params& p, const Ctx& c) {
    pg8::StaticOrder S; S.init(M, 2048, (int)gridDim.x, (int)blockIdx.x);
    asm volatile("s_waitcnt vmcnt(0)" ::: "memory");
    __syncthreads();
    if (c.tid == 0) { __builtin_amdgcn_fence(__ATOMIC_ACQUIRE, "agent"); asm volatile("s_waitcnt vmcnt(0)" ::: "memory"); }
    __syncthreads();
    for (int i = 0;; i += 2) {
        pg8::Unit u0, u1;
        if (!S.next(i, u0)) break;
        if (!S.next(i + 1, u1)) u1 = u0;
        select_batch(p, c, SelMap{1, u0.pm, u0.pn, u1.pm, u1.pn});
    }
}
#ifndef FAST_SEL
#define FAST_SEL 1
#endif

DI void phase_gather(const Params& p, const Ctx& c, float* dst, int rowmask = -1) {
    const bf16_t* H2 = (const bf16_t*)(p.ws + OFF_H); const unsigned char* U = p.ws + OFF_U16; const unsigned char* V = p.ws + OFF_V16;
    const int* IDX = (const int*)(p.ws + OFF_IDX); const float* GW = (const float*)(p.ws + OFF_GW); const float* mod = (const float*)(p.ws + OFF_MOD);
    constexpr int G = 8, GV = 16;
    const int lane = c.lane;
    unsigned* tokctr = (unsigned*)(p.ws + OFF_CTL) + 700;
    constexpr int NSTATIC = 6;
    LAS int* park = (LAS int*)(c.lds + c.wave * 20480);
    for (int it = 0;; ++it) {
        int m, slot; bool doU, doV;
        if (it < NSTATIC) { slot = it; m = c.gw + it * c.ngw; doU = true; doV = false; }
        else if (it < 2 * NSTATIC) { slot = it - NSTATIC; m = c.gw + slot * c.ngw; doU = false; doV = true; }
        else { unsigned t = 0; if (lane == 0) t = __hip_atomic_fetch_add(tokctr, 1u, __ATOMIC_RELAXED, __HIP_MEMORY_SCOPE_AGENT); m = NSTATIC * c.ngw + (int)__builtin_amdgcn_readfirstlane(t); if (m >= M) break; slot = 0; doU = true; doV = true; }
        if (m >= M) continue;
        const int b = m / SEQ;
        LAS int* ps = park + slot * 256;
        int ia = 0, ib = 0; float wa = 0.f, wb = 0.f;
        if (doU) {
        f32x2 hf[16];
#pragma unroll
        for (int i = 0; i < 4; ++i) { const u32x4 a = *(const u32x4*)(H2 + (size_t)m * D + lane * 32 + i * 8);
#pragma unroll
            for (int q = 0; q < 4; ++q) hf[4 * i + q] = (f32x2){bflo(a[q]), bfhi(a[q])}; }
        ia = IDX[(size_t)m * 128 + lane]; ib = IDX[(size_t)m * 128 + 64 + lane];
        const float ga = GW[(size_t)m * 128 + lane], gb = GW[(size_t)m * 128 + 64 + lane];
#pragma unroll 1
        for (int k0 = 0; k0 < 128; k0 += G) {
            u32x4 ua[G]; u32x2 ub[G];
#pragma unroll
            for (int g = 0; g < G; ++g) {
                const int e = __builtin_amdgcn_readlane(k0 < 64 ? ia : ib, (k0 + g) & 63) & rowmask;
                const unsigned char* ur = U + (size_t)e * 1536;
                ua[g] = *(const u32x4*)(ur + (unsigned)lane * 16u); ub[g] = *(const u32x2*)(ur + 1024u + (unsigned)lane * 8u);
            }
            float d[G];
#pragma unroll
            for (int g = 0; g < G; ++g) {
                const f32x32v f = __builtin_amdgcn_cvt_scalef32_pk32_f32_fp6((u32x6){ua[g][0], ua[g][1], ua[g][2], ua[g][3], ub[g][0], ub[g][1]}, 1.0f);
                f32x2 d2 = {0.f, 0.f};
#pragma unroll
                for (int i = 0; i < 16; ++i) d2 = (f32x2){f[2 * i], f[2 * i + 1]} * hf[i] + d2;
                d[g] = d2.x + d2.y;
            }
            { const bool u5 = lane & 32, u4 = lane & 16, u3 = lane & 8;
              float r4[4];
#pragma unroll
              for (int i = 0; i < 4; ++i) { const float send = u5 ? d[i] : d[4 + i], keep = u5 ? d[4 + i] : d[i]; r4[i] = keep + __shfl_xor(send, 32); }
              float r2[2];
#pragma unroll
              for (int i = 0; i < 2; ++i) { const float send = u4 ? r4[i] : r4[2 + i], keep = u4 ? r4[2 + i] : r4[i]; r2[i] = keep + __shfl_xor(send, 16); }
              const float send = u3 ? r2[0] : r2[1], keep = u3 ? r2[1] : r2[0];
              float r1 = keep + __shfl_xor(send, 8);
              r1 += __shfl_xor(r1, 4); r1 += __shfl_xor(r1, 2); r1 += __shfl_xor(r1, 1);
              const float act = gelu_tanh(r1 * (1.f / U8_SCALE)) * (1.f / V8_SCALE);
              const int gsel = lane - (k0 & 63);
              const int src = ((gsel & 4) << 3) | ((gsel & 2) << 3) | ((gsel & 1) << 3);
              const float got = __shfl(act, src & 63);
              if (gsel >= 0 && gsel < G) { if (k0 < 64) wa = got * ga; else wb = got * gb; }
            }
        }
        ps[lane] = ia; ps[64 + lane] = ib; ps[128 + lane] = __builtin_bit_cast(int, wa); ps[192 + lane] = __builtin_bit_cast(int, wb);
        }
        if (!doV) continue;
        if (!doU) { ia = ps[lane]; ib = ps[64 + lane]; wa = __builtin_bit_cast(float, ps[128 + lane]); wb = __builtin_bit_cast(float, ps[192 + lane]); }
        f32x2 acc[16];
#pragma unroll
        for (int i = 0; i < 16; ++i) acc[i] = (f32x2){0.f, 0.f};
#define VB_ISSUE(P, K0) do { _Pragma("unroll") for (int g = 0; g < 8; ++g) { \
            const int e = __builtin_amdgcn_readlane((K0) < 64 ? ia : ib, ((K0) + g) & 63) & rowmask; \
            P##w[g] = __builtin_bit_cast(float, __builtin_amdgcn_readlane(__builtin_bit_cast(int, (K0) < 64 ? wa : wb), ((K0) + g) & 63)); \
            const unsigned char* vr = V + (size_t)e * 1536; \
            P##a[g] = *(const u32x4*)(vr + (unsigned)lane * 16u); P##b[g] = *(const u32x2*)(vr + 1024u + (unsigned)lane * 8u); } } while (0)
#define VB_COMPUTE(P) do { _Pragma("unroll") for (int g = 0; g < 8; ++g) { const f32x2 w2 = {P##w[g], P##w[g]}; \
            const f32x32v f = __builtin_amdgcn_cvt_scalef32_pk32_f32_fp6((u32x6){P##a[g][0], P##a[g][1], P##a[g][2], P##a[g][3], P##b[g][0], P##b[g][1]}, 1.0f); \
            _Pragma("unroll") for (int i = 0; i < 16; ++i) acc[i] = (f32x2){f[2 * i], f[2 * i + 1]} * w2 + acc[i]; } } while (0)
        {
            u32x4 A_a[8], B_a[8]; u32x2 A_b[8], B_b[8]; float A_w[8], B_w[8];
            VB_ISSUE(A_, 0);
#pragma unroll 1
            for (int k0 = 0; k0 < 128; k0 += 16) {
                VB_ISSUE(B_, k0 + 8);
                VB_COMPUTE(A_);
                if (k0 + 16 < 128) VB_ISSUE(A_, k0 + 16);
                VB_COMPUTE(B_);
            }
        }
#undef VB_ISSUE
#undef VB_COMPUTE
        const float* orow = p.out + (size_t)m * D + lane * 32; float* drow = dst + (size_t)m * D + lane * 32; const float* gt2 = mod + b * 6 * D + 5 * D + lane * 32; const float* fg = p.fng + lane * 32;
        float ss = 0.f; f32x4 xv[8];
#pragma unroll
        for (int i = 0; i < 8; ++i) {
            const f32x4 xa = *(const f32x4*)(orow + 4 * i), ta = *(const f32x4*)(gt2 + 4 * i);
            const f32x4 pe = {acc[2 * i].x, acc[2 * i].y, acc[2 * i + 1].x, acc[2 * i + 1].y};
            const f32x4 v = xa + DBG_BETA * ta * pe; xv[i] = v; ss += (v[0] * v[0] + v[1] * v[1]) + (v[2] * v[2] + v[3] * v[3]);
        }
        const float rstd = rsqrtf(wave_sum(ss) * (1.f / D) + EPS);
#pragma unroll
        for (int i = 0; i < 8; ++i) *(f32x4*)(drow + 4 * i) = xv[i] * rstd * *(const f32x4*)(fg + 4 * i);
    }
}


DI void phase_gather_sorted(const Params& p, const Ctx& c) {
    const bf16_t* H2 = (const bf16_t*)(p.ws + OFF_H); const unsigned char* U = p.ws + OFF_U16; const unsigned char* V = p.ws + OFF_V16;
    const int* IDX = (const int*)(p.ws + OFF_IDX); const float* GW = (const float*)(p.ws + OFF_GW); const float* mod = (const float*)(p.ws + OFF_MOD);
    const int lane = c.lane;
    LAS unsigned char* wl = c.lds + c.wave * 20480;
    constexpr int RSH = 12;
    const bool u5 = lane & 32, u4 = lane & 16, u3 = lane & 8;
#pragma unroll 1
    for (int grp = 0; grp < 2; ++grp) {
#pragma unroll 1
        for (int t = 0; t < 4; ++t) {
            const int m = c.gw + (grp * 4 + t) * c.ngw;
            if (m >= M) continue;
            const int ia = IDX[(size_t)m * 128 + lane], ib = IDX[(size_t)m * 128 + 64 + lane];
            const float ga = GW[(size_t)m * 128 + lane], gb = GW[(size_t)m * 128 + 64 + lane];
            const int ra = ia >> RSH, rb = ib >> RSH;
            int off = 0, posA = 0, posB = 0;
#pragma unroll
            for (int r = 0; r < 4; ++r) {
                const unsigned long long mA = __ballot(ra == r), mB = __ballot(rb == r);
                const int cA = __builtin_popcountll(mA), cB = __builtin_popcountll(mB);
                const int rkA = __builtin_amdgcn_mbcnt_hi((unsigned)(mA >> 32), __builtin_amdgcn_mbcnt_lo((unsigned)mA, 0u));
                const int rkB = __builtin_amdgcn_mbcnt_hi((unsigned)(mB >> 32), __builtin_amdgcn_mbcnt_lo((unsigned)mB, 0u));
                posA = (ra == r) ? off + rkA : posA; posB = (rb == r) ? off + cA + rkB : posB; off += cA + cB;
            }
            LAS int* sE = (LAS int*)(wl + t * 1024); LAS float* sW = (LAS float*)(wl + t * 1024 + 512);
            sE[posA] = ia; sE[posB] = ib; sW[posA] = ga; sW[posB] = gb;
            LAS u32x4* hrow = (LAS u32x4*)(wl + 4096 + t * 4096 + lane * 64);
#pragma unroll
            for (int i = 0; i < 4; ++i) hrow[i] = *(const u32x4*)(H2 + (size_t)m * D + lane * 32 + i * 8);
        }
        asm volatile("s_waitcnt lgkmcnt(0)" ::: "memory");
#pragma unroll 1
        for (int vi = 0; vi < 16; ++vi) {
            {
                const int r = vi >> 2, t = vi & 3;
                const int m = c.gw + (grp * 4 + t) * c.ngw;
                if (m >= M) continue;
                LAS int* sE = (LAS int*)(wl + t * 1024); LAS float* sW = (LAS float*)(wl + t * 1024 + 512);
                const int eLo = sE[lane], eHi = sE[64 + lane];
                const unsigned long long mLo = __ballot((eLo >> RSH) == r), mHi = __ballot((eHi >> RSH) == r);
                if (!(mLo | mHi)) continue;
                const int s0 = mLo ? __builtin_ctzll(mLo) : 64 + __builtin_ctzll(mHi);
                const int e1 = s0 + __builtin_popcountll(mLo) + __builtin_popcountll(mHi);
                float wLo = sW[lane], wHi = sW[64 + lane];
                f32x2 hf[16];
                { const LAS u32x4* hrow = (const LAS u32x4*)(wl + 4096 + t * 4096 + lane * 64);
#pragma unroll
                  for (int i = 0; i < 4; ++i) { const u32x4 a = hrow[i];
#pragma unroll
                    for (int q = 0; q < 4; ++q) hf[4 * i + q] = (f32x2){bflo(a[q]), bfhi(a[q])}; } }
#pragma unroll 1
                for (int j0 = s0; j0 < e1; j0 += 8) {
                    u32x4 ua[8]; u32x2 ub[8];
#pragma unroll
                    for (int g = 0; g < 8; ++g) {
                        const int pos = j0 + g;
                        ua[g] = (u32x4){0u, 0u, 0u, 0u}; ub[g] = (u32x2){0u, 0u};
                        if (pos < e1) {
                            const int e = __builtin_amdgcn_readlane(pos < 64 ? eLo : eHi, pos & 63);
                            const unsigned char* ur = U + (size_t)e * 1536;
                            ua[g] = *(const u32x4*)(ur + (unsigned)lane * 16u); ub[g] = *(const u32x2*)(ur + 1024u + (unsigned)lane * 8u);
                        }
                    }
                    float d[8];
#pragma unroll
                    for (int g = 0; g < 8; ++g) {
                        d[g] = 0.f;
                        if (j0 + g < e1) {
                            const f32x32v f = __builtin_amdgcn_cvt_scalef32_pk32_f32_fp6((u32x6){ua[g][0], ua[g][1], ua[g][2], ua[g][3], ub[g][0], ub[g][1]}, 1.0f);
                            f32x2 d2 = {0.f, 0.f};
#pragma unroll
                            for (int i = 0; i < 16; ++i) d2 = (f32x2){f[2 * i], f[2 * i + 1]} * hf[i] + d2;
                            d[g] = d2.x + d2.y;
                        }
                    }
                    float r4[4];
#pragma unroll
                    for (int i = 0; i < 4; ++i) { const float send = u5 ? d[i] : d[4 + i], keep = u5 ? d[4 + i] : d[i]; r4[i] = keep + __shfl_xor(send, 32); }
                    float r2[2];
#pragma unroll
                    for (int i = 0; i < 2; ++i) { const float send = u4 ? r4[i] : r4[2 + i], keep = u4 ? r4[2 + i] : r4[i]; r2[i] = keep + __shfl_xor(send, 16); }
                    const float send = u3 ? r2[0] : r2[1], keep = u3 ? r2[1] : r2[0];
                    float r1 = keep + __shfl_xor(send, 8);
                    r1 += __shfl_xor(r1, 4); r1 += __shfl_xor(r1, 2); r1 += __shfl_xor(r1, 1);
                    const float act = gelu_tanh(r1 * (1.f / U8_SCALE)) * (1.f / V8_SCALE);
                    const bool inLo = (lane >= j0) && (lane < j0 + 8);
                    const int gsel = inLo ? lane - j0 : lane + 64 - j0;
                    const int src = ((gsel & 4) << 3) | ((gsel & 2) << 3) | ((gsel & 1) << 3);
                    const float got = __shfl(act, src & 63);
                    if (gsel >= 0 && gsel < 8 && j0 + gsel < e1) { if (inLo) wLo = got * wLo; else wHi = got * wHi; }
                }
                sW[lane] = wLo; sW[64 + lane] = wHi;
            }
        }
        asm volatile("s_waitcnt lgkmcnt(0)" ::: "memory");
#pragma unroll 1
        for (int r = 0; r < 4; ++r) {
#pragma unroll 1
            for (int t = 0; t < 4; ++t) {
                const int m = c.gw + (grp * 4 + t) * c.ngw;
                if (m >= M) continue;
                LAS int* sE = (LAS int*)(wl + t * 1024); LAS float* sW = (LAS float*)(wl + t * 1024 + 512);
                LAS u32x4* pk = (LAS u32x4*)(wl + 4096 + t * 4096 + lane * 64);
                const int eLo = sE[lane], eHi = sE[64 + lane]; const float wLo = sW[lane], wHi = sW[64 + lane];
                const unsigned long long mLo = __ballot((eLo >> RSH) == r), mHi = __ballot((eHi >> RSH) == r);
                const int s0 = mLo ? __builtin_ctzll(mLo) : (mHi ? 64 + __builtin_ctzll(mHi) : 0);
                const int e1 = s0 + __builtin_popcountll(mLo) + __builtin_popcountll(mHi);
                f32x2 acc[16];
                if (r == 0) {
#pragma unroll
                    for (int i = 0; i < 16; ++i) acc[i] = (f32x2){0.f, 0.f};
                } else {
#pragma unroll
                    for (int i = 0; i < 4; ++i) { const u32x4 a = pk[i];
#pragma unroll
                        for (int q = 0; q < 4; ++q) acc[4 * i + q] = (f32x2){bflo(a[q]), bfhi(a[q])}; }
                }
#define SV_ISSUE(P, J0) do { _Pragma("unroll") for (int g = 0; g < 8; ++g) { const int pos = (J0) + g; P##w[g] = 0.f; P##a[g] = (u32x4){0u, 0u, 0u, 0u}; P##b[g] = (u32x2){0u, 0u}; \
                        if (pos < e1) { const int e = __builtin_amdgcn_readlane(pos < 64 ? eLo : eHi, pos & 63); \
                            P##w[g] = __builtin_bit_cast(float, __builtin_amdgcn_readlane(__builtin_bit_cast(int, pos < 64 ? wLo : wHi), pos & 63)); \
                            const unsigned char* vr = V + (size_t)e * 1536; P##a[g] = *(const u32x4*)(vr + (unsigned)lane * 16u); P##b[g] = *(const u32x2*)(vr + 1024u + (unsigned)lane * 8u); } } } while (0)
#define SV_COMPUTE(P, J0) do { _Pragma("unroll") for (int g = 0; g < 8; ++g) if ((J0) + g < e1) { const f32x2 w2 = {P##w[g], P##w[g]}; \
                        const f32x32v f = __builtin_amdgcn_cvt_scalef32_pk32_f32_fp6((u32x6){P##a[g][0], P##a[g][1], P##a[g][2], P##a[g][3], P##b[g][0], P##b[g][1]}, 1.0f); \
                        _Pragma("unroll") for (int i = 0; i < 16; ++i) acc[i] = (f32x2){f[2 * i], f[2 * i + 1]} * w2 + acc[i]; } } while (0)
                if (s0 < e1) {
                    u32x4 A_a[8], B_a[8]; u32x2 A_b[8], B_b[8]; float A_w[8], B_w[8];
                    SV_ISSUE(A_, s0);
#pragma unroll 1
                    for (int j0 = s0; j0 < e1; j0 += 16) {
                        if (j0 + 8 < e1) SV_ISSUE(B_, j0 + 8);
                        SV_COMPUTE(A_, j0);
                        if (j0 + 16 < e1) SV_ISSUE(A_, j0 + 16);
                        if (j0 + 8 < e1) SV_COMPUTE(B_, j0 + 8);
                    }
                }
#undef SV_ISSUE
#undef SV_COMPUTE
                if (r < 3) {
#pragma unroll
                    for (int i = 0; i < 4; ++i) pk[i] = (u32x4){pk2(acc[4 * i].x, acc[4 * i].y), pk2(acc[4 * i + 1].x, acc[4 * i + 1].y), pk2(acc[4 * i + 2].x, acc[4 * i + 2].y), pk2(acc[4 * i + 3].x, acc[4 * i + 3].y)};
                } else {
                    const int b = m / SEQ;
                    float* orow = p.out + (size_t)m * D + lane * 32; const float* gt2 = mod + b * 6 * D + 5 * D + lane * 32; const float* fg = p.fng + lane * 32;
                    float ss = 0.f; f32x4 xv[8];
#pragma unroll
                    for (int i = 0; i < 8; ++i) {
                        const f32x4 xa = *(const f32x4*)(orow + 4 * i), ta = *(const f32x4*)(gt2 + 4 * i);
                        const f32x4 pe = {acc[2 * i].x, acc[2 * i].y, acc[2 * i + 1].x, acc[2 * i + 1].y};
                        const f32x4 v = xa + DBG_BETA * ta * pe; xv[i] = v; ss += (v[0] * v[0] + v[1] * v[1]) + (v[2] * v[2] + v[3] * v[3]);
                    }
                    const float rstd = rsqrtf(wave_sum(ss) * (1.f / D) + EPS);
#pragma unroll
                    for (int i = 0; i < 8; ++i) *(f32x4*)(orow + 4 * i) = xv[i] * rstd * *(const f32x4*)(fg + 4 * i);
                }
            }
        }
        asm volatile("s_waitcnt lgkmcnt(0)" ::: "memory");
    }
}
#ifndef GATHER_SORTED
#define GATHER_SORTED 1
#endif

struct XcdBarrier; DI void xcd_barrier(const XcdBarrier& b, int wave_s);
DI int rl2r(int a, int b, int k) { const int va = __builtin_amdgcn_readlane(a, k & 63), vb = __builtin_amdgcn_readlane(b, k & 63); return k < 64 ? va : vb; }
DI void phase_gather_rounds(const Params& p, const Ctx& c, const XcdBarrier& xbar) {
    const bf16_t* H2 = (const bf16_t*)(p.ws + OFF_H); const unsigned char* U = p.ws + OFF_U16; const unsigned char* V = p.ws + OFF_V16;
    const int* IDX = (const int*)(p.ws + OFF_IDX); const float* GW = (const float*)(p.ws + OFF_GW); const float* mod = (const float*)(p.ws + OFF_MOD);
    const int lane = c.lane;
    LAS unsigned char* wl = c.lds + c.wave * 20480;
    const bool u5 = lane & 32, u4 = lane & 16, u3 = lane & 8;
    constexpr int G = 8;
#pragma unroll 1
    for (int pass = 0; pass < 2; ++pass) {
#pragma unroll
        for (int t = 0; t < 4; ++t) {
            const int m = c.gw + (pass * 4 + t) * c.ngw;
            LAS unsigned char* ts = wl + t * 5120;
            if (m < M) {
#pragma unroll
                for (int i = 0; i < 4; ++i) *(LAS u32x4*)(ts + lane * 64 + i * 16) = *(const u32x4*)(H2 + (size_t)m * D + lane * 32 + i * 8);
                *(LAS int*)(ts + 4096 + lane * 4) = IDX[(size_t)m * 128 + lane]; *(LAS int*)(ts + 4096 + 256 + lane * 4) = IDX[(size_t)m * 128 + 64 + lane];
                *(LAS float*)(ts + 4608 + lane * 4) = GW[(size_t)m * 128 + lane]; *(LAS float*)(ts + 4608 + 256 + lane * 4) = GW[(size_t)m * 128 + 64 + lane];
            }
        }
        asm volatile("s_waitcnt vmcnt(0) lgkmcnt(0)" ::: "memory");
#pragma unroll 1
        for (int r = 0; r < 8; ++r) {
#pragma unroll 1
            for (int t = 0; t < 4; ++t) {
                if (c.gw + (pass * 4 + t) * c.ngw >= M) continue;
                LAS unsigned char* ts = wl + t * 5120;
                const int ia = *(LAS int*)(ts + 4096 + lane * 4), ib = *(LAS int*)(ts + 4096 + 256 + lane * 4);
                unsigned long long ma = __ballot((ia >> 11) == r), mb = __ballot((ib >> 11) == r);
                if (!(ma | mb)) continue;
                f32x2 hf[16];
#pragma unroll
                for (int i = 0; i < 4; ++i) { const u32x4 a = *(LAS u32x4*)(ts + lane * 64 + i * 16);
#pragma unroll
                    for (int q = 0; q < 4; ++q) hf[4 * i + q] = (f32x2){bflo(a[q]), bfhi(a[q])}; }
                float wa = 0.f, wb = 0.f; const unsigned long long ma0 = ma, mb0 = mb;
                while (ma | mb) {
                    u32x4 ua[G]; u32x2 ub[G]; int kk[G]; int n = 0;
#pragma unroll
                    for (int g = 0; g < G; ++g) {
                        int k = (g == 0) ? 0 : kk[g - 1];
                        if (ma) { k = __builtin_ctzll(ma); ma &= ma - 1; ++n; } else if (mb) { k = 64 + __builtin_ctzll(mb); mb &= mb - 1; ++n; }
                        kk[g] = k;
                        const int e = rl2r(ia, ib, k);
                        const unsigned char* ur = U + (size_t)e * 1536;
                        ua[g] = *(const u32x4*)(ur + (unsigned)lane * 16u); ub[g] = *(const u32x2*)(ur + 1024u + (unsigned)lane * 8u);
                    }
                    float d[G];
#pragma unroll
                    for (int g = 0; g < G; ++g) {
                        d[g] = 0.f;
                        if (g < n) {
                            const f32x32v f = __builtin_amdgcn_cvt_scalef32_pk32_f32_fp6((u32x6){ua[g][0], ua[g][1], ua[g][2], ua[g][3], ub[g][0], ub[g][1]}, 1.0f);
                            f32x2 d0 = {0.f, 0.f}, d1 = {0.f, 0.f};
#pragma unroll
                            for (int i = 0; i < 8; ++i) { d0 = (f32x2){f[4 * i], f[4 * i + 1]} * hf[2 * i] + d0; d1 = (f32x2){f[4 * i + 2], f[4 * i + 3]} * hf[2 * i + 1] + d1; }
                            d[g] = (d0.x + d0.y) + (d1.x + d1.y);
                        }
                    }
                    float r4[4];
#pragma unroll
                    for (int i = 0; i < 4; ++i) { const float send = u5 ? d[i] : d[4 + i], keep = u5 ? d[4 + i] : d[i]; r4[i] = keep + __shfl_xor(send, 32); }
                    float r2[2];
#pragma unroll
                    for (int i = 0; i < 2; ++i) { const float send = u4 ? r4[i] : r4[2 + i], keep = u4 ? r4[2 + i] : r4[i]; r2[i] = keep + __shfl_xor(send, 16); }
                    const float send = u3 ? r2[0] : r2[1], keep = u3 ? r2[1] : r2[0];
                    float r1 = keep + __shfl_xor(send, 8);
                    r1 += __shfl_xor(r1, 4); r1 += __shfl_xor(r1, 2); r1 += __shfl_xor(r1, 1);
                    const float act = gelu_tanh(r1 * (1.f / U8_SCALE)) * (1.f / V8_SCALE);
#pragma unroll
                    for (int g = 0; g < G; ++g) if (g < n) {
                        const float av = __builtin_bit_cast(float, __builtin_amdgcn_readlane(__builtin_bit_cast(int, act), ((g & 4) << 3) | ((g & 2) << 3) | ((g & 1) << 3)));
                        const int k = kk[g];
                        if (k < 64) { if (lane == k) wa = av; } else { if (lane == k - 64) wb = av; }
                    }
                }
                if ((ma0 >> lane) & 1ull) { LAS float* gp = (LAS float*)(ts + 4608 + lane * 4); *gp = *gp * wa; }
                if ((mb0 >> lane) & 1ull) { LAS float* gp = (LAS float*)(ts + 4608 + 256 + lane * 4); *gp = *gp * wb; }
            }
            if (DBG_ROUND_BAR) xcd_barrier(xbar, c.wave);
        }
        asm volatile("s_waitcnt lgkmcnt(0)" ::: "memory");
#pragma unroll 1
        for (int t = 0; t < 4; ++t) {
            const int m = c.gw + (pass * 4 + t) * c.ngw;
            if (m >= M) continue;
            const int b = m / SEQ;
            LAS unsigned char* ts = wl + t * 5120;
            const int ia = *(LAS int*)(ts + 4096 + lane * 4), ib = *(LAS int*)(ts + 4096 + 256 + lane * 4);
            const float wa = *(LAS float*)(ts + 4608 + lane * 4), wb = *(LAS float*)(ts + 4608 + 256 + lane * 4);
            f32x2 acc[16];
#pragma unroll
            for (int i = 0; i < 16; ++i) acc[i] = (f32x2){0.f, 0.f};
#pragma unroll 1
            for (int k0 = 0; k0 < 128; k0 += G) {
                u32x4 va[G]; u32x2 vb[G]; float wk[G];
#pragma unroll
                for (int g = 0; g < G; ++g) {
                    const int e = __builtin_amdgcn_readlane(k0 < 64 ? ia : ib, (k0 + g) & 63);
                    wk[g] = __builtin_bit_cast(float, __builtin_amdgcn_readlane(__builtin_bit_cast(int, k0 < 64 ? wa : wb), (k0 + g) & 63));
                    const unsigned char* vr = V + (size_t)e * 1536;
                    va[g] = *(const u32x4*)(vr + (unsigned)lane * 16u); vb[g] = *(const u32x2*)(vr + 1024u + (unsigned)lane * 8u);
                }
#pragma unroll
                for (int g = 0; g < G; ++g) { const f32x2 w2 = {wk[g], wk[g]};
                    const f32x32v f = __builtin_amdgcn_cvt_scalef32_pk32_f32_fp6((u32x6){va[g][0], va[g][1], va[g][2], va[g][3], vb[g][0], vb[g][1]}, 1.0f);
#pragma unroll
                    for (int i = 0; i < 16; ++i) acc[i] = (f32x2){f[2 * i], f[2 * i + 1]} * w2 + acc[i]; }
            }
            float* orow = p.out + (size_t)m * D + lane * 32; const float* gt2 = mod + b * 6 * D + 5 * D + lane * 32; const float* fg = p.fng + lane * 32;
            float ss = 0.f; f32x4 xv[8];
#pragma unroll
            for (int i = 0; i < 8; ++i) {
                const f32x4 xa = *(const f32x4*)(orow + 4 * i), ta = *(const f32x4*)(gt2 + 4 * i);
                const f32x4 pe = {acc[2 * i].x, acc[2 * i].y, acc[2 * i + 1].x, acc[2 * i + 1].y};
                const f32x4 v = xa + DBG_BETA * ta * pe; xv[i] = v; ss += (v[0] * v[0] + v[1] * v[1]) + (v[2] * v[2] + v[3] * v[3]);
            }
            const float rstd = rsqrtf(wave_sum(ss) * (1.f / D) + EPS);
#pragma unroll
            for (int i = 0; i < 8; ++i) *(f32x4*)(orow + 4 * i) = xv[i] * rstd * *(const f32x4*)(fg + 4 * i);
        }
    }
}
#ifndef GATHER_ROUNDS
#define GATHER_ROUNDS 0
#endif

constexpr size_t OFF_WK = OFF_GB + (size_t)32 * 1024 * 1024;
constexpr size_t OFF_SSQ = OFF_GB + (size_t)48 * 1024 * 1024;
constexpr int NPU = 2, NPV = 2;
struct PairPick { int k; bool valid; };
DI PairPick pick_next(unsigned long long& ma, unsigned long long& mb, int prev) {
    PairPick r;
    if (ma) { r.k = __builtin_ctzll(ma); ma &= ma - 1; r.valid = true; }
    else if (mb) { r.k = 64 + __builtin_ctzll(mb); mb &= mb - 1; r.valid = true; }
    else { r.k = prev; r.valid = false; }
    return r;
}
DI int rl2(int a, int b, int k) { const int va = __builtin_amdgcn_readlane(a, k & 63), vb = __builtin_amdgcn_readlane(b, k & 63); return k < 64 ? va : vb; }
DI float rl2f(float a, float b, int k) { return __builtin_bit_cast(float, rl2(__builtin_bit_cast(int, a), __builtin_bit_cast(int, b), k)); }

DI void gather_u(const Params& p, const Ctx& c) {
    const bf16_t* H2 = (const bf16_t*)(p.ws + OFF_H); const unsigned char* U = p.ws + OFF_U16;
    const int* IDX = (const int*)(p.ws + OFF_IDX); const float* GW = (const float*)(p.ws + OFF_GW); float* WK = (float*)(p.ws + OFF_WK);
    const int x = blockIdx.x & 7, jb = blockIdx.x >> 3, nj = ((int)gridDim.x - x + 7) >> 3;
    const int wl = jb * NWAVES + c.wave, nwl = nj * NWAVES;
    constexpr int G = 4, SH = (NPU == 2) ? 10 : 11;
#pragma unroll 1
    for (int ps = 0; ps < NPU; ++ps) {
        const int part = x * NPU + ps;
#pragma unroll 1
        for (int m = wl; m < M; m += nwl) {
            const int ia = IDX[(size_t)m * 128 + c.lane], ib = IDX[(size_t)m * 128 + 64 + c.lane];
            unsigned long long ma = __ballot((ia >> SH) == part), mb = __ballot((ib >> SH) == part);
            if (!(ma | mb)) continue;
            const unsigned long long ma0 = ma, mb0 = mb;
            float hf[2][16];
#pragma unroll
            for (int j = 0; j < 2; ++j) { const u32x4 a = *(const u32x4*)(H2 + (size_t)m * D + j * 1024 + c.lane * 16), bq = *(const u32x4*)(H2 + (size_t)m * D + j * 1024 + c.lane * 16 + 8);
#pragma unroll
                for (int q = 0; q < 4; ++q) { hf[j][2 * q] = bflo(a[q]); hf[j][2 * q + 1] = bfhi(a[q]); hf[j][8 + 2 * q] = bflo(bq[q]); hf[j][8 + 2 * q + 1] = bfhi(bq[q]); } }
            const float ga = GW[(size_t)m * 128 + c.lane], gb = GW[(size_t)m * 128 + 64 + c.lane];
            float wa = 0.f, wb = 0.f;
            int prev = 0;
            while (ma | mb) {
                PairPick pk[G]; u32x4 uu[G][2];
#pragma unroll
                for (int g = 0; g < G; ++g) { pk[g] = pick_next(ma, mb, prev); prev = pk[g].k;
                    const int e = rl2(ia, ib, pk[g].k);
                    const unsigned char* ur = U + (size_t)e * D;
#pragma unroll
                    for (int j = 0; j < 2; ++j) uu[g][j] = *(const u32x4*)(ur + ((unsigned)c.lane * 16u + j * 1024u)); }
                float d[G];
#pragma unroll
                for (int g = 0; g < G; ++g) {
                    float d0 = 0.f, d1 = 0.f;
#pragma unroll
                    for (int j = 0; j < 2; ++j)
#pragma unroll
                        for (int q = 0; q < 4; ++q) { const f32x2 lo = __builtin_amdgcn_cvt_pk_f32_fp8((int)uu[g][j][q], false), hi = __builtin_amdgcn_cvt_pk_f32_fp8((int)uu[g][j][q], true);
                            d0 += lo.x * hf[j][4 * q] + hi.x * hf[j][4 * q + 2]; d1 += lo.y * hf[j][4 * q + 1] + hi.y * hf[j][4 * q + 3]; }
                    d[g] = d0 + d1;
                }
#pragma unroll
                for (int o = 1; o < 64; o <<= 1)
#pragma unroll
                    for (int g = 0; g < G; ++g) d[g] += __shfl_xor(d[g], o);
#pragma unroll
                for (int g = 0; g < G; ++g) if (pk[g].valid) {
                    const float a = gelu_tanh(d[g] * (1.f / U8_SCALE)) * (1.f / V8_SCALE); const int k = pk[g].k;
                    if (k < 64) { if (c.lane == k) wa = a * ga; } else { if (c.lane == k - 64) wb = a * gb; }
                }
            }
            if ((ma0 >> c.lane) & 1ull) WK[(size_t)m * 128 + c.lane] = wa;
            if ((mb0 >> c.lane) & 1ull) WK[(size_t)m * 128 + 64 + c.lane] = wb;
        }
    }
}

DI void gather_v(const Params& p, const Ctx& c) {
    const unsigned char* V = p.ws + OFF_V16;
    const int* IDX = (const int*)(p.ws + OFF_IDX); const float* WK = (const float*)(p.ws + OFF_WK); const float* mod = (const float*)(p.ws + OFF_MOD);
    float* SSQ = (float*)(p.ws + OFF_SSQ);
    const int x = blockIdx.x & 7, jb = blockIdx.x >> 3, nj = ((int)gridDim.x - x + 7) >> 3;
    const int wl = jb * NWAVES + c.wave, nwl = nj * NWAVES;
    const int q4 = c.lane >> 4, l16 = c.lane & 15;
    const unsigned voff = 256u * x + l16 * 16u;
    constexpr int SHV = (NPV == 2) ? 13 : 14;
#pragma unroll 1
    for (int ps = 0; ps < NPV; ++ps) {
#pragma unroll 1
        for (int m = wl; m < M; m += nwl) {
            const int b = m / SEQ;
            const int ia = IDX[(size_t)m * 128 + c.lane], ib = IDX[(size_t)m * 128 + 64 + c.lane];
            const float wa = WK[(size_t)m * 128 + c.lane], wb = WK[(size_t)m * 128 + 64 + c.lane];
            unsigned long long ma = __ballot((ia >> SHV) == ps), mb = __ballot((ib >> SHV) == ps);
            float acc[16];
#pragma unroll
            for (int i = 0; i < 16; ++i) acc[i] = 0.f;
            int prev = 0;
            while (ma | mb) {
                u32x4 vv[4]; float wv[4];
#pragma unroll
                for (int s4 = 0; s4 < 4; ++s4) {
                    int e = 0; float w = 0.f;
#pragma unroll
                    for (int g = 0; g < 4; ++g) { const PairPick pk = pick_next(ma, mb, prev); prev = pk.k;
                        const int eg = rl2(ia, ib, pk.k); const float wg = pk.valid ? rl2f(wa, wb, pk.k) : 0.f;
                        e = (q4 == g) ? eg : e; w = (q4 == g) ? wg : w; }
                    vv[s4] = *(const u32x4*)(V + (size_t)e * D + voff); wv[s4] = w;
                }
#pragma unroll
                for (int s4 = 0; s4 < 4; ++s4)
#pragma unroll
                    for (int q = 0; q < 4; ++q) { const f32x2 lo = __builtin_amdgcn_cvt_pk_f32_fp8((int)vv[s4][q], false), hi = __builtin_amdgcn_cvt_pk_f32_fp8((int)vv[s4][q], true);
                        acc[4 * q] += wv[s4] * lo.x; acc[4 * q + 1] += wv[s4] * lo.y; acc[4 * q + 2] += wv[s4] * hi.x; acc[4 * q + 3] += wv[s4] * hi.y; }
            }
#pragma unroll
            for (int i = 0; i < 16; ++i) { acc[i] += __shfl_xor(acc[i], 16); acc[i] += __shfl_xor(acc[i], 32); }
            f32x4 sel;
#pragma unroll
            for (int e = 0; e < 4; ++e) sel[e] = q4 == 0 ? acc[e] : (q4 == 1 ? acc[4 + e] : (q4 == 2 ? acc[8 + e] : acc[12 + e]));
            const int col = 256 * x + 16 * l16 + 4 * q4;
            float* op = p.out + (size_t)m * D + col;
            const f32x4 val = *(const f32x4*)op + DBG_BETA * *(const f32x4*)(mod + b * 6 * D + 5 * D + col) * sel;
            *(f32x4*)op = val;
            if (ps == NPV - 1) { const float ss = wave_sum(val[0] * val[0] + val[1] * val[1] + val[2] * val[2] + val[3] * val[3]); if (c.lane == 0) SSQ[(size_t)m * 8 + x] = ss; }
        }
    }
}
DI void gather_final(const Params& p, const Ctx& c) {
    const float* SSQ = (const float*)(p.ws + OFF_SSQ);
    for (int m = c.gw; m < M; m += c.ngw) {
        float s = (c.lane < 8) ? SSQ[(size_t)m * 8 + c.lane] : 0.f;
        s += __shfl_xor(s, 1); s += __shfl_xor(s, 2); s += __shfl_xor(s, 4);
        const float rstd = rsqrtf(__shfl(s, 0) * (1.f / D) + EPS);
        float* orow = p.out + (size_t)m * D;
#pragma unroll
        for (int j = 0; j < 8; ++j) { const int col = (j * 64 + c.lane) * 4; *(f32x4*)(orow + col) = *(const f32x4*)(orow + col) * rstd * *(const f32x4*)(p.fng + col); }
    }
}
#ifndef GATHER_L2
#define GATHER_L2 0
#endif

DI void phase_gather_v2(const Params& p, const Ctx& c) {
    const bf16_t* H2 = (const bf16_t*)(p.ws + OFF_H);
    const int* IDX = (const int*)(p.ws + OFF_IDX); const float* GW = (const float*)(p.ws + OFF_GW); const float* mod = (const float*)(p.ws + OFF_MOD);
    LAS float* hs = (LAS float*)c.lds; LAS float* wk = hs + 2048; LAS int* ek = (LAS int*)(wk + 128); LAS float* red = (LAS float*)(ek + 128);
    for (int m = blockIdx.x; m < M; m += gridDim.x) {
        const int b = m / SEQ;
        __syncthreads();
        for (int i = c.tid; i < 2048; i += NTHREADS) hs[i] = bf2f(H2[(size_t)m * D + i]);
        if (c.tid < 128) ek[c.tid] = IDX[(size_t)m * 128 + c.tid];
        __syncthreads();
        for (int k = c.wave; k < 128; k += NWAVES) {
            const float* ur = p.pu + (size_t)ek[k] * D;
            float d = 0.f;
            for (int i = 0; i < 8; ++i) { const int col = i * 256 + c.lane * 4; const f32x4 u = *(const f32x4*)(ur + col);
                d += u[0] * hs[col] + u[1] * hs[col + 1] + u[2] * hs[col + 2] + u[3] * hs[col + 3]; }
            d = wave_sum(d);
            if (c.lane == 0) wk[k] = gelu_tanh(d) * GW[(size_t)m * 128 + k];
        }
        __syncthreads();
        const int col = c.tid * 4;
        f32x4 acc = {0.f, 0.f, 0.f, 0.f};
        for (int k = 0; k < 128; ++k) { const f32x4 v = *(const f32x4*)(p.pv + (size_t)ek[k] * D + col); acc += v * wk[k]; }
        float* orow = p.out + (size_t)m * D;
        const f32x4 x2 = *(const f32x4*)(orow + col) + DBG_BETA * *(const f32x4*)(mod + b * 6 * D + 5 * D + col) * acc;
        float ss = wave_sum(x2[0] * x2[0] + x2[1] * x2[1] + x2[2] * x2[2] + x2[3] * x2[3]);
        if (c.lane == 0) red[c.wave] = ss;
        __syncthreads();
        float tot = 0.f;
        for (int w = 0; w < NWAVES; ++w) tot += red[w];
        const float rstd = rsqrtf(tot * (1.f / D) + EPS);
        *(f32x4*)(orow + col) = x2 * rstd * *(const f32x4*)(p.fng + col);
    }
}


#define XB_TMO      128
#define XB_XCNT(j)  (256  + 64 * (j))
#define XB_XSUB(j)  (1280 + 64 * (j))
#define XB_XGEN(j)  (2304 + 64 * (j))
#define XB_TOP      3328
#define XB_TOPGEN   3392
#define XCD_BAR_WORDS 3456
#define XB_SPIN_CAP (1u << 18)

__device__ __forceinline__ unsigned xb_ld(unsigned* p)              { return __hip_atomic_load(p, __ATOMIC_RELAXED, __HIP_MEMORY_SCOPE_AGENT); }
__device__ __forceinline__ unsigned xb_add(unsigned* p, unsigned v) { return __hip_atomic_fetch_add(p, v, __ATOMIC_RELAXED, __HIP_MEMORY_SCOPE_AGENT); }
__device__ __forceinline__ unsigned xb_xcc_id() { return (unsigned)__builtin_amdgcn_s_getreg((3 << 11) | 20) & 0xFu; }
#define XB_SPIN(cond, bar) do { unsigned _sp = 0; while (cond) { __builtin_amdgcn_s_sleep(1); \
    if ((++_sp & 255u) == 0u) { if (xb_ld(&(bar)[XB_TMO])) break; if (_sp > XB_SPIN_CAP) { atomicAdd(&(bar)[XB_TMO], 1u); break; } } } } while (0)

struct XcdBarrier {
    unsigned* bar; unsigned x;
    volatile LAS unsigned* st;
};

__device__ __forceinline__ XcdBarrier xcd_barrier_post(unsigned* bar, volatile LAS unsigned* st) {
    XcdBarrier b; b.bar = bar; b.x = xb_xcc_id(); b.st = st;
    if (threadIdx.x == 0) (void)xb_add(&bar[XB_XCNT(b.x)], 1u);
    return b;
}
__device__ __forceinline__ void xcd_barrier_complete(unsigned* bar, unsigned x, unsigned& nloc, unsigned& nx) {
    const unsigned G = gridDim.x * gridDim.y * gridDim.z;
    unsigned sum, cnt, mine, sp = 0u;
    for (;;) {
        sum = 0u; cnt = 0u; mine = 0u;
#pragma unroll
        for (unsigned j = 0; j < 16; ++j) { const unsigned c = xb_ld(&bar[XB_XCNT(j)]); sum += c; cnt += (c > 0u) ? 1u : 0u; mine = (j == x) ? c : mine; }
        if (sum == G) break;
        __builtin_amdgcn_s_sleep(1);
        if ((++sp & 255u) == 0u) { if (xb_ld(&bar[XB_TMO])) break; if (sp > XB_SPIN_CAP) { atomicAdd(&bar[XB_TMO], 1u); break; } }
    }
    nloc = mine > 0u ? mine : 1u; nx = cnt > 0u ? cnt : 1u;
}

__device__ __forceinline__ bool xb_lead(int wave_s) { return wave_s == 0 && __builtin_amdgcn_mbcnt_hi(~0u, __builtin_amdgcn_mbcnt_lo(~0u, 0u)) == 0; }
__device__ __forceinline__ void xcd_barrier(const XcdBarrier& b, int wave_s) {
    asm volatile("s_waitcnt vmcnt(0)" ::: "memory");
    __syncthreads();
    if (xb_lead(wave_s)) {
        unsigned* bar = b.bar;
        __builtin_amdgcn_s_waitcnt(0);
        unsigned nloc = b.st[0], nx = b.st[1];
        if (nloc == 0u) { xcd_barrier_complete(bar, b.x, nloc, nx); b.st[0] = nloc; b.st[1] = nx; }
        const unsigned old = xb_add(&bar[XB_XSUB(b.x)], 1u);
        const unsigned gen = old / nloc;
        if (old + 1u == (gen + 1u) * nloc) {
            __builtin_amdgcn_fence(__ATOMIC_RELEASE, "agent");
            asm volatile("s_waitcnt vmcnt(0)" ::: "memory");
            const unsigned og = xb_add(&bar[XB_TOP], 1u);
            const unsigned tg = og / nx;
            if (og + 1u == (tg + 1u) * nx) xb_add(&bar[XB_TOPGEN], 1u);
            else XB_SPIN(xb_ld(&bar[XB_TOPGEN]) == tg, bar);
            __builtin_amdgcn_fence(__ATOMIC_ACQUIRE, "agent");
            xb_add(&bar[XB_XGEN(b.x)], 1u);
            asm volatile("s_waitcnt vmcnt(0)" ::: "memory");
        } else {
            XB_SPIN(xb_ld(&bar[XB_XGEN(b.x)]) == gen, bar);
            __builtin_amdgcn_fence(__ATOMIC_ACQUIRE, "agent");
            asm volatile("s_waitcnt vmcnt(0)" ::: "memory");
        }
    }
    __syncthreads();
}


DI void grid_barrier(unsigned* ctr, unsigned target, int wave_s) {
    asm volatile("s_waitcnt vmcnt(0)" ::: "memory");
    __syncthreads();
    if (wave_s == 0) {
        const int l = __builtin_amdgcn_mbcnt_hi(~0u, __builtin_amdgcn_mbcnt_lo(~0u, 0u));
        if (l == 0) {
            __builtin_amdgcn_fence(__ATOMIC_RELEASE, "agent");
            asm volatile("s_waitcnt vmcnt(0)" ::: "memory");
            __hip_atomic_fetch_add(ctr, 1u, __ATOMIC_RELAXED, __HIP_MEMORY_SCOPE_AGENT);
            unsigned spins = 0;
            while (__hip_atomic_load(ctr, __ATOMIC_RELAXED, __HIP_MEMORY_SCOPE_AGENT) < target) { __builtin_amdgcn_s_sleep(2); if (++spins > (1u << 23)) break; }
            __builtin_amdgcn_fence(__ATOMIC_ACQUIRE, "agent");
            asm volatile("s_waitcnt vmcnt(0)" ::: "memory");
        }
    }
    __syncthreads();
}

__global__ void __launch_bounds__(NTHREADS, 2) mega(Params p) {
    extern __shared__ __attribute__((aligned(16))) unsigned char lds_raw[];
    const int wave_s = __builtin_amdgcn_readfirstlane(threadIdx.x >> 6);
#define MKCTX() Ctx c; { int l_; asm volatile("v_mbcnt_lo_u32_b32 %0, -1, 0\n\tv_mbcnt_hi_u32_b32 %0, -1, %0" : "=v"(l_)); c.lds = (LAS unsigned char*)lds_raw; c.lane = l_; c.wave = wave_s; c.tid = wave_s * 64 + l_; \
    c.gw = blockIdx.x * NWAVES + wave_s; c.ngw = gridDim.x * NWAVES; }
    unsigned char* ws = p.ws;
    const float* mod = (const float*)(ws + OFF_MOD);
    const int lo = p.ph_lo, hi = p.ph_hi;
    XcdBarrier xbar; xbar.bar = (unsigned*)(ws + OFF_XBAR); xbar.x = 0; xbar.st = nullptr;
    if (USE_XBAR && lo == 0 && hi == NPHASE) {
        volatile LAS unsigned* stw = (volatile LAS unsigned*)(lds_raw + LDS_BYTES - 32);
        if (threadIdx.x < 2) stw[threadIdx.x] = 0u;
        __syncthreads();
        xbar = xcd_barrier_post((unsigned*)(ws + OFF_XBAR), stw);
    }
#define IN(k) (lo <= (k) && (k) < hi)
#define SEAM(k) do { if (IN(k) && IN((k) + 1)) { if (USE_XBAR) xcd_barrier(xbar, wave_s); else grid_barrier((unsigned*)(ws + OFF_CTL), (unsigned)((k) + 1) * gridDim.x, wave_s); \
    if (TIME_PHASE >= 0 && blockIdx.x == 0 && threadIdx.x == 0) ((unsigned long long*)(ws + OFF_CTL + 512))[(k) + 1] = __builtin_amdgcn_s_memrealtime(); } } while (0)

    if (TIME_PHASE >= 0 && blockIdx.x == 0 && threadIdx.x == 0) ((unsigned long long*)(ws + OFF_CTL + 512))[0] = __builtin_amdgcn_s_memrealtime();
    if (IN(0)) { MKCTX(); phase_prologue(p, c, true, PRO_SPLIT == 0); }
    SEAM(0);
    if (IN(1)) for (int rep_ = 0; rep_ < (DUP_PHASE == 1 ? 2 : 1); ++rep_) { MKCTX();
        const long long* modi = (const long long*)(ws + OFF_MODI); float* modw = (float*)(ws + OFF_MOD);
        for (int i = blockIdx.x * NTHREADS + c.tid; i < NB * 6 * D; i += gridDim.x * NTHREADS) modw[i] = (float)((double)modi[i] * (1.0 / 4294967296.0));
        modulate_rows(p.x, p.n1g, modi + 1 * D, modi + 0 * D, (bf16_t*)(ws + OFF_H), c);
        if (PRO_SPLIT) phase_prologue(p, c, false, true);
    }
    SEAM(1);
    if (IN(2)) for (int rep_ = 0; rep_ < (DUP_PHASE == 2 ? 2 : 1); ++rep_) { MKCTX();
        EpiProj e1{(bf16_t*)(ws + OFF_CQ), (bf16_t*)(ws + OFF_CKV), (bf16_t*)(ws + OFF_KR), (bf16_t*)(ws + OFF_SBQ), (bf16_t*)(ws + OFF_SBK), (bf16_t*)(ws + OFF_GA), (bf16_t*)(ws + OFF_GB), (const f32x2*)(ws + OFF_CS)};
        GEMM(c, (const bf16_t*)(ws + OFF_H), (const bf16_t*)(ws + OFF_WIN), M, 7168, 2048, e1);
        if (DUP_GEMM == 20) GEMM(c, (const bf16_t*)(ws + OFF_H), (const bf16_t*)(ws + OFF_WIN), M, 7168, 2048, e1);
        EpiT e2{(bf16_t*)(ws + OFF_SBVT), nullptr};
        GEMM(c, (const bf16_t*)(ws + OFF_WSBV), (const bf16_t*)(ws + OFF_H), 1024, M, 2048, e2);
        if (DUP_GEMM == 21) GEMM(c, (const bf16_t*)(ws + OFF_WSBV), (const bf16_t*)(ws + OFF_H), 1024, M, 2048, e2);
    }
    SEAM(2);
    if (IN(3)) for (int rep_ = 0; rep_ < (DUP_PHASE == 3 ? 2 : 1); ++rep_) { MKCTX(); phase_rowstats(p, c); }
    SEAM(3);
    if (DBG_XTRA_BAR) { for (int q_ = 0; q_ < DBG_XTRA_BAR; ++q_) { if (IN(3) && IN(4)) xcd_barrier(xbar, wave_s); } }
    if (IN(4)) for (int rep_ = 0; rep_ < (DUP_PHASE == 4 ? 2 : 1); ++rep_) { MKCTX();
        EpiUq e1{(bf16_t*)(ws + OFF_Q), (const float*)(ws + OFF_RSTQ), (const f32x2*)(ws + OFF_CS)};
        GEMM(c, (const bf16_t*)(ws + OFF_CQ), (const bf16_t*)(ws + OFF_WUQ), M, 1536, 512, e1);
        if (DUP_GEMM == 40) GEMM(c, (const bf16_t*)(ws + OFF_CQ), (const bf16_t*)(ws + OFF_WUQ), M, 1536, 512, e1);
        EpiRowScale e2{(bf16_t*)(ws + OFF_KN), 1024, (const float*)(ws + OFF_RSTKV)};
        GEMM(c, (const bf16_t*)(ws + OFF_CKV), (const bf16_t*)(ws + OFF_WUK), M, 1024, 256, e2);
        if (DUP_GEMM == 41) GEMM(c, (const bf16_t*)(ws + OFF_CKV), (const bf16_t*)(ws + OFF_WUK), M, 1024, 256, e2);
        EpiT e3{(bf16_t*)(ws + OFF_VT), (const float*)(ws + OFF_RSTKV)};
        GEMM(c, (const bf16_t*)(ws + OFF_WUV), (const bf16_t*)(ws + OFF_CKV), 1024, M, 256, e3);
        if (DUP_GEMM == 42) GEMM(c, (const bf16_t*)(ws + OFF_WUV), (const bf16_t*)(ws + OFF_CKV), 1024, M, 256, e3);
    }
    SEAM(4);
    if (IN(5)) for (int rep_ = 0; rep_ < (DUP_PHASE == 5 ? 2 : 1); ++rep_) {
#if FAST_ATTN
        { MKCTX(); attn_mla_fast(p, c); }
        if (DUP_GEMM == 51) { MKCTX(); attn_mla_fast(p, c); }
        { MKCTX(); attn_sb_fast(p, c); }
        if (DUP_GEMM == 52) { MKCTX(); attn_sb_fast(p, c); }
#else
        MKCTX();
        attn_mla_naive(p, c); attn_sb_naive(p, c);
#endif
    }
    SEAM(5);
    if (IN(6)) for (int rep_ = 0; rep_ < (DUP_PHASE == 6 ? 2 : 1); ++rep_) { MKCTX();
        EpiGate1 e1{(bf16_t*)(ws + OFF_MERGED), (const bf16_t*)(ws + OFF_GA)};
        GEMM(c, (const bf16_t*)(ws + OFF_ATTA), (const bf16_t*)(ws + OFF_WA), M, 2048, 1024, e1);
        if (DUP_GEMM == 60) GEMM(c, (const bf16_t*)(ws + OFF_ATTA), (const bf16_t*)(ws + OFF_WA), M, 2048, 1024, e1);
        EpiGate2 e2{(bf16_t*)(ws + OFF_MERGED), (const bf16_t*)(ws + OFF_GB)};
        GEMM(c, (const bf16_t*)(ws + OFF_ATTB), (const bf16_t*)(ws + OFF_WB), M, 2048, 1024, e2);
    }
    SEAM(6);
    if (IN(7)) for (int rep_ = 0; rep_ < (DUP_PHASE == 7 ? 2 : 1); ++rep_) { MKCTX();
        EpiRes e{p.x, mod + 2 * D, p.out};
        GEMM(c, (const bf16_t*)(ws + OFF_MERGED), (const bf16_t*)(ws + OFF_WOUT), M, 2048, 2048, e);
    }
    SEAM(7);
    if (IN(8)) for (int rep_ = 0; rep_ < (DUP_PHASE == 8 ? 2 : 1); ++rep_) { MKCTX();
        modulate_rows(p.out, p.n2g, mod + 4 * D, mod + 3 * D, (bf16_t*)(ws + OFF_H), c);
        convert_table(p.pu, ws + OFF_U16, U8_SCALE, c);
        convert_table(p.pv, ws + OFF_V16, V8_SCALE, c);
    }
    SEAM(8);
    if (IN(9)) for (int rep_ = 0; rep_ < (DUP_PHASE == 9 ? 2 : 1); ++rep_) { MKCTX();
        EpiPq e{(bf16_t*)(ws + OFF_PQ)};
        GEMM(c, (const bf16_t*)(ws + OFF_H), (const bf16_t*)(ws + OFF_WPQ), M, 2048, 2048, e);
#if FAST_SEL && FAST_GEMM && SEL_FUSED
        { MKCTX(); select_own_tiles(p, c); }
#endif
    }
#if !(FAST_SEL && FAST_GEMM && SEL_FUSED)
    SEAM(9);
    if (IN(10)) for (int rep_ = 0; rep_ < (DUP_PHASE == 10 ? 2 : 1); ++rep_) { MKCTX();
#if FAST_SEL
        select_fast(p, c);
#else
        select_naive(p, c);
#endif
    }
#else
    if (IN(9) && IN(10)) {   }
#endif
    SEAM(10);
#if GATHER_L2
    if (IN(11)) { MKCTX(); gather_u(p, c); }
    SEAM(11);
    if (IN(12)) { MKCTX(); gather_v(p, c); }
    SEAM(12);
    if (IN(13)) { MKCTX(); gather_final(p, c); }
#else
#if GATHER_SORTED
    if (IN(11)) { MKCTX(); phase_gather_sorted(p, c); }
#elif GATHER_ROUNDS
    if (IN(11)) { MKCTX(); phase_gather_rounds(p, c, xbar); }
#else
    if (IN(11)) { if (DUP_GEMM == 110) { MKCTX(); phase_gather(p, c, (float*)(ws + OFF_SBQ)); }
        if (DUP_GEMM == 111) { MKCTX(); phase_gather(p, c, (float*)(ws + OFF_SBQ), 0x3ff); } MKCTX(); phase_gather(p, c, p.out); }
#endif
#endif
#undef IN
#undef SEAM
}

extern "C" void kernel_launch(void* const* d_in, const int* in_sizes, int n_in, void* d_out, int out_size, void* d_ws, size_t ws_size, hipStream_t stream) {
    static int grid = 0;
    if (grid == 0) {
        if (n_in != 20 || out_size != M * D || ws_size < WS_END) { fprintf(stderr, "kernel_launch: unexpected shapes (n_in %d out %d ws %zu need %zu)\n", n_in, out_size, ws_size, (size_t)WS_END); grid = -1; return; }
        int dev = 0, cus = 0, per_cu = 0;
        (void)hipGetDevice(&dev); (void)hipDeviceGetAttribute(&cus, hipDeviceAttributeMultiprocessorCount, dev);
        if (hipFuncSetAttribute((const void*)mega, hipFuncAttributeMaxDynamicSharedMemorySize, LDS_BYTES) != hipSuccess) { fprintf(stderr, "kernel_launch: hipFuncSetAttribute failed\n"); grid = -1; return; }
        if (hipOccupancyMaxActiveBlocksPerMultiprocessor(&per_cu, (const void*)mega, NTHREADS, LDS_BYTES) != hipSuccess || per_cu < 1) { fprintf(stderr, "kernel_launch: occupancy query failed (%d)\n", per_cu); per_cu = 1; }
        (void)hipGetLastError();
        grid = cus;
    }
    if (grid < 0) return;
    (void)hipMemsetAsync((char*)d_ws + OFF_CTL, 0, ZERO_BYTES, stream);
    Params p{};
    p.x = (const float*)d_in[0]; p.c = (const float*)d_in[1]; p.pos = (const int*)d_in[2]; p.ada_w = (const float*)d_in[3]; p.ada_b = (const float*)d_in[4];
    p.n1g = (const float*)d_in[5]; p.n2g = (const float*)d_in[6]; p.w_in = (const float*)d_in[7]; p.qng = (const float*)d_in[8]; p.kvng = (const float*)d_in[9];
    p.w_uq = (const float*)d_in[10]; p.w_ukv = (const float*)d_in[11]; p.w_bm = (const float*)d_in[12]; p.w_bs = (const float*)d_in[13]; p.w_out = (const float*)d_in[14];
    p.w_pq = (const float*)d_in[15]; p.skeys = (const float*)d_in[16]; p.pu = (const float*)d_in[17]; p.pv = (const float*)d_in[18]; p.fng = (const float*)d_in[19];
    p.out = (float*)d_out; p.ws = (unsigned char*)d_ws;
    for (int i = 0; i < 32; ++i) p.invf[i] = (float)pow(10000.0, -(double)i / 32.0);
#if N_LAUNCH_MODE == 1
    p.ph_lo = 0; p.ph_hi = NPHASE;
    void* args[] = {&p};
    hipError_t e = hipLaunchCooperativeKernel((const void*)mega, dim3(grid), dim3(NTHREADS), args, LDS_BYTES, stream);
    if (e != hipSuccess) fprintf(stderr, "cooperative launch failed: %s (grid %d)\n", hipGetErrorString(e), grid);
#else
    for (int k = 0; k < NPHASE; ++k) {
        p.ph_lo = k; p.ph_hi = k + 1;
        hipLaunchKernelGGL(mega, dim3(grid), dim3(NTHREADS), LDS_BYTES, stream, p);
    }
#endif
}
```

```cpp
#include <hip/hip_runtime.h>
#include <hip/hip_cooperative_groups.h>
#include <cstdio>
#include <cstdint>
#include <cmath>
namespace cg = cooperative_groups;

#ifndef N_LAUNCH_MODE
#define N_LAUNCH_MODE 1
#endif

#ifndef TIME_PHASE
#define TIME_PHASE -1
#endif
#ifndef TIME_SCALE
#define TIME_SCALE 5000.f
#endif
#ifndef DUP_GEMM
#define DUP_GEMM -1
#endif
#ifndef PRO_SPLIT
#define PRO_SPLIT 1
#endif
#ifndef USE_XBAR
#define USE_XBAR 1
#endif
#ifndef DBG_XTRA_BAR
#define DBG_XTRA_BAR 0
#endif
#ifndef DBG_ROUND_BAR
#define DBG_ROUND_BAR 0
#endif
#ifndef GATHER_DYN
#define GATHER_DYN 1
#endif
#ifndef SEL_FUSED
#define SEL_FUSED 1
#endif
#ifndef DUP_PHASE
#define DUP_PHASE -1
#endif
#ifndef DBG_ALPHA
#define DBG_ALPHA 1.0f
#endif
#ifndef DBG_BETA
#define DBG_BETA 1.0f
#endif
#define LAS __attribute__((address_space(3)))
#define DI __device__ __forceinline__
typedef unsigned short bf16_t;
typedef short bf16x8 __attribute__((ext_vector_type(8)));
typedef float f32x4 __attribute__((ext_vector_type(4)));
typedef float f32x2 __attribute__((ext_vector_type(2)));
typedef unsigned u32x4 __attribute__((ext_vector_type(4)));
typedef unsigned u32x2 __attribute__((ext_vector_type(2)));
typedef __bf16 bf16v2 __attribute__((ext_vector_type(2)));

constexpr int M = 16384, D = 2048, SEQ = 4096, NB = 4;
constexpr int NTHREADS = 512, NWAVES = 8;
constexpr int LDS_BYTES = 160 * 1024;
constexpr float EPS = 1e-6f;
constexpr float LOG2E = 1.4426950408889634f;
constexpr int NPHASE = 14;

constexpr size_t al256(size_t x) { return (x + 255) & ~(size_t)255; }
constexpr size_t OFF_CTL = 0;
constexpr size_t OFF_XBAR = 4096;
constexpr size_t OFF_MODI = 32768;
constexpr size_t ZERO_BYTES = OFF_MODI + (size_t)NB * 6 * D * 8;
constexpr size_t OFF_MOD = al256(ZERO_BYTES);
constexpr size_t OFF_RSTQ = OFF_MOD + (size_t)NB * 6 * D * 4;
constexpr size_t OFF_RSTKV = OFF_RSTQ + (size_t)M * 4;
constexpr size_t OFF_CS = OFF_RSTKV + (size_t)M * 4;
constexpr size_t OFF_KEYS = OFF_CS + (size_t)M * 32 * 8;
constexpr size_t OFF_WIN = OFF_KEYS + (size_t)8 * 2 * 128 * 128 * 2;
constexpr size_t OFF_WSBV = OFF_WIN + (size_t)7168 * 2048 * 2;
constexpr size_t OFF_WUQ = OFF_WSBV + (size_t)1024 * 2048 * 2;
constexpr size_t OFF_WUK = OFF_WUQ + (size_t)1536 * 512 * 2;
constexpr size_t OFF_WUV = OFF_WUK + (size_t)1024 * 256 * 2;
constexpr size_t OFF_WA = OFF_WUV + (size_t)1024 * 256 * 2;
constexpr size_t OFF_WB = OFF_WA + (size_t)2048 * 1024 * 2;
constexpr size_t OFF_WOUT = OFF_WB + (size_t)2048 * 1024 * 2;
constexpr size_t OFF_WPQ = OFF_WOUT + (size_t)2048 * 2048 * 2;
constexpr size_t OFF_H = OFF_WPQ + (size_t)2048 * 2048 * 2;
constexpr size_t OFF_CQ = OFF_H + (size_t)M * 2048 * 2;
constexpr size_t OFF_CKV = OFF_CQ + (size_t)M * 512 * 2;
constexpr size_t OFF_KR = OFF_CKV + (size_t)M * 256 * 2;
constexpr size_t OFF_SBQ = OFF_KR + (size_t)M * 64 * 2;
constexpr size_t OFF_SBK = OFF_SBQ + (size_t)M * 1024 * 2;
constexpr size_t OFF_SBVT = OFF_SBK + (size_t)M * 1024 * 2;
constexpr size_t OFF_GA = OFF_SBVT + (size_t)M * 1024 * 2;
constexpr size_t OFF_GB = OFF_GA + (size_t)M * 2048 * 2;
constexpr size_t OFF_Q = OFF_GB + (size_t)M * 2048 * 2;
constexpr size_t OFF_KN = OFF_Q + (size_t)M * 1536 * 2;
constexpr size_t OFF_VT = OFF_KN + (size_t)M * 1024 * 2;
constexpr size_t OFF_ATTA = OFF_VT + (size_t)M * 1024 * 2;
constexpr size_t OFF_ATTB = OFF_ATTA + (size_t)M * 1024 * 2;
constexpr size_t WS_END = OFF_ATTB + (size_t)M * 1024 * 2;
constexpr size_t OFF_MERGED = OFF_SBQ;
constexpr size_t OFF_PQ = OFF_GA;
constexpr size_t OFF_IDX = OFF_GB;
constexpr size_t OFF_GW = OFF_GB + (size_t)M * 128 * 4;
constexpr size_t OFF_U16 = OFF_Q;
constexpr size_t OFF_V16 = OFF_U16 + (size_t)16384 * 2048;
static_assert(OFF_V16 + (size_t)16384 * 2048 <= WS_END, "u/v overlay");
constexpr float U8_SCALE = 68.f, V8_SCALE = 1.5f;
static_assert(WS_END < (size_t)620 * 1000 * 1000, "workspace budget");

struct Params {
    const float *x, *c; const int* pos;
    const float *ada_w, *ada_b, *n1g, *n2g, *w_in, *qng, *kvng, *w_uq, *w_ukv, *w_bm, *w_bs, *w_out, *w_pq, *skeys, *pu, *pv, *fng;
    float* out; unsigned char* ws;
    float invf[32];
    int ph_lo, ph_hi;
};

DI unsigned pk2(float lo, float hi) { bf16v2 p; p[0] = (__bf16)lo; p[1] = (__bf16)hi; return __builtin_bit_cast(unsigned, p); }
DI float bflo(unsigned u) { return __uint_as_float(u << 16); }
DI float bfhi(unsigned u) { return __uint_as_float(u & 0xffff0000u); }
DI float dot2bf(unsigned a, unsigned b, float c) { return __builtin_amdgcn_fdot2_f32_bf16(__builtin_bit_cast(bf16v2, a), __builtin_bit_cast(bf16v2, b), c, false); }
DI float bf2f(bf16_t b) { return __uint_as_float(((unsigned)b) << 16); }
DI float wave_sum(float v) {
#pragma unroll
    for (int o = 1; o < 64; o <<= 1) v += __shfl_xor(v, o);
    return v;
}
DI float wave_max(float v) {
#pragma unroll
    for (int o = 1; o < 64; o <<= 1) v = fmaxf(v, __shfl_xor(v, o));
    return v;
}
DI float sigmoidf_(float v) { return 1.f / (1.f + __expf(-v)); }
DI float gelu_tanh(float v) { const float u = 0.7978845608028654f * (v + 0.044715f * v * v * v); const float e = __expf(2.f * u); const float t = 1.f - 2.f / (e + 1.f); return 0.5f * v * (1.f + t); }
DI void store_bf16x4(bf16_t* p, f32x4 v) { u32x2 w; w.x = pk2(v[0], v[1]); w.y = pk2(v[2], v[3]); *(u32x2*)p = w; }
DI void store_bf16x8(bf16_t* p, f32x4 a, f32x4 b) { u32x4 w; w.x = pk2(a[0], a[1]); w.y = pk2(a[2], a[3]); w.z = pk2(b[0], b[1]); w.w = pk2(b[2], b[3]); *(u32x4*)p = w; }
DI void load_bf16x8(const bf16_t* p, f32x4& a, f32x4& b) { const u32x4 w = *(const u32x4*)p; a = (f32x4){bflo(w.x), bfhi(w.x), bflo(w.y), bfhi(w.y)}; b = (f32x4){bflo(w.z), bfhi(w.z), bflo(w.w), bfhi(w.w)}; }
DI f32x4 sig4(f32x4 v) { return (f32x4){sigmoidf_(v[0]), sigmoidf_(v[1]), sigmoidf_(v[2]), sigmoidf_(v[3])}; }
DI f32x4 rope4(f32x4 v, f32x2 c0, f32x2 c1) { return (f32x4){v[0] * c0.x - v[1] * c0.y, v[1] * c0.x + v[0] * c0.y, v[2] * c1.x - v[3] * c1.y, v[3] * c1.x + v[2] * c1.y}; }
DI f32x4 load_bf16x4(const bf16_t* p) { const u32x2 w = *(const u32x2*)p; return (f32x4){bflo(w.x), bfhi(w.x), bflo(w.y), bfhi(w.y)}; }

struct Ctx {
    LAS unsigned char* lds;
    int tid, lane, wave, gw, ngw;
};

struct MapWin { DI int operator()(int n) const {
    if (n < 768) return n;
    if (n < 1024) { const int j = n - 768; if (j >= 64) return -1; return 768 + (j >> 1) + 32 * (j & 1); }
    if (n < 2048) return 832 + (n - 1024);
    if (n < 3072) return 1856 + (n - 2048);
    if (n < 5120) return 3904 + (n - 3072);
    return 5952 + (n - 5120); } };
struct MapOff { int off; DI int operator()(int n) const { return n + off; } };
struct MapUq { DI int operator()(int n) const { const int hd = n / 192, j = n % 192; if (j < 128) return hd * 192 + j; const int jj = j - 128; return hd * 192 + 128 + (jj >> 1) + 32 * (jj & 1); } };
struct MapUk { DI int operator()(int n) const { return (n >> 7) * 256 + (n & 127); } };
struct MapUv { DI int operator()(int n) const { return (n >> 7) * 256 + 128 + (n & 127); } };

template <class Map>
DI void transpose_item(const float* W, int K, int N, const Map& mp, const float* rowscale, bf16_t* dst, int kb, int nb, LAS float* scr, int lane) {
    const int k0 = kb * 64, sc = mp(nb * 64 + lane);
#pragma unroll 8
    for (int kk = 0; kk < 64; ++kk) {
        float v = 0.f;
        if (sc >= 0) v = W[(size_t)(k0 + kk) * N + sc];
        if (rowscale) v *= rowscale[k0 + kk];
        scr[kk * 65 + lane] = v;
    }
    asm volatile("s_waitcnt lgkmcnt(0)" ::: "memory");
    const int kc = lane & 7;
#pragma unroll
    for (int j = 0; j < 8; ++j) {
        const int nrow = (lane >> 3) + 8 * j; const LAS float* s = scr + (8 * kc) * 65 + nrow;
        u32x4 o; o.x = pk2(s[0], s[65]); o.y = pk2(s[2 * 65], s[3 * 65]); o.z = pk2(s[4 * 65], s[5 * 65]); o.w = pk2(s[6 * 65], s[7 * 65]);
        *(u32x4*)(dst + (size_t)(nb * 64 + nrow) * K + k0 + 8 * kc) = o;
    }
    asm volatile("s_waitcnt lgkmcnt(0)" ::: "memory");
}

DI void phase_prologue(const Params& p, const Ctx& c, bool do_ada = true, bool do_rest = true) {
    unsigned char* ws = p.ws;
    LAS float* scr = (LAS float*)(c.lds + c.wave * 16640);
    unsigned long long* modi = (unsigned long long*)(ws + OFF_MODI);
    if (do_ada) for (int u = c.gw; u < 32 * 48; u += c.ngw) {
        const int kp = u / 48, ch = u % 48, k0 = kp * 64, c0 = ch * 256 + c.lane * 4;
        float sl[4];
#pragma unroll
        for (int b = 0; b < 4; ++b) { const float cv = p.c[b * D + k0 + c.lane]; sl[b] = cv / (1.f + __expf(-cv)); }
        f32x4 acc[4];
#pragma unroll
        for (int b = 0; b < 4; ++b) acc[b] = (f32x4){0.f, 0.f, 0.f, 0.f};
#pragma unroll 16
        for (int kk = 0; kk < 64; ++kk) {
            const f32x4 w = *(const f32x4*)(p.ada_w + (size_t)(k0 + kk) * (6 * D) + c0);
#pragma unroll
            for (int b = 0; b < 4; ++b) { const float s = __shfl(sl[b], kk); acc[b] += w * s; }
        }
        if (kp == 0) { const f32x4 bv = *(const f32x4*)(p.ada_b + c0);
#pragma unroll
            for (int b = 0; b < 4; ++b) acc[b] += bv; }
#pragma unroll
        for (int b = 0; b < 4; ++b)
#pragma unroll
            for (int e = 0; e < 4; ++e) atomicAdd(modi + b * 6 * D + c0 + e, (unsigned long long)(long long)__builtin_rint((double)acc[b][e] * 4294967296.0));
    }
    if (!do_rest) return;
    constexpr int I_WIN = 112 * 32, I_SBV = 16 * 32, I_UQ = 24 * 8, I_UK = 16 * 4, I_UV = 16 * 4, I_A = 32 * 16, I_B = 32 * 16, I_OUT = 32 * 32, I_PQ = 32 * 32;
    constexpr int NIT = I_WIN + I_SBV + I_UQ + I_UK + I_UV + I_A + I_B + I_OUT + I_PQ;
    for (int it = c.gw; it < NIT; it += c.ngw) {
        int r = it;
        if (r < I_WIN) { transpose_item(p.w_in, 2048, 8000, MapWin{}, nullptr, (bf16_t*)(ws + OFF_WIN), r % 32, r / 32, scr, c.lane); continue; } r -= I_WIN;
        if (r < I_SBV) { transpose_item(p.w_in, 2048, 8000, MapOff{2880}, nullptr, (bf16_t*)(ws + OFF_WSBV), r % 32, r / 32, scr, c.lane); continue; } r -= I_SBV;
        if (r < I_UQ) { transpose_item(p.w_uq, 512, 1536, MapUq{}, p.qng, (bf16_t*)(ws + OFF_WUQ), r % 8, r / 8, scr, c.lane); continue; } r -= I_UQ;
        if (r < I_UK) { transpose_item(p.w_ukv, 256, 2048, MapUk{}, p.kvng, (bf16_t*)(ws + OFF_WUK), r % 4, r / 4, scr, c.lane); continue; } r -= I_UK;
        if (r < I_UV) { transpose_item(p.w_ukv, 256, 2048, MapUv{}, p.kvng, (bf16_t*)(ws + OFF_WUV), r % 4, r / 4, scr, c.lane); continue; } r -= I_UV;
        if (r < I_A) { transpose_item(p.w_bm, 1024, 2048, MapOff{0}, nullptr, (bf16_t*)(ws + OFF_WA), r % 16, r / 16, scr, c.lane); continue; } r -= I_A;
        if (r < I_B) { transpose_item(p.w_bs, 1024, 2048, MapOff{0}, nullptr, (bf16_t*)(ws + OFF_WB), r % 16, r / 16, scr, c.lane); continue; } r -= I_B;
        if (r < I_OUT) { transpose_item(p.w_out, 2048, 2048, MapOff{0}, nullptr, (bf16_t*)(ws + OFF_WOUT), r % 32, r / 32, scr, c.lane); continue; } r -= I_OUT;
        transpose_item(p.w_pq, 2048, 2048, MapOff{0}, nullptr, (bf16_t*)(ws + OFF_WPQ), r % 32, r / 32, scr, c.lane);
    }
    { bf16_t* kd = (bf16_t*)(ws + OFF_KEYS);
      for (int i = (c.gw * 64 + c.lane) * 4; i < 8 * 2 * 128 * 128; i += c.ngw * 64 * 4) store_bf16x4(kd + i, *(const f32x4*)(p.skeys + i)); }
    { f32x2* cs = (f32x2*)(ws + OFF_CS);
      for (int i = c.gw * 64 + c.lane; i < M * 32; i += c.ngw * 64) {
          const int m = i >> 5, f = i & 31;
          const float ang = (float)p.pos[m] * p.invf[f];
          const double rev = (double)ang * 0.15915494309189533576888;
          const float fr = (float)(rev - __builtin_rint(rev));
          cs[i] = (f32x2){__builtin_amdgcn_cosf(fr), __builtin_amdgcn_sinf(fr)};
      } }
}

DI f32x4 ld_mod4(const float* p) { return *(const f32x4*)p; }
DI f32x4 ld_mod4(const long long* p) { f32x4 r;
#pragma unroll
    for (int e = 0; e < 4; ++e) r[e] = (float)((double)p[e] * (1.0 / 4294967296.0));
    return r; }
template <class MT>
DI void modulate_rows(const float* src, const float* g, const MT* sc, const MT* sh, bf16_t* dst, const Ctx& c) {
    for (int m = c.gw; m < M; m += c.ngw) {
        const int b = m / SEQ;
        const float* xr = src + (size_t)m * D;
        f32x4 v[8]; float ss = 0.f;
#pragma unroll
        for (int j = 0; j < 8; ++j) { v[j] = *(const f32x4*)(xr + (j * 64 + c.lane) * 4); ss += v[j][0] * v[j][0] + v[j][1] * v[j][1] + v[j][2] * v[j][2] + v[j][3] * v[j][3]; }
        const float rstd = rsqrtf(wave_sum(ss) * (1.f / D) + EPS);
#pragma unroll
        for (int j = 0; j < 8; ++j) {
            const int col = (j * 64 + c.lane) * 4;
            const f32x4 gg = *(const f32x4*)(g + col), s1 = ld_mod4(sc + b * 6 * D + col), h1 = ld_mod4(sh + b * 6 * D + col);
            const f32x4 o = v[j] * rstd * gg * (s1 + 1.f) + h1;
            store_bf16x4(dst + (size_t)m * D + col, o);
        }
    }
}
DI void phase_rowstats(const Params& p, const Ctx& c) {
    const bf16_t* cq = (const bf16_t*)(p.ws + OFF_CQ); const bf16_t* ckv = (const bf16_t*)(p.ws + OFF_CKV);
    float* rq = (float*)(p.ws + OFF_RSTQ); float* rkv = (float*)(p.ws + OFF_RSTKV);
    for (int m = c.gw; m < M; m += c.ngw) {
        const u32x4 a = *(const u32x4*)(cq + (size_t)m * 512 + c.lane * 8);
        const u32x2 b = *(const u32x2*)(ckv + (size_t)m * 256 + c.lane * 4);
        float s1 = 0.f, s2 = 0.f;
#pragma unroll
        for (int e = 0; e < 4; ++e) { const float lo = bflo(a[e]), hi = bfhi(a[e]); s1 += lo * lo + hi * hi; }
#pragma unroll
        for (int e = 0; e < 2; ++e) { const float lo = bflo(b[e]), hi = bfhi(b[e]); s2 += lo * lo + hi * hi; }
        s1 = wave_sum(s1); s2 = wave_sum(s2);
        if (c.lane == 0) { rq[m] = rsqrtf(s1 * (1.f / 512.f) + EPS); rkv[m] = rsqrtf(s2 * (1.f / 256.f) + EPS); }
    }
}
typedef float f32x16v __attribute__((ext_vector_type(16)));
typedef float f32x32v __attribute__((ext_vector_type(32)));
typedef unsigned u32x6 __attribute__((ext_vector_type(6)));
#ifndef FP6_ORDER
#define FP6_ORDER 1
#endif
DI void convert_table(const float* src, unsigned char* dst, float scale, const Ctx& c) {
    const size_t ngroups = (size_t)16384 * 64;
    for (size_t gi = (size_t)c.gw * 64 + c.lane; gi < ngroups; gi += (size_t)c.ngw * 64) {
        const size_t row = gi >> 6; const int l = (int)(gi & 63);
        const float* sp = src + row * 2048 + l * 32;
        f32x4 v[8];
#pragma unroll
        for (int i = 0; i < 8; ++i) v[i] = *(const f32x4*)(sp + 4 * i) * scale;
        f32x16v a, b;
#pragma unroll
        for (int e = 0; e < 16; ++e) {
#if FP6_ORDER == 0
            a[e] = v[e >> 2][e & 3]; b[e] = v[4 + (e >> 2)][e & 3];
#else
            a[e] = v[(2 * e) >> 2][(2 * e) & 3]; b[e] = v[(2 * e + 1) >> 2][(2 * e + 1) & 3];
#endif
        }
        const u32x6 pk = __builtin_amdgcn_cvt_scalef32_2xpk16_fp6_f32(a, b, 1.0f);
        unsigned char* dp = dst + row * 1536;
        *(u32x4*)(dp + 16 * l) = (u32x4){pk[0], pk[1], pk[2], pk[3]};
        *(u32x2*)(dp + 1024 + 8 * l) = (u32x2){pk[4], pk[5]};
    }
}

struct EpiProj {
    bf16_t *cq, *ckv, *kr, *sbq, *sbk, *ga, *gb; const f32x2* cs;
    DI void operator()(int row, int col, f32x4 v) const {
        const int tile = col >> 8;
        if (tile < 2) { store_bf16x4(cq + (size_t)row * 512 + col, v); }
        else if (tile == 2) { store_bf16x4(ckv + (size_t)row * 256 + (col - 512), v); }
        else if (tile == 3) { const int j = col - 768; if (j < 64) { const f32x2 c0 = cs[row * 32 + (j >> 1)], c1 = cs[row * 32 + (j >> 1) + 1];
            const f32x4 o = {v[0] * c0.x - v[1] * c0.y, v[1] * c0.x + v[0] * c0.y, v[2] * c1.x - v[3] * c1.y, v[3] * c1.x + v[2] * c1.y};
            store_bf16x4(kr + (size_t)row * 64 + j, o); } }
        else if (tile < 8) { store_bf16x4(sbq + (size_t)row * 1024 + (col - 1024), v * (0.08838834764831845f * LOG2E)); }
        else if (tile < 12) { store_bf16x4(sbk + (size_t)row * 1024 + (col - 2048), v); }
        else if (tile < 20) { store_bf16x4(ga + (size_t)row * 2048 + (col - 3072), (f32x4){sigmoidf_(v[0]), sigmoidf_(v[1]), sigmoidf_(v[2]), sigmoidf_(v[3])}); }
        else { store_bf16x4(gb + (size_t)row * 2048 + (col - 5120), (f32x4){sigmoidf_(v[0]), sigmoidf_(v[1]), sigmoidf_(v[2]), sigmoidf_(v[3])}); }
    }    DI void operator()(int row, int col, f32x4 v0, f32x4 v1) const {
        const int tile = col >> 8;
        if (tile < 2) { store_bf16x8(cq + (size_t)row * 512 + col, v0, v1); }
        else if (tile == 2) { store_bf16x8(ckv + (size_t)row * 256 + (col - 512), v0, v1); }
        else if (tile == 3) { const int j = col - 768; if (j < 64) { const f32x2* cp = cs + row * 32 + (j >> 1);
            store_bf16x8(kr + (size_t)row * 64 + j, rope4(v0, cp[0], cp[1]), rope4(v1, cp[2], cp[3])); } }
        else if (tile < 8) { const float sc = 0.08838834764831845f * LOG2E; store_bf16x8(sbq + (size_t)row * 1024 + (col - 1024), v0 * sc, v1 * sc); }
        else if (tile < 12) { store_bf16x8(sbk + (size_t)row * 1024 + (col - 2048), v0, v1); }
        else if (tile < 20) { store_bf16x8(ga + (size_t)row * 2048 + (col - 3072), sig4(v0), sig4(v1)); }
        else { store_bf16x8(gb + (size_t)row * 2048 + (col - 5120), sig4(v0), sig4(v1)); }
    }
};
struct EpiT { bf16_t* o; const float* cscale;
    DI void operator()(int row, int col, f32x4 v) const { if (cscale) v = v * *(const f32x4*)(cscale + col); store_bf16x4(o + (size_t)row * M + col, v); }
    DI void operator()(int row, int col, f32x4 v0, f32x4 v1) const { if (cscale) { v0 = v0 * *(const f32x4*)(cscale + col); v1 = v1 * *(const f32x4*)(cscale + col + 4); } store_bf16x8(o + (size_t)row * M + col, v0, v1); } };
struct EpiUq { bf16_t* q; const float* rst; const f32x2* cs;
    DI void operator()(int row, int col, f32x4 v) const {
        v = v * (rst[row] * (0.07216878364870322f * LOG2E));
        const int j = col % 192;
        if (j >= 128) { const int i0 = (j - 128) >> 1; const f32x2 c0 = cs[row * 32 + i0], c1 = cs[row * 32 + i0 + 1];
            v = (f32x4){v[0] * c0.x - v[1] * c0.y, v[1] * c0.x + v[0] * c0.y, v[2] * c1.x - v[3] * c1.y, v[3] * c1.x + v[2] * c1.y}; }
        store_bf16x4(q + (size_t)row * 1536 + col, v);
    }
    DI void operator()(int row, int col, f32x4 v0, f32x4 v1) const {
        const float sc = rst[row] * (0.07216878364870322f * LOG2E); v0 = v0 * sc; v1 = v1 * sc;
        const int j = col % 192;
        if (j >= 128) { const f32x2* cp = cs + row * 32 + ((j - 128) >> 1); v0 = rope4(v0, cp[0], cp[1]); v1 = rope4(v1, cp[2], cp[3]); }
        store_bf16x8(q + (size_t)row * 1536 + col, v0, v1);
    } };
struct EpiRowScale { bf16_t* o; int ld; const float* rst;
    DI void operator()(int row, int col, f32x4 v) const { store_bf16x4(o + (size_t)row * ld + col, v * rst[row]); }
    DI void operator()(int row, int col, f32x4 v0, f32x4 v1) const { const float sc = rst[row]; store_bf16x8(o + (size_t)row * ld + col, v0 * sc, v1 * sc); } };
struct EpiGate1 { bf16_t* mg; const bf16_t* g;
    static constexpr int MB = 4; typedef u32x4 Pre;
    DI Pre load(int row, int col) const { return *(const u32x4*)(g + (size_t)row * 2048 + col); }
    DI void apply(int row, int col, f32x4 v0, f32x4 v1, const Pre& w) const { const size_t i = (size_t)row * 2048 + col;
        const f32x4 g0 = {bflo(w.x), bfhi(w.x), bflo(w.y), bfhi(w.y)}, g1 = {bflo(w.z), bfhi(w.z), bflo(w.w), bfhi(w.w)}; store_bf16x8(mg + i, v0 * g0, v1 * g1); }
    DI void operator()(int row, int col, f32x4 v) const { const size_t i = (size_t)row * 2048 + col; store_bf16x4(mg + i, v * load_bf16x4(g + i)); }
    DI void operator()(int row, int col, f32x4 v0, f32x4 v1) const { const size_t i = (size_t)row * 2048 + col; f32x4 g0, g1; load_bf16x8(g + i, g0, g1); store_bf16x8(mg + i, v0 * g0, v1 * g1); } };
struct EpiGate2 { bf16_t* mg; const bf16_t* g;
    static constexpr int MB = 2; struct Pre { u32x4 g, m; };
    DI Pre load(int row, int col) const { const size_t i = (size_t)row * 2048 + col; Pre q; q.g = *(const u32x4*)(g + i); q.m = *(const u32x4*)(mg + i); return q; }
    DI void apply(int row, int col, f32x4 v0, f32x4 v1, const Pre& q) const { const size_t i = (size_t)row * 2048 + col;
        const f32x4 g0 = {bflo(q.g.x), bfhi(q.g.x), bflo(q.g.y), bfhi(q.g.y)}, g1 = {bflo(q.g.z), bfhi(q.g.z), bflo(q.g.w), bfhi(q.g.w)};
        const f32x4 m0 = {bflo(q.m.x), bfhi(q.m.x), bflo(q.m.y), bfhi(q.m.y)}, m1 = {bflo(q.m.z), bfhi(q.m.z), bflo(q.m.w), bfhi(q.m.w)};
        store_bf16x8(mg + i, m0 + v0 * g0, m1 + v1 * g1); }
    DI void operator()(int row, int col, f32x4 v) const { const size_t i = (size_t)row * 2048 + col; store_bf16x4(mg + i, load_bf16x4(mg + i) + v * load_bf16x4(g + i)); }
    DI void operator()(int row, int col, f32x4 v0, f32x4 v1) const { const size_t i = (size_t)row * 2048 + col; f32x4 g0, g1, m0, m1; load_bf16x8(g + i, g0, g1); load_bf16x8(mg + i, m0, m1); store_bf16x8(mg + i, m0 + v0 * g0, m1 + v1 * g1); } };
struct EpiRes { const float* x; const float* gt; float* x1;
    static constexpr int MB = 2; struct Pre { f32x4 a, b; };
    DI Pre load(int row, int col) const { const size_t i = (size_t)row * 2048 + col; Pre q; q.a = *(const f32x4*)(x + i); q.b = *(const f32x4*)(x + i + 4); return q; }
    DI void apply(int row, int col, f32x4 v0, f32x4 v1, const Pre& q) const { const size_t i = (size_t)row * 2048 + col; const int b = row / SEQ; const float* gp = gt + b * 6 * D + col;
        *(f32x4*)(x1 + i) = q.a + *(const f32x4*)gp * v0 * DBG_ALPHA; *(f32x4*)(x1 + i + 4) = q.b + *(const f32x4*)(gp + 4) * v1 * DBG_ALPHA; }
    DI void operator()(int row, int col, f32x4 v) const { const size_t i = (size_t)row * 2048 + col; const int b = row / SEQ;
        *(f32x4*)(x1 + i) = *(const f32x4*)(x + i) + *(const f32x4*)(gt + b * 6 * D + col) * v * DBG_ALPHA; }
    DI void operator()(int row, int col, f32x4 v0, f32x4 v1) const { (*this)(row, col, v0); (*this)(row, col + 4, v1); } };
struct EpiPq { bf16_t* pq;
    DI void operator()(int row, int col, f32x4 v) const { store_bf16x4(pq + (size_t)(col >> 8) * M * 256 + (size_t)row * 256 + (col & 255), v); }
    DI void operator()(int row, int col, f32x4 v0, f32x4 v1) const { store_bf16x8(pq + (size_t)(col >> 8) * M * 256 + (size_t)row * 256 + (col & 255), v0, v1); } };

template <class Epi>
DI void gemm_naive(const Ctx& c, const bf16_t* A, const bf16_t* Bt, int Mg, int Ng, int Kg, const Epi& E) {
    LAS float* As = (LAS float*)c.lds; LAS float* Bs = As + 16 * 132;
    const int tid = c.tid, ty = tid >> 5, tx = tid & 31;
    const int tilesN = Ng / 128, ntiles = (Mg / 128) * tilesN;
    for (int t = blockIdx.x; t < ntiles; t += gridDim.x) {
        const int tm = t / tilesN, tn = t % tilesN;
        float acc[8][4];
#pragma unroll
        for (int i = 0; i < 8; ++i)
#pragma unroll
            for (int j = 0; j < 4; ++j) acc[i][j] = 0.f;
        for (int k0 = 0; k0 < Kg; k0 += 16) {
            { const int lt = tid & 255, r = lt >> 1, kc = lt & 1;
              const bf16_t* src = (tid < 256 ? A + (size_t)(tm * 128 + r) * Kg : Bt + (size_t)(tn * 128 + r) * Kg) + k0 + kc * 8;
              const u32x4 v = *(const u32x4*)src;
              LAS float* dst = (tid < 256 ? As : Bs) + (kc * 8) * 132 + r;
              dst[0] = bflo(v.x); dst[132] = bfhi(v.x); dst[2 * 132] = bflo(v.y); dst[3 * 132] = bfhi(v.y);
              dst[4 * 132] = bflo(v.z); dst[5 * 132] = bfhi(v.z); dst[6 * 132] = bflo(v.w); dst[7 * 132] = bfhi(v.w); }
            __syncthreads();
#pragma unroll
            for (int kk = 0; kk < 16; ++kk) {
                const f32x4 a0 = *(const LAS f32x4*)(As + kk * 132 + ty * 8), a1 = *(const LAS f32x4*)(As + kk * 132 + ty * 8 + 4);
                const f32x4 b = *(const LAS f32x4*)(Bs + kk * 132 + tx * 4);
#pragma unroll
                for (int j = 0; j < 4; ++j) {
                    acc[0][j] += a0[0] * b[j]; acc[1][j] += a0[1] * b[j]; acc[2][j] += a0[2] * b[j]; acc[3][j] += a0[3] * b[j];
                    acc[4][j] += a1[0] * b[j]; acc[5][j] += a1[1] * b[j]; acc[6][j] += a1[2] * b[j]; acc[7][j] += a1[3] * b[j];
                }
            }
            __syncthreads();
        }
#pragma unroll
        for (int i = 0; i < 8; ++i) E(tm * 128 + ty * 8 + i, tn * 128 + tx * 4, (f32x4){acc[i][0], acc[i][1], acc[i][2], acc[i][3]});
    }
}

namespace pg8 {
#define PG8_LAS __attribute__((address_space(3)))
typedef unsigned short bf16_t;
typedef short bf16x8 __attribute__((ext_vector_type(8)));
typedef float f32x4 __attribute__((ext_vector_type(4)));
typedef unsigned u32x4 __attribute__((ext_vector_type(4)));
constexpr int BM = 256, BK = 64, HALF = 128, HTB = HALF * BK * 2  , STAGE_BYTES = 8 * HTB, NXCD = 8, WGM = 4;

__host__ __device__ __forceinline__ int lds_byte(int r, int c) { const int st = (r >> 4) * 2 + (c >> 5), rr = r & 15, cc = c & 31, ob = rr * 64 + cc * 2; return st * 1024 + (ob ^ (((ob >> 9) & 1) << 5)); }
__host__ __device__ __forceinline__ void stage_rc(int b, int& R, int& C) { const int st = b / 1024, sb = b % 1024, swz = sb ^ (((sb >> 9) & 1) << 5); R = (st >> 1) * 16 + swz / 64; C = (st & 1) * 32 + (swz % 64) / 2; }
__host__ __device__ __forceinline__ int perm32(int rho) { const int n = rho >> 4, i = rho & 15; return 8 * (i >> 2) + 4 * n + (i & 3); }

struct Unit { int pm, pn; };
struct Gemm { const bf16_t* A; const bf16_t* Bt; int M, N, K; int tid; };
struct StaticOrder {
    int nM, nN, nwg, G, c;
    __host__ __device__ void init(int M, int N, int G_, int c_) { nM = M / BM; nN = N / BM; nwg = nM * nN; G = G_; c = c_; }
    __host__ __device__ bool next(int i, Unit& u) const {
        const long L = (long)i * G + c; if (L >= nwg) return false;
        int wgid = (int)L; { const int q = nwg / NXCD, r = nwg % NXCD, xcd = wgid % NXCD, off = wgid / NXCD; wgid = (xcd < r ? xcd * (q + 1) : r * (q + 1) + (xcd - r) * q) + off; }
        const int nig = WGM * nN, gid = wgid / nig, fm = gid * WGM, gsz = (nM - fm) < WGM ? (nM - fm) : WGM;
        u.pm = fm + ((wgid % nig) % gsz); u.pn = (wgid % nig) / gsz; return true;
    }
    __device__ __forceinline__ void a_ready(const Unit&) const {}
    __device__ __forceinline__ void done(const Unit&) const {}
};
template <class Epi, class Sched, bool STAMP = false>
__device__ __forceinline__ void gemm_phase(PG8_LAS unsigned char* lds, const Gemm g, const Sched& S, const Epi& E, unsigned long long* stamps) {
    const int tid = g.tid, wid = __builtin_amdgcn_readfirstlane(tid >> 6), lane = tid & 63, wr = wid >> 2, wc = wid & 3, fr = lane & 15, fq = lane >> 4;
    const int K = g.K, nt = K / BK;
    int ts_lo = 0, ts_hi = 0, nts = 0; const unsigned long long rt_entry = STAMP ? (unsigned long long)wall_clock64() : 0ull;
#define PG8_STAMP() do { if (STAMP && wid == 0 && nts < 64) { const unsigned long long _c = (unsigned long long)clock64(); \
        ts_lo = (lane == nts) ? (int)(unsigned)_c : ts_lo; ts_hi = (lane == nts) ? (int)(unsigned)(_c >> 32) : ts_hi; ++nts; } } while (0)
    PG8_STAMP();
    unsigned voffA[2], voffB[2];
#pragma unroll
    for (int i = 0; i < 2; ++i) { int R, C; stage_rc(tid * 16 + i * 8192, R, C); const int Rb = Epi::PERM ? ((R & ~31) + perm32(R & 31)) : R;
        voffA[i] = (unsigned)(R * K + C) * 2u; voffB[i] = (unsigned)(Rb * K + C) * 2u; }
    const size_t kstep = (size_t)(BK * 2);
    const size_t hstep = (size_t)HALF * K * 2;
    const size_t tstep = 2 * hstep;
    const unsigned ldsw = (unsigned)wid * 1024u;
    const int aoff = lds_byte(wr * 64 + fr, fq * 8), boff = lds_byte(wc * 32 + fr, fq * 8);
#define PG8_SA(b, h) (((b) * 2 + (h)) * HTB)
#define PG8_SB(b, h) ((4 + (b) * 2 + (h)) * HTB)
#define PG8_STAGE(bufoff, gbase, voff) do { _Pragma("unroll") for (int _i = 0; _i < 2; ++_i) \
        __builtin_amdgcn_global_load_lds((const unsigned*)((const char*)(gbase) + (voff)[_i]), (PG8_LAS unsigned*)(lds + (bufoff) + ldsw + _i * 8192), 16, 0, 0); } while (0)
#define PG8_LDA(dst, b, h) do { _Pragma("unroll") for (int m = 0; m < 4; ++m) _Pragma("unroll") for (int k = 0; k < 2; ++k) dst[m][k] = *(const PG8_LAS bf16x8*)(lds + PG8_SA(b, h) + aoff + m * 2048 + k * 1024); } while (0)
#define PG8_LDB(dst, b, h) do { _Pragma("unroll") for (int n = 0; n < 2; ++n) _Pragma("unroll") for (int k = 0; k < 2; ++k) dst[n][k] = *(const PG8_LAS bf16x8*)(lds + PG8_SB(b, h) + boff + n * 2048 + k * 1024); } while (0)
#define PG8_MMA(ai, bj, At, Bt) do { __builtin_amdgcn_s_setprio(1); _Pragma("unroll") for (int m = 0; m < 4; ++m) _Pragma("unroll") for (int n = 0; n < 2; ++n) _Pragma("unroll") for (int k = 0; k < 2; ++k) \
        acc[ai][bj][m][n] = __builtin_amdgcn_mfma_f32_16x16x32_bf16(Bt[n][k], At[m][k], acc[ai][bj][m][n], 0, 0, 0); __builtin_amdgcn_s_setprio(0); } while (0)
#define PG8_WAIT_V(n) asm volatile("s_waitcnt vmcnt(" #n ")" ::: "memory")
#define PG8_WAIT_L(n) asm volatile("s_waitcnt lgkmcnt(" #n ")" ::: "memory")
#define PG8_BAR __builtin_amdgcn_s_barrier()
#define PG8_SCHED __builtin_amdgcn_sched_barrier(0)
    Unit cur, nxt; int ui = 0;
    if (!S.next(0, cur)) return;
    f32x4 acc[2][2][4][2];
#pragma unroll
    for (int a = 0; a < 2; ++a)
#pragma unroll
        for (int b = 0; b < 2; ++b)
#pragma unroll
            for (int m = 0; m < 4; ++m)
#pragma unroll
                for (int n = 0; n < 2; ++n) acc[a][b][m][n] = (f32x4){0.f, 0.f, 0.f, 0.f};
    bf16x8 At[4][2], B0[2][2], B1[2][2];
    const char* cA = (const char*)g.A + (size_t)cur.pm * tstep; const char* cB = (const char*)g.Bt + (size_t)cur.pn * tstep;
    S.a_ready(cur);
    PG8_STAGE(PG8_SB(0, 0), cB, voffB); PG8_STAGE(PG8_SA(0, 0), cA, voffA); PG8_STAGE(PG8_SB(0, 1), cB + hstep, voffB); PG8_STAGE(PG8_SA(0, 1), cA + hstep, voffA);
    if (wr == 1) PG8_BAR;
    PG8_WAIT_V(4); PG8_BAR;
    PG8_STAGE(PG8_SB(1, 0), cB + kstep, voffB); PG8_STAGE(PG8_SA(1, 0), cA + kstep, voffA); PG8_STAGE(PG8_SB(1, 1), cB + hstep + kstep, voffB);
    PG8_WAIT_V(6); PG8_BAR;
    PG8_STAMP();
    for (;;) {
        const bool has_next = S.next(ui + 1, nxt);
        const char* nA = has_next ? (const char*)g.A + (size_t)nxt.pm * tstep : cA; const char* nB = has_next ? (const char*)g.Bt + (size_t)nxt.pn * tstep : cB;
        for (int t = 0; t < nt; t += 2) {
            const bool last = (t == nt - 2);
            const char* a1 = cA + (size_t)(t + 1) * kstep;
            const char* a2 = last ? nA : cA + (size_t)(t + 2) * kstep; const char* b2 = last ? nB : cB + (size_t)(t + 2) * kstep;
            const char* a3 = a2 + kstep; const char* b3 = b2 + kstep;
            if (last && has_next) S.a_ready(nxt);
            PG8_LDB(B0, 0, 0); PG8_SCHED; PG8_LDA(At, 0, 0); PG8_STAGE(PG8_SA(1, 1), a1 + hstep, voffA);
            PG8_WAIT_L(8); PG8_BAR; PG8_WAIT_L(0); PG8_MMA(0, 0, At, B0); PG8_BAR; PG8_SCHED;
            PG8_LDB(B1, 0, 1); PG8_STAGE(PG8_SB(0, 0), b2, voffB);
            PG8_BAR; PG8_WAIT_L(0); PG8_MMA(0, 1, At, B1); PG8_BAR;
            PG8_LDA(At, 0, 1); PG8_STAGE(PG8_SA(0, 0), a2, voffA);
            PG8_BAR; PG8_WAIT_L(0); PG8_MMA(1, 0, At, B0); PG8_BAR; PG8_SCHED;
            PG8_STAGE(PG8_SB(0, 1), b2 + hstep, voffB);
            PG8_WAIT_V(6); PG8_BAR; PG8_MMA(1, 1, At, B1); PG8_BAR;
            PG8_LDB(B0, 1, 0); PG8_SCHED; PG8_LDA(At, 1, 0); PG8_STAGE(PG8_SA(0, 1), a2 + hstep, voffA);
            PG8_WAIT_L(8); PG8_BAR; PG8_WAIT_L(0); PG8_MMA(0, 0, At, B0); PG8_BAR; PG8_SCHED;
            PG8_LDB(B1, 1, 1); PG8_STAGE(PG8_SB(1, 0), b3, voffB);
            PG8_BAR; PG8_WAIT_L(0); PG8_MMA(0, 1, At, B1); PG8_BAR;
            PG8_LDA(At, 1, 1); PG8_STAGE(PG8_SA(1, 0), a3, voffA);
            PG8_BAR; PG8_WAIT_L(0); PG8_MMA(1, 0, At, B0); PG8_BAR; PG8_SCHED;
            PG8_STAGE(PG8_SB(1, 1), b3 + hstep, voffB);
            PG8_WAIT_V(6); PG8_BAR; PG8_MMA(1, 1, At, B1); PG8_BAR;
        }
        PG8_STAMP();
        if constexpr (!Epi::AFTER_DRAIN) { E(acc, cur, wr, wc, fr, fq); S.done(cur); }
        PG8_STAMP();
        if (!has_next) break;
#pragma unroll
        for (int a = 0; a < 2; ++a)
#pragma unroll
            for (int b = 0; b < 2; ++b)
#pragma unroll
                for (int m = 0; m < 4; ++m)
#pragma unroll
                    for (int n = 0; n < 2; ++n) acc[a][b][m][n] = (f32x4){0.f, 0.f, 0.f, 0.f};
        cur = nxt; cA = nA; cB = nB; ++ui;
    }
    PG8_WAIT_V(0);
    if (wr == 0) PG8_BAR;
    PG8_BAR;
    if constexpr (Epi::AFTER_DRAIN) { E.fused(acc, cur, wr, wc, fr, fq, lds, wid, lane); S.done(cur); }
    PG8_STAMP();
    if (STAMP && wid == 0) { stamps[lane] = lane < nts ? (((unsigned long long)(unsigned)ts_hi << 32) | (unsigned)ts_lo) : 0ull;
        if (lane == 62) stamps[62] = rt_entry; if (lane == 63) stamps[63] = (unsigned long long)wall_clock64(); }
#undef PG8_STAMP
#undef PG8_SA
#undef PG8_SB
#undef PG8_STAGE
#undef PG8_LDA
#undef PG8_LDB
#undef PG8_MMA
#undef PG8_WAIT_V
#undef PG8_WAIT_L
#undef PG8_BAR
#undef PG8_SCHED
}
}

template <class E4, class = void> struct epi_mb { static constexpr int value = 0; };
template <class E4> struct epi_mb<E4, decltype((void)E4::MB)> { static constexpr int value = E4::MB; };
template <class E4> struct EpiAdapt {
    static constexpr bool PERM = true, AFTER_DRAIN = false;
    E4 e;
    __device__ __forceinline__ void operator()(const pg8::f32x4 (&acc)[2][2][4][2], const pg8::Unit& u, int wr, int wc, int fr, int fq) const {
        if constexpr (epi_mb<E4>::value > 0) {
            constexpr int MB = epi_mb<E4>::value;
#pragma unroll
            for (int ai = 0; ai < 2; ++ai)
#pragma unroll
                for (int m0 = 0; m0 < 4; m0 += MB) {
                    typename E4::Pre pre[MB][2];
#pragma unroll
                    for (int mi = 0; mi < MB; ++mi)
#pragma unroll
                        for (int bj = 0; bj < 2; ++bj) pre[mi][bj] = e.load(u.pm * 256 + ai * 128 + wr * 64 + (m0 + mi) * 16 + fr, u.pn * 256 + bj * 128 + wc * 32 + fq * 8);
#pragma unroll
                    for (int mi = 0; mi < MB; ++mi)
#pragma unroll
                        for (int bj = 0; bj < 2; ++bj) e.apply(u.pm * 256 + ai * 128 + wr * 64 + (m0 + mi) * 16 + fr, u.pn * 256 + bj * 128 + wc * 32 + fq * 8, acc[ai][bj][m0 + mi][0], acc[ai][bj][m0 + mi][1], pre[mi][bj]);
                    asm volatile("" ::: "memory");
                }
        } else {
#pragma unroll
        for (int ai = 0; ai < 2; ++ai)
#pragma unroll
            for (int m = 0; m < 4; ++m) {
                const int row = u.pm * 256 + ai * 128 + wr * 64 + m * 16 + fr;
#pragma unroll
                for (int bj = 0; bj < 2; ++bj) e(row, u.pn * 256 + bj * 128 + wc * 32 + fq * 8, acc[ai][bj][m][0], acc[ai][bj][m][1]);
                asm volatile("" ::: "memory");
            }
        }
    }
};
template <class E4>
DI void gemm_fast(const Ctx& c, const bf16_t* A, const bf16_t* Bt, int Mg, int Ng, int Kg, const E4& e4) {
    pg8::Gemm g{A, Bt, Mg, Ng, Kg, c.tid}; pg8::StaticOrder S; S.init(Mg, Ng, (int)gridDim.x, (int)blockIdx.x);
    EpiAdapt<E4> E{e4};
    pg8::gemm_phase<EpiAdapt<E4>, pg8::StaticOrder, false>((PG8_LAS unsigned char*)c.lds, g, S, E, nullptr);
}
#ifndef FAST_GEMM
#define FAST_GEMM 1
#endif
#if FAST_GEMM
#define GEMM(c_, ...) do { MKCTX(); gemm_fast(c, __VA_ARGS__); } while (0)
#else
#define GEMM(c_, ...) do { MKCTX(); gemm_naive(c, __VA_ARGS__); } while (0)
#endif

DI void attn_mla_naive(const Params& p, const Ctx& c) {
    const bf16_t* Q = (const bf16_t*)(p.ws + OFF_Q); const bf16_t* KN = (const bf16_t*)(p.ws + OFF_KN); const bf16_t* KR = (const bf16_t*)(p.ws + OFF_KR);
    const bf16_t* VT = (const bf16_t*)(p.ws + OFF_VT); bf16_t* O = (bf16_t*)(p.ws + OFF_ATTA);
    for (int u = c.gw; u < M * 8; u += c.ngw) {
        const int m = u >> 3, hd = u & 7, b = m / SEQ, s = m % SEQ, base = b * SEQ, nkeys = ((s >> 6) + 1) << 6;
        const float q0 = bf2f(Q[(size_t)m * 1536 + hd * 192 + c.lane]), q1 = bf2f(Q[(size_t)m * 1536 + hd * 192 + 64 + c.lane]), q2 = bf2f(Q[(size_t)m * 1536 + hd * 192 + 128 + c.lane]);
        float mx = -1e30f, l = 0.f, o0 = 0.f, o1 = 0.f;
        const bf16_t* v0p = VT + (size_t)(hd * 128 + c.lane) * M + base; const bf16_t* v1p = v0p + (size_t)64 * M;
        for (int kk = 0; kk < nkeys; ++kk) {
            const size_t tk = base + kk;
            const float part = q0 * bf2f(KN[tk * 1024 + hd * 128 + c.lane]) + q1 * bf2f(KN[tk * 1024 + hd * 128 + 64 + c.lane]) + q2 * bf2f(KR[tk * 64 + c.lane]);
            const float sc = wave_sum(part);
            const float mn = fmaxf(mx, sc), al = exp2f(mx - mn), pp = exp2f(sc - mn);
            l = l * al + pp; o0 = o0 * al + pp * bf2f(v0p[kk]); o1 = o1 * al + pp * bf2f(v1p[kk]); mx = mn;
        }
        const float inv = 1.f / l;
        O[(size_t)m * 1024 + hd * 128 + c.lane] = (bf16_t)(pk2(o0 * inv, 0.f) & 0xffff);
        O[(size_t)m * 1024 + hd * 128 + 64 + c.lane] = (bf16_t)(pk2(o1 * inv, 0.f) & 0xffff);
    }
}
DI void attn_sb_naive(const Params& p, const Ctx& c) {
    const bf16_t* Q = (const bf16_t*)(p.ws + OFF_SBQ); const bf16_t* K = (const bf16_t*)(p.ws + OFF_SBK);
    const bf16_t* VT = (const bf16_t*)(p.ws + OFF_SBVT); bf16_t* O = (bf16_t*)(p.ws + OFF_ATTB);
    for (int u = c.gw; u < M * 8; u += c.ngw) {
        const int m = u >> 3, hd = u & 7, b = m / SEQ, s = m % SEQ, base = b * SEQ;
        const float q0 = bf2f(Q[(size_t)m * 1024 + hd * 128 + c.lane]), q1 = bf2f(Q[(size_t)m * 1024 + hd * 128 + 64 + c.lane]);
        float later = 0.f, o0 = 0.f, o1 = 0.f;
        const bf16_t* v0p = VT + (size_t)(hd * 128 + c.lane) * M + base; const bf16_t* v1p = v0p + (size_t)64 * M;
        for (int kk = s - 1; kk >= 0; --kk) {
            const size_t tk = base + kk;
            const float z2 = wave_sum(q0 * bf2f(K[tk * 1024 + hd * 128 + c.lane]) + q1 * bf2f(K[tk * 1024 + hd * 128 + 64 + c.lane]));
            const float ln2 = -(fmaxf(z2, 0.f) + __log2f(1.f + exp2f(-fabsf(z2))));
            const float w = exp2f(z2 + ln2 + later);
            later += ln2; o0 += w * bf2f(v0p[kk]); o1 += w * bf2f(v1p[kk]);
        }
        O[(size_t)m * 1024 + hd * 128 + c.lane] = (bf16_t)(pk2(o0, 0.f) & 0xffff);
        O[(size_t)m * 1024 + hd * 128 + 64 + c.lane] = (bf16_t)(pk2(o1, 0.f) & 0xffff);
    }
}


typedef float f32x16 __attribute__((ext_vector_type(16)));
#define MFMA32(a, b, c) __builtin_amdgcn_mfma_f32_32x32x16_bf16((a), (b), (c), 0, 0, 0)
constexpr int ST_KR = 16384, ST_VT = 24576, ST_BYTES = 40960;
constexpr int ATT_FLAGS = 2 * ST_BYTES;
DI float ex2(float x) { return __builtin_amdgcn_exp2f(x); }
DI float lg2(float x) { return __builtin_amdgcn_logf(x); }
DI bf16x8 pack8(float a0, float a1, float a2, float a3, float a4, float a5, float a6, float a7) {
    u32x4 t; t.x = pk2(a0, a1); t.y = pk2(a2, a3); t.z = pk2(a4, a5); t.w = pk2(a6, a7); return __builtin_bit_cast(bf16x8, t); }
#define GLDS16(gp, lp) __builtin_amdgcn_global_load_lds((const unsigned*)(gp), (LAS unsigned*)(lp), 16, 0, 0)

struct AttDmaOff { unsigned kn[2], kr, vt[2]; };
DI AttDmaOff att_dma_offsets(int w, int lane) {
    AttDmaOff o; const unsigned lr = lane >> 4, pp = lane & 15;
#pragma unroll
    for (int i = 0; i < 2; ++i) { const unsigned q = w * 2 + i, R = 4 * q + lr, cc = pp ^ (R & 15); o.kn[i] = R * 2048u + cc * 16u; }
    { const unsigned q = w, R2 = 4 * q + lr, cc = pp ^ (R2 & 15); o.kr = (2 * R2 + (cc >> 3)) * 128u + (cc & 7) * 16u; }
#pragma unroll
    for (int i = 0; i < 2; ++i) { const unsigned q = w * 2 + i, R2 = 4 * q + lr, cc = pp ^ (R2 & 15); o.vt[i] = (2 * R2 + (cc >> 3)) * (unsigned)(M * 2) + (cc & 7) * 16u; }
    return o;
}
template <bool ROPE>
DI void att_dma(LAS unsigned char* buf, __amdgpu_buffer_rsrc_t rs, const AttDmaOff& o, unsigned k_so, unsigned kr_so, unsigned vt_so, int w) {
#pragma unroll
    for (int i = 0; i < 2; ++i) __builtin_amdgcn_raw_ptr_buffer_load_lds(rs, (LAS void*)(buf + (w * 2 + i) * 1024), 16, o.kn[i], k_so, 0, 0);
    if (ROPE) __builtin_amdgcn_raw_ptr_buffer_load_lds(rs, (LAS void*)(buf + ST_KR + w * 1024), 16, o.kr, kr_so, 0, 0);
#pragma unroll
    for (int i = 0; i < 2; ++i) __builtin_amdgcn_raw_ptr_buffer_load_lds(rs, (LAS void*)(buf + ST_VT + (w * 2 + i) * 1024), 16, o.vt[i], vt_so, 0, 0);
}
DI void att_store(const f32x16 (&o)[4], float scale, bf16_t* O, size_t row, int hd, int h) {
#pragma unroll
    for (int db = 0; db < 4; ++db)
#pragma unroll
        for (int g = 0; g < 4; ++g)
            store_bf16x4(O + row * 1024 + hd * 128 + db * 32 + g * 8 + h * 4, (f32x4){o[db][4 * g] * scale, o[db][4 * g + 1] * scale, o[db][4 * g + 2] * scale, o[db][4 * g + 3] * scale});
}
DI void att_pv(f32x16 (&o)[4], const bf16x8 (&pf)[2][2], const LAS unsigned char* buf, unsigned va) {
#pragma unroll
    for (int db = 0; db < 4; ++db) {
#pragma unroll
        for (int blk = 0; blk < 2; ++blk)
#pragma unroll
            for (int ks = 0; ks < 2; ++ks) o[db] = MFMA32(*(const LAS bf16x8*)(buf + ((va ^ ((blk * 2 + ks) << 5)) + db * 4096)), pf[blk][ks], o[db]);
        asm volatile("" ::: "memory");
    }
}

DI void attn_mla_fast(const Params& p, const Ctx& c) {
    const bf16_t* Q = (const bf16_t*)(p.ws + OFF_Q); const bf16_t* KN = (const bf16_t*)(p.ws + OFF_KN); const bf16_t* KR = (const bf16_t*)(p.ws + OFF_KR);
    const bf16_t* VT = (const bf16_t*)(p.ws + OFF_VT); bf16_t* O = (bf16_t*)(p.ws + OFF_ATTA);
    const int lane = c.lane, r = lane & 31, h = lane >> 5, w = c.wave;
    const int pr = (r & 0x13) | ((r & 4) << 1) | ((r & 8) >> 1);
    const unsigned ka = (pr << 8) | ((((pr & 15) ^ h) & 15) << 4);
    const unsigned ra = ST_KR + (((pr >> 1) << 8) | (((((pr & 1) << 3) | h) ^ ((pr >> 1) & 15)) << 4));
    const unsigned va = ST_VT + (((r >> 1) << 8) | (((((r & 1) << 3) | h) ^ ((r >> 1) & 15)) << 4));
    const __amdgpu_buffer_rsrc_t rs = __builtin_amdgcn_make_buffer_rsrc((void*)p.ws, (short)0, (int)WS_END, 0x00020000);
    const AttDmaOff dof = att_dma_offsets(w, lane);
    for (int it = blockIdx.x; it < 256; it += gridDim.x) {
        const int bh = it & 31, b = bh >> 3, hd = bh & 7, pairi = it >> 5;
#pragma unroll 1
        for (int half = 0; half < 2; ++half) {
            const int qb = half ? 15 - pairi : pairi, q0 = qb * 256;
            const size_t base = (size_t)b * SEQ, qrow = base + q0 + w * 32 + r;
            bf16x8 qf[12];
#pragma unroll
            for (int st = 0; st < 12; ++st) qf[st] = *(const bf16x8*)(Q + qrow * 1536 + hd * 192 + st * 16 + h * 8);
            const int ntile = q0 / 64 + 4, myn = (q0 + w * 32) / 64 + 1;
            f32x16 o[4];
#pragma unroll
            for (int db = 0; db < 4; ++db)
#pragma unroll
                for (int i = 0; i < 16; ++i) o[db][i] = 0.f;
            float mrun = -1e30f, lrun = 0.f;
            __syncthreads();
            const unsigned k_so0 = (unsigned)(OFF_KN + (base * 1024 + hd * 128) * 2), kr_so0 = (unsigned)(OFF_KR + base * 64 * 2), vt_so0 = (unsigned)(OFF_VT + ((size_t)(hd * 128) * M + base) * 2);
            att_dma<true>(c.lds, rs, dof, k_so0, kr_so0, vt_so0, w);
            asm volatile("s_waitcnt vmcnt(0)" ::: "memory");
            __syncthreads();
            for (int j = 0; j < ntile; ++j) {
                LAS unsigned char* buf = c.lds + (j & 1) * ST_BYTES;
                if (j + 1 < ntile) att_dma<true>(c.lds + ((j + 1) & 1) * ST_BYTES, rs, dof, k_so0 + (unsigned)(j + 1) * (64 * 2048), kr_so0 + (unsigned)(j + 1) * (64 * 128), vt_so0 + (unsigned)(j + 1) * 128, w);
                if (j < myn) {
                    f32x16 s0, s1;
#pragma unroll
                    for (int i = 0; i < 16; ++i) { s0[i] = 0.f; s1[i] = 0.f; }
                    __builtin_amdgcn_s_setprio(1);
#pragma unroll
                    for (int st = 0; st < 8; ++st) {
                        s0 = MFMA32(*(const LAS bf16x8*)(buf + (ka ^ (st << 5))), qf[st], s0);
                        s1 = MFMA32(*(const LAS bf16x8*)(buf + ((ka ^ (st << 5)) + 8192)), qf[st], s1);
                    }
#pragma unroll
                    for (int st = 0; st < 4; ++st) {
                        s0 = MFMA32(*(const LAS bf16x8*)(buf + (ra ^ (st << 5))), qf[8 + st], s0);
                        s1 = MFMA32(*(const LAS bf16x8*)(buf + ((ra ^ (st << 5)) + 4096)), qf[8 + st], s1);
                    }
                    __builtin_amdgcn_s_setprio(0);
                    float mx = fmaxf(s0[0], s1[0]);
#pragma unroll
                    for (int i = 1; i < 16; ++i) mx = fmaxf(mx, fmaxf(s0[i], s1[i]));
                    mx = fmaxf(mx, __shfl_xor(mx, 32));
                    const float mnew = fmaxf(mrun, mx), alpha = ex2(mrun - mnew);
                    mrun = mnew;
                    float ps = 0.f;
#pragma unroll
                    for (int i = 0; i < 16; ++i) { s0[i] = ex2(s0[i] - mnew); s1[i] = ex2(s1[i] - mnew); ps += s0[i] + s1[i]; }
                    lrun = lrun * alpha + ps;
#pragma unroll
                    for (int db = 0; db < 4; ++db)
#pragma unroll
                        for (int i = 0; i < 16; ++i) o[db][i] *= alpha;
                    bf16x8 pf[2][2];
                    pf[0][0] = pack8(s0[0], s0[1], s0[2], s0[3], s0[4], s0[5], s0[6], s0[7]); pf[0][1] = pack8(s0[8], s0[9], s0[10], s0[11], s0[12], s0[13], s0[14], s0[15]);
                    pf[1][0] = pack8(s1[0], s1[1], s1[2], s1[3], s1[4], s1[5], s1[6], s1[7]); pf[1][1] = pack8(s1[8], s1[9], s1[10], s1[11], s1[12], s1[13], s1[14], s1[15]);
                    __builtin_amdgcn_s_setprio(1);
                    att_pv(o, pf, buf, va);
                    __builtin_amdgcn_s_setprio(0);
                }
                asm volatile("s_waitcnt vmcnt(0)" ::: "memory");
                __syncthreads();
            }
            const float ltot = lrun + __shfl_xor(lrun, 32);
            att_store(o, 1.f / ltot, O, qrow, hd, h);
        }
    }
}

DI void attn_sb_fast(const Params& p, const Ctx& c) {
    const bf16_t* Q = (const bf16_t*)(p.ws + OFF_SBQ); const bf16_t* K = (const bf16_t*)(p.ws + OFF_SBK);
    const bf16_t* VT = (const bf16_t*)(p.ws + OFF_SBVT); bf16_t* O = (bf16_t*)(p.ws + OFF_ATTB);
    const int lane = c.lane, r = lane & 31, h = lane >> 5, w = c.wave, tid = c.tid;
    const int pr = (r & 0x13) | ((r & 4) << 1) | ((r & 8) >> 1);
    const unsigned ka = (pr << 8) | ((((pr & 15) ^ h) & 15) << 4);
    const unsigned va = ST_VT + (((r >> 1) << 8) | (((((r & 1) << 3) | h) ^ ((r >> 1) & 15)) << 4));
    const __amdgpu_buffer_rsrc_t rs = __builtin_amdgcn_make_buffer_rsrc((void*)p.ws, (short)0, (int)WS_END, 0x00020000);
    const AttDmaOff dof = att_dma_offsets(w, lane);
    LAS int* flags = (LAS int*)(c.lds + ATT_FLAGS);
    for (int it = blockIdx.x; it < 256; it += gridDim.x) {
        const int bh = it & 31, b = bh >> 3, hd = bh & 7, pairi = it >> 5;
#pragma unroll 1
        for (int half = 0; half < 2; ++half) {
            const int qb = half ? 15 - pairi : pairi, q0 = qb * 256;
            const size_t base = (size_t)b * SEQ, qrow = base + q0 + w * 32 + r;
            const int tq = q0 + w * 32 + r;
            bf16x8 qf[8];
#pragma unroll
            for (int st = 0; st < 8; ++st) qf[st] = *(const bf16x8*)(Q + qrow * 1024 + hd * 128 + st * 16 + h * 8);
            const int jmax = q0 / 64 + 3, jd = (q0 + w * 32) / 64;
            f32x16 o[4];
#pragma unroll
            for (int db = 0; db < 4; ++db)
#pragma unroll
                for (int i = 0; i < 16; ++i) o[db][i] = 0.f;
            float carry = 0.f; bool wdone = false;
            __syncthreads();
            const unsigned k_so0 = (unsigned)(OFF_SBK + (base * 1024 + hd * 128) * 2), vt_so0 = (unsigned)(OFF_SBVT + ((size_t)(hd * 128) * M + base) * 2);
            att_dma<false>(c.lds, rs, dof, k_so0 + (unsigned)jmax * (64 * 2048), 0u, vt_so0 + (unsigned)jmax * 128, w);
            if (tid < 16) flags[tid] = 0;
            asm volatile("s_waitcnt vmcnt(0)" ::: "memory");
            __syncthreads();
            int itn = 0;
            for (int j = jmax; j >= 0; --j, ++itn) {
                LAS unsigned char* buf = c.lds + (itn & 1) * ST_BYTES;
                if (j > 0) att_dma<false>(c.lds + ((itn + 1) & 1) * ST_BYTES, rs, dof, k_so0 + (unsigned)(j - 1) * (64 * 2048), 0u, vt_so0 + (unsigned)(j - 1) * 128, w);
                if (j <= jd && !wdone) {
                    f32x16 s0, s1;
#pragma unroll
                    for (int i = 0; i < 16; ++i) { s0[i] = 0.f; s1[i] = 0.f; }
#pragma unroll
                    for (int st = 0; st < 8; ++st) {
                        s0 = MFMA32(*(const LAS bf16x8*)(buf + (ka ^ (st << 5))), qf[st], s0);
                        s1 = MFMA32(*(const LAS bf16x8*)(buf + ((ka ^ (st << 5)) + 8192)), qf[st], s1);
                    }
                    const int kb0 = 64 * j + 8 * h - tq;
                    bf16x8 pf[2][2];
                    {
                        f32x16 l1;
#pragma unroll
                        for (int i = 0; i < 16; ++i) { const float z = s1[i]; const float a = -(fmaxf(z, 0.f) + lg2(1.f + ex2(-fabsf(z)))); l1[i] = (kb0 + 32 + 16 * (i >> 3) + (i & 7) < 0) ? a : 0.f; }
                        float g0 = 0.f, g1 = 0.f;
#pragma unroll
                        for (int e = 0; e < 8; ++e) { g0 += l1[e]; g1 += l1[8 + e]; }
                        const float p0 = __shfl_xor(g0, 32), p1 = __shfl_xor(g1, 32);
                        float run = carry + (h == 0 ? p1 : 0.f);
#pragma unroll
                        for (int e = 7; e >= 0; --e) { run += l1[8 + e]; l1[8 + e] = run; }
                        run = carry + (g1 + p1) + (h == 0 ? p0 : 0.f);
#pragma unroll
                        for (int e = 7; e >= 0; --e) { run += l1[e]; l1[e] = run; }
                        carry += (g1 + p1) + (g0 + p0);
#pragma unroll
                        for (int i = 0; i < 16; ++i) { const float wv = ex2(s1[i] + l1[i]); s1[i] = (kb0 + 32 + 16 * (i >> 3) + (i & 7) < 0) ? wv : 0.f; }
                        pf[1][0] = pack8(s1[0], s1[1], s1[2], s1[3], s1[4], s1[5], s1[6], s1[7]); pf[1][1] = pack8(s1[8], s1[9], s1[10], s1[11], s1[12], s1[13], s1[14], s1[15]);
                    }
                    {
                        f32x16 l0;
#pragma unroll
                        for (int i = 0; i < 16; ++i) { const float z = s0[i]; const float a = -(fmaxf(z, 0.f) + lg2(1.f + ex2(-fabsf(z)))); l0[i] = (kb0 + 16 * (i >> 3) + (i & 7) < 0) ? a : 0.f; }
                        float g0 = 0.f, g1 = 0.f;
#pragma unroll
                        for (int e = 0; e < 8; ++e) { g0 += l0[e]; g1 += l0[8 + e]; }
                        const float p0 = __shfl_xor(g0, 32), p1 = __shfl_xor(g1, 32);
                        float run = carry + (h == 0 ? p1 : 0.f);
#pragma unroll
                        for (int e = 7; e >= 0; --e) { run += l0[8 + e]; l0[8 + e] = run; }
                        run = carry + (g1 + p1) + (h == 0 ? p0 : 0.f);
#pragma unroll
                        for (int e = 7; e >= 0; --e) { run += l0[e]; l0[e] = run; }
                        carry += (g1 + p1) + (g0 + p0);
#pragma unroll
                        for (int i = 0; i < 16; ++i) { const float wv = ex2(s0[i] + l0[i]); s0[i] = (kb0 + 16 * (i >> 3) + (i & 7) < 0) ? wv : 0.f; }
                        pf[0][0] = pack8(s0[0], s0[1], s0[2], s0[3], s0[4], s0[5], s0[6], s0[7]); pf[0][1] = pack8(s0[8], s0[9], s0[10], s0[11], s0[12], s0[13], s0[14], s0[15]);
                    }
                    att_pv(o, pf, buf, va);
                    wdone = __all(carry < -150.f);
                }
                if (lane == 0) flags[(itn & 1) * 8 + w] = wdone ? 1 : 0;
                asm volatile("s_waitcnt vmcnt(0)" ::: "memory");
                __syncthreads();
                int alld = 1;
#pragma unroll
                for (int q = 0; q < 8; ++q) alld &= flags[(itn & 1) * 8 + q];
                if (alld) break;
            }
            att_store(o, 1.f, O, qrow, hd, h);
        }
    }
}
#ifndef FAST_ATTN
#define FAST_ATTN 1
#endif

constexpr int SEL_LD = 260;
DI void topk_insert(float (&a)[16], float x) {
#pragma unroll
    for (int i = 15; i >= 1; --i) a[i] = __builtin_amdgcn_fmed3f(a[i - 1], a[i], x);
    a[0] = fmaxf(a[0], x);
}
struct SelMap { int mode, a0, a1, a2, a3; };
DI void sel_decode(const SelMap& mp, int q, int& t0, int& hd) {
    if (mp.mode == 0) { int u = mp.a0 + q * mp.a1; if (u >= 128 * 8) u = mp.a0; hd = u & 7; t0 = (u >> 3) * 128; }
    else { const int pm = (q >> 1) ? mp.a2 : mp.a0, pn = (q >> 1) ? mp.a3 : mp.a1; hd = pn; t0 = pm * 256 + (q & 1) * 128; }
}
template <int NU> DI void select_stage2(const Params& p, const Ctx& c, const SelMap mp, const LAS float* lst_all) {
    if (c.tid < 128 * NU) {
        const int tok = c.tid & 127, un = c.tid >> 7;
        int t0, hd; sel_decode(mp, un, t0, hd);
        const LAS float* lst = lst_all + un * 4096;
        float v1[16], v2[16];
#pragma unroll
        for (int i = 0; i < 16; ++i) { v1[i] = __uint_as_float(__float_as_uint(lst[(tok * 2) * 16 + i]) & ~127u); v2[i] = __uint_as_float(__float_as_uint(lst[(tok * 2 + 1) * 16 + i]) & ~127u); }
        float bb[16];
#pragma unroll
        for (int i = 0; i < 16; ++i) bb[i] = -__builtin_inff();
#pragma unroll
        for (int i = 0; i < 16; ++i)
#pragma unroll
            for (int j = 0; j < 16; ++j)
                if ((i + 1) * (j + 1) <= 16) topk_insert(bb, __uint_as_float((__float_as_uint(v1[i] + v2[j]) & ~255u) | (unsigned)(i * 16 + j)));
        float sv[16], mxv = -__builtin_inff(), sum = 0.f;
#pragma unroll
        for (int i = 0; i < 16; ++i) { sv[i] = __uint_as_float(__float_as_uint(bb[i]) & ~255u); mxv = fmaxf(mxv, sv[i]); }
#pragma unroll
        for (int i = 0; i < 16; ++i) { sv[i] = __expf(sv[i] - mxv); sum += sv[i]; }
        const float inv = 1.f / sum;
        int* idx = (int*)(p.ws + OFF_IDX) + (size_t)(t0 + tok) * 128 + hd * 16; float* gw = (float*)(p.ws + OFF_GW) + (size_t)(t0 + tok) * 128 + hd * 16;
#pragma unroll
        for (int i = 0; i < 16; ++i) {
            const unsigned code = __float_as_uint(bb[i]) & 255u;
            const unsigned e1 = __float_as_uint(lst[(tok * 2) * 16 + (code >> 4)]) & 127u, e2 = __float_as_uint(lst[(tok * 2 + 1) * 16 + (code & 15u)]) & 127u;
            idx[i] = (int)(e1 * 128u + e2); gw[i] = sv[i] * inv;
        }
    }
    __syncthreads();
}
DI void select_tail(const Params& p, const Ctx& c, int t0, int hd) {
    LAS float* sc = (LAS float*)c.lds; LAS float* lst = sc + 128 * SEL_LD;
    if (c.tid < 256) {
        const int tok = c.tid >> 1, hf = c.tid & 1;
        float a[16];
#pragma unroll
        for (int i = 0; i < 16; ++i) a[i] = -__builtin_inff();
        const LAS float* row = sc + tok * SEL_LD + hf * 128;
#pragma unroll 4
        for (int n4 = 0; n4 < 32; ++n4) {
            const f32x4 v = *(const LAS f32x4*)(row + n4 * 4);
#pragma unroll
            for (int e = 0; e < 4; ++e) topk_insert(a, __uint_as_float((__float_as_uint(v[e]) & ~127u) | (unsigned)(n4 * 4 + e)));
        }
#pragma unroll
        for (int i = 0; i < 16; ++i) lst[(tok * 2 + hf) * 16 + i] = a[i];
    }
    __syncthreads();
    select_stage2<1>(p, c, SelMap{0, ((t0 >> 7) << 3) | hd, 0, 0, 0}, lst);
}
DI void select_naive(const Params& p, const Ctx& c) {
    const bf16_t* PQ = (const bf16_t*)(p.ws + OFF_PQ); const bf16_t* KEYS = (const bf16_t*)(p.ws + OFF_KEYS);
    LAS float* sc = (LAS float*)c.lds;
    for (int u = blockIdx.x; u < 128 * 8; u += gridDim.x) {
        const int hd = u & 7, t0 = (u >> 3) * 128;
        const int tok = c.tid >> 2, part = c.tid & 3, hf = part >> 1, n0 = (part & 1) * 64;
        const bf16_t* qrow = PQ + (size_t)hd * M * 256 + (size_t)(t0 + tok) * 256 + hf * 128;
        const bf16_t* kb = KEYS + (size_t)((hd * 2 + hf) * 128 + n0) * 128;
        for (int n = 0; n < 64; ++n) {
            float acc = 0.f;
#pragma unroll
            for (int d8 = 0; d8 < 16; ++d8) {
                const u32x4 a = *(const u32x4*)(qrow + d8 * 8), b = *(const u32x4*)(kb + (size_t)n * 128 + d8 * 8);
#pragma unroll
                for (int e = 0; e < 4; ++e) acc += bflo(a[e]) * bflo(b[e]) + bfhi(a[e]) * bfhi(b[e]);
            }
            sc[tok * SEL_LD + hf * 128 + n0 + n] = acc;
        }
        __syncthreads();
        select_tail(p, c, t0, hd);
    }
}


DI void select_batch(const Params& p, const Ctx& c, const SelMap mp) {
    const bf16_t* PQ = (const bf16_t*)(p.ws + OFF_PQ); const bf16_t* KEYS = (const bf16_t*)(p.ws + OFF_KEYS);
    LAS float* lst_all = (LAS float*)c.lds;
    const int lane = c.lane, r = lane & 31, h = lane >> 5, w = c.wave, tb = w & 3, hf = w >> 2;
#pragma unroll
    for (int q = 0; q < 4; ++q) {
        int t0, hd; sel_decode(mp, q, t0, hd);
        LAS float* lst = lst_all + q * 4096;
        const bf16_t* qrow = PQ + (size_t)hd * M * 256 + (size_t)(t0 + tb * 32 + r) * 256 + hf * 128 + h * 8;
        const bf16_t* kbase = KEYS + (size_t)((hd * 2 + hf) * 128 + r) * 128 + h * 8;
        bf16x8 qf[8];
#pragma unroll
        for (int st = 0; st < 8; ++st) qf[st] = *(const bf16x8*)(qrow + st * 16);
        float a[16];
#pragma unroll
        for (int i = 0; i < 16; ++i) a[i] = -__builtin_inff();
#pragma unroll
        for (int kb = 0; kb < 4; ++kb) {
            f32x16 sc;
#pragma unroll
            for (int i = 0; i < 16; ++i) sc[i] = 0.f;
#pragma unroll
            for (int st = 0; st < 8; ++st) sc = MFMA32(*(const bf16x8*)(kbase + (size_t)kb * 32 * 128 + st * 16), qf[st], sc);
#pragma unroll
            for (int i = 0; i < 16; ++i) topk_insert(a, __uint_as_float((__float_as_uint(sc[i]) & ~127u) | (unsigned)(kb * 32 + (i & 3) + 8 * (i >> 2) + 4 * h)));
        }
        float bq[16];
#pragma unroll
        for (int i = 0; i < 16; ++i) bq[i] = __shfl_xor(a[i], 32);
#pragma unroll
        for (int i = 0; i < 16; ++i) topk_insert(a, bq[i]);
        if (h == 0) {
#pragma unroll
            for (int i = 0; i < 16; ++i) lst[((tb * 32 + r) * 2 + hf) * 16 + i] = a[i];
        }
    }
    __syncthreads();
    select_stage2<4>(p, c, mp, lst_all);
}
DI void select_fast(const Params& p, const Ctx& c) {
    for (int u0 = blockIdx.x; u0 < 128 * 8; u0 += 4 * gridDim.x) select_batch(p, c, SelMap{0, u0, (int)gridDim.x, 0, 0});
}
DI void select_own_tiles(const Params& p, const Ctx& c) {
    pg8::StaticOrder S; S.init(M, 2048, (int)gridDim.x, (int)blockIdx.x);
    asm volatile("s_waitcnt vmcnt(0)" ::: "memory");
    __syncthreads();
    if (c.tid == 0) { __builtin_amdgcn_fence(__ATOMIC_ACQUIRE, "agent"); asm volatile("s_waitcnt vmcnt(0)" ::: "memory"); }
    __syncthreads();
    for (int i = 0;; i += 2) {
        pg8::Unit u0, u1;
        if (!S.next(i, u0)) break;
        if (!S.next(i + 1, u1)) u1 = u0;
        select_batch(p, c, SelMap{1, u0.pm, u0.pn, u1.pm, u1.pn});
    }
}
#ifndef FAST_SEL
#define FAST_SEL 1
#endif

DI void phase_gather(const Params& p, const Ctx& c, float* dst, int rowmask = -1) {
    const bf16_t* H2 = (const bf16_t*)(p.ws + OFF_H); const unsigned char* U = p.ws + OFF_U16; const unsigned char* V = p.ws + OFF_V16;
    const int* IDX = (const int*)(p.ws + OFF_IDX); const float* GW = (const float*)(p.ws + OFF_GW); const float* mod = (const float*)(p.ws + OFF_MOD);
    constexpr int G = 8, GV = 16;
    const int lane = c.lane;
    unsigned* tokctr = (unsigned*)(p.ws + OFF_CTL) + 700;
    constexpr int NSTATIC = 6;
    LAS int* park = (LAS int*)(c.lds + c.wave * 20480);
    for (int it = 0;; ++it) {
        int m, slot; bool doU, doV;
        if (it < NSTATIC) { slot = it; m = c.gw + it * c.ngw; doU = true; doV = false; }
        else if (it < 2 * NSTATIC) { slot = it - NSTATIC; m = c.gw + slot * c.ngw; doU = false; doV = true; }
        else { unsigned t = 0; if (lane == 0) t = __hip_atomic_fetch_add(tokctr, 1u, __ATOMIC_RELAXED, __HIP_MEMORY_SCOPE_AGENT); m = NSTATIC * c.ngw + (int)__builtin_amdgcn_readfirstlane(t); if (m >= M) break; slot = 0; doU = true; doV = true; }
        if (m >= M) continue;
        const int b = m / SEQ;
        LAS int* ps = park + slot * 256;
        int ia = 0, ib = 0; float wa = 0.f, wb = 0.f;
        if (doU) {
        f32x2 hf[16];
#pragma unroll
        for (int i = 0; i < 4; ++i) { const u32x4 a = *(const u32x4*)(H2 + (size_t)m * D + lane * 32 + i * 8);
#pragma unroll
            for (int q = 0; q < 4; ++q) hf[4 * i + q] = (f32x2){bflo(a[q]), bfhi(a[q])}; }
        ia = IDX[(size_t)m * 128 + lane]; ib = IDX[(size_t)m * 128 + 64 + lane];
        const float ga = GW[(size_t)m * 128 + lane], gb = GW[(size_t)m * 128 + 64 + lane];
#pragma unroll 1
        for (int k0 = 0; k0 < 128; k0 += G) {
            u32x4 ua[G]; u32x2 ub[G];
#pragma unroll
            for (int g = 0; g < G; ++g) {
                const int e = __builtin_amdgcn_readlane(k0 < 64 ? ia : ib, (k0 + g) & 63) & rowmask;
                const unsigned char* ur = U + (size_t)e * 1536;
                ua[g] = *(const u32x4*)(ur + (unsigned)lane * 16u); ub[g] = *(const u32x2*)(ur + 1024u + (unsigned)lane * 8u);
            }
            float d[G];
#pragma unroll
            for (int g = 0; g < G; ++g) {
                const f32x32v f = __builtin_amdgcn_cvt_scalef32_pk32_f32_fp6((u32x6){ua[g][0], ua[g][1], ua[g][2], ua[g][3], ub[g][0], ub[g][1]}, 1.0f);
                f32x2 d2 = {0.f, 0.f};
#pragma unroll
                for (int i = 0; i < 16; ++i) d2 = (f32x2){f[2 * i], f[2 * i + 1]} * hf[i] + d2;
                d[g] = d2.x + d2.y;
            }
            { const bool u5 = lane & 32, u4 = lane & 16, u3 = lane & 8;
              float r4[4];
#pragma unroll
              for (int i = 0; i < 4; ++i) { const float send = u5 ? d[i] : d[4 + i], keep = u5 ? d[4 + i] : d[i]; r4[i] = keep + __shfl_xor(send, 32); }
              float r2[2];
#pragma unroll
              for (int i = 0; i < 2; ++i) { const float send = u4 ? r4[i] : r4[2 + i], keep = u4 ? r4[2 + i] : r4[i]; r2[i] = keep + __shfl_xor(send, 16); }
              const float send = u3 ? r2[0] : r2[1], keep = u3 ? r2[1] : r2[0];
              float r1 = keep + __shfl_xor(send, 8);
              r1 += __shfl_xor(r1, 4); r1 += __shfl_xor(r1, 2); r1 += __shfl_xor(r1, 1);
              const float act = gelu_tanh(r1 * (1.f / U8_SCALE)) * (1.f / V8_SCALE);
              const int gsel = lane - (k0 & 63);
              const int src = ((gsel & 4) << 3) | ((gsel & 2) << 3) | ((gsel & 1) << 3);
              const float got = __shfl(act, src & 63);
              if (gsel >= 0 && gsel < G) { if (k0 < 64) wa = got * ga; else wb = got * gb; }
            }
        }
        ps[lane] = ia; ps[64 + lane] = ib; ps[128 + lane] = __builtin_bit_cast(int, wa); ps[192 + lane] = __builtin_bit_cast(int, wb);
        }
        if (!doV) continue;
        if (!doU) { ia = ps[lane]; ib = ps[64 + lane]; wa = __builtin_bit_cast(float, ps[128 + lane]); wb = __builtin_bit_cast(float, ps[192 + lane]); }
        f32x2 acc[16];
#pragma unroll
        for (int i = 0; i < 16; ++i) acc[i] = (f32x2){0.f, 0.f};
#define VB_ISSUE(P, K0) do { _Pragma("unroll") for (int g = 0; g < 8; ++g) { \
            const int e = __builtin_amdgcn_readlane((K0) < 64 ? ia : ib, ((K0) + g) & 63) & rowmask; \
            P##w[g] = __builtin_bit_cast(float, __builtin_amdgcn_readlane(__builtin_bit_cast(int, (K0) < 64 ? wa : wb), ((K0) + g) & 63)); \
            const unsigned char* vr = V + (size_t)e * 1536; \
            P##a[g] = *(const u32x4*)(vr + (unsigned)lane * 16u); P##b[g] = *(const u32x2*)(vr + 1024u + (unsigned)lane * 8u); } } while (0)
#define VB_COMPUTE(P) do { _Pragma("unroll") for (int g = 0; g < 8; ++g) { const f32x2 w2 = {P##w[g], P##w[g]}; \
            const f32x32v f = __builtin_amdgcn_cvt_scalef32_pk32_f32_fp6((u32x6){P##a[g][0], P##a[g][1], P##a[g][2], P##a[g][3], P##b[g][0], P##b[g][1]}, 1.0f); \
            _Pragma("unroll") for (int i = 0; i < 16; ++i) acc[i] = (f32x2){f[2 * i], f[2 * i + 1]} * w2 + acc[i]; } } while (0)
        {
            u32x4 A_a[8], B_a[8]; u32x2 A_b[8], B_b[8]; float A_w[8], B_w[8];
            VB_ISSUE(A_, 0);
#pragma unroll 1
            for (int k0 = 0; k0 < 128; k0 += 16) {
                VB_ISSUE(B_, k0 + 8);
                VB_COMPUTE(A_);
                if (k0 + 16 < 128) VB_ISSUE(A_, k0 + 16);
                VB_COMPUTE(B_);
            }
        }
#undef VB_ISSUE
#undef VB_COMPUTE
        const float* orow = p.out + (size_t)m * D + lane * 32; float* drow = dst + (size_t)m * D + lane * 32; const float* gt2 = mod + b * 6 * D + 5 * D + lane * 32; const float* fg = p.fng + lane * 32;
        float ss = 0.f; f32x4 xv[8];
#pragma unroll
        for (int i = 0; i < 8; ++i) {
            const f32x4 xa = *(const f32x4*)(orow + 4 * i), ta = *(const f32x4*)(gt2 + 4 * i);
            const f32x4 pe = {acc[2 * i].x, acc[2 * i].y, acc[2 * i + 1].x, acc[2 * i + 1].y};
            const f32x4 v = xa + DBG_BETA * ta * pe; xv[i] = v; ss += (v[0] * v[0] + v[1] * v[1]) + (v[2] * v[2] + v[3] * v[3]);
        }
        const float rstd = rsqrtf(wave_sum(ss) * (1.f / D) + EPS);
#pragma unroll
        for (int i = 0; i < 8; ++i) *(f32x4*)(drow + 4 * i) = xv[i] * rstd * *(const f32x4*)(fg + 4 * i);
    }
}


DI void phase_gather_sorted(const Params& p, const Ctx& c) {
    const bf16_t* H2 = (const bf16_t*)(p.ws + OFF_H); const unsigned char* U = p.ws + OFF_U16; const unsigned char* V = p.ws + OFF_V16;
    const int* IDX = (const int*)(p.ws + OFF_IDX); const float* GW = (const float*)(p.ws + OFF_GW); const float* mod = (const float*)(p.ws + OFF_MOD);
    const int lane = c.lane;
    LAS unsigned char* wl = c.lds + c.wave * 20480;
    constexpr int RSH = 12;
    const bool u5 = lane & 32, u4 = lane & 16, u3 = lane & 8;
#pragma unroll 1
    for (int grp = 0; grp < 2; ++grp) {
#pragma unroll 1
        for (int t = 0; t < 4; ++t) {
            const int m = c.gw + (grp * 4 + t) * c.ngw;
            if (m >= M) continue;
            const int ia = IDX[(size_t)m * 128 + lane], ib = IDX[(size_t)m * 128 + 64 + lane];
            const float ga = GW[(size_t)m * 128 + lane], gb = GW[(size_t)m * 128 + 64 + lane];
            const int ra = ia >> RSH, rb = ib >> RSH;
            int off = 0, posA = 0, posB = 0;
#pragma unroll
            for (int r = 0; r < 4; ++r) {
                const unsigned long long mA = __ballot(ra == r), mB = __ballot(rb == r);
                const int cA = __builtin_popcountll(mA), cB = __builtin_popcountll(mB);
                const int rkA = __builtin_amdgcn_mbcnt_hi((unsigned)(mA >> 32), __builtin_amdgcn_mbcnt_lo((unsigned)mA, 0u));
                const int rkB = __builtin_amdgcn_mbcnt_hi((unsigned)(mB >> 32), __builtin_amdgcn_mbcnt_lo((unsigned)mB, 0u));
                posA = (ra == r) ? off + rkA : posA; posB = (rb == r) ? off + cA + rkB : posB; off += cA + cB;
            }
            LAS int* sE = (LAS int*)(wl + t * 1024); LAS float* sW = (LAS float*)(wl + t * 1024 + 512);
            sE[posA] = ia; sE[posB] = ib; sW[posA] = ga; sW[posB] = gb;
            LAS u32x4* hrow = (LAS u32x4*)(wl + 4096 + t * 4096 + lane * 64);
#pragma unroll
            for (int i = 0; i < 4; ++i) hrow[i] = *(const u32x4*)(H2 + (size_t)m * D + lane * 32 + i * 8);
        }
        asm volatile("s_waitcnt lgkmcnt(0)" ::: "memory");
#pragma unroll 1
        for (int vi = 0; vi < 16; ++vi) {
            {
                const int r = vi >> 2, t = vi & 3;
                const int m = c.gw + (grp * 4 + t) * c.ngw;
                if (m >= M) continue;
                LAS int* sE = (LAS int*)(wl + t * 1024); LAS float* sW = (LAS float*)(wl + t * 1024 + 512);
                const int eLo = sE[lane], eHi = sE[64 + lane];
                const unsigned long long mLo = __ballot((eLo >> RSH) == r), mHi = __ballot((eHi >> RSH) == r);
                if (!(mLo | mHi)) continue;
                const int s0 = mLo ? __builtin_ctzll(mLo) : 64 + __builtin_ctzll(mHi);
                const int e1 = s0 + __builtin_popcountll(mLo) + __builtin_popcountll(mHi);
                float wLo = sW[lane], wHi = sW[64 + lane];
                f32x2 hf[16];
                { const LAS u32x4* hrow = (const LAS u32x4*)(wl + 4096 + t * 4096 + lane * 64);
#pragma unroll
                  for (int i = 0; i < 4; ++i) { const u32x4 a = hrow[i];
#pragma unroll
                    for (int q = 0; q < 4; ++q) hf[4 * i + q] = (f32x2){bflo(a[q]), bfhi(a[q])}; } }
#pragma unroll 1
                for (int j0 = s0; j0 < e1; j0 += 8) {
                    u32x4 ua[8]; u32x2 ub[8];
#pragma unroll
                    for (int g = 0; g < 8; ++g) {
                        const int pos = j0 + g;
                        ua[g] = (u32x4){0u, 0u, 0u, 0u}; ub[g] = (u32x2){0u, 0u};
                        if (pos < e1) {
                            const int e = __builtin_amdgcn_readlane(pos < 64 ? eLo : eHi, pos & 63);
                            const unsigned char* ur = U + (size_t)e * 1536;
                            ua[g] = *(const u32x4*)(ur + (unsigned)lane * 16u); ub[g] = *(const u32x2*)(ur + 1024u + (unsigned)lane * 8u);
                        }
                    }
                    float d[8];
#pragma unroll
                    for (int g = 0; g < 8; ++g) {
                        d[g] = 0.f;
                        if (j0 + g < e1) {
                            const f32x32v f = __builtin_amdgcn_cvt_scalef32_pk32_f32_fp6((u32x6){ua[g][0], ua[g][1], ua[g][2], ua[g][3], ub[g][0], ub[g][1]}, 1.0f);
                            f32x2 d2 = {0.f, 0.f};
#pragma unroll
                            for (int i = 0; i < 16; ++i) d2 = (f32x2){f[2 * i], f[2 * i + 1]} * hf[i] + d2;
                            d[g] = d2.x + d2.y;
                        }
                    }
                    float r4[4];
#pragma unroll
                    for (int i = 0; i < 4; ++i) { const float send = u5 ? d[i] : d[4 + i], keep = u5 ? d[4 + i] : d[i]; r4[i] = keep + __shfl_xor(send, 32); }
                    float r2[2];
#pragma unroll
                    for (int i = 0; i < 2; ++i) { const float send = u4 ? r4[i] : r4[2 + i], keep = u4 ? r4[2 + i] : r4[i]; r2[i] = keep + __shfl_xor(send, 16); }
                    const float send = u3 ? r2[0] : r2[1], keep = u3 ? r2[1] : r2[0];
                    float r1 = keep + __shfl_xor(send, 8);
                    r1 += __shfl_xor(r1, 4); r1 += __shfl_xor(r1, 2); r1 += __shfl_xor(r1, 1);
                    const float act = gelu_tanh(r1 * (1.f / U8_SCALE)) * (1.f / V8_SCALE);
                    const bool inLo = (lane >= j0) && (lane < j0 + 8);
                    const int gsel = inLo ? lane - j0 : lane + 64 - j0;
                    const int src = ((gsel & 4) << 3) | ((gsel & 2) << 3) | ((gsel & 1) << 3);
                    const float got = __shfl(act, src & 63);
                    if (gsel >= 0 && gsel < 8 && j0 + gsel < e1) { if (inLo) wLo = got * wLo; else wHi = got * wHi; }
                }
                sW[lane] = wLo; sW[64 + lane] = wHi;
            }
        }
        asm volatile("s_waitcnt lgkmcnt(0)" ::: "memory");
#pragma unroll 1
        for (int r = 0; r < 4; ++r) {
#pragma unroll 1
            for (int t = 0; t < 4; ++t) {
                const int m = c.gw + (grp * 4 + t) * c.ngw;
                if (m >= M) continue;
                LAS int* sE = (LAS int*)(wl + t * 1024); LAS float* sW = (LAS float*)(wl + t * 1024 + 512);
                LAS u32x4* pk = (LAS u32x4*)(wl + 4096 + t * 4096 + lane * 64);
                const int eLo = sE[lane], eHi = sE[64 + lane]; const float wLo = sW[lane], wHi = sW[64 + lane];
                const unsigned long long mLo = __ballot((eLo >> RSH) == r), mHi = __ballot((eHi >> RSH) == r);
                const int s0 = mLo ? __builtin_ctzll(mLo) : (mHi ? 64 + __builtin_ctzll(mHi) : 0);
                const int e1 = s0 + __builtin_popcountll(mLo) + __builtin_popcountll(mHi);
                f32x2 acc[16];
                if (r == 0) {
#pragma unroll
                    for (int i = 0; i < 16; ++i) acc[i] = (f32x2){0.f, 0.f};
                } else {
#pragma unroll
                    for (int i = 0; i < 4; ++i) { const u32x4 a = pk[i];
#pragma unroll
                        for (int q = 0; q < 4; ++q) acc[4 * i + q] = (f32x2){bflo(a[q]), bfhi(a[q])}; }
                }
#define SV_ISSUE(P, J0) do { _Pragma("unroll") for (int g = 0; g < 8; ++g) { const int pos = (J0) + g; P##w[g] = 0.f; P##a[g] = (u32x4){0u, 0u, 0u, 0u}; P##b[g] = (u32x2){0u, 0u}; \
                        if (pos < e1) { const int e = __builtin_amdgcn_readlane(pos < 64 ? eLo : eHi, pos & 63); \
                            P##w[g] = __builtin_bit_cast(float, __builtin_amdgcn_readlane(__builtin_bit_cast(int, pos < 64 ? wLo : wHi), pos & 63)); \
                            const unsigned char* vr = V + (size_t)e * 1536; P##a[g] = *(const u32x4*)(vr + (unsigned)lane * 16u); P##b[g] = *(const u32x2*)(vr + 1024u + (unsigned)lane * 8u); } } } while (0)
#define SV_COMPUTE(P, J0) do { _Pragma("unroll") for (int g = 0; g < 8; ++g) if ((J0) + g < e1) { const f32x2 w2 = {P##w[g], P##w[g]}; \
                        const f32x32v f = __builtin_amdgcn_cvt_scalef32_pk32_f32_fp6((u32x6){P##a[g][0], P##a[g][1], P##a[g][2], P##a[g][3], P##b[g][0], P##b[g][1]}, 1.0f); \
                        _Pragma("unroll") for (int i = 0; i < 16; ++i) acc[i] = (f32x2){f[2 * i], f[2 * i + 1]} * w2 + acc[i]; } } while (0)
                if (s0 < e1) {
                    u32x4 A_a[8], B_a[8]; u32x2 A_b[8], B_b[8]; float A_w[8], B_w[8];
                    SV_ISSUE(A_, s0);
#pragma unroll 1
                    for (int j0 = s0; j0 < e1; j0 += 16) {
                        if (j0 + 8 < e1) SV_ISSUE(B_, j0 + 8);
                        SV_COMPUTE(A_, j0);
                        if (j0 + 16 < e1) SV_ISSUE(A_, j0 + 16);
                        if (j0 + 8 < e1) SV_COMPUTE(B_, j0 + 8);
                    }
                }
#undef SV_ISSUE
#undef SV_COMPUTE
                if (r < 3) {
#pragma unroll
                    for (int i = 0; i < 4; ++i) pk[i] = (u32x4){pk2(acc[4 * i].x, acc[4 * i].y), pk2(acc[4 * i + 1].x, acc[4 * i + 1].y), pk2(acc[4 * i + 2].x, acc[4 * i + 2].y), pk2(acc[4 * i + 3].x, acc[4 * i + 3].y)};
                } else {
                    const int b = m / SEQ;
                    float* orow = p.out + (size_t)m * D + lane * 32; const float* gt2 = mod + b * 6 * D + 5 * D + lane * 32; const float* fg = p.fng + lane * 32;
                    float ss = 0.f; f32x4 xv[8];
#pragma unroll
                    for (int i = 0; i < 8; ++i) {
                        const f32x4 xa = *(const f32x4*)(orow + 4 * i), ta = *(const f32x4*)(gt2 + 4 * i);
                        const f32x4 pe = {acc[2 * i].x, acc[2 * i].y, acc[2 * i + 1].x, acc[2 * i + 1].y};
                        const f32x4 v = xa + DBG_BETA * ta * pe; xv[i] = v; ss += (v[0] * v[0] + v[1] * v[1]) + (v[2] * v[2] + v[3] * v[3]);
                    }
                    const float rstd = rsqrtf(wave_sum(ss) * (1.f / D) + EPS);
#pragma unroll
                    for (int i = 0; i < 8; ++i) *(f32x4*)(orow + 4 * i) = xv[i] * rstd * *(const f32x4*)(fg + 4 * i);
                }
            }
        }
        asm volatile("s_waitcnt lgkmcnt(0)" ::: "memory");
    }
}
#ifndef GATHER_SORTED
#define GATHER_SORTED 1
#endif

struct XcdBarrier; DI void xcd_barrier(const XcdBarrier& b, int wave_s);
DI int rl2r(int a, int b, int k) { const int va = __builtin_amdgcn_readlane(a, k & 63), vb = __builtin_amdgcn_readlane(b, k & 63); return k < 64 ? va : vb; }
DI void phase_gather_rounds(const Params& p, const Ctx& c, const XcdBarrier& xbar) {
    const bf16_t* H2 = (const bf16_t*)(p.ws + OFF_H); const unsigned char* U = p.ws + OFF_U16; const unsigned char* V = p.ws + OFF_V16;
    const int* IDX = (const int*)(p.ws + OFF_IDX); const float* GW = (const float*)(p.ws + OFF_GW); const float* mod = (const float*)(p.ws + OFF_MOD);
    const int lane = c.lane;
    LAS unsigned char* wl = c.lds + c.wave * 20480;
    const bool u5 = lane & 32, u4 = lane & 16, u3 = lane & 8;
    constexpr int G = 8;
#pragma unroll 1
    for (int pass = 0; pass < 2; ++pass) {
#pragma unroll
        for (int t = 0; t < 4; ++t) {
            const int m = c.gw + (pass * 4 + t) * c.ngw;
            LAS unsigned char* ts = wl + t * 5120;
            if (m < M) {
#pragma unroll
                for (int i = 0; i < 4; ++i) *(LAS u32x4*)(ts + lane * 64 + i * 16) = *(const u32x4*)(H2 + (size_t)m * D + lane * 32 + i * 8);
                *(LAS int*)(ts + 4096 + lane * 4) = IDX[(size_t)m * 128 + lane]; *(LAS int*)(ts + 4096 + 256 + lane * 4) = IDX[(size_t)m * 128 + 64 + lane];
                *(LAS float*)(ts + 4608 + lane * 4) = GW[(size_t)m * 128 + lane]; *(LAS float*)(ts + 4608 + 256 + lane * 4) = GW[(size_t)m * 128 + 64 + lane];
            }
        }
        asm volatile("s_waitcnt vmcnt(0) lgkmcnt(0)" ::: "memory");
#pragma unroll 1
        for (int r = 0; r < 8; ++r) {
#pragma unroll 1
            for (int t = 0; t < 4; ++t) {
                if (c.gw + (pass * 4 + t) * c.ngw >= M) continue;
                LAS unsigned char* ts = wl + t * 5120;
                const int ia = *(LAS int*)(ts + 4096 + lane * 4), ib = *(LAS int*)(ts + 4096 + 256 + lane * 4);
                unsigned long long ma = __ballot((ia >> 11) == r), mb = __ballot((ib >> 11) == r);
                if (!(ma | mb)) continue;
                f32x2 hf[16];
#pragma unroll
                for (int i = 0; i < 4; ++i) { const u32x4 a = *(LAS u32x4*)(ts + lane * 64 + i * 16);
#pragma unroll
                    for (int q = 0; q < 4; ++q) hf[4 * i + q] = (f32x2){bflo(a[q]), bfhi(a[q])}; }
                float wa = 0.f, wb = 0.f; const unsigned long long ma0 = ma, mb0 = mb;
                while (ma | mb) {
                    u32x4 ua[G]; u32x2 ub[G]; int kk[G]; int n = 0;
#pragma unroll
                    for (int g = 0; g < G; ++g) {
                        int k = (g == 0) ? 0 : kk[g - 1];
                        if (ma) { k = __builtin_ctzll(ma); ma &= ma - 1; ++n; } else if (mb) { k = 64 + __builtin_ctzll(mb); mb &= mb - 1; ++n; }
                        kk[g] = k;
                        const int e = rl2r(ia, ib, k);
                        const unsigned char* ur = U + (size_t)e * 1536;
                        ua[g] = *(const u32x4*)(ur + (unsigned)lane * 16u); ub[g] = *(const u32x2*)(ur + 1024u + (unsigned)lane * 8u);
                    }
                    float d[G];
#pragma unroll
                    for (int g = 0; g < G; ++g) {
                        d[g] = 0.f;
                        if (g < n) {
                            const f32x32v f = __builtin_amdgcn_cvt_scalef32_pk32_f32_fp6((u32x6){ua[g][0], ua[g][1], ua[g][2], ua[g][3], ub[g][0], ub[g][1]}, 1.0f);
                            f32x2 d0 = {0.f, 0.f}, d1 = {0.f, 0.f};
#pragma unroll
                            for (int i = 0; i < 8; ++i) { d0 = (f32x2){f[4 * i], f[4 * i + 1]} * hf[2 * i] + d0; d1 = (f32x2){f[4 * i + 2], f[4 * i + 3]} * hf[2 * i + 1] + d1; }
                            d[g] = (d0.x + d0.y) + (d1.x + d1.y);
                        }
                    }
                    float r4[4];
#pragma unroll
                    for (int i = 0; i < 4; ++i) { const float send = u5 ? d[i] : d[4 + i], keep = u5 ? d[4 + i] : d[i]; r4[i] = keep + __shfl_xor(send, 32); }
                    float r2[2];
#pragma unroll
                    for (int i = 0; i < 2; ++i) { const float send = u4 ? r4[i] : r4[2 + i], keep = u4 ? r4[2 + i] : r4[i]; r2[i] = keep + __shfl_xor(send, 16); }
                    const float send = u3 ? r2[0] : r2[1], keep = u3 ? r2[1] : r2[0];
                    float r1 = keep + __shfl_xor(send, 8);
                    r1 += __shfl_xor(r1, 4); r1 += __shfl_xor(r1, 2); r1 += __shfl_xor(r1, 1);
                    const float act = gelu_tanh(r1 * (1.f / U8_SCALE)) * (1.f / V8_SCALE);
#pragma unroll
                    for (int g = 0; g < G; ++g) if (g < n) {
                        const float av = __builtin_bit_cast(float, __builtin_amdgcn_readlane(__builtin_bit_cast(int, act), ((g & 4) << 3) | ((g & 2) << 3) | ((g & 1) << 3)));
                        const int k = kk[g];
                        if (k < 64) { if (lane == k) wa = av; } else { if (lane == k - 64) wb = av; }
                    }
                }
                if ((ma0 >> lane) & 1ull) { LAS float* gp = (LAS float*)(ts + 4608 + lane * 4); *gp = *gp * wa; }
                if ((mb0 >> lane) & 1ull) { LAS float* gp = (LAS float*)(ts + 4608 + 256 + lane * 4); *gp = *gp * wb; }
            }
            if (DBG_ROUND_BAR) xcd_barrier(xbar, c.wave);
        }
        asm volatile("s_waitcnt lgkmcnt(0)" ::: "memory");
#pragma unroll 1
        for (int t = 0; t < 4; ++t) {
            const int m = c.gw + (pass * 4 + t) * c.ngw;
            if (m >= M) continue;
            const int b = m / SEQ;
            LAS unsigned char* ts = wl + t * 5120;
            const int ia = *(LAS int*)(ts + 4096 + lane * 4), ib = *(LAS int*)(ts + 4096 + 256 + lane * 4);
            const float wa = *(LAS float*)(ts + 4608 + lane * 4), wb = *(LAS float*)(ts + 4608 + 256 + lane * 4);
            f32x2 acc[16];
#pragma unroll
            for (int i = 0; i < 16; ++i) acc[i] = (f32x2){0.f, 0.f};
#pragma unroll 1
            for (int k0 = 0; k0 < 128; k0 += G) {
                u32x4 va[G]; u32x2 vb[G]; float wk[G];
#pragma unroll
                for (int g = 0; g < G; ++g) {
                    const int e = __builtin_amdgcn_readlane(k0 < 64 ? ia : ib, (k0 + g) & 63);
                    wk[g] = __builtin_bit_cast(float, __builtin_amdgcn_readlane(__builtin_bit_cast(int, k0 < 64 ? wa : wb), (k0 + g) & 63));
                    const unsigned char* vr = V + (size_t)e * 1536;
                    va[g] = *(const u32x4*)(vr + (unsigned)lane * 16u); vb[g] = *(const u32x2*)(vr + 1024u + (unsigned)lane * 8u);
                }
#pragma unroll
                for (int g = 0; g < G; ++g) { const f32x2 w2 = {wk[g], wk[g]};
                    const f32x32v f = __builtin_amdgcn_cvt_scalef32_pk32_f32_fp6((u32x6){va[g][0], va[g][1], va[g][2], va[g][3], vb[g][0], vb[g][1]}, 1.0f);
#pragma unroll
                    for (int i = 0; i < 16; ++i) acc[i] = (f32x2){f[2 * i], f[2 * i + 1]} * w2 + acc[i]; }
            }
            float* orow = p.out + (size_t)m * D + lane * 32; const float* gt2 = mod + b * 6 * D + 5 * D + lane * 32; const float* fg = p.fng + lane * 32;
            float ss = 0.f; f32x4 xv[8];
#pragma unroll
            for (int i = 0; i < 8; ++i) {
                const f32x4 xa = *(const f32x4*)(orow + 4 * i), ta = *(const f32x4*)(gt2 + 4 * i);
                const f32x4 pe = {acc[2 * i].x, acc[2 * i].y, acc[2 * i + 1].x, acc[2 * i + 1].y};
                const f32x4 v = xa + DBG_BETA * ta * pe; xv[i] = v; ss += (v[0] * v[0] + v[1] * v[1]) + (v[2] * v[2] + v[3] * v[3]);
            }
            const float rstd = rsqrtf(wave_sum(ss) * (1.f / D) + EPS);
#pragma unroll
            for (int i = 0; i < 8; ++i) *(f32x4*)(orow + 4 * i) = xv[i] * rstd * *(const f32x4*)(fg + 4 * i);
        }
    }
}
#ifndef GATHER_ROUNDS
#define GATHER_ROUNDS 0
#endif

constexpr size_t OFF_WK = OFF_GB + (size_t)32 * 1024 * 1024;
constexpr size_t OFF_SSQ = OFF_GB + (size_t)48 * 1024 * 1024;
constexpr int NPU = 2, NPV = 2;
struct PairPick { int k; bool valid; };
DI PairPick pick_next(unsigned long long& ma, unsigned long long& mb, int prev) {
    PairPick r;
    if (ma) { r.k = __builtin_ctzll(ma); ma &= ma - 1; r.valid = true; }
    else if (mb) { r.k = 64 + __builtin_ctzll(mb); mb &= mb - 1; r.valid = true; }
    else { r.k = prev; r.valid = false; }
    return r;
}
DI int rl2(int a, int b, int k) { const int va = __builtin_amdgcn_readlane(a, k & 63), vb = __builtin_amdgcn_readlane(b, k & 63); return k < 64 ? va : vb; }
DI float rl2f(float a, float b, int k) { return __builtin_bit_cast(float, rl2(__builtin_bit_cast(int, a), __builtin_bit_cast(int, b), k)); }

DI void gather_u(const Params& p, const Ctx& c) {
    const bf16_t* H2 = (const bf16_t*)(p.ws + OFF_H); const unsigned char* U = p.ws + OFF_U16;
    const int* IDX = (const int*)(p.ws + OFF_IDX); const float* GW = (const float*)(p.ws + OFF_GW); float* WK = (float*)(p.ws + OFF_WK);
    const int x = blockIdx.x & 7, jb = blockIdx.x >> 3, nj = ((int)gridDim.x - x + 7) >> 3;
    const int wl = jb * NWAVES + c.wave, nwl = nj * NWAVES;
    constexpr int G = 4, SH = (NPU == 2) ? 10 : 11;
#pragma unroll 1
    for (int ps = 0; ps < NPU; ++ps) {
        const int part = x * NPU + ps;
#pragma unroll 1
        for (int m = wl; m < M; m += nwl) {
            const int ia = IDX[(size_t)m * 128 + c.lane], ib = IDX[(size_t)m * 128 + 64 + c.lane];
            unsigned long long ma = __ballot((ia >> SH) == part), mb = __ballot((ib >> SH) == part);
            if (!(ma | mb)) continue;
            const unsigned long long ma0 = ma, mb0 = mb;
            float hf[2][16];
#pragma unroll
            for (int j = 0; j < 2; ++j) { const u32x4 a = *(const u32x4*)(H2 + (size_t)m * D + j * 1024 + c.lane * 16), bq = *(const u32x4*)(H2 + (size_t)m * D + j * 1024 + c.lane * 16 + 8);
#pragma unroll
                for (int q = 0; q < 4; ++q) { hf[j][2 * q] = bflo(a[q]); hf[j][2 * q + 1] = bfhi(a[q]); hf[j][8 + 2 * q] = bflo(bq[q]); hf[j][8 + 2 * q + 1] = bfhi(bq[q]); } }
            const float ga = GW[(size_t)m * 128 + c.lane], gb = GW[(size_t)m * 128 + 64 + c.lane];
            float wa = 0.f, wb = 0.f;
            int prev = 0;
            while (ma | mb) {
                PairPick pk[G]; u32x4 uu[G][2];
#pragma unroll
                for (int g = 0; g < G; ++g) { pk[g] = pick_next(ma, mb, prev); prev = pk[g].k;
                    const int e = rl2(ia, ib, pk[g].k);
                    const unsigned char* ur = U + (size_t)e * D;
#pragma unroll
                    for (int j = 0; j < 2; ++j) uu[g][j] = *(const u32x4*)(ur + ((unsigned)c.lane * 16u + j * 1024u)); }
                float d[G];
#pragma unroll
                for (int g = 0; g < G; ++g) {
                    float d0 = 0.f, d1 = 0.f;
#pragma unroll
                    for (int j = 0; j < 2; ++j)
#pragma unroll
                        for (int q = 0; q < 4; ++q) { const f32x2 lo = __builtin_amdgcn_cvt_pk_f32_fp8((int)uu[g][j][q], false), hi = __builtin_amdgcn_cvt_pk_f32_fp8((int)uu[g][j][q], true);
                            d0 += lo.x * hf[j][4 * q] + hi.x * hf[j][4 * q + 2]; d1 += lo.y * hf[j][4 * q + 1] + hi.y * hf[j][4 * q + 3]; }
                    d[g] = d0 + d1;
                }
#pragma unroll
                for (int o = 1; o < 64; o <<= 1)
#pragma unroll
                    for (int g = 0; g < G; ++g) d[g] += __shfl_xor(d[g], o);
#pragma unroll
                for (int g = 0; g < G; ++g) if (pk[g].valid) {
                    const float a = gelu_tanh(d[g] * (1.f / U8_SCALE)) * (1.f / V8_SCALE); const int k = pk[g].k;
                    if (k < 64) { if (c.lane == k) wa = a * ga; } else { if (c.lane == k - 64) wb = a * gb; }
                }
            }
            if ((ma0 >> c.lane) & 1ull) WK[(size_t)m * 128 + c.lane] = wa;
            if ((mb0 >> c.lane) & 1ull) WK[(size_t)m * 128 + 64 + c.lane] = wb;
        }
    }
}

DI void gather_v(const Params& p, const Ctx& c) {
    const unsigned char* V = p.ws + OFF_V16;
    const int* IDX = (const int*)(p.ws + OFF_IDX); const float* WK = (const float*)(p.ws + OFF_WK); const float* mod = (const float*)(p.ws + OFF_MOD);
    float* SSQ = (float*)(p.ws + OFF_SSQ);
    const int x = blockIdx.x & 7, jb = blockIdx.x >> 3, nj = ((int)gridDim.x - x + 7) >> 3;
    const int wl = jb * NWAVES + c.wave, nwl = nj * NWAVES;
    const int q4 = c.lane >> 4, l16 = c.lane & 15;
    const unsigned voff = 256u * x + l16 * 16u;
    constexpr int SHV = (NPV == 2) ? 13 : 14;
#pragma unroll 1
    for (int ps = 0; ps < NPV; ++ps) {
#pragma unroll 1
        for (int m = wl; m < M; m += nwl) {
            const int b = m / SEQ;
            const int ia = IDX[(size_t)m * 128 + c.lane], ib = IDX[(size_t)m * 128 + 64 + c.lane];
            const float wa = WK[(size_t)m * 128 + c.lane], wb = WK[(size_t)m * 128 + 64 + c.lane];
            unsigned long long ma = __ballot((ia >> SHV) == ps), mb = __ballot((ib >> SHV) == ps);
            float acc[16];
#pragma unroll
            for (int i = 0; i < 16; ++i) acc[i] = 0.f;
            int prev = 0;
            while (ma | mb) {
                u32x4 vv[4]; float wv[4];
#pragma unroll
                for (int s4 = 0; s4 < 4; ++s4) {
                    int e = 0; float w = 0.f;
#pragma unroll
                    for (int g = 0; g < 4; ++g) { const PairPick pk = pick_next(ma, mb, prev); prev = pk.k;
                        const int eg = rl2(ia, ib, pk.k); const float wg = pk.valid ? rl2f(wa, wb, pk.k) : 0.f;
                        e = (q4 == g) ? eg : e; w = (q4 == g) ? wg : w; }
                    vv[s4] = *(const u32x4*)(V + (size_t)e * D + voff); wv[s4] = w;
                }
#pragma unroll
                for (int s4 = 0; s4 < 4; ++s4)
#pragma unroll
                    for (int q = 0; q < 4; ++q) { const f32x2 lo = __builtin_amdgcn_cvt_pk_f32_fp8((int)vv[s4][q], false), hi = __builtin_amdgcn_cvt_pk_f32_fp8((int)vv[s4][q], true);
                        acc[4 * q] += wv[s4] * lo.x; acc[4 * q + 1] += wv[s4] * lo.y; acc[4 * q + 2] += wv[s4] * hi.x; acc[4 * q + 3] += wv[s4] * hi.y; }
            }
#pragma unroll
            for (int i = 0; i < 16; ++i) { acc[i] += __shfl_xor(acc[i], 16); acc[i] += __shfl_xor(acc[i], 32); }
            f32x4 sel;
#pragma unroll
            for (int e = 0; e < 4; ++e) sel[e] = q4 == 0 ? acc[e] : (q4 == 1 ? acc[4 + e] : (q4 == 2 ? acc[8 + e] : acc[12 + e]));
            const int col = 256 * x + 16 * l16 + 4 * q4;
            float* op = p.out + (size_t)m * D + col;
            const f32x4 val = *(const f32x4*)op + DBG_BETA * *(const f32x4*)(mod + b * 6 * D + 5 * D + col) * sel;
            *(f32x4*)op = val;
            if (ps == NPV - 1) { const float ss = wave_sum(val[0] * val[0] + val[1] * val[1] + val[2] * val[2] + val[3] * val[3]); if (c.lane == 0) SSQ[(size_t)m * 8 + x] = ss; }
        }
    }
}
DI void gather_final(const Params& p, const Ctx& c) {
    const float* SSQ = (const float*)(p.ws + OFF_SSQ);
    for (int m = c.gw; m < M; m += c.ngw) {
        float s = (c.lane < 8) ? SSQ[(size_t)m * 8 + c.lane] : 0.f;
        s += __shfl_xor(s, 1); s += __shfl_xor(s, 2); s += __shfl_xor(s, 4);
        const float rstd = rsqrtf(__shfl(s, 0) * (1.f / D) + EPS);
        float* orow = p.out + (size_t)m * D;
#pragma unroll
        for (int j = 0; j < 8; ++j) { const int col = (j * 64 + c.lane) * 4; *(f32x4*)(orow + col) = *(const f32x4*)(orow + col) * rstd * *(const f32x4*)(p.fng + col); }
    }
}
#ifndef GATHER_L2
#define GATHER_L2 0
#endif

DI void phase_gather_v2(const Params& p, const Ctx& c) {
    const bf16_t* H2 = (const bf16_t*)(p.ws + OFF_H);
    const int* IDX = (const int*)(p.ws + OFF_IDX); const float* GW = (const float*)(p.ws + OFF_GW); const float* mod = (const float*)(p.ws + OFF_MOD);
    LAS float* hs = (LAS float*)c.lds; LAS float* wk = hs + 2048; LAS int* ek = (LAS int*)(wk + 128); LAS float* red = (LAS float*)(ek + 128);
    for (int m = blockIdx.x; m < M; m += gridDim.x) {
        const int b = m / SEQ;
        __syncthreads();
        for (int i = c.tid; i < 2048; i += NTHREADS) hs[i] = bf2f(H2[(size_t)m * D + i]);
        if (c.tid < 128) ek[c.tid] = IDX[(size_t)m * 128 + c.tid];
        __syncthreads();
        for (int k = c.wave; k < 128; k += NWAVES) {
            const float* ur = p.pu + (size_t)ek[k] * D;
            float d = 0.f;
            for (int i = 0; i < 8; ++i) { const int col = i * 256 + c.lane * 4; const f32x4 u = *(const f32x4*)(ur + col);
                d += u[0] * hs[col] + u[1] * hs[col + 1] + u[2] * hs[col + 2] + u[3] * hs[col + 3]; }
            d = wave_sum(d);
            if (c.lane == 0) wk[k] = gelu_tanh(d) * GW[(size_t)m * 128 + k];
        }
        __syncthreads();
        const int col = c.tid * 4;
        f32x4 acc = {0.f, 0.f, 0.f, 0.f};
        for (int k = 0; k < 128; ++k) { const f32x4 v = *(const f32x4*)(p.pv + (size_t)ek[k] * D + col); acc += v * wk[k]; }
        float* orow = p.out + (size_t)m * D;
        const f32x4 x2 = *(const f32x4*)(orow + col) + DBG_BETA * *(const f32x4*)(mod + b * 6 * D + 5 * D + col) * acc;
        float ss = wave_sum(x2[0] * x2[0] + x2[1] * x2[1] + x2[2] * x2[2] + x2[3] * x2[3]);
        if (c.lane == 0) red[c.wave] = ss;
        __syncthreads();
        float tot = 0.f;
        for (int w = 0; w < NWAVES; ++w) tot += red[w];
        const float rstd = rsqrtf(tot * (1.f / D) + EPS);
        *(f32x4*)(orow + col) = x2 * rstd * *(const f32x4*)(p.fng + col);
    }
}


#define XB_TMO      128
#define XB_XCNT(j)  (256  + 64 * (j))
#define XB_XSUB(j)  (1280 + 64 * (j))
#define XB_XGEN(j)  (2304 + 64 * (j))
#define XB_TOP      3328
#define XB_TOPGEN   3392
#define XCD_BAR_WORDS 3456
#define XB_SPIN_CAP (1u << 18)

__device__ __forceinline__ unsigned xb_ld(unsigned* p)              { return __hip_atomic_load(p, __ATOMIC_RELAXED, __HIP_MEMORY_SCOPE_AGENT); }
__device__ __forceinline__ unsigned xb_add(unsigned* p, unsigned v) { return __hip_atomic_fetch_add(p, v, __ATOMIC_RELAXED, __HIP_MEMORY_SCOPE_AGENT); }
__device__ __forceinline__ unsigned xb_xcc_id() { return (unsigned)__builtin_amdgcn_s_getreg((3 << 11) | 20) & 0xFu; }
#define XB_SPIN(cond, bar) do { unsigned _sp = 0; while (cond) { __builtin_amdgcn_s_sleep(1); \
    if ((++_sp & 255u) == 0u) { if (xb_ld(&(bar)[XB_TMO])) break; if (_sp > XB_SPIN_CAP) { atomicAdd(&(bar)[XB_TMO], 1u); break; } } } } while (0)

struct XcdBarrier {
    unsigned* bar; unsigned x;
    volatile LAS unsigned* st;
};

__device__ __forceinline__ XcdBarrier xcd_barrier_post(unsigned* bar, volatile LAS unsigned* st) {
    XcdBarrier b; b.bar = bar; b.x = xb_xcc_id(); b.st = st;
    if (threadIdx.x == 0) (void)xb_add(&bar[XB_XCNT(b.x)], 1u);
    return b;
}
__device__ __forceinline__ void xcd_barrier_complete(unsigned* bar, unsigned x, unsigned& nloc, unsigned& nx) {
    const unsigned G = gridDim.x * gridDim.y * gridDim.z;
    unsigned sum, cnt, mine, sp = 0u;
    for (;;) {
        sum = 0u; cnt = 0u; mine = 0u;
#pragma unroll
        for (unsigned j = 0; j < 16; ++j) { const unsigned c = xb_ld(&bar[XB_XCNT(j)]); sum += c; cnt += (c > 0u) ? 1u : 0u; mine = (j == x) ? c : mine; }
        if (sum == G) break;
        __builtin_amdgcn_s_sleep(1);
        if ((++sp & 255u) == 0u) { if (xb_ld(&bar[XB_TMO])) break; if (sp > XB_SPIN_CAP) { atomicAdd(&bar[XB_TMO], 1u); break; } }
    }
    nloc = mine > 0u ? mine : 1u; nx = cnt > 0u ? cnt : 1u;
}

__device__ __forceinline__ bool xb_lead(int wave_s) { return wave_s == 0 && __builtin_amdgcn_mbcnt_hi(~0u, __builtin_amdgcn_mbcnt_lo(~0u, 0u)) == 0; }
__device__ __forceinline__ void xcd_barrier(const XcdBarrier& b, int wave_s) {
    asm volatile("s_waitcnt vmcnt(0)" ::: "memory");
    __syncthreads();
    if (xb_lead(wave_s)) {
        unsigned* bar = b.bar;
        __builtin_amdgcn_s_waitcnt(0);
        unsigned nloc = b.st[0], nx = b.st[1];
        if (nloc == 0u) { xcd_barrier_complete(bar, b.x, nloc, nx); b.st[0] = nloc; b.st[1] = nx; }
        const unsigned old = xb_add(&bar[XB_XSUB(b.x)], 1u);
        const unsigned gen = old / nloc;
        if (old + 1u == (gen + 1u) * nloc) {
            __builtin_amdgcn_fence(__ATOMIC_RELEASE, "agent");
            asm volatile("s_waitcnt vmcnt(0)" ::: "memory");
            const unsigned og = xb_add(&bar[XB_TOP], 1u);
            const unsigned tg = og / nx;
            if (og + 1u == (tg + 1u) * nx) xb_add(&bar[XB_TOPGEN], 1u);
            else XB_SPIN(xb_ld(&bar[XB_TOPGEN]) == tg, bar);
            __builtin_amdgcn_fence(__ATOMIC_ACQUIRE, "agent");
            xb_add(&bar[XB_XGEN(b.x)], 1u);
            asm volatile("s_waitcnt vmcnt(0)" ::: "memory");
        } else {
            XB_SPIN(xb_ld(&bar[XB_XGEN(b.x)]) == gen, bar);
            __builtin_amdgcn_fence(__ATOMIC_ACQUIRE, "agent");
            asm volatile("s_waitcnt vmcnt(0)" ::: "memory");
        }
    }
    __syncthreads();
}


DI void grid_barrier(unsigned* ctr, unsigned target, int wave_s) {
    asm volatile("s_waitcnt vmcnt(0)" ::: "memory");
    __syncthreads();
    if (wave_s == 0) {
        const int l = __builtin_amdgcn_mbcnt_hi(~0u, __builtin_amdgcn_mbcnt_lo(~0u, 0u));
        if (l == 0) {
            __builtin_amdgcn_fence(__ATOMIC_RELEASE, "agent");
            asm volatile("s_waitcnt vmcnt(0)" ::: "memory");
            __hip_atomic_fetch_add(ctr, 1u, __ATOMIC_RELAXED, __HIP_MEMORY_SCOPE_AGENT);
            unsigned spins = 0;
            while (__hip_atomic_load(ctr, __ATOMIC_RELAXED, __HIP_MEMORY_SCOPE_AGENT) < target) { __builtin_amdgcn_s_sleep(2); if (++spins > (1u << 23)) break; }
            __builtin_amdgcn_fence(__ATOMIC_ACQUIRE, "agent");
            asm volatile("s_waitcnt vmcnt(0)" ::: "memory");
        }
    }
    __syncthreads();
}

__global__ void __launch_bounds__(NTHREADS, 2) mega(Params p) {
    extern __shared__ __attribute__((aligned(16))) unsigned char lds_raw[];
    const int wave_s = __builtin_amdgcn_readfirstlane(threadIdx.x >> 6);
#define MKCTX() Ctx c; { int l_; asm volatile("v_mbcnt_lo_u32_b32 %0, -1, 0\n\tv_mbcnt_hi_u32_b32 %0, -1, %0" : "=v"(l_)); c.lds = (LAS unsigned char*)lds_raw; c.lane = l_; c.wave = wave_s; c.tid = wave_s * 64 + l_; \
    c.gw = blockIdx.x * NWAVES + wave_s; c.ngw = gridDim.x * NWAVES; }
    unsigned char* ws = p.ws;
    const float* mod = (const float*)(ws + OFF_MOD);
    const int lo = p.ph_lo, hi = p.ph_hi;
    XcdBarrier xbar; xbar.bar = (unsigned*)(ws + OFF_XBAR); xbar.x = 0; xbar.st = nullptr;
    if (USE_XBAR && lo == 0 && hi == NPHASE) {
        volatile LAS unsigned* stw = (volatile LAS unsigned*)(lds_raw + LDS_BYTES - 32);
        if (threadIdx.x < 2) stw[threadIdx.x] = 0u;
        __syncthreads();
        xbar = xcd_barrier_post((unsigned*)(ws + OFF_XBAR), stw);
    }
#define IN(k) (lo <= (k) && (k) < hi)
#define SEAM(k) do { if (IN(k) && IN((k) + 1)) { if (USE_XBAR) xcd_barrier(xbar, wave_s); else grid_barrier((unsigned*)(ws + OFF_CTL), (unsigned)((k) + 1) * gridDim.x, wave_s); \
    if (TIME_PHASE >= 0 && blockIdx.x == 0 && threadIdx.x == 0) ((unsigned long long*)(ws + OFF_CTL + 512))[(k) + 1] = __builtin_amdgcn_s_memrealtime(); } } while (0)

    if (TIME_PHASE >= 0 && blockIdx.x == 0 && threadIdx.x == 0) ((unsigned long long*)(ws + OFF_CTL + 512))[0] = __builtin_amdgcn_s_memrealtime();
    if (IN(0)) { MKCTX(); phase_prologue(p, c, true, PRO_SPLIT == 0); }
    SEAM(0);
    if (IN(1)) for (int rep_ = 0; rep_ < (DUP_PHASE == 1 ? 2 : 1); ++rep_) { MKCTX();
        const long long* modi = (const long long*)(ws + OFF_MODI); float* modw = (float*)(ws + OFF_MOD);
        for (int i = blockIdx.x * NTHREADS + c.tid; i < NB * 6 * D; i += gridDim.x * NTHREADS) modw[i] = (float)((double)modi[i] * (1.0 / 4294967296.0));
        modulate_rows(p.x, p.n1g, modi + 1 * D, modi + 0 * D, (bf16_t*)(ws + OFF_H), c);
        if (PRO_SPLIT) phase_prologue(p, c, false, true);
    }
    SEAM(1);
    if (IN(2)) for (int rep_ = 0; rep_ < (DUP_PHASE == 2 ? 2 : 1); ++rep_) { MKCTX();
        EpiProj e1{(bf16_t*)(ws + OFF_CQ), (bf16_t*)(ws + OFF_CKV), (bf16_t*)(ws + OFF_KR), (bf16_t*)(ws + OFF_SBQ), (bf16_t*)(ws + OFF_SBK), (bf16_t*)(ws + OFF_GA), (bf16_t*)(ws + OFF_GB), (const f32x2*)(ws + OFF_CS)};
        GEMM(c, (const bf16_t*)(ws + OFF_H), (const bf16_t*)(ws + OFF_WIN), M, 7168, 2048, e1);
        if (DUP_GEMM == 20) GEMM(c, (const bf16_t*)(ws + OFF_H), (const bf16_t*)(ws + OFF_WIN), M, 7168, 2048, e1);
        EpiT e2{(bf16_t*)(ws + OFF_SBVT), nullptr};
        GEMM(c, (const bf16_t*)(ws + OFF_WSBV), (const bf16_t*)(ws + OFF_H), 1024, M, 2048, e2);
        if (DUP_GEMM == 21) GEMM(c, (const bf16_t*)(ws + OFF_WSBV), (const bf16_t*)(ws + OFF_H), 1024, M, 2048, e2);
    }
    SEAM(2);
    if (IN(3)) for (int rep_ = 0; rep_ < (DUP_PHASE == 3 ? 2 : 1); ++rep_) { MKCTX(); phase_rowstats(p, c); }
    SEAM(3);
    if (DBG_XTRA_BAR) { for (int q_ = 0; q_ < DBG_XTRA_BAR; ++q_) { if (IN(3) && IN(4)) xcd_barrier(xbar, wave_s); } }
    if (IN(4)) for (int rep_ = 0; rep_ < (DUP_PHASE == 4 ? 2 : 1); ++rep_) { MKCTX();
        EpiUq e1{(bf16_t*)(ws + OFF_Q), (const float*)(ws + OFF_RSTQ), (const f32x2*)(ws + OFF_CS)};
        GEMM(c, (const bf16_t*)(ws + OFF_CQ), (const bf16_t*)(ws + OFF_WUQ), M, 1536, 512, e1);
        if (DUP_GEMM == 40) GEMM(c, (const bf16_t*)(ws + OFF_CQ), (const bf16_t*)(ws + OFF_WUQ), M, 1536, 512, e1);
        EpiRowScale e2{(bf16_t*)(ws + OFF_KN), 1024, (const float*)(ws + OFF_RSTKV)};
        GEMM(c, (const bf16_t*)(ws + OFF_CKV), (const bf16_t*)(ws + OFF_WUK), M, 1024, 256, e2);
        if (DUP_GEMM == 41) GEMM(c, (const bf16_t*)(ws + OFF_CKV), (const bf16_t*)(ws + OFF_WUK), M, 1024, 256, e2);
        EpiT e3{(bf16_t*)(ws + OFF_VT), (const float*)(ws + OFF_RSTKV)};
        GEMM(c, (const bf16_t*)(ws + OFF_WUV), (const bf16_t*)(ws + OFF_CKV), 1024, M, 256, e3);
        if (DUP_GEMM == 42) GEMM(c, (const bf16_t*)(ws + OFF_WUV), (const bf16_t*)(ws + OFF_CKV), 1024, M, 256, e3);
    }
    SEAM(4);
    if (IN(5)) for (int rep_ = 0; rep_ < (DUP_PHASE == 5 ? 2 : 1); ++rep_) {
#if FAST_ATTN
        { MKCTX(); attn_mla_fast(p, c); }
        if (DUP_GEMM == 51) { MKCTX(); attn_mla_fast(p, c); }
        { MKCTX(); attn_sb_fast(p, c); }
        if (DUP_GEMM == 52) { MKCTX(); attn_sb_fast(p, c); }
#else
        MKCTX();
        attn_mla_naive(p, c); attn_sb_naive(p, c);
#endif
    }
    SEAM(5);
    if (IN(6)) for (int rep_ = 0; rep_ < (DUP_PHASE == 6 ? 2 : 1); ++rep_) { MKCTX();
        EpiGate1 e1{(bf16_t*)(ws + OFF_MERGED), (const bf16_t*)(ws + OFF_GA)};
        GEMM(c, (const bf16_t*)(ws + OFF_ATTA), (const bf16_t*)(ws + OFF_WA), M, 2048, 1024, e1);
        if (DUP_GEMM == 60) GEMM(c, (const bf16_t*)(ws + OFF_ATTA), (const bf16_t*)(ws + OFF_WA), M, 2048, 1024, e1);
        EpiGate2 e2{(bf16_t*)(ws + OFF_MERGED), (const bf16_t*)(ws + OFF_GB)};
        GEMM(c, (const bf16_t*)(ws + OFF_ATTB), (const bf16_t*)(ws + OFF_WB), M, 2048, 1024, e2);
    }
    SEAM(6);
    if (IN(7)) for (int rep_ = 0; rep_ < (DUP_PHASE == 7 ? 2 : 1); ++rep_) { MKCTX();
        EpiRes e{p.x, mod + 2 * D, p.out};
        GEMM(c, (const bf16_t*)(ws + OFF_MERGED), (const bf16_t*)(ws + OFF_WOUT), M, 2048, 2048, e);
    }
    SEAM(7);
    if (IN(8)) for (int rep_ = 0; rep_ < (DUP_PHASE == 8 ? 2 : 1); ++rep_) { MKCTX();
        modulate_rows(p.out, p.n2g, mod + 4 * D, mod + 3 * D, (bf16_t*)(ws + OFF_H), c);
        convert_table(p.pu, ws + OFF_U16, U8_SCALE, c);
        convert_table(p.pv, ws + OFF_V16, V8_SCALE, c);
    }
    SEAM(8);
    if (IN(9)) for (int rep_ = 0; rep_ < (DUP_PHASE == 9 ? 2 : 1); ++rep_) { MKCTX();
        EpiPq e{(bf16_t*)(ws + OFF_PQ)};
        GEMM(c, (const bf16_t*)(ws + OFF_H), (const bf16_t*)(ws + OFF_WPQ), M, 2048, 2048, e);
#if FAST_SEL && FAST_GEMM && SEL_FUSED
        { MKCTX(); select_own_tiles(p, c); }
#endif
    }
#if !(FAST_SEL && FAST_GEMM && SEL_FUSED)
    SEAM(9);
    if (IN(10)) for (int rep_ = 0; rep_ < (DUP_PHASE == 10 ? 2 : 1); ++rep_) { MKCTX();
#if FAST_SEL
        select_fast(p, c);
#else
        select_naive(p, c);
#endif
    }
#else
    if (IN(9) && IN(10)) {   }
#endif
    SEAM(10);
#if GATHER_L2
    if (IN(11)) { MKCTX(); gather_u(p, c); }
    SEAM(11);
    if (IN(12)) { MKCTX(); gather_v(p, c); }
    SEAM(12);
    if (IN(13)) { MKCTX(); gather_final(p, c); }
#else
#if GATHER_SORTED
    if (IN(11)) { MKCTX(); phase_gather_sorted(p, c); }
#elif GATHER_ROUNDS
    if (IN(11)) { MKCTX(); phase_gather_rounds(p, c, xbar); }
#else
    if (IN(11)) { if (DUP_GEMM == 110) { MKCTX(); phase_gather(p, c, (float*)(ws + OFF_SBQ)); }
        if (DUP_GEMM == 111) { MKCTX(); phase_gather(p, c, (float*)(ws + OFF_SBQ), 0x3ff); } MKCTX(); phase_gather(p, c, p.out); }
#endif
#endif
#undef IN
#undef SEAM
}

extern "C" void kernel_launch(void* const* d_in, const int* in_sizes, int n_in, void* d_out, int out_size, void* d_ws, size_t ws_size, hipStream_t stream) {
    static int grid = 0;
    if (grid == 0) {
        if (n_in != 20 || out_size != M * D || ws_size < WS_END) { fprintf(stderr, "kernel_launch: unexpected shapes (n_in %d out %d ws %zu need %zu)\n", n_in, out_size, ws_size, (size_t)WS_END); grid = -1; return; }
        int dev = 0, cus = 0, per_cu = 0;
        (void)hipGetDevice(&dev); (void)hipDeviceGetAttribute(&cus, hipDeviceAttributeMultiprocessorCount, dev);
        if (hipFuncSetAttribute((const void*)mega, hipFuncAttributeMaxDynamicSharedMemorySize, LDS_BYTES) != hipSuccess) { fprintf(stderr, "kernel_launch: hipFuncSetAttribute failed\n"); grid = -1; return; }
        if (hipOccupancyMaxActiveBlocksPerMultiprocessor(&per_cu, (const void*)mega, NTHREADS, LDS_BYTES) != hipSuccess || per_cu < 1) { fprintf(stderr, "kernel_launch: occupancy query failed (%d)\n", per_cu); per_cu = 1; }
        (void)hipGetLastError();
        grid = cus;
    }
    if (grid < 0) return;
    (void)hipMemsetAsync((char*)d_ws + OFF_CTL, 0, ZERO_BYTES, stream);
    Params p{};
    p.x = (const float*)d_in[0]; p.c = (const float*)d_in[1]; p.pos = (const int*)d_in[2]; p.ada_w = (const float*)d_in[3]; p.ada_b = (const float*)d_in[4];
    p.n1g = (const float*)d_in[5]; p.n2g = (const float*)d_in[6]; p.w_in = (const float*)d_in[7]; p.qng = (const float*)d_in[8]; p.kvng = (const float*)d_in[9];
    p.w_uq = (const float*)d_in[10]; p.w_ukv = (const float*)d_in[11]; p.w_bm = (const float*)d_in[12]; p.w_bs = (const float*)d_in[13]; p.w_out = (const float*)d_in[14];
    p.w_pq = (const float*)d_in[15]; p.skeys = (const float*)d_in[16]; p.pu = (const float*)d_in[17]; p.pv = (const float*)d_in[18]; p.fng = (const float*)d_in[19];
    p.out = (float*)d_out; p.ws = (unsigned char*)d_ws;
    for (int i = 0; i < 32; ++i) p.invf[i] = (float)pow(10000.0, -(double)i / 32.0);
#if N_LAUNCH_MODE == 1
    p.ph_lo = 0; p.ph_hi = NPHASE;
    void* args[] = {&p};
    hipError_t e = hipLaunchCooperativeKernel((const void*)mega, dim3(grid), dim3(NTHREADS), args, LDS_BYTES, stream);
    if (e != hipSuccess) fprintf(stderr, "cooperative launch failed: %s (grid %d)\n", hipGetErrorString(e), grid);
#else
    for (int k = 0; k < NPHASE; ++k) {
        p.ph_lo = k; p.ph_hi = k + 1;
        hipLaunchKernelGGL(mega, dim3(grid), dim3(NTHREADS), LDS_BYTES, stream, p);
    }
#endif
}
```

```cpp
#include <hip/hip_runtime.h>
#include <hip/hip_cooperative_groups.h>
#include <cstdio>
#include <cstdint>
#include <cmath>
namespace cg = cooperative_groups;

#ifndef N_LAUNCH_MODE
#define N_LAUNCH_MODE 1
#endif

#ifndef TIME_PHASE
#define TIME_PHASE -1
#endif
#ifndef TIME_SCALE
#define TIME_SCALE 5000.f
#endif
#ifndef DUP_GEMM
#define DUP_GEMM -1
#endif
#ifndef PRO_SPLIT
#define PRO_SPLIT 1
#endif
#ifndef USE_XBAR
#define USE_XBAR 1
#endif
#ifndef DBG_XTRA_BAR
#define DBG_XTRA_BAR 0
#endif
#ifndef DBG_ROUND_BAR
#define DBG_ROUND_BAR 0
#endif
#ifndef GATHER_DYN
#define GATHER_DYN 1
#endif
#ifndef SEL_FUSED
#define SEL_FUSED 1
#endif
#ifndef DUP_PHASE
#define DUP_PHASE -1
#endif
#ifndef DBG_ALPHA
#define DBG_ALPHA 1.0f
#endif
#ifndef DBG_BETA
#define DBG_BETA 1.0f
#endif
#define LAS __attribute__((address_space(3)))
#define DI __device__ __forceinline__
typedef unsigned short bf16_t;
typedef short bf16x8 __attribute__((ext_vector_type(8)));
typedef float f32x4 __attribute__((ext_vector_type(4)));
typedef float f32x2 __attribute__((ext_vector_type(2)));
typedef unsigned u32x4 __attribute__((ext_vector_type(4)));
typedef unsigned u32x2 __attribute__((ext_vector_type(2)));
typedef __bf16 bf16v2 __attribute__((ext_vector_type(2)));

constexpr int M = 16384, D = 2048, SEQ = 4096, NB = 4;
constexpr int NTHREADS = 512, NWAVES = 8;
constexpr int LDS_BYTES = 160 * 1024;
constexpr float EPS = 1e-6f;
constexpr float LOG2E = 1.4426950408889634f;
constexpr int NPHASE = 14;

constexpr size_t al256(size_t x) { return (x + 255) & ~(size_t)255; }
constexpr size_t OFF_CTL = 0;
constexpr size_t OFF_XBAR = 4096;
constexpr size_t OFF_MODI = 32768;
constexpr size_t ZERO_BYTES = OFF_MODI + (size_t)NB * 6 * D * 8;
constexpr size_t OFF_MOD = al256(ZERO_BYTES);
constexpr size_t OFF_RSTQ = OFF_MOD + (size_t)NB * 6 * D * 4;
constexpr size_t OFF_RSTKV = OFF_RSTQ + (size_t)M * 4;
constexpr size_t OFF_CS = OFF_RSTKV + (size_t)M * 4;
constexpr size_t OFF_KEYS = OFF_CS + (size_t)M * 32 * 8;
constexpr size_t OFF_WIN = OFF_KEYS + (size_t)8 * 2 * 128 * 128 * 2;
constexpr size_t OFF_WSBV = OFF_WIN + (size_t)7168 * 2048 * 2;
constexpr size_t OFF_WUQ = OFF_WSBV + (size_t)1024 * 2048 * 2;
constexpr size_t OFF_WUK = OFF_WUQ + (size_t)1536 * 512 * 2;
constexpr size_t OFF_WUV = OFF_WUK + (size_t)1024 * 256 * 2;
constexpr size_t OFF_WA = OFF_WUV + (size_t)1024 * 256 * 2;
constexpr size_t OFF_WB = OFF_WA + (size_t)2048 * 1024 * 2;
constexpr size_t OFF_WOUT = OFF_WB + (size_t)2048 * 1024 * 2;
constexpr size_t OFF_WPQ = OFF_WOUT + (size_t)2048 * 2048 * 2;
constexpr size_t OFF_H = OFF_WPQ + (size_t)2048 * 2048 * 2;
constexpr size_t OFF_CQ = OFF_H + (size_t)M * 2048 * 2;
constexpr size_t OFF_CKV = OFF_CQ + (size_t)M * 512 * 2;
constexpr size_t OFF_KR = OFF_CKV + (size_t)M * 256 * 2;
constexpr size_t OFF_SBQ = OFF_KR + (size_t)M * 64 * 2;
constexpr size_t OFF_SBK = OFF_SBQ + (size_t)M * 1024 * 2;
constexpr size_t OFF_SBVT = OFF_SBK + (size_t)M * 1024 * 2;
constexpr size_t OFF_GA = OFF_SBVT + (size_t)M * 1024 * 2;
constexpr size_t OFF_GB = OFF_GA + (size_t)M * 2048 * 2;
constexpr size_t OFF_Q = OFF_GB + (size_t)M * 2048 * 2;
constexpr size_t OFF_KN = OFF_Q + (size_t)M * 1536 * 2;
constexpr size_t OFF_VT = OFF_KN + (size_t)M * 1024 * 2;
constexpr size_t OFF_ATTA = OFF_VT + (size_t)M * 1024 * 2;
constexpr size_t OFF_ATTB = OFF_ATTA + (size_t)M * 1024 * 2;
constexpr size_t WS_END = OFF_ATTB + (size_t)M * 1024 * 2;
constexpr size_t OFF_MERGED = OFF_SBQ;
constexpr size_t OFF_PQ = OFF_GA;
constexpr size_t OFF_IDX = OFF_GB;
constexpr size_t OFF_GW = OFF_GB + (size_t)M * 128 * 4;
constexpr size_t OFF_U16 = OFF_Q;
constexpr size_t OFF_V16 = OFF_U16 + (size_t)16384 * 2048;
static_assert(OFF_V16 + (size_t)16384 * 2048 <= WS_END, "u/v overlay");
constexpr float U8_SCALE = 68.f, V8_SCALE = 1.5f;
static_assert(WS_END < (size_t)620 * 1000 * 1000, "workspace budget");

struct Params {
    const float *x, *c; const int* pos;
    const float *ada_w, *ada_b, *n1g, *n2g, *w_in, *qng, *kvng, *w_uq, *w_ukv, *w_bm, *w_bs, *w_out, *w_pq, *skeys, *pu, *pv, *fng;
    float* out; unsigned char* ws;
    float invf[32];
    int ph_lo, ph_hi;
};

DI unsigned pk2(float lo, float hi) { bf16v2 p; p[0] = (__bf16)lo; p[1] = (__bf16)hi; return __builtin_bit_cast(unsigned, p); }
DI float bflo(unsigned u) { return __uint_as_float(u << 16); }
DI float bfhi(unsigned u) { return __uint_as_float(u & 0xffff0000u); }
DI float dot2bf(unsigned a, unsigned b, float c) { return __builtin_amdgcn_fdot2_f32_bf16(__builtin_bit_cast(bf16v2, a), __builtin_bit_cast(bf16v2, b), c, false); }
DI float bf2f(bf16_t b) { return __uint_as_float(((unsigned)b) << 16); }
DI float wave_sum(float v) {
#pragma unroll
    for (int o = 1; o < 64; o <<= 1) v += __shfl_xor(v, o);
    return v;
}
DI float wave_max(float v) {
#pragma unroll
    for (int o = 1; o < 64; o <<= 1) v = fmaxf(v, __shfl_xor(v, o));
    return v;
}
DI float sigmoidf_(float v) { return 1.f / (1.f + __expf(-v)); }
DI float gelu_tanh(float v) { const float u = 0.7978845608028654f * (v + 0.044715f * v * v * v); const float e = __expf(2.f * u); const float t = 1.f - 2.f / (e + 1.f); return 0.5f * v * (1.f + t); }
#ifndef P2_FP8
#define P2_FP8 1
#endif
constexpr float W8_SCALE = 64.f;
DI unsigned pk4f8(float a, float b, float c, float d) { int w = __builtin_amdgcn_cvt_pk_fp8_f32(a, b, 0, false); w = __builtin_amdgcn_cvt_pk_fp8_f32(c, d, w, true); return (unsigned)w; }
DI void store_bf16x4(bf16_t* p, f32x4 v) { u32x2 w; w.x = pk2(v[0], v[1]); w.y = pk2(v[2], v[3]); *(u32x2*)p = w; }
DI void store_bf16x8(bf16_t* p, f32x4 a, f32x4 b) { u32x4 w; w.x = pk2(a[0], a[1]); w.y = pk2(a[2], a[3]); w.z = pk2(b[0], b[1]); w.w = pk2(b[2], b[3]); *(u32x4*)p = w; }
DI void load_bf16x8(const bf16_t* p, f32x4& a, f32x4& b) { const u32x4 w = *(const u32x4*)p; a = (f32x4){bflo(w.x), bfhi(w.x), bflo(w.y), bfhi(w.y)}; b = (f32x4){bflo(w.z), bfhi(w.z), bflo(w.w), bfhi(w.w)}; }
DI f32x4 sig4(f32x4 v) { return (f32x4){sigmoidf_(v[0]), sigmoidf_(v[1]), sigmoidf_(v[2]), sigmoidf_(v[3])}; }
DI f32x4 rope4(f32x4 v, f32x2 c0, f32x2 c1) { return (f32x4){v[0] * c0.x - v[1] * c0.y, v[1] * c0.x + v[0] * c0.y, v[2] * c1.x - v[3] * c1.y, v[3] * c1.x + v[2] * c1.y}; }
DI f32x4 load_bf16x4(const bf16_t* p) { const u32x2 w = *(const u32x2*)p; return (f32x4){bflo(w.x), bfhi(w.x), bflo(w.y), bfhi(w.y)}; }

struct Ctx {
    LAS unsigned char* lds;
    int tid, lane, wave, gw, ngw;
};

struct MapWin { DI int operator()(int n) const {
    if (n < 768) return n;
    if (n < 1024) { const int j = n - 768; if (j >= 64) return -1; return 768 + (j >> 1) + 32 * (j & 1); }
    if (n < 2048) return 832 + (n - 1024);
    if (n < 3072) return 1856 + (n - 2048);
    if (n < 5120) return 3904 + (n - 3072);
    return 5952 + (n - 5120); } };
struct MapOff { int off; DI int operator()(int n) const { return n + off; } };
struct MapUq { DI int operator()(int n) const { const int hd = n / 192, j = n % 192; if (j < 128) return hd * 192 + j; const int jj = j - 128; return hd * 192 + 128 + (jj >> 1) + 32 * (jj & 1); } };
struct MapUk { DI int operator()(int n) const { return (n >> 7) * 256 + (n & 127); } };
struct MapUv { DI int operator()(int n) const { return (n >> 7) * 256 + 128 + (n & 127); } };

template <bool F8 = false, class Map>
DI void transpose_item(const float* W, int K, int N, const Map& mp, const float* rowscale, bf16_t* dst, int kb, int nb, LAS float* scr, int lane) {
    const int k0 = kb * 64, sc = mp(nb * 64 + lane);
#pragma unroll 8
    for (int kk = 0; kk < 64; ++kk) {
        float v = 0.f;
        if (sc >= 0) v = W[(size_t)(k0 + kk) * N + sc];
        if (rowscale) v *= rowscale[k0 + kk];
        scr[kk * 65 + lane] = v;
    }
    asm volatile("s_waitcnt lgkmcnt(0)" ::: "memory");
    const int kc = lane & 7;
#pragma unroll
    for (int j = 0; j < 8; ++j) {
        const int nrow = (lane >> 3) + 8 * j; const LAS float* s = scr + (8 * kc) * 65 + nrow;
        if constexpr (F8) { u32x2 o; o.x = pk4f8(s[0] * W8_SCALE, s[65] * W8_SCALE, s[2 * 65] * W8_SCALE, s[3 * 65] * W8_SCALE); o.y = pk4f8(s[4 * 65] * W8_SCALE, s[5 * 65] * W8_SCALE, s[6 * 65] * W8_SCALE, s[7 * 65] * W8_SCALE);
            *(u32x2*)((unsigned char*)dst + (size_t)(nb * 64 + nrow) * K + k0 + 8 * kc) = o; }
        else {
        u32x4 o; o.x = pk2(s[0], s[65]); o.y = pk2(s[2 * 65], s[3 * 65]); o.z = pk2(s[4 * 65], s[5 * 65]); o.w = pk2(s[6 * 65], s[7 * 65]);
        *(u32x4*)(dst + (size_t)(nb * 64 + nrow) * K + k0 + 8 * kc) = o; }
    }
    asm volatile("s_waitcnt lgkmcnt(0)" ::: "memory");
}

DI void phase_prologue(const Params& p, const Ctx& c, bool do_ada = true, bool do_rest = true) {
    unsigned char* ws = p.ws;
    LAS float* scr = (LAS float*)(c.lds + c.wave * 16640);
    unsigned long long* modi = (unsigned long long*)(ws + OFF_MODI);
    if (do_ada) for (int u = c.gw; u < 32 * 48; u += c.ngw) {
        const int kp = u / 48, ch = u % 48, k0 = kp * 64, c0 = ch * 256 + c.lane * 4;
        float sl[4];
#pragma unroll
        for (int b = 0; b < 4; ++b) { const float cv = p.c[b * D + k0 + c.lane]; sl[b] = cv / (1.f + __expf(-cv)); }
        f32x4 acc[4];
#pragma unroll
        for (int b = 0; b < 4; ++b) acc[b] = (f32x4){0.f, 0.f, 0.f, 0.f};
#pragma unroll 16
        for (int kk = 0; kk < 64; ++kk) {
            const f32x4 w = *(const f32x4*)(p.ada_w + (size_t)(k0 + kk) * (6 * D) + c0);
#pragma unroll
            for (int b = 0; b < 4; ++b) { const float s = __shfl(sl[b], kk); acc[b] += w * s; }
        }
        if (kp == 0) { const f32x4 bv = *(const f32x4*)(p.ada_b + c0);
#pragma unroll
            for (int b = 0; b < 4; ++b) acc[b] += bv; }
#pragma unroll
        for (int b = 0; b < 4; ++b)
#pragma unroll
            for (int e = 0; e < 4; ++e) atomicAdd(modi + b * 6 * D + c0 + e, (unsigned long long)(long long)__builtin_rint((double)acc[b][e] * 4294967296.0));
    }
    if (!do_rest) return;
    constexpr int I_WIN = 112 * 32, I_SBV = 16 * 32, I_UQ = 24 * 8, I_UK = 16 * 4, I_UV = 16 * 4, I_A = 32 * 16, I_B = 32 * 16, I_OUT = 32 * 32, I_PQ = 32 * 32;
    constexpr int NIT = I_WIN + I_SBV + I_UQ + I_UK + I_UV + I_A + I_B + I_OUT + I_PQ;
    for (int it = c.gw; it < NIT; it += c.ngw) {
        int r = it;
        if (r < I_WIN) { transpose_item<P2_FP8 != 0>(p.w_in, 2048, 8000, MapWin{}, nullptr, (bf16_t*)(ws + OFF_WIN), r % 32, r / 32, scr, c.lane); continue; } r -= I_WIN;
        if (r < I_SBV) { transpose_item<P2_FP8 != 0>(p.w_in, 2048, 8000, MapOff{2880}, nullptr, (bf16_t*)(ws + OFF_WSBV), r % 32, r / 32, scr, c.lane); continue; } r -= I_SBV;
        if (r < I_UQ) { transpose_item(p.w_uq, 512, 1536, MapUq{}, p.qng, (bf16_t*)(ws + OFF_WUQ), r % 8, r / 8, scr, c.lane); continue; } r -= I_UQ;
        if (r < I_UK) { transpose_item(p.w_ukv, 256, 2048, MapUk{}, p.kvng, (bf16_t*)(ws + OFF_WUK), r % 4, r / 4, scr, c.lane); continue; } r -= I_UK;
        if (r < I_UV) { transpose_item(p.w_ukv, 256, 2048, MapUv{}, p.kvng, (bf16_t*)(ws + OFF_WUV), r % 4, r / 4, scr, c.lane); continue; } r -= I_UV;
        if (r < I_A) { transpose_item(p.w_bm, 1024, 2048, MapOff{0}, nullptr, (bf16_t*)(ws + OFF_WA), r % 16, r / 16, scr, c.lane); continue; } r -= I_A;
        if (r < I_B) { transpose_item(p.w_bs, 1024, 2048, MapOff{0}, nullptr, (bf16_t*)(ws + OFF_WB), r % 16, r / 16, scr, c.lane); continue; } r -= I_B;
        if (r < I_OUT) { transpose_item(p.w_out, 2048, 2048, MapOff{0}, nullptr, (bf16_t*)(ws + OFF_WOUT), r % 32, r / 32, scr, c.lane); continue; } r -= I_OUT;
        transpose_item(p.w_pq, 2048, 2048, MapOff{0}, nullptr, (bf16_t*)(ws + OFF_WPQ), r % 32, r / 32, scr, c.lane);
    }
    { bf16_t* kd = (bf16_t*)(ws + OFF_KEYS);
      for (int i = (c.gw * 64 + c.lane) * 4; i < 8 * 2 * 128 * 128; i += c.ngw * 64 * 4) store_bf16x4(kd + i, *(const f32x4*)(p.skeys + i)); }
    { f32x2* cs = (f32x2*)(ws + OFF_CS);
      for (int i = c.gw * 64 + c.lane; i < M * 32; i += c.ngw * 64) {
          const int m = i >> 5, f = i & 31;
          const float ang = (float)p.pos[m] * p.invf[f];
          const double rev = (double)ang * 0.15915494309189533576888;
          const float fr = (float)(rev - __builtin_rint(rev));
          cs[i] = (f32x2){__builtin_amdgcn_cosf(fr), __builtin_amdgcn_sinf(fr)};
      } }
}

DI f32x4 ld_mod4(const float* p) { return *(const f32x4*)p; }
DI f32x4 ld_mod4(const long long* p) { f32x4 r;
#pragma unroll
    for (int e = 0; e < 4; ++e) r[e] = (float)((double)p[e] * (1.0 / 4294967296.0));
    return r; }
template <bool F8 = false, class MT>
DI void modulate_rows(const float* src, const float* g, const MT* sc, const MT* sh, bf16_t* dst, const Ctx& c) {
    for (int m = c.gw; m < M; m += c.ngw) {
        const int b = m / SEQ;
        const float* xr = src + (size_t)m * D;
        f32x4 v[8]; float ss = 0.f;
#pragma unroll
        for (int j = 0; j < 8; ++j) { v[j] = *(const f32x4*)(xr + (j * 64 + c.lane) * 4); ss += v[j][0] * v[j][0] + v[j][1] * v[j][1] + v[j][2] * v[j][2] + v[j][3] * v[j][3]; }
        const float rstd = rsqrtf(wave_sum(ss) * (1.f / D) + EPS);
#pragma unroll
        for (int j = 0; j < 8; ++j) {
            const int col = (j * 64 + c.lane) * 4;
            const f32x4 gg = *(const f32x4*)(g + col), s1 = ld_mod4(sc + b * 6 * D + col), h1 = ld_mod4(sh + b * 6 * D + col);
            const f32x4 o = v[j] * rstd * gg * (s1 + 1.f) + h1;
            if constexpr (F8) *(unsigned*)((unsigned char*)dst + (size_t)m * D + col) = pk4f8(o[0], o[1], o[2], o[3]);
            else store_bf16x4(dst + (size_t)m * D + col, o);
        }
    }
}
DI void phase_rowstats(const Params& p, const Ctx& c) {
    const bf16_t* cq = (const bf16_t*)(p.ws + OFF_CQ); const bf16_t* ckv = (const bf16_t*)(p.ws + OFF_CKV);
    float* rq = (float*)(p.ws + OFF_RSTQ); float* rkv = (float*)(p.ws + OFF_RSTKV);
    for (int m = c.gw; m < M; m += c.ngw) {
        const u32x4 a = *(const u32x4*)(cq + (size_t)m * 512 + c.lane * 8);
        const u32x2 b = *(const u32x2*)(ckv + (size_t)m * 256 + c.lane * 4);
        float s1 = 0.f, s2 = 0.f;
#pragma unroll
        for (int e = 0; e < 4; ++e) { const float lo = bflo(a[e]), hi = bfhi(a[e]); s1 += lo * lo + hi * hi; }
#pragma unroll
        for (int e = 0; e < 2; ++e) { const float lo = bflo(b[e]), hi = bfhi(b[e]); s2 += lo * lo + hi * hi; }
        s1 = wave_sum(s1); s2 = wave_sum(s2);
        if (c.lane == 0) { rq[m] = rsqrtf(s1 * (1.f / 512.f) + EPS); rkv[m] = rsqrtf(s2 * (1.f / 256.f) + EPS); }
    }
}
typedef float f32x16v __attribute__((ext_vector_type(16)));
typedef float f32x32v __attribute__((ext_vector_type(32)));
typedef unsigned u32x6 __attribute__((ext_vector_type(6)));
#ifndef FP6_ORDER
#define FP6_ORDER 1
#endif
DI void convert_table(const float* src, unsigned char* dst, float scale, const Ctx& c) {
    const size_t ngroups = (size_t)16384 * 64;
    for (size_t gi = (size_t)c.gw * 64 + c.lane; gi < ngroups; gi += (size_t)c.ngw * 64) {
        const size_t row = gi >> 6; const int l = (int)(gi & 63);
        const float* sp = src + row * 2048 + l * 32;
        f32x4 v[8];
#pragma unroll
        for (int i = 0; i < 8; ++i) v[i] = *(const f32x4*)(sp + 4 * i) * scale;
        f32x16v a, b;
#pragma unroll
        for (int e = 0; e < 16; ++e) {
#if FP6_ORDER == 0
            a[e] = v[e >> 2][e & 3]; b[e] = v[4 + (e >> 2)][e & 3];
#else
            a[e] = v[(2 * e) >> 2][(2 * e) & 3]; b[e] = v[(2 * e + 1) >> 2][(2 * e + 1) & 3];
#endif
        }
        const u32x6 pk = __builtin_amdgcn_cvt_scalef32_2xpk16_fp6_f32(a, b, 1.0f);
        unsigned char* dp = dst + row * 1536;
        *(u32x4*)(dp + 16 * l) = (u32x4){pk[0], pk[1], pk[2], pk[3]};
        *(u32x2*)(dp + 1024 + 8 * l) = (u32x2){pk[4], pk[5]};
    }
}

struct EpiProj {
    bf16_t *cq, *ckv, *kr, *sbq, *sbk, *ga, *gb; const f32x2* cs; float osc;
    DI void operator()(int row, int col, f32x4 v) const {
        const int tile = col >> 8; v = v * osc;
        if (tile < 2) { store_bf16x4(cq + (size_t)row * 512 + col, v); }
        else if (tile == 2) { store_bf16x4(ckv + (size_t)row * 256 + (col - 512), v); }
        else if (tile == 3) { const int j = col - 768; if (j < 64) { const f32x2 c0 = cs[row * 32 + (j >> 1)], c1 = cs[row * 32 + (j >> 1) + 1];
            const f32x4 o = {v[0] * c0.x - v[1] * c0.y, v[1] * c0.x + v[0] * c0.y, v[2] * c1.x - v[3] * c1.y, v[3] * c1.x + v[2] * c1.y};
            store_bf16x4(kr + (size_t)row * 64 + j, o); } }
        else if (tile < 8) { store_bf16x4(sbq + (size_t)row * 1024 + (col - 1024), v * (0.08838834764831845f * LOG2E)); }
        else if (tile < 12) { store_bf16x4(sbk + (size_t)row * 1024 + (col - 2048), v); }
        else if (tile < 20) { store_bf16x4(ga + (size_t)row * 2048 + (col - 3072), (f32x4){sigmoidf_(v[0]), sigmoidf_(v[1]), sigmoidf_(v[2]), sigmoidf_(v[3])}); }
        else { store_bf16x4(gb + (size_t)row * 2048 + (col - 5120), (f32x4){sigmoidf_(v[0]), sigmoidf_(v[1]), sigmoidf_(v[2]), sigmoidf_(v[3])}); }
    }    DI void operator()(int row, int col, f32x4 v0, f32x4 v1) const {
        const int tile = col >> 8; v0 = v0 * osc; v1 = v1 * osc;
        if (tile < 2) { store_bf16x8(cq + (size_t)row * 512 + col, v0, v1); }
        else if (tile == 2) { store_bf16x8(ckv + (size_t)row * 256 + (col - 512), v0, v1); }
        else if (tile == 3) { const int j = col - 768; if (j < 64) { const f32x2* cp = cs + row * 32 + (j >> 1);
            store_bf16x8(kr + (size_t)row * 64 + j, rope4(v0, cp[0], cp[1]), rope4(v1, cp[2], cp[3])); } }
        else if (tile < 8) { const float sc = 0.08838834764831845f * LOG2E; store_bf16x8(sbq + (size_t)row * 1024 + (col - 1024), v0 * sc, v1 * sc); }
        else if (tile < 12) { store_bf16x8(sbk + (size_t)row * 1024 + (col - 2048), v0, v1); }
        else if (tile < 20) { store_bf16x8(ga + (size_t)row * 2048 + (col - 3072), sig4(v0), sig4(v1)); }
        else { store_bf16x8(gb + (size_t)row * 2048 + (col - 5120), sig4(v0), sig4(v1)); }
    }
};
struct EpiT { bf16_t* o; const float* cscale; float osc;
    static constexpr int MB = 2; struct Pre { f32x4 a, b; };
    DI Pre load(int row, int col) const { Pre q; q.a = q.b = (f32x4){osc, osc, osc, osc}; if (cscale) { q.a = *(const f32x4*)(cscale + col) * osc; q.b = *(const f32x4*)(cscale + col + 4) * osc; } return q; }
    DI void apply(int row, int col, f32x4 v0, f32x4 v1, const Pre& q) const { store_bf16x8(o + (size_t)row * M + col, v0 * q.a, v1 * q.b); }
    DI void operator()(int row, int col, f32x4 v) const { if (cscale) v = v * *(const f32x4*)(cscale + col); store_bf16x4(o + (size_t)row * M + col, v); }
    DI void operator()(int row, int col, f32x4 v0, f32x4 v1) const { if (cscale) { v0 = v0 * *(const f32x4*)(cscale + col); v1 = v1 * *(const f32x4*)(cscale + col + 4); } store_bf16x8(o + (size_t)row * M + col, v0, v1); } };
struct EpiUq { bf16_t* q; const float* rst; const f32x2* cs;
    static constexpr int MB = 2; struct Pre { float sc; f32x2 c0, c1, c2, c3; };
    DI Pre load(int row, int col) const { Pre w; w.sc = rst[row]; w.c0 = w.c1 = w.c2 = w.c3 = (f32x2){0.f, 0.f}; const int j = col % 192;
        if (j >= 128) { const f32x2* cp = cs + row * 32 + ((j - 128) >> 1); w.c0 = cp[0]; w.c1 = cp[1]; w.c2 = cp[2]; w.c3 = cp[3]; } return w; }
    DI void apply(int row, int col, f32x4 v0, f32x4 v1, const Pre& w) const {
        const float sc = w.sc * (0.07216878364870322f * LOG2E); v0 = v0 * sc; v1 = v1 * sc;
        if (col % 192 >= 128) { v0 = rope4(v0, w.c0, w.c1); v1 = rope4(v1, w.c2, w.c3); }
        store_bf16x8(q + (size_t)row * 1536 + col, v0, v1); }
    DI void operator()(int row, int col, f32x4 v) const {
        v = v * (rst[row] * (0.07216878364870322f * LOG2E));
        const int j = col % 192;
        if (j >= 128) { const int i0 = (j - 128) >> 1; const f32x2 c0 = cs[row * 32 + i0], c1 = cs[row * 32 + i0 + 1];
            v = (f32x4){v[0] * c0.x - v[1] * c0.y, v[1] * c0.x + v[0] * c0.y, v[2] * c1.x - v[3] * c1.y, v[3] * c1.x + v[2] * c1.y}; }
        store_bf16x4(q + (size_t)row * 1536 + col, v);
    }
    DI void operator()(int row, int col, f32x4 v0, f32x4 v1) const {
        const float sc = rst[row] * (0.07216878364870322f * LOG2E); v0 = v0 * sc; v1 = v1 * sc;
        const int j = col % 192;
        if (j >= 128) { const f32x2* cp = cs + row * 32 + ((j - 128) >> 1); v0 = rope4(v0, cp[0], cp[1]); v1 = rope4(v1, cp[2], cp[3]); }
        store_bf16x8(q + (size_t)row * 1536 + col, v0, v1);
    } };
struct EpiRowScale { bf16_t* o; int ld; const float* rst;
    static constexpr int MB = 4; typedef float Pre;
    DI Pre load(int row, int col) const { return rst[row]; }
    DI void apply(int row, int col, f32x4 v0, f32x4 v1, const Pre& sc) const { store_bf16x8(o + (size_t)row * ld + col, v0 * sc, v1 * sc); }
    DI void operator()(int row, int col, f32x4 v) const { store_bf16x4(o + (size_t)row * ld + col, v * rst[row]); }
    DI void operator()(int row, int col, f32x4 v0, f32x4 v1) const { const float sc = rst[row]; store_bf16x8(o + (size_t)row * ld + col, v0 * sc, v1 * sc); } };
struct EpiGate1 { bf16_t* mg; const bf16_t* g;
    static constexpr int MB = 4; typedef u32x4 Pre;
    DI Pre load(int row, int col) const { return *(const u32x4*)(g + (size_t)row * 2048 + col); }
    DI void apply(int row, int col, f32x4 v0, f32x4 v1, const Pre& w) const { const size_t i = (size_t)row * 2048 + col;
        const f32x4 g0 = {bflo(w.x), bfhi(w.x), bflo(w.y), bfhi(w.y)}, g1 = {bflo(w.z), bfhi(w.z), bflo(w.w), bfhi(w.w)}; store_bf16x8(mg + i, v0 * g0, v1 * g1); }
    DI void operator()(int row, int col, f32x4 v) const { const size_t i = (size_t)row * 2048 + col; store_bf16x4(mg + i, v * load_bf16x4(g + i)); }
    DI void operator()(int row, int col, f32x4 v0, f32x4 v1) const { const size_t i = (size_t)row * 2048 + col; f32x4 g0, g1; load_bf16x8(g + i, g0, g1); store_bf16x8(mg + i, v0 * g0, v1 * g1); } };
struct EpiGate2 { bf16_t* mg; const bf16_t* g;
    static constexpr int MB = 4; struct Pre { u32x4 g, m; };
    DI Pre load(int row, int col) const { const size_t i = (size_t)row * 2048 + col; Pre q; q.g = *(const u32x4*)(g + i); q.m = *(const u32x4*)(mg + i); return q; }
    DI void apply(int row, int col, f32x4 v0, f32x4 v1, const Pre& q) const { const size_t i = (size_t)row * 2048 + col;
        const f32x4 g0 = {bflo(q.g.x), bfhi(q.g.x), bflo(q.g.y), bfhi(q.g.y)}, g1 = {bflo(q.g.z), bfhi(q.g.z), bflo(q.g.w), bfhi(q.g.w)};
        const f32x4 m0 = {bflo(q.m.x), bfhi(q.m.x), bflo(q.m.y), bfhi(q.m.y)}, m1 = {bflo(q.m.z), bfhi(q.m.z), bflo(q.m.w), bfhi(q.m.w)};
        store_bf16x8(mg + i, m0 + v0 * g0, m1 + v1 * g1); }
    DI void operator()(int row, int col, f32x4 v) const { const size_t i = (size_t)row * 2048 + col; store_bf16x4(mg + i, load_bf16x4(mg + i) + v * load_bf16x4(g + i)); }
    DI void operator()(int row, int col, f32x4 v0, f32x4 v1) const { const size_t i = (size_t)row * 2048 + col; f32x4 g0, g1, m0, m1; load_bf16x8(g + i, g0, g1); load_bf16x8(mg + i, m0, m1); store_bf16x8(mg + i, m0 + v0 * g0, m1 + v1 * g1); } };
struct EpiRes { const float* x; const float* gt; float* x1;
    static constexpr int MB = 4; struct Pre { f32x4 a, b; };
    DI Pre load(int row, int col) const { const size_t i = (size_t)row * 2048 + col; Pre q; q.a = *(const f32x4*)(x + i); q.b = *(const f32x4*)(x + i + 4); return q; }
    DI void apply(int row, int col, f32x4 v0, f32x4 v1, const Pre& q) const { const size_t i = (size_t)row * 2048 + col; const int b = row / SEQ; const float* gp = gt + b * 6 * D + col;
        *(f32x4*)(x1 + i) = q.a + *(const f32x4*)gp * v0 * DBG_ALPHA; *(f32x4*)(x1 + i + 4) = q.b + *(const f32x4*)(gp + 4) * v1 * DBG_ALPHA; }
    DI void operator()(int row, int col, f32x4 v) const { const size_t i = (size_t)row * 2048 + col; const int b = row / SEQ;
        *(f32x4*)(x1 + i) = *(const f32x4*)(x + i) + *(const f32x4*)(gt + b * 6 * D + col) * v * DBG_ALPHA; }
    DI void operator()(int row, int col, f32x4 v0, f32x4 v1) const { (*this)(row, col, v0); (*this)(row, col + 4, v1); } };
struct EpiPq { bf16_t* pq;
    DI void operator()(int row, int col, f32x4 v) const { store_bf16x4(pq + (size_t)(col >> 8) * M * 256 + (size_t)row * 256 + (col & 255), v); }
    DI void operator()(int row, int col, f32x4 v0, f32x4 v1) const { store_bf16x8(pq + (size_t)(col >> 8) * M * 256 + (size_t)row * 256 + (col & 255), v0, v1); } };

template <class Epi>
DI void gemm_naive(const Ctx& c, const bf16_t* A, const bf16_t* Bt, int Mg, int Ng, int Kg, const Epi& E) {
    LAS float* As = (LAS float*)c.lds; LAS float* Bs = As + 16 * 132;
    const int tid = c.tid, ty = tid >> 5, tx = tid & 31;
    const int tilesN = Ng / 128, ntiles = (Mg / 128) * tilesN;
    for (int t = blockIdx.x; t < ntiles; t += gridDim.x) {
        const int tm = t / tilesN, tn = t % tilesN;
        float acc[8][4];
#pragma unroll
        for (int i = 0; i < 8; ++i)
#pragma unroll
            for (int j = 0; j < 4; ++j) acc[i][j] = 0.f;
        for (int k0 = 0; k0 < Kg; k0 += 16) {
            { const int lt = tid & 255, r = lt >> 1, kc = lt & 1;
              const bf16_t* src = (tid < 256 ? A + (size_t)(tm * 128 + r) * Kg : Bt + (size_t)(tn * 128 + r) * Kg) + k0 + kc * 8;
              const u32x4 v = *(const u32x4*)src;
              LAS float* dst = (tid < 256 ? As : Bs) + (kc * 8) * 132 + r;
              dst[0] = bflo(v.x); dst[132] = bfhi(v.x); dst[2 * 132] = bflo(v.y); dst[3 * 132] = bfhi(v.y);
              dst[4 * 132] = bflo(v.z); dst[5 * 132] = bfhi(v.z); dst[6 * 132] = bflo(v.w); dst[7 * 132] = bfhi(v.w); }
            __syncthreads();
#pragma unroll
            for (int kk = 0; kk < 16; ++kk) {
                const f32x4 a0 = *(const LAS f32x4*)(As + kk * 132 + ty * 8), a1 = *(const LAS f32x4*)(As + kk * 132 + ty * 8 + 4);
                const f32x4 b = *(const LAS f32x4*)(Bs + kk * 132 + tx * 4);
#pragma unroll
                for (int j = 0; j < 4; ++j) {
                    acc[0][j] += a0[0] * b[j]; acc[1][j] += a0[1] * b[j]; acc[2][j] += a0[2] * b[j]; acc[3][j] += a0[3] * b[j];
                    acc[4][j] += a1[0] * b[j]; acc[5][j] += a1[1] * b[j]; acc[6][j] += a1[2] * b[j]; acc[7][j] += a1[3] * b[j];
                }
            }
            __syncthreads();
        }
#pragma unroll
        for (int i = 0; i < 8; ++i) E(tm * 128 + ty * 8 + i, tn * 128 + tx * 4, (f32x4){acc[i][0], acc[i][1], acc[i][2], acc[i][3]});
    }
}

namespace pg8 {
#define PG8_LAS __attribute__((address_space(3)))
typedef unsigned short bf16_t;
typedef short bf16x8 __attribute__((ext_vector_type(8)));
typedef float f32x4 __attribute__((ext_vector_type(4)));
typedef unsigned u32x4 __attribute__((ext_vector_type(4)));
constexpr int BM = 256, BK = 64, HALF = 128, HTB = HALF * BK * 2  , STAGE_BYTES = 8 * HTB, NXCD = 8, WGM = 4;

__host__ __device__ __forceinline__ int lds_byte(int r, int c) { const int st = (r >> 4) * 2 + (c >> 5), rr = r & 15, cc = c & 31, ob = rr * 64 + cc * 2; return st * 1024 + (ob ^ (((ob >> 9) & 1) << 5)); }
__host__ __device__ __forceinline__ void stage_rc(int b, int& R, int& C) { const int st = b / 1024, sb = b % 1024, swz = sb ^ (((sb >> 9) & 1) << 5); R = (st >> 1) * 16 + swz / 64; C = (st & 1) * 32 + (swz % 64) / 2; }
__host__ __device__ __forceinline__ int perm32(int rho) { const int n = rho >> 4, i = rho & 15; return 8 * (i >> 2) + 4 * n + (i & 3); }

struct Unit { int pm, pn; };
struct Gemm { const bf16_t* A; const bf16_t* Bt; int M, N, K; int tid; const unsigned char* base; };
struct StaticOrder {
    int nM, nN, nwg, G, c;
    __host__ __device__ void init(int M, int N, int G_, int c_) { nM = M / BM; nN = N / BM; nwg = nM * nN; G = G_; c = c_; }
    __host__ __device__ bool next(int i, Unit& u) const {
        const long L = (long)i * G + c; if (L >= nwg) return false;
        int wgid = (int)L; { const int q = nwg / NXCD, r = nwg % NXCD, xcd = wgid % NXCD, off = wgid / NXCD; wgid = (xcd < r ? xcd * (q + 1) : r * (q + 1) + (xcd - r) * q) + off; }
        const int nig = WGM * nN, gid = wgid / nig, fm = gid * WGM, gsz = (nM - fm) < WGM ? (nM - fm) : WGM;
        u.pm = fm + ((wgid % nig) % gsz); u.pn = (wgid % nig) / gsz; return true;
    }
    __device__ __forceinline__ void a_ready(const Unit&) const {}
    __device__ __forceinline__ void done(const Unit&) const {}
};
typedef int i32x8 __attribute__((ext_vector_type(8)));
template <class Epi, class Sched, bool STAMP = false, bool F8 = false>
__device__ __forceinline__ void gemm_phase(PG8_LAS unsigned char* lds, const Gemm g, const Sched& S, const Epi& E, unsigned long long* stamps) {
    const int tid = g.tid, wid = __builtin_amdgcn_readfirstlane(tid >> 6), lane = tid & 63, wr = wid >> 2, wc = wid & 3, fr = lane & 15, fq = lane >> 4;
    const int K = g.K, nt = K / BK;
    int ts_lo = 0, ts_hi = 0, nts = 0; const unsigned long long rt_entry = STAMP ? (unsigned long long)wall_clock64() : 0ull;
#define PG8_STAMP() do { if (STAMP && wid == 0 && nts < 64) { const unsigned long long _c = (unsigned long long)clock64(); \
        ts_lo = (lane == nts) ? (int)(unsigned)_c : ts_lo; ts_hi = (lane == nts) ? (int)(unsigned)(_c >> 32) : ts_hi; ++nts; } } while (0)
    PG8_STAMP();
    unsigned voffA[2], voffB[2];
#pragma unroll
    for (int i = 0; i < 2; ++i) { int R, C; stage_rc(tid * 16 + i * 8192, R, C); const int Rb = Epi::PERM ? ((R & ~31) + perm32(R & 31)) : R;
        voffA[i] = (unsigned)(R * K + C) * 2u; voffB[i] = (unsigned)(Rb * K + C) * 2u; }
    const unsigned kstep = (unsigned)(BK * 2);
    const unsigned hstep = (unsigned)HALF * K * 2;
    const unsigned tstep = 2 * hstep;
    const __amdgpu_buffer_rsrc_t rs = __builtin_amdgcn_make_buffer_rsrc((void*)g.base, (short)0, (int)0x7fffffff, 0x00020000);
    const unsigned oA = (unsigned)((const unsigned char*)g.A - g.base), oB = (unsigned)((const unsigned char*)g.Bt - g.base);
    const unsigned ldsw = (unsigned)wid * 1024u;
    const int aoff = lds_byte(wr * 64 + fr, fq * 8), boff = lds_byte(wc * 32 + fr, fq * 8);
#define PG8_SA(b, h) (((b) * 2 + (h)) * HTB)
#define PG8_SB(b, h) ((4 + (b) * 2 + (h)) * HTB)
#define PG8_STAGE(bufoff, gbase, voff) do { _Pragma("unroll") for (int _i = 0; _i < 2; ++_i) \
        __builtin_amdgcn_raw_ptr_buffer_load_lds(rs, (PG8_LAS void*)(lds + (bufoff) + ldsw + _i * 8192), 16, (voff)[_i], (gbase), 0, 0); } while (0)
#define PG8_LDA(dst, b, h) do { _Pragma("unroll") for (int m = 0; m < 4; ++m) _Pragma("unroll") for (int k = 0; k < 2; ++k) dst[m][k] = *(const PG8_LAS bf16x8*)(lds + PG8_SA(b, h) + aoff + m * 2048 + k * 1024); } while (0)
#define PG8_LDB(dst, b, h) do { _Pragma("unroll") for (int n = 0; n < 2; ++n) _Pragma("unroll") for (int k = 0; k < 2; ++k) dst[n][k] = *(const PG8_LAS bf16x8*)(lds + PG8_SB(b, h) + boff + n * 2048 + k * 1024); } while (0)
#define PG8_CAT8(x0, x1) __builtin_bit_cast(i32x8, __builtin_shufflevector(x0, x1, 0, 1, 2, 3, 4, 5, 6, 7, 8, 9, 10, 11, 12, 13, 14, 15))
#define PG8_MMA(ai, bj, At, Bt) do { __builtin_amdgcn_s_setprio(1); _Pragma("unroll") for (int m = 0; m < 4; ++m) _Pragma("unroll") for (int n = 0; n < 2; ++n) { \
        if constexpr (F8) acc[ai][bj][m][n] = __builtin_amdgcn_mfma_scale_f32_16x16x128_f8f6f4(PG8_CAT8(Bt[n][0], Bt[n][1]), PG8_CAT8(At[m][0], At[m][1]), acc[ai][bj][m][n], 0, 0, 0, 0, 0, 0); \
        else { _Pragma("unroll") for (int k = 0; k < 2; ++k) acc[ai][bj][m][n] = __builtin_amdgcn_mfma_f32_16x16x32_bf16(Bt[n][k], At[m][k], acc[ai][bj][m][n], 0, 0, 0); } } \
        __builtin_amdgcn_s_setprio(0); } while (0)
#define PG8_WAIT_V(n) asm volatile("s_waitcnt vmcnt(" #n ")" ::: "memory")
#define PG8_WAIT_L(n) asm volatile("s_waitcnt lgkmcnt(" #n ")" ::: "memory")
#define PG8_BAR __builtin_amdgcn_s_barrier()
#define PG8_SCHED __builtin_amdgcn_sched_barrier(0)
    Unit cur, nxt; int ui = 0;
    if (!S.next(0, cur)) return;
    f32x4 acc[2][2][4][2];
#pragma unroll
    for (int a = 0; a < 2; ++a)
#pragma unroll
        for (int b = 0; b < 2; ++b)
#pragma unroll
            for (int m = 0; m < 4; ++m)
#pragma unroll
                for (int n = 0; n < 2; ++n) acc[a][b][m][n] = (f32x4){0.f, 0.f, 0.f, 0.f};
    bf16x8 At[4][2], B0[2][2], B1[2][2];
    unsigned cA = oA + (unsigned)cur.pm * tstep, cB = oB + (unsigned)cur.pn * tstep;
    S.a_ready(cur);
    PG8_STAGE(PG8_SB(0, 0), cB, voffB); PG8_STAGE(PG8_SA(0, 0), cA, voffA); PG8_STAGE(PG8_SB(0, 1), cB + hstep, voffB); PG8_STAGE(PG8_SA(0, 1), cA + hstep, voffA);
    if (wr == 1) PG8_BAR;
    PG8_WAIT_V(4); PG8_BAR;
    PG8_STAGE(PG8_SB(1, 0), cB + kstep, voffB); PG8_STAGE(PG8_SA(1, 0), cA + kstep, voffA); PG8_STAGE(PG8_SB(1, 1), cB + hstep + kstep, voffB);
    PG8_WAIT_V(6); PG8_BAR;
    PG8_STAMP();
    for (;;) {
        const bool has_next = S.next(ui + 1, nxt);
        const unsigned nA = has_next ? oA + (unsigned)nxt.pm * tstep : cA, nB = has_next ? oB + (unsigned)nxt.pn * tstep : cB;
        for (int t = 0; t < nt; t += 2) {
            const bool last = (t == nt - 2);
            const unsigned a1 = cA + (unsigned)(t + 1) * kstep;
            const unsigned a2 = last ? nA : cA + (unsigned)(t + 2) * kstep, b2 = last ? nB : cB + (unsigned)(t + 2) * kstep;
            const unsigned a3 = a2 + kstep, b3 = b2 + kstep;
            if (last && has_next) S.a_ready(nxt);
            PG8_LDB(B0, 0, 0); PG8_SCHED; PG8_LDA(At, 0, 0); PG8_STAGE(PG8_SA(1, 1), a1 + hstep, voffA);
            PG8_WAIT_L(8); PG8_BAR; PG8_WAIT_L(0); PG8_MMA(0, 0, At, B0); PG8_BAR; PG8_SCHED;
            PG8_LDB(B1, 0, 1); PG8_STAGE(PG8_SB(0, 0), b2, voffB);
            PG8_BAR; PG8_WAIT_L(0); PG8_MMA(0, 1, At, B1); PG8_BAR;
            PG8_LDA(At, 0, 1); PG8_STAGE(PG8_SA(0, 0), a2, voffA);
            PG8_BAR; PG8_WAIT_L(0); PG8_MMA(1, 0, At, B0); PG8_BAR; PG8_SCHED;
            PG8_STAGE(PG8_SB(0, 1), b2 + hstep, voffB);
            PG8_WAIT_V(6); PG8_BAR; PG8_MMA(1, 1, At, B1); PG8_BAR;
            PG8_LDB(B0, 1, 0); PG8_SCHED; PG8_LDA(At, 1, 0); PG8_STAGE(PG8_SA(0, 1), a2 + hstep, voffA);
            PG8_WAIT_L(8); PG8_BAR; PG8_WAIT_L(0); PG8_MMA(0, 0, At, B0); PG8_BAR; PG8_SCHED;
            PG8_LDB(B1, 1, 1); PG8_STAGE(PG8_SB(1, 0), b3, voffB);
            PG8_BAR; PG8_WAIT_L(0); PG8_MMA(0, 1, At, B1); PG8_BAR;
            PG8_LDA(At, 1, 1); PG8_STAGE(PG8_SA(1, 0), a3, voffA);
            PG8_BAR; PG8_WAIT_L(0); PG8_MMA(1, 0, At, B0); PG8_BAR; PG8_SCHED;
            PG8_STAGE(PG8_SB(1, 1), b3 + hstep, voffB);
            PG8_WAIT_V(6); PG8_BAR; PG8_MMA(1, 1, At, B1); PG8_BAR;
        }
        PG8_STAMP();
        if constexpr (!Epi::AFTER_DRAIN) { E(acc, cur, wr, wc, fr, fq); S.done(cur); }
        PG8_STAMP();
        if (!has_next) break;
#pragma unroll
        for (int a = 0; a < 2; ++a)
#pragma unroll
            for (int b = 0; b < 2; ++b)
#pragma unroll
                for (int m = 0; m < 4; ++m)
#pragma unroll
                    for (int n = 0; n < 2; ++n) acc[a][b][m][n] = (f32x4){0.f, 0.f, 0.f, 0.f};
        cur = nxt; cA = nA; cB = nB; ++ui;
    }
    PG8_WAIT_V(0);
    if (wr == 0) PG8_BAR;
    PG8_BAR;
    if constexpr (Epi::AFTER_DRAIN) { E.fused(acc, cur, wr, wc, fr, fq, lds, wid, lane); S.done(cur); }
    PG8_STAMP();
    if (STAMP && wid == 0) { stamps[lane] = lane < nts ? (((unsigned long long)(unsigned)ts_hi << 32) | (unsigned)ts_lo) : 0ull;
        if (lane == 62) stamps[62] = rt_entry; if (lane == 63) stamps[63] = (unsigned long long)wall_clock64(); }
#undef PG8_STAMP
#undef PG8_SA
#undef PG8_SB
#undef PG8_STAGE
#undef PG8_LDA
#undef PG8_LDB
#undef PG8_MMA
#undef PG8_CAT8
#undef PG8_WAIT_V
#undef PG8_WAIT_L
#undef PG8_BAR
#undef PG8_SCHED
}
}

template <class E4, class = void> struct epi_mb { static constexpr int value = 0; };
template <class E4> struct epi_mb<E4, decltype((void)E4::MB)> { static constexpr int value = E4::MB; };
template <class E4> struct EpiAdapt {
    static constexpr bool PERM = true, AFTER_DRAIN = false;
    E4 e;
    __device__ __forceinline__ void operator()(const pg8::f32x4 (&acc)[2][2][4][2], const pg8::Unit& u, int wr, int wc, int fr, int fq) const {
        if constexpr (epi_mb<E4>::value > 0) {
            constexpr int MB = epi_mb<E4>::value;
#pragma unroll
            for (int ai = 0; ai < 2; ++ai)
#pragma unroll
                for (int m0 = 0; m0 < 4; m0 += MB) {
                    typename E4::Pre pre[MB][2];
#pragma unroll
                    for (int mi = 0; mi < MB; ++mi)
#pragma unroll
                        for (int bj = 0; bj < 2; ++bj) pre[mi][bj] = e.load(u.pm * 256 + ai * 128 + wr * 64 + (m0 + mi) * 16 + fr, u.pn * 256 + bj * 128 + wc * 32 + fq * 8);
#pragma unroll
                    for (int mi = 0; mi < MB; ++mi)
#pragma unroll
                        for (int bj = 0; bj < 2; ++bj) e.apply(u.pm * 256 + ai * 128 + wr * 64 + (m0 + mi) * 16 + fr, u.pn * 256 + bj * 128 + wc * 32 + fq * 8, acc[ai][bj][m0 + mi][0], acc[ai][bj][m0 + mi][1], pre[mi][bj]);
                    asm volatile("" ::: "memory");
                }
        } else {
#pragma unroll
        for (int ai = 0; ai < 2; ++ai)
#pragma unroll
            for (int m = 0; m < 4; ++m) {
                const int row = u.pm * 256 + ai * 128 + wr * 64 + m * 16 + fr;
#pragma unroll
                for (int bj = 0; bj < 2; ++bj) e(row, u.pn * 256 + bj * 128 + wc * 32 + fq * 8, acc[ai][bj][m][0], acc[ai][bj][m][1]);
                asm volatile("" ::: "memory");
            }
        }
    }
};
template <class E4>
DI void gemm_fast(const Ctx& c, const unsigned char* WSB, const bf16_t* A, const bf16_t* Bt, int Mg, int Ng, int Kg, const E4& e4) {
    pg8::Gemm g{A, Bt, Mg, Ng, Kg, c.tid, WSB}; pg8::StaticOrder S; S.init(Mg, Ng, (int)gridDim.x, (int)blockIdx.x);
    EpiAdapt<E4> E{e4};
    pg8::gemm_phase<EpiAdapt<E4>, pg8::StaticOrder, false>((PG8_LAS unsigned char*)c.lds, g, S, E, nullptr);
}
template <class E4>
DI void gemm_fast8(const Ctx& c, const unsigned char* WSB, const unsigned char* A, const unsigned char* Bt, int Mg, int Ng, int Kg, const E4& e4) {
    pg8::Gemm g{(const bf16_t*)A, (const bf16_t*)Bt, Mg, Ng, Kg / 2, c.tid, WSB}; pg8::StaticOrder S; S.init(Mg, Ng, (int)gridDim.x, (int)blockIdx.x);
    EpiAdapt<E4> E{e4};
    pg8::gemm_phase<EpiAdapt<E4>, pg8::StaticOrder, false, true>((PG8_LAS unsigned char*)c.lds, g, S, E, nullptr);
}
#define GEMM8(c_, ...) do { MKCTX(); gemm_fast8(c, ws, __VA_ARGS__); } while (0)
#ifndef FAST_GEMM
#define FAST_GEMM 1
#endif
#if FAST_GEMM
#define GEMM(c_, ...) do { MKCTX(); gemm_fast(c, ws, __VA_ARGS__); } while (0)
#else
#define GEMM(c_, ...) do { MKCTX(); gemm_naive(c, __VA_ARGS__); } while (0)
#endif

DI void attn_mla_naive(const Params& p, const Ctx& c) {
    const bf16_t* Q = (const bf16_t*)(p.ws + OFF_Q); const bf16_t* KN = (const bf16_t*)(p.ws + OFF_KN); const bf16_t* KR = (const bf16_t*)(p.ws + OFF_KR);
    const bf16_t* VT = (const bf16_t*)(p.ws + OFF_VT); bf16_t* O = (bf16_t*)(p.ws + OFF_ATTA);
    for (int u = c.gw; u < M * 8; u += c.ngw) {
        const int m = u >> 3, hd = u & 7, b = m / SEQ, s = m % SEQ, base = b * SEQ, nkeys = ((s >> 6) + 1) << 6;
        const float q0 = bf2f(Q[(size_t)m * 1536 + hd * 192 + c.lane]), q1 = bf2f(Q[(size_t)m * 1536 + hd * 192 + 64 + c.lane]), q2 = bf2f(Q[(size_t)m * 1536 + hd * 192 + 128 + c.lane]);
        float mx = -1e30f, l = 0.f, o0 = 0.f, o1 = 0.f;
        const bf16_t* v0p = VT + (size_t)(hd * 128 + c.lane) * M + base; const bf16_t* v1p = v0p + (size_t)64 * M;
        for (int kk = 0; kk < nkeys; ++kk) {
            const size_t tk = base + kk;
            const float part = q0 * bf2f(KN[tk * 1024 + hd * 128 + c.lane]) + q1 * bf2f(KN[tk * 1024 + hd * 128 + 64 + c.lane]) + q2 * bf2f(KR[tk * 64 + c.lane]);
            const float sc = wave_sum(part);
            const float mn = fmaxf(mx, sc), al = exp2f(mx - mn), pp = exp2f(sc - mn);
            l = l * al + pp; o0 = o0 * al + pp * bf2f(v0p[kk]); o1 = o1 * al + pp * bf2f(v1p[kk]); mx = mn;
        }
        const float inv = 1.f / l;
        O[(size_t)m * 1024 + hd * 128 + c.lane] = (bf16_t)(pk2(o0 * inv, 0.f) & 0xffff);
        O[(size_t)m * 1024 + hd * 128 + 64 + c.lane] = (bf16_t)(pk2(o1 * inv, 0.f) & 0xffff);
    }
}
DI void attn_sb_naive(const Params& p, const Ctx& c) {
    const bf16_t* Q = (const bf16_t*)(p.ws + OFF_SBQ); const bf16_t* K = (const bf16_t*)(p.ws + OFF_SBK);
    const bf16_t* VT = (const bf16_t*)(p.ws + OFF_SBVT); bf16_t* O = (bf16_t*)(p.ws + OFF_ATTB);
    for (int u = c.gw; u < M * 8; u += c.ngw) {
        const int m = u >> 3, hd = u & 7, b = m / SEQ, s = m % SEQ, base = b * SEQ;
        const float q0 = bf2f(Q[(size_t)m * 1024 + hd * 128 + c.lane]), q1 = bf2f(Q[(size_t)m * 1024 + hd * 128 + 64 + c.lane]);
        float later = 0.f, o0 = 0.f, o1 = 0.f;
        const bf16_t* v0p = VT + (size_t)(hd * 128 + c.lane) * M + base; const bf16_t* v1p = v0p + (size_t)64 * M;
        for (int kk = s - 1; kk >= 0; --kk) {
            const size_t tk = base + kk;
            const float z2 = wave_sum(q0 * bf2f(K[tk * 1024 + hd * 128 + c.lane]) + q1 * bf2f(K[tk * 1024 + hd * 128 + 64 + c.lane]));
            const float ln2 = -(fmaxf(z2, 0.f) + __log2f(1.f + exp2f(-fabsf(z2))));
            const float w = exp2f(z2 + ln2 + later);
            later += ln2; o0 += w * bf2f(v0p[kk]); o1 += w * bf2f(v1p[kk]);
        }
        O[(size_t)m * 1024 + hd * 128 + c.lane] = (bf16_t)(pk2(o0, 0.f) & 0xffff);
        O[(size_t)m * 1024 + hd * 128 + 64 + c.lane] = (bf16_t)(pk2(o1, 0.f) & 0xffff);
    }
}


typedef float f32x16 __attribute__((ext_vector_type(16)));
#define MFMA32(a, b, c) __builtin_amdgcn_mfma_f32_32x32x16_bf16((a), (b), (c), 0, 0, 0)
constexpr int ST_KR = 16384, ST_VT = 24576, ST_BYTES = 40960;
constexpr int ATT_FLAGS = 2 * ST_BYTES;
DI float ex2(float x) { return __builtin_amdgcn_exp2f(x); }
DI float lg2(float x) { return __builtin_amdgcn_logf(x); }
DI bf16x8 pack8(float a0, float a1, float a2, float a3, float a4, float a5, float a6, float a7) {
    u32x4 t; t.x = pk2(a0, a1); t.y = pk2(a2, a3); t.z = pk2(a4, a5); t.w = pk2(a6, a7); return __builtin_bit_cast(bf16x8, t); }
#define GLDS16(gp, lp) __builtin_amdgcn_global_load_lds((const unsigned*)(gp), (LAS unsigned*)(lp), 16, 0, 0)

struct AttDmaOff { unsigned kn[2], kr, vt[2]; };
DI AttDmaOff att_dma_offsets(int w, int lane) {
    AttDmaOff o; const unsigned lr = lane >> 4, pp = lane & 15;
#pragma unroll
    for (int i = 0; i < 2; ++i) { const unsigned q = w * 2 + i, R = 4 * q + lr, cc = pp ^ (R & 15); o.kn[i] = R * 2048u + cc * 16u; }
    { const unsigned q = w, R2 = 4 * q + lr, cc = pp ^ (R2 & 15); o.kr = (2 * R2 + (cc >> 3)) * 128u + (cc & 7) * 16u; }
#pragma unroll
    for (int i = 0; i < 2; ++i) { const unsigned q = w * 2 + i, R2 = 4 * q + lr, cc = pp ^ (R2 & 15); o.vt[i] = (2 * R2 + (cc >> 3)) * (unsigned)(M * 2) + (cc & 7) * 16u; }
    return o;
}
template <bool ROPE>
DI void att_dma(LAS unsigned char* buf, __amdgpu_buffer_rsrc_t rs, const AttDmaOff& o, unsigned k_so, unsigned kr_so, unsigned vt_so, int w) {
#pragma unroll
    for (int i = 0; i < 2; ++i) __builtin_amdgcn_raw_ptr_buffer_load_lds(rs, (LAS void*)(buf + (w * 2 + i) * 1024), 16, o.kn[i], k_so, 0, 0);
    if (ROPE) __builtin_amdgcn_raw_ptr_buffer_load_lds(rs, (LAS void*)(buf + ST_KR + w * 1024), 16, o.kr, kr_so, 0, 0);
#pragma unroll
    for (int i = 0; i < 2; ++i) __builtin_amdgcn_raw_ptr_buffer_load_lds(rs, (LAS void*)(buf + ST_VT + (w * 2 + i) * 1024), 16, o.vt[i], vt_so, 0, 0);
}
DI void att_store(const f32x16 (&o)[4], float scale, bf16_t* O, size_t row, int hd, int h) {
#pragma unroll
    for (int db = 0; db < 4; ++db)
#pragma unroll
        for (int g = 0; g < 4; ++g)
            store_bf16x4(O + row * 1024 + hd * 128 + db * 32 + g * 8 + h * 4, (f32x4){o[db][4 * g] * scale, o[db][4 * g + 1] * scale, o[db][4 * g + 2] * scale, o[db][4 * g + 3] * scale});
}
DI void att_pv(f32x16 (&o)[4], const bf16x8 (&pf)[2][2], const LAS unsigned char* buf, unsigned va) {
#pragma unroll
    for (int db = 0; db < 4; ++db) {
#pragma unroll
        for (int blk = 0; blk < 2; ++blk)
#pragma unroll
            for (int ks = 0; ks < 2; ++ks) o[db] = MFMA32(*(const LAS bf16x8*)(buf + ((va ^ ((blk * 2 + ks) << 5)) + db * 4096)), pf[blk][ks], o[db]);
        asm volatile("" ::: "memory");
    }
}

DI void attn_mla_fast(const Params& p, const Ctx& c) {
    const bf16_t* Q = (const bf16_t*)(p.ws + OFF_Q); const bf16_t* KN = (const bf16_t*)(p.ws + OFF_KN); const bf16_t* KR = (const bf16_t*)(p.ws + OFF_KR);
    const bf16_t* VT = (const bf16_t*)(p.ws + OFF_VT); bf16_t* O = (bf16_t*)(p.ws + OFF_ATTA);
    const int lane = c.lane, r = lane & 31, h = lane >> 5, w = c.wave;
    const int pr = (r & 0x13) | ((r & 4) << 1) | ((r & 8) >> 1);
    const unsigned ka = (pr << 8) | ((((pr & 15) ^ h) & 15) << 4);
    const unsigned ra = ST_KR + (((pr >> 1) << 8) | (((((pr & 1) << 3) | h) ^ ((pr >> 1) & 15)) << 4));
    const unsigned va = ST_VT + (((r >> 1) << 8) | (((((r & 1) << 3) | h) ^ ((r >> 1) & 15)) << 4));
    const __amdgpu_buffer_rsrc_t rs = __builtin_amdgcn_make_buffer_rsrc((void*)p.ws, (short)0, (int)WS_END, 0x00020000);
    const AttDmaOff dof = att_dma_offsets(w, lane);
    for (int it = blockIdx.x; it < 256; it += gridDim.x) {
        const int bh = it & 31, b = bh >> 3, hd = bh & 7, pairi = it >> 5;
#pragma unroll 1
        for (int half = 0; half < 2; ++half) {
            const int qb = half ? 15 - pairi : pairi, q0 = qb * 256;
            const size_t base = (size_t)b * SEQ, qrow = base + q0 + w * 32 + r;
            bf16x8 qf[12];
#pragma unroll
            for (int st = 0; st < 12; ++st) qf[st] = *(const bf16x8*)(Q + qrow * 1536 + hd * 192 + st * 16 + h * 8);
            const int ntile = q0 / 64 + 4, myn = (q0 + w * 32) / 64 + 1;
            f32x16 o[4];
#pragma unroll
            for (int db = 0; db < 4; ++db)
#pragma unroll
                for (int i = 0; i < 16; ++i) o[db][i] = 0.f;
            float mrun = -1e30f, lrun = 0.f;
            __syncthreads();
            const unsigned k_so0 = (unsigned)(OFF_KN + (base * 1024 + hd * 128) * 2), kr_so0 = (unsigned)(OFF_KR + base * 64 * 2), vt_so0 = (unsigned)(OFF_VT + ((size_t)(hd * 128) * M + base) * 2);
            att_dma<true>(c.lds, rs, dof, k_so0, kr_so0, vt_so0, w);
            asm volatile("s_waitcnt vmcnt(0)" ::: "memory");
            __syncthreads();
            for (int j = 0; j < ntile; ++j) {
                LAS unsigned char* buf = c.lds + (j & 1) * ST_BYTES;
                if (j + 1 < ntile) att_dma<true>(c.lds + ((j + 1) & 1) * ST_BYTES, rs, dof, k_so0 + (unsigned)(j + 1) * (64 * 2048), kr_so0 + (unsigned)(j + 1) * (64 * 128), vt_so0 + (unsigned)(j + 1) * 128, w);
                if (j < myn) {
                    f32x16 s0, s1;
#pragma unroll
                    for (int i = 0; i < 16; ++i) { s0[i] = 0.f; s1[i] = 0.f; }
                    __builtin_amdgcn_s_setprio(1);
#pragma unroll
                    for (int st = 0; st < 8; ++st) {
                        s0 = MFMA32(*(const LAS bf16x8*)(buf + (ka ^ (st << 5))), qf[st], s0);
                        s1 = MFMA32(*(const LAS bf16x8*)(buf + ((ka ^ (st << 5)) + 8192)), qf[st], s1);
                    }
#pragma unroll
                    for (int st = 0; st < 4; ++st) {
                        s0 = MFMA32(*(const LAS bf16x8*)(buf + (ra ^ (st << 5))), qf[8 + st], s0);
                        s1 = MFMA32(*(const LAS bf16x8*)(buf + ((ra ^ (st << 5)) + 4096)), qf[8 + st], s1);
                    }
                    __builtin_amdgcn_s_setprio(0);
                    float mx = fmaxf(s0[0], s1[0]);
#pragma unroll
                    for (int i = 1; i < 16; ++i) mx = fmaxf(mx, fmaxf(s0[i], s1[i]));
                    mx = fmaxf(mx, __shfl_xor(mx, 32));
                    const float mnew = fmaxf(mrun, mx), alpha = ex2(mrun - mnew);
                    mrun = mnew;
                    float ps = 0.f;
#pragma unroll
                    for (int i = 0; i < 16; ++i) { s0[i] = ex2(s0[i] - mnew); s1[i] = ex2(s1[i] - mnew); ps += s0[i] + s1[i]; }
                    lrun = lrun * alpha + ps;
#pragma unroll
                    for (int db = 0; db < 4; ++db)
#pragma unroll
                        for (int i = 0; i < 16; ++i) o[db][i] *= alpha;
                    bf16x8 pf[2][2];
                    pf[0][0] = pack8(s0[0], s0[1], s0[2], s0[3], s0[4], s0[5], s0[6], s0[7]); pf[0][1] = pack8(s0[8], s0[9], s0[10], s0[11], s0[12], s0[13], s0[14], s0[15]);
                    pf[1][0] = pack8(s1[0], s1[1], s1[2], s1[3], s1[4], s1[5], s1[6], s1[7]); pf[1][1] = pack8(s1[8], s1[9], s1[10], s1[11], s1[12], s1[13], s1[14], s1[15]);
                    __builtin_amdgcn_s_setprio(1);
                    att_pv(o, pf, buf, va);
                    __builtin_amdgcn_s_setprio(0);
                }
                asm volatile("s_waitcnt vmcnt(0)" ::: "memory");
                __syncthreads();
            }
            const float ltot = lrun + __shfl_xor(lrun, 32);
            att_store(o, 1.f / ltot, O, qrow, hd, h);
        }
    }
}

DI void attn_sb_fast(const Params& p, const Ctx& c) {
    const bf16_t* Q = (const bf16_t*)(p.ws + OFF_SBQ); const bf16_t* K = (const bf16_t*)(p.ws + OFF_SBK);
    const bf16_t* VT = (const bf16_t*)(p.ws + OFF_SBVT); bf16_t* O = (bf16_t*)(p.ws + OFF_ATTB);
    const int lane = c.lane, r = lane & 31, h = lane >> 5, w = c.wave, tid = c.tid;
    const int pr = (r & 0x13) | ((r & 4) << 1) | ((r & 8) >> 1);
    const unsigned ka = (pr << 8) | ((((pr & 15) ^ h) & 15) << 4);
    const unsigned va = ST_VT + (((r >> 1) << 8) | (((((r & 1) << 3) | h) ^ ((r >> 1) & 15)) << 4));
    const __amdgpu_buffer_rsrc_t rs = __builtin_amdgcn_make_buffer_rsrc((void*)p.ws, (short)0, (int)WS_END, 0x00020000);
    const AttDmaOff dof = att_dma_offsets(w, lane);
    LAS int* flags = (LAS int*)(c.lds + ATT_FLAGS);
    for (int it = blockIdx.x; it < 256; it += gridDim.x) {
        const int bh = it & 31, b = bh >> 3, hd = bh & 7, pairi = it >> 5;
#pragma unroll 1
        for (int half = 0; half < 2; ++half) {
            const int qb = half ? 15 - pairi : pairi, q0 = qb * 256;
            const size_t base = (size_t)b * SEQ, qrow = base + q0 + w * 32 + r;
            const int tq = q0 + w * 32 + r;
            bf16x8 qf[8];
#pragma unroll
            for (int st = 0; st < 8; ++st) qf[st] = *(const bf16x8*)(Q + qrow * 1024 + hd * 128 + st * 16 + h * 8);
            const int jmax = q0 / 64 + 3, jd = (q0 + w * 32) / 64;
            f32x16 o[4];
#pragma unroll
            for (int db = 0; db < 4; ++db)
#pragma unroll
                for (int i = 0; i < 16; ++i) o[db][i] = 0.f;
            float carry = 0.f; bool wdone = false;
            __syncthreads();
            const unsigned k_so0 = (unsigned)(OFF_SBK + (base * 1024 + hd * 128) * 2), vt_so0 = (unsigned)(OFF_SBVT + ((size_t)(hd * 128) * M + base) * 2);
            att_dma<false>(c.lds, rs, dof, k_so0 + (unsigned)jmax * (64 * 2048), 0u, vt_so0 + (unsigned)jmax * 128, w);
            if (tid < 16) flags[tid] = 0;
            asm volatile("s_waitcnt vmcnt(0)" ::: "memory");
            __syncthreads();
            int itn = 0;
            for (int j = jmax; j >= 0; --j, ++itn) {
                LAS unsigned char* buf = c.lds + (itn & 1) * ST_BYTES;
                if (j > 0) att_dma<false>(c.lds + ((itn + 1) & 1) * ST_BYTES, rs, dof, k_so0 + (unsigned)(j - 1) * (64 * 2048), 0u, vt_so0 + (unsigned)(j - 1) * 128, w);
                if (j <= jd && !wdone) {
                    f32x16 s0, s1;
#pragma unroll
                    for (int i = 0; i < 16; ++i) { s0[i] = 0.f; s1[i] = 0.f; }
#pragma unroll
                    for (int st = 0; st < 8; ++st) {
                        s0 = MFMA32(*(const LAS bf16x8*)(buf + (ka ^ (st << 5))), qf[st], s0);
                        s1 = MFMA32(*(const LAS bf16x8*)(buf + ((ka ^ (st << 5)) + 8192)), qf[st], s1);
                    }
                    const int kb0 = 64 * j + 8 * h - tq;
                    bf16x8 pf[2][2];
                    {
                        f32x16 l1;
#pragma unroll
                        for (int i = 0; i < 16; ++i) { const float z = s1[i]; const float a = -(fmaxf(z, 0.f) + lg2(1.f + ex2(-fabsf(z)))); l1[i] = (kb0 + 32 + 16 * (i >> 3) + (i & 7) < 0) ? a : 0.f; }
                        float g0 = 0.f, g1 = 0.f;
#pragma unroll
                        for (int e = 0; e < 8; ++e) { g0 += l1[e]; g1 += l1[8 + e]; }
                        const float p0 = __shfl_xor(g0, 32), p1 = __shfl_xor(g1, 32);
                        float run = carry + (h == 0 ? p1 : 0.f);
#pragma unroll
                        for (int e = 7; e >= 0; --e) { run += l1[8 + e]; l1[8 + e] = run; }
                        run = carry + (g1 + p1) + (h == 0 ? p0 : 0.f);
#pragma unroll
                        for (int e = 7; e >= 0; --e) { run += l1[e]; l1[e] = run; }
                        carry += (g1 + p1) + (g0 + p0);
#pragma unroll
                        for (int i = 0; i < 16; ++i) { const float wv = ex2(s1[i] + l1[i]); s1[i] = (kb0 + 32 + 16 * (i >> 3) + (i & 7) < 0) ? wv : 0.f; }
                        pf[1][0] = pack8(s1[0], s1[1], s1[2], s1[3], s1[4], s1[5], s1[6], s1[7]); pf[1][1] = pack8(s1[8], s1[9], s1[10], s1[11], s1[12], s1[13], s1[14], s1[15]);
                    }
                    {
                        f32x16 l0;
#pragma unroll
                        for (int i = 0; i < 16; ++i) { const float z = s0[i]; const float a = -(fmaxf(z, 0.f) + lg2(1.f + ex2(-fabsf(z)))); l0[i] = (kb0 + 16 * (i >> 3) + (i & 7) < 0) ? a : 0.f; }
                        float g0 = 0.f, g1 = 0.f;
#pragma unroll
                        for (int e = 0; e < 8; ++e) { g0 += l0[e]; g1 += l0[8 + e]; }
                        const float p0 = __shfl_xor(g0, 32), p1 = __shfl_xor(g1, 32);
                        float run = carry + (h == 0 ? p1 : 0.f);
#pragma unroll
                        for (int e = 7; e >= 0; --e) { run += l0[8 + e]; l0[8 + e] = run; }
                        run = carry + (g1 + p1) + (h == 0 ? p0 : 0.f);
#pragma unroll
                        for (int e = 7; e >= 0; --e) { run += l0[e]; l0[e] = run; }
                        carry += (g1 + p1) + (g0 + p0);
#pragma unroll
                        for (int i = 0; i < 16; ++i) { const float wv = ex2(s0[i] + l0[i]); s0[i] = (kb0 + 16 * (i >> 3) + (i & 7) < 0) ? wv : 0.f; }
                        pf[0][0] = pack8(s0[0], s0[1], s0[2], s0[3], s0[4], s0[5], s0[6], s0[7]); pf[0][1] = pack8(s0[8], s0[9], s0[10], s0[11], s0[12], s0[13], s0[14], s0[15]);
                    }
                    att_pv(o, pf, buf, va);
                    wdone = __all(carry < -150.f);
                }
                if (lane == 0) flags[(itn & 1) * 8 + w] = wdone ? 1 : 0;
                asm volatile("s_waitcnt vmcnt(0)" ::: "memory");
                __syncthreads();
                int alld = 1;
#pragma unroll
                for (int q = 0; q < 8; ++q) alld &= flags[(itn & 1) * 8 + q];
                if (alld) break;
            }
            att_store(o, 1.f, O, qrow, hd, h);
        }
    }
}
#ifndef FAST_ATTN
#define FAST_ATTN 1
#endif

constexpr int SEL_LD = 260;
DI void topk_insert(float (&a)[16], float x) {
#pragma unroll
    for (int i = 15; i >= 1; --i) a[i] = __builtin_amdgcn_fmed3f(a[i - 1], a[i], x);
    a[0] = fmaxf(a[0], x);
}
struct SelMap { int mode, a0, a1, a2, a3; };
DI void sel_decode(const SelMap& mp, int q, int& t0, int& hd) {
    if (mp.mode == 0) { int u = mp.a0 + q * mp.a1; if (u >= 128 * 8) u = mp.a0; hd = u & 7; t0 = (u >> 3) * 128; }
    else { const int pm = (q >> 1) ? mp.a2 : mp.a0, pn = (q >> 1) ? mp.a3 : mp.a1; hd = pn; t0 = pm * 256 + (q & 1) * 128; }
}
template <int NU> DI void select_stage2(const Params& p, const Ctx& c, const SelMap mp, const LAS float* lst_all) {
    if (c.tid < 128 * NU) {
        const int tok = c.tid & 127, un = c.tid >> 7;
        int t0, hd; sel_decode(mp, un, t0, hd);
        const LAS float* lst = lst_all + un * 4096;
        float v1[16], v2[16];
#pragma unroll
        for (int i = 0; i < 16; ++i) { v1[i] = __uint_as_float(__float_as_uint(lst[(tok * 2) * 16 + i]) & ~127u); v2[i] = __uint_as_float(__float_as_uint(lst[(tok * 2 + 1) * 16 + i]) & ~127u); }
        float bb[16];
#pragma unroll
        for (int i = 0; i < 16; ++i) bb[i] = -__builtin_inff();
#pragma unroll
        for (int i = 0; i < 16; ++i)
#pragma unroll
            for (int j = 0; j < 16; ++j)
                if ((i + 1) * (j + 1) <= 16) topk_insert(bb, __uint_as_float((__float_as_uint(v1[i] + v2[j]) & ~255u) | (unsigned)(i * 16 + j)));
        float sv[16], mxv = -__builtin_inff(), sum = 0.f;
#pragma unroll
        for (int i = 0; i < 16; ++i) { sv[i] = __uint_as_float(__float_as_uint(bb[i]) & ~255u); mxv = fmaxf(mxv, sv[i]); }
#pragma unroll
        for (int i = 0; i < 16; ++i) { sv[i] = __expf(sv[i] - mxv); sum += sv[i]; }
        const float inv = 1.f / sum;
        int* idx = (int*)(p.ws + OFF_IDX) + (size_t)(t0 + tok) * 128 + hd * 16; float* gw = (float*)(p.ws + OFF_GW) + (size_t)(t0 + tok) * 128 + hd * 16;
#pragma unroll
        for (int i = 0; i < 16; ++i) {
            const unsigned code = __float_as_uint(bb[i]) & 255u;
            const unsigned e1 = __float_as_uint(lst[(tok * 2) * 16 + (code >> 4)]) & 127u, e2 = __float_as_uint(lst[(tok * 2 + 1) * 16 + (code & 15u)]) & 127u;
            idx[i] = (int)(e1 * 128u + e2); gw[i] = sv[i] * inv;
        }
    }
    __syncthreads();
}
DI void select_tail(const Params& p, const Ctx& c, int t0, int hd) {
    LAS float* sc = (LAS float*)c.lds; LAS float* lst = sc + 128 * SEL_LD;
    if (c.tid < 256) {
        const int tok = c.tid >> 1, hf = c.tid & 1;
        float a[16];
#pragma unroll
        for (int i = 0; i < 16; ++i) a[i] = -__builtin_inff();
        const LAS float* row = sc + tok * SEL_LD + hf * 128;
#pragma unroll 4
        for (int n4 = 0; n4 < 32; ++n4) {
            const f32x4 v = *(const LAS f32x4*)(row + n4 * 4);
#pragma unroll
            for (int e = 0; e < 4; ++e) topk_insert(a, __uint_as_float((__float_as_uint(v[e]) & ~127u) | (unsigned)(n4 * 4 + e)));
        }
#pragma unroll
        for (int i = 0; i < 16; ++i) lst[(tok * 2 + hf) * 16 + i] = a[i];
    }
    __syncthreads();
    select_stage2<1>(p, c, SelMap{0, ((t0 >> 7) << 3) | hd, 0, 0, 0}, lst);
}
DI void select_naive(const Params& p, const Ctx& c) {
    const bf16_t* PQ = (const bf16_t*)(p.ws + OFF_PQ); const bf16_t* KEYS = (const bf16_t*)(p.ws + OFF_KEYS);
    LAS float* sc = (LAS float*)c.lds;
    for (int u = blockIdx.x; u < 128 * 8; u += gridDim.x) {
        const int hd = u & 7, t0 = (u >> 3) * 128;
        const int tok = c.tid >> 2, part = c.tid & 3, hf = part >> 1, n0 = (part & 1) * 64;
        const bf16_t* qrow = PQ + (size_t)hd * M * 256 + (size_t)(t0 + tok) * 256 + hf * 128;
        const bf16_t* kb = KEYS + (size_t)((hd * 2 + hf) * 128 + n0) * 128;
        for (int n = 0; n < 64; ++n) {
            float acc = 0.f;
#pragma unroll
            for (int d8 = 0; d8 < 16; ++d8) {
                const u32x4 a = *(const u32x4*)(qrow + d8 * 8), b = *(const u32x4*)(kb + (size_t)n * 128 + d8 * 8);
#pragma unroll
                for (int e = 0; e < 4; ++e) acc += bflo(a[e]) * bflo(b[e]) + bfhi(a[e]) * bfhi(b[e]);
            }
            sc[tok * SEL_LD + hf * 128 + n0 + n] = acc;
        }
        __syncthreads();
        select_tail(p, c, t0, hd);
    }
}


DI void select_batch(const Params& p, const Ctx& c, const SelMap mp) {
    const bf16_t* PQ = (const bf16_t*)(p.ws + OFF_PQ); const bf16_t* KEYS = (const bf16_t*)(p.ws + OFF_KEYS);
    LAS float* lst_all = (LAS float*)c.lds;
    const int lane = c.lane, r = lane & 31, h = lane >> 5, w = c.wave, tb = w & 3, hf = w >> 2;
#pragma unroll
    for (int q = 0; q < 4; ++q) {
        int t0, hd; sel_decode(mp, q, t0, hd);
        LAS float* lst = lst_all + q * 4096;
        const bf16_t* qrow = PQ + (size_t)hd * M * 256 + (size_t)(t0 + tb * 32 + r) * 256 + hf * 128 + h * 8;
        const bf16_t* kbase = KEYS + (size_t)((hd * 2 + hf) * 128 + r) * 128 + h * 8;
        bf16x8 qf[8];
#pragma unroll
        for (int st = 0; st < 8; ++st) qf[st] = *(const bf16x8*)(qrow + st * 16);
        float a[16];
#pragma unroll
        for (int i = 0; i < 16; ++i) a[i] = -__builtin_inff();
#pragma unroll
        for (int kb = 0; kb < 4; ++kb) {
            f32x16 sc;
#pragma unroll
            for (int i = 0; i < 16; ++i) sc[i] = 0.f;
#pragma unroll
            for (int st = 0; st < 8; ++st) sc = MFMA32(*(const bf16x8*)(kbase + (size_t)kb * 32 * 128 + st * 16), qf[st], sc);
#pragma unroll
            for (int i = 0; i < 16; ++i) topk_insert(a, __uint_as_float((__float_as_uint(sc[i]) & ~127u) | (unsigned)(kb * 32 + (i & 3) + 8 * (i >> 2) + 4 * h)));
        }
        float bq[16];
#pragma unroll
        for (int i = 0; i < 16; ++i) bq[i] = __shfl_xor(a[i], 32);
#pragma unroll
        for (int i = 0; i < 16; ++i) topk_insert(a, bq[i]);
        if (h == 0) {
#pragma unroll
            for (int i = 0; i < 16; ++i) lst[((tb * 32 + r) * 2 + hf) * 16 + i] = a[i];
        }
    }
    __syncthreads();
    select_stage2<4>(p, c, mp, lst_all);
}
DI void select_fast(const Params& p, const Ctx& c) {
    for (int u0 = blockIdx.x; u0 < 128 * 8; u0 += 4 * gridDim.x) select_batch(p, c, SelMap{0, u0, (int)gridDim.x, 0, 0});
}
DI void select_own_tiles(const Params& p, const Ctx& c) {
    pg8::StaticOrder S; S.init(M, 2048, (int)gridDim.x, (int)blockIdx.x);
    asm volatile("s_waitcnt vmcnt(0)" ::: "memory");
    __syncthreads();
    if (c.tid == 0) { __builtin_amdgcn_fence(__ATOMIC_ACQUIRE, "agent"); asm volatile("s_waitcnt vmcnt(0)" ::: "memory"); }
    __syncthreads();
    for (int i = 0;; i += 2) {
        pg8::Unit u0, u1;
        if (!S.next(i, u0)) break;
        if (!S.next(i + 1, u1)) u1 = u0;
        select_batch(p, c, SelMap{1, u0.pm, u0.pn, u1.pm, u1.pn});
    }
}
#ifndef FAST_SEL
#define FAST_SEL 1
#endif

DI void phase_gather(const Params& p, const Ctx& c, float* dst, int rowmask = -1) {
    const bf16_t* H2 = (const bf16_t*)(p.ws + OFF_H); const unsigned char* U = p.ws + OFF_U16; const unsigned char* V = p.ws + OFF_V16;
    const int* IDX = (const int*)(p.ws + OFF_IDX); const float* GW = (const float*)(p.ws + OFF_GW); const float* mod = (const float*)(p.ws + OFF_MOD);
    constexpr int G = 8, GV = 16;
    const int lane = c.lane;
    unsigned* tokctr = (unsigned*)(p.ws + OFF_CTL) + 700;
    constexpr int NSTATIC = 6;
    LAS int* park = (LAS int*)(c.lds + c.wave * 20480);
    for (int it = 0;; ++it) {
        int m, slot; bool doU, doV;
        if (it < NSTATIC) { slot = it; m = c.gw + it * c.ngw; doU = true; doV = false; }
        else if (it < 2 * NSTATIC) { slot = it - NSTATIC; m = c.gw + slot * c.ngw; doU = false; doV = true; }
        else { unsigned t = 0; if (lane == 0) t = __hip_atomic_fetch_add(tokctr, 1u, __ATOMIC_RELAXED, __HIP_MEMORY_SCOPE_AGENT); m = NSTATIC * c.ngw + (int)__builtin_amdgcn_readfirstlane(t); if (m >= M) break; slot = 0; doU = true; doV = true; }
        if (m >= M) continue;
        const int b = m / SEQ;
        LAS int* ps = park + slot * 256;
        int ia = 0, ib = 0; float wa = 0.f, wb = 0.f;
        if (doU) {
        f32x2 hf[16];
#pragma unroll
        for (int i = 0; i < 4; ++i) { const u32x4 a = *(const u32x4*)(H2 + (size_t)m * D + lane * 32 + i * 8);
#pragma unroll
            for (int q = 0; q < 4; ++q) hf[4 * i + q] = (f32x2){bflo(a[q]), bfhi(a[q])}; }
        ia = IDX[(size_t)m * 128 + lane]; ib = IDX[(size_t)m * 128 + 64 + lane];
        const float ga = GW[(size_t)m * 128 + lane], gb = GW[(size_t)m * 128 + 64 + lane];
#pragma unroll 1
        for (int k0 = 0; k0 < 128; k0 += G) {
            u32x4 ua[G]; u32x2 ub[G];
#pragma unroll
            for (int g = 0; g < G; ++g) {
                const int e = __builtin_amdgcn_readlane(k0 < 64 ? ia : ib, (k0 + g) & 63) & rowmask;
                const unsigned char* ur = U + (size_t)e * 1536;
                ua[g] = *(const u32x4*)(ur + (unsigned)lane * 16u); ub[g] = *(const u32x2*)(ur + 1024u + (unsigned)lane * 8u);
            }
            float d[G];
#pragma unroll
            for (int g = 0; g < G; ++g) {
                const f32x32v f = __builtin_amdgcn_cvt_scalef32_pk32_f32_fp6((u32x6){ua[g][0], ua[g][1], ua[g][2], ua[g][3], ub[g][0], ub[g][1]}, 1.0f);
                f32x2 d2 = {0.f, 0.f};
#pragma unroll
                for (int i = 0; i < 16; ++i) d2 = (f32x2){f[2 * i], f[2 * i + 1]} * hf[i] + d2;
                d[g] = d2.x + d2.y;
            }
            { const bool u5 = lane & 32, u4 = lane & 16, u3 = lane & 8;
              float r4[4];
#pragma unroll
              for (int i = 0; i < 4; ++i) { const float send = u5 ? d[i] : d[4 + i], keep = u5 ? d[4 + i] : d[i]; r4[i] = keep + __shfl_xor(send, 32); }
              float r2[2];
#pragma unroll
              for (int i = 0; i < 2; ++i) { const float send = u4 ? r4[i] : r4[2 + i], keep = u4 ? r4[2 + i] : r4[i]; r2[i] = keep + __shfl_xor(send, 16); }
              const float send = u3 ? r2[0] : r2[1], keep = u3 ? r2[1] : r2[0];
              float r1 = keep + __shfl_xor(send, 8);
              r1 += __shfl_xor(r1, 4); r1 += __shfl_xor(r1, 2); r1 += __shfl_xor(r1, 1);
              const float act = gelu_tanh(r1 * (1.f / U8_SCALE)) * (1.f / V8_SCALE);
              const int gsel = lane - (k0 & 63);
              const int src = ((gsel & 4) << 3) | ((gsel & 2) << 3) | ((gsel & 1) << 3);
              const float got = __shfl(act, src & 63);
              if (gsel >= 0 && gsel < G) { if (k0 < 64) wa = got * ga; else wb = got * gb; }
            }
        }
        ps[lane] = ia; ps[64 + lane] = ib; ps[128 + lane] = __builtin_bit_cast(int, wa); ps[192 + lane] = __builtin_bit_cast(int, wb);
        }
        if (!doV) continue;
        if (!doU) { ia = ps[lane]; ib = ps[64 + lane]; wa = __builtin_bit_cast(float, ps[128 + lane]); wb = __builtin_bit_cast(float, ps[192 + lane]); }
        f32x2 acc[16];
#pragma unroll
        for (int i = 0; i < 16; ++i) acc[i] = (f32x2){0.f, 0.f};
#define VB_ISSUE(P, K0) do { _Pragma("unroll") for (int g = 0; g < 8; ++g) { \
            const int e = __builtin_amdgcn_readlane((K0) < 64 ? ia : ib, ((K0) + g) & 63) & rowmask; \
            P##w[g] = __builtin_bit_cast(float, __builtin_amdgcn_readlane(__builtin_bit_cast(int, (K0) < 64 ? wa : wb), ((K0) + g) & 63)); \
            const unsigned char* vr = V + (size_t)e * 1536; \
            P##a[g] = *(const u32x4*)(vr + (unsigned)lane * 16u); P##b[g] = *(const u32x2*)(vr + 1024u + (unsigned)lane * 8u); } } while (0)
#define VB_COMPUTE(P) do { _Pragma("unroll") for (int g = 0; g < 8; ++g) { const f32x2 w2 = {P##w[g], P##w[g]}; \
            const f32x32v f = __builtin_amdgcn_cvt_scalef32_pk32_f32_fp6((u32x6){P##a[g][0], P##a[g][1], P##a[g][2], P##a[g][3], P##b[g][0], P##b[g][1]}, 1.0f); \
            _Pragma("unroll") for (int i = 0; i < 16; ++i) acc[i] = (f32x2){f[2 * i], f[2 * i + 1]} * w2 + acc[i]; } } while (0)
        {
            u32x4 A_a[8], B_a[8]; u32x2 A_b[8], B_b[8]; float A_w[8], B_w[8];
            VB_ISSUE(A_, 0);
#pragma unroll 1
            for (int k0 = 0; k0 < 128; k0 += 16) {
                VB_ISSUE(B_, k0 + 8);
                VB_COMPUTE(A_);
                if (k0 + 16 < 128) VB_ISSUE(A_, k0 + 16);
                VB_COMPUTE(B_);
            }
        }
#undef VB_ISSUE
#undef VB_COMPUTE
        const float* orow = p.out + (size_t)m * D + lane * 32; float* drow = dst + (size_t)m * D + lane * 32; const float* gt2 = mod + b * 6 * D + 5 * D + lane * 32; const float* fg = p.fng + lane * 32;
        float ss = 0.f; f32x4 xv[8];
#pragma unroll
        for (int i = 0; i < 8; ++i) {
            const f32x4 xa = *(const f32x4*)(orow + 4 * i), ta = *(const f32x4*)(gt2 + 4 * i);
            const f32x4 pe = {acc[2 * i].x, acc[2 * i].y, acc[2 * i + 1].x, acc[2 * i + 1].y};
            const f32x4 v = xa + DBG_BETA * ta * pe; xv[i] = v; ss += (v[0] * v[0] + v[1] * v[1]) + (v[2] * v[2] + v[3] * v[3]);
        }
        const float rstd = rsqrtf(wave_sum(ss) * (1.f / D) + EPS);
#pragma unroll
        for (int i = 0; i < 8; ++i) *(f32x4*)(drow + 4 * i) = xv[i] * rstd * *(const f32x4*)(fg + 4 * i);
    }
}


DI void phase_gather_sorted(const Params& p, const Ctx& c) {
    const bf16_t* H2 = (const bf16_t*)(p.ws + OFF_H); const unsigned char* U = p.ws + OFF_U16; const unsigned char* V = p.ws + OFF_V16;
    const int* IDX = (const int*)(p.ws + OFF_IDX); const float* GW = (const float*)(p.ws + OFF_GW); const float* mod = (const float*)(p.ws + OFF_MOD);
    const int lane = c.lane;
    LAS unsigned char* wl = c.lds + c.wave * 20480;
    constexpr int RSH = 12;
    const bool u5 = lane & 32, u4 = lane & 16, u3 = lane & 8;
#pragma unroll 1
    for (int grp = 0; grp < 2; ++grp) {
#pragma unroll 1
        for (int t = 0; t < 4; ++t) {
            const int m = c.gw + (grp * 4 + t) * c.ngw;
            if (m >= M) continue;
            const int ia = IDX[(size_t)m * 128 + lane], ib = IDX[(size_t)m * 128 + 64 + lane];
            const float ga = GW[(size_t)m * 128 + lane], gb = GW[(size_t)m * 128 + 64 + lane];
            const int ra = ia >> RSH, rb = ib >> RSH;
            int off = 0, posA = 0, posB = 0;
#pragma unroll
            for (int r = 0; r < 4; ++r) {
                const unsigned long long mA = __ballot(ra == r), mB = __ballot(rb == r);
                const int cA = __builtin_popcountll(mA), cB = __builtin_popcountll(mB);
                const int rkA = __builtin_amdgcn_mbcnt_hi((unsigned)(mA >> 32), __builtin_amdgcn_mbcnt_lo((unsigned)mA, 0u));
                const int rkB = __builtin_amdgcn_mbcnt_hi((unsigned)(mB >> 32), __builtin_amdgcn_mbcnt_lo((unsigned)mB, 0u));
                posA = (ra == r) ? off + rkA : posA; posB = (rb == r) ? off + cA + rkB : posB; off += cA + cB;
            }
            LAS int* sE = (LAS int*)(wl + t * 1024); LAS float* sW = (LAS float*)(wl + t * 1024 + 512);
            sE[posA] = ia; sE[posB] = ib; sW[posA] = ga; sW[posB] = gb;
            LAS u32x4* hrow = (LAS u32x4*)(wl + 4096 + t * 4096 + lane * 64);
#pragma unroll
            for (int i = 0; i < 4; ++i) hrow[i] = *(const u32x4*)(H2 + (size_t)m * D + lane * 32 + i * 8);
        }
        asm volatile("s_waitcnt lgkmcnt(0)" ::: "memory");
#pragma unroll 1
        for (int vi = 0; vi < 16; ++vi) {
            {
                const int r = vi >> 2, t = vi & 3;
                const int m = c.gw + (grp * 4 + t) * c.ngw;
                if (m >= M) continue;
                LAS int* sE = (LAS int*)(wl + t * 1024); LAS float* sW = (LAS float*)(wl + t * 1024 + 512);
                const int eLo = sE[lane], eHi = sE[64 + lane];
                const unsigned long long mLo = __ballot((eLo >> RSH) == r), mHi = __ballot((eHi >> RSH) == r);
                if (!(mLo | mHi)) continue;
                const int s0 = mLo ? __builtin_ctzll(mLo) : 64 + __builtin_ctzll(mHi);
                const int e1 = s0 + __builtin_popcountll(mLo) + __builtin_popcountll(mHi);
                float wLo = sW[lane], wHi = sW[64 + lane];
                f32x2 hf[16];
                { const LAS u32x4* hrow = (const LAS u32x4*)(wl + 4096 + t * 4096 + lane * 64);
#pragma unroll
                  for (int i = 0; i < 4; ++i) { const u32x4 a = hrow[i];
#pragma unroll
                    for (int q = 0; q < 4; ++q) hf[4 * i + q] = (f32x2){bflo(a[q]), bfhi(a[q])}; } }
#pragma unroll 1
                for (int j0 = s0; j0 < e1; j0 += 8) {
                    u32x4 ua[8]; u32x2 ub[8];
#pragma unroll
                    for (int g = 0; g < 8; ++g) {
                        const int pos = j0 + g;
                        ua[g] = (u32x4){0u, 0u, 0u, 0u}; ub[g] = (u32x2){0u, 0u};
                        if (pos < e1) {
                            const int e = __builtin_amdgcn_readlane(pos < 64 ? eLo : eHi, pos & 63);
                            const unsigned char* ur = U + (size_t)e * 1536;
                            ua[g] = *(const u32x4*)(ur + (unsigned)lane * 16u); ub[g] = *(const u32x2*)(ur + 1024u + (unsigned)lane * 8u);
                        }
                    }
                    float d[8];
#pragma unroll
                    for (int g = 0; g < 8; ++g) {
                        d[g] = 0.f;
                        if (j0 + g < e1) {
                            const f32x32v f = __builtin_amdgcn_cvt_scalef32_pk32_f32_fp6((u32x6){ua[g][0], ua[g][1], ua[g][2], ua[g][3], ub[g][0], ub[g][1]}, 1.0f);
                            f32x2 d2 = {0.f, 0.f};
#pragma unroll
                            for (int i = 0; i < 16; ++i) d2 = (f32x2){f[2 * i], f[2 * i + 1]} * hf[i] + d2;
                            d[g] = d2.x + d2.y;
                        }
                    }
                    float r4[4];
#pragma unroll
                    for (int i = 0; i < 4; ++i) { const float send = u5 ? d[i] : d[4 + i], keep = u5 ? d[4 + i] : d[i]; r4[i] = keep + __shfl_xor(send, 32); }
                    float r2[2];
#pragma unroll
                    for (int i = 0; i < 2; ++i) { const float send = u4 ? r4[i] : r4[2 + i], keep = u4 ? r4[2 + i] : r4[i]; r2[i] = keep + __shfl_xor(send, 16); }
                    const float send = u3 ? r2[0] : r2[1], keep = u3 ? r2[1] : r2[0];
                    float r1 = keep + __shfl_xor(send, 8);
                    r1 += __shfl_xor(r1, 4); r1 += __shfl_xor(r1, 2); r1 += __shfl_xor(r1, 1);
                    const float act = gelu_tanh(r1 * (1.f / U8_SCALE)) * (1.f / V8_SCALE);
                    const bool inLo = (lane >= j0) && (lane < j0 + 8);
                    const int gsel = inLo ? lane - j0 : lane + 64 - j0;
                    const int src = ((gsel & 4) << 3) | ((gsel & 2) << 3) | ((gsel & 1) << 3);
                    const float got = __shfl(act, src & 63);
                    if (gsel >= 0 && gsel < 8 && j0 + gsel < e1) { if (inLo) wLo = got * wLo; else wHi = got * wHi; }
                }
                sW[lane] = wLo; sW[64 + lane] = wHi;
            }
        }
        asm volatile("s_waitcnt lgkmcnt(0)" ::: "memory");
#pragma unroll 1
        for (int r = 0; r < 4; ++r) {
#pragma unroll 1
            for (int t = 0; t < 4; ++t) {
                const int m = c.gw + (grp * 4 + t) * c.ngw;
                if (m >= M) continue;
                LAS int* sE = (LAS int*)(wl + t * 1024); LAS float* sW = (LAS float*)(wl + t * 1024 + 512);
                LAS u32x4* pk = (LAS u32x4*)(wl + 4096 + t * 4096 + lane * 64);
                const int eLo = sE[lane], eHi = sE[64 + lane]; const float wLo = sW[lane], wHi = sW[64 + lane];
                const unsigned long long mLo = __ballot((eLo >> RSH) == r), mHi = __ballot((eHi >> RSH) == r);
                const int s0 = mLo ? __builtin_ctzll(mLo) : (mHi ? 64 + __builtin_ctzll(mHi) : 0);
                const int e1 = s0 + __builtin_popcountll(mLo) + __builtin_popcountll(mHi);
                f32x2 acc[16];
                if (r == 0) {
#pragma unroll
                    for (int i = 0; i < 16; ++i) acc[i] = (f32x2){0.f, 0.f};
                } else {
#pragma unroll
                    for (int i = 0; i < 4; ++i) { const u32x4 a = pk[i];
#pragma unroll
                        for (int q = 0; q < 4; ++q) acc[4 * i + q] = (f32x2){bflo(a[q]), bfhi(a[q])}; }
                }
#define SV_ISSUE(P, J0) do { _Pragma("unroll") for (int g = 0; g < 8; ++g) { const int pos = (J0) + g; P##w[g] = 0.f; P##a[g] = (u32x4){0u, 0u, 0u, 0u}; P##b[g] = (u32x2){0u, 0u}; \
                        if (pos < e1) { const int e = __builtin_amdgcn_readlane(pos < 64 ? eLo : eHi, pos & 63); \
                            P##w[g] = __builtin_bit_cast(float, __builtin_amdgcn_readlane(__builtin_bit_cast(int, pos < 64 ? wLo : wHi), pos & 63)); \
                            const unsigned char* vr = V + (size_t)e * 1536; P##a[g] = *(const u32x4*)(vr + (unsigned)lane * 16u); P##b[g] = *(const u32x2*)(vr + 1024u + (unsigned)lane * 8u); } } } while (0)
#define SV_COMPUTE(P, J0) do { _Pragma("unroll") for (int g = 0; g < 8; ++g) if ((J0) + g < e1) { const f32x2 w2 = {P##w[g], P##w[g]}; \
                        const f32x32v f = __builtin_amdgcn_cvt_scalef32_pk32_f32_fp6((u32x6){P##a[g][0], P##a[g][1], P##a[g][2], P##a[g][3], P##b[g][0], P##b[g][1]}, 1.0f); \
                        _Pragma("unroll") for (int i = 0; i < 16; ++i) acc[i] = (f32x2){f[2 * i], f[2 * i + 1]} * w2 + acc[i]; } } while (0)
                if (s0 < e1) {
                    u32x4 A_a[8], B_a[8]; u32x2 A_b[8], B_b[8]; float A_w[8], B_w[8];
                    SV_ISSUE(A_, s0);
#pragma unroll 1
                    for (int j0 = s0; j0 < e1; j0 += 16) {
                        if (j0 + 8 < e1) SV_ISSUE(B_, j0 + 8);
                        SV_COMPUTE(A_, j0);
                        if (j0 + 16 < e1) SV_ISSUE(A_, j0 + 16);
                        if (j0 + 8 < e1) SV_COMPUTE(B_, j0 + 8);
                    }
                }
#undef SV_ISSUE
#undef SV_COMPUTE
                if (r < 3) {
#pragma unroll
                    for (int i = 0; i < 4; ++i) pk[i] = (u32x4){pk2(acc[4 * i].x, acc[4 * i].y), pk2(acc[4 * i + 1].x, acc[4 * i + 1].y), pk2(acc[4 * i + 2].x, acc[4 * i + 2].y), pk2(acc[4 * i + 3].x, acc[4 * i + 3].y)};
                } else {
                    const int b = m / SEQ;
                    float* orow = p.out + (size_t)m * D + lane * 32; const float* gt2 = mod + b * 6 * D + 5 * D + lane * 32; const float* fg = p.fng + lane * 32;
                    float ss = 0.f; f32x4 xv[8];
#pragma unroll
                    for (int i = 0; i < 8; ++i) {
                        const f32x4 xa = *(const f32x4*)(orow + 4 * i), ta = *(const f32x4*)(gt2 + 4 * i);
                        const f32x4 pe = {acc[2 * i].x, acc[2 * i].y, acc[2 * i + 1].x, acc[2 * i + 1].y};
                        const f32x4 v = xa + DBG_BETA * ta * pe; xv[i] = v; ss += (v[0] * v[0] + v[1] * v[1]) + (v[2] * v[2] + v[3] * v[3]);
                    }
                    const float rstd = rsqrtf(wave_sum(ss) * (1.f / D) + EPS);
#pragma unroll
                    for (int i = 0; i < 8; ++i) *(f32x4*)(orow + 4 * i) = xv[i] * rstd * *(const f32x4*)(fg + 4 * i);
                }
            }
        }
        asm volatile("s_waitcnt lgkmcnt(0)" ::: "memory");
    }
}
#ifndef GATHER_SORTED
#define GATHER_SORTED 1
#endif

struct XcdBarrier; DI void xcd_barrier(const XcdBarrier& b, int wave_s);
DI int rl2r(int a, int b, int k) { const int va = __builtin_amdgcn_readlane(a, k & 63), vb = __builtin_amdgcn_readlane(b, k & 63); return k < 64 ? va : vb; }
DI void phase_gather_rounds(const Params& p, const Ctx& c, const XcdBarrier& xbar) {
    const bf16_t* H2 = (const bf16_t*)(p.ws + OFF_H); const unsigned char* U = p.ws + OFF_U16; const unsigned char* V = p.ws + OFF_V16;
    const int* IDX = (const int*)(p.ws + OFF_IDX); const float* GW = (const float*)(p.ws + OFF_GW); const float* mod = (const float*)(p.ws + OFF_MOD);
    const int lane = c.lane;
    LAS unsigned char* wl = c.lds + c.wave * 20480;
    const bool u5 = lane & 32, u4 = lane & 16, u3 = lane & 8;
    constexpr int G = 8;
#pragma unroll 1
    for (int pass = 0; pass < 2; ++pass) {
#pragma unroll
        for (int t = 0; t < 4; ++t) {
            const int m = c.gw + (pass * 4 + t) * c.ngw;
            LAS unsigned char* ts = wl + t * 5120;
            if (m < M) {
#pragma unroll
                for (int i = 0; i < 4; ++i) *(LAS u32x4*)(ts + lane * 64 + i * 16) = *(const u32x4*)(H2 + (size_t)m * D + lane * 32 + i * 8);
                *(LAS int*)(ts + 4096 + lane * 4) = IDX[(size_t)m * 128 + lane]; *(LAS int*)(ts + 4096 + 256 + lane * 4) = IDX[(size_t)m * 128 + 64 + lane];
                *(LAS float*)(ts + 4608 + lane * 4) = GW[(size_t)m * 128 + lane]; *(LAS float*)(ts + 4608 + 256 + lane * 4) = GW[(size_t)m * 128 + 64 + lane];
            }
        }
        asm volatile("s_waitcnt vmcnt(0) lgkmcnt(0)" ::: "memory");
#pragma unroll 1
        for (int r = 0; r < 8; ++r) {
#pragma unroll 1
            for (int t = 0; t < 4; ++t) {
                if (c.gw + (pass * 4 + t) * c.ngw >= M) continue;
                LAS unsigned char* ts = wl + t * 5120;
                const int ia = *(LAS int*)(ts + 4096 + lane * 4), ib = *(LAS int*)(ts + 4096 + 256 + lane * 4);
                unsigned long long ma = __ballot((ia >> 11) == r), mb = __ballot((ib >> 11) == r);
                if (!(ma | mb)) continue;
                f32x2 hf[16];
#pragma unroll
                for (int i = 0; i < 4; ++i) { const u32x4 a = *(LAS u32x4*)(ts + lane * 64 + i * 16);
#pragma unroll
                    for (int q = 0; q < 4; ++q) hf[4 * i + q] = (f32x2){bflo(a[q]), bfhi(a[q])}; }
                float wa = 0.f, wb = 0.f; const unsigned long long ma0 = ma, mb0 = mb;
                while (ma | mb) {
                    u32x4 ua[G]; u32x2 ub[G]; int kk[G]; int n = 0;
#pragma unroll
                    for (int g = 0; g < G; ++g) {
                        int k = (g == 0) ? 0 : kk[g - 1];
                        if (ma) { k = __builtin_ctzll(ma); ma &= ma - 1; ++n; } else if (mb) { k = 64 + __builtin_ctzll(mb); mb &= mb - 1; ++n; }
                        kk[g] = k;
                        const int e = rl2r(ia, ib, k);
                        const unsigned char* ur = U + (size_t)e * 1536;
                        ua[g] = *(const u32x4*)(ur + (unsigned)lane * 16u); ub[g] = *(const u32x2*)(ur + 1024u + (unsigned)lane * 8u);
                    }
                    float d[G];
#pragma unroll
                    for (int g = 0; g < G; ++g) {
                        d[g] = 0.f;
                        if (g < n) {
                            const f32x32v f = __builtin_amdgcn_cvt_scalef32_pk32_f32_fp6((u32x6){ua[g][0], ua[g][1], ua[g][2], ua[g][3], ub[g][0], ub[g][1]}, 1.0f);
                            f32x2 d0 = {0.f, 0.f}, d1 = {0.f, 0.f};
#pragma unroll
                            for (int i = 0; i < 8; ++i) { d0 = (f32x2){f[4 * i], f[4 * i + 1]} * hf[2 * i] + d0; d1 = (f32x2){f[4 * i + 2], f[4 * i + 3]} * hf[2 * i + 1] + d1; }
                            d[g] = (d0.x + d0.y) + (d1.x + d1.y);
                        }
                    }
                    float r4[4];
#pragma unroll
                    for (int i = 0; i < 4; ++i) { const float send = u5 ? d[i] : d[4 + i], keep = u5 ? d[4 + i] : d[i]; r4[i] = keep + __shfl_xor(send, 32); }
                    float r2[2];
#pragma unroll
                    for (int i = 0; i < 2; ++i) { const float send = u4 ? r4[i] : r4[2 + i], keep = u4 ? r4[2 + i] : r4[i]; r2[i] = keep + __shfl_xor(send, 16); }
                    const float send = u3 ? r2[0] : r2[1], keep = u3 ? r2[1] : r2[0];
                    float r1 = keep + __shfl_xor(send, 8);
                    r1 += __shfl_xor(r1, 4); r1 += __shfl_xor(r1, 2); r1 += __shfl_xor(r1, 1);
                    const float act = gelu_tanh(r1 * (1.f / U8_SCALE)) * (1.f / V8_SCALE);
#pragma unroll
                    for (int g = 0; g < G; ++g) if (g < n) {
                        const float av = __builtin_bit_cast(float, __builtin_amdgcn_readlane(__builtin_bit_cast(int, act), ((g & 4) << 3) | ((g & 2) << 3) | ((g & 1) << 3)));
                        const int k = kk[g];
                        if (k < 64) { if (lane == k) wa = av; } else { if (lane == k - 64) wb = av; }
                    }
                }
                if ((ma0 >> lane) & 1ull) { LAS float* gp = (LAS float*)(ts + 4608 + lane * 4); *gp = *gp * wa; }
                if ((mb0 >> lane) & 1ull) { LAS float* gp = (LAS float*)(ts + 4608 + 256 + lane * 4); *gp = *gp * wb; }
            }
            if (DBG_ROUND_BAR) xcd_barrier(xbar, c.wave);
        }
        asm volatile("s_waitcnt lgkmcnt(0)" ::: "memory");
#pragma unroll 1
        for (int t = 0; t < 4; ++t) {
            const int m = c.gw + (pass * 4 + t) * c.ngw;
            if (m >= M) continue;
            const int b = m / SEQ;
            LAS unsigned char* ts = wl + t * 5120;
            const int ia = *(LAS int*)(ts + 4096 + lane * 4), ib = *(LAS int*)(ts + 4096 + 256 + lane * 4);
            const float wa = *(LAS float*)(ts + 4608 + lane * 4), wb = *(LAS float*)(ts + 4608 + 256 + lane * 4);
            f32x2 acc[16];
#pragma unroll
            for (int i = 0; i < 16; ++i) acc[i] = (f32x2){0.f, 0.f};
#pragma unroll 1
            for (int k0 = 0; k0 < 128; k0 += G) {
                u32x4 va[G]; u32x2 vb[G]; float wk[G];
#pragma unroll
                for (int g = 0; g < G; ++g) {
                    const int e = __builtin_amdgcn_readlane(k0 < 64 ? ia : ib, (k0 + g) & 63);
                    wk[g] = __builtin_bit_cast(float, __builtin_amdgcn_readlane(__builtin_bit_cast(int, k0 < 64 ? wa : wb), (k0 + g) & 63));
                    const unsigned char* vr = V + (size_t)e * 1536;
                    va[g] = *(const u32x4*)(vr + (unsigned)lane * 16u); vb[g] = *(const u32x2*)(vr + 1024u + (unsigned)lane * 8u);
                }
#pragma unroll
                for (int g = 0; g < G; ++g) { const f32x2 w2 = {wk[g], wk[g]};
                    const f32x32v f = __builtin_amdgcn_cvt_scalef32_pk32_f32_fp6((u32x6){va[g][0], va[g][1], va[g][2], va[g][3], vb[g][0], vb[g][1]}, 1.0f);
#pragma unroll
                    for (int i = 0; i < 16; ++i) acc[i] = (f32x2){f[2 * i], f[2 * i + 1]} * w2 + acc[i]; }
            }
            float* orow = p.out + (size_t)m * D + lane * 32; const float* gt2 = mod + b * 6 * D + 5 * D + lane * 32; const float* fg = p.fng + lane * 32;
            float ss = 0.f; f32x4 xv[8];
#pragma unroll
            for (int i = 0; i < 8; ++i) {
                const f32x4 xa = *(const f32x4*)(orow + 4 * i), ta = *(const f32x4*)(gt2 + 4 * i);
                const f32x4 pe = {acc[2 * i].x, acc[2 * i].y, acc[2 * i + 1].x, acc[2 * i + 1].y};
                const f32x4 v = xa + DBG_BETA * ta * pe; xv[i] = v; ss += (v[0] * v[0] + v[1] * v[1]) + (v[2] * v[2] + v[3] * v[3]);
            }
            const float rstd = rsqrtf(wave_sum(ss) * (1.f / D) + EPS);
#pragma unroll
            for (int i = 0; i < 8; ++i) *(f32x4*)(orow + 4 * i) = xv[i] * rstd * *(const f32x4*)(fg + 4 * i);
        }
    }
}
#ifndef GATHER_ROUNDS
#define GATHER_ROUNDS 0
#endif

constexpr size_t OFF_WK = OFF_GB + (size_t)32 * 1024 * 1024;
constexpr size_t OFF_SSQ = OFF_GB + (size_t)48 * 1024 * 1024;
constexpr int NPU = 2, NPV = 2;
struct PairPick { int k; bool valid; };
DI PairPick pick_next(unsigned long long& ma, unsigned long long& mb, int prev) {
    PairPick r;
    if (ma) { r.k = __builtin_ctzll(ma); ma &= ma - 1; r.valid = true; }
    else if (mb) { r.k = 64 + __builtin_ctzll(mb); mb &= mb - 1; r.valid = true; }
    else { r.k = prev; r.valid = false; }
    return r;
}
DI int rl2(int a, int b, int k) { const int va = __builtin_amdgcn_readlane(a, k & 63), vb = __builtin_amdgcn_readlane(b, k & 63); return k < 64 ? va : vb; }
DI float rl2f(float a, float b, int k) { return __builtin_bit_cast(float, rl2(__builtin_bit_cast(int, a), __builtin_bit_cast(int, b), k)); }

DI void gather_u(const Params& p, const Ctx& c) {
    const bf16_t* H2 = (const bf16_t*)(p.ws + OFF_H); const unsigned char* U = p.ws + OFF_U16;
    const int* IDX = (const int*)(p.ws + OFF_IDX); const float* GW = (const float*)(p.ws + OFF_GW); float* WK = (float*)(p.ws + OFF_WK);
    const int x = blockIdx.x & 7, jb = blockIdx.x >> 3, nj = ((int)gridDim.x - x + 7) >> 3;
    const int wl = jb * NWAVES + c.wave, nwl = nj * NWAVES;
    constexpr int G = 4, SH = (NPU == 2) ? 10 : 11;
#pragma unroll 1
    for (int ps = 0; ps < NPU; ++ps) {
        const int part = x * NPU + ps;
#pragma unroll 1
        for (int m = wl; m < M; m += nwl) {
            const int ia = IDX[(size_t)m * 128 + c.lane], ib = IDX[(size_t)m * 128 + 64 + c.lane];
            unsigned long long ma = __ballot((ia >> SH) == part), mb = __ballot((ib >> SH) == part);
            if (!(ma | mb)) continue;
            const unsigned long long ma0 = ma, mb0 = mb;
            float hf[2][16];
#pragma unroll
            for (int j = 0; j < 2; ++j) { const u32x4 a = *(const u32x4*)(H2 + (size_t)m * D + j * 1024 + c.lane * 16), bq = *(const u32x4*)(H2 + (size_t)m * D + j * 1024 + c.lane * 16 + 8);
#pragma unroll
                for (int q = 0; q < 4; ++q) { hf[j][2 * q] = bflo(a[q]); hf[j][2 * q + 1] = bfhi(a[q]); hf[j][8 + 2 * q] = bflo(bq[q]); hf[j][8 + 2 * q + 1] = bfhi(bq[q]); } }
            const float ga = GW[(size_t)m * 128 + c.lane], gb = GW[(size_t)m * 128 + 64 + c.lane];
            float wa = 0.f, wb = 0.f;
            int prev = 0;
            while (ma | mb) {
                PairPick pk[G]; u32x4 uu[G][2];
#pragma unroll
                for (int g = 0; g < G; ++g) { pk[g] = pick_next(ma, mb, prev); prev = pk[g].k;
                    const int e = rl2(ia, ib, pk[g].k);
                    const unsigned char* ur = U + (size_t)e * D;
#pragma unroll
                    for (int j = 0; j < 2; ++j) uu[g][j] = *(const u32x4*)(ur + ((unsigned)c.lane * 16u + j * 1024u)); }
                float d[G];
#pragma unroll
                for (int g = 0; g < G; ++g) {
                    float d0 = 0.f, d1 = 0.f;
#pragma unroll
                    for (int j = 0; j < 2; ++j)
#pragma unroll
                        for (int q = 0; q < 4; ++q) { const f32x2 lo = __builtin_amdgcn_cvt_pk_f32_fp8((int)uu[g][j][q], false), hi = __builtin_amdgcn_cvt_pk_f32_fp8((int)uu[g][j][q], true);
                            d0 += lo.x * hf[j][4 * q] + hi.x * hf[j][4 * q + 2]; d1 += lo.y * hf[j][4 * q + 1] + hi.y * hf[j][4 * q + 3]; }
                    d[g] = d0 + d1;
                }
#pragma unroll
                for (int o = 1; o < 64; o <<= 1)
#pragma unroll
                    for (int g = 0; g < G; ++g) d[g] += __shfl_xor(d[g], o);
#pragma unroll
                for (int g = 0; g < G; ++g) if (pk[g].valid) {
                    const float a = gelu_tanh(d[g] * (1.f / U8_SCALE)) * (1.f / V8_SCALE); const int k = pk[g].k;
                    if (k < 64) { if (c.lane == k) wa = a * ga; } else { if (c.lane == k - 64) wb = a * gb; }
                }
            }
            if ((ma0 >> c.lane) & 1ull) WK[(size_t)m * 128 + c.lane] = wa;
            if ((mb0 >> c.lane) & 1ull) WK[(size_t)m * 128 + 64 + c.lane] = wb;
        }
    }
}

DI void gather_v(const Params& p, const Ctx& c) {
    const unsigned char* V = p.ws + OFF_V16;
    const int* IDX = (const int*)(p.ws + OFF_IDX); const float* WK = (const float*)(p.ws + OFF_WK); const float* mod = (const float*)(p.ws + OFF_MOD);
    float* SSQ = (float*)(p.ws + OFF_SSQ);
    const int x = blockIdx.x & 7, jb = blockIdx.x >> 3, nj = ((int)gridDim.x - x + 7) >> 3;
    const int wl = jb * NWAVES + c.wave, nwl = nj * NWAVES;
    const int q4 = c.lane >> 4, l16 = c.lane & 15;
    const unsigned voff = 256u * x + l16 * 16u;
    constexpr int SHV = (NPV == 2) ? 13 : 14;
#pragma unroll 1
    for (int ps = 0; ps < NPV; ++ps) {
#pragma unroll 1
        for (int m = wl; m < M; m += nwl) {
            const int b = m / SEQ;
            const int ia = IDX[(size_t)m * 128 + c.lane], ib = IDX[(size_t)m * 128 + 64 + c.lane];
            const float wa = WK[(size_t)m * 128 + c.lane], wb = WK[(size_t)m * 128 + 64 + c.lane];
            unsigned long long ma = __ballot((ia >> SHV) == ps), mb = __ballot((ib >> SHV) == ps);
            float acc[16];
#pragma unroll
            for (int i = 0; i < 16; ++i) acc[i] = 0.f;
            int prev = 0;
            while (ma | mb) {
                u32x4 vv[4]; float wv[4];
#pragma unroll
                for (int s4 = 0; s4 < 4; ++s4) {
                    int e = 0; float w = 0.f;
#pragma unroll
                    for (int g = 0; g < 4; ++g) { const PairPick pk = pick_next(ma, mb, prev); prev = pk.k;
                        const int eg = rl2(ia, ib, pk.k); const float wg = pk.valid ? rl2f(wa, wb, pk.k) : 0.f;
                        e = (q4 == g) ? eg : e; w = (q4 == g) ? wg : w; }
                    vv[s4] = *(const u32x4*)(V + (size_t)e * D + voff); wv[s4] = w;
                }
#pragma unroll
                for (int s4 = 0; s4 < 4; ++s4)
#pragma unroll
                    for (int q = 0; q < 4; ++q) { const f32x2 lo = __builtin_amdgcn_cvt_pk_f32_fp8((int)vv[s4][q], false), hi = __builtin_amdgcn_cvt_pk_f32_fp8((int)vv[s4][q], true);
                        acc[4 * q] += wv[s4] * lo.x; acc[4 * q + 1] += wv[s4] * lo.y; acc[4 * q + 2] += wv[s4] * hi.x; acc[4 * q + 3] += wv[s4] * hi.y; }
            }
#pragma unroll
            for (int i = 0; i < 16; ++i) { acc[i] += __shfl_xor(acc[i], 16); acc[i] += __shfl_xor(acc[i], 32); }
            f32x4 sel;
#pragma unroll
            for (int e = 0; e < 4; ++e) sel[e] = q4 == 0 ? acc[e] : (q4 == 1 ? acc[4 + e] : (q4 == 2 ? acc[8 + e] : acc[12 + e]));
            const int col = 256 * x + 16 * l16 + 4 * q4;
            float* op = p.out + (size_t)m * D + col;
            const f32x4 val = *(const f32x4*)op + DBG_BETA * *(const f32x4*)(mod + b * 6 * D + 5 * D + col) * sel;
            *(f32x4*)op = val;
            if (ps == NPV - 1) { const float ss = wave_sum(val[0] * val[0] + val[1] * val[1] + val[2] * val[2] + val[3] * val[3]); if (c.lane == 0) SSQ[(size_t)m * 8 + x] = ss; }
        }
    }
}
DI void gather_final(const Params& p, const Ctx& c) {
    const float* SSQ = (const float*)(p.ws + OFF_SSQ);
    for (int m = c.gw; m < M; m += c.ngw) {
        float s = (c.lane < 8) ? SSQ[(size_t)m * 8 + c.lane] : 0.f;
        s += __shfl_xor(s, 1); s += __shfl_xor(s, 2); s += __shfl_xor(s, 4);
        const float rstd = rsqrtf(__shfl(s, 0) * (1.f / D) + EPS);
        float* orow = p.out + (size_t)m * D;
#pragma unroll
        for (int j = 0; j < 8; ++j) { const int col = (j * 64 + c.lane) * 4; *(f32x4*)(orow + col) = *(const f32x4*)(orow + col) * rstd * *(const f32x4*)(p.fng + col); }
    }
}
#ifndef GATHER_L2
#define GATHER_L2 0
#endif

DI void phase_gather_v2(const Params& p, const Ctx& c) {
    const bf16_t* H2 = (const bf16_t*)(p.ws + OFF_H);
    const int* IDX = (const int*)(p.ws + OFF_IDX); const float* GW = (const float*)(p.ws + OFF_GW); const float* mod = (const float*)(p.ws + OFF_MOD);
    LAS float* hs = (LAS float*)c.lds; LAS float* wk = hs + 2048; LAS int* ek = (LAS int*)(wk + 128); LAS float* red = (LAS float*)(ek + 128);
    for (int m = blockIdx.x; m < M; m += gridDim.x) {
        const int b = m / SEQ;
        __syncthreads();
        for (int i = c.tid; i < 2048; i += NTHREADS) hs[i] = bf2f(H2[(size_t)m * D + i]);
        if (c.tid < 128) ek[c.tid] = IDX[(size_t)m * 128 + c.tid];
        __syncthreads();
        for (int k = c.wave; k < 128; k += NWAVES) {
            const float* ur = p.pu + (size_t)ek[k] * D;
            float d = 0.f;
            for (int i = 0; i < 8; ++i) { const int col = i * 256 + c.lane * 4; const f32x4 u = *(const f32x4*)(ur + col);
                d += u[0] * hs[col] + u[1] * hs[col + 1] + u[2] * hs[col + 2] + u[3] * hs[col + 3]; }
            d = wave_sum(d);
            if (c.lane == 0) wk[k] = gelu_tanh(d) * GW[(size_t)m * 128 + k];
        }
        __syncthreads();
        const int col = c.tid * 4;
        f32x4 acc = {0.f, 0.f, 0.f, 0.f};
        for (int k = 0; k < 128; ++k) { const f32x4 v = *(const f32x4*)(p.pv + (size_t)ek[k] * D + col); acc += v * wk[k]; }
        float* orow = p.out + (size_t)m * D;
        const f32x4 x2 = *(const f32x4*)(orow + col) + DBG_BETA * *(const f32x4*)(mod + b * 6 * D + 5 * D + col) * acc;
        float ss = wave_sum(x2[0] * x2[0] + x2[1] * x2[1] + x2[2] * x2[2] + x2[3] * x2[3]);
        if (c.lane == 0) red[c.wave] = ss;
        __syncthreads();
        float tot = 0.f;
        for (int w = 0; w < NWAVES; ++w) tot += red[w];
        const float rstd = rsqrtf(tot * (1.f / D) + EPS);
        *(f32x4*)(orow + col) = x2 * rstd * *(const f32x4*)(p.fng + col);
    }
}


#define XB_TMO      128
#define XB_XCNT(j)  (256  + 64 * (j))
#define XB_XSUB(j)  (1280 + 64 * (j))
#define XB_XGEN(j)  (2304 + 64 * (j))
#define XB_TOP      3328
#define XB_TOPGEN   3392
#define XCD_BAR_WORDS 3456
#define XB_SPIN_CAP (1u << 18)

__device__ __forceinline__ unsigned xb_ld(unsigned* p)              { return __hip_atomic_load(p, __ATOMIC_RELAXED, __HIP_MEMORY_SCOPE_AGENT); }
__device__ __forceinline__ unsigned xb_add(unsigned* p, unsigned v) { return __hip_atomic_fetch_add(p, v, __ATOMIC_RELAXED, __HIP_MEMORY_SCOPE_AGENT); }
__device__ __forceinline__ unsigned xb_xcc_id() { return (unsigned)__builtin_amdgcn_s_getreg((3 << 11) | 20) & 0xFu; }
#define XB_SPIN(cond, bar) do { unsigned _sp = 0; while (cond) { __builtin_amdgcn_s_sleep(1); \
    if ((++_sp & 255u) == 0u) { if (xb_ld(&(bar)[XB_TMO])) break; if (_sp > XB_SPIN_CAP) { atomicAdd(&(bar)[XB_TMO], 1u); break; } } } } while (0)

struct XcdBarrier {
    unsigned* bar; unsigned x;
    volatile LAS unsigned* st;
};

__device__ __forceinline__ XcdBarrier xcd_barrier_post(unsigned* bar, volatile LAS unsigned* st) {
    XcdBarrier b; b.bar = bar; b.x = xb_xcc_id(); b.st = st;
    if (threadIdx.x == 0) (void)xb_add(&bar[XB_XCNT(b.x)], 1u);
    return b;
}
__device__ __forceinline__ void xcd_barrier_complete(unsigned* bar, unsigned x, unsigned& nloc, unsigned& nx) {
    const unsigned G = gridDim.x * gridDim.y * gridDim.z;
    unsigned sum, cnt, mine, sp = 0u;
    for (;;) {
        sum = 0u; cnt = 0u; mine = 0u;
#pragma unroll
        for (unsigned j = 0; j < 16; ++j) { const unsigned c = xb_ld(&bar[XB_XCNT(j)]); sum += c; cnt += (c > 0u) ? 1u : 0u; mine = (j == x) ? c : mine; }
        if (sum == G) break;
        __builtin_amdgcn_s_sleep(1);
        if ((++sp & 255u) == 0u) { if (xb_ld(&bar[XB_TMO])) break; if (sp > XB_SPIN_CAP) { atomicAdd(&bar[XB_TMO], 1u); break; } }
    }
    nloc = mine > 0u ? mine : 1u; nx = cnt > 0u ? cnt : 1u;
}

__device__ __forceinline__ bool xb_lead(int wave_s) { return wave_s == 0 && __builtin_amdgcn_mbcnt_hi(~0u, __builtin_amdgcn_mbcnt_lo(~0u, 0u)) == 0; }
__device__ __forceinline__ void xcd_barrier(const XcdBarrier& b, int wave_s) {
    asm volatile("s_waitcnt vmcnt(0)" ::: "memory");
    __syncthreads();
    if (xb_lead(wave_s)) {
        unsigned* bar = b.bar;
        __builtin_amdgcn_s_waitcnt(0);
        unsigned nloc = b.st[0], nx = b.st[1];
        if (nloc == 0u) { xcd_barrier_complete(bar, b.x, nloc, nx); b.st[0] = nloc; b.st[1] = nx; }
        const unsigned old = xb_add(&bar[XB_XSUB(b.x)], 1u);
        const unsigned gen = old / nloc;
        if (old + 1u == (gen + 1u) * nloc) {
            __builtin_amdgcn_fence(__ATOMIC_RELEASE, "agent");
            asm volatile("s_waitcnt vmcnt(0)" ::: "memory");
            const unsigned og = xb_add(&bar[XB_TOP], 1u);
            const unsigned tg = og / nx;
            if (og + 1u == (tg + 1u) * nx) xb_add(&bar[XB_TOPGEN], 1u);
            else XB_SPIN(xb_ld(&bar[XB_TOPGEN]) == tg, bar);
            __builtin_amdgcn_fence(__ATOMIC_ACQUIRE, "agent");
            xb_add(&bar[XB_XGEN(b.x)], 1u);
            asm volatile("s_waitcnt vmcnt(0)" ::: "memory");
        } else {
            XB_SPIN(xb_ld(&bar[XB_XGEN(b.x)]) == gen, bar);
            __builtin_amdgcn_fence(__ATOMIC_ACQUIRE, "agent");
            asm volatile("s_waitcnt vmcnt(0)" ::: "memory");
        }
    }
    __syncthreads();
}


DI void grid_barrier(unsigned* ctr, unsigned target, int wave_s) {
    asm volatile("s_waitcnt vmcnt(0)" ::: "memory");
    __syncthreads();
    if (wave_s == 0) {
        const int l = __builtin_amdgcn_mbcnt_hi(~0u, __builtin_amdgcn_mbcnt_lo(~0u, 0u));
        if (l == 0) {
            __builtin_amdgcn_fence(__ATOMIC_RELEASE, "agent");
            asm volatile("s_waitcnt vmcnt(0)" ::: "memory");
            __hip_atomic_fetch_add(ctr, 1u, __ATOMIC_RELAXED, __HIP_MEMORY_SCOPE_AGENT);
            unsigned spins = 0;
            while (__hip_atomic_load(ctr, __ATOMIC_RELAXED, __HIP_MEMORY_SCOPE_AGENT) < target) { __builtin_amdgcn_s_sleep(2); if (++spins > (1u << 23)) break; }
            __builtin_amdgcn_fence(__ATOMIC_ACQUIRE, "agent");
            asm volatile("s_waitcnt vmcnt(0)" ::: "memory");
        }
    }
    __syncthreads();
}

__global__ void __launch_bounds__(NTHREADS, 2) mega(Params p) {
    extern __shared__ __attribute__((aligned(16))) unsigned char lds_raw[];
    const int wave_s = __builtin_amdgcn_readfirstlane(threadIdx.x >> 6);
#define MKCTX() Ctx c; { int l_; asm volatile("v_mbcnt_lo_u32_b32 %0, -1, 0\n\tv_mbcnt_hi_u32_b32 %0, -1, %0" : "=v"(l_)); c.lds = (LAS unsigned char*)lds_raw; c.lane = l_; c.wave = wave_s; c.tid = wave_s * 64 + l_; \
    c.gw = blockIdx.x * NWAVES + wave_s; c.ngw = gridDim.x * NWAVES; }
    unsigned char* ws = p.ws;
    const float* mod = (const float*)(ws + OFF_MOD);
    const int lo = p.ph_lo, hi = p.ph_hi;
    XcdBarrier xbar; xbar.bar = (unsigned*)(ws + OFF_XBAR); xbar.x = 0; xbar.st = nullptr;
    if (USE_XBAR && lo == 0 && hi == NPHASE) {
        volatile LAS unsigned* stw = (volatile LAS unsigned*)(lds_raw + LDS_BYTES - 32);
        if (threadIdx.x < 2) stw[threadIdx.x] = 0u;
        __syncthreads();
        xbar = xcd_barrier_post((unsigned*)(ws + OFF_XBAR), stw);
    }
#define IN(k) (lo <= (k) && (k) < hi)
#define SEAM(k) do { if (IN(k) && IN((k) + 1)) { if (USE_XBAR) xcd_barrier(xbar, wave_s); else grid_barrier((unsigned*)(ws + OFF_CTL), (unsigned)((k) + 1) * gridDim.x, wave_s); \
    if (TIME_PHASE >= 0 && blockIdx.x == 0 && threadIdx.x == 0) ((unsigned long long*)(ws + OFF_CTL + 512))[(k) + 1] = __builtin_amdgcn_s_memrealtime(); } } while (0)

    if (TIME_PHASE >= 0 && blockIdx.x == 0 && threadIdx.x == 0) ((unsigned long long*)(ws + OFF_CTL + 512))[0] = __builtin_amdgcn_s_memrealtime();
    if (IN(0)) { MKCTX(); phase_prologue(p, c, true, PRO_SPLIT == 0); }
    SEAM(0);
    if (IN(1)) for (int rep_ = 0; rep_ < (DUP_PHASE == 1 ? 2 : 1); ++rep_) { MKCTX();
        const long long* modi = (const long long*)(ws + OFF_MODI); float* modw = (float*)(ws + OFF_MOD);
        for (int i = blockIdx.x * NTHREADS + c.tid; i < NB * 6 * D; i += gridDim.x * NTHREADS) modw[i] = (float)((double)modi[i] * (1.0 / 4294967296.0));
        modulate_rows<P2_FP8 != 0>(p.x, p.n1g, modi + 1 * D, modi + 0 * D, (bf16_t*)(ws + OFF_H), c);
        if (PRO_SPLIT) phase_prologue(p, c, false, true);
    }
    SEAM(1);
    if (IN(2)) for (int rep_ = 0; rep_ < (DUP_PHASE == 2 ? 2 : 1); ++rep_) { MKCTX();
        EpiProj e1{(bf16_t*)(ws + OFF_CQ), (bf16_t*)(ws + OFF_CKV), (bf16_t*)(ws + OFF_KR), (bf16_t*)(ws + OFF_SBQ), (bf16_t*)(ws + OFF_SBK), (bf16_t*)(ws + OFF_GA), (bf16_t*)(ws + OFF_GB), (const f32x2*)(ws + OFF_CS), P2_FP8 ? 1.f / W8_SCALE : 1.f};
#if P2_FP8
        GEMM8(c, ws + OFF_H, ws + OFF_WIN, M, 7168, 2048, e1);
#else
        GEMM(c, (const bf16_t*)(ws + OFF_H), (const bf16_t*)(ws + OFF_WIN), M, 7168, 2048, e1);
#endif
        if (DUP_GEMM == 20) GEMM(c, (const bf16_t*)(ws + OFF_H), (const bf16_t*)(ws + OFF_WIN), M, 7168, 2048, e1);
        EpiT e2{(bf16_t*)(ws + OFF_SBVT), nullptr, P2_FP8 ? 1.f / W8_SCALE : 1.f};
#if P2_FP8
        GEMM8(c, ws + OFF_WSBV, ws + OFF_H, 1024, M, 2048, e2);
#else
        GEMM(c, (const bf16_t*)(ws + OFF_WSBV), (const bf16_t*)(ws + OFF_H), 1024, M, 2048, e2);
#endif
        if (DUP_GEMM == 21) GEMM(c, (const bf16_t*)(ws + OFF_WSBV), (const bf16_t*)(ws + OFF_H), 1024, M, 2048, e2);
    }
    SEAM(2);
    if (IN(3)) for (int rep_ = 0; rep_ < (DUP_PHASE == 3 ? 2 : 1); ++rep_) { MKCTX(); phase_rowstats(p, c); }
    SEAM(3);
    if (DBG_XTRA_BAR) { for (int q_ = 0; q_ < DBG_XTRA_BAR; ++q_) { if (IN(3) && IN(4)) xcd_barrier(xbar, wave_s); } }
    if (IN(4)) for (int rep_ = 0; rep_ < (DUP_PHASE == 4 ? 2 : 1); ++rep_) { MKCTX();
        EpiUq e1{(bf16_t*)(ws + OFF_Q), (const float*)(ws + OFF_RSTQ), (const f32x2*)(ws + OFF_CS)};
        GEMM(c, (const bf16_t*)(ws + OFF_CQ), (const bf16_t*)(ws + OFF_WUQ), M, 1536, 512, e1);
        if (DUP_GEMM == 40) GEMM(c, (const bf16_t*)(ws + OFF_CQ), (const bf16_t*)(ws + OFF_WUQ), M, 1536, 512, e1);
        EpiRowScale e2{(bf16_t*)(ws + OFF_KN), 1024, (const float*)(ws + OFF_RSTKV)};
        GEMM(c, (const bf16_t*)(ws + OFF_CKV), (const bf16_t*)(ws + OFF_WUK), M, 1024, 256, e2);
        if (DUP_GEMM == 41) GEMM(c, (const bf16_t*)(ws + OFF_CKV), (const bf16_t*)(ws + OFF_WUK), M, 1024, 256, e2);
        EpiT e3{(bf16_t*)(ws + OFF_VT), (const float*)(ws + OFF_RSTKV), 1.f};
        GEMM(c, (const bf16_t*)(ws + OFF_WUV), (const bf16_t*)(ws + OFF_CKV), 1024, M, 256, e3);
        if (DUP_GEMM == 42) GEMM(c, (const bf16_t*)(ws + OFF_WUV), (const bf16_t*)(ws + OFF_CKV), 1024, M, 256, e3);
    }
    SEAM(4);
    if (IN(5)) for (int rep_ = 0; rep_ < (DUP_PHASE == 5 ? 2 : 1); ++rep_) {
#if FAST_ATTN
        { MKCTX(); attn_mla_fast(p, c); }
        if (DUP_GEMM == 51) { MKCTX(); attn_mla_fast(p, c); }
        { MKCTX(); attn_sb_fast(p, c); }
        if (DUP_GEMM == 52) { MKCTX(); attn_sb_fast(p, c); }
#else
        MKCTX();
        attn_mla_naive(p, c); attn_sb_naive(p, c);
#endif
    }
    SEAM(5);
    if (IN(6)) for (int rep_ = 0; rep_ < (DUP_PHASE == 6 ? 2 : 1); ++rep_) { MKCTX();
        EpiGate1 e1{(bf16_t*)(ws + OFF_MERGED), (const bf16_t*)(ws + OFF_GA)};
        GEMM(c, (const bf16_t*)(ws + OFF_ATTA), (const bf16_t*)(ws + OFF_WA), M, 2048, 1024, e1);
        if (DUP_GEMM == 60) GEMM(c, (const bf16_t*)(ws + OFF_ATTA), (const bf16_t*)(ws + OFF_WA), M, 2048, 1024, e1);
        EpiGate2 e2{(bf16_t*)(ws + OFF_MERGED), (const bf16_t*)(ws + OFF_GB)};
        GEMM(c, (const bf16_t*)(ws + OFF_ATTB), (const bf16_t*)(ws + OFF_WB), M, 2048, 1024, e2);
    }
    SEAM(6);
    if (IN(7)) for (int rep_ = 0; rep_ < (DUP_PHASE == 7 ? 2 : 1); ++rep_) { MKCTX();
        EpiRes e{p.x, mod + 2 * D, p.out};
        GEMM(c, (const bf16_t*)(ws + OFF_MERGED), (const bf16_t*)(ws + OFF_WOUT), M, 2048, 2048, e);
    }
    SEAM(7);
    if (IN(8)) for (int rep_ = 0; rep_ < (DUP_PHASE == 8 ? 2 : 1); ++rep_) { MKCTX();
        modulate_rows(p.out, p.n2g, mod + 4 * D, mod + 3 * D, (bf16_t*)(ws + OFF_H), c);
        convert_table(p.pu, ws + OFF_U16, U8_SCALE, c);
        convert_table(p.pv, ws + OFF_V16, V8_SCALE, c);
    }
    SEAM(8);
    if (IN(9)) for (int rep_ = 0; rep_ < (DUP_PHASE == 9 ? 2 : 1); ++rep_) { MKCTX();
        EpiPq e{(bf16_t*)(ws + OFF_PQ)};
        GEMM(c, (const bf16_t*)(ws + OFF_H), (const bf16_t*)(ws + OFF_WPQ), M, 2048, 2048, e);
#if FAST_SEL && FAST_GEMM && SEL_FUSED
        { MKCTX(); select_own_tiles(p, c); }
#endif
    }
#if !(FAST_SEL && FAST_GEMM && SEL_FUSED)
    SEAM(9);
    if (IN(10)) for (int rep_ = 0; rep_ < (DUP_PHASE == 10 ? 2 : 1); ++rep_) { MKCTX();
#if FAST_SEL
        select_fast(p, c);
#else
        select_naive(p, c);
#endif
    }
#else
    if (IN(9) && IN(10)) {   }
#endif
    SEAM(10);
#if GATHER_L2
    if (IN(11)) { MKCTX(); gather_u(p, c); }
    SEAM(11);
    if (IN(12)) { MKCTX(); gather_v(p, c); }
    SEAM(12);
    if (IN(13)) { MKCTX(); gather_final(p, c); }
#else
#if GATHER_SORTED
    if (IN(11)) { MKCTX(); phase_gather_sorted(p, c); }
#elif GATHER_ROUNDS
    if (IN(11)) { MKCTX(); phase_gather_rounds(p, c, xbar); }
#else
    if (IN(11)) { if (DUP_GEMM == 110) { MKCTX(); phase_gather(p, c, (float*)(ws + OFF_SBQ)); }
        if (DUP_GEMM == 111) { MKCTX(); phase_gather(p, c, (float*)(ws + OFF_SBQ), 0x3ff); } MKCTX(); phase_gather(p, c, p.out); }
#endif
#endif
#undef IN
#undef SEAM
}

extern "C" void kernel_launch(void* const* d_in, const int* in_sizes, int n_in, void* d_out, int out_size, void* d_ws, size_t ws_size, hipStream_t stream) {
    static int grid = 0;
    if (grid == 0) {
        if (n_in != 20 || out_size != M * D || ws_size < WS_END) { fprintf(stderr, "kernel_launch: unexpected shapes (n_in %d out %d ws %zu need %zu)\n", n_in, out_size, ws_size, (size_t)WS_END); grid = -1; return; }
        int dev = 0, cus = 0, per_cu = 0;
        (void)hipGetDevice(&dev); (void)hipDeviceGetAttribute(&cus, hipDeviceAttributeMultiprocessorCount, dev);
        if (hipFuncSetAttribute((const void*)mega, hipFuncAttributeMaxDynamicSharedMemorySize, LDS_BYTES) != hipSuccess) { fprintf(stderr, "kernel_launch: hipFuncSetAttribute failed\n"); grid = -1; return; }
        if (hipOccupancyMaxActiveBlocksPerMultiprocessor(&per_cu, (const void*)mega, NTHREADS, LDS_BYTES) != hipSuccess || per_cu < 1) { fprintf(stderr, "kernel_launch: occupancy query failed (%d)\n", per_cu); per_cu = 1; }
        (void)hipGetLastError();
        grid = cus;
    }
    if (grid < 0) return;
    (void)hipMemsetAsync((char*)d_ws + OFF_CTL, 0, ZERO_BYTES, stream);
    Params p{};
    p.x = (const float*)d_in[0]; p.c = (const float*)d_in[1]; p.pos = (const int*)d_in[2]; p.ada_w = (const float*)d_in[3]; p.ada_b = (const float*)d_in[4];
    p.n1g = (const float*)d_in[5]; p.n2g = (const float*)d_in[6]; p.w_in = (const float*)d_in[7]; p.qng = (const float*)d_in[8]; p.kvng = (const float*)d_in[9];
    p.w_uq = (const float*)d_in[10]; p.w_ukv = (const float*)d_in[11]; p.w_bm = (const float*)d_in[12]; p.w_bs = (const float*)d_in[13]; p.w_out = (const float*)d_in[14];
    p.w_pq = (const float*)d_in[15]; p.skeys = (const float*)d_in[16]; p.pu = (const float*)d_in[17]; p.pv = (const float*)d_in[18]; p.fng = (const float*)d_in[19];
    p.out = (float*)d_out; p.ws = (unsigned char*)d_ws;
    for (int i = 0; i < 32; ++i) p.invf[i] = (float)pow(10000.0, -(double)i / 32.0);
#if N_LAUNCH_MODE == 1
    p.ph_lo = 0; p.ph_hi = NPHASE;
    void* args[] = {&p};
    hipError_t e = hipLaunchCooperativeKernel((const void*)mega, dim3(grid), dim3(NTHREADS), args, LDS_BYTES, stream);
    if (e != hipSuccess) fprintf(stderr, "cooperative launch failed: %s (grid %d)\n", hipGetErrorString(e), grid);
#else
    for (int k = 0; k < NPHASE; ++k) {
        p.ph_lo = k; p.ph_hi = k + 1;
        hipLaunchKernelGGL(mega, dim3(grid), dim3(NTHREADS), LDS_BYTES, stream, p);
    }
#endif
}
```

```cpp
#include <hip/hip_runtime.h>
#include <hip/hip_cooperative_groups.h>
#include <cstdio>
#include <cstdint>
#include <cmath>
namespace cg = cooperative_groups;

#ifndef N_LAUNCH_MODE
#define N_LAUNCH_MODE 1
#endif

#ifndef TIME_PHASE
#define TIME_PHASE -1
#endif
#ifndef TIME_SCALE
#define TIME_SCALE 5000.f
#endif
#ifndef DUP_GEMM
#define DUP_GEMM -1
#endif
#ifndef PRO_SPLIT
#define PRO_SPLIT 1
#endif
#ifndef USE_XBAR
#define USE_XBAR 1
#endif
#ifndef DBG_XTRA_BAR
#define DBG_XTRA_BAR 0
#endif
#ifndef DBG_ROUND_BAR
#define DBG_ROUND_BAR 0
#endif
#ifndef GATHER_DYN
#define GATHER_DYN 1
#endif
#ifndef SEL_FUSED
#define SEL_FUSED 1
#endif
#ifndef DUP_PHASE
#define DUP_PHASE -1
#endif
#ifndef DBG_ALPHA
#define DBG_ALPHA 1.0f
#endif
#ifndef DBG_BETA
#define DBG_BETA 1.0f
#endif
#define LAS __attribute__((address_space(3)))
#define DI __device__ __forceinline__
typedef unsigned short bf16_t;
typedef short bf16x8 __attribute__((ext_vector_type(8)));
typedef float f32x4 __attribute__((ext_vector_type(4)));
typedef float f32x2 __attribute__((ext_vector_type(2)));
typedef unsigned u32x4 __attribute__((ext_vector_type(4)));
typedef unsigned u32x2 __attribute__((ext_vector_type(2)));
typedef __bf16 bf16v2 __attribute__((ext_vector_type(2)));

constexpr int M = 16384, D = 2048, SEQ = 4096, NB = 4;
constexpr int NTHREADS = 512, NWAVES = 8;
constexpr int LDS_BYTES = 160 * 1024;
constexpr float EPS = 1e-6f;
constexpr float LOG2E = 1.4426950408889634f;
constexpr int NPHASE = 14;

constexpr size_t al256(size_t x) { return (x + 255) & ~(size_t)255; }
constexpr size_t OFF_CTL = 0;
constexpr size_t OFF_XBAR = 4096;
constexpr size_t OFF_MODI = 32768;
constexpr size_t ZERO_BYTES = OFF_MODI + (size_t)NB * 6 * D * 8;
constexpr size_t OFF_MOD = al256(ZERO_BYTES);
constexpr size_t OFF_RSTQ = OFF_MOD + (size_t)NB * 6 * D * 4;
constexpr size_t OFF_RSTKV = OFF_RSTQ + (size_t)M * 4;
constexpr size_t OFF_CS = OFF_RSTKV + (size_t)M * 4;
constexpr size_t OFF_KEYS = OFF_CS + (size_t)M * 32 * 8;
constexpr size_t OFF_WIN = OFF_KEYS + (size_t)8 * 2 * 128 * 128 * 2;
constexpr size_t OFF_WSBV = OFF_WIN + (size_t)7168 * 2048 * 2;
constexpr size_t OFF_WUQ = OFF_WSBV + (size_t)1024 * 2048 * 2;
constexpr size_t OFF_WUK = OFF_WUQ + (size_t)1536 * 512 * 2;
constexpr size_t OFF_WUV = OFF_WUK + (size_t)1024 * 256 * 2;
constexpr size_t OFF_WA = OFF_WUV + (size_t)1024 * 256 * 2;
constexpr size_t OFF_WB = OFF_WA + (size_t)2048 * 1024 * 2;
constexpr size_t OFF_WOUT = OFF_WB + (size_t)2048 * 1024 * 2;
constexpr size_t OFF_WPQ = OFF_WOUT + (size_t)2048 * 2048 * 2;
constexpr size_t OFF_H = OFF_WPQ + (size_t)2048 * 2048 * 2;
constexpr size_t OFF_CQ = OFF_H + (size_t)M * 2048 * 2;
constexpr size_t OFF_CKV = OFF_CQ + (size_t)M * 512 * 2;
constexpr size_t OFF_KR = OFF_CKV + (size_t)M * 256 * 2;
constexpr size_t OFF_SBQ = OFF_KR + (size_t)M * 64 * 2;
constexpr size_t OFF_SBK = OFF_SBQ + (size_t)M * 1024 * 2;
constexpr size_t OFF_SBVT = OFF_SBK + (size_t)M * 1024 * 2;
constexpr size_t OFF_GA = OFF_SBVT + (size_t)M * 1024 * 2;
constexpr size_t OFF_GB = OFF_GA + (size_t)M * 2048 * 2;
constexpr size_t OFF_Q = OFF_GB + (size_t)M * 2048 * 2;
constexpr size_t OFF_KN = OFF_Q + (size_t)M * 1536 * 2;
constexpr size_t OFF_VT = OFF_KN + (size_t)M * 1024 * 2;
constexpr size_t OFF_ATTA = OFF_VT + (size_t)M * 1024 * 2;
constexpr size_t OFF_ATTB = OFF_ATTA + (size_t)M * 1024 * 2;
constexpr size_t WS_END = OFF_ATTB + (size_t)M * 1024 * 2;
constexpr size_t OFF_MERGED = OFF_SBQ;
constexpr size_t OFF_PQ = OFF_GA;
constexpr size_t OFF_IDX = OFF_GB;
constexpr size_t OFF_GW = OFF_GB + (size_t)M * 128 * 4;
constexpr size_t OFF_U16 = OFF_Q;
constexpr size_t OFF_V16 = OFF_U16 + (size_t)16384 * 2048;
static_assert(OFF_V16 + (size_t)16384 * 2048 <= WS_END, "u/v overlay");
constexpr float U8_SCALE = 68.f, V8_SCALE = 1.5f;
static_assert(WS_END < (size_t)620 * 1000 * 1000, "workspace budget");

struct Params {
    const float *x, *c; const int* pos;
    const float *ada_w, *ada_b, *n1g, *n2g, *w_in, *qng, *kvng, *w_uq, *w_ukv, *w_bm, *w_bs, *w_out, *w_pq, *skeys, *pu, *pv, *fng;
    float* out; unsigned char* ws;
    float invf[32];
    int ph_lo, ph_hi;
};

DI unsigned pk2(float lo, float hi) { bf16v2 p; p[0] = (__bf16)lo; p[1] = (__bf16)hi; return __builtin_bit_cast(unsigned, p); }
DI float bflo(unsigned u) { return __uint_as_float(u << 16); }
DI float bfhi(unsigned u) { return __uint_as_float(u & 0xffff0000u); }
DI float dot2bf(unsigned a, unsigned b, float c) { return __builtin_amdgcn_fdot2_f32_bf16(__builtin_bit_cast(bf16v2, a), __builtin_bit_cast(bf16v2, b), c, false); }
DI float bf2f(bf16_t b) { return __uint_as_float(((unsigned)b) << 16); }
DI float wave_sum(float v) {
#pragma unroll
    for (int o = 1; o < 64; o <<= 1) v += __shfl_xor(v, o);
    return v;
}
DI float wave_max(float v) {
#pragma unroll
    for (int o = 1; o < 64; o <<= 1) v = fmaxf(v, __shfl_xor(v, o));
    return v;
}
DI float sigmoidf_(float v) { return 1.f / (1.f + __expf(-v)); }
DI float gelu_tanh(float v) { const float u = 0.7978845608028654f * (v + 0.044715f * v * v * v); const float e = __expf(2.f * u); const float t = 1.f - 2.f / (e + 1.f); return 0.5f * v * (1.f + t); }
#ifndef P2_FP8
#define P2_FP8 1
#endif
constexpr float W8_SCALE = 64.f;
#ifndef P67_FP8
#define P67_FP8 1
#endif
constexpr float ACT8_SCALE = 16.f;
DI unsigned pk4f8(float a, float b, float c, float d) { int w = __builtin_amdgcn_cvt_pk_fp8_f32(a, b, 0, false); w = __builtin_amdgcn_cvt_pk_fp8_f32(c, d, w, true); return (unsigned)w; }
DI void store_bf16x4(bf16_t* p, f32x4 v) { u32x2 w; w.x = pk2(v[0], v[1]); w.y = pk2(v[2], v[3]); *(u32x2*)p = w; }
DI void store_bf16x8(bf16_t* p, f32x4 a, f32x4 b) { u32x4 w; w.x = pk2(a[0], a[1]); w.y = pk2(a[2], a[3]); w.z = pk2(b[0], b[1]); w.w = pk2(b[2], b[3]); *(u32x4*)p = w; }
DI void load_bf16x8(const bf16_t* p, f32x4& a, f32x4& b) { const u32x4 w = *(const u32x4*)p; a = (f32x4){bflo(w.x), bfhi(w.x), bflo(w.y), bfhi(w.y)}; b = (f32x4){bflo(w.z), bfhi(w.z), bflo(w.w), bfhi(w.w)}; }
DI f32x4 sig4(f32x4 v) { return (f32x4){sigmoidf_(v[0]), sigmoidf_(v[1]), sigmoidf_(v[2]), sigmoidf_(v[3])}; }
DI f32x4 rope4(f32x4 v, f32x2 c0, f32x2 c1) { return (f32x4){v[0] * c0.x - v[1] * c0.y, v[1] * c0.x + v[0] * c0.y, v[2] * c1.x - v[3] * c1.y, v[3] * c1.x + v[2] * c1.y}; }
DI f32x4 load_bf16x4(const bf16_t* p) { const u32x2 w = *(const u32x2*)p; return (f32x4){bflo(w.x), bfhi(w.x), bflo(w.y), bfhi(w.y)}; }

struct Ctx {
    LAS unsigned char* lds;
    int tid, lane, wave, gw, ngw;
};

struct MapWin { DI int operator()(int n) const {
    if (n < 768) return n;
    if (n < 1024) { const int j = n - 768; if (j >= 64) return -1; return 768 + (j >> 1) + 32 * (j & 1); }
    if (n < 2048) return 832 + (n - 1024);
    if (n < 3072) return 1856 + (n - 2048);
    if (n < 5120) return 3904 + (n - 3072);
    return 5952 + (n - 5120); } };
struct MapOff { int off; DI int operator()(int n) const { return n + off; } };
struct MapUq { DI int operator()(int n) const { const int hd = n / 192, j = n % 192; if (j < 128) return hd * 192 + j; const int jj = j - 128; return hd * 192 + 128 + (jj >> 1) + 32 * (jj & 1); } };
struct MapUk { DI int operator()(int n) const { return (n >> 7) * 256 + (n & 127); } };
struct MapUv { DI int operator()(int n) const { return (n >> 7) * 256 + 128 + (n & 127); } };

template <bool F8 = false, class Map>
DI void transpose_item(const float* W, int K, int N, const Map& mp, const float* rowscale, bf16_t* dst, int kb, int nb, LAS float* scr, int lane) {
    const int k0 = kb * 64, sc = mp(nb * 64 + lane);
#pragma unroll 8
    for (int kk = 0; kk < 64; ++kk) {
        float v = 0.f;
        if (sc >= 0) v = W[(size_t)(k0 + kk) * N + sc];
        if (rowscale) v *= rowscale[k0 + kk];
        scr[kk * 65 + lane] = v;
    }
    asm volatile("s_waitcnt lgkmcnt(0)" ::: "memory");
    const int kc = lane & 7;
#pragma unroll
    for (int j = 0; j < 8; ++j) {
        const int nrow = (lane >> 3) + 8 * j; const LAS float* s = scr + (8 * kc) * 65 + nrow;
        if constexpr (F8) { u32x2 o; o.x = pk4f8(s[0] * W8_SCALE, s[65] * W8_SCALE, s[2 * 65] * W8_SCALE, s[3 * 65] * W8_SCALE); o.y = pk4f8(s[4 * 65] * W8_SCALE, s[5 * 65] * W8_SCALE, s[6 * 65] * W8_SCALE, s[7 * 65] * W8_SCALE);
            *(u32x2*)((unsigned char*)dst + (size_t)(nb * 64 + nrow) * K + k0 + 8 * kc) = o; }
        else {
        u32x4 o; o.x = pk2(s[0], s[65]); o.y = pk2(s[2 * 65], s[3 * 65]); o.z = pk2(s[4 * 65], s[5 * 65]); o.w = pk2(s[6 * 65], s[7 * 65]);
        *(u32x4*)(dst + (size_t)(nb * 64 + nrow) * K + k0 + 8 * kc) = o; }
    }
    asm volatile("s_waitcnt lgkmcnt(0)" ::: "memory");
}

DI void phase_prologue(const Params& p, const Ctx& c, bool do_ada = true, bool do_rest = true) {
    unsigned char* ws = p.ws;
    LAS float* scr = (LAS float*)(c.lds + c.wave * 16640);
    unsigned long long* modi = (unsigned long long*)(ws + OFF_MODI);
    if (do_ada) for (int u = c.gw; u < 32 * 48; u += c.ngw) {
        const int kp = u / 48, ch = u % 48, k0 = kp * 64, c0 = ch * 256 + c.lane * 4;
        float sl[4];
#pragma unroll
        for (int b = 0; b < 4; ++b) { const float cv = p.c[b * D + k0 + c.lane]; sl[b] = cv / (1.f + __expf(-cv)); }
        f32x4 acc[4];
#pragma unroll
        for (int b = 0; b < 4; ++b) acc[b] = (f32x4){0.f, 0.f, 0.f, 0.f};
#pragma unroll 16
        for (int kk = 0; kk < 64; ++kk) {
            const f32x4 w = *(const f32x4*)(p.ada_w + (size_t)(k0 + kk) * (6 * D) + c0);
#pragma unroll
            for (int b = 0; b < 4; ++b) { const float s = __shfl(sl[b], kk); acc[b] += w * s; }
        }
        if (kp == 0) { const f32x4 bv = *(const f32x4*)(p.ada_b + c0);
#pragma unroll
            for (int b = 0; b < 4; ++b) acc[b] += bv; }
#pragma unroll
        for (int b = 0; b < 4; ++b)
#pragma unroll
            for (int e = 0; e < 4; ++e) atomicAdd(modi + b * 6 * D + c0 + e, (unsigned long long)(long long)__builtin_rint((double)acc[b][e] * 4294967296.0));
    }
    if (!do_rest) return;
    constexpr int I_WIN = 112 * 32, I_SBV = 16 * 32, I_UQ = 24 * 8, I_UK = 16 * 4, I_UV = 16 * 4, I_A = 32 * 16, I_B = 32 * 16, I_OUT = 32 * 32, I_PQ = 32 * 32;
    constexpr int NIT = I_WIN + I_SBV + I_UQ + I_UK + I_UV + I_A + I_B + I_OUT + I_PQ;
    for (int it = c.gw; it < NIT; it += c.ngw) {
        int r = it;
        if (r < I_WIN) { transpose_item<P2_FP8 != 0>(p.w_in, 2048, 8000, MapWin{}, nullptr, (bf16_t*)(ws + OFF_WIN), r % 32, r / 32, scr, c.lane); continue; } r -= I_WIN;
        if (r < I_SBV) { transpose_item<P2_FP8 != 0>(p.w_in, 2048, 8000, MapOff{2880}, nullptr, (bf16_t*)(ws + OFF_WSBV), r % 32, r / 32, scr, c.lane); continue; } r -= I_SBV;
        if (r < I_UQ) { transpose_item(p.w_uq, 512, 1536, MapUq{}, p.qng, (bf16_t*)(ws + OFF_WUQ), r % 8, r / 8, scr, c.lane); continue; } r -= I_UQ;
        if (r < I_UK) { transpose_item(p.w_ukv, 256, 2048, MapUk{}, p.kvng, (bf16_t*)(ws + OFF_WUK), r % 4, r / 4, scr, c.lane); continue; } r -= I_UK;
        if (r < I_UV) { transpose_item(p.w_ukv, 256, 2048, MapUv{}, p.kvng, (bf16_t*)(ws + OFF_WUV), r % 4, r / 4, scr, c.lane); continue; } r -= I_UV;
        if (r < I_A) { transpose_item<P67_FP8 != 0>(p.w_bm, 1024, 2048, MapOff{0}, nullptr, (bf16_t*)(ws + OFF_WA), r % 16, r / 16, scr, c.lane); continue; } r -= I_A;
        if (r < I_B) { transpose_item<P67_FP8 != 0>(p.w_bs, 1024, 2048, MapOff{0}, nullptr, (bf16_t*)(ws + OFF_WB), r % 16, r / 16, scr, c.lane); continue; } r -= I_B;
        if (r < I_OUT) { transpose_item<P67_FP8 != 0>(p.w_out, 2048, 2048, MapOff{0}, nullptr, (bf16_t*)(ws + OFF_WOUT), r % 32, r / 32, scr, c.lane); continue; } r -= I_OUT;
        transpose_item(p.w_pq, 2048, 2048, MapOff{0}, nullptr, (bf16_t*)(ws + OFF_WPQ), r % 32, r / 32, scr, c.lane);
    }
    { bf16_t* kd = (bf16_t*)(ws + OFF_KEYS);
      for (int i = (c.gw * 64 + c.lane) * 4; i < 8 * 2 * 128 * 128; i += c.ngw * 64 * 4) store_bf16x4(kd + i, *(const f32x4*)(p.skeys + i)); }
    { f32x2* cs = (f32x2*)(ws + OFF_CS);
      for (int i = c.gw * 64 + c.lane; i < M * 32; i += c.ngw * 64) {
          const int m = i >> 5, f = i & 31;
          const float ang = (float)p.pos[m] * p.invf[f];
          const double rev = (double)ang * 0.15915494309189533576888;
          const float fr = (float)(rev - __builtin_rint(rev));
          cs[i] = (f32x2){__builtin_amdgcn_cosf(fr), __builtin_amdgcn_sinf(fr)};
      } }
}

DI f32x4 ld_mod4(const float* p) { return *(const f32x4*)p; }
DI f32x4 ld_mod4(const long long* p) { f32x4 r;
#pragma unroll
    for (int e = 0; e < 4; ++e) r[e] = (float)((double)p[e] * (1.0 / 4294967296.0));
    return r; }
template <bool F8 = false, class MT>
DI void modulate_rows(const float* src, const float* g, const MT* sc, const MT* sh, bf16_t* dst, const Ctx& c) {
    for (int m = c.gw; m < M; m += c.ngw) {
        const int b = m / SEQ;
        const float* xr = src + (size_t)m * D;
        f32x4 v[8]; float ss = 0.f;
#pragma unroll
        for (int j = 0; j < 8; ++j) { v[j] = *(const f32x4*)(xr + (j * 64 + c.lane) * 4); ss += v[j][0] * v[j][0] + v[j][1] * v[j][1] + v[j][2] * v[j][2] + v[j][3] * v[j][3]; }
        const float rstd = rsqrtf(wave_sum(ss) * (1.f / D) + EPS);
#pragma unroll
        for (int j = 0; j < 8; ++j) {
            const int col = (j * 64 + c.lane) * 4;
            const f32x4 gg = *(const f32x4*)(g + col), s1 = ld_mod4(sc + b * 6 * D + col), h1 = ld_mod4(sh + b * 6 * D + col);
            const f32x4 o = v[j] * rstd * gg * (s1 + 1.f) + h1;
            if constexpr (F8) *(unsigned*)((unsigned char*)dst + (size_t)m * D + col) = pk4f8(o[0], o[1], o[2], o[3]);
            else store_bf16x4(dst + (size_t)m * D + col, o);
        }
    }
}
DI void phase_rowstats(const Params& p, const Ctx& c) {
    const bf16_t* cq = (const bf16_t*)(p.ws + OFF_CQ); const bf16_t* ckv = (const bf16_t*)(p.ws + OFF_CKV);
    float* rq = (float*)(p.ws + OFF_RSTQ); float* rkv = (float*)(p.ws + OFF_RSTKV);
    for (int m = c.gw; m < M; m += c.ngw) {
        const u32x4 a = *(const u32x4*)(cq + (size_t)m * 512 + c.lane * 8);
        const u32x2 b = *(const u32x2*)(ckv + (size_t)m * 256 + c.lane * 4);
        float s1 = 0.f, s2 = 0.f;
#pragma unroll
        for (int e = 0; e < 4; ++e) { const float lo = bflo(a[e]), hi = bfhi(a[e]); s1 += lo * lo + hi * hi; }
#pragma unroll
        for (int e = 0; e < 2; ++e) { const float lo = bflo(b[e]), hi = bfhi(b[e]); s2 += lo * lo + hi * hi; }
        s1 = wave_sum(s1); s2 = wave_sum(s2);
        if (c.lane == 0) { rq[m] = rsqrtf(s1 * (1.f / 512.f) + EPS); rkv[m] = rsqrtf(s2 * (1.f / 256.f) + EPS); }
    }
}
typedef float f32x16v __attribute__((ext_vector_type(16)));
typedef float f32x32v __attribute__((ext_vector_type(32)));
typedef unsigned u32x6 __attribute__((ext_vector_type(6)));
#ifndef FP6_ORDER
#define FP6_ORDER 1
#endif
DI void convert_table(const float* src, unsigned char* dst, float scale, const Ctx& c) {
    const size_t ngroups = (size_t)16384 * 64;
    for (size_t gi = (size_t)c.gw * 64 + c.lane; gi < ngroups; gi += (size_t)c.ngw * 64) {
        const size_t row = gi >> 6; const int l = (int)(gi & 63);
        const float* sp = src + row * 2048 + l * 32;
        f32x4 v[8];
#pragma unroll
        for (int i = 0; i < 8; ++i) v[i] = *(const f32x4*)(sp + 4 * i) * scale;
        f32x16v a, b;
#pragma unroll
        for (int e = 0; e < 16; ++e) {
#if FP6_ORDER == 0
            a[e] = v[e >> 2][e & 3]; b[e] = v[4 + (e >> 2)][e & 3];
#else
            a[e] = v[(2 * e) >> 2][(2 * e) & 3]; b[e] = v[(2 * e + 1) >> 2][(2 * e + 1) & 3];
#endif
        }
        const u32x6 pk = __builtin_amdgcn_cvt_scalef32_2xpk16_fp6_f32(a, b, 1.0f);
        unsigned char* dp = dst + row * 1536;
        *(u32x4*)(dp + 16 * l) = (u32x4){pk[0], pk[1], pk[2], pk[3]};
        *(u32x2*)(dp + 1024 + 8 * l) = (u32x2){pk[4], pk[5]};
    }
}

struct EpiProj {
    bf16_t *cq, *ckv, *kr, *sbq, *sbk, *ga, *gb; const f32x2* cs; float osc;
    DI void operator()(int row, int col, f32x4 v) const {
        const int tile = col >> 8; v = v * osc;
        if (tile < 2) { store_bf16x4(cq + (size_t)row * 512 + col, v); }
        else if (tile == 2) { store_bf16x4(ckv + (size_t)row * 256 + (col - 512), v); }
        else if (tile == 3) { const int j = col - 768; if (j < 64) { const f32x2 c0 = cs[row * 32 + (j >> 1)], c1 = cs[row * 32 + (j >> 1) + 1];
            const f32x4 o = {v[0] * c0.x - v[1] * c0.y, v[1] * c0.x + v[0] * c0.y, v[2] * c1.x - v[3] * c1.y, v[3] * c1.x + v[2] * c1.y};
            store_bf16x4(kr + (size_t)row * 64 + j, o); } }
        else if (tile < 8) { store_bf16x4(sbq + (size_t)row * 1024 + (col - 1024), v * (0.08838834764831845f * LOG2E)); }
        else if (tile < 12) { store_bf16x4(sbk + (size_t)row * 1024 + (col - 2048), v); }
        else if (tile < 20) { store_bf16x4(ga + (size_t)row * 2048 + (col - 3072), (f32x4){sigmoidf_(v[0]), sigmoidf_(v[1]), sigmoidf_(v[2]), sigmoidf_(v[3])}); }
        else { store_bf16x4(gb + (size_t)row * 2048 + (col - 5120), (f32x4){sigmoidf_(v[0]), sigmoidf_(v[1]), sigmoidf_(v[2]), sigmoidf_(v[3])}); }
    }    DI void operator()(int row, int col, f32x4 v0, f32x4 v1) const {
        const int tile = col >> 8; v0 = v0 * osc; v1 = v1 * osc;
        if (tile < 2) { store_bf16x8(cq + (size_t)row * 512 + col, v0, v1); }
        else if (tile == 2) { store_bf16x8(ckv + (size_t)row * 256 + (col - 512), v0, v1); }
        else if (tile == 3) { const int j = col - 768; if (j < 64) { const f32x2* cp = cs + row * 32 + (j >> 1);
            store_bf16x8(kr + (size_t)row * 64 + j, rope4(v0, cp[0], cp[1]), rope4(v1, cp[2], cp[3])); } }
        else if (tile < 8) { const float sc = 0.08838834764831845f * LOG2E; store_bf16x8(sbq + (size_t)row * 1024 + (col - 1024), v0 * sc, v1 * sc); }
        else if (tile < 12) { store_bf16x8(sbk + (size_t)row * 1024 + (col - 2048), v0, v1); }
        else if (tile < 20) { store_bf16x8(ga + (size_t)row * 2048 + (col - 3072), sig4(v0), sig4(v1)); }
        else { store_bf16x8(gb + (size_t)row * 2048 + (col - 5120), sig4(v0), sig4(v1)); }
    }
};
struct EpiT { bf16_t* o; const float* cscale; float osc;
    static constexpr int MB = 2; struct Pre { f32x4 a, b; };
    DI Pre load(int row, int col) const { Pre q; q.a = q.b = (f32x4){osc, osc, osc, osc}; if (cscale) { q.a = *(const f32x4*)(cscale + col) * osc; q.b = *(const f32x4*)(cscale + col + 4) * osc; } return q; }
    DI void apply(int row, int col, f32x4 v0, f32x4 v1, const Pre& q) const { store_bf16x8(o + (size_t)row * M + col, v0 * q.a, v1 * q.b); }
    DI void operator()(int row, int col, f32x4 v) const { if (cscale) v = v * *(const f32x4*)(cscale + col); store_bf16x4(o + (size_t)row * M + col, v); }
    DI void operator()(int row, int col, f32x4 v0, f32x4 v1) const { if (cscale) { v0 = v0 * *(const f32x4*)(cscale + col); v1 = v1 * *(const f32x4*)(cscale + col + 4); } store_bf16x8(o + (size_t)row * M + col, v0, v1); } };
struct EpiUq { bf16_t* q; const float* rst; const f32x2* cs;
    static constexpr int MB = 2; struct Pre { float sc; f32x2 c0, c1, c2, c3; };
    DI Pre load(int row, int col) const { Pre w; w.sc = rst[row]; w.c0 = w.c1 = w.c2 = w.c3 = (f32x2){0.f, 0.f}; const int j = col % 192;
        if (j >= 128) { const f32x2* cp = cs + row * 32 + ((j - 128) >> 1); w.c0 = cp[0]; w.c1 = cp[1]; w.c2 = cp[2]; w.c3 = cp[3]; } return w; }
    DI void apply(int row, int col, f32x4 v0, f32x4 v1, const Pre& w) const {
        const float sc = w.sc * (0.07216878364870322f * LOG2E); v0 = v0 * sc; v1 = v1 * sc;
        if (col % 192 >= 128) { v0 = rope4(v0, w.c0, w.c1); v1 = rope4(v1, w.c2, w.c3); }
        store_bf16x8(q + (size_t)row * 1536 + col, v0, v1); }
    DI void operator()(int row, int col, f32x4 v) const {
        v = v * (rst[row] * (0.07216878364870322f * LOG2E));
        const int j = col % 192;
        if (j >= 128) { const int i0 = (j - 128) >> 1; const f32x2 c0 = cs[row * 32 + i0], c1 = cs[row * 32 + i0 + 1];
            v = (f32x4){v[0] * c0.x - v[1] * c0.y, v[1] * c0.x + v[0] * c0.y, v[2] * c1.x - v[3] * c1.y, v[3] * c1.x + v[2] * c1.y}; }
        store_bf16x4(q + (size_t)row * 1536 + col, v);
    }
    DI void operator()(int row, int col, f32x4 v0, f32x4 v1) const {
        const float sc = rst[row] * (0.07216878364870322f * LOG2E); v0 = v0 * sc; v1 = v1 * sc;
        const int j = col % 192;
        if (j >= 128) { const f32x2* cp = cs + row * 32 + ((j - 128) >> 1); v0 = rope4(v0, cp[0], cp[1]); v1 = rope4(v1, cp[2], cp[3]); }
        store_bf16x8(q + (size_t)row * 1536 + col, v0, v1);
    } };
struct EpiRowScale { bf16_t* o; int ld; const float* rst;
    static constexpr int MB = 4; typedef float Pre;
    DI Pre load(int row, int col) const { return rst[row]; }
    DI void apply(int row, int col, f32x4 v0, f32x4 v1, const Pre& sc) const { store_bf16x8(o + (size_t)row * ld + col, v0 * sc, v1 * sc); }
    DI void operator()(int row, int col, f32x4 v) const { store_bf16x4(o + (size_t)row * ld + col, v * rst[row]); }
    DI void operator()(int row, int col, f32x4 v0, f32x4 v1) const { const float sc = rst[row]; store_bf16x8(o + (size_t)row * ld + col, v0 * sc, v1 * sc); } };
struct EpiGate1 { bf16_t* mg; const bf16_t* g; float osc;
    static constexpr int MB = 2; typedef u32x4 Pre;
    DI Pre load(int row, int col) const { return *(const u32x4*)(g + (size_t)row * 2048 + col); }
    DI void apply(int row, int col, f32x4 v0, f32x4 v1, const Pre& w) const { const size_t i = (size_t)row * 2048 + col;
        const f32x4 g0 = {bflo(w.x), bfhi(w.x), bflo(w.y), bfhi(w.y)}, g1 = {bflo(w.z), bfhi(w.z), bflo(w.w), bfhi(w.w)}; store_bf16x8(mg + i, v0 * osc * g0, v1 * osc * g1); }
    DI void operator()(int row, int col, f32x4 v) const { const size_t i = (size_t)row * 2048 + col; store_bf16x4(mg + i, v * load_bf16x4(g + i)); }
    DI void operator()(int row, int col, f32x4 v0, f32x4 v1) const { const size_t i = (size_t)row * 2048 + col; f32x4 g0, g1; load_bf16x8(g + i, g0, g1); store_bf16x8(mg + i, v0 * g0, v1 * g1); } };
struct EpiGate2 { bf16_t* mg; const bf16_t* g; unsigned char* m8; float osc;
    static constexpr int MB = 2; struct Pre { u32x4 g, m; };
    DI Pre load(int row, int col) const { const size_t i = (size_t)row * 2048 + col; Pre q; q.g = *(const u32x4*)(g + i); q.m = *(const u32x4*)(mg + i); return q; }
    DI void apply(int row, int col, f32x4 v0, f32x4 v1, const Pre& q) const { const size_t i = (size_t)row * 2048 + col;
        const f32x4 g0 = {bflo(q.g.x), bfhi(q.g.x), bflo(q.g.y), bfhi(q.g.y)}, g1 = {bflo(q.g.z), bfhi(q.g.z), bflo(q.g.w), bfhi(q.g.w)};
        const f32x4 m0 = {bflo(q.m.x), bfhi(q.m.x), bflo(q.m.y), bfhi(q.m.y)}, m1 = {bflo(q.m.z), bfhi(q.m.z), bflo(q.m.w), bfhi(q.m.w)};
        const f32x4 r0 = m0 + v0 * osc * g0, r1 = m1 + v1 * osc * g1;
        if (P67_FP8) *(u32x2*)(m8 + i) = (u32x2){pk4f8(r0[0] * ACT8_SCALE, r0[1] * ACT8_SCALE, r0[2] * ACT8_SCALE, r0[3] * ACT8_SCALE), pk4f8(r1[0] * ACT8_SCALE, r1[1] * ACT8_SCALE, r1[2] * ACT8_SCALE, r1[3] * ACT8_SCALE)};
        else store_bf16x8(mg + i, r0, r1); }
    DI void operator()(int row, int col, f32x4 v) const { const size_t i = (size_t)row * 2048 + col; store_bf16x4(mg + i, load_bf16x4(mg + i) + v * load_bf16x4(g + i)); }
    DI void operator()(int row, int col, f32x4 v0, f32x4 v1) const { const size_t i = (size_t)row * 2048 + col; f32x4 g0, g1, m0, m1; load_bf16x8(g + i, g0, g1); load_bf16x8(mg + i, m0, m1); store_bf16x8(mg + i, m0 + v0 * g0, m1 + v1 * g1); } };
struct EpiRes { const float* x; const float* gt; float* x1; float osc;
    static constexpr int MB = 2; struct Pre { f32x4 a, b; };
    DI Pre load(int row, int col) const { const size_t i = (size_t)row * 2048 + col; Pre q; q.a = *(const f32x4*)(x + i); q.b = *(const f32x4*)(x + i + 4); return q; }
    DI void apply(int row, int col, f32x4 v0, f32x4 v1, const Pre& q) const { const size_t i = (size_t)row * 2048 + col; const int b = row / SEQ; const float* gp = gt + b * 6 * D + col;
        *(f32x4*)(x1 + i) = q.a + *(const f32x4*)gp * v0 * (osc * DBG_ALPHA); *(f32x4*)(x1 + i + 4) = q.b + *(const f32x4*)(gp + 4) * v1 * (osc * DBG_ALPHA); }
    DI void operator()(int row, int col, f32x4 v) const { const size_t i = (size_t)row * 2048 + col; const int b = row / SEQ;
        *(f32x4*)(x1 + i) = *(const f32x4*)(x + i) + *(const f32x4*)(gt + b * 6 * D + col) * v * DBG_ALPHA; }
    DI void operator()(int row, int col, f32x4 v0, f32x4 v1) const { (*this)(row, col, v0); (*this)(row, col + 4, v1); } };
struct EpiPq { bf16_t* pq;
    DI void operator()(int row, int col, f32x4 v) const { store_bf16x4(pq + (size_t)(col >> 8) * M * 256 + (size_t)row * 256 + (col & 255), v); }
    DI void operator()(int row, int col, f32x4 v0, f32x4 v1) const { store_bf16x8(pq + (size_t)(col >> 8) * M * 256 + (size_t)row * 256 + (col & 255), v0, v1); } };

template <class Epi>
DI void gemm_naive(const Ctx& c, const bf16_t* A, const bf16_t* Bt, int Mg, int Ng, int Kg, const Epi& E) {
    LAS float* As = (LAS float*)c.lds; LAS float* Bs = As + 16 * 132;
    const int tid = c.tid, ty = tid >> 5, tx = tid & 31;
    const int tilesN = Ng / 128, ntiles = (Mg / 128) * tilesN;
    for (int t = blockIdx.x; t < ntiles; t += gridDim.x) {
        const int tm = t / tilesN, tn = t % tilesN;
        float acc[8][4];
#pragma unroll
        for (int i = 0; i < 8; ++i)
#pragma unroll
            for (int j = 0; j < 4; ++j) acc[i][j] = 0.f;
        for (int k0 = 0; k0 < Kg; k0 += 16) {
            { const int lt = tid & 255, r = lt >> 1, kc = lt & 1;
              const bf16_t* src = (tid < 256 ? A + (size_t)(tm * 128 + r) * Kg : Bt + (size_t)(tn * 128 + r) * Kg) + k0 + kc * 8;
              const u32x4 v = *(const u32x4*)src;
              LAS float* dst = (tid < 256 ? As : Bs) + (kc * 8) * 132 + r;
              dst[0] = bflo(v.x); dst[132] = bfhi(v.x); dst[2 * 132] = bflo(v.y); dst[3 * 132] = bfhi(v.y);
              dst[4 * 132] = bflo(v.z); dst[5 * 132] = bfhi(v.z); dst[6 * 132] = bflo(v.w); dst[7 * 132] = bfhi(v.w); }
            __syncthreads();
#pragma unroll
            for (int kk = 0; kk < 16; ++kk) {
                const f32x4 a0 = *(const LAS f32x4*)(As + kk * 132 + ty * 8), a1 = *(const LAS f32x4*)(As + kk * 132 + ty * 8 + 4);
                const f32x4 b = *(const LAS f32x4*)(Bs + kk * 132 + tx * 4);
#pragma unroll
                for (int j = 0; j < 4; ++j) {
                    acc[0][j] += a0[0] * b[j]; acc[1][j] += a0[1] * b[j]; acc[2][j] += a0[2] * b[j]; acc[3][j] += a0[3] * b[j];
                    acc[4][j] += a1[0] * b[j]; acc[5][j] += a1[1] * b[j]; acc[6][j] += a1[2] * b[j]; acc[7][j] += a1[3] * b[j];
                }
            }
            __syncthreads();
        }
#pragma unroll
        for (int i = 0; i < 8; ++i) E(tm * 128 + ty * 8 + i, tn * 128 + tx * 4, (f32x4){acc[i][0], acc[i][1], acc[i][2], acc[i][3]});
    }
}

namespace pg8 {
#define PG8_LAS __attribute__((address_space(3)))
typedef unsigned short bf16_t;
typedef short bf16x8 __attribute__((ext_vector_type(8)));
typedef float f32x4 __attribute__((ext_vector_type(4)));
typedef unsigned u32x4 __attribute__((ext_vector_type(4)));
constexpr int BM = 256, BK = 64, HALF = 128, HTB = HALF * BK * 2  , STAGE_BYTES = 8 * HTB, NXCD = 8, WGM = 4;

__host__ __device__ __forceinline__ int lds_byte(int r, int c) { const int st = (r >> 4) * 2 + (c >> 5), rr = r & 15, cc = c & 31, ob = rr * 64 + cc * 2; return st * 1024 + (ob ^ (((ob >> 9) & 1) << 5)); }
__host__ __device__ __forceinline__ void stage_rc(int b, int& R, int& C) { const int st = b / 1024, sb = b % 1024, swz = sb ^ (((sb >> 9) & 1) << 5); R = (st >> 1) * 16 + swz / 64; C = (st & 1) * 32 + (swz % 64) / 2; }
__host__ __device__ __forceinline__ int perm32(int rho) { const int n = rho >> 4, i = rho & 15; return 8 * (i >> 2) + 4 * n + (i & 3); }

struct Unit { int pm, pn; };
struct Gemm { const bf16_t* A; const bf16_t* Bt; int M, N, K; int tid; const unsigned char* base; };
struct StaticOrder {
    int nM, nN, nwg, G, c;
    __host__ __device__ void init(int M, int N, int G_, int c_) { nM = M / BM; nN = N / BM; nwg = nM * nN; G = G_; c = c_; }
    __host__ __device__ bool next(int i, Unit& u) const {
        const long L = (long)i * G + c; if (L >= nwg) return false;
        int wgid = (int)L; { const int q = nwg / NXCD, r = nwg % NXCD, xcd = wgid % NXCD, off = wgid / NXCD; wgid = (xcd < r ? xcd * (q + 1) : r * (q + 1) + (xcd - r) * q) + off; }
        const int nig = WGM * nN, gid = wgid / nig, fm = gid * WGM, gsz = (nM - fm) < WGM ? (nM - fm) : WGM;
        u.pm = fm + ((wgid % nig) % gsz); u.pn = (wgid % nig) / gsz; return true;
    }
    __device__ __forceinline__ void a_ready(const Unit&) const {}
    __device__ __forceinline__ void done(const Unit&) const {}
};
typedef int i32x8 __attribute__((ext_vector_type(8)));
template <class Epi, class Sched, bool STAMP = false, bool F8 = false>
__device__ __forceinline__ void gemm_phase(PG8_LAS unsigned char* lds, const Gemm g, const Sched& S, const Epi& E, unsigned long long* stamps) {
    const int tid = g.tid, wid = __builtin_amdgcn_readfirstlane(tid >> 6), lane = tid & 63, wr = wid >> 2, wc = wid & 3, fr = lane & 15, fq = lane >> 4;
    const int K = g.K, nt = K / BK;
    int ts_lo = 0, ts_hi = 0, nts = 0; const unsigned long long rt_entry = STAMP ? (unsigned long long)wall_clock64() : 0ull;
#define PG8_STAMP() do { if (STAMP && wid == 0 && nts < 64) { const unsigned long long _c = (unsigned long long)clock64(); \
        ts_lo = (lane == nts) ? (int)(unsigned)_c : ts_lo; ts_hi = (lane == nts) ? (int)(unsigned)(_c >> 32) : ts_hi; ++nts; } } while (0)
    PG8_STAMP();
    unsigned voffA, voffB;
    { int R, C; stage_rc(tid * 16, R, C); const int Rb = Epi::PERM ? ((R & ~31) + perm32(R & 31)) : R;
        voffA = (unsigned)(R * K + C) * 2u; voffB = (unsigned)(Rb * K + C) * 2u; }
    const unsigned qstep = 64u * (unsigned)K * 2u;
    const unsigned kstep = (unsigned)(BK * 2);
    const unsigned hstep = (unsigned)HALF * K * 2;
    const unsigned tstep = 2 * hstep;
    const __amdgpu_buffer_rsrc_t rs = __builtin_amdgcn_make_buffer_rsrc((void*)g.base, (short)0, (int)0x7fffffff, 0x00020000);
    const unsigned oA = (unsigned)((const unsigned char*)g.A - g.base), oB = (unsigned)((const unsigned char*)g.Bt - g.base);
    const unsigned ldsw = (unsigned)wid * 1024u;
    const int aoff = lds_byte(wr * 64 + fr, fq * 8), boff = lds_byte(wc * 32 + fr, fq * 8);
#define PG8_SA(b, h) (((b) * 2 + (h)) * HTB)
#define PG8_SB(b, h) ((4 + (b) * 2 + (h)) * HTB)
#define PG8_STAGE(bufoff, gbase, voff) do { _Pragma("unroll") for (int _i = 0; _i < 2; ++_i) \
        __builtin_amdgcn_raw_ptr_buffer_load_lds(rs, (PG8_LAS void*)(lds + (bufoff) + ldsw + _i * 8192), 16, (voff), (gbase) + _i * qstep, 0, 0); } while (0)
#define PG8_LDA(dst, b, h) do { _Pragma("unroll") for (int m = 0; m < 4; ++m) _Pragma("unroll") for (int k = 0; k < 2; ++k) dst[m][k] = *(const PG8_LAS bf16x8*)(lds + PG8_SA(b, h) + aoff + m * 2048 + k * 1024); } while (0)
#define PG8_LDB(dst, b, h) do { _Pragma("unroll") for (int n = 0; n < 2; ++n) _Pragma("unroll") for (int k = 0; k < 2; ++k) dst[n][k] = *(const PG8_LAS bf16x8*)(lds + PG8_SB(b, h) + boff + n * 2048 + k * 1024); } while (0)
#define PG8_CAT8(x0, x1) __builtin_bit_cast(i32x8, __builtin_shufflevector(x0, x1, 0, 1, 2, 3, 4, 5, 6, 7, 8, 9, 10, 11, 12, 13, 14, 15))
#define PG8_MMA(ai, bj, At, Bt) do { __builtin_amdgcn_s_setprio(1); _Pragma("unroll") for (int m = 0; m < 4; ++m) _Pragma("unroll") for (int n = 0; n < 2; ++n) { \
        if constexpr (F8) acc[ai][bj][m][n] = __builtin_amdgcn_mfma_scale_f32_16x16x128_f8f6f4(PG8_CAT8(Bt[n][0], Bt[n][1]), PG8_CAT8(At[m][0], At[m][1]), acc[ai][bj][m][n], 0, 0, 0, 0, 0, 0); \
        else { _Pragma("unroll") for (int k = 0; k < 2; ++k) acc[ai][bj][m][n] = __builtin_amdgcn_mfma_f32_16x16x32_bf16(Bt[n][k], At[m][k], acc[ai][bj][m][n], 0, 0, 0); } } \
        __builtin_amdgcn_s_setprio(0); } while (0)
#define PG8_WAIT_V(n) asm volatile("s_waitcnt vmcnt(" #n ")" ::: "memory")
#define PG8_WAIT_L(n) asm volatile("s_waitcnt lgkmcnt(" #n ")" ::: "memory")
#define PG8_BAR __builtin_amdgcn_s_barrier()
#define PG8_SCHED __builtin_amdgcn_sched_barrier(0)
    Unit cur, nxt; int ui = 0;
    if (!S.next(0, cur)) return;
    f32x4 acc[2][2][4][2];
#pragma unroll
    for (int a = 0; a < 2; ++a)
#pragma unroll
        for (int b = 0; b < 2; ++b)
#pragma unroll
            for (int m = 0; m < 4; ++m)
#pragma unroll
                for (int n = 0; n < 2; ++n) acc[a][b][m][n] = (f32x4){0.f, 0.f, 0.f, 0.f};
    bf16x8 At[4][2], B0[2][2], B1[2][2];
    unsigned cA = oA + (unsigned)cur.pm * tstep, cB = oB + (unsigned)cur.pn * tstep;
    S.a_ready(cur);
    PG8_STAGE(PG8_SB(0, 0), cB, voffB); PG8_STAGE(PG8_SA(0, 0), cA, voffA); PG8_STAGE(PG8_SB(0, 1), cB + hstep, voffB); PG8_STAGE(PG8_SA(0, 1), cA + hstep, voffA);
    if (wr == 1) PG8_BAR;
    PG8_WAIT_V(4); PG8_BAR;
    PG8_STAGE(PG8_SB(1, 0), cB + kstep, voffB); PG8_STAGE(PG8_SA(1, 0), cA + kstep, voffA); PG8_STAGE(PG8_SB(1, 1), cB + hstep + kstep, voffB);
    PG8_WAIT_V(6); PG8_BAR;
    PG8_STAMP();
    for (;;) {
        const bool has_next = S.next(ui + 1, nxt);
        const unsigned nA = has_next ? oA + (unsigned)nxt.pm * tstep : cA, nB = has_next ? oB + (unsigned)nxt.pn * tstep : cB;
        for (int t = 0; t < nt; t += 2) {
            const bool last = (t == nt - 2);
            const unsigned a1 = cA + (unsigned)(t + 1) * kstep;
            const unsigned a2 = last ? nA : cA + (unsigned)(t + 2) * kstep, b2 = last ? nB : cB + (unsigned)(t + 2) * kstep;
            const unsigned a3 = a2 + kstep, b3 = b2 + kstep;
            if (last && has_next) S.a_ready(nxt);
            PG8_LDB(B0, 0, 0); PG8_SCHED; PG8_LDA(At, 0, 0); PG8_STAGE(PG8_SA(1, 1), a1 + hstep, voffA);
            PG8_WAIT_L(8); PG8_BAR; PG8_WAIT_L(0); PG8_MMA(0, 0, At, B0); PG8_BAR; PG8_SCHED;
            PG8_LDB(B1, 0, 1); PG8_STAGE(PG8_SB(0, 0), b2, voffB);
            PG8_BAR; PG8_WAIT_L(0); PG8_MMA(0, 1, At, B1); PG8_BAR;
            PG8_LDA(At, 0, 1); PG8_STAGE(PG8_SA(0, 0), a2, voffA);
            PG8_BAR; PG8_WAIT_L(0); PG8_MMA(1, 0, At, B0); PG8_BAR; PG8_SCHED;
            PG8_STAGE(PG8_SB(0, 1), b2 + hstep, voffB);
            PG8_WAIT_V(6); PG8_BAR; PG8_MMA(1, 1, At, B1); PG8_BAR;
            PG8_LDB(B0, 1, 0); PG8_SCHED; PG8_LDA(At, 1, 0); PG8_STAGE(PG8_SA(0, 1), a2 + hstep, voffA);
            PG8_WAIT_L(8); PG8_BAR; PG8_WAIT_L(0); PG8_MMA(0, 0, At, B0); PG8_BAR; PG8_SCHED;
            PG8_LDB(B1, 1, 1); PG8_STAGE(PG8_SB(1, 0), b3, voffB);
            PG8_BAR; PG8_WAIT_L(0); PG8_MMA(0, 1, At, B1); PG8_BAR;
            PG8_LDA(At, 1, 1); PG8_STAGE(PG8_SA(1, 0), a3, voffA);
            PG8_BAR; PG8_WAIT_L(0); PG8_MMA(1, 0, At, B0); PG8_BAR; PG8_SCHED;
            PG8_STAGE(PG8_SB(1, 1), b3 + hstep, voffB);
            PG8_WAIT_V(6); PG8_BAR; PG8_MMA(1, 1, At, B1); PG8_BAR;
        }
        PG8_STAMP();
        if constexpr (!Epi::AFTER_DRAIN) { E(acc, cur, wr, wc, fr, fq); S.done(cur); }
        PG8_STAMP();
        if (!has_next) break;
#pragma unroll
        for (int a = 0; a < 2; ++a)
#pragma unroll
            for (int b = 0; b < 2; ++b)
#pragma unroll
                for (int m = 0; m < 4; ++m)
#pragma unroll
                    for (int n = 0; n < 2; ++n) acc[a][b][m][n] = (f32x4){0.f, 0.f, 0.f, 0.f};
        cur = nxt; cA = nA; cB = nB; ++ui;
    }
    PG8_WAIT_V(0);
    if (wr == 0) PG8_BAR;
    PG8_BAR;
    if constexpr (Epi::AFTER_DRAIN) { E.fused(acc, cur, wr, wc, fr, fq, lds, wid, lane); S.done(cur); }
    PG8_STAMP();
    if (STAMP && wid == 0) { stamps[lane] = lane < nts ? (((unsigned long long)(unsigned)ts_hi << 32) | (unsigned)ts_lo) : 0ull;
        if (lane == 62) stamps[62] = rt_entry; if (lane == 63) stamps[63] = (unsigned long long)wall_clock64(); }
#undef PG8_STAMP
#undef PG8_SA
#undef PG8_SB
#undef PG8_STAGE
#undef PG8_LDA
#undef PG8_LDB
#undef PG8_MMA
#undef PG8_CAT8
#undef PG8_WAIT_V
#undef PG8_WAIT_L
#undef PG8_BAR
#undef PG8_SCHED
}
}

template <class E4, class = void> struct epi_mb { static constexpr int value = 0; };
template <class E4> struct epi_mb<E4, decltype((void)E4::MB)> { static constexpr int value = E4::MB; };
template <class E4> struct EpiAdapt {
    static constexpr bool PERM = true, AFTER_DRAIN = false;
    E4 e;
    __device__ __forceinline__ void operator()(const pg8::f32x4 (&acc)[2][2][4][2], const pg8::Unit& u, int wr, int wc, int fr, int fq) const {
        if constexpr (epi_mb<E4>::value > 0) {
            constexpr int MB = epi_mb<E4>::value;
#pragma unroll
            for (int ai = 0; ai < 2; ++ai)
#pragma unroll
                for (int m0 = 0; m0 < 4; m0 += MB) {
                    typename E4::Pre pre[MB][2];
#pragma unroll
                    for (int mi = 0; mi < MB; ++mi)
#pragma unroll
                        for (int bj = 0; bj < 2; ++bj) pre[mi][bj] = e.load(u.pm * 256 + ai * 128 + wr * 64 + (m0 + mi) * 16 + fr, u.pn * 256 + bj * 128 + wc * 32 + fq * 8);
#pragma unroll
                    for (int mi = 0; mi < MB; ++mi)
#pragma unroll
                        for (int bj = 0; bj < 2; ++bj) e.apply(u.pm * 256 + ai * 128 + wr * 64 + (m0 + mi) * 16 + fr, u.pn * 256 + bj * 128 + wc * 32 + fq * 8, acc[ai][bj][m0 + mi][0], acc[ai][bj][m0 + mi][1], pre[mi][bj]);
                    asm volatile("" ::: "memory");
                }
        } else {
#pragma unroll
        for (int ai = 0; ai < 2; ++ai)
#pragma unroll
            for (int m = 0; m < 4; ++m) {
                const int row = u.pm * 256 + ai * 128 + wr * 64 + m * 16 + fr;
#pragma unroll
                for (int bj = 0; bj < 2; ++bj) e(row, u.pn * 256 + bj * 128 + wc * 32 + fq * 8, acc[ai][bj][m][0], acc[ai][bj][m][1]);
                asm volatile("" ::: "memory");
            }
        }
    }
};
template <class E4>
DI void gemm_fast(const Ctx& c, const unsigned char* WSB, const bf16_t* A, const bf16_t* Bt, int Mg, int Ng, int Kg, const E4& e4) {
    pg8::Gemm g{A, Bt, Mg, Ng, Kg, c.tid, WSB}; pg8::StaticOrder S; S.init(Mg, Ng, (int)gridDim.x, (int)blockIdx.x);
    EpiAdapt<E4> E{e4};
    pg8::gemm_phase<EpiAdapt<E4>, pg8::StaticOrder, false>((PG8_LAS unsigned char*)c.lds, g, S, E, nullptr);
}
template <class E4>
DI void gemm_fast8(const Ctx& c, const unsigned char* WSB, const unsigned char* A, const unsigned char* Bt, int Mg, int Ng, int Kg, const E4& e4) {
    pg8::Gemm g{(const bf16_t*)A, (const bf16_t*)Bt, Mg, Ng, Kg / 2, c.tid, WSB}; pg8::StaticOrder S; S.init(Mg, Ng, (int)gridDim.x, (int)blockIdx.x);
    EpiAdapt<E4> E{e4};
    pg8::gemm_phase<EpiAdapt<E4>, pg8::StaticOrder, false, true>((PG8_LAS unsigned char*)c.lds, g, S, E, nullptr);
}
#define GEMM8(c_, ...) do { MKCTX(); gemm_fast8(c, ws, __VA_ARGS__); } while (0)
#ifndef FAST_GEMM
#define FAST_GEMM 1
#endif
#if FAST_GEMM
#define GEMM(c_, ...) do { MKCTX(); gemm_fast(c, ws, __VA_ARGS__); } while (0)
#else
#define GEMM(c_, ...) do { MKCTX(); gemm_naive(c, __VA_ARGS__); } while (0)
#endif

DI void attn_mla_naive(const Params& p, const Ctx& c) {
    const bf16_t* Q = (const bf16_t*)(p.ws + OFF_Q); const bf16_t* KN = (const bf16_t*)(p.ws + OFF_KN); const bf16_t* KR = (const bf16_t*)(p.ws + OFF_KR);
    const bf16_t* VT = (const bf16_t*)(p.ws + OFF_VT); bf16_t* O = (bf16_t*)(p.ws + OFF_ATTA);
    for (int u = c.gw; u < M * 8; u += c.ngw) {
        const int m = u >> 3, hd = u & 7, b = m / SEQ, s = m % SEQ, base = b * SEQ, nkeys = ((s >> 6) + 1) << 6;
        const float q0 = bf2f(Q[(size_t)m * 1536 + hd * 192 + c.lane]), q1 = bf2f(Q[(size_t)m * 1536 + hd * 192 + 64 + c.lane]), q2 = bf2f(Q[(size_t)m * 1536 + hd * 192 + 128 + c.lane]);
        float mx = -1e30f, l = 0.f, o0 = 0.f, o1 = 0.f;
        const bf16_t* v0p = VT + (size_t)(hd * 128 + c.lane) * M + base; const bf16_t* v1p = v0p + (size_t)64 * M;
        for (int kk = 0; kk < nkeys; ++kk) {
            const size_t tk = base + kk;
            const float part = q0 * bf2f(KN[tk * 1024 + hd * 128 + c.lane]) + q1 * bf2f(KN[tk * 1024 + hd * 128 + 64 + c.lane]) + q2 * bf2f(KR[tk * 64 + c.lane]);
            const float sc = wave_sum(part);
            const float mn = fmaxf(mx, sc), al = exp2f(mx - mn), pp = exp2f(sc - mn);
            l = l * al + pp; o0 = o0 * al + pp * bf2f(v0p[kk]); o1 = o1 * al + pp * bf2f(v1p[kk]); mx = mn;
        }
        const float inv = 1.f / l;
        O[(size_t)m * 1024 + hd * 128 + c.lane] = (bf16_t)(pk2(o0 * inv, 0.f) & 0xffff);
        O[(size_t)m * 1024 + hd * 128 + 64 + c.lane] = (bf16_t)(pk2(o1 * inv, 0.f) & 0xffff);
    }
}
DI void attn_sb_naive(const Params& p, const Ctx& c) {
    const bf16_t* Q = (const bf16_t*)(p.ws + OFF_SBQ); const bf16_t* K = (const bf16_t*)(p.ws + OFF_SBK);
    const bf16_t* VT = (const bf16_t*)(p.ws + OFF_SBVT); bf16_t* O = (bf16_t*)(p.ws + OFF_ATTB);
    for (int u = c.gw; u < M * 8; u += c.ngw) {
        const int m = u >> 3, hd = u & 7, b = m / SEQ, s = m % SEQ, base = b * SEQ;
        const float q0 = bf2f(Q[(size_t)m * 1024 + hd * 128 + c.lane]), q1 = bf2f(Q[(size_t)m * 1024 + hd * 128 + 64 + c.lane]);
        float later = 0.f, o0 = 0.f, o1 = 0.f;
        const bf16_t* v0p = VT + (size_t)(hd * 128 + c.lane) * M + base; const bf16_t* v1p = v0p + (size_t)64 * M;
        for (int kk = s - 1; kk >= 0; --kk) {
            const size_t tk = base + kk;
            const float z2 = wave_sum(q0 * bf2f(K[tk * 1024 + hd * 128 + c.lane]) + q1 * bf2f(K[tk * 1024 + hd * 128 + 64 + c.lane]));
            const float ln2 = -(fmaxf(z2, 0.f) + __log2f(1.f + exp2f(-fabsf(z2))));
            const float w = exp2f(z2 + ln2 + later);
            later += ln2; o0 += w * bf2f(v0p[kk]); o1 += w * bf2f(v1p[kk]);
        }
        O[(size_t)m * 1024 + hd * 128 + c.lane] = (bf16_t)(pk2(o0, 0.f) & 0xffff);
        O[(size_t)m * 1024 + hd * 128 + 64 + c.lane] = (bf16_t)(pk2(o1, 0.f) & 0xffff);
    }
}


typedef float f32x16 __attribute__((ext_vector_type(16)));
#define MFMA32(a, b, c) __builtin_amdgcn_mfma_f32_32x32x16_bf16((a), (b), (c), 0, 0, 0)
constexpr int ST_KR = 16384, ST_VT = 24576, ST_BYTES = 40960;
constexpr int ATT_FLAGS = 2 * ST_BYTES;
DI float ex2(float x) { return __builtin_amdgcn_exp2f(x); }
DI float lg2(float x) { return __builtin_amdgcn_logf(x); }
DI bf16x8 pack8(float a0, float a1, float a2, float a3, float a4, float a5, float a6, float a7) {
    u32x4 t; t.x = pk2(a0, a1); t.y = pk2(a2, a3); t.z = pk2(a4, a5); t.w = pk2(a6, a7); return __builtin_bit_cast(bf16x8, t); }
#define GLDS16(gp, lp) __builtin_amdgcn_global_load_lds((const unsigned*)(gp), (LAS unsigned*)(lp), 16, 0, 0)

struct AttDmaOff { unsigned kn[2], kr, vt[2]; };
DI AttDmaOff att_dma_offsets(int w, int lane) {
    AttDmaOff o; const unsigned lr = lane >> 4, pp = lane & 15;
#pragma unroll
    for (int i = 0; i < 2; ++i) { const unsigned q = w * 2 + i, R = 4 * q + lr, cc = pp ^ (R & 15); o.kn[i] = R * 2048u + cc * 16u; }
    { const unsigned q = w, R2 = 4 * q + lr, cc = pp ^ (R2 & 15); o.kr = (2 * R2 + (cc >> 3)) * 128u + (cc & 7) * 16u; }
#pragma unroll
    for (int i = 0; i < 2; ++i) { const unsigned q = w * 2 + i, R2 = 4 * q + lr, cc = pp ^ (R2 & 15); o.vt[i] = (2 * R2 + (cc >> 3)) * (unsigned)(M * 2) + (cc & 7) * 16u; }
    return o;
}
template <bool ROPE>
DI void att_dma(LAS unsigned char* buf, __amdgpu_buffer_rsrc_t rs, const AttDmaOff& o, unsigned k_so, unsigned kr_so, unsigned vt_so, int w) {
#pragma unroll
    for (int i = 0; i < 2; ++i) __builtin_amdgcn_raw_ptr_buffer_load_lds(rs, (LAS void*)(buf + (w * 2 + i) * 1024), 16, o.kn[i], k_so, 0, 0);
    if (ROPE) __builtin_amdgcn_raw_ptr_buffer_load_lds(rs, (LAS void*)(buf + ST_KR + w * 1024), 16, o.kr, kr_so, 0, 0);
#pragma unroll
    for (int i = 0; i < 2; ++i) __builtin_amdgcn_raw_ptr_buffer_load_lds(rs, (LAS void*)(buf + ST_VT + (w * 2 + i) * 1024), 16, o.vt[i], vt_so, 0, 0);
}
DI void att_store(const f32x16 (&o)[4], float scale, bf16_t* O, size_t row, int hd, int h) {
#pragma unroll
    for (int db = 0; db < 4; ++db)
#pragma unroll
        for (int g = 0; g < 4; ++g)
#if P67_FP8
            { const float sc8 = scale * ACT8_SCALE; *(unsigned*)((unsigned char*)O + row * 1024 + hd * 128 + db * 32 + g * 8 + h * 4) = pk4f8(o[db][4 * g] * sc8, o[db][4 * g + 1] * sc8, o[db][4 * g + 2] * sc8, o[db][4 * g + 3] * sc8); }
#else
            store_bf16x4(O + row * 1024 + hd * 128 + db * 32 + g * 8 + h * 4, (f32x4){o[db][4 * g] * scale, o[db][4 * g + 1] * scale, o[db][4 * g + 2] * scale, o[db][4 * g + 3] * scale});
#endif
}
DI void att_pv(f32x16 (&o)[4], const bf16x8 (&pf)[2][2], const LAS unsigned char* buf, unsigned va) {
#pragma unroll
    for (int db = 0; db < 4; ++db) {
#pragma unroll
        for (int blk = 0; blk < 2; ++blk)
#pragma unroll
            for (int ks = 0; ks < 2; ++ks) o[db] = MFMA32(*(const LAS bf16x8*)(buf + ((va ^ ((blk * 2 + ks) << 5)) + db * 4096)), pf[blk][ks], o[db]);
        asm volatile("" ::: "memory");
    }
}

DI void attn_mla_fast(const Params& p, const Ctx& c) {
    const bf16_t* Q = (const bf16_t*)(p.ws + OFF_Q); const bf16_t* KN = (const bf16_t*)(p.ws + OFF_KN); const bf16_t* KR = (const bf16_t*)(p.ws + OFF_KR);
    const bf16_t* VT = (const bf16_t*)(p.ws + OFF_VT); bf16_t* O = (bf16_t*)(p.ws + OFF_ATTA);
    const int lane = c.lane, r = lane & 31, h = lane >> 5, w = c.wave;
    const int pr = (r & 0x13) | ((r & 4) << 1) | ((r & 8) >> 1);
    const unsigned ka = (pr << 8) | ((((pr & 15) ^ h) & 15) << 4);
    const unsigned ra = ST_KR + (((pr >> 1) << 8) | (((((pr & 1) << 3) | h) ^ ((pr >> 1) & 15)) << 4));
    const unsigned va = ST_VT + (((r >> 1) << 8) | (((((r & 1) << 3) | h) ^ ((r >> 1) & 15)) << 4));
    const __amdgpu_buffer_rsrc_t rs = __builtin_amdgcn_make_buffer_rsrc((void*)p.ws, (short)0, (int)WS_END, 0x00020000);
    const AttDmaOff dof = att_dma_offsets(w, lane);
    for (int it = blockIdx.x; it < 256; it += gridDim.x) {
        const int bh = it & 31, b = bh >> 3, hd = bh & 7, pairi = it >> 5;
#pragma unroll 1
        for (int half = 0; half < 2; ++half) {
            const int qb = half ? 15 - pairi : pairi, q0 = qb * 256;
            const size_t base = (size_t)b * SEQ, qrow = base + q0 + w * 32 + r;
            bf16x8 qf[12];
#pragma unroll
            for (int st = 0; st < 12; ++st) qf[st] = *(const bf16x8*)(Q + qrow * 1536 + hd * 192 + st * 16 + h * 8);
            const int ntile = q0 / 64 + 4, myn = (q0 + w * 32) / 64 + 1;
            f32x16 o[4];
#pragma unroll
            for (int db = 0; db < 4; ++db)
#pragma unroll
                for (int i = 0; i < 16; ++i) o[db][i] = 0.f;
            float mrun = -1e30f, lrun = 0.f;
            __syncthreads();
            const unsigned k_so0 = (unsigned)(OFF_KN + (base * 1024 + hd * 128) * 2), kr_so0 = (unsigned)(OFF_KR + base * 64 * 2), vt_so0 = (unsigned)(OFF_VT + ((size_t)(hd * 128) * M + base) * 2);
            att_dma<true>(c.lds, rs, dof, k_so0, kr_so0, vt_so0, w);
            asm volatile("s_waitcnt vmcnt(0)" ::: "memory");
            __syncthreads();
            for (int j = 0; j < ntile; ++j) {
                LAS unsigned char* buf = c.lds + (j & 1) * ST_BYTES;
                if (j + 1 < ntile) att_dma<true>(c.lds + ((j + 1) & 1) * ST_BYTES, rs, dof, k_so0 + (unsigned)(j + 1) * (64 * 2048), kr_so0 + (unsigned)(j + 1) * (64 * 128), vt_so0 + (unsigned)(j + 1) * 128, w);
                if (j < myn) {
                    f32x16 s0, s1;
#pragma unroll
                    for (int i = 0; i < 16; ++i) { s0[i] = 0.f; s1[i] = 0.f; }
                    __builtin_amdgcn_s_setprio(1);
#pragma unroll
                    for (int st = 0; st < 8; ++st) {
                        s0 = MFMA32(*(const LAS bf16x8*)(buf + (ka ^ (st << 5))), qf[st], s0);
                        s1 = MFMA32(*(const LAS bf16x8*)(buf + ((ka ^ (st << 5)) + 8192)), qf[st], s1);
                    }
#pragma unroll
                    for (int st = 0; st < 4; ++st) {
                        s0 = MFMA32(*(const LAS bf16x8*)(buf + (ra ^ (st << 5))), qf[8 + st], s0);
                        s1 = MFMA32(*(const LAS bf16x8*)(buf + ((ra ^ (st << 5)) + 4096)), qf[8 + st], s1);
                    }
                    __builtin_amdgcn_s_setprio(0);
                    float mx = fmaxf(s0[0], s1[0]);
#pragma unroll
                    for (int i = 1; i < 16; ++i) mx = fmaxf(mx, fmaxf(s0[i], s1[i]));
                    mx = fmaxf(mx, __shfl_xor(mx, 32));
                    const float mnew = fmaxf(mrun, mx), alpha = ex2(mrun - mnew);
                    mrun = mnew;
                    float ps = 0.f;
#pragma unroll
                    for (int i = 0; i < 16; ++i) { s0[i] = ex2(s0[i] - mnew); s1[i] = ex2(s1[i] - mnew); ps += s0[i] + s1[i]; }
                    lrun = lrun * alpha + ps;
#pragma unroll
                    for (int db = 0; db < 4; ++db)
#pragma unroll
                        for (int i = 0; i < 16; ++i) o[db][i] *= alpha;
                    bf16x8 pf[2][2];
                    pf[0][0] = pack8(s0[0], s0[1], s0[2], s0[3], s0[4], s0[5], s0[6], s0[7]); pf[0][1] = pack8(s0[8], s0[9], s0[10], s0[11], s0[12], s0[13], s0[14], s0[15]);
                    pf[1][0] = pack8(s1[0], s1[1], s1[2], s1[3], s1[4], s1[5], s1[6], s1[7]); pf[1][1] = pack8(s1[8], s1[9], s1[10], s1[11], s1[12], s1[13], s1[14], s1[15]);
                    __builtin_amdgcn_s_setprio(1);
                    att_pv(o, pf, buf, va);
                    __builtin_amdgcn_s_setprio(0);
                }
                asm volatile("s_waitcnt vmcnt(0)" ::: "memory");
                __syncthreads();
            }
            const float ltot = lrun + __shfl_xor(lrun, 32);
            att_store(o, 1.f / ltot, O, qrow, hd, h);
        }
    }
}

DI void attn_sb_fast(const Params& p, const Ctx& c) {
    const bf16_t* Q = (const bf16_t*)(p.ws + OFF_SBQ); const bf16_t* K = (const bf16_t*)(p.ws + OFF_SBK);
    const bf16_t* VT = (const bf16_t*)(p.ws + OFF_SBVT); bf16_t* O = (bf16_t*)(p.ws + OFF_ATTB);
    const int lane = c.lane, r = lane & 31, h = lane >> 5, w = c.wave, tid = c.tid;
    const int pr = (r & 0x13) | ((r & 4) << 1) | ((r & 8) >> 1);
    const unsigned ka = (pr << 8) | ((((pr & 15) ^ h) & 15) << 4);
    const unsigned va = ST_VT + (((r >> 1) << 8) | (((((r & 1) << 3) | h) ^ ((r >> 1) & 15)) << 4));
    const __amdgpu_buffer_rsrc_t rs = __builtin_amdgcn_make_buffer_rsrc((void*)p.ws, (short)0, (int)WS_END, 0x00020000);
    const AttDmaOff dof = att_dma_offsets(w, lane);
    LAS int* flags = (LAS int*)(c.lds + ATT_FLAGS);
    for (int it = blockIdx.x; it < 256; it += gridDim.x) {
        const int bh = it & 31, b = bh >> 3, hd = bh & 7, pairi = it >> 5;
#pragma unroll 1
        for (int half = 0; half < 2; ++half) {
            const int qb = half ? 15 - pairi : pairi, q0 = qb * 256;
            const size_t base = (size_t)b * SEQ, qrow = base + q0 + w * 32 + r;
            const int tq = q0 + w * 32 + r;
            bf16x8 qf[8];
#pragma unroll
            for (int st = 0; st < 8; ++st) qf[st] = *(const bf16x8*)(Q + qrow * 1024 + hd * 128 + st * 16 + h * 8);
            const int jmax = q0 / 64 + 3, jd = (q0 + w * 32) / 64;
            f32x16 o[4];
#pragma unroll
            for (int db = 0; db < 4; ++db)
#pragma unroll
                for (int i = 0; i < 16; ++i) o[db][i] = 0.f;
            float carry = 0.f; bool wdone = false;
            __syncthreads();
            const unsigned k_so0 = (unsigned)(OFF_SBK + (base * 1024 + hd * 128) * 2), vt_so0 = (unsigned)(OFF_SBVT + ((size_t)(hd * 128) * M + base) * 2);
            att_dma<false>(c.lds, rs, dof, k_so0 + (unsigned)jmax * (64 * 2048), 0u, vt_so0 + (unsigned)jmax * 128, w);
            if (tid < 16) flags[tid] = 0;
            asm volatile("s_waitcnt vmcnt(0)" ::: "memory");
            __syncthreads();
            int itn = 0;
            for (int j = jmax; j >= 0; --j, ++itn) {
                LAS unsigned char* buf = c.lds + (itn & 1) * ST_BYTES;
                if (j > 0) att_dma<false>(c.lds + ((itn + 1) & 1) * ST_BYTES, rs, dof, k_so0 + (unsigned)(j - 1) * (64 * 2048), 0u, vt_so0 + (unsigned)(j - 1) * 128, w);
                if (j <= jd && !wdone) {
                    f32x16 s0, s1;
#pragma unroll
                    for (int i = 0; i < 16; ++i) { s0[i] = 0.f; s1[i] = 0.f; }
#pragma unroll
                    for (int st = 0; st < 8; ++st) {
                        s0 = MFMA32(*(const LAS bf16x8*)(buf + (ka ^ (st << 5))), qf[st], s0);
                        s1 = MFMA32(*(const LAS bf16x8*)(buf + ((ka ^ (st << 5)) + 8192)), qf[st], s1);
                    }
                    const int kb0 = 64 * j + 8 * h - tq;
                    bf16x8 pf[2][2];
                    {
                        f32x16 l1;
#pragma unroll
                        for (int i = 0; i < 16; ++i) { const float z = s1[i]; const float a = -(fmaxf(z, 0.f) + lg2(1.f + ex2(-fabsf(z)))); l1[i] = (kb0 + 32 + 16 * (i >> 3) + (i & 7) < 0) ? a : 0.f; }
                        float g0 = 0.f, g1 = 0.f;
#pragma unroll
                        for (int e = 0; e < 8; ++e) { g0 += l1[e]; g1 += l1[8 + e]; }
                        const float p0 = __shfl_xor(g0, 32), p1 = __shfl_xor(g1, 32);
                        float run = carry + (h == 0 ? p1 : 0.f);
#pragma unroll
                        for (int e = 7; e >= 0; --e) { run += l1[8 + e]; l1[8 + e] = run; }
                        run = carry + (g1 + p1) + (h == 0 ? p0 : 0.f);
#pragma unroll
                        for (int e = 7; e >= 0; --e) { run += l1[e]; l1[e] = run; }
                        carry += (g1 + p1) + (g0 + p0);
#pragma unroll
                        for (int i = 0; i < 16; ++i) { const float wv = ex2(s1[i] + l1[i]); s1[i] = (kb0 + 32 + 16 * (i >> 3) + (i & 7) < 0) ? wv : 0.f; }
                        pf[1][0] = pack8(s1[0], s1[1], s1[2], s1[3], s1[4], s1[5], s1[6], s1[7]); pf[1][1] = pack8(s1[8], s1[9], s1[10], s1[11], s1[12], s1[13], s1[14], s1[15]);
                    }
                    {
                        f32x16 l0;
#pragma unroll
                        for (int i = 0; i < 16; ++i) { const float z = s0[i]; const float a = -(fmaxf(z, 0.f) + lg2(1.f + ex2(-fabsf(z)))); l0[i] = (kb0 + 16 * (i >> 3) + (i & 7) < 0) ? a : 0.f; }
                        float g0 = 0.f, g1 = 0.f;
#pragma unroll
                        for (int e = 0; e < 8; ++e) { g0 += l0[e]; g1 += l0[8 + e]; }
                        const float p0 = __shfl_xor(g0, 32), p1 = __shfl_xor(g1, 32);
                        float run = carry + (h == 0 ? p1 : 0.f);
#pragma unroll
                        for (int e = 7; e >= 0; --e) { run += l0[8 + e]; l0[8 + e] = run; }
                        run = carry + (g1 + p1) + (h == 0 ? p0 : 0.f);
#pragma unroll
                        for (int e = 7; e >= 0; --e) { run += l0[e]; l0[e] = run; }
                        carry += (g1 + p1) + (g0 + p0);
#pragma unroll
                        for (int i = 0; i < 16; ++i) { const float wv = ex2(s0[i] + l0[i]); s0[i] = (kb0 + 16 * (i >> 3) + (i & 7) < 0) ? wv : 0.f; }
                        pf[0][0] = pack8(s0[0], s0[1], s0[2], s0[3], s0[4], s0[5], s0[6], s0[7]); pf[0][1] = pack8(s0[8], s0[9], s0[10], s0[11], s0[12], s0[13], s0[14], s0[15]);
                    }
                    att_pv(o, pf, buf, va);
                    wdone = __all(carry < -150.f);
                }
                if (lane == 0) flags[(itn & 1) * 8 + w] = wdone ? 1 : 0;
                asm volatile("s_waitcnt vmcnt(0)" ::: "memory");
                __syncthreads();
                int alld = 1;
#pragma unroll
                for (int q = 0; q < 8; ++q) alld &= flags[(itn & 1) * 8 + q];
                if (alld) break;
            }
            att_store(o, 1.f, O, qrow, hd, h);
        }
    }
}
#ifndef FAST_ATTN
#define FAST_ATTN 1
#endif

constexpr int SEL_LD = 260;
DI void topk_insert(float (&a)[16], float x) {
#pragma unroll
    for (int i = 15; i >= 1; --i) a[i] = __builtin_amdgcn_fmed3f(a[i - 1], a[i], x);
    a[0] = fmaxf(a[0], x);
}
struct SelMap { int mode, a0, a1, a2, a3; };
DI void sel_decode(const SelMap& mp, int q, int& t0, int& hd) {
    if (mp.mode == 0) { int u = mp.a0 + q * mp.a1; if (u >= 128 * 8) u = mp.a0; hd = u & 7; t0 = (u >> 3) * 128; }
    else { const int pm = (q >> 1) ? mp.a2 : mp.a0, pn = (q >> 1) ? mp.a3 : mp.a1; hd = pn; t0 = pm * 256 + (q & 1) * 128; }
}
template <int NU> DI void select_stage2(const Params& p, const Ctx& c, const SelMap mp, const LAS float* lst_all) {
    if (c.tid < 128 * NU) {
        const int tok = c.tid & 127, un = c.tid >> 7;
        int t0, hd; sel_decode(mp, un, t0, hd);
        const LAS float* lst = lst_all + un * 4096;
        float v1[16], v2[16];
#pragma unroll
        for (int i = 0; i < 16; ++i) { v1[i] = __uint_as_float(__float_as_uint(lst[(tok * 2) * 16 + i]) & ~127u); v2[i] = __uint_as_float(__float_as_uint(lst[(tok * 2 + 1) * 16 + i]) & ~127u); }
        float bb[16];
#pragma unroll
        for (int i = 0; i < 16; ++i) bb[i] = -__builtin_inff();
#pragma unroll
        for (int i = 0; i < 16; ++i)
#pragma unroll
            for (int j = 0; j < 16; ++j)
                if ((i + 1) * (j + 1) <= 16) topk_insert(bb, __uint_as_float((__float_as_uint(v1[i] + v2[j]) & ~255u) | (unsigned)(i * 16 + j)));
        float sv[16], mxv = -__builtin_inff(), sum = 0.f;
#pragma unroll
        for (int i = 0; i < 16; ++i) { sv[i] = __uint_as_float(__float_as_uint(bb[i]) & ~255u); mxv = fmaxf(mxv, sv[i]); }
#pragma unroll
        for (int i = 0; i < 16; ++i) { sv[i] = __expf(sv[i] - mxv); sum += sv[i]; }
        const float inv = 1.f / sum;
        int* idx = (int*)(p.ws + OFF_IDX) + (size_t)(t0 + tok) * 128 + hd * 16; float* gw = (float*)(p.ws + OFF_GW) + (size_t)(t0 + tok) * 128 + hd * 16;
#pragma unroll
        for (int i = 0; i < 16; ++i) {
            const unsigned code = __float_as_uint(bb[i]) & 255u;
            const unsigned e1 = __float_as_uint(lst[(tok * 2) * 16 + (code >> 4)]) & 127u, e2 = __float_as_uint(lst[(tok * 2 + 1) * 16 + (code & 15u)]) & 127u;
            idx[i] = (int)(e1 * 128u + e2); gw[i] = sv[i] * inv;
        }
    }
    __syncthreads();
}
DI void select_tail(const Params& p, const Ctx& c, int t0, int hd) {
    LAS float* sc = (LAS float*)c.lds; LAS float* lst = sc + 128 * SEL_LD;
    if (c.tid < 256) {
        const int tok = c.tid >> 1, hf = c.tid & 1;
        float a[16];
#pragma unroll
        for (int i = 0; i < 16; ++i) a[i] = -__builtin_inff();
        const LAS float* row = sc + tok * SEL_LD + hf * 128;
#pragma unroll 4
        for (int n4 = 0; n4 < 32; ++n4) {
            const f32x4 v = *(const LAS f32x4*)(row + n4 * 4);
#pragma unroll
            for (int e = 0; e < 4; ++e) topk_insert(a, __uint_as_float((__float_as_uint(v[e]) & ~127u) | (unsigned)(n4 * 4 + e)));
        }
#pragma unroll
        for (int i = 0; i < 16; ++i) lst[(tok * 2 + hf) * 16 + i] = a[i];
    }
    __syncthreads();
    select_stage2<1>(p, c, SelMap{0, ((t0 >> 7) << 3) | hd, 0, 0, 0}, lst);
}
DI void select_naive(const Params& p, const Ctx& c) {
    const bf16_t* PQ = (const bf16_t*)(p.ws + OFF_PQ); const bf16_t* KEYS = (const bf16_t*)(p.ws + OFF_KEYS);
    LAS float* sc = (LAS float*)c.lds;
    for (int u = blockIdx.x; u < 128 * 8; u += gridDim.x) {
        const int hd = u & 7, t0 = (u >> 3) * 128;
        const int tok = c.tid >> 2, part = c.tid & 3, hf = part >> 1, n0 = (part & 1) * 64;
        const bf16_t* qrow = PQ + (size_t)hd * M * 256 + (size_t)(t0 + tok) * 256 + hf * 128;
        const bf16_t* kb = KEYS + (size_t)((hd * 2 + hf) * 128 + n0) * 128;
        for (int n = 0; n < 64; ++n) {
            float acc = 0.f;
#pragma unroll
            for (int d8 = 0; d8 < 16; ++d8) {
                const u32x4 a = *(const u32x4*)(qrow + d8 * 8), b = *(const u32x4*)(kb + (size_t)n * 128 + d8 * 8);
#pragma unroll
                for (int e = 0; e < 4; ++e) acc += bflo(a[e]) * bflo(b[e]) + bfhi(a[e]) * bfhi(b[e]);
            }
            sc[tok * SEL_LD + hf * 128 + n0 + n] = acc;
        }
        __syncthreads();
        select_tail(p, c, t0, hd);
    }
}


DI void select_batch(const Params& p, const Ctx& c, const SelMap mp) {
    const bf16_t* PQ = (const bf16_t*)(p.ws + OFF_PQ); const bf16_t* KEYS = (const bf16_t*)(p.ws + OFF_KEYS);
    LAS float* lst_all = (LAS float*)c.lds;
    const int lane = c.lane, r = lane & 31, h = lane >> 5, w = c.wave, tb = w & 3, hf = w >> 2;
#pragma unroll
    for (int q = 0; q < 4; ++q) {
        int t0, hd; sel_decode(mp, q, t0, hd);
        LAS float* lst = lst_all + q * 4096;
        const bf16_t* qrow = PQ + (size_t)hd * M * 256 + (size_t)(t0 + tb * 32 + r) * 256 + hf * 128 + h * 8;
        const bf16_t* kbase = KEYS + (size_t)((hd * 2 + hf) * 128 + r) * 128 + h * 8;
        bf16x8 qf[8];
#pragma unroll
        for (int st = 0; st < 8; ++st) qf[st] = *(const bf16x8*)(qrow + st * 16);
        float a[16];
#pragma unroll
        for (int i = 0; i < 16; ++i) a[i] = -__builtin_inff();
#pragma unroll
        for (int kb = 0; kb < 4; ++kb) {
            f32x16 sc;
#pragma unroll
            for (int i = 0; i < 16; ++i) sc[i] = 0.f;
#pragma unroll
            for (int st = 0; st < 8; ++st) sc = MFMA32(*(const bf16x8*)(kbase + (size_t)kb * 32 * 128 + st * 16), qf[st], sc);
#pragma unroll
            for (int i = 0; i < 16; ++i) topk_insert(a, __uint_as_float((__float_as_uint(sc[i]) & ~127u) | (unsigned)(kb * 32 + (i & 3) + 8 * (i >> 2) + 4 * h)));
        }
        float bq[16];
#pragma unroll
        for (int i = 0; i < 16; ++i) bq[i] = __shfl_xor(a[i], 32);
#pragma unroll
        for (int i = 0; i < 16; ++i) topk_insert(a, bq[i]);
        if (h == 0) {
#pragma unroll
            for (int i = 0; i < 16; ++i) lst[((tb * 32 + r) * 2 + hf) * 16 + i] = a[i];
        }
    }
    __syncthreads();
    select_stage2<4>(p, c, mp, lst_all);
}
DI void select_fast(const Params& p, const Ctx& c) {
    for (int u0 = blockIdx.x; u0 < 128 * 8; u0 += 4 * gridDim.x) select_batch(p, c, SelMap{0, u0, (int)gridDim.x, 0, 0});
}
DI void select_own_tiles(const Params& p, const Ctx& c) {
    pg8::StaticOrder S; S.init(M, 2048, (int)gridDim.x, (int)blockIdx.x);
    asm volatile("s_waitcnt vmcnt(0)" ::: "memory");
    __syncthreads();
    if (c.tid == 0) { __builtin_amdgcn_fence(__ATOMIC_ACQUIRE, "agent"); asm volatile("s_waitcnt vmcnt(0)" ::: "memory"); }
    __syncthreads();
    for (int i = 0;; i += 2) {
        pg8::Unit u0, u1;
        if (!S.next(i, u0)) break;
        if (!S.next(i + 1, u1)) u1 = u0;
        select_batch(p, c, SelMap{1, u0.pm, u0.pn, u1.pm, u1.pn});
    }
}
#ifndef FAST_SEL
#define FAST_SEL 1
#endif

DI void phase_gather(const Params& p, const Ctx& c, float* dst, int rowmask = -1) {
    const bf16_t* H2 = (const bf16_t*)(p.ws + OFF_H); const unsigned char* U = p.ws + OFF_U16; const unsigned char* V = p.ws + OFF_V16;
    const int* IDX = (const int*)(p.ws + OFF_IDX); const float* GW = (const float*)(p.ws + OFF_GW); const float* mod = (const float*)(p.ws + OFF_MOD);
    constexpr int G = 8, GV = 16;
    const int lane = c.lane;
    unsigned* tokctr = (unsigned*)(p.ws + OFF_CTL) + 700;
    constexpr int NSTATIC = 6;
    LAS int* park = (LAS int*)(c.lds + c.wave * 20480);
    for (int it = 0;; ++it) {
        int m, slot; bool doU, doV;
        if (it < NSTATIC) { slot = it; m = c.gw + it * c.ngw; doU = true; doV = false; }
        else if (it < 2 * NSTATIC) { slot = it - NSTATIC; m = c.gw + slot * c.ngw; doU = false; doV = true; }
        else { unsigned t = 0; if (lane == 0) t = __hip_atomic_fetch_add(tokctr, 1u, __ATOMIC_RELAXED, __HIP_MEMORY_SCOPE_AGENT); m = NSTATIC * c.ngw + (int)__builtin_amdgcn_readfirstlane(t); if (m >= M) break; slot = 0; doU = true; doV = true; }
        if (m >= M) continue;
        const int b = m / SEQ;
        LAS int* ps = park + slot * 256;
        int ia = 0, ib = 0; float wa = 0.f, wb = 0.f;
        if (doU) {
        f32x2 hf[16];
#pragma unroll
        for (int i = 0; i < 4; ++i) { const u32x4 a = *(const u32x4*)(H2 + (size_t)m * D + lane * 32 + i * 8);
#pragma unroll
            for (int q = 0; q < 4; ++q) hf[4 * i + q] = (f32x2){bflo(a[q]), bfhi(a[q])}; }
        ia = IDX[(size_t)m * 128 + lane]; ib = IDX[(size_t)m * 128 + 64 + lane];
        const float ga = GW[(size_t)m * 128 + lane], gb = GW[(size_t)m * 128 + 64 + lane];
#pragma unroll 1
        for (int k0 = 0; k0 < 128; k0 += G) {
            u32x4 ua[G]; u32x2 ub[G];
#pragma unroll
            for (int g = 0; g < G; ++g) {
                const int e = __builtin_amdgcn_readlane(k0 < 64 ? ia : ib, (k0 + g) & 63) & rowmask;
                const unsigned char* ur = U + (size_t)e * 1536;
                ua[g] = *(const u32x4*)(ur + (unsigned)lane * 16u); ub[g] = *(const u32x2*)(ur + 1024u + (unsigned)lane * 8u);
            }
            float d[G];
#pragma unroll
            for (int g = 0; g < G; ++g) {
                const f32x32v f = __builtin_amdgcn_cvt_scalef32_pk32_f32_fp6((u32x6){ua[g][0], ua[g][1], ua[g][2], ua[g][3], ub[g][0], ub[g][1]}, 1.0f);
                f32x2 d2 = {0.f, 0.f};
#pragma unroll
                for (int i = 0; i < 16; ++i) d2 = (f32x2){f[2 * i], f[2 * i + 1]} * hf[i] + d2;
                d[g] = d2.x + d2.y;
            }
            { const bool u5 = lane & 32, u4 = lane & 16, u3 = lane & 8;
              float r4[4];
#pragma unroll
              for (int i = 0; i < 4; ++i) { const float send = u5 ? d[i] : d[4 + i], keep = u5 ? d[4 + i] : d[i]; r4[i] = keep + __shfl_xor(send, 32); }
              float r2[2];
#pragma unroll
              for (int i = 0; i < 2; ++i) { const float send = u4 ? r4[i] : r4[2 + i], keep = u4 ? r4[2 + i] : r4[i]; r2[i] = keep + __shfl_xor(send, 16); }
              const float send = u3 ? r2[0] : r2[1], keep = u3 ? r2[1] : r2[0];
              float r1 = keep + __shfl_xor(send, 8);
              r1 += __shfl_xor(r1, 4); r1 += __shfl_xor(r1, 2); r1 += __shfl_xor(r1, 1);
              const float act = gelu_tanh(r1 * (1.f / U8_SCALE)) * (1.f / V8_SCALE);
              const int gsel = lane - (k0 & 63);
              const int src = ((gsel & 4) << 3) | ((gsel & 2) << 3) | ((gsel & 1) << 3);
              const float got = __shfl(act, src & 63);
              if (gsel >= 0 && gsel < G) { if (k0 < 64) wa = got * ga; else wb = got * gb; }
            }
        }
        ps[lane] = ia; ps[64 + lane] = ib; ps[128 + lane] = __builtin_bit_cast(int, wa); ps[192 + lane] = __builtin_bit_cast(int, wb);
        }
        if (!doV) continue;
        if (!doU) { ia = ps[lane]; ib = ps[64 + lane]; wa = __builtin_bit_cast(float, ps[128 + lane]); wb = __builtin_bit_cast(float, ps[192 + lane]); }
        f32x2 acc[16];
#pragma unroll
        for (int i = 0; i < 16; ++i) acc[i] = (f32x2){0.f, 0.f};
#define VB_ISSUE(P, K0) do { _Pragma("unroll") for (int g = 0; g < 8; ++g) { \
            const int e = __builtin_amdgcn_readlane((K0) < 64 ? ia : ib, ((K0) + g) & 63) & rowmask; \
            P##w[g] = __builtin_bit_cast(float, __builtin_amdgcn_readlane(__builtin_bit_cast(int, (K0) < 64 ? wa : wb), ((K0) + g) & 63)); \
            const unsigned char* vr = V + (size_t)e * 1536; \
            P##a[g] = *(const u32x4*)(vr + (unsigned)lane * 16u); P##b[g] = *(const u32x2*)(vr + 1024u + (unsigned)lane * 8u); } } while (0)
#define VB_COMPUTE(P) do { _Pragma("unroll") for (int g = 0; g < 8; ++g) { const f32x2 w2 = {P##w[g], P##w[g]}; \
            const f32x32v f = __builtin_amdgcn_cvt_scalef32_pk32_f32_fp6((u32x6){P##a[g][0], P##a[g][1], P##a[g][2], P##a[g][3], P##b[g][0], P##b[g][1]}, 1.0f); \
            _Pragma("unroll") for (int i = 0; i < 16; ++i) acc[i] = (f32x2){f[2 * i], f[2 * i + 1]} * w2 + acc[i]; } } while (0)
        {
            u32x4 A_a[8], B_a[8]; u32x2 A_b[8], B_b[8]; float A_w[8], B_w[8];
            VB_ISSUE(A_, 0);
#pragma unroll 1
            for (int k0 = 0; k0 < 128; k0 += 16) {
                VB_ISSUE(B_, k0 + 8);
                VB_COMPUTE(A_);
                if (k0 + 16 < 128) VB_ISSUE(A_, k0 + 16);
                VB_COMPUTE(B_);
            }
        }
#undef VB_ISSUE
#undef VB_COMPUTE
        const float* orow = p.out + (size_t)m * D + lane * 32; float* drow = dst + (size_t)m * D + lane * 32; const float* gt2 = mod + b * 6 * D + 5 * D + lane * 32; const float* fg = p.fng + lane * 32;
        float ss = 0.f; f32x4 xv[8];
#pragma unroll
        for (int i = 0; i < 8; ++i) {
            const f32x4 xa = *(const f32x4*)(orow + 4 * i), ta = *(const f32x4*)(gt2 + 4 * i);
            const f32x4 pe = {acc[2 * i].x, acc[2 * i].y, acc[2 * i + 1].x, acc[2 * i + 1].y};
            const f32x4 v = xa + DBG_BETA * ta * pe; xv[i] = v; ss += (v[0] * v[0] + v[1] * v[1]) + (v[2] * v[2] + v[3] * v[3]);
        }
        const float rstd = rsqrtf(wave_sum(ss) * (1.f / D) + EPS);
#pragma unroll
        for (int i = 0; i < 8; ++i) *(f32x4*)(drow + 4 * i) = xv[i] * rstd * *(const f32x4*)(fg + 4 * i);
    }
}


DI void phase_gather_sorted(const Params& p, const Ctx& c) {
    const bf16_t* H2 = (const bf16_t*)(p.ws + OFF_H); const unsigned char* U = p.ws + OFF_U16; const unsigned char* V = p.ws + OFF_V16;
    const int* IDX = (const int*)(p.ws + OFF_IDX); const float* GW = (const float*)(p.ws + OFF_GW); const float* mod = (const float*)(p.ws + OFF_MOD);
    const int lane = c.lane;
    LAS unsigned char* wl = c.lds + c.wave * 20480;
    constexpr int RSH = 12;
    const bool u5 = lane & 32, u4 = lane & 16, u3 = lane & 8;
#pragma unroll 1
    for (int grp = 0; grp < 2; ++grp) {
#pragma unroll 1
        for (int t = 0; t < 4; ++t) {
            const int m = c.gw + (grp * 4 + t) * c.ngw;
            if (m >= M) continue;
            const int ia = IDX[(size_t)m * 128 + lane], ib = IDX[(size_t)m * 128 + 64 + lane];
            const float ga = GW[(size_t)m * 128 + lane], gb = GW[(size_t)m * 128 + 64 + lane];
            const int ra = ia >> RSH, rb = ib >> RSH;
            int off = 0, posA = 0, posB = 0;
#pragma unroll
            for (int r = 0; r < 4; ++r) {
                const unsigned long long mA = __ballot(ra == r), mB = __ballot(rb == r);
                const int cA = __builtin_popcountll(mA), cB = __builtin_popcountll(mB);
                const int rkA = __builtin_amdgcn_mbcnt_hi((unsigned)(mA >> 32), __builtin_amdgcn_mbcnt_lo((unsigned)mA, 0u));
                const int rkB = __builtin_amdgcn_mbcnt_hi((unsigned)(mB >> 32), __builtin_amdgcn_mbcnt_lo((unsigned)mB, 0u));
                posA = (ra == r) ? off + rkA : posA; posB = (rb == r) ? off + cA + rkB : posB; off += cA + cB;
            }
            LAS int* sE = (LAS int*)(wl + t * 1024); LAS float* sW = (LAS float*)(wl + t * 1024 + 512);
            sE[posA] = ia; sE[posB] = ib; sW[posA] = ga; sW[posB] = gb;
            LAS u32x4* hrow = (LAS u32x4*)(wl + 4096 + t * 4096 + lane * 64);
#pragma unroll
            for (int i = 0; i < 4; ++i) hrow[i] = *(const u32x4*)(H2 + (size_t)m * D + lane * 32 + i * 8);
        }
        asm volatile("s_waitcnt lgkmcnt(0)" ::: "memory");
#pragma unroll 1
        for (int vi = 0; vi < 16; ++vi) {
            {
                const int r = vi >> 2, t = vi & 3;
                const int m = c.gw + (grp * 4 + t) * c.ngw;
                if (m >= M) continue;
                LAS int* sE = (LAS int*)(wl + t * 1024); LAS float* sW = (LAS float*)(wl + t * 1024 + 512);
                const int eLo = sE[lane], eHi = sE[64 + lane];
                const unsigned long long mLo = __ballot((eLo >> RSH) == r), mHi = __ballot((eHi >> RSH) == r);
                if (!(mLo | mHi)) continue;
                const int s0 = mLo ? __builtin_ctzll(mLo) : 64 + __builtin_ctzll(mHi);
                const int e1 = s0 + __builtin_popcountll(mLo) + __builtin_popcountll(mHi);
                float wLo = sW[lane], wHi = sW[64 + lane];
                f32x2 hf[16];
                { const LAS u32x4* hrow = (const LAS u32x4*)(wl + 4096 + t * 4096 + lane * 64);
#pragma unroll
                  for (int i = 0; i < 4; ++i) { const u32x4 a = hrow[i];
#pragma unroll
                    for (int q = 0; q < 4; ++q) hf[4 * i + q] = (f32x2){bflo(a[q]), bfhi(a[q])}; } }
#pragma unroll 1
                for (int j0 = s0; j0 < e1; j0 += 8) {
                    u32x4 ua[8]; u32x2 ub[8];
#pragma unroll
                    for (int g = 0; g < 8; ++g) {
                        const int pos = j0 + g;
                        ua[g] = (u32x4){0u, 0u, 0u, 0u}; ub[g] = (u32x2){0u, 0u};
                        if (pos < e1) {
                            const int e = __builtin_amdgcn_readlane(pos < 64 ? eLo : eHi, pos & 63);
                            const unsigned char* ur = U + (size_t)e * 1536;
                            ua[g] = *(const u32x4*)(ur + (unsigned)lane * 16u); ub[g] = *(const u32x2*)(ur + 1024u + (unsigned)lane * 8u);
                        }
                    }
                    float d[8];
#pragma unroll
                    for (int g = 0; g < 8; ++g) {
                        d[g] = 0.f;
                        if (j0 + g < e1) {
                            const f32x32v f = __builtin_amdgcn_cvt_scalef32_pk32_f32_fp6((u32x6){ua[g][0], ua[g][1], ua[g][2], ua[g][3], ub[g][0], ub[g][1]}, 1.0f);
                            f32x2 d2 = {0.f, 0.f};
#pragma unroll
                            for (int i = 0; i < 16; ++i) d2 = (f32x2){f[2 * i], f[2 * i + 1]} * hf[i] + d2;
                            d[g] = d2.x + d2.y;
                        }
                    }
                    float r4[4];
#pragma unroll
                    for (int i = 0; i < 4; ++i) { const float send = u5 ? d[i] : d[4 + i], keep = u5 ? d[4 + i] : d[i]; r4[i] = keep + __shfl_xor(send, 32); }
                    float r2[2];
#pragma unroll
                    for (int i = 0; i < 2; ++i) { const float send = u4 ? r4[i] : r4[2 + i], keep = u4 ? r4[2 + i] : r4[i]; r2[i] = keep + __shfl_xor(send, 16); }
                    const float send = u3 ? r2[0] : r2[1], keep = u3 ? r2[1] : r2[0];
                    float r1 = keep + __shfl_xor(send, 8);
                    r1 += __shfl_xor(r1, 4); r1 += __shfl_xor(r1, 2); r1 += __shfl_xor(r1, 1);
                    const float act = gelu_tanh(r1 * (1.f / U8_SCALE)) * (1.f / V8_SCALE);
                    const bool inLo = (lane >= j0) && (lane < j0 + 8);
                    const int gsel = inLo ? lane - j0 : lane + 64 - j0;
                    const int src = ((gsel & 4) << 3) | ((gsel & 2) << 3) | ((gsel & 1) << 3);
                    const float got = __shfl(act, src & 63);
                    if (gsel >= 0 && gsel < 8 && j0 + gsel < e1) { if (inLo) wLo = got * wLo; else wHi = got * wHi; }
                }
                sW[lane] = wLo; sW[64 + lane] = wHi;
            }
        }
        asm volatile("s_waitcnt lgkmcnt(0)" ::: "memory");
#pragma unroll 1
        for (int r = 0; r < 4; ++r) {
#pragma unroll 1
            for (int t = 0; t < 4; ++t) {
                const int m = c.gw + (grp * 4 + t) * c.ngw;
                if (m >= M) continue;
                LAS int* sE = (LAS int*)(wl + t * 1024); LAS float* sW = (LAS float*)(wl + t * 1024 + 512);
                LAS u32x4* pk = (LAS u32x4*)(wl + 4096 + t * 4096 + lane * 64);
                const int eLo = sE[lane], eHi = sE[64 + lane]; const float wLo = sW[lane], wHi = sW[64 + lane];
                const unsigned long long mLo = __ballot((eLo >> RSH) == r), mHi = __ballot((eHi >> RSH) == r);
                const int s0 = mLo ? __builtin_ctzll(mLo) : (mHi ? 64 + __builtin_ctzll(mHi) : 0);
                const int e1 = s0 + __builtin_popcountll(mLo) + __builtin_popcountll(mHi);
                f32x2 acc[16];
                if (r == 0) {
#pragma unroll
                    for (int i = 0; i < 16; ++i) acc[i] = (f32x2){0.f, 0.f};
                } else {
#pragma unroll
                    for (int i = 0; i < 4; ++i) { const u32x4 a = pk[i];
#pragma unroll
                        for (int q = 0; q < 4; ++q) acc[4 * i + q] = (f32x2){bflo(a[q]), bfhi(a[q])}; }
                }
#define SV_ISSUE(P, J0) do { _Pragma("unroll") for (int g = 0; g < 8; ++g) { const int pos = (J0) + g; P##w[g] = 0.f; P##a[g] = (u32x4){0u, 0u, 0u, 0u}; P##b[g] = (u32x2){0u, 0u}; \
                        if (pos < e1) { const int e = __builtin_amdgcn_readlane(pos < 64 ? eLo : eHi, pos & 63); \
                            P##w[g] = __builtin_bit_cast(float, __builtin_amdgcn_readlane(__builtin_bit_cast(int, pos < 64 ? wLo : wHi), pos & 63)); \
                            const unsigned char* vr = V + (size_t)e * 1536; P##a[g] = *(const u32x4*)(vr + (unsigned)lane * 16u); P##b[g] = *(const u32x2*)(vr + 1024u + (unsigned)lane * 8u); } } } while (0)
#define SV_COMPUTE(P, J0) do { _Pragma("unroll") for (int g = 0; g < 8; ++g) if ((J0) + g < e1) { const f32x2 w2 = {P##w[g], P##w[g]}; \
                        const f32x32v f = __builtin_amdgcn_cvt_scalef32_pk32_f32_fp6((u32x6){P##a[g][0], P##a[g][1], P##a[g][2], P##a[g][3], P##b[g][0], P##b[g][1]}, 1.0f); \
                        _Pragma("unroll") for (int i = 0; i < 16; ++i) acc[i] = (f32x2){f[2 * i], f[2 * i + 1]} * w2 + acc[i]; } } while (0)
                if (s0 < e1) {
                    u32x4 A_a[8], B_a[8]; u32x2 A_b[8], B_b[8]; float A_w[8], B_w[8];
                    SV_ISSUE(A_, s0);
#pragma unroll 1
                    for (int j0 = s0; j0 < e1; j0 += 16) {
                        if (j0 + 8 < e1) SV_ISSUE(B_, j0 + 8);
                        SV_COMPUTE(A_, j0);
                        if (j0 + 16 < e1) SV_ISSUE(A_, j0 + 16);
                        if (j0 + 8 < e1) SV_COMPUTE(B_, j0 + 8);
                    }
                }
#undef SV_ISSUE
#undef SV_COMPUTE
                if (r < 3) {
#pragma unroll
                    for (int i = 0; i < 4; ++i) pk[i] = (u32x4){pk2(acc[4 * i].x, acc[4 * i].y), pk2(acc[4 * i + 1].x, acc[4 * i + 1].y), pk2(acc[4 * i + 2].x, acc[4 * i + 2].y), pk2(acc[4 * i + 3].x, acc[4 * i + 3].y)};
                } else {
                    const int b = m / SEQ;
                    float* orow = p.out + (size_t)m * D + lane * 32; const float* gt2 = mod + b * 6 * D + 5 * D + lane * 32; const float* fg = p.fng + lane * 32;
                    float ss = 0.f; f32x4 xv[8];
#pragma unroll
                    for (int i = 0; i < 8; ++i) {
                        const f32x4 xa = *(const f32x4*)(orow + 4 * i), ta = *(const f32x4*)(gt2 + 4 * i);
                        const f32x4 pe = {acc[2 * i].x, acc[2 * i].y, acc[2 * i + 1].x, acc[2 * i + 1].y};
                        const f32x4 v = xa + DBG_BETA * ta * pe; xv[i] = v; ss += (v[0] * v[0] + v[1] * v[1]) + (v[2] * v[2] + v[3] * v[3]);
                    }
                    const float rstd = rsqrtf(wave_sum(ss) * (1.f / D) + EPS);
#pragma unroll
                    for (int i = 0; i < 8; ++i) *(f32x4*)(orow + 4 * i) = xv[i] * rstd * *(const f32x4*)(fg + 4 * i);
                }
            }
        }
        asm volatile("s_waitcnt lgkmcnt(0)" ::: "memory");
    }
}
#ifndef GATHER_SORTED
#define GATHER_SORTED 1
#endif

struct XcdBarrier; DI void xcd_barrier(const XcdBarrier& b, int wave_s);
DI int rl2r(int a, int b, int k) { const int va = __builtin_amdgcn_readlane(a, k & 63), vb = __builtin_amdgcn_readlane(b, k & 63); return k < 64 ? va : vb; }
DI void phase_gather_rounds(const Params& p, const Ctx& c, const XcdBarrier& xbar) {
    const bf16_t* H2 = (const bf16_t*)(p.ws + OFF_H); const unsigned char* U = p.ws + OFF_U16; const unsigned char* V = p.ws + OFF_V16;
    const int* IDX = (const int*)(p.ws + OFF_IDX); const float* GW = (const float*)(p.ws + OFF_GW); const float* mod = (const float*)(p.ws + OFF_MOD);
    const int lane = c.lane;
    LAS unsigned char* wl = c.lds + c.wave * 20480;
    const bool u5 = lane & 32, u4 = lane & 16, u3 = lane & 8;
    constexpr int G = 8;
#pragma unroll 1
    for (int pass = 0; pass < 2; ++pass) {
#pragma unroll
        for (int t = 0; t < 4; ++t) {
            const int m = c.gw + (pass * 4 + t) * c.ngw;
            LAS unsigned char* ts = wl + t * 5120;
            if (m < M) {
#pragma unroll
                for (int i = 0; i < 4; ++i) *(LAS u32x4*)(ts + lane * 64 + i * 16) = *(const u32x4*)(H2 + (size_t)m * D + lane * 32 + i * 8);
                *(LAS int*)(ts + 4096 + lane * 4) = IDX[(size_t)m * 128 + lane]; *(LAS int*)(ts + 4096 + 256 + lane * 4) = IDX[(size_t)m * 128 + 64 + lane];
                *(LAS float*)(ts + 4608 + lane * 4) = GW[(size_t)m * 128 + lane]; *(LAS float*)(ts + 4608 + 256 + lane * 4) = GW[(size_t)m * 128 + 64 + lane];
            }
        }
        asm volatile("s_waitcnt vmcnt(0) lgkmcnt(0)" ::: "memory");
#pragma unroll 1
        for (int r = 0; r < 8; ++r) {
#pragma unroll 1
            for (int t = 0; t < 4; ++t) {
                if (c.gw + (pass * 4 + t) * c.ngw >= M) continue;
                LAS unsigned char* ts = wl + t * 5120;
                const int ia = *(LAS int*)(ts + 4096 + lane * 4), ib = *(LAS int*)(ts + 4096 + 256 + lane * 4);
                unsigned long long ma = __ballot((ia >> 11) == r), mb = __ballot((ib >> 11) == r);
                if (!(ma | mb)) continue;
                f32x2 hf[16];
#pragma unroll
                for (int i = 0; i < 4; ++i) { const u32x4 a = *(LAS u32x4*)(ts + lane * 64 + i * 16);
#pragma unroll
                    for (int q = 0; q < 4; ++q) hf[4 * i + q] = (f32x2){bflo(a[q]), bfhi(a[q])}; }
                float wa = 0.f, wb = 0.f; const unsigned long long ma0 = ma, mb0 = mb;
                while (ma | mb) {
                    u32x4 ua[G]; u32x2 ub[G]; int kk[G]; int n = 0;
#pragma unroll
                    for (int g = 0; g < G; ++g) {
                        int k = (g == 0) ? 0 : kk[g - 1];
                        if (ma) { k = __builtin_ctzll(ma); ma &= ma - 1; ++n; } else if (mb) { k = 64 + __builtin_ctzll(mb); mb &= mb - 1; ++n; }
                        kk[g] = k;
                        const int e = rl2r(ia, ib, k);
                        const unsigned char* ur = U + (size_t)e * 1536;
                        ua[g] = *(const u32x4*)(ur + (unsigned)lane * 16u); ub[g] = *(const u32x2*)(ur + 1024u + (unsigned)lane * 8u);
                    }
                    float d[G];
#pragma unroll
                    for (int g = 0; g < G; ++g) {
                        d[g] = 0.f;
                        if (g < n) {
                            const f32x32v f = __builtin_amdgcn_cvt_scalef32_pk32_f32_fp6((u32x6){ua[g][0], ua[g][1], ua[g][2], ua[g][3], ub[g][0], ub[g][1]}, 1.0f);
                            f32x2 d0 = {0.f, 0.f}, d1 = {0.f, 0.f};
#pragma unroll
                            for (int i = 0; i < 8; ++i) { d0 = (f32x2){f[4 * i], f[4 * i + 1]} * hf[2 * i] + d0; d1 = (f32x2){f[4 * i + 2], f[4 * i + 3]} * hf[2 * i + 1] + d1; }
                            d[g] = (d0.x + d0.y) + (d1.x + d1.y);
                        }
                    }
                    float r4[4];
#pragma unroll
                    for (int i = 0; i < 4; ++i) { const float send = u5 ? d[i] : d[4 + i], keep = u5 ? d[4 + i] : d[i]; r4[i] = keep + __shfl_xor(send, 32); }
                    float r2[2];
#pragma unroll
                    for (int i = 0; i < 2; ++i) { const float send = u4 ? r4[i] : r4[2 + i], keep = u4 ? r4[2 + i] : r4[i]; r2[i] = keep + __shfl_xor(send, 16); }
                    const float send = u3 ? r2[0] : r2[1], keep = u3 ? r2[1] : r2[0];
                    float r1 = keep + __shfl_xor(send, 8);
                    r1 += __shfl_xor(r1, 4); r1 += __shfl_xor(r1, 2); r1 += __shfl_xor(r1, 1);
                    const float act = gelu_tanh(r1 * (1.f / U8_SCALE)) * (1.f / V8_SCALE);
#pragma unroll
                    for (int g = 0; g < G; ++g) if (g < n) {
                        const float av = __builtin_bit_cast(float, __builtin_amdgcn_readlane(__builtin_bit_cast(int, act), ((g & 4) << 3) | ((g & 2) << 3) | ((g & 1) << 3)));
                        const int k = kk[g];
                        if (k < 64) { if (lane == k) wa = av; } else { if (lane == k - 64) wb = av; }
                    }
                }
                if ((ma0 >> lane) & 1ull) { LAS float* gp = (LAS float*)(ts + 4608 + lane * 4); *gp = *gp * wa; }
                if ((mb0 >> lane) & 1ull) { LAS float* gp = (LAS float*)(ts + 4608 + 256 + lane * 4); *gp = *gp * wb; }
            }
            if (DBG_ROUND_BAR) xcd_barrier(xbar, c.wave);
        }
        asm volatile("s_waitcnt lgkmcnt(0)" ::: "memory");
#pragma unroll 1
        for (int t = 0; t < 4; ++t) {
            const int m = c.gw + (pass * 4 + t) * c.ngw;
            if (m >= M) continue;
            const int b = m / SEQ;
            LAS unsigned char* ts = wl + t * 5120;
            const int ia = *(LAS int*)(ts + 4096 + lane * 4), ib = *(LAS int*)(ts + 4096 + 256 + lane * 4);
            const float wa = *(LAS float*)(ts + 4608 + lane * 4), wb = *(LAS float*)(ts + 4608 + 256 + lane * 4);
            f32x2 acc[16];
#pragma unroll
            for (int i = 0; i < 16; ++i) acc[i] = (f32x2){0.f, 0.f};
#pragma unroll 1
            for (int k0 = 0; k0 < 128; k0 += G) {
                u32x4 va[G]; u32x2 vb[G]; float wk[G];
#pragma unroll
                for (int g = 0; g < G; ++g) {
                    const int e = __builtin_amdgcn_readlane(k0 < 64 ? ia : ib, (k0 + g) & 63);
                    wk[g] = __builtin_bit_cast(float, __builtin_amdgcn_readlane(__builtin_bit_cast(int, k0 < 64 ? wa : wb), (k0 + g) & 63));
                    const unsigned char* vr = V + (size_t)e * 1536;
                    va[g] = *(const u32x4*)(vr + (unsigned)lane * 16u); vb[g] = *(const u32x2*)(vr + 1024u + (unsigned)lane * 8u);
                }
#pragma unroll
                for (int g = 0; g < G; ++g) { const f32x2 w2 = {wk[g], wk[g]};
                    const f32x32v f = __builtin_amdgcn_cvt_scalef32_pk32_f32_fp6((u32x6){va[g][0], va[g][1], va[g][2], va[g][3], vb[g][0], vb[g][1]}, 1.0f);
#pragma unroll
                    for (int i = 0; i < 16; ++i) acc[i] = (f32x2){f[2 * i], f[2 * i + 1]} * w2 + acc[i]; }
            }
            float* orow = p.out + (size_t)m * D + lane * 32; const float* gt2 = mod + b * 6 * D + 5 * D + lane * 32; const float* fg = p.fng + lane * 32;
            float ss = 0.f; f32x4 xv[8];
#pragma unroll
            for (int i = 0; i < 8; ++i) {
                const f32x4 xa = *(const f32x4*)(orow + 4 * i), ta = *(const f32x4*)(gt2 + 4 * i);
                const f32x4 pe = {acc[2 * i].x, acc[2 * i].y, acc[2 * i + 1].x, acc[2 * i + 1].y};
                const f32x4 v = xa + DBG_BETA * ta * pe; xv[i] = v; ss += (v[0] * v[0] + v[1] * v[1]) + (v[2] * v[2] + v[3] * v[3]);
            }
            const float rstd = rsqrtf(wave_sum(ss) * (1.f / D) + EPS);
#pragma unroll
            for (int i = 0; i < 8; ++i) *(f32x4*)(orow + 4 * i) = xv[i] * rstd * *(const f32x4*)(fg + 4 * i);
        }
    }
}
#ifndef GATHER_ROUNDS
#define GATHER_ROUNDS 0
#endif

constexpr size_t OFF_WK = OFF_GB + (size_t)32 * 1024 * 1024;
constexpr size_t OFF_SSQ = OFF_GB + (size_t)48 * 1024 * 1024;
constexpr int NPU = 2, NPV = 2;
struct PairPick { int k; bool valid; };
DI PairPick pick_next(unsigned long long& ma, unsigned long long& mb, int prev) {
    PairPick r;
    if (ma) { r.k = __builtin_ctzll(ma); ma &= ma - 1; r.valid = true; }
    else if (mb) { r.k = 64 + __builtin_ctzll(mb); mb &= mb - 1; r.valid = true; }
    else { r.k = prev; r.valid = false; }
    return r;
}
DI int rl2(int a, int b, int k) { const int va = __builtin_amdgcn_readlane(a, k & 63), vb = __builtin_amdgcn_readlane(b, k & 63); return k < 64 ? va : vb; }
DI float rl2f(float a, float b, int k) { return __builtin_bit_cast(float, rl2(__builtin_bit_cast(int, a), __builtin_bit_cast(int, b), k)); }

DI void gather_u(const Params& p, const Ctx& c) {
    const bf16_t* H2 = (const bf16_t*)(p.ws + OFF_H); const unsigned char* U = p.ws + OFF_U16;
    const int* IDX = (const int*)(p.ws + OFF_IDX); const float* GW = (const float*)(p.ws + OFF_GW); float* WK = (float*)(p.ws + OFF_WK);
    const int x = blockIdx.x & 7, jb = blockIdx.x >> 3, nj = ((int)gridDim.x - x + 7) >> 3;
    const int wl = jb * NWAVES + c.wave, nwl = nj * NWAVES;
    constexpr int G = 4, SH = (NPU == 2) ? 10 : 11;
#pragma unroll 1
    for (int ps = 0; ps < NPU; ++ps) {
        const int part = x * NPU + ps;
#pragma unroll 1
        for (int m = wl; m < M; m += nwl) {
            const int ia = IDX[(size_t)m * 128 + c.lane], ib = IDX[(size_t)m * 128 + 64 + c.lane];
            unsigned long long ma = __ballot((ia >> SH) == part), mb = __ballot((ib >> SH) == part);
            if (!(ma | mb)) continue;
            const unsigned long long ma0 = ma, mb0 = mb;
            float hf[2][16];
#pragma unroll
            for (int j = 0; j < 2; ++j) { const u32x4 a = *(const u32x4*)(H2 + (size_t)m * D + j * 1024 + c.lane * 16), bq = *(const u32x4*)(H2 + (size_t)m * D + j * 1024 + c.lane * 16 + 8);
#pragma unroll
                for (int q = 0; q < 4; ++q) { hf[j][2 * q] = bflo(a[q]); hf[j][2 * q + 1] = bfhi(a[q]); hf[j][8 + 2 * q] = bflo(bq[q]); hf[j][8 + 2 * q + 1] = bfhi(bq[q]); } }
            const float ga = GW[(size_t)m * 128 + c.lane], gb = GW[(size_t)m * 128 + 64 + c.lane];
            float wa = 0.f, wb = 0.f;
            int prev = 0;
            while (ma | mb) {
                PairPick pk[G]; u32x4 uu[G][2];
#pragma unroll
                for (int g = 0; g < G; ++g) { pk[g] = pick_next(ma, mb, prev); prev = pk[g].k;
                    const int e = rl2(ia, ib, pk[g].k);
                    const unsigned char* ur = U + (size_t)e * D;
#pragma unroll
                    for (int j = 0; j < 2; ++j) uu[g][j] = *(const u32x4*)(ur + ((unsigned)c.lane * 16u + j * 1024u)); }
                float d[G];
#pragma unroll
                for (int g = 0; g < G; ++g) {
                    float d0 = 0.f, d1 = 0.f;
#pragma unroll
                    for (int j = 0; j < 2; ++j)
#pragma unroll
                        for (int q = 0; q < 4; ++q) { const f32x2 lo = __builtin_amdgcn_cvt_pk_f32_fp8((int)uu[g][j][q], false), hi = __builtin_amdgcn_cvt_pk_f32_fp8((int)uu[g][j][q], true);
                            d0 += lo.x * hf[j][4 * q] + hi.x * hf[j][4 * q + 2]; d1 += lo.y * hf[j][4 * q + 1] + hi.y * hf[j][4 * q + 3]; }
                    d[g] = d0 + d1;
                }
#pragma unroll
                for (int o = 1; o < 64; o <<= 1)
#pragma unroll
                    for (int g = 0; g < G; ++g) d[g] += __shfl_xor(d[g], o);
#pragma unroll
                for (int g = 0; g < G; ++g) if (pk[g].valid) {
                    const float a = gelu_tanh(d[g] * (1.f / U8_SCALE)) * (1.f / V8_SCALE); const int k = pk[g].k;
                    if (k < 64) { if (c.lane == k) wa = a * ga; } else { if (c.lane == k - 64) wb = a * gb; }
                }
            }
            if ((ma0 >> c.lane) & 1ull) WK[(size_t)m * 128 + c.lane] = wa;
            if ((mb0 >> c.lane) & 1ull) WK[(size_t)m * 128 + 64 + c.lane] = wb;
        }
    }
}

DI void gather_v(const Params& p, const Ctx& c) {
    const unsigned char* V = p.ws + OFF_V16;
    const int* IDX = (const int*)(p.ws + OFF_IDX); const float* WK = (const float*)(p.ws + OFF_WK); const float* mod = (const float*)(p.ws + OFF_MOD);
    float* SSQ = (float*)(p.ws + OFF_SSQ);
    const int x = blockIdx.x & 7, jb = blockIdx.x >> 3, nj = ((int)gridDim.x - x + 7) >> 3;
    const int wl = jb * NWAVES + c.wave, nwl = nj * NWAVES;
    const int q4 = c.lane >> 4, l16 = c.lane & 15;
    const unsigned voff = 256u * x + l16 * 16u;
    constexpr int SHV = (NPV == 2) ? 13 : 14;
#pragma unroll 1
    for (int ps = 0; ps < NPV; ++ps) {
#pragma unroll 1
        for (int m = wl; m < M; m += nwl) {
            const int b = m / SEQ;
            const int ia = IDX[(size_t)m * 128 + c.lane], ib = IDX[(size_t)m * 128 + 64 + c.lane];
            const float wa = WK[(size_t)m * 128 + c.lane], wb = WK[(size_t)m * 128 + 64 + c.lane];
            unsigned long long ma = __ballot((ia >> SHV) == ps), mb = __ballot((ib >> SHV) == ps);
            float acc[16];
#pragma unroll
            for (int i = 0; i < 16; ++i) acc[i] = 0.f;
            int prev = 0;
            while (ma | mb) {
                u32x4 vv[4]; float wv[4];
#pragma unroll
                for (int s4 = 0; s4 < 4; ++s4) {
                    int e = 0; float w = 0.f;
#pragma unroll
                    for (int g = 0; g < 4; ++g) { const PairPick pk = pick_next(ma, mb, prev); prev = pk.k;
                        const int eg = rl2(ia, ib, pk.k); const float wg = pk.valid ? rl2f(wa, wb, pk.k) : 0.f;
                        e = (q4 == g) ? eg : e; w = (q4 == g) ? wg : w; }
                    vv[s4] = *(const u32x4*)(V + (size_t)e * D + voff); wv[s4] = w;
                }
#pragma unroll
                for (int s4 = 0; s4 < 4; ++s4)
#pragma unroll
                    for (int q = 0; q < 4; ++q) { const f32x2 lo = __builtin_amdgcn_cvt_pk_f32_fp8((int)vv[s4][q], false), hi = __builtin_amdgcn_cvt_pk_f32_fp8((int)vv[s4][q], true);
                        acc[4 * q] += wv[s4] * lo.x; acc[4 * q + 1] += wv[s4] * lo.y; acc[4 * q + 2] += wv[s4] * hi.x; acc[4 * q + 3] += wv[s4] * hi.y; }
            }
#pragma unroll
            for (int i = 0; i < 16; ++i) { acc[i] += __shfl_xor(acc[i], 16); acc[i] += __shfl_xor(acc[i], 32); }
            f32x4 sel;
#pragma unroll
            for (int e = 0; e < 4; ++e) sel[e] = q4 == 0 ? acc[e] : (q4 == 1 ? acc[4 + e] : (q4 == 2 ? acc[8 + e] : acc[12 + e]));
            const int col = 256 * x + 16 * l16 + 4 * q4;
            float* op = p.out + (size_t)m * D + col;
            const f32x4 val = *(const f32x4*)op + DBG_BETA * *(const f32x4*)(mod + b * 6 * D + 5 * D + col) * sel;
            *(f32x4*)op = val;
            if (ps == NPV - 1) { const float ss = wave_sum(val[0] * val[0] + val[1] * val[1] + val[2] * val[2] + val[3] * val[3]); if (c.lane == 0) SSQ[(size_t)m * 8 + x] = ss; }
        }
    }
}
DI void gather_final(const Params& p, const Ctx& c) {
    const float* SSQ = (const float*)(p.ws + OFF_SSQ);
    for (int m = c.gw; m < M; m += c.ngw) {
        float s = (c.lane < 8) ? SSQ[(size_t)m * 8 + c.lane] : 0.f;
        s += __shfl_xor(s, 1); s += __shfl_xor(s, 2); s += __shfl_xor(s, 4);
        const float rstd = rsqrtf(__shfl(s, 0) * (1.f / D) + EPS);
        float* orow = p.out + (size_t)m * D;
#pragma unroll
        for (int j = 0; j < 8; ++j) { const int col = (j * 64 + c.lane) * 4; *(f32x4*)(orow + col) = *(const f32x4*)(orow + col) * rstd * *(const f32x4*)(p.fng + col); }
    }
}
#ifndef GATHER_L2
#define GATHER_L2 0
#endif

DI void phase_gather_v2(const Params& p, const Ctx& c) {
    const bf16_t* H2 = (const bf16_t*)(p.ws + OFF_H);
    const int* IDX = (const int*)(p.ws + OFF_IDX); const float* GW = (const float*)(p.ws + OFF_GW); const float* mod = (const float*)(p.ws + OFF_MOD);
    LAS float* hs = (LAS float*)c.lds; LAS float* wk = hs + 2048; LAS int* ek = (LAS int*)(wk + 128); LAS float* red = (LAS float*)(ek + 128);
    for (int m = blockIdx.x; m < M; m += gridDim.x) {
        const int b = m / SEQ;
        __syncthreads();
        for (int i = c.tid; i < 2048; i += NTHREADS) hs[i] = bf2f(H2[(size_t)m * D + i]);
        if (c.tid < 128) ek[c.tid] = IDX[(size_t)m * 128 + c.tid];
        __syncthreads();
        for (int k = c.wave; k < 128; k += NWAVES) {
            const float* ur = p.pu + (size_t)ek[k] * D;
            float d = 0.f;
            for (int i = 0; i < 8; ++i) { const int col = i * 256 + c.lane * 4; const f32x4 u = *(const f32x4*)(ur + col);
                d += u[0] * hs[col] + u[1] * hs[col + 1] + u[2] * hs[col + 2] + u[3] * hs[col + 3]; }
            d = wave_sum(d);
            if (c.lane == 0) wk[k] = gelu_tanh(d) * GW[(size_t)m * 128 + k];
        }
        __syncthreads();
        const int col = c.tid * 4;
        f32x4 acc = {0.f, 0.f, 0.f, 0.f};
        for (int k = 0; k < 128; ++k) { const f32x4 v = *(const f32x4*)(p.pv + (size_t)ek[k] * D + col); acc += v * wk[k]; }
        float* orow = p.out + (size_t)m * D;
        const f32x4 x2 = *(const f32x4*)(orow + col) + DBG_BETA * *(const f32x4*)(mod + b * 6 * D + 5 * D + col) * acc;
        float ss = wave_sum(x2[0] * x2[0] + x2[1] * x2[1] + x2[2] * x2[2] + x2[3] * x2[3]);
        if (c.lane == 0) red[c.wave] = ss;
        __syncthreads();
        float tot = 0.f;
        for (int w = 0; w < NWAVES; ++w) tot += red[w];
        const float rstd = rsqrtf(tot * (1.f / D) + EPS);
        *(f32x4*)(orow + col) = x2 * rstd * *(const f32x4*)(p.fng + col);
    }
}


#define XB_TMO      128
#define XB_XCNT(j)  (256  + 64 * (j))
#define XB_XSUB(j)  (1280 + 64 * (j))
#define XB_XGEN(j)  (2304 + 64 * (j))
#define XB_TOP      3328
#define XB_TOPGEN   3392
#define XCD_BAR_WORDS 3456
#define XB_SPIN_CAP (1u << 18)

__device__ __forceinline__ unsigned xb_ld(unsigned* p)              { return __hip_atomic_load(p, __ATOMIC_RELAXED, __HIP_MEMORY_SCOPE_AGENT); }
__device__ __forceinline__ unsigned xb_add(unsigned* p, unsigned v) { return __hip_atomic_fetch_add(p, v, __ATOMIC_RELAXED, __HIP_MEMORY_SCOPE_AGENT); }
__device__ __forceinline__ unsigned xb_xcc_id() { return (unsigned)__builtin_amdgcn_s_getreg((3 << 11) | 20) & 0xFu; }
#define XB_SPIN(cond, bar) do { unsigned _sp = 0; while (cond) { __builtin_amdgcn_s_sleep(1); \
    if ((++_sp & 255u) == 0u) { if (xb_ld(&(bar)[XB_TMO])) break; if (_sp > XB_SPIN_CAP) { atomicAdd(&(bar)[XB_TMO], 1u); break; } } } } while (0)

struct XcdBarrier {
    unsigned* bar; unsigned x;
    volatile LAS unsigned* st;
};

__device__ __forceinline__ XcdBarrier xcd_barrier_post(unsigned* bar, volatile LAS unsigned* st) {
    XcdBarrier b; b.bar = bar; b.x = xb_xcc_id(); b.st = st;
    if (threadIdx.x == 0) (void)xb_add(&bar[XB_XCNT(b.x)], 1u);
    return b;
}
__device__ __forceinline__ void xcd_barrier_complete(unsigned* bar, unsigned x, unsigned& nloc, unsigned& nx) {
    const unsigned G = gridDim.x * gridDim.y * gridDim.z;
    unsigned sum, cnt, mine, sp = 0u;
    for (;;) {
        sum = 0u; cnt = 0u; mine = 0u;
#pragma unroll
        for (unsigned j = 0; j < 16; ++j) { const unsigned c = xb_ld(&bar[XB_XCNT(j)]); sum += c; cnt += (c > 0u) ? 1u : 0u; mine = (j == x) ? c : mine; }
        if (sum == G) break;
        __builtin_amdgcn_s_sleep(1);
        if ((++sp & 255u) == 0u) { if (xb_ld(&bar[XB_TMO])) break; if (sp > XB_SPIN_CAP) { atomicAdd(&bar[XB_TMO], 1u); break; } }
    }
    nloc = mine > 0u ? mine : 1u; nx = cnt > 0u ? cnt : 1u;
}

__device__ __forceinline__ bool xb_lead(int wave_s) { return wave_s == 0 && __builtin_amdgcn_mbcnt_hi(~0u, __builtin_amdgcn_mbcnt_lo(~0u, 0u)) == 0; }
__device__ __forceinline__ void xcd_barrier(const XcdBarrier& b, int wave_s) {
    asm volatile("s_waitcnt vmcnt(0)" ::: "memory");
    __syncthreads();
    if (xb_lead(wave_s)) {
        unsigned* bar = b.bar;
        __builtin_amdgcn_s_waitcnt(0);
        unsigned nloc = b.st[0], nx = b.st[1];
        if (nloc == 0u) { xcd_barrier_complete(bar, b.x, nloc, nx); b.st[0] = nloc; b.st[1] = nx; }
        const unsigned old = xb_add(&bar[XB_XSUB(b.x)], 1u);
        const unsigned gen = old / nloc;
        if (old + 1u == (gen + 1u) * nloc) {
            __builtin_amdgcn_fence(__ATOMIC_RELEASE, "agent");
            asm volatile("s_waitcnt vmcnt(0)" ::: "memory");
            const unsigned og = xb_add(&bar[XB_TOP], 1u);
            const unsigned tg = og / nx;
            if (og + 1u == (tg + 1u) * nx) xb_add(&bar[XB_TOPGEN], 1u);
            else XB_SPIN(xb_ld(&bar[XB_TOPGEN]) == tg, bar);
            __builtin_amdgcn_fence(__ATOMIC_ACQUIRE, "agent");
            xb_add(&bar[XB_XGEN(b.x)], 1u);
            asm volatile("s_waitcnt vmcnt(0)" ::: "memory");
        } else {
            XB_SPIN(xb_ld(&bar[XB_XGEN(b.x)]) == gen, bar);
            __builtin_amdgcn_fence(__ATOMIC_ACQUIRE, "agent");
            asm volatile("s_waitcnt vmcnt(0)" ::: "memory");
        }
    }
    __syncthreads();
}


DI void grid_barrier(unsigned* ctr, unsigned target, int wave_s) {
    asm volatile("s_waitcnt vmcnt(0)" ::: "memory");
    __syncthreads();
    if (wave_s == 0) {
        const int l = __builtin_amdgcn_mbcnt_hi(~0u, __builtin_amdgcn_mbcnt_lo(~0u, 0u));
        if (l == 0) {
            __builtin_amdgcn_fence(__ATOMIC_RELEASE, "agent");
            asm volatile("s_waitcnt vmcnt(0)" ::: "memory");
            __hip_atomic_fetch_add(ctr, 1u, __ATOMIC_RELAXED, __HIP_MEMORY_SCOPE_AGENT);
            unsigned spins = 0;
            while (__hip_atomic_load(ctr, __ATOMIC_RELAXED, __HIP_MEMORY_SCOPE_AGENT) < target) { __builtin_amdgcn_s_sleep(2); if (++spins > (1u << 23)) break; }
            __builtin_amdgcn_fence(__ATOMIC_ACQUIRE, "agent");
            asm volatile("s_waitcnt vmcnt(0)" ::: "memory");
        }
    }
    __syncthreads();
}

__global__ void __launch_bounds__(NTHREADS, 2) mega(Params p) {
    extern __shared__ __attribute__((aligned(16))) unsigned char lds_raw[];
    const int wave_s = __builtin_amdgcn_readfirstlane(threadIdx.x >> 6);
#define MKCTX() Ctx c; { int l_; asm volatile("v_mbcnt_lo_u32_b32 %0, -1, 0\n\tv_mbcnt_hi_u32_b32 %0, -1, %0" : "=v"(l_)); c.lds = (LAS unsigned char*)lds_raw; c.lane = l_; c.wave = wave_s; c.tid = wave_s * 64 + l_; \
    c.gw = blockIdx.x * NWAVES + wave_s; c.ngw = gridDim.x * NWAVES; }
    unsigned char* ws = p.ws;
    const float* mod = (const float*)(ws + OFF_MOD);
    const int lo = p.ph_lo, hi = p.ph_hi;
    XcdBarrier xbar; xbar.bar = (unsigned*)(ws + OFF_XBAR); xbar.x = 0; xbar.st = nullptr;
    if (USE_XBAR && lo == 0 && hi == NPHASE) {
        volatile LAS unsigned* stw = (volatile LAS unsigned*)(lds_raw + LDS_BYTES - 32);
        if (threadIdx.x < 2) stw[threadIdx.x] = 0u;
        __syncthreads();
        xbar = xcd_barrier_post((unsigned*)(ws + OFF_XBAR), stw);
    }
#define IN(k) (lo <= (k) && (k) < hi)
#define SEAM(k) do { if (IN(k) && IN((k) + 1)) { if (USE_XBAR) xcd_barrier(xbar, wave_s); else grid_barrier((unsigned*)(ws + OFF_CTL), (unsigned)((k) + 1) * gridDim.x, wave_s); \
    if (TIME_PHASE >= 0 && blockIdx.x == 0 && threadIdx.x == 0) ((unsigned long long*)(ws + OFF_CTL + 512))[(k) + 1] = __builtin_amdgcn_s_memrealtime(); } } while (0)

    if (TIME_PHASE >= 0 && blockIdx.x == 0 && threadIdx.x == 0) ((unsigned long long*)(ws + OFF_CTL + 512))[0] = __builtin_amdgcn_s_memrealtime();
    if (IN(0)) { MKCTX(); phase_prologue(p, c, true, PRO_SPLIT == 0); }
    SEAM(0);
    if (IN(1)) for (int rep_ = 0; rep_ < (DUP_PHASE == 1 ? 2 : 1); ++rep_) { MKCTX();
        const long long* modi = (const long long*)(ws + OFF_MODI); float* modw = (float*)(ws + OFF_MOD);
        for (int i = blockIdx.x * NTHREADS + c.tid; i < NB * 6 * D; i += gridDim.x * NTHREADS) modw[i] = (float)((double)modi[i] * (1.0 / 4294967296.0));
        modulate_rows<P2_FP8 != 0>(p.x, p.n1g, modi + 1 * D, modi + 0 * D, (bf16_t*)(ws + OFF_H), c);
        if (PRO_SPLIT) phase_prologue(p, c, false, true);
    }
    SEAM(1);
    if (IN(2)) for (int rep_ = 0; rep_ < (DUP_PHASE == 2 ? 2 : 1); ++rep_) { MKCTX();
        EpiProj e1{(bf16_t*)(ws + OFF_CQ), (bf16_t*)(ws + OFF_CKV), (bf16_t*)(ws + OFF_KR), (bf16_t*)(ws + OFF_SBQ), (bf16_t*)(ws + OFF_SBK), (bf16_t*)(ws + OFF_GA), (bf16_t*)(ws + OFF_GB), (const f32x2*)(ws + OFF_CS), P2_FP8 ? 1.f / W8_SCALE : 1.f};
#if P2_FP8
        GEMM8(c, ws + OFF_H, ws + OFF_WIN, M, 7168, 2048, e1);
#else
        GEMM(c, (const bf16_t*)(ws + OFF_H), (const bf16_t*)(ws + OFF_WIN), M, 7168, 2048, e1);
#endif
        if (DUP_GEMM == 20) GEMM(c, (const bf16_t*)(ws + OFF_H), (const bf16_t*)(ws + OFF_WIN), M, 7168, 2048, e1);
        EpiT e2{(bf16_t*)(ws + OFF_SBVT), nullptr, P2_FP8 ? 1.f / W8_SCALE : 1.f};
#if P2_FP8
        GEMM8(c, ws + OFF_WSBV, ws + OFF_H, 1024, M, 2048, e2);
#else
        GEMM(c, (const bf16_t*)(ws + OFF_WSBV), (const bf16_t*)(ws + OFF_H), 1024, M, 2048, e2);
#endif
        if (DUP_GEMM == 21) GEMM(c, (const bf16_t*)(ws + OFF_WSBV), (const bf16_t*)(ws + OFF_H), 1024, M, 2048, e2);
    }
    SEAM(2);
    if (IN(3)) for (int rep_ = 0; rep_ < (DUP_PHASE == 3 ? 2 : 1); ++rep_) { MKCTX(); phase_rowstats(p, c); }
    SEAM(3);
    if (DBG_XTRA_BAR) { for (int q_ = 0; q_ < DBG_XTRA_BAR; ++q_) { if (IN(3) && IN(4)) xcd_barrier(xbar, wave_s); } }
    if (IN(4)) for (int rep_ = 0; rep_ < (DUP_PHASE == 4 ? 2 : 1); ++rep_) { MKCTX();
        EpiUq e1{(bf16_t*)(ws + OFF_Q), (const float*)(ws + OFF_RSTQ), (const f32x2*)(ws + OFF_CS)};
        GEMM(c, (const bf16_t*)(ws + OFF_CQ), (const bf16_t*)(ws + OFF_WUQ), M, 1536, 512, e1);
        if (DUP_GEMM == 40) GEMM(c, (const bf16_t*)(ws + OFF_CQ), (const bf16_t*)(ws + OFF_WUQ), M, 1536, 512, e1);
        EpiRowScale e2{(bf16_t*)(ws + OFF_KN), 1024, (const float*)(ws + OFF_RSTKV)};
        GEMM(c, (const bf16_t*)(ws + OFF_CKV), (const bf16_t*)(ws + OFF_WUK), M, 1024, 256, e2);
        if (DUP_GEMM == 41) GEMM(c, (const bf16_t*)(ws + OFF_CKV), (const bf16_t*)(ws + OFF_WUK), M, 1024, 256, e2);
        EpiT e3{(bf16_t*)(ws + OFF_VT), (const float*)(ws + OFF_RSTKV), 1.f};
        GEMM(c, (const bf16_t*)(ws + OFF_WUV), (const bf16_t*)(ws + OFF_CKV), 1024, M, 256, e3);
        if (DUP_GEMM == 42) GEMM(c, (const bf16_t*)(ws + OFF_WUV), (const bf16_t*)(ws + OFF_CKV), 1024, M, 256, e3);
    }
    SEAM(4);
    if (IN(5)) for (int rep_ = 0; rep_ < (DUP_PHASE == 5 ? 2 : 1); ++rep_) {
#if FAST_ATTN
        { MKCTX(); attn_mla_fast(p, c); }
        if (DUP_GEMM == 51) { MKCTX(); attn_mla_fast(p, c); }
        { MKCTX(); attn_sb_fast(p, c); }
        if (DUP_GEMM == 52) { MKCTX(); attn_sb_fast(p, c); }
#else
        MKCTX();
        attn_mla_naive(p, c); attn_sb_naive(p, c);
#endif
    }
    SEAM(5);
    if (IN(6)) for (int rep_ = 0; rep_ < (DUP_PHASE == 6 ? 2 : 1); ++rep_) { MKCTX();
        EpiGate1 e1{(bf16_t*)(ws + OFF_MERGED), (const bf16_t*)(ws + OFF_GA), P67_FP8 ? 1.f / (W8_SCALE * ACT8_SCALE) : 1.f};
#if P67_FP8
        GEMM8(c, ws + OFF_ATTA, ws + OFF_WA, M, 2048, 1024, e1);
#else
        GEMM(c, (const bf16_t*)(ws + OFF_ATTA), (const bf16_t*)(ws + OFF_WA), M, 2048, 1024, e1);
#endif
        if (DUP_GEMM == 60) GEMM(c, (const bf16_t*)(ws + OFF_ATTA), (const bf16_t*)(ws + OFF_WA), M, 2048, 1024, e1);
        EpiGate2 e2{(bf16_t*)(ws + OFF_MERGED), (const bf16_t*)(ws + OFF_GB), ws + OFF_H, P67_FP8 ? 1.f / (W8_SCALE * ACT8_SCALE) : 1.f};
#if P67_FP8
        GEMM8(c, ws + OFF_ATTB, ws + OFF_WB, M, 2048, 1024, e2);
#else
        GEMM(c, (const bf16_t*)(ws + OFF_ATTB), (const bf16_t*)(ws + OFF_WB), M, 2048, 1024, e2);
#endif
    }
    SEAM(6);
    if (IN(7)) for (int rep_ = 0; rep_ < (DUP_PHASE == 7 ? 2 : 1); ++rep_) { MKCTX();
        EpiRes e{p.x, mod + 2 * D, p.out, P67_FP8 ? 1.f / (W8_SCALE * ACT8_SCALE) : 1.f};
#if P67_FP8
        GEMM8(c, ws + OFF_H, ws + OFF_WOUT, M, 2048, 2048, e);
#else
        GEMM(c, (const bf16_t*)(ws + OFF_MERGED), (const bf16_t*)(ws + OFF_WOUT), M, 2048, 2048, e);
#endif
    }
    SEAM(7);
    if (IN(8)) for (int rep_ = 0; rep_ < (DUP_PHASE == 8 ? 2 : 1); ++rep_) { MKCTX();
        modulate_rows(p.out, p.n2g, mod + 4 * D, mod + 3 * D, (bf16_t*)(ws + OFF_H), c);
        convert_table(p.pu, ws + OFF_U16, U8_SCALE, c);
        convert_table(p.pv, ws + OFF_V16, V8_SCALE, c);
    }
    SEAM(8);
    if (IN(9)) for (int rep_ = 0; rep_ < (DUP_PHASE == 9 ? 2 : 1); ++rep_) { MKCTX();
        EpiPq e{(bf16_t*)(ws + OFF_PQ)};
        GEMM(c, (const bf16_t*)(ws + OFF_H), (const bf16_t*)(ws + OFF_WPQ), M, 2048, 2048, e);
#if FAST_SEL && FAST_GEMM && SEL_FUSED
        { MKCTX(); select_own_tiles(p, c); }
#endif
    }
#if !(FAST_SEL && FAST_GEMM && SEL_FUSED)
    SEAM(9);
    if (IN(10)) for (int rep_ = 0; rep_ < (DUP_PHASE == 10 ? 2 : 1); ++rep_) { MKCTX();
#if FAST_SEL
        select_fast(p, c);
#else
        select_naive(p, c);
#endif
    }
#else
    if (IN(9) && IN(10)) {   }
#endif
    SEAM(10);
#if GATHER_L2
    if (IN(11)) { MKCTX(); gather_u(p, c); }
    SEAM(11);
    if (IN(12)) { MKCTX(); gather_v(p, c); }
    SEAM(12);
    if (IN(13)) { MKCTX(); gather_final(p, c); }
#else
#if GATHER_SORTED
    if (IN(11)) { MKCTX(); phase_gather_sorted(p, c); }
#elif GATHER_ROUNDS
    if (IN(11)) { MKCTX(); phase_gather_rounds(p, c, xbar); }
#else
    if (IN(11)) { if (DUP_GEMM == 110) { MKCTX(); phase_gather(p, c, (float*)(ws + OFF_SBQ)); }
        if (DUP_GEMM == 111) { MKCTX(); phase_gather(p, c, (float*)(ws + OFF_SBQ), 0x3ff); } MKCTX(); phase_gather(p, c, p.out); }
#endif
#endif
#undef IN
#undef SEAM
}

extern "C" void kernel_launch(void* const* d_in, const int* in_sizes, int n_in, void* d_out, int out_size, void* d_ws, size_t ws_size, hipStream_t stream) {
    static int grid = 0;
    if (grid == 0) {
        if (n_in != 20 || out_size != M * D || ws_size < WS_END) { fprintf(stderr, "kernel_launch: unexpected shapes (n_in %d out %d ws %zu need %zu)\n", n_in, out_size, ws_size, (size_t)WS_END); grid = -1; return; }
        int dev = 0, cus = 0, per_cu = 0;
        (void)hipGetDevice(&dev); (void)hipDeviceGetAttribute(&cus, hipDeviceAttributeMultiprocessorCount, dev);
        if (hipFuncSetAttribute((const void*)mega, hipFuncAttributeMaxDynamicSharedMemorySize, LDS_BYTES) != hipSuccess) { fprintf(stderr, "kernel_launch: hipFuncSetAttribute failed\n"); grid = -1; return; }
        if (hipOccupancyMaxActiveBlocksPerMultiprocessor(&per_cu, (const void*)mega, NTHREADS, LDS_BYTES) != hipSuccess || per_cu < 1) { fprintf(stderr, "kernel_launch: occupancy query failed (%d)\n", per_cu); per_cu = 1; }
        (void)hipGetLastError();
        grid = cus;
    }
    if (grid < 0) return;
    (void)hipMemsetAsync((char*)d_ws + OFF_CTL, 0, ZERO_BYTES, stream);
    Params p{};
    p.x = (const float*)d_in[0]; p.c = (const float*)d_in[1]; p.pos = (const int*)d_in[2]; p.ada_w = (const float*)d_in[3]; p.ada_b = (const float*)d_in[4];
    p.n1g = (const float*)d_in[5]; p.n2g = (const float*)d_in[6]; p.w_in = (const float*)d_in[7]; p.qng = (const float*)d_in[8]; p.kvng = (const float*)d_in[9];
    p.w_uq = (const float*)d_in[10]; p.w_ukv = (const float*)d_in[11]; p.w_bm = (const float*)d_in[12]; p.w_bs = (const float*)d_in[13]; p.w_out = (const float*)d_in[14];
    p.w_pq = (const float*)d_in[15]; p.skeys = (const float*)d_in[16]; p.pu = (const float*)d_in[17]; p.pv = (const float*)d_in[18]; p.fng = (const float*)d_in[19];
    p.out = (float*)d_out; p.ws = (unsigned char*)d_ws;
    for (int i = 0; i < 32; ++i) p.invf[i] = (float)pow(10000.0, -(double)i / 32.0);
#if N_LAUNCH_MODE == 1
    p.ph_lo = 0; p.ph_hi = NPHASE;
    void* args[] = {&p};
    hipError_t e = hipLaunchCooperativeKernel((const void*)mega, dim3(grid), dim3(NTHREADS), args, LDS_BYTES, stream);
    if (e != hipSuccess) fprintf(stderr, "cooperative launch failed: %s (grid %d)\n", hipGetErrorString(e), grid);
#else
    for (int k = 0; k < NPHASE; ++k) {
        p.ph_lo = k; p.ph_hi = k + 1;
        hipLaunchKernelGGL(mega, dim3(grid), dim3(NTHREADS), LDS_BYTES, stream, p);
    }
#endif
}
```

```cpp
#include <hip/hip_runtime.h>
#include <hip/hip_cooperative_groups.h>
#include <cstdio>
#include <cstdint>
#include <cmath>
namespace cg = cooperative_groups;

#ifndef N_LAUNCH_MODE
#define N_LAUNCH_MODE 1
#endif

#ifndef TIME_PHASE
#define TIME_PHASE -1
#endif
#ifndef TIME_SCALE
#define TIME_SCALE 5000.f
#endif
#ifndef DUP_GEMM
#define DUP_GEMM -1
#endif
#ifndef PRO_SPLIT
#define PRO_SPLIT 1
#endif
#ifndef USE_XBAR
#define USE_XBAR 1
#endif
#ifndef DBG_XTRA_BAR
#define DBG_XTRA_BAR 0
#endif
#ifndef DBG_ROUND_BAR
#define DBG_ROUND_BAR 0
#endif
#ifndef GATHER_DYN
#define GATHER_DYN 1
#endif
#ifndef SEL_FUSED
#define SEL_FUSED 1
#endif
#ifndef DUP_PHASE
#define DUP_PHASE -1
#endif
#ifndef DBG_ALPHA
#define DBG_ALPHA 1.0f
#endif
#ifndef DBG_BETA
#define DBG_BETA 1.0f
#endif
#define LAS __attribute__((address_space(3)))
#define DI __device__ __forceinline__
typedef unsigned short bf16_t;
typedef short bf16x8 __attribute__((ext_vector_type(8)));
typedef float f32x4 __attribute__((ext_vector_type(4)));
typedef float f32x2 __attribute__((ext_vector_type(2)));
typedef unsigned u32x4 __attribute__((ext_vector_type(4)));
typedef unsigned u32x2 __attribute__((ext_vector_type(2)));
typedef __bf16 bf16v2 __attribute__((ext_vector_type(2)));

constexpr int M = 16384, D = 2048, SEQ = 4096, NB = 4;
constexpr int NTHREADS = 512, NWAVES = 8;
constexpr int LDS_BYTES = 160 * 1024;
constexpr float EPS = 1e-6f;
constexpr float LOG2E = 1.4426950408889634f;
constexpr int NPHASE = 14;

constexpr size_t al256(size_t x) { return (x + 255) & ~(size_t)255; }
constexpr size_t OFF_CTL = 0;
constexpr size_t OFF_XBAR = 4096;
constexpr size_t OFF_MODI = 32768;
constexpr size_t ZERO_BYTES = OFF_MODI + (size_t)NB * 6 * D * 8;
constexpr size_t OFF_MOD = al256(ZERO_BYTES);
constexpr size_t OFF_RSTQ = OFF_MOD + (size_t)NB * 6 * D * 4;
constexpr size_t OFF_RSTKV = OFF_RSTQ + (size_t)M * 4;
constexpr size_t OFF_CS = OFF_RSTKV + (size_t)M * 4;
constexpr size_t OFF_KEYS = OFF_CS + (size_t)M * 32 * 8;
constexpr size_t OFF_WIN = OFF_KEYS + (size_t)8 * 2 * 128 * 128 * 2;
constexpr size_t OFF_WSBV = OFF_WIN + (size_t)7168 * 2048 * 2;
constexpr size_t OFF_WUQ = OFF_WSBV + (size_t)1024 * 2048 * 2;
constexpr size_t OFF_WUK = OFF_WUQ + (size_t)1536 * 512 * 2;
constexpr size_t OFF_WUV = OFF_WUK + (size_t)1024 * 256 * 2;
constexpr size_t OFF_WA = OFF_WUV + (size_t)1024 * 256 * 2;
constexpr size_t OFF_WB = OFF_WA + (size_t)2048 * 1024 * 2;
constexpr size_t OFF_WOUT = OFF_WB + (size_t)2048 * 1024 * 2;
constexpr size_t OFF_WPQ = OFF_WOUT + (size_t)2048 * 2048 * 2;
constexpr size_t OFF_H = OFF_WPQ + (size_t)2048 * 2048 * 2;
constexpr size_t OFF_CQ = OFF_H + (size_t)M * 2048 * 2;
constexpr size_t OFF_CKV = OFF_CQ + (size_t)M * 512 * 2;
constexpr size_t OFF_KR = OFF_CKV + (size_t)M * 256 * 2;
constexpr size_t OFF_SBQ = OFF_KR + (size_t)M * 64 * 2;
constexpr size_t OFF_SBK = OFF_SBQ + (size_t)M * 1024 * 2;
constexpr size_t OFF_SBVT = OFF_SBK + (size_t)M * 1024 * 2;
constexpr size_t OFF_GA = OFF_SBVT + (size_t)M * 1024 * 2;
constexpr size_t OFF_GB = OFF_GA + (size_t)M * 2048 * 2;
constexpr size_t OFF_Q = OFF_GB + (size_t)M * 2048 * 2;
constexpr size_t OFF_KN = OFF_Q + (size_t)M * 1536 * 2;
constexpr size_t OFF_VT = OFF_KN + (size_t)M * 1024 * 2;
constexpr size_t OFF_ATTA = OFF_VT + (size_t)M * 1024 * 2;
constexpr size_t OFF_ATTB = OFF_ATTA + (size_t)M * 1024 * 2;
constexpr size_t WS_END = OFF_ATTB + (size_t)M * 1024 * 2;
constexpr size_t OFF_MERGED = OFF_SBQ;
constexpr size_t OFF_PQ = OFF_GA;
constexpr size_t OFF_IDX = OFF_GB;
constexpr size_t OFF_GW = OFF_GB + (size_t)M * 128 * 4;
constexpr size_t OFF_U16 = OFF_Q;
constexpr size_t OFF_V16 = OFF_U16 + (size_t)16384 * 2048;
static_assert(OFF_V16 + (size_t)16384 * 2048 <= WS_END, "u/v overlay");
constexpr float U8_SCALE = 68.f, V8_SCALE = 1.5f;
static_assert(WS_END < (size_t)620 * 1000 * 1000, "workspace budget");

struct Params {
    const float *x, *c; const int* pos;
    const float *ada_w, *ada_b, *n1g, *n2g, *w_in, *qng, *kvng, *w_uq, *w_ukv, *w_bm, *w_bs, *w_out, *w_pq, *skeys, *pu, *pv, *fng;
    float* out; unsigned char* ws;
    float invf[32];
    int ph_lo, ph_hi;
};

DI unsigned pk2(float lo, float hi) { bf16v2 p; p[0] = (__bf16)lo; p[1] = (__bf16)hi; return __builtin_bit_cast(unsigned, p); }
DI float bflo(unsigned u) { return __uint_as_float(u << 16); }
DI float bfhi(unsigned u) { return __uint_as_float(u & 0xffff0000u); }
DI float dot2bf(unsigned a, unsigned b, float c) { return __builtin_amdgcn_fdot2_f32_bf16(__builtin_bit_cast(bf16v2, a), __builtin_bit_cast(bf16v2, b), c, false); }
DI float bf2f(bf16_t b) { return __uint_as_float(((unsigned)b) << 16); }
DI float wave_sum(float v) {
#pragma unroll
    for (int o = 1; o < 64; o <<= 1) v += __shfl_xor(v, o);
    return v;
}
DI float wave_max(float v) {
#pragma unroll
    for (int o = 1; o < 64; o <<= 1) v = fmaxf(v, __shfl_xor(v, o));
    return v;
}
DI float sigmoidf_(float v) { return 1.f / (1.f + __expf(-v)); }
DI float gelu_tanh(float v) { const float u = 0.7978845608028654f * (v + 0.044715f * v * v * v); const float e = __expf(2.f * u); const float t = 1.f - 2.f / (e + 1.f); return 0.5f * v * (1.f + t); }
#ifndef P2_FP8
#define P2_FP8 1
#endif
constexpr float W8_SCALE = 64.f;
#ifndef P67_FP8
#define P67_FP8 1
#endif
constexpr float ACT8_SCALE = 16.f;
#ifndef GATE_FP8
#define GATE_FP8 1
#endif
#ifndef GATEA_FP8
#define GATEA_FP8 0
#endif
constexpr float GATE8_SCALE = 256.f;
DI unsigned pk4f8(float a, float b, float c, float d) { int w = __builtin_amdgcn_cvt_pk_fp8_f32(a, b, 0, false); w = __builtin_amdgcn_cvt_pk_fp8_f32(c, d, w, true); return (unsigned)w; }
DI void store_bf16x4(bf16_t* p, f32x4 v) { u32x2 w; w.x = pk2(v[0], v[1]); w.y = pk2(v[2], v[3]); *(u32x2*)p = w; }
DI void store_bf16x8(bf16_t* p, f32x4 a, f32x4 b) { u32x4 w; w.x = pk2(a[0], a[1]); w.y = pk2(a[2], a[3]); w.z = pk2(b[0], b[1]); w.w = pk2(b[2], b[3]); *(u32x4*)p = w; }
DI void load_bf16x8(const bf16_t* p, f32x4& a, f32x4& b) { const u32x4 w = *(const u32x4*)p; a = (f32x4){bflo(w.x), bfhi(w.x), bflo(w.y), bfhi(w.y)}; b = (f32x4){bflo(w.z), bfhi(w.z), bflo(w.w), bfhi(w.w)}; }
DI f32x4 sig4(f32x4 v) { return (f32x4){sigmoidf_(v[0]), sigmoidf_(v[1]), sigmoidf_(v[2]), sigmoidf_(v[3])}; }
DI f32x4 rope4(f32x4 v, f32x2 c0, f32x2 c1) { return (f32x4){v[0] * c0.x - v[1] * c0.y, v[1] * c0.x + v[0] * c0.y, v[2] * c1.x - v[3] * c1.y, v[3] * c1.x + v[2] * c1.y}; }
DI f32x4 load_bf16x4(const bf16_t* p) { const u32x2 w = *(const u32x2*)p; return (f32x4){bflo(w.x), bfhi(w.x), bflo(w.y), bfhi(w.y)}; }

struct Ctx {
    LAS unsigned char* lds;
    int tid, lane, wave, gw, ngw;
};

struct MapWin { DI int operator()(int n) const {
    if (n < 768) return n;
    if (n < 1024) { const int j = n - 768; if (j >= 64) return -1; return 768 + (j >> 1) + 32 * (j & 1); }
    if (n < 2048) return 832 + (n - 1024);
    if (n < 3072) return 1856 + (n - 2048);
    if (n < 5120) return 3904 + (n - 3072);
    return 5952 + (n - 5120); } };
struct MapOff { int off; DI int operator()(int n) const { return n + off; } };
struct MapUq { DI int operator()(int n) const { const int hd = n / 192, j = n % 192; if (j < 128) return hd * 192 + j; const int jj = j - 128; return hd * 192 + 128 + (jj >> 1) + 32 * (jj & 1); } };
struct MapUk { DI int operator()(int n) const { return (n >> 7) * 256 + (n & 127); } };
struct MapUv { DI int operator()(int n) const { return (n >> 7) * 256 + 128 + (n & 127); } };

template <bool F8 = false, class Map>
DI void transpose_item(const float* W, int K, int N, const Map& mp, const float* rowscale, bf16_t* dst, int kb, int nb, LAS float* scr, int lane) {
    const int k0 = kb * 64, sc = mp(nb * 64 + lane);
#pragma unroll 8
    for (int kk = 0; kk < 64; ++kk) {
        float v = 0.f;
        if (sc >= 0) v = W[(size_t)(k0 + kk) * N + sc];
        if (rowscale) v *= rowscale[k0 + kk];
        scr[kk * 65 + lane] = v;
    }
    asm volatile("s_waitcnt lgkmcnt(0)" ::: "memory");
    const int kc = lane & 7;
#pragma unroll
    for (int j = 0; j < 8; ++j) {
        const int nrow = (lane >> 3) + 8 * j; const LAS float* s = scr + (8 * kc) * 65 + nrow;
        if constexpr (F8) { u32x2 o; o.x = pk4f8(s[0] * W8_SCALE, s[65] * W8_SCALE, s[2 * 65] * W8_SCALE, s[3 * 65] * W8_SCALE); o.y = pk4f8(s[4 * 65] * W8_SCALE, s[5 * 65] * W8_SCALE, s[6 * 65] * W8_SCALE, s[7 * 65] * W8_SCALE);
            *(u32x2*)((unsigned char*)dst + (size_t)(nb * 64 + nrow) * K + k0 + 8 * kc) = o; }
        else {
        u32x4 o; o.x = pk2(s[0], s[65]); o.y = pk2(s[2 * 65], s[3 * 65]); o.z = pk2(s[4 * 65], s[5 * 65]); o.w = pk2(s[6 * 65], s[7 * 65]);
        *(u32x4*)(dst + (size_t)(nb * 64 + nrow) * K + k0 + 8 * kc) = o; }
    }
    asm volatile("s_waitcnt lgkmcnt(0)" ::: "memory");
}

DI void phase_prologue(const Params& p, const Ctx& c, bool do_ada = true, bool do_rest = true) {
    unsigned char* ws = p.ws;
    LAS float* scr = (LAS float*)(c.lds + c.wave * 16640);
    unsigned long long* modi = (unsigned long long*)(ws + OFF_MODI);
    if (do_ada) for (int u = c.gw; u < 32 * 48; u += c.ngw) {
        const int kp = u / 48, ch = u % 48, k0 = kp * 64, c0 = ch * 256 + c.lane * 4;
        float sl[4];
#pragma unroll
        for (int b = 0; b < 4; ++b) { const float cv = p.c[b * D + k0 + c.lane]; sl[b] = cv / (1.f + __expf(-cv)); }
        f32x4 acc[4];
#pragma unroll
        for (int b = 0; b < 4; ++b) acc[b] = (f32x4){0.f, 0.f, 0.f, 0.f};
#pragma unroll 16
        for (int kk = 0; kk < 64; ++kk) {
            const f32x4 w = *(const f32x4*)(p.ada_w + (size_t)(k0 + kk) * (6 * D) + c0);
#pragma unroll
            for (int b = 0; b < 4; ++b) { const float s = __shfl(sl[b], kk); acc[b] += w * s; }
        }
        if (kp == 0) { const f32x4 bv = *(const f32x4*)(p.ada_b + c0);
#pragma unroll
            for (int b = 0; b < 4; ++b) acc[b] += bv; }
#pragma unroll
        for (int b = 0; b < 4; ++b)
#pragma unroll
            for (int e = 0; e < 4; ++e) atomicAdd(modi + b * 6 * D + c0 + e, (unsigned long long)(long long)__builtin_rint((double)acc[b][e] * 4294967296.0));
    }
    if (!do_rest) return;
    constexpr int I_WIN = 112 * 32, I_SBV = 16 * 32, I_UQ = 24 * 8, I_UK = 16 * 4, I_UV = 16 * 4, I_A = 32 * 16, I_B = 32 * 16, I_OUT = 32 * 32, I_PQ = 32 * 32;
    constexpr int NIT = I_WIN + I_SBV + I_UQ + I_UK + I_UV + I_A + I_B + I_OUT + I_PQ;
    for (int it = c.gw; it < NIT; it += c.ngw) {
        int r = it;
        if (r < I_WIN) { transpose_item<P2_FP8 != 0>(p.w_in, 2048, 8000, MapWin{}, nullptr, (bf16_t*)(ws + OFF_WIN), r % 32, r / 32, scr, c.lane); continue; } r -= I_WIN;
        if (r < I_SBV) { transpose_item<P2_FP8 != 0>(p.w_in, 2048, 8000, MapOff{2880}, nullptr, (bf16_t*)(ws + OFF_WSBV), r % 32, r / 32, scr, c.lane); continue; } r -= I_SBV;
        if (r < I_UQ) { transpose_item(p.w_uq, 512, 1536, MapUq{}, p.qng, (bf16_t*)(ws + OFF_WUQ), r % 8, r / 8, scr, c.lane); continue; } r -= I_UQ;
        if (r < I_UK) { transpose_item(p.w_ukv, 256, 2048, MapUk{}, p.kvng, (bf16_t*)(ws + OFF_WUK), r % 4, r / 4, scr, c.lane); continue; } r -= I_UK;
        if (r < I_UV) { transpose_item(p.w_ukv, 256, 2048, MapUv{}, p.kvng, (bf16_t*)(ws + OFF_WUV), r % 4, r / 4, scr, c.lane); continue; } r -= I_UV;
        if (r < I_A) { transpose_item<P67_FP8 != 0>(p.w_bm, 1024, 2048, MapOff{0}, nullptr, (bf16_t*)(ws + OFF_WA), r % 16, r / 16, scr, c.lane); continue; } r -= I_A;
        if (r < I_B) { transpose_item<P67_FP8 != 0>(p.w_bs, 1024, 2048, MapOff{0}, nullptr, (bf16_t*)(ws + OFF_WB), r % 16, r / 16, scr, c.lane); continue; } r -= I_B;
        if (r < I_OUT) { transpose_item<P67_FP8 != 0>(p.w_out, 2048, 2048, MapOff{0}, nullptr, (bf16_t*)(ws + OFF_WOUT), r % 32, r / 32, scr, c.lane); continue; } r -= I_OUT;
        transpose_item(p.w_pq, 2048, 2048, MapOff{0}, nullptr, (bf16_t*)(ws + OFF_WPQ), r % 32, r / 32, scr, c.lane);
    }
    { bf16_t* kd = (bf16_t*)(ws + OFF_KEYS);
      for (int i = (c.gw * 64 + c.lane) * 4; i < 8 * 2 * 128 * 128; i += c.ngw * 64 * 4) store_bf16x4(kd + i, *(const f32x4*)(p.skeys + i)); }
    { f32x2* cs = (f32x2*)(ws + OFF_CS);
      for (int i = c.gw * 64 + c.lane; i < M * 32; i += c.ngw * 64) {
          const int m = i >> 5, f = i & 31;
          const float ang = (float)p.pos[m] * p.invf[f];
          const double rev = (double)ang * 0.15915494309189533576888;
          const float fr = (float)(rev - __builtin_rint(rev));
          cs[i] = (f32x2){__builtin_amdgcn_cosf(fr), __builtin_amdgcn_sinf(fr)};
      } }
}

DI f32x4 ld_mod4(const float* p) { return *(const f32x4*)p; }
DI f32x4 ld_mod4(const long long* p) { f32x4 r;
#pragma unroll
    for (int e = 0; e < 4; ++e) r[e] = (float)((double)p[e] * (1.0 / 4294967296.0));
    return r; }
template <bool F8 = false, class MT>
DI void modulate_rows(const float* src, const float* g, const MT* sc, const MT* sh, bf16_t* dst, const Ctx& c) {
    for (int m = c.gw; m < M; m += c.ngw) {
        const int b = m / SEQ;
        const float* xr = src + (size_t)m * D;
        f32x4 v[8]; float ss = 0.f;
#pragma unroll
        for (int j = 0; j < 8; ++j) { v[j] = *(const f32x4*)(xr + (j * 64 + c.lane) * 4); ss += v[j][0] * v[j][0] + v[j][1] * v[j][1] + v[j][2] * v[j][2] + v[j][3] * v[j][3]; }
        const float rstd = rsqrtf(wave_sum(ss) * (1.f / D) + EPS);
#pragma unroll
        for (int j = 0; j < 8; ++j) {
            const int col = (j * 64 + c.lane) * 4;
            const f32x4 gg = *(const f32x4*)(g + col), s1 = ld_mod4(sc + b * 6 * D + col), h1 = ld_mod4(sh + b * 6 * D + col);
            const f32x4 o = v[j] * rstd * gg * (s1 + 1.f) + h1;
            if constexpr (F8) *(unsigned*)((unsigned char*)dst + (size_t)m * D + col) = pk4f8(o[0], o[1], o[2], o[3]);
            else store_bf16x4(dst + (size_t)m * D + col, o);
        }
    }
}
DI void phase_rowstats(const Params& p, const Ctx& c) {
    const bf16_t* cq = (const bf16_t*)(p.ws + OFF_CQ); const bf16_t* ckv = (const bf16_t*)(p.ws + OFF_CKV);
    float* rq = (float*)(p.ws + OFF_RSTQ); float* rkv = (float*)(p.ws + OFF_RSTKV);
    for (int m = c.gw; m < M; m += c.ngw) {
        const u32x4 a = *(const u32x4*)(cq + (size_t)m * 512 + c.lane * 8);
        const u32x2 b = *(const u32x2*)(ckv + (size_t)m * 256 + c.lane * 4);
        float s1 = 0.f, s2 = 0.f;
#pragma unroll
        for (int e = 0; e < 4; ++e) { const float lo = bflo(a[e]), hi = bfhi(a[e]); s1 += lo * lo + hi * hi; }
#pragma unroll
        for (int e = 0; e < 2; ++e) { const float lo = bflo(b[e]), hi = bfhi(b[e]); s2 += lo * lo + hi * hi; }
        s1 = wave_sum(s1); s2 = wave_sum(s2);
        if (c.lane == 0) { rq[m] = rsqrtf(s1 * (1.f / 512.f) + EPS); rkv[m] = rsqrtf(s2 * (1.f / 256.f) + EPS); }
    }
}
typedef float f32x16v __attribute__((ext_vector_type(16)));
typedef float f32x32v __attribute__((ext_vector_type(32)));
typedef unsigned u32x6 __attribute__((ext_vector_type(6)));
#ifndef FP6_ORDER
#define FP6_ORDER 1
#endif
DI void convert_table(const float* src, unsigned char* dst, float scale, const Ctx& c) {
    const size_t ngroups = (size_t)16384 * 64;
    for (size_t gi = (size_t)c.gw * 64 + c.lane; gi < ngroups; gi += (size_t)c.ngw * 64) {
        const size_t row = gi >> 6; const int l = (int)(gi & 63);
        const float* sp = src + row * 2048 + l * 32;
        f32x4 v[8];
#pragma unroll
        for (int i = 0; i < 8; ++i) v[i] = *(const f32x4*)(sp + 4 * i) * scale;
        f32x16v a, b;
#pragma unroll
        for (int e = 0; e < 16; ++e) {
#if FP6_ORDER == 0
            a[e] = v[e >> 2][e & 3]; b[e] = v[4 + (e >> 2)][e & 3];
#else
            a[e] = v[(2 * e) >> 2][(2 * e) & 3]; b[e] = v[(2 * e + 1) >> 2][(2 * e + 1) & 3];
#endif
        }
        const u32x6 pk = __builtin_amdgcn_cvt_scalef32_2xpk16_fp6_f32(a, b, 1.0f);
        unsigned char* dp = dst + row * 1536;
        *(u32x4*)(dp + 16 * l) = (u32x4){pk[0], pk[1], pk[2], pk[3]};
        *(u32x2*)(dp + 1024 + 8 * l) = (u32x2){pk[4], pk[5]};
    }
}

struct EpiProj {
    bf16_t *cq, *ckv, *kr, *sbq, *sbk, *ga, *gb; const f32x2* cs; float osc;
    DI void operator()(int row, int col, f32x4 v) const {
        const int tile = col >> 8; v = v * osc;
        if (tile < 2) { store_bf16x4(cq + (size_t)row * 512 + col, v); }
        else if (tile == 2) { store_bf16x4(ckv + (size_t)row * 256 + (col - 512), v); }
        else if (tile == 3) { const int j = col - 768; if (j < 64) { const f32x2 c0 = cs[row * 32 + (j >> 1)], c1 = cs[row * 32 + (j >> 1) + 1];
            const f32x4 o = {v[0] * c0.x - v[1] * c0.y, v[1] * c0.x + v[0] * c0.y, v[2] * c1.x - v[3] * c1.y, v[3] * c1.x + v[2] * c1.y};
            store_bf16x4(kr + (size_t)row * 64 + j, o); } }
        else if (tile < 8) { store_bf16x4(sbq + (size_t)row * 1024 + (col - 1024), v * (0.08838834764831845f * LOG2E)); }
        else if (tile < 12) { store_bf16x4(sbk + (size_t)row * 1024 + (col - 2048), v); }
        else if (tile < 20) { store_bf16x4(ga + (size_t)row * 2048 + (col - 3072), (f32x4){sigmoidf_(v[0]), sigmoidf_(v[1]), sigmoidf_(v[2]), sigmoidf_(v[3])}); }
        else { store_bf16x4(gb + (size_t)row * 2048 + (col - 5120), (f32x4){sigmoidf_(v[0]), sigmoidf_(v[1]), sigmoidf_(v[2]), sigmoidf_(v[3])}); }
    }    DI void operator()(int row, int col, f32x4 v0, f32x4 v1) const {
        const int tile = col >> 8; v0 = v0 * osc; v1 = v1 * osc;
        if (tile < 2) { store_bf16x8(cq + (size_t)row * 512 + col, v0, v1); }
        else if (tile == 2) { store_bf16x8(ckv + (size_t)row * 256 + (col - 512), v0, v1); }
        else if (tile == 3) { const int j = col - 768; if (j < 64) { const f32x2* cp = cs + row * 32 + (j >> 1);
            store_bf16x8(kr + (size_t)row * 64 + j, rope4(v0, cp[0], cp[1]), rope4(v1, cp[2], cp[3])); } }
        else if (tile < 8) { const float sc = 0.08838834764831845f * LOG2E; store_bf16x8(sbq + (size_t)row * 1024 + (col - 1024), v0 * sc, v1 * sc); }
        else if (tile < 12) { store_bf16x8(sbk + (size_t)row * 1024 + (col - 2048), v0, v1); }
#if GATE_FP8
        else if (!GATEA_FP8 && tile < 20) { store_bf16x8(ga + (size_t)row * 2048 + (col - 3072), sig4(v0), sig4(v1)); }
        else { const f32x4 s0 = sig4(v0) * GATE8_SCALE, s1 = sig4(v1) * GATE8_SCALE; unsigned char* gp = tile < 20 ? (unsigned char*)ga + (size_t)row * 2048 + (col - 3072) : (unsigned char*)gb + (size_t)row * 2048 + (col - 5120);
            *(u32x2*)gp = (u32x2){pk4f8(s0[0], s0[1], s0[2], s0[3]), pk4f8(s1[0], s1[1], s1[2], s1[3])}; }
#else
        else if (tile < 20) { store_bf16x8(ga + (size_t)row * 2048 + (col - 3072), sig4(v0), sig4(v1)); }
        else { store_bf16x8(gb + (size_t)row * 2048 + (col - 5120), sig4(v0), sig4(v1)); }
#endif
    }
};
struct EpiT { bf16_t* o; const float* cscale; float osc;
    static constexpr int MB = 2; struct Pre { f32x4 a, b; };
    DI Pre load(int row, int col) const { Pre q; q.a = q.b = (f32x4){osc, osc, osc, osc}; if (cscale) { q.a = *(const f32x4*)(cscale + col) * osc; q.b = *(const f32x4*)(cscale + col + 4) * osc; } return q; }
    DI void apply(int row, int col, f32x4 v0, f32x4 v1, const Pre& q) const { store_bf16x8(o + (size_t)row * M + col, v0 * q.a, v1 * q.b); }
    DI void operator()(int row, int col, f32x4 v) const { if (cscale) v = v * *(const f32x4*)(cscale + col); store_bf16x4(o + (size_t)row * M + col, v); }
    DI void operator()(int row, int col, f32x4 v0, f32x4 v1) const { if (cscale) { v0 = v0 * *(const f32x4*)(cscale + col); v1 = v1 * *(const f32x4*)(cscale + col + 4); } store_bf16x8(o + (size_t)row * M + col, v0, v1); } };
struct EpiUq { bf16_t* q; const float* rst; const f32x2* cs;
    static constexpr int MB = 2; struct Pre { float sc; f32x2 c0, c1, c2, c3; };
    DI Pre load(int row, int col) const { Pre w; w.sc = rst[row]; w.c0 = w.c1 = w.c2 = w.c3 = (f32x2){0.f, 0.f}; const int j = col % 192;
        if (j >= 128) { const f32x2* cp = cs + row * 32 + ((j - 128) >> 1); w.c0 = cp[0]; w.c1 = cp[1]; w.c2 = cp[2]; w.c3 = cp[3]; } return w; }
    DI void apply(int row, int col, f32x4 v0, f32x4 v1, const Pre& w) const {
        const float sc = w.sc * (0.07216878364870322f * LOG2E); v0 = v0 * sc; v1 = v1 * sc;
        if (col % 192 >= 128) { v0 = rope4(v0, w.c0, w.c1); v1 = rope4(v1, w.c2, w.c3); }
        store_bf16x8(q + (size_t)row * 1536 + col, v0, v1); }
    DI void operator()(int row, int col, f32x4 v) const {
        v = v * (rst[row] * (0.07216878364870322f * LOG2E));
        const int j = col % 192;
        if (j >= 128) { const int i0 = (j - 128) >> 1; const f32x2 c0 = cs[row * 32 + i0], c1 = cs[row * 32 + i0 + 1];
            v = (f32x4){v[0] * c0.x - v[1] * c0.y, v[1] * c0.x + v[0] * c0.y, v[2] * c1.x - v[3] * c1.y, v[3] * c1.x + v[2] * c1.y}; }
        store_bf16x4(q + (size_t)row * 1536 + col, v);
    }
    DI void operator()(int row, int col, f32x4 v0, f32x4 v1) const {
        const float sc = rst[row] * (0.07216878364870322f * LOG2E); v0 = v0 * sc; v1 = v1 * sc;
        const int j = col % 192;
        if (j >= 128) { const f32x2* cp = cs + row * 32 + ((j - 128) >> 1); v0 = rope4(v0, cp[0], cp[1]); v1 = rope4(v1, cp[2], cp[3]); }
        store_bf16x8(q + (size_t)row * 1536 + col, v0, v1);
    } };
struct EpiRowScale { bf16_t* o; int ld; const float* rst;
    static constexpr int MB = 4; typedef float Pre;
    DI Pre load(int row, int col) const { return rst[row]; }
    DI void apply(int row, int col, f32x4 v0, f32x4 v1, const Pre& sc) const { store_bf16x8(o + (size_t)row * ld + col, v0 * sc, v1 * sc); }
    DI void operator()(int row, int col, f32x4 v) const { store_bf16x4(o + (size_t)row * ld + col, v * rst[row]); }
    DI void operator()(int row, int col, f32x4 v0, f32x4 v1) const { const float sc = rst[row]; store_bf16x8(o + (size_t)row * ld + col, v0 * sc, v1 * sc); } };
struct EpiGate1 { bf16_t* mg; const bf16_t* g; float osc;
#if GATEA_FP8
    static constexpr int MB = 2; typedef u32x2 Pre;
    DI Pre load(int row, int col) const { return *(const u32x2*)((const unsigned char*)g + (size_t)row * 2048 + col); }
#else
    static constexpr int MB = 2; typedef u32x4 Pre;
    DI Pre load(int row, int col) const { return *(const u32x4*)(g + (size_t)row * 2048 + col); }
#endif
    DI void apply(int row, int col, f32x4 v0, f32x4 v1, const Pre& w) const { const size_t i = (size_t)row * 2048 + col;
#if GATEA_FP8
        const f32x4 g0 = {__builtin_amdgcn_cvt_f32_fp8((int)w.x, 0), __builtin_amdgcn_cvt_f32_fp8((int)w.x, 1), __builtin_amdgcn_cvt_f32_fp8((int)w.x, 2), __builtin_amdgcn_cvt_f32_fp8((int)w.x, 3)};
        const f32x4 g1 = {__builtin_amdgcn_cvt_f32_fp8((int)w.y, 0), __builtin_amdgcn_cvt_f32_fp8((int)w.y, 1), __builtin_amdgcn_cvt_f32_fp8((int)w.y, 2), __builtin_amdgcn_cvt_f32_fp8((int)w.y, 3)};
        const float os = osc * (1.f / GATE8_SCALE);
#else
        const f32x4 g0 = {bflo(w.x), bfhi(w.x), bflo(w.y), bfhi(w.y)}, g1 = {bflo(w.z), bfhi(w.z), bflo(w.w), bfhi(w.w)}; const float os = osc;
#endif
        store_bf16x8(mg + i, v0 * os * g0, v1 * os * g1); }
    DI void operator()(int row, int col, f32x4 v) const { const size_t i = (size_t)row * 2048 + col; store_bf16x4(mg + i, v * load_bf16x4(g + i)); }
    DI void operator()(int row, int col, f32x4 v0, f32x4 v1) const { const size_t i = (size_t)row * 2048 + col; f32x4 g0, g1; load_bf16x8(g + i, g0, g1); store_bf16x8(mg + i, v0 * g0, v1 * g1); } };
struct EpiGate2 { bf16_t* mg; const bf16_t* g; unsigned char* m8; float osc;
    static constexpr int MB = 2;
#if GATE_FP8
    struct Pre { u32x4 m; u32x2 g; };
#else
    struct Pre { u32x4 g, m; };
#endif
#if GATE_FP8
    DI Pre load(int row, int col) const { const size_t i = (size_t)row * 2048 + col; Pre q; q.g = *(const u32x2*)((const unsigned char*)g + i); q.m = *(const u32x4*)(mg + i); return q; }
#else
    DI Pre load(int row, int col) const { const size_t i = (size_t)row * 2048 + col; Pre q; q.g = *(const u32x4*)(g + i); q.m = *(const u32x4*)(mg + i); return q; }
#endif
    DI void apply(int row, int col, f32x4 v0, f32x4 v1, const Pre& q) const { const size_t i = (size_t)row * 2048 + col;
#if GATE_FP8
        const f32x4 g0 = {__builtin_amdgcn_cvt_f32_fp8((int)q.g.x, 0), __builtin_amdgcn_cvt_f32_fp8((int)q.g.x, 1), __builtin_amdgcn_cvt_f32_fp8((int)q.g.x, 2), __builtin_amdgcn_cvt_f32_fp8((int)q.g.x, 3)};
        const f32x4 g1 = {__builtin_amdgcn_cvt_f32_fp8((int)q.g.y, 0), __builtin_amdgcn_cvt_f32_fp8((int)q.g.y, 1), __builtin_amdgcn_cvt_f32_fp8((int)q.g.y, 2), __builtin_amdgcn_cvt_f32_fp8((int)q.g.y, 3)};
        const float osc = this->osc * (1.f / GATE8_SCALE);
#else
        const f32x4 g0 = {bflo(q.g.x), bfhi(q.g.x), bflo(q.g.y), bfhi(q.g.y)}, g1 = {bflo(q.g.z), bfhi(q.g.z), bflo(q.g.w), bfhi(q.g.w)};
#endif
        const f32x4 m0 = {bflo(q.m.x), bfhi(q.m.x), bflo(q.m.y), bfhi(q.m.y)}, m1 = {bflo(q.m.z), bfhi(q.m.z), bflo(q.m.w), bfhi(q.m.w)};
        const f32x4 r0 = m0 + v0 * osc * g0, r1 = m1 + v1 * osc * g1;
        if (P67_FP8) *(u32x2*)(m8 + i) = (u32x2){pk4f8(r0[0] * ACT8_SCALE, r0[1] * ACT8_SCALE, r0[2] * ACT8_SCALE, r0[3] * ACT8_SCALE), pk4f8(r1[0] * ACT8_SCALE, r1[1] * ACT8_SCALE, r1[2] * ACT8_SCALE, r1[3] * ACT8_SCALE)};
        else store_bf16x8(mg + i, r0, r1); }
    DI void operator()(int row, int col, f32x4 v) const { const size_t i = (size_t)row * 2048 + col; store_bf16x4(mg + i, load_bf16x4(mg + i) + v * load_bf16x4(g + i)); }
    DI void operator()(int row, int col, f32x4 v0, f32x4 v1) const { const size_t i = (size_t)row * 2048 + col; f32x4 g0, g1, m0, m1; load_bf16x8(g + i, g0, g1); load_bf16x8(mg + i, m0, m1); store_bf16x8(mg + i, m0 + v0 * g0, m1 + v1 * g1); } };
struct EpiRes { const float* x; const float* gt; float* x1; float osc;
    static constexpr int MB = 2; struct Pre { f32x4 a, b; };
    DI Pre load(int row, int col) const { const size_t i = (size_t)row * 2048 + col; Pre q; q.a = *(const f32x4*)(x + i); q.b = *(const f32x4*)(x + i + 4); return q; }
    DI void apply(int row, int col, f32x4 v0, f32x4 v1, const Pre& q) const { const size_t i = (size_t)row * 2048 + col; const int b = row / SEQ; const float* gp = gt + b * 6 * D + col;
        *(f32x4*)(x1 + i) = q.a + *(const f32x4*)gp * v0 * (osc * DBG_ALPHA); *(f32x4*)(x1 + i + 4) = q.b + *(const f32x4*)(gp + 4) * v1 * (osc * DBG_ALPHA); }
    DI void operator()(int row, int col, f32x4 v) const { const size_t i = (size_t)row * 2048 + col; const int b = row / SEQ;
        *(f32x4*)(x1 + i) = *(const f32x4*)(x + i) + *(const f32x4*)(gt + b * 6 * D + col) * v * DBG_ALPHA; }
    DI void operator()(int row, int col, f32x4 v0, f32x4 v1) const { (*this)(row, col, v0); (*this)(row, col + 4, v1); } };
struct EpiPq { bf16_t* pq;
    DI void operator()(int row, int col, f32x4 v) const { store_bf16x4(pq + (size_t)(col >> 8) * M * 256 + (size_t)row * 256 + (col & 255), v); }
    DI void operator()(int row, int col, f32x4 v0, f32x4 v1) const { store_bf16x8(pq + (size_t)(col >> 8) * M * 256 + (size_t)row * 256 + (col & 255), v0, v1); } };

template <class Epi>
DI void gemm_naive(const Ctx& c, const bf16_t* A, const bf16_t* Bt, int Mg, int Ng, int Kg, const Epi& E) {
    LAS float* As = (LAS float*)c.lds; LAS float* Bs = As + 16 * 132;
    const int tid = c.tid, ty = tid >> 5, tx = tid & 31;
    const int tilesN = Ng / 128, ntiles = (Mg / 128) * tilesN;
    for (int t = blockIdx.x; t < ntiles; t += gridDim.x) {
        const int tm = t / tilesN, tn = t % tilesN;
        float acc[8][4];
#pragma unroll
        for (int i = 0; i < 8; ++i)
#pragma unroll
            for (int j = 0; j < 4; ++j) acc[i][j] = 0.f;
        for (int k0 = 0; k0 < Kg; k0 += 16) {
            { const int lt = tid & 255, r = lt >> 1, kc = lt & 1;
              const bf16_t* src = (tid < 256 ? A + (size_t)(tm * 128 + r) * Kg : Bt + (size_t)(tn * 128 + r) * Kg) + k0 + kc * 8;
              const u32x4 v = *(const u32x4*)src;
              LAS float* dst = (tid < 256 ? As : Bs) + (kc * 8) * 132 + r;
              dst[0] = bflo(v.x); dst[132] = bfhi(v.x); dst[2 * 132] = bflo(v.y); dst[3 * 132] = bfhi(v.y);
              dst[4 * 132] = bflo(v.z); dst[5 * 132] = bfhi(v.z); dst[6 * 132] = bflo(v.w); dst[7 * 132] = bfhi(v.w); }
            __syncthreads();
#pragma unroll
            for (int kk = 0; kk < 16; ++kk) {
                const f32x4 a0 = *(const LAS f32x4*)(As + kk * 132 + ty * 8), a1 = *(const LAS f32x4*)(As + kk * 132 + ty * 8 + 4);
                const f32x4 b = *(const LAS f32x4*)(Bs + kk * 132 + tx * 4);
#pragma unroll
                for (int j = 0; j < 4; ++j) {
                    acc[0][j] += a0[0] * b[j]; acc[1][j] += a0[1] * b[j]; acc[2][j] += a0[2] * b[j]; acc[3][j] += a0[3] * b[j];
                    acc[4][j] += a1[0] * b[j]; acc[5][j] += a1[1] * b[j]; acc[6][j] += a1[2] * b[j]; acc[7][j] += a1[3] * b[j];
                }
            }
            __syncthreads();
        }
#pragma unroll
        for (int i = 0; i < 8; ++i) E(tm * 128 + ty * 8 + i, tn * 128 + tx * 4, (f32x4){acc[i][0], acc[i][1], acc[i][2], acc[i][3]});
    }
}

namespace pg8 {
#define PG8_LAS __attribute__((address_space(3)))
typedef unsigned short bf16_t;
typedef short bf16x8 __attribute__((ext_vector_type(8)));
typedef float f32x4 __attribute__((ext_vector_type(4)));
typedef unsigned u32x4 __attribute__((ext_vector_type(4)));
constexpr int BM = 256, BK = 64, HALF = 128, HTB = HALF * BK * 2  , STAGE_BYTES = 8 * HTB, NXCD = 8, WGM = 4;

__host__ __device__ __forceinline__ int lds_byte(int r, int c) { const int st = (r >> 4) * 2 + (c >> 5), rr = r & 15, cc = c & 31, ob = rr * 64 + cc * 2; return st * 1024 + (ob ^ (((ob >> 9) & 1) << 5)); }
__host__ __device__ __forceinline__ void stage_rc(int b, int& R, int& C) { const int st = b / 1024, sb = b % 1024, swz = sb ^ (((sb >> 9) & 1) << 5); R = (st >> 1) * 16 + swz / 64; C = (st & 1) * 32 + (swz % 64) / 2; }
__host__ __device__ __forceinline__ int perm32(int rho) { const int n = rho >> 4, i = rho & 15; return 8 * (i >> 2) + 4 * n + (i & 3); }

struct Unit { int pm, pn; };
struct Gemm { const bf16_t* A; const bf16_t* Bt; int M, N, K; int tid; const unsigned char* base; };
struct StaticOrder {
    int nM, nN, nwg, G, c;
    __host__ __device__ void init(int M, int N, int G_, int c_) { nM = M / BM; nN = N / BM; nwg = nM * nN; G = G_; c = c_; }
    __host__ __device__ bool next(int i, Unit& u) const {
        const long L = (long)i * G + c; if (L >= nwg) return false;
        int wgid = (int)L; { const int q = nwg / NXCD, r = nwg % NXCD, xcd = wgid % NXCD, off = wgid / NXCD; wgid = (xcd < r ? xcd * (q + 1) : r * (q + 1) + (xcd - r) * q) + off; }
        const int nig = WGM * nN, gid = wgid / nig, fm = gid * WGM, gsz = (nM - fm) < WGM ? (nM - fm) : WGM;
        u.pm = fm + ((wgid % nig) % gsz); u.pn = (wgid % nig) / gsz; return true;
    }
    __device__ __forceinline__ void a_ready(const Unit&) const {}
    __device__ __forceinline__ void done(const Unit&) const {}
};
typedef int i32x8 __attribute__((ext_vector_type(8)));
template <class Epi, class Sched, bool STAMP = false, bool F8 = false>
__device__ __forceinline__ void gemm_phase(PG8_LAS unsigned char* lds, const Gemm g, const Sched& S, const Epi& E, unsigned long long* stamps) {
    const int tid = g.tid, wid = __builtin_amdgcn_readfirstlane(tid >> 6), lane = tid & 63, wr = wid >> 2, wc = wid & 3, fr = lane & 15, fq = lane >> 4;
    const int K = g.K, nt = K / BK;
    int ts_lo = 0, ts_hi = 0, nts = 0; const unsigned long long rt_entry = STAMP ? (unsigned long long)wall_clock64() : 0ull;
#define PG8_STAMP() do { if (STAMP && wid == 0 && nts < 64) { const unsigned long long _c = (unsigned long long)clock64(); \
        ts_lo = (lane == nts) ? (int)(unsigned)_c : ts_lo; ts_hi = (lane == nts) ? (int)(unsigned)(_c >> 32) : ts_hi; ++nts; } } while (0)
    PG8_STAMP();
    unsigned voffA, voffB;
    { int R, C; stage_rc(tid * 16, R, C); const int Rb = Epi::PERM ? ((R & ~31) + perm32(R & 31)) : R;
        voffA = (unsigned)(R * K + C) * 2u; voffB = (unsigned)(Rb * K + C) * 2u; }
    const unsigned qstep = 64u * (unsigned)K * 2u;
    const unsigned kstep = (unsigned)(BK * 2);
    const unsigned hstep = (unsigned)HALF * K * 2;
    const unsigned tstep = 2 * hstep;
    const __amdgpu_buffer_rsrc_t rs = __builtin_amdgcn_make_buffer_rsrc((void*)g.base, (short)0, (int)0x7fffffff, 0x00020000);
    const unsigned oA = (unsigned)((const unsigned char*)g.A - g.base), oB = (unsigned)((const unsigned char*)g.Bt - g.base);
    const unsigned ldsw = (unsigned)wid * 1024u;
    const int aoff = lds_byte(wr * 64 + fr, fq * 8), boff = lds_byte(wc * 32 + fr, fq * 8);
#define PG8_SA(b, h) (((b) * 2 + (h)) * HTB)
#define PG8_SB(b, h) ((4 + (b) * 2 + (h)) * HTB)
#define PG8_STAGE(bufoff, gbase, voff) do { _Pragma("unroll") for (int _i = 0; _i < 2; ++_i) \
        __builtin_amdgcn_raw_ptr_buffer_load_lds(rs, (PG8_LAS void*)(lds + (bufoff) + ldsw + _i * 8192), 16, (voff), (gbase) + _i * qstep, 0, 0); } while (0)
#define PG8_LDA(dst, b, h) do { _Pragma("unroll") for (int m = 0; m < 4; ++m) _Pragma("unroll") for (int k = 0; k < 2; ++k) dst[m][k] = *(const PG8_LAS bf16x8*)(lds + PG8_SA(b, h) + aoff + m * 2048 + k * 1024); } while (0)
#define PG8_LDB(dst, b, h) do { _Pragma("unroll") for (int n = 0; n < 2; ++n) _Pragma("unroll") for (int k = 0; k < 2; ++k) dst[n][k] = *(const PG8_LAS bf16x8*)(lds + PG8_SB(b, h) + boff + n * 2048 + k * 1024); } while (0)
#define PG8_CAT8(x0, x1) __builtin_bit_cast(i32x8, __builtin_shufflevector(x0, x1, 0, 1, 2, 3, 4, 5, 6, 7, 8, 9, 10, 11, 12, 13, 14, 15))
#define PG8_MMA(ai, bj, At, Bt) do { __builtin_amdgcn_s_setprio(1); _Pragma("unroll") for (int m = 0; m < 4; ++m) _Pragma("unroll") for (int n = 0; n < 2; ++n) { \
        if constexpr (F8) acc[ai][bj][m][n] = __builtin_amdgcn_mfma_scale_f32_16x16x128_f8f6f4(PG8_CAT8(Bt[n][0], Bt[n][1]), PG8_CAT8(At[m][0], At[m][1]), acc[ai][bj][m][n], 0, 0, 0, 0, 0, 0); \
        else { _Pragma("unroll") for (int k = 0; k < 2; ++k) acc[ai][bj][m][n] = __builtin_amdgcn_mfma_f32_16x16x32_bf16(Bt[n][k], At[m][k], acc[ai][bj][m][n], 0, 0, 0); } } \
        __builtin_amdgcn_s_setprio(0); } while (0)
#define PG8_WAIT_V(n) asm volatile("s_waitcnt vmcnt(" #n ")" ::: "memory")
#define PG8_WAIT_L(n) asm volatile("s_waitcnt lgkmcnt(" #n ")" ::: "memory")
#define PG8_BAR __builtin_amdgcn_s_barrier()
#define PG8_SCHED __builtin_amdgcn_sched_barrier(0)
    Unit cur, nxt; int ui = 0;
    if (!S.next(0, cur)) return;
    f32x4 acc[2][2][4][2];
#pragma unroll
    for (int a = 0; a < 2; ++a)
#pragma unroll
        for (int b = 0; b < 2; ++b)
#pragma unroll
            for (int m = 0; m < 4; ++m)
#pragma unroll
                for (int n = 0; n < 2; ++n) acc[a][b][m][n] = (f32x4){0.f, 0.f, 0.f, 0.f};
    bf16x8 At[4][2], B0[2][2], B1[2][2];
    unsigned cA = oA + (unsigned)cur.pm * tstep, cB = oB + (unsigned)cur.pn * tstep;
    S.a_ready(cur);
    PG8_STAGE(PG8_SB(0, 0), cB, voffB); PG8_STAGE(PG8_SA(0, 0), cA, voffA); PG8_STAGE(PG8_SB(0, 1), cB + hstep, voffB); PG8_STAGE(PG8_SA(0, 1), cA + hstep, voffA);
    if (wr == 1) PG8_BAR;
    PG8_WAIT_V(4); PG8_BAR;
    PG8_STAGE(PG8_SB(1, 0), cB + kstep, voffB); PG8_STAGE(PG8_SA(1, 0), cA + kstep, voffA); PG8_STAGE(PG8_SB(1, 1), cB + hstep + kstep, voffB);
    PG8_WAIT_V(6); PG8_BAR;
    PG8_STAMP();
    for (;;) {
        const bool has_next = S.next(ui + 1, nxt);
        const unsigned nA = has_next ? oA + (unsigned)nxt.pm * tstep : cA, nB = has_next ? oB + (unsigned)nxt.pn * tstep : cB;
        for (int t = 0; t < nt; t += 2) {
            const bool last = (t == nt - 2);
            const unsigned a1 = cA + (unsigned)(t + 1) * kstep;
            const unsigned a2 = last ? nA : cA + (unsigned)(t + 2) * kstep, b2 = last ? nB : cB + (unsigned)(t + 2) * kstep;
            const unsigned a3 = a2 + kstep, b3 = b2 + kstep;
            if (last && has_next) S.a_ready(nxt);
            PG8_LDB(B0, 0, 0); PG8_SCHED; PG8_LDA(At, 0, 0); PG8_STAGE(PG8_SA(1, 1), a1 + hstep, voffA);
            PG8_WAIT_L(8); PG8_BAR; PG8_WAIT_L(0); PG8_MMA(0, 0, At, B0); PG8_BAR; PG8_SCHED;
            PG8_LDB(B1, 0, 1); PG8_STAGE(PG8_SB(0, 0), b2, voffB);
            PG8_BAR; PG8_WAIT_L(0); PG8_MMA(0, 1, At, B1); PG8_BAR;
            PG8_LDA(At, 0, 1); PG8_STAGE(PG8_SA(0, 0), a2, voffA);
            PG8_BAR; PG8_WAIT_L(0); PG8_MMA(1, 0, At, B0); PG8_BAR; PG8_SCHED;
            PG8_STAGE(PG8_SB(0, 1), b2 + hstep, voffB);
            PG8_WAIT_V(6); PG8_BAR; PG8_MMA(1, 1, At, B1); PG8_BAR;
            PG8_LDB(B0, 1, 0); PG8_SCHED; PG8_LDA(At, 1, 0); PG8_STAGE(PG8_SA(0, 1), a2 + hstep, voffA);
            PG8_WAIT_L(8); PG8_BAR; PG8_WAIT_L(0); PG8_MMA(0, 0, At, B0); PG8_BAR; PG8_SCHED;
            PG8_LDB(B1, 1, 1); PG8_STAGE(PG8_SB(1, 0), b3, voffB);
            PG8_BAR; PG8_WAIT_L(0); PG8_MMA(0, 1, At, B1); PG8_BAR;
            PG8_LDA(At, 1, 1); PG8_STAGE(PG8_SA(1, 0), a3, voffA);
            PG8_BAR; PG8_WAIT_L(0); PG8_MMA(1, 0, At, B0); PG8_BAR; PG8_SCHED;
            PG8_STAGE(PG8_SB(1, 1), b3 + hstep, voffB);
            PG8_WAIT_V(6); PG8_BAR; PG8_MMA(1, 1, At, B1); PG8_BAR;
        }
        PG8_STAMP();
        if constexpr (!Epi::AFTER_DRAIN) { E(acc, cur, wr, wc, fr, fq); S.done(cur); }
        PG8_STAMP();
        if (!has_next) break;
#pragma unroll
        for (int a = 0; a < 2; ++a)
#pragma unroll
            for (int b = 0; b < 2; ++b)
#pragma unroll
                for (int m = 0; m < 4; ++m)
#pragma unroll
                    for (int n = 0; n < 2; ++n) acc[a][b][m][n] = (f32x4){0.f, 0.f, 0.f, 0.f};
        cur = nxt; cA = nA; cB = nB; ++ui;
    }
    PG8_WAIT_V(0);
    if (wr == 0) PG8_BAR;
    PG8_BAR;
    if constexpr (Epi::AFTER_DRAIN) { E.fused(acc, cur, wr, wc, fr, fq, lds, wid, lane); S.done(cur); }
    PG8_STAMP();
    if (STAMP && wid == 0) { stamps[lane] = lane < nts ? (((unsigned long long)(unsigned)ts_hi << 32) | (unsigned)ts_lo) : 0ull;
        if (lane == 62) stamps[62] = rt_entry; if (lane == 63) stamps[63] = (unsigned long long)wall_clock64(); }
#undef PG8_STAMP
#undef PG8_SA
#undef PG8_SB
#undef PG8_STAGE
#undef PG8_LDA
#undef PG8_LDB
#undef PG8_MMA
#undef PG8_CAT8
#undef PG8_WAIT_V
#undef PG8_WAIT_L
#undef PG8_BAR
#undef PG8_SCHED
}
}

template <class E4, class = void> struct epi_mb { static constexpr int value = 0; };
template <class E4> struct epi_mb<E4, decltype((void)E4::MB)> { static constexpr int value = E4::MB; };
template <class E4> struct EpiAdapt {
    static constexpr bool PERM = true, AFTER_DRAIN = false;
    E4 e;
    __device__ __forceinline__ void operator()(const pg8::f32x4 (&acc)[2][2][4][2], const pg8::Unit& u, int wr, int wc, int fr, int fq) const {
        if constexpr (epi_mb<E4>::value > 0) {
            constexpr int MB = epi_mb<E4>::value;
#pragma unroll
            for (int ai = 0; ai < 2; ++ai)
#pragma unroll
                for (int m0 = 0; m0 < 4; m0 += MB) {
                    typename E4::Pre pre[MB][2];
#pragma unroll
                    for (int mi = 0; mi < MB; ++mi)
#pragma unroll
                        for (int bj = 0; bj < 2; ++bj) pre[mi][bj] = e.load(u.pm * 256 + ai * 128 + wr * 64 + (m0 + mi) * 16 + fr, u.pn * 256 + bj * 128 + wc * 32 + fq * 8);
#pragma unroll
                    for (int mi = 0; mi < MB; ++mi)
#pragma unroll
                        for (int bj = 0; bj < 2; ++bj) e.apply(u.pm * 256 + ai * 128 + wr * 64 + (m0 + mi) * 16 + fr, u.pn * 256 + bj * 128 + wc * 32 + fq * 8, acc[ai][bj][m0 + mi][0], acc[ai][bj][m0 + mi][1], pre[mi][bj]);
                    asm volatile("" ::: "memory");
                }
        } else {
#pragma unroll
        for (int ai = 0; ai < 2; ++ai)
#pragma unroll
            for (int m = 0; m < 4; ++m) {
                const int row = u.pm * 256 + ai * 128 + wr * 64 + m * 16 + fr;
#pragma unroll
                for (int bj = 0; bj < 2; ++bj) e(row, u.pn * 256 + bj * 128 + wc * 32 + fq * 8, acc[ai][bj][m][0], acc[ai][bj][m][1]);
                asm volatile("" ::: "memory");
            }
        }
    }
};
template <class E4>
DI void gemm_fast(const Ctx& c, const unsigned char* WSB, const bf16_t* A, const bf16_t* Bt, int Mg, int Ng, int Kg, const E4& e4) {
    pg8::Gemm g{A, Bt, Mg, Ng, Kg, c.tid, WSB}; pg8::StaticOrder S; S.init(Mg, Ng, (int)gridDim.x, (int)blockIdx.x);
    EpiAdapt<E4> E{e4};
    pg8::gemm_phase<EpiAdapt<E4>, pg8::StaticOrder, false>((PG8_LAS unsigned char*)c.lds, g, S, E, nullptr);
}
template <class E4>
DI void gemm_fast8(const Ctx& c, const unsigned char* WSB, const unsigned char* A, const unsigned char* Bt, int Mg, int Ng, int Kg, const E4& e4) {
    pg8::Gemm g{(const bf16_t*)A, (const bf16_t*)Bt, Mg, Ng, Kg / 2, c.tid, WSB}; pg8::StaticOrder S; S.init(Mg, Ng, (int)gridDim.x, (int)blockIdx.x);
    EpiAdapt<E4> E{e4};
    pg8::gemm_phase<EpiAdapt<E4>, pg8::StaticOrder, false, true>((PG8_LAS unsigned char*)c.lds, g, S, E, nullptr);
}
#define GEMM8(c_, ...) do { MKCTX(); gemm_fast8(c, ws, __VA_ARGS__); } while (0)
#ifndef FAST_GEMM
#define FAST_GEMM 1
#endif
#if FAST_GEMM
#define GEMM(c_, ...) do { MKCTX(); gemm_fast(c, ws, __VA_ARGS__); } while (0)
#else
#define GEMM(c_, ...) do { MKCTX(); gemm_naive(c, __VA_ARGS__); } while (0)
#endif

DI void attn_mla_naive(const Params& p, const Ctx& c) {
    const bf16_t* Q = (const bf16_t*)(p.ws + OFF_Q); const bf16_t* KN = (const bf16_t*)(p.ws + OFF_KN); const bf16_t* KR = (const bf16_t*)(p.ws + OFF_KR);
    const bf16_t* VT = (const bf16_t*)(p.ws + OFF_VT); bf16_t* O = (bf16_t*)(p.ws + OFF_ATTA);
    for (int u = c.gw; u < M * 8; u += c.ngw) {
        const int m = u >> 3, hd = u & 7, b = m / SEQ, s = m % SEQ, base = b * SEQ, nkeys = ((s >> 6) + 1) << 6;
        const float q0 = bf2f(Q[(size_t)m * 1536 + hd * 192 + c.lane]), q1 = bf2f(Q[(size_t)m * 1536 + hd * 192 + 64 + c.lane]), q2 = bf2f(Q[(size_t)m * 1536 + hd * 192 + 128 + c.lane]);
        float mx = -1e30f, l = 0.f, o0 = 0.f, o1 = 0.f;
        const bf16_t* v0p = VT + (size_t)(hd * 128 + c.lane) * M + base; const bf16_t* v1p = v0p + (size_t)64 * M;
        for (int kk = 0; kk < nkeys; ++kk) {
            const size_t tk = base + kk;
            const float part = q0 * bf2f(KN[tk * 1024 + hd * 128 + c.lane]) + q1 * bf2f(KN[tk * 1024 + hd * 128 + 64 + c.lane]) + q2 * bf2f(KR[tk * 64 + c.lane]);
            const float sc = wave_sum(part);
            const float mn = fmaxf(mx, sc), al = exp2f(mx - mn), pp = exp2f(sc - mn);
            l = l * al + pp; o0 = o0 * al + pp * bf2f(v0p[kk]); o1 = o1 * al + pp * bf2f(v1p[kk]); mx = mn;
        }
        const float inv = 1.f / l;
        O[(size_t)m * 1024 + hd * 128 + c.lane] = (bf16_t)(pk2(o0 * inv, 0.f) & 0xffff);
        O[(size_t)m * 1024 + hd * 128 + 64 + c.lane] = (bf16_t)(pk2(o1 * inv, 0.f) & 0xffff);
    }
}
DI void attn_sb_naive(const Params& p, const Ctx& c) {
    const bf16_t* Q = (const bf16_t*)(p.ws + OFF_SBQ); const bf16_t* K = (const bf16_t*)(p.ws + OFF_SBK);
    const bf16_t* VT = (const bf16_t*)(p.ws + OFF_SBVT); bf16_t* O = (bf16_t*)(p.ws + OFF_ATTB);
    for (int u = c.gw; u < M * 8; u += c.ngw) {
        const int m = u >> 3, hd = u & 7, b = m / SEQ, s = m % SEQ, base = b * SEQ;
        const float q0 = bf2f(Q[(size_t)m * 1024 + hd * 128 + c.lane]), q1 = bf2f(Q[(size_t)m * 1024 + hd * 128 + 64 + c.lane]);
        float later = 0.f, o0 = 0.f, o1 = 0.f;
        const bf16_t* v0p = VT + (size_t)(hd * 128 + c.lane) * M + base; const bf16_t* v1p = v0p + (size_t)64 * M;
        for (int kk = s - 1; kk >= 0; --kk) {
            const size_t tk = base + kk;
            const float z2 = wave_sum(q0 * bf2f(K[tk * 1024 + hd * 128 + c.lane]) + q1 * bf2f(K[tk * 1024 + hd * 128 + 64 + c.lane]));
            const float ln2 = -(fmaxf(z2, 0.f) + __log2f(1.f + exp2f(-fabsf(z2))));
            const float w = exp2f(z2 + ln2 + later);
            later += ln2; o0 += w * bf2f(v0p[kk]); o1 += w * bf2f(v1p[kk]);
        }
        O[(size_t)m * 1024 + hd * 128 + c.lane] = (bf16_t)(pk2(o0, 0.f) & 0xffff);
        O[(size_t)m * 1024 + hd * 128 + 64 + c.lane] = (bf16_t)(pk2(o1, 0.f) & 0xffff);
    }
}


typedef float f32x16 __attribute__((ext_vector_type(16)));
#define MFMA32(a, b, c) __builtin_amdgcn_mfma_f32_32x32x16_bf16((a), (b), (c), 0, 0, 0)
constexpr int ST_KR = 16384, ST_VT = 24576, ST_BYTES = 40960;
constexpr int ATT_FLAGS = 2 * ST_BYTES;
DI float ex2(float x) { return __builtin_amdgcn_exp2f(x); }
DI float lg2(float x) { return __builtin_amdgcn_logf(x); }
DI bf16x8 pack8(float a0, float a1, float a2, float a3, float a4, float a5, float a6, float a7) {
    u32x4 t; t.x = pk2(a0, a1); t.y = pk2(a2, a3); t.z = pk2(a4, a5); t.w = pk2(a6, a7); return __builtin_bit_cast(bf16x8, t); }
#define GLDS16(gp, lp) __builtin_amdgcn_global_load_lds((const unsigned*)(gp), (LAS unsigned*)(lp), 16, 0, 0)

struct AttDmaOff { unsigned kn[2], kr, vt[2]; };
DI AttDmaOff att_dma_offsets(int w, int lane) {
    AttDmaOff o; const unsigned lr = lane >> 4, pp = lane & 15;
#pragma unroll
    for (int i = 0; i < 2; ++i) { const unsigned q = w * 2 + i, R = 4 * q + lr, cc = pp ^ (R & 15); o.kn[i] = R * 2048u + cc * 16u; }
    { const unsigned q = w, R2 = 4 * q + lr, cc = pp ^ (R2 & 15); o.kr = (2 * R2 + (cc >> 3)) * 128u + (cc & 7) * 16u; }
#pragma unroll
    for (int i = 0; i < 2; ++i) { const unsigned q = w * 2 + i, R2 = 4 * q + lr, cc = pp ^ (R2 & 15); o.vt[i] = (2 * R2 + (cc >> 3)) * (unsigned)(M * 2) + (cc & 7) * 16u; }
    return o;
}
template <bool ROPE>
DI void att_dma(LAS unsigned char* buf, __amdgpu_buffer_rsrc_t rs, const AttDmaOff& o, unsigned k_so, unsigned kr_so, unsigned vt_so, int w) {
#pragma unroll
    for (int i = 0; i < 2; ++i) __builtin_amdgcn_raw_ptr_buffer_load_lds(rs, (LAS void*)(buf + (w * 2 + i) * 1024), 16, o.kn[i], k_so, 0, 0);
    if (ROPE) __builtin_amdgcn_raw_ptr_buffer_load_lds(rs, (LAS void*)(buf + ST_KR + w * 1024), 16, o.kr, kr_so, 0, 0);
#pragma unroll
    for (int i = 0; i < 2; ++i) __builtin_amdgcn_raw_ptr_buffer_load_lds(rs, (LAS void*)(buf + ST_VT + (w * 2 + i) * 1024), 16, o.vt[i], vt_so, 0, 0);
}
DI void att_store(const f32x16 (&o)[4], float scale, bf16_t* O, size_t row, int hd, int h) {
#pragma unroll
    for (int db = 0; db < 4; ++db)
#pragma unroll
        for (int g = 0; g < 4; ++g)
#if P67_FP8
            { const float sc8 = scale * ACT8_SCALE; *(unsigned*)((unsigned char*)O + row * 1024 + hd * 128 + db * 32 + g * 8 + h * 4) = pk4f8(o[db][4 * g] * sc8, o[db][4 * g + 1] * sc8, o[db][4 * g + 2] * sc8, o[db][4 * g + 3] * sc8); }
#else
            store_bf16x4(O + row * 1024 + hd * 128 + db * 32 + g * 8 + h * 4, (f32x4){o[db][4 * g] * scale, o[db][4 * g + 1] * scale, o[db][4 * g + 2] * scale, o[db][4 * g + 3] * scale});
#endif
}
DI void att_pv(f32x16 (&o)[4], const bf16x8 (&pf)[2][2], const LAS unsigned char* buf, unsigned va) {
#pragma unroll
    for (int db = 0; db < 4; ++db) {
#pragma unroll
        for (int blk = 0; blk < 2; ++blk)
#pragma unroll
            for (int ks = 0; ks < 2; ++ks) o[db] = MFMA32(*(const LAS bf16x8*)(buf + ((va ^ ((blk * 2 + ks) << 5)) + db * 4096)), pf[blk][ks], o[db]);
        asm volatile("" ::: "memory");
    }
}

DI void attn_mla_fast(const Params& p, const Ctx& c) {
    const bf16_t* Q = (const bf16_t*)(p.ws + OFF_Q); const bf16_t* KN = (const bf16_t*)(p.ws + OFF_KN); const bf16_t* KR = (const bf16_t*)(p.ws + OFF_KR);
    const bf16_t* VT = (const bf16_t*)(p.ws + OFF_VT); bf16_t* O = (bf16_t*)(p.ws + OFF_ATTA);
    const int lane = c.lane, r = lane & 31, h = lane >> 5, w = c.wave;
    const int pr = (r & 0x13) | ((r & 4) << 1) | ((r & 8) >> 1);
    const unsigned ka = (pr << 8) | ((((pr & 15) ^ h) & 15) << 4);
    const unsigned ra = ST_KR + (((pr >> 1) << 8) | (((((pr & 1) << 3) | h) ^ ((pr >> 1) & 15)) << 4));
    const unsigned va = ST_VT + (((r >> 1) << 8) | (((((r & 1) << 3) | h) ^ ((r >> 1) & 15)) << 4));
    const __amdgpu_buffer_rsrc_t rs = __builtin_amdgcn_make_buffer_rsrc((void*)p.ws, (short)0, (int)WS_END, 0x00020000);
    const AttDmaOff dof = att_dma_offsets(w, lane);
    for (int it = blockIdx.x; it < 256; it += gridDim.x) {
        const int bh = it & 31, b = bh >> 3, hd = bh & 7, pairi = it >> 5;
#pragma unroll 1
        for (int half = 0; half < 2; ++half) {
            const int qb = half ? 15 - pairi : pairi, q0 = qb * 256;
            const size_t base = (size_t)b * SEQ, qrow = base + q0 + w * 32 + r;
            bf16x8 qf[12];
#pragma unroll
            for (int st = 0; st < 12; ++st) qf[st] = *(const bf16x8*)(Q + qrow * 1536 + hd * 192 + st * 16 + h * 8);
            const int ntile = q0 / 64 + 4, myn = (q0 + w * 32) / 64 + 1;
            f32x16 o[4];
#pragma unroll
            for (int db = 0; db < 4; ++db)
#pragma unroll
                for (int i = 0; i < 16; ++i) o[db][i] = 0.f;
            float mrun = -1e30f, lrun = 0.f;
            __syncthreads();
            const unsigned k_so0 = (unsigned)(OFF_KN + (base * 1024 + hd * 128) * 2), kr_so0 = (unsigned)(OFF_KR + base * 64 * 2), vt_so0 = (unsigned)(OFF_VT + ((size_t)(hd * 128) * M + base) * 2);
            att_dma<true>(c.lds, rs, dof, k_so0, kr_so0, vt_so0, w);
            asm volatile("s_waitcnt vmcnt(0)" ::: "memory");
            __syncthreads();
            for (int j = 0; j < ntile; ++j) {
                LAS unsigned char* buf = c.lds + (j & 1) * ST_BYTES;
                if (j + 1 < ntile) att_dma<true>(c.lds + ((j + 1) & 1) * ST_BYTES, rs, dof, k_so0 + (unsigned)(j + 1) * (64 * 2048), kr_so0 + (unsigned)(j + 1) * (64 * 128), vt_so0 + (unsigned)(j + 1) * 128, w);
                if (j < myn) {
                    f32x16 s0, s1;
#pragma unroll
                    for (int i = 0; i < 16; ++i) { s0[i] = 0.f; s1[i] = 0.f; }
                    __builtin_amdgcn_s_setprio(1);
#pragma unroll
                    for (int st = 0; st < 8; ++st) {
                        s0 = MFMA32(*(const LAS bf16x8*)(buf + (ka ^ (st << 5))), qf[st], s0);
                        s1 = MFMA32(*(const LAS bf16x8*)(buf + ((ka ^ (st << 5)) + 8192)), qf[st], s1);
                    }
#pragma unroll
                    for (int st = 0; st < 4; ++st) {
                        s0 = MFMA32(*(const LAS bf16x8*)(buf + (ra ^ (st << 5))), qf[8 + st], s0);
                        s1 = MFMA32(*(const LAS bf16x8*)(buf + ((ra ^ (st << 5)) + 4096)), qf[8 + st], s1);
                    }
                    __builtin_amdgcn_s_setprio(0);
                    float mx = fmaxf(s0[0], s1[0]);
#pragma unroll
                    for (int i = 1; i < 16; ++i) mx = fmaxf(mx, fmaxf(s0[i], s1[i]));
                    mx = fmaxf(mx, __shfl_xor(mx, 32));
                    const float mnew = fmaxf(mrun, mx), alpha = ex2(mrun - mnew);
                    mrun = mnew;
                    float ps = 0.f;
#pragma unroll
                    for (int i = 0; i < 16; ++i) { s0[i] = ex2(s0[i] - mnew); s1[i] = ex2(s1[i] - mnew); ps += s0[i] + s1[i]; }
                    lrun = lrun * alpha + ps;
#pragma unroll
                    for (int db = 0; db < 4; ++db)
#pragma unroll
                        for (int i = 0; i < 16; ++i) o[db][i] *= alpha;
                    bf16x8 pf[2][2];
                    pf[0][0] = pack8(s0[0], s0[1], s0[2], s0[3], s0[4], s0[5], s0[6], s0[7]); pf[0][1] = pack8(s0[8], s0[9], s0[10], s0[11], s0[12], s0[13], s0[14], s0[15]);
                    pf[1][0] = pack8(s1[0], s1[1], s1[2], s1[3], s1[4], s1[5], s1[6], s1[7]); pf[1][1] = pack8(s1[8], s1[9], s1[10], s1[11], s1[12], s1[13], s1[14], s1[15]);
                    __builtin_amdgcn_s_setprio(1);
                    att_pv(o, pf, buf, va);
                    __builtin_amdgcn_s_setprio(0);
                }
                asm volatile("s_waitcnt vmcnt(0)" ::: "memory");
                __syncthreads();
            }
            const float ltot = lrun + __shfl_xor(lrun, 32);
            att_store(o, 1.f / ltot, O, qrow, hd, h);
        }
    }
}

DI void attn_sb_fast(const Params& p, const Ctx& c) {
    const bf16_t* Q = (const bf16_t*)(p.ws + OFF_SBQ); const bf16_t* K = (const bf16_t*)(p.ws + OFF_SBK);
    const bf16_t* VT = (const bf16_t*)(p.ws + OFF_SBVT); bf16_t* O = (bf16_t*)(p.ws + OFF_ATTB);
    const int lane = c.lane, r = lane & 31, h = lane >> 5, w = c.wave, tid = c.tid;
    const int pr = (r & 0x13) | ((r & 4) << 1) | ((r & 8) >> 1);
    const unsigned ka = (pr << 8) | ((((pr & 15) ^ h) & 15) << 4);
    const unsigned va = ST_VT + (((r >> 1) << 8) | (((((r & 1) << 3) | h) ^ ((r >> 1) & 15)) << 4));
    const __amdgpu_buffer_rsrc_t rs = __builtin_amdgcn_make_buffer_rsrc((void*)p.ws, (short)0, (int)WS_END, 0x00020000);
    const AttDmaOff dof = att_dma_offsets(w, lane);
    LAS int* flags = (LAS int*)(c.lds + ATT_FLAGS);
    for (int it = blockIdx.x; it < 256; it += gridDim.x) {
        const int bh = it & 31, b = bh >> 3, hd = bh & 7, pairi = it >> 5;
#pragma unroll 1
        for (int half = 0; half < 2; ++half) {
            const int qb = half ? 15 - pairi : pairi, q0 = qb * 256;
            const size_t base = (size_t)b * SEQ, qrow = base + q0 + w * 32 + r;
            const int tq = q0 + w * 32 + r;
            bf16x8 qf[8];
#pragma unroll
            for (int st = 0; st < 8; ++st) qf[st] = *(const bf16x8*)(Q + qrow * 1024 + hd * 128 + st * 16 + h * 8);
            const int jmax = q0 / 64 + 3, jd = (q0 + w * 32) / 64;
            f32x16 o[4];
#pragma unroll
            for (int db = 0; db < 4; ++db)
#pragma unroll
                for (int i = 0; i < 16; ++i) o[db][i] = 0.f;
            float carry = 0.f; bool wdone = false;
            __syncthreads();
            const unsigned k_so0 = (unsigned)(OFF_SBK + (base * 1024 + hd * 128) * 2), vt_so0 = (unsigned)(OFF_SBVT + ((size_t)(hd * 128) * M + base) * 2);
            att_dma<false>(c.lds, rs, dof, k_so0 + (unsigned)jmax * (64 * 2048), 0u, vt_so0 + (unsigned)jmax * 128, w);
            if (tid < 16) flags[tid] = 0;
            asm volatile("s_waitcnt vmcnt(0)" ::: "memory");
            __syncthreads();
            int itn = 0;
            for (int j = jmax; j >= 0; --j, ++itn) {
                LAS unsigned char* buf = c.lds + (itn & 1) * ST_BYTES;
                if (j > 0) att_dma<false>(c.lds + ((itn + 1) & 1) * ST_BYTES, rs, dof, k_so0 + (unsigned)(j - 1) * (64 * 2048), 0u, vt_so0 + (unsigned)(j - 1) * 128, w);
                if (j <= jd && !wdone) {
                    f32x16 s0, s1;
#pragma unroll
                    for (int i = 0; i < 16; ++i) { s0[i] = 0.f; s1[i] = 0.f; }
#pragma unroll
                    for (int st = 0; st < 8; ++st) {
                        s0 = MFMA32(*(const LAS bf16x8*)(buf + (ka ^ (st << 5))), qf[st], s0);
                        s1 = MFMA32(*(const LAS bf16x8*)(buf + ((ka ^ (st << 5)) + 8192)), qf[st], s1);
                    }
                    const int kb0 = 64 * j + 8 * h - tq;
                    bf16x8 pf[2][2];
                    {
                        f32x16 l1;
#pragma unroll
                        for (int i = 0; i < 16; ++i) { const float z = s1[i]; const float a = -(fmaxf(z, 0.f) + lg2(1.f + ex2(-fabsf(z)))); l1[i] = (kb0 + 32 + 16 * (i >> 3) + (i & 7) < 0) ? a : 0.f; }
                        float g0 = 0.f, g1 = 0.f;
#pragma unroll
                        for (int e = 0; e < 8; ++e) { g0 += l1[e]; g1 += l1[8 + e]; }
                        const float p0 = __shfl_xor(g0, 32), p1 = __shfl_xor(g1, 32);
                        float run = carry + (h == 0 ? p1 : 0.f);
#pragma unroll
                        for (int e = 7; e >= 0; --e) { run += l1[8 + e]; l1[8 + e] = run; }
                        run = carry + (g1 + p1) + (h == 0 ? p0 : 0.f);
#pragma unroll
                        for (int e = 7; e >= 0; --e) { run += l1[e]; l1[e] = run; }
                        carry += (g1 + p1) + (g0 + p0);
#pragma unroll
                        for (int i = 0; i < 16; ++i) { const float wv = ex2(s1[i] + l1[i]); s1[i] = (kb0 + 32 + 16 * (i >> 3) + (i & 7) < 0) ? wv : 0.f; }
                        pf[1][0] = pack8(s1[0], s1[1], s1[2], s1[3], s1[4], s1[5], s1[6], s1[7]); pf[1][1] = pack8(s1[8], s1[9], s1[10], s1[11], s1[12], s1[13], s1[14], s1[15]);
                    }
                    {
                        f32x16 l0;
#pragma unroll
                        for (int i = 0; i < 16; ++i) { const float z = s0[i]; const float a = -(fmaxf(z, 0.f) + lg2(1.f + ex2(-fabsf(z)))); l0[i] = (kb0 + 16 * (i >> 3) + (i & 7) < 0) ? a : 0.f; }
                        float g0 = 0.f, g1 = 0.f;
#pragma unroll
                        for (int e = 0; e < 8; ++e) { g0 += l0[e]; g1 += l0[8 + e]; }
                        const float p0 = __shfl_xor(g0, 32), p1 = __shfl_xor(g1, 32);
                        float run = carry + (h == 0 ? p1 : 0.f);
#pragma unroll
                        for (int e = 7; e >= 0; --e) { run += l0[8 + e]; l0[8 + e] = run; }
                        run = carry + (g1 + p1) + (h == 0 ? p0 : 0.f);
#pragma unroll
                        for (int e = 7; e >= 0; --e) { run += l0[e]; l0[e] = run; }
                        carry += (g1 + p1) + (g0 + p0);
#pragma unroll
                        for (int i = 0; i < 16; ++i) { const float wv = ex2(s0[i] + l0[i]); s0[i] = (kb0 + 16 * (i >> 3) + (i & 7) < 0) ? wv : 0.f; }
                        pf[0][0] = pack8(s0[0], s0[1], s0[2], s0[3], s0[4], s0[5], s0[6], s0[7]); pf[0][1] = pack8(s0[8], s0[9], s0[10], s0[11], s0[12], s0[13], s0[14], s0[15]);
                    }
                    att_pv(o, pf, buf, va);
                    wdone = __all(carry < -150.f);
                }
                if (lane == 0) flags[(itn & 1) * 8 + w] = wdone ? 1 : 0;
                asm volatile("s_waitcnt vmcnt(0)" ::: "memory");
                __syncthreads();
                int alld = 1;
#pragma unroll
                for (int q = 0; q < 8; ++q) alld &= flags[(itn & 1) * 8 + q];
                if (alld) break;
            }
            att_store(o, 1.f, O, qrow, hd, h);
        }
    }
}
#ifndef FAST_ATTN
#define FAST_ATTN 1
#endif

constexpr int SEL_LD = 260;
DI void topk_insert(float (&a)[16], float x) {
#pragma unroll
    for (int i = 15; i >= 1; --i) a[i] = __builtin_amdgcn_fmed3f(a[i - 1], a[i], x);
    a[0] = fmaxf(a[0], x);
}
struct SelMap { int mode, a0, a1, a2, a3; };
DI void sel_decode(const SelMap& mp, int q, int& t0, int& hd) {
    if (mp.mode == 0) { int u = mp.a0 + q * mp.a1; if (u >= 128 * 8) u = mp.a0; hd = u & 7; t0 = (u >> 3) * 128; }
    else { const int pm = (q >> 1) ? mp.a2 : mp.a0, pn = (q >> 1) ? mp.a3 : mp.a1; hd = pn; t0 = pm * 256 + (q & 1) * 128; }
}
template <int NU> DI void select_stage2(const Params& p, const Ctx& c, const SelMap mp, const LAS float* lst_all) {
    if (c.tid < 128 * NU) {
        const int tok = c.tid & 127, un = c.tid >> 7;
        int t0, hd; sel_decode(mp, un, t0, hd);
        const LAS float* lst = lst_all + un * 4096;
        float v1[16], v2[16];
#pragma unroll
        for (int i = 0; i < 16; ++i) { v1[i] = __uint_as_float(__float_as_uint(lst[(tok * 2) * 16 + i]) & ~127u); v2[i] = __uint_as_float(__float_as_uint(lst[(tok * 2 + 1) * 16 + i]) & ~127u); }
        float bb[16];
#pragma unroll
        for (int i = 0; i < 16; ++i) bb[i] = -__builtin_inff();
#pragma unroll
        for (int i = 0; i < 16; ++i)
#pragma unroll
            for (int j = 0; j < 16; ++j)
                if ((i + 1) * (j + 1) <= 16) topk_insert(bb, __uint_as_float((__float_as_uint(v1[i] + v2[j]) & ~255u) | (unsigned)(i * 16 + j)));
        float sv[16], mxv = -__builtin_inff(), sum = 0.f;
#pragma unroll
        for (int i = 0; i < 16; ++i) { sv[i] = __uint_as_float(__float_as_uint(bb[i]) & ~255u); mxv = fmaxf(mxv, sv[i]); }
#pragma unroll
        for (int i = 0; i < 16; ++i) { sv[i] = __expf(sv[i] - mxv); sum += sv[i]; }
        const float inv = 1.f / sum;
        int* idx = (int*)(p.ws + OFF_IDX) + (size_t)(t0 + tok) * 128 + hd * 16; float* gw = (float*)(p.ws + OFF_GW) + (size_t)(t0 + tok) * 128 + hd * 16;
#pragma unroll
        for (int i = 0; i < 16; ++i) {
            const unsigned code = __float_as_uint(bb[i]) & 255u;
            const unsigned e1 = __float_as_uint(lst[(tok * 2) * 16 + (code >> 4)]) & 127u, e2 = __float_as_uint(lst[(tok * 2 + 1) * 16 + (code & 15u)]) & 127u;
            idx[i] = (int)(e1 * 128u + e2); gw[i] = sv[i] * inv;
        }
    }
    __syncthreads();
}
DI void select_tail(const Params& p, const Ctx& c, int t0, int hd) {
    LAS float* sc = (LAS float*)c.lds; LAS float* lst = sc + 128 * SEL_LD;
    if (c.tid < 256) {
        const int tok = c.tid >> 1, hf = c.tid & 1;
        float a[16];
#pragma unroll
        for (int i = 0; i < 16; ++i) a[i] = -__builtin_inff();
        const LAS float* row = sc + tok * SEL_LD + hf * 128;
#pragma unroll 4
        for (int n4 = 0; n4 < 32; ++n4) {
            const f32x4 v = *(const LAS f32x4*)(row + n4 * 4);
#pragma unroll
            for (int e = 0; e < 4; ++e) topk_insert(a, __uint_as_float((__float_as_uint(v[e]) & ~127u) | (unsigned)(n4 * 4 + e)));
        }
#pragma unroll
        for (int i = 0; i < 16; ++i) lst[(tok * 2 + hf) * 16 + i] = a[i];
    }
    __syncthreads();
    select_stage2<1>(p, c, SelMap{0, ((t0 >> 7) << 3) | hd, 0, 0, 0}, lst);
}
DI void select_naive(const Params& p, const Ctx& c) {
    const bf16_t* PQ = (const bf16_t*)(p.ws + OFF_PQ); const bf16_t* KEYS = (const bf16_t*)(p.ws + OFF_KEYS);
    LAS float* sc = (LAS float*)c.lds;
    for (int u = blockIdx.x; u < 128 * 8; u += gridDim.x) {
        const int hd = u & 7, t0 = (u >> 3) * 128;
        const int tok = c.tid >> 2, part = c.tid & 3, hf = part >> 1, n0 = (part & 1) * 64;
        const bf16_t* qrow = PQ + (size_t)hd * M * 256 + (size_t)(t0 + tok) * 256 + hf * 128;
        const bf16_t* kb = KEYS + (size_t)((hd * 2 + hf) * 128 + n0) * 128;
        for (int n = 0; n < 64; ++n) {
            float acc = 0.f;
#pragma unroll
            for (int d8 = 0; d8 < 16; ++d8) {
                const u32x4 a = *(const u32x4*)(qrow + d8 * 8), b = *(const u32x4*)(kb + (size_t)n * 128 + d8 * 8);
#pragma unroll
                for (int e = 0; e < 4; ++e) acc += bflo(a[e]) * bflo(b[e]) + bfhi(a[e]) * bfhi(b[e]);
            }
            sc[tok * SEL_LD + hf * 128 + n0 + n] = acc;
        }
        __syncthreads();
        select_tail(p, c, t0, hd);
    }
}


DI void select_batch(const Params& p, const Ctx& c, const SelMap mp) {
    const bf16_t* PQ = (const bf16_t*)(p.ws + OFF_PQ); const bf16_t* KEYS = (const bf16_t*)(p.ws + OFF_KEYS);
    LAS float* lst_all = (LAS float*)c.lds;
    const int lane = c.lane, r = lane & 31, h = lane >> 5, w = c.wave, tb = w & 3, hf = w >> 2;
#pragma unroll
    for (int q = 0; q < 4; ++q) {
        int t0, hd; sel_decode(mp, q, t0, hd);
        LAS float* lst = lst_all + q * 4096;
        const bf16_t* qrow = PQ + (size_t)hd * M * 256 + (size_t)(t0 + tb * 32 + r) * 256 + hf * 128 + h * 8;
        const bf16_t* kbase = KEYS + (size_t)((hd * 2 + hf) * 128 + r) * 128 + h * 8;
        bf16x8 qf[8];
#pragma unroll
        for (int st = 0; st < 8; ++st) qf[st] = *(const bf16x8*)(qrow + st * 16);
        float a[16];
#pragma unroll
        for (int i = 0; i < 16; ++i) a[i] = -__builtin_inff();
#pragma unroll
        for (int kb = 0; kb < 4; ++kb) {
            f32x16 sc;
#pragma unroll
            for (int i = 0; i < 16; ++i) sc[i] = 0.f;
#pragma unroll
            for (int st = 0; st < 8; ++st) sc = MFMA32(*(const bf16x8*)(kbase + (size_t)kb * 32 * 128 + st * 16), qf[st], sc);
#pragma unroll
            for (int i = 0; i < 16; ++i) topk_insert(a, __uint_as_float((__float_as_uint(sc[i]) & ~127u) | (unsigned)(kb * 32 + (i & 3) + 8 * (i >> 2) + 4 * h)));
        }
        float bq[16];
#pragma unroll
        for (int i = 0; i < 16; ++i) bq[i] = __shfl_xor(a[i], 32);
#pragma unroll
        for (int i = 0; i < 16; ++i) topk_insert(a, bq[i]);
        if (h == 0) {
#pragma unroll
            for (int i = 0; i < 16; ++i) lst[((tb * 32 + r) * 2 + hf) * 16 + i] = a[i];
        }
    }
    __syncthreads();
    select_stage2<4>(p, c, mp, lst_all);
}
DI void select_fast(const Params& p, const Ctx& c) {
    for (int u0 = blockIdx.x; u0 < 128 * 8; u0 += 4 * gridDim.x) select_batch(p, c, SelMap{0, u0, (int)gridDim.x, 0, 0});
}
DI void select_own_tiles(const Params& p, const Ctx& c) {
    pg8::StaticOrder S; S.init(M, 2048, (int)gridDim.x, (int)blockIdx.x);
    asm volatile("s_waitcnt vmcnt(0)" ::: "memory");
    __syncthreads();
    if (c.tid == 0) { __builtin_amdgcn_fence(__ATOMIC_ACQUIRE, "agent"); asm volatile("s_waitcnt vmcnt(0)" ::: "memory"); }
    __syncthreads();
    for (int i = 0;; i += 2) {
        pg8::Unit u0, u1;
        if (!S.next(i, u0)) break;
        if (!S.next(i + 1, u1)) u1 = u0;
        select_batch(p, c, SelMap{1, u0.pm, u0.pn, u1.pm, u1.pn});
    }
}
#ifndef FAST_SEL
#define FAST_SEL 1
#endif

DI void phase_gather(const Params& p, const Ctx& c, float* dst, int rowmask = -1) {
    const bf16_t* H2 = (const bf16_t*)(p.ws + OFF_H); const unsigned char* U = p.ws + OFF_U16; const unsigned char* V = p.ws + OFF_V16;
    const int* IDX = (const int*)(p.ws + OFF_IDX); const float* GW = (const float*)(p.ws + OFF_GW); const float* mod = (const float*)(p.ws + OFF_MOD);
    constexpr int G = 8, GV = 16;
    const int lane = c.lane;
    unsigned* tokctr = (unsigned*)(p.ws + OFF_CTL) + 700;
    constexpr int NSTATIC = 6;
    LAS int* park = (LAS int*)(c.lds + c.wave * 20480);
    for (int it = 0;; ++it) {
        int m, slot; bool doU, doV;
        if (it < NSTATIC) { slot = it; m = c.gw + it * c.ngw; doU = true; doV = false; }
        else if (it < 2 * NSTATIC) { slot = it - NSTATIC; m = c.gw + slot * c.ngw; doU = false; doV = true; }
        else { unsigned t = 0; if (lane == 0) t = __hip_atomic_fetch_add(tokctr, 1u, __ATOMIC_RELAXED, __HIP_MEMORY_SCOPE_AGENT); m = NSTATIC * c.ngw + (int)__builtin_amdgcn_readfirstlane(t); if (m >= M) break; slot = 0; doU = true; doV = true; }
        if (m >= M) continue;
        const int b = m / SEQ;
        LAS int* ps = park + slot * 256;
        int ia = 0, ib = 0; float wa = 0.f, wb = 0.f;
        if (doU) {
        f32x2 hf[16];
#pragma unroll
        for (int i = 0; i < 4; ++i) { const u32x4 a = *(const u32x4*)(H2 + (size_t)m * D + lane * 32 + i * 8);
#pragma unroll
            for (int q = 0; q < 4; ++q) hf[4 * i + q] = (f32x2){bflo(a[q]), bfhi(a[q])}; }
        ia = IDX[(size_t)m * 128 + lane]; ib = IDX[(size_t)m * 128 + 64 + lane];
        const float ga = GW[(size_t)m * 128 + lane], gb = GW[(size_t)m * 128 + 64 + lane];
#pragma unroll 1
        for (int k0 = 0; k0 < 128; k0 += G) {
            u32x4 ua[G]; u32x2 ub[G];
#pragma unroll
            for (int g = 0; g < G; ++g) {
                const int e = __builtin_amdgcn_readlane(k0 < 64 ? ia : ib, (k0 + g) & 63) & rowmask;
                const unsigned char* ur = U + (size_t)e * 1536;
                ua[g] = *(const u32x4*)(ur + (unsigned)lane * 16u); ub[g] = *(const u32x2*)(ur + 1024u + (unsigned)lane * 8u);
            }
            float d[G];
#pragma unroll
            for (int g = 0; g < G; ++g) {
                const f32x32v f = __builtin_amdgcn_cvt_scalef32_pk32_f32_fp6((u32x6){ua[g][0], ua[g][1], ua[g][2], ua[g][3], ub[g][0], ub[g][1]}, 1.0f);
                f32x2 d2 = {0.f, 0.f};
#pragma unroll
                for (int i = 0; i < 16; ++i) d2 = (f32x2){f[2 * i], f[2 * i + 1]} * hf[i] + d2;
                d[g] = d2.x + d2.y;
            }
            { const bool u5 = lane & 32, u4 = lane & 16, u3 = lane & 8;
              float r4[4];
#pragma unroll
              for (int i = 0; i < 4; ++i) { const float send = u5 ? d[i] : d[4 + i], keep = u5 ? d[4 + i] : d[i]; r4[i] = keep + __shfl_xor(send, 32); }
              float r2[2];
#pragma unroll
              for (int i = 0; i < 2; ++i) { const float send = u4 ? r4[i] : r4[2 + i], keep = u4 ? r4[2 + i] : r4[i]; r2[i] = keep + __shfl_xor(send, 16); }
              const float send = u3 ? r2[0] : r2[1], keep = u3 ? r2[1] : r2[0];
              float r1 = keep + __shfl_xor(send, 8);
              r1 += __shfl_xor(r1, 4); r1 += __shfl_xor(r1, 2); r1 += __shfl_xor(r1, 1);
              const float act = gelu_tanh(r1 * (1.f / U8_SCALE)) * (1.f / V8_SCALE);
              const int gsel = lane - (k0 & 63);
              const int src = ((gsel & 4) << 3) | ((gsel & 2) << 3) | ((gsel & 1) << 3);
              const float got = __shfl(act, src & 63);
              if (gsel >= 0 && gsel < G) { if (k0 < 64) wa = got * ga; else wb = got * gb; }
            }
        }
        ps[lane] = ia; ps[64 + lane] = ib; ps[128 + lane] = __builtin_bit_cast(int, wa); ps[192 + lane] = __builtin_bit_cast(int, wb);
        }
        if (!doV) continue;
        if (!doU) { ia = ps[lane]; ib = ps[64 + lane]; wa = __builtin_bit_cast(float, ps[128 + lane]); wb = __builtin_bit_cast(float, ps[192 + lane]); }
        f32x2 acc[16];
#pragma unroll
        for (int i = 0; i < 16; ++i) acc[i] = (f32x2){0.f, 0.f};
#define VB_ISSUE(P, K0) do { _Pragma("unroll") for (int g = 0; g < 8; ++g) { \
            const int e = __builtin_amdgcn_readlane((K0) < 64 ? ia : ib, ((K0) + g) & 63) & rowmask; \
            P##w[g] = __builtin_bit_cast(float, __builtin_amdgcn_readlane(__builtin_bit_cast(int, (K0) < 64 ? wa : wb), ((K0) + g) & 63)); \
            const unsigned char* vr = V + (size_t)e * 1536; \
            P##a[g] = *(const u32x4*)(vr + (unsigned)lane * 16u); P##b[g] = *(const u32x2*)(vr + 1024u + (unsigned)lane * 8u); } } while (0)
#define VB_COMPUTE(P) do { _Pragma("unroll") for (int g = 0; g < 8; ++g) { const f32x2 w2 = {P##w[g], P##w[g]}; \
            const f32x32v f = __builtin_amdgcn_cvt_scalef32_pk32_f32_fp6((u32x6){P##a[g][0], P##a[g][1], P##a[g][2], P##a[g][3], P##b[g][0], P##b[g][1]}, 1.0f); \
            _Pragma("unroll") for (int i = 0; i < 16; ++i) acc[i] = (f32x2){f[2 * i], f[2 * i + 1]} * w2 + acc[i]; } } while (0)
        {
            u32x4 A_a[8], B_a[8]; u32x2 A_b[8], B_b[8]; float A_w[8], B_w[8];
            VB_ISSUE(A_, 0);
#pragma unroll 1
            for (int k0 = 0; k0 < 128; k0 += 16) {
                VB_ISSUE(B_, k0 + 8);
                VB_COMPUTE(A_);
                if (k0 + 16 < 128) VB_ISSUE(A_, k0 + 16);
                VB_COMPUTE(B_);
            }
        }
#undef VB_ISSUE
#undef VB_COMPUTE
        const float* orow = p.out + (size_t)m * D + lane * 32; float* drow = dst + (size_t)m * D + lane * 32; const float* gt2 = mod + b * 6 * D + 5 * D + lane * 32; const float* fg = p.fng + lane * 32;
        float ss = 0.f; f32x4 xv[8];
#pragma unroll
        for (int i = 0; i < 8; ++i) {
            const f32x4 xa = *(const f32x4*)(orow + 4 * i), ta = *(const f32x4*)(gt2 + 4 * i);
            const f32x4 pe = {acc[2 * i].x, acc[2 * i].y, acc[2 * i + 1].x, acc[2 * i + 1].y};
            const f32x4 v = xa + DBG_BETA * ta * pe; xv[i] = v; ss += (v[0] * v[0] + v[1] * v[1]) + (v[2] * v[2] + v[3] * v[3]);
        }
        const float rstd = rsqrtf(wave_sum(ss) * (1.f / D) + EPS);
#pragma unroll
        for (int i = 0; i < 8; ++i) *(f32x4*)(drow + 4 * i) = xv[i] * rstd * *(const f32x4*)(fg + 4 * i);
    }
}


DI void phase_gather_sorted(const Params& p, const Ctx& c) {
    const bf16_t* H2 = (const bf16_t*)(p.ws + OFF_H); const unsigned char* U = p.ws + OFF_U16; const unsigned char* V = p.ws + OFF_V16;
    const int* IDX = (const int*)(p.ws + OFF_IDX); const float* GW = (const float*)(p.ws + OFF_GW); const float* mod = (const float*)(p.ws + OFF_MOD);
    const int lane = c.lane;
    LAS unsigned char* wl = c.lds + c.wave * 20480;
    constexpr int RSH = 12;
    const bool u5 = lane & 32, u4 = lane & 16, u3 = lane & 8;
#pragma unroll 1
    for (int grp = 0; grp < 2; ++grp) {
#pragma unroll 1
        for (int t = 0; t < 4; ++t) {
            const int m = c.gw + (grp * 4 + t) * c.ngw;
            if (m >= M) continue;
            const int ia = IDX[(size_t)m * 128 + lane], ib = IDX[(size_t)m * 128 + 64 + lane];
            const float ga = GW[(size_t)m * 128 + lane], gb = GW[(size_t)m * 128 + 64 + lane];
            const int ra = ia >> RSH, rb = ib >> RSH;
            int off = 0, posA = 0, posB = 0;
#pragma unroll
            for (int r = 0; r < 4; ++r) {
                const unsigned long long mA = __ballot(ra == r), mB = __ballot(rb == r);
                const int cA = __builtin_popcountll(mA), cB = __builtin_popcountll(mB);
                const int rkA = __builtin_amdgcn_mbcnt_hi((unsigned)(mA >> 32), __builtin_amdgcn_mbcnt_lo((unsigned)mA, 0u));
                const int rkB = __builtin_amdgcn_mbcnt_hi((unsigned)(mB >> 32), __builtin_amdgcn_mbcnt_lo((unsigned)mB, 0u));
                posA = (ra == r) ? off + rkA : posA; posB = (rb == r) ? off + cA + rkB : posB; off += cA + cB;
            }
            LAS int* sE = (LAS int*)(wl + t * 1024); LAS float* sW = (LAS float*)(wl + t * 1024 + 512);
            sE[posA] = ia; sE[posB] = ib; sW[posA] = ga; sW[posB] = gb;
            LAS u32x4* hrow = (LAS u32x4*)(wl + 4096 + t * 4096 + lane * 64);
#pragma unroll
            for (int i = 0; i < 4; ++i) hrow[i] = *(const u32x4*)(H2 + (size_t)m * D + lane * 32 + i * 8);
        }
        asm volatile("s_waitcnt lgkmcnt(0)" ::: "memory");
#pragma unroll 1
        for (int vi = 0; vi < 16; ++vi) {
            {
                const int r = vi >> 2, t = vi & 3;
                const int m = c.gw + (grp * 4 + t) * c.ngw;
                if (m >= M) continue;
                LAS int* sE = (LAS int*)(wl + t * 1024); LAS float* sW = (LAS float*)(wl + t * 1024 + 512);
                const int eLo = sE[lane], eHi = sE[64 + lane];
                const unsigned long long mLo = __ballot((eLo >> RSH) == r), mHi = __ballot((eHi >> RSH) == r);
                if (!(mLo | mHi)) continue;
                const int s0 = mLo ? __builtin_ctzll(mLo) : 64 + __builtin_ctzll(mHi);
                const int e1 = s0 + __builtin_popcountll(mLo) + __builtin_popcountll(mHi);
                float wLo = sW[lane], wHi = sW[64 + lane];
                f32x2 hf[16];
                { const LAS u32x4* hrow = (const LAS u32x4*)(wl + 4096 + t * 4096 + lane * 64);
#pragma unroll
                  for (int i = 0; i < 4; ++i) { const u32x4 a = hrow[i];
#pragma unroll
                    for (int q = 0; q < 4; ++q) hf[4 * i + q] = (f32x2){bflo(a[q]), bfhi(a[q])}; } }
#pragma unroll 1
                for (int j0 = s0; j0 < e1; j0 += 8) {
                    u32x4 ua[8]; u32x2 ub[8];
#pragma unroll
                    for (int g = 0; g < 8; ++g) {
                        const int pos = j0 + g;
                        ua[g] = (u32x4){0u, 0u, 0u, 0u}; ub[g] = (u32x2){0u, 0u};
                        if (pos < e1) {
                            const int e = __builtin_amdgcn_readlane(pos < 64 ? eLo : eHi, pos & 63);
                            const unsigned char* ur = U + (size_t)e * 1536;
                            ua[g] = *(const u32x4*)(ur + (unsigned)lane * 16u); ub[g] = *(const u32x2*)(ur + 1024u + (unsigned)lane * 8u);
                        }
                    }
                    float d[8];
#pragma unroll
                    for (int g = 0; g < 8; ++g) {
                        d[g] = 0.f;
                        if (j0 + g < e1) {
                            const f32x32v f = __builtin_amdgcn_cvt_scalef32_pk32_f32_fp6((u32x6){ua[g][0], ua[g][1], ua[g][2], ua[g][3], ub[g][0], ub[g][1]}, 1.0f);
                            f32x2 d2 = {0.f, 0.f};
#pragma unroll
                            for (int i = 0; i < 16; ++i) d2 = (f32x2){f[2 * i], f[2 * i + 1]} * hf[i] + d2;
                            d[g] = d2.x + d2.y;
                        }
                    }
                    float r4[4];
#pragma unroll
                    for (int i = 0; i < 4; ++i) { const float send = u5 ? d[i] : d[4 + i], keep = u5 ? d[4 + i] : d[i]; r4[i] = keep + __shfl_xor(send, 32); }
                    float r2[2];
#pragma unroll
                    for (int i = 0; i < 2; ++i) { const float send = u4 ? r4[i] : r4[2 + i], keep = u4 ? r4[2 + i] : r4[i]; r2[i] = keep + __shfl_xor(send, 16); }
                    const float send = u3 ? r2[0] : r2[1], keep = u3 ? r2[1] : r2[0];
                    float r1 = keep + __shfl_xor(send, 8);
                    r1 += __shfl_xor(r1, 4); r1 += __shfl_xor(r1, 2); r1 += __shfl_xor(r1, 1);
                    const float act = gelu_tanh(r1 * (1.f / U8_SCALE)) * (1.f / V8_SCALE);
                    const bool inLo = (lane >= j0) && (lane < j0 + 8);
                    const int gsel = inLo ? lane - j0 : lane + 64 - j0;
                    const int src = ((gsel & 4) << 3) | ((gsel & 2) << 3) | ((gsel & 1) << 3);
                    const float got = __shfl(act, src & 63);
                    if (gsel >= 0 && gsel < 8 && j0 + gsel < e1) { if (inLo) wLo = got * wLo; else wHi = got * wHi; }
                }
                sW[lane] = wLo; sW[64 + lane] = wHi;
            }
        }
        asm volatile("s_waitcnt lgkmcnt(0)" ::: "memory");
#pragma unroll 1
        for (int r = 0; r < 4; ++r) {
#pragma unroll 1
            for (int t = 0; t < 4; ++t) {
                const int m = c.gw + (grp * 4 + t) * c.ngw;
                if (m >= M) continue;
                LAS int* sE = (LAS int*)(wl + t * 1024); LAS float* sW = (LAS float*)(wl + t * 1024 + 512);
                LAS u32x4* pk = (LAS u32x4*)(wl + 4096 + t * 4096 + lane * 64);
                const int eLo = sE[lane], eHi = sE[64 + lane]; const float wLo = sW[lane], wHi = sW[64 + lane];
                const unsigned long long mLo = __ballot((eLo >> RSH) == r), mHi = __ballot((eHi >> RSH) == r);
                const int s0 = mLo ? __builtin_ctzll(mLo) : (mHi ? 64 + __builtin_ctzll(mHi) : 0);
                const int e1 = s0 + __builtin_popcountll(mLo) + __builtin_popcountll(mHi);
                f32x2 acc[16];
                if (r == 0) {
#pragma unroll
                    for (int i = 0; i < 16; ++i) acc[i] = (f32x2){0.f, 0.f};
                } else {
#pragma unroll
                    for (int i = 0; i < 4; ++i) { const u32x4 a = pk[i];
#pragma unroll
                        for (int q = 0; q < 4; ++q) acc[4 * i + q] = (f32x2){bflo(a[q]), bfhi(a[q])}; }
                }
#define SV_ISSUE(P, J0) do { _Pragma("unroll") for (int g = 0; g < 8; ++g) { const int pos = (J0) + g; P##w[g] = 0.f; P##a[g] = (u32x4){0u, 0u, 0u, 0u}; P##b[g] = (u32x2){0u, 0u}; \
                        if (pos < e1) { const int e = __builtin_amdgcn_readlane(pos < 64 ? eLo : eHi, pos & 63); \
                            P##w[g] = __builtin_bit_cast(float, __builtin_amdgcn_readlane(__builtin_bit_cast(int, pos < 64 ? wLo : wHi), pos & 63)); \
                            const unsigned char* vr = V + (size_t)e * 1536; P##a[g] = *(const u32x4*)(vr + (unsigned)lane * 16u); P##b[g] = *(const u32x2*)(vr + 1024u + (unsigned)lane * 8u); } } } while (0)
#define SV_COMPUTE(P, J0) do { _Pragma("unroll") for (int g = 0; g < 8; ++g) if ((J0) + g < e1) { const f32x2 w2 = {P##w[g], P##w[g]}; \
                        const f32x32v f = __builtin_amdgcn_cvt_scalef32_pk32_f32_fp6((u32x6){P##a[g][0], P##a[g][1], P##a[g][2], P##a[g][3], P##b[g][0], P##b[g][1]}, 1.0f); \
                        _Pragma("unroll") for (int i = 0; i < 16; ++i) acc[i] = (f32x2){f[2 * i], f[2 * i + 1]} * w2 + acc[i]; } } while (0)
                if (s0 < e1) {
                    u32x4 A_a[8], B_a[8]; u32x2 A_b[8], B_b[8]; float A_w[8], B_w[8];
                    SV_ISSUE(A_, s0);
#pragma unroll 1
                    for (int j0 = s0; j0 < e1; j0 += 16) {
                        if (j0 + 8 < e1) SV_ISSUE(B_, j0 + 8);
                        SV_COMPUTE(A_, j0);
                        if (j0 + 16 < e1) SV_ISSUE(A_, j0 + 16);
                        if (j0 + 8 < e1) SV_COMPUTE(B_, j0 + 8);
                    }
                }
#undef SV_ISSUE
#undef SV_COMPUTE
                if (r < 3) {
#pragma unroll
                    for (int i = 0; i < 4; ++i) pk[i] = (u32x4){pk2(acc[4 * i].x, acc[4 * i].y), pk2(acc[4 * i + 1].x, acc[4 * i + 1].y), pk2(acc[4 * i + 2].x, acc[4 * i + 2].y), pk2(acc[4 * i + 3].x, acc[4 * i + 3].y)};
                } else {
                    const int b = m / SEQ;
                    float* orow = p.out + (size_t)m * D + lane * 32; const float* gt2 = mod + b * 6 * D + 5 * D + lane * 32; const float* fg = p.fng + lane * 32;
                    float ss = 0.f; f32x4 xv[8];
#pragma unroll
                    for (int i = 0; i < 8; ++i) {
                        const f32x4 xa = *(const f32x4*)(orow + 4 * i), ta = *(const f32x4*)(gt2 + 4 * i);
                        const f32x4 pe = {acc[2 * i].x, acc[2 * i].y, acc[2 * i + 1].x, acc[2 * i + 1].y};
                        const f32x4 v = xa + DBG_BETA * ta * pe; xv[i] = v; ss += (v[0] * v[0] + v[1] * v[1]) + (v[2] * v[2] + v[3] * v[3]);
                    }
                    const float rstd = rsqrtf(wave_sum(ss) * (1.f / D) + EPS);
#pragma unroll
                    for (int i = 0; i < 8; ++i) *(f32x4*)(orow + 4 * i) = xv[i] * rstd * *(const f32x4*)(fg + 4 * i);
                }
            }
        }
        asm volatile("s_waitcnt lgkmcnt(0)" ::: "memory");
    }
}
#ifndef GATHER_SORTED
#define GATHER_SORTED 1
#endif

struct XcdBarrier; DI void xcd_barrier(const XcdBarrier& b, int wave_s);
DI int rl2r(int a, int b, int k) { const int va = __builtin_amdgcn_readlane(a, k & 63), vb = __builtin_amdgcn_readlane(b, k & 63); return k < 64 ? va : vb; }
DI void phase_gather_rounds(const Params& p, const Ctx& c, const XcdBarrier& xbar) {
    const bf16_t* H2 = (const bf16_t*)(p.ws + OFF_H); const unsigned char* U = p.ws + OFF_U16; const unsigned char* V = p.ws + OFF_V16;
    const int* IDX = (const int*)(p.ws + OFF_IDX); const float* GW = (const float*)(p.ws + OFF_GW); const float* mod = (const float*)(p.ws + OFF_MOD);
    const int lane = c.lane;
    LAS unsigned char* wl = c.lds + c.wave * 20480;
    const bool u5 = lane & 32, u4 = lane & 16, u3 = lane & 8;
    constexpr int G = 8;
#pragma unroll 1
    for (int pass = 0; pass < 2; ++pass) {
#pragma unroll
        for (int t = 0; t < 4; ++t) {
            const int m = c.gw + (pass * 4 + t) * c.ngw;
            LAS unsigned char* ts = wl + t * 5120;
            if (m < M) {
#pragma unroll
                for (int i = 0; i < 4; ++i) *(LAS u32x4*)(ts + lane * 64 + i * 16) = *(const u32x4*)(H2 + (size_t)m * D + lane * 32 + i * 8);
                *(LAS int*)(ts + 4096 + lane * 4) = IDX[(size_t)m * 128 + lane]; *(LAS int*)(ts + 4096 + 256 + lane * 4) = IDX[(size_t)m * 128 + 64 + lane];
                *(LAS float*)(ts + 4608 + lane * 4) = GW[(size_t)m * 128 + lane]; *(LAS float*)(ts + 4608 + 256 + lane * 4) = GW[(size_t)m * 128 + 64 + lane];
            }
        }
        asm volatile("s_waitcnt vmcnt(0) lgkmcnt(0)" ::: "memory");
#pragma unroll 1
        for (int r = 0; r < 8; ++r) {
#pragma unroll 1
            for (int t = 0; t < 4; ++t) {
                if (c.gw + (pass * 4 + t) * c.ngw >= M) continue;
                LAS unsigned char* ts = wl + t * 5120;
                const int ia = *(LAS int*)(ts + 4096 + lane * 4), ib = *(LAS int*)(ts + 4096 + 256 + lane * 4);
                unsigned long long ma = __ballot((ia >> 11) == r), mb = __ballot((ib >> 11) == r);
                if (!(ma | mb)) continue;
                f32x2 hf[16];
#pragma unroll
                for (int i = 0; i < 4; ++i) { const u32x4 a = *(LAS u32x4*)(ts + lane * 64 + i * 16);
#pragma unroll
                    for (int q = 0; q < 4; ++q) hf[4 * i + q] = (f32x2){bflo(a[q]), bfhi(a[q])}; }
                float wa = 0.f, wb = 0.f; const unsigned long long ma0 = ma, mb0 = mb;
                while (ma | mb) {
                    u32x4 ua[G]; u32x2 ub[G]; int kk[G]; int n = 0;
#pragma unroll
                    for (int g = 0; g < G; ++g) {
                        int k = (g == 0) ? 0 : kk[g - 1];
                        if (ma) { k = __builtin_ctzll(ma); ma &= ma - 1; ++n; } else if (mb) { k = 64 + __builtin_ctzll(mb); mb &= mb - 1; ++n; }
                        kk[g] = k;
                        const int e = rl2r(ia, ib, k);
                        const unsigned char* ur = U + (size_t)e * 1536;
                        ua[g] = *(const u32x4*)(ur + (unsigned)lane * 16u); ub[g] = *(const u32x2*)(ur + 1024u + (unsigned)lane * 8u);
                    }
                    float d[G];
#pragma unroll
                    for (int g = 0; g < G; ++g) {
                        d[g] = 0.f;
                        if (g < n) {
                            const f32x32v f = __builtin_amdgcn_cvt_scalef32_pk32_f32_fp6((u32x6){ua[g][0], ua[g][1], ua[g][2], ua[g][3], ub[g][0], ub[g][1]}, 1.0f);
                            f32x2 d0 = {0.f, 0.f}, d1 = {0.f, 0.f};
#pragma unroll
                            for (int i = 0; i < 8; ++i) { d0 = (f32x2){f[4 * i], f[4 * i + 1]} * hf[2 * i] + d0; d1 = (f32x2){f[4 * i + 2], f[4 * i + 3]} * hf[2 * i + 1] + d1; }
                            d[g] = (d0.x + d0.y) + (d1.x + d1.y);
                        }
                    }
                    float r4[4];
#pragma unroll
                    for (int i = 0; i < 4; ++i) { const float send = u5 ? d[i] : d[4 + i], keep = u5 ? d[4 + i] : d[i]; r4[i] = keep + __shfl_xor(send, 32); }
                    float r2[2];
#pragma unroll
                    for (int i = 0; i < 2; ++i) { const float send = u4 ? r4[i] : r4[2 + i], keep = u4 ? r4[2 + i] : r4[i]; r2[i] = keep + __shfl_xor(send, 16); }
                    const float send = u3 ? r2[0] : r2[1], keep = u3 ? r2[1] : r2[0];
                    float r1 = keep + __shfl_xor(send, 8);
                    r1 += __shfl_xor(r1, 4); r1 += __shfl_xor(r1, 2); r1 += __shfl_xor(r1, 1);
                    const float act = gelu_tanh(r1 * (1.f / U8_SCALE)) * (1.f / V8_SCALE);
#pragma unroll
                    for (int g = 0; g < G; ++g) if (g < n) {
                        const float av = __builtin_bit_cast(float, __builtin_amdgcn_readlane(__builtin_bit_cast(int, act), ((g & 4) << 3) | ((g & 2) << 3) | ((g & 1) << 3)));
                        const int k = kk[g];
                        if (k < 64) { if (lane == k) wa = av; } else { if (lane == k - 64) wb = av; }
                    }
                }
                if ((ma0 >> lane) & 1ull) { LAS float* gp = (LAS float*)(ts + 4608 + lane * 4); *gp = *gp * wa; }
                if ((mb0 >> lane) & 1ull) { LAS float* gp = (LAS float*)(ts + 4608 + 256 + lane * 4); *gp = *gp * wb; }
            }
            if (DBG_ROUND_BAR) xcd_barrier(xbar, c.wave);
        }
        asm volatile("s_waitcnt lgkmcnt(0)" ::: "memory");
#pragma unroll 1
        for (int t = 0; t < 4; ++t) {
            const int m = c.gw + (pass * 4 + t) * c.ngw;
            if (m >= M) continue;
            const int b = m / SEQ;
            LAS unsigned char* ts = wl + t * 5120;
            const int ia = *(LAS int*)(ts + 4096 + lane * 4), ib = *(LAS int*)(ts + 4096 + 256 + lane * 4);
            const float wa = *(LAS float*)(ts + 4608 + lane * 4), wb = *(LAS float*)(ts + 4608 + 256 + lane * 4);
            f32x2 acc[16];
#pragma unroll
            for (int i = 0; i < 16; ++i) acc[i] = (f32x2){0.f, 0.f};
#pragma unroll 1
            for (int k0 = 0; k0 < 128; k0 += G) {
                u32x4 va[G]; u32x2 vb[G]; float wk[G];
#pragma unroll
                for (int g = 0; g < G; ++g) {
                    const int e = __builtin_amdgcn_readlane(k0 < 64 ? ia : ib, (k0 + g) & 63);
                    wk[g] = __builtin_bit_cast(float, __builtin_amdgcn_readlane(__builtin_bit_cast(int, k0 < 64 ? wa : wb), (k0 + g) & 63));
                    const unsigned char* vr = V + (size_t)e * 1536;
                    va[g] = *(const u32x4*)(vr + (unsigned)lane * 16u); vb[g] = *(const u32x2*)(vr + 1024u + (unsigned)lane * 8u);
                }
#pragma unroll
                for (int g = 0; g < G; ++g) { const f32x2 w2 = {wk[g], wk[g]};
                    const f32x32v f = __builtin_amdgcn_cvt_scalef32_pk32_f32_fp6((u32x6){va[g][0], va[g][1], va[g][2], va[g][3], vb[g][0], vb[g][1]}, 1.0f);
#pragma unroll
                    for (int i = 0; i < 16; ++i) acc[i] = (f32x2){f[2 * i], f[2 * i + 1]} * w2 + acc[i]; }
            }
            float* orow = p.out + (size_t)m * D + lane * 32; const float* gt2 = mod + b * 6 * D + 5 * D + lane * 32; const float* fg = p.fng + lane * 32;
            float ss = 0.f; f32x4 xv[8];
#pragma unroll
            for (int i = 0; i < 8; ++i) {
                const f32x4 xa = *(const f32x4*)(orow + 4 * i), ta = *(const f32x4*)(gt2 + 4 * i);
                const f32x4 pe = {acc[2 * i].x, acc[2 * i].y, acc[2 * i + 1].x, acc[2 * i + 1].y};
                const f32x4 v = xa + DBG_BETA * ta * pe; xv[i] = v; ss += (v[0] * v[0] + v[1] * v[1]) + (v[2] * v[2] + v[3] * v[3]);
            }
            const float rstd = rsqrtf(wave_sum(ss) * (1.f / D) + EPS);
#pragma unroll
            for (int i = 0; i < 8; ++i) *(f32x4*)(orow + 4 * i) = xv[i] * rstd * *(const f32x4*)(fg + 4 * i);
        }
    }
}
#ifndef GATHER_ROUNDS
#define GATHER_ROUNDS 0
#endif

constexpr size_t OFF_WK = OFF_GB + (size_t)32 * 1024 * 1024;
constexpr size_t OFF_SSQ = OFF_GB + (size_t)48 * 1024 * 1024;
constexpr int NPU = 2, NPV = 2;
struct PairPick { int k; bool valid; };
DI PairPick pick_next(unsigned long long& ma, unsigned long long& mb, int prev) {
    PairPick r;
    if (ma) { r.k = __builtin_ctzll(ma); ma &= ma - 1; r.valid = true; }
    else if (mb) { r.k = 64 + __builtin_ctzll(mb); mb &= mb - 1; r.valid = true; }
    else { r.k = prev; r.valid = false; }
    return r;
}
DI int rl2(int a, int b, int k) { const int va = __builtin_amdgcn_readlane(a, k & 63), vb = __builtin_amdgcn_readlane(b, k & 63); return k < 64 ? va : vb; }
DI float rl2f(float a, float b, int k) { return __builtin_bit_cast(float, rl2(__builtin_bit_cast(int, a), __builtin_bit_cast(int, b), k)); }

DI void gather_u(const Params& p, const Ctx& c) {
    const bf16_t* H2 = (const bf16_t*)(p.ws + OFF_H); const unsigned char* U = p.ws + OFF_U16;
    const int* IDX = (const int*)(p.ws + OFF_IDX); const float* GW = (const float*)(p.ws + OFF_GW); float* WK = (float*)(p.ws + OFF_WK);
    const int x = blockIdx.x & 7, jb = blockIdx.x >> 3, nj = ((int)gridDim.x - x + 7) >> 3;
    const int wl = jb * NWAVES + c.wave, nwl = nj * NWAVES;
    constexpr int G = 4, SH = (NPU == 2) ? 10 : 11;
#pragma unroll 1
    for (int ps = 0; ps < NPU; ++ps) {
        const int part = x * NPU + ps;
#pragma unroll 1
        for (int m = wl; m < M; m += nwl) {
            const int ia = IDX[(size_t)m * 128 + c.lane], ib = IDX[(size_t)m * 128 + 64 + c.lane];
            unsigned long long ma = __ballot((ia >> SH) == part), mb = __ballot((ib >> SH) == part);
            if (!(ma | mb)) continue;
            const unsigned long long ma0 = ma, mb0 = mb;
            float hf[2][16];
#pragma unroll
            for (int j = 0; j < 2; ++j) { const u32x4 a = *(const u32x4*)(H2 + (size_t)m * D + j * 1024 + c.lane * 16), bq = *(const u32x4*)(H2 + (size_t)m * D + j * 1024 + c.lane * 16 + 8);
#pragma unroll
                for (int q = 0; q < 4; ++q) { hf[j][2 * q] = bflo(a[q]); hf[j][2 * q + 1] = bfhi(a[q]); hf[j][8 + 2 * q] = bflo(bq[q]); hf[j][8 + 2 * q + 1] = bfhi(bq[q]); } }
            const float ga = GW[(size_t)m * 128 + c.lane], gb = GW[(size_t)m * 128 + 64 + c.lane];
            float wa = 0.f, wb = 0.f;
            int prev = 0;
            while (ma | mb) {
                PairPick pk[G]; u32x4 uu[G][2];
#pragma unroll
                for (int g = 0; g < G; ++g) { pk[g] = pick_next(ma, mb, prev); prev = pk[g].k;
                    const int e = rl2(ia, ib, pk[g].k);
                    const unsigned char* ur = U + (size_t)e * D;
#pragma unroll
                    for (int j = 0; j < 2; ++j) uu[g][j] = *(const u32x4*)(ur + ((unsigned)c.lane * 16u + j * 1024u)); }
                float d[G];
#pragma unroll
                for (int g = 0; g < G; ++g) {
                    float d0 = 0.f, d1 = 0.f;
#pragma unroll
                    for (int j = 0; j < 2; ++j)
#pragma unroll
                        for (int q = 0; q < 4; ++q) { const f32x2 lo = __builtin_amdgcn_cvt_pk_f32_fp8((int)uu[g][j][q], false), hi = __builtin_amdgcn_cvt_pk_f32_fp8((int)uu[g][j][q], true);
                            d0 += lo.x * hf[j][4 * q] + hi.x * hf[j][4 * q + 2]; d1 += lo.y * hf[j][4 * q + 1] + hi.y * hf[j][4 * q + 3]; }
                    d[g] = d0 + d1;
                }
#pragma unroll
                for (int o = 1; o < 64; o <<= 1)
#pragma unroll
                    for (int g = 0; g < G; ++g) d[g] += __shfl_xor(d[g], o);
#pragma unroll
                for (int g = 0; g < G; ++g) if (pk[g].valid) {
                    const float a = gelu_tanh(d[g] * (1.f / U8_SCALE)) * (1.f / V8_SCALE); const int k = pk[g].k;
                    if (k < 64) { if (c.lane == k) wa = a * ga; } else { if (c.lane == k - 64) wb = a * gb; }
                }
            }
            if ((ma0 >> c.lane) & 1ull) WK[(size_t)m * 128 + c.lane] = wa;
            if ((mb0 >> c.lane) & 1ull) WK[(size_t)m * 128 + 64 + c.lane] = wb;
        }
    }
}

DI void gather_v(const Params& p, const Ctx& c) {
    const unsigned char* V = p.ws + OFF_V16;
    const int* IDX = (const int*)(p.ws + OFF_IDX); const float* WK = (const float*)(p.ws + OFF_WK); const float* mod = (const float*)(p.ws + OFF_MOD);
    float* SSQ = (float*)(p.ws + OFF_SSQ);
    const int x = blockIdx.x & 7, jb = blockIdx.x >> 3, nj = ((int)gridDim.x - x + 7) >> 3;
    const int wl = jb * NWAVES + c.wave, nwl = nj * NWAVES;
    const int q4 = c.lane >> 4, l16 = c.lane & 15;
    const unsigned voff = 256u * x + l16 * 16u;
    constexpr int SHV = (NPV == 2) ? 13 : 14;
#pragma unroll 1
    for (int ps = 0; ps < NPV; ++ps) {
#pragma unroll 1
        for (int m = wl; m < M; m += nwl) {
            const int b = m / SEQ;
            const int ia = IDX[(size_t)m * 128 + c.lane], ib = IDX[(size_t)m * 128 + 64 + c.lane];
            const float wa = WK[(size_t)m * 128 + c.lane], wb = WK[(size_t)m * 128 + 64 + c.lane];
            unsigned long long ma = __ballot((ia >> SHV) == ps), mb = __ballot((ib >> SHV) == ps);
            float acc[16];
#pragma unroll
            for (int i = 0; i < 16; ++i) acc[i] = 0.f;
            int prev = 0;
            while (ma | mb) {
                u32x4 vv[4]; float wv[4];
#pragma unroll
                for (int s4 = 0; s4 < 4; ++s4) {
                    int e = 0; float w = 0.f;
#pragma unroll
                    for (int g = 0; g < 4; ++g) { const PairPick pk = pick_next(ma, mb, prev); prev = pk.k;
                        const int eg = rl2(ia, ib, pk.k); const float wg = pk.valid ? rl2f(wa, wb, pk.k) : 0.f;
                        e = (q4 == g) ? eg : e; w = (q4 == g) ? wg : w; }
                    vv[s4] = *(const u32x4*)(V + (size_t)e * D + voff); wv[s4] = w;
                }
#pragma unroll
                for (int s4 = 0; s4 < 4; ++s4)
#pragma unroll
                    for (int q = 0; q < 4; ++q) { const f32x2 lo = __builtin_amdgcn_cvt_pk_f32_fp8((int)vv[s4][q], false), hi = __builtin_amdgcn_cvt_pk_f32_fp8((int)vv[s4][q], true);
                        acc[4 * q] += wv[s4] * lo.x; acc[4 * q + 1] += wv[s4] * lo.y; acc[4 * q + 2] += wv[s4] * hi.x; acc[4 * q + 3] += wv[s4] * hi.y; }
            }
#pragma unroll
            for (int i = 0; i < 16; ++i) { acc[i] += __shfl_xor(acc[i], 16); acc[i] += __shfl_xor(acc[i], 32); }
            f32x4 sel;
#pragma unroll
            for (int e = 0; e < 4; ++e) sel[e] = q4 == 0 ? acc[e] : (q4 == 1 ? acc[4 + e] : (q4 == 2 ? acc[8 + e] : acc[12 + e]));
            const int col = 256 * x + 16 * l16 + 4 * q4;
            float* op = p.out + (size_t)m * D + col;
            const f32x4 val = *(const f32x4*)op + DBG_BETA * *(const f32x4*)(mod + b * 6 * D + 5 * D + col) * sel;
            *(f32x4*)op = val;
            if (ps == NPV - 1) { const float ss = wave_sum(val[0] * val[0] + val[1] * val[1] + val[2] * val[2] + val[3] * val[3]); if (c.lane == 0) SSQ[(size_t)m * 8 + x] = ss; }
        }
    }
}
DI void gather_final(const Params& p, const Ctx& c) {
    const float* SSQ = (const float*)(p.ws + OFF_SSQ);
    for (int m = c.gw; m < M; m += c.ngw) {
        float s = (c.lane < 8) ? SSQ[(size_t)m * 8 + c.lane] : 0.f;
        s += __shfl_xor(s, 1); s += __shfl_xor(s, 2); s += __shfl_xor(s, 4);
        const float rstd = rsqrtf(__shfl(s, 0) * (1.f / D) + EPS);
        float* orow = p.out + (size_t)m * D;
#pragma unroll
        for (int j = 0; j < 8; ++j) { const int col = (j * 64 + c.lane) * 4; *(f32x4*)(orow + col) = *(const f32x4*)(orow + col) * rstd * *(const f32x4*)(p.fng + col); }
    }
}
#ifndef GATHER_L2
#define GATHER_L2 0
#endif

DI void phase_gather_v2(const Params& p, const Ctx& c) {
    const bf16_t* H2 = (const bf16_t*)(p.ws + OFF_H);
    const int* IDX = (const int*)(p.ws + OFF_IDX); const float* GW = (const float*)(p.ws + OFF_GW); const float* mod = (const float*)(p.ws + OFF_MOD);
    LAS float* hs = (LAS float*)c.lds; LAS float* wk = hs + 2048; LAS int* ek = (LAS int*)(wk + 128); LAS float* red = (LAS float*)(ek + 128);
    for (int m = blockIdx.x; m < M; m += gridDim.x) {
        const int b = m / SEQ;
        __syncthreads();
        for (int i = c.tid; i < 2048; i += NTHREADS) hs[i] = bf2f(H2[(size_t)m * D + i]);
        if (c.tid < 128) ek[c.tid] = IDX[(size_t)m * 128 + c.tid];
        __syncthreads();
        for (int k = c.wave; k < 128; k += NWAVES) {
            const float* ur = p.pu + (size_t)ek[k] * D;
            float d = 0.f;
            for (int i = 0; i < 8; ++i) { const int col = i * 256 + c.lane * 4; const f32x4 u = *(const f32x4*)(ur + col);
                d += u[0] * hs[col] + u[1] * hs[col + 1] + u[2] * hs[col + 2] + u[3] * hs[col + 3]; }
            d = wave_sum(d);
            if (c.lane == 0) wk[k] = gelu_tanh(d) * GW[(size_t)m * 128 + k];
        }
        __syncthreads();
        const int col = c.tid * 4;
        f32x4 acc = {0.f, 0.f, 0.f, 0.f};
        for (int k = 0; k < 128; ++k) { const f32x4 v = *(const f32x4*)(p.pv + (size_t)ek[k] * D + col); acc += v * wk[k]; }
        float* orow = p.out + (size_t)m * D;
        const f32x4 x2 = *(const f32x4*)(orow + col) + DBG_BETA * *(const f32x4*)(mod + b * 6 * D + 5 * D + col) * acc;
        float ss = wave_sum(x2[0] * x2[0] + x2[1] * x2[1] + x2[2] * x2[2] + x2[3] * x2[3]);
        if (c.lane == 0) red[c.wave] = ss;
        __syncthreads();
        float tot = 0.f;
        for (int w = 0; w < NWAVES; ++w) tot += red[w];
        const float rstd = rsqrtf(tot * (1.f / D) + EPS);
        *(f32x4*)(orow + col) = x2 * rstd * *(const f32x4*)(p.fng + col);
    }
}


#define XB_TMO      128
#define XB_XCNT(j)  (256  + 64 * (j))
#define XB_XSUB(j)  (1280 + 64 * (j))
#define XB_XGEN(j)  (2304 + 64 * (j))
#define XB_TOP      3328
#define XB_TOPGEN   3392
#define XCD_BAR_WORDS 3456
#define XB_SPIN_CAP (1u << 18)

__device__ __forceinline__ unsigned xb_ld(unsigned* p)              { return __hip_atomic_load(p, __ATOMIC_RELAXED, __HIP_MEMORY_SCOPE_AGENT); }
__device__ __forceinline__ unsigned xb_add(unsigned* p, unsigned v) { return __hip_atomic_fetch_add(p, v, __ATOMIC_RELAXED, __HIP_MEMORY_SCOPE_AGENT); }
__device__ __forceinline__ unsigned xb_xcc_id() { return (unsigned)__builtin_amdgcn_s_getreg((3 << 11) | 20) & 0xFu; }
#define XB_SPIN(cond, bar) do { unsigned _sp = 0; while (cond) { __builtin_amdgcn_s_sleep(1); \
    if ((++_sp & 255u) == 0u) { if (xb_ld(&(bar)[XB_TMO])) break; if (_sp > XB_SPIN_CAP) { atomicAdd(&(bar)[XB_TMO], 1u); break; } } } } while (0)

struct XcdBarrier {
    unsigned* bar; unsigned x;
    volatile LAS unsigned* st;
};

__device__ __forceinline__ XcdBarrier xcd_barrier_post(unsigned* bar, volatile LAS unsigned* st) {
    XcdBarrier b; b.bar = bar; b.x = xb_xcc_id(); b.st = st;
    if (threadIdx.x == 0) (void)xb_add(&bar[XB_XCNT(b.x)], 1u);
    return b;
}
__device__ __forceinline__ void xcd_barrier_complete(unsigned* bar, unsigned x, unsigned& nloc, unsigned& nx) {
    const unsigned G = gridDim.x * gridDim.y * gridDim.z;
    unsigned sum, cnt, mine, sp = 0u;
    for (;;) {
        sum = 0u; cnt = 0u; mine = 0u;
#pragma unroll
        for (unsigned j = 0; j < 16; ++j) { const unsigned c = xb_ld(&bar[XB_XCNT(j)]); sum += c; cnt += (c > 0u) ? 1u : 0u; mine = (j == x) ? c : mine; }
        if (sum == G) break;
        __builtin_amdgcn_s_sleep(1);
        if ((++sp & 255u) == 0u) { if (xb_ld(&bar[XB_TMO])) break; if (sp > XB_SPIN_CAP) { atomicAdd(&bar[XB_TMO], 1u); break; } }
    }
    nloc = mine > 0u ? mine : 1u; nx = cnt > 0u ? cnt : 1u;
}

__device__ __forceinline__ bool xb_lead(int wave_s) { return wave_s == 0 && __builtin_amdgcn_mbcnt_hi(~0u, __builtin_amdgcn_mbcnt_lo(~0u, 0u)) == 0; }
__device__ __forceinline__ void xcd_barrier(const XcdBarrier& b, int wave_s) {
    asm volatile("s_waitcnt vmcnt(0)" ::: "memory");
    __syncthreads();
    if (xb_lead(wave_s)) {
        unsigned* bar = b.bar;
        __builtin_amdgcn_s_waitcnt(0);
        unsigned nloc = b.st[0], nx = b.st[1];
        if (nloc == 0u) { xcd_barrier_complete(bar, b.x, nloc, nx); b.st[0] = nloc; b.st[1] = nx; }
        const unsigned old = xb_add(&bar[XB_XSUB(b.x)], 1u);
        const unsigned gen = old / nloc;
        if (old + 1u == (gen + 1u) * nloc) {
            __builtin_amdgcn_fence(__ATOMIC_RELEASE, "agent");
            asm volatile("s_waitcnt vmcnt(0)" ::: "memory");
            const unsigned og = xb_add(&bar[XB_TOP], 1u);
            const unsigned tg = og / nx;
            if (og + 1u == (tg + 1u) * nx) xb_add(&bar[XB_TOPGEN], 1u);
            else XB_SPIN(xb_ld(&bar[XB_TOPGEN]) == tg, bar);
            __builtin_amdgcn_fence(__ATOMIC_ACQUIRE, "agent");
            xb_add(&bar[XB_XGEN(b.x)], 1u);
            asm volatile("s_waitcnt vmcnt(0)" ::: "memory");
        } else {
            XB_SPIN(xb_ld(&bar[XB_XGEN(b.x)]) == gen, bar);
            __builtin_amdgcn_fence(__ATOMIC_ACQUIRE, "agent");
            asm volatile("s_waitcnt vmcnt(0)" ::: "memory");
        }
    }
    __syncthreads();
}


DI void grid_barrier(unsigned* ctr, unsigned target, int wave_s) {
    asm volatile("s_waitcnt vmcnt(0)" ::: "memory");
    __syncthreads();
    if (wave_s == 0) {
        const int l = __builtin_amdgcn_mbcnt_hi(~0u, __builtin_amdgcn_mbcnt_lo(~0u, 0u));
        if (l == 0) {
            __builtin_amdgcn_fence(__ATOMIC_RELEASE, "agent");
            asm volatile("s_waitcnt vmcnt(0)" ::: "memory");
            __hip_atomic_fetch_add(ctr, 1u, __ATOMIC_RELAXED, __HIP_MEMORY_SCOPE_AGENT);
            unsigned spins = 0;
            while (__hip_atomic_load(ctr, __ATOMIC_RELAXED, __HIP_MEMORY_SCOPE_AGENT) < target) { __builtin_amdgcn_s_sleep(2); if (++spins > (1u << 23)) break; }
            __builtin_amdgcn_fence(__ATOMIC_ACQUIRE, "agent");
            asm volatile("s_waitcnt vmcnt(0)" ::: "memory");
        }
    }
    __syncthreads();
}

__global__ void __launch_bounds__(NTHREADS, 2) mega(Params p) {
    extern __shared__ __attribute__((aligned(16))) unsigned char lds_raw[];
    const int wave_s = __builtin_amdgcn_readfirstlane(threadIdx.x >> 6);
#define MKCTX() Ctx c; { int l_; asm volatile("v_mbcnt_lo_u32_b32 %0, -1, 0\n\tv_mbcnt_hi_u32_b32 %0, -1, %0" : "=v"(l_)); c.lds = (LAS unsigned char*)lds_raw; c.lane = l_; c.wave = wave_s; c.tid = wave_s * 64 + l_; \
    c.gw = blockIdx.x * NWAVES + wave_s; c.ngw = gridDim.x * NWAVES; }
    unsigned char* ws = p.ws;
    const float* mod = (const float*)(ws + OFF_MOD);
    const int lo = p.ph_lo, hi = p.ph_hi;
    XcdBarrier xbar; xbar.bar = (unsigned*)(ws + OFF_XBAR); xbar.x = 0; xbar.st = nullptr;
    if (USE_XBAR && lo == 0 && hi == NPHASE) {
        volatile LAS unsigned* stw = (volatile LAS unsigned*)(lds_raw + LDS_BYTES - 32);
        if (threadIdx.x < 2) stw[threadIdx.x] = 0u;
        __syncthreads();
        xbar = xcd_barrier_post((unsigned*)(ws + OFF_XBAR), stw);
    }
#define IN(k) (lo <= (k) && (k) < hi)
#define SEAM(k) do { if (IN(k) && IN((k) + 1)) { if (USE_XBAR) xcd_barrier(xbar, wave_s); else grid_barrier((unsigned*)(ws + OFF_CTL), (unsigned)((k) + 1) * gridDim.x, wave_s); \
    if (TIME_PHASE >= 0 && blockIdx.x == 0 && threadIdx.x == 0) ((unsigned long long*)(ws + OFF_CTL + 512))[(k) + 1] = __builtin_amdgcn_s_memrealtime(); } } while (0)

    if (TIME_PHASE >= 0 && blockIdx.x == 0 && threadIdx.x == 0) ((unsigned long long*)(ws + OFF_CTL + 512))[0] = __builtin_amdgcn_s_memrealtime();
    if (IN(0)) { MKCTX(); phase_prologue(p, c, true, PRO_SPLIT == 0); }
    SEAM(0);
    if (IN(1)) for (int rep_ = 0; rep_ < (DUP_PHASE == 1 ? 2 : 1); ++rep_) { MKCTX();
        const long long* modi = (const long long*)(ws + OFF_MODI); float* modw = (float*)(ws + OFF_MOD);
        for (int i = blockIdx.x * NTHREADS + c.tid; i < NB * 6 * D; i += gridDim.x * NTHREADS) modw[i] = (float)((double)modi[i] * (1.0 / 4294967296.0));
        modulate_rows<P2_FP8 != 0>(p.x, p.n1g, modi + 1 * D, modi + 0 * D, (bf16_t*)(ws + OFF_H), c);
        if (PRO_SPLIT) phase_prologue(p, c, false, true);
    }
    SEAM(1);
    if (IN(2)) for (int rep_ = 0; rep_ < (DUP_PHASE == 2 ? 2 : 1); ++rep_) { MKCTX();
        EpiProj e1{(bf16_t*)(ws + OFF_CQ), (bf16_t*)(ws + OFF_CKV), (bf16_t*)(ws + OFF_KR), (bf16_t*)(ws + OFF_SBQ), (bf16_t*)(ws + OFF_SBK), (bf16_t*)(ws + OFF_GA), (bf16_t*)(ws + OFF_GB), (const f32x2*)(ws + OFF_CS), P2_FP8 ? 1.f / W8_SCALE : 1.f};
#if P2_FP8
        GEMM8(c, ws + OFF_H, ws + OFF_WIN, M, 7168, 2048, e1);
#else
        GEMM(c, (const bf16_t*)(ws + OFF_H), (const bf16_t*)(ws + OFF_WIN), M, 7168, 2048, e1);
#endif
        if (DUP_GEMM == 20) GEMM(c, (const bf16_t*)(ws + OFF_H), (const bf16_t*)(ws + OFF_WIN), M, 7168, 2048, e1);
        EpiT e2{(bf16_t*)(ws + OFF_SBVT), nullptr, P2_FP8 ? 1.f / W8_SCALE : 1.f};
#if P2_FP8
        GEMM8(c, ws + OFF_WSBV, ws + OFF_H, 1024, M, 2048, e2);
#else
        GEMM(c, (const bf16_t*)(ws + OFF_WSBV), (const bf16_t*)(ws + OFF_H), 1024, M, 2048, e2);
#endif
        if (DUP_GEMM == 21) GEMM(c, (const bf16_t*)(ws + OFF_WSBV), (const bf16_t*)(ws + OFF_H), 1024, M, 2048, e2);
    }
    SEAM(2);
    if (IN(3)) for (int rep_ = 0; rep_ < (DUP_PHASE == 3 ? 2 : 1); ++rep_) { MKCTX(); phase_rowstats(p, c); }
    SEAM(3);
    if (DBG_XTRA_BAR) { for (int q_ = 0; q_ < DBG_XTRA_BAR; ++q_) { if (IN(3) && IN(4)) xcd_barrier(xbar, wave_s); } }
    if (IN(4)) for (int rep_ = 0; rep_ < (DUP_PHASE == 4 ? 2 : 1); ++rep_) { MKCTX();
        EpiUq e1{(bf16_t*)(ws + OFF_Q), (const float*)(ws + OFF_RSTQ), (const f32x2*)(ws + OFF_CS)};
        GEMM(c, (const bf16_t*)(ws + OFF_CQ), (const bf16_t*)(ws + OFF_WUQ), M, 1536, 512, e1);
        if (DUP_GEMM == 40) GEMM(c, (const bf16_t*)(ws + OFF_CQ), (const bf16_t*)(ws + OFF_WUQ), M, 1536, 512, e1);
        EpiRowScale e2{(bf16_t*)(ws + OFF_KN), 1024, (const float*)(ws + OFF_RSTKV)};
        GEMM(c, (const bf16_t*)(ws + OFF_CKV), (const bf16_t*)(ws + OFF_WUK), M, 1024, 256, e2);
        if (DUP_GEMM == 41) GEMM(c, (const bf16_t*)(ws + OFF_CKV), (const bf16_t*)(ws + OFF_WUK), M, 1024, 256, e2);
        EpiT e3{(bf16_t*)(ws + OFF_VT), (const float*)(ws + OFF_RSTKV), 1.f};
        GEMM(c, (const bf16_t*)(ws + OFF_WUV), (const bf16_t*)(ws + OFF_CKV), 1024, M, 256, e3);
        if (DUP_GEMM == 42) GEMM(c, (const bf16_t*)(ws + OFF_WUV), (const bf16_t*)(ws + OFF_CKV), 1024, M, 256, e3);
    }
    SEAM(4);
    if (IN(5)) for (int rep_ = 0; rep_ < (DUP_PHASE == 5 ? 2 : 1); ++rep_) {
#if FAST_ATTN
        { MKCTX(); attn_mla_fast(p, c); }
        if (DUP_GEMM == 51) { MKCTX(); attn_mla_fast(p, c); }
        { MKCTX(); attn_sb_fast(p, c); }
        if (DUP_GEMM == 52) { MKCTX(); attn_sb_fast(p, c); }
#else
        MKCTX();
        attn_mla_naive(p, c); attn_sb_naive(p, c);
#endif
    }
    SEAM(5);
    if (IN(6)) for (int rep_ = 0; rep_ < (DUP_PHASE == 6 ? 2 : 1); ++rep_) { MKCTX();
        EpiGate1 e1{(bf16_t*)(ws + OFF_MERGED), (const bf16_t*)(ws + OFF_GA), P67_FP8 ? 1.f / (W8_SCALE * ACT8_SCALE) : 1.f};
#if P67_FP8
        GEMM8(c, ws + OFF_ATTA, ws + OFF_WA, M, 2048, 1024, e1);
#else
        GEMM(c, (const bf16_t*)(ws + OFF_ATTA), (const bf16_t*)(ws + OFF_WA), M, 2048, 1024, e1);
#endif
        if (DUP_GEMM == 60) GEMM(c, (const bf16_t*)(ws + OFF_ATTA), (const bf16_t*)(ws + OFF_WA), M, 2048, 1024, e1);
        EpiGate2 e2{(bf16_t*)(ws + OFF_MERGED), (const bf16_t*)(ws + OFF_GB), ws + OFF_H, P67_FP8 ? 1.f / (W8_SCALE * ACT8_SCALE) : 1.f};
#if P67_FP8
        GEMM8(c, ws + OFF_ATTB, ws + OFF_WB, M, 2048, 1024, e2);
#else
        GEMM(c, (const bf16_t*)(ws + OFF_ATTB), (const bf16_t*)(ws + OFF_WB), M, 2048, 1024, e2);
#endif
    }
    SEAM(6);
    if (IN(7)) for (int rep_ = 0; rep_ < (DUP_PHASE == 7 ? 2 : 1); ++rep_) { MKCTX();
        EpiRes e{p.x, mod + 2 * D, p.out, P67_FP8 ? 1.f / (W8_SCALE * ACT8_SCALE) : 1.f};
#if P67_FP8
        GEMM8(c, ws + OFF_H, ws + OFF_WOUT, M, 2048, 2048, e);
#else
        GEMM(c, (const bf16_t*)(ws + OFF_MERGED), (const bf16_t*)(ws + OFF_WOUT), M, 2048, 2048, e);
#endif
    }
    SEAM(7);
    if (IN(8)) for (int rep_ = 0; rep_ < (DUP_PHASE == 8 ? 2 : 1); ++rep_) { MKCTX();
        modulate_rows(p.out, p.n2g, mod + 4 * D, mod + 3 * D, (bf16_t*)(ws + OFF_H), c);
        convert_table(p.pu, ws + OFF_U16, U8_SCALE, c);
        convert_table(p.pv, ws + OFF_V16, V8_SCALE, c);
    }
    SEAM(8);
    if (IN(9)) for (int rep_ = 0; rep_ < (DUP_PHASE == 9 ? 2 : 1); ++rep_) { MKCTX();
        EpiPq e{(bf16_t*)(ws + OFF_PQ)};
        GEMM(c, (const bf16_t*)(ws + OFF_H), (const bf16_t*)(ws + OFF_WPQ), M, 2048, 2048, e);
#if FAST_SEL && FAST_GEMM && SEL_FUSED
        { MKCTX(); select_own_tiles(p, c); }
#endif
    }
#if !(FAST_SEL && FAST_GEMM && SEL_FUSED)
    SEAM(9);
    if (IN(10)) for (int rep_ = 0; rep_ < (DUP_PHASE == 10 ? 2 : 1); ++rep_) { MKCTX();
#if FAST_SEL
        select_fast(p, c);
#else
        select_naive(p, c);
#endif
    }
#else
    if (IN(9) && IN(10)) {   }
#endif
    SEAM(10);
#if GATHER_L2
    if (IN(11)) { MKCTX(); gather_u(p, c); }
    SEAM(11);
    if (IN(12)) { MKCTX(); gather_v(p, c); }
    SEAM(12);
    if (IN(13)) { MKCTX(); gather_final(p, c); }
#else
#if GATHER_SORTED
    if (IN(11)) { MKCTX(); phase_gather_sorted(p, c); }
#elif GATHER_ROUNDS
    if (IN(11)) { MKCTX(); phase_gather_rounds(p, c, xbar); }
#else
    if (IN(11)) { if (DUP_GEMM == 110) { MKCTX(); phase_gather(p, c, (float*)(ws + OFF_SBQ)); }
        if (DUP_GEMM == 111) { MKCTX(); phase_gather(p, c, (float*)(ws + OFF_SBQ), 0x3ff); } MKCTX(); phase_gather(p, c, p.out); }
#endif
#endif
#undef IN
#undef SEAM
}

extern "C" void kernel_launch(void* const* d_in, const int* in_sizes, int n_in, void* d_out, int out_size, void* d_ws, size_t ws_size, hipStream_t stream) {
    static int grid = 0;
    if (grid == 0) {
        if (n_in != 20 || out_size != M * D || ws_size < WS_END) { fprintf(stderr, "kernel_launch: unexpected shapes (n_in %d out %d ws %zu need %zu)\n", n_in, out_size, ws_size, (size_t)WS_END); grid = -1; return; }
        int dev = 0, cus = 0, per_cu = 0;
        (void)hipGetDevice(&dev); (void)hipDeviceGetAttribute(&cus, hipDeviceAttributeMultiprocessorCount, dev);
        if (hipFuncSetAttribute((const void*)mega, hipFuncAttributeMaxDynamicSharedMemorySize, LDS_BYTES) != hipSuccess) { fprintf(stderr, "kernel_launch: hipFuncSetAttribute failed\n"); grid = -1; return; }
        if (hipOccupancyMaxActiveBlocksPerMultiprocessor(&per_cu, (const void*)mega, NTHREADS, LDS_BYTES) != hipSuccess || per_cu < 1) { fprintf(stderr, "kernel_launch: occupancy query failed (%d)\n", per_cu); per_cu = 1; }
        (void)hipGetLastError();
        grid = cus;
    }
    if (grid < 0) return;
    (void)hipMemsetAsync((char*)d_ws + OFF_CTL, 0, ZERO_BYTES, stream);
    Params p{};
    p.x = (const float*)d_in[0]; p.c = (const float*)d_in[1]; p.pos = (const int*)d_in[2]; p.ada_w = (const float*)d_in[3]; p.ada_b = (const float*)d_in[4];
    p.n1g = (const float*)d_in[5]; p.n2g = (const float*)d_in[6]; p.w_in = (const float*)d_in[7]; p.qng = (const float*)d_in[8]; p.kvng = (const float*)d_in[9];
    p.w_uq = (const float*)d_in[10]; p.w_ukv = (const float*)d_in[11]; p.w_bm = (const float*)d_in[12]; p.w_bs = (const float*)d_in[13]; p.w_out = (const float*)d_in[14];
    p.w_pq = (const float*)d_in[15]; p.skeys = (const float*)d_in[16]; p.pu = (const float*)d_in[17]; p.pv = (const float*)d_in[18]; p.fng = (const float*)d_in[19];
    p.out = (float*)d_out; p.ws = (unsigned char*)d_ws;
    for (int i = 0; i < 32; ++i) p.invf[i] = (float)pow(10000.0, -(double)i / 32.0);
#if N_LAUNCH_MODE == 1
    p.ph_lo = 0; p.ph_hi = NPHASE;
    void* args[] = {&p};
    hipError_t e = hipLaunchCooperativeKernel((const void*)mega, dim3(grid), dim3(NTHREADS), args, LDS_BYTES, stream);
    if (e != hipSuccess) fprintf(stderr, "cooperative launch failed: %s (grid %d)\n", hipGetErrorString(e), grid);
#else
    for (int k = 0; k < NPHASE; ++k) {
        p.ph_lo = k; p.ph_hi = k + 1;
        hipLaunchKernelGGL(mega, dim3(grid), dim3(NTHREADS), LDS_BYTES, stream, p);
    }
#endif
}
```

```cpp
#include <hip/hip_runtime.h>
#include <hip/hip_cooperative_groups.h>
#include <cstdio>
#include <cstdint>
#include <cmath>
namespace cg = cooperative_groups;

#ifndef N_LAUNCH_MODE
#define N_LAUNCH_MODE 1
#endif

#ifndef TIME_PHASE
#define TIME_PHASE -1
#endif
#ifndef TIME_SCALE
#define TIME_SCALE 5000.f
#endif
#ifndef DUP_GEMM
#define DUP_GEMM -1
#endif
#ifndef PRO_SPLIT
#define PRO_SPLIT 1
#endif
#ifndef USE_XBAR
#define USE_XBAR 1
#endif
#ifndef DBG_XTRA_BAR
#define DBG_XTRA_BAR 0
#endif
#ifndef DBG_ROUND_BAR
#define DBG_ROUND_BAR 0
#endif
#ifndef GATHER_DYN
#define GATHER_DYN 1
#endif
#ifndef SEL_FUSED
#define SEL_FUSED 1
#endif
#ifndef DUP_PHASE
#define DUP_PHASE -1
#endif
#ifndef DBG_ALPHA
#define DBG_ALPHA 1.0f
#endif
#ifndef DBG_BETA
#define DBG_BETA 1.0f
#endif
#define LAS __attribute__((address_space(3)))
#define DI __device__ __forceinline__
typedef unsigned short bf16_t;
typedef short bf16x8 __attribute__((ext_vector_type(8)));
typedef float f32x4 __attribute__((ext_vector_type(4)));
typedef float f32x2 __attribute__((ext_vector_type(2)));
typedef unsigned u32x4 __attribute__((ext_vector_type(4)));
typedef unsigned u32x2 __attribute__((ext_vector_type(2)));
typedef __bf16 bf16v2 __attribute__((ext_vector_type(2)));

constexpr int M = 16384, D = 2048, SEQ = 4096, NB = 4;
constexpr int NTHREADS = 512, NWAVES = 8;
constexpr int LDS_BYTES = 160 * 1024;
constexpr float EPS = 1e-6f;
constexpr float LOG2E = 1.4426950408889634f;
constexpr int NPHASE = 14;

constexpr size_t al256(size_t x) { return (x + 255) & ~(size_t)255; }
constexpr size_t OFF_CTL = 0;
constexpr size_t OFF_XBAR = 4096;
constexpr size_t OFF_MODI = 32768;
constexpr size_t ZERO_BYTES = OFF_MODI + (size_t)NB * 6 * D * 8;
constexpr size_t OFF_MOD = al256(ZERO_BYTES);
constexpr size_t OFF_RSTQ = OFF_MOD + (size_t)NB * 6 * D * 4;
constexpr size_t OFF_RSTKV = OFF_RSTQ + (size_t)M * 4;
constexpr size_t OFF_CS = OFF_RSTKV + (size_t)M * 4;
constexpr size_t OFF_KEYS = OFF_CS + (size_t)M * 32 * 8;
constexpr size_t OFF_WIN = OFF_KEYS + (size_t)8 * 2 * 128 * 128 * 2;
constexpr size_t OFF_WSBV = OFF_WIN + (size_t)7168 * 2048 * 2;
constexpr size_t OFF_WUQ = OFF_WSBV + (size_t)1024 * 2048 * 2;
constexpr size_t OFF_WUK = OFF_WUQ + (size_t)1536 * 512 * 2;
constexpr size_t OFF_WUV = OFF_WUK + (size_t)1024 * 256 * 2;
constexpr size_t OFF_WA = OFF_WUV + (size_t)1024 * 256 * 2;
constexpr size_t OFF_WB = OFF_WA + (size_t)2048 * 1024 * 2;
constexpr size_t OFF_WOUT = OFF_WB + (size_t)2048 * 1024 * 2;
constexpr size_t OFF_WPQ = OFF_WOUT + (size_t)2048 * 2048 * 2;
constexpr size_t OFF_H = OFF_WPQ + (size_t)2048 * 2048 * 2;
constexpr size_t OFF_CQ = OFF_H + (size_t)M * 2048 * 2;
constexpr size_t OFF_CKV = OFF_CQ + (size_t)M * 512 * 2;
constexpr size_t OFF_KR = OFF_CKV + (size_t)M * 256 * 2;
constexpr size_t OFF_SBQ = OFF_KR + (size_t)M * 64 * 2;
constexpr size_t OFF_SBK = OFF_SBQ + (size_t)M * 1024 * 2;
constexpr size_t OFF_SBVT = OFF_SBK + (size_t)M * 1024 * 2;
constexpr size_t OFF_GA = OFF_SBVT + (size_t)M * 1024 * 2;
constexpr size_t OFF_GB = OFF_GA + (size_t)M * 2048 * 2;
constexpr size_t OFF_Q = OFF_GB + (size_t)M * 2048 * 2;
constexpr size_t OFF_KN = OFF_Q + (size_t)M * 1536 * 2;
constexpr size_t OFF_VT = OFF_KN + (size_t)M * 1024 * 2;
constexpr size_t OFF_ATTA = OFF_VT + (size_t)M * 1024 * 2;
constexpr size_t OFF_ATTB = OFF_ATTA + (size_t)M * 1024 * 2;
constexpr size_t WS_END = OFF_ATTB + (size_t)M * 1024 * 2;
constexpr size_t OFF_MERGED = OFF_SBQ;
constexpr size_t OFF_PQ = OFF_GA;
constexpr size_t OFF_IDX = OFF_GB;
constexpr size_t OFF_GW = OFF_GB + (size_t)M * 128 * 4;
constexpr size_t OFF_U16 = OFF_Q;
constexpr size_t OFF_V16 = OFF_U16 + (size_t)16384 * 2048;
static_assert(OFF_V16 + (size_t)16384 * 2048 <= WS_END, "u/v overlay");
constexpr float U8_SCALE = 68.f, V8_SCALE = 1.5f;
static_assert(WS_END < (size_t)620 * 1000 * 1000, "workspace budget");

struct Params {
    const float *x, *c; const int* pos;
    const float *ada_w, *ada_b, *n1g, *n2g, *w_in, *qng, *kvng, *w_uq, *w_ukv, *w_bm, *w_bs, *w_out, *w_pq, *skeys, *pu, *pv, *fng;
    float* out; unsigned char* ws;
    float invf[32];
    int ph_lo, ph_hi;
};

DI unsigned pk2(float lo, float hi) { bf16v2 p; p[0] = (__bf16)lo; p[1] = (__bf16)hi; return __builtin_bit_cast(unsigned, p); }
DI float bflo(unsigned u) { return __uint_as_float(u << 16); }
DI float bfhi(unsigned u) { return __uint_as_float(u & 0xffff0000u); }
DI float dot2bf(unsigned a, unsigned b, float c) { return __builtin_amdgcn_fdot2_f32_bf16(__builtin_bit_cast(bf16v2, a), __builtin_bit_cast(bf16v2, b), c, false); }
DI float bf2f(bf16_t b) { return __uint_as_float(((unsigned)b) << 16); }
DI float wave_sum(float v) {
#pragma unroll
    for (int o = 1; o < 64; o <<= 1) v += __shfl_xor(v, o);
    return v;
}
DI float wave_max(float v) {
#pragma unroll
    for (int o = 1; o < 64; o <<= 1) v = fmaxf(v, __shfl_xor(v, o));
    return v;
}
DI float sigmoidf_(float v) { return 1.f / (1.f + __expf(-v)); }
DI float gelu_tanh(float v) { const float u = 0.7978845608028654f * (v + 0.044715f * v * v * v); const float e = __expf(2.f * u); const float t = 1.f - 2.f / (e + 1.f); return 0.5f * v * (1.f + t); }
#ifndef P2_FP8
#define P2_FP8 1
#endif
constexpr float W8_SCALE = 64.f;
#ifndef P67_FP8
#define P67_FP8 1
#endif
constexpr float ACT8_SCALE = 16.f;
#ifndef GATE_FP8
#define GATE_FP8 1
#endif
#ifndef GATEA_FP8
#define GATEA_FP8 0
#endif
constexpr float GATE8_SCALE = 256.f;
#ifndef X1_BF16
#define X1_BF16 1
#endif
DI unsigned pk4f8(float a, float b, float c, float d) { int w = __builtin_amdgcn_cvt_pk_fp8_f32(a, b, 0, false); w = __builtin_amdgcn_cvt_pk_fp8_f32(c, d, w, true); return (unsigned)w; }
DI void store_bf16x4(bf16_t* p, f32x4 v) { u32x2 w; w.x = pk2(v[0], v[1]); w.y = pk2(v[2], v[3]); *(u32x2*)p = w; }
DI void store_bf16x8(bf16_t* p, f32x4 a, f32x4 b) { u32x4 w; w.x = pk2(a[0], a[1]); w.y = pk2(a[2], a[3]); w.z = pk2(b[0], b[1]); w.w = pk2(b[2], b[3]); *(u32x4*)p = w; }
DI void load_bf16x8(const bf16_t* p, f32x4& a, f32x4& b) { const u32x4 w = *(const u32x4*)p; a = (f32x4){bflo(w.x), bfhi(w.x), bflo(w.y), bfhi(w.y)}; b = (f32x4){bflo(w.z), bfhi(w.z), bflo(w.w), bfhi(w.w)}; }
DI f32x4 sig4(f32x4 v) { return (f32x4){sigmoidf_(v[0]), sigmoidf_(v[1]), sigmoidf_(v[2]), sigmoidf_(v[3])}; }
DI f32x4 rope4(f32x4 v, f32x2 c0, f32x2 c1) { return (f32x4){v[0] * c0.x - v[1] * c0.y, v[1] * c0.x + v[0] * c0.y, v[2] * c1.x - v[3] * c1.y, v[3] * c1.x + v[2] * c1.y}; }
DI f32x4 load_bf16x4(const bf16_t* p) { const u32x2 w = *(const u32x2*)p; return (f32x4){bflo(w.x), bfhi(w.x), bflo(w.y), bfhi(w.y)}; }

struct Ctx {
    LAS unsigned char* lds;
    int tid, lane, wave, gw, ngw;
};

struct MapWin { DI int operator()(int n) const {
    if (n < 768) return n;
    if (n < 1024) { const int j = n - 768; if (j >= 64) return -1; return 768 + (j >> 1) + 32 * (j & 1); }
    if (n < 2048) return 832 + (n - 1024);
    if (n < 3072) return 1856 + (n - 2048);
    if (n < 5120) return 3904 + (n - 3072);
    return 5952 + (n - 5120); } };
struct MapOff { int off; DI int operator()(int n) const { return n + off; } };
struct MapUq { DI int operator()(int n) const { const int hd = n / 192, j = n % 192; if (j < 128) return hd * 192 + j; const int jj = j - 128; return hd * 192 + 128 + (jj >> 1) + 32 * (jj & 1); } };
struct MapUk { DI int operator()(int n) const { return (n >> 7) * 256 + (n & 127); } };
struct MapUv { DI int operator()(int n) const { return (n >> 7) * 256 + 128 + (n & 127); } };

template <bool F8 = false, class Map>
DI void transpose_item(const float* W, int K, int N, const Map& mp, const float* rowscale, bf16_t* dst, int kb, int nb, LAS float* scr, int lane) {
    const int k0 = kb * 64, sc = mp(nb * 64 + lane);
#pragma unroll 8
    for (int kk = 0; kk < 64; ++kk) {
        float v = 0.f;
        if (sc >= 0) v = W[(size_t)(k0 + kk) * N + sc];
        if (rowscale) v *= rowscale[k0 + kk];
        scr[kk * 65 + lane] = v;
    }
    asm volatile("s_waitcnt lgkmcnt(0)" ::: "memory");
    const int kc = lane & 7;
#pragma unroll
    for (int j = 0; j < 8; ++j) {
        const int nrow = (lane >> 3) + 8 * j; const LAS float* s = scr + (8 * kc) * 65 + nrow;
        if constexpr (F8) { u32x2 o; o.x = pk4f8(s[0] * W8_SCALE, s[65] * W8_SCALE, s[2 * 65] * W8_SCALE, s[3 * 65] * W8_SCALE); o.y = pk4f8(s[4 * 65] * W8_SCALE, s[5 * 65] * W8_SCALE, s[6 * 65] * W8_SCALE, s[7 * 65] * W8_SCALE);
            *(u32x2*)((unsigned char*)dst + (size_t)(nb * 64 + nrow) * K + k0 + 8 * kc) = o; }
        else {
        u32x4 o; o.x = pk2(s[0], s[65]); o.y = pk2(s[2 * 65], s[3 * 65]); o.z = pk2(s[4 * 65], s[5 * 65]); o.w = pk2(s[6 * 65], s[7 * 65]);
        *(u32x4*)(dst + (size_t)(nb * 64 + nrow) * K + k0 + 8 * kc) = o; }
    }
    asm volatile("s_waitcnt lgkmcnt(0)" ::: "memory");
}

DI void phase_prologue(const Params& p, const Ctx& c, bool do_ada = true, bool do_rest = true) {
    unsigned char* ws = p.ws;
    LAS float* scr = (LAS float*)(c.lds + c.wave * 16640);
    unsigned long long* modi = (unsigned long long*)(ws + OFF_MODI);
    if (do_ada) for (int u = c.gw; u < 32 * 48; u += c.ngw) {
        const int kp = u / 48, ch = u % 48, k0 = kp * 64, c0 = ch * 256 + c.lane * 4;
        float sl[4];
#pragma unroll
        for (int b = 0; b < 4; ++b) { const float cv = p.c[b * D + k0 + c.lane]; sl[b] = cv / (1.f + __expf(-cv)); }
        f32x4 acc[4];
#pragma unroll
        for (int b = 0; b < 4; ++b) acc[b] = (f32x4){0.f, 0.f, 0.f, 0.f};
#pragma unroll 16
        for (int kk = 0; kk < 64; ++kk) {
            const f32x4 w = *(const f32x4*)(p.ada_w + (size_t)(k0 + kk) * (6 * D) + c0);
#pragma unroll
            for (int b = 0; b < 4; ++b) { const float s = __shfl(sl[b], kk); acc[b] += w * s; }
        }
        if (kp == 0) { const f32x4 bv = *(const f32x4*)(p.ada_b + c0);
#pragma unroll
            for (int b = 0; b < 4; ++b) acc[b] += bv; }
#pragma unroll
        for (int b = 0; b < 4; ++b)
#pragma unroll
            for (int e = 0; e < 4; ++e) atomicAdd(modi + b * 6 * D + c0 + e, (unsigned long long)(long long)__builtin_rint((double)acc[b][e] * 4294967296.0));
    }
    if (!do_rest) return;
    constexpr int I_WIN = 112 * 32, I_SBV = 16 * 32, I_UQ = 24 * 8, I_UK = 16 * 4, I_UV = 16 * 4, I_A = 32 * 16, I_B = 32 * 16, I_OUT = 32 * 32, I_PQ = 32 * 32;
    constexpr int NIT = I_WIN + I_SBV + I_UQ + I_UK + I_UV + I_A + I_B + I_OUT + I_PQ;
    for (int it = c.gw; it < NIT; it += c.ngw) {
        int r = it;
        if (r < I_WIN) { transpose_item<P2_FP8 != 0>(p.w_in, 2048, 8000, MapWin{}, nullptr, (bf16_t*)(ws + OFF_WIN), r % 32, r / 32, scr, c.lane); continue; } r -= I_WIN;
        if (r < I_SBV) { transpose_item<P2_FP8 != 0>(p.w_in, 2048, 8000, MapOff{2880}, nullptr, (bf16_t*)(ws + OFF_WSBV), r % 32, r / 32, scr, c.lane); continue; } r -= I_SBV;
        if (r < I_UQ) { transpose_item(p.w_uq, 512, 1536, MapUq{}, p.qng, (bf16_t*)(ws + OFF_WUQ), r % 8, r / 8, scr, c.lane); continue; } r -= I_UQ;
        if (r < I_UK) { transpose_item(p.w_ukv, 256, 2048, MapUk{}, p.kvng, (bf16_t*)(ws + OFF_WUK), r % 4, r / 4, scr, c.lane); continue; } r -= I_UK;
        if (r < I_UV) { transpose_item(p.w_ukv, 256, 2048, MapUv{}, p.kvng, (bf16_t*)(ws + OFF_WUV), r % 4, r / 4, scr, c.lane); continue; } r -= I_UV;
        if (r < I_A) { transpose_item<P67_FP8 != 0>(p.w_bm, 1024, 2048, MapOff{0}, nullptr, (bf16_t*)(ws + OFF_WA), r % 16, r / 16, scr, c.lane); continue; } r -= I_A;
        if (r < I_B) { transpose_item<P67_FP8 != 0>(p.w_bs, 1024, 2048, MapOff{0}, nullptr, (bf16_t*)(ws + OFF_WB), r % 16, r / 16, scr, c.lane); continue; } r -= I_B;
        if (r < I_OUT) { transpose_item<P67_FP8 != 0>(p.w_out, 2048, 2048, MapOff{0}, nullptr, (bf16_t*)(ws + OFF_WOUT), r % 32, r / 32, scr, c.lane); continue; } r -= I_OUT;
        transpose_item(p.w_pq, 2048, 2048, MapOff{0}, nullptr, (bf16_t*)(ws + OFF_WPQ), r % 32, r / 32, scr, c.lane);
    }
    { bf16_t* kd = (bf16_t*)(ws + OFF_KEYS);
      for (int i = (c.gw * 64 + c.lane) * 4; i < 8 * 2 * 128 * 128; i += c.ngw * 64 * 4) store_bf16x4(kd + i, *(const f32x4*)(p.skeys + i)); }
    { f32x2* cs = (f32x2*)(ws + OFF_CS);
      for (int i = c.gw * 64 + c.lane; i < M * 32; i += c.ngw * 64) {
          const int m = i >> 5, f = i & 31;
          const float ang = (float)p.pos[m] * p.invf[f];
          const double rev = (double)ang * 0.15915494309189533576888;
          const float fr = (float)(rev - __builtin_rint(rev));
          cs[i] = (f32x2){__builtin_amdgcn_cosf(fr), __builtin_amdgcn_sinf(fr)};
      } }
}

DI f32x4 ld_mod4(const float* p) { return *(const f32x4*)p; }
DI f32x4 ld_mod4(const long long* p) { f32x4 r;
#pragma unroll
    for (int e = 0; e < 4; ++e) r[e] = (float)((double)p[e] * (1.0 / 4294967296.0));
    return r; }
template <bool F8 = false, bool SRC16 = false, class MT>
DI void modulate_rows(const float* src, const float* g, const MT* sc, const MT* sh, bf16_t* dst, const Ctx& c) {
    for (int m = c.gw; m < M; m += c.ngw) {
        const int b = m / SEQ;
        const float* xr = src + (size_t)m * D;
        f32x4 v[8]; float ss = 0.f;
#pragma unroll
        for (int j = 0; j < 8; ++j) { if constexpr (SRC16) v[j] = load_bf16x4((const bf16_t*)src + (size_t)m * D + (j * 64 + c.lane) * 4); else v[j] = *(const f32x4*)(xr + (j * 64 + c.lane) * 4); ss += v[j][0] * v[j][0] + v[j][1] * v[j][1] + v[j][2] * v[j][2] + v[j][3] * v[j][3]; }
        const float rstd = rsqrtf(wave_sum(ss) * (1.f / D) + EPS);
#pragma unroll
        for (int j = 0; j < 8; ++j) {
            const int col = (j * 64 + c.lane) * 4;
            const f32x4 gg = *(const f32x4*)(g + col), s1 = ld_mod4(sc + b * 6 * D + col), h1 = ld_mod4(sh + b * 6 * D + col);
            const f32x4 o = v[j] * rstd * gg * (s1 + 1.f) + h1;
            if constexpr (F8) *(unsigned*)((unsigned char*)dst + (size_t)m * D + col) = pk4f8(o[0], o[1], o[2], o[3]);
            else store_bf16x4(dst + (size_t)m * D + col, o);
        }
    }
}
DI void phase_rowstats(const Params& p, const Ctx& c) {
    const bf16_t* cq = (const bf16_t*)(p.ws + OFF_CQ); const bf16_t* ckv = (const bf16_t*)(p.ws + OFF_CKV);
    float* rq = (float*)(p.ws + OFF_RSTQ); float* rkv = (float*)(p.ws + OFF_RSTKV);
    for (int m = c.gw; m < M; m += c.ngw) {
        const u32x4 a = *(const u32x4*)(cq + (size_t)m * 512 + c.lane * 8);
        const u32x2 b = *(const u32x2*)(ckv + (size_t)m * 256 + c.lane * 4);
        float s1 = 0.f, s2 = 0.f;
#pragma unroll
        for (int e = 0; e < 4; ++e) { const float lo = bflo(a[e]), hi = bfhi(a[e]); s1 += lo * lo + hi * hi; }
#pragma unroll
        for (int e = 0; e < 2; ++e) { const float lo = bflo(b[e]), hi = bfhi(b[e]); s2 += lo * lo + hi * hi; }
        s1 = wave_sum(s1); s2 = wave_sum(s2);
        if (c.lane == 0) { rq[m] = rsqrtf(s1 * (1.f / 512.f) + EPS); rkv[m] = rsqrtf(s2 * (1.f / 256.f) + EPS); }
    }
}
typedef float f32x16v __attribute__((ext_vector_type(16)));
typedef float f32x32v __attribute__((ext_vector_type(32)));
typedef unsigned u32x6 __attribute__((ext_vector_type(6)));
#ifndef FP6_ORDER
#define FP6_ORDER 1
#endif
DI void convert_table(const float* src, unsigned char* dst, float scale, const Ctx& c) {
    const size_t ngroups = (size_t)16384 * 64;
    for (size_t gi = (size_t)c.gw * 64 + c.lane; gi < ngroups; gi += (size_t)c.ngw * 64) {
        const size_t row = gi >> 6; const int l = (int)(gi & 63);
        const float* sp = src + row * 2048 + l * 32;
        f32x4 v[8];
#pragma unroll
        for (int i = 0; i < 8; ++i) v[i] = *(const f32x4*)(sp + 4 * i) * scale;
        f32x16v a, b;
#pragma unroll
        for (int e = 0; e < 16; ++e) {
#if FP6_ORDER == 0
            a[e] = v[e >> 2][e & 3]; b[e] = v[4 + (e >> 2)][e & 3];
#else
            a[e] = v[(2 * e) >> 2][(2 * e) & 3]; b[e] = v[(2 * e + 1) >> 2][(2 * e + 1) & 3];
#endif
        }
        const u32x6 pk = __builtin_amdgcn_cvt_scalef32_2xpk16_fp6_f32(a, b, 1.0f);
        unsigned char* dp = dst + row * 1536;
        *(u32x4*)(dp + 16 * l) = (u32x4){pk[0], pk[1], pk[2], pk[3]};
        *(u32x2*)(dp + 1024 + 8 * l) = (u32x2){pk[4], pk[5]};
    }
}

struct EpiProj {
    bf16_t *cq, *ckv, *kr, *sbq, *sbk, *ga, *gb; const f32x2* cs; float osc;
    DI void operator()(int row, int col, f32x4 v) const {
        const int tile = col >> 8; v = v * osc;
        if (tile < 2) { store_bf16x4(cq + (size_t)row * 512 + col, v); }
        else if (tile == 2) { store_bf16x4(ckv + (size_t)row * 256 + (col - 512), v); }
        else if (tile == 3) { const int j = col - 768; if (j < 64) { const f32x2 c0 = cs[row * 32 + (j >> 1)], c1 = cs[row * 32 + (j >> 1) + 1];
            const f32x4 o = {v[0] * c0.x - v[1] * c0.y, v[1] * c0.x + v[0] * c0.y, v[2] * c1.x - v[3] * c1.y, v[3] * c1.x + v[2] * c1.y};
            store_bf16x4(kr + (size_t)row * 64 + j, o); } }
        else if (tile < 8) { store_bf16x4(sbq + (size_t)row * 1024 + (col - 1024), v * (0.08838834764831845f * LOG2E)); }
        else if (tile < 12) { store_bf16x4(sbk + (size_t)row * 1024 + (col - 2048), v); }
        else if (tile < 20) { store_bf16x4(ga + (size_t)row * 2048 + (col - 3072), (f32x4){sigmoidf_(v[0]), sigmoidf_(v[1]), sigmoidf_(v[2]), sigmoidf_(v[3])}); }
        else { store_bf16x4(gb + (size_t)row * 2048 + (col - 5120), (f32x4){sigmoidf_(v[0]), sigmoidf_(v[1]), sigmoidf_(v[2]), sigmoidf_(v[3])}); }
    }    DI void operator()(int row, int col, f32x4 v0, f32x4 v1) const {
        const int tile = col >> 8; v0 = v0 * osc; v1 = v1 * osc;
        if (tile < 2) { store_bf16x8(cq + (size_t)row * 512 + col, v0, v1); }
        else if (tile == 2) { store_bf16x8(ckv + (size_t)row * 256 + (col - 512), v0, v1); }
        else if (tile == 3) { const int j = col - 768; if (j < 64) { const f32x2* cp = cs + row * 32 + (j >> 1);
            store_bf16x8(kr + (size_t)row * 64 + j, rope4(v0, cp[0], cp[1]), rope4(v1, cp[2], cp[3])); } }
        else if (tile < 8) { const float sc = 0.08838834764831845f * LOG2E; store_bf16x8(sbq + (size_t)row * 1024 + (col - 1024), v0 * sc, v1 * sc); }
        else if (tile < 12) { store_bf16x8(sbk + (size_t)row * 1024 + (col - 2048), v0, v1); }
#if GATE_FP8
        else if (!GATEA_FP8 && tile < 20) { store_bf16x8(ga + (size_t)row * 2048 + (col - 3072), sig4(v0), sig4(v1)); }
        else { const f32x4 s0 = sig4(v0) * GATE8_SCALE, s1 = sig4(v1) * GATE8_SCALE; unsigned char* gp = tile < 20 ? (unsigned char*)ga + (size_t)row * 2048 + (col - 3072) : (unsigned char*)gb + (size_t)row * 2048 + (col - 5120);
            *(u32x2*)gp = (u32x2){pk4f8(s0[0], s0[1], s0[2], s0[3]), pk4f8(s1[0], s1[1], s1[2], s1[3])}; }
#else
        else if (tile < 20) { store_bf16x8(ga + (size_t)row * 2048 + (col - 3072), sig4(v0), sig4(v1)); }
        else { store_bf16x8(gb + (size_t)row * 2048 + (col - 5120), sig4(v0), sig4(v1)); }
#endif
    }
};
struct EpiT { bf16_t* o; const float* cscale; float osc;
    static constexpr int MB = 2; struct Pre { f32x4 a, b; };
    DI Pre load(int row, int col) const { Pre q; q.a = q.b = (f32x4){osc, osc, osc, osc}; if (cscale) { q.a = *(const f32x4*)(cscale + col) * osc; q.b = *(const f32x4*)(cscale + col + 4) * osc; } return q; }
    DI void apply(int row, int col, f32x4 v0, f32x4 v1, const Pre& q) const { store_bf16x8(o + (size_t)row * M + col, v0 * q.a, v1 * q.b); }
    DI void operator()(int row, int col, f32x4 v) const { if (cscale) v = v * *(const f32x4*)(cscale + col); store_bf16x4(o + (size_t)row * M + col, v); }
    DI void operator()(int row, int col, f32x4 v0, f32x4 v1) const { if (cscale) { v0 = v0 * *(const f32x4*)(cscale + col); v1 = v1 * *(const f32x4*)(cscale + col + 4); } store_bf16x8(o + (size_t)row * M + col, v0, v1); } };
struct EpiUq { bf16_t* q; const float* rst; const f32x2* cs;
    static constexpr int MB = 2; struct Pre { float sc; f32x2 c0, c1, c2, c3; };
    DI Pre load(int row, int col) const { Pre w; w.sc = rst[row]; w.c0 = w.c1 = w.c2 = w.c3 = (f32x2){0.f, 0.f}; const int j = col % 192;
        if (j >= 128) { const f32x2* cp = cs + row * 32 + ((j - 128) >> 1); w.c0 = cp[0]; w.c1 = cp[1]; w.c2 = cp[2]; w.c3 = cp[3]; } return w; }
    DI void apply(int row, int col, f32x4 v0, f32x4 v1, const Pre& w) const {
        const float sc = w.sc * (0.07216878364870322f * LOG2E); v0 = v0 * sc; v1 = v1 * sc;
        if (col % 192 >= 128) { v0 = rope4(v0, w.c0, w.c1); v1 = rope4(v1, w.c2, w.c3); }
        store_bf16x8(q + (size_t)row * 1536 + col, v0, v1); }
    DI void operator()(int row, int col, f32x4 v) const {
        v = v * (rst[row] * (0.07216878364870322f * LOG2E));
        const int j = col % 192;
        if (j >= 128) { const int i0 = (j - 128) >> 1; const f32x2 c0 = cs[row * 32 + i0], c1 = cs[row * 32 + i0 + 1];
            v = (f32x4){v[0] * c0.x - v[1] * c0.y, v[1] * c0.x + v[0] * c0.y, v[2] * c1.x - v[3] * c1.y, v[3] * c1.x + v[2] * c1.y}; }
        store_bf16x4(q + (size_t)row * 1536 + col, v);
    }
    DI void operator()(int row, int col, f32x4 v0, f32x4 v1) const {
        const float sc = rst[row] * (0.07216878364870322f * LOG2E); v0 = v0 * sc; v1 = v1 * sc;
        const int j = col % 192;
        if (j >= 128) { const f32x2* cp = cs + row * 32 + ((j - 128) >> 1); v0 = rope4(v0, cp[0], cp[1]); v1 = rope4(v1, cp[2], cp[3]); }
        store_bf16x8(q + (size_t)row * 1536 + col, v0, v1);
    } };
struct EpiRowScale { bf16_t* o; int ld; const float* rst;
    static constexpr int MB = 4; typedef float Pre;
    DI Pre load(int row, int col) const { return rst[row]; }
    DI void apply(int row, int col, f32x4 v0, f32x4 v1, const Pre& sc) const { store_bf16x8(o + (size_t)row * ld + col, v0 * sc, v1 * sc); }
    DI void operator()(int row, int col, f32x4 v) const { store_bf16x4(o + (size_t)row * ld + col, v * rst[row]); }
    DI void operator()(int row, int col, f32x4 v0, f32x4 v1) const { const float sc = rst[row]; store_bf16x8(o + (size_t)row * ld + col, v0 * sc, v1 * sc); } };
struct EpiGate1 { bf16_t* mg; const bf16_t* g; float osc;
#if GATEA_FP8
    static constexpr int MB = 2; typedef u32x2 Pre;
    DI Pre load(int row, int col) const { return *(const u32x2*)((const unsigned char*)g + (size_t)row * 2048 + col); }
#else
    static constexpr int MB = 2; typedef u32x4 Pre;
    DI Pre load(int row, int col) const { return *(const u32x4*)(g + (size_t)row * 2048 + col); }
#endif
    DI void apply(int row, int col, f32x4 v0, f32x4 v1, const Pre& w) const { const size_t i = (size_t)row * 2048 + col;
#if GATEA_FP8
        const f32x4 g0 = {__builtin_amdgcn_cvt_f32_fp8((int)w.x, 0), __builtin_amdgcn_cvt_f32_fp8((int)w.x, 1), __builtin_amdgcn_cvt_f32_fp8((int)w.x, 2), __builtin_amdgcn_cvt_f32_fp8((int)w.x, 3)};
        const f32x4 g1 = {__builtin_amdgcn_cvt_f32_fp8((int)w.y, 0), __builtin_amdgcn_cvt_f32_fp8((int)w.y, 1), __builtin_amdgcn_cvt_f32_fp8((int)w.y, 2), __builtin_amdgcn_cvt_f32_fp8((int)w.y, 3)};
        const float os = osc * (1.f / GATE8_SCALE);
#else
        const f32x4 g0 = {bflo(w.x), bfhi(w.x), bflo(w.y), bfhi(w.y)}, g1 = {bflo(w.z), bfhi(w.z), bflo(w.w), bfhi(w.w)}; const float os = osc;
#endif
        store_bf16x8(mg + i, v0 * os * g0, v1 * os * g1); }
    DI void operator()(int row, int col, f32x4 v) const { const size_t i = (size_t)row * 2048 + col; store_bf16x4(mg + i, v * load_bf16x4(g + i)); }
    DI void operator()(int row, int col, f32x4 v0, f32x4 v1) const { const size_t i = (size_t)row * 2048 + col; f32x4 g0, g1; load_bf16x8(g + i, g0, g1); store_bf16x8(mg + i, v0 * g0, v1 * g1); } };
struct EpiGate2 { bf16_t* mg; const bf16_t* g; unsigned char* m8; float osc;
    static constexpr int MB = 2;
#if GATE_FP8
    struct Pre { u32x4 m; u32x2 g; };
#else
    struct Pre { u32x4 g, m; };
#endif
#if GATE_FP8
    DI Pre load(int row, int col) const { const size_t i = (size_t)row * 2048 + col; Pre q; q.g = *(const u32x2*)((const unsigned char*)g + i); q.m = *(const u32x4*)(mg + i); return q; }
#else
    DI Pre load(int row, int col) const { const size_t i = (size_t)row * 2048 + col; Pre q; q.g = *(const u32x4*)(g + i); q.m = *(const u32x4*)(mg + i); return q; }
#endif
    DI void apply(int row, int col, f32x4 v0, f32x4 v1, const Pre& q) const { const size_t i = (size_t)row * 2048 + col;
#if GATE_FP8
        const f32x4 g0 = {__builtin_amdgcn_cvt_f32_fp8((int)q.g.x, 0), __builtin_amdgcn_cvt_f32_fp8((int)q.g.x, 1), __builtin_amdgcn_cvt_f32_fp8((int)q.g.x, 2), __builtin_amdgcn_cvt_f32_fp8((int)q.g.x, 3)};
        const f32x4 g1 = {__builtin_amdgcn_cvt_f32_fp8((int)q.g.y, 0), __builtin_amdgcn_cvt_f32_fp8((int)q.g.y, 1), __builtin_amdgcn_cvt_f32_fp8((int)q.g.y, 2), __builtin_amdgcn_cvt_f32_fp8((int)q.g.y, 3)};
        const float osc = this->osc * (1.f / GATE8_SCALE);
#else
        const f32x4 g0 = {bflo(q.g.x), bfhi(q.g.x), bflo(q.g.y), bfhi(q.g.y)}, g1 = {bflo(q.g.z), bfhi(q.g.z), bflo(q.g.w), bfhi(q.g.w)};
#endif
        const f32x4 m0 = {bflo(q.m.x), bfhi(q.m.x), bflo(q.m.y), bfhi(q.m.y)}, m1 = {bflo(q.m.z), bfhi(q.m.z), bflo(q.m.w), bfhi(q.m.w)};
        const f32x4 r0 = m0 + v0 * osc * g0, r1 = m1 + v1 * osc * g1;
        if (P67_FP8) *(u32x2*)(m8 + i) = (u32x2){pk4f8(r0[0] * ACT8_SCALE, r0[1] * ACT8_SCALE, r0[2] * ACT8_SCALE, r0[3] * ACT8_SCALE), pk4f8(r1[0] * ACT8_SCALE, r1[1] * ACT8_SCALE, r1[2] * ACT8_SCALE, r1[3] * ACT8_SCALE)};
        else store_bf16x8(mg + i, r0, r1); }
    DI void operator()(int row, int col, f32x4 v) const { const size_t i = (size_t)row * 2048 + col; store_bf16x4(mg + i, load_bf16x4(mg + i) + v * load_bf16x4(g + i)); }
    DI void operator()(int row, int col, f32x4 v0, f32x4 v1) const { const size_t i = (size_t)row * 2048 + col; f32x4 g0, g1, m0, m1; load_bf16x8(g + i, g0, g1); load_bf16x8(mg + i, m0, m1); store_bf16x8(mg + i, m0 + v0 * g0, m1 + v1 * g1); } };
struct EpiRes { const float* x; const float* gt; float* x1; float osc;
    static constexpr int MB = 2; struct Pre { f32x4 a, b; };
    DI Pre load(int row, int col) const { const size_t i = (size_t)row * 2048 + col; Pre q; q.a = *(const f32x4*)(x + i); q.b = *(const f32x4*)(x + i + 4); return q; }
    DI void apply(int row, int col, f32x4 v0, f32x4 v1, const Pre& q) const { const size_t i = (size_t)row * 2048 + col; const int b = row / SEQ; const float* gp = gt + b * 6 * D + col;
        const f32x4 r0 = q.a + *(const f32x4*)gp * v0 * (osc * DBG_ALPHA), r1 = q.b + *(const f32x4*)(gp + 4) * v1 * (osc * DBG_ALPHA);
        if (X1_BF16) store_bf16x8((bf16_t*)x1 + i, r0, r1); else { *(f32x4*)(x1 + i) = r0; *(f32x4*)(x1 + i + 4) = r1; } }
    DI void operator()(int row, int col, f32x4 v) const { const size_t i = (size_t)row * 2048 + col; const int b = row / SEQ;
        *(f32x4*)(x1 + i) = *(const f32x4*)(x + i) + *(const f32x4*)(gt + b * 6 * D + col) * v * DBG_ALPHA; }
    DI void operator()(int row, int col, f32x4 v0, f32x4 v1) const { (*this)(row, col, v0); (*this)(row, col + 4, v1); } };
struct EpiPq { bf16_t* pq;
    DI void operator()(int row, int col, f32x4 v) const { store_bf16x4(pq + (size_t)(col >> 8) * M * 256 + (size_t)row * 256 + (col & 255), v); }
    DI void operator()(int row, int col, f32x4 v0, f32x4 v1) const { store_bf16x8(pq + (size_t)(col >> 8) * M * 256 + (size_t)row * 256 + (col & 255), v0, v1); } };

template <class Epi>
DI void gemm_naive(const Ctx& c, const bf16_t* A, const bf16_t* Bt, int Mg, int Ng, int Kg, const Epi& E) {
    LAS float* As = (LAS float*)c.lds; LAS float* Bs = As + 16 * 132;
    const int tid = c.tid, ty = tid >> 5, tx = tid & 31;
    const int tilesN = Ng / 128, ntiles = (Mg / 128) * tilesN;
    for (int t = blockIdx.x; t < ntiles; t += gridDim.x) {
        const int tm = t / tilesN, tn = t % tilesN;
        float acc[8][4];
#pragma unroll
        for (int i = 0; i < 8; ++i)
#pragma unroll
            for (int j = 0; j < 4; ++j) acc[i][j] = 0.f;
        for (int k0 = 0; k0 < Kg; k0 += 16) {
            { const int lt = tid & 255, r = lt >> 1, kc = lt & 1;
              const bf16_t* src = (tid < 256 ? A + (size_t)(tm * 128 + r) * Kg : Bt + (size_t)(tn * 128 + r) * Kg) + k0 + kc * 8;
              const u32x4 v = *(const u32x4*)src;
              LAS float* dst = (tid < 256 ? As : Bs) + (kc * 8) * 132 + r;
              dst[0] = bflo(v.x); dst[132] = bfhi(v.x); dst[2 * 132] = bflo(v.y); dst[3 * 132] = bfhi(v.y);
              dst[4 * 132] = bflo(v.z); dst[5 * 132] = bfhi(v.z); dst[6 * 132] = bflo(v.w); dst[7 * 132] = bfhi(v.w); }
            __syncthreads();
#pragma unroll
            for (int kk = 0; kk < 16; ++kk) {
                const f32x4 a0 = *(const LAS f32x4*)(As + kk * 132 + ty * 8), a1 = *(const LAS f32x4*)(As + kk * 132 + ty * 8 + 4);
                const f32x4 b = *(const LAS f32x4*)(Bs + kk * 132 + tx * 4);
#pragma unroll
                for (int j = 0; j < 4; ++j) {
                    acc[0][j] += a0[0] * b[j]; acc[1][j] += a0[1] * b[j]; acc[2][j] += a0[2] * b[j]; acc[3][j] += a0[3] * b[j];
                    acc[4][j] += a1[0] * b[j]; acc[5][j] += a1[1] * b[j]; acc[6][j] += a1[2] * b[j]; acc[7][j] += a1[3] * b[j];
                }
            }
            __syncthreads();
        }
#pragma unroll
        for (int i = 0; i < 8; ++i) E(tm * 128 + ty * 8 + i, tn * 128 + tx * 4, (f32x4){acc[i][0], acc[i][1], acc[i][2], acc[i][3]});
    }
}

namespace pg8 {
#define PG8_LAS __attribute__((address_space(3)))
typedef unsigned short bf16_t;
typedef short bf16x8 __attribute__((ext_vector_type(8)));
typedef float f32x4 __attribute__((ext_vector_type(4)));
typedef unsigned u32x4 __attribute__((ext_vector_type(4)));
constexpr int BM = 256, BK = 64, HALF = 128, HTB = HALF * BK * 2  , STAGE_BYTES = 8 * HTB, NXCD = 8, WGM = 4;

__host__ __device__ __forceinline__ int lds_byte(int r, int c) { const int st = (r >> 4) * 2 + (c >> 5), rr = r & 15, cc = c & 31, ob = rr * 64 + cc * 2; return st * 1024 + (ob ^ (((ob >> 9) & 1) << 5)); }
__host__ __device__ __forceinline__ void stage_rc(int b, int& R, int& C) { const int st = b / 1024, sb = b % 1024, swz = sb ^ (((sb >> 9) & 1) << 5); R = (st >> 1) * 16 + swz / 64; C = (st & 1) * 32 + (swz % 64) / 2; }
__host__ __device__ __forceinline__ int perm32(int rho) { const int n = rho >> 4, i = rho & 15; return 8 * (i >> 2) + 4 * n + (i & 3); }

struct Unit { int pm, pn; };
struct Gemm { const bf16_t* A; const bf16_t* Bt; int M, N, K; int tid; const unsigned char* base; };
struct StaticOrder {
    int nM, nN, nwg, G, c;
    __host__ __device__ void init(int M, int N, int G_, int c_) { nM = M / BM; nN = N / BM; nwg = nM * nN; G = G_; c = c_; }
    __host__ __device__ bool next(int i, Unit& u) const {
        const long L = (long)i * G + c; if (L >= nwg) return false;
        int wgid = (int)L; { const int q = nwg / NXCD, r = nwg % NXCD, xcd = wgid % NXCD, off = wgid / NXCD; wgid = (xcd < r ? xcd * (q + 1) : r * (q + 1) + (xcd - r) * q) + off; }
        const int nig = WGM * nN, gid = wgid / nig, fm = gid * WGM, gsz = (nM - fm) < WGM ? (nM - fm) : WGM;
        u.pm = fm + ((wgid % nig) % gsz); u.pn = (wgid % nig) / gsz; return true;
    }
    __device__ __forceinline__ void a_ready(const Unit&) const {}
    __device__ __forceinline__ void done(const Unit&) const {}
};
typedef int i32x8 __attribute__((ext_vector_type(8)));
template <class Epi, class Sched, bool STAMP = false, bool F8 = false>
__device__ __forceinline__ void gemm_phase(PG8_LAS unsigned char* lds, const Gemm g, const Sched& S, const Epi& E, unsigned long long* stamps) {
    const int tid = g.tid, wid = __builtin_amdgcn_readfirstlane(tid >> 6), lane = tid & 63, wr = wid >> 2, wc = wid & 3, fr = lane & 15, fq = lane >> 4;
    const int K = g.K, nt = K / BK;
    int ts_lo = 0, ts_hi = 0, nts = 0; const unsigned long long rt_entry = STAMP ? (unsigned long long)wall_clock64() : 0ull;
#define PG8_STAMP() do { if (STAMP && wid == 0 && nts < 64) { const unsigned long long _c = (unsigned long long)clock64(); \
        ts_lo = (lane == nts) ? (int)(unsigned)_c : ts_lo; ts_hi = (lane == nts) ? (int)(unsigned)(_c >> 32) : ts_hi; ++nts; } } while (0)
    PG8_STAMP();
    unsigned voffA, voffB;
    { int R, C; stage_rc(tid * 16, R, C); const int Rb = Epi::PERM ? ((R & ~31) + perm32(R & 31)) : R;
        voffA = (unsigned)(R * K + C) * 2u; voffB = (unsigned)(Rb * K + C) * 2u; }
    const unsigned qstep = 64u * (unsigned)K * 2u;
    const unsigned kstep = (unsigned)(BK * 2);
    const unsigned hstep = (unsigned)HALF * K * 2;
    const unsigned tstep = 2 * hstep;
    const __amdgpu_buffer_rsrc_t rs = __builtin_amdgcn_make_buffer_rsrc((void*)g.base, (short)0, (int)0x7fffffff, 0x00020000);
    const unsigned oA = (unsigned)((const unsigned char*)g.A - g.base), oB = (unsigned)((const unsigned char*)g.Bt - g.base);
    const unsigned ldsw = (unsigned)wid * 1024u;
    const int aoff = lds_byte(wr * 64 + fr, fq * 8), boff = lds_byte(wc * 32 + fr, fq * 8);
#define PG8_SA(b, h) (((b) * 2 + (h)) * HTB)
#define PG8_SB(b, h) ((4 + (b) * 2 + (h)) * HTB)
#define PG8_STAGE(bufoff, gbase, voff) do { _Pragma("unroll") for (int _i = 0; _i < 2; ++_i) \
        __builtin_amdgcn_raw_ptr_buffer_load_lds(rs, (PG8_LAS void*)(lds + (bufoff) + ldsw + _i * 8192), 16, (voff), (gbase) + _i * qstep, 0, 0); } while (0)
#define PG8_LDA(dst, b, h) do { _Pragma("unroll") for (int m = 0; m < 4; ++m) _Pragma("unroll") for (int k = 0; k < 2; ++k) dst[m][k] = *(const PG8_LAS bf16x8*)(lds + PG8_SA(b, h) + aoff + m * 2048 + k * 1024); } while (0)
#define PG8_LDB(dst, b, h) do { _Pragma("unroll") for (int n = 0; n < 2; ++n) _Pragma("unroll") for (int k = 0; k < 2; ++k) dst[n][k] = *(const PG8_LAS bf16x8*)(lds + PG8_SB(b, h) + boff + n * 2048 + k * 1024); } while (0)
#define PG8_CAT8(x0, x1) __builtin_bit_cast(i32x8, __builtin_shufflevector(x0, x1, 0, 1, 2, 3, 4, 5, 6, 7, 8, 9, 10, 11, 12, 13, 14, 15))
#define PG8_MMA(ai, bj, At, Bt) do { __builtin_amdgcn_s_setprio(1); _Pragma("unroll") for (int m = 0; m < 4; ++m) _Pragma("unroll") for (int n = 0; n < 2; ++n) { \
        if constexpr (F8) acc[ai][bj][m][n] = __builtin_amdgcn_mfma_scale_f32_16x16x128_f8f6f4(PG8_CAT8(Bt[n][0], Bt[n][1]), PG8_CAT8(At[m][0], At[m][1]), acc[ai][bj][m][n], 0, 0, 0, 0, 0, 0); \
        else { _Pragma("unroll") for (int k = 0; k < 2; ++k) acc[ai][bj][m][n] = __builtin_amdgcn_mfma_f32_16x16x32_bf16(Bt[n][k], At[m][k], acc[ai][bj][m][n], 0, 0, 0); } } \
        __builtin_amdgcn_s_setprio(0); } while (0)
#define PG8_WAIT_V(n) asm volatile("s_waitcnt vmcnt(" #n ")" ::: "memory")
#define PG8_WAIT_L(n) asm volatile("s_waitcnt lgkmcnt(" #n ")" ::: "memory")
#define PG8_BAR __builtin_amdgcn_s_barrier()
#define PG8_SCHED __builtin_amdgcn_sched_barrier(0)
    Unit cur, nxt; int ui = 0;
    if (!S.next(0, cur)) return;
    f32x4 acc[2][2][4][2];
#pragma unroll
    for (int a = 0; a < 2; ++a)
#pragma unroll
        for (int b = 0; b < 2; ++b)
#pragma unroll
            for (int m = 0; m < 4; ++m)
#pragma unroll
                for (int n = 0; n < 2; ++n) acc[a][b][m][n] = (f32x4){0.f, 0.f, 0.f, 0.f};
    bf16x8 At[4][2], B0[2][2], B1[2][2];
    unsigned cA = oA + (unsigned)cur.pm * tstep, cB = oB + (unsigned)cur.pn * tstep;
    S.a_ready(cur);
    PG8_STAGE(PG8_SB(0, 0), cB, voffB); PG8_STAGE(PG8_SA(0, 0), cA, voffA); PG8_STAGE(PG8_SB(0, 1), cB + hstep, voffB); PG8_STAGE(PG8_SA(0, 1), cA + hstep, voffA);
    if (wr == 1) PG8_BAR;
    PG8_WAIT_V(4); PG8_BAR;
    PG8_STAGE(PG8_SB(1, 0), cB + kstep, voffB); PG8_STAGE(PG8_SA(1, 0), cA + kstep, voffA); PG8_STAGE(PG8_SB(1, 1), cB + hstep + kstep, voffB);
    PG8_WAIT_V(6); PG8_BAR;
    PG8_STAMP();
    for (;;) {
        const bool has_next = S.next(ui + 1, nxt);
        const unsigned nA = has_next ? oA + (unsigned)nxt.pm * tstep : cA, nB = has_next ? oB + (unsigned)nxt.pn * tstep : cB;
        for (int t = 0; t < nt; t += 2) {
            const bool last = (t == nt - 2);
            const unsigned a1 = cA + (unsigned)(t + 1) * kstep;
            const unsigned a2 = last ? nA : cA + (unsigned)(t + 2) * kstep, b2 = last ? nB : cB + (unsigned)(t + 2) * kstep;
            const unsigned a3 = a2 + kstep, b3 = b2 + kstep;
            if (last && has_next) S.a_ready(nxt);
            PG8_LDB(B0, 0, 0); PG8_SCHED; PG8_LDA(At, 0, 0); PG8_STAGE(PG8_SA(1, 1), a1 + hstep, voffA);
            PG8_WAIT_L(8); PG8_BAR; PG8_WAIT_L(0); PG8_MMA(0, 0, At, B0); PG8_BAR; PG8_SCHED;
            PG8_LDB(B1, 0, 1); PG8_STAGE(PG8_SB(0, 0), b2, voffB);
            PG8_BAR; PG8_WAIT_L(0); PG8_MMA(0, 1, At, B1); PG8_BAR;
            PG8_LDA(At, 0, 1); PG8_STAGE(PG8_SA(0, 0), a2, voffA);
            PG8_BAR; PG8_WAIT_L(0); PG8_MMA(1, 0, At, B0); PG8_BAR; PG8_SCHED;
            PG8_STAGE(PG8_SB(0, 1), b2 + hstep, voffB);
            PG8_WAIT_V(6); PG8_BAR; PG8_MMA(1, 1, At, B1); PG8_BAR;
            PG8_LDB(B0, 1, 0); PG8_SCHED; PG8_LDA(At, 1, 0); PG8_STAGE(PG8_SA(0, 1), a2 + hstep, voffA);
            PG8_WAIT_L(8); PG8_BAR; PG8_WAIT_L(0); PG8_MMA(0, 0, At, B0); PG8_BAR; PG8_SCHED;
            PG8_LDB(B1, 1, 1); PG8_STAGE(PG8_SB(1, 0), b3, voffB);
            PG8_BAR; PG8_WAIT_L(0); PG8_MMA(0, 1, At, B1); PG8_BAR;
            PG8_LDA(At, 1, 1); PG8_STAGE(PG8_SA(1, 0), a3, voffA);
            PG8_BAR; PG8_WAIT_L(0); PG8_MMA(1, 0, At, B0); PG8_BAR; PG8_SCHED;
            PG8_STAGE(PG8_SB(1, 1), b3 + hstep, voffB);
            PG8_WAIT_V(6); PG8_BAR; PG8_MMA(1, 1, At, B1); PG8_BAR;
        }
        PG8_STAMP();
        if constexpr (!Epi::AFTER_DRAIN) { E(acc, cur, wr, wc, fr, fq); S.done(cur); }
        PG8_STAMP();
        if (!has_next) break;
#pragma unroll
        for (int a = 0; a < 2; ++a)
#pragma unroll
            for (int b = 0; b < 2; ++b)
#pragma unroll
                for (int m = 0; m < 4; ++m)
#pragma unroll
                    for (int n = 0; n < 2; ++n) acc[a][b][m][n] = (f32x4){0.f, 0.f, 0.f, 0.f};
        cur = nxt; cA = nA; cB = nB; ++ui;
    }
    PG8_WAIT_V(0);
    if (wr == 0) PG8_BAR;
    PG8_BAR;
    if constexpr (Epi::AFTER_DRAIN) { E.fused(acc, cur, wr, wc, fr, fq, lds, wid, lane); S.done(cur); }
    PG8_STAMP();
    if (STAMP && wid == 0) { stamps[lane] = lane < nts ? (((unsigned long long)(unsigned)ts_hi << 32) | (unsigned)ts_lo) : 0ull;
        if (lane == 62) stamps[62] = rt_entry; if (lane == 63) stamps[63] = (unsigned long long)wall_clock64(); }
#undef PG8_STAMP
#undef PG8_SA
#undef PG8_SB
#undef PG8_STAGE
#undef PG8_LDA
#undef PG8_LDB
#undef PG8_MMA
#undef PG8_CAT8
#undef PG8_WAIT_V
#undef PG8_WAIT_L
#undef PG8_BAR
#undef PG8_SCHED
}
}

template <class E4, class = void> struct epi_mb { static constexpr int value = 0; };
template <class E4> struct epi_mb<E4, decltype((void)E4::MB)> { static constexpr int value = E4::MB; };
template <class E4> struct EpiAdapt {
    static constexpr bool PERM = true, AFTER_DRAIN = false;
    E4 e;
    __device__ __forceinline__ void operator()(const pg8::f32x4 (&acc)[2][2][4][2], const pg8::Unit& u, int wr, int wc, int fr, int fq) const {
        if constexpr (epi_mb<E4>::value > 0) {
            constexpr int MB = epi_mb<E4>::value;
#pragma unroll
            for (int ai = 0; ai < 2; ++ai)
#pragma unroll
                for (int m0 = 0; m0 < 4; m0 += MB) {
                    typename E4::Pre pre[MB][2];
#pragma unroll
                    for (int mi = 0; mi < MB; ++mi)
#pragma unroll
                        for (int bj = 0; bj < 2; ++bj) pre[mi][bj] = e.load(u.pm * 256 + ai * 128 + wr * 64 + (m0 + mi) * 16 + fr, u.pn * 256 + bj * 128 + wc * 32 + fq * 8);
#pragma unroll
                    for (int mi = 0; mi < MB; ++mi)
#pragma unroll
                        for (int bj = 0; bj < 2; ++bj) e.apply(u.pm * 256 + ai * 128 + wr * 64 + (m0 + mi) * 16 + fr, u.pn * 256 + bj * 128 + wc * 32 + fq * 8, acc[ai][bj][m0 + mi][0], acc[ai][bj][m0 + mi][1], pre[mi][bj]);
                    asm volatile("" ::: "memory");
                }
        } else {
#pragma unroll
        for (int ai = 0; ai < 2; ++ai)
#pragma unroll
            for (int m = 0; m < 4; ++m) {
                const int row = u.pm * 256 + ai * 128 + wr * 64 + m * 16 + fr;
#pragma unroll
                for (int bj = 0; bj < 2; ++bj) e(row, u.pn * 256 + bj * 128 + wc * 32 + fq * 8, acc[ai][bj][m][0], acc[ai][bj][m][1]);
                asm volatile("" ::: "memory");
            }
        }
    }
};
template <class E4>
DI void gemm_fast(const Ctx& c, const unsigned char* WSB, const bf16_t* A, const bf16_t* Bt, int Mg, int Ng, int Kg, const E4& e4) {
    pg8::Gemm g{A, Bt, Mg, Ng, Kg, c.tid, WSB}; pg8::StaticOrder S; S.init(Mg, Ng, (int)gridDim.x, (int)blockIdx.x);
    EpiAdapt<E4> E{e4};
    pg8::gemm_phase<EpiAdapt<E4>, pg8::StaticOrder, false>((PG8_LAS unsigned char*)c.lds, g, S, E, nullptr);
}
template <class E4>
DI void gemm_fast8(const Ctx& c, const unsigned char* WSB, const unsigned char* A, const unsigned char* Bt, int Mg, int Ng, int Kg, const E4& e4) {
    pg8::Gemm g{(const bf16_t*)A, (const bf16_t*)Bt, Mg, Ng, Kg / 2, c.tid, WSB}; pg8::StaticOrder S; S.init(Mg, Ng, (int)gridDim.x, (int)blockIdx.x);
    EpiAdapt<E4> E{e4};
    pg8::gemm_phase<EpiAdapt<E4>, pg8::StaticOrder, false, true>((PG8_LAS unsigned char*)c.lds, g, S, E, nullptr);
}
#define GEMM8(c_, ...) do { MKCTX(); gemm_fast8(c, ws, __VA_ARGS__); } while (0)
#ifndef FAST_GEMM
#define FAST_GEMM 1
#endif
#if FAST_GEMM
#define GEMM(c_, ...) do { MKCTX(); gemm_fast(c, ws, __VA_ARGS__); } while (0)
#else
#define GEMM(c_, ...) do { MKCTX(); gemm_naive(c, __VA_ARGS__); } while (0)
#endif

DI void attn_mla_naive(const Params& p, const Ctx& c) {
    const bf16_t* Q = (const bf16_t*)(p.ws + OFF_Q); const bf16_t* KN = (const bf16_t*)(p.ws + OFF_KN); const bf16_t* KR = (const bf16_t*)(p.ws + OFF_KR);
    const bf16_t* VT = (const bf16_t*)(p.ws + OFF_VT); bf16_t* O = (bf16_t*)(p.ws + OFF_ATTA);
    for (int u = c.gw; u < M * 8; u += c.ngw) {
        const int m = u >> 3, hd = u & 7, b = m / SEQ, s = m % SEQ, base = b * SEQ, nkeys = ((s >> 6) + 1) << 6;
        const float q0 = bf2f(Q[(size_t)m * 1536 + hd * 192 + c.lane]), q1 = bf2f(Q[(size_t)m * 1536 + hd * 192 + 64 + c.lane]), q2 = bf2f(Q[(size_t)m * 1536 + hd * 192 + 128 + c.lane]);
        float mx = -1e30f, l = 0.f, o0 = 0.f, o1 = 0.f;
        const bf16_t* v0p = VT + (size_t)(hd * 128 + c.lane) * M + base; const bf16_t* v1p = v0p + (size_t)64 * M;
        for (int kk = 0; kk < nkeys; ++kk) {
            const size_t tk = base + kk;
            const float part = q0 * bf2f(KN[tk * 1024 + hd * 128 + c.lane]) + q1 * bf2f(KN[tk * 1024 + hd * 128 + 64 + c.lane]) + q2 * bf2f(KR[tk * 64 + c.lane]);
            const float sc = wave_sum(part);
            const float mn = fmaxf(mx, sc), al = exp2f(mx - mn), pp = exp2f(sc - mn);
            l = l * al + pp; o0 = o0 * al + pp * bf2f(v0p[kk]); o1 = o1 * al + pp * bf2f(v1p[kk]); mx = mn;
        }
        const float inv = 1.f / l;
        O[(size_t)m * 1024 + hd * 128 + c.lane] = (bf16_t)(pk2(o0 * inv, 0.f) & 0xffff);
        O[(size_t)m * 1024 + hd * 128 + 64 + c.lane] = (bf16_t)(pk2(o1 * inv, 0.f) & 0xffff);
    }
}
DI void attn_sb_naive(const Params& p, const Ctx& c) {
    const bf16_t* Q = (const bf16_t*)(p.ws + OFF_SBQ); const bf16_t* K = (const bf16_t*)(p.ws + OFF_SBK);
    const bf16_t* VT = (const bf16_t*)(p.ws + OFF_SBVT); bf16_t* O = (bf16_t*)(p.ws + OFF_ATTB);
    for (int u = c.gw; u < M * 8; u += c.ngw) {
        const int m = u >> 3, hd = u & 7, b = m / SEQ, s = m % SEQ, base = b * SEQ;
        const float q0 = bf2f(Q[(size_t)m * 1024 + hd * 128 + c.lane]), q1 = bf2f(Q[(size_t)m * 1024 + hd * 128 + 64 + c.lane]);
        float later = 0.f, o0 = 0.f, o1 = 0.f;
        const bf16_t* v0p = VT + (size_t)(hd * 128 + c.lane) * M + base; const bf16_t* v1p = v0p + (size_t)64 * M;
        for (int kk = s - 1; kk >= 0; --kk) {
            const size_t tk = base + kk;
            const float z2 = wave_sum(q0 * bf2f(K[tk * 1024 + hd * 128 + c.lane]) + q1 * bf2f(K[tk * 1024 + hd * 128 + 64 + c.lane]));
            const float ln2 = -(fmaxf(z2, 0.f) + __log2f(1.f + exp2f(-fabsf(z2))));
            const float w = exp2f(z2 + ln2 + later);
            later += ln2; o0 += w * bf2f(v0p[kk]); o1 += w * bf2f(v1p[kk]);
        }
        O[(size_t)m * 1024 + hd * 128 + c.lane] = (bf16_t)(pk2(o0, 0.f) & 0xffff);
        O[(size_t)m * 1024 + hd * 128 + 64 + c.lane] = (bf16_t)(pk2(o1, 0.f) & 0xffff);
    }
}


typedef float f32x16 __attribute__((ext_vector_type(16)));
#define MFMA32(a, b, c) __builtin_amdgcn_mfma_f32_32x32x16_bf16((a), (b), (c), 0, 0, 0)
constexpr int ST_KR = 16384, ST_VT = 24576, ST_BYTES = 40960;
constexpr int ATT_FLAGS = 2 * ST_BYTES;
DI float ex2(float x) { return __builtin_amdgcn_exp2f(x); }
DI float lg2(float x) { return __builtin_amdgcn_logf(x); }
DI bf16x8 pack8(float a0, float a1, float a2, float a3, float a4, float a5, float a6, float a7) {
    u32x4 t; t.x = pk2(a0, a1); t.y = pk2(a2, a3); t.z = pk2(a4, a5); t.w = pk2(a6, a7); return __builtin_bit_cast(bf16x8, t); }
#define GLDS16(gp, lp) __builtin_amdgcn_global_load_lds((const unsigned*)(gp), (LAS unsigned*)(lp), 16, 0, 0)

struct AttDmaOff { unsigned kn[2], kr, vt[2]; };
DI AttDmaOff att_dma_offsets(int w, int lane) {
    AttDmaOff o; const unsigned lr = lane >> 4, pp = lane & 15;
#pragma unroll
    for (int i = 0; i < 2; ++i) { const unsigned q = w * 2 + i, R = 4 * q + lr, cc = pp ^ (R & 15); o.kn[i] = R * 2048u + cc * 16u; }
    { const unsigned q = w, R2 = 4 * q + lr, cc = pp ^ (R2 & 15); o.kr = (2 * R2 + (cc >> 3)) * 128u + (cc & 7) * 16u; }
#pragma unroll
    for (int i = 0; i < 2; ++i) { const unsigned q = w * 2 + i, R2 = 4 * q + lr, cc = pp ^ (R2 & 15); o.vt[i] = (2 * R2 + (cc >> 3)) * (unsigned)(M * 2) + (cc & 7) * 16u; }
    return o;
}
template <bool ROPE>
DI void att_dma(LAS unsigned char* buf, __amdgpu_buffer_rsrc_t rs, const AttDmaOff& o, unsigned k_so, unsigned kr_so, unsigned vt_so, int w) {
#pragma unroll
    for (int i = 0; i < 2; ++i) __builtin_amdgcn_raw_ptr_buffer_load_lds(rs, (LAS void*)(buf + (w * 2 + i) * 1024), 16, o.kn[i], k_so, 0, 0);
    if (ROPE) __builtin_amdgcn_raw_ptr_buffer_load_lds(rs, (LAS void*)(buf + ST_KR + w * 1024), 16, o.kr, kr_so, 0, 0);
#pragma unroll
    for (int i = 0; i < 2; ++i) __builtin_amdgcn_raw_ptr_buffer_load_lds(rs, (LAS void*)(buf + ST_VT + (w * 2 + i) * 1024), 16, o.vt[i], vt_so, 0, 0);
}
DI void att_store(const f32x16 (&o)[4], float scale, bf16_t* O, size_t row, int hd, int h) {
#pragma unroll
    for (int db = 0; db < 4; ++db)
#pragma unroll
        for (int g = 0; g < 4; ++g)
#if P67_FP8
            { const float sc8 = scale * ACT8_SCALE; *(unsigned*)((unsigned char*)O + row * 1024 + hd * 128 + db * 32 + g * 8 + h * 4) = pk4f8(o[db][4 * g] * sc8, o[db][4 * g + 1] * sc8, o[db][4 * g + 2] * sc8, o[db][4 * g + 3] * sc8); }
#else
            store_bf16x4(O + row * 1024 + hd * 128 + db * 32 + g * 8 + h * 4, (f32x4){o[db][4 * g] * scale, o[db][4 * g + 1] * scale, o[db][4 * g + 2] * scale, o[db][4 * g + 3] * scale});
#endif
}
DI void att_pv(f32x16 (&o)[4], const bf16x8 (&pf)[2][2], const LAS unsigned char* buf, unsigned va) {
#pragma unroll
    for (int db = 0; db < 4; ++db) {
#pragma unroll
        for (int blk = 0; blk < 2; ++blk)
#pragma unroll
            for (int ks = 0; ks < 2; ++ks) o[db] = MFMA32(*(const LAS bf16x8*)(buf + ((va ^ ((blk * 2 + ks) << 5)) + db * 4096)), pf[blk][ks], o[db]);
        asm volatile("" ::: "memory");
    }
}

DI void attn_mla_fast(const Params& p, const Ctx& c) {
    const bf16_t* Q = (const bf16_t*)(p.ws + OFF_Q); const bf16_t* KN = (const bf16_t*)(p.ws + OFF_KN); const bf16_t* KR = (const bf16_t*)(p.ws + OFF_KR);
    const bf16_t* VT = (const bf16_t*)(p.ws + OFF_VT); bf16_t* O = (bf16_t*)(p.ws + OFF_ATTA);
    const int lane = c.lane, r = lane & 31, h = lane >> 5, w = c.wave;
    const int pr = (r & 0x13) | ((r & 4) << 1) | ((r & 8) >> 1);
    const unsigned ka = (pr << 8) | ((((pr & 15) ^ h) & 15) << 4);
    const unsigned ra = ST_KR + (((pr >> 1) << 8) | (((((pr & 1) << 3) | h) ^ ((pr >> 1) & 15)) << 4));
    const unsigned va = ST_VT + (((r >> 1) << 8) | (((((r & 1) << 3) | h) ^ ((r >> 1) & 15)) << 4));
    const __amdgpu_buffer_rsrc_t rs = __builtin_amdgcn_make_buffer_rsrc((void*)p.ws, (short)0, (int)WS_END, 0x00020000);
    const AttDmaOff dof = att_dma_offsets(w, lane);
    for (int it = blockIdx.x; it < 256; it += gridDim.x) {
        const int bh = it & 31, b = bh >> 3, hd = bh & 7, pairi = it >> 5;
#pragma unroll 1
        for (int half = 0; half < 2; ++half) {
            const int qb = half ? 15 - pairi : pairi, q0 = qb * 256;
            const size_t base = (size_t)b * SEQ, qrow = base + q0 + w * 32 + r;
            bf16x8 qf[12];
#pragma unroll
            for (int st = 0; st < 12; ++st) qf[st] = *(const bf16x8*)(Q + qrow * 1536 + hd * 192 + st * 16 + h * 8);
            const int ntile = q0 / 64 + 4, myn = (q0 + w * 32) / 64 + 1;
            f32x16 o[4];
#pragma unroll
            for (int db = 0; db < 4; ++db)
#pragma unroll
                for (int i = 0; i < 16; ++i) o[db][i] = 0.f;
            float mrun = -1e30f, lrun = 0.f;
            __syncthreads();
            const unsigned k_so0 = (unsigned)(OFF_KN + (base * 1024 + hd * 128) * 2), kr_so0 = (unsigned)(OFF_KR + base * 64 * 2), vt_so0 = (unsigned)(OFF_VT + ((size_t)(hd * 128) * M + base) * 2);
            att_dma<true>(c.lds, rs, dof, k_so0, kr_so0, vt_so0, w);
            asm volatile("s_waitcnt vmcnt(0)" ::: "memory");
            __syncthreads();
            for (int j = 0; j < ntile; ++j) {
                LAS unsigned char* buf = c.lds + (j & 1) * ST_BYTES;
                if (j + 1 < ntile) att_dma<true>(c.lds + ((j + 1) & 1) * ST_BYTES, rs, dof, k_so0 + (unsigned)(j + 1) * (64 * 2048), kr_so0 + (unsigned)(j + 1) * (64 * 128), vt_so0 + (unsigned)(j + 1) * 128, w);
                if (j < myn) {
                    f32x16 s0, s1;
#pragma unroll
                    for (int i = 0; i < 16; ++i) { s0[i] = 0.f; s1[i] = 0.f; }
                    __builtin_amdgcn_s_setprio(1);
#pragma unroll
                    for (int st = 0; st < 8; ++st) {
                        s0 = MFMA32(*(const LAS bf16x8*)(buf + (ka ^ (st << 5))), qf[st], s0);
                        s1 = MFMA32(*(const LAS bf16x8*)(buf + ((ka ^ (st << 5)) + 8192)), qf[st], s1);
                    }
#pragma unroll
                    for (int st = 0; st < 4; ++st) {
                        s0 = MFMA32(*(const LAS bf16x8*)(buf + (ra ^ (st << 5))), qf[8 + st], s0);
                        s1 = MFMA32(*(const LAS bf16x8*)(buf + ((ra ^ (st << 5)) + 4096)), qf[8 + st], s1);
                    }
                    __builtin_amdgcn_s_setprio(0);
                    float mx = fmaxf(s0[0], s1[0]);
#pragma unroll
                    for (int i = 1; i < 16; ++i) mx = fmaxf(mx, fmaxf(s0[i], s1[i]));
                    mx = fmaxf(mx, __shfl_xor(mx, 32));
                    const float mnew = fmaxf(mrun, mx), alpha = ex2(mrun - mnew);
                    mrun = mnew;
                    float ps = 0.f;
#pragma unroll
                    for (int i = 0; i < 16; ++i) { s0[i] = ex2(s0[i] - mnew); s1[i] = ex2(s1[i] - mnew); ps += s0[i] + s1[i]; }
                    lrun = lrun * alpha + ps;
#pragma unroll
                    for (int db = 0; db < 4; ++db)
#pragma unroll
                        for (int i = 0; i < 16; ++i) o[db][i] *= alpha;
                    bf16x8 pf[2][2];
                    pf[0][0] = pack8(s0[0], s0[1], s0[2], s0[3], s0[4], s0[5], s0[6], s0[7]); pf[0][1] = pack8(s0[8], s0[9], s0[10], s0[11], s0[12], s0[13], s0[14], s0[15]);
                    pf[1][0] = pack8(s1[0], s1[1], s1[2], s1[3], s1[4], s1[5], s1[6], s1[7]); pf[1][1] = pack8(s1[8], s1[9], s1[10], s1[11], s1[12], s1[13], s1[14], s1[15]);
                    __builtin_amdgcn_s_setprio(1);
                    att_pv(o, pf, buf, va);
                    __builtin_amdgcn_s_setprio(0);
                }
                asm volatile("s_waitcnt vmcnt(0)" ::: "memory");
                __syncthreads();
            }
            const float ltot = lrun + __shfl_xor(lrun, 32);
            att_store(o, 1.f / ltot, O, qrow, hd, h);
        }
    }
}

DI void attn_sb_fast(const Params& p, const Ctx& c) {
    const bf16_t* Q = (const bf16_t*)(p.ws + OFF_SBQ); const bf16_t* K = (const bf16_t*)(p.ws + OFF_SBK);
    const bf16_t* VT = (const bf16_t*)(p.ws + OFF_SBVT); bf16_t* O = (bf16_t*)(p.ws + OFF_ATTB);
    const int lane = c.lane, r = lane & 31, h = lane >> 5, w = c.wave, tid = c.tid;
    const int pr = (r & 0x13) | ((r & 4) << 1) | ((r & 8) >> 1);
    const unsigned ka = (pr << 8) | ((((pr & 15) ^ h) & 15) << 4);
    const unsigned va = ST_VT + (((r >> 1) << 8) | (((((r & 1) << 3) | h) ^ ((r >> 1) & 15)) << 4));
    const __amdgpu_buffer_rsrc_t rs = __builtin_amdgcn_make_buffer_rsrc((void*)p.ws, (short)0, (int)WS_END, 0x00020000);
    const AttDmaOff dof = att_dma_offsets(w, lane);
    LAS int* flags = (LAS int*)(c.lds + ATT_FLAGS);
    for (int it = blockIdx.x; it < 256; it += gridDim.x) {
        const int bh = it & 31, b = bh >> 3, hd = bh & 7, pairi = it >> 5;
#pragma unroll 1
        for (int half = 0; half < 2; ++half) {
            const int qb = half ? 15 - pairi : pairi, q0 = qb * 256;
            const size_t base = (size_t)b * SEQ, qrow = base + q0 + w * 32 + r;
            const int tq = q0 + w * 32 + r;
            bf16x8 qf[8];
#pragma unroll
            for (int st = 0; st < 8; ++st) qf[st] = *(const bf16x8*)(Q + qrow * 1024 + hd * 128 + st * 16 + h * 8);
            const int jmax = q0 / 64 + 3, jd = (q0 + w * 32) / 64;
            f32x16 o[4];
#pragma unroll
            for (int db = 0; db < 4; ++db)
#pragma unroll
                for (int i = 0; i < 16; ++i) o[db][i] = 0.f;
            float carry = 0.f; bool wdone = false;
            __syncthreads();
            const unsigned k_so0 = (unsigned)(OFF_SBK + (base * 1024 + hd * 128) * 2), vt_so0 = (unsigned)(OFF_SBVT + ((size_t)(hd * 128) * M + base) * 2);
            att_dma<false>(c.lds, rs, dof, k_so0 + (unsigned)jmax * (64 * 2048), 0u, vt_so0 + (unsigned)jmax * 128, w);
            if (tid < 16) flags[tid] = 0;
            asm volatile("s_waitcnt vmcnt(0)" ::: "memory");
            __syncthreads();
            int itn = 0;
            for (int j = jmax; j >= 0; --j, ++itn) {
                LAS unsigned char* buf = c.lds + (itn & 1) * ST_BYTES;
                if (j > 0) att_dma<false>(c.lds + ((itn + 1) & 1) * ST_BYTES, rs, dof, k_so0 + (unsigned)(j - 1) * (64 * 2048), 0u, vt_so0 + (unsigned)(j - 1) * 128, w);
                if (j <= jd && !wdone) {
                    f32x16 s0, s1;
#pragma unroll
                    for (int i = 0; i < 16; ++i) { s0[i] = 0.f; s1[i] = 0.f; }
#pragma unroll
                    for (int st = 0; st < 8; ++st) {
                        s0 = MFMA32(*(const LAS bf16x8*)(buf + (ka ^ (st << 5))), qf[st], s0);
                        s1 = MFMA32(*(const LAS bf16x8*)(buf + ((ka ^ (st << 5)) + 8192)), qf[st], s1);
                    }
                    const int kb0 = 64 * j + 8 * h - tq;
                    bf16x8 pf[2][2];
                    {
                        f32x16 l1;
#pragma unroll
                        for (int i = 0; i < 16; ++i) { const float z = s1[i]; const float a = -(fmaxf(z, 0.f) + lg2(1.f + ex2(-fabsf(z)))); l1[i] = (kb0 + 32 + 16 * (i >> 3) + (i & 7) < 0) ? a : 0.f; }
                        float g0 = 0.f, g1 = 0.f;
#pragma unroll
                        for (int e = 0; e < 8; ++e) { g0 += l1[e]; g1 += l1[8 + e]; }
                        const float p0 = __shfl_xor(g0, 32), p1 = __shfl_xor(g1, 32);
                        float run = carry + (h == 0 ? p1 : 0.f);
#pragma unroll
                        for (int e = 7; e >= 0; --e) { run += l1[8 + e]; l1[8 + e] = run; }
                        run = carry + (g1 + p1) + (h == 0 ? p0 : 0.f);
#pragma unroll
                        for (int e = 7; e >= 0; --e) { run += l1[e]; l1[e] = run; }
                        carry += (g1 + p1) + (g0 + p0);
#pragma unroll
                        for (int i = 0; i < 16; ++i) { const float wv = ex2(s1[i] + l1[i]); s1[i] = (kb0 + 32 + 16 * (i >> 3) + (i & 7) < 0) ? wv : 0.f; }
                        pf[1][0] = pack8(s1[0], s1[1], s1[2], s1[3], s1[4], s1[5], s1[6], s1[7]); pf[1][1] = pack8(s1[8], s1[9], s1[10], s1[11], s1[12], s1[13], s1[14], s1[15]);
                    }
                    {
                        f32x16 l0;
#pragma unroll
                        for (int i = 0; i < 16; ++i) { const float z = s0[i]; const float a = -(fmaxf(z, 0.f) + lg2(1.f + ex2(-fabsf(z)))); l0[i] = (kb0 + 16 * (i >> 3) + (i & 7) < 0) ? a : 0.f; }
                        float g0 = 0.f, g1 = 0.f;
#pragma unroll
                        for (int e = 0; e < 8; ++e) { g0 += l0[e]; g1 += l0[8 + e]; }
                        const float p0 = __shfl_xor(g0, 32), p1 = __shfl_xor(g1, 32);
                        float run = carry + (h == 0 ? p1 : 0.f);
#pragma unroll
                        for (int e = 7; e >= 0; --e) { run += l0[8 + e]; l0[8 + e] = run; }
                        run = carry + (g1 + p1) + (h == 0 ? p0 : 0.f);
#pragma unroll
                        for (int e = 7; e >= 0; --e) { run += l0[e]; l0[e] = run; }
                        carry += (g1 + p1) + (g0 + p0);
#pragma unroll
                        for (int i = 0; i < 16; ++i) { const float wv = ex2(s0[i] + l0[i]); s0[i] = (kb0 + 16 * (i >> 3) + (i & 7) < 0) ? wv : 0.f; }
                        pf[0][0] = pack8(s0[0], s0[1], s0[2], s0[3], s0[4], s0[5], s0[6], s0[7]); pf[0][1] = pack8(s0[8], s0[9], s0[10], s0[11], s0[12], s0[13], s0[14], s0[15]);
                    }
                    att_pv(o, pf, buf, va);
                    wdone = __all(carry < -150.f);
                }
                if (lane == 0) flags[(itn & 1) * 8 + w] = wdone ? 1 : 0;
                asm volatile("s_waitcnt vmcnt(0)" ::: "memory");
                __syncthreads();
                int alld = 1;
#pragma unroll
                for (int q = 0; q < 8; ++q) alld &= flags[(itn & 1) * 8 + q];
                if (alld) break;
            }
            att_store(o, 1.f, O, qrow, hd, h);
        }
    }
}
#ifndef FAST_ATTN
#define FAST_ATTN 1
#endif

constexpr int SEL_LD = 260;
DI void topk_insert(float (&a)[16], float x) {
#pragma unroll
    for (int i = 15; i >= 1; --i) a[i] = __builtin_amdgcn_fmed3f(a[i - 1], a[i], x);
    a[0] = fmaxf(a[0], x);
}
struct SelMap { int mode, a0, a1, a2, a3; };
DI void sel_decode(const SelMap& mp, int q, int& t0, int& hd) {
    if (mp.mode == 0) { int u = mp.a0 + q * mp.a1; if (u >= 128 * 8) u = mp.a0; hd = u & 7; t0 = (u >> 3) * 128; }
    else { const int pm = (q >> 1) ? mp.a2 : mp.a0, pn = (q >> 1) ? mp.a3 : mp.a1; hd = pn; t0 = pm * 256 + (q & 1) * 128; }
}
template <int NU> DI void select_stage2(const Params& p, const Ctx& c, const SelMap mp, const LAS float* lst_all) {
    if (c.tid < 128 * NU) {
        const int tok = c.tid & 127, un = c.tid >> 7;
        int t0, hd; sel_decode(mp, un, t0, hd);
        const LAS float* lst = lst_all + un * 4096;
        float v1[16], v2[16];
#pragma unroll
        for (int i = 0; i < 16; ++i) { v1[i] = __uint_as_float(__float_as_uint(lst[(tok * 2) * 16 + i]) & ~127u); v2[i] = __uint_as_float(__float_as_uint(lst[(tok * 2 + 1) * 16 + i]) & ~127u); }
        float bb[16];
#pragma unroll
        for (int i = 0; i < 16; ++i) bb[i] = -__builtin_inff();
#pragma unroll
        for (int i = 0; i < 16; ++i)
#pragma unroll
            for (int j = 0; j < 16; ++j)
                if ((i + 1) * (j + 1) <= 16) topk_insert(bb, __uint_as_float((__float_as_uint(v1[i] + v2[j]) & ~255u) | (unsigned)(i * 16 + j)));
        float sv[16], mxv = -__builtin_inff(), sum = 0.f;
#pragma unroll
        for (int i = 0; i < 16; ++i) { sv[i] = __uint_as_float(__float_as_uint(bb[i]) & ~255u); mxv = fmaxf(mxv, sv[i]); }
#pragma unroll
        for (int i = 0; i < 16; ++i) { sv[i] = __expf(sv[i] - mxv); sum += sv[i]; }
        const float inv = 1.f / sum;
        int* idx = (int*)(p.ws + OFF_IDX) + (size_t)(t0 + tok) * 128 + hd * 16; float* gw = (float*)(p.ws + OFF_GW) + (size_t)(t0 + tok) * 128 + hd * 16;
#pragma unroll
        for (int i = 0; i < 16; ++i) {
            const unsigned code = __float_as_uint(bb[i]) & 255u;
            const unsigned e1 = __float_as_uint(lst[(tok * 2) * 16 + (code >> 4)]) & 127u, e2 = __float_as_uint(lst[(tok * 2 + 1) * 16 + (code & 15u)]) & 127u;
            idx[i] = (int)(e1 * 128u + e2); gw[i] = sv[i] * inv;
        }
    }
    __syncthreads();
}
DI void select_tail(const Params& p, const Ctx& c, int t0, int hd) {
    LAS float* sc = (LAS float*)c.lds; LAS float* lst = sc + 128 * SEL_LD;
    if (c.tid < 256) {
        const int tok = c.tid >> 1, hf = c.tid & 1;
        float a[16];
#pragma unroll
        for (int i = 0; i < 16; ++i) a[i] = -__builtin_inff();
        const LAS float* row = sc + tok * SEL_LD + hf * 128;
#pragma unroll 4
        for (int n4 = 0; n4 < 32; ++n4) {
            const f32x4 v = *(const LAS f32x4*)(row + n4 * 4);
#pragma unroll
            for (int e = 0; e < 4; ++e) topk_insert(a, __uint_as_float((__float_as_uint(v[e]) & ~127u) | (unsigned)(n4 * 4 + e)));
        }
#pragma unroll
        for (int i = 0; i < 16; ++i) lst[(tok * 2 + hf) * 16 + i] = a[i];
    }
    __syncthreads();
    select_stage2<1>(p, c, SelMap{0, ((t0 >> 7) << 3) | hd, 0, 0, 0}, lst);
}
DI void select_naive(const Params& p, const Ctx& c) {
    const bf16_t* PQ = (const bf16_t*)(p.ws + OFF_PQ); const bf16_t* KEYS = (const bf16_t*)(p.ws + OFF_KEYS);
    LAS float* sc = (LAS float*)c.lds;
    for (int u = blockIdx.x; u < 128 * 8; u += gridDim.x) {
        const int hd = u & 7, t0 = (u >> 3) * 128;
        const int tok = c.tid >> 2, part = c.tid & 3, hf = part >> 1, n0 = (part & 1) * 64;
        const bf16_t* qrow = PQ + (size_t)hd * M * 256 + (size_t)(t0 + tok) * 256 + hf * 128;
        const bf16_t* kb = KEYS + (size_t)((hd * 2 + hf) * 128 + n0) * 128;
        for (int n = 0; n < 64; ++n) {
            float acc = 0.f;
#pragma unroll
            for (int d8 = 0; d8 < 16; ++d8) {
                const u32x4 a = *(const u32x4*)(qrow + d8 * 8), b = *(const u32x4*)(kb + (size_t)n * 128 + d8 * 8);
#pragma unroll
                for (int e = 0; e < 4; ++e) acc += bflo(a[e]) * bflo(b[e]) + bfhi(a[e]) * bfhi(b[e]);
            }
            sc[tok * SEL_LD + hf * 128 + n0 + n] = acc;
        }
        __syncthreads();
        select_tail(p, c, t0, hd);
    }
}


DI void select_batch(const Params& p, const Ctx& c, const SelMap mp) {
    const bf16_t* PQ = (const bf16_t*)(p.ws + OFF_PQ); const bf16_t* KEYS = (const bf16_t*)(p.ws + OFF_KEYS);
    LAS float* lst_all = (LAS float*)c.lds;
    const int lane = c.lane, r = lane & 31, h = lane >> 5, w = c.wave, tb = w & 3, hf = w >> 2;
#pragma unroll
    for (int q = 0; q < 4; ++q) {
        int t0, hd; sel_decode(mp, q, t0, hd);
        LAS float* lst = lst_all + q * 4096;
        const bf16_t* qrow = PQ + (size_t)hd * M * 256 + (size_t)(t0 + tb * 32 + r) * 256 + hf * 128 + h * 8;
        const bf16_t* kbase = KEYS + (size_t)((hd * 2 + hf) * 128 + r) * 128 + h * 8;
        bf16x8 qf[8];
#pragma unroll
        for (int st = 0; st < 8; ++st) qf[st] = *(const bf16x8*)(qrow + st * 16);
        float a[16];
#pragma unroll
        for (int i = 0; i < 16; ++i) a[i] = -__builtin_inff();
#pragma unroll
        for (int kb = 0; kb < 4; ++kb) {
            f32x16 sc;
#pragma unroll
            for (int i = 0; i < 16; ++i) sc[i] = 0.f;
#pragma unroll
            for (int st = 0; st < 8; ++st) sc = MFMA32(*(const bf16x8*)(kbase + (size_t)kb * 32 * 128 + st * 16), qf[st], sc);
#pragma unroll
            for (int i = 0; i < 16; ++i) topk_insert(a, __uint_as_float((__float_as_uint(sc[i]) & ~127u) | (unsigned)(kb * 32 + (i & 3) + 8 * (i >> 2) + 4 * h)));
        }
        float bq[16];
#pragma unroll
        for (int i = 0; i < 16; ++i) bq[i] = __shfl_xor(a[i], 32);
#pragma unroll
        for (int i = 0; i < 16; ++i) topk_insert(a, bq[i]);
        if (h == 0) {
#pragma unroll
            for (int i = 0; i < 16; ++i) lst[((tb * 32 + r) * 2 + hf) * 16 + i] = a[i];
        }
    }
    __syncthreads();
    select_stage2<4>(p, c, mp, lst_all);
}
DI void select_fast(const Params& p, const Ctx& c) {
    for (int u0 = blockIdx.x; u0 < 128 * 8; u0 += 4 * gridDim.x) select_batch(p, c, SelMap{0, u0, (int)gridDim.x, 0, 0});
}
DI void select_own_tiles(const Params& p, const Ctx& c) {
    pg8::StaticOrder S; S.init(M, 2048, (int)gridDim.x, (int)blockIdx.x);
    asm volatile("s_waitcnt vmcnt(0)" ::: "memory");
    __syncthreads();
    if (c.tid == 0) { __builtin_amdgcn_fence(__ATOMIC_ACQUIRE, "agent"); asm volatile("s_waitcnt vmcnt(0)" ::: "memory"); }
    __syncthreads();
    for (int i = 0;; i += 2) {
        pg8::Unit u0, u1;
        if (!S.next(i, u0)) break;
        if (!S.next(i + 1, u1)) u1 = u0;
        select_batch(p, c, SelMap{1, u0.pm, u0.pn, u1.pm, u1.pn});
    }
}
#ifndef FAST_SEL
#define FAST_SEL 1
#endif

DI void phase_gather(const Params& p, const Ctx& c, float* dst, int rowmask = -1) {
    const bf16_t* H2 = (const bf16_t*)(p.ws + OFF_H); const unsigned char* U = p.ws + OFF_U16; const unsigned char* V = p.ws + OFF_V16;
    const int* IDX = (const int*)(p.ws + OFF_IDX); const float* GW = (const float*)(p.ws + OFF_GW); const float* mod = (const float*)(p.ws + OFF_MOD);
    constexpr int G = 8, GV = 16;
    const int lane = c.lane;
    unsigned* tokctr = (unsigned*)(p.ws + OFF_CTL) + 700;
    constexpr int NSTATIC = 6;
    LAS int* park = (LAS int*)(c.lds + c.wave * 20480);
    for (int it = 0;; ++it) {
        int m, slot; bool doU, doV;
        if (it < NSTATIC) { slot = it; m = c.gw + it * c.ngw; doU = true; doV = false; }
        else if (it < 2 * NSTATIC) { slot = it - NSTATIC; m = c.gw + slot * c.ngw; doU = false; doV = true; }
        else { unsigned t = 0; if (lane == 0) t = __hip_atomic_fetch_add(tokctr, 1u, __ATOMIC_RELAXED, __HIP_MEMORY_SCOPE_AGENT); m = NSTATIC * c.ngw + (int)__builtin_amdgcn_readfirstlane(t); if (m >= M) break; slot = 0; doU = true; doV = true; }
        if (m >= M) continue;
        const int b = m / SEQ;
        LAS int* ps = park + slot * 256;
        int ia = 0, ib = 0; float wa = 0.f, wb = 0.f;
        if (doU) {
        f32x2 hf[16];
#pragma unroll
        for (int i = 0; i < 4; ++i) { const u32x4 a = *(const u32x4*)(H2 + (size_t)m * D + lane * 32 + i * 8);
#pragma unroll
            for (int q = 0; q < 4; ++q) hf[4 * i + q] = (f32x2){bflo(a[q]), bfhi(a[q])}; }
        ia = IDX[(size_t)m * 128 + lane]; ib = IDX[(size_t)m * 128 + 64 + lane];
        const float ga = GW[(size_t)m * 128 + lane], gb = GW[(size_t)m * 128 + 64 + lane];
#pragma unroll 1
        for (int k0 = 0; k0 < 128; k0 += G) {
            u32x4 ua[G]; u32x2 ub[G];
#pragma unroll
            for (int g = 0; g < G; ++g) {
                const int e = __builtin_amdgcn_readlane(k0 < 64 ? ia : ib, (k0 + g) & 63) & rowmask;
                const unsigned char* ur = U + (size_t)e * 1536;
                ua[g] = *(const u32x4*)(ur + (unsigned)lane * 16u); ub[g] = *(const u32x2*)(ur + 1024u + (unsigned)lane * 8u);
            }
            float d[G];
#pragma unroll
            for (int g = 0; g < G; ++g) {
                const f32x32v f = __builtin_amdgcn_cvt_scalef32_pk32_f32_fp6((u32x6){ua[g][0], ua[g][1], ua[g][2], ua[g][3], ub[g][0], ub[g][1]}, 1.0f);
                f32x2 d2 = {0.f, 0.f};
#pragma unroll
                for (int i = 0; i < 16; ++i) d2 = (f32x2){f[2 * i], f[2 * i + 1]} * hf[i] + d2;
                d[g] = d2.x + d2.y;
            }
            { const bool u5 = lane & 32, u4 = lane & 16, u3 = lane & 8;
              float r4[4];
#pragma unroll
              for (int i = 0; i < 4; ++i) { const float send = u5 ? d[i] : d[4 + i], keep = u5 ? d[4 + i] : d[i]; r4[i] = keep + __shfl_xor(send, 32); }
              float r2[2];
#pragma unroll
              for (int i = 0; i < 2; ++i) { const float send = u4 ? r4[i] : r4[2 + i], keep = u4 ? r4[2 + i] : r4[i]; r2[i] = keep + __shfl_xor(send, 16); }
              const float send = u3 ? r2[0] : r2[1], keep = u3 ? r2[1] : r2[0];
              float r1 = keep + __shfl_xor(send, 8);
              r1 += __shfl_xor(r1, 4); r1 += __shfl_xor(r1, 2); r1 += __shfl_xor(r1, 1);
              const float act = gelu_tanh(r1 * (1.f / U8_SCALE)) * (1.f / V8_SCALE);
              const int gsel = lane - (k0 & 63);
              const int src = ((gsel & 4) << 3) | ((gsel & 2) << 3) | ((gsel & 1) << 3);
              const float got = __shfl(act, src & 63);
              if (gsel >= 0 && gsel < G) { if (k0 < 64) wa = got * ga; else wb = got * gb; }
            }
        }
        ps[lane] = ia; ps[64 + lane] = ib; ps[128 + lane] = __builtin_bit_cast(int, wa); ps[192 + lane] = __builtin_bit_cast(int, wb);
        }
        if (!doV) continue;
        if (!doU) { ia = ps[lane]; ib = ps[64 + lane]; wa = __builtin_bit_cast(float, ps[128 + lane]); wb = __builtin_bit_cast(float, ps[192 + lane]); }
        f32x2 acc[16];
#pragma unroll
        for (int i = 0; i < 16; ++i) acc[i] = (f32x2){0.f, 0.f};
#define VB_ISSUE(P, K0) do { _Pragma("unroll") for (int g = 0; g < 8; ++g) { \
            const int e = __builtin_amdgcn_readlane((K0) < 64 ? ia : ib, ((K0) + g) & 63) & rowmask; \
            P##w[g] = __builtin_bit_cast(float, __builtin_amdgcn_readlane(__builtin_bit_cast(int, (K0) < 64 ? wa : wb), ((K0) + g) & 63)); \
            const unsigned char* vr = V + (size_t)e * 1536; \
            P##a[g] = *(const u32x4*)(vr + (unsigned)lane * 16u); P##b[g] = *(const u32x2*)(vr + 1024u + (unsigned)lane * 8u); } } while (0)
#define VB_COMPUTE(P) do { _Pragma("unroll") for (int g = 0; g < 8; ++g) { const f32x2 w2 = {P##w[g], P##w[g]}; \
            const f32x32v f = __builtin_amdgcn_cvt_scalef32_pk32_f32_fp6((u32x6){P##a[g][0], P##a[g][1], P##a[g][2], P##a[g][3], P##b[g][0], P##b[g][1]}, 1.0f); \
            _Pragma("unroll") for (int i = 0; i < 16; ++i) acc[i] = (f32x2){f[2 * i], f[2 * i + 1]} * w2 + acc[i]; } } while (0)
        {
            u32x4 A_a[8], B_a[8]; u32x2 A_b[8], B_b[8]; float A_w[8], B_w[8];
            VB_ISSUE(A_, 0);
#pragma unroll 1
            for (int k0 = 0; k0 < 128; k0 += 16) {
                VB_ISSUE(B_, k0 + 8);
                VB_COMPUTE(A_);
                if (k0 + 16 < 128) VB_ISSUE(A_, k0 + 16);
                VB_COMPUTE(B_);
            }
        }
#undef VB_ISSUE
#undef VB_COMPUTE
        const float* orow = p.out + (size_t)m * D + lane * 32; float* drow = dst + (size_t)m * D + lane * 32; const float* gt2 = mod + b * 6 * D + 5 * D + lane * 32; const float* fg = p.fng + lane * 32;
        float ss = 0.f; f32x4 xv[8];
#pragma unroll
        for (int i = 0; i < 8; ++i) {
            const f32x4 xa = *(const f32x4*)(orow + 4 * i), ta = *(const f32x4*)(gt2 + 4 * i);
            const f32x4 pe = {acc[2 * i].x, acc[2 * i].y, acc[2 * i + 1].x, acc[2 * i + 1].y};
            const f32x4 v = xa + DBG_BETA * ta * pe; xv[i] = v; ss += (v[0] * v[0] + v[1] * v[1]) + (v[2] * v[2] + v[3] * v[3]);
        }
        const float rstd = rsqrtf(wave_sum(ss) * (1.f / D) + EPS);
#pragma unroll
        for (int i = 0; i < 8; ++i) *(f32x4*)(drow + 4 * i) = xv[i] * rstd * *(const f32x4*)(fg + 4 * i);
    }
}


DI void phase_gather_sorted(const Params& p, const Ctx& c) {
    const bf16_t* H2 = (const bf16_t*)(p.ws + OFF_H); const unsigned char* U = p.ws + OFF_U16; const unsigned char* V = p.ws + OFF_V16;
    const int* IDX = (const int*)(p.ws + OFF_IDX); const float* GW = (const float*)(p.ws + OFF_GW); const float* mod = (const float*)(p.ws + OFF_MOD);
    const int lane = c.lane;
    LAS unsigned char* wl = c.lds + c.wave * 20480;
    constexpr int RSH = 12;
    const bool u5 = lane & 32, u4 = lane & 16, u3 = lane & 8;
#pragma unroll 1
    for (int grp = 0; grp < 2; ++grp) {
#pragma unroll 1
        for (int t = 0; t < 4; ++t) {
            const int m = c.gw + (grp * 4 + t) * c.ngw;
            if (m >= M) continue;
            const int ia = IDX[(size_t)m * 128 + lane], ib = IDX[(size_t)m * 128 + 64 + lane];
            const float ga = GW[(size_t)m * 128 + lane], gb = GW[(size_t)m * 128 + 64 + lane];
            const int ra = ia >> RSH, rb = ib >> RSH;
            int off = 0, posA = 0, posB = 0;
#pragma unroll
            for (int r = 0; r < 4; ++r) {
                const unsigned long long mA = __ballot(ra == r), mB = __ballot(rb == r);
                const int cA = __builtin_popcountll(mA), cB = __builtin_popcountll(mB);
                const int rkA = __builtin_amdgcn_mbcnt_hi((unsigned)(mA >> 32), __builtin_amdgcn_mbcnt_lo((unsigned)mA, 0u));
                const int rkB = __builtin_amdgcn_mbcnt_hi((unsigned)(mB >> 32), __builtin_amdgcn_mbcnt_lo((unsigned)mB, 0u));
                posA = (ra == r) ? off + rkA : posA; posB = (rb == r) ? off + cA + rkB : posB; off += cA + cB;
            }
            LAS int* sE = (LAS int*)(wl + t * 1024); LAS float* sW = (LAS float*)(wl + t * 1024 + 512);
            sE[posA] = ia; sE[posB] = ib; sW[posA] = ga; sW[posB] = gb;
            LAS u32x4* hrow = (LAS u32x4*)(wl + 4096 + t * 4096 + lane * 64);
#pragma unroll
            for (int i = 0; i < 4; ++i) hrow[i] = *(const u32x4*)(H2 + (size_t)m * D + lane * 32 + i * 8);
        }
        asm volatile("s_waitcnt lgkmcnt(0)" ::: "memory");
#pragma unroll 1
        for (int vi = 0; vi < 16; ++vi) {
            {
                const int r = vi >> 2, t = vi & 3;
                const int m = c.gw + (grp * 4 + t) * c.ngw;
                if (m >= M) continue;
                LAS int* sE = (LAS int*)(wl + t * 1024); LAS float* sW = (LAS float*)(wl + t * 1024 + 512);
                const int eLo = sE[lane], eHi = sE[64 + lane];
                const unsigned long long mLo = __ballot((eLo >> RSH) == r), mHi = __ballot((eHi >> RSH) == r);
                if (!(mLo | mHi)) continue;
                const int s0 = mLo ? __builtin_ctzll(mLo) : 64 + __builtin_ctzll(mHi);
                const int e1 = s0 + __builtin_popcountll(mLo) + __builtin_popcountll(mHi);
                float wLo = sW[lane], wHi = sW[64 + lane];
                f32x2 hf[16];
                { const LAS u32x4* hrow = (const LAS u32x4*)(wl + 4096 + t * 4096 + lane * 64);
#pragma unroll
                  for (int i = 0; i < 4; ++i) { const u32x4 a = hrow[i];
#pragma unroll
                    for (int q = 0; q < 4; ++q) hf[4 * i + q] = (f32x2){bflo(a[q]), bfhi(a[q])}; } }
#pragma unroll 1
                for (int j0 = s0; j0 < e1; j0 += 8) {
                    u32x4 ua[8]; u32x2 ub[8];
#pragma unroll
                    for (int g = 0; g < 8; ++g) {
                        const int pos = j0 + g;
                        ua[g] = (u32x4){0u, 0u, 0u, 0u}; ub[g] = (u32x2){0u, 0u};
                        if (pos < e1) {
                            const int e = __builtin_amdgcn_readlane(pos < 64 ? eLo : eHi, pos & 63);
                            const unsigned char* ur = U + (size_t)e * 1536;
                            ua[g] = *(const u32x4*)(ur + (unsigned)lane * 16u); ub[g] = *(const u32x2*)(ur + 1024u + (unsigned)lane * 8u);
                        }
                    }
                    float d[8];
#pragma unroll
                    for (int g = 0; g < 8; ++g) {
                        d[g] = 0.f;
                        if (j0 + g < e1) {
                            const f32x32v f = __builtin_amdgcn_cvt_scalef32_pk32_f32_fp6((u32x6){ua[g][0], ua[g][1], ua[g][2], ua[g][3], ub[g][0], ub[g][1]}, 1.0f);
                            f32x2 d2 = {0.f, 0.f};
#pragma unroll
                            for (int i = 0; i < 16; ++i) d2 = (f32x2){f[2 * i], f[2 * i + 1]} * hf[i] + d2;
                            d[g] = d2.x + d2.y;
                        }
                    }
                    float r4[4];
#pragma unroll
                    for (int i = 0; i < 4; ++i) { const float send = u5 ? d[i] : d[4 + i], keep = u5 ? d[4 + i] : d[i]; r4[i] = keep + __shfl_xor(send, 32); }
                    float r2[2];
#pragma unroll
                    for (int i = 0; i < 2; ++i) { const float send = u4 ? r4[i] : r4[2 + i], keep = u4 ? r4[2 + i] : r4[i]; r2[i] = keep + __shfl_xor(send, 16); }
                    const float send = u3 ? r2[0] : r2[1], keep = u3 ? r2[1] : r2[0];
                    float r1 = keep + __shfl_xor(send, 8);
                    r1 += __shfl_xor(r1, 4); r1 += __shfl_xor(r1, 2); r1 += __shfl_xor(r1, 1);
                    const float act = gelu_tanh(r1 * (1.f / U8_SCALE)) * (1.f / V8_SCALE);
                    const bool inLo = (lane >= j0) && (lane < j0 + 8);
                    const int gsel = inLo ? lane - j0 : lane + 64 - j0;
                    const int src = ((gsel & 4) << 3) | ((gsel & 2) << 3) | ((gsel & 1) << 3);
                    const float got = __shfl(act, src & 63);
                    if (gsel >= 0 && gsel < 8 && j0 + gsel < e1) { if (inLo) wLo = got * wLo; else wHi = got * wHi; }
                }
                sW[lane] = wLo; sW[64 + lane] = wHi;
            }
        }
        asm volatile("s_waitcnt lgkmcnt(0)" ::: "memory");
#pragma unroll 1
        for (int r = 0; r < 4; ++r) {
#pragma unroll 1
            for (int t = 0; t < 4; ++t) {
                const int m = c.gw + (grp * 4 + t) * c.ngw;
                if (m >= M) continue;
                LAS int* sE = (LAS int*)(wl + t * 1024); LAS float* sW = (LAS float*)(wl + t * 1024 + 512);
                LAS u32x4* pk = (LAS u32x4*)(wl + 4096 + t * 4096 + lane * 64);
                const int eLo = sE[lane], eHi = sE[64 + lane]; const float wLo = sW[lane], wHi = sW[64 + lane];
                const unsigned long long mLo = __ballot((eLo >> RSH) == r), mHi = __ballot((eHi >> RSH) == r);
                const int s0 = mLo ? __builtin_ctzll(mLo) : (mHi ? 64 + __builtin_ctzll(mHi) : 0);
                const int e1 = s0 + __builtin_popcountll(mLo) + __builtin_popcountll(mHi);
                f32x2 acc[16];
                if (r == 0) {
#pragma unroll
                    for (int i = 0; i < 16; ++i) acc[i] = (f32x2){0.f, 0.f};
                } else {
#pragma unroll
                    for (int i = 0; i < 4; ++i) { const u32x4 a = pk[i];
#pragma unroll
                        for (int q = 0; q < 4; ++q) acc[4 * i + q] = (f32x2){bflo(a[q]), bfhi(a[q])}; }
                }
#define SV_ISSUE(P, J0) do { _Pragma("unroll") for (int g = 0; g < 8; ++g) { const int pos = (J0) + g; P##w[g] = 0.f; P##a[g] = (u32x4){0u, 0u, 0u, 0u}; P##b[g] = (u32x2){0u, 0u}; \
                        if (pos < e1) { const int e = __builtin_amdgcn_readlane(pos < 64 ? eLo : eHi, pos & 63); \
                            P##w[g] = __builtin_bit_cast(float, __builtin_amdgcn_readlane(__builtin_bit_cast(int, pos < 64 ? wLo : wHi), pos & 63)); \
                            const unsigned char* vr = V + (size_t)e * 1536; P##a[g] = *(const u32x4*)(vr + (unsigned)lane * 16u); P##b[g] = *(const u32x2*)(vr + 1024u + (unsigned)lane * 8u); } } } while (0)
#define SV_COMPUTE(P, J0) do { _Pragma("unroll") for (int g = 0; g < 8; ++g) if ((J0) + g < e1) { const f32x2 w2 = {P##w[g], P##w[g]}; \
                        const f32x32v f = __builtin_amdgcn_cvt_scalef32_pk32_f32_fp6((u32x6){P##a[g][0], P##a[g][1], P##a[g][2], P##a[g][3], P##b[g][0], P##b[g][1]}, 1.0f); \
                        _Pragma("unroll") for (int i = 0; i < 16; ++i) acc[i] = (f32x2){f[2 * i], f[2 * i + 1]} * w2 + acc[i]; } } while (0)
                if (s0 < e1) {
                    u32x4 A_a[8], B_a[8]; u32x2 A_b[8], B_b[8]; float A_w[8], B_w[8];
                    SV_ISSUE(A_, s0);
#pragma unroll 1
                    for (int j0 = s0; j0 < e1; j0 += 16) {
                        if (j0 + 8 < e1) SV_ISSUE(B_, j0 + 8);
                        SV_COMPUTE(A_, j0);
                        if (j0 + 16 < e1) SV_ISSUE(A_, j0 + 16);
                        if (j0 + 8 < e1) SV_COMPUTE(B_, j0 + 8);
                    }
                }
#undef SV_ISSUE
#undef SV_COMPUTE
                if (r < 3) {
#pragma unroll
                    for (int i = 0; i < 4; ++i) pk[i] = (u32x4){pk2(acc[4 * i].x, acc[4 * i].y), pk2(acc[4 * i + 1].x, acc[4 * i + 1].y), pk2(acc[4 * i + 2].x, acc[4 * i + 2].y), pk2(acc[4 * i + 3].x, acc[4 * i + 3].y)};
                } else {
                    const int b = m / SEQ;
                    float* orow = p.out + (size_t)m * D + lane * 32; const float* gt2 = mod + b * 6 * D + 5 * D + lane * 32; const float* fg = p.fng + lane * 32;
                    const bf16_t* x1b = (const bf16_t*)(p.ws + OFF_MERGED) + (size_t)m * D + lane * 32;
                    float ss = 0.f; f32x4 xv[8];
#pragma unroll
                    for (int i = 0; i < 8; ++i) {
                        const f32x4 xa = X1_BF16 ? load_bf16x4(x1b + 4 * i) : *(const f32x4*)(orow + 4 * i), ta = *(const f32x4*)(gt2 + 4 * i);
                        const f32x4 pe = {acc[2 * i].x, acc[2 * i].y, acc[2 * i + 1].x, acc[2 * i + 1].y};
                        const f32x4 v = xa + DBG_BETA * ta * pe; xv[i] = v; ss += (v[0] * v[0] + v[1] * v[1]) + (v[2] * v[2] + v[3] * v[3]);
                    }
                    const float rstd = rsqrtf(wave_sum(ss) * (1.f / D) + EPS);
#pragma unroll
                    for (int i = 0; i < 8; ++i) *(f32x4*)(orow + 4 * i) = xv[i] * rstd * *(const f32x4*)(fg + 4 * i);
                }
            }
        }
        asm volatile("s_waitcnt lgkmcnt(0)" ::: "memory");
    }
}
#ifndef GATHER_SORTED
#define GATHER_SORTED 1
#endif

struct XcdBarrier; DI void xcd_barrier(const XcdBarrier& b, int wave_s);
DI int rl2r(int a, int b, int k) { const int va = __builtin_amdgcn_readlane(a, k & 63), vb = __builtin_amdgcn_readlane(b, k & 63); return k < 64 ? va : vb; }
DI void phase_gather_rounds(const Params& p, const Ctx& c, const XcdBarrier& xbar) {
    const bf16_t* H2 = (const bf16_t*)(p.ws + OFF_H); const unsigned char* U = p.ws + OFF_U16; const unsigned char* V = p.ws + OFF_V16;
    const int* IDX = (const int*)(p.ws + OFF_IDX); const float* GW = (const float*)(p.ws + OFF_GW); const float* mod = (const float*)(p.ws + OFF_MOD);
    const int lane = c.lane;
    LAS unsigned char* wl = c.lds + c.wave * 20480;
    const bool u5 = lane & 32, u4 = lane & 16, u3 = lane & 8;
    constexpr int G = 8;
#pragma unroll 1
    for (int pass = 0; pass < 2; ++pass) {
#pragma unroll
        for (int t = 0; t < 4; ++t) {
            const int m = c.gw + (pass * 4 + t) * c.ngw;
            LAS unsigned char* ts = wl + t * 5120;
            if (m < M) {
#pragma unroll
                for (int i = 0; i < 4; ++i) *(LAS u32x4*)(ts + lane * 64 + i * 16) = *(const u32x4*)(H2 + (size_t)m * D + lane * 32 + i * 8);
                *(LAS int*)(ts + 4096 + lane * 4) = IDX[(size_t)m * 128 + lane]; *(LAS int*)(ts + 4096 + 256 + lane * 4) = IDX[(size_t)m * 128 + 64 + lane];
                *(LAS float*)(ts + 4608 + lane * 4) = GW[(size_t)m * 128 + lane]; *(LAS float*)(ts + 4608 + 256 + lane * 4) = GW[(size_t)m * 128 + 64 + lane];
            }
        }
        asm volatile("s_waitcnt vmcnt(0) lgkmcnt(0)" ::: "memory");
#pragma unroll 1
        for (int r = 0; r < 8; ++r) {
#pragma unroll 1
            for (int t = 0; t < 4; ++t) {
                if (c.gw + (pass * 4 + t) * c.ngw >= M) continue;
                LAS unsigned char* ts = wl + t * 5120;
                const int ia = *(LAS int*)(ts + 4096 + lane * 4), ib = *(LAS int*)(ts + 4096 + 256 + lane * 4);
                unsigned long long ma = __ballot((ia >> 11) == r), mb = __ballot((ib >> 11) == r);
                if (!(ma | mb)) continue;
                f32x2 hf[16];
#pragma unroll
                for (int i = 0; i < 4; ++i) { const u32x4 a = *(LAS u32x4*)(ts + lane * 64 + i * 16);
#pragma unroll
                    for (int q = 0; q < 4; ++q) hf[4 * i + q] = (f32x2){bflo(a[q]), bfhi(a[q])}; }
                float wa = 0.f, wb = 0.f; const unsigned long long ma0 = ma, mb0 = mb;
                while (ma | mb) {
                    u32x4 ua[G]; u32x2 ub[G]; int kk[G]; int n = 0;
#pragma unroll
                    for (int g = 0; g < G; ++g) {
                        int k = (g == 0) ? 0 : kk[g - 1];
                        if (ma) { k = __builtin_ctzll(ma); ma &= ma - 1; ++n; } else if (mb) { k = 64 + __builtin_ctzll(mb); mb &= mb - 1; ++n; }
                        kk[g] = k;
                        const int e = rl2r(ia, ib, k);
                        const unsigned char* ur = U + (size_t)e * 1536;
                        ua[g] = *(const u32x4*)(ur + (unsigned)lane * 16u); ub[g] = *(const u32x2*)(ur + 1024u + (unsigned)lane * 8u);
                    }
                    float d[G];
#pragma unroll
                    for (int g = 0; g < G; ++g) {
                        d[g] = 0.f;
                        if (g < n) {
                            const f32x32v f = __builtin_amdgcn_cvt_scalef32_pk32_f32_fp6((u32x6){ua[g][0], ua[g][1], ua[g][2], ua[g][3], ub[g][0], ub[g][1]}, 1.0f);
                            f32x2 d0 = {0.f, 0.f}, d1 = {0.f, 0.f};
#pragma unroll
                            for (int i = 0; i < 8; ++i) { d0 = (f32x2){f[4 * i], f[4 * i + 1]} * hf[2 * i] + d0; d1 = (f32x2){f[4 * i + 2], f[4 * i + 3]} * hf[2 * i + 1] + d1; }
                            d[g] = (d0.x + d0.y) + (d1.x + d1.y);
                        }
                    }
                    float r4[4];
#pragma unroll
                    for (int i = 0; i < 4; ++i) { const float send = u5 ? d[i] : d[4 + i], keep = u5 ? d[4 + i] : d[i]; r4[i] = keep + __shfl_xor(send, 32); }
                    float r2[2];
#pragma unroll
                    for (int i = 0; i < 2; ++i) { const float send = u4 ? r4[i] : r4[2 + i], keep = u4 ? r4[2 + i] : r4[i]; r2[i] = keep + __shfl_xor(send, 16); }
                    const float send = u3 ? r2[0] : r2[1], keep = u3 ? r2[1] : r2[0];
                    float r1 = keep + __shfl_xor(send, 8);
                    r1 += __shfl_xor(r1, 4); r1 += __shfl_xor(r1, 2); r1 += __shfl_xor(r1, 1);
                    const float act = gelu_tanh(r1 * (1.f / U8_SCALE)) * (1.f / V8_SCALE);
#pragma unroll
                    for (int g = 0; g < G; ++g) if (g < n) {
                        const float av = __builtin_bit_cast(float, __builtin_amdgcn_readlane(__builtin_bit_cast(int, act), ((g & 4) << 3) | ((g & 2) << 3) | ((g & 1) << 3)));
                        const int k = kk[g];
                        if (k < 64) { if (lane == k) wa = av; } else { if (lane == k - 64) wb = av; }
                    }
                }
                if ((ma0 >> lane) & 1ull) { LAS float* gp = (LAS float*)(ts + 4608 + lane * 4); *gp = *gp * wa; }
                if ((mb0 >> lane) & 1ull) { LAS float* gp = (LAS float*)(ts + 4608 + 256 + lane * 4); *gp = *gp * wb; }
            }
            if (DBG_ROUND_BAR) xcd_barrier(xbar, c.wave);
        }
        asm volatile("s_waitcnt lgkmcnt(0)" ::: "memory");
#pragma unroll 1
        for (int t = 0; t < 4; ++t) {
            const int m = c.gw + (pass * 4 + t) * c.ngw;
            if (m >= M) continue;
            const int b = m / SEQ;
            LAS unsigned char* ts = wl + t * 5120;
            const int ia = *(LAS int*)(ts + 4096 + lane * 4), ib = *(LAS int*)(ts + 4096 + 256 + lane * 4);
            const float wa = *(LAS float*)(ts + 4608 + lane * 4), wb = *(LAS float*)(ts + 4608 + 256 + lane * 4);
            f32x2 acc[16];
#pragma unroll
            for (int i = 0; i < 16; ++i) acc[i] = (f32x2){0.f, 0.f};
#pragma unroll 1
            for (int k0 = 0; k0 < 128; k0 += G) {
                u32x4 va[G]; u32x2 vb[G]; float wk[G];
#pragma unroll
                for (int g = 0; g < G; ++g) {
                    const int e = __builtin_amdgcn_readlane(k0 < 64 ? ia : ib, (k0 + g) & 63);
                    wk[g] = __builtin_bit_cast(float, __builtin_amdgcn_readlane(__builtin_bit_cast(int, k0 < 64 ? wa : wb), (k0 + g) & 63));
                    const unsigned char* vr = V + (size_t)e * 1536;
                    va[g] = *(const u32x4*)(vr + (unsigned)lane * 16u); vb[g] = *(const u32x2*)(vr + 1024u + (unsigned)lane * 8u);
                }
#pragma unroll
                for (int g = 0; g < G; ++g) { const f32x2 w2 = {wk[g], wk[g]};
                    const f32x32v f = __builtin_amdgcn_cvt_scalef32_pk32_f32_fp6((u32x6){va[g][0], va[g][1], va[g][2], va[g][3], vb[g][0], vb[g][1]}, 1.0f);
#pragma unroll
                    for (int i = 0; i < 16; ++i) acc[i] = (f32x2){f[2 * i], f[2 * i + 1]} * w2 + acc[i]; }
            }
            float* orow = p.out + (size_t)m * D + lane * 32; const float* gt2 = mod + b * 6 * D + 5 * D + lane * 32; const float* fg = p.fng + lane * 32;
            float ss = 0.f; f32x4 xv[8];
#pragma unroll
            for (int i = 0; i < 8; ++i) {
                const f32x4 xa = *(const f32x4*)(orow + 4 * i), ta = *(const f32x4*)(gt2 + 4 * i);
                const f32x4 pe = {acc[2 * i].x, acc[2 * i].y, acc[2 * i + 1].x, acc[2 * i + 1].y};
                const f32x4 v = xa + DBG_BETA * ta * pe; xv[i] = v; ss += (v[0] * v[0] + v[1] * v[1]) + (v[2] * v[2] + v[3] * v[3]);
            }
            const float rstd = rsqrtf(wave_sum(ss) * (1.f / D) + EPS);
#pragma unroll
            for (int i = 0; i < 8; ++i) *(f32x4*)(orow + 4 * i) = xv[i] * rstd * *(const f32x4*)(fg + 4 * i);
        }
    }
}
#ifndef GATHER_ROUNDS
#define GATHER_ROUNDS 0
#endif

constexpr size_t OFF_WK = OFF_GB + (size_t)32 * 1024 * 1024;
constexpr size_t OFF_SSQ = OFF_GB + (size_t)48 * 1024 * 1024;
constexpr int NPU = 2, NPV = 2;
struct PairPick { int k; bool valid; };
DI PairPick pick_next(unsigned long long& ma, unsigned long long& mb, int prev) {
    PairPick r;
    if (ma) { r.k = __builtin_ctzll(ma); ma &= ma - 1; r.valid = true; }
    else if (mb) { r.k = 64 + __builtin_ctzll(mb); mb &= mb - 1; r.valid = true; }
    else { r.k = prev; r.valid = false; }
    return r;
}
DI int rl2(int a, int b, int k) { const int va = __builtin_amdgcn_readlane(a, k & 63), vb = __builtin_amdgcn_readlane(b, k & 63); return k < 64 ? va : vb; }
DI float rl2f(float a, float b, int k) { return __builtin_bit_cast(float, rl2(__builtin_bit_cast(int, a), __builtin_bit_cast(int, b), k)); }

DI void gather_u(const Params& p, const Ctx& c) {
    const bf16_t* H2 = (const bf16_t*)(p.ws + OFF_H); const unsigned char* U = p.ws + OFF_U16;
    const int* IDX = (const int*)(p.ws + OFF_IDX); const float* GW = (const float*)(p.ws + OFF_GW); float* WK = (float*)(p.ws + OFF_WK);
    const int x = blockIdx.x & 7, jb = blockIdx.x >> 3, nj = ((int)gridDim.x - x + 7) >> 3;
    const int wl = jb * NWAVES + c.wave, nwl = nj * NWAVES;
    constexpr int G = 4, SH = (NPU == 2) ? 10 : 11;
#pragma unroll 1
    for (int ps = 0; ps < NPU; ++ps) {
        const int part = x * NPU + ps;
#pragma unroll 1
        for (int m = wl; m < M; m += nwl) {
            const int ia = IDX[(size_t)m * 128 + c.lane], ib = IDX[(size_t)m * 128 + 64 + c.lane];
            unsigned long long ma = __ballot((ia >> SH) == part), mb = __ballot((ib >> SH) == part);
            if (!(ma | mb)) continue;
            const unsigned long long ma0 = ma, mb0 = mb;
            float hf[2][16];
#pragma unroll
            for (int j = 0; j < 2; ++j) { const u32x4 a = *(const u32x4*)(H2 + (size_t)m * D + j * 1024 + c.lane * 16), bq = *(const u32x4*)(H2 + (size_t)m * D + j * 1024 + c.lane * 16 + 8);
#pragma unroll
                for (int q = 0; q < 4; ++q) { hf[j][2 * q] = bflo(a[q]); hf[j][2 * q + 1] = bfhi(a[q]); hf[j][8 + 2 * q] = bflo(bq[q]); hf[j][8 + 2 * q + 1] = bfhi(bq[q]); } }
            const float ga = GW[(size_t)m * 128 + c.lane], gb = GW[(size_t)m * 128 + 64 + c.lane];
            float wa = 0.f, wb = 0.f;
            int prev = 0;
            while (ma | mb) {
                PairPick pk[G]; u32x4 uu[G][2];
#pragma unroll
                for (int g = 0; g < G; ++g) { pk[g] = pick_next(ma, mb, prev); prev = pk[g].k;
                    const int e = rl2(ia, ib, pk[g].k);
                    const unsigned char* ur = U + (size_t)e * D;
#pragma unroll
                    for (int j = 0; j < 2; ++j) uu[g][j] = *(const u32x4*)(ur + ((unsigned)c.lane * 16u + j * 1024u)); }
                float d[G];
#pragma unroll
                for (int g = 0; g < G; ++g) {
                    float d0 = 0.f, d1 = 0.f;
#pragma unroll
                    for (int j = 0; j < 2; ++j)
#pragma unroll
                        for (int q = 0; q < 4; ++q) { const f32x2 lo = __builtin_amdgcn_cvt_pk_f32_fp8((int)uu[g][j][q], false), hi = __builtin_amdgcn_cvt_pk_f32_fp8((int)uu[g][j][q], true);
                            d0 += lo.x * hf[j][4 * q] + hi.x * hf[j][4 * q + 2]; d1 += lo.y * hf[j][4 * q + 1] + hi.y * hf[j][4 * q + 3]; }
                    d[g] = d0 + d1;
                }
#pragma unroll
                for (int o = 1; o < 64; o <<= 1)
#pragma unroll
                    for (int g = 0; g < G; ++g) d[g] += __shfl_xor(d[g], o);
#pragma unroll
                for (int g = 0; g < G; ++g) if (pk[g].valid) {
                    const float a = gelu_tanh(d[g] * (1.f / U8_SCALE)) * (1.f / V8_SCALE); const int k = pk[g].k;
                    if (k < 64) { if (c.lane == k) wa = a * ga; } else { if (c.lane == k - 64) wb = a * gb; }
                }
            }
            if ((ma0 >> c.lane) & 1ull) WK[(size_t)m * 128 + c.lane] = wa;
            if ((mb0 >> c.lane) & 1ull) WK[(size_t)m * 128 + 64 + c.lane] = wb;
        }
    }
}

DI void gather_v(const Params& p, const Ctx& c) {
    const unsigned char* V = p.ws + OFF_V16;
    const int* IDX = (const int*)(p.ws + OFF_IDX); const float* WK = (const float*)(p.ws + OFF_WK); const float* mod = (const float*)(p.ws + OFF_MOD);
    float* SSQ = (float*)(p.ws + OFF_SSQ);
    const int x = blockIdx.x & 7, jb = blockIdx.x >> 3, nj = ((int)gridDim.x - x + 7) >> 3;
    const int wl = jb * NWAVES + c.wave, nwl = nj * NWAVES;
    const int q4 = c.lane >> 4, l16 = c.lane & 15;
    const unsigned voff = 256u * x + l16 * 16u;
    constexpr int SHV = (NPV == 2) ? 13 : 14;
#pragma unroll 1
    for (int ps = 0; ps < NPV; ++ps) {
#pragma unroll 1
        for (int m = wl; m < M; m += nwl) {
            const int b = m / SEQ;
            const int ia = IDX[(size_t)m * 128 + c.lane], ib = IDX[(size_t)m * 128 + 64 + c.lane];
            const float wa = WK[(size_t)m * 128 + c.lane], wb = WK[(size_t)m * 128 + 64 + c.lane];
            unsigned long long ma = __ballot((ia >> SHV) == ps), mb = __ballot((ib >> SHV) == ps);
            float acc[16];
#pragma unroll
            for (int i = 0; i < 16; ++i) acc[i] = 0.f;
            int prev = 0;
            while (ma | mb) {
                u32x4 vv[4]; float wv[4];
#pragma unroll
                for (int s4 = 0; s4 < 4; ++s4) {
                    int e = 0; float w = 0.f;
#pragma unroll
                    for (int g = 0; g < 4; ++g) { const PairPick pk = pick_next(ma, mb, prev); prev = pk.k;
                        const int eg = rl2(ia, ib, pk.k); const float wg = pk.valid ? rl2f(wa, wb, pk.k) : 0.f;
                        e = (q4 == g) ? eg : e; w = (q4 == g) ? wg : w; }
                    vv[s4] = *(const u32x4*)(V + (size_t)e * D + voff); wv[s4] = w;
                }
#pragma unroll
                for (int s4 = 0; s4 < 4; ++s4)
#pragma unroll
                    for (int q = 0; q < 4; ++q) { const f32x2 lo = __builtin_amdgcn_cvt_pk_f32_fp8((int)vv[s4][q], false), hi = __builtin_amdgcn_cvt_pk_f32_fp8((int)vv[s4][q], true);
                        acc[4 * q] += wv[s4] * lo.x; acc[4 * q + 1] += wv[s4] * lo.y; acc[4 * q + 2] += wv[s4] * hi.x; acc[4 * q + 3] += wv[s4] * hi.y; }
            }
#pragma unroll
            for (int i = 0; i < 16; ++i) { acc[i] += __shfl_xor(acc[i], 16); acc[i] += __shfl_xor(acc[i], 32); }
            f32x4 sel;
#pragma unroll
            for (int e = 0; e < 4; ++e) sel[e] = q4 == 0 ? acc[e] : (q4 == 1 ? acc[4 + e] : (q4 == 2 ? acc[8 + e] : acc[12 + e]));
            const int col = 256 * x + 16 * l16 + 4 * q4;
            float* op = p.out + (size_t)m * D + col;
            const f32x4 val = *(const f32x4*)op + DBG_BETA * *(const f32x4*)(mod + b * 6 * D + 5 * D + col) * sel;
            *(f32x4*)op = val;
            if (ps == NPV - 1) { const float ss = wave_sum(val[0] * val[0] + val[1] * val[1] + val[2] * val[2] + val[3] * val[3]); if (c.lane == 0) SSQ[(size_t)m * 8 + x] = ss; }
        }
    }
}
DI void gather_final(const Params& p, const Ctx& c) {
    const float* SSQ = (const float*)(p.ws + OFF_SSQ);
    for (int m = c.gw; m < M; m += c.ngw) {
        float s = (c.lane < 8) ? SSQ[(size_t)m * 8 + c.lane] : 0.f;
        s += __shfl_xor(s, 1); s += __shfl_xor(s, 2); s += __shfl_xor(s, 4);
        const float rstd = rsqrtf(__shfl(s, 0) * (1.f / D) + EPS);
        float* orow = p.out + (size_t)m * D;
#pragma unroll
        for (int j = 0; j < 8; ++j) { const int col = (j * 64 + c.lane) * 4; *(f32x4*)(orow + col) = *(const f32x4*)(orow + col) * rstd * *(const f32x4*)(p.fng + col); }
    }
}
#ifndef GATHER_L2
#define GATHER_L2 0
#endif

DI void phase_gather_v2(const Params& p, const Ctx& c) {
    const bf16_t* H2 = (const bf16_t*)(p.ws + OFF_H);
    const int* IDX = (const int*)(p.ws + OFF_IDX); const float* GW = (const float*)(p.ws + OFF_GW); const float* mod = (const float*)(p.ws + OFF_MOD);
    LAS float* hs = (LAS float*)c.lds; LAS float* wk = hs + 2048; LAS int* ek = (LAS int*)(wk + 128); LAS float* red = (LAS float*)(ek + 128);
    for (int m = blockIdx.x; m < M; m += gridDim.x) {
        const int b = m / SEQ;
        __syncthreads();
        for (int i = c.tid; i < 2048; i += NTHREADS) hs[i] = bf2f(H2[(size_t)m * D + i]);
        if (c.tid < 128) ek[c.tid] = IDX[(size_t)m * 128 + c.tid];
        __syncthreads();
        for (int k = c.wave; k < 128; k += NWAVES) {
            const float* ur = p.pu + (size_t)ek[k] * D;
            float d = 0.f;
            for (int i = 0; i < 8; ++i) { const int col = i * 256 + c.lane * 4; const f32x4 u = *(const f32x4*)(ur + col);
                d += u[0] * hs[col] + u[1] * hs[col + 1] + u[2] * hs[col + 2] + u[3] * hs[col + 3]; }
            d = wave_sum(d);
            if (c.lane == 0) wk[k] = gelu_tanh(d) * GW[(size_t)m * 128 + k];
        }
        __syncthreads();
        const int col = c.tid * 4;
        f32x4 acc = {0.f, 0.f, 0.f, 0.f};
        for (int k = 0; k < 128; ++k) { const f32x4 v = *(const f32x4*)(p.pv + (size_t)ek[k] * D + col); acc += v * wk[k]; }
        float* orow = p.out + (size_t)m * D;
        const f32x4 x2 = *(const f32x4*)(orow + col) + DBG_BETA * *(const f32x4*)(mod + b * 6 * D + 5 * D + col) * acc;
        float ss = wave_sum(x2[0] * x2[0] + x2[1] * x2[1] + x2[2] * x2[2] + x2[3] * x2[3]);
        if (c.lane == 0) red[c.wave] = ss;
        __syncthreads();
        float tot = 0.f;
        for (int w = 0; w < NWAVES; ++w) tot += red[w];
        const float rstd = rsqrtf(tot * (1.f / D) + EPS);
        *(f32x4*)(orow + col) = x2 * rstd * *(const f32x4*)(p.fng + col);
    }
}


#define XB_TMO      128
#define XB_XCNT(j)  (256  + 64 * (j))
#define XB_XSUB(j)  (1280 + 64 * (j))
#define XB_XGEN(j)  (2304 + 64 * (j))
#define XB_TOP      3328
#define XB_TOPGEN   3392
#define XCD_BAR_WORDS 3456
#define XB_SPIN_CAP (1u << 18)

__device__ __forceinline__ unsigned xb_ld(unsigned* p)              { return __hip_atomic_load(p, __ATOMIC_RELAXED, __HIP_MEMORY_SCOPE_AGENT); }
__device__ __forceinline__ unsigned xb_add(unsigned* p, unsigned v) { return __hip_atomic_fetch_add(p, v, __ATOMIC_RELAXED, __HIP_MEMORY_SCOPE_AGENT); }
__device__ __forceinline__ unsigned xb_xcc_id() { return (unsigned)__builtin_amdgcn_s_getreg((3 << 11) | 20) & 0xFu; }
#define XB_SPIN(cond, bar) do { unsigned _sp = 0; while (cond) { __builtin_amdgcn_s_sleep(1); \
    if ((++_sp & 255u) == 0u) { if (xb_ld(&(bar)[XB_TMO])) break; if (_sp > XB_SPIN_CAP) { atomicAdd(&(bar)[XB_TMO], 1u); break; } } } } while (0)

struct XcdBarrier {
    unsigned* bar; unsigned x;
    volatile LAS unsigned* st;
};

__device__ __forceinline__ XcdBarrier xcd_barrier_post(unsigned* bar, volatile LAS unsigned* st) {
    XcdBarrier b; b.bar = bar; b.x = xb_xcc_id(); b.st = st;
    if (threadIdx.x == 0) (void)xb_add(&bar[XB_XCNT(b.x)], 1u);
    return b;
}
__device__ __forceinline__ void xcd_barrier_complete(unsigned* bar, unsigned x, unsigned& nloc, unsigned& nx) {
    const unsigned G = gridDim.x * gridDim.y * gridDim.z;
    unsigned sum, cnt, mine, sp = 0u;
    for (;;) {
        sum = 0u; cnt = 0u; mine = 0u;
#pragma unroll
        for (unsigned j = 0; j < 16; ++j) { const unsigned c = xb_ld(&bar[XB_XCNT(j)]); sum += c; cnt += (c > 0u) ? 1u : 0u; mine = (j == x) ? c : mine; }
        if (sum == G) break;
        __builtin_amdgcn_s_sleep(1);
        if ((++sp & 255u) == 0u) { if (xb_ld(&bar[XB_TMO])) break; if (sp > XB_SPIN_CAP) { atomicAdd(&bar[XB_TMO], 1u); break; } }
    }
    nloc = mine > 0u ? mine : 1u; nx = cnt > 0u ? cnt : 1u;
}

__device__ __forceinline__ bool xb_lead(int wave_s) { return wave_s == 0 && __builtin_amdgcn_mbcnt_hi(~0u, __builtin_amdgcn_mbcnt_lo(~0u, 0u)) == 0; }
__device__ __forceinline__ void xcd_barrier(const XcdBarrier& b, int wave_s) {
    asm volatile("s_waitcnt vmcnt(0)" ::: "memory");
    __syncthreads();
    if (xb_lead(wave_s)) {
        unsigned* bar = b.bar;
        __builtin_amdgcn_s_waitcnt(0);
        unsigned nloc = b.st[0], nx = b.st[1];
        if (nloc == 0u) { xcd_barrier_complete(bar, b.x, nloc, nx); b.st[0] = nloc; b.st[1] = nx; }
        const unsigned old = xb_add(&bar[XB_XSUB(b.x)], 1u);
        const unsigned gen = old / nloc;
        if (old + 1u == (gen + 1u) * nloc) {
            __builtin_amdgcn_fence(__ATOMIC_RELEASE, "agent");
            asm volatile("s_waitcnt vmcnt(0)" ::: "memory");
            const unsigned og = xb_add(&bar[XB_TOP], 1u);
            const unsigned tg = og / nx;
            if (og + 1u == (tg + 1u) * nx) xb_add(&bar[XB_TOPGEN], 1u);
            else XB_SPIN(xb_ld(&bar[XB_TOPGEN]) == tg, bar);
            __builtin_amdgcn_fence(__ATOMIC_ACQUIRE, "agent");
            xb_add(&bar[XB_XGEN(b.x)], 1u);
            asm volatile("s_waitcnt vmcnt(0)" ::: "memory");
        } else {
            XB_SPIN(xb_ld(&bar[XB_XGEN(b.x)]) == gen, bar);
            __builtin_amdgcn_fence(__ATOMIC_ACQUIRE, "agent");
            asm volatile("s_waitcnt vmcnt(0)" ::: "memory");
        }
    }
    __syncthreads();
}


DI void grid_barrier(unsigned* ctr, unsigned target, int wave_s) {
    asm volatile("s_waitcnt vmcnt(0)" ::: "memory");
    __syncthreads();
    if (wave_s == 0) {
        const int l = __builtin_amdgcn_mbcnt_hi(~0u, __builtin_amdgcn_mbcnt_lo(~0u, 0u));
        if (l == 0) {
            __builtin_amdgcn_fence(__ATOMIC_RELEASE, "agent");
            asm volatile("s_waitcnt vmcnt(0)" ::: "memory");
            __hip_atomic_fetch_add(ctr, 1u, __ATOMIC_RELAXED, __HIP_MEMORY_SCOPE_AGENT);
            unsigned spins = 0;
            while (__hip_atomic_load(ctr, __ATOMIC_RELAXED, __HIP_MEMORY_SCOPE_AGENT) < target) { __builtin_amdgcn_s_sleep(2); if (++spins > (1u << 23)) break; }
            __builtin_amdgcn_fence(__ATOMIC_ACQUIRE, "agent");
            asm volatile("s_waitcnt vmcnt(0)" ::: "memory");
        }
    }
    __syncthreads();
}

__global__ void __launch_bounds__(NTHREADS, 2) mega(Params p) {
    extern __shared__ __attribute__((aligned(16))) unsigned char lds_raw[];
    const int wave_s = __builtin_amdgcn_readfirstlane(threadIdx.x >> 6);
#define MKCTX() Ctx c; { int l_; asm volatile("v_mbcnt_lo_u32_b32 %0, -1, 0\n\tv_mbcnt_hi_u32_b32 %0, -1, %0" : "=v"(l_)); c.lds = (LAS unsigned char*)lds_raw; c.lane = l_; c.wave = wave_s; c.tid = wave_s * 64 + l_; \
    c.gw = blockIdx.x * NWAVES + wave_s; c.ngw = gridDim.x * NWAVES; }
    unsigned char* ws = p.ws;
    const float* mod = (const float*)(ws + OFF_MOD);
    const int lo = p.ph_lo, hi = p.ph_hi;
    XcdBarrier xbar; xbar.bar = (unsigned*)(ws + OFF_XBAR); xbar.x = 0; xbar.st = nullptr;
    if (USE_XBAR && lo == 0 && hi == NPHASE) {
        volatile LAS unsigned* stw = (volatile LAS unsigned*)(lds_raw + LDS_BYTES - 32);
        if (threadIdx.x < 2) stw[threadIdx.x] = 0u;
        __syncthreads();
        xbar = xcd_barrier_post((unsigned*)(ws + OFF_XBAR), stw);
    }
#define IN(k) (lo <= (k) && (k) < hi)
#define SEAM(k) do { if (IN(k) && IN((k) + 1)) { if (USE_XBAR) xcd_barrier(xbar, wave_s); else grid_barrier((unsigned*)(ws + OFF_CTL), (unsigned)((k) + 1) * gridDim.x, wave_s); \
    if (TIME_PHASE >= 0 && blockIdx.x == 0 && threadIdx.x == 0) ((unsigned long long*)(ws + OFF_CTL + 512))[(k) + 1] = __builtin_amdgcn_s_memrealtime(); } } while (0)

    if (TIME_PHASE >= 0 && blockIdx.x == 0 && threadIdx.x == 0) ((unsigned long long*)(ws + OFF_CTL + 512))[0] = __builtin_amdgcn_s_memrealtime();
    if (IN(0)) { MKCTX(); phase_prologue(p, c, true, PRO_SPLIT == 0); }
    SEAM(0);
    if (IN(1)) for (int rep_ = 0; rep_ < (DUP_PHASE == 1 ? 2 : 1); ++rep_) { MKCTX();
        const long long* modi = (const long long*)(ws + OFF_MODI); float* modw = (float*)(ws + OFF_MOD);
        for (int i = blockIdx.x * NTHREADS + c.tid; i < NB * 6 * D; i += gridDim.x * NTHREADS) modw[i] = (float)((double)modi[i] * (1.0 / 4294967296.0));
        modulate_rows<P2_FP8 != 0>(p.x, p.n1g, modi + 1 * D, modi + 0 * D, (bf16_t*)(ws + OFF_H), c);
        if (PRO_SPLIT) phase_prologue(p, c, false, true);
    }
    SEAM(1);
    if (IN(2)) for (int rep_ = 0; rep_ < (DUP_PHASE == 2 ? 2 : 1); ++rep_) { MKCTX();
        EpiProj e1{(bf16_t*)(ws + OFF_CQ), (bf16_t*)(ws + OFF_CKV), (bf16_t*)(ws + OFF_KR), (bf16_t*)(ws + OFF_SBQ), (bf16_t*)(ws + OFF_SBK), (bf16_t*)(ws + OFF_GA), (bf16_t*)(ws + OFF_GB), (const f32x2*)(ws + OFF_CS), P2_FP8 ? 1.f / W8_SCALE : 1.f};
#if P2_FP8
        GEMM8(c, ws + OFF_H, ws + OFF_WIN, M, 7168, 2048, e1);
#else
        GEMM(c, (const bf16_t*)(ws + OFF_H), (const bf16_t*)(ws + OFF_WIN), M, 7168, 2048, e1);
#endif
        if (DUP_GEMM == 20) GEMM(c, (const bf16_t*)(ws + OFF_H), (const bf16_t*)(ws + OFF_WIN), M, 7168, 2048, e1);
        EpiT e2{(bf16_t*)(ws + OFF_SBVT), nullptr, P2_FP8 ? 1.f / W8_SCALE : 1.f};
#if P2_FP8
        GEMM8(c, ws + OFF_WSBV, ws + OFF_H, 1024, M, 2048, e2);
#else
        GEMM(c, (const bf16_t*)(ws + OFF_WSBV), (const bf16_t*)(ws + OFF_H), 1024, M, 2048, e2);
#endif
        if (DUP_GEMM == 21) GEMM(c, (const bf16_t*)(ws + OFF_WSBV), (const bf16_t*)(ws + OFF_H), 1024, M, 2048, e2);
    }
    SEAM(2);
    if (IN(3)) for (int rep_ = 0; rep_ < (DUP_PHASE == 3 ? 2 : 1); ++rep_) { MKCTX(); phase_rowstats(p, c); }
    SEAM(3);
    if (DBG_XTRA_BAR) { for (int q_ = 0; q_ < DBG_XTRA_BAR; ++q_) { if (IN(3) && IN(4)) xcd_barrier(xbar, wave_s); } }
    if (IN(4)) for (int rep_ = 0; rep_ < (DUP_PHASE == 4 ? 2 : 1); ++rep_) { MKCTX();
        EpiUq e1{(bf16_t*)(ws + OFF_Q), (const float*)(ws + OFF_RSTQ), (const f32x2*)(ws + OFF_CS)};
        GEMM(c, (const bf16_t*)(ws + OFF_CQ), (const bf16_t*)(ws + OFF_WUQ), M, 1536, 512, e1);
        if (DUP_GEMM == 40) GEMM(c, (const bf16_t*)(ws + OFF_CQ), (const bf16_t*)(ws + OFF_WUQ), M, 1536, 512, e1);
        EpiRowScale e2{(bf16_t*)(ws + OFF_KN), 1024, (const float*)(ws + OFF_RSTKV)};
        GEMM(c, (const bf16_t*)(ws + OFF_CKV), (const bf16_t*)(ws + OFF_WUK), M, 1024, 256, e2);
        if (DUP_GEMM == 41) GEMM(c, (const bf16_t*)(ws + OFF_CKV), (const bf16_t*)(ws + OFF_WUK), M, 1024, 256, e2);
        EpiT e3{(bf16_t*)(ws + OFF_VT), (const float*)(ws + OFF_RSTKV), 1.f};
        GEMM(c, (const bf16_t*)(ws + OFF_WUV), (const bf16_t*)(ws + OFF_CKV), 1024, M, 256, e3);
        if (DUP_GEMM == 42) GEMM(c, (const bf16_t*)(ws + OFF_WUV), (const bf16_t*)(ws + OFF_CKV), 1024, M, 256, e3);
    }
    SEAM(4);
    if (IN(5)) for (int rep_ = 0; rep_ < (DUP_PHASE == 5 ? 2 : 1); ++rep_) {
#if FAST_ATTN
        { MKCTX(); attn_mla_fast(p, c); }
        if (DUP_GEMM == 51) { MKCTX(); attn_mla_fast(p, c); }
        { MKCTX(); attn_sb_fast(p, c); }
        if (DUP_GEMM == 52) { MKCTX(); attn_sb_fast(p, c); }
#else
        MKCTX();
        attn_mla_naive(p, c); attn_sb_naive(p, c);
#endif
    }
    SEAM(5);
    if (IN(6)) for (int rep_ = 0; rep_ < (DUP_PHASE == 6 ? 2 : 1); ++rep_) { MKCTX();
        EpiGate1 e1{(bf16_t*)(ws + OFF_MERGED), (const bf16_t*)(ws + OFF_GA), P67_FP8 ? 1.f / (W8_SCALE * ACT8_SCALE) : 1.f};
#if P67_FP8
        GEMM8(c, ws + OFF_ATTA, ws + OFF_WA, M, 2048, 1024, e1);
#else
        GEMM(c, (const bf16_t*)(ws + OFF_ATTA), (const bf16_t*)(ws + OFF_WA), M, 2048, 1024, e1);
#endif
        if (DUP_GEMM == 60) GEMM(c, (const bf16_t*)(ws + OFF_ATTA), (const bf16_t*)(ws + OFF_WA), M, 2048, 1024, e1);
        EpiGate2 e2{(bf16_t*)(ws + OFF_MERGED), (const bf16_t*)(ws + OFF_GB), ws + OFF_H, P67_FP8 ? 1.f / (W8_SCALE * ACT8_SCALE) : 1.f};
#if P67_FP8
        GEMM8(c, ws + OFF_ATTB, ws + OFF_WB, M, 2048, 1024, e2);
#else
        GEMM(c, (const bf16_t*)(ws + OFF_ATTB), (const bf16_t*)(ws + OFF_WB), M, 2048, 1024, e2);
#endif
    }
    SEAM(6);
    if (IN(7)) for (int rep_ = 0; rep_ < (DUP_PHASE == 7 ? 2 : 1); ++rep_) { MKCTX();
        EpiRes e{p.x, mod + 2 * D, X1_BF16 ? (float*)(ws + OFF_MERGED) : p.out, P67_FP8 ? 1.f / (W8_SCALE * ACT8_SCALE) : 1.f};
#if P67_FP8
        GEMM8(c, ws + OFF_H, ws + OFF_WOUT, M, 2048, 2048, e);
#else
        GEMM(c, (const bf16_t*)(ws + OFF_MERGED), (const bf16_t*)(ws + OFF_WOUT), M, 2048, 2048, e);
#endif
    }
    SEAM(7);
    if (IN(8)) for (int rep_ = 0; rep_ < (DUP_PHASE == 8 ? 2 : 1); ++rep_) { MKCTX();
        modulate_rows<false, X1_BF16 != 0>(X1_BF16 ? (const float*)(ws + OFF_MERGED) : p.out, p.n2g, mod + 4 * D, mod + 3 * D, (bf16_t*)(ws + OFF_H), c);
        convert_table(p.pu, ws + OFF_U16, U8_SCALE, c);
        convert_table(p.pv, ws + OFF_V16, V8_SCALE, c);
    }
    SEAM(8);
    if (IN(9)) for (int rep_ = 0; rep_ < (DUP_PHASE == 9 ? 2 : 1); ++rep_) { MKCTX();
        EpiPq e{(bf16_t*)(ws + OFF_PQ)};
        GEMM(c, (const bf16_t*)(ws + OFF_H), (const bf16_t*)(ws + OFF_WPQ), M, 2048, 2048, e);
#if FAST_SEL && FAST_GEMM && SEL_FUSED
        { MKCTX(); select_own_tiles(p, c); }
#endif
    }
#if !(FAST_SEL && FAST_GEMM && SEL_FUSED)
    SEAM(9);
    if (IN(10)) for (int rep_ = 0; rep_ < (DUP_PHASE == 10 ? 2 : 1); ++rep_) { MKCTX();
#if FAST_SEL
        select_fast(p, c);
#else
        select_naive(p, c);
#endif
    }
#else
    if (IN(9) && IN(10)) {   }
#endif
    SEAM(10);
#if GATHER_L2
    if (IN(11)) { MKCTX(); gather_u(p, c); }
    SEAM(11);
    if (IN(12)) { MKCTX(); gather_v(p, c); }
    SEAM(12);
    if (IN(13)) { MKCTX(); gather_final(p, c); }
#else
#if GATHER_SORTED
    if (IN(11)) { MKCTX(); phase_gather_sorted(p, c); }
#elif GATHER_ROUNDS
    if (IN(11)) { MKCTX(); phase_gather_rounds(p, c, xbar); }
#else
    if (IN(11)) { if (DUP_GEMM == 110) { MKCTX(); phase_gather(p, c, (float*)(ws + OFF_SBQ)); }
        if (DUP_GEMM == 111) { MKCTX(); phase_gather(p, c, (float*)(ws + OFF_SBQ), 0x3ff); } MKCTX(); phase_gather(p, c, p.out); }
#endif
#endif
#undef IN
#undef SEAM
}

extern "C" void kernel_launch(void* const* d_in, const int* in_sizes, int n_in, void* d_out, int out_size, void* d_ws, size_t ws_size, hipStream_t stream) {
    static int grid = 0;
    if (grid == 0) {
        if (n_in != 20 || out_size != M * D || ws_size < WS_END) { fprintf(stderr, "kernel_launch: unexpected shapes (n_in %d out %d ws %zu need %zu)\n", n_in, out_size, ws_size, (size_t)WS_END); grid = -1; return; }
        int dev = 0, cus = 0, per_cu = 0;
        (void)hipGetDevice(&dev); (void)hipDeviceGetAttribute(&cus, hipDeviceAttributeMultiprocessorCount, dev);
        if (hipFuncSetAttribute((const void*)mega, hipFuncAttributeMaxDynamicSharedMemorySize, LDS_BYTES) != hipSuccess) { fprintf(stderr, "kernel_launch: hipFuncSetAttribute failed\n"); grid = -1; return; }
        if (hipOccupancyMaxActiveBlocksPerMultiprocessor(&per_cu, (const void*)mega, NTHREADS, LDS_BYTES) != hipSuccess || per_cu < 1) { fprintf(stderr, "kernel_launch: occupancy query failed (%d)\n", per_cu); per_cu = 1; }
        (void)hipGetLastError();
        grid = cus;
    }
    if (grid < 0) return;
    (void)hipMemsetAsync((char*)d_ws + OFF_CTL, 0, ZERO_BYTES, stream);
    Params p{};
    p.x = (const float*)d_in[0]; p.c = (const float*)d_in[1]; p.pos = (const int*)d_in[2]; p.ada_w = (const float*)d_in[3]; p.ada_b = (const float*)d_in[4];
    p.n1g = (const float*)d_in[5]; p.n2g = (const float*)d_in[6]; p.w_in = (const float*)d_in[7]; p.qng = (const float*)d_in[8]; p.kvng = (const float*)d_in[9];
    p.w_uq = (const float*)d_in[10]; p.w_ukv = (const float*)d_in[11]; p.w_bm = (const float*)d_in[12]; p.w_bs = (const float*)d_in[13]; p.w_out = (const float*)d_in[14];
    p.w_pq = (const float*)d_in[15]; p.skeys = (const float*)d_in[16]; p.pu = (const float*)d_in[17]; p.pv = (const float*)d_in[18]; p.fng = (const float*)d_in[19];
    p.out = (float*)d_out; p.ws = (unsigned char*)d_ws;
    for (int i = 0; i < 32; ++i) p.invf[i] = (float)pow(10000.0, -(double)i / 32.0);
#if N_LAUNCH_MODE == 1
    p.ph_lo = 0; p.ph_hi = NPHASE;
    void* args[] = {&p};
    hipError_t e = hipLaunchCooperativeKernel((const void*)mega, dim3(grid), dim3(NTHREADS), args, LDS_BYTES, stream);
    if (e != hipSuccess) fprintf(stderr, "cooperative launch failed: %s (grid %d)\n", hipGetErrorString(e), grid);
#else
    for (int k = 0; k < NPHASE; ++k) {
        p.ph_lo = k; p.ph_hi = k + 1;
        hipLaunchKernelGGL(mega, dim3(grid), dim3(NTHREADS), LDS_BYTES, stream, p);
    }
#endif
}
```

```cpp
#include <hip/hip_runtime.h>
#include <hip/hip_cooperative_groups.h>
#include <cstdio>
#include <cstdint>
#include <cmath>
namespace cg = cooperative_groups;

#ifndef N_LAUNCH_MODE
#define N_LAUNCH_MODE 1
#endif

#ifndef TIME_PHASE
#define TIME_PHASE -1
#endif
#ifndef TIME_SCALE
#define TIME_SCALE 5000.f
#endif
#ifndef DUP_GEMM
#define DUP_GEMM -1
#endif
#ifndef PRO_SPLIT
#define PRO_SPLIT 1
#endif
#ifndef USE_XBAR
#define USE_XBAR 1
#endif
#ifndef DBG_XTRA_BAR
#define DBG_XTRA_BAR 0
#endif
#ifndef DBG_ROUND_BAR
#define DBG_ROUND_BAR 0
#endif
#ifndef GATHER_DYN
#define GATHER_DYN 1
#endif
#ifndef SEL_FUSED
#define SEL_FUSED 1
#endif
#ifndef DUP_PHASE
#define DUP_PHASE -1
#endif
#ifndef DBG_ALPHA
#define DBG_ALPHA 1.0f
#endif
#ifndef DBG_BETA
#define DBG_BETA 1.0f
#endif
#define LAS __attribute__((address_space(3)))
#define DI __device__ __forceinline__
typedef unsigned short bf16_t;
typedef short bf16x8 __attribute__((ext_vector_type(8)));
typedef float f32x4 __attribute__((ext_vector_type(4)));
typedef float f32x2 __attribute__((ext_vector_type(2)));
typedef unsigned u32x4 __attribute__((ext_vector_type(4)));
typedef unsigned u32x2 __attribute__((ext_vector_type(2)));
typedef __bf16 bf16v2 __attribute__((ext_vector_type(2)));

constexpr int M = 16384, D = 2048, SEQ = 4096, NB = 4;
constexpr int NTHREADS = 512, NWAVES = 8;
constexpr int LDS_BYTES = 160 * 1024;
constexpr float EPS = 1e-6f;
constexpr float LOG2E = 1.4426950408889634f;
constexpr int NPHASE = 14;

constexpr size_t al256(size_t x) { return (x + 255) & ~(size_t)255; }
constexpr size_t OFF_CTL = 0;
constexpr size_t OFF_XBAR = 4096;
constexpr size_t OFF_MODI = 32768;
constexpr size_t ZERO_BYTES = OFF_MODI + (size_t)NB * 6 * D * 8;
constexpr size_t OFF_MOD = al256(ZERO_BYTES);
constexpr size_t OFF_RSTQ = OFF_MOD + (size_t)NB * 6 * D * 4;
constexpr size_t OFF_RSTKV = OFF_RSTQ + (size_t)M * 4;
constexpr size_t OFF_CS = OFF_RSTKV + (size_t)M * 4;
constexpr size_t OFF_KEYS = OFF_CS + (size_t)M * 32 * 8;
constexpr size_t OFF_WIN = OFF_KEYS + (size_t)8 * 2 * 128 * 128 * 2;
constexpr size_t OFF_WSBV = OFF_WIN + (size_t)7168 * 2048 * 2;
constexpr size_t OFF_WUQ = OFF_WSBV + (size_t)1024 * 2048 * 2;
constexpr size_t OFF_WUK = OFF_WUQ + (size_t)1536 * 512 * 2;
constexpr size_t OFF_WUV = OFF_WUK + (size_t)1024 * 256 * 2;
constexpr size_t OFF_WA = OFF_WUV + (size_t)1024 * 256 * 2;
constexpr size_t OFF_WB = OFF_WA + (size_t)2048 * 1024 * 2;
constexpr size_t OFF_WOUT = OFF_WB + (size_t)2048 * 1024 * 2;
constexpr size_t OFF_WPQ = OFF_WOUT + (size_t)2048 * 2048 * 2;
constexpr size_t OFF_H = OFF_WPQ + (size_t)2048 * 2048 * 2;
constexpr size_t OFF_CQ = OFF_H + (size_t)M * 2048 * 2;
constexpr size_t OFF_CKV = OFF_CQ + (size_t)M * 512 * 2;
constexpr size_t OFF_KR = OFF_CKV + (size_t)M * 256 * 2;
constexpr size_t OFF_SBQ = OFF_KR + (size_t)M * 64 * 2;
constexpr size_t OFF_SBK = OFF_SBQ + (size_t)M * 1024 * 2;
constexpr size_t OFF_SBVT = OFF_SBK + (size_t)M * 1024 * 2;
constexpr size_t OFF_GA = OFF_SBVT + (size_t)M * 1024 * 2;
constexpr size_t OFF_GB = OFF_GA + (size_t)M * 2048 * 2;
constexpr size_t OFF_Q = OFF_GB + (size_t)M * 2048 * 2;
constexpr size_t OFF_KN = OFF_Q + (size_t)M * 1536 * 2;
constexpr size_t OFF_VT = OFF_KN + (size_t)M * 1024 * 2;
constexpr size_t OFF_ATTA = OFF_VT + (size_t)M * 1024 * 2;
constexpr size_t OFF_ATTB = OFF_ATTA + (size_t)M * 1024 * 2;
constexpr size_t WS_END = OFF_ATTB + (size_t)M * 1024 * 2;
constexpr size_t OFF_MERGED = OFF_SBQ;
constexpr size_t OFF_PQ = OFF_GA;
constexpr size_t OFF_IDX = OFF_GB;
constexpr size_t OFF_GW = OFF_GB + (size_t)M * 128 * 4;
constexpr size_t OFF_U16 = OFF_Q;
constexpr size_t OFF_V16 = OFF_U16 + (size_t)16384 * 2048;
static_assert(OFF_V16 + (size_t)16384 * 2048 <= WS_END, "u/v overlay");
constexpr float U8_SCALE = 68.f, V8_SCALE = 1.5f;
static_assert(WS_END < (size_t)620 * 1000 * 1000, "workspace budget");

struct Params {
    const float *x, *c; const int* pos;
    const float *ada_w, *ada_b, *n1g, *n2g, *w_in, *qng, *kvng, *w_uq, *w_ukv, *w_bm, *w_bs, *w_out, *w_pq, *skeys, *pu, *pv, *fng;
    float* out; unsigned char* ws;
    float invf[32];
    int ph_lo, ph_hi;
};

DI unsigned pk2(float lo, float hi) { bf16v2 p; p[0] = (__bf16)lo; p[1] = (__bf16)hi; return __builtin_bit_cast(unsigned, p); }
DI float bflo(unsigned u) { return __uint_as_float(u << 16); }
DI float bfhi(unsigned u) { return __uint_as_float(u & 0xffff0000u); }
DI float dot2bf(unsigned a, unsigned b, float c) { return __builtin_amdgcn_fdot2_f32_bf16(__builtin_bit_cast(bf16v2, a), __builtin_bit_cast(bf16v2, b), c, false); }
DI float bf2f(bf16_t b) { return __uint_as_float(((unsigned)b) << 16); }
DI float wave_sum(float v) {
#pragma unroll
    for (int o = 1; o < 64; o <<= 1) v += __shfl_xor(v, o);
    return v;
}
DI float wave_max(float v) {
#pragma unroll
    for (int o = 1; o < 64; o <<= 1) v = fmaxf(v, __shfl_xor(v, o));
    return v;
}
DI float sigmoidf_(float v) { return 1.f / (1.f + __expf(-v)); }
DI float gelu_tanh(float v) { const float u = 0.7978845608028654f * (v + 0.044715f * v * v * v); const float e = __expf(2.f * u); const float t = 1.f - 2.f / (e + 1.f); return 0.5f * v * (1.f + t); }
#ifndef P2_FP8
#define P2_FP8 1
#endif
constexpr float W8_SCALE = 64.f;
#ifndef P67_FP8
#define P67_FP8 1
#endif
constexpr float ACT8_SCALE = 16.f;
#ifndef GATE_FP8
#define GATE_FP8 1
#endif
#ifndef GATEA_FP8
#define GATEA_FP8 1
#endif
constexpr float GATE8_SCALE = 256.f;
#ifndef X1_BF16
#define X1_BF16 1
#endif
DI unsigned pk4f8(float a, float b, float c, float d) { int w = __builtin_amdgcn_cvt_pk_fp8_f32(a, b, 0, false); w = __builtin_amdgcn_cvt_pk_fp8_f32(c, d, w, true); return (unsigned)w; }
DI void store_bf16x4(bf16_t* p, f32x4 v) { u32x2 w; w.x = pk2(v[0], v[1]); w.y = pk2(v[2], v[3]); *(u32x2*)p = w; }
DI void store_bf16x8(bf16_t* p, f32x4 a, f32x4 b) { u32x4 w; w.x = pk2(a[0], a[1]); w.y = pk2(a[2], a[3]); w.z = pk2(b[0], b[1]); w.w = pk2(b[2], b[3]); *(u32x4*)p = w; }
DI void load_bf16x8(const bf16_t* p, f32x4& a, f32x4& b) { const u32x4 w = *(const u32x4*)p; a = (f32x4){bflo(w.x), bfhi(w.x), bflo(w.y), bfhi(w.y)}; b = (f32x4){bflo(w.z), bfhi(w.z), bflo(w.w), bfhi(w.w)}; }
DI f32x4 sig4(f32x4 v) { return (f32x4){sigmoidf_(v[0]), sigmoidf_(v[1]), sigmoidf_(v[2]), sigmoidf_(v[3])}; }
DI f32x4 rope4(f32x4 v, f32x2 c0, f32x2 c1) { return (f32x4){v[0] * c0.x - v[1] * c0.y, v[1] * c0.x + v[0] * c0.y, v[2] * c1.x - v[3] * c1.y, v[3] * c1.x + v[2] * c1.y}; }
DI f32x4 load_bf16x4(const bf16_t* p) { const u32x2 w = *(const u32x2*)p; return (f32x4){bflo(w.x), bfhi(w.x), bflo(w.y), bfhi(w.y)}; }

struct Ctx {
    LAS unsigned char* lds;
    int tid, lane, wave, gw, ngw;
};

struct MapWin { DI int operator()(int n) const {
    if (n < 768) return n;
    if (n < 1024) { const int j = n - 768; if (j >= 64) return -1; return 768 + (j >> 1) + 32 * (j & 1); }
    if (n < 2048) return 832 + (n - 1024);
    if (n < 3072) return 1856 + (n - 2048);
    if (n < 5120) return 3904 + (n - 3072);
    return 5952 + (n - 5120); } };
struct MapOff { int off; DI int operator()(int n) const { return n + off; } };
struct MapUq { DI int operator()(int n) const { const int hd = n / 192, j = n % 192; if (j < 128) return hd * 192 + j; const int jj = j - 128; return hd * 192 + 128 + (jj >> 1) + 32 * (jj & 1); } };
struct MapUk { DI int operator()(int n) const { return (n >> 7) * 256 + (n & 127); } };
struct MapUv { DI int operator()(int n) const { return (n >> 7) * 256 + 128 + (n & 127); } };

template <bool F8 = false, class Map>
DI void transpose_item(const float* W, int K, int N, const Map& mp, const float* rowscale, bf16_t* dst, int kb, int nb, LAS float* scr, int lane) {
    const int k0 = kb * 64, sc = mp(nb * 64 + lane);
#pragma unroll 8
    for (int kk = 0; kk < 64; ++kk) {
        float v = 0.f;
        if (sc >= 0) v = W[(size_t)(k0 + kk) * N + sc];
        if (rowscale) v *= rowscale[k0 + kk];
        scr[kk * 65 + lane] = v;
    }
    asm volatile("s_waitcnt lgkmcnt(0)" ::: "memory");
    const int kc = lane & 7;
#pragma unroll
    for (int j = 0; j < 8; ++j) {
        const int nrow = (lane >> 3) + 8 * j; const LAS float* s = scr + (8 * kc) * 65 + nrow;
        if constexpr (F8) { u32x2 o; o.x = pk4f8(s[0] * W8_SCALE, s[65] * W8_SCALE, s[2 * 65] * W8_SCALE, s[3 * 65] * W8_SCALE); o.y = pk4f8(s[4 * 65] * W8_SCALE, s[5 * 65] * W8_SCALE, s[6 * 65] * W8_SCALE, s[7 * 65] * W8_SCALE);
            *(u32x2*)((unsigned char*)dst + (size_t)(nb * 64 + nrow) * K + k0 + 8 * kc) = o; }
        else {
        u32x4 o; o.x = pk2(s[0], s[65]); o.y = pk2(s[2 * 65], s[3 * 65]); o.z = pk2(s[4 * 65], s[5 * 65]); o.w = pk2(s[6 * 65], s[7 * 65]);
        *(u32x4*)(dst + (size_t)(nb * 64 + nrow) * K + k0 + 8 * kc) = o; }
    }
    asm volatile("s_waitcnt lgkmcnt(0)" ::: "memory");
}

DI void phase_prologue(const Params& p, const Ctx& c, bool do_ada = true, bool do_rest = true) {
    unsigned char* ws = p.ws;
    LAS float* scr = (LAS float*)(c.lds + c.wave * 16640);
    unsigned long long* modi = (unsigned long long*)(ws + OFF_MODI);
    if (do_ada) for (int u = c.gw; u < 32 * 48; u += c.ngw) {
        const int kp = u / 48, ch = u % 48, k0 = kp * 64, c0 = ch * 256 + c.lane * 4;
        float sl[4];
#pragma unroll
        for (int b = 0; b < 4; ++b) { const float cv = p.c[b * D + k0 + c.lane]; sl[b] = cv / (1.f + __expf(-cv)); }
        f32x4 acc[4];
#pragma unroll
        for (int b = 0; b < 4; ++b) acc[b] = (f32x4){0.f, 0.f, 0.f, 0.f};
#pragma unroll 16
        for (int kk = 0; kk < 64; ++kk) {
            const f32x4 w = *(const f32x4*)(p.ada_w + (size_t)(k0 + kk) * (6 * D) + c0);
#pragma unroll
            for (int b = 0; b < 4; ++b) { const float s = __shfl(sl[b], kk); acc[b] += w * s; }
        }
        if (kp == 0) { const f32x4 bv = *(const f32x4*)(p.ada_b + c0);
#pragma unroll
            for (int b = 0; b < 4; ++b) acc[b] += bv; }
#pragma unroll
        for (int b = 0; b < 4; ++b)
#pragma unroll
            for (int e = 0; e < 4; ++e) atomicAdd(modi + b * 6 * D + c0 + e, (unsigned long long)(long long)__builtin_rint((double)acc[b][e] * 4294967296.0));
    }
    if (!do_rest) return;
    constexpr int I_WIN = 112 * 32, I_SBV = 16 * 32, I_UQ = 24 * 8, I_UK = 16 * 4, I_UV = 16 * 4, I_A = 32 * 16, I_B = 32 * 16, I_OUT = 32 * 32, I_PQ = 32 * 32;
    constexpr int NIT = I_WIN + I_SBV + I_UQ + I_UK + I_UV + I_A + I_B + I_OUT + I_PQ;
    for (int it = c.gw; it < NIT; it += c.ngw) {
        int r = it;
        if (r < I_WIN) { transpose_item<P2_FP8 != 0>(p.w_in, 2048, 8000, MapWin{}, nullptr, (bf16_t*)(ws + OFF_WIN), r % 32, r / 32, scr, c.lane); continue; } r -= I_WIN;
        if (r < I_SBV) { transpose_item<P2_FP8 != 0>(p.w_in, 2048, 8000, MapOff{2880}, nullptr, (bf16_t*)(ws + OFF_WSBV), r % 32, r / 32, scr, c.lane); continue; } r -= I_SBV;
        if (r < I_UQ) { transpose_item(p.w_uq, 512, 1536, MapUq{}, p.qng, (bf16_t*)(ws + OFF_WUQ), r % 8, r / 8, scr, c.lane); continue; } r -= I_UQ;
        if (r < I_UK) { transpose_item(p.w_ukv, 256, 2048, MapUk{}, p.kvng, (bf16_t*)(ws + OFF_WUK), r % 4, r / 4, scr, c.lane); continue; } r -= I_UK;
        if (r < I_UV) { transpose_item(p.w_ukv, 256, 2048, MapUv{}, p.kvng, (bf16_t*)(ws + OFF_WUV), r % 4, r / 4, scr, c.lane); continue; } r -= I_UV;
        if (r < I_A) { transpose_item<P67_FP8 != 0>(p.w_bm, 1024, 2048, MapOff{0}, nullptr, (bf16_t*)(ws + OFF_WA), r % 16, r / 16, scr, c.lane); continue; } r -= I_A;
        if (r < I_B) { transpose_item<P67_FP8 != 0>(p.w_bs, 1024, 2048, MapOff{0}, nullptr, (bf16_t*)(ws + OFF_WB), r % 16, r / 16, scr, c.lane); continue; } r -= I_B;
        if (r < I_OUT) { transpose_item<P67_FP8 != 0>(p.w_out, 2048, 2048, MapOff{0}, nullptr, (bf16_t*)(ws + OFF_WOUT), r % 32, r / 32, scr, c.lane); continue; } r -= I_OUT;
        transpose_item(p.w_pq, 2048, 2048, MapOff{0}, nullptr, (bf16_t*)(ws + OFF_WPQ), r % 32, r / 32, scr, c.lane);
    }
    { bf16_t* kd = (bf16_t*)(ws + OFF_KEYS);
      for (int i = (c.gw * 64 + c.lane) * 4; i < 8 * 2 * 128 * 128; i += c.ngw * 64 * 4) store_bf16x4(kd + i, *(const f32x4*)(p.skeys + i)); }
    { f32x2* cs = (f32x2*)(ws + OFF_CS);
      for (int i = c.gw * 64 + c.lane; i < M * 32; i += c.ngw * 64) {
          const int m = i >> 5, f = i & 31;
          const float ang = (float)p.pos[m] * p.invf[f];
          const double rev = (double)ang * 0.15915494309189533576888;
          const float fr = (float)(rev - __builtin_rint(rev));
          cs[i] = (f32x2){__builtin_amdgcn_cosf(fr), __builtin_amdgcn_sinf(fr)};
      } }
}

DI f32x4 ld_mod4(const float* p) { return *(const f32x4*)p; }
DI f32x4 ld_mod4(const long long* p) { f32x4 r;
#pragma unroll
    for (int e = 0; e < 4; ++e) r[e] = (float)((double)p[e] * (1.0 / 4294967296.0));
    return r; }
template <bool F8 = false, bool SRC16 = false, class MT>
DI void modulate_rows(const float* src, const float* g, const MT* sc, const MT* sh, bf16_t* dst, const Ctx& c) {
    for (int m = c.gw; m < M; m += c.ngw) {
        const int b = m / SEQ;
        const float* xr = src + (size_t)m * D;
        f32x4 v[8]; float ss = 0.f;
#pragma unroll
        for (int j = 0; j < 8; ++j) { if constexpr (SRC16) v[j] = load_bf16x4((const bf16_t*)src + (size_t)m * D + (j * 64 + c.lane) * 4); else v[j] = *(const f32x4*)(xr + (j * 64 + c.lane) * 4); ss += v[j][0] * v[j][0] + v[j][1] * v[j][1] + v[j][2] * v[j][2] + v[j][3] * v[j][3]; }
        const float rstd = rsqrtf(wave_sum(ss) * (1.f / D) + EPS);
#pragma unroll
        for (int j = 0; j < 8; ++j) {
            const int col = (j * 64 + c.lane) * 4;
            const f32x4 gg = *(const f32x4*)(g + col), s1 = ld_mod4(sc + b * 6 * D + col), h1 = ld_mod4(sh + b * 6 * D + col);
            const f32x4 o = v[j] * rstd * gg * (s1 + 1.f) + h1;
            if constexpr (F8) *(unsigned*)((unsigned char*)dst + (size_t)m * D + col) = pk4f8(o[0], o[1], o[2], o[3]);
            else store_bf16x4(dst + (size_t)m * D + col, o);
        }
    }
}
DI void phase_rowstats(const Params& p, const Ctx& c) {
    const bf16_t* cq = (const bf16_t*)(p.ws + OFF_CQ); const bf16_t* ckv = (const bf16_t*)(p.ws + OFF_CKV);
    float* rq = (float*)(p.ws + OFF_RSTQ); float* rkv = (float*)(p.ws + OFF_RSTKV);
    for (int m = c.gw; m < M; m += c.ngw) {
        const u32x4 a = *(const u32x4*)(cq + (size_t)m * 512 + c.lane * 8);
        const u32x2 b = *(const u32x2*)(ckv + (size_t)m * 256 + c.lane * 4);
        float s1 = 0.f, s2 = 0.f;
#pragma unroll
        for (int e = 0; e < 4; ++e) { const float lo = bflo(a[e]), hi = bfhi(a[e]); s1 += lo * lo + hi * hi; }
#pragma unroll
        for (int e = 0; e < 2; ++e) { const float lo = bflo(b[e]), hi = bfhi(b[e]); s2 += lo * lo + hi * hi; }
        s1 = wave_sum(s1); s2 = wave_sum(s2);
        if (c.lane == 0) { rq[m] = rsqrtf(s1 * (1.f / 512.f) + EPS); rkv[m] = rsqrtf(s2 * (1.f / 256.f) + EPS); }
    }
}
typedef float f32x16v __attribute__((ext_vector_type(16)));
typedef float f32x32v __attribute__((ext_vector_type(32)));
typedef unsigned u32x6 __attribute__((ext_vector_type(6)));
#ifndef FP6_ORDER
#define FP6_ORDER 1
#endif
DI void convert_table(const float* src, unsigned char* dst, float scale, const Ctx& c) {
    const size_t ngroups = (size_t)16384 * 64;
    for (size_t gi = (size_t)c.gw * 64 + c.lane; gi < ngroups; gi += (size_t)c.ngw * 64) {
        const size_t row = gi >> 6; const int l = (int)(gi & 63);
        const float* sp = src + row * 2048 + l * 32;
        f32x4 v[8];
#pragma unroll
        for (int i = 0; i < 8; ++i) v[i] = *(const f32x4*)(sp + 4 * i) * scale;
        f32x16v a, b;
#pragma unroll
        for (int e = 0; e < 16; ++e) {
#if FP6_ORDER == 0
            a[e] = v[e >> 2][e & 3]; b[e] = v[4 + (e >> 2)][e & 3];
#else
            a[e] = v[(2 * e) >> 2][(2 * e) & 3]; b[e] = v[(2 * e + 1) >> 2][(2 * e + 1) & 3];
#endif
        }
        const u32x6 pk = __builtin_amdgcn_cvt_scalef32_2xpk16_fp6_f32(a, b, 1.0f);
        unsigned char* dp = dst + row * 1536;
        *(u32x4*)(dp + 16 * l) = (u32x4){pk[0], pk[1], pk[2], pk[3]};
        *(u32x2*)(dp + 1024 + 8 * l) = (u32x2){pk[4], pk[5]};
    }
}

struct EpiProj {
    bf16_t *cq, *ckv, *kr, *sbq, *sbk, *ga, *gb; const f32x2* cs; float osc;
    DI void operator()(int row, int col, f32x4 v) const {
        const int tile = col >> 8; v = v * osc;
        if (tile < 2) { store_bf16x4(cq + (size_t)row * 512 + col, v); }
        else if (tile == 2) { store_bf16x4(ckv + (size_t)row * 256 + (col - 512), v); }
        else if (tile == 3) { const int j = col - 768; if (j < 64) { const f32x2 c0 = cs[row * 32 + (j >> 1)], c1 = cs[row * 32 + (j >> 1) + 1];
            const f32x4 o = {v[0] * c0.x - v[1] * c0.y, v[1] * c0.x + v[0] * c0.y, v[2] * c1.x - v[3] * c1.y, v[3] * c1.x + v[2] * c1.y};
            store_bf16x4(kr + (size_t)row * 64 + j, o); } }
        else if (tile < 8) { store_bf16x4(sbq + (size_t)row * 1024 + (col - 1024), v * (0.08838834764831845f * LOG2E)); }
        else if (tile < 12) { store_bf16x4(sbk + (size_t)row * 1024 + (col - 2048), v); }
        else if (tile < 20) { store_bf16x4(ga + (size_t)row * 2048 + (col - 3072), (f32x4){sigmoidf_(v[0]), sigmoidf_(v[1]), sigmoidf_(v[2]), sigmoidf_(v[3])}); }
        else { store_bf16x4(gb + (size_t)row * 2048 + (col - 5120), (f32x4){sigmoidf_(v[0]), sigmoidf_(v[1]), sigmoidf_(v[2]), sigmoidf_(v[3])}); }
    }    DI void operator()(int row, int col, f32x4 v0, f32x4 v1) const {
        const int tile = col >> 8; v0 = v0 * osc; v1 = v1 * osc;
        if (tile < 2) { store_bf16x8(cq + (size_t)row * 512 + col, v0, v1); }
        else if (tile == 2) { store_bf16x8(ckv + (size_t)row * 256 + (col - 512), v0, v1); }
        else if (tile == 3) { const int j = col - 768; if (j < 64) { const f32x2* cp = cs + row * 32 + (j >> 1);
            store_bf16x8(kr + (size_t)row * 64 + j, rope4(v0, cp[0], cp[1]), rope4(v1, cp[2], cp[3])); } }
        else if (tile < 8) { const float sc = 0.08838834764831845f * LOG2E; store_bf16x8(sbq + (size_t)row * 1024 + (col - 1024), v0 * sc, v1 * sc); }
        else if (tile < 12) { store_bf16x8(sbk + (size_t)row * 1024 + (col - 2048), v0, v1); }
#if GATE_FP8
        else if (!GATEA_FP8 && tile < 20) { store_bf16x8(ga + (size_t)row * 2048 + (col - 3072), sig4(v0), sig4(v1)); }
        else { const f32x4 s0 = sig4(v0) * GATE8_SCALE, s1 = sig4(v1) * GATE8_SCALE; unsigned char* gp = tile < 20 ? (unsigned char*)ga + (size_t)row * 2048 + (col - 3072) : (unsigned char*)gb + (size_t)row * 2048 + (col - 5120);
            *(u32x2*)gp = (u32x2){pk4f8(s0[0], s0[1], s0[2], s0[3]), pk4f8(s1[0], s1[1], s1[2], s1[3])}; }
#else
        else if (tile < 20) { store_bf16x8(ga + (size_t)row * 2048 + (col - 3072), sig4(v0), sig4(v1)); }
        else { store_bf16x8(gb + (size_t)row * 2048 + (col - 5120), sig4(v0), sig4(v1)); }
#endif
    }
};
struct EpiT { bf16_t* o; const float* cscale; float osc;
    static constexpr int MB = 2; struct Pre { f32x4 a, b; };
    DI Pre load(int row, int col) const { Pre q; q.a = q.b = (f32x4){osc, osc, osc, osc}; if (cscale) { q.a = *(const f32x4*)(cscale + col) * osc; q.b = *(const f32x4*)(cscale + col + 4) * osc; } return q; }
    DI void apply(int row, int col, f32x4 v0, f32x4 v1, const Pre& q) const { store_bf16x8(o + (size_t)row * M + col, v0 * q.a, v1 * q.b); }
    DI void operator()(int row, int col, f32x4 v) const { if (cscale) v = v * *(const f32x4*)(cscale + col); store_bf16x4(o + (size_t)row * M + col, v); }
    DI void operator()(int row, int col, f32x4 v0, f32x4 v1) const { if (cscale) { v0 = v0 * *(const f32x4*)(cscale + col); v1 = v1 * *(const f32x4*)(cscale + col + 4); } store_bf16x8(o + (size_t)row * M + col, v0, v1); } };
struct EpiUq { bf16_t* q; const float* rst; const f32x2* cs;
    static constexpr int MB = 2; struct Pre { float sc; f32x2 c0, c1, c2, c3; };
    DI Pre load(int row, int col) const { Pre w; w.sc = rst[row]; w.c0 = w.c1 = w.c2 = w.c3 = (f32x2){0.f, 0.f}; const int j = col % 192;
        if (j >= 128) { const f32x2* cp = cs + row * 32 + ((j - 128) >> 1); w.c0 = cp[0]; w.c1 = cp[1]; w.c2 = cp[2]; w.c3 = cp[3]; } return w; }
    DI void apply(int row, int col, f32x4 v0, f32x4 v1, const Pre& w) const {
        const float sc = w.sc * (0.07216878364870322f * LOG2E); v0 = v0 * sc; v1 = v1 * sc;
        if (col % 192 >= 128) { v0 = rope4(v0, w.c0, w.c1); v1 = rope4(v1, w.c2, w.c3); }
        store_bf16x8(q + (size_t)row * 1536 + col, v0, v1); }
    DI void operator()(int row, int col, f32x4 v) const {
        v = v * (rst[row] * (0.07216878364870322f * LOG2E));
        const int j = col % 192;
        if (j >= 128) { const int i0 = (j - 128) >> 1; const f32x2 c0 = cs[row * 32 + i0], c1 = cs[row * 32 + i0 + 1];
            v = (f32x4){v[0] * c0.x - v[1] * c0.y, v[1] * c0.x + v[0] * c0.y, v[2] * c1.x - v[3] * c1.y, v[3] * c1.x + v[2] * c1.y}; }
        store_bf16x4(q + (size_t)row * 1536 + col, v);
    }
    DI void operator()(int row, int col, f32x4 v0, f32x4 v1) const {
        const float sc = rst[row] * (0.07216878364870322f * LOG2E); v0 = v0 * sc; v1 = v1 * sc;
        const int j = col % 192;
        if (j >= 128) { const f32x2* cp = cs + row * 32 + ((j - 128) >> 1); v0 = rope4(v0, cp[0], cp[1]); v1 = rope4(v1, cp[2], cp[3]); }
        store_bf16x8(q + (size_t)row * 1536 + col, v0, v1);
    } };
struct EpiRowScale { bf16_t* o; int ld; const float* rst;
    static constexpr int MB = 4; typedef float Pre;
    DI Pre load(int row, int col) const { return rst[row]; }
    DI void apply(int row, int col, f32x4 v0, f32x4 v1, const Pre& sc) const { store_bf16x8(o + (size_t)row * ld + col, v0 * sc, v1 * sc); }
    DI void operator()(int row, int col, f32x4 v) const { store_bf16x4(o + (size_t)row * ld + col, v * rst[row]); }
    DI void operator()(int row, int col, f32x4 v0, f32x4 v1) const { const float sc = rst[row]; store_bf16x8(o + (size_t)row * ld + col, v0 * sc, v1 * sc); } };
struct EpiGate1 { bf16_t* mg; const bf16_t* g; float osc;
#if GATEA_FP8
    static constexpr int MB = 4; typedef u32x2 Pre;
    DI Pre load(int row, int col) const { return *(const u32x2*)((const unsigned char*)g + (size_t)row * 2048 + col); }
#else
    static constexpr int MB = 2; typedef u32x4 Pre;
    DI Pre load(int row, int col) const { return *(const u32x4*)(g + (size_t)row * 2048 + col); }
#endif
    DI void apply(int row, int col, f32x4 v0, f32x4 v1, const Pre& w) const { const size_t i = (size_t)row * 2048 + col;
#if GATEA_FP8
        const f32x4 g0 = {__builtin_amdgcn_cvt_f32_fp8((int)w.x, 0), __builtin_amdgcn_cvt_f32_fp8((int)w.x, 1), __builtin_amdgcn_cvt_f32_fp8((int)w.x, 2), __builtin_amdgcn_cvt_f32_fp8((int)w.x, 3)};
        const f32x4 g1 = {__builtin_amdgcn_cvt_f32_fp8((int)w.y, 0), __builtin_amdgcn_cvt_f32_fp8((int)w.y, 1), __builtin_amdgcn_cvt_f32_fp8((int)w.y, 2), __builtin_amdgcn_cvt_f32_fp8((int)w.y, 3)};
        const float os = osc * (1.f / GATE8_SCALE);
#else
        const f32x4 g0 = {bflo(w.x), bfhi(w.x), bflo(w.y), bfhi(w.y)}, g1 = {bflo(w.z), bfhi(w.z), bflo(w.w), bfhi(w.w)}; const float os = osc;
#endif
        store_bf16x8(mg + i, v0 * os * g0, v1 * os * g1); }
    DI void operator()(int row, int col, f32x4 v) const { const size_t i = (size_t)row * 2048 + col; store_bf16x4(mg + i, v * load_bf16x4(g + i)); }
    DI void operator()(int row, int col, f32x4 v0, f32x4 v1) const { const size_t i = (size_t)row * 2048 + col; f32x4 g0, g1; load_bf16x8(g + i, g0, g1); store_bf16x8(mg + i, v0 * g0, v1 * g1); } };
struct EpiGate2 { bf16_t* mg; const bf16_t* g; unsigned char* m8; float osc;
    static constexpr int MB = 2;
#if GATE_FP8
    struct Pre { u32x4 m; u32x2 g; };
#else
    struct Pre { u32x4 g, m; };
#endif
#if GATE_FP8
    DI Pre load(int row, int col) const { const size_t i = (size_t)row * 2048 + col; Pre q; q.g = *(const u32x2*)((const unsigned char*)g + i); q.m = *(const u32x4*)(mg + i); return q; }
#else
    DI Pre load(int row, int col) const { const size_t i = (size_t)row * 2048 + col; Pre q; q.g = *(const u32x4*)(g + i); q.m = *(const u32x4*)(mg + i); return q; }
#endif
    DI void apply(int row, int col, f32x4 v0, f32x4 v1, const Pre& q) const { const size_t i = (size_t)row * 2048 + col;
#if GATE_FP8
        const f32x4 g0 = {__builtin_amdgcn_cvt_f32_fp8((int)q.g.x, 0), __builtin_amdgcn_cvt_f32_fp8((int)q.g.x, 1), __builtin_amdgcn_cvt_f32_fp8((int)q.g.x, 2), __builtin_amdgcn_cvt_f32_fp8((int)q.g.x, 3)};
        const f32x4 g1 = {__builtin_amdgcn_cvt_f32_fp8((int)q.g.y, 0), __builtin_amdgcn_cvt_f32_fp8((int)q.g.y, 1), __builtin_amdgcn_cvt_f32_fp8((int)q.g.y, 2), __builtin_amdgcn_cvt_f32_fp8((int)q.g.y, 3)};
        const float osc = this->osc * (1.f / GATE8_SCALE);
#else
        const f32x4 g0 = {bflo(q.g.x), bfhi(q.g.x), bflo(q.g.y), bfhi(q.g.y)}, g1 = {bflo(q.g.z), bfhi(q.g.z), bflo(q.g.w), bfhi(q.g.w)};
#endif
        const f32x4 m0 = {bflo(q.m.x), bfhi(q.m.x), bflo(q.m.y), bfhi(q.m.y)}, m1 = {bflo(q.m.z), bfhi(q.m.z), bflo(q.m.w), bfhi(q.m.w)};
        const f32x4 r0 = m0 + v0 * osc * g0, r1 = m1 + v1 * osc * g1;
        if (P67_FP8) *(u32x2*)(m8 + i) = (u32x2){pk4f8(r0[0] * ACT8_SCALE, r0[1] * ACT8_SCALE, r0[2] * ACT8_SCALE, r0[3] * ACT8_SCALE), pk4f8(r1[0] * ACT8_SCALE, r1[1] * ACT8_SCALE, r1[2] * ACT8_SCALE, r1[3] * ACT8_SCALE)};
        else store_bf16x8(mg + i, r0, r1); }
    DI void operator()(int row, int col, f32x4 v) const { const size_t i = (size_t)row * 2048 + col; store_bf16x4(mg + i, load_bf16x4(mg + i) + v * load_bf16x4(g + i)); }
    DI void operator()(int row, int col, f32x4 v0, f32x4 v1) const { const size_t i = (size_t)row * 2048 + col; f32x4 g0, g1, m0, m1; load_bf16x8(g + i, g0, g1); load_bf16x8(mg + i, m0, m1); store_bf16x8(mg + i, m0 + v0 * g0, m1 + v1 * g1); } };
struct EpiRes { const float* x; const float* gt; float* x1; float osc;
    static constexpr int MB = 4; struct Pre { f32x4 a, b; };
    DI Pre load(int row, int col) const { const size_t i = (size_t)row * 2048 + col; Pre q; q.a = *(const f32x4*)(x + i); q.b = *(const f32x4*)(x + i + 4); return q; }
    DI void apply(int row, int col, f32x4 v0, f32x4 v1, const Pre& q) const { const size_t i = (size_t)row * 2048 + col; const int b = row / SEQ; const float* gp = gt + b * 6 * D + col;
        const f32x4 r0 = q.a + *(const f32x4*)gp * v0 * (osc * DBG_ALPHA), r1 = q.b + *(const f32x4*)(gp + 4) * v1 * (osc * DBG_ALPHA);
        if (X1_BF16) store_bf16x8((bf16_t*)x1 + i, r0, r1); else { *(f32x4*)(x1 + i) = r0; *(f32x4*)(x1 + i + 4) = r1; } }
    DI void operator()(int row, int col, f32x4 v) const { const size_t i = (size_t)row * 2048 + col; const int b = row / SEQ;
        *(f32x4*)(x1 + i) = *(const f32x4*)(x + i) + *(const f32x4*)(gt + b * 6 * D + col) * v * DBG_ALPHA; }
    DI void operator()(int row, int col, f32x4 v0, f32x4 v1) const { (*this)(row, col, v0); (*this)(row, col + 4, v1); } };
struct EpiPq { bf16_t* pq;
    DI void operator()(int row, int col, f32x4 v) const { store_bf16x4(pq + (size_t)(col >> 8) * M * 256 + (size_t)row * 256 + (col & 255), v); }
    DI void operator()(int row, int col, f32x4 v0, f32x4 v1) const { store_bf16x8(pq + (size_t)(col >> 8) * M * 256 + (size_t)row * 256 + (col & 255), v0, v1); } };

template <class Epi>
DI void gemm_naive(const Ctx& c, const bf16_t* A, const bf16_t* Bt, int Mg, int Ng, int Kg, const Epi& E) {
    LAS float* As = (LAS float*)c.lds; LAS float* Bs = As + 16 * 132;
    const int tid = c.tid, ty = tid >> 5, tx = tid & 31;
    const int tilesN = Ng / 128, ntiles = (Mg / 128) * tilesN;
    for (int t = blockIdx.x; t < ntiles; t += gridDim.x) {
        const int tm = t / tilesN, tn = t % tilesN;
        float acc[8][4];
#pragma unroll
        for (int i = 0; i < 8; ++i)
#pragma unroll
            for (int j = 0; j < 4; ++j) acc[i][j] = 0.f;
        for (int k0 = 0; k0 < Kg; k0 += 16) {
            { const int lt = tid & 255, r = lt >> 1, kc = lt & 1;
              const bf16_t* src = (tid < 256 ? A + (size_t)(tm * 128 + r) * Kg : Bt + (size_t)(tn * 128 + r) * Kg) + k0 + kc * 8;
              const u32x4 v = *(const u32x4*)src;
              LAS float* dst = (tid < 256 ? As : Bs) + (kc * 8) * 132 + r;
              dst[0] = bflo(v.x); dst[132] = bfhi(v.x); dst[2 * 132] = bflo(v.y); dst[3 * 132] = bfhi(v.y);
              dst[4 * 132] = bflo(v.z); dst[5 * 132] = bfhi(v.z); dst[6 * 132] = bflo(v.w); dst[7 * 132] = bfhi(v.w); }
            __syncthreads();
#pragma unroll
            for (int kk = 0; kk < 16; ++kk) {
                const f32x4 a0 = *(const LAS f32x4*)(As + kk * 132 + ty * 8), a1 = *(const LAS f32x4*)(As + kk * 132 + ty * 8 + 4);
                const f32x4 b = *(const LAS f32x4*)(Bs + kk * 132 + tx * 4);
#pragma unroll
                for (int j = 0; j < 4; ++j) {
                    acc[0][j] += a0[0] * b[j]; acc[1][j] += a0[1] * b[j]; acc[2][j] += a0[2] * b[j]; acc[3][j] += a0[3] * b[j];
                    acc[4][j] += a1[0] * b[j]; acc[5][j] += a1[1] * b[j]; acc[6][j] += a1[2] * b[j]; acc[7][j] += a1[3] * b[j];
                }
            }
            __syncthreads();
        }
#pragma unroll
        for (int i = 0; i < 8; ++i) E(tm * 128 + ty * 8 + i, tn * 128 + tx * 4, (f32x4){acc[i][0], acc[i][1], acc[i][2], acc[i][3]});
    }
}

namespace pg8 {
#define PG8_LAS __attribute__((address_space(3)))
typedef unsigned short bf16_t;
typedef short bf16x8 __attribute__((ext_vector_type(8)));
typedef float f32x4 __attribute__((ext_vector_type(4)));
typedef unsigned u32x4 __attribute__((ext_vector_type(4)));
constexpr int BM = 256, BK = 64, HALF = 128, HTB = HALF * BK * 2  , STAGE_BYTES = 8 * HTB, NXCD = 8, WGM = 4;

__host__ __device__ __forceinline__ int lds_byte(int r, int c) { const int st = (r >> 4) * 2 + (c >> 5), rr = r & 15, cc = c & 31, ob = rr * 64 + cc * 2; return st * 1024 + (ob ^ (((ob >> 9) & 1) << 5)); }
__host__ __device__ __forceinline__ void stage_rc(int b, int& R, int& C) { const int st = b / 1024, sb = b % 1024, swz = sb ^ (((sb >> 9) & 1) << 5); R = (st >> 1) * 16 + swz / 64; C = (st & 1) * 32 + (swz % 64) / 2; }
__host__ __device__ __forceinline__ int perm32(int rho) { const int n = rho >> 4, i = rho & 15; return 8 * (i >> 2) + 4 * n + (i & 3); }

struct Unit { int pm, pn; };
struct Gemm { const bf16_t* A; const bf16_t* Bt; int M, N, K; int tid; const unsigned char* base; };
struct StaticOrder {
    int nM, nN, nwg, G, c;
    __host__ __device__ void init(int M, int N, int G_, int c_) { nM = M / BM; nN = N / BM; nwg = nM * nN; G = G_; c = c_; }
    __host__ __device__ bool next(int i, Unit& u) const {
        const long L = (long)i * G + c; if (L >= nwg) return false;
        int wgid = (int)L; { const int q = nwg / NXCD, r = nwg % NXCD, xcd = wgid % NXCD, off = wgid / NXCD; wgid = (xcd < r ? xcd * (q + 1) : r * (q + 1) + (xcd - r) * q) + off; }
        const int nig = WGM * nN, gid = wgid / nig, fm = gid * WGM, gsz = (nM - fm) < WGM ? (nM - fm) : WGM;
        u.pm = fm + ((wgid % nig) % gsz); u.pn = (wgid % nig) / gsz; return true;
    }
    __device__ __forceinline__ void a_ready(const Unit&) const {}
    __device__ __forceinline__ void done(const Unit&) const {}
};
typedef int i32x8 __attribute__((ext_vector_type(8)));
template <class Epi, class Sched, bool STAMP = false, bool F8 = false>
__device__ __forceinline__ void gemm_phase(PG8_LAS unsigned char* lds, const Gemm g, const Sched& S, const Epi& E, unsigned long long* stamps) {
    const int tid = g.tid, wid = __builtin_amdgcn_readfirstlane(tid >> 6), lane = tid & 63, wr = wid >> 2, wc = wid & 3, fr = lane & 15, fq = lane >> 4;
    const int K = g.K, nt = K / BK;
    int ts_lo = 0, ts_hi = 0, nts = 0; const unsigned long long rt_entry = STAMP ? (unsigned long long)wall_clock64() : 0ull;
#define PG8_STAMP() do { if (STAMP && wid == 0 && nts < 64) { const unsigned long long _c = (unsigned long long)clock64(); \
        ts_lo = (lane == nts) ? (int)(unsigned)_c : ts_lo; ts_hi = (lane == nts) ? (int)(unsigned)(_c >> 32) : ts_hi; ++nts; } } while (0)
    PG8_STAMP();
    unsigned voffA, voffB;
    { int R, C; stage_rc(tid * 16, R, C); const int Rb = Epi::PERM ? ((R & ~31) + perm32(R & 31)) : R;
        voffA = (unsigned)(R * K + C) * 2u; voffB = (unsigned)(Rb * K + C) * 2u; }
    const unsigned qstep = 64u * (unsigned)K * 2u;
    const unsigned kstep = (unsigned)(BK * 2);
    const unsigned hstep = (unsigned)HALF * K * 2;
    const unsigned tstep = 2 * hstep;
    const __amdgpu_buffer_rsrc_t rs = __builtin_amdgcn_make_buffer_rsrc((void*)g.base, (short)0, (int)0x7fffffff, 0x00020000);
    const unsigned oA = (unsigned)((const unsigned char*)g.A - g.base), oB = (unsigned)((const unsigned char*)g.Bt - g.base);
    const unsigned ldsw = (unsigned)wid * 1024u;
    const int aoff = lds_byte(wr * 64 + fr, fq * 8), boff = lds_byte(wc * 32 + fr, fq * 8);
#define PG8_SA(b, h) (((b) * 2 + (h)) * HTB)
#define PG8_SB(b, h) ((4 + (b) * 2 + (h)) * HTB)
#define PG8_STAGE(bufoff, gbase, voff) do { _Pragma("unroll") for (int _i = 0; _i < 2; ++_i) \
        __builtin_amdgcn_raw_ptr_buffer_load_lds(rs, (PG8_LAS void*)(lds + (bufoff) + ldsw + _i * 8192), 16, (voff), (gbase) + _i * qstep, 0, 0); } while (0)
#define PG8_LDA(dst, b, h) do { _Pragma("unroll") for (int m = 0; m < 4; ++m) _Pragma("unroll") for (int k = 0; k < 2; ++k) dst[m][k] = *(const PG8_LAS bf16x8*)(lds + PG8_SA(b, h) + aoff + m * 2048 + k * 1024); } while (0)
#define PG8_LDB(dst, b, h) do { _Pragma("unroll") for (int n = 0; n < 2; ++n) _Pragma("unroll") for (int k = 0; k < 2; ++k) dst[n][k] = *(const PG8_LAS bf16x8*)(lds + PG8_SB(b, h) + boff + n * 2048 + k * 1024); } while (0)
#define PG8_CAT8(x0, x1) __builtin_bit_cast(i32x8, __builtin_shufflevector(x0, x1, 0, 1, 2, 3, 4, 5, 6, 7, 8, 9, 10, 11, 12, 13, 14, 15))
#define PG8_MMA(ai, bj, At, Bt) do { __builtin_amdgcn_s_setprio(1); _Pragma("unroll") for (int m = 0; m < 4; ++m) _Pragma("unroll") for (int n = 0; n < 2; ++n) { \
        if constexpr (F8) acc[ai][bj][m][n] = __builtin_amdgcn_mfma_scale_f32_16x16x128_f8f6f4(PG8_CAT8(Bt[n][0], Bt[n][1]), PG8_CAT8(At[m][0], At[m][1]), acc[ai][bj][m][n], 0, 0, 0, 0, 0, 0); \
        else { _Pragma("unroll") for (int k = 0; k < 2; ++k) acc[ai][bj][m][n] = __builtin_amdgcn_mfma_f32_16x16x32_bf16(Bt[n][k], At[m][k], acc[ai][bj][m][n], 0, 0, 0); } } \
        __builtin_amdgcn_s_setprio(0); } while (0)
#define PG8_WAIT_V(n) asm volatile("s_waitcnt vmcnt(" #n ")" ::: "memory")
#define PG8_WAIT_L(n) asm volatile("s_waitcnt lgkmcnt(" #n ")" ::: "memory")
#define PG8_BAR __builtin_amdgcn_s_barrier()
#define PG8_SCHED __builtin_amdgcn_sched_barrier(0)
    Unit cur, nxt; int ui = 0;
    if (!S.next(0, cur)) return;
    f32x4 acc[2][2][4][2];
#pragma unroll
    for (int a = 0; a < 2; ++a)
#pragma unroll
        for (int b = 0; b < 2; ++b)
#pragma unroll
            for (int m = 0; m < 4; ++m)
#pragma unroll
                for (int n = 0; n < 2; ++n) acc[a][b][m][n] = (f32x4){0.f, 0.f, 0.f, 0.f};
    bf16x8 At[4][2], B0[2][2], B1[2][2];
    unsigned cA = oA + (unsigned)cur.pm * tstep, cB = oB + (unsigned)cur.pn * tstep;
    S.a_ready(cur);
    PG8_STAGE(PG8_SB(0, 0), cB, voffB); PG8_STAGE(PG8_SA(0, 0), cA, voffA); PG8_STAGE(PG8_SB(0, 1), cB + hstep, voffB); PG8_STAGE(PG8_SA(0, 1), cA + hstep, voffA);
    if (wr == 1) PG8_BAR;
    PG8_WAIT_V(4); PG8_BAR;
    PG8_STAGE(PG8_SB(1, 0), cB + kstep, voffB); PG8_STAGE(PG8_SA(1, 0), cA + kstep, voffA); PG8_STAGE(PG8_SB(1, 1), cB + hstep + kstep, voffB);
    PG8_WAIT_V(6); PG8_BAR;
    PG8_STAMP();
    for (;;) {
        const bool has_next = S.next(ui + 1, nxt);
        const unsigned nA = has_next ? oA + (unsigned)nxt.pm * tstep : cA, nB = has_next ? oB + (unsigned)nxt.pn * tstep : cB;
        for (int t = 0; t < nt; t += 2) {
            const bool last = (t == nt - 2);
            const unsigned a1 = cA + (unsigned)(t + 1) * kstep;
            const unsigned a2 = last ? nA : cA + (unsigned)(t + 2) * kstep, b2 = last ? nB : cB + (unsigned)(t + 2) * kstep;
            const unsigned a3 = a2 + kstep, b3 = b2 + kstep;
            if (last && has_next) S.a_ready(nxt);
            PG8_LDB(B0, 0, 0); PG8_SCHED; PG8_LDA(At, 0, 0); PG8_STAGE(PG8_SA(1, 1), a1 + hstep, voffA);
            PG8_WAIT_L(8); PG8_BAR; PG8_WAIT_L(0); PG8_MMA(0, 0, At, B0); PG8_BAR; PG8_SCHED;
            PG8_LDB(B1, 0, 1); PG8_STAGE(PG8_SB(0, 0), b2, voffB);
            PG8_BAR; PG8_WAIT_L(0); PG8_MMA(0, 1, At, B1); PG8_BAR;
            PG8_LDA(At, 0, 1); PG8_STAGE(PG8_SA(0, 0), a2, voffA);
            PG8_BAR; PG8_WAIT_L(0); PG8_MMA(1, 0, At, B0); PG8_BAR; PG8_SCHED;
            PG8_STAGE(PG8_SB(0, 1), b2 + hstep, voffB);
            PG8_WAIT_V(6); PG8_BAR; PG8_MMA(1, 1, At, B1); PG8_BAR;
            PG8_LDB(B0, 1, 0); PG8_SCHED; PG8_LDA(At, 1, 0); PG8_STAGE(PG8_SA(0, 1), a2 + hstep, voffA);
            PG8_WAIT_L(8); PG8_BAR; PG8_WAIT_L(0); PG8_MMA(0, 0, At, B0); PG8_BAR; PG8_SCHED;
            PG8_LDB(B1, 1, 1); PG8_STAGE(PG8_SB(1, 0), b3, voffB);
            PG8_BAR; PG8_WAIT_L(0); PG8_MMA(0, 1, At, B1); PG8_BAR;
            PG8_LDA(At, 1, 1); PG8_STAGE(PG8_SA(1, 0), a3, voffA);
            PG8_BAR; PG8_WAIT_L(0); PG8_MMA(1, 0, At, B0); PG8_BAR; PG8_SCHED;
            PG8_STAGE(PG8_SB(1, 1), b3 + hstep, voffB);
            PG8_WAIT_V(6); PG8_BAR; PG8_MMA(1, 1, At, B1); PG8_BAR;
        }
        PG8_STAMP();
        if constexpr (!Epi::AFTER_DRAIN) { int l2_; asm volatile("v_mbcnt_lo_u32_b32 %0, -1, 0\n\tv_mbcnt_hi_u32_b32 %0, -1, %0" : "=v"(l2_));
            E(acc, cur, wr, wc, l2_ & 15, l2_ >> 4); S.done(cur); }
        PG8_STAMP();
        if (!has_next) break;
#pragma unroll
        for (int a = 0; a < 2; ++a)
#pragma unroll
            for (int b = 0; b < 2; ++b)
#pragma unroll
                for (int m = 0; m < 4; ++m)
#pragma unroll
                    for (int n = 0; n < 2; ++n) acc[a][b][m][n] = (f32x4){0.f, 0.f, 0.f, 0.f};
        cur = nxt; cA = nA; cB = nB; ++ui;
    }
    PG8_WAIT_V(0);
    if (wr == 0) PG8_BAR;
    PG8_BAR;
    if constexpr (Epi::AFTER_DRAIN) { E.fused(acc, cur, wr, wc, fr, fq, lds, wid, lane); S.done(cur); }
    PG8_STAMP();
    if (STAMP && wid == 0) { stamps[lane] = lane < nts ? (((unsigned long long)(unsigned)ts_hi << 32) | (unsigned)ts_lo) : 0ull;
        if (lane == 62) stamps[62] = rt_entry; if (lane == 63) stamps[63] = (unsigned long long)wall_clock64(); }
#undef PG8_STAMP
#undef PG8_SA
#undef PG8_SB
#undef PG8_STAGE
#undef PG8_LDA
#undef PG8_LDB
#undef PG8_MMA
#undef PG8_CAT8
#undef PG8_WAIT_V
#undef PG8_WAIT_L
#undef PG8_BAR
#undef PG8_SCHED
}
}

template <class E4, class = void> struct epi_mb { static constexpr int value = 0; };
template <class E4> struct epi_mb<E4, decltype((void)E4::MB)> { static constexpr int value = E4::MB; };
template <class E4> struct EpiAdapt {
    static constexpr bool PERM = true, AFTER_DRAIN = false;
    E4 e;
    __device__ __forceinline__ void operator()(const pg8::f32x4 (&acc)[2][2][4][2], const pg8::Unit& u, int wr, int wc, int fr, int fq) const {
        if constexpr (epi_mb<E4>::value > 0) {
            constexpr int MB = epi_mb<E4>::value;
#pragma unroll
            for (int ai = 0; ai < 2; ++ai)
#pragma unroll
                for (int m0 = 0; m0 < 4; m0 += MB) {
                    typename E4::Pre pre[MB][2];
#pragma unroll
                    for (int mi = 0; mi < MB; ++mi)
#pragma unroll
                        for (int bj = 0; bj < 2; ++bj) pre[mi][bj] = e.load(u.pm * 256 + ai * 128 + wr * 64 + (m0 + mi) * 16 + fr, u.pn * 256 + bj * 128 + wc * 32 + fq * 8);
#pragma unroll
                    for (int mi = 0; mi < MB; ++mi)
#pragma unroll
                        for (int bj = 0; bj < 2; ++bj) e.apply(u.pm * 256 + ai * 128 + wr * 64 + (m0 + mi) * 16 + fr, u.pn * 256 + bj * 128 + wc * 32 + fq * 8, acc[ai][bj][m0 + mi][0], acc[ai][bj][m0 + mi][1], pre[mi][bj]);
                    asm volatile("" ::: "memory");
                }
        } else {
#pragma unroll
        for (int ai = 0; ai < 2; ++ai)
#pragma unroll
            for (int m = 0; m < 4; ++m) {
                const int row = u.pm * 256 + ai * 128 + wr * 64 + m * 16 + fr;
#pragma unroll
                for (int bj = 0; bj < 2; ++bj) e(row, u.pn * 256 + bj * 128 + wc * 32 + fq * 8, acc[ai][bj][m][0], acc[ai][bj][m][1]);
                asm volatile("" ::: "memory");
            }
        }
    }
};
template <class E4>
DI void gemm_fast(const Ctx& c, const unsigned char* WSB, const bf16_t* A, const bf16_t* Bt, int Mg, int Ng, int Kg, const E4& e4) {
    pg8::Gemm g{A, Bt, Mg, Ng, Kg, c.tid, WSB}; pg8::StaticOrder S; S.init(Mg, Ng, (int)gridDim.x, (int)blockIdx.x);
    EpiAdapt<E4> E{e4};
    pg8::gemm_phase<EpiAdapt<E4>, pg8::StaticOrder, false>((PG8_LAS unsigned char*)c.lds, g, S, E, nullptr);
}
template <class E4>
DI void gemm_fast8(const Ctx& c, const unsigned char* WSB, const unsigned char* A, const unsigned char* Bt, int Mg, int Ng, int Kg, const E4& e4) {
    pg8::Gemm g{(const bf16_t*)A, (const bf16_t*)Bt, Mg, Ng, Kg / 2, c.tid, WSB}; pg8::StaticOrder S; S.init(Mg, Ng, (int)gridDim.x, (int)blockIdx.x);
    EpiAdapt<E4> E{e4};
    pg8::gemm_phase<EpiAdapt<E4>, pg8::StaticOrder, false, true>((PG8_LAS unsigned char*)c.lds, g, S, E, nullptr);
}
#define GEMM8(c_, ...) do { MKCTX(); gemm_fast8(c, ws, __VA_ARGS__); } while (0)
#ifndef FAST_GEMM
#define FAST_GEMM 1
#endif
#if FAST_GEMM
#define GEMM(c_, ...) do { MKCTX(); gemm_fast(c, ws, __VA_ARGS__); } while (0)
#else
#define GEMM(c_, ...) do { MKCTX(); gemm_naive(c, __VA_ARGS__); } while (0)
#endif

DI void attn_mla_naive(const Params& p, const Ctx& c) {
    const bf16_t* Q = (const bf16_t*)(p.ws + OFF_Q); const bf16_t* KN = (const bf16_t*)(p.ws + OFF_KN); const bf16_t* KR = (const bf16_t*)(p.ws + OFF_KR);
    const bf16_t* VT = (const bf16_t*)(p.ws + OFF_VT); bf16_t* O = (bf16_t*)(p.ws + OFF_ATTA);
    for (int u = c.gw; u < M * 8; u += c.ngw) {
        const int m = u >> 3, hd = u & 7, b = m / SEQ, s = m % SEQ, base = b * SEQ, nkeys = ((s >> 6) + 1) << 6;
        const float q0 = bf2f(Q[(size_t)m * 1536 + hd * 192 + c.lane]), q1 = bf2f(Q[(size_t)m * 1536 + hd * 192 + 64 + c.lane]), q2 = bf2f(Q[(size_t)m * 1536 + hd * 192 + 128 + c.lane]);
        float mx = -1e30f, l = 0.f, o0 = 0.f, o1 = 0.f;
        const bf16_t* v0p = VT + (size_t)(hd * 128 + c.lane) * M + base; const bf16_t* v1p = v0p + (size_t)64 * M;
        for (int kk = 0; kk < nkeys; ++kk) {
            const size_t tk = base + kk;
            const float part = q0 * bf2f(KN[tk * 1024 + hd * 128 + c.lane]) + q1 * bf2f(KN[tk * 1024 + hd * 128 + 64 + c.lane]) + q2 * bf2f(KR[tk * 64 + c.lane]);
            const float sc = wave_sum(part);
            const float mn = fmaxf(mx, sc), al = exp2f(mx - mn), pp = exp2f(sc - mn);
            l = l * al + pp; o0 = o0 * al + pp * bf2f(v0p[kk]); o1 = o1 * al + pp * bf2f(v1p[kk]); mx = mn;
        }
        const float inv = 1.f / l;
        O[(size_t)m * 1024 + hd * 128 + c.lane] = (bf16_t)(pk2(o0 * inv, 0.f) & 0xffff);
        O[(size_t)m * 1024 + hd * 128 + 64 + c.lane] = (bf16_t)(pk2(o1 * inv, 0.f) & 0xffff);
    }
}
DI void attn_sb_naive(const Params& p, const Ctx& c) {
    const bf16_t* Q = (const bf16_t*)(p.ws + OFF_SBQ); const bf16_t* K = (const bf16_t*)(p.ws + OFF_SBK);
    const bf16_t* VT = (const bf16_t*)(p.ws + OFF_SBVT); bf16_t* O = (bf16_t*)(p.ws + OFF_ATTB);
    for (int u = c.gw; u < M * 8; u += c.ngw) {
        const int m = u >> 3, hd = u & 7, b = m / SEQ, s = m % SEQ, base = b * SEQ;
        const float q0 = bf2f(Q[(size_t)m * 1024 + hd * 128 + c.lane]), q1 = bf2f(Q[(size_t)m * 1024 + hd * 128 + 64 + c.lane]);
        float later = 0.f, o0 = 0.f, o1 = 0.f;
        const bf16_t* v0p = VT + (size_t)(hd * 128 + c.lane) * M + base; const bf16_t* v1p = v0p + (size_t)64 * M;
        for (int kk = s - 1; kk >= 0; --kk) {
            const size_t tk = base + kk;
            const float z2 = wave_sum(q0 * bf2f(K[tk * 1024 + hd * 128 + c.lane]) + q1 * bf2f(K[tk * 1024 + hd * 128 + 64 + c.lane]));
            const float ln2 = -(fmaxf(z2, 0.f) + __log2f(1.f + exp2f(-fabsf(z2))));
            const float w = exp2f(z2 + ln2 + later);
            later += ln2; o0 += w * bf2f(v0p[kk]); o1 += w * bf2f(v1p[kk]);
        }
        O[(size_t)m * 1024 + hd * 128 + c.lane] = (bf16_t)(pk2(o0, 0.f) & 0xffff);
        O[(size_t)m * 1024 + hd * 128 + 64 + c.lane] = (bf16_t)(pk2(o1, 0.f) & 0xffff);
    }
}


typedef float f32x16 __attribute__((ext_vector_type(16)));
#define MFMA32(a, b, c) __builtin_amdgcn_mfma_f32_32x32x16_bf16((a), (b), (c), 0, 0, 0)
constexpr int ST_KR = 16384, ST_VT = 24576, ST_BYTES = 40960;
constexpr int ATT_FLAGS = 2 * ST_BYTES;
DI float ex2(float x) { return __builtin_amdgcn_exp2f(x); }
DI float lg2(float x) { return __builtin_amdgcn_logf(x); }
DI bf16x8 pack8(float a0, float a1, float a2, float a3, float a4, float a5, float a6, float a7) {
    u32x4 t; t.x = pk2(a0, a1); t.y = pk2(a2, a3); t.z = pk2(a4, a5); t.w = pk2(a6, a7); return __builtin_bit_cast(bf16x8, t); }
#define GLDS16(gp, lp) __builtin_amdgcn_global_load_lds((const unsigned*)(gp), (LAS unsigned*)(lp), 16, 0, 0)

struct AttDmaOff { unsigned kn[2], kr, vt[2]; };
DI AttDmaOff att_dma_offsets(int w, int lane) {
    AttDmaOff o; const unsigned lr = lane >> 4, pp = lane & 15;
#pragma unroll
    for (int i = 0; i < 2; ++i) { const unsigned q = w * 2 + i, R = 4 * q + lr, cc = pp ^ (R & 15); o.kn[i] = R * 2048u + cc * 16u; }
    { const unsigned q = w, R2 = 4 * q + lr, cc = pp ^ (R2 & 15); o.kr = (2 * R2 + (cc >> 3)) * 128u + (cc & 7) * 16u; }
#pragma unroll
    for (int i = 0; i < 2; ++i) { const unsigned q = w * 2 + i, R2 = 4 * q + lr, cc = pp ^ (R2 & 15); o.vt[i] = (2 * R2 + (cc >> 3)) * (unsigned)(M * 2) + (cc & 7) * 16u; }
    return o;
}
template <bool ROPE>
DI void att_dma(LAS unsigned char* buf, __amdgpu_buffer_rsrc_t rs, const AttDmaOff& o, unsigned k_so, unsigned kr_so, unsigned vt_so, int w) {
#pragma unroll
    for (int i = 0; i < 2; ++i) __builtin_amdgcn_raw_ptr_buffer_load_lds(rs, (LAS void*)(buf + (w * 2 + i) * 1024), 16, o.kn[i], k_so, 0, 0);
    if (ROPE) __builtin_amdgcn_raw_ptr_buffer_load_lds(rs, (LAS void*)(buf + ST_KR + w * 1024), 16, o.kr, kr_so, 0, 0);
#pragma unroll
    for (int i = 0; i < 2; ++i) __builtin_amdgcn_raw_ptr_buffer_load_lds(rs, (LAS void*)(buf + ST_VT + (w * 2 + i) * 1024), 16, o.vt[i], vt_so, 0, 0);
}
DI void att_store(const f32x16 (&o)[4], float scale, bf16_t* O, size_t row, int hd, int h) {
#pragma unroll
    for (int db = 0; db < 4; ++db)
#pragma unroll
        for (int g = 0; g < 4; ++g)
#if P67_FP8
            { const float sc8 = scale * ACT8_SCALE; *(unsigned*)((unsigned char*)O + row * 1024 + hd * 128 + db * 32 + g * 8 + h * 4) = pk4f8(o[db][4 * g] * sc8, o[db][4 * g + 1] * sc8, o[db][4 * g + 2] * sc8, o[db][4 * g + 3] * sc8); }
#else
            store_bf16x4(O + row * 1024 + hd * 128 + db * 32 + g * 8 + h * 4, (f32x4){o[db][4 * g] * scale, o[db][4 * g + 1] * scale, o[db][4 * g + 2] * scale, o[db][4 * g + 3] * scale});
#endif
}
DI void att_pv(f32x16 (&o)[4], const bf16x8 (&pf)[2][2], const LAS unsigned char* buf, unsigned va) {
#pragma unroll
    for (int db = 0; db < 4; ++db) {
#pragma unroll
        for (int blk = 0; blk < 2; ++blk)
#pragma unroll
            for (int ks = 0; ks < 2; ++ks) o[db] = MFMA32(*(const LAS bf16x8*)(buf + ((va ^ ((blk * 2 + ks) << 5)) + db * 4096)), pf[blk][ks], o[db]);
        asm volatile("" ::: "memory");
    }
}

DI void attn_mla_fast(const Params& p, const Ctx& c) {
    const bf16_t* Q = (const bf16_t*)(p.ws + OFF_Q); const bf16_t* KN = (const bf16_t*)(p.ws + OFF_KN); const bf16_t* KR = (const bf16_t*)(p.ws + OFF_KR);
    const bf16_t* VT = (const bf16_t*)(p.ws + OFF_VT); bf16_t* O = (bf16_t*)(p.ws + OFF_ATTA);
    const int lane = c.lane, r = lane & 31, h = lane >> 5, w = c.wave;
    const int pr = (r & 0x13) | ((r & 4) << 1) | ((r & 8) >> 1);
    const unsigned ka = (pr << 8) | ((((pr & 15) ^ h) & 15) << 4);
    const unsigned ra = ST_KR + (((pr >> 1) << 8) | (((((pr & 1) << 3) | h) ^ ((pr >> 1) & 15)) << 4));
    const unsigned va = ST_VT + (((r >> 1) << 8) | (((((r & 1) << 3) | h) ^ ((r >> 1) & 15)) << 4));
    const __amdgpu_buffer_rsrc_t rs = __builtin_amdgcn_make_buffer_rsrc((void*)p.ws, (short)0, (int)WS_END, 0x00020000);
    const AttDmaOff dof = att_dma_offsets(w, lane);
    for (int it = blockIdx.x; it < 256; it += gridDim.x) {
        const int bh = it & 31, b = bh >> 3, hd = bh & 7, pairi = it >> 5;
#pragma unroll 1
        for (int half = 0; half < 2; ++half) {
            const int qb = half ? 15 - pairi : pairi, q0 = qb * 256;
            const size_t base = (size_t)b * SEQ, qrow = base + q0 + w * 32 + r;
            bf16x8 qf[12];
#pragma unroll
            for (int st = 0; st < 12; ++st) qf[st] = *(const bf16x8*)(Q + qrow * 1536 + hd * 192 + st * 16 + h * 8);
            const int ntile = q0 / 64 + 4, myn = (q0 + w * 32) / 64 + 1;
            f32x16 o[4];
#pragma unroll
            for (int db = 0; db < 4; ++db)
#pragma unroll
                for (int i = 0; i < 16; ++i) o[db][i] = 0.f;
            float mrun = -1e30f, lrun = 0.f;
            __syncthreads();
            const unsigned k_so0 = (unsigned)(OFF_KN + (base * 1024 + hd * 128) * 2), kr_so0 = (unsigned)(OFF_KR + base * 64 * 2), vt_so0 = (unsigned)(OFF_VT + ((size_t)(hd * 128) * M + base) * 2);
            att_dma<true>(c.lds, rs, dof, k_so0, kr_so0, vt_so0, w);
            asm volatile("s_waitcnt vmcnt(0)" ::: "memory");
            __syncthreads();
            for (int j = 0; j < ntile; ++j) {
                LAS unsigned char* buf = c.lds + (j & 1) * ST_BYTES;
                if (j + 1 < ntile) att_dma<true>(c.lds + ((j + 1) & 1) * ST_BYTES, rs, dof, k_so0 + (unsigned)(j + 1) * (64 * 2048), kr_so0 + (unsigned)(j + 1) * (64 * 128), vt_so0 + (unsigned)(j + 1) * 128, w);
                if (j < myn) {
                    f32x16 s0, s1;
#pragma unroll
                    for (int i = 0; i < 16; ++i) { s0[i] = 0.f; s1[i] = 0.f; }
                    __builtin_amdgcn_s_setprio(1);
#pragma unroll
                    for (int st = 0; st < 8; ++st) {
                        s0 = MFMA32(*(const LAS bf16x8*)(buf + (ka ^ (st << 5))), qf[st], s0);
                        s1 = MFMA32(*(const LAS bf16x8*)(buf + ((ka ^ (st << 5)) + 8192)), qf[st], s1);
                    }
#pragma unroll
                    for (int st = 0; st < 4; ++st) {
                        s0 = MFMA32(*(const LAS bf16x8*)(buf + (ra ^ (st << 5))), qf[8 + st], s0);
                        s1 = MFMA32(*(const LAS bf16x8*)(buf + ((ra ^ (st << 5)) + 4096)), qf[8 + st], s1);
                    }
                    __builtin_amdgcn_s_setprio(0);
                    float mx = fmaxf(s0[0], s1[0]);
#pragma unroll
                    for (int i = 1; i < 16; ++i) mx = fmaxf(mx, fmaxf(s0[i], s1[i]));
                    mx = fmaxf(mx, __shfl_xor(mx, 32));
                    const float mnew = fmaxf(mrun, mx), alpha = ex2(mrun - mnew);
                    mrun = mnew;
                    float ps = 0.f;
#pragma unroll
                    for (int i = 0; i < 16; ++i) { s0[i] = ex2(s0[i] - mnew); s1[i] = ex2(s1[i] - mnew); ps += s0[i] + s1[i]; }
                    lrun = lrun * alpha + ps;
#pragma unroll
                    for (int db = 0; db < 4; ++db)
#pragma unroll
                        for (int i = 0; i < 16; ++i) o[db][i] *= alpha;
                    bf16x8 pf[2][2];
                    pf[0][0] = pack8(s0[0], s0[1], s0[2], s0[3], s0[4], s0[5], s0[6], s0[7]); pf[0][1] = pack8(s0[8], s0[9], s0[10], s0[11], s0[12], s0[13], s0[14], s0[15]);
                    pf[1][0] = pack8(s1[0], s1[1], s1[2], s1[3], s1[4], s1[5], s1[6], s1[7]); pf[1][1] = pack8(s1[8], s1[9], s1[10], s1[11], s1[12], s1[13], s1[14], s1[15]);
                    __builtin_amdgcn_s_setprio(1);
                    att_pv(o, pf, buf, va);
                    __builtin_amdgcn_s_setprio(0);
                }
                asm volatile("s_waitcnt vmcnt(0)" ::: "memory");
                __syncthreads();
            }
            const float ltot = lrun + __shfl_xor(lrun, 32);
            att_store(o, 1.f / ltot, O, qrow, hd, h);
        }
    }
}

DI void attn_sb_fast(const Params& p, const Ctx& c) {
    const bf16_t* Q = (const bf16_t*)(p.ws + OFF_SBQ); const bf16_t* K = (const bf16_t*)(p.ws + OFF_SBK);
    const bf16_t* VT = (const bf16_t*)(p.ws + OFF_SBVT); bf16_t* O = (bf16_t*)(p.ws + OFF_ATTB);
    const int lane = c.lane, r = lane & 31, h = lane >> 5, w = c.wave, tid = c.tid;
    const int pr = (r & 0x13) | ((r & 4) << 1) | ((r & 8) >> 1);
    const unsigned ka = (pr << 8) | ((((pr & 15) ^ h) & 15) << 4);
    const unsigned va = ST_VT + (((r >> 1) << 8) | (((((r & 1) << 3) | h) ^ ((r >> 1) & 15)) << 4));
    const __amdgpu_buffer_rsrc_t rs = __builtin_amdgcn_make_buffer_rsrc((void*)p.ws, (short)0, (int)WS_END, 0x00020000);
    const AttDmaOff dof = att_dma_offsets(w, lane);
    LAS int* flags = (LAS int*)(c.lds + ATT_FLAGS);
    for (int it = blockIdx.x; it < 256; it += gridDim.x) {
        const int bh = it & 31, b = bh >> 3, hd = bh & 7, pairi = it >> 5;
#pragma unroll 1
        for (int half = 0; half < 2; ++half) {
            const int qb = half ? 15 - pairi : pairi, q0 = qb * 256;
            const size_t base = (size_t)b * SEQ, qrow = base + q0 + w * 32 + r;
            const int tq = q0 + w * 32 + r;
            bf16x8 qf[8];
#pragma unroll
            for (int st = 0; st < 8; ++st) qf[st] = *(const bf16x8*)(Q + qrow * 1024 + hd * 128 + st * 16 + h * 8);
            const int jmax = q0 / 64 + 3, jd = (q0 + w * 32) / 64;
            f32x16 o[4];
#pragma unroll
            for (int db = 0; db < 4; ++db)
#pragma unroll
                for (int i = 0; i < 16; ++i) o[db][i] = 0.f;
            float carry = 0.f; bool wdone = false;
            __syncthreads();
            const unsigned k_so0 = (unsigned)(OFF_SBK + (base * 1024 + hd * 128) * 2), vt_so0 = (unsigned)(OFF_SBVT + ((size_t)(hd * 128) * M + base) * 2);
            att_dma<false>(c.lds, rs, dof, k_so0 + (unsigned)jmax * (64 * 2048), 0u, vt_so0 + (unsigned)jmax * 128, w);
            if (tid < 16) flags[tid] = 0;
            asm volatile("s_waitcnt vmcnt(0)" ::: "memory");
            __syncthreads();
            int itn = 0;
            for (int j = jmax; j >= 0; --j, ++itn) {
                LAS unsigned char* buf = c.lds + (itn & 1) * ST_BYTES;
                if (j > 0) att_dma<false>(c.lds + ((itn + 1) & 1) * ST_BYTES, rs, dof, k_so0 + (unsigned)(j - 1) * (64 * 2048), 0u, vt_so0 + (unsigned)(j - 1) * 128, w);
                if (j <= jd && !wdone) {
                    f32x16 s0, s1;
#pragma unroll
                    for (int i = 0; i < 16; ++i) { s0[i] = 0.f; s1[i] = 0.f; }
#pragma unroll
                    for (int st = 0; st < 8; ++st) {
                        s0 = MFMA32(*(const LAS bf16x8*)(buf + (ka ^ (st << 5))), qf[st], s0);
                        s1 = MFMA32(*(const LAS bf16x8*)(buf + ((ka ^ (st << 5)) + 8192)), qf[st], s1);
                    }
                    const int kb0 = 64 * j + 8 * h - tq;
                    bf16x8 pf[2][2];
                    {
                        f32x16 l1;
#pragma unroll
                        for (int i = 0; i < 16; ++i) { const float z = s1[i]; const float a = -(fmaxf(z, 0.f) + lg2(1.f + ex2(-fabsf(z)))); l1[i] = (kb0 + 32 + 16 * (i >> 3) + (i & 7) < 0) ? a : 0.f; }
                        float g0 = 0.f, g1 = 0.f;
#pragma unroll
                        for (int e = 0; e < 8; ++e) { g0 += l1[e]; g1 += l1[8 + e]; }
                        const float p0 = __shfl_xor(g0, 32), p1 = __shfl_xor(g1, 32);
                        float run = carry + (h == 0 ? p1 : 0.f);
#pragma unroll
                        for (int e = 7; e >= 0; --e) { run += l1[8 + e]; l1[8 + e] = run; }
                        run = carry + (g1 + p1) + (h == 0 ? p0 : 0.f);
#pragma unroll
                        for (int e = 7; e >= 0; --e) { run += l1[e]; l1[e] = run; }
                        carry += (g1 + p1) + (g0 + p0);
#pragma unroll
                        for (int i = 0; i < 16; ++i) { const float wv = ex2(s1[i] + l1[i]); s1[i] = (kb0 + 32 + 16 * (i >> 3) + (i & 7) < 0) ? wv : 0.f; }
                        pf[1][0] = pack8(s1[0], s1[1], s1[2], s1[3], s1[4], s1[5], s1[6], s1[7]); pf[1][1] = pack8(s1[8], s1[9], s1[10], s1[11], s1[12], s1[13], s1[14], s1[15]);
                    }
                    {
                        f32x16 l0;
#pragma unroll
                        for (int i = 0; i < 16; ++i) { const float z = s0[i]; const float a = -(fmaxf(z, 0.f) + lg2(1.f + ex2(-fabsf(z)))); l0[i] = (kb0 + 16 * (i >> 3) + (i & 7) < 0) ? a : 0.f; }
                        float g0 = 0.f, g1 = 0.f;
#pragma unroll
                        for (int e = 0; e < 8; ++e) { g0 += l0[e]; g1 += l0[8 + e]; }
                        const float p0 = __shfl_xor(g0, 32), p1 = __shfl_xor(g1, 32);
                        float run = carry + (h == 0 ? p1 : 0.f);
#pragma unroll
                        for (int e = 7; e >= 0; --e) { run += l0[8 + e]; l0[8 + e] = run; }
                        run = carry + (g1 + p1) + (h == 0 ? p0 : 0.f);
#pragma unroll
                        for (int e = 7; e >= 0; --e) { run += l0[e]; l0[e] = run; }
                        carry += (g1 + p1) + (g0 + p0);
#pragma unroll
                        for (int i = 0; i < 16; ++i) { const float wv = ex2(s0[i] + l0[i]); s0[i] = (kb0 + 16 * (i >> 3) + (i & 7) < 0) ? wv : 0.f; }
                        pf[0][0] = pack8(s0[0], s0[1], s0[2], s0[3], s0[4], s0[5], s0[6], s0[7]); pf[0][1] = pack8(s0[8], s0[9], s0[10], s0[11], s0[12], s0[13], s0[14], s0[15]);
                    }
                    att_pv(o, pf, buf, va);
                    wdone = __all(carry < -150.f);
                }
                if (lane == 0) flags[(itn & 1) * 8 + w] = wdone ? 1 : 0;
                asm volatile("s_waitcnt vmcnt(0)" ::: "memory");
                __syncthreads();
                int alld = 1;
#pragma unroll
                for (int q = 0; q < 8; ++q) alld &= flags[(itn & 1) * 8 + q];
                if (alld) break;
            }
            att_store(o, 1.f, O, qrow, hd, h);
        }
    }
}
#ifndef FAST_ATTN
#define FAST_ATTN 1
#endif

constexpr int SEL_LD = 260;
DI void topk_insert(float (&a)[16], float x) {
#pragma unroll
    for (int i = 15; i >= 1; --i) a[i] = __builtin_amdgcn_fmed3f(a[i - 1], a[i], x);
    a[0] = fmaxf(a[0], x);
}
struct SelMap { int mode, a0, a1, a2, a3; };
DI void sel_decode(const SelMap& mp, int q, int& t0, int& hd) {
    if (mp.mode == 0) { int u = mp.a0 + q * mp.a1; if (u >= 128 * 8) u = mp.a0; hd = u & 7; t0 = (u >> 3) * 128; }
    else { const int pm = (q >> 1) ? mp.a2 : mp.a0, pn = (q >> 1) ? mp.a3 : mp.a1; hd = pn; t0 = pm * 256 + (q & 1) * 128; }
}
template <int NU> DI void select_stage2(const Params& p, const Ctx& c, const SelMap mp, const LAS float* lst_all) {
    if (c.tid < 128 * NU) {
        const int tok = c.tid & 127, un = c.tid >> 7;
        int t0, hd; sel_decode(mp, un, t0, hd);
        const LAS float* lst = lst_all + un * 4096;
        float v1[16], v2[16];
#pragma unroll
        for (int i = 0; i < 16; ++i) { v1[i] = __uint_as_float(__float_as_uint(lst[(tok * 2) * 16 + i]) & ~127u); v2[i] = __uint_as_float(__float_as_uint(lst[(tok * 2 + 1) * 16 + i]) & ~127u); }
        float bb[16];
#pragma unroll
        for (int i = 0; i < 16; ++i) bb[i] = -__builtin_inff();
#pragma unroll
        for (int i = 0; i < 16; ++i)
#pragma unroll
            for (int j = 0; j < 16; ++j)
                if ((i + 1) * (j + 1) <= 16) topk_insert(bb, __uint_as_float((__float_as_uint(v1[i] + v2[j]) & ~255u) | (unsigned)(i * 16 + j)));
        float sv[16], mxv = -__builtin_inff(), sum = 0.f;
#pragma unroll
        for (int i = 0; i < 16; ++i) { sv[i] = __uint_as_float(__float_as_uint(bb[i]) & ~255u); mxv = fmaxf(mxv, sv[i]); }
#pragma unroll
        for (int i = 0; i < 16; ++i) { sv[i] = __expf(sv[i] - mxv); sum += sv[i]; }
        const float inv = 1.f / sum;
        int* idx = (int*)(p.ws + OFF_IDX) + (size_t)(t0 + tok) * 128 + hd * 16; float* gw = (float*)(p.ws + OFF_GW) + (size_t)(t0 + tok) * 128 + hd * 16;
#pragma unroll
        for (int i = 0; i < 16; ++i) {
            const unsigned code = __float_as_uint(bb[i]) & 255u;
            const unsigned e1 = __float_as_uint(lst[(tok * 2) * 16 + (code >> 4)]) & 127u, e2 = __float_as_uint(lst[(tok * 2 + 1) * 16 + (code & 15u)]) & 127u;
            idx[i] = (int)(e1 * 128u + e2); gw[i] = sv[i] * inv;
        }
    }
    __syncthreads();
}
DI void select_tail(const Params& p, const Ctx& c, int t0, int hd) {
    LAS float* sc = (LAS float*)c.lds; LAS float* lst = sc + 128 * SEL_LD;
    if (c.tid < 256) {
        const int tok = c.tid >> 1, hf = c.tid & 1;
        float a[16];
#pragma unroll
        for (int i = 0; i < 16; ++i) a[i] = -__builtin_inff();
        const LAS float* row = sc + tok * SEL_LD + hf * 128;
#pragma unroll 4
        for (int n4 = 0; n4 < 32; ++n4) {
            const f32x4 v = *(const LAS f32x4*)(row + n4 * 4);
#pragma unroll
            for (int e = 0; e < 4; ++e) topk_insert(a, __uint_as_float((__float_as_uint(v[e]) & ~127u) | (unsigned)(n4 * 4 + e)));
        }
#pragma unroll
        for (int i = 0; i < 16; ++i) lst[(tok * 2 + hf) * 16 + i] = a[i];
    }
    __syncthreads();
    select_stage2<1>(p, c, SelMap{0, ((t0 >> 7) << 3) | hd, 0, 0, 0}, lst);
}
DI void select_naive(const Params& p, const Ctx& c) {
    const bf16_t* PQ = (const bf16_t*)(p.ws + OFF_PQ); const bf16_t* KEYS = (const bf16_t*)(p.ws + OFF_KEYS);
    LAS float* sc = (LAS float*)c.lds;
    for (int u = blockIdx.x; u < 128 * 8; u += gridDim.x) {
        const int hd = u & 7, t0 = (u >> 3) * 128;
        const int tok = c.tid >> 2, part = c.tid & 3, hf = part >> 1, n0 = (part & 1) * 64;
        const bf16_t* qrow = PQ + (size_t)hd * M * 256 + (size_t)(t0 + tok) * 256 + hf * 128;
        const bf16_t* kb = KEYS + (size_t)((hd * 2 + hf) * 128 + n0) * 128;
        for (int n = 0; n < 64; ++n) {
            float acc = 0.f;
#pragma unroll
            for (int d8 = 0; d8 < 16; ++d8) {
                const u32x4 a = *(const u32x4*)(qrow + d8 * 8), b = *(const u32x4*)(kb + (size_t)n * 128 + d8 * 8);
#pragma unroll
                for (int e = 0; e < 4; ++e) acc += bflo(a[e]) * bflo(b[e]) + bfhi(a[e]) * bfhi(b[e]);
            }
            sc[tok * SEL_LD + hf * 128 + n0 + n] = acc;
        }
        __syncthreads();
        select_tail(p, c, t0, hd);
    }
}


DI void select_batch(const Params& p, const Ctx& c, const SelMap mp) {
    const bf16_t* PQ = (const bf16_t*)(p.ws + OFF_PQ); const bf16_t* KEYS = (const bf16_t*)(p.ws + OFF_KEYS);
    LAS float* lst_all = (LAS float*)c.lds;
    const int lane = c.lane, r = lane & 31, h = lane >> 5, w = c.wave, tb = w & 3, hf = w >> 2;
#pragma unroll
    for (int q = 0; q < 4; ++q) {
        int t0, hd; sel_decode(mp, q, t0, hd);
        LAS float* lst = lst_all + q * 4096;
        const bf16_t* qrow = PQ + (size_t)hd * M * 256 + (size_t)(t0 + tb * 32 + r) * 256 + hf * 128 + h * 8;
        const bf16_t* kbase = KEYS + (size_t)((hd * 2 + hf) * 128 + r) * 128 + h * 8;
        bf16x8 qf[8];
#pragma unroll
        for (int st = 0; st < 8; ++st) qf[st] = *(const bf16x8*)(qrow + st * 16);
        float a[16];
#pragma unroll
        for (int i = 0; i < 16; ++i) a[i] = -__builtin_inff();
#pragma unroll
        for (int kb = 0; kb < 4; ++kb) {
            f32x16 sc;
#pragma unroll
            for (int i = 0; i < 16; ++i) sc[i] = 0.f;
#pragma unroll
            for (int st = 0; st < 8; ++st) sc = MFMA32(*(const bf16x8*)(kbase + (size_t)kb * 32 * 128 + st * 16), qf[st], sc);
#pragma unroll
            for (int i = 0; i < 16; ++i) topk_insert(a, __uint_as_float((__float_as_uint(sc[i]) & ~127u) | (unsigned)(kb * 32 + (i & 3) + 8 * (i >> 2) + 4 * h)));
        }
        float bq[16];
#pragma unroll
        for (int i = 0; i < 16; ++i) bq[i] = __shfl_xor(a[i], 32);
#pragma unroll
        for (int i = 0; i < 16; ++i) topk_insert(a, bq[i]);
        if (h == 0) {
#pragma unroll
            for (int i = 0; i < 16; ++i) lst[((tb * 32 + r) * 2 + hf) * 16 + i] = a[i];
        }
    }
    __syncthreads();
    select_stage2<4>(p, c, mp, lst_all);
}
DI void select_fast(const Params& p, const Ctx& c) {
    for (int u0 = blockIdx.x; u0 < 128 * 8; u0 += 4 * gridDim.x) select_batch(p, c, SelMap{0, u0, (int)gridDim.x, 0, 0});
}
DI void select_own_tiles(const Params& p, const Ctx& c) {
    pg8::StaticOrder S; S.init(M, 2048, (int)gridDim.x, (int)blockIdx.x);
    asm volatile("s_waitcnt vmcnt(0)" ::: "memory");
    __syncthreads();
    if (c.tid == 0) { __builtin_amdgcn_fence(__ATOMIC_ACQUIRE, "agent"); asm volatile("s_waitcnt vmcnt(0)" ::: "memory"); }
    __syncthreads();
    for (int i = 0;; i += 2) {
        pg8::Unit u0, u1;
        if (!S.next(i, u0)) break;
        if (!S.next(i + 1, u1)) u1 = u0;
        select_batch(p, c, SelMap{1, u0.pm, u0.pn, u1.pm, u1.pn});
    }
}
#ifndef FAST_SEL
#define FAST_SEL 1
#endif

DI void phase_gather(const Params& p, const Ctx& c, float* dst, int rowmask = -1) {
    const bf16_t* H2 = (const bf16_t*)(p.ws + OFF_H); const unsigned char* U = p.ws + OFF_U16; const unsigned char* V = p.ws + OFF_V16;
    const int* IDX = (const int*)(p.ws + OFF_IDX); const float* GW = (const float*)(p.ws + OFF_GW); const float* mod = (const float*)(p.ws + OFF_MOD);
    constexpr int G = 8, GV = 16;
    const int lane = c.lane;
    unsigned* tokctr = (unsigned*)(p.ws + OFF_CTL) + 700;
    constexpr int NSTATIC = 6;
    LAS int* park = (LAS int*)(c.lds + c.wave * 20480);
    for (int it = 0;; ++it) {
        int m, slot; bool doU, doV;
        if (it < NSTATIC) { slot = it; m = c.gw + it * c.ngw; doU = true; doV = false; }
        else if (it < 2 * NSTATIC) { slot = it - NSTATIC; m = c.gw + slot * c.ngw; doU = false; doV = true; }
        else { unsigned t = 0; if (lane == 0) t = __hip_atomic_fetch_add(tokctr, 1u, __ATOMIC_RELAXED, __HIP_MEMORY_SCOPE_AGENT); m = NSTATIC * c.ngw + (int)__builtin_amdgcn_readfirstlane(t); if (m >= M) break; slot = 0; doU = true; doV = true; }
        if (m >= M) continue;
        const int b = m / SEQ;
        LAS int* ps = park + slot * 256;
        int ia = 0, ib = 0; float wa = 0.f, wb = 0.f;
        if (doU) {
        f32x2 hf[16];
#pragma unroll
        for (int i = 0; i < 4; ++i) { const u32x4 a = *(const u32x4*)(H2 + (size_t)m * D + lane * 32 + i * 8);
#pragma unroll
            for (int q = 0; q < 4; ++q) hf[4 * i + q] = (f32x2){bflo(a[q]), bfhi(a[q])}; }
        ia = IDX[(size_t)m * 128 + lane]; ib = IDX[(size_t)m * 128 + 64 + lane];
        const float ga = GW[(size_t)m * 128 + lane], gb = GW[(size_t)m * 128 + 64 + lane];
#pragma unroll 1
        for (int k0 = 0; k0 < 128; k0 += G) {
            u32x4 ua[G]; u32x2 ub[G];
#pragma unroll
            for (int g = 0; g < G; ++g) {
                const int e = __builtin_amdgcn_readlane(k0 < 64 ? ia : ib, (k0 + g) & 63) & rowmask;
                const unsigned char* ur = U + (size_t)e * 1536;
                ua[g] = *(const u32x4*)(ur + (unsigned)lane * 16u); ub[g] = *(const u32x2*)(ur + 1024u + (unsigned)lane * 8u);
            }
            float d[G];
#pragma unroll
            for (int g = 0; g < G; ++g) {
                const f32x32v f = __builtin_amdgcn_cvt_scalef32_pk32_f32_fp6((u32x6){ua[g][0], ua[g][1], ua[g][2], ua[g][3], ub[g][0], ub[g][1]}, 1.0f);
                f32x2 d2 = {0.f, 0.f};
#pragma unroll
                for (int i = 0; i < 16; ++i) d2 = (f32x2){f[2 * i], f[2 * i + 1]} * hf[i] + d2;
                d[g] = d2.x + d2.y;
            }
            { const bool u5 = lane & 32, u4 = lane & 16, u3 = lane & 8;
              float r4[4];
#pragma unroll
              for (int i = 0; i < 4; ++i) { const float send = u5 ? d[i] : d[4 + i], keep = u5 ? d[4 + i] : d[i]; r4[i] = keep + __shfl_xor(send, 32); }
              float r2[2];
#pragma unroll
              for (int i = 0; i < 2; ++i) { const float send = u4 ? r4[i] : r4[2 + i], keep = u4 ? r4[2 + i] : r4[i]; r2[i] = keep + __shfl_xor(send, 16); }
              const float send = u3 ? r2[0] : r2[1], keep = u3 ? r2[1] : r2[0];
              float r1 = keep + __shfl_xor(send, 8);
              r1 += __shfl_xor(r1, 4); r1 += __shfl_xor(r1, 2); r1 += __shfl_xor(r1, 1);
              const float act = gelu_tanh(r1 * (1.f / U8_SCALE)) * (1.f / V8_SCALE);
              const int gsel = lane - (k0 & 63);
              const int src = ((gsel & 4) << 3) | ((gsel & 2) << 3) | ((gsel & 1) << 3);
              const float got = __shfl(act, src & 63);
              if (gsel >= 0 && gsel < G) { if (k0 < 64) wa = got * ga; else wb = got * gb; }
            }
        }
        ps[lane] = ia; ps[64 + lane] = ib; ps[128 + lane] = __builtin_bit_cast(int, wa); ps[192 + lane] = __builtin_bit_cast(int, wb);
        }
        if (!doV) continue;
        if (!doU) { ia = ps[lane]; ib = ps[64 + lane]; wa = __builtin_bit_cast(float, ps[128 + lane]); wb = __builtin_bit_cast(float, ps[192 + lane]); }
        f32x2 acc[16];
#pragma unroll
        for (int i = 0; i < 16; ++i) acc[i] = (f32x2){0.f, 0.f};
#define VB_ISSUE(P, K0) do { _Pragma("unroll") for (int g = 0; g < 8; ++g) { \
            const int e = __builtin_amdgcn_readlane((K0) < 64 ? ia : ib, ((K0) + g) & 63) & rowmask; \
            P##w[g] = __builtin_bit_cast(float, __builtin_amdgcn_readlane(__builtin_bit_cast(int, (K0) < 64 ? wa : wb), ((K0) + g) & 63)); \
            const unsigned char* vr = V + (size_t)e * 1536; \
            P##a[g] = *(const u32x4*)(vr + (unsigned)lane * 16u); P##b[g] = *(const u32x2*)(vr + 1024u + (unsigned)lane * 8u); } } while (0)
#define VB_COMPUTE(P) do { _Pragma("unroll") for (int g = 0; g < 8; ++g) { const f32x2 w2 = {P##w[g], P##w[g]}; \
            const f32x32v f = __builtin_amdgcn_cvt_scalef32_pk32_f32_fp6((u32x6){P##a[g][0], P##a[g][1], P##a[g][2], P##a[g][3], P##b[g][0], P##b[g][1]}, 1.0f); \
            _Pragma("unroll") for (int i = 0; i < 16; ++i) acc[i] = (f32x2){f[2 * i], f[2 * i + 1]} * w2 + acc[i]; } } while (0)
        {
            u32x4 A_a[8], B_a[8]; u32x2 A_b[8], B_b[8]; float A_w[8], B_w[8];
            VB_ISSUE(A_, 0);
#pragma unroll 1
            for (int k0 = 0; k0 < 128; k0 += 16) {
                VB_ISSUE(B_, k0 + 8);
                VB_COMPUTE(A_);
                if (k0 + 16 < 128) VB_ISSUE(A_, k0 + 16);
                VB_COMPUTE(B_);
            }
        }
#undef VB_ISSUE
#undef VB_COMPUTE
        const float* orow = p.out + (size_t)m * D + lane * 32; float* drow = dst + (size_t)m * D + lane * 32; const float* gt2 = mod + b * 6 * D + 5 * D + lane * 32; const float* fg = p.fng + lane * 32;
        float ss = 0.f; f32x4 xv[8];
#pragma unroll
        for (int i = 0; i < 8; ++i) {
            const f32x4 xa = *(const f32x4*)(orow + 4 * i), ta = *(const f32x4*)(gt2 + 4 * i);
            const f32x4 pe = {acc[2 * i].x, acc[2 * i].y, acc[2 * i + 1].x, acc[2 * i + 1].y};
            const f32x4 v = xa + DBG_BETA * ta * pe; xv[i] = v; ss += (v[0] * v[0] + v[1] * v[1]) + (v[2] * v[2] + v[3] * v[3]);
        }
        const float rstd = rsqrtf(wave_sum(ss) * (1.f / D) + EPS);
#pragma unroll
        for (int i = 0; i < 8; ++i) *(f32x4*)(drow + 4 * i) = xv[i] * rstd * *(const f32x4*)(fg + 4 * i);
    }
}


DI void phase_gather_sorted(const Params& p, const Ctx& c) {
    const bf16_t* H2 = (const bf16_t*)(p.ws + OFF_H); const unsigned char* U = p.ws + OFF_U16; const unsigned char* V = p.ws + OFF_V16;
    const int* IDX = (const int*)(p.ws + OFF_IDX); const float* GW = (const float*)(p.ws + OFF_GW); const float* mod = (const float*)(p.ws + OFF_MOD);
    const int lane = c.lane;
    LAS unsigned char* wl = c.lds + c.wave * 20480;
    constexpr int RSH = 12;
    const bool u5 = lane & 32, u4 = lane & 16, u3 = lane & 8;
#pragma unroll 1
    for (int grp = 0; grp < 2; ++grp) {
#pragma unroll 1
        for (int t = 0; t < 4; ++t) {
            const int m = c.gw + (grp * 4 + t) * c.ngw;
            if (m >= M) continue;
            const int ia = IDX[(size_t)m * 128 + lane], ib = IDX[(size_t)m * 128 + 64 + lane];
            const float ga = GW[(size_t)m * 128 + lane], gb = GW[(size_t)m * 128 + 64 + lane];
            const int ra = ia >> RSH, rb = ib >> RSH;
            int off = 0, posA = 0, posB = 0;
#pragma unroll
            for (int r = 0; r < 4; ++r) {
                const unsigned long long mA = __ballot(ra == r), mB = __ballot(rb == r);
                const int cA = __builtin_popcountll(mA), cB = __builtin_popcountll(mB);
                const int rkA = __builtin_amdgcn_mbcnt_hi((unsigned)(mA >> 32), __builtin_amdgcn_mbcnt_lo((unsigned)mA, 0u));
                const int rkB = __builtin_amdgcn_mbcnt_hi((unsigned)(mB >> 32), __builtin_amdgcn_mbcnt_lo((unsigned)mB, 0u));
                posA = (ra == r) ? off + rkA : posA; posB = (rb == r) ? off + cA + rkB : posB; off += cA + cB;
            }
            LAS int* sE = (LAS int*)(wl + t * 1024); LAS float* sW = (LAS float*)(wl + t * 1024 + 512);
            sE[posA] = ia; sE[posB] = ib; sW[posA] = ga; sW[posB] = gb;
            LAS u32x4* hrow = (LAS u32x4*)(wl + 4096 + t * 4096 + lane * 64);
#pragma unroll
            for (int i = 0; i < 4; ++i) hrow[i] = *(const u32x4*)(H2 + (size_t)m * D + lane * 32 + i * 8);
        }
        asm volatile("s_waitcnt lgkmcnt(0)" ::: "memory");
#pragma unroll 1
        for (int vi = 0; vi < 16; ++vi) {
            {
                const int r = vi >> 2, t = vi & 3;
                const int m = c.gw + (grp * 4 + t) * c.ngw;
                if (m >= M) continue;
                LAS int* sE = (LAS int*)(wl + t * 1024); LAS float* sW = (LAS float*)(wl + t * 1024 + 512);
                const int eLo = sE[lane], eHi = sE[64 + lane];
                const unsigned long long mLo = __ballot((eLo >> RSH) == r), mHi = __ballot((eHi >> RSH) == r);
                if (!(mLo | mHi)) continue;
                const int s0 = mLo ? __builtin_ctzll(mLo) : 64 + __builtin_ctzll(mHi);
                const int e1 = s0 + __builtin_popcountll(mLo) + __builtin_popcountll(mHi);
                float wLo = sW[lane], wHi = sW[64 + lane];
                f32x2 hf[16];
                { const LAS u32x4* hrow = (const LAS u32x4*)(wl + 4096 + t * 4096 + lane * 64);
#pragma unroll
                  for (int i = 0; i < 4; ++i) { const u32x4 a = hrow[i];
#pragma unroll
                    for (int q = 0; q < 4; ++q) hf[4 * i + q] = (f32x2){bflo(a[q]), bfhi(a[q])}; } }
#pragma unroll 1
                for (int j0 = s0; j0 < e1; j0 += 8) {
                    u32x4 ua[8]; u32x2 ub[8];
#pragma unroll
                    for (int g = 0; g < 8; ++g) {
                        const int pos = j0 + g;
                        ua[g] = (u32x4){0u, 0u, 0u, 0u}; ub[g] = (u32x2){0u, 0u};
                        if (pos < e1) {
                            const int e = __builtin_amdgcn_readlane(pos < 64 ? eLo : eHi, pos & 63);
                            const unsigned char* ur = U + (size_t)e * 1536;
                            ua[g] = *(const u32x4*)(ur + (unsigned)lane * 16u); ub[g] = *(const u32x2*)(ur + 1024u + (unsigned)lane * 8u);
                        }
                    }
                    float d[8];
#pragma unroll
                    for (int g = 0; g < 8; ++g) {
                        d[g] = 0.f;
                        if (j0 + g < e1) {
                            const f32x32v f = __builtin_amdgcn_cvt_scalef32_pk32_f32_fp6((u32x6){ua[g][0], ua[g][1], ua[g][2], ua[g][3], ub[g][0], ub[g][1]}, 1.0f);
                            f32x2 d2 = {0.f, 0.f};
#pragma unroll
                            for (int i = 0; i < 16; ++i) d2 = (f32x2){f[2 * i], f[2 * i + 1]} * hf[i] + d2;
                            d[g] = d2.x + d2.y;
                        }
                    }
                    float r4[4];
#pragma unroll
                    for (int i = 0; i < 4; ++i) { const float send = u5 ? d[i] : d[4 + i], keep = u5 ? d[4 + i] : d[i]; r4[i] = keep + __shfl_xor(send, 32); }
                    float r2[2];
#pragma unroll
                    for (int i = 0; i < 2; ++i) { const float send = u4 ? r4[i] : r4[2 + i], keep = u4 ? r4[2 + i] : r4[i]; r2[i] = keep + __shfl_xor(send, 16); }
                    const float send = u3 ? r2[0] : r2[1], keep = u3 ? r2[1] : r2[0];
                    float r1 = keep + __shfl_xor(send, 8);
                    r1 += __shfl_xor(r1, 4); r1 += __shfl_xor(r1, 2); r1 += __shfl_xor(r1, 1);
                    const float act = gelu_tanh(r1 * (1.f / U8_SCALE)) * (1.f / V8_SCALE);
                    const bool inLo = (lane >= j0) && (lane < j0 + 8);
                    const int gsel = inLo ? lane - j0 : lane + 64 - j0;
                    const int src = ((gsel & 4) << 3) | ((gsel & 2) << 3) | ((gsel & 1) << 3);
                    const float got = __shfl(act, src & 63);
                    if (gsel >= 0 && gsel < 8 && j0 + gsel < e1) { if (inLo) wLo = got * wLo; else wHi = got * wHi; }
                }
                sW[lane] = wLo; sW[64 + lane] = wHi;
            }
        }
        asm volatile("s_waitcnt lgkmcnt(0)" ::: "memory");
#pragma unroll 1
        for (int r = 0; r < 4; ++r) {
#pragma unroll 1
            for (int t = 0; t < 4; ++t) {
                const int m = c.gw + (grp * 4 + t) * c.ngw;
                if (m >= M) continue;
                LAS int* sE = (LAS int*)(wl + t * 1024); LAS float* sW = (LAS float*)(wl + t * 1024 + 512);
                LAS u32x4* pk = (LAS u32x4*)(wl + 4096 + t * 4096 + lane * 64);
                const int eLo = sE[lane], eHi = sE[64 + lane]; const float wLo = sW[lane], wHi = sW[64 + lane];
                const unsigned long long mLo = __ballot((eLo >> RSH) == r), mHi = __ballot((eHi >> RSH) == r);
                const int s0 = mLo ? __builtin_ctzll(mLo) : (mHi ? 64 + __builtin_ctzll(mHi) : 0);
                const int e1 = s0 + __builtin_popcountll(mLo) + __builtin_popcountll(mHi);
                f32x2 acc[16];
                if (r == 0) {
#pragma unroll
                    for (int i = 0; i < 16; ++i) acc[i] = (f32x2){0.f, 0.f};
                } else {
#pragma unroll
                    for (int i = 0; i < 4; ++i) { const u32x4 a = pk[i];
#pragma unroll
                        for (int q = 0; q < 4; ++q) acc[4 * i + q] = (f32x2){bflo(a[q]), bfhi(a[q])}; }
                }
#define SV_ISSUE(P, J0) do { _Pragma("unroll") for (int g = 0; g < 8; ++g) { const int pos = (J0) + g; P##w[g] = 0.f; P##a[g] = (u32x4){0u, 0u, 0u, 0u}; P##b[g] = (u32x2){0u, 0u}; \
                        if (pos < e1) { const int e = __builtin_amdgcn_readlane(pos < 64 ? eLo : eHi, pos & 63); \
                            P##w[g] = __builtin_bit_cast(float, __builtin_amdgcn_readlane(__builtin_bit_cast(int, pos < 64 ? wLo : wHi), pos & 63)); \
                            const unsigned char* vr = V + (size_t)e * 1536; P##a[g] = *(const u32x4*)(vr + (unsigned)lane * 16u); P##b[g] = *(const u32x2*)(vr + 1024u + (unsigned)lane * 8u); } } } while (0)
#define SV_COMPUTE(P, J0) do { _Pragma("unroll") for (int g = 0; g < 8; ++g) if ((J0) + g < e1) { const f32x2 w2 = {P##w[g], P##w[g]}; \
                        const f32x32v f = __builtin_amdgcn_cvt_scalef32_pk32_f32_fp6((u32x6){P##a[g][0], P##a[g][1], P##a[g][2], P##a[g][3], P##b[g][0], P##b[g][1]}, 1.0f); \
                        _Pragma("unroll") for (int i = 0; i < 16; ++i) acc[i] = (f32x2){f[2 * i], f[2 * i + 1]} * w2 + acc[i]; } } while (0)
                if (s0 < e1) {
                    u32x4 A_a[8], B_a[8]; u32x2 A_b[8], B_b[8]; float A_w[8], B_w[8];
                    SV_ISSUE(A_, s0);
#pragma unroll 1
                    for (int j0 = s0; j0 < e1; j0 += 16) {
                        if (j0 + 8 < e1) SV_ISSUE(B_, j0 + 8);
                        SV_COMPUTE(A_, j0);
                        if (j0 + 16 < e1) SV_ISSUE(A_, j0 + 16);
                        if (j0 + 8 < e1) SV_COMPUTE(B_, j0 + 8);
                    }
                }
#undef SV_ISSUE
#undef SV_COMPUTE
                if (r < 3) {
#pragma unroll
                    for (int i = 0; i < 4; ++i) pk[i] = (u32x4){pk2(acc[4 * i].x, acc[4 * i].y), pk2(acc[4 * i + 1].x, acc[4 * i + 1].y), pk2(acc[4 * i + 2].x, acc[4 * i + 2].y), pk2(acc[4 * i + 3].x, acc[4 * i + 3].y)};
                } else {
                    const int b = m / SEQ;
                    float* orow = p.out + (size_t)m * D + lane * 32; const float* gt2 = mod + b * 6 * D + 5 * D + lane * 32; const float* fg = p.fng + lane * 32;
                    const bf16_t* x1b = (const bf16_t*)(p.ws + OFF_MERGED) + (size_t)m * D + lane * 32;
                    float ss = 0.f; f32x4 xv[8];
#pragma unroll
                    for (int i = 0; i < 8; ++i) {
                        const f32x4 xa = X1_BF16 ? load_bf16x4(x1b + 4 * i) : *(const f32x4*)(orow + 4 * i), ta = *(const f32x4*)(gt2 + 4 * i);
                        const f32x4 pe = {acc[2 * i].x, acc[2 * i].y, acc[2 * i + 1].x, acc[2 * i + 1].y};
                        const f32x4 v = xa + DBG_BETA * ta * pe; xv[i] = v; ss += (v[0] * v[0] + v[1] * v[1]) + (v[2] * v[2] + v[3] * v[3]);
                    }
                    const float rstd = rsqrtf(wave_sum(ss) * (1.f / D) + EPS);
#pragma unroll
                    for (int i = 0; i < 8; ++i) *(f32x4*)(orow + 4 * i) = xv[i] * rstd * *(const f32x4*)(fg + 4 * i);
                }
            }
        }
        asm volatile("s_waitcnt lgkmcnt(0)" ::: "memory");
    }
}
#ifndef GATHER_SORTED
#define GATHER_SORTED 1
#endif

struct XcdBarrier; DI void xcd_barrier(const XcdBarrier& b, int wave_s);
DI int rl2r(int a, int b, int k) { const int va = __builtin_amdgcn_readlane(a, k & 63), vb = __builtin_amdgcn_readlane(b, k & 63); return k < 64 ? va : vb; }
DI void phase_gather_rounds(const Params& p, const Ctx& c, const XcdBarrier& xbar) {
    const bf16_t* H2 = (const bf16_t*)(p.ws + OFF_H); const unsigned char* U = p.ws + OFF_U16; const unsigned char* V = p.ws + OFF_V16;
    const int* IDX = (const int*)(p.ws + OFF_IDX); const float* GW = (const float*)(p.ws + OFF_GW); const float* mod = (const float*)(p.ws + OFF_MOD);
    const int lane = c.lane;
    LAS unsigned char* wl = c.lds + c.wave * 20480;
    const bool u5 = lane & 32, u4 = lane & 16, u3 = lane & 8;
    constexpr int G = 8;
#pragma unroll 1
    for (int pass = 0; pass < 2; ++pass) {
#pragma unroll
        for (int t = 0; t < 4; ++t) {
            const int m = c.gw + (pass * 4 + t) * c.ngw;
            LAS unsigned char* ts = wl + t * 5120;
            if (m < M) {
#pragma unroll
                for (int i = 0; i < 4; ++i) *(LAS u32x4*)(ts + lane * 64 + i * 16) = *(const u32x4*)(H2 + (size_t)m * D + lane * 32 + i * 8);
                *(LAS int*)(ts + 4096 + lane * 4) = IDX[(size_t)m * 128 + lane]; *(LAS int*)(ts + 4096 + 256 + lane * 4) = IDX[(size_t)m * 128 + 64 + lane];
                *(LAS float*)(ts + 4608 + lane * 4) = GW[(size_t)m * 128 + lane]; *(LAS float*)(ts + 4608 + 256 + lane * 4) = GW[(size_t)m * 128 + 64 + lane];
            }
        }
        asm volatile("s_waitcnt vmcnt(0) lgkmcnt(0)" ::: "memory");
#pragma unroll 1
        for (int r = 0; r < 8; ++r) {
#pragma unroll 1
            for (int t = 0; t < 4; ++t) {
                if (c.gw + (pass * 4 + t) * c.ngw >= M) continue;
                LAS unsigned char* ts = wl + t * 5120;
                const int ia = *(LAS int*)(ts + 4096 + lane * 4), ib = *(LAS int*)(ts + 4096 + 256 + lane * 4);
                unsigned long long ma = __ballot((ia >> 11) == r), mb = __ballot((ib >> 11) == r);
                if (!(ma | mb)) continue;
                f32x2 hf[16];
#pragma unroll
                for (int i = 0; i < 4; ++i) { const u32x4 a = *(LAS u32x4*)(ts + lane * 64 + i * 16);
#pragma unroll
                    for (int q = 0; q < 4; ++q) hf[4 * i + q] = (f32x2){bflo(a[q]), bfhi(a[q])}; }
                float wa = 0.f, wb = 0.f; const unsigned long long ma0 = ma, mb0 = mb;
                while (ma | mb) {
                    u32x4 ua[G]; u32x2 ub[G]; int kk[G]; int n = 0;
#pragma unroll
                    for (int g = 0; g < G; ++g) {
                        int k = (g == 0) ? 0 : kk[g - 1];
                        if (ma) { k = __builtin_ctzll(ma); ma &= ma - 1; ++n; } else if (mb) { k = 64 + __builtin_ctzll(mb); mb &= mb - 1; ++n; }
                        kk[g] = k;
                        const int e = rl2r(ia, ib, k);
                        const unsigned char* ur = U + (size_t)e * 1536;
                        ua[g] = *(const u32x4*)(ur + (unsigned)lane * 16u); ub[g] = *(const u32x2*)(ur + 1024u + (unsigned)lane * 8u);
                    }
                    float d[G];
#pragma unroll
                    for (int g = 0; g < G; ++g) {
                        d[g] = 0.f;
                        if (g < n) {
                            const f32x32v f = __builtin_amdgcn_cvt_scalef32_pk32_f32_fp6((u32x6){ua[g][0], ua[g][1], ua[g][2], ua[g][3], ub[g][0], ub[g][1]}, 1.0f);
                            f32x2 d0 = {0.f, 0.f}, d1 = {0.f, 0.f};
#pragma unroll
                            for (int i = 0; i < 8; ++i) { d0 = (f32x2){f[4 * i], f[4 * i + 1]} * hf[2 * i] + d0; d1 = (f32x2){f[4 * i + 2], f[4 * i + 3]} * hf[2 * i + 1] + d1; }
                            d[g] = (d0.x + d0.y) + (d1.x + d1.y);
                        }
                    }
                    float r4[4];
#pragma unroll
                    for (int i = 0; i < 4; ++i) { const float send = u5 ? d[i] : d[4 + i], keep = u5 ? d[4 + i] : d[i]; r4[i] = keep + __shfl_xor(send, 32); }
                    float r2[2];
#pragma unroll
                    for (int i = 0; i < 2; ++i) { const float send = u4 ? r4[i] : r4[2 + i], keep = u4 ? r4[2 + i] : r4[i]; r2[i] = keep + __shfl_xor(send, 16); }
                    const float send = u3 ? r2[0] : r2[1], keep = u3 ? r2[1] : r2[0];
                    float r1 = keep + __shfl_xor(send, 8);
                    r1 += __shfl_xor(r1, 4); r1 += __shfl_xor(r1, 2); r1 += __shfl_xor(r1, 1);
                    const float act = gelu_tanh(r1 * (1.f / U8_SCALE)) * (1.f / V8_SCALE);
#pragma unroll
                    for (int g = 0; g < G; ++g) if (g < n) {
                        const float av = __builtin_bit_cast(float, __builtin_amdgcn_readlane(__builtin_bit_cast(int, act), ((g & 4) << 3) | ((g & 2) << 3) | ((g & 1) << 3)));
                        const int k = kk[g];
                        if (k < 64) { if (lane == k) wa = av; } else { if (lane == k - 64) wb = av; }
                    }
                }
                if ((ma0 >> lane) & 1ull) { LAS float* gp = (LAS float*)(ts + 4608 + lane * 4); *gp = *gp * wa; }
                if ((mb0 >> lane) & 1ull) { LAS float* gp = (LAS float*)(ts + 4608 + 256 + lane * 4); *gp = *gp * wb; }
            }
            if (DBG_ROUND_BAR) xcd_barrier(xbar, c.wave);
        }
        asm volatile("s_waitcnt lgkmcnt(0)" ::: "memory");
#pragma unroll 1
        for (int t = 0; t < 4; ++t) {
            const int m = c.gw + (pass * 4 + t) * c.ngw;
            if (m >= M) continue;
            const int b = m / SEQ;
            LAS unsigned char* ts = wl + t * 5120;
            const int ia = *(LAS int*)(ts + 4096 + lane * 4), ib = *(LAS int*)(ts + 4096 + 256 + lane * 4);
            const float wa = *(LAS float*)(ts + 4608 + lane * 4), wb = *(LAS float*)(ts + 4608 + 256 + lane * 4);
            f32x2 acc[16];
#pragma unroll
            for (int i = 0; i < 16; ++i) acc[i] = (f32x2){0.f, 0.f};
#pragma unroll 1
            for (int k0 = 0; k0 < 128; k0 += G) {
                u32x4 va[G]; u32x2 vb[G]; float wk[G];
#pragma unroll
                for (int g = 0; g < G; ++g) {
                    const int e = __builtin_amdgcn_readlane(k0 < 64 ? ia : ib, (k0 + g) & 63);
                    wk[g] = __builtin_bit_cast(float, __builtin_amdgcn_readlane(__builtin_bit_cast(int, k0 < 64 ? wa : wb), (k0 + g) & 63));
                    const unsigned char* vr = V + (size_t)e * 1536;
                    va[g] = *(const u32x4*)(vr + (unsigned)lane * 16u); vb[g] = *(const u32x2*)(vr + 1024u + (unsigned)lane * 8u);
                }
#pragma unroll
                for (int g = 0; g < G; ++g) { const f32x2 w2 = {wk[g], wk[g]};
                    const f32x32v f = __builtin_amdgcn_cvt_scalef32_pk32_f32_fp6((u32x6){va[g][0], va[g][1], va[g][2], va[g][3], vb[g][0], vb[g][1]}, 1.0f);
#pragma unroll
                    for (int i = 0; i < 16; ++i) acc[i] = (f32x2){f[2 * i], f[2 * i + 1]} * w2 + acc[i]; }
            }
            float* orow = p.out + (size_t)m * D + lane * 32; const float* gt2 = mod + b * 6 * D + 5 * D + lane * 32; const float* fg = p.fng + lane * 32;
            float ss = 0.f; f32x4 xv[8];
#pragma unroll
            for (int i = 0; i < 8; ++i) {
                const f32x4 xa = *(const f32x4*)(orow + 4 * i), ta = *(const f32x4*)(gt2 + 4 * i);
                const f32x4 pe = {acc[2 * i].x, acc[2 * i].y, acc[2 * i + 1].x, acc[2 * i + 1].y};
                const f32x4 v = xa + DBG_BETA * ta * pe; xv[i] = v; ss += (v[0] * v[0] + v[1] * v[1]) + (v[2] * v[2] + v[3] * v[3]);
            }
            const float rstd = rsqrtf(wave_sum(ss) * (1.f / D) + EPS);
#pragma unroll
            for (int i = 0; i < 8; ++i) *(f32x4*)(orow + 4 * i) = xv[i] * rstd * *(const f32x4*)(fg + 4 * i);
        }
    }
}
#ifndef GATHER_ROUNDS
#define GATHER_ROUNDS 0
#endif

constexpr size_t OFF_WK = OFF_GB + (size_t)32 * 1024 * 1024;
constexpr size_t OFF_SSQ = OFF_GB + (size_t)48 * 1024 * 1024;
constexpr int NPU = 2, NPV = 2;
struct PairPick { int k; bool valid; };
DI PairPick pick_next(unsigned long long& ma, unsigned long long& mb, int prev) {
    PairPick r;
    if (ma) { r.k = __builtin_ctzll(ma); ma &= ma - 1; r.valid = true; }
    else if (mb) { r.k = 64 + __builtin_ctzll(mb); mb &= mb - 1; r.valid = true; }
    else { r.k = prev; r.valid = false; }
    return r;
}
DI int rl2(int a, int b, int k) { const int va = __builtin_amdgcn_readlane(a, k & 63), vb = __builtin_amdgcn_readlane(b, k & 63); return k < 64 ? va : vb; }
DI float rl2f(float a, float b, int k) { return __builtin_bit_cast(float, rl2(__builtin_bit_cast(int, a), __builtin_bit_cast(int, b), k)); }

DI void gather_u(const Params& p, const Ctx& c) {
    const bf16_t* H2 = (const bf16_t*)(p.ws + OFF_H); const unsigned char* U = p.ws + OFF_U16;
    const int* IDX = (const int*)(p.ws + OFF_IDX); const float* GW = (const float*)(p.ws + OFF_GW); float* WK = (float*)(p.ws + OFF_WK);
    const int x = blockIdx.x & 7, jb = blockIdx.x >> 3, nj = ((int)gridDim.x - x + 7) >> 3;
    const int wl = jb * NWAVES + c.wave, nwl = nj * NWAVES;
    constexpr int G = 4, SH = (NPU == 2) ? 10 : 11;
#pragma unroll 1
    for (int ps = 0; ps < NPU; ++ps) {
        const int part = x * NPU + ps;
#pragma unroll 1
        for (int m = wl; m < M; m += nwl) {
            const int ia = IDX[(size_t)m * 128 + c.lane], ib = IDX[(size_t)m * 128 + 64 + c.lane];
            unsigned long long ma = __ballot((ia >> SH) == part), mb = __ballot((ib >> SH) == part);
            if (!(ma | mb)) continue;
            const unsigned long long ma0 = ma, mb0 = mb;
            float hf[2][16];
#pragma unroll
            for (int j = 0; j < 2; ++j) { const u32x4 a = *(const u32x4*)(H2 + (size_t)m * D + j * 1024 + c.lane * 16), bq = *(const u32x4*)(H2 + (size_t)m * D + j * 1024 + c.lane * 16 + 8);
#pragma unroll
                for (int q = 0; q < 4; ++q) { hf[j][2 * q] = bflo(a[q]); hf[j][2 * q + 1] = bfhi(a[q]); hf[j][8 + 2 * q] = bflo(bq[q]); hf[j][8 + 2 * q + 1] = bfhi(bq[q]); } }
            const float ga = GW[(size_t)m * 128 + c.lane], gb = GW[(size_t)m * 128 + 64 + c.lane];
            float wa = 0.f, wb = 0.f;
            int prev = 0;
            while (ma | mb) {
                PairPick pk[G]; u32x4 uu[G][2];
#pragma unroll
                for (int g = 0; g < G; ++g) { pk[g] = pick_next(ma, mb, prev); prev = pk[g].k;
                    const int e = rl2(ia, ib, pk[g].k);
                    const unsigned char* ur = U + (size_t)e * D;
#pragma unroll
                    for (int j = 0; j < 2; ++j) uu[g][j] = *(const u32x4*)(ur + ((unsigned)c.lane * 16u + j * 1024u)); }
                float d[G];
#pragma unroll
                for (int g = 0; g < G; ++g) {
                    float d0 = 0.f, d1 = 0.f;
#pragma unroll
                    for (int j = 0; j < 2; ++j)
#pragma unroll
                        for (int q = 0; q < 4; ++q) { const f32x2 lo = __builtin_amdgcn_cvt_pk_f32_fp8((int)uu[g][j][q], false), hi = __builtin_amdgcn_cvt_pk_f32_fp8((int)uu[g][j][q], true);
                            d0 += lo.x * hf[j][4 * q] + hi.x * hf[j][4 * q + 2]; d1 += lo.y * hf[j][4 * q + 1] + hi.y * hf[j][4 * q + 3]; }
                    d[g] = d0 + d1;
                }
#pragma unroll
                for (int o = 1; o < 64; o <<= 1)
#pragma unroll
                    for (int g = 0; g < G; ++g) d[g] += __shfl_xor(d[g], o);
#pragma unroll
                for (int g = 0; g < G; ++g) if (pk[g].valid) {
                    const float a = gelu_tanh(d[g] * (1.f / U8_SCALE)) * (1.f / V8_SCALE); const int k = pk[g].k;
                    if (k < 64) { if (c.lane == k) wa = a * ga; } else { if (c.lane == k - 64) wb = a * gb; }
                }
            }
            if ((ma0 >> c.lane) & 1ull) WK[(size_t)m * 128 + c.lane] = wa;
            if ((mb0 >> c.lane) & 1ull) WK[(size_t)m * 128 + 64 + c.lane] = wb;
        }
    }
}

DI void gather_v(const Params& p, const Ctx& c) {
    const unsigned char* V = p.ws + OFF_V16;
    const int* IDX = (const int*)(p.ws + OFF_IDX); const float* WK = (const float*)(p.ws + OFF_WK); const float* mod = (const float*)(p.ws + OFF_MOD);
    float* SSQ = (float*)(p.ws + OFF_SSQ);
    const int x = blockIdx.x & 7, jb = blockIdx.x >> 3, nj = ((int)gridDim.x - x + 7) >> 3;
    const int wl = jb * NWAVES + c.wave, nwl = nj * NWAVES;
    const int q4 = c.lane >> 4, l16 = c.lane & 15;
    const unsigned voff = 256u * x + l16 * 16u;
    constexpr int SHV = (NPV == 2) ? 13 : 14;
#pragma unroll 1
    for (int ps = 0; ps < NPV; ++ps) {
#pragma unroll 1
        for (int m = wl; m < M; m += nwl) {
            const int b = m / SEQ;
            const int ia = IDX[(size_t)m * 128 + c.lane], ib = IDX[(size_t)m * 128 + 64 + c.lane];
            const float wa = WK[(size_t)m * 128 + c.lane], wb = WK[(size_t)m * 128 + 64 + c.lane];
            unsigned long long ma = __ballot((ia >> SHV) == ps), mb = __ballot((ib >> SHV) == ps);
            float acc[16];
#pragma unroll
            for (int i = 0; i < 16; ++i) acc[i] = 0.f;
            int prev = 0;
            while (ma | mb) {
                u32x4 vv[4]; float wv[4];
#pragma unroll
                for (int s4 = 0; s4 < 4; ++s4) {
                    int e = 0; float w = 0.f;
#pragma unroll
                    for (int g = 0; g < 4; ++g) { const PairPick pk = pick_next(ma, mb, prev); prev = pk.k;
                        const int eg = rl2(ia, ib, pk.k); const float wg = pk.valid ? rl2f(wa, wb, pk.k) : 0.f;
                        e = (q4 == g) ? eg : e; w = (q4 == g) ? wg : w; }
                    vv[s4] = *(const u32x4*)(V + (size_t)e * D + voff); wv[s4] = w;
                }
#pragma unroll
                for (int s4 = 0; s4 < 4; ++s4)
#pragma unroll
                    for (int q = 0; q < 4; ++q) { const f32x2 lo = __builtin_amdgcn_cvt_pk_f32_fp8((int)vv[s4][q], false), hi = __builtin_amdgcn_cvt_pk_f32_fp8((int)vv[s4][q], true);
                        acc[4 * q] += wv[s4] * lo.x; acc[4 * q + 1] += wv[s4] * lo.y; acc[4 * q + 2] += wv[s4] * hi.x; acc[4 * q + 3] += wv[s4] * hi.y; }
            }
#pragma unroll
            for (int i = 0; i < 16; ++i) { acc[i] += __shfl_xor(acc[i], 16); acc[i] += __shfl_xor(acc[i], 32); }
            f32x4 sel;
#pragma unroll
            for (int e = 0; e < 4; ++e) sel[e] = q4 == 0 ? acc[e] : (q4 == 1 ? acc[4 + e] : (q4 == 2 ? acc[8 + e] : acc[12 + e]));
            const int col = 256 * x + 16 * l16 + 4 * q4;
            float* op = p.out + (size_t)m * D + col;
            const f32x4 val = *(const f32x4*)op + DBG_BETA * *(const f32x4*)(mod + b * 6 * D + 5 * D + col) * sel;
            *(f32x4*)op = val;
            if (ps == NPV - 1) { const float ss = wave_sum(val[0] * val[0] + val[1] * val[1] + val[2] * val[2] + val[3] * val[3]); if (c.lane == 0) SSQ[(size_t)m * 8 + x] = ss; }
        }
    }
}
DI void gather_final(const Params& p, const Ctx& c) {
    const float* SSQ = (const float*)(p.ws + OFF_SSQ);
    for (int m = c.gw; m < M; m += c.ngw) {
        float s = (c.lane < 8) ? SSQ[(size_t)m * 8 + c.lane] : 0.f;
        s += __shfl_xor(s, 1); s += __shfl_xor(s, 2); s += __shfl_xor(s, 4);
        const float rstd = rsqrtf(__shfl(s, 0) * (1.f / D) + EPS);
        float* orow = p.out + (size_t)m * D;
#pragma unroll
        for (int j = 0; j < 8; ++j) { const int col = (j * 64 + c.lane) * 4; *(f32x4*)(orow + col) = *(const f32x4*)(orow + col) * rstd * *(const f32x4*)(p.fng + col); }
    }
}
#ifndef GATHER_L2
#define GATHER_L2 0
#endif

DI void phase_gather_v2(const Params& p, const Ctx& c) {
    const bf16_t* H2 = (const bf16_t*)(p.ws + OFF_H);
    const int* IDX = (const int*)(p.ws + OFF_IDX); const float* GW = (const float*)(p.ws + OFF_GW); const float* mod = (const float*)(p.ws + OFF_MOD);
    LAS float* hs = (LAS float*)c.lds; LAS float* wk = hs + 2048; LAS int* ek = (LAS int*)(wk + 128); LAS float* red = (LAS float*)(ek + 128);
    for (int m = blockIdx.x; m < M; m += gridDim.x) {
        const int b = m / SEQ;
        __syncthreads();
        for (int i = c.tid; i < 2048; i += NTHREADS) hs[i] = bf2f(H2[(size_t)m * D + i]);
        if (c.tid < 128) ek[c.tid] = IDX[(size_t)m * 128 + c.tid];
        __syncthreads();
        for (int k = c.wave; k < 128; k += NWAVES) {
            const float* ur = p.pu + (size_t)ek[k] * D;
            float d = 0.f;
            for (int i = 0; i < 8; ++i) { const int col = i * 256 + c.lane * 4; const f32x4 u = *(const f32x4*)(ur + col);
                d += u[0] * hs[col] + u[1] * hs[col + 1] + u[2] * hs[col + 2] + u[3] * hs[col + 3]; }
            d = wave_sum(d);
            if (c.lane == 0) wk[k] = gelu_tanh(d) * GW[(size_t)m * 128 + k];
        }
        __syncthreads();
        const int col = c.tid * 4;
        f32x4 acc = {0.f, 0.f, 0.f, 0.f};
        for (int k = 0; k < 128; ++k) { const f32x4 v = *(const f32x4*)(p.pv + (size_t)ek[k] * D + col); acc += v * wk[k]; }
        float* orow = p.out + (size_t)m * D;
        const f32x4 x2 = *(const f32x4*)(orow + col) + DBG_BETA * *(const f32x4*)(mod + b * 6 * D + 5 * D + col) * acc;
        float ss = wave_sum(x2[0] * x2[0] + x2[1] * x2[1] + x2[2] * x2[2] + x2[3] * x2[3]);
        if (c.lane == 0) red[c.wave] = ss;
        __syncthreads();
        float tot = 0.f;
        for (int w = 0; w < NWAVES; ++w) tot += red[w];
        const float rstd = rsqrtf(tot * (1.f / D) + EPS);
        *(f32x4*)(orow + col) = x2 * rstd * *(const f32x4*)(p.fng + col);
    }
}


#define XB_TMO      128
#define XB_XCNT(j)  (256  + 64 * (j))
#define XB_XSUB(j)  (1280 + 64 * (j))
#define XB_XGEN(j)  (2304 + 64 * (j))
#define XB_TOP      3328
#define XB_TOPGEN   3392
#define XCD_BAR_WORDS 3456
#define XB_SPIN_CAP (1u << 18)

__device__ __forceinline__ unsigned xb_ld(unsigned* p)              { return __hip_atomic_load(p, __ATOMIC_RELAXED, __HIP_MEMORY_SCOPE_AGENT); }
__device__ __forceinline__ unsigned xb_add(unsigned* p, unsigned v) { return __hip_atomic_fetch_add(p, v, __ATOMIC_RELAXED, __HIP_MEMORY_SCOPE_AGENT); }
__device__ __forceinline__ unsigned xb_xcc_id() { return (unsigned)__builtin_amdgcn_s_getreg((3 << 11) | 20) & 0xFu; }
#define XB_SPIN(cond, bar) do { unsigned _sp = 0; while (cond) { __builtin_amdgcn_s_sleep(1); \
    if ((++_sp & 255u) == 0u) { if (xb_ld(&(bar)[XB_TMO])) break; if (_sp > XB_SPIN_CAP) { atomicAdd(&(bar)[XB_TMO], 1u); break; } } } } while (0)

struct XcdBarrier {
    unsigned* bar; unsigned x;
    volatile LAS unsigned* st;
};

__device__ __forceinline__ XcdBarrier xcd_barrier_post(unsigned* bar, volatile LAS unsigned* st) {
    XcdBarrier b; b.bar = bar; b.x = xb_xcc_id(); b.st = st;
    if (threadIdx.x == 0) (void)xb_add(&bar[XB_XCNT(b.x)], 1u);
    return b;
}
__device__ __forceinline__ void xcd_barrier_complete(unsigned* bar, unsigned x, unsigned& nloc, unsigned& nx) {
    const unsigned G = gridDim.x * gridDim.y * gridDim.z;
    unsigned sum, cnt, mine, sp = 0u;
    for (;;) {
        sum = 0u; cnt = 0u; mine = 0u;
#pragma unroll
        for (unsigned j = 0; j < 16; ++j) { const unsigned c = xb_ld(&bar[XB_XCNT(j)]); sum += c; cnt += (c > 0u) ? 1u : 0u; mine = (j == x) ? c : mine; }
        if (sum == G) break;
        __builtin_amdgcn_s_sleep(1);
        if ((++sp & 255u) == 0u) { if (xb_ld(&bar[XB_TMO])) break; if (sp > XB_SPIN_CAP) { atomicAdd(&bar[XB_TMO], 1u); break; } }
    }
    nloc = mine > 0u ? mine : 1u; nx = cnt > 0u ? cnt : 1u;
}

__device__ __forceinline__ bool xb_lead(int wave_s) { return wave_s == 0 && __builtin_amdgcn_mbcnt_hi(~0u, __builtin_amdgcn_mbcnt_lo(~0u, 0u)) == 0; }
__device__ __forceinline__ void xcd_barrier(const XcdBarrier& b, int wave_s) {
    asm volatile("s_waitcnt vmcnt(0)" ::: "memory");
    __syncthreads();
    if (xb_lead(wave_s)) {
        unsigned* bar = b.bar;
        __builtin_amdgcn_s_waitcnt(0);
        unsigned nloc = b.st[0], nx = b.st[1];
        if (nloc == 0u) { xcd_barrier_complete(bar, b.x, nloc, nx); b.st[0] = nloc; b.st[1] = nx; }
        const unsigned old = xb_add(&bar[XB_XSUB(b.x)], 1u);
        const unsigned gen = old / nloc;
        if (old + 1u == (gen + 1u) * nloc) {
            __builtin_amdgcn_fence(__ATOMIC_RELEASE, "agent");
            asm volatile("s_waitcnt vmcnt(0)" ::: "memory");
            const unsigned og = xb_add(&bar[XB_TOP], 1u);
            const unsigned tg = og / nx;
            if (og + 1u == (tg + 1u) * nx) xb_add(&bar[XB_TOPGEN], 1u);
            else XB_SPIN(xb_ld(&bar[XB_TOPGEN]) == tg, bar);
            __builtin_amdgcn_fence(__ATOMIC_ACQUIRE, "agent");
            xb_add(&bar[XB_XGEN(b.x)], 1u);
            asm volatile("s_waitcnt vmcnt(0)" ::: "memory");
        } else {
            XB_SPIN(xb_ld(&bar[XB_XGEN(b.x)]) == gen, bar);
            __builtin_amdgcn_fence(__ATOMIC_ACQUIRE, "agent");
            asm volatile("s_waitcnt vmcnt(0)" ::: "memory");
        }
    }
    __syncthreads();
}


DI void grid_barrier(unsigned* ctr, unsigned target, int wave_s) {
    asm volatile("s_waitcnt vmcnt(0)" ::: "memory");
    __syncthreads();
    if (wave_s == 0) {
        const int l = __builtin_amdgcn_mbcnt_hi(~0u, __builtin_amdgcn_mbcnt_lo(~0u, 0u));
        if (l == 0) {
            __builtin_amdgcn_fence(__ATOMIC_RELEASE, "agent");
            asm volatile("s_waitcnt vmcnt(0)" ::: "memory");
            __hip_atomic_fetch_add(ctr, 1u, __ATOMIC_RELAXED, __HIP_MEMORY_SCOPE_AGENT);
            unsigned spins = 0;
            while (__hip_atomic_load(ctr, __ATOMIC_RELAXED, __HIP_MEMORY_SCOPE_AGENT) < target) { __builtin_amdgcn_s_sleep(2); if (++spins > (1u << 23)) break; }
            __builtin_amdgcn_fence(__ATOMIC_ACQUIRE, "agent");
            asm volatile("s_waitcnt vmcnt(0)" ::: "memory");
        }
    }
    __syncthreads();
}

__global__ void __launch_bounds__(NTHREADS, 2) mega(Params p) {
    extern __shared__ __attribute__((aligned(16))) unsigned char lds_raw[];
    const int wave_s = __builtin_amdgcn_readfirstlane(threadIdx.x >> 6);
#define MKCTX() Ctx c; { int l_; asm volatile("v_mbcnt_lo_u32_b32 %0, -1, 0\n\tv_mbcnt_hi_u32_b32 %0, -1, %0" : "=v"(l_)); c.lds = (LAS unsigned char*)lds_raw; c.lane = l_; c.wave = wave_s; c.tid = wave_s * 64 + l_; \
    c.gw = blockIdx.x * NWAVES + wave_s; c.ngw = gridDim.x * NWAVES; }
    unsigned char* ws = p.ws;
    const float* mod = (const float*)(ws + OFF_MOD);
    const int lo = p.ph_lo, hi = p.ph_hi;
    XcdBarrier xbar; xbar.bar = (unsigned*)(ws + OFF_XBAR); xbar.x = 0; xbar.st = nullptr;
    if (USE_XBAR && lo == 0 && hi == NPHASE) {
        volatile LAS unsigned* stw = (volatile LAS unsigned*)(lds_raw + LDS_BYTES - 32);
        if (threadIdx.x < 2) stw[threadIdx.x] = 0u;
        __syncthreads();
        xbar = xcd_barrier_post((unsigned*)(ws + OFF_XBAR), stw);
    }
#define IN(k) (lo <= (k) && (k) < hi)
#define SEAM(k) do { if (IN(k) && IN((k) + 1)) { if (USE_XBAR) xcd_barrier(xbar, wave_s); else grid_barrier((unsigned*)(ws + OFF_CTL), (unsigned)((k) + 1) * gridDim.x, wave_s); \
    if (TIME_PHASE >= 0 && blockIdx.x == 0 && threadIdx.x == 0) ((unsigned long long*)(ws + OFF_CTL + 512))[(k) + 1] = __builtin_amdgcn_s_memrealtime(); } } while (0)

    if (TIME_PHASE >= 0 && blockIdx.x == 0 && threadIdx.x == 0) ((unsigned long long*)(ws + OFF_CTL + 512))[0] = __builtin_amdgcn_s_memrealtime();
    if (IN(0)) { MKCTX(); phase_prologue(p, c, true, PRO_SPLIT == 0); }
    SEAM(0);
    if (IN(1)) for (int rep_ = 0; rep_ < (DUP_PHASE == 1 ? 2 : 1); ++rep_) { MKCTX();
        const long long* modi = (const long long*)(ws + OFF_MODI); float* modw = (float*)(ws + OFF_MOD);
        for (int i = blockIdx.x * NTHREADS + c.tid; i < NB * 6 * D; i += gridDim.x * NTHREADS) modw[i] = (float)((double)modi[i] * (1.0 / 4294967296.0));
        modulate_rows<P2_FP8 != 0>(p.x, p.n1g, modi + 1 * D, modi + 0 * D, (bf16_t*)(ws + OFF_H), c);
        if (PRO_SPLIT) phase_prologue(p, c, false, true);
    }
    SEAM(1);
    if (IN(2)) for (int rep_ = 0; rep_ < (DUP_PHASE == 2 ? 2 : 1); ++rep_) { MKCTX();
        EpiProj e1{(bf16_t*)(ws + OFF_CQ), (bf16_t*)(ws + OFF_CKV), (bf16_t*)(ws + OFF_KR), (bf16_t*)(ws + OFF_SBQ), (bf16_t*)(ws + OFF_SBK), (bf16_t*)(ws + OFF_GA), (bf16_t*)(ws + OFF_GB), (const f32x2*)(ws + OFF_CS), P2_FP8 ? 1.f / W8_SCALE : 1.f};
#if P2_FP8
        GEMM8(c, ws + OFF_H, ws + OFF_WIN, M, 7168, 2048, e1);
#else
        GEMM(c, (const bf16_t*)(ws + OFF_H), (const bf16_t*)(ws + OFF_WIN), M, 7168, 2048, e1);
#endif
        if (DUP_GEMM == 20) GEMM(c, (const bf16_t*)(ws + OFF_H), (const bf16_t*)(ws + OFF_WIN), M, 7168, 2048, e1);
        EpiT e2{(bf16_t*)(ws + OFF_SBVT), nullptr, P2_FP8 ? 1.f / W8_SCALE : 1.f};
#if P2_FP8
        GEMM8(c, ws + OFF_WSBV, ws + OFF_H, 1024, M, 2048, e2);
#else
        GEMM(c, (const bf16_t*)(ws + OFF_WSBV), (const bf16_t*)(ws + OFF_H), 1024, M, 2048, e2);
#endif
        if (DUP_GEMM == 21) GEMM(c, (const bf16_t*)(ws + OFF_WSBV), (const bf16_t*)(ws + OFF_H), 1024, M, 2048, e2);
    }
    SEAM(2);
    if (IN(3)) for (int rep_ = 0; rep_ < (DUP_PHASE == 3 ? 2 : 1); ++rep_) { MKCTX(); phase_rowstats(p, c); }
    SEAM(3);
    if (DBG_XTRA_BAR) { for (int q_ = 0; q_ < DBG_XTRA_BAR; ++q_) { if (IN(3) && IN(4)) xcd_barrier(xbar, wave_s); } }
    if (IN(4)) for (int rep_ = 0; rep_ < (DUP_PHASE == 4 ? 2 : 1); ++rep_) { MKCTX();
        EpiUq e1{(bf16_t*)(ws + OFF_Q), (const float*)(ws + OFF_RSTQ), (const f32x2*)(ws + OFF_CS)};
        GEMM(c, (const bf16_t*)(ws + OFF_CQ), (const bf16_t*)(ws + OFF_WUQ), M, 1536, 512, e1);
        if (DUP_GEMM == 40) GEMM(c, (const bf16_t*)(ws + OFF_CQ), (const bf16_t*)(ws + OFF_WUQ), M, 1536, 512, e1);
        EpiRowScale e2{(bf16_t*)(ws + OFF_KN), 1024, (const float*)(ws + OFF_RSTKV)};
        GEMM(c, (const bf16_t*)(ws + OFF_CKV), (const bf16_t*)(ws + OFF_WUK), M, 1024, 256, e2);
        if (DUP_GEMM == 41) GEMM(c, (const bf16_t*)(ws + OFF_CKV), (const bf16_t*)(ws + OFF_WUK), M, 1024, 256, e2);
        EpiT e3{(bf16_t*)(ws + OFF_VT), (const float*)(ws + OFF_RSTKV), 1.f};
        GEMM(c, (const bf16_t*)(ws + OFF_WUV), (const bf16_t*)(ws + OFF_CKV), 1024, M, 256, e3);
        if (DUP_GEMM == 42) GEMM(c, (const bf16_t*)(ws + OFF_WUV), (const bf16_t*)(ws + OFF_CKV), 1024, M, 256, e3);
    }
    SEAM(4);
    if (IN(5)) for (int rep_ = 0; rep_ < (DUP_PHASE == 5 ? 2 : 1); ++rep_) {
#if FAST_ATTN
        { MKCTX(); attn_mla_fast(p, c); }
        if (DUP_GEMM == 51) { MKCTX(); attn_mla_fast(p, c); }
        { MKCTX(); attn_sb_fast(p, c); }
        if (DUP_GEMM == 52) { MKCTX(); attn_sb_fast(p, c); }
#else
        MKCTX();
        attn_mla_naive(p, c); attn_sb_naive(p, c);
#endif
    }
    SEAM(5);
    if (IN(6)) for (int rep_ = 0; rep_ < (DUP_PHASE == 6 ? 2 : 1); ++rep_) { MKCTX();
        EpiGate1 e1{(bf16_t*)(ws + OFF_MERGED), (const bf16_t*)(ws + OFF_GA), P67_FP8 ? 1.f / (W8_SCALE * ACT8_SCALE) : 1.f};
#if P67_FP8
        GEMM8(c, ws + OFF_ATTA, ws + OFF_WA, M, 2048, 1024, e1);
#else
        GEMM(c, (const bf16_t*)(ws + OFF_ATTA), (const bf16_t*)(ws + OFF_WA), M, 2048, 1024, e1);
#endif
        if (DUP_GEMM == 60) GEMM(c, (const bf16_t*)(ws + OFF_ATTA), (const bf16_t*)(ws + OFF_WA), M, 2048, 1024, e1);
        EpiGate2 e2{(bf16_t*)(ws + OFF_MERGED), (const bf16_t*)(ws + OFF_GB), ws + OFF_H, P67_FP8 ? 1.f / (W8_SCALE * ACT8_SCALE) : 1.f};
#if P67_FP8
        GEMM8(c, ws + OFF_ATTB, ws + OFF_WB, M, 2048, 1024, e2);
#else
        GEMM(c, (const bf16_t*)(ws + OFF_ATTB), (const bf16_t*)(ws + OFF_WB), M, 2048, 1024, e2);
#endif
    }
    SEAM(6);
    if (IN(7)) for (int rep_ = 0; rep_ < (DUP_PHASE == 7 ? 2 : 1); ++rep_) { MKCTX();
        EpiRes e{p.x, mod + 2 * D, X1_BF16 ? (float*)(ws + OFF_MERGED) : p.out, P67_FP8 ? 1.f / (W8_SCALE * ACT8_SCALE) : 1.f};
#if P67_FP8
        GEMM8(c, ws + OFF_H, ws + OFF_WOUT, M, 2048, 2048, e);
#else
        GEMM(c, (const bf16_t*)(ws + OFF_MERGED), (const bf16_t*)(ws + OFF_WOUT), M, 2048, 2048, e);
#endif
    }
    SEAM(7);
    if (IN(8)) for (int rep_ = 0; rep_ < (DUP_PHASE == 8 ? 2 : 1); ++rep_) { MKCTX();
        modulate_rows<false, X1_BF16 != 0>(X1_BF16 ? (const float*)(ws + OFF_MERGED) : p.out, p.n2g, mod + 4 * D, mod + 3 * D, (bf16_t*)(ws + OFF_H), c);
        convert_table(p.pu, ws + OFF_U16, U8_SCALE, c);
        convert_table(p.pv, ws + OFF_V16, V8_SCALE, c);
    }
    SEAM(8);
    if (IN(9)) for (int rep_ = 0; rep_ < (DUP_PHASE == 9 ? 2 : 1); ++rep_) { MKCTX();
        EpiPq e{(bf16_t*)(ws + OFF_PQ)};
        GEMM(c, (const bf16_t*)(ws + OFF_H), (const bf16_t*)(ws + OFF_WPQ), M, 2048, 2048, e);
#if FAST_SEL && FAST_GEMM && SEL_FUSED
        { MKCTX(); select_own_tiles(p, c); }
#endif
    }
#if !(FAST_SEL && FAST_GEMM && SEL_FUSED)
    SEAM(9);
    if (IN(10)) for (int rep_ = 0; rep_ < (DUP_PHASE == 10 ? 2 : 1); ++rep_) { MKCTX();
#if FAST_SEL
        select_fast(p, c);
#else
        select_naive(p, c);
#endif
    }
#else
    if (IN(9) && IN(10)) {   }
#endif
    SEAM(10);
#if GATHER_L2
    if (IN(11)) { MKCTX(); gather_u(p, c); }
    SEAM(11);
    if (IN(12)) { MKCTX(); gather_v(p, c); }
    SEAM(12);
    if (IN(13)) { MKCTX(); gather_final(p, c); }
#else
#if GATHER_SORTED
    if (IN(11)) { MKCTX(); phase_gather_sorted(p, c); }
#elif GATHER_ROUNDS
    if (IN(11)) { MKCTX(); phase_gather_rounds(p, c, xbar); }
#else
    if (IN(11)) { if (DUP_GEMM == 110) { MKCTX(); phase_gather(p, c, (float*)(ws + OFF_SBQ)); }
        if (DUP_GEMM == 111) { MKCTX(); phase_gather(p, c, (float*)(ws + OFF_SBQ), 0x3ff); } MKCTX(); phase_gather(p, c, p.out); }
#endif
#endif
#undef IN
#undef SEAM
}

extern "C" void kernel_launch(void* const* d_in, const int* in_sizes, int n_in, void* d_out, int out_size, void* d_ws, size_t ws_size, hipStream_t stream) {
    static int grid = 0;
    if (grid == 0) {
        if (n_in != 20 || out_size != M * D || ws_size < WS_END) { fprintf(stderr, "kernel_launch: unexpected shapes (n_in %d out %d ws %zu need %zu)\n", n_in, out_size, ws_size, (size_t)WS_END); grid = -1; return; }
        int dev = 0, cus = 0, per_cu = 0;
        (void)hipGetDevice(&dev); (void)hipDeviceGetAttribute(&cus, hipDeviceAttributeMultiprocessorCount, dev);
        if (hipFuncSetAttribute((const void*)mega, hipFuncAttributeMaxDynamicSharedMemorySize, LDS_BYTES) != hipSuccess) { fprintf(stderr, "kernel_launch: hipFuncSetAttribute failed\n"); grid = -1; return; }
        if (hipOccupancyMaxActiveBlocksPerMultiprocessor(&per_cu, (const void*)mega, NTHREADS, LDS_BYTES) != hipSuccess || per_cu < 1) { fprintf(stderr, "kernel_launch: occupancy query failed (%d)\n", per_cu); per_cu = 1; }
        (void)hipGetLastError();
        grid = cus;
    }
    if (grid < 0) return;
    (void)hipMemsetAsync((char*)d_ws + OFF_CTL, 0, ZERO_BYTES, stream);
    Params p{};
    p.x = (const float*)d_in[0]; p.c = (const float*)d_in[1]; p.pos = (const int*)d_in[2]; p.ada_w = (const float*)d_in[3]; p.ada_b = (const float*)d_in[4];
    p.n1g = (const float*)d_in[5]; p.n2g = (const float*)d_in[6]; p.w_in = (const float*)d_in[7]; p.qng = (const float*)d_in[8]; p.kvng = (const float*)d_in[9];
    p.w_uq = (const float*)d_in[10]; p.w_ukv = (const float*)d_in[11]; p.w_bm = (const float*)d_in[12]; p.w_bs = (const float*)d_in[13]; p.w_out = (const float*)d_in[14];
    p.w_pq = (const float*)d_in[15]; p.skeys = (const float*)d_in[16]; p.pu = (const float*)d_in[17]; p.pv = (const float*)d_in[18]; p.fng = (const float*)d_in[19];
    p.out = (float*)d_out; p.ws = (unsigned char*)d_ws;
    for (int i = 0; i < 32; ++i) p.invf[i] = (float)pow(10000.0, -(double)i / 32.0);
#if N_LAUNCH_MODE == 1
    p.ph_lo = 0; p.ph_hi = NPHASE;
    void* args[] = {&p};
    hipError_t e = hipLaunchCooperativeKernel((const void*)mega, dim3(grid), dim3(NTHREADS), args, LDS_BYTES, stream);
    if (e != hipSuccess) fprintf(stderr, "cooperative launch failed: %s (grid %d)\n", hipGetErrorString(e), grid);
#else
    for (int k = 0; k < NPHASE; ++k) {
        p.ph_lo = k; p.ph_hi = k + 1;
        hipLaunchKernelGGL(mega, dim3(grid), dim3(NTHREADS), LDS_BYTES, stream, p);
    }
#endif
}
```

```cpp
#include <hip/hip_runtime.h>
#include <hip/hip_cooperative_groups.h>
#include <cstdio>
#include <cstdint>
#include <cmath>
namespace cg = cooperative_groups;

#ifndef N_LAUNCH_MODE
#define N_LAUNCH_MODE 1
#endif

#ifndef TIME_PHASE
#define TIME_PHASE -1
#endif
#ifndef TIME_SCALE
#define TIME_SCALE 5000.f
#endif
#ifndef DUP_GEMM
#define DUP_GEMM -1
#endif
#ifndef PRO_SPLIT
#define PRO_SPLIT 1
#endif
#ifndef USE_XBAR
#define USE_XBAR 1
#endif
#ifndef DBG_XTRA_BAR
#define DBG_XTRA_BAR 0
#endif
#ifndef DBG_ROUND_BAR
#define DBG_ROUND_BAR 0
#endif
#ifndef GATHER_DYN
#define GATHER_DYN 1
#endif
#ifndef SEL_FUSED
#define SEL_FUSED 1
#endif
#ifndef DUP_PHASE
#define DUP_PHASE -1
#endif
#ifndef DBG_ALPHA
#define DBG_ALPHA 1.0f
#endif
#ifndef DBG_BETA
#define DBG_BETA 1.0f
#endif
#define LAS __attribute__((address_space(3)))
#define DI __device__ __forceinline__
typedef unsigned short bf16_t;
typedef short bf16x8 __attribute__((ext_vector_type(8)));
typedef float f32x4 __attribute__((ext_vector_type(4)));
typedef float f32x2 __attribute__((ext_vector_type(2)));
typedef unsigned u32x4 __attribute__((ext_vector_type(4)));
typedef unsigned u32x2 __attribute__((ext_vector_type(2)));
typedef __bf16 bf16v2 __attribute__((ext_vector_type(2)));

constexpr int M = 16384, D = 2048, SEQ = 4096, NB = 4;
constexpr int NTHREADS = 512, NWAVES = 8;
constexpr int LDS_BYTES = 160 * 1024;
constexpr float EPS = 1e-6f;
constexpr float LOG2E = 1.4426950408889634f;
constexpr int NPHASE = 14;

constexpr size_t al256(size_t x) { return (x + 255) & ~(size_t)255; }
constexpr size_t OFF_CTL = 0;
constexpr size_t OFF_XBAR = 4096;
constexpr size_t OFF_MODI = 32768;
constexpr size_t ZERO_BYTES = OFF_MODI + (size_t)NB * 6 * D * 8;
constexpr size_t OFF_MOD = al256(ZERO_BYTES);
constexpr size_t OFF_RSTQ = OFF_MOD + (size_t)NB * 6 * D * 4;
constexpr size_t OFF_RSTKV = OFF_RSTQ + (size_t)M * 4;
constexpr size_t OFF_CS = OFF_RSTKV + (size_t)M * 4;
constexpr size_t OFF_KEYS = OFF_CS + (size_t)M * 32 * 8;
constexpr size_t OFF_WIN = OFF_KEYS + (size_t)8 * 2 * 128 * 128 * 2;
constexpr size_t OFF_WSBV = OFF_WIN + (size_t)7168 * 2048 * 2;
constexpr size_t OFF_WUQ = OFF_WSBV + (size_t)1024 * 2048 * 2;
constexpr size_t OFF_WUK = OFF_WUQ + (size_t)1536 * 512 * 2;
constexpr size_t OFF_WUV = OFF_WUK + (size_t)1024 * 256 * 2;
constexpr size_t OFF_WA = OFF_WUV + (size_t)1024 * 256 * 2;
constexpr size_t OFF_WB = OFF_WA + (size_t)2048 * 1024 * 2;
constexpr size_t OFF_WOUT = OFF_WB + (size_t)2048 * 1024 * 2;
constexpr size_t OFF_WPQ = OFF_WOUT + (size_t)2048 * 2048 * 2;
constexpr size_t OFF_H = OFF_WPQ + (size_t)2048 * 2048 * 2;
constexpr size_t OFF_CQ = OFF_H + (size_t)M * 2048 * 2;
constexpr size_t OFF_CKV = OFF_CQ + (size_t)M * 512 * 2;
constexpr size_t OFF_KR = OFF_CKV + (size_t)M * 256 * 2;
constexpr size_t OFF_SBQ = OFF_KR + (size_t)M * 64 * 2;
constexpr size_t OFF_SBK = OFF_SBQ + (size_t)M * 1024 * 2;
constexpr size_t OFF_SBVT = OFF_SBK + (size_t)M * 1024 * 2;
constexpr size_t OFF_GA = OFF_SBVT + (size_t)M * 1024 * 2;
constexpr size_t OFF_GB = OFF_GA + (size_t)M * 2048 * 2;
constexpr size_t OFF_Q = OFF_GB + (size_t)M * 2048 * 2;
constexpr size_t OFF_KN = OFF_Q + (size_t)M * 1536 * 2;
constexpr size_t OFF_VT = OFF_KN + (size_t)M * 1024 * 2;
constexpr size_t OFF_ATTA = OFF_VT + (size_t)M * 1024 * 2;
constexpr size_t OFF_ATTB = OFF_ATTA + (size_t)M * 1024 * 2;
constexpr size_t WS_END = OFF_ATTB + (size_t)M * 1024 * 2;
constexpr size_t OFF_MERGED = OFF_SBQ;
constexpr size_t OFF_PQ = OFF_GA;
constexpr size_t OFF_IDX = OFF_GB;
constexpr size_t OFF_GW = OFF_GB + (size_t)M * 128 * 4;
constexpr size_t OFF_U16 = WS_END;
constexpr size_t OFF_V16LO = OFF_U16 + (size_t)16384 * 1536;
constexpr size_t OFF_V16HI = OFF_ATTA + (size_t)M * 1024;
constexpr size_t WS_END2 = OFF_V16LO + (size_t)8192 * 1536;
static_assert((size_t)8192 * 1536 <= (size_t)M * 1024, "v table upper half must fit the spare half of ATTA");
static_assert(WS_END2 <= (size_t)625000000, "workspace budget");
DI const unsigned char* vrow(const unsigned char* ws, int e) { return ws + ((e & 8192) ? OFF_V16HI - (size_t)8192 * 1536 : OFF_V16LO) + (size_t)e * 1536; }
constexpr float U8_SCALE = 68.f, V8_SCALE = 1.5f;
static_assert(WS_END < (size_t)620 * 1000 * 1000, "workspace budget");

struct Params {
    const float *x, *c; const int* pos;
    const float *ada_w, *ada_b, *n1g, *n2g, *w_in, *qng, *kvng, *w_uq, *w_ukv, *w_bm, *w_bs, *w_out, *w_pq, *skeys, *pu, *pv, *fng;
    float* out; unsigned char* ws;
    float invf[32];
    int ph_lo, ph_hi;
};

DI unsigned pk2(float lo, float hi) { bf16v2 p; p[0] = (__bf16)lo; p[1] = (__bf16)hi; return __builtin_bit_cast(unsigned, p); }
DI float bflo(unsigned u) { return __uint_as_float(u << 16); }
DI float bfhi(unsigned u) { return __uint_as_float(u & 0xffff0000u); }
DI float dot2bf(unsigned a, unsigned b, float c) { return __builtin_amdgcn_fdot2_f32_bf16(__builtin_bit_cast(bf16v2, a), __builtin_bit_cast(bf16v2, b), c, false); }
DI float bf2f(bf16_t b) { return __uint_as_float(((unsigned)b) << 16); }
DI float wave_sum(float v) {
#pragma unroll
    for (int o = 1; o < 64; o <<= 1) v += __shfl_xor(v, o);
    return v;
}
DI float wave_max(float v) {
#pragma unroll
    for (int o = 1; o < 64; o <<= 1) v = fmaxf(v, __shfl_xor(v, o));
    return v;
}
DI float sigmoidf_(float v) { return __builtin_amdgcn_rcpf(1.f + __expf(-v)); }
DI float gelu_tanh(float v) { const float u = 0.7978845608028654f * (v + 0.044715f * v * v * v); const float e = __expf(2.f * u); const float t = 1.f - 2.f * __builtin_amdgcn_rcpf(e + 1.f); return 0.5f * v * (1.f + t); }
#ifndef P2_FP8
#define P2_FP8 1
#endif
constexpr float W8_SCALE = 64.f;
#ifndef P67_FP8
#define P67_FP8 1
#endif
constexpr float ACT8_SCALE = 16.f;
#ifndef GATE_FP8
#define GATE_FP8 1
#endif
#ifndef GATEA_FP8
#define GATEA_FP8 1
#endif
constexpr float GATE8_SCALE = 256.f;
#ifndef X1_BF16
#define X1_BF16 1
#endif
DI unsigned pk4f8(float a, float b, float c, float d) { int w = __builtin_amdgcn_cvt_pk_fp8_f32(a, b, 0, false); w = __builtin_amdgcn_cvt_pk_fp8_f32(c, d, w, true); return (unsigned)w; }
DI void store_bf16x4(bf16_t* p, f32x4 v) { u32x2 w; w.x = pk2(v[0], v[1]); w.y = pk2(v[2], v[3]); *(u32x2*)p = w; }
DI void store_bf16x8(bf16_t* p, f32x4 a, f32x4 b) { u32x4 w; w.x = pk2(a[0], a[1]); w.y = pk2(a[2], a[3]); w.z = pk2(b[0], b[1]); w.w = pk2(b[2], b[3]); *(u32x4*)p = w; }
DI void load_bf16x8(const bf16_t* p, f32x4& a, f32x4& b) { const u32x4 w = *(const u32x4*)p; a = (f32x4){bflo(w.x), bfhi(w.x), bflo(w.y), bfhi(w.y)}; b = (f32x4){bflo(w.z), bfhi(w.z), bflo(w.w), bfhi(w.w)}; }
DI f32x4 sig4(f32x4 v) { return (f32x4){sigmoidf_(v[0]), sigmoidf_(v[1]), sigmoidf_(v[2]), sigmoidf_(v[3])}; }
DI f32x4 rope4(f32x4 v, f32x2 c0, f32x2 c1) { return (f32x4){v[0] * c0.x - v[1] * c0.y, v[1] * c0.x + v[0] * c0.y, v[2] * c1.x - v[3] * c1.y, v[3] * c1.x + v[2] * c1.y}; }
DI f32x4 load_bf16x4(const bf16_t* p) { const u32x2 w = *(const u32x2*)p; return (f32x4){bflo(w.x), bfhi(w.x), bflo(w.y), bfhi(w.y)}; }

struct Ctx {
    LAS unsigned char* lds;
    int tid, lane, wave, gw, ngw;
};

struct MapWin { DI int operator()(int n) const {
    if (n < 768) return n;
    if (n < 1024) { const int j = n - 768; if (j >= 64) return -1; return 768 + (j >> 1) + 32 * (j & 1); }
    if (n < 2048) return 832 + (n - 1024);
    if (n < 3072) return 1856 + (n - 2048);
    if (n < 5120) return 3904 + (n - 3072);
    return 5952 + (n - 5120); } };
struct MapOff { int off; DI int operator()(int n) const { return n + off; } };
struct MapUq { DI int operator()(int n) const { const int hd = n / 192, j = n % 192; if (j < 128) return hd * 192 + j; const int jj = j - 128; return hd * 192 + 128 + (jj >> 1) + 32 * (jj & 1); } };
struct MapUk { DI int operator()(int n) const { return (n >> 7) * 256 + (n & 127); } };
struct MapUv { DI int operator()(int n) const { return (n >> 7) * 256 + 128 + (n & 127); } };

template <bool F8 = false, class Map>
DI void transpose_item(const float* W, int K, int N, const Map& mp, const float* rowscale, bf16_t* dst, int kb, int nb, LAS float* scr, int lane) {
    const int k0 = kb * 64, sc = mp(nb * 64 + lane), scc = sc >= 0 ? sc : 0;
    const float rsv = rowscale ? rowscale[k0 + lane] : 1.f;
#pragma unroll 32
    for (int kk = 0; kk < 64; ++kk) {
        float v = W[(size_t)(k0 + kk) * N + scc];
        v = sc >= 0 ? v : 0.f;
        v *= __builtin_bit_cast(float, __builtin_amdgcn_readlane(__builtin_bit_cast(int, rsv), kk));
        scr[kk * 65 + lane] = v;
    }
    asm volatile("s_waitcnt lgkmcnt(0)" ::: "memory");
    const int kc = lane & 7;
#pragma unroll
    for (int j = 0; j < 8; ++j) {
        const int nrow = (lane >> 3) + 8 * j; const LAS float* s = scr + (8 * kc) * 65 + nrow;
        if constexpr (F8) { u32x2 o; o.x = pk4f8(s[0] * W8_SCALE, s[65] * W8_SCALE, s[2 * 65] * W8_SCALE, s[3 * 65] * W8_SCALE); o.y = pk4f8(s[4 * 65] * W8_SCALE, s[5 * 65] * W8_SCALE, s[6 * 65] * W8_SCALE, s[7 * 65] * W8_SCALE);
            *(u32x2*)((unsigned char*)dst + (size_t)(nb * 64 + nrow) * K + k0 + 8 * kc) = o; }
        else {
        u32x4 o; o.x = pk2(s[0], s[65]); o.y = pk2(s[2 * 65], s[3 * 65]); o.z = pk2(s[4 * 65], s[5 * 65]); o.w = pk2(s[6 * 65], s[7 * 65]);
        *(u32x4*)(dst + (size_t)(nb * 64 + nrow) * K + k0 + 8 * kc) = o; }
    }
    asm volatile("s_waitcnt lgkmcnt(0)" ::: "memory");
}

DI void phase_prologue(const Params& p, const Ctx& c, bool do_ada = true, bool do_rest = true) {
    unsigned char* ws = p.ws;
    LAS float* scr = (LAS float*)(c.lds + c.wave * 16640);
    unsigned long long* modi = (unsigned long long*)(ws + OFF_MODI);
    if (do_ada) for (int u = c.gw; u < 32 * 48; u += c.ngw) {
        const int kp = u / 48, ch = u % 48, k0 = kp * 64, c0 = ch * 256 + c.lane * 4;
        float sl[4];
#pragma unroll
        for (int b = 0; b < 4; ++b) { const float cv = p.c[b * D + k0 + c.lane]; sl[b] = cv / (1.f + __expf(-cv)); }
        f32x4 acc[4];
#pragma unroll
        for (int b = 0; b < 4; ++b) acc[b] = (f32x4){0.f, 0.f, 0.f, 0.f};
#pragma unroll 16
        for (int kk = 0; kk < 64; ++kk) {
            const f32x4 w = *(const f32x4*)(p.ada_w + (size_t)(k0 + kk) * (6 * D) + c0);
#pragma unroll
            for (int b = 0; b < 4; ++b) { const float s = __shfl(sl[b], kk); acc[b] += w * s; }
        }
        if (kp == 0) { const f32x4 bv = *(const f32x4*)(p.ada_b + c0);
#pragma unroll
            for (int b = 0; b < 4; ++b) acc[b] += bv; }
#pragma unroll
        for (int b = 0; b < 4; ++b)
#pragma unroll
            for (int e = 0; e < 4; ++e) atomicAdd(modi + b * 6 * D + c0 + e, (unsigned long long)(long long)__builtin_rint((double)acc[b][e] * 4294967296.0));
    }
    if (!do_rest) return;
    constexpr int I_WIN = 112 * 32, I_SBV = 16 * 32, I_UQ = 24 * 8, I_UK = 16 * 4, I_UV = 16 * 4, I_A = 32 * 16, I_B = 32 * 16, I_OUT = 32 * 32, I_PQ = 32 * 32;
    constexpr int NIT = I_WIN + I_SBV + I_UQ + I_UK + I_UV + I_A + I_B + I_OUT + I_PQ;
    for (int it = c.gw; it < NIT; it += c.ngw) {
        int r = it;
        if (r < I_WIN) { transpose_item<P2_FP8 != 0>(p.w_in, 2048, 8000, MapWin{}, nullptr, (bf16_t*)(ws + OFF_WIN), r % 32, r / 32, scr, c.lane); continue; } r -= I_WIN;
        if (r < I_SBV) { transpose_item<P2_FP8 != 0>(p.w_in, 2048, 8000, MapOff{2880}, nullptr, (bf16_t*)(ws + OFF_WSBV), r % 32, r / 32, scr, c.lane); continue; } r -= I_SBV;
        if (r < I_UQ) { transpose_item(p.w_uq, 512, 1536, MapUq{}, p.qng, (bf16_t*)(ws + OFF_WUQ), r % 8, r / 8, scr, c.lane); continue; } r -= I_UQ;
        if (r < I_UK) { transpose_item(p.w_ukv, 256, 2048, MapUk{}, p.kvng, (bf16_t*)(ws + OFF_WUK), r % 4, r / 4, scr, c.lane); continue; } r -= I_UK;
        if (r < I_UV) { transpose_item(p.w_ukv, 256, 2048, MapUv{}, p.kvng, (bf16_t*)(ws + OFF_WUV), r % 4, r / 4, scr, c.lane); continue; } r -= I_UV;
        if (r < I_A) { transpose_item<P67_FP8 != 0>(p.w_bm, 1024, 2048, MapOff{0}, nullptr, (bf16_t*)(ws + OFF_WA), r % 16, r / 16, scr, c.lane); continue; } r -= I_A;
        if (r < I_B) { transpose_item<P67_FP8 != 0>(p.w_bs, 1024, 2048, MapOff{0}, nullptr, (bf16_t*)(ws + OFF_WB), r % 16, r / 16, scr, c.lane); continue; } r -= I_B;
        if (r < I_OUT) { transpose_item<P67_FP8 != 0>(p.w_out, 2048, 2048, MapOff{0}, nullptr, (bf16_t*)(ws + OFF_WOUT), r % 32, r / 32, scr, c.lane); continue; } r -= I_OUT;
        transpose_item(p.w_pq, 2048, 2048, MapOff{0}, nullptr, (bf16_t*)(ws + OFF_WPQ), r % 32, r / 32, scr, c.lane);
    }
    { bf16_t* kd = (bf16_t*)(ws + OFF_KEYS);
      for (int i = (c.gw * 64 + c.lane) * 4; i < 8 * 2 * 128 * 128; i += c.ngw * 64 * 4) store_bf16x4(kd + i, *(const f32x4*)(p.skeys + i)); }
    { f32x2* cs = (f32x2*)(ws + OFF_CS);
      for (int i = c.gw * 64 + c.lane; i < M * 32; i += c.ngw * 64) {
          const int m = i >> 5, f = i & 31;
          const float ang = (float)p.pos[m] * p.invf[f];
          const double rev = (double)ang * 0.15915494309189533576888;
          const float fr = (float)(rev - __builtin_rint(rev));
          cs[i] = (f32x2){__builtin_amdgcn_cosf(fr), __builtin_amdgcn_sinf(fr)};
      } }
}

DI f32x4 ld_mod4(const float* p) { return *(const f32x4*)p; }
DI f32x4 ld_mod4(const long long* p) { f32x4 r;
    const u32x4 a = *(const u32x4*)p, b = *(const u32x4*)(p + 2);
    r[0] = (float)(int)a.y + (float)a.x * (1.f / 4294967296.f); r[1] = (float)(int)a.w + (float)a.z * (1.f / 4294967296.f);
    r[2] = (float)(int)b.y + (float)b.x * (1.f / 4294967296.f); r[3] = (float)(int)b.w + (float)b.z * (1.f / 4294967296.f);
    return r; }
template <bool F8 = false, bool SRC16 = false, class MT>
DI void modulate_rows(const float* src, const float* g, const MT* sc, const MT* sh, bf16_t* dst, const Ctx& c) {
    const int rpw = (M + c.ngw - 1) / c.ngw, m0 = c.gw * rpw, m1 = (m0 + rpw < M) ? m0 + rpw : M;
    f32x4 ga[8], hb[8]; int bcur = -1;
    for (int m = m0; m < m1; ++m) {
        const int b = m / SEQ;
        if (b != bcur) { bcur = b;
#pragma unroll
            for (int j = 0; j < 8; ++j) { const int col = (j * 64 + c.lane) * 4; ga[j] = *(const f32x4*)(g + col) * (ld_mod4(sc + b * 6 * D + col) + 1.f); hb[j] = ld_mod4(sh + b * 6 * D + col); } }
        const float* xr = src + (size_t)m * D;
        f32x4 v[8]; float ss = 0.f;
#pragma unroll
        for (int j = 0; j < 8; ++j) { if constexpr (SRC16) v[j] = load_bf16x4((const bf16_t*)src + (size_t)m * D + (j * 64 + c.lane) * 4); else v[j] = *(const f32x4*)(xr + (j * 64 + c.lane) * 4); ss += v[j][0] * v[j][0] + v[j][1] * v[j][1] + v[j][2] * v[j][2] + v[j][3] * v[j][3]; }
        const float rstd = rsqrtf(wave_sum(ss) * (1.f / D) + EPS);
#pragma unroll
        for (int j = 0; j < 8; ++j) {
            const int col = (j * 64 + c.lane) * 4;
            const f32x4 o = v[j] * rstd * ga[j] + hb[j];
            if constexpr (F8) *(unsigned*)((unsigned char*)dst + (size_t)m * D + col) = pk4f8(o[0], o[1], o[2], o[3]);
            else store_bf16x4(dst + (size_t)m * D + col, o);
        }
    }
}
DI void phase_rowstats(const Params& p, const Ctx& c) {
    const bf16_t* cq = (const bf16_t*)(p.ws + OFF_CQ); const bf16_t* ckv = (const bf16_t*)(p.ws + OFF_CKV);
    float* rq = (float*)(p.ws + OFF_RSTQ); float* rkv = (float*)(p.ws + OFF_RSTKV);
    for (int m0 = c.gw; m0 < M; m0 += 8 * c.ngw) {
        u32x4 a[8]; u32x2 b[8];
#pragma unroll
        for (int k = 0; k < 8; ++k) { const int m = m0 + k * c.ngw < M ? m0 + k * c.ngw : m0; a[k] = *(const u32x4*)(cq + (size_t)m * 512 + c.lane * 8); b[k] = *(const u32x2*)(ckv + (size_t)m * 256 + c.lane * 4); }
#pragma unroll
        for (int k = 0; k < 8; ++k) {
            const int m = m0 + k * c.ngw;
            float s1 = 0.f, s2 = 0.f;
#pragma unroll
            for (int e = 0; e < 4; ++e) { const float lo = bflo(a[k][e]), hi = bfhi(a[k][e]); s1 += lo * lo + hi * hi; }
#pragma unroll
            for (int e = 0; e < 2; ++e) { const float lo = bflo(b[k][e]), hi = bfhi(b[k][e]); s2 += lo * lo + hi * hi; }
            s1 = wave_sum(s1); s2 = wave_sum(s2);
            if (c.lane == 0 && m < M) { rq[m] = rsqrtf(s1 * (1.f / 512.f) + EPS); rkv[m] = rsqrtf(s2 * (1.f / 256.f) + EPS); }
        }
    }
}
typedef float f32x16v __attribute__((ext_vector_type(16)));
typedef float f32x32v __attribute__((ext_vector_type(32)));
typedef unsigned u32x6 __attribute__((ext_vector_type(6)));
#ifndef FP6_ORDER
#define FP6_ORDER 1
#endif
#ifndef COL_COALESCED
#define COL_COALESCED 1
#endif
DI void convert_table(const float* src, unsigned char* dst, float scale, const Ctx& c) {
    const size_t ngroups = (size_t)16384 * 64;
    for (size_t gi = (size_t)c.gw * 64 + c.lane; gi < ngroups; gi += (size_t)c.ngw * 64) {
        const size_t row = gi >> 6; const int l = (int)(gi & 63);
        const float* sp = src + row * 2048 + l * 32;
        f32x4 v[8];
#pragma unroll
        for (int i = 0; i < 8; ++i) v[i] = (COL_COALESCED ? *(const f32x4*)(src + row * 2048 + 256 * i + 4 * l) : *(const f32x4*)(sp + 4 * i)) * scale;
        f32x16v a, b;
#pragma unroll
        for (int e = 0; e < 16; ++e) {
#if FP6_ORDER == 0
            a[e] = v[e >> 2][e & 3]; b[e] = v[4 + (e >> 2)][e & 3];
#else
            a[e] = v[(2 * e) >> 2][(2 * e) & 3]; b[e] = v[(2 * e + 1) >> 2][(2 * e + 1) & 3];
#endif
        }
        const u32x6 pk = __builtin_amdgcn_cvt_scalef32_2xpk16_fp6_f32(a, b, 1.0f);
        unsigned char* dp = dst + row * 1536;
        *(u32x4*)(dp + 16 * l) = (u32x4){pk[0], pk[1], pk[2], pk[3]};
        *(u32x2*)(dp + 1024 + 8 * l) = (u32x2){pk[4], pk[5]};
    }
}

#ifndef BAR_FILL
#define BAR_FILL 1
#endif
constexpr int FILL_ROWS = 128;
DI void convert_row(const Params& p, int g, int l) {
    const bool isv = g >= 16384; const size_t row = (size_t)(g & 16383);
    const float* src = isv ? p.pv : p.pu; const float scale = isv ? V8_SCALE : U8_SCALE;
    f32x4 v[8];
#pragma unroll
    for (int i = 0; i < 8; ++i) v[i] = (COL_COALESCED ? *(const f32x4*)(src + row * 2048 + 256 * i + 4 * l) : *(const f32x4*)(src + row * 2048 + l * 32 + 4 * i)) * scale;
    f32x16v a, b;
#pragma unroll
    for (int e = 0; e < 16; ++e) {
#if FP6_ORDER == 0
        a[e] = v[e >> 2][e & 3]; b[e] = v[4 + (e >> 2)][e & 3];
#else
        a[e] = v[(2 * e) >> 2][(2 * e) & 3]; b[e] = v[(2 * e + 1) >> 2][(2 * e + 1) & 3];
#endif
    }
    const u32x6 pk = __builtin_amdgcn_cvt_scalef32_2xpk16_fp6_f32(a, b, 1.0f);
    unsigned char* dp = isv ? (unsigned char*)vrow(p.ws, (int)row) : p.ws + OFF_U16 + row * 1536;
    *(u32x4*)(dp + 16 * l) = (u32x4){pk[0], pk[1], pk[2], pk[3]};
    *(u32x2*)(dp + 1024 + 8 * l) = (u32x2){pk[4], pk[5]};
}

#ifndef FRAG_ORDER
#define FRAG_ORDER 1
#endif
DI size_t frag_grp(int row, int col) {
    const int rr = row & 255, cc = col & 255;
    const int wave = ((rr >> 6) & 1) * 4 + ((cc >> 5) & 3), ai = rr >> 7, m = (rr >> 4) & 3, bj = cc >> 7, ln = ((cc >> 3) & 3) * 16 + (rr & 15);
    return (size_t)((row >> 8) * 8 + (col >> 8)) * 8192 + (size_t)((((wave * 2 + ai) * 4 + m) * 2 + bj) * 64 + ln);
}
struct EpiProj {
    bf16_t *cq, *ckv, *kr, *sbq, *sbk, *ga, *gb; const f32x2* cs; float osc;
    DI void operator()(int row, int col, f32x4 v) const {
        const int tile = col >> 8; v = v * osc;
        if (tile < 2) { store_bf16x4(cq + (size_t)row * 512 + col, v); }
        else if (tile == 2) { store_bf16x4(ckv + (size_t)row * 256 + (col - 512), v); }
        else if (tile == 3) { const int j = col - 768; if (j < 64) { const f32x2 c0 = cs[row * 32 + (j >> 1)], c1 = cs[row * 32 + (j >> 1) + 1];
            const f32x4 o = {v[0] * c0.x - v[1] * c0.y, v[1] * c0.x + v[0] * c0.y, v[2] * c1.x - v[3] * c1.y, v[3] * c1.x + v[2] * c1.y};
            store_bf16x4(kr + (size_t)row * 64 + j, o); } }
        else if (tile < 8) { store_bf16x4(sbq + (size_t)row * 1024 + (col - 1024), v * (0.08838834764831845f * LOG2E)); }
        else if (tile < 12) { store_bf16x4(sbk + (size_t)row * 1024 + (col - 2048), v); }
        else if (tile < 20) { store_bf16x4(ga + (size_t)row * 2048 + (col - 3072), (f32x4){sigmoidf_(v[0]), sigmoidf_(v[1]), sigmoidf_(v[2]), sigmoidf_(v[3])}); }
        else { store_bf16x4(gb + (size_t)row * 2048 + (col - 5120), (f32x4){sigmoidf_(v[0]), sigmoidf_(v[1]), sigmoidf_(v[2]), sigmoidf_(v[3])}); }
    }    DI void operator()(int row, int col, f32x4 v0, f32x4 v1) const {
        const int tile = col >> 8; v0 = v0 * osc; v1 = v1 * osc;
        if (tile < 2) { store_bf16x8(cq + (size_t)row * 512 + col, v0, v1); }
        else if (tile == 2) { store_bf16x8(ckv + (size_t)row * 256 + (col - 512), v0, v1); }
        else if (tile == 3) { const int j = col - 768; if (j < 64) { const f32x2* cp = cs + row * 32 + (j >> 1);
            store_bf16x8(kr + (size_t)row * 64 + j, rope4(v0, cp[0], cp[1]), rope4(v1, cp[2], cp[3])); } }
        else if (tile < 8) { const float sc = 0.08838834764831845f * LOG2E; store_bf16x8(sbq + (size_t)row * 1024 + (col - 1024), v0 * sc, v1 * sc); }
        else if (tile < 12) { store_bf16x8(sbk + (size_t)row * 1024 + (col - 2048), v0, v1); }
#if GATE_FP8
        else if (!GATEA_FP8 && tile < 20) { store_bf16x8(ga + (size_t)row * 2048 + (col - 3072), sig4(v0), sig4(v1)); }
        else { const f32x4 s0 = sig4(v0) * GATE8_SCALE, s1 = sig4(v1) * GATE8_SCALE; const int gc = tile < 20 ? col - 3072 : col - 5120; unsigned char* gp = (unsigned char*)(tile < 20 ? ga : gb) + (FRAG_ORDER ? frag_grp(row, gc) * 8 : (size_t)row * 2048 + gc);
            *(u32x2*)gp = (u32x2){pk4f8(s0[0], s0[1], s0[2], s0[3]), pk4f8(s1[0], s1[1], s1[2], s1[3])}; }
#else
        else if (tile < 20) { store_bf16x8(ga + (size_t)row * 2048 + (col - 3072), sig4(v0), sig4(v1)); }
        else { store_bf16x8(gb + (size_t)row * 2048 + (col - 5120), sig4(v0), sig4(v1)); }
#endif
    }
};
struct EpiT { bf16_t* o; const float* cscale; float osc;
    static constexpr int MB = 2; struct Pre { f32x4 a, b; };
    DI Pre load(int row, int col) const { Pre q; q.a = q.b = (f32x4){osc, osc, osc, osc}; if (cscale) { q.a = *(const f32x4*)(cscale + col) * osc; q.b = *(const f32x4*)(cscale + col + 4) * osc; } return q; }
    DI void apply(int row, int col, f32x4 v0, f32x4 v1, const Pre& q) const { store_bf16x8(o + (size_t)row * M + col, v0 * q.a, v1 * q.b); }
    DI void operator()(int row, int col, f32x4 v) const { if (cscale) v = v * *(const f32x4*)(cscale + col); store_bf16x4(o + (size_t)row * M + col, v); }
    DI void operator()(int row, int col, f32x4 v0, f32x4 v1) const { if (cscale) { v0 = v0 * *(const f32x4*)(cscale + col); v1 = v1 * *(const f32x4*)(cscale + col + 4); } store_bf16x8(o + (size_t)row * M + col, v0, v1); } };
struct EpiUq { bf16_t* q; const float* rst; const f32x2* cs;
    static constexpr int MB = 2; struct Pre { float sc; f32x2 c0, c1, c2, c3; };
    DI Pre load(int row, int col) const { Pre w; w.sc = rst[row]; w.c0 = w.c1 = w.c2 = w.c3 = (f32x2){0.f, 0.f}; const int j = col % 192;
        if (j >= 128) { const f32x2* cp = cs + row * 32 + ((j - 128) >> 1); w.c0 = cp[0]; w.c1 = cp[1]; w.c2 = cp[2]; w.c3 = cp[3]; } return w; }
    DI void apply(int row, int col, f32x4 v0, f32x4 v1, const Pre& w) const {
        const float sc = w.sc * (0.07216878364870322f * LOG2E); v0 = v0 * sc; v1 = v1 * sc;
        if (col % 192 >= 128) { v0 = rope4(v0, w.c0, w.c1); v1 = rope4(v1, w.c2, w.c3); }
        store_bf16x8(q + (size_t)row * 1536 + col, v0, v1); }
    DI void operator()(int row, int col, f32x4 v) const {
        v = v * (rst[row] * (0.07216878364870322f * LOG2E));
        const int j = col % 192;
        if (j >= 128) { const int i0 = (j - 128) >> 1; const f32x2 c0 = cs[row * 32 + i0], c1 = cs[row * 32 + i0 + 1];
            v = (f32x4){v[0] * c0.x - v[1] * c0.y, v[1] * c0.x + v[0] * c0.y, v[2] * c1.x - v[3] * c1.y, v[3] * c1.x + v[2] * c1.y}; }
        store_bf16x4(q + (size_t)row * 1536 + col, v);
    }
    DI void operator()(int row, int col, f32x4 v0, f32x4 v1) const {
        const float sc = rst[row] * (0.07216878364870322f * LOG2E); v0 = v0 * sc; v1 = v1 * sc;
        const int j = col % 192;
        if (j >= 128) { const f32x2* cp = cs + row * 32 + ((j - 128) >> 1); v0 = rope4(v0, cp[0], cp[1]); v1 = rope4(v1, cp[2], cp[3]); }
        store_bf16x8(q + (size_t)row * 1536 + col, v0, v1);
    } };
struct EpiRowScale { bf16_t* o; int ld; const float* rst;
    static constexpr int MB = 4; typedef float Pre;
    DI Pre load(int row, int col) const { return rst[row]; }
    DI void apply(int row, int col, f32x4 v0, f32x4 v1, const Pre& sc) const { store_bf16x8(o + (size_t)row * ld + col, v0 * sc, v1 * sc); }
    DI void operator()(int row, int col, f32x4 v) const { store_bf16x4(o + (size_t)row * ld + col, v * rst[row]); }
    DI void operator()(int row, int col, f32x4 v0, f32x4 v1) const { const float sc = rst[row]; store_bf16x8(o + (size_t)row * ld + col, v0 * sc, v1 * sc); } };
struct EpiGate1 { bf16_t* mg; const bf16_t* g; float osc;
#if GATEA_FP8
    static constexpr int MB = 2; typedef u32x2 Pre;
    DI Pre load(int row, int col) const { return *(const u32x2*)((const unsigned char*)g + (FRAG_ORDER ? frag_grp(row, col) * 8 : (size_t)row * 2048 + col)); }
#else
    static constexpr int MB = 2; typedef u32x4 Pre;
    DI Pre load(int row, int col) const { return *(const u32x4*)(g + (size_t)row * 2048 + col); }
#endif
    DI void apply(int row, int col, f32x4 v0, f32x4 v1, const Pre& w) const { const size_t i = (size_t)row * 2048 + col;
#if GATEA_FP8
        const f32x4 g0 = {__builtin_amdgcn_cvt_f32_fp8((int)w.x, 0), __builtin_amdgcn_cvt_f32_fp8((int)w.x, 1), __builtin_amdgcn_cvt_f32_fp8((int)w.x, 2), __builtin_amdgcn_cvt_f32_fp8((int)w.x, 3)};
        const f32x4 g1 = {__builtin_amdgcn_cvt_f32_fp8((int)w.y, 0), __builtin_amdgcn_cvt_f32_fp8((int)w.y, 1), __builtin_amdgcn_cvt_f32_fp8((int)w.y, 2), __builtin_amdgcn_cvt_f32_fp8((int)w.y, 3)};
        const float os = osc * (1.f / GATE8_SCALE);
#else
        const f32x4 g0 = {bflo(w.x), bfhi(w.x), bflo(w.y), bfhi(w.y)}, g1 = {bflo(w.z), bfhi(w.z), bflo(w.w), bfhi(w.w)}; const float os = osc;
#endif
        store_bf16x8(FRAG_ORDER && GATEA_FP8 && GATE_FP8 ? mg + frag_grp(row, col) * 8 : mg + i, v0 * os * g0, v1 * os * g1); }
    DI void operator()(int row, int col, f32x4 v) const { const size_t i = (size_t)row * 2048 + col; store_bf16x4(mg + i, v * load_bf16x4(g + i)); }
    DI void operator()(int row, int col, f32x4 v0, f32x4 v1) const { const size_t i = (size_t)row * 2048 + col; f32x4 g0, g1; load_bf16x8(g + i, g0, g1); store_bf16x8(mg + i, v0 * g0, v1 * g1); } };
struct EpiGate2 { bf16_t* mg; const bf16_t* g; unsigned char* m8; float osc;
    static constexpr int MB = 2;
#if GATE_FP8
    struct Pre { u32x4 m; u32x2 g; };
#else
    struct Pre { u32x4 g, m; };
#endif
#if GATE_FP8
    DI Pre load(int row, int col) const { const size_t i = (size_t)row * 2048 + col; Pre q;
        if (FRAG_ORDER && GATEA_FP8) { const size_t fg = frag_grp(row, col); q.g = *(const u32x2*)((const unsigned char*)g + fg * 8); q.m = *(const u32x4*)(mg + fg * 8); }
        else { q.g = *(const u32x2*)((const unsigned char*)g + i); q.m = *(const u32x4*)(mg + i); } return q; }
#else
    DI Pre load(int row, int col) const { const size_t i = (size_t)row * 2048 + col; Pre q; q.g = *(const u32x4*)(g + i); q.m = *(const u32x4*)(mg + i); return q; }
#endif
    DI void apply(int row, int col, f32x4 v0, f32x4 v1, const Pre& q) const { const size_t i = (size_t)row * 2048 + col;
#if GATE_FP8
        const f32x4 g0 = {__builtin_amdgcn_cvt_f32_fp8((int)q.g.x, 0), __builtin_amdgcn_cvt_f32_fp8((int)q.g.x, 1), __builtin_amdgcn_cvt_f32_fp8((int)q.g.x, 2), __builtin_amdgcn_cvt_f32_fp8((int)q.g.x, 3)};
        const f32x4 g1 = {__builtin_amdgcn_cvt_f32_fp8((int)q.g.y, 0), __builtin_amdgcn_cvt_f32_fp8((int)q.g.y, 1), __builtin_amdgcn_cvt_f32_fp8((int)q.g.y, 2), __builtin_amdgcn_cvt_f32_fp8((int)q.g.y, 3)};
        const float osc = this->osc * (1.f / GATE8_SCALE);
#else
        const f32x4 g0 = {bflo(q.g.x), bfhi(q.g.x), bflo(q.g.y), bfhi(q.g.y)}, g1 = {bflo(q.g.z), bfhi(q.g.z), bflo(q.g.w), bfhi(q.g.w)};
#endif
        const f32x4 m0 = {bflo(q.m.x), bfhi(q.m.x), bflo(q.m.y), bfhi(q.m.y)}, m1 = {bflo(q.m.z), bfhi(q.m.z), bflo(q.m.w), bfhi(q.m.w)};
        const f32x4 r0 = m0 + v0 * osc * g0, r1 = m1 + v1 * osc * g1;
        if (P67_FP8) *(u32x2*)(m8 + i) = (u32x2){pk4f8(r0[0] * ACT8_SCALE, r0[1] * ACT8_SCALE, r0[2] * ACT8_SCALE, r0[3] * ACT8_SCALE), pk4f8(r1[0] * ACT8_SCALE, r1[1] * ACT8_SCALE, r1[2] * ACT8_SCALE, r1[3] * ACT8_SCALE)};
        else store_bf16x8(mg + i, r0, r1); }
    DI void operator()(int row, int col, f32x4 v) const { const size_t i = (size_t)row * 2048 + col; store_bf16x4(mg + i, load_bf16x4(mg + i) + v * load_bf16x4(g + i)); }
    DI void operator()(int row, int col, f32x4 v0, f32x4 v1) const { const size_t i = (size_t)row * 2048 + col; f32x4 g0, g1, m0, m1; load_bf16x8(g + i, g0, g1); load_bf16x8(mg + i, m0, m1); store_bf16x8(mg + i, m0 + v0 * g0, m1 + v1 * g1); } };
struct EpiRes { const float* x; const float* gt; float* x1; float osc;
    static constexpr int MB = 4; struct Pre { f32x4 a, b; };
    DI Pre load(int row, int col) const { const size_t i = (size_t)row * 2048 + col; Pre q; q.a = *(const f32x4*)(x + i); q.b = *(const f32x4*)(x + i + 4); return q; }
    DI void apply(int row, int col, f32x4 v0, f32x4 v1, const Pre& q) const { const size_t i = (size_t)row * 2048 + col; const int b = row / SEQ; const float* gp = gt + b * 6 * D + col;
        const f32x4 r0 = q.a + *(const f32x4*)gp * v0 * (osc * DBG_ALPHA), r1 = q.b + *(const f32x4*)(gp + 4) * v1 * (osc * DBG_ALPHA);
        if (X1_BF16) store_bf16x8((bf16_t*)x1 + i, r0, r1); else { *(f32x4*)(x1 + i) = r0; *(f32x4*)(x1 + i + 4) = r1; } }
    DI void operator()(int row, int col, f32x4 v) const { const size_t i = (size_t)row * 2048 + col; const int b = row / SEQ;
        *(f32x4*)(x1 + i) = *(const f32x4*)(x + i) + *(const f32x4*)(gt + b * 6 * D + col) * v * DBG_ALPHA; }
    DI void operator()(int row, int col, f32x4 v0, f32x4 v1) const { (*this)(row, col, v0); (*this)(row, col + 4, v1); } };
struct EpiPq { bf16_t* pq;
    DI void operator()(int row, int col, f32x4 v) const { store_bf16x4(pq + (size_t)(col >> 8) * M * 256 + (size_t)row * 256 + (col & 255), v); }
    DI void operator()(int row, int col, f32x4 v0, f32x4 v1) const { store_bf16x8(pq + (size_t)(col >> 8) * M * 256 + (size_t)row * 256 + (col & 255), v0, v1); } };

template <class Epi>
DI void gemm_naive(const Ctx& c, const bf16_t* A, const bf16_t* Bt, int Mg, int Ng, int Kg, const Epi& E) {
    LAS float* As = (LAS float*)c.lds; LAS float* Bs = As + 16 * 132;
    const int tid = c.tid, ty = tid >> 5, tx = tid & 31;
    const int tilesN = Ng / 128, ntiles = (Mg / 128) * tilesN;
    for (int t = blockIdx.x; t < ntiles; t += gridDim.x) {
        const int tm = t / tilesN, tn = t % tilesN;
        float acc[8][4];
#pragma unroll
        for (int i = 0; i < 8; ++i)
#pragma unroll
            for (int j = 0; j < 4; ++j) acc[i][j] = 0.f;
        for (int k0 = 0; k0 < Kg; k0 += 16) {
            { const int lt = tid & 255, r = lt >> 1, kc = lt & 1;
              const bf16_t* src = (tid < 256 ? A + (size_t)(tm * 128 + r) * Kg : Bt + (size_t)(tn * 128 + r) * Kg) + k0 + kc * 8;
              const u32x4 v = *(const u32x4*)src;
              LAS float* dst = (tid < 256 ? As : Bs) + (kc * 8) * 132 + r;
              dst[0] = bflo(v.x); dst[132] = bfhi(v.x); dst[2 * 132] = bflo(v.y); dst[3 * 132] = bfhi(v.y);
              dst[4 * 132] = bflo(v.z); dst[5 * 132] = bfhi(v.z); dst[6 * 132] = bflo(v.w); dst[7 * 132] = bfhi(v.w); }
            __syncthreads();
#pragma unroll
            for (int kk = 0; kk < 16; ++kk) {
                const f32x4 a0 = *(const LAS f32x4*)(As + kk * 132 + ty * 8), a1 = *(const LAS f32x4*)(As + kk * 132 + ty * 8 + 4);
                const f32x4 b = *(const LAS f32x4*)(Bs + kk * 132 + tx * 4);
#pragma unroll
                for (int j = 0; j < 4; ++j) {
                    acc[0][j] += a0[0] * b[j]; acc[1][j] += a0[1] * b[j]; acc[2][j] += a0[2] * b[j]; acc[3][j] += a0[3] * b[j];
                    acc[4][j] += a1[0] * b[j]; acc[5][j] += a1[1] * b[j]; acc[6][j] += a1[2] * b[j]; acc[7][j] += a1[3] * b[j];
                }
            }
            __syncthreads();
        }
#pragma unroll
        for (int i = 0; i < 8; ++i) E(tm * 128 + ty * 8 + i, tn * 128 + tx * 4, (f32x4){acc[i][0], acc[i][1], acc[i][2], acc[i][3]});
    }
}

namespace pg8 {
#define PG8_LAS __attribute__((address_space(3)))
typedef unsigned short bf16_t;
typedef short bf16x8 __attribute__((ext_vector_type(8)));
typedef float f32x4 __attribute__((ext_vector_type(4)));
typedef unsigned u32x4 __attribute__((ext_vector_type(4)));
constexpr int BM = 256, BK = 64, HALF = 128, HTB = HALF * BK * 2  , STAGE_BYTES = 8 * HTB, NXCD = 8, WGM = 4;

__host__ __device__ __forceinline__ int lds_byte(int r, int c) { const int st = (r >> 4) * 2 + (c >> 5), rr = r & 15, cc = c & 31, ob = rr * 64 + cc * 2; return st * 1024 + (ob ^ (((ob >> 9) & 1) << 5)); }
__host__ __device__ __forceinline__ void stage_rc(int b, int& R, int& C) { const int st = b / 1024, sb = b % 1024, swz = sb ^ (((sb >> 9) & 1) << 5); R = (st >> 1) * 16 + swz / 64; C = (st & 1) * 32 + (swz % 64) / 2; }
__host__ __device__ __forceinline__ int perm32(int rho) { const int n = rho >> 4, i = rho & 15; return 8 * (i >> 2) + 4 * n + (i & 3); }

struct Unit { int pm, pn; };
struct Gemm { const bf16_t* A; const bf16_t* Bt; int M, N, K; int tid; const unsigned char* base; };
struct StaticOrder {
    int nM, nN, nwg, G, c;
    __host__ __device__ void init(int M, int N, int G_, int c_) { nM = M / BM; nN = N / BM; nwg = nM * nN; G = G_; c = c_; }
    __host__ __device__ bool next(int i, Unit& u) const {
        const long L = (long)i * G + c; if (L >= nwg) return false;
        int wgid = (int)L; { const int q = nwg / NXCD, r = nwg % NXCD, xcd = wgid % NXCD, off = wgid / NXCD; wgid = (xcd < r ? xcd * (q + 1) : r * (q + 1) + (xcd - r) * q) + off; }
        const int nig = WGM * nN, gid = wgid / nig, fm = gid * WGM, gsz = (nM - fm) < WGM ? (nM - fm) : WGM;
        u.pm = fm + ((wgid % nig) % gsz); u.pn = (wgid % nig) / gsz; return true;
    }
    __device__ __forceinline__ void a_ready(const Unit&) const {}
    __device__ __forceinline__ void done(const Unit&) const {}
};
typedef int i32x8 __attribute__((ext_vector_type(8)));
template <class Epi, class Sched, bool STAMP = false, bool F8 = false>
__device__ __forceinline__ void gemm_phase(PG8_LAS unsigned char* lds, const Gemm g, const Sched& S, const Epi& E, unsigned long long* stamps) {
    const int tid = g.tid, wid = __builtin_amdgcn_readfirstlane(tid >> 6), lane = tid & 63, wr = wid >> 2, wc = wid & 3, fr = lane & 15, fq = lane >> 4;
    const int K = g.K, nt = K / BK;
    int ts_lo = 0, ts_hi = 0, nts = 0; const unsigned long long rt_entry = STAMP ? (unsigned long long)wall_clock64() : 0ull;
#define PG8_STAMP() do { if (STAMP && wid == 0 && nts < 64) { const unsigned long long _c = (unsigned long long)clock64(); \
        ts_lo = (lane == nts) ? (int)(unsigned)_c : ts_lo; ts_hi = (lane == nts) ? (int)(unsigned)(_c >> 32) : ts_hi; ++nts; } } while (0)
    PG8_STAMP();
    unsigned voffA, voffB;
    { int R, C; stage_rc(tid * 16, R, C); const int Rb = Epi::PERM ? ((R & ~31) + perm32(R & 31)) : R;
        voffA = (unsigned)(R * K + C) * 2u; voffB = (unsigned)(Rb * K + C) * 2u; }
    const unsigned qstep = 64u * (unsigned)K * 2u;
    const unsigned kstep = (unsigned)(BK * 2);
    const unsigned hstep = (unsigned)HALF * K * 2;
    const unsigned tstep = 2 * hstep;
    const __amdgpu_buffer_rsrc_t rs = __builtin_amdgcn_make_buffer_rsrc((void*)g.base, (short)0, (int)0x7fffffff, 0x00020000);
    const unsigned oA = (unsigned)((const unsigned char*)g.A - g.base), oB = (unsigned)((const unsigned char*)g.Bt - g.base);
    const unsigned ldsw = (unsigned)wid * 1024u;
    const int aoff = lds_byte(wr * 64 + fr, fq * 8), boff = lds_byte(wc * 32 + fr, fq * 8);
#define PG8_SA(b, h) (((b) * 2 + (h)) * HTB)
#define PG8_SB(b, h) ((4 + (b) * 2 + (h)) * HTB)
#define PG8_STAGE(bufoff, gbase, voff) do { _Pragma("unroll") for (int _i = 0; _i < 2; ++_i) \
        __builtin_amdgcn_raw_ptr_buffer_load_lds(rs, (PG8_LAS void*)(lds + (bufoff) + ldsw + _i * 8192), 16, (voff), (gbase) + _i * qstep, 0, 0); } while (0)
#define PG8_LDA(dst, b, h) do { _Pragma("unroll") for (int m = 0; m < 4; ++m) _Pragma("unroll") for (int k = 0; k < 2; ++k) dst[m][k] = *(const PG8_LAS bf16x8*)(lds + PG8_SA(b, h) + aoff + m * 2048 + k * 1024); } while (0)
#define PG8_LDB(dst, b, h) do { unsigned bb_; asm volatile("v_add_u32 %0, %2, %1" : "=v"(bb_) : "v"(boff), "i"(PG8_SB(b, h)));     \
        _Pragma("unroll") for (int n = 0; n < 2; ++n) _Pragma("unroll") for (int k = 0; k < 2; ++k) dst[n][k] = *(const PG8_LAS bf16x8*)(lds + bb_ + n * 2048 + k * 1024); } while (0)
#define PG8_CAT8(x0, x1) __builtin_bit_cast(i32x8, __builtin_shufflevector(x0, x1, 0, 1, 2, 3, 4, 5, 6, 7, 8, 9, 10, 11, 12, 13, 14, 15))
#define PG8_MMA(ai, bj, At, Bt) do { __builtin_amdgcn_s_setprio(1); _Pragma("unroll") for (int m = 0; m < 4; ++m) _Pragma("unroll") for (int n = 0; n < 2; ++n) { \
        if constexpr (F8) acc[ai][bj][m][n] = __builtin_amdgcn_mfma_scale_f32_16x16x128_f8f6f4(PG8_CAT8(Bt[n][0], Bt[n][1]), PG8_CAT8(At[m][0], At[m][1]), acc[ai][bj][m][n], 0, 0, 0, 0, 0, 0); \
        else { _Pragma("unroll") for (int k = 0; k < 2; ++k) acc[ai][bj][m][n] = __builtin_amdgcn_mfma_f32_16x16x32_bf16(Bt[n][k], At[m][k], acc[ai][bj][m][n], 0, 0, 0); } } \
        __builtin_amdgcn_s_setprio(0); } while (0)
#define PG8_WAIT_V(n) asm volatile("s_waitcnt vmcnt(" #n ")" ::: "memory")
#define PG8_WAIT_L(n) asm volatile("s_waitcnt lgkmcnt(" #n ")" ::: "memory")
#define PG8_BAR __builtin_amdgcn_s_barrier()
#define PG8_SCHED __builtin_amdgcn_sched_barrier(0)
    Unit cur, nxt; int ui = 0;
    if (!S.next(0, cur)) return;
    f32x4 acc[2][2][4][2];
#pragma unroll
    for (int a = 0; a < 2; ++a)
#pragma unroll
        for (int b = 0; b < 2; ++b)
#pragma unroll
            for (int m = 0; m < 4; ++m)
#pragma unroll
                for (int n = 0; n < 2; ++n) acc[a][b][m][n] = (f32x4){0.f, 0.f, 0.f, 0.f};
    bf16x8 At[4][2], B0[2][2], B1[2][2];
    unsigned cA = oA + (unsigned)cur.pm * tstep, cB = oB + (unsigned)cur.pn * tstep;
    S.a_ready(cur);
    PG8_STAGE(PG8_SB(0, 0), cB, voffB); PG8_STAGE(PG8_SA(0, 0), cA, voffA); PG8_STAGE(PG8_SB(0, 1), cB + hstep, voffB); PG8_STAGE(PG8_SA(0, 1), cA + hstep, voffA);
    if (wr == 1) PG8_BAR;
    PG8_WAIT_V(4); PG8_BAR;
    PG8_STAGE(PG8_SB(1, 0), cB + kstep, voffB); PG8_STAGE(PG8_SA(1, 0), cA + kstep, voffA); PG8_STAGE(PG8_SB(1, 1), cB + hstep + kstep, voffB);
    PG8_WAIT_V(6); PG8_BAR;
    PG8_STAMP();
    for (;;) {
        const bool has_next = S.next(ui + 1, nxt);
        const unsigned nA = has_next ? oA + (unsigned)nxt.pm * tstep : cA, nB = has_next ? oB + (unsigned)nxt.pn * tstep : cB;
        for (int t = 0; t < nt; t += 2) {
            const bool last = (t == nt - 2);
            const unsigned a1 = cA + (unsigned)(t + 1) * kstep;
            const unsigned a2 = last ? nA : cA + (unsigned)(t + 2) * kstep, b2 = last ? nB : cB + (unsigned)(t + 2) * kstep;
            const unsigned a3 = a2 + kstep, b3 = b2 + kstep;
            if (last && has_next) S.a_ready(nxt);
            PG8_LDB(B0, 0, 0); PG8_SCHED; PG8_LDA(At, 0, 0); PG8_STAGE(PG8_SA(1, 1), a1 + hstep, voffA);
            PG8_WAIT_L(8); PG8_BAR; PG8_WAIT_L(0); PG8_MMA(0, 0, At, B0); PG8_BAR; PG8_SCHED;
            PG8_LDB(B1, 0, 1); PG8_STAGE(PG8_SB(0, 0), b2, voffB);
            PG8_BAR; PG8_WAIT_L(0); PG8_MMA(0, 1, At, B1); PG8_BAR;
            PG8_LDA(At, 0, 1); PG8_STAGE(PG8_SA(0, 0), a2, voffA);
            PG8_BAR; PG8_WAIT_L(0); PG8_MMA(1, 0, At, B0); PG8_BAR; PG8_SCHED;
            PG8_STAGE(PG8_SB(0, 1), b2 + hstep, voffB);
            PG8_WAIT_V(6); PG8_BAR; PG8_MMA(1, 1, At, B1); PG8_BAR;
            PG8_LDB(B0, 1, 0); PG8_SCHED; PG8_LDA(At, 1, 0); PG8_STAGE(PG8_SA(0, 1), a2 + hstep, voffA);
            PG8_WAIT_L(8); PG8_BAR; PG8_WAIT_L(0); PG8_MMA(0, 0, At, B0); PG8_BAR; PG8_SCHED;
            PG8_LDB(B1, 1, 1); PG8_STAGE(PG8_SB(1, 0), b3, voffB);
            PG8_BAR; PG8_WAIT_L(0); PG8_MMA(0, 1, At, B1); PG8_BAR;
            PG8_LDA(At, 1, 1); PG8_STAGE(PG8_SA(1, 0), a3, voffA);
            PG8_BAR; PG8_WAIT_L(0); PG8_MMA(1, 0, At, B0); PG8_BAR; PG8_SCHED;
            PG8_STAGE(PG8_SB(1, 1), b3 + hstep, voffB);
            PG8_WAIT_V(6); PG8_BAR; PG8_MMA(1, 1, At, B1); PG8_BAR;
        }
        PG8_STAMP();
        if constexpr (!Epi::AFTER_DRAIN) { int l2_; asm volatile("v_mbcnt_lo_u32_b32 %0, -1, 0\n\tv_mbcnt_hi_u32_b32 %0, -1, %0" : "=v"(l2_));
            E(acc, cur, wr, wc, l2_ & 15, l2_ >> 4); S.done(cur); }
        PG8_STAMP();
        if (!has_next) break;
#pragma unroll
        for (int a = 0; a < 2; ++a)
#pragma unroll
            for (int b = 0; b < 2; ++b)
#pragma unroll
                for (int m = 0; m < 4; ++m)
#pragma unroll
                    for (int n = 0; n < 2; ++n) acc[a][b][m][n] = (f32x4){0.f, 0.f, 0.f, 0.f};
        cur = nxt; cA = nA; cB = nB; ++ui;
    }
    PG8_WAIT_V(0);
    if (wr == 0) PG8_BAR;
    PG8_BAR;
    if constexpr (Epi::AFTER_DRAIN) { E.fused(acc, cur, wr, wc, fr, fq, lds, wid, lane); S.done(cur); }
    PG8_STAMP();
    if (STAMP && wid == 0) { stamps[lane] = lane < nts ? (((unsigned long long)(unsigned)ts_hi << 32) | (unsigned)ts_lo) : 0ull;
        if (lane == 62) stamps[62] = rt_entry; if (lane == 63) stamps[63] = (unsigned long long)wall_clock64(); }
#undef PG8_STAMP
#undef PG8_SA
#undef PG8_SB
#undef PG8_STAGE
#undef PG8_LDA
#undef PG8_LDB
#undef PG8_MMA
#undef PG8_CAT8
#undef PG8_WAIT_V
#undef PG8_WAIT_L
#undef PG8_BAR
#undef PG8_SCHED
}
}

template <class E4, class = void> struct epi_mb { static constexpr int value = 0; };
template <class E4> struct epi_mb<E4, decltype((void)E4::MB)> { static constexpr int value = E4::MB; };
template <class E4> struct EpiAdapt {
    static constexpr bool PERM = true, AFTER_DRAIN = false;
    E4 e;
    __device__ __forceinline__ void operator()(const pg8::f32x4 (&acc)[2][2][4][2], const pg8::Unit& u, int wr, int wc, int fr, int fq) const {
        if constexpr (epi_mb<E4>::value > 0) {
            constexpr int MB = epi_mb<E4>::value;
#pragma unroll
            for (int ai = 0; ai < 2; ++ai)
#pragma unroll
                for (int m0 = 0; m0 < 4; m0 += MB) {
                    typename E4::Pre pre[MB][2];
#pragma unroll
                    for (int mi = 0; mi < MB; ++mi)
#pragma unroll
                        for (int bj = 0; bj < 2; ++bj) pre[mi][bj] = e.load(u.pm * 256 + ai * 128 + wr * 64 + (m0 + mi) * 16 + fr, u.pn * 256 + bj * 128 + wc * 32 + fq * 8);
#pragma unroll
                    for (int mi = 0; mi < MB; ++mi)
#pragma unroll
                        for (int bj = 0; bj < 2; ++bj) e.apply(u.pm * 256 + ai * 128 + wr * 64 + (m0 + mi) * 16 + fr, u.pn * 256 + bj * 128 + wc * 32 + fq * 8, acc[ai][bj][m0 + mi][0], acc[ai][bj][m0 + mi][1], pre[mi][bj]);
                    asm volatile("" ::: "memory");
                }
        } else {
#pragma unroll
        for (int ai = 0; ai < 2; ++ai)
#pragma unroll
            for (int m = 0; m < 4; ++m) {
                const int row = u.pm * 256 + ai * 128 + wr * 64 + m * 16 + fr;
#pragma unroll
                for (int bj = 0; bj < 2; ++bj) e(row, u.pn * 256 + bj * 128 + wc * 32 + fq * 8, acc[ai][bj][m][0], acc[ai][bj][m][1]);
                asm volatile("" ::: "memory");
            }
        }
    }
};
template <class E4>
DI void gemm_fast(const Ctx& c, const unsigned char* WSB, const bf16_t* A, const bf16_t* Bt, int Mg, int Ng, int Kg, const E4& e4, int Gsub = 0, int csub = 0) {
    pg8::Gemm g{A, Bt, Mg, Ng, Kg, c.tid, WSB}; pg8::StaticOrder S; S.init(Mg, Ng, Gsub > 0 ? Gsub : (int)gridDim.x, Gsub > 0 ? csub : (int)blockIdx.x);
    EpiAdapt<E4> E{e4};
    pg8::gemm_phase<EpiAdapt<E4>, pg8::StaticOrder, false>((PG8_LAS unsigned char*)c.lds, g, S, E, nullptr);
}
template <class E4>
DI void gemm_fast8(const Ctx& c, const unsigned char* WSB, const unsigned char* A, const unsigned char* Bt, int Mg, int Ng, int Kg, const E4& e4) {
    pg8::Gemm g{(const bf16_t*)A, (const bf16_t*)Bt, Mg, Ng, Kg / 2, c.tid, WSB}; pg8::StaticOrder S; S.init(Mg, Ng, (int)gridDim.x, (int)blockIdx.x);
    EpiAdapt<E4> E{e4};
    pg8::gemm_phase<EpiAdapt<E4>, pg8::StaticOrder, false, true>((PG8_LAS unsigned char*)c.lds, g, S, E, nullptr);
}
#define GEMM8(c_, ...) do { MKCTX(); gemm_fast8(c, ws, __VA_ARGS__); } while (0)
#ifndef FAST_GEMM
#define FAST_GEMM 1
#endif
#if FAST_GEMM
#define GEMM(c_, ...) do { MKCTX(); gemm_fast(c, ws, __VA_ARGS__); } while (0)
#else
#define GEMM(c_, ...) do { MKCTX(); gemm_naive(c, __VA_ARGS__); } while (0)
#endif

DI void attn_mla_naive(const Params& p, const Ctx& c) {
    const bf16_t* Q = (const bf16_t*)(p.ws + OFF_Q); const bf16_t* KN = (const bf16_t*)(p.ws + OFF_KN); const bf16_t* KR = (const bf16_t*)(p.ws + OFF_KR);
    const bf16_t* VT = (const bf16_t*)(p.ws + OFF_VT); bf16_t* O = (bf16_t*)(p.ws + OFF_ATTA);
    for (int u = c.gw; u < M * 8; u += c.ngw) {
        const int m = u >> 3, hd = u & 7, b = m / SEQ, s = m % SEQ, base = b * SEQ, nkeys = ((s >> 6) + 1) << 6;
        const float q0 = bf2f(Q[(size_t)m * 1536 + hd * 192 + c.lane]), q1 = bf2f(Q[(size_t)m * 1536 + hd * 192 + 64 + c.lane]), q2 = bf2f(Q[(size_t)m * 1536 + hd * 192 + 128 + c.lane]);
        float mx = -1e30f, l = 0.f, o0 = 0.f, o1 = 0.f;
        const bf16_t* v0p = VT + (size_t)(hd * 128 + c.lane) * M + base; const bf16_t* v1p = v0p + (size_t)64 * M;
        for (int kk = 0; kk < nkeys; ++kk) {
            const size_t tk = base + kk;
            const float part = q0 * bf2f(KN[tk * 1024 + hd * 128 + c.lane]) + q1 * bf2f(KN[tk * 1024 + hd * 128 + 64 + c.lane]) + q2 * bf2f(KR[tk * 64 + c.lane]);
            const float sc = wave_sum(part);
            const float mn = fmaxf(mx, sc), al = exp2f(mx - mn), pp = exp2f(sc - mn);
            l = l * al + pp; o0 = o0 * al + pp * bf2f(v0p[kk]); o1 = o1 * al + pp * bf2f(v1p[kk]); mx = mn;
        }
        const float inv = 1.f / l;
        O[(size_t)m * 1024 + hd * 128 + c.lane] = (bf16_t)(pk2(o0 * inv, 0.f) & 0xffff);
        O[(size_t)m * 1024 + hd * 128 + 64 + c.lane] = (bf16_t)(pk2(o1 * inv, 0.f) & 0xffff);
    }
}
DI void attn_sb_naive(const Params& p, const Ctx& c) {
    const bf16_t* Q = (const bf16_t*)(p.ws + OFF_SBQ); const bf16_t* K = (const bf16_t*)(p.ws + OFF_SBK);
    const bf16_t* VT = (const bf16_t*)(p.ws + OFF_SBVT); bf16_t* O = (bf16_t*)(p.ws + OFF_ATTB);
    for (int u = c.gw; u < M * 8; u += c.ngw) {
        const int m = u >> 3, hd = u & 7, b = m / SEQ, s = m % SEQ, base = b * SEQ;
        const float q0 = bf2f(Q[(size_t)m * 1024 + hd * 128 + c.lane]), q1 = bf2f(Q[(size_t)m * 1024 + hd * 128 + 64 + c.lane]);
        float later = 0.f, o0 = 0.f, o1 = 0.f;
        const bf16_t* v0p = VT + (size_t)(hd * 128 + c.lane) * M + base; const bf16_t* v1p = v0p + (size_t)64 * M;
        for (int kk = s - 1; kk >= 0; --kk) {
            const size_t tk = base + kk;
            const float z2 = wave_sum(q0 * bf2f(K[tk * 1024 + hd * 128 + c.lane]) + q1 * bf2f(K[tk * 1024 + hd * 128 + 64 + c.lane]));
            const float ln2 = -(fmaxf(z2, 0.f) + __log2f(1.f + exp2f(-fabsf(z2))));
            const float w = exp2f(z2 + ln2 + later);
            later += ln2; o0 += w * bf2f(v0p[kk]); o1 += w * bf2f(v1p[kk]);
        }
        O[(size_t)m * 1024 + hd * 128 + c.lane] = (bf16_t)(pk2(o0, 0.f) & 0xffff);
        O[(size_t)m * 1024 + hd * 128 + 64 + c.lane] = (bf16_t)(pk2(o1, 0.f) & 0xffff);
    }
}


typedef float f32x16 __attribute__((ext_vector_type(16)));
#define MFMA32(a, b, c) __builtin_amdgcn_mfma_f32_32x32x16_bf16((a), (b), (c), 0, 0, 0)
constexpr int ST_KR = 16384, ST_VT = 24576, ST_BYTES = 40960;
constexpr int ATT_FLAGS = 2 * ST_BYTES;
DI float ex2(float x) { return __builtin_amdgcn_exp2f(x); }
DI float lg2(float x) { return __builtin_amdgcn_logf(x); }
DI bf16x8 pack8(float a0, float a1, float a2, float a3, float a4, float a5, float a6, float a7) {
    u32x4 t; t.x = pk2(a0, a1); t.y = pk2(a2, a3); t.z = pk2(a4, a5); t.w = pk2(a6, a7); return __builtin_bit_cast(bf16x8, t); }
#define GLDS16(gp, lp) __builtin_amdgcn_global_load_lds((const unsigned*)(gp), (LAS unsigned*)(lp), 16, 0, 0)

struct AttDmaOff { unsigned kn[2], kr, vt[2]; };
DI AttDmaOff att_dma_offsets(int w, int lane) {
    AttDmaOff o; const unsigned lr = lane >> 4, pp = lane & 15;
#pragma unroll
    for (int i = 0; i < 2; ++i) { const unsigned q = w * 2 + i, R = 4 * q + lr, cc = pp ^ (R & 15); o.kn[i] = R * 2048u + cc * 16u; }
    { const unsigned q = w, R2 = 4 * q + lr, cc = pp ^ (R2 & 15); o.kr = (2 * R2 + (cc >> 3)) * 128u + (cc & 7) * 16u; }
#pragma unroll
    for (int i = 0; i < 2; ++i) { const unsigned q = w * 2 + i, R2 = 4 * q + lr, cc = pp ^ (R2 & 15); o.vt[i] = (2 * R2 + (cc >> 3)) * (unsigned)(M * 2) + (cc & 7) * 16u; }
    return o;
}
template <bool ROPE>
DI void att_dma(LAS unsigned char* buf, __amdgpu_buffer_rsrc_t rs, const AttDmaOff& o, unsigned k_so, unsigned kr_so, unsigned vt_so, int w) {
#pragma unroll
    for (int i = 0; i < 2; ++i) __builtin_amdgcn_raw_ptr_buffer_load_lds(rs, (LAS void*)(buf + (w * 2 + i) * 1024), 16, o.kn[i], k_so, 0, 0);
    if (ROPE) __builtin_amdgcn_raw_ptr_buffer_load_lds(rs, (LAS void*)(buf + ST_KR + w * 1024), 16, o.kr, kr_so, 0, 0);
#pragma unroll
    for (int i = 0; i < 2; ++i) __builtin_amdgcn_raw_ptr_buffer_load_lds(rs, (LAS void*)(buf + ST_VT + (w * 2 + i) * 1024), 16, o.vt[i], vt_so, 0, 0);
}
#ifndef ATT_STORE_LDS
#define ATT_STORE_LDS 1
#endif
constexpr int ATT_OSCR = 2 * 40960 + 1024, ATT_OSCR_WAVE = 32 * 144;
DI void att_store(const f32x16 (&o)[4], float scale, bf16_t* O, size_t row, int hd, int h, LAS unsigned char* scr, int lane) {
#if P67_FP8 && ATT_STORE_LDS
    { const int r = lane & 31; const float sc8 = scale * ACT8_SCALE;
#pragma unroll
      for (int db = 0; db < 4; ++db)
#pragma unroll
        for (int g = 0; g < 4; ++g)
            *(LAS unsigned*)(scr + r * 144 + db * 32 + g * 8 + h * 4) = pk4f8(o[db][4 * g] * sc8, o[db][4 * g + 1] * sc8, o[db][4 * g + 2] * sc8, o[db][4 * g + 3] * sc8);
      const size_t row0 = row - (size_t)r;
#pragma unroll
      for (int it = 0; it < 4; ++it) { const int rr = it * 8 + (lane >> 3), pc = lane & 7;
          const u32x4 v = *(const LAS u32x4*)(scr + rr * 144 + pc * 16);
          *(u32x4*)((unsigned char*)O + (row0 + rr) * 1024 + hd * 128 + pc * 16) = v; }
      asm volatile("s_waitcnt lgkmcnt(0)" ::: "memory");
      return; }
#endif
#pragma unroll
    for (int db = 0; db < 4; ++db)
#pragma unroll
        for (int g = 0; g < 4; ++g)
#if P67_FP8
            { const float sc8 = scale * ACT8_SCALE; *(unsigned*)((unsigned char*)O + row * 1024 + hd * 128 + db * 32 + g * 8 + h * 4) = pk4f8(o[db][4 * g] * sc8, o[db][4 * g + 1] * sc8, o[db][4 * g + 2] * sc8, o[db][4 * g + 3] * sc8); }
#else
            store_bf16x4(O + row * 1024 + hd * 128 + db * 32 + g * 8 + h * 4, (f32x4){o[db][4 * g] * scale, o[db][4 * g + 1] * scale, o[db][4 * g + 2] * scale, o[db][4 * g + 3] * scale});
#endif
}
#ifndef MLA_PD
#define MLA_PD 2
#endif
DI void att_pv(f32x16 (&o)[4], const bf16x8 (&pf)[2][2], const LAS unsigned char* buf, unsigned va) {
    bf16x8 vf[2][4];
#pragma unroll
    for (int db = 0; db < 4; ++db) vf[0][db] = *(const LAS bf16x8*)(buf + ((va ^ (0 << 5)) + db * 4096));
#pragma unroll
    for (int k = 0; k < 4; ++k) {
        if (k + 1 < 4) {
#pragma unroll
            for (int db = 0; db < 4; ++db) vf[(k + 1) & 1][db] = *(const LAS bf16x8*)(buf + ((va ^ ((k + 1) << 5)) + db * 4096));
        }
#pragma unroll
        for (int db = 0; db < 4; ++db) o[db] = MFMA32(vf[k & 1][db], pf[k >> 1][k & 1], o[db]);
    }
    __builtin_amdgcn_sched_group_barrier(0x100, 4, 0);
#pragma unroll
    for (int k = 0; k < 4; ++k) {
        if (k + 1 < 4) __builtin_amdgcn_sched_group_barrier(0x100, 4, 0);
        __builtin_amdgcn_sched_group_barrier(0x008, 4, 0);
    }
}

DI void attn_mla_fast(const Params& p, const Ctx& c) {
    const bf16_t* Q = (const bf16_t*)(p.ws + OFF_Q); const bf16_t* KN = (const bf16_t*)(p.ws + OFF_KN); const bf16_t* KR = (const bf16_t*)(p.ws + OFF_KR);
    const bf16_t* VT = (const bf16_t*)(p.ws + OFF_VT); bf16_t* O = (bf16_t*)(p.ws + OFF_ATTA);
    const int lane = c.lane, r = lane & 31, h = lane >> 5, w = c.wave;
    const int pr = (r & 0x13) | ((r & 4) << 1) | ((r & 8) >> 1);
    const unsigned ka = (pr << 8) | ((((pr & 15) ^ h) & 15) << 4);
    const unsigned ra = ST_KR + (((pr >> 1) << 8) | (((((pr & 1) << 3) | h) ^ ((pr >> 1) & 15)) << 4));
    const unsigned va = ST_VT + (((r >> 1) << 8) | (((((r & 1) << 3) | h) ^ ((r >> 1) & 15)) << 4));
    const __amdgpu_buffer_rsrc_t rs = __builtin_amdgcn_make_buffer_rsrc((void*)p.ws, (short)0, (int)WS_END, 0x00020000);
    const AttDmaOff dof = att_dma_offsets(w, lane);
    for (int it = blockIdx.x; it < 256; it += gridDim.x) {
        const int bh = it & 31, b = bh >> 3, hd = bh & 7, pairi = it >> 5;
#pragma unroll 1
        for (int half = 0; half < 2; ++half) {
            const int qb = half ? 15 - pairi : pairi, q0 = qb * 256;
            const size_t base = (size_t)b * SEQ, qrow = base + q0 + w * 32 + r;
            bf16x8 qf[12];
#pragma unroll
            for (int st = 0; st < 12; ++st) qf[st] = *(const bf16x8*)(Q + qrow * 1536 + hd * 192 + st * 16 + h * 8);
            const int ntile = q0 / 64 + 4, myn = (q0 + w * 32) / 64 + 1;
            f32x16 o[4];
#pragma unroll
            for (int db = 0; db < 4; ++db)
#pragma unroll
                for (int i = 0; i < 16; ++i) o[db][i] = 0.f;
            float mrun = -1e30f, lrun = 0.f;
            const unsigned k_so0 = (unsigned)(OFF_KN + (base * 1024 + hd * 128) * 2), kr_so0 = (unsigned)(OFF_KR + base * 64 * 2), vt_so0 = (unsigned)(OFF_VT + ((size_t)(hd * 128) * M + base) * 2);
            if (half == 0) { __syncthreads();
                att_dma<true>(c.lds, rs, dof, k_so0, kr_so0, vt_so0, w); }
            asm volatile("s_waitcnt vmcnt(0)" ::: "memory");
            __syncthreads();
            for (int j = 0; j < ntile; ++j) {
                LAS unsigned char* buf = c.lds + (j & 1) * ST_BYTES;
                if (j + 1 < ntile) att_dma<true>(c.lds + ((j + 1) & 1) * ST_BYTES, rs, dof, k_so0 + (unsigned)(j + 1) * (64 * 2048), kr_so0 + (unsigned)(j + 1) * (64 * 128), vt_so0 + (unsigned)(j + 1) * 128, w);
                if (j < myn) {
                    f32x16 s0, s1;
#pragma unroll
                    for (int i = 0; i < 16; ++i) { s0[i] = 0.f; s1[i] = 0.f; }
                    __builtin_amdgcn_s_setprio(1);
#define MLA_KF(st_, hi_) (*(const LAS bf16x8*)(buf + ((st_) < 8 ? (ka ^ ((st_) << 5)) + (hi_) * 8192 : (ra ^ (((st_) - 8) << 5)) + (hi_) * 4096)))
                    {
                        bf16x8 kf[MLA_PD + 1][2];
#pragma unroll
                        for (int st = 0; st < MLA_PD; ++st) { kf[st][0] = MLA_KF(st, 0); kf[st][1] = MLA_KF(st, 1); }
#pragma unroll
                        for (int st = 0; st < 12; ++st) {
                            if (st + MLA_PD < 12) { kf[(st + MLA_PD) % (MLA_PD + 1)][0] = MLA_KF(st + MLA_PD, 0); kf[(st + MLA_PD) % (MLA_PD + 1)][1] = MLA_KF(st + MLA_PD, 1); }
                            s0 = MFMA32(kf[st % (MLA_PD + 1)][0], qf[st], s0);
                            s1 = MFMA32(kf[st % (MLA_PD + 1)][1], qf[st], s1);
                        }
                        __builtin_amdgcn_sched_group_barrier(0x100, 2 * MLA_PD, 0);
#pragma unroll
                        for (int st = 0; st < 12; ++st) {
                            if (st + MLA_PD < 12) __builtin_amdgcn_sched_group_barrier(0x100, 2, 0);
                            __builtin_amdgcn_sched_group_barrier(0x008, 2, 0);
                        }
                    }
                    __builtin_amdgcn_s_setprio(0);
                    float mx = fmaxf(s0[0], s1[0]);
#pragma unroll
                    for (int i = 1; i < 16; ++i) mx = fmaxf(mx, fmaxf(s0[i], s1[i]));
                    mx = fmaxf(mx, __shfl_xor(mx, 32));
                    if (__builtin_amdgcn_ballot_w64(mx > mrun + 8.f) != 0ull) {
                        const float mnew = fmaxf(mrun, mx), alpha = ex2(mrun - mnew);
                        mrun = mnew; lrun *= alpha;
#pragma unroll
                        for (int db = 0; db < 4; ++db)
#pragma unroll
                            for (int i = 0; i < 16; ++i) o[db][i] *= alpha;
                    }
                    float ps = 0.f;
#pragma unroll
                    for (int i = 0; i < 16; ++i) { s0[i] = ex2(s0[i] - mrun); s1[i] = ex2(s1[i] - mrun); ps += s0[i] + s1[i]; }
                    lrun += ps;
                    bf16x8 pf[2][2];
                    pf[0][0] = pack8(s0[0], s0[1], s0[2], s0[3], s0[4], s0[5], s0[6], s0[7]); pf[0][1] = pack8(s0[8], s0[9], s0[10], s0[11], s0[12], s0[13], s0[14], s0[15]);
                    pf[1][0] = pack8(s1[0], s1[1], s1[2], s1[3], s1[4], s1[5], s1[6], s1[7]); pf[1][1] = pack8(s1[8], s1[9], s1[10], s1[11], s1[12], s1[13], s1[14], s1[15]);
                    __builtin_amdgcn_s_setprio(1);
                    att_pv(o, pf, buf, va);
                    __builtin_amdgcn_s_setprio(0);
                }
                asm volatile("s_waitcnt vmcnt(0)" ::: "memory");
                __syncthreads();
            }
            if (half == 0) att_dma<true>(c.lds, rs, dof, k_so0, kr_so0, vt_so0, w);
            const float ltot = lrun + __shfl_xor(lrun, 32);
            att_store(o, 1.f / ltot, O, qrow, hd, h, c.lds + ATT_OSCR + w * ATT_OSCR_WAVE, c.lane);
        }
    }
}

DI void attn_sb_fast(const Params& p, const Ctx& c) {
    const bf16_t* Q = (const bf16_t*)(p.ws + OFF_SBQ); const bf16_t* K = (const bf16_t*)(p.ws + OFF_SBK);
    const bf16_t* VT = (const bf16_t*)(p.ws + OFF_SBVT); bf16_t* O = (bf16_t*)(p.ws + OFF_ATTB);
    const int lane = c.lane, r = lane & 31, h = lane >> 5, w = c.wave, tid = c.tid;
    const int pr = (r & 0x13) | ((r & 4) << 1) | ((r & 8) >> 1);
    const unsigned ka = (pr << 8) | ((((pr & 15) ^ h) & 15) << 4);
    const unsigned va = ST_VT + (((r >> 1) << 8) | (((((r & 1) << 3) | h) ^ ((r >> 1) & 15)) << 4));
    const __amdgpu_buffer_rsrc_t rs = __builtin_amdgcn_make_buffer_rsrc((void*)p.ws, (short)0, (int)WS_END, 0x00020000);
    const AttDmaOff dof = att_dma_offsets(w, lane);
    LAS int* flags = (LAS int*)(c.lds + ATT_FLAGS);
    for (int it = blockIdx.x; it < 256; it += gridDim.x) {
        const int bh = it & 31, b = bh >> 3, hd = bh & 7, pairi = it >> 5;
#pragma unroll 1
        for (int half = 0; half < 2; ++half) {
            const int qb = half ? 15 - pairi : pairi, q0 = qb * 256;
            const size_t base = (size_t)b * SEQ, qrow = base + q0 + w * 32 + r;
            const int tq = q0 + w * 32 + r;
            bf16x8 qf[8];
#pragma unroll
            for (int st = 0; st < 8; ++st) qf[st] = *(const bf16x8*)(Q + qrow * 1024 + hd * 128 + st * 16 + h * 8);
            const int jmax = q0 / 64 + 3, jd = (q0 + w * 32) / 64;
            f32x16 o[4];
#pragma unroll
            for (int db = 0; db < 4; ++db)
#pragma unroll
                for (int i = 0; i < 16; ++i) o[db][i] = 0.f;
            float carry = 0.f; bool wdone = false;
            __syncthreads();
            const unsigned k_so0 = (unsigned)(OFF_SBK + (base * 1024 + hd * 128) * 2), vt_so0 = (unsigned)(OFF_SBVT + ((size_t)(hd * 128) * M + base) * 2);
            att_dma<false>(c.lds, rs, dof, k_so0 + (unsigned)jmax * (64 * 2048), 0u, vt_so0 + (unsigned)jmax * 128, w);
            if (tid < 16) flags[tid] = 0;
            asm volatile("s_waitcnt vmcnt(0)" ::: "memory");
            __syncthreads();
            int itn = 0;
            for (int j = jmax; j >= 0; --j, ++itn) {
                LAS unsigned char* buf = c.lds + (itn & 1) * ST_BYTES;
                if (j > 0) att_dma<false>(c.lds + ((itn + 1) & 1) * ST_BYTES, rs, dof, k_so0 + (unsigned)(j - 1) * (64 * 2048), 0u, vt_so0 + (unsigned)(j - 1) * 128, w);
                if (j <= jd && !wdone) {
                    f32x16 s0, s1;
#pragma unroll
                    for (int i = 0; i < 16; ++i) { s0[i] = 0.f; s1[i] = 0.f; }
#pragma unroll
                    for (int st = 0; st < 8; ++st) {
                        s0 = MFMA32(*(const LAS bf16x8*)(buf + (ka ^ (st << 5))), qf[st], s0);
                        s1 = MFMA32(*(const LAS bf16x8*)(buf + ((ka ^ (st << 5)) + 8192)), qf[st], s1);
                    }
                    const int kb0 = 64 * j + 8 * h - tq;
                    bf16x8 pf[2][2];
                    {
                        f32x16 l1;
#pragma unroll
                        for (int i = 0; i < 16; ++i) { const float z = s1[i]; const float a = -(fmaxf(z, 0.f) + lg2(1.f + ex2(-fabsf(z)))); l1[i] = (kb0 + 32 + 16 * (i >> 3) + (i & 7) < 0) ? a : 0.f; }
                        float g0 = 0.f, g1 = 0.f;
#pragma unroll
                        for (int e = 0; e < 8; ++e) { g0 += l1[e]; g1 += l1[8 + e]; }
                        const float p0 = __shfl_xor(g0, 32), p1 = __shfl_xor(g1, 32);
                        float run = carry + (h == 0 ? p1 : 0.f);
#pragma unroll
                        for (int e = 7; e >= 0; --e) { run += l1[8 + e]; l1[8 + e] = run; }
                        run = carry + (g1 + p1) + (h == 0 ? p0 : 0.f);
#pragma unroll
                        for (int e = 7; e >= 0; --e) { run += l1[e]; l1[e] = run; }
                        carry += (g1 + p1) + (g0 + p0);
#pragma unroll
                        for (int i = 0; i < 16; ++i) { const float wv = ex2(s1[i] + l1[i]); s1[i] = (kb0 + 32 + 16 * (i >> 3) + (i & 7) < 0) ? wv : 0.f; }
                        pf[1][0] = pack8(s1[0], s1[1], s1[2], s1[3], s1[4], s1[5], s1[6], s1[7]); pf[1][1] = pack8(s1[8], s1[9], s1[10], s1[11], s1[12], s1[13], s1[14], s1[15]);
                    }
                    {
                        f32x16 l0;
#pragma unroll
                        for (int i = 0; i < 16; ++i) { const float z = s0[i]; const float a = -(fmaxf(z, 0.f) + lg2(1.f + ex2(-fabsf(z)))); l0[i] = (kb0 + 16 * (i >> 3) + (i & 7) < 0) ? a : 0.f; }
                        float g0 = 0.f, g1 = 0.f;
#pragma unroll
                        for (int e = 0; e < 8; ++e) { g0 += l0[e]; g1 += l0[8 + e]; }
                        const float p0 = __shfl_xor(g0, 32), p1 = __shfl_xor(g1, 32);
                        float run = carry + (h == 0 ? p1 : 0.f);
#pragma unroll
                        for (int e = 7; e >= 0; --e) { run += l0[8 + e]; l0[8 + e] = run; }
                        run = carry + (g1 + p1) + (h == 0 ? p0 : 0.f);
#pragma unroll
                        for (int e = 7; e >= 0; --e) { run += l0[e]; l0[e] = run; }
                        carry += (g1 + p1) + (g0 + p0);
#pragma unroll
                        for (int i = 0; i < 16; ++i) { const float wv = ex2(s0[i] + l0[i]); s0[i] = (kb0 + 16 * (i >> 3) + (i & 7) < 0) ? wv : 0.f; }
                        pf[0][0] = pack8(s0[0], s0[1], s0[2], s0[3], s0[4], s0[5], s0[6], s0[7]); pf[0][1] = pack8(s0[8], s0[9], s0[10], s0[11], s0[12], s0[13], s0[14], s0[15]);
                    }
                    att_pv(o, pf, buf, va);
                    wdone = __all(carry < -150.f);
                }
                if (lane == 0) flags[(itn & 1) * 8 + w] = wdone ? 1 : 0;
                asm volatile("s_waitcnt vmcnt(0)" ::: "memory");
                __syncthreads();
                int alld = 1;
#pragma unroll
                for (int q = 0; q < 8; ++q) alld &= flags[(itn & 1) * 8 + q];
                if (alld) break;
            }
            att_store(o, 1.f, O, qrow, hd, h, c.lds + ATT_OSCR + w * ATT_OSCR_WAVE, c.lane);
        }
    }
}
#ifndef FAST_ATTN
#define FAST_ATTN 1
#endif

constexpr int SEL_LD = 260;
DI void topk_insert(float (&a)[16], float x) {
#pragma unroll
    for (int i = 15; i >= 1; --i) a[i] = __builtin_amdgcn_fmed3f(a[i - 1], a[i], x);
    a[0] = fmaxf(a[0], x);
}
struct SelMap { int mode, a0, a1, a2, a3; };
DI void sel_decode(const SelMap& mp, int q, int& t0, int& hd) {
    if (mp.mode == 0) { int u = mp.a0 + q * mp.a1; if (u >= 128 * 8) u = mp.a0; hd = u & 7; t0 = (u >> 3) * 128; }
    else { const int pm = (q >> 1) ? mp.a2 : mp.a0, pn = (q >> 1) ? mp.a3 : mp.a1; hd = pn; t0 = pm * 256 + (q & 1) * 128; }
}
template <int NU> DI void select_stage2(const Params& p, const Ctx& c, const SelMap mp, const LAS float* lst_all) {
    if (c.tid < 128 * NU) {
        const int tok = c.tid & 127, un = c.tid >> 7;
        int t0, hd; sel_decode(mp, un, t0, hd);
        const LAS float* lst = lst_all + un * 4096;
        float v1[16], v2[16];
#pragma unroll
        for (int i = 0; i < 16; ++i) { v1[i] = __uint_as_float(__float_as_uint(lst[(tok * 2) * 16 + i]) & ~127u); v2[i] = __uint_as_float(__float_as_uint(lst[(tok * 2 + 1) * 16 + i]) & ~127u); }
        float bb[16];
#pragma unroll
        for (int i = 0; i < 16; ++i) bb[i] = -__builtin_inff();
#pragma unroll
        for (int i = 0; i < 16; ++i)
#pragma unroll
            for (int j = 0; j < 16; ++j)
                if ((i + 1) * (j + 1) <= 16) topk_insert(bb, __uint_as_float((__float_as_uint(v1[i] + v2[j]) & ~255u) | (unsigned)(i * 16 + j)));
        float sv[16], mxv = -__builtin_inff(), sum = 0.f;
#pragma unroll
        for (int i = 0; i < 16; ++i) { sv[i] = __uint_as_float(__float_as_uint(bb[i]) & ~255u); mxv = fmaxf(mxv, sv[i]); }
#pragma unroll
        for (int i = 0; i < 16; ++i) { sv[i] = __expf(sv[i] - mxv); sum += sv[i]; }
        const float inv = 1.f / sum;
        int* idx = (int*)(p.ws + OFF_IDX) + (size_t)(t0 + tok) * 128 + hd * 16; float* gw = (float*)(p.ws + OFF_GW) + (size_t)(t0 + tok) * 128 + hd * 16;
#pragma unroll
        for (int i = 0; i < 16; ++i) {
            const unsigned code = __float_as_uint(bb[i]) & 255u;
            const unsigned e1 = __float_as_uint(lst[(tok * 2) * 16 + (code >> 4)]) & 127u, e2 = __float_as_uint(lst[(tok * 2 + 1) * 16 + (code & 15u)]) & 127u;
            idx[i] = (int)(e1 * 128u + e2); gw[i] = sv[i] * inv;
        }
    }
    __syncthreads();
}
DI void select_tail(const Params& p, const Ctx& c, int t0, int hd) {
    LAS float* sc = (LAS float*)c.lds; LAS float* lst = sc + 128 * SEL_LD;
    if (c.tid < 256) {
        const int tok = c.tid >> 1, hf = c.tid & 1;
        float a[16];
#pragma unroll
        for (int i = 0; i < 16; ++i) a[i] = -__builtin_inff();
        const LAS float* row = sc + tok * SEL_LD + hf * 128;
#pragma unroll 4
        for (int n4 = 0; n4 < 32; ++n4) {
            const f32x4 v = *(const LAS f32x4*)(row + n4 * 4);
#pragma unroll
            for (int e = 0; e < 4; ++e) topk_insert(a, __uint_as_float((__float_as_uint(v[e]) & ~127u) | (unsigned)(n4 * 4 + e)));
        }
#pragma unroll
        for (int i = 0; i < 16; ++i) lst[(tok * 2 + hf) * 16 + i] = a[i];
    }
    __syncthreads();
    select_stage2<1>(p, c, SelMap{0, ((t0 >> 7) << 3) | hd, 0, 0, 0}, lst);
}
DI void select_naive(const Params& p, const Ctx& c) {
    const bf16_t* PQ = (const bf16_t*)(p.ws + OFF_PQ); const bf16_t* KEYS = (const bf16_t*)(p.ws + OFF_KEYS);
    LAS float* sc = (LAS float*)c.lds;
    for (int u = blockIdx.x; u < 128 * 8; u += gridDim.x) {
        const int hd = u & 7, t0 = (u >> 3) * 128;
        const int tok = c.tid >> 2, part = c.tid & 3, hf = part >> 1, n0 = (part & 1) * 64;
        const bf16_t* qrow = PQ + (size_t)hd * M * 256 + (size_t)(t0 + tok) * 256 + hf * 128;
        const bf16_t* kb = KEYS + (size_t)((hd * 2 + hf) * 128 + n0) * 128;
        for (int n = 0; n < 64; ++n) {
            float acc = 0.f;
#pragma unroll
            for (int d8 = 0; d8 < 16; ++d8) {
                const u32x4 a = *(const u32x4*)(qrow + d8 * 8), b = *(const u32x4*)(kb + (size_t)n * 128 + d8 * 8);
#pragma unroll
                for (int e = 0; e < 4; ++e) acc += bflo(a[e]) * bflo(b[e]) + bfhi(a[e]) * bfhi(b[e]);
            }
            sc[tok * SEL_LD + hf * 128 + n0 + n] = acc;
        }
        __syncthreads();
        select_tail(p, c, t0, hd);
    }
}


DI void select_batch(const Params& p, const Ctx& c, const SelMap mp) {
    const bf16_t* PQ = (const bf16_t*)(p.ws + OFF_PQ); const bf16_t* KEYS = (const bf16_t*)(p.ws + OFF_KEYS);
    LAS float* lst_all = (LAS float*)c.lds;
    const int lane = c.lane, r = lane & 31, h = lane >> 5, w = c.wave, tb = w & 3, hf = w >> 2;
#ifndef SEL_KEYS_LDS
#define SEL_KEYS_LDS 1
#endif
    LAS unsigned char* kl = c.lds + 65536;
    int hd_staged = -1;
#pragma unroll 1
    for (int q = 0; q < 4; ++q) {
        int t0, hd; sel_decode(mp, q, t0, hd);
        LAS float* lst = lst_all + q * 4096;
        const bf16_t* qrow = PQ + (size_t)hd * M * 256 + (size_t)(t0 + tb * 32 + r) * 256 + hf * 128 + h * 8;
        const bf16_t* kbase = KEYS + (size_t)((hd * 2 + hf) * 128 + r) * 128 + h * 8;
        if (SEL_KEYS_LDS && hd != hd_staged) {
            __syncthreads();
#pragma unroll
            for (int k = 0; k < 8; ++k) { const int pi = c.tid + 512 * k, row = pi >> 4, pc = pi & 15;
                *(LAS u32x4*)(kl + row * 256 + ((pc ^ (row & 15)) << 4)) = *(const u32x4*)(KEYS + (size_t)hd * 2 * 128 * 128 + (size_t)pi * 8); }
            __syncthreads();
            hd_staged = hd;
        }
        bf16x8 qf[8];
#pragma unroll
        for (int st = 0; st < 8; ++st) qf[st] = *(const bf16x8*)(qrow + st * 16);
        float a[16];
#pragma unroll
        for (int i = 0; i < 16; ++i) a[i] = -__builtin_inff();
#pragma unroll
        for (int kb = 0; kb < 4; ++kb) {
            f32x16 sc;
#pragma unroll
            for (int i = 0; i < 16; ++i) sc[i] = 0.f;
#pragma unroll
            for (int st = 0; st < 8; ++st) {
                const int krow = hf * 128 + kb * 32 + r, pc = st * 2 + h;
                const bf16x8 kf = SEL_KEYS_LDS ? *(const LAS bf16x8*)(kl + krow * 256 + ((pc ^ (krow & 15)) << 4)) : *(const bf16x8*)(kbase + (size_t)kb * 32 * 128 + st * 16);
                sc = MFMA32(kf, qf[st], sc);
            }
#pragma unroll
            for (int i = 0; i < 16; ++i) topk_insert(a, __uint_as_float((__float_as_uint(sc[i]) & ~127u) | (unsigned)(kb * 32 + (i & 3) + 8 * (i >> 2) + 4 * h)));
        }
        float bq[16];
#pragma unroll
        for (int i = 0; i < 16; ++i) bq[i] = __shfl_xor(a[i], 32);
#pragma unroll
        for (int i = 0; i < 16; ++i) topk_insert(a, bq[i]);
        if (h == 0) {
#pragma unroll
            for (int i = 0; i < 16; ++i) lst[((tb * 32 + r) * 2 + hf) * 16 + i] = a[i];
        }
    }
    __syncthreads();
    select_stage2<4>(p, c, mp, lst_all);
}
DI void select_fast(const Params& p, const Ctx& c) {
    for (int u0 = blockIdx.x; u0 < 128 * 8; u0 += 4 * gridDim.x) select_batch(p, c, SelMap{0, u0, (int)gridDim.x, 0, 0});
}
DI void select_own_tiles(const Params& p, const Ctx& c) {
    pg8::StaticOrder S; S.init(M, 2048, (int)gridDim.x, (int)blockIdx.x);
    asm volatile("s_waitcnt vmcnt(0)" ::: "memory");
    __syncthreads();
    if (c.tid == 0) { __builtin_amdgcn_fence(__ATOMIC_ACQUIRE, "agent"); asm volatile("s_waitcnt vmcnt(0)" ::: "memory"); }
    __syncthreads();
    for (int i = 0;; i += 2) {
        pg8::Unit u0, u1;
        if (!S.next(i, u0)) break;
        if (!S.next(i + 1, u1)) u1 = u0;
        select_batch(p, c, SelMap{1, u0.pm, u0.pn, u1.pm, u1.pn});
    }
}
#ifndef FAST_SEL
#define FAST_SEL 1
#endif

DI void phase_gather(const Params& p, const Ctx& c, float* dst, int rowmask = -1) {
    const bf16_t* H2 = (const bf16_t*)(p.ws + OFF_H); const unsigned char* U = p.ws + OFF_U16; const unsigned char* V = p.ws + OFF_V16LO;
    const int* IDX = (const int*)(p.ws + OFF_IDX); const float* GW = (const float*)(p.ws + OFF_GW); const float* mod = (const float*)(p.ws + OFF_MOD);
    constexpr int G = 8, GV = 16;
    const int lane = c.lane;
    unsigned* tokctr = (unsigned*)(p.ws + OFF_CTL) + 700;
    constexpr int NSTATIC = 6;
    LAS int* park = (LAS int*)(c.lds + c.wave * 20480);
    for (int it = 0;; ++it) {
        int m, slot; bool doU, doV;
        if (it < NSTATIC) { slot = it; m = c.gw + it * c.ngw; doU = true; doV = false; }
        else if (it < 2 * NSTATIC) { slot = it - NSTATIC; m = c.gw + slot * c.ngw; doU = false; doV = true; }
        else { unsigned t = 0; if (lane == 0) t = __hip_atomic_fetch_add(tokctr, 1u, __ATOMIC_RELAXED, __HIP_MEMORY_SCOPE_AGENT); m = NSTATIC * c.ngw + (int)__builtin_amdgcn_readfirstlane(t); if (m >= M) break; slot = 0; doU = true; doV = true; }
        if (m >= M) continue;
        const int b = m / SEQ;
        LAS int* ps = park + slot * 256;
        int ia = 0, ib = 0; float wa = 0.f, wb = 0.f;
        if (doU) {
        f32x2 hf[16];
#pragma unroll
        for (int i = 0; i < 4; ++i) { const u32x4 a = *(const u32x4*)(H2 + (size_t)m * D + lane * 32 + i * 8);
#pragma unroll
            for (int q = 0; q < 4; ++q) hf[4 * i + q] = (f32x2){bflo(a[q]), bfhi(a[q])}; }
        ia = IDX[(size_t)m * 128 + lane]; ib = IDX[(size_t)m * 128 + 64 + lane];
        const float ga = GW[(size_t)m * 128 + lane], gb = GW[(size_t)m * 128 + 64 + lane];
#pragma unroll 1
        for (int k0 = 0; k0 < 128; k0 += G) {
            u32x4 ua[G]; u32x2 ub[G];
#pragma unroll
            for (int g = 0; g < G; ++g) {
                const int e = __builtin_amdgcn_readlane(k0 < 64 ? ia : ib, (k0 + g) & 63) & rowmask;
                const unsigned char* ur = U + (size_t)e * 1536;
                ua[g] = *(const u32x4*)(ur + (unsigned)lane * 16u); ub[g] = *(const u32x2*)(ur + 1024u + (unsigned)lane * 8u);
            }
            float d[G];
#pragma unroll
            for (int g = 0; g < G; ++g) {
                const f32x32v f = __builtin_amdgcn_cvt_scalef32_pk32_f32_fp6((u32x6){ua[g][0], ua[g][1], ua[g][2], ua[g][3], ub[g][0], ub[g][1]}, 1.0f);
                f32x2 d2 = {0.f, 0.f};
#pragma unroll
                for (int i = 0; i < 16; ++i) d2 = (f32x2){f[2 * i], f[2 * i + 1]} * hf[i] + d2;
                d[g] = d2.x + d2.y;
            }
            { const bool u5 = lane & 32, u4 = lane & 16, u3 = lane & 8;
              float r4[4];
#pragma unroll
              for (int i = 0; i < 4; ++i) { const float send = u5 ? d[i] : d[4 + i], keep = u5 ? d[4 + i] : d[i]; r4[i] = keep + __shfl_xor(send, 32); }
              float r2[2];
#pragma unroll
              for (int i = 0; i < 2; ++i) { const float send = u4 ? r4[i] : r4[2 + i], keep = u4 ? r4[2 + i] : r4[i]; r2[i] = keep + __shfl_xor(send, 16); }
              const float send = u3 ? r2[0] : r2[1], keep = u3 ? r2[1] : r2[0];
              float r1 = keep + __shfl_xor(send, 8);
              r1 += __shfl_xor(r1, 4); r1 += __shfl_xor(r1, 2); r1 += __shfl_xor(r1, 1);
              const float act = gelu_tanh(r1 * (1.f / U8_SCALE)) * (1.f / V8_SCALE);
              const int gsel = lane - (k0 & 63);
              const int src = ((gsel & 4) << 3) | ((gsel & 2) << 3) | ((gsel & 1) << 3);
              const float got = __shfl(act, src & 63);
              if (gsel >= 0 && gsel < G) { if (k0 < 64) wa = got * ga; else wb = got * gb; }
            }
        }
        ps[lane] = ia; ps[64 + lane] = ib; ps[128 + lane] = __builtin_bit_cast(int, wa); ps[192 + lane] = __builtin_bit_cast(int, wb);
        }
        if (!doV) continue;
        if (!doU) { ia = ps[lane]; ib = ps[64 + lane]; wa = __builtin_bit_cast(float, ps[128 + lane]); wb = __builtin_bit_cast(float, ps[192 + lane]); }
        f32x2 acc[16];
#pragma unroll
        for (int i = 0; i < 16; ++i) acc[i] = (f32x2){0.f, 0.f};
#define VB_ISSUE(P, K0) do { _Pragma("unroll") for (int g = 0; g < 8; ++g) { \
            const int e = __builtin_amdgcn_readlane((K0) < 64 ? ia : ib, ((K0) + g) & 63) & rowmask; \
            P##w[g] = __builtin_bit_cast(float, __builtin_amdgcn_readlane(__builtin_bit_cast(int, (K0) < 64 ? wa : wb), ((K0) + g) & 63)); \
            const unsigned char* vr = V + (size_t)e * 1536; \
            P##a[g] = *(const u32x4*)(vr + (unsigned)lane * 16u); P##b[g] = *(const u32x2*)(vr + 1024u + (unsigned)lane * 8u); } } while (0)
#define VB_COMPUTE(P) do { _Pragma("unroll") for (int g = 0; g < 8; ++g) { const f32x2 w2 = {P##w[g], P##w[g]}; \
            const f32x32v f = __builtin_amdgcn_cvt_scalef32_pk32_f32_fp6((u32x6){P##a[g][0], P##a[g][1], P##a[g][2], P##a[g][3], P##b[g][0], P##b[g][1]}, 1.0f); \
            _Pragma("unroll") for (int i = 0; i < 16; ++i) acc[i] = (f32x2){f[2 * i], f[2 * i + 1]} * w2 + acc[i]; } } while (0)
        {
            u32x4 A_a[8], B_a[8]; u32x2 A_b[8], B_b[8]; float A_w[8], B_w[8];
            VB_ISSUE(A_, 0);
#pragma unroll 1
            for (int k0 = 0; k0 < 128; k0 += 16) {
                VB_ISSUE(B_, k0 + 8);
                VB_COMPUTE(A_);
                if (k0 + 16 < 128) VB_ISSUE(A_, k0 + 16);
                VB_COMPUTE(B_);
            }
        }
#undef VB_ISSUE
#undef VB_COMPUTE
        const float* orow = p.out + (size_t)m * D + lane * 32; float* drow = dst + (size_t)m * D + lane * 32; const float* gt2 = mod + b * 6 * D + 5 * D + lane * 32; const float* fg = p.fng + lane * 32;
        float ss = 0.f; f32x4 xv[8];
#pragma unroll
        for (int i = 0; i < 8; ++i) {
            const f32x4 xa = *(const f32x4*)(orow + 4 * i), ta = *(const f32x4*)(gt2 + 4 * i);
            const f32x4 pe = {acc[2 * i].x, acc[2 * i].y, acc[2 * i + 1].x, acc[2 * i + 1].y};
            const f32x4 v = xa + DBG_BETA * ta * pe; xv[i] = v; ss += (v[0] * v[0] + v[1] * v[1]) + (v[2] * v[2] + v[3] * v[3]);
        }
        const float rstd = rsqrtf(wave_sum(ss) * (1.f / D) + EPS);
#pragma unroll
        for (int i = 0; i < 8; ++i) *(f32x4*)(drow + 4 * i) = xv[i] * rstd * *(const f32x4*)(fg + 4 * i);
    }
}


DI void phase_gather_sorted(const Params& p, const Ctx& c) {
    const bf16_t* H2 = (const bf16_t*)(p.ws + OFF_H); const unsigned char* U = p.ws + OFF_U16; const unsigned char* V = p.ws + OFF_V16LO;
    const int* IDX = (const int*)(p.ws + OFF_IDX); const float* GW = (const float*)(p.ws + OFF_GW); const float* mod = (const float*)(p.ws + OFF_MOD);
    const int lane = c.lane;
    LAS unsigned char* wl = c.lds + c.wave * 20480;
    constexpr int RSH = 12;
    const bool u5 = lane & 32, u4 = lane & 16, u3 = lane & 8;
#pragma unroll 1
    for (int grp = 0; grp < 2; ++grp) {
        int sia[4], sib[4]; float sga[4], sgb[4]; u32x2 sh2[4][8];
#pragma unroll
        for (int t = 0; t < 4; ++t) {
            const int m = c.gw + (grp * 4 + t) * c.ngw;
            sia[t] = IDX[(size_t)m * 128 + lane]; sib[t] = IDX[(size_t)m * 128 + 64 + lane];
            sga[t] = GW[(size_t)m * 128 + lane]; sgb[t] = GW[(size_t)m * 128 + 64 + lane];
#pragma unroll
            for (int i = 0; i < 8; ++i) sh2[t][i] = COL_COALESCED ? *(const u32x2*)(H2 + (size_t)m * D + 256 * i + 4 * lane) : *(const u32x2*)(H2 + (size_t)m * D + lane * 32 + i * 4);
        }
#pragma unroll
        for (int t = 0; t < 4; ++t) {
            const int ia = sia[t], ib = sib[t]; const float ga = sga[t], gb = sgb[t];
            const int ra = ia >> RSH, rb = ib >> RSH;
            int off = 0, posA = 0, posB = 0;
#pragma unroll
            for (int r = 0; r < 4; ++r) {
                const unsigned long long mA = __ballot(ra == r), mB = __ballot(rb == r);
                const int cA = __builtin_popcountll(mA), cB = __builtin_popcountll(mB);
                const int rkA = __builtin_amdgcn_mbcnt_hi((unsigned)(mA >> 32), __builtin_amdgcn_mbcnt_lo((unsigned)mA, 0u));
                const int rkB = __builtin_amdgcn_mbcnt_hi((unsigned)(mB >> 32), __builtin_amdgcn_mbcnt_lo((unsigned)mB, 0u));
                posA = (ra == r) ? off + rkA : posA; posB = (rb == r) ? off + cA + rkB : posB; off += cA + cB;
            }
            LAS int* sE = (LAS int*)(wl + t * 1024); LAS float* sW = (LAS float*)(wl + t * 1024 + 512);
            sE[posA] = ia; sE[posB] = ib; sW[posA] = ga; sW[posB] = gb;
            LAS u32x4* hrow = (LAS u32x4*)(wl + 4096 + t * 4096 + lane * 64);
#pragma unroll
            for (int i = 0; i < 4; ++i) hrow[i] = (u32x4){sh2[t][2 * i].x, sh2[t][2 * i].y, sh2[t][2 * i + 1].x, sh2[t][2 * i + 1].y};
        }
        asm volatile("s_waitcnt lgkmcnt(0)" ::: "memory");
#pragma unroll 1
        for (int vi = 0; vi < 16; ++vi) {
            {
                const int r = vi >> 2, t = vi & 3;
                const int m = c.gw + (grp * 4 + t) * c.ngw;
                if (m >= M) continue;
                LAS int* sE = (LAS int*)(wl + t * 1024); LAS float* sW = (LAS float*)(wl + t * 1024 + 512);
                const int eLo = sE[lane], eHi = sE[64 + lane];
                const unsigned long long mLo = __ballot((eLo >> RSH) == r), mHi = __ballot((eHi >> RSH) == r);
                if (!(mLo | mHi)) continue;
                const int s0 = mLo ? __builtin_ctzll(mLo) : 64 + __builtin_ctzll(mHi);
                const int e1 = s0 + __builtin_popcountll(mLo) + __builtin_popcountll(mHi);
                float wLo = sW[lane], wHi = sW[64 + lane];
                f32x2 hf[16];
                { const LAS u32x4* hrow = (const LAS u32x4*)(wl + 4096 + t * 4096 + lane * 64);
#pragma unroll
                  for (int i = 0; i < 4; ++i) { const u32x4 a = hrow[i];
#pragma unroll
                    for (int q = 0; q < 4; ++q) hf[4 * i + q] = (f32x2){bflo(a[q]), bfhi(a[q])}; } }
#pragma unroll 1
                for (int j0 = s0; j0 < e1; j0 += 8) {
                    u32x4 ua[8]; u32x2 ub[8];
#pragma unroll
                    for (int g = 0; g < 8; ++g) {
                        const int pos = j0 + g;
                        ua[g] = (u32x4){0u, 0u, 0u, 0u}; ub[g] = (u32x2){0u, 0u};
                        if (pos < e1) {
                            const int e = __builtin_amdgcn_readlane(pos < 64 ? eLo : eHi, pos & 63);
                            const unsigned char* ur = U + (size_t)e * 1536;
                            ua[g] = *(const u32x4*)(ur + (unsigned)lane * 16u); ub[g] = *(const u32x2*)(ur + 1024u + (unsigned)lane * 8u);
                        }
                    }
                    float d[8];
#pragma unroll
                    for (int g = 0; g < 8; ++g) {
                        d[g] = 0.f;
                        if (j0 + g < e1) {
                            const f32x32v f = __builtin_amdgcn_cvt_scalef32_pk32_f32_fp6((u32x6){ua[g][0], ua[g][1], ua[g][2], ua[g][3], ub[g][0], ub[g][1]}, 1.0f);
                            f32x2 d2 = {0.f, 0.f};
#pragma unroll
                            for (int i = 0; i < 16; ++i) d2 = (f32x2){f[2 * i], f[2 * i + 1]} * hf[i] + d2;
                            d[g] = d2.x + d2.y;
                        }
                    }
                    float r4[4];
#pragma unroll
                    for (int i = 0; i < 4; ++i) { const float send = u5 ? d[i] : d[4 + i], keep = u5 ? d[4 + i] : d[i]; r4[i] = keep + __shfl_xor(send, 32); }
                    float r2[2];
#pragma unroll
                    for (int i = 0; i < 2; ++i) { const float send = u4 ? r4[i] : r4[2 + i], keep = u4 ? r4[2 + i] : r4[i]; r2[i] = keep + __shfl_xor(send, 16); }
                    const float send = u3 ? r2[0] : r2[1], keep = u3 ? r2[1] : r2[0];
                    float r1 = keep + __shfl_xor(send, 8);
                    r1 += __shfl_xor(r1, 4); r1 += __shfl_xor(r1, 2); r1 += __shfl_xor(r1, 1);
                    const float act = gelu_tanh(r1 * (1.f / U8_SCALE)) * (1.f / V8_SCALE);
                    const bool inLo = (lane >= j0) && (lane < j0 + 8);
                    const int gsel = inLo ? lane - j0 : lane + 64 - j0;
                    const int src = ((gsel & 4) << 3) | ((gsel & 2) << 3) | ((gsel & 1) << 3);
                    const float got = __shfl(act, src & 63);
                    if (gsel >= 0 && gsel < 8 && j0 + gsel < e1) { if (inLo) wLo = got * wLo; else wHi = got * wHi; }
                }
                sW[lane] = wLo; sW[64 + lane] = wHi;
            }
        }
        asm volatile("s_waitcnt lgkmcnt(0)" ::: "memory");
#pragma unroll 1
        for (int r = 0; r < 4; ++r) {
#pragma unroll 1
            for (int t = 0; t < 4; ++t) {
                const int m = c.gw + (grp * 4 + t) * c.ngw;
                if (m >= M) continue;
                LAS int* sE = (LAS int*)(wl + t * 1024); LAS float* sW = (LAS float*)(wl + t * 1024 + 512);
                LAS u32x4* pk = (LAS u32x4*)(wl + 4096 + t * 4096 + lane * 64);
                const int eLo = sE[lane], eHi = sE[64 + lane]; const float wLo = sW[lane], wHi = sW[64 + lane];
                const unsigned long long mLo = __ballot((eLo >> RSH) == r), mHi = __ballot((eHi >> RSH) == r);
                const int s0 = mLo ? __builtin_ctzll(mLo) : (mHi ? 64 + __builtin_ctzll(mHi) : 0);
                const int e1 = s0 + __builtin_popcountll(mLo) + __builtin_popcountll(mHi);
                f32x2 acc[16];
                if (r == 0) {
#pragma unroll
                    for (int i = 0; i < 16; ++i) acc[i] = (f32x2){0.f, 0.f};
                } else {
#pragma unroll
                    for (int i = 0; i < 4; ++i) { const u32x4 a = pk[i];
#pragma unroll
                        for (int q = 0; q < 4; ++q) acc[4 * i + q] = (f32x2){bflo(a[q]), bfhi(a[q])}; }
                }
#define SV_ISSUE(P, J0) do { _Pragma("unroll") for (int g = 0; g < 8; ++g) { const int pos = (J0) + g; P##w[g] = 0.f; P##a[g] = (u32x4){0u, 0u, 0u, 0u}; P##b[g] = (u32x2){0u, 0u}; \
                        if (pos < e1) { const int e = __builtin_amdgcn_readlane(pos < 64 ? eLo : eHi, pos & 63); \
                            P##w[g] = __builtin_bit_cast(float, __builtin_amdgcn_readlane(__builtin_bit_cast(int, pos < 64 ? wLo : wHi), pos & 63)); \
                            const unsigned char* vr = vrow(p.ws, e); P##a[g] = *(const u32x4*)(vr + (unsigned)lane * 16u); P##b[g] = *(const u32x2*)(vr + 1024u + (unsigned)lane * 8u); } } } while (0)
#define SV_COMPUTE(P, J0) do { _Pragma("unroll") for (int g = 0; g < 8; ++g) if ((J0) + g < e1) { const f32x2 w2 = {P##w[g], P##w[g]}; \
                        const f32x32v f = __builtin_amdgcn_cvt_scalef32_pk32_f32_fp6((u32x6){P##a[g][0], P##a[g][1], P##a[g][2], P##a[g][3], P##b[g][0], P##b[g][1]}, 1.0f); \
                        _Pragma("unroll") for (int i = 0; i < 16; ++i) acc[i] = (f32x2){f[2 * i], f[2 * i + 1]} * w2 + acc[i]; } } while (0)
                if (s0 < e1) {
                    u32x4 A_a[8], B_a[8]; u32x2 A_b[8], B_b[8]; float A_w[8], B_w[8];
                    SV_ISSUE(A_, s0);
#pragma unroll 1
                    for (int j0 = s0; j0 < e1; j0 += 16) {
                        if (j0 + 8 < e1) SV_ISSUE(B_, j0 + 8);
                        SV_COMPUTE(A_, j0);
                        if (j0 + 16 < e1) SV_ISSUE(A_, j0 + 16);
                        if (j0 + 8 < e1) SV_COMPUTE(B_, j0 + 8);
                    }
                }
#undef SV_ISSUE
#undef SV_COMPUTE
                if (r < 3) {
#pragma unroll
                    for (int i = 0; i < 4; ++i) pk[i] = (u32x4){pk2(acc[4 * i].x, acc[4 * i].y), pk2(acc[4 * i + 1].x, acc[4 * i + 1].y), pk2(acc[4 * i + 2].x, acc[4 * i + 2].y), pk2(acc[4 * i + 3].x, acc[4 * i + 3].y)};
                } else {
                    const int b = m / SEQ;
                    constexpr int CS = COL_COALESCED ? 256 : 4;
                    const int c0 = COL_COALESCED ? lane * 4 : lane * 32;
                    float* orow = p.out + (size_t)m * D + c0; const float* gt2 = mod + b * 6 * D + 5 * D + c0; const float* fg = p.fng + c0;
                    const bf16_t* x1b = (const bf16_t*)(p.ws + OFF_MERGED) + (size_t)m * D + c0;
                    float ss = 0.f; f32x4 xv[8];
#pragma unroll
                    for (int i = 0; i < 8; ++i) {
                        const f32x4 xa = X1_BF16 ? load_bf16x4(x1b + CS * i) : *(const f32x4*)(orow + CS * i), ta = *(const f32x4*)(gt2 + CS * i);
                        const f32x4 pe = {acc[2 * i].x, acc[2 * i].y, acc[2 * i + 1].x, acc[2 * i + 1].y};
                        const f32x4 v = xa + DBG_BETA * ta * pe; xv[i] = v; ss += (v[0] * v[0] + v[1] * v[1]) + (v[2] * v[2] + v[3] * v[3]);
                    }
                    const float rstd = rsqrtf(wave_sum(ss) * (1.f / D) + EPS);
#pragma unroll
                    for (int i = 0; i < 8; ++i) *(f32x4*)(orow + CS * i) = xv[i] * rstd * *(const f32x4*)(fg + CS * i);
                }
            }
        }
        asm volatile("s_waitcnt lgkmcnt(0)" ::: "memory");
    }
}
#ifndef GATHER_SORTED
#define GATHER_SORTED 1
#endif

struct XcdBarrier; DI void xcd_barrier(const XcdBarrier& b, int wave_s);
DI int rl2r(int a, int b, int k) { const int va = __builtin_amdgcn_readlane(a, k & 63), vb = __builtin_amdgcn_readlane(b, k & 63); return k < 64 ? va : vb; }
DI void phase_gather_rounds(const Params& p, const Ctx& c, const XcdBarrier& xbar) {
    const bf16_t* H2 = (const bf16_t*)(p.ws + OFF_H); const unsigned char* U = p.ws + OFF_U16; const unsigned char* V = p.ws + OFF_V16LO;
    const int* IDX = (const int*)(p.ws + OFF_IDX); const float* GW = (const float*)(p.ws + OFF_GW); const float* mod = (const float*)(p.ws + OFF_MOD);
    const int lane = c.lane;
    LAS unsigned char* wl = c.lds + c.wave * 20480;
    const bool u5 = lane & 32, u4 = lane & 16, u3 = lane & 8;
    constexpr int G = 8;
#pragma unroll 1
    for (int pass = 0; pass < 2; ++pass) {
#pragma unroll
        for (int t = 0; t < 4; ++t) {
            const int m = c.gw + (pass * 4 + t) * c.ngw;
            LAS unsigned char* ts = wl + t * 5120;
            if (m < M) {
#pragma unroll
                for (int i = 0; i < 4; ++i) *(LAS u32x4*)(ts + lane * 64 + i * 16) = *(const u32x4*)(H2 + (size_t)m * D + lane * 32 + i * 8);
                *(LAS int*)(ts + 4096 + lane * 4) = IDX[(size_t)m * 128 + lane]; *(LAS int*)(ts + 4096 + 256 + lane * 4) = IDX[(size_t)m * 128 + 64 + lane];
                *(LAS float*)(ts + 4608 + lane * 4) = GW[(size_t)m * 128 + lane]; *(LAS float*)(ts + 4608 + 256 + lane * 4) = GW[(size_t)m * 128 + 64 + lane];
            }
        }
        asm volatile("s_waitcnt vmcnt(0) lgkmcnt(0)" ::: "memory");
#pragma unroll 1
        for (int r = 0; r < 8; ++r) {
#pragma unroll 1
            for (int t = 0; t < 4; ++t) {
                if (c.gw + (pass * 4 + t) * c.ngw >= M) continue;
                LAS unsigned char* ts = wl + t * 5120;
                const int ia = *(LAS int*)(ts + 4096 + lane * 4), ib = *(LAS int*)(ts + 4096 + 256 + lane * 4);
                unsigned long long ma = __ballot((ia >> 11) == r), mb = __ballot((ib >> 11) == r);
                if (!(ma | mb)) continue;
                f32x2 hf[16];
#pragma unroll
                for (int i = 0; i < 4; ++i) { const u32x4 a = *(LAS u32x4*)(ts + lane * 64 + i * 16);
#pragma unroll
                    for (int q = 0; q < 4; ++q) hf[4 * i + q] = (f32x2){bflo(a[q]), bfhi(a[q])}; }
                float wa = 0.f, wb = 0.f; const unsigned long long ma0 = ma, mb0 = mb;
                while (ma | mb) {
                    u32x4 ua[G]; u32x2 ub[G]; int kk[G]; int n = 0;
#pragma unroll
                    for (int g = 0; g < G; ++g) {
                        int k = (g == 0) ? 0 : kk[g - 1];
                        if (ma) { k = __builtin_ctzll(ma); ma &= ma - 1; ++n; } else if (mb) { k = 64 + __builtin_ctzll(mb); mb &= mb - 1; ++n; }
                        kk[g] = k;
                        const int e = rl2r(ia, ib, k);
                        const unsigned char* ur = U + (size_t)e * 1536;
                        ua[g] = *(const u32x4*)(ur + (unsigned)lane * 16u); ub[g] = *(const u32x2*)(ur + 1024u + (unsigned)lane * 8u);
                    }
                    float d[G];
#pragma unroll
                    for (int g = 0; g < G; ++g) {
                        d[g] = 0.f;
                        if (g < n) {
                            const f32x32v f = __builtin_amdgcn_cvt_scalef32_pk32_f32_fp6((u32x6){ua[g][0], ua[g][1], ua[g][2], ua[g][3], ub[g][0], ub[g][1]}, 1.0f);
                            f32x2 d0 = {0.f, 0.f}, d1 = {0.f, 0.f};
#pragma unroll
                            for (int i = 0; i < 8; ++i) { d0 = (f32x2){f[4 * i], f[4 * i + 1]} * hf[2 * i] + d0; d1 = (f32x2){f[4 * i + 2], f[4 * i + 3]} * hf[2 * i + 1] + d1; }
                            d[g] = (d0.x + d0.y) + (d1.x + d1.y);
                        }
                    }
                    float r4[4];
#pragma unroll
                    for (int i = 0; i < 4; ++i) { const float send = u5 ? d[i] : d[4 + i], keep = u5 ? d[4 + i] : d[i]; r4[i] = keep + __shfl_xor(send, 32); }
                    float r2[2];
#pragma unroll
                    for (int i = 0; i < 2; ++i) { const float send = u4 ? r4[i] : r4[2 + i], keep = u4 ? r4[2 + i] : r4[i]; r2[i] = keep + __shfl_xor(send, 16); }
                    const float send = u3 ? r2[0] : r2[1], keep = u3 ? r2[1] : r2[0];
                    float r1 = keep + __shfl_xor(send, 8);
                    r1 += __shfl_xor(r1, 4); r1 += __shfl_xor(r1, 2); r1 += __shfl_xor(r1, 1);
                    const float act = gelu_tanh(r1 * (1.f / U8_SCALE)) * (1.f / V8_SCALE);
#pragma unroll
                    for (int g = 0; g < G; ++g) if (g < n) {
                        const float av = __builtin_bit_cast(float, __builtin_amdgcn_readlane(__builtin_bit_cast(int, act), ((g & 4) << 3) | ((g & 2) << 3) | ((g & 1) << 3)));
                        const int k = kk[g];
                        if (k < 64) { if (lane == k) wa = av; } else { if (lane == k - 64) wb = av; }
                    }
                }
                if ((ma0 >> lane) & 1ull) { LAS float* gp = (LAS float*)(ts + 4608 + lane * 4); *gp = *gp * wa; }
                if ((mb0 >> lane) & 1ull) { LAS float* gp = (LAS float*)(ts + 4608 + 256 + lane * 4); *gp = *gp * wb; }
            }
            if (DBG_ROUND_BAR) xcd_barrier(xbar, c.wave);
        }
        asm volatile("s_waitcnt lgkmcnt(0)" ::: "memory");
#pragma unroll 1
        for (int t = 0; t < 4; ++t) {
            const int m = c.gw + (pass * 4 + t) * c.ngw;
            if (m >= M) continue;
            const int b = m / SEQ;
            LAS unsigned char* ts = wl + t * 5120;
            const int ia = *(LAS int*)(ts + 4096 + lane * 4), ib = *(LAS int*)(ts + 4096 + 256 + lane * 4);
            const float wa = *(LAS float*)(ts + 4608 + lane * 4), wb = *(LAS float*)(ts + 4608 + 256 + lane * 4);
            f32x2 acc[16];
#pragma unroll
            for (int i = 0; i < 16; ++i) acc[i] = (f32x2){0.f, 0.f};
#pragma unroll 1
            for (int k0 = 0; k0 < 128; k0 += G) {
                u32x4 va[G]; u32x2 vb[G]; float wk[G];
#pragma unroll
                for (int g = 0; g < G; ++g) {
                    const int e = __builtin_amdgcn_readlane(k0 < 64 ? ia : ib, (k0 + g) & 63);
                    wk[g] = __builtin_bit_cast(float, __builtin_amdgcn_readlane(__builtin_bit_cast(int, k0 < 64 ? wa : wb), (k0 + g) & 63));
                    const unsigned char* vr = V + (size_t)e * 1536;
                    va[g] = *(const u32x4*)(vr + (unsigned)lane * 16u); vb[g] = *(const u32x2*)(vr + 1024u + (unsigned)lane * 8u);
                }
#pragma unroll
                for (int g = 0; g < G; ++g) { const f32x2 w2 = {wk[g], wk[g]};
                    const f32x32v f = __builtin_amdgcn_cvt_scalef32_pk32_f32_fp6((u32x6){va[g][0], va[g][1], va[g][2], va[g][3], vb[g][0], vb[g][1]}, 1.0f);
#pragma unroll
                    for (int i = 0; i < 16; ++i) acc[i] = (f32x2){f[2 * i], f[2 * i + 1]} * w2 + acc[i]; }
            }
            float* orow = p.out + (size_t)m * D + lane * 32; const float* gt2 = mod + b * 6 * D + 5 * D + lane * 32; const float* fg = p.fng + lane * 32;
            float ss = 0.f; f32x4 xv[8];
#pragma unroll
            for (int i = 0; i < 8; ++i) {
                const f32x4 xa = *(const f32x4*)(orow + 4 * i), ta = *(const f32x4*)(gt2 + 4 * i);
                const f32x4 pe = {acc[2 * i].x, acc[2 * i].y, acc[2 * i + 1].x, acc[2 * i + 1].y};
                const f32x4 v = xa + DBG_BETA * ta * pe; xv[i] = v; ss += (v[0] * v[0] + v[1] * v[1]) + (v[2] * v[2] + v[3] * v[3]);
            }
            const float rstd = rsqrtf(wave_sum(ss) * (1.f / D) + EPS);
#pragma unroll
            for (int i = 0; i < 8; ++i) *(f32x4*)(orow + 4 * i) = xv[i] * rstd * *(const f32x4*)(fg + 4 * i);
        }
    }
}
#ifndef GATHER_ROUNDS
#define GATHER_ROUNDS 0
#endif

constexpr size_t OFF_WK = OFF_GB + (size_t)32 * 1024 * 1024;
constexpr size_t OFF_SSQ = OFF_GB + (size_t)48 * 1024 * 1024;
constexpr int NPU = 2, NPV = 2;
struct PairPick { int k; bool valid; };
DI PairPick pick_next(unsigned long long& ma, unsigned long long& mb, int prev) {
    PairPick r;
    if (ma) { r.k = __builtin_ctzll(ma); ma &= ma - 1; r.valid = true; }
    else if (mb) { r.k = 64 + __builtin_ctzll(mb); mb &= mb - 1; r.valid = true; }
    else { r.k = prev; r.valid = false; }
    return r;
}
DI int rl2(int a, int b, int k) { const int va = __builtin_amdgcn_readlane(a, k & 63), vb = __builtin_amdgcn_readlane(b, k & 63); return k < 64 ? va : vb; }
DI float rl2f(float a, float b, int k) { return __builtin_bit_cast(float, rl2(__builtin_bit_cast(int, a), __builtin_bit_cast(int, b), k)); }

DI void gather_u(const Params& p, const Ctx& c) {
    const bf16_t* H2 = (const bf16_t*)(p.ws + OFF_H); const unsigned char* U = p.ws + OFF_U16;
    const int* IDX = (const int*)(p.ws + OFF_IDX); const float* GW = (const float*)(p.ws + OFF_GW); float* WK = (float*)(p.ws + OFF_WK);
    const int x = blockIdx.x & 7, jb = blockIdx.x >> 3, nj = ((int)gridDim.x - x + 7) >> 3;
    const int wl = jb * NWAVES + c.wave, nwl = nj * NWAVES;
    constexpr int G = 4, SH = (NPU == 2) ? 10 : 11;
#pragma unroll 1
    for (int ps = 0; ps < NPU; ++ps) {
        const int part = x * NPU + ps;
#pragma unroll 1
        for (int m = wl; m < M; m += nwl) {
            const int ia = IDX[(size_t)m * 128 + c.lane], ib = IDX[(size_t)m * 128 + 64 + c.lane];
            unsigned long long ma = __ballot((ia >> SH) == part), mb = __ballot((ib >> SH) == part);
            if (!(ma | mb)) continue;
            const unsigned long long ma0 = ma, mb0 = mb;
            float hf[2][16];
#pragma unroll
            for (int j = 0; j < 2; ++j) { const u32x4 a = *(const u32x4*)(H2 + (size_t)m * D + j * 1024 + c.lane * 16), bq = *(const u32x4*)(H2 + (size_t)m * D + j * 1024 + c.lane * 16 + 8);
#pragma unroll
                for (int q = 0; q < 4; ++q) { hf[j][2 * q] = bflo(a[q]); hf[j][2 * q + 1] = bfhi(a[q]); hf[j][8 + 2 * q] = bflo(bq[q]); hf[j][8 + 2 * q + 1] = bfhi(bq[q]); } }
            const float ga = GW[(size_t)m * 128 + c.lane], gb = GW[(size_t)m * 128 + 64 + c.lane];
            float wa = 0.f, wb = 0.f;
            int prev = 0;
            while (ma | mb) {
                PairPick pk[G]; u32x4 uu[G][2];
#pragma unroll
                for (int g = 0; g < G; ++g) { pk[g] = pick_next(ma, mb, prev); prev = pk[g].k;
                    const int e = rl2(ia, ib, pk[g].k);
                    const unsigned char* ur = U + (size_t)e * D;
#pragma unroll
                    for (int j = 0; j < 2; ++j) uu[g][j] = *(const u32x4*)(ur + ((unsigned)c.lane * 16u + j * 1024u)); }
                float d[G];
#pragma unroll
                for (int g = 0; g < G; ++g) {
                    float d0 = 0.f, d1 = 0.f;
#pragma unroll
                    for (int j = 0; j < 2; ++j)
#pragma unroll
                        for (int q = 0; q < 4; ++q) { const f32x2 lo = __builtin_amdgcn_cvt_pk_f32_fp8((int)uu[g][j][q], false), hi = __builtin_amdgcn_cvt_pk_f32_fp8((int)uu[g][j][q], true);
                            d0 += lo.x * hf[j][4 * q] + hi.x * hf[j][4 * q + 2]; d1 += lo.y * hf[j][4 * q + 1] + hi.y * hf[j][4 * q + 3]; }
                    d[g] = d0 + d1;
                }
#pragma unroll
                for (int o = 1; o < 64; o <<= 1)
#pragma unroll
                    for (int g = 0; g < G; ++g) d[g] += __shfl_xor(d[g], o);
#pragma unroll
                for (int g = 0; g < G; ++g) if (pk[g].valid) {
                    const float a = gelu_tanh(d[g] * (1.f / U8_SCALE)) * (1.f / V8_SCALE); const int k = pk[g].k;
                    if (k < 64) { if (c.lane == k) wa = a * ga; } else { if (c.lane == k - 64) wb = a * gb; }
                }
            }
            if ((ma0 >> c.lane) & 1ull) WK[(size_t)m * 128 + c.lane] = wa;
            if ((mb0 >> c.lane) & 1ull) WK[(size_t)m * 128 + 64 + c.lane] = wb;
        }
    }
}

DI void gather_v(const Params& p, const Ctx& c) {
    const unsigned char* V = p.ws + OFF_V16LO;
    const int* IDX = (const int*)(p.ws + OFF_IDX); const float* WK = (const float*)(p.ws + OFF_WK); const float* mod = (const float*)(p.ws + OFF_MOD);
    float* SSQ = (float*)(p.ws + OFF_SSQ);
    const int x = blockIdx.x & 7, jb = blockIdx.x >> 3, nj = ((int)gridDim.x - x + 7) >> 3;
    const int wl = jb * NWAVES + c.wave, nwl = nj * NWAVES;
    const int q4 = c.lane >> 4, l16 = c.lane & 15;
    const unsigned voff = 256u * x + l16 * 16u;
    constexpr int SHV = (NPV == 2) ? 13 : 14;
#pragma unroll 1
    for (int ps = 0; ps < NPV; ++ps) {
#pragma unroll 1
        for (int m = wl; m < M; m += nwl) {
            const int b = m / SEQ;
            const int ia = IDX[(size_t)m * 128 + c.lane], ib = IDX[(size_t)m * 128 + 64 + c.lane];
            const float wa = WK[(size_t)m * 128 + c.lane], wb = WK[(size_t)m * 128 + 64 + c.lane];
            unsigned long long ma = __ballot((ia >> SHV) == ps), mb = __ballot((ib >> SHV) == ps);
            float acc[16];
#pragma unroll
            for (int i = 0; i < 16; ++i) acc[i] = 0.f;
            int prev = 0;
            while (ma | mb) {
                u32x4 vv[4]; float wv[4];
#pragma unroll
                for (int s4 = 0; s4 < 4; ++s4) {
                    int e = 0; float w = 0.f;
#pragma unroll
                    for (int g = 0; g < 4; ++g) { const PairPick pk = pick_next(ma, mb, prev); prev = pk.k;
                        const int eg = rl2(ia, ib, pk.k); const float wg = pk.valid ? rl2f(wa, wb, pk.k) : 0.f;
                        e = (q4 == g) ? eg : e; w = (q4 == g) ? wg : w; }
                    vv[s4] = *(const u32x4*)(V + (size_t)e * D + voff); wv[s4] = w;
                }
#pragma unroll
                for (int s4 = 0; s4 < 4; ++s4)
#pragma unroll
                    for (int q = 0; q < 4; ++q) { const f32x2 lo = __builtin_amdgcn_cvt_pk_f32_fp8((int)vv[s4][q], false), hi = __builtin_amdgcn_cvt_pk_f32_fp8((int)vv[s4][q], true);
                        acc[4 * q] += wv[s4] * lo.x; acc[4 * q + 1] += wv[s4] * lo.y; acc[4 * q + 2] += wv[s4] * hi.x; acc[4 * q + 3] += wv[s4] * hi.y; }
            }
#pragma unroll
            for (int i = 0; i < 16; ++i) { acc[i] += __shfl_xor(acc[i], 16); acc[i] += __shfl_xor(acc[i], 32); }
            f32x4 sel;
#pragma unroll
            for (int e = 0; e < 4; ++e) sel[e] = q4 == 0 ? acc[e] : (q4 == 1 ? acc[4 + e] : (q4 == 2 ? acc[8 + e] : acc[12 + e]));
            const int col = 256 * x + 16 * l16 + 4 * q4;
            float* op = p.out + (size_t)m * D + col;
            const f32x4 val = *(const f32x4*)op + DBG_BETA * *(const f32x4*)(mod + b * 6 * D + 5 * D + col) * sel;
            *(f32x4*)op = val;
            if (ps == NPV - 1) { const float ss = wave_sum(val[0] * val[0] + val[1] * val[1] + val[2] * val[2] + val[3] * val[3]); if (c.lane == 0) SSQ[(size_t)m * 8 + x] = ss; }
        }
    }
}
DI void gather_final(const Params& p, const Ctx& c) {
    const float* SSQ = (const float*)(p.ws + OFF_SSQ);
    for (int m = c.gw; m < M; m += c.ngw) {
        float s = (c.lane < 8) ? SSQ[(size_t)m * 8 + c.lane] : 0.f;
        s += __shfl_xor(s, 1); s += __shfl_xor(s, 2); s += __shfl_xor(s, 4);
        const float rstd = rsqrtf(__shfl(s, 0) * (1.f / D) + EPS);
        float* orow = p.out + (size_t)m * D;
#pragma unroll
        for (int j = 0; j < 8; ++j) { const int col = (j * 64 + c.lane) * 4; *(f32x4*)(orow + col) = *(const f32x4*)(orow + col) * rstd * *(const f32x4*)(p.fng + col); }
    }
}
#ifndef GATHER_L2
#define GATHER_L2 0
#endif

DI void phase_gather_v2(const Params& p, const Ctx& c) {
    const bf16_t* H2 = (const bf16_t*)(p.ws + OFF_H);
    const int* IDX = (const int*)(p.ws + OFF_IDX); const float* GW = (const float*)(p.ws + OFF_GW); const float* mod = (const float*)(p.ws + OFF_MOD);
    LAS float* hs = (LAS float*)c.lds; LAS float* wk = hs + 2048; LAS int* ek = (LAS int*)(wk + 128); LAS float* red = (LAS float*)(ek + 128);
    for (int m = blockIdx.x; m < M; m += gridDim.x) {
        const int b = m / SEQ;
        __syncthreads();
        for (int i = c.tid; i < 2048; i += NTHREADS) hs[i] = bf2f(H2[(size_t)m * D + i]);
        if (c.tid < 128) ek[c.tid] = IDX[(size_t)m * 128 + c.tid];
        __syncthreads();
        for (int k = c.wave; k < 128; k += NWAVES) {
            const float* ur = p.pu + (size_t)ek[k] * D;
            float d = 0.f;
            for (int i = 0; i < 8; ++i) { const int col = i * 256 + c.lane * 4; const f32x4 u = *(const f32x4*)(ur + col);
                d += u[0] * hs[col] + u[1] * hs[col + 1] + u[2] * hs[col + 2] + u[3] * hs[col + 3]; }
            d = wave_sum(d);
            if (c.lane == 0) wk[k] = gelu_tanh(d) * GW[(size_t)m * 128 + k];
        }
        __syncthreads();
        const int col = c.tid * 4;
        f32x4 acc = {0.f, 0.f, 0.f, 0.f};
        for (int k = 0; k < 128; ++k) { const f32x4 v = *(const f32x4*)(p.pv + (size_t)ek[k] * D + col); acc += v * wk[k]; }
        float* orow = p.out + (size_t)m * D;
        const f32x4 x2 = *(const f32x4*)(orow + col) + DBG_BETA * *(const f32x4*)(mod + b * 6 * D + 5 * D + col) * acc;
        float ss = wave_sum(x2[0] * x2[0] + x2[1] * x2[1] + x2[2] * x2[2] + x2[3] * x2[3]);
        if (c.lane == 0) red[c.wave] = ss;
        __syncthreads();
        float tot = 0.f;
        for (int w = 0; w < NWAVES; ++w) tot += red[w];
        const float rstd = rsqrtf(tot * (1.f / D) + EPS);
        *(f32x4*)(orow + col) = x2 * rstd * *(const f32x4*)(p.fng + col);
    }
}


#define XB_TMO      128
#define XB_XCNT(j)  (256  + 64 * (j))
#define XB_XSUB(j)  (1280 + 64 * (j))
#define XB_XGEN(j)  (2304 + 64 * (j))
#define XB_TOP      3328
#define XB_TOPGEN   3392
#define XCD_BAR_WORDS 3456
#define XB_SPIN_CAP (1u << 18)

__device__ __forceinline__ unsigned xb_ld(unsigned* p)              { return __hip_atomic_load(p, __ATOMIC_RELAXED, __HIP_MEMORY_SCOPE_AGENT); }
__device__ __forceinline__ unsigned xb_add(unsigned* p, unsigned v) { return __hip_atomic_fetch_add(p, v, __ATOMIC_RELAXED, __HIP_MEMORY_SCOPE_AGENT); }
__device__ __forceinline__ unsigned xb_xcc_id() { return (unsigned)__builtin_amdgcn_s_getreg((3 << 11) | 20) & 0xFu; }
#define XB_SPIN(cond, bar) do { unsigned _sp = 0; while (cond) { __builtin_amdgcn_s_sleep(1); \
    if ((++_sp & 255u) == 0u) { if (xb_ld(&(bar)[XB_TMO])) break; if (_sp > XB_SPIN_CAP) { atomicAdd(&(bar)[XB_TMO], 1u); break; } } } } while (0)

struct XcdBarrier {
    unsigned* bar; unsigned x;
    volatile LAS unsigned* st;
};

__device__ __forceinline__ XcdBarrier xcd_barrier_post(unsigned* bar, volatile LAS unsigned* st) {
    XcdBarrier b; b.bar = bar; b.x = xb_xcc_id(); b.st = st;
    if (threadIdx.x == 0) (void)xb_add(&bar[XB_XCNT(b.x)], 1u);
    return b;
}
__device__ __forceinline__ void xcd_barrier_complete(unsigned* bar, unsigned x, unsigned& nloc, unsigned& nx) {
    const unsigned G = gridDim.x * gridDim.y * gridDim.z;
    unsigned sum, cnt, mine, sp = 0u;
    for (;;) {
        sum = 0u; cnt = 0u; mine = 0u;
#pragma unroll
        for (unsigned j = 0; j < 16; ++j) { const unsigned c = xb_ld(&bar[XB_XCNT(j)]); sum += c; cnt += (c > 0u) ? 1u : 0u; mine = (j == x) ? c : mine; }
        if (sum == G) break;
        __builtin_amdgcn_s_sleep(1);
        if ((++sp & 255u) == 0u) { if (xb_ld(&bar[XB_TMO])) break; if (sp > XB_SPIN_CAP) { atomicAdd(&bar[XB_TMO], 1u); break; } }
    }
    nloc = mine > 0u ? mine : 1u; nx = cnt > 0u ? cnt : 1u;
}

__device__ __forceinline__ bool xb_lead(int wave_s) { return wave_s == 0 && __builtin_amdgcn_mbcnt_hi(~0u, __builtin_amdgcn_mbcnt_lo(~0u, 0u)) == 0; }
__device__ __forceinline__ void xcd_barrier(const XcdBarrier& b, int wave_s) {
    asm volatile("s_waitcnt vmcnt(0)" ::: "memory");
    __syncthreads();
    if (xb_lead(wave_s)) {
        unsigned* bar = b.bar;
        __builtin_amdgcn_s_waitcnt(0);
        unsigned nloc = b.st[0], nx = b.st[1];
        if (nloc == 0u) { xcd_barrier_complete(bar, b.x, nloc, nx); b.st[0] = nloc; b.st[1] = nx; }
        const unsigned old = xb_add(&bar[XB_XSUB(b.x)], 1u);
        const unsigned gen = old / nloc;
        if (old + 1u == (gen + 1u) * nloc) {
            __builtin_amdgcn_fence(__ATOMIC_RELEASE, "agent");
            asm volatile("s_waitcnt vmcnt(0)" ::: "memory");
            const unsigned og = xb_add(&bar[XB_TOP], 1u);
            const unsigned tg = og / nx;
            if (og + 1u == (tg + 1u) * nx) xb_add(&bar[XB_TOPGEN], 1u);
            else XB_SPIN(xb_ld(&bar[XB_TOPGEN]) == tg, bar);
            __builtin_amdgcn_fence(__ATOMIC_ACQUIRE, "agent");
            asm volatile("s_waitcnt vmcnt(0)" ::: "memory");
        } else {
            XB_SPIN(xb_ld(&bar[XB_TOPGEN]) == gen, bar);
            __builtin_amdgcn_fence(__ATOMIC_ACQUIRE, "agent");
            asm volatile("s_waitcnt vmcnt(0)" ::: "memory");
        }
    }
    __syncthreads();
}

__device__ __forceinline__ void xcd_barrier_fill(const XcdBarrier& b, int wave_s, unsigned genk, const Params& p) {
    asm volatile("s_waitcnt vmcnt(0)" ::: "memory");
    __syncthreads();
    if (wave_s == 0) {
        if (xb_lead(wave_s)) {
            unsigned* bar = b.bar;
            __builtin_amdgcn_s_waitcnt(0);
            unsigned nloc = b.st[0], nx = b.st[1];
            if (nloc == 0u) { xcd_barrier_complete(bar, b.x, nloc, nx); b.st[0] = nloc; b.st[1] = nx; }
            const unsigned old = xb_add(&bar[XB_XSUB(b.x)], 1u);
            const unsigned gen = old / nloc;
            if (old + 1u == (gen + 1u) * nloc) {
                __builtin_amdgcn_fence(__ATOMIC_RELEASE, "agent");
                asm volatile("s_waitcnt vmcnt(0)" ::: "memory");
                const unsigned og = xb_add(&bar[XB_TOP], 1u);
                const unsigned tg = og / nx;
                if (og + 1u == (tg + 1u) * nx) xb_add(&bar[XB_TOPGEN], 1u);
                else XB_SPIN(xb_ld(&bar[XB_TOPGEN]) == tg, bar);
            } else {
                XB_SPIN(xb_ld(&bar[XB_TOPGEN]) == gen, bar);
            }
            __builtin_amdgcn_fence(__ATOMIC_ACQUIRE, "agent");
            asm volatile("s_waitcnt vmcnt(0)" ::: "memory");
            b.st[4] = genk;
        }
    } else {
        int l; asm volatile("v_mbcnt_lo_u32_b32 %0, -1, 0\n\tv_mbcnt_hi_u32_b32 %0, -1, %0" : "=v"(l));
        for (;;) {
            if (b.st[4] == genk) break;
            unsigned r = 0u;
            if (l == 0) r = __hip_atomic_fetch_add((LAS unsigned*)&b.st[3], 1u, __ATOMIC_RELAXED, __HIP_MEMORY_SCOPE_WORKGROUP);
            r = __builtin_amdgcn_readfirstlane(r);
            if (r >= (unsigned)FILL_ROWS) { while (b.st[4] != genk) __builtin_amdgcn_s_sleep(2); break; }
            convert_row(p, (int)(blockIdx.x * FILL_ROWS + r), l);
        }
    }
    asm volatile("s_waitcnt lgkmcnt(0)" ::: "memory");
    __syncthreads();
}

DI void grid_barrier(unsigned* ctr, unsigned target, int wave_s) {
    asm volatile("s_waitcnt vmcnt(0)" ::: "memory");
    __syncthreads();
    if (wave_s == 0) {
        const int l = __builtin_amdgcn_mbcnt_hi(~0u, __builtin_amdgcn_mbcnt_lo(~0u, 0u));
        if (l == 0) {
            __builtin_amdgcn_fence(__ATOMIC_RELEASE, "agent");
            asm volatile("s_waitcnt vmcnt(0)" ::: "memory");
            __hip_atomic_fetch_add(ctr, 1u, __ATOMIC_RELAXED, __HIP_MEMORY_SCOPE_AGENT);
            unsigned spins = 0;
            while (__hip_atomic_load(ctr, __ATOMIC_RELAXED, __HIP_MEMORY_SCOPE_AGENT) < target) { __builtin_amdgcn_s_sleep(2); if (++spins > (1u << 23)) break; }
            __builtin_amdgcn_fence(__ATOMIC_ACQUIRE, "agent");
            asm volatile("s_waitcnt vmcnt(0)" ::: "memory");
        }
    }
    __syncthreads();
}

__global__ void __launch_bounds__(NTHREADS, 2) mega(Params p) {
    extern __shared__ __attribute__((aligned(16))) unsigned char lds_raw[];
    const int wave_s = __builtin_amdgcn_readfirstlane(threadIdx.x >> 6);
#define MKCTX() Ctx c; { int l_; asm volatile("v_mbcnt_lo_u32_b32 %0, -1, 0\n\tv_mbcnt_hi_u32_b32 %0, -1, %0" : "=v"(l_)); c.lds = (LAS unsigned char*)lds_raw; c.lane = l_; c.wave = wave_s; c.tid = wave_s * 64 + l_; \
    c.gw = blockIdx.x * NWAVES + wave_s; c.ngw = gridDim.x * NWAVES; }
    unsigned char* ws = p.ws;
    const float* mod = (const float*)(ws + OFF_MOD);
    const int lo = p.ph_lo, hi = p.ph_hi;
    XcdBarrier xbar; xbar.bar = (unsigned*)(ws + OFF_XBAR); xbar.x = 0; xbar.st = nullptr;
    if (USE_XBAR && lo == 0 && hi == NPHASE) {
        volatile LAS unsigned* stw = (volatile LAS unsigned*)(lds_raw + LDS_BYTES - 32);
        if (threadIdx.x < 5 && threadIdx.x != 2) stw[threadIdx.x] = 0u;
        __syncthreads();
        xbar = xcd_barrier_post((unsigned*)(ws + OFF_XBAR), stw);
    }
#define IN(k) (lo <= (k) && (k) < hi)
#define SEAM(k) do { if (IN(k) && IN((k) + 1)) { if (USE_XBAR) { if (BAR_FILL && (k) < 8 && xbar.st) xcd_barrier_fill(xbar, wave_s, (unsigned)(k) + 1u, p); else xcd_barrier(xbar, wave_s); } else grid_barrier((unsigned*)(ws + OFF_CTL), (unsigned)((k) + 1) * gridDim.x, wave_s); \
    if (TIME_PHASE >= 0 && blockIdx.x == 0 && threadIdx.x == 0) ((unsigned long long*)(ws + OFF_CTL + 512))[(k) + 1] = __builtin_amdgcn_s_memrealtime(); } } while (0)

    if (TIME_PHASE >= 0 && blockIdx.x == 0 && threadIdx.x == 0) ((unsigned long long*)(ws + OFF_CTL + 512))[0] = __builtin_amdgcn_s_memrealtime();
    if (IN(0)) { MKCTX(); phase_prologue(p, c, true, PRO_SPLIT == 0); }
    SEAM(0);
    if (IN(1)) for (int rep_ = 0; rep_ < (DUP_PHASE == 1 ? 2 : 1); ++rep_) { MKCTX();
        const long long* modi = (const long long*)(ws + OFF_MODI); float* modw = (float*)(ws + OFF_MOD);
        for (int i = blockIdx.x * NTHREADS + c.tid; i < NB * 6 * D; i += gridDim.x * NTHREADS) modw[i] = (float)((double)modi[i] * (1.0 / 4294967296.0));
        modulate_rows<P2_FP8 != 0>(p.x, p.n1g, modi + 1 * D, modi + 0 * D, (bf16_t*)(ws + OFF_H), c);
        if (PRO_SPLIT) phase_prologue(p, c, false, true);
    }
    SEAM(1);
    if (IN(2)) for (int rep_ = 0; rep_ < (DUP_PHASE == 2 ? 2 : 1); ++rep_) { MKCTX();
        EpiProj e1{(bf16_t*)(ws + OFF_CQ), (bf16_t*)(ws + OFF_CKV), (bf16_t*)(ws + OFF_KR), (bf16_t*)(ws + OFF_SBQ), (bf16_t*)(ws + OFF_SBK), (bf16_t*)(ws + OFF_GA), (bf16_t*)(ws + OFF_GB), (const f32x2*)(ws + OFF_CS), P2_FP8 ? 1.f / W8_SCALE : 1.f};
#if P2_FP8
        GEMM8(c, ws + OFF_H, ws + OFF_WIN, M, 7168, 2048, e1);
#else
        GEMM(c, (const bf16_t*)(ws + OFF_H), (const bf16_t*)(ws + OFF_WIN), M, 7168, 2048, e1);
#endif
        if (DUP_GEMM == 20) GEMM(c, (const bf16_t*)(ws + OFF_H), (const bf16_t*)(ws + OFF_WIN), M, 7168, 2048, e1);
        EpiT e2{(bf16_t*)(ws + OFF_SBVT), nullptr, P2_FP8 ? 1.f / W8_SCALE : 1.f};
#if P2_FP8
        GEMM8(c, ws + OFF_WSBV, ws + OFF_H, 1024, M, 2048, e2);
#else
        GEMM(c, (const bf16_t*)(ws + OFF_WSBV), (const bf16_t*)(ws + OFF_H), 1024, M, 2048, e2);
#endif
        if (DUP_GEMM == 21) GEMM(c, (const bf16_t*)(ws + OFF_WSBV), (const bf16_t*)(ws + OFF_H), 1024, M, 2048, e2);
    }
    SEAM(2);
    if (IN(3)) for (int rep_ = 0; rep_ < (DUP_PHASE == 3 ? 2 : 1); ++rep_) { MKCTX(); phase_rowstats(p, c); }
    SEAM(3);
    if (DBG_XTRA_BAR) { for (int q_ = 0; q_ < DBG_XTRA_BAR; ++q_) { if (IN(3) && IN(4)) xcd_barrier(xbar, wave_s); } }
    if (IN(4)) for (int rep_ = 0; rep_ < (DUP_PHASE == 4 ? 2 : 1); ++rep_) { MKCTX();
        EpiUq e1{(bf16_t*)(ws + OFF_Q), (const float*)(ws + OFF_RSTQ), (const f32x2*)(ws + OFF_CS)};
        GEMM(c, (const bf16_t*)(ws + OFF_CQ), (const bf16_t*)(ws + OFF_WUQ), M, 1536, 512, e1);
        if (DUP_GEMM == 40) GEMM(c, (const bf16_t*)(ws + OFF_CQ), (const bf16_t*)(ws + OFF_WUQ), M, 1536, 512, e1);
        EpiRowScale e2{(bf16_t*)(ws + OFF_KN), 1024, (const float*)(ws + OFF_RSTKV)};
        GEMM(c, (const bf16_t*)(ws + OFF_CKV), (const bf16_t*)(ws + OFF_WUK), M, 1024, 256, e2);
        if (DUP_GEMM == 41) GEMM(c, (const bf16_t*)(ws + OFF_CKV), (const bf16_t*)(ws + OFF_WUK), M, 1024, 256, e2);
        EpiT e3{(bf16_t*)(ws + OFF_VT), (const float*)(ws + OFF_RSTKV), 1.f};
        if ((gridDim.x & 1) == 0) { if (blockIdx.x >= gridDim.x / 2) GEMM(c, (const bf16_t*)(ws + OFF_WUV), (const bf16_t*)(ws + OFF_CKV), 1024, M, 256, e3, (int)(gridDim.x / 2), (int)(blockIdx.x - gridDim.x / 2)); }
        else GEMM(c, (const bf16_t*)(ws + OFF_WUV), (const bf16_t*)(ws + OFF_CKV), 1024, M, 256, e3);
        if (DUP_GEMM == 42) GEMM(c, (const bf16_t*)(ws + OFF_WUV), (const bf16_t*)(ws + OFF_CKV), 1024, M, 256, e3);
    }
    SEAM(4);
    if (IN(5)) for (int rep_ = 0; rep_ < (DUP_PHASE == 5 ? 2 : 1); ++rep_) {
#if FAST_ATTN
        { MKCTX(); attn_mla_fast(p, c); }
        if (DUP_GEMM == 51) { MKCTX(); attn_mla_fast(p, c); }
        { MKCTX(); attn_sb_fast(p, c); }
        if (DUP_GEMM == 52) { MKCTX(); attn_sb_fast(p, c); }
#else
        MKCTX();
        attn_mla_naive(p, c); attn_sb_naive(p, c);
#endif
    }
    SEAM(5);
    if (IN(6)) for (int rep_ = 0; rep_ < (DUP_PHASE == 6 ? 2 : 1); ++rep_) { MKCTX();
        EpiGate1 e1{(bf16_t*)(ws + OFF_MERGED), (const bf16_t*)(ws + OFF_GA), P67_FP8 ? 1.f / (W8_SCALE * ACT8_SCALE) : 1.f};
#if P67_FP8
        GEMM8(c, ws + OFF_ATTA, ws + OFF_WA, M, 2048, 1024, e1);
#else
        GEMM(c, (const bf16_t*)(ws + OFF_ATTA), (const bf16_t*)(ws + OFF_WA), M, 2048, 1024, e1);
#endif
        if (DUP_GEMM == 60) GEMM(c, (const bf16_t*)(ws + OFF_ATTA), (const bf16_t*)(ws + OFF_WA), M, 2048, 1024, e1);
        EpiGate2 e2{(bf16_t*)(ws + OFF_MERGED), (const bf16_t*)(ws + OFF_GB), ws + OFF_H, P67_FP8 ? 1.f / (W8_SCALE * ACT8_SCALE) : 1.f};
#if P67_FP8
        GEMM8(c, ws + OFF_ATTB, ws + OFF_WB, M, 2048, 1024, e2);
#else
        GEMM(c, (const bf16_t*)(ws + OFF_ATTB), (const bf16_t*)(ws + OFF_WB), M, 2048, 1024, e2);
#endif
    }
    SEAM(6);
    if (IN(7)) for (int rep_ = 0; rep_ < (DUP_PHASE == 7 ? 2 : 1); ++rep_) { MKCTX();
        EpiRes e{p.x, mod + 2 * D, X1_BF16 ? (float*)(ws + OFF_MERGED) : p.out, P67_FP8 ? 1.f / (W8_SCALE * ACT8_SCALE) : 1.f};
#if P67_FP8
        GEMM8(c, ws + OFF_H, ws + OFF_WOUT, M, 2048, 2048, e);
#else
        GEMM(c, (const bf16_t*)(ws + OFF_MERGED), (const bf16_t*)(ws + OFF_WOUT), M, 2048, 2048, e);
#endif
    }
    SEAM(7);
    if (IN(8)) for (int rep_ = 0; rep_ < (DUP_PHASE == 8 ? 2 : 1); ++rep_) { MKCTX();
        modulate_rows<false, X1_BF16 != 0>(X1_BF16 ? (const float*)(ws + OFF_MERGED) : p.out, p.n2g, mod + 4 * D, mod + 3 * D, (bf16_t*)(ws + OFF_H), c);
        if (BAR_FILL && xbar.st) {
            for (;;) { unsigned r = 0u; if (c.lane == 0) r = __hip_atomic_fetch_add((LAS unsigned*)&xbar.st[3], 1u, __ATOMIC_RELAXED, __HIP_MEMORY_SCOPE_WORKGROUP);
                r = __builtin_amdgcn_readfirstlane(r); if (r >= (unsigned)FILL_ROWS) break; convert_row(p, (int)(blockIdx.x * FILL_ROWS + r), c.lane); }
        } else {
        convert_table(p.pu, ws + OFF_U16, U8_SCALE, c);
        convert_table(p.pv, ws + OFF_V16LO, V8_SCALE, c);
        }
    }
    SEAM(8);
    if (IN(9)) for (int rep_ = 0; rep_ < (DUP_PHASE == 9 ? 2 : 1); ++rep_) { MKCTX();
        EpiPq e{(bf16_t*)(ws + OFF_PQ)};
        GEMM(c, (const bf16_t*)(ws + OFF_H), (const bf16_t*)(ws + OFF_WPQ), M, 2048, 2048, e);
#if FAST_SEL && FAST_GEMM && SEL_FUSED
        { MKCTX(); select_own_tiles(p, c); }
#endif
    }
#if !(FAST_SEL && FAST_GEMM && SEL_FUSED)
    SEAM(9);
    if (IN(10)) for (int rep_ = 0; rep_ < (DUP_PHASE == 10 ? 2 : 1); ++rep_) { MKCTX();
#if FAST_SEL
        select_fast(p, c);
#else
        select_naive(p, c);
#endif
    }
#else
    if (IN(9) && IN(10)) {   }
#endif
    SEAM(10);
#if GATHER_L2
    if (IN(11)) { MKCTX(); gather_u(p, c); }
    SEAM(11);
    if (IN(12)) { MKCTX(); gather_v(p, c); }
    SEAM(12);
    if (IN(13)) { MKCTX(); gather_final(p, c); }
#else
#if GATHER_SORTED
    if (IN(11)) { MKCTX(); phase_gather_sorted(p, c); }
#elif GATHER_ROUNDS
    if (IN(11)) { MKCTX(); phase_gather_rounds(p, c, xbar); }
#else
    if (IN(11)) { if (DUP_GEMM == 110) { MKCTX(); phase_gather(p, c, (float*)(ws + OFF_SBQ)); }
        if (DUP_GEMM == 111) { MKCTX(); phase_gather(p, c, (float*)(ws + OFF_SBQ), 0x3ff); } MKCTX(); phase_gather(p, c, p.out); }
#endif
#endif
#undef IN
#undef SEAM
}

extern "C" void kernel_launch(void* const* d_in, const int* in_sizes, int n_in, void* d_out, int out_size, void* d_ws, size_t ws_size, hipStream_t stream) {
    static int grid = 0;
    if (grid == 0) {
        if (n_in != 20 || out_size != M * D || ws_size < WS_END2) { fprintf(stderr, "kernel_launch: unexpected shapes (n_in %d out %d ws %zu need %zu)\n", n_in, out_size, ws_size, (size_t)WS_END2); grid = -1; return; }
        int dev = 0, cus = 0, per_cu = 0;
        (void)hipGetDevice(&dev); (void)hipDeviceGetAttribute(&cus, hipDeviceAttributeMultiprocessorCount, dev);
        if (hipFuncSetAttribute((const void*)mega, hipFuncAttributeMaxDynamicSharedMemorySize, LDS_BYTES) != hipSuccess) { fprintf(stderr, "kernel_launch: hipFuncSetAttribute failed\n"); grid = -1; return; }
        if (hipOccupancyMaxActiveBlocksPerMultiprocessor(&per_cu, (const void*)mega, NTHREADS, LDS_BYTES) != hipSuccess || per_cu < 1) { fprintf(stderr, "kernel_launch: occupancy query failed (%d)\n", per_cu); per_cu = 1; }
        (void)hipGetLastError();
        grid = cus;
    }
    if (grid < 0) return;
    (void)hipMemsetAsync((char*)d_ws + OFF_CTL, 0, ZERO_BYTES, stream);
    Params p{};
    p.x = (const float*)d_in[0]; p.c = (const float*)d_in[1]; p.pos = (const int*)d_in[2]; p.ada_w = (const float*)d_in[3]; p.ada_b = (const float*)d_in[4];
    p.n1g = (const float*)d_in[5]; p.n2g = (const float*)d_in[6]; p.w_in = (const float*)d_in[7]; p.qng = (const float*)d_in[8]; p.kvng = (const float*)d_in[9];
    p.w_uq = (const float*)d_in[10]; p.w_ukv = (const float*)d_in[11]; p.w_bm = (const float*)d_in[12]; p.w_bs = (const float*)d_in[13]; p.w_out = (const float*)d_in[14];
    p.w_pq = (const float*)d_in[15]; p.skeys = (const float*)d_in[16]; p.pu = (const float*)d_in[17]; p.pv = (const float*)d_in[18]; p.fng = (const float*)d_in[19];
    p.out = (float*)d_out; p.ws = (unsigned char*)d_ws;
    for (int i = 0; i < 32; ++i) p.invf[i] = (float)pow(10000.0, -(double)i / 32.0);
#if N_LAUNCH_MODE == 1
    p.ph_lo = 0; p.ph_hi = NPHASE;
    void* args[] = {&p};
    hipError_t e = hipLaunchCooperativeKernel((const void*)mega, dim3(grid), dim3(NTHREADS), args, LDS_BYTES, stream);
    if (e != hipSuccess) fprintf(stderr, "cooperative launch failed: %s (grid %d)\n", hipGetErrorString(e), grid);
#else
    for (int k = 0; k < NPHASE; ++k) {
        p.ph_lo = k; p.ph_hi = k + 1;
        hipLaunchKernelGGL(mega, dim3(grid), dim3(NTHREADS), LDS_BYTES, stream, p);
    }
#endif
}
```
